# Optimizing an MI355X kernel written in HIP

```python
import math
import numpy as np
import jax
import jax.numpy as jnp
from jax import lax

D_MODEL = 1024
BATCH = 8
SEQ = 2048
DEPTH = 4
DEC_BATCH = 128
DEC_SEQ = 1
PAST_LEN = 2048
PAGE_SIZE = 128

N_A_LAYERS = DEPTH // 2
N_B_LAYERS = DEPTH - N_A_LAYERS
MIX_W = 3 * D_MODEL // 4
MEM_W = D_MODEL - MIX_W
HEAD_DIM = 64
MEM_HEADS = MEM_W // HEAD_DIM
MEM_TOKENS = 256
MLSTM_HEADS = 4
MLSTM_DH = MIX_W // MLSTM_HEADS
MLSTM_CHUNK = 64
NSA_HEADS = MIX_W // HEAD_DIM
NSA_KV_HEADS = 2
NSA_GROUP = NSA_HEADS // NSA_KV_HEADS
CMP_LEN = 32
CMP_STRIDE = 16
CMP_HIDDEN = 128
SLC_BLOCK = 64
N_SELECT = 8
WINDOW = 512
WIN_QBLOCK = 128
SLC_QBLOCK = 64
REL_BUCKETS = 32
REL_MAX_EXACT = 16
REL_MAX_DIST = 128
D_FF = -(-(8 * D_MODEL) // (3 * 256)) * 256
A_COLS = 4 * MIX_W + 2 * MLSTM_HEADS + MEM_W
B_COLS = MIX_W + 3 * NSA_HEADS + MEM_W
KV_COLS = 3 * 2 * NSA_KV_HEADS * HEAD_DIM
EPS = 1e-6
NEG = -1e30
FORCED = 1e6

kernel_name = 'yoco_mlstm_nsa_decode_step'


def rmsnorm(x, g):
    xf = x.astype(jnp.float32)
    y = xf * lax.rsqrt(jnp.mean(xf * xf, axis=-1, keepdims=True) + EPS)
    return (y * g.astype(jnp.float32)).astype(x.dtype)


def masked_softmax(s, mask):
    p = jax.nn.softmax(jnp.where(mask, s, NEG), axis=-1)
    return jnp.where(mask, p, 0.0)


def rel_bucket(dist):
    d = jnp.maximum(dist, 0)
    ratio = jnp.maximum(d, REL_MAX_EXACT).astype(jnp.float32) / REL_MAX_EXACT
    large = REL_MAX_EXACT + (jnp.log(ratio) / math.log(REL_MAX_DIST / REL_MAX_EXACT)
                             * (REL_BUCKETS - REL_MAX_EXACT)).astype(jnp.int32)
    return jnp.where(d < REL_MAX_EXACT, d, jnp.minimum(large, REL_BUCKETS - 1))


def swiglu(h, w_gu, w_down):
    gu = h @ w_gu
    return (jax.nn.silu(gu[..., :D_FF]) * gu[..., D_FF:]) @ w_down


def mem_kv_rows(mem, w, g_k):
    b, m, _ = mem.shape
    kv = (mem @ w).reshape(b, m, 2, MEM_HEADS, HEAD_DIM)
    return jnp.stack([rmsnorm(kv[:, :, 0], g_k), kv[:, :, 1]], axis=2)


def mem_attn(pm, mkv, g_q):
    b, s, _ = pm.shape
    q = rmsnorm(pm.reshape(b, s, MEM_HEADS, HEAD_DIM), g_q)
    sc = jnp.einsum('bshd,bmhd->bhsm', q, mkv[:, :, 0], preferred_element_type=jnp.float32) * HEAD_DIM ** -0.5
    p = jax.nn.softmax(sc, axis=-1)
    o = jnp.einsum('bhsm,bmhd->bshd', p.astype(mkv.dtype), mkv[:, :, 1])
    return o.reshape(b, s, MEM_W).astype(pm.dtype)


def mlstm_chunkwise(q, k, v, i_pre, logf, c0, n0, m0):
    b, s, h, d = q.shape
    L = MLSTM_CHUNK if s % MLSTM_CHUNK == 0 else s
    nc = s // L

    def chunks(a):
        return jnp.swapaxes(a.reshape(b, nc, L, *a.shape[2:]), 0, 1)

    causal = jnp.tril(jnp.ones((L, L), dtype=bool))

    def step(carry, xs):
        c, n, m = carry
        qc, kc, vc, ic, fc = xs
        bcum = jnp.swapaxes(jnp.cumsum(fc, axis=1), 1, 2)
        ig = jnp.swapaxes(ic, 1, 2)
        log_d = jnp.where(causal, bcum[..., :, None] - bcum[..., None, :] + ig[..., None, :], -jnp.inf)
        log_inter = bcum + m[..., None]
        m_t = jnp.maximum(jnp.max(log_d, axis=-1), log_inter)
        w_intra = jnp.exp(log_d - m_t[..., None])
        w_inter = jnp.exp(log_inter - m_t)
        sc = jnp.einsum('bthd,bshd->bhts', qc, kc) * w_intra
        num = jnp.einsum('bhts,bshd->bhtd', sc, vc) + w_inter[..., None] * jnp.einsum('bthd,bhde->bhte', qc, c)
        den = jnp.sum(sc, axis=-1) + w_inter * jnp.einsum('bthd,bhd->bht', qc, n)
        hh = num / jnp.maximum(jnp.abs(den), jnp.exp(-m_t))[..., None]
        g = bcum[..., -1]
        m_new = m_t[..., -1]
        w_s = jnp.exp(g[..., None] - bcum + ig - m_new[..., None])
        decay = jnp.exp(g + m - m_new)
        c_new = decay[..., None, None] * c + jnp.einsum('bhs,bshd,bshe->bhde', w_s, kc, vc)
        n_new = decay[..., None] * n + jnp.einsum('bhs,bshd->bhd', w_s, kc)
        return (c_new, n_new, m_new), jnp.swapaxes(hh, 1, 2)

    (c, n, m), hs = lax.scan(step, (c0, n0, m0), tuple(chunks(a) for a in (q, k, v, i_pre, logf)))
    return jnp.swapaxes(hs, 0, 1).reshape(b, s, h, d), (c, n, m)


def mlstm_mixer(p, state, b_if, g_hnorm):
    b, s, _ = p.shape
    f32 = jnp.float32

    def heads(a):
        return a.reshape(b, s, MLSTM_HEADS, MLSTM_DH).astype(f32)

    q = heads(p[..., :MIX_W])
    k = heads(p[..., MIX_W:2 * MIX_W]) * MLSTM_DH ** -0.5
    v = heads(p[..., 2 * MIX_W:3 * MIX_W])
    o = p[..., 3 * MIX_W:4 * MIX_W].astype(f32)
    gates = p[..., 4 * MIX_W:4 * MIX_W + 2 * MLSTM_HEADS].astype(f32) + b_if.astype(f32)
    i_pre = gates[..., :MLSTM_HEADS]
    logf = jax.nn.log_sigmoid(gates[..., MLSTM_HEADS:])
    c0, n0, m0 = (a.astype(f32) for a in state)
    h, new_state = mlstm_chunkwise(q, k, v, i_pre, logf, c0, n0, m0)
    h = rmsnorm(h, g_hnorm).reshape(b, s, MIX_W)
    return (jax.nn.sigmoid(o) * h).astype(p.dtype), new_state


def kv_rows(x, g_kv, w_kv, g_k_slc, g_k_win):
    b, s, _ = x.shape
    kv = (rmsnorm(x, g_kv) @ w_kv).reshape(b, s, 3, 2, NSA_KV_HEADS, HEAD_DIM)
    cmp = kv[:, :, 0]
    slc = jnp.stack([rmsnorm(kv[:, :, 1, 0], g_k_slc), kv[:, :, 1, 1]], axis=2)
    win = jnp.stack([rmsnorm(kv[:, :, 2, 0], g_k_win), kv[:, :, 2, 1]], axis=2)
    return cmp, slc, win


def compress(cmp_kv, w1, b1, w2, b2, pos_enc, g_k_cmp):
    b, t = cmp_kv.shape[:2]
    r_n = CMP_LEN // CMP_STRIDE
    nc = (t - CMP_LEN) // CMP_STRIDE + 1
    nseg = nc + r_n - 1
    seg = cmp_kv[:, :nseg * CMP_STRIDE].reshape(b, nseg, CMP_STRIDE, 2, NSA_KV_HEADS, HEAD_DIM)
    w1r = w1.reshape(2, r_n, CMP_STRIDE, HEAD_DIM, CMP_HIDDEN)
    pe = jnp.einsum('pcd,cpdh->ch', pos_enc, w1)
    pre = (b1 + pe)[None, None, :, None, :]
    for r in range(r_n):
        pre = pre + jnp.einsum('bnucgd,cudh->bncgh', seg[:, r:r + nc], w1r[:, r])
    out = jnp.einsum('bncgh,chd->bncgd', jax.nn.gelu(pre), w2) + b2[None, None, :, None, :]
    ck = rmsnorm(out[:, :, 0], g_k_cmp)
    cv = out[:, :, 1]
    c_end = jnp.arange(nc) * CMP_STRIDE + CMP_LEN - 1
    return ck, cv, c_end


def cmp_to_slc_matrix(n_cmp, n_slc):
    c0 = np.arange(n_cmp)[:, None] * CMP_STRIDE
    s0 = np.arange(n_slc)[None, :] * SLC_BLOCK
    ov = np.clip(np.minimum(c0 + CMP_LEN, s0 + SLC_BLOCK) - np.maximum(c0, s0), 0, None)
    return jnp.asarray(ov / CMP_STRIDE, dtype=jnp.float32)


def cmp_branch(q, qpos, ck, cv, c_end, table):
    sc = jnp.einsum('bsgzd,bngd->bsgzn', q, ck, preferred_element_type=jnp.float32) * HEAD_DIM ** -0.5
    dist = qpos[:, None] - c_end[None, :]
    bias = jnp.transpose(table[rel_bucket(dist)], (0, 2, 3, 1))
    p = masked_softmax(sc + bias[None], (dist >= 0)[:, None, None, :])
    o = jnp.einsum('bsgzn,bngd->bsgzd', p.astype(cv.dtype), cv)
    return o, p


def select_blocks(p_cmp, qpos, n_slc):
    imp = jnp.einsum('bsgzn,nj->bsgj', p_cmp, cmp_to_slc_matrix(p_cmp.shape[-1], n_slc))
    j = jnp.arange(n_slc)
    cur = (qpos // SLC_BLOCK)[:, None]
    valid = j <= cur
    forced = (j == 0) | (j == cur) | (j == cur - 1)
    score = jnp.where(forced[None, :, None], FORCED, jnp.where(valid[None, :, None], imp, -1.0))
    _, idx = lax.top_k(score, min(N_SELECT, n_slc))
    return idx


def slc_branch(q, qpos, idx, fetch, table):
    b, s = q.shape[:2]
    qb = SLC_QBLOCK if s % SLC_QBLOCK == 0 else s
    nb = s // qb
    g_i = jnp.arange(NSA_KV_HEADS)[None, None, :, None]

    def blk(args):
        qx, px, ix = args
        tok = (ix[..., None] * SLC_BLOCK + jnp.arange(SLC_BLOCK)).reshape(b, qb, NSA_KV_HEADS, -1)
        kx, vx = fetch(tok)
        sc = jnp.einsum('bsgzd,bsgjd->bsgzj', qx, kx, preferred_element_type=jnp.float32) * HEAD_DIM ** -0.5
        dist = px[None, :, None, None] - tok
        bias = jnp.swapaxes(table[rel_bucket(dist), g_i], -1, -2)
        p = masked_softmax(sc + bias, (dist >= 0)[:, :, :, None, :])
        return jnp.einsum('bsgzj,bsgjd->bsgzd', p.astype(vx.dtype), vx)

    qs = jnp.swapaxes(q.reshape(b, nb, qb, NSA_KV_HEADS, NSA_GROUP, HEAD_DIM), 0, 1)
    ids = jnp.swapaxes(idx.reshape(b, nb, qb, NSA_KV_HEADS, idx.shape[-1]), 0, 1)
    out = lax.map(blk, (qs, qpos.reshape(nb, qb), ids))
    return jnp.swapaxes(out, 0, 1).reshape(b, s, NSA_KV_HEADS, NSA_GROUP, HEAD_DIM)


def win_branch(q, q_pos0, wkv, wpos0, table):
    b, s = q.shape[:2]
    qb = WIN_QBLOCK if s % WIN_QBLOCK == 0 else s
    nb = s // qb
    lk = WINDOW + qb
    wpad = jnp.pad(wkv, ((0, 0), (WINDOW, 0), (0, 0), (0, 0), (0, 0)))
    starts = q_pos0 + jnp.arange(nb) * qb
    offs = jnp.arange(lk)
    kidx = starts[:, None] - wpos0 + offs[None, :]
    kpos = starts[:, None] - WINDOW + offs[None, :]

    def blk(args):
        qx, px, ki, kp = args
        kv = jnp.take(wpad, ki, axis=1)
        sc = jnp.einsum('bigzd,bjgd->bgzij', qx, kv[:, :, 0], preferred_element_type=jnp.float32) * HEAD_DIM ** -0.5
        dist = px[:, None] - kp[None, :]
        bias = jnp.transpose(table[rel_bucket(dist)], (2, 3, 0, 1))
        mask = (dist >= 0) & (dist < WINDOW) & (kp >= wpos0)[None, :]
        p = masked_softmax(sc + bias[None], mask)
        return jnp.einsum('bgzij,bjgd->bigzd', p.astype(kv.dtype), kv[:, :, 1])

    qs = jnp.swapaxes(q.reshape(b, nb, qb, NSA_KV_HEADS, NSA_GROUP, HEAD_DIM), 0, 1)
    qpos = (q_pos0 + jnp.arange(s)).reshape(nb, qb)
    out = lax.map(blk, (qs, qpos, kidx, kpos))
    return jnp.swapaxes(out, 0, 1).reshape(b, s, NSA_KV_HEADS, NSA_GROUP, HEAD_DIM)


def nsa_mixer(p, q_pos0, ctx, g_q, b_gate, rel_table):
    b, s, _ = p.shape
    q = rmsnorm(p[..., :MIX_W].reshape(b, s, NSA_HEADS, HEAD_DIM), g_q)
    q = q.reshape(b, s, NSA_KV_HEADS, NSA_GROUP, HEAD_DIM)
    gates = jax.nn.sigmoid(p[..., MIX_W:MIX_W + 3 * NSA_HEADS].astype(jnp.float32) + b_gate.astype(jnp.float32))
    gates = gates.reshape(b, s, 3, NSA_KV_HEADS, NSA_GROUP, 1)
    qpos = q_pos0 + jnp.arange(s)
    table = rel_table.astype(jnp.float32).reshape(REL_BUCKETS, NSA_KV_HEADS, NSA_GROUP)
    o_cmp, p_cmp = cmp_branch(q, qpos, ctx['ck'], ctx['cv'], ctx['c_end'], table)
    idx = select_blocks(p_cmp, qpos, ctx['n_slc'])
    o_slc = slc_branch(q, qpos, idx, ctx['fetch'], table)
    o_win = win_branch(q, q_pos0, ctx['wkv'], ctx['wpos0'], table)
    o = gates[:, :, 0] * o_cmp + gates[:, :, 1] * o_slc + gates[:, :, 2] * o_win
    return o.reshape(b, s, MIX_W).astype(p.dtype)


def run_trunk(x, q_pos0, mem_kv, init_states, build_ctx, prm):
    states = []
    ctx = None
    rows = None
    for l in range(DEPTH):
        h = rmsnorm(x, prm['g_mix'][l])
        if l < N_A_LAYERS:
            p = h @ prm['w_in_a'][l]
            mix, st = mlstm_mixer(p, init_states[l], prm['b_if'][l], prm['g_hnorm'][l])
            states.append(st)
        else:
            j = l - N_A_LAYERS
            p = h @ prm['w_in_b'][j]
            mix = nsa_mixer(p, q_pos0, ctx, prm['g_q'][j], prm['b_gate'][j], prm['rel_table'])
        mem_o = mem_attn(p[..., -MEM_W:], mem_kv[l], prm['g_mem_q'][l])
        x = x + jnp.concatenate([mix, mem_o], axis=-1) @ prm['w_out'][l]
        x = x + swiglu(rmsnorm(x, prm['g_ffn'][l]), prm['w_gu'][l], prm['w_down'][l])
        if l == N_A_LAYERS - 1:
            rows = kv_rows(x, prm['g_kv'], prm['w_kv'], prm['g_k_slc'], prm['g_k_win'])
            ctx = build_ctx(*rows)
    new_states = tuple(jnp.stack([st[i] for st in states]) for i in range(3))
    return x, new_states, rows


def setup_inputs(seed: int = 0) -> dict:
    key = jax.random.key(seed)
    keys = iter(jax.random.split(key, 48))

    def nrm(shape, scale=1.0):
        return jax.random.normal(next(keys), shape, jnp.float32) * scale

    def gain(shape):
        return 1.0 + nrm(shape, 0.02)

    n_pages = PAST_LEN // PAGE_SIZE
    n_pool = (DEC_BATCH * n_pages * 5 + 3) // 4
    wb = min(WINDOW, PAST_LEN)
    d_in = D_MODEL ** -0.5
    res = (2 * DEPTH) ** -0.5
    kvh, hd = NSA_KV_HEADS, HEAD_DIM
    page_table = jax.random.permutation(next(keys), n_pool)[:DEC_BATCH * n_pages].reshape(DEC_BATCH, n_pages).astype(jnp.int32)
    b_if = jnp.concatenate([nrm((N_A_LAYERS, MLSTM_HEADS), 0.1),
                            jnp.linspace(3.0, 6.0, MLSTM_HEADS, dtype=jnp.float32)[None, :] + nrm((N_A_LAYERS, MLSTM_HEADS), 0.1)], axis=-1)
    return {
        'x_prompt': nrm((BATCH, SEQ, D_MODEL)),
        'x_sample': nrm((DEC_BATCH, DEC_SEQ, D_MODEL)),
        'state_mlstm_c': nrm((N_A_LAYERS, DEC_BATCH, MLSTM_HEADS, MLSTM_DH, MLSTM_DH), 0.05),
        'state_mlstm_n': nrm((N_A_LAYERS, DEC_BATCH, MLSTM_HEADS, MLSTM_DH), 0.5),
        'state_mlstm_m': nrm((N_A_LAYERS, DEC_BATCH, MLSTM_HEADS), 1.0),
        'cache_mem_kv': nrm((DEPTH, DEC_BATCH, MEM_TOKENS, 2, MEM_HEADS, hd)),
        'cache_cmp_kv': nrm((n_pool, PAGE_SIZE, 2, kvh, hd)),
        'cache_slc_kv': nrm((n_pool, PAGE_SIZE, 2, kvh, hd)),
        'cache_win_kv': nrm((DEC_BATCH, wb, 2, kvh, hd)),
        'page_table': page_table,
        'mem_prompt': nrm((BATCH, MEM_TOKENS, D_MODEL)),
        'g_mix': gain((DEPTH, D_MODEL)),
        'w_in_a': nrm((N_A_LAYERS, D_MODEL, A_COLS), d_in),
        'b_if': b_if,
        'g_hnorm': gain((N_A_LAYERS, MLSTM_DH)),
        'w_in_b': nrm((N_B_LAYERS, D_MODEL, B_COLS), d_in),
        'g_q': gain((N_B_LAYERS, hd)),
        'b_gate': nrm((N_B_LAYERS, 3 * NSA_HEADS), 0.1),
        'rel_table': nrm((REL_BUCKETS, NSA_HEADS), 0.5),
        'g_kv': gain((D_MODEL,)),
        'w_kv': nrm((D_MODEL, KV_COLS), d_in),
        'g_k_slc': gain((hd,)),
        'g_k_win': gain((hd,)),
        'g_k_cmp': gain((hd,)),
        'cmp_pos': nrm((CMP_LEN, 2, hd), 0.1),
        'cmp_w1': nrm((2, CMP_LEN, hd, CMP_HIDDEN), (CMP_LEN * hd) ** -0.5),
        'cmp_b1': nrm((2, CMP_HIDDEN), 0.02),
        'cmp_w2': nrm((2, CMP_HIDDEN, hd), CMP_HIDDEN ** -0.5),
        'cmp_b2': nrm((2, hd), 0.02),
        'w_mem_kv': nrm((DEPTH, D_MODEL, 2 * MEM_W), d_in),
        'g_mem_k': gain((DEPTH, hd)),
        'g_mem_q': gain((DEPTH, hd)),
        'w_out': nrm((DEPTH, D_MODEL, D_MODEL), d_in * res),
        'g_ffn': gain((DEPTH, D_MODEL)),
        'w_gu': nrm((DEPTH, D_MODEL, 2 * D_FF), d_in),
        'w_down': nrm((DEPTH, D_FF, D_MODEL), D_FF ** -0.5 * res),
    }


def reference(x_prompt, x_sample, state_mlstm_c, state_mlstm_n, state_mlstm_m, cache_mem_kv,
              cache_cmp_kv, cache_slc_kv, cache_win_kv, page_table, mem_prompt,
              g_mix, w_in_a, b_if, g_hnorm, w_in_b, g_q, b_gate, rel_table, g_kv, w_kv,
              g_k_slc, g_k_win, g_k_cmp, cmp_pos, cmp_w1, cmp_b1, cmp_w2, cmp_b2,
              w_mem_kv, g_mem_k, g_mem_q, w_out, g_ffn, w_gu, w_down):
    prm = {'g_mix': g_mix, 'w_in_a': w_in_a, 'b_if': b_if, 'g_hnorm': g_hnorm, 'w_in_b': w_in_b,
           'g_q': g_q, 'b_gate': b_gate, 'rel_table': rel_table, 'g_kv': g_kv, 'w_kv': w_kv,
           'g_k_slc': g_k_slc, 'g_k_win': g_k_win, 'g_mem_q': g_mem_q, 'w_out': w_out,
           'g_ffn': g_ffn, 'w_gu': w_gu, 'w_down': w_down}
    g_i = jnp.arange(NSA_KV_HEADS)[None, None, :, None]

    b_p, s_p, _ = x_prompt.shape
    mem_kv_p = jnp.stack([mem_kv_rows(mem_prompt, w_mem_kv[l], g_mem_k[l]) for l in range(DEPTH)])
    init_p = [(jnp.zeros((b_p, MLSTM_HEADS, MLSTM_DH, MLSTM_DH), jnp.float32),
               jnp.zeros((b_p, MLSTM_HEADS, MLSTM_DH), jnp.float32),
               jnp.full((b_p, MLSTM_HEADS), NEG, jnp.float32)) for _ in range(N_A_LAYERS)]
    b_ip = jnp.arange(b_p)[:, None, None, None]

    def ctx_prompt(cmp_rows, slc_rows, win_rows):
        ck, cv, c_end = compress(cmp_rows, cmp_w1, cmp_b1, cmp_w2, cmp_b2, cmp_pos, g_k_cmp)

        def fetch(tok):
            kv = slc_rows[b_ip, jnp.minimum(tok, s_p - 1), :, g_i]
            return kv[..., 0, :], kv[..., 1, :]

        return {'ck': ck, 'cv': cv, 'c_end': c_end, 'n_slc': -(-s_p // SLC_BLOCK),
                'fetch': fetch, 'wkv': win_rows, 'wpos0': 0}

    y_p, st_p, rows_p = run_trunk(x_prompt, 0, mem_kv_p, init_p, ctx_prompt, prm)

    b_s, s_s, _ = x_sample.shape
    past = page_table.shape[1] * PAGE_SIZE
    wb = cache_win_kv.shape[1]
    init_s = [(state_mlstm_c[l], state_mlstm_n[l], state_mlstm_m[l]) for l in range(N_A_LAYERS)]
    b_is = jnp.arange(b_s)[:, None, None, None]

    def ctx_sample(cmp_new, slc_new, win_new):
        cmp_past = cache_cmp_kv[page_table].reshape(b_s, past, 2, NSA_KV_HEADS, HEAD_DIM)
        ck, cv, c_end = compress(jnp.concatenate([cmp_past, cmp_new], axis=1),
                                 cmp_w1, cmp_b1, cmp_w2, cmp_b2, cmp_pos, g_k_cmp)

        def fetch(tok):
            tp = jnp.minimum(tok, past - 1)
            phys = page_table[b_is, tp // PAGE_SIZE]
            kv_old = cache_slc_kv[phys, tp % PAGE_SIZE, :, g_i]
            kv_new = slc_new[b_is, jnp.clip(tok - past, 0, s_s - 1), :, g_i]
            kv = jnp.where((tok < past)[..., None, None], kv_old, kv_new)
            return kv[..., 0, :], kv[..., 1, :]

        return {'ck': ck, 'cv': cv, 'c_end': c_end, 'n_slc': -(-(past + s_s) // SLC_BLOCK),
                'fetch': fetch, 'wkv': jnp.concatenate([cache_win_kv, win_new], axis=1), 'wpos0': past - wb}

    y_s, st_s, rows_s = run_trunk(x_sample, past, cache_mem_kv, init_s, ctx_sample, prm)

    p_win = rows_p[2][:, s_p - min(WINDOW, s_p):]
    s_win = jnp.concatenate([cache_win_kv, rows_s[2]], axis=1)[:, -wb:]
    return (y_p, y_s, st_p[0], st_p[1], st_p[2], mem_kv_p, rows_p[0], rows_p[1], p_win,
            st_s[0], st_s[1], st_s[2], rows_s[0], rows_s[1], s_win)
```

```cpp
#include <hip/hip_runtime.h>
#include <cstdio>
#include <cstdint>

#ifndef MK_MULTI
#define MK_MULTI 0
#endif

#define LAS __attribute__((address_space(3)))
#define XB_TMO      128
#define XB_XCNT(j)  (256  + 64 * (j))
#define XB_XSUB(j)  (1280 + 64 * (j))
#define XB_XGEN(j)  (2304 + 64 * (j))
#define XB_TOP      3328
#define XB_TOPGEN   3392
#define XCD_BAR_WORDS 3456
#define XB_SPIN_CAP (1u << 24)
__device__ __forceinline__ unsigned xb_ld(unsigned* p)              { return __hip_atomic_load(p, __ATOMIC_RELAXED, __HIP_MEMORY_SCOPE_AGENT); }
__device__ __forceinline__ unsigned xb_add(unsigned* p, unsigned v) { return __hip_atomic_fetch_add(p, v, __ATOMIC_RELAXED, __HIP_MEMORY_SCOPE_AGENT); }
__device__ __forceinline__ unsigned xb_xcc_id() { return (unsigned)__builtin_amdgcn_s_getreg((3 << 11) | 20) & 0xFu; }
#define XB_SPIN(cond, bar) do { unsigned _sp = 0; while (cond) { __builtin_amdgcn_s_sleep(1); \
    if ((++_sp & 255u) == 0u) { if (xb_ld(&(bar)[XB_TMO])) break; if (_sp > XB_SPIN_CAP) { atomicAdd(&(bar)[XB_TMO], 1u); break; } } } } while (0)
struct XcdBarrier { unsigned* bar; unsigned x; volatile LAS unsigned* st; };
__device__ __forceinline__ XcdBarrier xcd_barrier_post(unsigned* bar, volatile LAS unsigned* st) {
    XcdBarrier b; b.bar = bar; b.x = xb_xcc_id(); b.st = st;
    if (threadIdx.x == 0) (void)xb_add(&bar[XB_XCNT(b.x)], 1u);
    return b;
}
__device__ __forceinline__ void xcd_barrier_complete(unsigned* bar, unsigned x, unsigned& nloc, unsigned& nx) {
    const unsigned G = gridDim.x * gridDim.y * gridDim.z;
    unsigned sum, cnt, mine, sp = 0u;
    for (;;) {
        sum = 0u; cnt = 0u; mine = 0u;
#pragma unroll
        for (unsigned j = 0; j < 16; ++j) { const unsigned c = xb_ld(&bar[XB_XCNT(j)]); sum += c; cnt += (c > 0u) ? 1u : 0u; mine = (j == x) ? c : mine; }
        if (sum == G) break;
        __builtin_amdgcn_s_sleep(1);
        if ((++sp & 255u) == 0u) { if (xb_ld(&bar[XB_TMO])) break; if (sp > XB_SPIN_CAP) { atomicAdd(&bar[XB_TMO], 1u); break; } }
    }
    nloc = mine > 0u ? mine : 1u; nx = cnt > 0u ? cnt : 1u;
}
__device__ __forceinline__ void xcd_barrier(const XcdBarrier& b) {
    asm volatile("s_waitcnt vmcnt(0)" ::: "memory");
    __syncthreads();
    if (threadIdx.x == 0) {
        unsigned* bar = b.bar;
        __builtin_amdgcn_s_waitcnt(0);
        unsigned nloc = b.st[0], nx = b.st[1];
        if (nloc == 0u) { xcd_barrier_complete(bar, b.x, nloc, nx); b.st[0] = nloc; b.st[1] = nx; }
        const unsigned old = xb_add(&bar[XB_XSUB(b.x)], 1u);
        const unsigned gen = old / nloc;
        if (old + 1u == (gen + 1u) * nloc) {
            __builtin_amdgcn_fence(__ATOMIC_RELEASE, "agent");
            asm volatile("s_waitcnt vmcnt(0)" ::: "memory");
            const unsigned og = xb_add(&bar[XB_TOP], 1u);
            const unsigned tg = og / nx;
            if (og + 1u == (tg + 1u) * nx) xb_add(&bar[XB_TOPGEN], 1u);
            else XB_SPIN(xb_ld(&bar[XB_TOPGEN]) == tg, bar);
            __builtin_amdgcn_fence(__ATOMIC_ACQUIRE, "agent");
            xb_add(&bar[XB_XGEN(b.x)], 1u);
            asm volatile("s_waitcnt vmcnt(0)" ::: "memory");
        } else {
            XB_SPIN(xb_ld(&bar[XB_XGEN(b.x)]) == gen, bar);
            __builtin_amdgcn_fence(__ATOMIC_ACQUIRE, "agent");
            asm volatile("s_waitcnt vmcnt(0)" ::: "memory");
        }
    }
    __syncthreads();
}

constexpr int DM = 1024, BP = 8, SP = 2048, MP = BP * SP, BS = 128, MA = MP + BS;
constexpr int ACOLS = 3336, BCOLS = 1060, DFF = 2816;
constexpr int PAST = 2048;
constexpr float EPS = 1e-6f, NEGM = -1e30f;

enum { I_XP = 0, I_XS, I_SC, I_SN, I_SM, I_CMEM, I_CCMP, I_CSLC, I_CWIN, I_PT, I_MEMP, I_GMIX, I_WINA, I_BIF, I_GHN, I_WINB, I_GQ, I_BGATE, I_REL,
       I_GKV, I_WKV, I_GKSLC, I_GKWIN, I_GKCMP, I_CPOS, I_CW1, I_CB1, I_CW2, I_CB2, I_WMEMKV, I_GMEMK, I_GMEMQ, I_WOUT, I_GFFN, I_WGU, I_WDOWN, N_IN };
constexpr size_t O_YP = 0, O_YS = O_YP + (size_t)MP * DM, O_PC = O_YS + (size_t)BS * DM, O_PN = O_PC + 2ull * 8 * 4 * 192 * 192, O_PM = O_PN + 2ull * 8 * 4 * 192,
    O_PMEM = O_PM + 64, O_PCMP = O_PMEM + 4ull * 8 * 256 * 512, O_PSLC = O_PCMP + (size_t)MP * 256, O_PWIN = O_PSLC + (size_t)MP * 256, O_SC = O_PWIN + 8ull * 512 * 256,
    O_SN = O_SC + 2ull * 128 * 4 * 192 * 192, O_SM = O_SN + 2ull * 128 * 4 * 192, O_SCMP = O_SM + 1024, O_SSLC = O_SCMP + 128 * 256, O_SWIN = O_SSLC + 128 * 256,
    O_END = O_SWIN + 128ull * 512 * 256;
static_assert(O_END == 87700544ull, "output size");
constexpr size_t W_CTL = 0, W_X = 262144, W_H = W_X + (size_t)MA * DM, W_CAT = W_H + (size_t)MA * DM, W_HRAW = W_CAT + (size_t)MA * DM, W_KVR = W_HRAW + (size_t)MA * 768,
    W_CK = W_KVR + (size_t)MA * 768, W_CV = W_CK + 136ull * 127 * 128, W_ACT = W_CV + 136ull * 127 * 128, W_P = W_ACT + (size_t)MA * DFF, W_END = W_P + (size_t)MA * 2 * DFF;

struct Params { const float* in[N_IN]; float* out; float* ws; unsigned* bar; int ph_lo, ph_hi; };

__device__ const unsigned char REL_LUT[128] = {0, 1, 2, 3, 4, 5, 6, 7, 8, 9, 10, 11, 12, 13, 14, 15, 16, 16, 16, 17, 17, 18, 18, 18, 19, 19, 19, 20, 20, 20, 20, 21, 21, 21, 21, 22, 22, 22, 22, 22, 23, 23, 23, 23, 23, 23, 24, 24, 24, 24, 24, 24, 25, 25, 25, 25, 25, 25, 25, 26, 26, 26, 26, 26, 26, 26, 26, 27, 27, 27, 27, 27, 27, 27, 27, 27, 27, 28, 28, 28, 28, 28, 28, 28, 28, 28, 28, 29, 29, 29, 29, 29, 29, 29, 29, 29, 29, 29, 29, 30, 30, 30, 30, 30, 30, 30, 30, 30, 30, 30, 30, 30, 30, 31, 31, 31, 31, 31, 31, 31, 31, 31, 31, 31, 31, 31, 31, 31};
__device__ __forceinline__ int rel_bucket(int d) { return d >= 128 ? 31 : (int)REL_LUT[d < 0 ? 0 : d]; }

__device__ __forceinline__ float wave_sum(float v) {
#pragma unroll
    for (int o = 32; o; o >>= 1) v += __shfl_xor(v, o);
    return v;
}
__device__ __forceinline__ float wave_max(float v) {
#pragma unroll
    for (int o = 32; o; o >>= 1) v = fmaxf(v, __shfl_xor(v, o));
    return v;
}
__device__ __forceinline__ float sigmoidf_(float x) { return 1.0f / (1.0f + expf(-x)); }
__device__ __forceinline__ float logsigmoidf_(float x) { return fminf(x, 0.f) - log1pf(expf(-fabsf(x))); }
__device__ __forceinline__ float dot4(float4 a, float4 b) { return a.x * b.x + a.y * b.y + a.z * b.z + a.w * b.w; }

__device__ __forceinline__ void ph_rmsnorm(const float* X, const float* g, float* H, int rows) {
    const int lane = threadIdx.x & 63, wid = threadIdx.x >> 6;
    for (int r = blockIdx.x * 4 + wid; r < rows; r += gridDim.x * 4) {
        const float4* xr = (const float4*)(X + (size_t)r * DM); float4 v[4]; float ss = 0.f;
#pragma unroll
        for (int i = 0; i < 4; ++i) { v[i] = xr[lane + 64 * i]; ss += dot4(v[i], v[i]); }
        ss = wave_sum(ss); const float rs = rsqrtf(ss * (1.0f / DM) + EPS);
        float4* hr = (float4*)(H + (size_t)r * DM);
#pragma unroll
        for (int i = 0; i < 4; ++i) { const float4 gg = ((const float4*)g)[lane + 64 * i]; float4 o; o.x = v[i].x * rs * gg.x; o.y = v[i].y * rs * gg.y; o.z = v[i].z * rs * gg.z; o.w = v[i].w * rs * gg.w; hr[lane + 64 * i] = o; }
    }
}
__device__ __forceinline__ void ph_gemm(const float* A, int lda, const float* B, int ldb, float* C, int ldc, int M, int N, int K, bool accum, float* lds) {
    float* As = lds;
    float* Bs = lds + 16 * 132;
    const int tid = threadIdx.x, tx = tid & 15, ty = tid >> 4;
    const int ntm = M / 128, ntn = (N + 127) / 128;
    for (int t = blockIdx.x; t < ntm * ntn; t += gridDim.x) {
        const int tn = t / ntm, tm = t % ntm;
        float acc[8][8];
#pragma unroll
        for (int i = 0; i < 8; ++i)
#pragma unroll
            for (int j = 0; j < 8; ++j) acc[i][j] = 0.f;
        const float* ap = A + (size_t)(tm * 128 + (tid >> 1)) * lda + (tid & 1) * 8;
        const int bc = tn * 128 + (tid & 15) * 8;
        const bool v0 = bc < N, v1 = bc + 4 < N;
        const float* bp = B + (size_t)(tid >> 4) * ldb + (v0 ? bc : 0);
        const int o1 = v1 ? 4 : 0;
        float4 ra0, ra1, rb0, rb1;
        ra0 = *(const float4*)ap; ra1 = *(const float4*)(ap + 4);
        rb0 = *(const float4*)bp; rb1 = *(const float4*)(bp + o1);
        for (int k0 = 0; k0 < K; k0 += 16) {
            __syncthreads();
            { const int r = tid >> 1, kb = (tid & 1) * 8;
              As[(kb + 0) * 132 + r] = ra0.x; As[(kb + 1) * 132 + r] = ra0.y; As[(kb + 2) * 132 + r] = ra0.z; As[(kb + 3) * 132 + r] = ra0.w;
              As[(kb + 4) * 132 + r] = ra1.x; As[(kb + 5) * 132 + r] = ra1.y; As[(kb + 6) * 132 + r] = ra1.z; As[(kb + 7) * 132 + r] = ra1.w;
              *(float4*)(Bs + (tid >> 4) * 128 + (tid & 15) * 8) = make_float4(v0 ? rb0.x : 0.f, v0 ? rb0.y : 0.f, v0 ? rb0.z : 0.f, v0 ? rb0.w : 0.f);
              *(float4*)(Bs + (tid >> 4) * 128 + (tid & 15) * 8 + 4) = make_float4(v1 ? rb1.x : 0.f, v1 ? rb1.y : 0.f, v1 ? rb1.z : 0.f, v1 ? rb1.w : 0.f); }
            __syncthreads();
            if (k0 + 16 < K) {
                ap += 16; bp += (size_t)16 * ldb;
                ra0 = *(const float4*)ap; ra1 = *(const float4*)(ap + 4);
                rb0 = *(const float4*)bp; rb1 = *(const float4*)(bp + o1);
            }
#pragma unroll 2
            for (int kk = 0; kk < 16; ++kk) {
                const float4 a0 = *(const float4*)(As + kk * 132 + ty * 8), a1 = *(const float4*)(As + kk * 132 + ty * 8 + 4);
                const float4 b0 = *(const float4*)(Bs + kk * 128 + tx * 8), b1 = *(const float4*)(Bs + kk * 128 + tx * 8 + 4);
#define GROW(i, av) do { acc[i][0] = fmaf(av, b0.x, acc[i][0]); acc[i][1] = fmaf(av, b0.y, acc[i][1]); acc[i][2] = fmaf(av, b0.z, acc[i][2]); acc[i][3] = fmaf(av, b0.w, acc[i][3]); \
                                 acc[i][4] = fmaf(av, b1.x, acc[i][4]); acc[i][5] = fmaf(av, b1.y, acc[i][5]); acc[i][6] = fmaf(av, b1.z, acc[i][6]); acc[i][7] = fmaf(av, b1.w, acc[i][7]); } while (0)
                GROW(0, a0.x); GROW(1, a0.y); GROW(2, a0.z); GROW(3, a0.w); GROW(4, a1.x); GROW(5, a1.y); GROW(6, a1.z); GROW(7, a1.w);
#undef GROW
            }
        }
#pragma unroll
        for (int i = 0; i < 8; ++i) {
            float* cp = C + (size_t)(tm * 128 + ty * 8 + i) * ldc + tn * 128 + tx * 8;
#pragma unroll
            for (int h = 0; h < 2; ++h) {
                if (tn * 128 + tx * 8 + 4 * h < N) {
                    float4 o = make_float4(acc[i][4 * h], acc[i][4 * h + 1], acc[i][4 * h + 2], acc[i][4 * h + 3]);
                    if (accum) { const float4 c0 = *(const float4*)(cp + 4 * h); o.x += c0.x; o.y += c0.y; o.z += c0.z; o.w += c0.w; }
                    *(float4*)(cp + 4 * h) = o;
                }
            }
        }
    }
}
__device__ __forceinline__ void ph_copy4(const float* src, float* dst, size_t n4) {
    for (size_t i = (size_t)blockIdx.x * 256 + threadIdx.x; i < n4; i += (size_t)gridDim.x * 256) ((float4*)dst)[i] = ((const float4*)src)[i];
}

__device__ __forceinline__ void ph_memk_norm(const Params& p) {
    const int lane = threadIdx.x & 63, wid = threadIdx.x >> 6;
    for (int it = blockIdx.x * 4 + wid; it < 4 * 8 * 256; it += gridDim.x * 4) {
        const int l = it / 2048;
        float4* kr = (float4*)(p.out + O_PMEM + (size_t)it * 512);
        float4 v = kr[lane]; float ss = dot4(v, v);
        ss += __shfl_xor(ss, 1); ss += __shfl_xor(ss, 2); ss += __shfl_xor(ss, 4); ss += __shfl_xor(ss, 8);
        const float rs = rsqrtf(ss * (1.0f / 64) + EPS);
        const float4 g = ((const float4*)(p.in[I_GMEMK] + l * 64))[lane & 15];
        v.x *= rs * g.x; v.y *= rs * g.y; v.z *= rs * g.z; v.w *= rs * g.w; kr[lane] = v;
    }
}

__device__ __forceinline__ void ph_mlstm_prompt(const Params& p, int l, float* lds) {
    const float* P = p.ws + W_P; const float* bif = p.in[I_BIF] + l * 8; float* HR = p.ws + W_HRAW;
    const int tid = threadIdx.x, lane = tid & 63, wid = tid >> 6;
    float* red = lds;
    const float kscale = 0.07216878364870322f;
    for (int item = blockIdx.x; item < 8 * 4 * 12; item += gridDim.x) {
        const int es = item % 12, h = (item / 12) % 4, b = item / 48;
        const bool act = tid < 192; const int d = act ? tid : 0;
        float C[16]; float n = 0.f, m = NEGM;
#pragma unroll
        for (int e = 0; e < 16; ++e) C[e] = 0.f;
        const float* pr = P + (size_t)(b * SP) * ACOLS;
        float qn = act ? pr[h * 192 + d] : 0.f, kn = act ? pr[768 + h * 192 + d] * kscale : 0.f; float4 vn[4];
#pragma unroll
        for (int e = 0; e < 4; ++e) vn[e] = *(const float4*)(pr + 1536 + h * 192 + es * 16 + 4 * e);
        float in_ = pr[3072 + h] + bif[h], fn = pr[3076 + h] + bif[4 + h];
        for (int t = 0; t < SP; ++t) {
            const float q = qn, k = kn, ig = in_, fg = fn; float v[16];
#pragma unroll
            for (int e = 0; e < 4; ++e) { v[4 * e] = vn[e].x; v[4 * e + 1] = vn[e].y; v[4 * e + 2] = vn[e].z; v[4 * e + 3] = vn[e].w; }
            if (t + 1 < SP) {
                pr += ACOLS;
                qn = act ? pr[h * 192 + d] : 0.f; kn = act ? pr[768 + h * 192 + d] * kscale : 0.f;
#pragma unroll
                for (int e = 0; e < 4; ++e) vn[e] = *(const float4*)(pr + 1536 + h * 192 + es * 16 + 4 * e);
                in_ = pr[3072 + h] + bif[h]; fn = pr[3076 + h] + bif[4 + h];
            }
            const float logf = logsigmoidf_(fg);
            const float m_new = fmaxf(logf + m, ig);
            const float a = expf(logf + m - m_new), bb = expf(ig - m_new);
            const float kb = bb * k;
            float part[17];
#pragma unroll
            for (int e = 0; e < 16; ++e) { C[e] = a * C[e] + kb * v[e]; part[e] = q * C[e]; }
            n = a * n + kb; part[16] = q * n;
#pragma unroll
            for (int e = 0; e < 17; ++e) part[e] = wave_sum(part[e]);
            float* rb = red + (t & 1) * 68;
            if (lane == 0) {
#pragma unroll
                for (int e = 0; e < 17; ++e) rb[wid * 17 + e] = part[e];
            }
            __syncthreads();
            if (tid < 16) {
                const float num = rb[tid] + rb[17 + tid] + rb[34 + tid] + rb[51 + tid];
                const float den = rb[16] + rb[17 + 16] + rb[34 + 16] + rb[51 + 16];
                HR[(size_t)(b * SP + t) * 768 + h * 192 + es * 16 + tid] = num / fmaxf(fabsf(den), expf(-m_new));
            }
            m = m_new;
        }
        if (act) {
            float* co = p.out + O_PC + ((size_t)((l * 8 + b) * 4 + h) * 192 + d) * 192 + es * 16;
#pragma unroll
            for (int e = 0; e < 16; ++e) co[e] = C[e];
            if (es == 0) p.out[O_PN + (size_t)((l * 8 + b) * 4 + h) * 192 + d] = n;
        }
        if (es == 0 && tid == 0) p.out[O_PM + (l * 8 + b) * 4 + h] = m;
        __syncthreads();
    }
}
__device__ __forceinline__ void ph_mlstm_sample(const Params& p, int l, float* lds) {
    const float* P = p.ws + W_P; const float* bif = p.in[I_BIF] + l * 8; float* HR = p.ws + W_HRAW;
    const int tid = threadIdx.x;
    float* qs = lds; float* ks = lds + 192; float* n0s = lds + 384;
    const float kscale = 0.07216878364870322f;
    for (int item = blockIdx.x; item < 128 * 4; item += gridDim.x) {
        const int h = item & 3, b = item >> 2; const int row = MP + b;
        const float* pr = P + (size_t)row * ACOLS;
        const size_t sidx = (size_t)(l * 128 + b) * 4 + h;
        __syncthreads();
        if (tid < 192) { qs[tid] = pr[h * 192 + tid]; ks[tid] = pr[768 + h * 192 + tid] * kscale; n0s[tid] = p.in[I_SN][sidx * 192 + tid]; }
        __syncthreads();
        const float ig = pr[3072 + h] + bif[h], fg = pr[3076 + h] + bif[4 + h];
        const float m0 = p.in[I_SM][sidx];
        const float logf = logsigmoidf_(fg);
        const float m_new = fmaxf(logf + m0, ig);
        const float a = expf(logf + m0 - m_new), bb = expf(ig - m_new);
        if (tid < 192) {
            const int e = tid; const float ve = pr[1536 + h * 192 + e];
            const float* C0 = p.in[I_SC] + sidx * 192 * 192; float* C1 = p.out + O_SC + sidx * 192 * 192;
            float num = 0.f, den = 0.f;
            for (int d = 0; d < 192; ++d) {
                const float c = a * C0[d * 192 + e] + bb * ks[d] * ve; C1[d * 192 + e] = c; num += qs[d] * c;
                const float nd = a * n0s[d] + bb * ks[d]; den += qs[d] * nd;
            }
            HR[(size_t)row * 768 + h * 192 + e] = num / fmaxf(fabsf(den), expf(-m_new));
            p.out[O_SN + sidx * 192 + e] = a * n0s[e] + bb * ks[e];
        }
        if (tid == 0) p.out[O_SM + sidx] = m_new;
    }
}
__device__ __forceinline__ void ph_mlstm_fin(const Params& p, int l) {
    const float* P = p.ws + W_P; const float* HR = p.ws + W_HRAW; float* CAT = p.ws + W_CAT; const float* g = p.in[I_GHN] + l * 192;
    const int lane = threadIdx.x & 63, wid = threadIdx.x >> 6;
    for (int it = blockIdx.x * 4 + wid; it < MA * 4; it += gridDim.x * 4) {
        const int row = it >> 2, h = it & 3;
        const float* hr = HR + (size_t)row * 768 + h * 192; float v[3]; float ss = 0.f;
#pragma unroll
        for (int i = 0; i < 3; ++i) { v[i] = hr[lane + 64 * i]; ss += v[i] * v[i]; }
        ss = wave_sum(ss); const float rs = rsqrtf(ss * (1.0f / 192) + EPS);
#pragma unroll
        for (int i = 0; i < 3; ++i) { const int d = lane + 64 * i; const float o = P[(size_t)row * ACOLS + 2304 + h * 192 + d];
            CAT[(size_t)row * DM + h * 192 + d] = sigmoidf_(o) * (v[i] * rs * g[d]); }
    }
}
__device__ __forceinline__ void ph_mem_attn(const Params& p, int l) {
    const int ldp = l < 2 ? ACOLS : BCOLS, qoff = l < 2 ? 3080 : 804;
    const float* P = p.ws + W_P; float* CAT = p.ws + W_CAT; const float* gq = p.in[I_GMEMQ] + l * 64;
    for (int idx4 = blockIdx.x * 256 + threadIdx.x; idx4 < 16 * MA; idx4 += gridDim.x * 256) {
        const int part = idx4 & 3, idx = idx4 >> 2;
        const int hh = idx / MA, row = idx % MA;
        const float* kvb = row < MP ? p.out + O_PMEM + (size_t)(l * 8 + row / SP) * 256 * 512 : p.in[I_CMEM] + (size_t)(l * 128 + (row - MP)) * 256 * 512;
        float q[16]; float ss = 0.f;
        const float4* qp = (const float4*)(P + (size_t)row * ldp + qoff + hh * 64 + part * 16);
#pragma unroll
        for (int i = 0; i < 4; ++i) { const float4 t = qp[i]; q[4 * i] = t.x; q[4 * i + 1] = t.y; q[4 * i + 2] = t.z; q[4 * i + 3] = t.w; ss += dot4(t, t); }
        ss += __shfl_xor(ss, 1); ss += __shfl_xor(ss, 2);
        const float rs = rsqrtf(ss * (1.0f / 64) + EPS) * 0.125f;
#pragma unroll
        for (int i = 0; i < 16; ++i) q[i] *= rs * gq[part * 16 + i];
        float mx = -3e38f, den = 0.f; float o[16];
#pragma unroll
        for (int i = 0; i < 16; ++i) o[i] = 0.f;
        for (int m = 0; m < 256; ++m) {
            const float4* kp = (const float4*)(kvb + (size_t)m * 512 + hh * 64 + part * 16); const float4* vp = (const float4*)(kvb + (size_t)m * 512 + 256 + hh * 64 + part * 16);
            float s = 0.f;
#pragma unroll
            for (int i = 0; i < 4; ++i) { const float4 t = kp[i]; s += q[4 * i] * t.x + q[4 * i + 1] * t.y + q[4 * i + 2] * t.z + q[4 * i + 3] * t.w; }
            s += __shfl_xor(s, 1); s += __shfl_xor(s, 2);
            const float mn = fmaxf(mx, s); const float sc = expf(mx - mn), e = expf(s - mn); mx = mn; den = den * sc + e;
#pragma unroll
            for (int i = 0; i < 4; ++i) { const float4 t = vp[i]; o[4 * i] = o[4 * i] * sc + e * t.x; o[4 * i + 1] = o[4 * i + 1] * sc + e * t.y; o[4 * i + 2] = o[4 * i + 2] * sc + e * t.z; o[4 * i + 3] = o[4 * i + 3] * sc + e * t.w; }
        }
        const float inv = 1.0f / den; float4* op = (float4*)(CAT + (size_t)row * DM + 768 + hh * 64 + part * 16);
#pragma unroll
        for (int i = 0; i < 4; ++i) op[i] = make_float4(o[4 * i] * inv, o[4 * i + 1] * inv, o[4 * i + 2] * inv, o[4 * i + 3] * inv);
    }
}
__device__ __forceinline__ void ph_act(const Params& p) {
    const float* GU = p.ws + W_P; float* ACT = p.ws + W_ACT;
    for (size_t i = (size_t)blockIdx.x * 256 + threadIdx.x; i < (size_t)MA * (DFF / 4); i += (size_t)gridDim.x * 256) {
        const size_t row = i / (DFF / 4), c = (i % (DFF / 4)) * 4;
        const float4 g = *(const float4*)(GU + row * (2 * DFF) + c), u = *(const float4*)(GU + row * (2 * DFF) + DFF + c);
        float4 o; o.x = g.x * sigmoidf_(g.x) * u.x; o.y = g.y * sigmoidf_(g.y) * u.y; o.z = g.z * sigmoidf_(g.z) * u.z; o.w = g.w * sigmoidf_(g.w) * u.w;
        *(float4*)(ACT + row * DFF + c) = o;
    }
}
__device__ __forceinline__ void ph_rows_post(const Params& p) {
    float* KVR = p.ws + W_KVR; const int lane = threadIdx.x & 63, wid = threadIdx.x >> 6;
    for (int row = blockIdx.x * 4 + wid; row < MA; row += gridDim.x * 4) {
        float* r = KVR + (size_t)row * 768;
        float4 c = ((const float4*)r)[lane], s = ((const float4*)(r + 256))[lane], w = ((const float4*)(r + 512))[lane];
        {
            float ss = dot4(s, s), sw = dot4(w, w);
            ss += __shfl_xor(ss, 1); ss += __shfl_xor(ss, 2); ss += __shfl_xor(ss, 4); ss += __shfl_xor(ss, 8);
            sw += __shfl_xor(sw, 1); sw += __shfl_xor(sw, 2); sw += __shfl_xor(sw, 4); sw += __shfl_xor(sw, 8);
            if (lane < 32) {
                const float rs = rsqrtf(ss * (1.0f / 64) + EPS), rw = rsqrtf(sw * (1.0f / 64) + EPS);
                const float4 gs = ((const float4*)p.in[I_GKSLC])[lane & 15], gw = ((const float4*)p.in[I_GKWIN])[lane & 15];
                s.x *= rs * gs.x; s.y *= rs * gs.y; s.z *= rs * gs.z; s.w *= rs * gs.w;
                w.x *= rw * gw.x; w.y *= rw * gw.y; w.z *= rw * gw.z; w.w *= rw * gw.w;
                ((float4*)(r + 256))[lane] = s; ((float4*)(r + 512))[lane] = w;
            }
        }
        if (row < MP) {
            ((float4*)(p.out + O_PCMP + (size_t)row * 256))[lane] = c; ((float4*)(p.out + O_PSLC + (size_t)row * 256))[lane] = s;
            const int b = row / SP, sp = row % SP;
            if (sp >= SP - 512) ((float4*)(p.out + O_PWIN + (size_t)(b * 512 + sp - (SP - 512)) * 256))[lane] = w;
        } else {
            const int b = row - MP;
            ((float4*)(p.out + O_SCMP + (size_t)b * 256))[lane] = c; ((float4*)(p.out + O_SSLC + (size_t)b * 256))[lane] = s;
            ((float4*)(p.out + O_SWIN + (size_t)(b * 512 + 511) * 256))[lane] = w;
        }
    }
}
__device__ __forceinline__ float gelu_tanh(float x) { return 0.5f * x * (1.0f + tanhf(0.7978845608028654f * (x + 0.044715f * x * x * x))); }
__device__ __forceinline__ void ph_compress(const Params& p, float* lds) {
    const float* KVR = p.ws + W_KVR; const int tid = threadIdx.x;
    float* xs = lds;
    float* hs = lds + 4096;
    const float* w1 = p.in[I_CW1]; const float* w2 = p.in[I_CW2]; const int* pt = (const int*)p.in[I_PT];
    for (int item = blockIdx.x; item < 136 * 127 * 2; item += gridDim.x) {
        const int c = item & 1, n = (item >> 1) % 127, bb = (item >> 1) / 127;
        __syncthreads();
        for (int i = tid; i < 4096; i += 256) {
            const int g = i >> 11, pp = (i >> 6) & 31, d = i & 63; const int tok = 16 * n + pp; float x;
            if (bb < 8) x = KVR[(size_t)(bb * SP + tok) * 768 + c * 128 + g * 64 + d];
            else { const int b = bb - 8; const int phys = pt[b * 16 + (tok >> 7)]; x = p.in[I_CCMP][((size_t)phys * 128 + (tok & 127)) * 256 + c * 128 + g * 64 + d]; }
            xs[i] = x + p.in[I_CPOS][(pp * 2 + c) * 64 + d];
        }
        __syncthreads();
        { const int g = tid >> 7, h = tid & 127; float pre = p.in[I_CB1][c * 128 + h]; const float* wp = w1 + (size_t)c * 2048 * 128 + h; const float* xp = xs + g * 2048;
          for (int i = 0; i < 2048; ++i) pre = fmaf(xp[i], wp[(size_t)i * 128], pre);
          hs[g * 128 + h] = gelu_tanh(pre); }
        __syncthreads();
        if (tid < 128) {
            const int g = tid >> 6, d = tid & 63; float o = p.in[I_CB2][c * 64 + d];
            for (int h = 0; h < 128; ++h) o = fmaf(hs[g * 128 + h], w2[(size_t)(c * 128 + h) * 64 + d], o);
            if (c == 0) { const float ss = wave_sum(o * o); o = o * rsqrtf(ss * (1.0f / 64) + EPS) * p.in[I_GKCMP][d]; }
            (p.ws + (c == 0 ? W_CK : W_CV))[((size_t)bb * 127 + n) * 128 + g * 64 + d] = o;
        }
    }
}
__device__ __forceinline__ void row_softmax(float* r, int n, int lane) {
    float mx = NEGM;
    for (int i = lane; i < n; i += 64) mx = fmaxf(mx, r[i]);
    mx = wave_max(mx);
    if (mx <= 0.5f * NEGM) { for (int i = lane; i < n; i += 64) r[i] = 0.f; return; }
    float s = 0.f;
    for (int i = lane; i < n; i += 64) { const float e = r[i] <= 0.5f * NEGM ? 0.f : expf(r[i] - mx); r[i] = e; s += e; }
    s = wave_sum(s); const float inv = 1.0f / s;
    for (int i = lane; i < n; i += 64) r[i] *= inv;
}
__device__ __forceinline__ void ph_nsa(const Params& p, int j, float* lds) {
    const int tid = threadIdx.x, lane = tid & 63, wid = tid >> 6;
    float* qs = lds;
    float* sc = lds + 384;
    float* imp = sc + 3072;
    int* sel = (int*)(imp + 40);
    float* gate = (float*)(sel + 8);
    float* oacc = gate + 24;
    const float* P = p.ws + W_P; const float* KVR = p.ws + W_KVR; float* CAT = p.ws + W_CAT;
    const float* table = p.in[I_REL]; const int* pt = (const int*)p.in[I_PT];
    for (int item = blockIdx.x; item < MA * 2; item += gridDim.x) {
        const int row = item >> 1, g = item & 1; const bool smp = row >= MP;
        const int b = smp ? row - MP : row / SP, pos = smp ? PAST : row % SP;
        const float* pr = P + (size_t)row * BCOLS;
        __syncthreads();
        for (int z = wid; z < 6; z += 4) { const float v = pr[(g * 6 + z) * 64 + lane]; const float ss = wave_sum(v * v); qs[z * 64 + lane] = v * rsqrtf(ss * (1.0f / 64) + EPS) * p.in[I_GQ][j * 64 + lane]; }
        if (tid < 18) { const int br = tid / 6, z = tid % 6; gate[tid] = sigmoidf_(pr[768 + br * 12 + g * 6 + z] + p.in[I_BGATE][j * 36 + br * 12 + g * 6 + z]); }
        for (int i = tid; i < 384; i += 256) oacc[i] = 0.f;
        __syncthreads();
        const float* ck = p.ws + W_CK + (size_t)(smp ? 8 + b : b) * 127 * 128; const float* cv = p.ws + W_CV + (size_t)(smp ? 8 + b : b) * 127 * 128;
        for (int i = tid; i < 6 * 127; i += 256) {
            const int z = i / 127, n = i % 127; const int dist = pos - (16 * n + 31); float s = NEGM;
            if (dist >= 0) { const float4* kp = (const float4*)(ck + n * 128 + g * 64); const float4* qp = (const float4*)(qs + z * 64); float a = 0.f;
#pragma unroll 4
                for (int d = 0; d < 16; ++d) a += dot4(kp[d], qp[d]);
                s = a * 0.125f + table[rel_bucket(dist) * 12 + g * 6 + z]; }
            sc[z * 128 + n] = s;
        }
        __syncthreads();
        for (int z = wid; z < 6; z += 4) row_softmax(sc + z * 128, 127, lane);
        __syncthreads();
        const int nslc = smp ? 33 : 32, cur = pos >> 6;
        if (tid < nslc) { const int jb = tid; float s = 0.f;
            for (int z = 0; z < 6; ++z) for (int n = 0; n < 127; ++n) { const int lo = max(16 * n, 64 * jb), hi = min(16 * n + 32, 64 * jb + 64); if (hi > lo) s += sc[z * 128 + n] * (float)(hi - lo) * (1.0f / 16); }
            imp[jb] = s; }
        __syncthreads();
        if (tid == 0) {
            int cnt = 0;
            if (cur + 1 <= 8) { for (int jb = 0; jb <= cur; ++jb) sel[cnt++] = jb; }
            else {
                sel[0] = 0; sel[1] = cur; sel[2] = cur - 1; cnt = 3; unsigned long long taken = 0ull;
                for (int k = 0; k < 5; ++k) { int best = -1; float bv = -1.f;
                    for (int jb = 1; jb <= cur - 2; ++jb) if (!((taken >> jb) & 1ull) && imp[jb] > bv) { bv = imp[jb]; best = jb; }
                    if (best >= 0) { taken |= 1ull << best; sel[cnt++] = best; } }
            }
            for (; cnt < 8; ++cnt) sel[cnt] = -1;
        }
        for (int i = tid; i < 384; i += 256) { const int z = i >> 6, d = i & 63; float o = 0.f;
            for (int n = 0; n < 127; ++n) o = fmaf(sc[z * 128 + n], cv[n * 128 + g * 64 + d], o);
            oacc[i] += gate[0 * 6 + z] * o; }
        __syncthreads();
        for (int br = 1; br <= 2; ++br) {
            for (int t = tid; t < 512; t += 256) {
                const float* kp = nullptr; int dist = -1;
                if (br == 1) {
                    const int blk = sel[t >> 6];
                    if (blk >= 0) { const int tok = blk * 64 + (t & 63); dist = pos - tok;
                        if (dist >= 0) { if (!smp) kp = KVR + (size_t)(b * SP + tok) * 768 + 256 + g * 64;
                            else if (tok < PAST) kp = p.in[I_CSLC] + ((size_t)pt[b * 16 + (tok >> 7)] * 128 + (tok & 127)) * 256 + g * 64;
                            else kp = KVR + (size_t)row * 768 + 256 + g * 64; } }
                } else {
                    const int kpos = pos - 511 + t; dist = 511 - t;
                    if (!smp) { if (kpos >= 0) kp = KVR + (size_t)(b * SP + kpos) * 768 + 512 + g * 64; else dist = -1; }
                    else { if (kpos < PAST) kp = p.in[I_CWIN] + ((size_t)b * 512 + (kpos - (PAST - 512))) * 256 + g * 64; else kp = KVR + (size_t)row * 768 + 512 + g * 64; }
                }
                if (dist >= 0 && kp) {
                    float s[6] = {0.f, 0.f, 0.f, 0.f, 0.f, 0.f};
#pragma unroll 2
                    for (int d = 0; d < 16; ++d) { const float4 kk = ((const float4*)kp)[d];
#pragma unroll
                        for (int z = 0; z < 6; ++z) s[z] += dot4(kk, ((const float4*)(qs + z * 64))[d]); }
                    const int bk = rel_bucket(dist);
#pragma unroll
                    for (int z = 0; z < 6; ++z) sc[z * 512 + t] = s[z] * 0.125f + table[bk * 12 + g * 6 + z];
                } else {
#pragma unroll
                    for (int z = 0; z < 6; ++z) sc[z * 512 + t] = NEGM;
                }
            }
            __syncthreads();
            for (int z = wid; z < 6; z += 4) row_softmax(sc + z * 512, 512, lane);
            __syncthreads();
            for (int i = tid; i < 384; i += 256) { const int z = i >> 6, d = i & 63; float o = 0.f;
                for (int t = 0; t < 512; ++t) { const float pw = sc[z * 512 + t]; if (pw != 0.f) { const float* vp;
                    if (br == 1) { const int tok = sel[t >> 6] * 64 + (t & 63);
                        if (!smp) vp = KVR + (size_t)(b * SP + tok) * 768 + 256 + 128 + g * 64;
                        else if (tok < PAST) vp = p.in[I_CSLC] + ((size_t)pt[b * 16 + (tok >> 7)] * 128 + (tok & 127)) * 256 + 128 + g * 64;
                        else vp = KVR + (size_t)row * 768 + 256 + 128 + g * 64;
                    } else { const int kpos = pos - 511 + t;
                        if (!smp) vp = KVR + (size_t)(b * SP + kpos) * 768 + 512 + 128 + g * 64;
                        else if (kpos < PAST) vp = p.in[I_CWIN] + ((size_t)b * 512 + (kpos - (PAST - 512))) * 256 + 128 + g * 64;
                        else vp = KVR + (size_t)row * 768 + 512 + 128 + g * 64; }
                    o = fmaf(pw, vp[d], o); } }
                oacc[i] += gate[br * 6 + z] * o; }
            __syncthreads();
        }
        for (int i = tid; i < 384; i += 256) CAT[(size_t)row * DM + g * 384 + i] = oacc[i];
    }
}

constexpr int PL = 13, NPH = 2 + 4 * PL + 1;
enum { K_INIT = 0, K_MEMKNORM, K_NORM, K_GEMM, K_MIXA, K_MIXB, K_FIN, K_ACT, K_ROWS, K_COMPRESS, K_FINAL, N_KINDS };
__host__ __device__ constexpr int phase_kind(int ph) {
    if (ph == 0) return K_INIT; if (ph == 1) return K_MEMKNORM; if (ph == NPH - 1) return K_FINAL;
    const int l = (ph - 2) / PL, r = (ph - 2) % PL;
    switch (r) { case 0: case 5: return K_NORM; case 1: case 4: case 6: case 8: return K_GEMM; case 2: return l < 2 ? K_MIXA : K_MIXB; case 3: return l < 2 ? K_FIN : -1; case 7: return K_ACT;
                 case 9: return l == 1 ? K_NORM : -1; case 10: return l == 1 ? K_GEMM : -1; case 11: return l == 1 ? K_ROWS : -1; case 12: return l == 1 ? K_COMPRESS : -1; }
    return -1;
}
template <unsigned MASK> __global__ void __launch_bounds__(256, 2) fwd(Params p) {
    __shared__ __attribute__((aligned(16))) float smem[8192];
    __shared__ uint4 xb_words;
    if (threadIdx.x == 0) xb_words = make_uint4(0u, 0u, 0u, 0u);
    __syncthreads();
    XcdBarrier bar; bar.bar = p.bar; bar.x = 0; bar.st = (volatile LAS unsigned*)&xb_words;
    const bool multi = (p.ph_hi - p.ph_lo) > 1;
    if (multi) bar = xcd_barrier_post(p.bar, (volatile LAS unsigned*)&xb_words);
    float* ws = p.ws; float* X = ws + W_X; float* H = ws + W_H; float* CAT = ws + W_CAT; float* PB = ws + W_P; float* KVR = ws + W_KVR; float* ACT = ws + W_ACT;
    int ph = 0;
#define ON(k) (((MASK >> (k)) & 1u) && ph >= p.ph_lo && ph < p.ph_hi)
#define NEXT() do { ++ph; if (ph > p.ph_lo && ph < p.ph_hi) xcd_barrier(bar); } while (0)
    if (ON(K_INIT)) {
        ph_copy4(p.in[I_XP], X, (size_t)MP * DM / 4); ph_copy4(p.in[I_XS], X + (size_t)MP * DM, (size_t)BS * DM / 4);
        for (size_t i = (size_t)blockIdx.x * 256 + threadIdx.x; i < 128ull * 511 * 64; i += (size_t)gridDim.x * 256) {
            const size_t b = i / (511 * 64), r = i % (511 * 64);
            ((float4*)(p.out + O_SWIN + b * 512 * 256))[r] = ((const float4*)(p.in[I_CWIN] + b * 512 * 256 + 256))[r];
        }
        for (int l = 0; l < 4; ++l) ph_gemm(p.in[I_MEMP], DM, p.in[I_WMEMKV] + (size_t)l * DM * 512, 512, p.out + O_PMEM + (size_t)l * 2048 * 512, 512, 2048, 512, DM, false, smem);
    }
    NEXT();
    if (ON(K_MEMKNORM)) ph_memk_norm(p);
    NEXT();
    for (int l = 0; l < 4; ++l) {
        if (ON(K_NORM)) ph_rmsnorm(X, p.in[I_GMIX] + l * DM, H, MA);
        NEXT();
        if (ON(K_GEMM)) { const float* W = l < 2 ? p.in[I_WINA] + (size_t)l * DM * ACOLS : p.in[I_WINB] + (size_t)(l - 2) * DM * BCOLS; const int n = l < 2 ? ACOLS : BCOLS;
                          ph_gemm(H, DM, W, n, PB, n, MA, n, DM, false, smem); }
        NEXT();
        if (l < 2) { if (ON(K_MIXA)) { ph_mlstm_prompt(p, l, smem); ph_mlstm_sample(p, l, smem); ph_mem_attn(p, l); } }
        else       { if (ON(K_MIXB)) { ph_nsa(p, l - 2, smem); ph_mem_attn(p, l); } }
        NEXT();
        if (ON(K_FIN)) { if (l < 2) ph_mlstm_fin(p, l); }
        NEXT();
        if (ON(K_GEMM)) ph_gemm(CAT, DM, p.in[I_WOUT] + (size_t)l * DM * DM, DM, X, DM, MA, DM, DM, true, smem);
        NEXT();
        if (ON(K_NORM)) ph_rmsnorm(X, p.in[I_GFFN] + l * DM, H, MA);
        NEXT();
        if (ON(K_GEMM)) ph_gemm(H, DM, p.in[I_WGU] + (size_t)l * DM * 2 * DFF, 2 * DFF, PB, 2 * DFF, MA, 2 * DFF, DM, false, smem);
        NEXT();
        if (ON(K_ACT)) ph_act(p);
        NEXT();
        if (ON(K_GEMM)) ph_gemm(ACT, DFF, p.in[I_WDOWN] + (size_t)l * DFF * DM, DM, X, DM, MA, DM, DFF, true, smem);
        NEXT();
        if (ON(K_NORM)) { if (l == 1) ph_rmsnorm(X, p.in[I_GKV], H, MA); }
        NEXT();
        if (ON(K_GEMM)) { if (l == 1) ph_gemm(H, DM, p.in[I_WKV], 768, KVR, 768, MA, 768, DM, false, smem); }
        NEXT();
        if (ON(K_ROWS)) { if (l == 1) ph_rows_post(p); }
        NEXT();
        if (ON(K_COMPRESS)) { if (l == 1) ph_compress(p, smem); }
        NEXT();
    }
    if (ON(K_FINAL)) { ph_copy4(X, p.out + O_YP, (size_t)MP * DM / 4); ph_copy4(X + (size_t)MP * DM, p.out + O_YS, (size_t)BS * DM / 4); }
}

template <unsigned MASK> static void launch_one(const Params& p, int grid, hipStream_t stream) { hipLaunchKernelGGL((fwd<MASK>), dim3(grid), dim3(256), 0, stream, p); }
#ifndef MK_ONLY
#define MK_ONLY 0xFFFFFFFFu
#endif
extern "C" void kernel_launch(void* const* d_in, const int* in_sizes, int n_in, void* d_out, int out_size, void* d_ws, size_t ws_size, hipStream_t stream) {
    static int grid = 0;
    if (!grid) {
        int dev = 0, cus = 0;
        (void)hipGetDevice(&dev); (void)hipDeviceGetAttribute(&cus, hipDeviceAttributeMultiprocessorCount, dev);
        if (cus < 1) cus = 256;
        grid = cus * 2;
    }
    if (n_in != N_IN || (size_t)out_size != O_END || ws_size < W_END * 4) fprintf(stderr, "kernel_launch: unexpected sizes n_in=%d out=%d ws=%zu need %zu\n", n_in, out_size, ws_size, (size_t)W_END * 4);
    (void)hipMemsetAsync(d_ws, 0, 1u << 20, stream);
    Params p{};
    for (int i = 0; i < N_IN; ++i) p.in[i] = (const float*)d_in[i];
    p.out = (float*)d_out; p.ws = (float*)d_ws; p.bar = (unsigned*)d_ws;
#if MK_MULTI
    for (int ph = 0; ph < NPH; ++ph) {
        const int k = phase_kind(ph); if (k < 0) continue;
        p.ph_lo = ph; p.ph_hi = ph + 1;
        switch (k) {
            case K_INIT: launch_one<1u << K_INIT>(p, grid, stream); break;
            case K_MEMKNORM: launch_one<1u << K_MEMKNORM>(p, grid, stream); break;
            case K_NORM: launch_one<1u << K_NORM>(p, grid, stream); break;
            case K_GEMM: launch_one<1u << K_GEMM>(p, grid, stream); break;
            case K_MIXA: launch_one<1u << K_MIXA>(p, grid, stream); break;
            case K_MIXB: launch_one<1u << K_MIXB>(p, grid, stream); break;
            case K_FIN: launch_one<1u << K_FIN>(p, grid, stream); break;
            case K_ACT: launch_one<1u << K_ACT>(p, grid, stream); break;
            case K_ROWS: launch_one<1u << K_ROWS>(p, grid, stream); break;
            case K_COMPRESS: launch_one<1u << K_COMPRESS>(p, grid, stream); break;
            case K_FINAL: launch_one<1u << K_FINAL>(p, grid, stream); break;
        }
    }
#else
    p.ph_lo = 0; p.ph_hi = NPH;
    launch_one<MK_ONLY>(p, grid, stream);
#endif
}
```

```cpp
#include <hip/hip_runtime.h>
#include <cstdio>
#include <cstdint>

#define LAS __attribute__((address_space(3)))
#define GAS __attribute__((address_space(1)))
#define XB_TMO      128
#define XB_XCNT(j)  (256  + 64 * (j))
#define XB_XSUB(j)  (1280 + 64 * (j))
#define XB_XGEN(j)  (2304 + 64 * (j))
#define XB_TOP      3328
#define XB_TOPGEN   3392
#define XCD_BAR_WORDS 3456
#define XB_SPIN_CAP (1u << 23)
__device__ __forceinline__ unsigned xb_ld(unsigned* p)              { return __hip_atomic_load(p, __ATOMIC_RELAXED, __HIP_MEMORY_SCOPE_AGENT); }
__device__ __forceinline__ unsigned xb_add(unsigned* p, unsigned v) { return __hip_atomic_fetch_add(p, v, __ATOMIC_RELAXED, __HIP_MEMORY_SCOPE_AGENT); }
__device__ __forceinline__ unsigned xb_xcc_id() { return (unsigned)__builtin_amdgcn_s_getreg((3 << 11) | 20) & 0xFu; }
#define XB_SPIN(cond, bar) do { unsigned _sp = 0; while (cond) { __builtin_amdgcn_s_sleep(1); \
    if ((++_sp & 255u) == 0u) { if (xb_ld(&(bar)[XB_TMO])) break; if (_sp > XB_SPIN_CAP) { atomicAdd(&(bar)[XB_TMO], 1u); break; } } } } while (0)
struct XcdBarrier { unsigned* bar; unsigned x; volatile LAS unsigned* st; };
__device__ __forceinline__ XcdBarrier xcd_barrier_post(unsigned* bar, volatile LAS unsigned* st) {
    XcdBarrier b; b.bar = bar; b.x = xb_xcc_id(); b.st = st;
    if (threadIdx.x == 0) (void)xb_add(&bar[XB_XCNT(b.x)], 1u);
    return b;
}
__device__ __forceinline__ void xcd_barrier_complete(unsigned* bar, unsigned x, unsigned& nloc, unsigned& nx) {
    const unsigned G = gridDim.x * gridDim.y * gridDim.z;
    unsigned sum, cnt, mine, sp = 0u;
    for (;;) {
        sum = 0u; cnt = 0u; mine = 0u;
#pragma unroll
        for (unsigned j = 0; j < 16; ++j) { const unsigned c = xb_ld(&bar[XB_XCNT(j)]); sum += c; cnt += (c > 0u) ? 1u : 0u; mine = (j == x) ? c : mine; }
        if (sum == G) break;
        __builtin_amdgcn_s_sleep(1);
        if ((++sp & 255u) == 0u) { if (xb_ld(&bar[XB_TMO])) break; if (sp > XB_SPIN_CAP) { atomicAdd(&bar[XB_TMO], 1u); break; } }
    }
    nloc = mine > 0u ? mine : 1u; nx = cnt > 0u ? cnt : 1u;
}
__device__ __forceinline__ void xcd_barrier(const XcdBarrier& b) {
    asm volatile("s_waitcnt vmcnt(0)" ::: "memory");
    __syncthreads();
    if (threadIdx.x == 0) {
        unsigned* bar = b.bar;
        __builtin_amdgcn_s_waitcnt(0);
        unsigned nloc = b.st[0], nx = b.st[1];
        if (nloc == 0u) { xcd_barrier_complete(bar, b.x, nloc, nx); b.st[0] = nloc; b.st[1] = nx; }
        const unsigned old = xb_add(&bar[XB_XSUB(b.x)], 1u);
        const unsigned gen = old / nloc;
        if (old + 1u == (gen + 1u) * nloc) {
            __builtin_amdgcn_fence(__ATOMIC_RELEASE, "agent");
            asm volatile("s_waitcnt vmcnt(0)" ::: "memory");
            const unsigned og = xb_add(&bar[XB_TOP], 1u);
            const unsigned tg = og / nx;
            if (og + 1u == (tg + 1u) * nx) xb_add(&bar[XB_TOPGEN], 1u);
            else XB_SPIN(xb_ld(&bar[XB_TOPGEN]) == tg, bar);
            __builtin_amdgcn_fence(__ATOMIC_ACQUIRE, "agent");
            xb_add(&bar[XB_XGEN(b.x)], 1u);
            asm volatile("s_waitcnt vmcnt(0)" ::: "memory");
        } else {
            XB_SPIN(xb_ld(&bar[XB_XGEN(b.x)]) == gen, bar);
            __builtin_amdgcn_fence(__ATOMIC_ACQUIRE, "agent");
            asm volatile("s_waitcnt vmcnt(0)" ::: "memory");
        }
    }
    __syncthreads();
}

constexpr int NT_ = 512, NW_ = 8;
constexpr int DM = 1024, BP = 8, SP = 2048, MP = BP * SP, BS = 128, MA = MP + BS;
constexpr int ACOLS = 3336, BCOLS = 1060, DFF = 2816;
constexpr int LDA_ = 3328, LDB_ = 1024;
constexpr int NBTA = 3344, NBTB = 1072;
constexpr int PAST = 2048, GTW = 48;
constexpr float EPS = 1e-6f, NEGM = -1e30f;
typedef unsigned short bf16_t;

enum { I_XP = 0, I_XS, I_SC, I_SN, I_SM, I_CMEM, I_CCMP, I_CSLC, I_CWIN, I_PT, I_MEMP, I_GMIX, I_WINA, I_BIF, I_GHN, I_WINB, I_GQ, I_BGATE, I_REL,
       I_GKV, I_WKV, I_GKSLC, I_GKWIN, I_GKCMP, I_CPOS, I_CW1, I_CB1, I_CW2, I_CB2, I_WMEMKV, I_GMEMK, I_GMEMQ, I_WOUT, I_GFFN, I_WGU, I_WDOWN, N_IN };
constexpr size_t O_YP = 0, O_YS = O_YP + (size_t)MP * DM, O_PC = O_YS + (size_t)BS * DM, O_PN = O_PC + 2ull * 8 * 4 * 192 * 192, O_PM = O_PN + 2ull * 8 * 4 * 192,
    O_PMEM = O_PM + 64, O_PCMP = O_PMEM + 4ull * 8 * 256 * 512, O_PSLC = O_PCMP + (size_t)MP * 256, O_PWIN = O_PSLC + (size_t)MP * 256, O_SC = O_PWIN + 8ull * 512 * 256,
    O_SN = O_SC + 2ull * 128 * 4 * 192 * 192, O_SM = O_SN + 2ull * 128 * 4 * 192, O_SCMP = O_SM + 1024, O_SSLC = O_SCMP + 128 * 256, O_SWIN = O_SSLC + 128 * 256,
    O_END = O_SWIN + 128ull * 512 * 256;
static_assert(O_END == 87700544ull, "output size");
constexpr size_t CTL_BYTES = 2u << 20, B_SSQ = 65536;
constexpr size_t al256(size_t x) { return (x + 255) & ~(size_t)255; }
constexpr size_t B_XB = CTL_BYTES, B_P16 = al256(B_XB + (size_t)MA * DM * 2), B_GT = al256(B_P16 + (size_t)MA * LDA_ * 2), B_CATB = al256(B_GT + (size_t)MA * GTW * 4),
    B_HID = al256(B_CATB + (size_t)MA * DM * 2), B_HRAW = al256(B_HID + (size_t)MA * DFF * 2), B_KVR = al256(B_HRAW + (size_t)MA * 768 * 4), B_CK = al256(B_KVR + (size_t)MA * 768 * 4),
    B_CV = al256(B_CK + 136ull * 127 * 128 * 4), B_MPB = al256(B_CV + 136ull * 127 * 128 * 4),
    B_BTA = al256(B_MPB + 2048ull * DM * 2), B_BTB = al256(B_BTA + 2ull * NBTA * DM * 2), B_BTO = al256(B_BTB + 2ull * NBTB * DM * 2), B_BTG = al256(B_BTO + 4ull * DM * DM * 2),
    B_BTD = al256(B_BTG + 4ull * 2 * DFF * DM * 2), B_BTK = al256(B_BTD + 4ull * DM * DFF * 2), B_BTM = al256(B_BTK + 768ull * DM * 2), B_END = al256(B_BTM + 2048ull * DM * 2);
static_assert(8 * MA * 4 + B_SSQ <= CTL_BYTES, "ssq sites inside the control region");

struct Params { const float* in[N_IN]; float* out; unsigned char* ws; int ph_lo, ph_hi; };

__device__ const unsigned char REL_LUT[128] = {0, 1, 2, 3, 4, 5, 6, 7, 8, 9, 10, 11, 12, 13, 14, 15, 16, 16, 16, 17, 17, 18, 18, 18, 19, 19, 19, 20, 20, 20, 20, 21, 21, 21, 21, 22, 22, 22, 22, 22, 23, 23, 23, 23, 23, 23, 24, 24, 24, 24, 24, 24, 25, 25, 25, 25, 25, 25, 25, 26, 26, 26, 26, 26, 26, 26, 26, 27, 27, 27, 27, 27, 27, 27, 27, 27, 27, 28, 28, 28, 28, 28, 28, 28, 28, 28, 28, 29, 29, 29, 29, 29, 29, 29, 29, 29, 29, 29, 29, 30, 30, 30, 30, 30, 30, 30, 30, 30, 30, 30, 30, 30, 30, 31, 31, 31, 31, 31, 31, 31, 31, 31, 31, 31, 31, 31, 31, 31};
__device__ __forceinline__ int rel_bucket(int d) { return d >= 128 ? 31 : (int)REL_LUT[d < 0 ? 0 : d]; }

__device__ __forceinline__ int ltid() { int t = threadIdx.x; asm volatile("" : "+v"(t)); return t; }
__device__ __forceinline__ float wave_sum(float v) {
#pragma unroll
    for (int o = 32; o; o >>= 1) v += __shfl_xor(v, o);
    return v;
}
__device__ __forceinline__ float wave_max(float v) {
#pragma unroll
    for (int o = 32; o; o >>= 1) v = fmaxf(v, __shfl_xor(v, o));
    return v;
}
__device__ __forceinline__ float sigmoidf_(float x) { return 1.0f / (1.0f + expf(-x)); }
__device__ __forceinline__ float logsigmoidf_(float x) { return fminf(x, 0.f) - log1pf(expf(-fabsf(x))); }
__device__ __forceinline__ float dot4(float4 a, float4 b) { return a.x * b.x + a.y * b.y + a.z * b.z + a.w * b.w; }
__device__ __forceinline__ float bf2f(bf16_t u) { return __uint_as_float((unsigned)u << 16); }
__device__ __forceinline__ unsigned f2bf(float f) { unsigned u = __float_as_uint(f); return (u + 0x7fffu + ((u >> 16) & 1u)) >> 16; }
__device__ __forceinline__ unsigned pk2(float lo, float hi) { return f2bf(lo) | (f2bf(hi) << 16); }
__device__ __forceinline__ float bflo(unsigned w) { return __uint_as_float(w << 16); }
__device__ __forceinline__ float bfhi(unsigned w) { return __uint_as_float(w & 0xffff0000u); }
__device__ __forceinline__ float rstd_of(float ssq) { return rsqrtf(ssq * (1.0f / DM) + EPS); }

namespace pg8 {
#define PG8_LAS __attribute__((address_space(3)))
typedef unsigned short bf16_t;
typedef short bf16x8 __attribute__((ext_vector_type(8)));
typedef float f32x4 __attribute__((ext_vector_type(4)));
typedef unsigned u32x4 __attribute__((ext_vector_type(4)));
constexpr int BM = 256, BK = 64, HALF = 128, HTB = HALF * BK * 2  , STAGE_BYTES = 8 * HTB, NXCD = 8, WGM = 8;

__host__ __device__ __forceinline__ int lds_byte(int r, int c) { const int st = (r >> 4) * 2 + (c >> 5), rr = r & 15, cc = c & 31, ob = rr * 64 + cc * 2; return st * 1024 + (ob ^ (((ob >> 9) & 1) << 5)); }
__host__ __device__ __forceinline__ void stage_rc(int b, int& R, int& C) { const int st = b / 1024, sb = b % 1024, swz = sb ^ (((sb >> 9) & 1) << 5); R = (st >> 1) * 16 + swz / 64; C = (st & 1) * 32 + (swz % 64) / 2; }
__host__ __device__ __forceinline__ int perm32(int rho) { const int n = rho >> 4, i = rho & 15; return 8 * (i >> 2) + 4 * n + (i & 3); }

struct Unit { int pm, pn; };
struct Gemm { const bf16_t* A; const bf16_t* Bt; int M, N, K; };

struct StaticOrder {
    int nM, nN, nwg, G, c;
    __host__ __device__ void init(int M, int N, int G_, int c_) { nM = M / BM; nN = N / BM; nwg = nM * nN; G = G_; c = c_; }
    __host__ __device__ bool next(int i, Unit& u) const {
        const long L = (long)i * G + c; if (L >= nwg) return false;
        int wgid = (int)L; { const int q = nwg / NXCD, r = nwg % NXCD, xcd = wgid % NXCD, off = wgid / NXCD; wgid = (xcd < r ? xcd * (q + 1) : r * (q + 1) + (xcd - r) * q) + off; }
        const int nig = WGM * nN, gid = wgid / nig, fm = gid * WGM, gsz = (nM - fm) < WGM ? (nM - fm) : WGM;
        u.pm = fm + ((wgid % nig) % gsz); u.pn = (wgid % nig) / gsz; return true;
    }
    __device__ __forceinline__ void a_ready(const Unit&) const {}
    __device__ __forceinline__ void done(const Unit&) const {}
};

__device__ __forceinline__ unsigned cvt_pk_bf16(float lo, float hi) { unsigned r; asm volatile("v_cvt_pk_bf16_f32 %0, %1, %2" : "=v"(r) : "v"(lo), "v"(hi)); return r; }
typedef float f32x2 __attribute__((ext_vector_type(2)));
__device__ __forceinline__ float fast_sigmoid(float x) { return __builtin_amdgcn_rcpf(1.0f + __builtin_amdgcn_exp2f(-1.4426950408889634f * x)); }
struct EpiF32 {
    static constexpr bool PERM = false, AFTER_DRAIN = false;
    float* O; int ldc; const float* ssq; int split_cols; size_t split_stride;
    __device__ __forceinline__ void operator()(const f32x4 (&acc)[2][2][4][2], const Unit& u, int wr, int wc, int fr, int fq) const {
        int colt = u.pn * BM; float* base = O; if (split_cols) { const int t = colt / split_cols; base += (size_t)t * split_stride; colt -= t * split_cols; }
        const int row0 = u.pm * BM + wr * 64 + fr, col0 = colt + wc * 32 + 4 * fq;
#pragma unroll
        for (int ai = 0; ai < 2; ++ai)
#pragma unroll
            for (int m = 0; m < 4; ++m) { const int r = row0 + ai * HALF + m * 16; const float rs = ssq ? rstd_of(ssq[r]) : 1.0f; float* rowp = base + (size_t)r * ldc + col0;
#pragma unroll
                for (int bj = 0; bj < 2; ++bj)
#pragma unroll
                    for (int n = 0; n < 2; ++n) *(f32x4*)(rowp + bj * HALF + n * 16) = acc[ai][bj][m][n] * rs; }
    }
};
struct EpiBf16S {
    static constexpr bool PERM = true, AFTER_DRAIN = false;
    bf16_t* O; int ldc; const float* ssq;
    __device__ __forceinline__ void operator()(const f32x4 (&acc)[2][2][4][2], const Unit& u, int wr, int wc, int fr, int fq) const {
        const int row0 = u.pm * BM + wr * 64 + fr, col0 = u.pn * BM + wc * 32 + 8 * fq;
#pragma unroll
        for (int ai = 0; ai < 2; ++ai)
#pragma unroll
            for (int m = 0; m < 4; ++m) { const int r = row0 + ai * HALF + m * 16; const float rs = rstd_of(ssq[r]); bf16_t* rowp = O + (size_t)r * ldc + col0;
#pragma unroll
                for (int bj = 0; bj < 2; ++bj) { const f32x4 v0 = acc[ai][bj][m][0] * rs, v1 = acc[ai][bj][m][1] * rs;
                    u32x4 w; w.x = cvt_pk_bf16(v0[0], v0[1]); w.y = cvt_pk_bf16(v0[2], v0[3]); w.z = cvt_pk_bf16(v1[0], v1[1]); w.w = cvt_pk_bf16(v1[2], v1[3]);
                    *(u32x4*)(rowp + bj * HALF) = w; } }
    }
};
struct EpiSwiglu {
    static constexpr bool PERM = true, AFTER_DRAIN = false;
    bf16_t* O; const float* ssq;
    __device__ __forceinline__ void operator()(const f32x4 (&acc)[2][2][4][2], const Unit& u, int wr, int wc, int fr, int fq) const {
        const int row0 = u.pm * BM + wr * 64 + fr, col0 = u.pn * HALF + wc * 32 + 8 * fq;
#pragma unroll
        for (int ai = 0; ai < 2; ++ai)
#pragma unroll
            for (int m = 0; m < 4; ++m) { const int r = row0 + ai * HALF + m * 16; const float rs = rstd_of(ssq[r]); float h[8];
#pragma unroll
                for (int n = 0; n < 2; ++n)
#pragma unroll
                    for (int j = 0; j < 4; ++j) { const float g = acc[ai][0][m][n][j] * rs, up = acc[ai][1][m][n][j] * rs; h[4 * n + j] = g * fast_sigmoid(g) * up; }
                u32x4 w; w.x = cvt_pk_bf16(h[0], h[1]); w.y = cvt_pk_bf16(h[2], h[3]); w.z = cvt_pk_bf16(h[4], h[5]); w.w = cvt_pk_bf16(h[6], h[7]);
                *(u32x4*)(O + (size_t)r * 2816 + col0) = w; }
    }
};
struct EpiResid {
    static constexpr bool PERM = false, AFTER_DRAIN = false;
    float* XF; bf16_t* XB; float* ssq;
    __device__ __forceinline__ void operator()(const f32x4 (&acc)[2][2][4][2], const Unit& u, int wr, int wc, int fr, int fq) const {
        const int row0 = u.pm * BM + wr * 64 + fr, col0 = u.pn * BM + wc * 32 + 4 * fq;
#pragma unroll
        for (int ai = 0; ai < 2; ++ai)
#pragma unroll
            for (int m = 0; m < 4; ++m) { const int r = row0 + ai * HALF + m * 16; float* xp = XF + (size_t)r * 1024 + col0; bf16_t* bp = XB + (size_t)r * 1024 + col0; float ss = 0.f;
#pragma unroll
                for (int bj = 0; bj < 2; ++bj)
#pragma unroll
                    for (int n = 0; n < 2; ++n) { f32x4 x = *(const f32x4*)(xp + bj * HALF + n * 16); x = x + acc[ai][bj][m][n]; *(f32x4*)(xp + bj * HALF + n * 16) = x;
                        typedef unsigned u32x2 __attribute__((ext_vector_type(2))); u32x2 w; w.x = cvt_pk_bf16(x[0], x[1]); w.y = cvt_pk_bf16(x[2], x[3]); *(u32x2*)(bp + bj * HALF + n * 16) = w;
                        ss += (x[0] * x[0] + x[1] * x[1]) + (x[2] * x[2] + x[3] * x[3]); }
                ss += __shfl_xor(ss, 16); ss += __shfl_xor(ss, 32);
                if (fq == 0) (void)__hip_atomic_fetch_add(ssq + r, ss, __ATOMIC_RELAXED, __HIP_MEMORY_SCOPE_AGENT); }
    }
};
template <class Epi, class Sched, bool ALIGN_EPI = false, bool SP2 = false>
__device__ __forceinline__ void gemm_phase(PG8_LAS unsigned char* lds, const Gemm g, const Sched& S, const Epi& E) {
    int tid_l = threadIdx.x; asm volatile("" : "+v"(tid_l));
    const int tid = tid_l, wid = __builtin_amdgcn_readfirstlane(tid >> 6), lane = tid & 63, wr = wid >> 2, wc = wid & 3, fr = lane & 15, fq = lane >> 4;
    const int K = g.K, nt = K / BK;
    unsigned voffA[2], voffB[2];
#pragma unroll
    for (int i = 0; i < 2; ++i) { int R, C; stage_rc(tid * 16 + i * 8192, R, C); const int Rb = Epi::PERM ? ((R & ~31) + perm32(R & 31)) : R;
        voffA[i] = (unsigned)(R * K + C) * 2u; voffB[i] = (unsigned)(Rb * K + C) * 2u; }
    const size_t kstep = (size_t)(BK * 2);
    const size_t hstep = (size_t)HALF * K * 2;
    const size_t tstep = 2 * hstep;
    const unsigned ldsw = (unsigned)wid * 1024u;
    const int aoff = lds_byte(wr * 64 + fr, fq * 8), boff = lds_byte(wc * 32 + fr, fq * 8);
#define PG8_SA(b, h) (((b) * 2 + (h)) * HTB)
#define PG8_SB(b, h) ((4 + (b) * 2 + (h)) * HTB)
#define PG8_STAGE(bufoff, gbase, voff) do { _Pragma("unroll") for (int _i = 0; _i < 2; ++_i) \
        __builtin_amdgcn_global_load_lds((const unsigned*)((const char*)(gbase) + (voff)[_i]), (PG8_LAS unsigned*)(lds + (bufoff) + ldsw + _i * 8192), 16, 0, 0); } while (0)
#define PG8_LDA(dst, b, h) do { _Pragma("unroll") for (int m = 0; m < 4; ++m) _Pragma("unroll") for (int k = 0; k < 2; ++k) dst[m][k] = *(const PG8_LAS bf16x8*)(lds + PG8_SA(b, h) + aoff + m * 2048 + k * 1024); } while (0)
#define PG8_LDB(dst, b, h) do { _Pragma("unroll") for (int n = 0; n < 2; ++n) _Pragma("unroll") for (int k = 0; k < 2; ++k) dst[n][k] = *(const PG8_LAS bf16x8*)(lds + PG8_SB(b, h) + boff + n * 2048 + k * 1024); } while (0)
#define PG8_MMA(ai, bj, At, Bt) do { __builtin_amdgcn_s_setprio(1); _Pragma("unroll") for (int m = 0; m < 4; ++m) _Pragma("unroll") for (int n = 0; n < 2; ++n) _Pragma("unroll") for (int k = 0; k < 2; ++k) \
        acc[ai][bj][m][n] = __builtin_amdgcn_mfma_f32_16x16x32_bf16(Bt[n][k], At[m][k], acc[ai][bj][m][n], 0, 0, 0); __builtin_amdgcn_s_setprio(0); } while (0)
#define PG8_WAIT_V(n) asm volatile("s_waitcnt vmcnt(" #n ")" ::: "memory")
#define PG8_WAIT_L(n) asm volatile("s_waitcnt lgkmcnt(" #n ")" ::: "memory")
#define PG8_BAR __builtin_amdgcn_s_barrier()
#define PG8_SCHED __builtin_amdgcn_sched_barrier(0)
    Unit cur, nxt; int ui = 0;
    if (!S.next(0, cur)) return;
    f32x4 acc[2][2][4][2];
#pragma unroll
    for (int a = 0; a < 2; ++a)
#pragma unroll
        for (int b = 0; b < 2; ++b)
#pragma unroll
            for (int m = 0; m < 4; ++m)
#pragma unroll
                for (int n = 0; n < 2; ++n) acc[a][b][m][n] = (f32x4){0.f, 0.f, 0.f, 0.f};
    bf16x8 At[4][2], B0[2][2], B1[2][2];
    const char* cA = (const char*)g.A + (size_t)cur.pm * tstep; const char* cB = (const char*)g.Bt + (size_t)cur.pn * tstep;
    S.a_ready(cur);
    if constexpr (SP2) {
        PG8_STAGE(PG8_SB(0, 0), cB, voffB); PG8_STAGE(PG8_SB(0, 1), cB + hstep, voffB); PG8_STAGE(PG8_SA(0, 0), cA, voffA); PG8_STAGE(PG8_SA(0, 1), cA + hstep, voffA);
        if (wr == 1) PG8_BAR;
        PG8_WAIT_V(2); PG8_BAR;
        PG8_STAGE(PG8_SB(1, 0), cB + kstep, voffB); PG8_STAGE(PG8_SA(1, 0), cA + kstep, voffA); PG8_STAGE(PG8_SB(1, 1), cB + hstep + kstep, voffB);
        PG8_WAIT_V(6); PG8_BAR;
    } else {
        PG8_STAGE(PG8_SB(0, 0), cB, voffB); PG8_STAGE(PG8_SA(0, 0), cA, voffA); PG8_STAGE(PG8_SB(0, 1), cB + hstep, voffB); PG8_STAGE(PG8_SA(0, 1), cA + hstep, voffA);
        if (wr == 1) PG8_BAR;
        PG8_WAIT_V(4); PG8_BAR;
        PG8_STAGE(PG8_SB(1, 0), cB + kstep, voffB); PG8_STAGE(PG8_SA(1, 0), cA + kstep, voffA); PG8_STAGE(PG8_SB(1, 1), cB + hstep + kstep, voffB);
        PG8_WAIT_V(6); PG8_BAR;
    }
    for (;;) {
        const bool has_next = S.next(ui + 1, nxt);
        const char* nA = has_next ? (const char*)g.A + (size_t)nxt.pm * tstep : cA; const char* nB = has_next ? (const char*)g.Bt + (size_t)nxt.pn * tstep : cB;
        for (int t = 0; t < nt; t += 2) {
            const bool last = (t == nt - 2);
            const char* a1 = cA + (size_t)(t + 1) * kstep;
            const char* a2 = last ? nA : cA + (size_t)(t + 2) * kstep; const char* b2 = last ? nB : cB + (size_t)(t + 2) * kstep;
            const char* a3 = a2 + kstep; const char* b3 = b2 + kstep;
            if (last && has_next) S.a_ready(nxt);
            if constexpr (SP2) {
            PG8_LDB(B0, 0, 0); PG8_LDB(B1, 0, 1); PG8_SCHED; PG8_LDA(At, 0, 0); PG8_STAGE(PG8_SA(1, 1), a1 + hstep, voffA);
            PG8_WAIT_V(8); PG8_WAIT_L(0); PG8_BAR; PG8_MMA(0, 0, At, B0); PG8_MMA(0, 1, At, B1); PG8_BAR; PG8_SCHED;
            PG8_LDA(At, 0, 1); PG8_STAGE(PG8_SB(0, 0), b2, voffB); PG8_STAGE(PG8_SB(0, 1), b2 + hstep, voffB); PG8_STAGE(PG8_SA(0, 0), a2, voffA);
            PG8_WAIT_V(8); PG8_WAIT_L(0); PG8_BAR; PG8_MMA(1, 0, At, B0); PG8_MMA(1, 1, At, B1); PG8_BAR; PG8_SCHED;
            PG8_LDB(B0, 1, 0); PG8_LDB(B1, 1, 1); PG8_SCHED; PG8_LDA(At, 1, 0); PG8_STAGE(PG8_SA(0, 1), a2 + hstep, voffA);
            PG8_WAIT_V(8); PG8_WAIT_L(0); PG8_BAR; PG8_MMA(0, 0, At, B0); PG8_MMA(0, 1, At, B1); PG8_BAR; PG8_SCHED;
            PG8_LDA(At, 1, 1); PG8_STAGE(PG8_SB(1, 0), b3, voffB); PG8_STAGE(PG8_SB(1, 1), b3 + hstep, voffB); PG8_STAGE(PG8_SA(1, 0), a3, voffA);
            PG8_WAIT_V(8); PG8_WAIT_L(0); PG8_BAR; PG8_MMA(1, 0, At, B0); PG8_MMA(1, 1, At, B1); PG8_BAR; PG8_SCHED;
            } else {
            PG8_LDB(B0, 0, 0); PG8_SCHED; PG8_LDA(At, 0, 0); PG8_STAGE(PG8_SA(1, 1), a1 + hstep, voffA);
            PG8_WAIT_L(8); PG8_BAR; PG8_WAIT_L(0); PG8_MMA(0, 0, At, B0); PG8_BAR; PG8_SCHED;
            PG8_LDB(B1, 0, 1); PG8_STAGE(PG8_SB(0, 0), b2, voffB);
            PG8_BAR; PG8_WAIT_L(0); PG8_MMA(0, 1, At, B1); PG8_BAR;
            PG8_LDA(At, 0, 1); PG8_STAGE(PG8_SA(0, 0), a2, voffA);
            PG8_BAR; PG8_WAIT_L(0); PG8_MMA(1, 0, At, B0); PG8_BAR; PG8_SCHED;
            PG8_STAGE(PG8_SB(0, 1), b2 + hstep, voffB);
            PG8_WAIT_V(6); PG8_BAR; PG8_MMA(1, 1, At, B1); PG8_BAR;
            PG8_LDB(B0, 1, 0); PG8_SCHED; PG8_LDA(At, 1, 0); PG8_STAGE(PG8_SA(0, 1), a2 + hstep, voffA);
            PG8_WAIT_L(8); PG8_BAR; PG8_WAIT_L(0); PG8_MMA(0, 0, At, B0); PG8_BAR; PG8_SCHED;
            PG8_LDB(B1, 1, 1); PG8_STAGE(PG8_SB(1, 0), b3, voffB);
            PG8_BAR; PG8_WAIT_L(0); PG8_MMA(0, 1, At, B1); PG8_BAR;
            PG8_LDA(At, 1, 1); PG8_STAGE(PG8_SA(1, 0), a3, voffA);
            PG8_BAR; PG8_WAIT_L(0); PG8_MMA(1, 0, At, B0); PG8_BAR; PG8_SCHED;
            PG8_STAGE(PG8_SB(1, 1), b3 + hstep, voffB);
            PG8_WAIT_V(6); PG8_BAR; PG8_MMA(1, 1, At, B1); PG8_BAR;
            }
        }
        if constexpr (ALIGN_EPI) { if (wr == 0) PG8_BAR; }
        if constexpr (!Epi::AFTER_DRAIN) { E(acc, cur, wr, wc, fr, fq); S.done(cur); }
        if (!has_next) break;
#pragma unroll
        for (int a = 0; a < 2; ++a)
#pragma unroll
            for (int b = 0; b < 2; ++b)
#pragma unroll
                for (int m = 0; m < 4; ++m)
#pragma unroll
                    for (int n = 0; n < 2; ++n) acc[a][b][m][n] = (f32x4){0.f, 0.f, 0.f, 0.f};
        cur = nxt; cA = nA; cB = nB; ++ui;
        if constexpr (ALIGN_EPI) { if (wr == 1) PG8_BAR; }
    }
    PG8_WAIT_V(0);
    if constexpr (!ALIGN_EPI) { if (wr == 0) PG8_BAR; }
    PG8_BAR;
    if constexpr (Epi::AFTER_DRAIN) { E.fused(acc, cur, wr, wc, fr, fq, lds, wid, lane); S.done(cur); }
#undef PG8_SA
#undef PG8_SB
#undef PG8_STAGE
#undef PG8_LDA
#undef PG8_LDB
#undef PG8_MMA
#undef PG8_WAIT_V
#undef PG8_WAIT_L
#undef PG8_BAR
#undef PG8_SCHED
}
}
typedef short s_bf16x8 __attribute__((ext_vector_type(8)));
typedef float s_f32x4 __attribute__((ext_vector_type(4)));
template <int NT> struct StripAcc { s_f32x4 a[NT]; };
template <int NT> __device__ __forceinline__ void strip_gemm(const bf16_t* A, int K, int row0, const bf16_t* Bt, const int* brow  , StripAcc<NT>& R) {
    const int tid_ = ltid(); const int lane = tid_ & 63, wave = tid_ >> 6, fr = lane & 15, fq = lane >> 4;
    const bf16_t* ap = A + (size_t)(row0 + wave * 16 + fr) * K + fq * 8;
    const bf16_t* bp[NT];
#pragma unroll
    for (int t = 0; t < NT; ++t) { bp[t] = Bt + (size_t)(brow[t] + fr) * K + fq * 8; R.a[t] = (s_f32x4){0.f, 0.f, 0.f, 0.f}; }
    for (int k0 = 0; k0 < K; k0 += 128) {
        s_bf16x8 a[4], b[NT][4];
#pragma unroll
        for (int s = 0; s < 4; ++s) { a[s] = *(const s_bf16x8*)(ap + k0 + s * 32);
#pragma unroll
            for (int t = 0; t < NT; ++t) b[t][s] = *(const s_bf16x8*)(bp[t] + k0 + s * 32); }
#pragma unroll
        for (int s = 0; s < 4; ++s)
#pragma unroll
            for (int t = 0; t < NT; ++t) R.a[t] = __builtin_amdgcn_mfma_f32_16x16x32_bf16(b[t][s], a[s], R.a[t], 0, 0, 0);
    }
}
enum { TR_ID = 0, TR_INA, TR_INB, TR_GU };
__device__ __forceinline__ int tr_rowmap(int kind, int n) {
    if (kind == TR_INA) return n < 3072 ? n : (n < 3080 ? 3328 + (n - 3072) : 3072 + (n - 3080));
    if (kind == TR_INB) return n < 768 ? n : (n < 804 ? 1024 + (n - 768) : 768 + (n - 804));
    if (kind == TR_GU) { if (n < DFF) return (n >> 7) * 256 + (n & 127); const int m = n - DFF; return (m >> 7) * 256 + 128 + (m & 127); }
    return n;
}
__device__ __forceinline__ void tr_item(const float* W, int K, int N, bf16_t* WT, const float* gain, int kind, LAS float* scr, int item, int lane) {
    const int nblk = (N + 31) >> 5, kb = item / nblk, nb = item % nblk, k0 = 64 * kb, n0 = 32 * nb;
#pragma unroll 8
    for (int i = 0; i < 32; ++i) { const int kk = 2 * i + (lane >> 5), n = n0 + (lane & 31); float v = 0.f;
        if (n < N) { v = W[(size_t)(k0 + kk) * N + n]; if (gain) v *= gain[k0 + kk]; }
        scr[kk * 33 + (lane & 31)] = v; }
    asm volatile("s_waitcnt lgkmcnt(0)" ::: "memory");
    const int c = lane & 7;
#pragma unroll
    for (int j = 0; j < 4; ++j) { const int nn = (lane >> 3) + 8 * j, n = n0 + nn;
        if (n < N) { const int row = tr_rowmap(kind, n); const float sc = (kind == TR_INA && n >= 768 && n < 1536) ? 0.07216878364870322f : 1.0f;
            const LAS float* s = scr + (8 * c) * 33 + nn; uint4 o;
            o.x = pk2(s[0 * 33] * sc, s[1 * 33] * sc); o.y = pk2(s[2 * 33] * sc, s[3 * 33] * sc); o.z = pk2(s[4 * 33] * sc, s[5 * 33] * sc); o.w = pk2(s[6 * 33] * sc, s[7 * 33] * sc);
            *(uint4*)(WT + (size_t)row * K + k0 + 8 * c) = o; } }
    asm volatile("s_waitcnt lgkmcnt(0)" ::: "memory");
}
__device__ __forceinline__ void ph_prologue(const Params& p, LAS unsigned char* lds) {
    const int tid = ltid(), lane = tid & 63, wid = tid >> 6; const int gw = blockIdx.x * NW_ + wid, NGW = gridDim.x * NW_;
    LAS float* scr = (LAS float*)(lds + wid * 16384);
    unsigned char* ws = p.ws;
    for (int it = gw; ; it += NGW) {
        int r = it; bool done = false;
#define TRJ(Wp, K_, N_, WTp, gainp, kind_) if (!done) { const int cnt = ((K_) / 64) * (((N_) + 31) / 32); if (r < cnt) { tr_item(Wp, K_, N_, WTp, gainp, kind_, scr, r, lane); done = true; } else r -= cnt; }
        for (int l = 0; l < 4; ++l) TRJ(p.in[I_WGU] + (size_t)l * DM * 2 * DFF, DM, 2 * DFF, (bf16_t*)(ws + B_BTG) + (size_t)l * 2 * DFF * DM, p.in[I_GFFN] + l * DM, TR_GU)
        for (int l = 0; l < 4; ++l) TRJ(p.in[I_WDOWN] + (size_t)l * DFF * DM, DFF, DM, (bf16_t*)(ws + B_BTD) + (size_t)l * DM * DFF, (const float*)nullptr, TR_ID)
        for (int l = 0; l < 2; ++l) TRJ(p.in[I_WINA] + (size_t)l * DM * ACOLS, DM, ACOLS, (bf16_t*)(ws + B_BTA) + (size_t)l * NBTA * DM, p.in[I_GMIX] + l * DM, TR_INA)
        for (int l = 0; l < 2; ++l) TRJ(p.in[I_WINB] + (size_t)l * DM * BCOLS, DM, BCOLS, (bf16_t*)(ws + B_BTB) + (size_t)l * NBTB * DM, p.in[I_GMIX] + (2 + l) * DM, TR_INB)
        for (int l = 0; l < 4; ++l) TRJ(p.in[I_WOUT] + (size_t)l * DM * DM, DM, DM, (bf16_t*)(ws + B_BTO) + (size_t)l * DM * DM, (const float*)nullptr, TR_ID)
        TRJ(p.in[I_WKV], DM, 768, (bf16_t*)(ws + B_BTK), p.in[I_GKV], TR_ID)
        for (int l = 0; l < 4; ++l) TRJ(p.in[I_WMEMKV] + (size_t)l * DM * 512, DM, 512, (bf16_t*)(ws + B_BTM) + (size_t)l * 512 * DM, (const float*)nullptr, TR_ID)
#undef TRJ
        if (!done) break;
    }
    for (int i = blockIdx.x * NT_ + tid; i < 2 * 8 * 128 + 2 * 12 * 128; i += gridDim.x * NT_) {
        uint4 z = make_uint4(0u, 0u, 0u, 0u);
        if (i < 2048) { const int l = i >> 10, rr = (i >> 7) & 7, c = i & 127; ((uint4*)((bf16_t*)(ws + B_BTA) + ((size_t)l * NBTA + 3336 + rr) * DM))[c] = z; }
        else { const int k = i - 2048; const int l = k / 1536, rr = (k % 1536) >> 7, c = k & 127; ((uint4*)((bf16_t*)(ws + B_BTB) + ((size_t)l * NBTB + 1060 + rr) * DM))[c] = z; }
    }
    float* XF = p.out; bf16_t* XB = (bf16_t*)(ws + B_XB); float* ssq0 = (float*)(ws + B_SSQ); bf16_t* MPB = (bf16_t*)(ws + B_MPB);
    for (int r = gw; r < MA + 2048; r += NGW) {
        const bool isx = r < MA; const float* src = isx ? (r < MP ? p.in[I_XP] + (size_t)r * DM : p.in[I_XS] + (size_t)(r - MP) * DM) : p.in[I_MEMP] + (size_t)(r - MA) * DM;
        bf16_t* dstb = isx ? XB + (size_t)r * DM : MPB + (size_t)(r - MA) * DM; float ss = 0.f;
#pragma unroll
        for (int j = 0; j < 4; ++j) { const float4 v = ((const float4*)src)[lane + 64 * j]; ss += dot4(v, v);
            if (isx) ((float4*)(XF + (size_t)r * DM))[lane + 64 * j] = v;
            ((uint2*)dstb)[lane + 64 * j] = make_uint2(pk2(v.x, v.y), pk2(v.z, v.w)); }
        ss = wave_sum(ss); if (isx && lane == 0) ssq0[r] = ss;
    }
    for (size_t i = (size_t)blockIdx.x * NT_ + tid; i < 128ull * 511 * 64; i += (size_t)gridDim.x * NT_) {
        const size_t b = i / (511 * 64), r = i % (511 * 64);
        ((float4*)(p.out + O_SWIN + b * 512 * 256))[r] = ((const float4*)(p.in[I_CWIN] + b * 512 * 256 + 256))[r];
    }
}

__device__ __forceinline__ void ph_memk_norm(const Params& p) {
    const int tid_ = ltid(); const int lane = tid_ & 63, wid = tid_ >> 6;
    for (int it = blockIdx.x * NW_ + wid; it < 4 * 8 * 256; it += gridDim.x * NW_) {
        const int l = it / 2048;
        float4* kr = (float4*)(p.out + O_PMEM + (size_t)it * 512);
        float4 v = kr[lane]; float ss = dot4(v, v);
        ss += __shfl_xor(ss, 1); ss += __shfl_xor(ss, 2); ss += __shfl_xor(ss, 4); ss += __shfl_xor(ss, 8);
        const float rs = rsqrtf(ss * (1.0f / 64) + EPS);
        const float4 g = ((const float4*)(p.in[I_GMEMK] + l * 64))[lane & 15];
        v.x *= rs * g.x; v.y *= rs * g.y; v.z *= rs * g.z; v.w *= rs * g.w; kr[lane] = v;
    }
}

__device__ __forceinline__ void ph_mlstm_prompt(const Params& p, int l, float* lds) {
    const bf16_t* P = (const bf16_t*)(p.ws + B_P16); const float* GT = (const float*)(p.ws + B_GT); const float* bif = p.in[I_BIF] + l * 8; float* HR = (float*)(p.ws + B_HRAW);
    const int tid = ltid(), lane = tid & 63, wid = tid >> 6;
    float* red = lds;
    for (int item = blockIdx.x; item < 256; item += gridDim.x) {
        const int es = item & 7, h = (item >> 3) & 3, b = item >> 5;
        const bool act = tid < 384; const int grp = tid >= 192 ? 1 : 0; const int d = act ? tid - grp * 192 : 0;
        const int col0 = h * 192 + es * 24 + (act ? grp : 0) * 12;
        float C[12]; float n = 0.f, m = NEGM;
#pragma unroll
        for (int e = 0; e < 12; ++e) C[e] = 0.f;
        const bf16_t* pr = P + (size_t)(b * SP) * LDA_; const float* gr = GT + (size_t)(b * SP) * GTW;
        float qn = act ? bf2f(pr[h * 192 + d]) : 0.f, kn = act ? bf2f(pr[768 + h * 192 + d]) : 0.f; uint2 vn[3];
#pragma unroll
        for (int e = 0; e < 3; ++e) vn[e] = *(const uint2*)(pr + 1536 + col0 + 4 * e);
        float in_ = gr[h] + bif[h], fn = gr[4 + h] + bif[4 + h];
        for (int t = 0; t < SP; ++t) {
            const float q = qn, k = kn, ig = in_, fg = fn; float v[12];
#pragma unroll
            for (int e = 0; e < 3; ++e) { v[4 * e] = bflo(vn[e].x); v[4 * e + 1] = bfhi(vn[e].x); v[4 * e + 2] = bflo(vn[e].y); v[4 * e + 3] = bfhi(vn[e].y); }
            if (t + 1 < SP) {
                pr += LDA_; gr += GTW;
                qn = act ? bf2f(pr[h * 192 + d]) : 0.f; kn = act ? bf2f(pr[768 + h * 192 + d]) : 0.f;
#pragma unroll
                for (int e = 0; e < 3; ++e) vn[e] = *(const uint2*)(pr + 1536 + col0 + 4 * e);
                in_ = gr[h] + bif[h]; fn = gr[4 + h] + bif[4 + h];
            }
            const float logf = logsigmoidf_(fg);
            const float m_new = fmaxf(logf + m, ig);
            const float a = expf(logf + m - m_new), bb = expf(ig - m_new);
            const float kb = bb * k;
            float part[13];
#pragma unroll
            for (int e = 0; e < 12; ++e) { C[e] = a * C[e] + kb * v[e]; part[e] = q * C[e]; }
            n = a * n + kb; part[12] = q * n;
#pragma unroll
            for (int e = 0; e < 13; ++e) part[e] = wave_sum(part[e]);
            float* rb = red + (t & 1) * 104;
            if (lane == 0) {
#pragma unroll
                for (int e = 0; e < 13; ++e) rb[wid * 13 + e] = part[e];
            }
            __syncthreads();
            if (tid < 24) {
                const int g2 = tid / 12, e = tid % 12;
                const float num = rb[(g2 * 3) * 13 + e] + rb[(g2 * 3 + 1) * 13 + e] + rb[(g2 * 3 + 2) * 13 + e];
                const float den = rb[12] + rb[13 + 12] + rb[26 + 12];
                HR[(size_t)(b * SP + t) * 768 + h * 192 + es * 24 + tid] = num / fmaxf(fabsf(den), expf(-m_new));
            }
            m = m_new;
        }
        if (act) {
            float* co = p.out + O_PC + ((size_t)((l * 8 + b) * 4 + h) * 192 + d) * 192 + es * 24 + grp * 12;
#pragma unroll
            for (int e = 0; e < 12; ++e) co[e] = C[e];
            if (es == 0 && grp == 0) p.out[O_PN + (size_t)((l * 8 + b) * 4 + h) * 192 + d] = n;
        }
        if (es == 0 && tid == 0) p.out[O_PM + (l * 8 + b) * 4 + h] = m;
        __syncthreads();
    }
}
__device__ __forceinline__ void ph_mlstm_sample(const Params& p, int l, float* lds) {
    const bf16_t* P = (const bf16_t*)(p.ws + B_P16); const float* GT = (const float*)(p.ws + B_GT); const float* bif = p.in[I_BIF] + l * 8; float* HR = (float*)(p.ws + B_HRAW);
    const int tid = ltid();
    float* qs = lds + 512; float* ks = lds + 512 + 192; float* n0s = lds + 512 + 384;
    for (int item = blockIdx.x; item < 128 * 4; item += gridDim.x) {
        const int h = item & 3, b = item >> 2; const int row = MP + b;
        const bf16_t* pr = P + (size_t)row * LDA_; const float* gr = GT + (size_t)row * GTW;
        const size_t sidx = (size_t)(l * 128 + b) * 4 + h;
        __syncthreads();
        if (tid < 192) { qs[tid] = bf2f(pr[h * 192 + tid]); ks[tid] = bf2f(pr[768 + h * 192 + tid]); n0s[tid] = p.in[I_SN][sidx * 192 + tid]; }
        __syncthreads();
        const float ig = gr[h] + bif[h], fg = gr[4 + h] + bif[4 + h];
        const float m0 = p.in[I_SM][sidx];
        const float logf = logsigmoidf_(fg);
        const float m_new = fmaxf(logf + m0, ig);
        const float a = expf(logf + m0 - m_new), bb = expf(ig - m_new);
        if (tid < 192) {
            const int e = tid; const float ve = bf2f(pr[1536 + h * 192 + e]);
            const float* C0 = p.in[I_SC] + sidx * 192 * 192; float* C1 = p.out + O_SC + sidx * 192 * 192;
            float num = 0.f, den = 0.f;
            for (int d = 0; d < 192; ++d) {
                const float c = a * C0[d * 192 + e] + bb * ks[d] * ve; C1[d * 192 + e] = c; num += qs[d] * c;
                const float nd = a * n0s[d] + bb * ks[d]; den += qs[d] * nd;
            }
            HR[(size_t)row * 768 + h * 192 + e] = num / fmaxf(fabsf(den), expf(-m_new));
            p.out[O_SN + sidx * 192 + e] = a * n0s[e] + bb * ks[e];
        }
        if (tid == 0) p.out[O_SM + sidx] = m_new;
    }
}
__device__ __forceinline__ void ph_mlstm_fin(const Params& p, int l) {
    const bf16_t* P = (const bf16_t*)(p.ws + B_P16); const float* HR = (const float*)(p.ws + B_HRAW); bf16_t* CATB = (bf16_t*)(p.ws + B_CATB); const float* g = p.in[I_GHN] + l * 192;
    const int tid_ = ltid(); const int lane = tid_ & 63, wid = tid_ >> 6;
    for (int it = blockIdx.x * NW_ + wid; it < MA * 4; it += gridDim.x * NW_) {
        const int row = it >> 2, h = it & 3;
        const float* hr = HR + (size_t)row * 768 + h * 192; float v[3]; float ss = 0.f;
#pragma unroll
        for (int i = 0; i < 3; ++i) { v[i] = hr[lane + 64 * i]; ss += v[i] * v[i]; }
        ss = wave_sum(ss); const float rs = rsqrtf(ss * (1.0f / 192) + EPS);
#pragma unroll
        for (int i = 0; i < 3; ++i) { const int d = lane + 64 * i; const float o = bf2f(P[(size_t)row * LDA_ + 2304 + h * 192 + d]);
            CATB[(size_t)row * DM + h * 192 + d] = (bf16_t)f2bf(sigmoidf_(o) * (v[i] * rs * g[d])); }
    }
}
__device__ __forceinline__ void ph_mem_attn(const Params& p, int l) {
    const int ldp = l < 2 ? LDA_ : LDB_, qoff = l < 2 ? 3072 : 768;
    const bf16_t* P = (const bf16_t*)(p.ws + B_P16); bf16_t* CATB = (bf16_t*)(p.ws + B_CATB); const float* gq = p.in[I_GMEMQ] + l * 64;
    for (int idx4 = blockIdx.x * NT_ + ltid(); idx4 < 16 * MA; idx4 += gridDim.x * NT_) {
        const int part = idx4 & 3, idx = idx4 >> 2;
        const int hh = idx / MA, row = idx % MA;
        const float* kvb = row < MP ? p.out + O_PMEM + (size_t)(l * 8 + row / SP) * 256 * 512 : p.in[I_CMEM] + (size_t)(l * 128 + (row - MP)) * 256 * 512;
        float q[16]; float ss = 0.f;
        const uint4* qp = (const uint4*)(P + (size_t)row * ldp + qoff + hh * 64 + part * 16);
#pragma unroll
        for (int i = 0; i < 2; ++i) { const uint4 t = qp[i]; q[8 * i] = bflo(t.x); q[8 * i + 1] = bfhi(t.x); q[8 * i + 2] = bflo(t.y); q[8 * i + 3] = bfhi(t.y); q[8 * i + 4] = bflo(t.z); q[8 * i + 5] = bfhi(t.z); q[8 * i + 6] = bflo(t.w); q[8 * i + 7] = bfhi(t.w); }
#pragma unroll
        for (int i = 0; i < 16; ++i) ss += q[i] * q[i];
        ss += __shfl_xor(ss, 1); ss += __shfl_xor(ss, 2);
        const float rs = rsqrtf(ss * (1.0f / 64) + EPS) * 0.125f;
#pragma unroll
        for (int i = 0; i < 16; ++i) q[i] *= rs * gq[part * 16 + i];
        float mx = -3e38f, den = 0.f; float o[16];
#pragma unroll
        for (int i = 0; i < 16; ++i) o[i] = 0.f;
        for (int m = 0; m < 256; ++m) {
            const float4* kp = (const float4*)(kvb + (size_t)m * 512 + hh * 64 + part * 16); const float4* vp = (const float4*)(kvb + (size_t)m * 512 + 256 + hh * 64 + part * 16);
            float s = 0.f;
#pragma unroll
            for (int i = 0; i < 4; ++i) { const float4 t = kp[i]; s += q[4 * i] * t.x + q[4 * i + 1] * t.y + q[4 * i + 2] * t.z + q[4 * i + 3] * t.w; }
            s += __shfl_xor(s, 1); s += __shfl_xor(s, 2);
            const float mn = fmaxf(mx, s); const float sc = expf(mx - mn), e = expf(s - mn); mx = mn; den = den * sc + e;
#pragma unroll
            for (int i = 0; i < 4; ++i) { const float4 t = vp[i]; o[4 * i] = o[4 * i] * sc + e * t.x; o[4 * i + 1] = o[4 * i + 1] * sc + e * t.y; o[4 * i + 2] = o[4 * i + 2] * sc + e * t.z; o[4 * i + 3] = o[4 * i + 3] * sc + e * t.w; }
        }
        const float inv = 1.0f / den; uint4* op = (uint4*)(CATB + (size_t)row * DM + 768 + hh * 64 + part * 16);
#pragma unroll
        for (int i = 0; i < 2; ++i) op[i] = make_uint4(pk2(o[8 * i] * inv, o[8 * i + 1] * inv), pk2(o[8 * i + 2] * inv, o[8 * i + 3] * inv), pk2(o[8 * i + 4] * inv, o[8 * i + 5] * inv), pk2(o[8 * i + 6] * inv, o[8 * i + 7] * inv));
    }
}
__device__ __forceinline__ void ph_rows_post(const Params& p) {
    float* KVR = (float*)(p.ws + B_KVR); const int tid_ = ltid(); const int lane = tid_ & 63, wid = tid_ >> 6;
    for (int row = blockIdx.x * NW_ + wid; row < MA; row += gridDim.x * NW_) {
        float* r = KVR + (size_t)row * 768;
        float4 c = ((const float4*)r)[lane], s = ((const float4*)(r + 256))[lane], w = ((const float4*)(r + 512))[lane];
        {
            float ss = dot4(s, s), sw = dot4(w, w);
            ss += __shfl_xor(ss, 1); ss += __shfl_xor(ss, 2); ss += __shfl_xor(ss, 4); ss += __shfl_xor(ss, 8);
            sw += __shfl_xor(sw, 1); sw += __shfl_xor(sw, 2); sw += __shfl_xor(sw, 4); sw += __shfl_xor(sw, 8);
            if (lane < 32) {
                const float rs = rsqrtf(ss * (1.0f / 64) + EPS), rw = rsqrtf(sw * (1.0f / 64) + EPS);
                const float4 gs = ((const float4*)p.in[I_GKSLC])[lane & 15], gw = ((const float4*)p.in[I_GKWIN])[lane & 15];
                s.x *= rs * gs.x; s.y *= rs * gs.y; s.z *= rs * gs.z; s.w *= rs * gs.w;
                w.x *= rw * gw.x; w.y *= rw * gw.y; w.z *= rw * gw.z; w.w *= rw * gw.w;
                ((float4*)(r + 256))[lane] = s; ((float4*)(r + 512))[lane] = w;
            }
        }
        if (row < MP) {
            ((float4*)(p.out + O_PCMP + (size_t)row * 256))[lane] = c; ((float4*)(p.out + O_PSLC + (size_t)row * 256))[lane] = s;
            const int b = row / SP, sp = row % SP;
            if (sp >= SP - 512) ((float4*)(p.out + O_PWIN + (size_t)(b * 512 + sp - (SP - 512)) * 256))[lane] = w;
        } else {
            const int b = row - MP;
            ((float4*)(p.out + O_SCMP + (size_t)b * 256))[lane] = c; ((float4*)(p.out + O_SSLC + (size_t)b * 256))[lane] = s;
            ((float4*)(p.out + O_SWIN + (size_t)(b * 512 + 511) * 256))[lane] = w;
        }
    }
}
__device__ __forceinline__ float gelu_tanh(float x) { return 0.5f * x * (1.0f + tanhf(0.7978845608028654f * (x + 0.044715f * x * x * x))); }
__device__ __forceinline__ void ph_compress(const Params& p, float* lds) {
    const float* KVR = (const float*)(p.ws + B_KVR); const int tid = ltid();
    float* xs = lds;
    float* hs = lds + 4096;
    const float* w1 = p.in[I_CW1]; const float* w2 = p.in[I_CW2]; const int* pt = (const int*)p.in[I_PT];
    for (int item = blockIdx.x; item < 136 * 127 * 2; item += gridDim.x) {
        const int c = item & 1, n = (item >> 1) % 127, bb = (item >> 1) / 127;
        __syncthreads();
        for (int i = tid; i < 4096; i += NT_) {
            const int g = i >> 11, pp = (i >> 6) & 31, d = i & 63; const int tok = 16 * n + pp; float x;
            if (bb < 8) x = KVR[(size_t)(bb * SP + tok) * 768 + c * 128 + g * 64 + d];
            else { const int b = bb - 8; const int phys = pt[b * 16 + (tok >> 7)]; x = p.in[I_CCMP][((size_t)phys * 128 + (tok & 127)) * 256 + c * 128 + g * 64 + d]; }
            xs[i] = x + p.in[I_CPOS][(pp * 2 + c) * 64 + d];
        }
        __syncthreads();
        if (tid < 256) { const int g = tid >> 7, h = tid & 127; float pre = p.in[I_CB1][c * 128 + h]; const float* wp = w1 + (size_t)c * 2048 * 128 + h; const float* xp = xs + g * 2048;
          for (int i = 0; i < 2048; ++i) pre = fmaf(xp[i], wp[(size_t)i * 128], pre);
          hs[g * 128 + h] = gelu_tanh(pre); }
        __syncthreads();
        if (tid < 128) {
            const int g = tid >> 6, d = tid & 63; float o = p.in[I_CB2][c * 64 + d];
            for (int h = 0; h < 128; ++h) o = fmaf(hs[g * 128 + h], w2[(size_t)(c * 128 + h) * 64 + d], o);
            if (c == 0) { const float ss = wave_sum(o * o); o = o * rsqrtf(ss * (1.0f / 64) + EPS) * p.in[I_GKCMP][d]; }
            ((float*)(p.ws + (c == 0 ? B_CK : B_CV)))[((size_t)bb * 127 + n) * 128 + g * 64 + d] = o;
        }
    }
}
__device__ __forceinline__ void row_softmax(float* r, int n, int lane) {
    float mx = NEGM;
    for (int i = lane; i < n; i += 64) mx = fmaxf(mx, r[i]);
    mx = wave_max(mx);
    if (mx <= 0.5f * NEGM) { for (int i = lane; i < n; i += 64) r[i] = 0.f; return; }
    float s = 0.f;
    for (int i = lane; i < n; i += 64) { const float e = r[i] <= 0.5f * NEGM ? 0.f : expf(r[i] - mx); r[i] = e; s += e; }
    s = wave_sum(s); const float inv = 1.0f / s;
    for (int i = lane; i < n; i += 64) r[i] *= inv;
}
__device__ __forceinline__ void ph_nsa(const Params& p, int j, float* lds) {
    const int tid = ltid(), lane = tid & 63, wid = tid >> 6;
    float* qs = lds;
    float* sc = lds + 384;
    float* imp = sc + 3072;
    int* sel = (int*)(imp + 40);
    float* gate = (float*)(sel + 8);
    float* oacc = gate + 24;
    const bf16_t* P = (const bf16_t*)(p.ws + B_P16); const float* GT = (const float*)(p.ws + B_GT); const float* KVR = (const float*)(p.ws + B_KVR); bf16_t* CATB = (bf16_t*)(p.ws + B_CATB);
    const float* table = p.in[I_REL]; const int* pt = (const int*)p.in[I_PT];
    for (int item = blockIdx.x; item < MA * 2; item += gridDim.x) {
        const int row = item >> 1, g = item & 1; const bool smp = row >= MP;
        const int b = smp ? row - MP : row / SP, pos = smp ? PAST : row % SP;
        const bf16_t* pr = P + (size_t)row * LDB_;
        __syncthreads();
        if (wid < 6) { const int z = wid; const float v = bf2f(pr[(g * 6 + z) * 64 + lane]); const float ss = wave_sum(v * v); qs[z * 64 + lane] = v * rsqrtf(ss * (1.0f / 64) + EPS) * p.in[I_GQ][j * 64 + lane]; }
        if (tid >= 384 && tid < 384 + 18) { const int t2 = tid - 384; const int br = t2 / 6, z = t2 % 6; gate[t2] = sigmoidf_(GT[(size_t)row * GTW + br * 12 + g * 6 + z] + p.in[I_BGATE][j * 36 + br * 12 + g * 6 + z]); }
        if (tid < 384) oacc[tid] = 0.f;
        __syncthreads();
        const float* ck = (const float*)(p.ws + B_CK) + (size_t)(smp ? 8 + b : b) * 127 * 128; const float* cv = (const float*)(p.ws + B_CV) + (size_t)(smp ? 8 + b : b) * 127 * 128;
        for (int i = tid; i < 6 * 127; i += NT_) {
            const int z = i / 127, n = i % 127; const int dist = pos - (16 * n + 31); float s = NEGM;
            if (dist >= 0) { const float4* kp = (const float4*)(ck + n * 128 + g * 64); const float4* qp = (const float4*)(qs + z * 64); float a = 0.f;
#pragma unroll 4
                for (int d = 0; d < 16; ++d) a += dot4(kp[d], qp[d]);
                s = a * 0.125f + table[rel_bucket(dist) * 12 + g * 6 + z]; }
            sc[z * 128 + n] = s;
        }
        __syncthreads();
        if (wid < 6) row_softmax(sc + wid * 128, 127, lane);
        __syncthreads();
        const int nslc = smp ? 33 : 32, cur = pos >> 6;
        if (tid < nslc) { const int jb = tid; float s = 0.f;
            for (int z = 0; z < 6; ++z) for (int n = 0; n < 127; ++n) { const int lo = max(16 * n, 64 * jb), hi = min(16 * n + 32, 64 * jb + 64); if (hi > lo) s += sc[z * 128 + n] * (float)(hi - lo) * (1.0f / 16); }
            imp[jb] = s; }
        __syncthreads();
        if (tid == 0) {
            int cnt = 0;
            if (cur + 1 <= 8) { for (int jb = 0; jb <= cur; ++jb) sel[cnt++] = jb; }
            else {
                sel[0] = 0; sel[1] = cur; sel[2] = cur - 1; cnt = 3; unsigned long long taken = 0ull;
                for (int k = 0; k < 5; ++k) { int best = -1; float bv = -1.f;
                    for (int jb = 1; jb <= cur - 2; ++jb) if (!((taken >> jb) & 1ull) && imp[jb] > bv) { bv = imp[jb]; best = jb; }
                    if (best >= 0) { taken |= 1ull << best; sel[cnt++] = best; } }
            }
            for (; cnt < 8; ++cnt) sel[cnt] = -1;
        }
        if (tid < 384) { const int z = tid >> 6, d = tid & 63; float o = 0.f;
            for (int n = 0; n < 127; ++n) o = fmaf(sc[z * 128 + n], cv[n * 128 + g * 64 + d], o);
            oacc[tid] += gate[0 * 6 + z] * o; }
        __syncthreads();
        for (int br = 1; br <= 2; ++br) {
            { const int t = tid;
                const float* kp = nullptr; int dist = -1;
                if (br == 1) {
                    const int blk = sel[t >> 6];
                    if (blk >= 0) { const int tok = blk * 64 + (t & 63); dist = pos - tok;
                        if (dist >= 0) { if (!smp) kp = KVR + (size_t)(b * SP + tok) * 768 + 256 + g * 64;
                            else if (tok < PAST) kp = p.in[I_CSLC] + ((size_t)pt[b * 16 + (tok >> 7)] * 128 + (tok & 127)) * 256 + g * 64;
                            else kp = KVR + (size_t)row * 768 + 256 + g * 64; } }
                } else {
                    const int kpos = pos - 511 + t; dist = 511 - t;
                    if (!smp) { if (kpos >= 0) kp = KVR + (size_t)(b * SP + kpos) * 768 + 512 + g * 64; else dist = -1; }
                    else { if (kpos < PAST) kp = p.in[I_CWIN] + ((size_t)b * 512 + (kpos - (PAST - 512))) * 256 + g * 64; else kp = KVR + (size_t)row * 768 + 512 + g * 64; }
                }
                if (dist >= 0 && kp) {
                    float s[6] = {0.f, 0.f, 0.f, 0.f, 0.f, 0.f};
#pragma unroll 2
                    for (int d = 0; d < 16; ++d) { const float4 kk = ((const float4*)kp)[d];
#pragma unroll
                        for (int z = 0; z < 6; ++z) s[z] += dot4(kk, ((const float4*)(qs + z * 64))[d]); }
                    const int bk = rel_bucket(dist);
#pragma unroll
                    for (int z = 0; z < 6; ++z) sc[z * 512 + t] = s[z] * 0.125f + table[bk * 12 + g * 6 + z];
                } else {
#pragma unroll
                    for (int z = 0; z < 6; ++z) sc[z * 512 + t] = NEGM;
                }
            }
            __syncthreads();
            if (wid < 6) row_softmax(sc + wid * 512, 512, lane);
            __syncthreads();
            if (tid < 384) { const int z = tid >> 6, d = tid & 63; float o = 0.f;
                for (int t = 0; t < 512; ++t) { const float pw = sc[z * 512 + t]; if (pw != 0.f) { const float* vp;
                    if (br == 1) { const int tok = sel[t >> 6] * 64 + (t & 63);
                        if (!smp) vp = KVR + (size_t)(b * SP + tok) * 768 + 256 + 128 + g * 64;
                        else if (tok < PAST) vp = p.in[I_CSLC] + ((size_t)pt[b * 16 + (tok >> 7)] * 128 + (tok & 127)) * 256 + 128 + g * 64;
                        else vp = KVR + (size_t)row * 768 + 256 + 128 + g * 64;
                    } else { const int kpos = pos - 511 + t;
                        if (!smp) vp = KVR + (size_t)(b * SP + kpos) * 768 + 512 + 128 + g * 64;
                        else if (kpos < PAST) vp = p.in[I_CWIN] + ((size_t)b * 512 + (kpos - (PAST - 512))) * 256 + 128 + g * 64;
                        else vp = KVR + (size_t)row * 768 + 512 + 128 + g * 64; }
                    o = fmaf(pw, vp[d], o); } }
                oacc[tid] += gate[br * 6 + z] * o; }
            __syncthreads();
        }
        if (tid < 384) CATB[(size_t)row * DM + g * 384 + tid] = (bf16_t)f2bf(oacc[tid]);
    }
}
constexpr int RING_BYTES = 131072, MISC_OFF = RING_BYTES + 320, LDS_BYTES = 147456;
typedef float f32x4_ __attribute__((ext_vector_type(4)));

#define STRIP_JOBS(njobs) for (int job = (int)gridDim.x - 1 - (int)blockIdx.x; job < (njobs); job += (int)gridDim.x)
__device__ __forceinline__ void strips_inproj(const Params& p, int l) {
    unsigned char* ws = p.ws; const bf16_t* XB = (const bf16_t*)(ws + B_XB); bf16_t* P16 = (bf16_t*)(ws + B_P16); float* GT = (float*)(ws + B_GT);
    const float* ssq = (const float*)(ws + B_SSQ) + (size_t)(2 * l) * MA;
    const bool ka = l < 2; const int ldp = ka ? LDA_ : LDB_, nmain = ka ? 52 : 16;
    const bf16_t* Bt = ka ? (const bf16_t*)(ws + B_BTA) + (size_t)l * NBTA * DM : (const bf16_t*)(ws + B_BTB) + (size_t)(l - 2) * NBTB * DM;
    const int tid_ = ltid(); const int lane = tid_ & 63, wave = tid_ >> 6, fr = lane & 15, fq = lane >> 4;
    STRIP_JOBS(nmain + 129) {
        if (job < nmain) {
            const int brow[4] = {job * 64, job * 64 + 16, job * 64 + 32, job * 64 + 48}; StripAcc<4> R; strip_gemm<4>(XB, DM, MP, Bt, brow, R);
            const int row = MP + wave * 16 + fr; const float rs = rstd_of(ssq[row]);
#pragma unroll
            for (int t = 0; t < 4; ++t) { const f32x4_ v = R.a[t] * rs; *(uint2*)(P16 + (size_t)row * ldp + job * 64 + t * 16 + 4 * fq) = make_uint2(pk2(v[0], v[1]), pk2(v[2], v[3])); }
        } else {
            const int rb = job - nmain, row = rb * 128 + wave * 16 + fr; const float rs = rstd_of(ssq[row]);
            if (ka) { const int brow[1] = {3328}; StripAcc<1> R; strip_gemm<1>(XB, DM, rb * 128, Bt, brow, R); *(f32x4_*)(GT + (size_t)row * GTW + 4 * fq) = R.a[0] * rs; }
            else { const int brow[3] = {1024, 1040, 1056}; StripAcc<3> R; strip_gemm<3>(XB, DM, rb * 128, Bt, brow, R);
#pragma unroll
                for (int t = 0; t < 3; ++t) *(f32x4_*)(GT + (size_t)row * GTW + t * 16 + 4 * fq) = R.a[t] * rs; }
        }
    }
}
__device__ __forceinline__ void strips_resid(const Params& p, const bf16_t* A, int K, const bf16_t* Bt, float* ssq) {
    float* XF = p.out; bf16_t* XB = (bf16_t*)(p.ws + B_XB);
    const int tid_ = ltid(); const int lane = tid_ & 63, wave = tid_ >> 6, fr = lane & 15, fq = lane >> 4;
    STRIP_JOBS(64) {
        const int brow[1] = {job * 16}; StripAcc<1> R; strip_gemm<1>(A, K, MP, Bt, brow, R);
        const int row = MP + wave * 16 + fr; float* xp = XF + (size_t)row * DM + job * 16 + 4 * fq;
        f32x4_ x = *(const f32x4_*)xp; x = x + R.a[0]; *(f32x4_*)xp = x;
        *(uint2*)(XB + (size_t)row * DM + job * 16 + 4 * fq) = make_uint2(pk2(x[0], x[1]), pk2(x[2], x[3]));
        float ss = (x[0] * x[0] + x[1] * x[1]) + (x[2] * x[2] + x[3] * x[3]); ss += __shfl_xor(ss, 16); ss += __shfl_xor(ss, 32);
        if (fq == 0) (void)__hip_atomic_fetch_add(ssq + row, ss, __ATOMIC_RELAXED, __HIP_MEMORY_SCOPE_AGENT);
    }
}
__device__ __forceinline__ void strips_gu(const Params& p, int l) {
    unsigned char* ws = p.ws; const bf16_t* XB = (const bf16_t*)(ws + B_XB); bf16_t* HID = (bf16_t*)(ws + B_HID);
    const float* ssq = (const float*)(ws + B_SSQ) + (size_t)(2 * l + 1) * MA; const bf16_t* Bt = (const bf16_t*)(ws + B_BTG) + (size_t)l * 2 * DFF * DM;
    const int tid_ = ltid(); const int lane = tid_ & 63, wave = tid_ >> 6, fr = lane & 15, fq = lane >> 4;
    STRIP_JOBS(176) {
        const int brow[2] = {(job >> 3) * 256 + (job & 7) * 16, (job >> 3) * 256 + 128 + (job & 7) * 16}; StripAcc<2> R; strip_gemm<2>(XB, DM, MP, Bt, brow, R);
        const int row = MP + wave * 16 + fr; const float rs = rstd_of(ssq[row]); float h[4];
#pragma unroll
        for (int j = 0; j < 4; ++j) { const float g = R.a[0][j] * rs, up = R.a[1][j] * rs; h[j] = g * pg8::fast_sigmoid(g) * up; }
        *(uint2*)(HID + (size_t)row * DFF + job * 16 + 4 * fq) = make_uint2(pk2(h[0], h[1]), pk2(h[2], h[3]));
    }
}
__device__ __forceinline__ void strips_kv(const Params& p) {
    unsigned char* ws = p.ws; const bf16_t* XB = (const bf16_t*)(ws + B_XB); float* KVR = (float*)(ws + B_KVR);
    const float* ssq = (const float*)(ws + B_SSQ) + (size_t)4 * MA; const bf16_t* Bt = (const bf16_t*)(ws + B_BTK);
    const int tid_ = ltid(); const int lane = tid_ & 63, wave = tid_ >> 6, fr = lane & 15, fq = lane >> 4;
    STRIP_JOBS(48) {
        const int brow[1] = {job * 16}; StripAcc<1> R; strip_gemm<1>(XB, DM, MP, Bt, brow, R);
        const int row = MP + wave * 16 + fr; const float rs = rstd_of(ssq[row]);
        *(f32x4_*)(KVR + (size_t)row * 768 + job * 16 + 4 * fq) = R.a[0] * rs;
    }
}

#ifndef MK_MULTI
#define MK_MULTI 0
#endif
constexpr int PL = 9, NPH = 1 + 4 * PL;
__host__ __device__ constexpr bool phase_nonempty(int ph) {
    if (ph == 0) return true;
    const int l = (ph - 1) / PL, r = (ph - 1) % PL;
    if (r == 2) return l < 2;
    if (r >= 6) return l == 1;
    return true;
}
__global__ void __launch_bounds__(NT_, 2) fwd(Params p) {
    extern __shared__ __attribute__((aligned(16))) unsigned char lds_raw[];
    LAS unsigned char* lds = (LAS unsigned char*)lds_raw;
    float* ldsf = (float*)lds_raw;
    volatile LAS unsigned* MISC = (volatile LAS unsigned*)(lds + MISC_OFF);
    for (int u = threadIdx.x; u < (LDS_BYTES - RING_BYTES) / 4; u += NT_) ((LAS unsigned*)(lds + RING_BYTES))[u] = 0u;
    __syncthreads();
    unsigned char* ws = p.ws;
    XcdBarrier bar; bar.bar = (unsigned*)ws; bar.x = 0; bar.st = MISC + 8;
    const bool single = (p.ph_hi - p.ph_lo) > 1;
    if (single) bar = xcd_barrier_post((unsigned*)ws, MISC + 8);
    float* XF = p.out; bf16_t* XB = (bf16_t*)(ws + B_XB); bf16_t* P16 = (bf16_t*)(ws + B_P16); bf16_t* CATB = (bf16_t*)(ws + B_CATB); bf16_t* HID = (bf16_t*)(ws + B_HID);
    float* SSQ = (float*)(ws + B_SSQ);
    const int G = gridDim.x, c = blockIdx.x;
    int ph = 0;
#define ON() (ph >= p.ph_lo && ph < p.ph_hi)
#define NEXT() do { const bool ne_ = phase_nonempty(ph); ++ph; if (ne_ && ph > p.ph_lo && ph < p.ph_hi) xcd_barrier(bar); } while (0)
#ifndef NO_PRO
    if (ON()) ph_prologue(p, lds);
#endif
    NEXT();
    for (int l = 0; l < 4; ++l) {
        if (ON()) {
            if (l == 0) { pg8::Gemm g{(const bf16_t*)(ws + B_MPB), (const bf16_t*)(ws + B_BTM), 2048, 2048, DM}; pg8::StaticOrder S; S.init(2048, 2048, G, c);
                pg8::EpiF32 E{p.out + O_PMEM, 512, nullptr, 512, (size_t)2048 * 512};
                pg8::gemm_phase<pg8::EpiF32, pg8::StaticOrder, true, true>(lds, g, S, E); }
            if (l < 2) { pg8::Gemm g{XB, (const bf16_t*)(ws + B_BTA) + (size_t)l * NBTA * DM, MP, LDA_, DM}; pg8::StaticOrder S; S.init(MP, LDA_, G, l == 0 ? (c + 192) % G : c);
                pg8::EpiBf16S E{P16, LDA_, SSQ + (size_t)(2 * l) * MA};
                pg8::gemm_phase<pg8::EpiBf16S, pg8::StaticOrder, true, true>(lds, g, S, E); }
            else { pg8::Gemm g{XB, (const bf16_t*)(ws + B_BTB) + (size_t)(l - 2) * NBTB * DM, MP, LDB_, DM}; pg8::StaticOrder S; S.init(MP, LDB_, G, c);
                pg8::EpiBf16S E{P16, LDB_, SSQ + (size_t)(2 * l) * MA};
                pg8::gemm_phase<pg8::EpiBf16S, pg8::StaticOrder, true, true>(lds, g, S, E); }
#ifndef NO_STRIPS
            strips_inproj(p, l);
#endif
        }
        NEXT();
#ifndef NO_NAIVE
        if (ON()) {
            if (l < 2) { if (l == 0) ph_memk_norm(p); ph_mlstm_prompt(p, l, ldsf); ph_mlstm_sample(p, l, ldsf); }
            else { ph_nsa(p, l - 2, ldsf); ph_mem_attn(p, l); }
        }
#endif
        NEXT();
#ifndef NO_NAIVE
        if (ON()) { if (l < 2) { ph_mlstm_fin(p, l); ph_mem_attn(p, l); } }
#endif
        NEXT();
        if (ON()) {
            const bf16_t* Bt = (const bf16_t*)(ws + B_BTO) + (size_t)l * DM * DM; float* sq = SSQ + (size_t)(2 * l + 1) * MA;
            pg8::Gemm g{CATB, Bt, MP, DM, DM}; pg8::StaticOrder S; S.init(MP, DM, G, c); pg8::EpiResid E{XF, XB, sq};
            pg8::gemm_phase<pg8::EpiResid, pg8::StaticOrder, true, true>(lds, g, S, E);
#ifndef NO_STRIPS
            strips_resid(p, CATB, DM, Bt, sq);
#endif
        }
        NEXT();
        if (ON()) {
            pg8::Gemm g{XB, (const bf16_t*)(ws + B_BTG) + (size_t)l * 2 * DFF * DM, MP, 2 * DFF, DM}; pg8::StaticOrder S; S.init(MP, 2 * DFF, G, c); pg8::EpiSwiglu E{HID, SSQ + (size_t)(2 * l + 1) * MA};
            pg8::gemm_phase<pg8::EpiSwiglu, pg8::StaticOrder, true, true>(lds, g, S, E);
#ifndef NO_STRIPS
            strips_gu(p, l);
#endif
        }
        NEXT();
        if (ON()) {
            const bf16_t* Bt = (const bf16_t*)(ws + B_BTD) + (size_t)l * DM * DFF; float* sq = SSQ + (size_t)(2 * l + 2) * MA;
            pg8::Gemm g{HID, Bt, MP, DM, DFF}; pg8::StaticOrder S; S.init(MP, DM, G, c); pg8::EpiResid E{XF, XB, sq};
            pg8::gemm_phase<pg8::EpiResid, pg8::StaticOrder, true, true>(lds, g, S, E);
#ifndef NO_STRIPS
            strips_resid(p, HID, DFF, Bt, sq);
#endif
        }
        NEXT();
        if (ON()) { if (l == 1) {
            pg8::Gemm g{XB, (const bf16_t*)(ws + B_BTK), MP, 768, DM}; pg8::StaticOrder S; S.init(MP, 768, G, c); pg8::EpiF32 E{(float*)(ws + B_KVR), 768, SSQ + (size_t)4 * MA, 0, 0};
            pg8::gemm_phase<pg8::EpiF32, pg8::StaticOrder, true, true>(lds, g, S, E);

#ifndef NO_STRIPS
            strips_kv(p);
#endif
            } }
        NEXT();
#ifndef NO_NAIVE
        if (ON()) { if (l == 1) ph_rows_post(p); }
#endif
        NEXT();
#ifndef NO_NAIVE
        if (ON()) { if (l == 1) ph_compress(p, ldsf); }
#endif
        NEXT();
    }
}

extern "C" void kernel_launch(void* const* d_in, const int* in_sizes, int n_in, void* d_out, int out_size, void* d_ws, size_t ws_size, hipStream_t stream) {
    static int grid = 0;
    if (!grid) {
        int dev = 0, cus = 0;
        (void)hipGetDevice(&dev); (void)hipDeviceGetAttribute(&cus, hipDeviceAttributeMultiprocessorCount, dev);
        if (cus < 1) cus = 256;
        if (hipFuncSetAttribute((const void*)fwd, hipFuncAttributeMaxDynamicSharedMemorySize, LDS_BYTES) != hipSuccess) fprintf(stderr, "kernel_launch: hipFuncSetAttribute failed\n");
        int per_cu = 0; (void)hipOccupancyMaxActiveBlocksPerMultiprocessor(&per_cu, (const void*)fwd, NT_, LDS_BYTES); (void)hipGetLastError();
        if (per_cu < 1) fprintf(stderr, "kernel_launch: occupancy query says %d\n", per_cu);
        grid = cus;
    }
    if (n_in != N_IN || (size_t)out_size != O_END || ws_size < B_END) fprintf(stderr, "kernel_launch: unexpected sizes n_in=%d out=%d ws=%zu need %zu\n", n_in, out_size, ws_size, (size_t)B_END);
    (void)hipMemsetAsync(d_ws, 0, CTL_BYTES, stream);
    Params p{};
    for (int i = 0; i < N_IN; ++i) p.in[i] = (const float*)d_in[i];
    p.out = (float*)d_out; p.ws = (unsigned char*)d_ws;
#if MK_MULTI
    for (int ph = 0; ph < NPH; ++ph) {
        if (!phase_nonempty(ph)) continue;
        p.ph_lo = ph; p.ph_hi = ph + 1;
        hipLaunchKernelGGL(fwd, dim3(grid), dim3(NT_), LDS_BYTES, stream, p);
    }
#else
    p.ph_lo = 0; p.ph_hi = NPH;
    hipLaunchKernelGGL(fwd, dim3(grid), dim3(NT_), LDS_BYTES, stream, p);
#endif
}
```

```cpp
#include <hip/hip_runtime.h>
#include <cstdio>
#include <cstdint>

#define LAS __attribute__((address_space(3)))
#define GAS __attribute__((address_space(1)))
#define XB_TMO      128
#define XB_XCNT(j)  (256  + 64 * (j))
#define XB_XSUB(j)  (1280 + 64 * (j))
#define XB_XGEN(j)  (2304 + 64 * (j))
#define XB_TOP      3328
#define XB_TOPGEN   3392
#define XCD_BAR_WORDS 3456
#define XB_SPIN_CAP (1u << 23)
__device__ __forceinline__ unsigned xb_ld(unsigned* p)              { return __hip_atomic_load(p, __ATOMIC_RELAXED, __HIP_MEMORY_SCOPE_AGENT); }
__device__ __forceinline__ unsigned xb_add(unsigned* p, unsigned v) { return __hip_atomic_fetch_add(p, v, __ATOMIC_RELAXED, __HIP_MEMORY_SCOPE_AGENT); }
__device__ __forceinline__ unsigned xb_xcc_id() { return (unsigned)__builtin_amdgcn_s_getreg((3 << 11) | 20) & 0xFu; }
#define XB_SPIN(cond, bar) do { unsigned _sp = 0; while (cond) { __builtin_amdgcn_s_sleep(1); \
    if ((++_sp & 255u) == 0u) { if (xb_ld(&(bar)[XB_TMO])) break; if (_sp > XB_SPIN_CAP) { atomicAdd(&(bar)[XB_TMO], 1u); break; } } } } while (0)
struct XcdBarrier { unsigned* bar; unsigned x; volatile LAS unsigned* st; };
__device__ __forceinline__ XcdBarrier xcd_barrier_post(unsigned* bar, volatile LAS unsigned* st) {
    XcdBarrier b; b.bar = bar; b.x = xb_xcc_id(); b.st = st;
    if (threadIdx.x == 0) (void)xb_add(&bar[XB_XCNT(b.x)], 1u);
    return b;
}
__device__ __forceinline__ void xcd_barrier_complete(unsigned* bar, unsigned x, unsigned& nloc, unsigned& nx) {
    const unsigned G = gridDim.x * gridDim.y * gridDim.z;
    unsigned sum, cnt, mine, sp = 0u;
    for (;;) {
        sum = 0u; cnt = 0u; mine = 0u;
#pragma unroll
        for (unsigned j = 0; j < 16; ++j) { const unsigned c = xb_ld(&bar[XB_XCNT(j)]); sum += c; cnt += (c > 0u) ? 1u : 0u; mine = (j == x) ? c : mine; }
        if (sum == G) break;
        __builtin_amdgcn_s_sleep(1);
        if ((++sp & 255u) == 0u) { if (xb_ld(&bar[XB_TMO])) break; if (sp > XB_SPIN_CAP) { atomicAdd(&bar[XB_TMO], 1u); break; } }
    }
    nloc = mine > 0u ? mine : 1u; nx = cnt > 0u ? cnt : 1u;
}
__device__ __forceinline__ void xcd_barrier(const XcdBarrier& b) {
    asm volatile("s_waitcnt vmcnt(0)" ::: "memory");
    __syncthreads();
    if (threadIdx.x == 0) {
        unsigned* bar = b.bar;
        __builtin_amdgcn_s_waitcnt(0);
        unsigned nloc = b.st[0], nx = b.st[1];
        if (nloc == 0u) { xcd_barrier_complete(bar, b.x, nloc, nx); b.st[0] = nloc; b.st[1] = nx; }
        const unsigned old = xb_add(&bar[XB_XSUB(b.x)], 1u);
        const unsigned gen = old / nloc;
        if (old + 1u == (gen + 1u) * nloc) {
            __builtin_amdgcn_fence(__ATOMIC_RELEASE, "agent");
            asm volatile("s_waitcnt vmcnt(0)" ::: "memory");
            const unsigned og = xb_add(&bar[XB_TOP], 1u);
            const unsigned tg = og / nx;
            if (og + 1u == (tg + 1u) * nx) xb_add(&bar[XB_TOPGEN], 1u);
            else XB_SPIN(xb_ld(&bar[XB_TOPGEN]) == tg, bar);
            __builtin_amdgcn_fence(__ATOMIC_ACQUIRE, "agent");
            xb_add(&bar[XB_XGEN(b.x)], 1u);
            asm volatile("s_waitcnt vmcnt(0)" ::: "memory");
        } else {
            XB_SPIN(xb_ld(&bar[XB_XGEN(b.x)]) == gen, bar);
            __builtin_amdgcn_fence(__ATOMIC_ACQUIRE, "agent");
            asm volatile("s_waitcnt vmcnt(0)" ::: "memory");
        }
    }
    __syncthreads();
}

constexpr int NT_ = 512, NW_ = 8;
constexpr int DM = 1024, BP = 8, SP = 2048, MP = BP * SP, BS = 128, MA = MP + BS, MAP = MP + 256;
constexpr int ACOLS = 3336, BCOLS = 1060, DFF = 2816;
constexpr int LDA_ = 3328, LDB_ = 1024;
constexpr int NBTA = 3344, NBTB = 1072;
constexpr int PAST = 2048, GTW = 48;
constexpr float EPS = 1e-6f, NEGM = -1e30f;
typedef unsigned short bf16_t;

enum { I_XP = 0, I_XS, I_SC, I_SN, I_SM, I_CMEM, I_CCMP, I_CSLC, I_CWIN, I_PT, I_MEMP, I_GMIX, I_WINA, I_BIF, I_GHN, I_WINB, I_GQ, I_BGATE, I_REL,
       I_GKV, I_WKV, I_GKSLC, I_GKWIN, I_GKCMP, I_CPOS, I_CW1, I_CB1, I_CW2, I_CB2, I_WMEMKV, I_GMEMK, I_GMEMQ, I_WOUT, I_GFFN, I_WGU, I_WDOWN, N_IN };
constexpr size_t O_YP = 0, O_YS = O_YP + (size_t)MP * DM, O_PC = O_YS + (size_t)BS * DM, O_PN = O_PC + 2ull * 8 * 4 * 192 * 192, O_PM = O_PN + 2ull * 8 * 4 * 192,
    O_PMEM = O_PM + 64, O_PCMP = O_PMEM + 4ull * 8 * 256 * 512, O_PSLC = O_PCMP + (size_t)MP * 256, O_PWIN = O_PSLC + (size_t)MP * 256, O_SC = O_PWIN + 8ull * 512 * 256,
    O_SN = O_SC + 2ull * 128 * 4 * 192 * 192, O_SM = O_SN + 2ull * 128 * 4 * 192, O_SCMP = O_SM + 1024, O_SSLC = O_SCMP + 128 * 256, O_SWIN = O_SSLC + 128 * 256,
    O_END = O_SWIN + 128ull * 512 * 256;
static_assert(O_END == 87700544ull, "output size");
constexpr size_t CTL_BYTES = 2u << 20, B_SSQ = 65536;
constexpr size_t al256(size_t x) { return (x + 255) & ~(size_t)255; }
constexpr size_t B_XB = CTL_BYTES, B_P16 = al256(B_XB + (size_t)MAP * DM * 2), B_GT = al256(B_P16 + (size_t)MAP * LDA_ * 2), B_CATB = al256(B_GT + (size_t)MAP * GTW * 4),
    B_HID = al256(B_CATB + (size_t)MA * DM * 2), B_HRAW = al256(B_HID + (size_t)MAP * DFF * 2), B_KVR = al256(B_HRAW + (size_t)MA * 768 * 4), B_CK = al256(B_KVR + (size_t)MAP * 768 * 4),
    B_CV = al256(B_CK + 136ull * 127 * 128 * 4), B_MPB = al256(B_CV + 136ull * 127 * 128 * 4),
    B_BTA = al256(B_MPB + 2048ull * DM * 2), B_BTB = al256(B_BTA + 2ull * NBTA * DM * 2), B_BTO = al256(B_BTB + 2ull * NBTB * DM * 2), B_BTG = al256(B_BTO + 4ull * DM * DM * 2),
    B_BTD = al256(B_BTG + 4ull * 2 * DFF * DM * 2), B_BTK = al256(B_BTD + 4ull * DM * DFF * 2), B_BTM = al256(B_BTK + 768ull * DM * 2), B_KVB = al256(B_BTM + 2048ull * DM * 2), B_SKF = al256(B_KVB + 6ull * BP * 2 * SP * 64 * 2), B_SVF = al256(B_SKF + (size_t)BP * 2 * SP * 64 * 2), B_KC16 = al256(B_SVF + (size_t)BP * 2 * SP * 64 * 2),
    B_W1T = al256(B_KC16 + 136ull * 2 * 2 * 128 * 64 * 2), B_W2T = al256(B_W1T + 2ull * 128 * 2048 * 2), B_PEB = al256(B_W2T + 2ull * 64 * 128 * 2), B_MEMR = al256(B_PEB + 1024), B_END = al256(B_MEMR + 4ull * 2048 * 512 * 4);
constexpr int SSQS = MAP;
static_assert(9 * SSQS * 4 + B_SSQ <= CTL_BYTES, "ssq sites inside the control region");

#ifndef TIME_SUB
#define TIME_SUB 0
#endif
__device__ unsigned long long g_tsub[4];
#define TSUB_BEGIN() unsigned long long tsub_t0_ = (TIME_SUB && blockIdx.x == gridDim.x - 1 && threadIdx.x == 0) ? __builtin_amdgcn_s_memrealtime() : 0ull
#define TSUB_END(k) do { if (TIME_SUB && blockIdx.x == gridDim.x - 1 && threadIdx.x == 0) { const unsigned long long n_ = __builtin_amdgcn_s_memrealtime(); g_tsub[k] += n_ - tsub_t0_; tsub_t0_ = n_; } } while (0)
struct Params { const float* in[N_IN]; float* out; unsigned char* ws; int ph_lo, ph_hi; };

__device__ const unsigned char REL_LUT[128] = {0, 1, 2, 3, 4, 5, 6, 7, 8, 9, 10, 11, 12, 13, 14, 15, 16, 16, 16, 17, 17, 18, 18, 18, 19, 19, 19, 20, 20, 20, 20, 21, 21, 21, 21, 22, 22, 22, 22, 22, 23, 23, 23, 23, 23, 23, 24, 24, 24, 24, 24, 24, 25, 25, 25, 25, 25, 25, 25, 26, 26, 26, 26, 26, 26, 26, 26, 27, 27, 27, 27, 27, 27, 27, 27, 27, 27, 28, 28, 28, 28, 28, 28, 28, 28, 28, 28, 29, 29, 29, 29, 29, 29, 29, 29, 29, 29, 29, 29, 30, 30, 30, 30, 30, 30, 30, 30, 30, 30, 30, 30, 30, 30, 31, 31, 31, 31, 31, 31, 31, 31, 31, 31, 31, 31, 31, 31, 31};
__device__ __forceinline__ int rel_bucket(int d) { return d >= 128 ? 31 : (int)REL_LUT[d < 0 ? 0 : d]; }
__device__ __forceinline__ int rel_bucket_alu(int d) { d = d < 0 ? 0 : d; if (d < 16) return d;
    return 16 + (d >= 19) + (d >= 21) + (d >= 24) + (d >= 27) + (d >= 31) + (d >= 35) + (d >= 40) + (d >= 46) + (d >= 52) + (d >= 59) + (d >= 67) + (d >= 77) + (d >= 87) + (d >= 99) + (d >= 113); }

__device__ __forceinline__ int opq(int i) { asm volatile("" : "+s"(i)); return i; }
__device__ __forceinline__ int ltid() { int t = threadIdx.x; asm volatile("" : "+v"(t)); return t; }
__device__ __forceinline__ float wave_sum(float v) {
#pragma unroll
    for (int o = 32; o; o >>= 1) v += __shfl_xor(v, o);
    return v;
}
__device__ __forceinline__ float wave_max(float v) {
#pragma unroll
    for (int o = 32; o; o >>= 1) v = fmaxf(v, __shfl_xor(v, o));
    return v;
}
__device__ __forceinline__ float sigmoidf_(float x) { return 1.0f / (1.0f + expf(-x)); }
__device__ __forceinline__ float logsigmoidf_(float x) { return fminf(x, 0.f) - log1pf(expf(-fabsf(x))); }
__device__ __forceinline__ float dot4(float4 a, float4 b) { return a.x * b.x + a.y * b.y + a.z * b.z + a.w * b.w; }
__device__ __forceinline__ float bf2f(bf16_t u) { return __uint_as_float((unsigned)u << 16); }
__device__ __forceinline__ unsigned f2bf(float f) { unsigned u = __float_as_uint(f); return (u + 0x7fffu + ((u >> 16) & 1u)) >> 16; }
__device__ __forceinline__ unsigned pk2(float lo, float hi) { return f2bf(lo) | (f2bf(hi) << 16); }
__device__ __forceinline__ float bflo(unsigned w) { return __uint_as_float(w << 16); }
__device__ __forceinline__ float bfhi(unsigned w) { return __uint_as_float(w & 0xffff0000u); }
__device__ __forceinline__ float rstd_of(float ssq) { return rsqrtf(ssq * (1.0f / DM) + EPS); }

namespace pg8 {
#define PG8_LAS __attribute__((address_space(3)))
typedef unsigned short bf16_t;
typedef short bf16x8 __attribute__((ext_vector_type(8)));
typedef float f32x4 __attribute__((ext_vector_type(4)));
typedef unsigned u32x4 __attribute__((ext_vector_type(4)));
constexpr int BM = 256, BK = 64, HALF = 128, HTB = HALF * BK * 2  , STAGE_BYTES = 8 * HTB, NXCD = 8, WGM = 8;

__host__ __device__ __forceinline__ int lds_byte(int r, int c) { const int st = (r >> 4) * 2 + (c >> 5), rr = r & 15, cc = c & 31, ob = rr * 64 + cc * 2; return st * 1024 + (ob ^ (((ob >> 9) & 1) << 5)); }
__host__ __device__ __forceinline__ void stage_rc(int b, int& R, int& C) { const int st = b / 1024, sb = b % 1024, swz = sb ^ (((sb >> 9) & 1) << 5); R = (st >> 1) * 16 + swz / 64; C = (st & 1) * 32 + (swz % 64) / 2; }
__host__ __device__ __forceinline__ int perm32(int rho) { const int n = rho >> 4, i = rho & 15; return 8 * (i >> 2) + 4 * n + (i & 3); }

struct Unit { int pm, pn; };
struct Gemm { const bf16_t* A; const bf16_t* Bt; int M, N, K; };

struct StaticOrder {
    int nM, nN, nwg, G, c;
    __host__ __device__ void init(int M, int N, int G_, int c_) { nM = M / BM; nN = N / BM; nwg = nM * nN; G = G_; c = c_; }
    __host__ __device__ bool next(int i, Unit& u) const {
        const long L = (long)i * G + c; if (L >= nwg) return false;
        int wgid = (int)L; { const int q = nwg / NXCD, r = nwg % NXCD, xcd = wgid % NXCD, off = wgid / NXCD; wgid = (xcd < r ? xcd * (q + 1) : r * (q + 1) + (xcd - r) * q) + off; }
        const int nig = WGM * nN, gid = wgid / nig, fm = gid * WGM, gsz = (nM - fm) < WGM ? (nM - fm) : WGM;
        u.pm = fm + ((wgid % nig) % gsz); u.pn = (wgid % nig) / gsz; return true;
    }
    __device__ __forceinline__ void a_ready(const Unit&) const {}
    __device__ __forceinline__ void done(const Unit&) const {}
};

__device__ __forceinline__ unsigned cvt_pk_bf16(float lo, float hi) { unsigned r; asm volatile("v_cvt_pk_bf16_f32 %0, %1, %2" : "=v"(r) : "v"(lo), "v"(hi)); return r; }
typedef float f32x2 __attribute__((ext_vector_type(2)));
__device__ __forceinline__ float fast_sigmoid(float x) { return __builtin_amdgcn_rcpf(1.0f + __builtin_amdgcn_exp2f(-1.4426950408889634f * x)); }
struct EpiF32 {
    static constexpr bool PERM = false, AFTER_DRAIN = false;
    float* O; int ldc; const float* ssq; int split_cols; size_t split_stride;
    __device__ __forceinline__ void operator()(const f32x4 (&acc)[2][2][4][2], const Unit& u, int wr, int wc, int fr, int fq) const {
        int colt = u.pn * BM; float* base = O; if (split_cols) { const int t = colt / split_cols; base += (size_t)t * split_stride; colt -= t * split_cols; }
        const int row0 = u.pm * BM + wr * 64 + fr, col0 = colt + wc * 32 + 4 * fq;
#pragma unroll
        for (int ai = 0; ai < 2; ++ai)
#pragma unroll
            for (int m = 0; m < 4; ++m) { const int r = row0 + ai * HALF + m * 16; const float rs = ssq ? rstd_of(ssq[r]) : 1.0f; float* rowp = base + (size_t)r * ldc + col0;
#pragma unroll
                for (int bj = 0; bj < 2; ++bj)
#pragma unroll
                    for (int n = 0; n < 2; ++n) *(f32x4*)(rowp + bj * HALF + n * 16) = acc[ai][bj][m][n] * rs; }
    }
};
struct EpiBf16S {
    static constexpr bool PERM = true, AFTER_DRAIN = false;
    bf16_t* O; int ldc; const float* ssq; int gate_pn; float* GT;
    __device__ __forceinline__ void operator()(const f32x4 (&acc)[2][2][4][2], const Unit& u, int wr, int wc, int fr, int fq) const {
        const int row0 = u.pm * BM + wr * 64 + fr, col0 = u.pn * BM + wc * 32 + 8 * fq;
        if (u.pn == gate_pn) {
            if (wc == 0 && fq == 0) {
#pragma unroll
                for (int ai = 0; ai < 2; ++ai)
#pragma unroll
                    for (int m = 0; m < 4; ++m) { const int r = row0 + ai * HALF + m * 16; const float rs = rstd_of(ssq[r]);
                        *(f32x4*)(GT + (size_t)r * 48) = acc[ai][0][m][0] * rs; *(f32x4*)(GT + (size_t)r * 48 + 4) = acc[ai][0][m][1] * rs; } }
            return; }
#pragma unroll
        for (int ai = 0; ai < 2; ++ai)
#pragma unroll
            for (int m = 0; m < 4; ++m) { const int r = row0 + ai * HALF + m * 16; const float rs = rstd_of(ssq[r]); bf16_t* rowp = O + (size_t)r * ldc + col0;
#pragma unroll
                for (int bj = 0; bj < 2; ++bj) { const f32x4 v0 = acc[ai][bj][m][0] * rs, v1 = acc[ai][bj][m][1] * rs;
                    u32x4 w; w.x = cvt_pk_bf16(v0[0], v0[1]); w.y = cvt_pk_bf16(v0[2], v0[3]); w.z = cvt_pk_bf16(v1[0], v1[1]); w.w = cvt_pk_bf16(v1[2], v1[3]);
                    *(u32x4*)(rowp + bj * HALF) = w; } }
    }
};
struct EpiSwiglu {
    static constexpr bool PERM = true, AFTER_DRAIN = false;
    bf16_t* O; const float* ssq;
    __device__ __forceinline__ void operator()(const f32x4 (&acc)[2][2][4][2], const Unit& u, int wr, int wc, int fr, int fq) const {
        const int row0 = u.pm * BM + wr * 64 + fr, col0 = u.pn * HALF + wc * 32 + 8 * fq;
#pragma unroll
        for (int ai = 0; ai < 2; ++ai)
#pragma unroll
            for (int m = 0; m < 4; ++m) { const int r = row0 + ai * HALF + m * 16; const float rs = rstd_of(ssq[r]); float h[8];
#pragma unroll
                for (int n = 0; n < 2; ++n)
#pragma unroll
                    for (int j = 0; j < 4; ++j) { const float g = acc[ai][0][m][n][j] * rs, up = acc[ai][1][m][n][j] * rs; h[4 * n + j] = g * fast_sigmoid(g) * up; }
                u32x4 w; w.x = cvt_pk_bf16(h[0], h[1]); w.y = cvt_pk_bf16(h[2], h[3]); w.z = cvt_pk_bf16(h[4], h[5]); w.w = cvt_pk_bf16(h[6], h[7]);
                *(u32x4*)(O + (size_t)r * 2816 + col0) = w; }
    }
};
struct EpiResid {
    static constexpr bool PERM = false, AFTER_DRAIN = false;
    float* Y; bf16_t* XB; float* ssq;
    __device__ __forceinline__ void operator()(const f32x4 (&acc)[2][2][4][2], const Unit& u, int wr, int wc, int fr, int fq) const {
        const int row0 = u.pm * BM + wr * 64 + fr, col0 = u.pn * BM + wc * 32 + 4 * fq;
        typedef unsigned u32x2 __attribute__((ext_vector_type(2)));
#pragma unroll
        for (int ai = 0; ai < 2; ++ai)
#pragma unroll
            for (int m = 0; m < 4; ++m) { const int r = row0 + ai * HALF + m * 16; bf16_t* bp = XB + (size_t)r * 1024 + col0; float ss = 0.f; u32x2 old[2][2];
#pragma unroll
                for (int bj = 0; bj < 2; ++bj)
#pragma unroll
                    for (int n = 0; n < 2; ++n) old[bj][n] = *(const u32x2*)(bp + bj * HALF + n * 16);
#pragma unroll
                for (int bj = 0; bj < 2; ++bj)
#pragma unroll
                    for (int n = 0; n < 2; ++n) { const u32x2 o = old[bj][n]; f32x4 x = (f32x4){bflo(o.x), bfhi(o.x), bflo(o.y), bfhi(o.y)} + acc[ai][bj][m][n];
                        u32x2 w; w.x = cvt_pk_bf16(x[0], x[1]); w.y = cvt_pk_bf16(x[2], x[3]); *(u32x2*)(bp + bj * HALF + n * 16) = w;
                        if (Y) *(f32x4*)(Y + (size_t)r * 1024 + col0 + bj * HALF + n * 16) = x;
                        ss += (x[0] * x[0] + x[1] * x[1]) + (x[2] * x[2] + x[3] * x[3]); }
                ss += __shfl_xor(ss, 16); ss += __shfl_xor(ss, 32);
                if (fq == 0) (void)__hip_atomic_fetch_add(ssq + r, ss, __ATOMIC_RELAXED, __HIP_MEMORY_SCOPE_AGENT); }
    }
};
template <class Epi, class Sched, bool ALIGN_EPI = false, bool SP2 = false>
__device__ __forceinline__ void gemm_phase(PG8_LAS unsigned char* lds, const Gemm g, const Sched& S, const Epi& E) {
    int tid_l = threadIdx.x; asm volatile("" : "+v"(tid_l));
    const int tid = tid_l, wid = __builtin_amdgcn_readfirstlane(tid >> 6), lane = tid & 63, wr = wid >> 2, wc = wid & 3, fr = lane & 15, fq = lane >> 4;
    const int K = g.K, nt = K / BK;
    unsigned voffA[2], voffB[2];
#pragma unroll
    for (int i = 0; i < 2; ++i) { int R, C; stage_rc(tid * 16 + i * 8192, R, C); const int Rb = Epi::PERM ? ((R & ~31) + perm32(R & 31)) : R;
        voffA[i] = (unsigned)(R * K + C) * 2u; voffB[i] = (unsigned)(Rb * K + C) * 2u; }
    const size_t kstep = (size_t)(BK * 2);
    const size_t hstep = (size_t)HALF * K * 2;
    const size_t tstep = 2 * hstep;
    const unsigned ldsw = (unsigned)wid * 1024u;
    const int aoff = lds_byte(wr * 64 + fr, fq * 8), boff = lds_byte(wc * 32 + fr, fq * 8);
#define PG8_SA(b, h) (((b) * 2 + (h)) * HTB)
#define PG8_SB(b, h) ((4 + (b) * 2 + (h)) * HTB)
#define PG8_STAGE(bufoff, gbase, voff) do { _Pragma("unroll") for (int _i = 0; _i < 2; ++_i) \
        __builtin_amdgcn_global_load_lds((const unsigned*)((const char*)(gbase) + (voff)[_i]), (PG8_LAS unsigned*)(lds + (bufoff) + ldsw + _i * 8192), 16, 0, 0); } while (0)
#define PG8_LDA(dst, b, h) do { _Pragma("unroll") for (int m = 0; m < 4; ++m) _Pragma("unroll") for (int k = 0; k < 2; ++k) dst[m][k] = *(const PG8_LAS bf16x8*)(lds + PG8_SA(b, h) + aoff + m * 2048 + k * 1024); } while (0)
#define PG8_LDB(dst, b, h) do { _Pragma("unroll") for (int n = 0; n < 2; ++n) _Pragma("unroll") for (int k = 0; k < 2; ++k) dst[n][k] = *(const PG8_LAS bf16x8*)(lds + PG8_SB(b, h) + boff + n * 2048 + k * 1024); } while (0)
#define PG8_MMA(ai, bj, At, Bt) do { __builtin_amdgcn_s_setprio(1); _Pragma("unroll") for (int m = 0; m < 4; ++m) _Pragma("unroll") for (int n = 0; n < 2; ++n) _Pragma("unroll") for (int k = 0; k < 2; ++k) \
        acc[ai][bj][m][n] = __builtin_amdgcn_mfma_f32_16x16x32_bf16(Bt[n][k], At[m][k], acc[ai][bj][m][n], 0, 0, 0); __builtin_amdgcn_s_setprio(0); } while (0)
#define PG8_WAIT_V(n) asm volatile("s_waitcnt vmcnt(" #n ")" ::: "memory")
#define PG8_WAIT_L(n) asm volatile("s_waitcnt lgkmcnt(" #n ")" ::: "memory")
#define PG8_BAR __builtin_amdgcn_s_barrier()
#define PG8_SCHED __builtin_amdgcn_sched_barrier(0)
    Unit cur, nxt; int ui = 0;
    if (!S.next(0, cur)) return;
    f32x4 acc[2][2][4][2];
#pragma unroll
    for (int a = 0; a < 2; ++a)
#pragma unroll
        for (int b = 0; b < 2; ++b)
#pragma unroll
            for (int m = 0; m < 4; ++m)
#pragma unroll
                for (int n = 0; n < 2; ++n) acc[a][b][m][n] = (f32x4){0.f, 0.f, 0.f, 0.f};
    bf16x8 At[4][2], B0[2][2], B1[2][2];
    const char* cA = (const char*)g.A + (size_t)cur.pm * tstep; const char* cB = (const char*)g.Bt + (size_t)cur.pn * tstep;
    S.a_ready(cur);
    if constexpr (SP2) {
        PG8_STAGE(PG8_SB(0, 0), cB, voffB); PG8_STAGE(PG8_SB(0, 1), cB + hstep, voffB); PG8_STAGE(PG8_SA(0, 0), cA, voffA); PG8_STAGE(PG8_SA(0, 1), cA + hstep, voffA);
        if (wr == 1) PG8_BAR;
        PG8_WAIT_V(2); PG8_BAR;
        PG8_STAGE(PG8_SB(1, 0), cB + kstep, voffB); PG8_STAGE(PG8_SA(1, 0), cA + kstep, voffA); PG8_STAGE(PG8_SB(1, 1), cB + hstep + kstep, voffB);
        PG8_WAIT_V(6); PG8_BAR;
    } else {
        PG8_STAGE(PG8_SB(0, 0), cB, voffB); PG8_STAGE(PG8_SA(0, 0), cA, voffA); PG8_STAGE(PG8_SB(0, 1), cB + hstep, voffB); PG8_STAGE(PG8_SA(0, 1), cA + hstep, voffA);
        if (wr == 1) PG8_BAR;
        PG8_WAIT_V(4); PG8_BAR;
        PG8_STAGE(PG8_SB(1, 0), cB + kstep, voffB); PG8_STAGE(PG8_SA(1, 0), cA + kstep, voffA); PG8_STAGE(PG8_SB(1, 1), cB + hstep + kstep, voffB);
        PG8_WAIT_V(6); PG8_BAR;
    }
    for (;;) {
        const bool has_next = S.next(ui + 1, nxt);
        const char* nA = has_next ? (const char*)g.A + (size_t)nxt.pm * tstep : cA; const char* nB = has_next ? (const char*)g.Bt + (size_t)nxt.pn * tstep : cB;
        for (int t = 0; t < nt; t += 2) {
            const bool last = (t == nt - 2);
            const char* a1 = cA + (size_t)(t + 1) * kstep;
            const char* a2 = last ? nA : cA + (size_t)(t + 2) * kstep; const char* b2 = last ? nB : cB + (size_t)(t + 2) * kstep;
            const char* a3 = a2 + kstep; const char* b3 = b2 + kstep;
            if (last && has_next) S.a_ready(nxt);
            if constexpr (SP2) {
            PG8_LDB(B0, 0, 0); PG8_LDB(B1, 0, 1); PG8_SCHED; PG8_LDA(At, 0, 0); PG8_STAGE(PG8_SA(1, 1), a1 + hstep, voffA);
            PG8_WAIT_V(8); PG8_WAIT_L(0); PG8_BAR; PG8_MMA(0, 0, At, B0); PG8_MMA(0, 1, At, B1); PG8_BAR; PG8_SCHED;
            PG8_LDA(At, 0, 1); PG8_STAGE(PG8_SB(0, 0), b2, voffB); PG8_STAGE(PG8_SB(0, 1), b2 + hstep, voffB); PG8_STAGE(PG8_SA(0, 0), a2, voffA);
            PG8_WAIT_V(8); PG8_WAIT_L(0); PG8_BAR; PG8_MMA(1, 0, At, B0); PG8_MMA(1, 1, At, B1); PG8_BAR; PG8_SCHED;
            PG8_LDB(B0, 1, 0); PG8_LDB(B1, 1, 1); PG8_SCHED; PG8_LDA(At, 1, 0); PG8_STAGE(PG8_SA(0, 1), a2 + hstep, voffA);
            PG8_WAIT_V(8); PG8_WAIT_L(0); PG8_BAR; PG8_MMA(0, 0, At, B0); PG8_MMA(0, 1, At, B1); PG8_BAR; PG8_SCHED;
            PG8_LDA(At, 1, 1); PG8_STAGE(PG8_SB(1, 0), b3, voffB); PG8_STAGE(PG8_SB(1, 1), b3 + hstep, voffB); PG8_STAGE(PG8_SA(1, 0), a3, voffA);
            PG8_WAIT_V(8); PG8_WAIT_L(0); PG8_BAR; PG8_MMA(1, 0, At, B0); PG8_MMA(1, 1, At, B1); PG8_BAR; PG8_SCHED;
            } else {
            PG8_LDB(B0, 0, 0); PG8_SCHED; PG8_LDA(At, 0, 0); PG8_STAGE(PG8_SA(1, 1), a1 + hstep, voffA);
            PG8_WAIT_L(8); PG8_BAR; PG8_WAIT_L(0); PG8_MMA(0, 0, At, B0); PG8_BAR; PG8_SCHED;
            PG8_LDB(B1, 0, 1); PG8_STAGE(PG8_SB(0, 0), b2, voffB);
            PG8_BAR; PG8_WAIT_L(0); PG8_MMA(0, 1, At, B1); PG8_BAR;
            PG8_LDA(At, 0, 1); PG8_STAGE(PG8_SA(0, 0), a2, voffA);
            PG8_BAR; PG8_WAIT_L(0); PG8_MMA(1, 0, At, B0); PG8_BAR; PG8_SCHED;
            PG8_STAGE(PG8_SB(0, 1), b2 + hstep, voffB);
            PG8_WAIT_V(6); PG8_BAR; PG8_MMA(1, 1, At, B1); PG8_BAR;
            PG8_LDB(B0, 1, 0); PG8_SCHED; PG8_LDA(At, 1, 0); PG8_STAGE(PG8_SA(0, 1), a2 + hstep, voffA);
            PG8_WAIT_L(8); PG8_BAR; PG8_WAIT_L(0); PG8_MMA(0, 0, At, B0); PG8_BAR; PG8_SCHED;
            PG8_LDB(B1, 1, 1); PG8_STAGE(PG8_SB(1, 0), b3, voffB);
            PG8_BAR; PG8_WAIT_L(0); PG8_MMA(0, 1, At, B1); PG8_BAR;
            PG8_LDA(At, 1, 1); PG8_STAGE(PG8_SA(1, 0), a3, voffA);
            PG8_BAR; PG8_WAIT_L(0); PG8_MMA(1, 0, At, B0); PG8_BAR; PG8_SCHED;
            PG8_STAGE(PG8_SB(1, 1), b3 + hstep, voffB);
            PG8_WAIT_V(6); PG8_BAR; PG8_MMA(1, 1, At, B1); PG8_BAR;
            }
        }
        if constexpr (ALIGN_EPI) { if (wr == 0) PG8_BAR; }
        if constexpr (!Epi::AFTER_DRAIN) { E(acc, cur, wr, wc, fr, fq); S.done(cur); }
        if (!has_next) break;
#pragma unroll
        for (int a = 0; a < 2; ++a)
#pragma unroll
            for (int b = 0; b < 2; ++b)
#pragma unroll
                for (int m = 0; m < 4; ++m)
#pragma unroll
                    for (int n = 0; n < 2; ++n) acc[a][b][m][n] = (f32x4){0.f, 0.f, 0.f, 0.f};
        cur = nxt; cA = nA; cB = nB; ++ui;
        if constexpr (ALIGN_EPI) { if (wr == 1) PG8_BAR; }
    }
    PG8_WAIT_V(0);
    if constexpr (!ALIGN_EPI) { if (wr == 0) PG8_BAR; }
    PG8_BAR;
    if constexpr (Epi::AFTER_DRAIN) { E.fused(acc, cur, wr, wc, fr, fq, lds, wid, lane); S.done(cur); }
#undef PG8_SA
#undef PG8_SB
#undef PG8_STAGE
#undef PG8_LDA
#undef PG8_LDB
#undef PG8_MMA
#undef PG8_WAIT_V
#undef PG8_WAIT_L
#undef PG8_BAR
#undef PG8_SCHED
}
}
typedef short s_bf16x8 __attribute__((ext_vector_type(8)));
typedef float s_f32x4 __attribute__((ext_vector_type(4)));
template <int NT> struct StripAcc { s_f32x4 a[NT]; };
template <int NT> __device__ __forceinline__ void strip_gemm(const bf16_t* A, int K, int row0, const bf16_t* Bt, const int* brow  , StripAcc<NT>& R, LAS unsigned char* lds) {
    const int tid_ = ltid(), lane = tid_ & 63, wave = tid_ >> 6, fr = lane & 15, fq = lane >> 4, rt = wave & 1, kq = wave >> 1;
    LAS float* red = (LAS float*)lds;
    const int kw = K >> 2;
    const bf16_t* ap = A + (size_t)(row0 + 16 * rt + fr) * K + kq * kw + fq * 8;
    const bf16_t* bp[NT];
#pragma unroll
    for (int t = 0; t < NT; ++t) { bp[t] = Bt + (size_t)(brow[t] + fr) * K + kq * kw + fq * 8; R.a[t] = (s_f32x4){0.f, 0.f, 0.f, 0.f}; }
    int k0 = 0;
#pragma unroll 1
    for (; k0 + 256 <= kw; k0 += 256) {
        s_bf16x8 a[8], b[NT][8];
#pragma unroll
        for (int s2 = 0; s2 < 8; ++s2) { a[s2] = *(const s_bf16x8*)(ap + k0 + s2 * 32);
#pragma unroll
            for (int t = 0; t < NT; ++t) b[t][s2] = *(const s_bf16x8*)(bp[t] + k0 + s2 * 32); }
#pragma unroll
        for (int s2 = 0; s2 < 8; ++s2)
#pragma unroll
            for (int t = 0; t < NT; ++t) R.a[t] = __builtin_amdgcn_mfma_f32_16x16x32_bf16(b[t][s2], a[s2], R.a[t], 0, 0, 0);
    }
#pragma unroll 1
    for (; k0 < kw; k0 += 64) {
        s_bf16x8 a[2], b[NT][2];
#pragma unroll
        for (int s2 = 0; s2 < 2; ++s2) { a[s2] = *(const s_bf16x8*)(ap + k0 + s2 * 32);
#pragma unroll
            for (int t = 0; t < NT; ++t) b[t][s2] = *(const s_bf16x8*)(bp[t] + k0 + s2 * 32); }
#pragma unroll
        for (int s2 = 0; s2 < 2; ++s2)
#pragma unroll
            for (int t = 0; t < NT; ++t) R.a[t] = __builtin_amdgcn_mfma_f32_16x16x32_bf16(b[t][s2], a[s2], R.a[t], 0, 0, 0);
    }
    __syncthreads();
    if (kq > 0) {
#pragma unroll
        for (int t = 0; t < NT; ++t) *(LAS s_f32x4*)(red + ((((kq - 1) * 2 + rt) * NT + t) * 64 + lane) * 4) = R.a[t]; }
    __syncthreads();
    if (kq == 0) {
#pragma unroll
        for (int q = 0; q < 3; ++q)
#pragma unroll
            for (int t = 0; t < NT; ++t) R.a[t] = R.a[t] + *(const LAS s_f32x4*)(red + (((q * 2 + rt) * NT + t) * 64 + lane) * 4); }
}
enum { TR_ID = 0, TR_INA, TR_INB, TR_GU };
__device__ __forceinline__ int tr_rowmap(int kind, int n) {
    if (kind == TR_INA) return n < 3072 ? n : (n < 3080 ? 3328 + (n - 3072) : 3072 + (n - 3080));
    if (kind == TR_INB) return n < 768 ? n : (n < 804 ? 1024 + (n - 768) : 768 + (n - 804));
    if (kind == TR_GU) { if (n < DFF) return (n >> 7) * 256 + (n & 127); const int m = n - DFF; return (m >> 7) * 256 + 128 + (m & 127); }
    return n;
}
__device__ __forceinline__ void tr_item(const float* W, int K, int N, bf16_t* WT, const float* gain, int kind, LAS float* scr, int item, int lane) {
    const int nblk = (N + 31) >> 5, kb = item / nblk, nb = item % nblk, k0 = 64 * kb, n0 = 32 * nb;
    { float v[32]; const int n = n0 + (lane & 31); const bool ok = n < N; const float* wp = W + (size_t)(k0 + (lane >> 5)) * N + (ok ? n : 0);
#pragma unroll
      for (int i = 0; i < 32; ++i) v[i] = wp[(size_t)(2 * i) * N];
#pragma unroll
      for (int i = 0; i < 32; ++i) { const int kk = 2 * i + (lane >> 5); float x = ok ? v[i] : 0.f; if (gain) x *= gain[k0 + kk]; scr[kk * 33 + (lane & 31)] = x; } }
    asm volatile("s_waitcnt lgkmcnt(0)" ::: "memory");
    const int c = lane & 7;
#pragma unroll
    for (int j = 0; j < 4; ++j) { const int nn = (lane >> 3) + 8 * j, n = n0 + nn;
        if (n < N) { const int row = tr_rowmap(kind, n); const float sc = (kind == TR_INA && n >= 768 && n < 1536) ? 0.07216878364870322f : 1.0f;
            const LAS float* s = scr + (8 * c) * 33 + nn; uint4 o;
            o.x = pk2(s[0 * 33] * sc, s[1 * 33] * sc); o.y = pk2(s[2 * 33] * sc, s[3 * 33] * sc); o.z = pk2(s[4 * 33] * sc, s[5 * 33] * sc); o.w = pk2(s[6 * 33] * sc, s[7 * 33] * sc);
            *(uint4*)(WT + (size_t)row * K + k0 + 8 * c) = o; } }
    asm volatile("s_waitcnt lgkmcnt(0)" ::: "memory");
}
__device__ __forceinline__ void ph_convert_layer(const Params& p, LAS unsigned char* lds, int l, int gw, int NGW, bool shared) {
    const int tid = ltid(), lane = tid & 63, wid = tid >> 6;
    LAS float* scr = (LAS float*)(lds + wid * 16384);
    unsigned char* ws = p.ws;
    for (int it = gw; ; it += NGW) {
        int r = it; bool done = false;
#define TRJ(Wp, K_, N_, WTp, gainp, kind_) if (!done) { const int cnt = ((K_) / 64) * (((N_) + 31) / 32); if (r < cnt) { tr_item(Wp, K_, N_, WTp, gainp, kind_, scr, r, lane); done = true; } else r -= cnt; }
        TRJ(p.in[I_WGU] + (size_t)l * DM * 2 * DFF, DM, 2 * DFF, (bf16_t*)(ws + B_BTG) + (size_t)l * 2 * DFF * DM, p.in[I_GFFN] + l * DM, TR_GU)
        TRJ(p.in[I_WDOWN] + (size_t)l * DFF * DM, DFF, DM, (bf16_t*)(ws + B_BTD) + (size_t)l * DM * DFF, (const float*)nullptr, TR_ID)
        if (l < 2) { TRJ(p.in[I_WINA] + (size_t)l * DM * ACOLS, DM, ACOLS, (bf16_t*)(ws + B_BTA) + (size_t)l * NBTA * DM, p.in[I_GMIX] + l * DM, TR_INA) }
        else { TRJ(p.in[I_WINB] + (size_t)(l - 2) * DM * BCOLS, DM, BCOLS, (bf16_t*)(ws + B_BTB) + (size_t)(l - 2) * NBTB * DM, p.in[I_GMIX] + l * DM, TR_INB) }
        TRJ(p.in[I_WOUT] + (size_t)l * DM * DM, DM, DM, (bf16_t*)(ws + B_BTO) + (size_t)l * DM * DM, (const float*)nullptr, TR_ID)
        if (shared) {
            TRJ(p.in[I_WKV], DM, 768, (bf16_t*)(ws + B_BTK), p.in[I_GKV], TR_ID)
            for (int m = 0; m < 4; ++m) TRJ(p.in[I_WMEMKV] + (size_t)m * DM * 512, DM, 512, (bf16_t*)(ws + B_BTM) + (size_t)m * 512 * DM, (const float*)nullptr, TR_ID)
            for (int c = 0; c < 2; ++c) TRJ(p.in[I_CW1] + (size_t)c * 2048 * 128, 2048, 128, (bf16_t*)(ws + B_W1T) + (size_t)c * 128 * 2048, (const float*)nullptr, TR_ID)
            for (int c = 0; c < 2; ++c) TRJ(p.in[I_CW2] + (size_t)c * 128 * 64, 128, 64, (bf16_t*)(ws + B_W2T) + (size_t)c * 64 * 128, (const float*)nullptr, TR_ID)
        }
#undef TRJ
        if (!done) break;
    }
}
__device__ __forceinline__ void ph_prologue(const Params& p, LAS unsigned char* lds) {
    const int tid = ltid(), lane = tid & 63, wid = tid >> 6; const int gw = blockIdx.x * NW_ + wid, NGW = gridDim.x * NW_;
    LAS float* scr = (LAS float*)(lds + wid * 16384);
    unsigned char* ws = p.ws;
    ph_convert_layer(p, lds, 0, gw, NGW, true);
    if (gridDim.x != 256) { for (int l = 1; l < 4; ++l) ph_convert_layer(p, lds, l, gw, NGW, false); }
    for (int idx = gw; idx < 256; idx += NGW) { const int c = idx >> 7, h = idx & 127; float s = 0.f;
        for (int k = lane; k < 2048; k += 64) s += p.in[I_CPOS][((k >> 6) * 2 + c) * 64 + (k & 63)] * p.in[I_CW1][((size_t)c * 2048 + k) * 128 + h];
        s = wave_sum(s); if (lane == 0) ((float*)(ws + B_PEB))[idx] = s + p.in[I_CB1][idx]; }
    for (int i = blockIdx.x * NT_ + tid; i < 2 * 8 * 128 + 2 * 12 * 128; i += gridDim.x * NT_) {
        uint4 z = make_uint4(0u, 0u, 0u, 0u);
        if (i < 2048) { const int l = i >> 10, rr = (i >> 7) & 7, c = i & 127; ((uint4*)((bf16_t*)(ws + B_BTA) + ((size_t)l * NBTA + 3336 + rr) * DM))[c] = z; }
        else { const int k = i - 2048; const int l = k / 1536, rr = (k % 1536) >> 7, c = k & 127; ((uint4*)((bf16_t*)(ws + B_BTB) + ((size_t)l * NBTB + 1060 + rr) * DM))[c] = z; }
    }
    bf16_t* XB = (bf16_t*)(ws + B_XB); float* ssq0 = (float*)(ws + B_SSQ); bf16_t* MPB = (bf16_t*)(ws + B_MPB);
    for (int r0 = gw; r0 < MA + 2048; r0 += 2 * NGW) {
        float4 v[2][4]; const int r1 = r0 + NGW < MA + 2048 ? r0 + NGW : r0;
#pragma unroll
        for (int u = 0; u < 2; ++u) { const int r = u ? r1 : r0; const float* src = r < MA ? (r < MP ? p.in[I_XP] + (size_t)r * DM : p.in[I_XS] + (size_t)(r - MP) * DM) : p.in[I_MEMP] + (size_t)(r - MA) * DM;
#pragma unroll
            for (int j = 0; j < 4; ++j) v[u][j] = ((const float4*)src)[lane + 64 * j]; }
#pragma unroll
        for (int u = 0; u < 2; ++u) { const int r = u ? r1 : r0; if (u == 1 && r1 == r0) break; const bool isx = r < MA;
            bf16_t* dstb = isx ? XB + (size_t)r * DM : MPB + (size_t)(r - MA) * DM; float ss = 0.f;
#pragma unroll
            for (int j = 0; j < 4; ++j) { ss += dot4(v[u][j], v[u][j]); ((uint2*)dstb)[lane + 64 * j] = make_uint2(pk2(v[u][j].x, v[u][j].y), pk2(v[u][j].z, v[u][j].w)); }
            ss = wave_sum(ss); if (isx && lane == 0) ssq0[r] = ss; }
    }
}

__device__ __forceinline__ void ph_swin_copy(const Params& p, int blk0, int nblk) {
    if ((int)blockIdx.x < blk0 || (int)blockIdx.x >= blk0 + nblk) return;
    const int tid = ltid();
    {   const unsigned n4 = 128u * 511u * 64u, stride = nblk * NT_;
#define SW_SRC(i_) (((const float4*)(p.in[I_CWIN] + (size_t)((i_) / (511u * 64u)) * 512 * 256 + 256))[(i_) % (511u * 64u)])
#define SW_DST(i_) (((float4*)(p.out + O_SWIN + (size_t)((i_) / (511u * 64u)) * 512 * 256))[(i_) % (511u * 64u)])
        for (unsigned i0 = (blockIdx.x - blk0) * NT_ + tid; i0 < n4; i0 += 4 * stride) {
            const unsigned i1 = i0 + stride, i2 = i0 + 2 * stride, i3 = i0 + 3 * stride;
            const float4 v0 = SW_SRC(i0), v1 = SW_SRC(i1 < n4 ? i1 : i0), v2 = SW_SRC(i2 < n4 ? i2 : i0), v3 = SW_SRC(i3 < n4 ? i3 : i0);
            SW_DST(i0) = v0; if (i1 < n4) SW_DST(i1) = v1; if (i2 < n4) SW_DST(i2) = v2; if (i3 < n4) SW_DST(i3) = v3; }
#undef SW_SRC
#undef SW_DST
    }
}

__device__ __forceinline__ void ph_memk_norm(const Params& p) {
    const int tid_ = ltid(); const int lane = tid_ & 63, wid = tid_ >> 6;
    const float* raw = (const float*)(p.ws + B_MEMR);
    for (int it = blockIdx.x * NW_ + wid; it < 4 * 8 * 256; it += gridDim.x * NW_) {
        const int l = it / 2048;
        const float4* rr = (const float4*)(raw + (size_t)it * 512); float4* orow = (float4*)(p.out + O_PMEM + (size_t)it * 512);
        float4 v = rr[lane]; const float4 vv = rr[64 + lane]; float ss = dot4(v, v);
        ss += __shfl_xor(ss, 1); ss += __shfl_xor(ss, 2); ss += __shfl_xor(ss, 4); ss += __shfl_xor(ss, 8);
        const float rs = rsqrtf(ss * (1.0f / 64) + EPS);
        const float4 g = ((const float4*)(p.in[I_GMEMK] + l * 64))[lane & 15];
        v.x *= rs * g.x; v.y *= rs * g.y; v.z *= rs * g.z; v.w *= rs * g.w; orow[lane] = v; orow[64 + lane] = vv;
    }
}

__device__ __forceinline__ void ph_mlstm_prompt(const Params& p, int l, float* lds) {
    const bf16_t* P = (const bf16_t*)(p.ws + B_P16); const float* GT = (const float*)(p.ws + B_GT); const float* bif = p.in[I_BIF] + l * 8; float* HR = (float*)(p.ws + B_HRAW);
    const int tid = ltid(), lane = tid & 63, wid = tid >> 6;
    float* red = lds;
    for (int item = blockIdx.x; item < 256; item += gridDim.x) {
        const int es = item & 7, h = (item >> 3) & 3, b = item >> 5;
        const bool act = tid < 384; const int grp = tid >= 192 ? 1 : 0; const int d = act ? tid - grp * 192 : 0;
        const int col0 = h * 192 + es * 24 + (act ? grp : 0) * 12;
        float C[12]; float n = 0.f, m = NEGM;
#pragma unroll
        for (int e = 0; e < 12; ++e) C[e] = 0.f;
        const bf16_t* pr = P + (size_t)(b * SP) * LDA_; const float* gr = GT + (size_t)(b * SP) * GTW;
        float qn = act ? bf2f(pr[h * 192 + d]) : 0.f, kn = act ? bf2f(pr[768 + h * 192 + d]) : 0.f; uint2 vn[3];
#pragma unroll
        for (int e = 0; e < 3; ++e) vn[e] = *(const uint2*)(pr + 1536 + col0 + 4 * e);
        float in_ = gr[h] + bif[h], fn = gr[4 + h] + bif[4 + h];
        for (int t = 0; t < SP; ++t) {
            const float q = qn, k = kn, ig = in_, fg = fn; float v[12];
#pragma unroll
            for (int e = 0; e < 3; ++e) { v[4 * e] = bflo(vn[e].x); v[4 * e + 1] = bfhi(vn[e].x); v[4 * e + 2] = bflo(vn[e].y); v[4 * e + 3] = bfhi(vn[e].y); }
            if (t + 1 < SP) {
                pr += LDA_; gr += GTW;
                qn = act ? bf2f(pr[h * 192 + d]) : 0.f; kn = act ? bf2f(pr[768 + h * 192 + d]) : 0.f;
#pragma unroll
                for (int e = 0; e < 3; ++e) vn[e] = *(const uint2*)(pr + 1536 + col0 + 4 * e);
                in_ = gr[h] + bif[h]; fn = gr[4 + h] + bif[4 + h];
            }
            const float logf = logsigmoidf_(fg);
            const float m_new = fmaxf(logf + m, ig);
            const float a = expf(logf + m - m_new), bb = expf(ig - m_new);
            const float kb = bb * k;
            float part[13];
#pragma unroll
            for (int e = 0; e < 12; ++e) { C[e] = a * C[e] + kb * v[e]; part[e] = q * C[e]; }
            n = a * n + kb; part[12] = q * n;
#pragma unroll
            for (int e = 0; e < 13; ++e) part[e] = wave_sum(part[e]);
            float* rb = red + (t & 1) * 104;
            if (lane == 0) {
#pragma unroll
                for (int e = 0; e < 13; ++e) rb[wid * 13 + e] = part[e];
            }
            __syncthreads();
            if (tid < 24) {
                const int g2 = tid / 12, e = tid % 12;
                const float num = rb[(g2 * 3) * 13 + e] + rb[(g2 * 3 + 1) * 13 + e] + rb[(g2 * 3 + 2) * 13 + e];
                const float den = rb[12] + rb[13 + 12] + rb[26 + 12];
                HR[(size_t)(b * SP + t) * 768 + h * 192 + es * 24 + tid] = num / fmaxf(fabsf(den), expf(-m_new));
            }
            m = m_new;
        }
        if (act) {
            float* co = p.out + O_PC + ((size_t)((l * 8 + b) * 4 + h) * 192 + d) * 192 + es * 24 + grp * 12;
#pragma unroll
            for (int e = 0; e < 12; ++e) co[e] = C[e];
            if (es == 0 && grp == 0) p.out[O_PN + (size_t)((l * 8 + b) * 4 + h) * 192 + d] = n;
        }
        if (es == 0 && tid == 0) p.out[O_PM + (l * 8 + b) * 4 + h] = m;
        __syncthreads();
    }
}
__device__ __forceinline__ void ph_mlstm_sample(const Params& p, int l, float* lds) {
    const bf16_t* P = (const bf16_t*)(p.ws + B_P16); const float* GT = (const float*)(p.ws + B_GT); const float* bif = p.in[I_BIF] + l * 8; float* HR = (float*)(p.ws + B_HRAW);
    const int tid = ltid();
    float* qs = lds + 512; float* ks = lds + 512 + 192; float* n0s = lds + 512 + 384;
    for (int item = blockIdx.x; item < 128 * 4; item += gridDim.x) {
        const int h = item & 3, b = item >> 2; const int row = MP + b;
        const bf16_t* pr = P + (size_t)row * LDA_; const float* gr = GT + (size_t)row * GTW;
        const size_t sidx = (size_t)(l * 128 + b) * 4 + h;
        __syncthreads();
        if (tid < 192) { qs[tid] = bf2f(pr[h * 192 + tid]); ks[tid] = bf2f(pr[768 + h * 192 + tid]); n0s[tid] = p.in[I_SN][sidx * 192 + tid]; }
        __syncthreads();
        const float ig = gr[h] + bif[h], fg = gr[4 + h] + bif[4 + h];
        const float m0 = p.in[I_SM][sidx];
        const float logf = logsigmoidf_(fg);
        const float m_new = fmaxf(logf + m0, ig);
        const float a = expf(logf + m0 - m_new), bb = expf(ig - m_new);
        if (tid < 192) {
            const int e = tid; const float ve = bf2f(pr[1536 + h * 192 + e]);
            const float* C0 = p.in[I_SC] + sidx * 192 * 192; float* C1 = p.out + O_SC + sidx * 192 * 192;
            float num = 0.f, den = 0.f;
            for (int d = 0; d < 192; ++d) {
                const float c = a * C0[d * 192 + e] + bb * ks[d] * ve; C1[d * 192 + e] = c; num += qs[d] * c;
                const float nd = a * n0s[d] + bb * ks[d]; den += qs[d] * nd;
            }
            HR[(size_t)row * 768 + h * 192 + e] = num / fmaxf(fabsf(den), expf(-m_new));
            p.out[O_SN + sidx * 192 + e] = a * n0s[e] + bb * ks[e];
        }
        if (tid == 0) p.out[O_SM + sidx] = m_new;
    }
}
__device__ __forceinline__ void ph_mlstm_fin(const Params& p, int l) {
    const bf16_t* P = (const bf16_t*)(p.ws + B_P16); const float* HR = (const float*)(p.ws + B_HRAW); bf16_t* CATB = (bf16_t*)(p.ws + B_CATB); const float* g = p.in[I_GHN] + l * 192;
    const int tid_ = ltid(); const int lane = tid_ & 63, wid = tid_ >> 6;
    for (int row = blockIdx.x * NW_ + wid; row < MA; row += gridDim.x * NW_) {
        float v[4][3]; bf16_t og[4][3];
#pragma unroll
        for (int h = 0; h < 4; ++h)
#pragma unroll
            for (int i = 0; i < 3; ++i) { v[h][i] = HR[(size_t)row * 768 + h * 192 + lane + 64 * i]; og[h][i] = P[(size_t)row * LDA_ + 2304 + h * 192 + lane + 64 * i]; }
#pragma unroll
        for (int h = 0; h < 4; ++h) { float ss = v[h][0] * v[h][0] + v[h][1] * v[h][1] + v[h][2] * v[h][2]; ss = wave_sum(ss); const float rs = rsqrtf(ss * (1.0f / 192) + EPS);
#pragma unroll
            for (int i = 0; i < 3; ++i) { const int d = lane + 64 * i; CATB[(size_t)row * DM + h * 192 + d] = (bf16_t)f2bf(sigmoidf_(bf2f(og[h][i])) * (v[h][i] * rs * g[d])); } }
    }
}
__device__ __forceinline__ void ph_mem_attn(const Params& p, int l) {
    const int ldp = l < 2 ? LDA_ : LDB_, qoff = l < 2 ? 3072 : 768;
    const bf16_t* P = (const bf16_t*)(p.ws + B_P16); bf16_t* CATB = (bf16_t*)(p.ws + B_CATB); const float* gq = p.in[I_GMEMQ] + l * 64;
    for (int idx4 = blockIdx.x * NT_ + ltid(); idx4 < 16 * MA; idx4 += gridDim.x * NT_) {
        const int part = idx4 & 3, idx = idx4 >> 2;
        const int hh = idx / MA, row = idx % MA;
        const float* kvb = row < MP ? p.out + O_PMEM + (size_t)(l * 8 + row / SP) * 256 * 512 : p.in[I_CMEM] + (size_t)(l * 128 + (row - MP)) * 256 * 512;
        float q[16]; float ss = 0.f;
        const uint4* qp = (const uint4*)(P + (size_t)row * ldp + qoff + hh * 64 + part * 16);
#pragma unroll
        for (int i = 0; i < 2; ++i) { const uint4 t = qp[i]; q[8 * i] = bflo(t.x); q[8 * i + 1] = bfhi(t.x); q[8 * i + 2] = bflo(t.y); q[8 * i + 3] = bfhi(t.y); q[8 * i + 4] = bflo(t.z); q[8 * i + 5] = bfhi(t.z); q[8 * i + 6] = bflo(t.w); q[8 * i + 7] = bfhi(t.w); }
#pragma unroll
        for (int i = 0; i < 16; ++i) ss += q[i] * q[i];
        ss += __shfl_xor(ss, 1); ss += __shfl_xor(ss, 2);
        const float rs = rsqrtf(ss * (1.0f / 64) + EPS) * 0.125f;
#pragma unroll
        for (int i = 0; i < 16; ++i) q[i] *= rs * gq[part * 16 + i];
        float mx = -3e38f, den = 0.f; float o[16];
#pragma unroll
        for (int i = 0; i < 16; ++i) o[i] = 0.f;
        for (int m = 0; m < 256; ++m) {
            const float4* kp = (const float4*)(kvb + (size_t)m * 512 + hh * 64 + part * 16); const float4* vp = (const float4*)(kvb + (size_t)m * 512 + 256 + hh * 64 + part * 16);
            float s = 0.f;
#pragma unroll
            for (int i = 0; i < 4; ++i) { const float4 t = kp[i]; s += q[4 * i] * t.x + q[4 * i + 1] * t.y + q[4 * i + 2] * t.z + q[4 * i + 3] * t.w; }
            s += __shfl_xor(s, 1); s += __shfl_xor(s, 2);
            const float mn = fmaxf(mx, s); const float sc = expf(mx - mn), e = expf(s - mn); mx = mn; den = den * sc + e;
#pragma unroll
            for (int i = 0; i < 4; ++i) { const float4 t = vp[i]; o[4 * i] = o[4 * i] * sc + e * t.x; o[4 * i + 1] = o[4 * i + 1] * sc + e * t.y; o[4 * i + 2] = o[4 * i + 2] * sc + e * t.z; o[4 * i + 3] = o[4 * i + 3] * sc + e * t.w; }
        }
        const float inv = 1.0f / den; uint4* op = (uint4*)(CATB + (size_t)row * DM + 768 + hh * 64 + part * 16);
#pragma unroll
        for (int i = 0; i < 2; ++i) op[i] = make_uint4(pk2(o[8 * i] * inv, o[8 * i + 1] * inv), pk2(o[8 * i + 2] * inv, o[8 * i + 3] * inv), pk2(o[8 * i + 4] * inv, o[8 * i + 5] * inv), pk2(o[8 * i + 6] * inv, o[8 * i + 7] * inv));
    }
}
__device__ __forceinline__ void rows_post_tile(const Params& p, int row0, int t) {
    float* KVR = (float*)(p.ws + B_KVR); const int tid_ = ltid(); const int lane = tid_ & 63, wid = tid_ >> 6;
    const int c2 = lane >> 5, gg = (lane >> 4) & 1, d = (lane & 15) * 4; bf16_t* KVB = (bf16_t*)(p.ws + B_KVB); const size_t KT = (size_t)BP * 2 * SP * 64;
#pragma unroll 1
    for (int rr0 = wid; rr0 < 256; rr0 += 4 * NW_) {
      float4 vv[4];
#pragma unroll
      for (int k = 0; k < 4; ++k) { const int rowk = row0 + rr0 + k * NW_; vv[k] = ((const float4*)(KVR + (size_t)(rowk < MA ? rowk : MA - 1) * 768 + t * 256))[lane]; }
#pragma unroll
      for (int k = 0; k < 4; ++k) {
        const int row = row0 + rr0 + k * NW_; if (row >= MA) continue;
        float* r = KVR + (size_t)row * 768 + t * 256;
        float4 v = vv[k];
        if (t >= 1) {
            float ss = dot4(v, v);
            ss += __shfl_xor(ss, 1); ss += __shfl_xor(ss, 2); ss += __shfl_xor(ss, 4); ss += __shfl_xor(ss, 8);
            if (lane < 32) { const float rs = rsqrtf(ss * (1.0f / 64) + EPS); const float4 gk = ((const float4*)(t == 1 ? p.in[I_GKSLC] : p.in[I_GKWIN]))[lane & 15];
                v.x *= rs * gk.x; v.y *= rs * gk.y; v.z *= rs * gk.z; v.w *= rs * gk.w;
                if (row >= MP) ((float4*)r)[lane] = v; }
        }
        if (row < MP) {
            const int b = row / SP, sp = row % SP; const size_t off = (((size_t)b * 2 + gg) * SP + sp) * 64 + d;
            if (t == 0) { ((float4*)(p.out + O_PCMP + (size_t)row * 256))[lane] = v; *(uint2*)(KVB + (0 + c2) * KT + off) = make_uint2(pk2(v.x, v.y), pk2(v.z, v.w)); }
            else if (t == 2) { if (sp >= SP - 512) ((float4*)(p.out + O_PWIN + (size_t)(b * 512 + sp - (SP - 512)) * 256))[lane] = v; *(uint2*)(KVB + (4 + c2) * KT + off) = make_uint2(pk2(v.x, v.y), pk2(v.z, v.w)); }
            else {
                ((float4*)(p.out + O_PSLC + (size_t)row * 256))[lane] = v;
                const size_t blkbase = (((size_t)b * 2 + gg) * 32 + (sp >> 6)) * 4096;
                if (c2 == 0) { const int nt = (sp >> 4) & 3, fr2 = sp & 15, ks = d >> 5, fg2 = (d >> 3) & 3, e = d & 7;
                    *(uint2*)((bf16_t*)(p.ws + B_SKF) + blkbase + (size_t)(((nt * 2 + ks) * 64 + fg2 * 16 + fr2) * 8 + e)) = make_uint2(pk2(v.x, v.y), pk2(v.z, v.w)); }
                else { const int cs = (sp >> 5) & 1, kk = sp & 31, fg2 = (kk & 15) >> 2, e = (kk & 3) + (kk >= 16 ? 4 : 0), dt = d >> 4, fr2 = d & 15;
                    bf16_t* vf = (bf16_t*)(p.ws + B_SVF) + blkbase + (size_t)(((dt * 2 + cs) * 64 + fg2 * 16 + fr2) * 8 + e);
                    vf[0] = (bf16_t)f2bf(v.x); vf[8] = (bf16_t)f2bf(v.y); vf[16] = (bf16_t)f2bf(v.z); vf[24] = (bf16_t)f2bf(v.w); } }
        } else {
            const int b = row - MP;
            if (t == 0) ((float4*)(p.out + O_SCMP + (size_t)b * 256))[lane] = v; else if (t == 1) ((float4*)(p.out + O_SSLC + (size_t)b * 256))[lane] = v;
            else ((float4*)(p.out + O_SWIN + (size_t)(b * 512 + 511) * 256))[lane] = v;
        }
      }
    }
}
__device__ __forceinline__ float gelu_tanh(float x) { return 0.5f * x * (1.0f + tanhf(0.7978845608028654f * (x + 0.044715f * x * x * x))); }
__device__ __forceinline__ void ph_compress(const Params& p, float* lds) {
    const float* KVR = (const float*)(p.ws + B_KVR); const int tid = ltid();
    float* xs = lds;
    float* hs = lds + 4096;
    const float* w1 = p.in[I_CW1]; const float* w2 = p.in[I_CW2]; const int* pt = (const int*)p.in[I_PT];
    for (int item = blockIdx.x; item < 136 * 127 * 2; item += gridDim.x) {
        const int c = item & 1, n = (item >> 1) % 127, bb = (item >> 1) / 127;
        __syncthreads();
        for (int i = tid; i < 4096; i += NT_) {
            const int g = i >> 11, pp = (i >> 6) & 31, d = i & 63; const int tok = 16 * n + pp; float x;
            if (bb < 8) x = KVR[(size_t)(bb * SP + tok) * 768 + c * 128 + g * 64 + d];
            else { const int b = bb - 8; const int phys = pt[b * 16 + (tok >> 7)]; x = p.in[I_CCMP][((size_t)phys * 128 + (tok & 127)) * 256 + c * 128 + g * 64 + d]; }
            xs[i] = x + p.in[I_CPOS][(pp * 2 + c) * 64 + d];
        }
        __syncthreads();
        if (tid < 256) { const int g = tid >> 7, h = tid & 127; float pre = p.in[I_CB1][c * 128 + h]; const float* wp = w1 + (size_t)c * 2048 * 128 + h; const float* xp = xs + g * 2048;
          for (int i = 0; i < 2048; ++i) pre = fmaf(xp[i], wp[(size_t)i * 128], pre);
          hs[g * 128 + h] = gelu_tanh(pre); }
        __syncthreads();
        if (tid < 128) {
            const int g = tid >> 6, d = tid & 63; float o = p.in[I_CB2][c * 64 + d];
            for (int h = 0; h < 128; ++h) o = fmaf(hs[g * 128 + h], w2[(size_t)(c * 128 + h) * 64 + d], o);
            if (c == 0) { const float ss = wave_sum(o * o); o = o * rsqrtf(ss * (1.0f / 64) + EPS) * p.in[I_GKCMP][d]; }
            ((float*)(p.ws + (c == 0 ? B_CK : B_CV)))[((size_t)bb * 127 + n) * 128 + g * 64 + d] = o;
            bf16_t* kc = (bf16_t*)(p.ws + B_KC16) + ((((size_t)bb * 2 + c) * 2 + g) * 128 + n) * 64 + d; kc[0] = (bf16_t)f2bf(o); if (n == 126) kc[64] = 0;
        }
    }
}
#ifndef NSA_NAIVE_ALL
#define NSA_NAIVE_ALL 0
#endif
__device__ __forceinline__ void row_softmax(float* r, int n, int lane) {
    float mx = NEGM;
    for (int i = lane; i < n; i += 64) mx = fmaxf(mx, r[i]);
    mx = wave_max(mx);
    if (mx <= 0.5f * NEGM) { for (int i = lane; i < n; i += 64) r[i] = 0.f; return; }
    float s = 0.f;
    for (int i = lane; i < n; i += 64) { const float e = r[i] <= 0.5f * NEGM ? 0.f : expf(r[i] - mx); r[i] = e; s += e; }
    s = wave_sum(s); const float inv = 1.0f / s;
    for (int i = lane; i < n; i += 64) r[i] *= inv;
}
__device__ __forceinline__ void ph_nsa(const Params& p, int j, float* lds) {
    const int tid = ltid(), lane = tid & 63, wid = tid >> 6;
    float* qs = lds;
    float* sc = lds + 384;
    float* imp = sc + 3072;
    int* sel = (int*)(imp + 40);
    float* gate = (float*)(sel + 8);
    float* oacc = gate + 24;
    const bf16_t* P = (const bf16_t*)(p.ws + B_P16); const float* GT = (const float*)(p.ws + B_GT); const float* KVR = (const float*)(p.ws + B_KVR); bf16_t* CATB = (bf16_t*)(p.ws + B_CATB);
    const float* table = p.in[I_REL]; const int* pt = (const int*)p.in[I_PT];
    for (int item = blockIdx.x; item < (NSA_NAIVE_ALL ? MA : BS) * 2; item += gridDim.x) {
        const int row = (NSA_NAIVE_ALL ? 0 : MP) + (item >> 1), g = item & 1; const bool smp = row >= MP;
        const int b = smp ? row - MP : row / SP, pos = smp ? PAST : row % SP;
        const bf16_t* pr = P + (size_t)row * LDB_;
        __syncthreads();
        if (wid < 6) { const int z = wid; const float v = bf2f(pr[(g * 6 + z) * 64 + lane]); const float ss = wave_sum(v * v); qs[z * 64 + lane] = v * rsqrtf(ss * (1.0f / 64) + EPS) * p.in[I_GQ][j * 64 + lane]; }
        if (tid >= 384 && tid < 384 + 18) { const int t2 = tid - 384; const int br = t2 / 6, z = t2 % 6; gate[t2] = sigmoidf_(GT[(size_t)row * GTW + br * 12 + g * 6 + z] + p.in[I_BGATE][j * 36 + br * 12 + g * 6 + z]); }
        if (tid < 384) oacc[tid] = 0.f;
        __syncthreads();
        const float* ck = (const float*)(p.ws + B_CK) + (size_t)(smp ? 8 + b : b) * 127 * 128; const float* cv = (const float*)(p.ws + B_CV) + (size_t)(smp ? 8 + b : b) * 127 * 128;
        for (int i = tid; i < 6 * 127; i += NT_) {
            const int z = i / 127, n = i % 127; const int dist = pos - (16 * n + 31); float s = NEGM;
            if (dist >= 0) { const float4* kp = (const float4*)(ck + n * 128 + g * 64); const float4* qp = (const float4*)(qs + z * 64); float a = 0.f;
#pragma unroll 4
                for (int d = 0; d < 16; ++d) a += dot4(kp[d], qp[d]);
                s = a * 0.125f + table[rel_bucket(dist) * 12 + g * 6 + z]; }
            sc[z * 128 + n] = s;
        }
        __syncthreads();
        if (wid < 6) row_softmax(sc + wid * 128, 127, lane);
        __syncthreads();
        const int nslc = smp ? 33 : 32, cur = pos >> 6;
        if (tid < nslc) { const int jb = tid; float s = 0.f;
            for (int z = 0; z < 6; ++z) for (int n = 0; n < 127; ++n) { const int lo = max(16 * n, 64 * jb), hi = min(16 * n + 32, 64 * jb + 64); if (hi > lo) s += sc[z * 128 + n] * (float)(hi - lo) * (1.0f / 16); }
            imp[jb] = s; }
        __syncthreads();
        if (tid == 0) {
            int cnt = 0;
            if (cur + 1 <= 8) { for (int jb = 0; jb <= cur; ++jb) sel[cnt++] = jb; }
            else {
                sel[0] = 0; sel[1] = cur; sel[2] = cur - 1; cnt = 3; unsigned long long taken = 0ull;
                for (int k = 0; k < 5; ++k) { int best = -1; float bv = -1.f;
                    for (int jb = 1; jb <= cur - 2; ++jb) if (!((taken >> jb) & 1ull) && imp[jb] > bv) { bv = imp[jb]; best = jb; }
                    if (best >= 0) { taken |= 1ull << best; sel[cnt++] = best; } }
            }
            for (; cnt < 8; ++cnt) sel[cnt] = -1;
        }
        if (tid < 384) { const int z = tid >> 6, d = tid & 63; float o = 0.f;
            for (int n = 0; n < 127; ++n) o = fmaf(sc[z * 128 + n], cv[n * 128 + g * 64 + d], o);
            oacc[tid] += gate[0 * 6 + z] * o; }
        __syncthreads();
        for (int br = 1; br <= 2; ++br) {
            { const int t = tid;
                const float* kp = nullptr; int dist = -1;
                if (br == 1) {
                    const int blk = sel[t >> 6];
                    if (blk >= 0) { const int tok = blk * 64 + (t & 63); dist = pos - tok;
                        if (dist >= 0) { if (!smp) kp = KVR + (size_t)(b * SP + tok) * 768 + 256 + g * 64;
                            else if (tok < PAST) kp = p.in[I_CSLC] + ((size_t)pt[b * 16 + (tok >> 7)] * 128 + (tok & 127)) * 256 + g * 64;
                            else kp = KVR + (size_t)row * 768 + 256 + g * 64; } }
                } else {
                    const int kpos = pos - 511 + t; dist = 511 - t;
                    if (!smp) { if (kpos >= 0) kp = KVR + (size_t)(b * SP + kpos) * 768 + 512 + g * 64; else dist = -1; }
                    else { if (kpos < PAST) kp = p.in[I_CWIN] + ((size_t)b * 512 + (kpos - (PAST - 512))) * 256 + g * 64; else kp = KVR + (size_t)row * 768 + 512 + g * 64; }
                }
                if (dist >= 0 && kp) {
                    float s[6] = {0.f, 0.f, 0.f, 0.f, 0.f, 0.f};
#pragma unroll 2
                    for (int d = 0; d < 16; ++d) { const float4 kk = ((const float4*)kp)[d];
#pragma unroll
                        for (int z = 0; z < 6; ++z) s[z] += dot4(kk, ((const float4*)(qs + z * 64))[d]); }
                    const int bk = rel_bucket(dist);
#pragma unroll
                    for (int z = 0; z < 6; ++z) sc[z * 512 + t] = s[z] * 0.125f + table[bk * 12 + g * 6 + z];
                } else {
#pragma unroll
                    for (int z = 0; z < 6; ++z) sc[z * 512 + t] = NEGM;
                }
            }
            __syncthreads();
            if (wid < 6) row_softmax(sc + wid * 512, 512, lane);
            __syncthreads();
            if (tid < 384) { const int z = tid >> 6, d = tid & 63; float o = 0.f;
                for (int t = 0; t < 512; ++t) { const float pw = sc[z * 512 + t]; if (pw != 0.f) { const float* vp;
                    if (br == 1) { const int tok = sel[t >> 6] * 64 + (t & 63);
                        if (!smp) vp = KVR + (size_t)(b * SP + tok) * 768 + 256 + 128 + g * 64;
                        else if (tok < PAST) vp = p.in[I_CSLC] + ((size_t)pt[b * 16 + (tok >> 7)] * 128 + (tok & 127)) * 256 + 128 + g * 64;
                        else vp = KVR + (size_t)row * 768 + 256 + 128 + g * 64;
                    } else { const int kpos = pos - 511 + t;
                        if (!smp) vp = KVR + (size_t)(b * SP + kpos) * 768 + 512 + 128 + g * 64;
                        else if (kpos < PAST) vp = p.in[I_CWIN] + ((size_t)b * 512 + (kpos - (PAST - 512))) * 256 + 128 + g * 64;
                        else vp = KVR + (size_t)row * 768 + 512 + 128 + g * 64; }
                    o = fmaf(pw, vp[d], o); } }
                oacc[tid] += gate[br * 6 + z] * o; }
            __syncthreads();
        }
        if (tid < 384) CATB[(size_t)row * DM + g * 384 + tid] = (bf16_t)f2bf(oacc[tid]);
    }
}
constexpr size_t KVB_T = (size_t)BP * 2 * SP * 64;
typedef short v4i16_t __attribute__((ext_vector_type(4)));
typedef short bf16x8_t __attribute__((ext_vector_type(8)));
typedef float f32x4_t __attribute__((ext_vector_type(4)));
typedef unsigned u32x4_t __attribute__((ext_vector_type(4)));
__device__ __forceinline__ bf16x8_t ldtr2(const LAS unsigned char* p0, const LAS unsigned char* p1) {
    const v4i16_t a = __builtin_amdgcn_ds_read_tr16_b64_v4i16((LAS v4i16_t*)p0), b = __builtin_amdgcn_ds_read_tr16_b64_v4i16((LAS v4i16_t*)p1);
    return __builtin_shufflevector(a, b, 0, 1, 2, 3, 4, 5, 6, 7);
}
__device__ __forceinline__ unsigned cvtpk(float lo, float hi) { unsigned r; asm volatile("v_cvt_pk_bf16_f32 %0, %1, %2" : "=v"(r) : "v"(lo), "v"(hi)); return r; }
__device__ __forceinline__ bf16x8_t pack8(f32x4_t a, f32x4_t b) { uint4 w; w.x = cvtpk(a[0], a[1]); w.y = cvtpk(a[2], a[3]); w.z = cvtpk(b[0], b[1]); w.w = cvtpk(b[2], b[3]); return __builtin_bit_cast(bf16x8_t, w); }
__device__ __forceinline__ f32x4_t mfma16(bf16x8_t a, bf16x8_t b, f32x4_t c) { return __builtin_amdgcn_mfma_f32_16x16x32_bf16(a, b, c, 0, 0, 0); }
__device__ __forceinline__ float ex2(float x) { return __builtin_amdgcn_exp2f(x); }
__device__ __forceinline__ float xmax4(float v) { v = fmaxf(v, __shfl_xor(v, 16)); return fmaxf(v, __shfl_xor(v, 32)); }
__device__ __forceinline__ float xsum4(float v) { v += __shfl_xor(v, 16); return v + __shfl_xor(v, 32); }
constexpr float LOG2E = 1.4426950408889634f, NINF = -__builtin_inff();
constexpr int KROW = 144;

__device__ __forceinline__ void ph_nsa_fast(const Params& p, int j, LAS unsigned char* lds) {
    const int tid = ltid(), lane0 = tid & 63, w = tid >> 6;
    unsigned char* ws = p.ws;
    const bf16_t* P16 = (const bf16_t*)(ws + B_P16); const float* GT = (const float*)(ws + B_GT); bf16_t* CATB = (bf16_t*)(ws + B_CATB);
    const bf16_t* KVB = (const bf16_t*)(ws + B_KVB); const bf16_t* KC16 = (const bf16_t*)(ws + B_KC16);
    LAS unsigned char* Kw = lds;
    LAS unsigned char* Vw = lds + 18432;
    LAS unsigned char* Kc = lds + 36864;
    LAS unsigned char* Vc = lds + 55296;
    LAS float* biasT = (LAS float*)(lds + 73728);
    LAS float* impL = (LAS float*)(lds + 73728 + 3072);
    LAS int* selL = (LAS int*)(lds + 73728 + 3072 + 16384);
    const float* table = p.in[I_REL]; const float* gq = p.in[I_GQ] + j * 64; const float* bgate = p.in[I_BGATE] + j * 36;
    for (int unit = blockIdx.x; unit < 256; unit += gridDim.x) {
        int lane_a = lane0; asm volatile("" : "+v"(lane_a)); const int lane = lane_a, fr = lane & 15, fg = lane >> 4;
        const int g = unit & 1, b = (unit >> 1) & 7, tile = unit >> 4, t0 = tile * 128, tw = t0 + 16 * w, trow = tw + fr;
        TSUB_BEGIN();
        __syncthreads();
        for (int i = tid; i < 2048; i += NT_) { const int tsel = i >> 10, r = (i >> 3) & 127, ch = i & 7;
            const u32x4_t v = *(const u32x4_t*)(KC16 + (((size_t)b * 2 + tsel) * 2 + g) * 128 * 64 + r * 64 + ch * 8);
            *(LAS u32x4_t*)((tsel ? Vc : Kc) + r * KROW + ch * 16) = v; }
        for (int i = tid; i < 768; i += NT_) { const int d = i / 6, z = i % 6; biasT[i] = table[rel_bucket_alu(d) * 12 + g * 6 + z] * LOG2E; }
        if (tid < 64) ((LAS float*)(lds + 73728 + 3072 + 16384 + 4096))[tid] = gq[tid] * (0.125f * LOG2E);
        __syncthreads();
        const bf16_t* qrow = P16 + (size_t)(b * SP + trow) * LDB_ + g * 384;
        LAS float* gqL = (LAS float*)(lds + 73728 + 3072 + 16384 + 4096);
#define FETCH_Q(z_, ra_, rb_) do { ra_ = *(const uint4*)(qrow + (z_) * 64 + fg * 8); rb_ = *(const uint4*)(qrow + (z_) * 64 + 32 + fg * 8); } while (0)
#define LOAD_Q(z_, q0_, q1_) do { uint4 r0, r1; FETCH_Q(z_, r0, r1); FINISH_Q(r0, r1, q0_, q1_); } while (0)
#define FINISH_Q(r0, r1, q0_, q1_) do { \
            float v[16] = {bflo(r0.x), bfhi(r0.x), bflo(r0.y), bfhi(r0.y), bflo(r0.z), bfhi(r0.z), bflo(r0.w), bfhi(r0.w), bflo(r1.x), bfhi(r1.x), bflo(r1.y), bfhi(r1.y), bflo(r1.z), bfhi(r1.z), bflo(r1.w), bfhi(r1.w)}; \
            float ss = 0.f; _Pragma("unroll") for (int i = 0; i < 16; ++i) ss += v[i] * v[i]; \
            ss = xsum4(ss); const float rs = rsqrtf(ss * (1.0f / 64) + EPS); { const f32x4_t g0 = *(const LAS f32x4_t*)(gqL + fg * 8), g1 = *(const LAS f32x4_t*)(gqL + fg * 8 + 4), g2 = *(const LAS f32x4_t*)(gqL + 32 + fg * 8), g3 = *(const LAS f32x4_t*)(gqL + 32 + fg * 8 + 4); \
              _Pragma("unroll") for (int i = 0; i < 4; ++i) { v[i] *= rs * g0[i]; v[4 + i] *= rs * g1[i]; v[8 + i] *= rs * g2[i]; v[12 + i] *= rs * g3[i]; } } \
            q0_ = pack8((f32x4_t){v[0], v[1], v[2], v[3]}, (f32x4_t){v[4], v[5], v[6], v[7]}); q1_ = pack8((f32x4_t){v[8], v[9], v[10], v[11]}, (f32x4_t){v[12], v[13], v[14], v[15]}); } while (0)
        const float* gtrow = GT + (size_t)(b * SP + trow) * GTW;
#pragma unroll 1
        for (int hp = 0; hp < 2; ++hp) {
        bf16x8_t qf[3][2];
#pragma unroll
        for (int z = 0; z < 3; ++z) LOAD_Q(hp * 3 + z, qf[z][0], qf[z][1]);
        f32x4_t O[3][4]; float mrun[3], lrun[3];
#pragma unroll
        for (int z = 0; z < 3; ++z) { mrun[z] = NINF; lrun[z] = 0.f;
#pragma unroll
            for (int dt = 0; dt < 4; ++dt) O[z][dt] = (f32x4_t){0.f, 0.f, 0.f, 0.f}; }
        const bf16_t* WK = KVB + 4 * KVB_T + ((size_t)b * 2 + g) * SP * 64; const bf16_t* WV = KVB + 5 * KVB_T + ((size_t)b * 2 + g) * SP * 64;
        u32x4_t rst[4];
#define WIN_LOAD(it_) do { const int k128_ = t0 - 512 + 128 * (it_); _Pragma("unroll") for (int q_ = 0; q_ < 4; ++q_) { const int i_ = tid + NT_ * q_, tsel_ = i_ >> 10, r_ = (i_ >> 3) & 127, ch_ = i_ & 7; const int tok_ = k128_ + r_; \
            rst[q_] = (u32x4_t){0u, 0u, 0u, 0u}; if (tok_ >= 0) rst[q_] = *(const u32x4_t*)((tsel_ ? WV : WK) + (size_t)tok_ * 64 + ch_ * 8); } } while (0)
#define WIN_STORE() do { _Pragma("unroll") for (int q_ = 0; q_ < 4; ++q_) { const int i_ = tid + NT_ * q_, tsel_ = i_ >> 10, r_ = (i_ >> 3) & 127, ch_ = i_ & 7; *(LAS u32x4_t*)((tsel_ ? Vw : Kw) + r_ * KROW + ch_ * 16) = rst[q_]; } } while (0)
        WIN_LOAD(0);
        __syncthreads();
        WIN_STORE();
#pragma unroll 1
        for (int it = 0; it < 5; ++it) {
            const int k128 = t0 - 512 + 128 * it;
            __syncthreads();
            if (it + 1 < 5) WIN_LOAD(it + 1);
#pragma unroll 1
            for (int sc = 0; sc < 4; ++sc) {
                const int kb = k128 + 32 * sc;
                if (kb > tw + 15 || kb + 31 < tw - 511 || kb + 31 < 0) continue;
                const bool fast = (kb + 31 <= tw - 113) && (kb >= tw + 15 - 511) && kb >= 0;
                bf16x8_t kf[2][2], vf[4];
#pragma unroll
                for (int nt = 0; nt < 2; ++nt)
#pragma unroll
                    for (int ks = 0; ks < 2; ++ks) kf[nt][ks] = *(const LAS bf16x8_t*)(Kw + (32 * sc + 16 * nt + fr) * KROW + (ks * 32 + fg * 8) * 2);
#pragma unroll
                for (int dt = 0; dt < 4; ++dt) { const LAS unsigned char* vp = Vw + (32 * sc + 4 * fg + (fr >> 2)) * KROW + (16 * dt + 4 * (fr & 3)) * 2; vf[dt] = ldtr2(vp, vp + 16 * KROW); }
#pragma unroll
                for (int z = 0; z < 3; ++z) {
                    f32x4_t s0 = (f32x4_t){0.f, 0.f, 0.f, 0.f}, s1 = s0;
                    s0 = mfma16(kf[0][0], qf[z][0], s0); s0 = mfma16(kf[0][1], qf[z][1], s0);
                    s1 = mfma16(kf[1][0], qf[z][0], s1); s1 = mfma16(kf[1][1], qf[z][1], s1);
                    if (fast) { const float cb = biasT[127 * 6 + hp * 3 + z]; s0 = s0 + cb; s1 = s1 + cb; }
                    else {
#pragma unroll
                        for (int jj = 0; jj < 4; ++jj) { const int key0 = kb + 4 * fg + jj, d0 = trow - key0, d1 = d0 - 16;
                            s0[jj] = (d0 >= 0 && d0 < 512 && key0 >= 0) ? s0[jj] + biasT[min(d0, 127) * 6 + hp * 3 + z] : NINF;
                            s1[jj] = (d1 >= 0 && d1 < 512 && key0 + 16 >= 0) ? s1[jj] + biasT[min(d1, 127) * 6 + hp * 3 + z] : NINF; }
                    }
                    float mx = fmaxf(fmaxf(fmaxf(s0[0], s0[1]), fmaxf(s0[2], s0[3])), fmaxf(fmaxf(s1[0], s1[1]), fmaxf(s1[2], s1[3])));
                    mx = xmax4(mx);
                    const float mnew = fmaxf(mrun[z], mx), msafe = mnew == NINF ? 0.f : mnew;
                    const float alpha = ex2(mrun[z] - msafe);
                    mrun[z] = mnew;
                    f32x4_t p0, p1;
#pragma unroll
                    for (int jj = 0; jj < 4; ++jj) { p0[jj] = ex2(s0[jj] - msafe); p1[jj] = ex2(s1[jj] - msafe); }
                    lrun[z] = lrun[z] * alpha + ((p0[0] + p0[1]) + (p0[2] + p0[3])) + ((p1[0] + p1[1]) + (p1[2] + p1[3]));
                    if (__any(alpha != 1.0f)) {
#pragma unroll
                        for (int dt = 0; dt < 4; ++dt) O[z][dt] = O[z][dt] * alpha; }
                    const bf16x8_t pf = pack8(p0, p1);
#pragma unroll
                    for (int dt = 0; dt < 4; ++dt) O[z][dt] = mfma16(vf[dt], pf, O[z][dt]);
                }
            }
            if (it + 1 < 5) { __syncthreads(); WIN_STORE(); }
        }
#undef WIN_LOAD
#undef WIN_STORE
#pragma unroll
        for (int z = 0; z < 3; ++z) { const int hz2 = hp * 3 + z; const float lt = xsum4(lrun[z]); const float gw = sigmoidf_(gtrow[24 + g * 6 + hz2] + bgate[24 + g * 6 + hz2]); const float sc = gw / lt;
            bf16_t* orow = CATB + (size_t)(b * SP + trow) * DM + (g * 6 + hz2) * 64;
#pragma unroll
            for (int dt = 0; dt < 4; ++dt) { const f32x4_t v = O[z][dt] * sc; *(uint2*)(orow + 16 * dt + 4 * fg) = make_uint2(cvtpk(v[0], v[1]), cvtpk(v[2], v[3])); } }
        }
        asm volatile("s_waitcnt vmcnt(0)" ::: "memory");
        TSUB_END(0);
        float impacc[8];
#pragma unroll
        for (int nt = 0; nt < 8; ++nt) impacc[nt] = 0.f;
        const int nmax = trow >= 31 ? (trow - 31) >> 4 : -1;
        uint4 rqa_c, rqb_c; FETCH_Q(0, rqa_c, rqb_c);
#pragma unroll 1
        for (int z = 0; z < 6; ++z) {
            bf16_t* orow = CATB + (size_t)(b * SP + trow) * DM + (g * 6 + z) * 64; unsigned long long oldc[4];
#pragma unroll
            for (int dt = 0; dt < 4; ++dt) oldc[dt] = __hip_atomic_load((unsigned long long*)(orow + 16 * dt + 4 * fg), __ATOMIC_RELAXED, __HIP_MEMORY_SCOPE_AGENT);
            const float gcraw = gtrow[g * 6 + z];
            f32x4_t s[8]; bf16x8_t qz[2]; { const uint4 ra = rqa_c, rb = rqb_c; if (z + 1 < 6) FETCH_Q(z + 1, rqa_c, rqb_c); FINISH_Q(ra, rb, qz[0], qz[1]); }
#pragma unroll
            for (int nt = 0; nt < 8; ++nt) { s[nt] = (f32x4_t){0.f, 0.f, 0.f, 0.f};
#pragma unroll
                for (int ks = 0; ks < 2; ++ks) { const bf16x8_t kf = *(const LAS bf16x8_t*)(Kc + (16 * nt + fr) * KROW + (ks * 32 + fg * 8) * 2); s[nt] = mfma16(kf, qz[ks], s[nt]); } }
            float mx = NINF;
#pragma unroll
            for (int nt = 0; nt < 8; ++nt)
#pragma unroll
                for (int jj = 0; jj < 4; ++jj) { const int n = 16 * nt + 4 * fg + jj; const int dist = trow - 16 * n - 31;
                    const float v = (n <= nmax && n <= 126) ? s[nt][jj] + biasT[min(dist, 127) * 6 + z] : NINF; s[nt][jj] = v; mx = fmaxf(mx, v); }
            asm volatile("" ::: "memory");
            mx = xmax4(mx); const float msafe = mx == NINF ? 0.f : mx; float sum = 0.f;
#pragma unroll
            for (int nt = 0; nt < 8; ++nt)
#pragma unroll
                for (int jj = 0; jj < 4; ++jj) { const float e = ex2(s[nt][jj] - msafe); s[nt][jj] = e; sum += e; }
            sum = xsum4(sum); const float inv = sum > 0.f ? 1.0f / sum : 0.f;
            float p3prev = 0.f;
#pragma unroll
            for (int nt = 0; nt < 8; ++nt) { s[nt] = s[nt] * inv;
                const float p3 = s[nt][3]; const float up = __shfl(p3, (lane + 48) & 63);
                const float prev_tile = __shfl(p3prev, (lane + 48) & 63);
                impacc[nt] += 2.0f * (s[nt][0] + s[nt][1] + s[nt][2]) + p3 + (fg == 0 ? prev_tile : up);
                p3prev = p3; }
            f32x4_t oc[4];
#pragma unroll
            for (int dt = 0; dt < 4; ++dt) oc[dt] = (f32x4_t){0.f, 0.f, 0.f, 0.f};
#pragma unroll
            for (int c2 = 0; c2 < 4; ++c2) { const bf16x8_t pf = pack8(s[2 * c2], s[2 * c2 + 1]);
#pragma unroll
                for (int dt = 0; dt < 4; ++dt) { const LAS unsigned char* vp = Vc + (32 * c2 + 4 * fg + (fr >> 2)) * KROW + (16 * dt + 4 * (fr & 3)) * 2; oc[dt] = mfma16(ldtr2(vp, vp + 16 * KROW), pf, oc[dt]); }
                asm volatile("" ::: "memory"); }
            const float gc = sigmoidf_(gcraw + bgate[g * 6 + z]);
#pragma unroll
            for (int dt = 0; dt < 4; ++dt) { const unsigned long long o64 = oldc[dt];
                const f32x4_t v = oc[dt] * gc + (f32x4_t){bflo((unsigned)o64), bfhi((unsigned)o64), bflo((unsigned)(o64 >> 32)), bfhi((unsigned)(o64 >> 32))};
                *(uint2*)(orow + 16 * dt + 4 * fg) = make_uint2(cvtpk(v[0], v[1]), cvtpk(v[2], v[3])); }
        }
        TSUB_END(1);
#pragma unroll
        for (int nt = 0; nt < 8; ++nt) impL[(w * 16 + fr) * 32 + 4 * nt + fg] = impacc[nt];
        asm volatile("s_waitcnt lgkmcnt(0)" ::: "memory");
        if (lane < 16) {
            const int t = tw + lane, cur = t >> 6; LAS int* so = selL + (w * 16 + lane) * 8; const LAS float* im = impL + (w * 16 + lane) * 32;
            int cnt = 0;
            if (cur + 1 <= 8) { for (int jb = 0; jb <= cur; ++jb) so[cnt++] = jb; }
            else { so[0] = 0; so[1] = cur; so[2] = cur - 1; cnt = 3; unsigned taken = 0u;
                for (int k = 0; k < 5; ++k) { int best = -1; float bv = -1.f;
                    for (int jb = 1; jb <= cur - 2; ++jb) { const float v = im[jb]; if (!((taken >> jb) & 1u) && v > bv) { bv = v; best = jb; } }
                    if (best >= 0) { taken |= 1u << best; so[cnt++] = best; } } }
            for (; cnt < 8; ++cnt) so[cnt] = -1;
        }
        asm volatile("s_waitcnt vmcnt(0) lgkmcnt(0)" ::: "memory");
        const bf16_t* SKF = (const bf16_t*)(ws + B_SKF) + ((size_t)b * 2 + g) * 32 * 4096; const bf16_t* SVF = (const bf16_t*)(ws + B_SVF) + ((size_t)b * 2 + g) * 32 * 4096;
        const int c0 = 2 * tile;
        TSUB_END(2);
        __syncthreads();
        for (int i = tid; i < 4 * 1024; i += NT_) { const int slot = i >> 10, r = i & 1023; const int blk = slot == 0 ? 0 : c0 - 2 + slot;
            if (blk >= 0 && blk < 32) { const u32x4_t v = *(const u32x4_t*)((r < 512 ? SKF : SVF) + (size_t)blk * 4096 + (r & 511) * 8); *(LAS u32x4_t*)(lds + slot * 16384 + r * 16) = v; } }
        __syncthreads();
        { int lane_b = lane0; asm volatile("" : "+v"(lane_b)); const int lane = lane_b, fr = lane & 15, fg = lane >> 4;
        const int hz = fr < 6 ? fr : 5;
        uint4 rqa, rqb;
        { const bf16_t* qrow = P16 + ((size_t)b * SP + tw) * LDB_ + g * 384 + hz * 64; rqa = *(const uint4*)(qrow + fg * 8); rqb = *(const uint4*)(qrow + 32 + fg * 8); }
#pragma unroll 1
        for (int ti = 0; ti < 16; ++ti) {
            const int t = tw + ti; const size_t row = (size_t)b * SP + t;
            bf16x8_t qs[2];
            const uint4 r0 = rqa, r1 = rqb;
            if (ti + 1 < 16) { const bf16_t* qrow = P16 + (row + 1) * LDB_ + g * 384 + hz * 64; rqa = *(const uint4*)(qrow + fg * 8); rqb = *(const uint4*)(qrow + 32 + fg * 8); }
            bf16_t* orow = CATB + row * DM + (g * 6 + hz) * 64; unsigned long long oldv[4];
#pragma unroll
            for (int dt = 0; dt < 4; ++dt) oldv[dt] = __hip_atomic_load((unsigned long long*)(orow + 16 * dt + 4 * fg), __ATOMIC_RELAXED, __HIP_MEMORY_SCOPE_AGENT);
            const float graw = GT[row * GTW + 12 + g * 6 + hz];
            {
              float v[16] = {bflo(r0.x), bfhi(r0.x), bflo(r0.y), bfhi(r0.y), bflo(r0.z), bfhi(r0.z), bflo(r0.w), bfhi(r0.w), bflo(r1.x), bfhi(r1.x), bflo(r1.y), bfhi(r1.y), bflo(r1.z), bfhi(r1.z), bflo(r1.w), bfhi(r1.w)};
              float ss = 0.f;
#pragma unroll
              for (int i = 0; i < 16; ++i) ss += v[i] * v[i];
              ss = xsum4(ss); const float rs = rsqrtf(ss * (1.0f / 64) + EPS) * (0.125f * LOG2E);
#pragma unroll
              for (int i = 0; i < 8; ++i) { v[i] *= rs * gq[fg * 8 + i]; v[8 + i] *= rs * gq[32 + fg * 8 + i]; }
              qs[0] = pack8((f32x4_t){v[0], v[1], v[2], v[3]}, (f32x4_t){v[4], v[5], v[6], v[7]});
              qs[1] = pack8((f32x4_t){v[8], v[9], v[10], v[11]}, (f32x4_t){v[12], v[13], v[14], v[15]}); }
            f32x4_t os[4]; float ms = NINF, ls = 0.f;
#pragma unroll
            for (int dt = 0; dt < 4; ++dt) os[dt] = (f32x4_t){0.f, 0.f, 0.f, 0.f};
#define SLC_LOADK(KF, blk_) do { const int slot_ = (blk_) == 0 ? 0 : ((blk_) >= c0 - 1 ? (blk_) - c0 + 2 : -1); \
                if (slot_ >= 0) { const LAS unsigned char* fb_ = lds + slot_ * 16384 + lane * 16; \
                    _Pragma("unroll") for (int nt = 0; nt < 4; ++nt) _Pragma("unroll") for (int ks = 0; ks < 2; ++ks) KF[nt][ks] = *(const LAS bf16x8_t*)(fb_ + (nt * 2 + ks) * 1024); \
                } else { const bf16_t* kb_ = SKF + (size_t)(blk_) * 4096 + lane * 8; \
                    _Pragma("unroll") for (int nt = 0; nt < 4; ++nt) _Pragma("unroll") for (int ks = 0; ks < 2; ++ks) KF[nt][ks] = *(const bf16x8_t*)(kb_ + (nt * 2 + ks) * 512); } } while (0)
#define SLC_LOADV(VF, blk_) do { const int slot_ = (blk_) == 0 ? 0 : ((blk_) >= c0 - 1 ? (blk_) - c0 + 2 : -1); \
                if (slot_ >= 0) { const LAS unsigned char* fb_ = lds + slot_ * 16384 + lane * 16; \
                    _Pragma("unroll") for (int dt = 0; dt < 4; ++dt) _Pragma("unroll") for (int cs = 0; cs < 2; ++cs) VF[dt][cs] = *(const LAS bf16x8_t*)(fb_ + 8192 + (dt * 2 + cs) * 1024); \
                } else { const bf16_t* vb_ = SVF + (size_t)(blk_) * 4096 + lane * 8; \
                    _Pragma("unroll") for (int dt = 0; dt < 4; ++dt) _Pragma("unroll") for (int cs = 0; cs < 2; ++cs) VF[dt][cs] = *(const bf16x8_t*)(vb_ + (dt * 2 + cs) * 512); } } while (0)
#define SLC_COMPUTE(KF, VF, blk_, nblk_) do { const int tok0 = (blk_) * 64; f32x4_t s[4]; \
                _Pragma("unroll") for (int nt = 0; nt < 4; ++nt) { s[nt] = (f32x4_t){0.f, 0.f, 0.f, 0.f}; s[nt] = mfma16(KF[nt][0], qs[0], s[nt]); s[nt] = mfma16(KF[nt][1], qs[1], s[nt]); } \
                float mx = NINF; \
                if (tok0 + 63 <= t - 113) { const float cb = biasT[127 * 6 + hz]; \
                    _Pragma("unroll") for (int nt = 0; nt < 4; ++nt) { s[nt] = s[nt] + cb; mx = fmaxf(mx, fmaxf(fmaxf(s[nt][0], s[nt][1]), fmaxf(s[nt][2], s[nt][3]))); } } \
                else { _Pragma("unroll") for (int nt = 0; nt < 4; ++nt) _Pragma("unroll") for (int jj = 0; jj < 4; ++jj) { const int dist = t - (tok0 + 16 * nt + 4 * fg + jj); const float v = dist >= 0 ? s[nt][jj] + biasT[min(dist, 127) * 6 + hz] : NINF; s[nt][jj] = v; mx = fmaxf(mx, v); } } \
                mx = xmax4(mx); \
                const float mnew = fmaxf(ms, mx), msafe = mnew == NINF ? 0.f : mnew; const float alpha = ex2(ms - msafe); ms = mnew; \
                float sum = 0.f; \
                _Pragma("unroll") for (int nt = 0; nt < 4; ++nt) _Pragma("unroll") for (int jj = 0; jj < 4; ++jj) { const float e = ex2(s[nt][jj] - msafe); s[nt][jj] = e; sum += e; } \
                ls = ls * alpha + sum; \
                _Pragma("unroll") for (int dt = 0; dt < 4; ++dt) os[dt] = os[dt] * alpha; \
                _Pragma("unroll") for (int cs = 0; cs < 2; ++cs) { const bf16x8_t pf = pack8(s[2 * cs], s[2 * cs + 1]); \
                    _Pragma("unroll") for (int dt = 0; dt < 4; ++dt) os[dt] = mfma16(VF[dt][cs], pf, os[dt]); } \
                if ((nblk_) >= 0) SLC_LOADV(VF, nblk_); } while (0)
            const LAS int* sbl = selL + (w * 16 + ti) * 8; int nb = 0;
#pragma unroll
            for (int bi = 0; bi < 8; ++bi) nb += sbl[bi] >= 0 ? 1 : 0;
            bf16x8_t kfC[4][2], kfN[4][2], vfX[4][2];
            { const int b0 = sbl[0]; SLC_LOADK(kfN, b0); SLC_LOADV(vfX, b0); }
#pragma unroll 1
            for (int bi = 0; bi < nb; ++bi) {
                const int bA = sbl[bi], bB = bi + 1 < nb ? sbl[bi + 1] : -1;
#pragma unroll
                for (int nt = 0; nt < 4; ++nt) { kfC[nt][0] = kfN[nt][0]; kfC[nt][1] = kfN[nt][1]; }
                if (bB >= 0) SLC_LOADK(kfN, bB);
                SLC_COMPUTE(kfC, vfX, bA, bB);
            }
#undef SLC_LOADK
#undef SLC_LOADV
#undef SLC_COMPUTE
            const float lt = xsum4(ls);
            if (fr < 6) {
                const float gs = sigmoidf_(graw + bgate[12 + g * 6 + fr]); const float sc = lt > 0.f ? gs / lt : 0.f;
#pragma unroll
                for (int dt = 0; dt < 4; ++dt) { const unsigned long long o64 = oldv[dt]; const f32x4_t v = os[dt] * sc + (f32x4_t){bflo((unsigned)o64), bfhi((unsigned)o64), bflo((unsigned)(o64 >> 32)), bfhi((unsigned)(o64 >> 32))};
                    *(uint2*)(orow + 16 * dt + 4 * fg) = make_uint2(cvtpk(v[0], v[1]), cvtpk(v[2], v[3])); }
            }
        }
        }
        TSUB_END(3);
    }
}

constexpr int CW_P = 272, CW_BUF = 128 * CW_P;
template <bool SMP> __device__ __forceinline__ void compress_job(const Params& p, int bb, int c, int g, LAS unsigned char* lds) {
    const int tid = ltid(), lane = tid & 63, w = tid >> 6, fr = lane & 15, fg = lane >> 4, n = 16 * w + fr;
    unsigned char* ws = p.ws;
    const bf16_t* W1T = (const bf16_t*)(ws + B_W1T) + (size_t)c * 128 * 2048; const bf16_t* W2T = (const bf16_t*)(ws + B_W2T) + (size_t)c * 64 * 128;
    f32x4_t acc[8];
#pragma unroll
    for (int t = 0; t < 8; ++t) acc[t] = (f32x4_t){0.f, 0.f, 0.f, 0.f};
    const bf16_t* ap = (const bf16_t*)(ws + B_KVB) + (size_t)c * KVB_T + ((size_t)(SMP ? 0 : bb) * 2 + g) * SP * 64 + (size_t)n * 1024 + fg * 8;
    const float* pg0 = nullptr; const float* pg1 = nullptr; int tsplit = 0;
    if (SMP) { const int* pt = (const int*)p.in[I_PT] + (bb - 8) * 16; const int t0 = 16 * n > 2016 ? 2016 : 16 * n; const int pa = t0 >> 7, pb = (t0 + 31) >> 7;
        pg0 = p.in[I_CCMP] + (((size_t)pt[pa] * 128 + (t0 & 127)) * 4 + c * 2 + g) * 64 + fg * 8; tsplit = pb == pa ? 64 : 128 - (t0 & 127);
        pg1 = p.in[I_CCMP] + (((size_t)pt[pb] * 128) * 4 + c * 2 + g) * 64 + fg * 8 - (size_t)tsplit * 256; }
    u32x4_t rb[4]; bf16x8_t acur[4]; f32x4_t araw[SMP ? 8 : 1]; bf16x8_t anext[SMP ? 1 : 4];
#define CW_LOADB(st_) do { _Pragma("unroll") for (int i_ = 0; i_ < 4; ++i_) { const int ch_ = tid + NT_ * i_, r_ = ch_ >> 4, cc_ = ch_ & 15; rb[i_] = *(const u32x4_t*)(W1T + (size_t)r_ * 2048 + (st_) * 128 + cc_ * 8); } } while (0)
#define CW_STOREB(buf_) do { _Pragma("unroll") for (int i_ = 0; i_ < 4; ++i_) { const int ch_ = tid + NT_ * i_, r_ = ch_ >> 4, cc_ = ch_ & 15; *(LAS u32x4_t*)(lds + (buf_) * CW_BUF + r_ * CW_P + cc_ * 16) = rb[i_]; } } while (0)
#define CW_LOADA(st_) do { _Pragma("unroll") for (int u_ = 0; u_ < 4; ++u_) { const int s_ = (st_) * 4 + u_; \
        if (SMP) { const int tk_ = s_ >> 1; const float* src_ = (tk_ < tsplit ? pg0 : pg1) + (size_t)tk_ * 256 + (s_ & 1) * 32; araw[2 * u_] = *(const f32x4_t*)src_; araw[2 * u_ + 1] = *(const f32x4_t*)(src_ + 4); } \
        else anext[u_] = *(const bf16x8_t*)(ap + s_ * 32); } } while (0)
#define CW_TAKEA() do { _Pragma("unroll") for (int u_ = 0; u_ < 4; ++u_) { if (SMP) acur[u_] = pack8(araw[2 * u_], araw[2 * u_ + 1]); else acur[u_] = anext[u_]; } } while (0)
    __syncthreads();
    CW_LOADB(0); CW_LOADA(0); CW_STOREB(0); CW_TAKEA();
    __syncthreads();
#pragma unroll 1
    for (int st = 0; st < 16; ++st) {
        if (st + 1 < 16) { CW_LOADB(st + 1); CW_LOADA(st + 1); }
        const LAS unsigned char* bb_ = lds + (st & 1) * CW_BUF + fr * CW_P + fg * 16;
#pragma unroll
        for (int u = 0; u < 4; ++u)
#pragma unroll
            for (int t = 0; t < 8; ++t) acc[t] = mfma16(*(const LAS bf16x8_t*)(bb_ + t * 16 * CW_P + u * 64), acur[u], acc[t]);
        if (st + 1 < 16) { CW_STOREB((st + 1) & 1); CW_TAKEA(); }
        __syncthreads();
    }
#undef CW_LOADB
#undef CW_STOREB
#undef CW_LOADA
#undef CW_TAKEA
    const float* peb = (const float*)(ws + B_PEB) + c * 128;
#pragma unroll
    for (int t = 0; t < 8; ++t) { const f32x4_t pb = *(const f32x4_t*)(peb + 16 * t + 4 * fg);
#pragma unroll
        for (int j = 0; j < 4; ++j) { const float x = acc[t][j] + pb[j]; const float u2 = 1.5957691216057308f * (x + 0.044715f * x * x * x);
            const float th = 1.0f - 2.0f * __builtin_amdgcn_rcpf(1.0f + ex2(u2 * LOG2E)); acc[t][j] = 0.5f * x * (1.0f + th); } }
    f32x4_t o[4];
#pragma unroll
    for (int dt = 0; dt < 4; ++dt) o[dt] = (f32x4_t){0.f, 0.f, 0.f, 0.f};
#pragma unroll
    for (int ks = 0; ks < 4; ++ks) { const bf16x8_t gf = pack8(acc[2 * ks], acc[2 * ks + 1]);
#pragma unroll
        for (int dt = 0; dt < 4; ++dt) { const bf16_t* wp = W2T + (size_t)(16 * dt + fr) * 128 + 32 * ks + 4 * fg; const uint2 x0 = *(const uint2*)wp, x1 = *(const uint2*)(wp + 16);
            o[dt] = mfma16(__builtin_bit_cast(bf16x8_t, make_uint4(x0.x, x0.y, x1.x, x1.y)), gf, o[dt]); } }
    float ss = 0.f;
#pragma unroll
    for (int dt = 0; dt < 4; ++dt) { const f32x4_t b2 = *(const f32x4_t*)(p.in[I_CB2] + c * 64 + 16 * dt + 4 * fg); o[dt] = o[dt] + b2; ss += (o[dt][0] * o[dt][0] + o[dt][1] * o[dt][1]) + (o[dt][2] * o[dt][2] + o[dt][3] * o[dt][3]); }
    if (c == 0) { ss = xsum4(ss); const float rs = rsqrtf(ss * (1.0f / 64) + EPS);
#pragma unroll
        for (int dt = 0; dt < 4; ++dt) { const f32x4_t gk = *(const f32x4_t*)(p.in[I_GKCMP] + 16 * dt + 4 * fg); o[dt] = o[dt] * rs * gk; } }
    bf16_t* kc = (bf16_t*)(ws + B_KC16) + ((((size_t)bb * 2 + c) * 2 + g) * 128 + n) * 64;
    float* cf = (float*)(ws + (c == 0 ? B_CK : B_CV)) + ((size_t)bb * 127 + n) * 128 + g * 64;
#pragma unroll
    for (int dt = 0; dt < 4; ++dt) {
        if (n < 127) { *(f32x4_t*)(cf + 16 * dt + 4 * fg) = o[dt]; *(uint2*)(kc + 16 * dt + 4 * fg) = make_uint2(cvtpk(o[dt][0], o[dt][1]), cvtpk(o[dt][2], o[dt][3])); }
        else *(uint2*)(kc + 16 * dt + 4 * fg) = make_uint2(0u, 0u);
    }
}
__device__ __forceinline__ void ph_compress_fast(const Params& p, LAS unsigned char* lds) {
    for (int job = blockIdx.x; job < 544; job += gridDim.x) { const int jj = job < 512 ? job + 32 : job - 512; const int bb = jj >> 2, c = (jj >> 1) & 1, g = jj & 1;
        if (bb < 8) compress_job<false>(p, bb, c, g, lds); else compress_job<true>(p, bb, c, g, lds); }
}
constexpr int ML_QP = 400, ML_VP = 80, ML_WP = 112;
__device__ __forceinline__ void ph_mlstm_fast(const Params& p, int l, LAS unsigned char* lds) {
    const int tid = ltid(), lane = tid & 63, w = tid >> 6, fr = lane & 15, fg = lane >> 4;
    unsigned char* ws = p.ws;
    const bf16_t* P16 = (const bf16_t*)(ws + B_P16); const float* GT = (const float*)(ws + B_GT); const float* bif = p.in[I_BIF] + l * 8; float* HR = (float*)(ws + B_HRAW);
    LAS unsigned char* Ql = lds;
    LAS unsigned char* Kl = lds + 25600;
    LAS unsigned char* Vl = lds + 51200;
    LAS unsigned char* Wl = lds + 56320;
    LAS unsigned char* CT = lds + 63488;
    LAS float* INTER = (LAS float*)(lds + 82688);
    LAS float* QN = (LAS float*)(lds + 91904);
    LAS float* RTa = (LAS float*)(lds + 92160);
    LAS float* WSa = RTa + 2048;
    LAS float* EIa = RTa + 4096;
    LAS float* DEC = RTa + 6144;
    LAS float* Gk = DEC + 32; LAS float* Ak = DEC + 64; LAS float* MPk = DEC + 96;
    for (int unit = blockIdx.x; unit < 192; unit += gridDim.x) {
        const int es = unit % 6, h = (unit / 6) & 3, b = unit / 24;
        const size_t row0 = (size_t)b * SP;
        __syncthreads();
        for (int i = tid; i < 48 * 100; i += NT_) ((LAS unsigned*)CT)[i] = 0u;
        for (int i = tid; i < 64 * 28; i += NT_) ((LAS unsigned*)Wl)[i] = 0u;
        float gia[4], gfa[4];
#pragma unroll
        for (int q = 0; q < 4; ++q) { const float* g_ = GT + (row0 + 64 * (w + 8 * q) + lane) * GTW; gia[q] = g_[h]; gfa[q] = g_[4 + h]; }
#pragma unroll
        for (int q = 0; q < 4; ++q) { const int k = w + 8 * q; const float gi = gia[q] + bif[h], gf = gfa[q] + bif[4 + h];
            float bc = logsigmoidf_(gf);
#pragma unroll
            for (int o = 1; o < 64; o <<= 1) { const float t = __shfl_up(bc, o); if (lane >= o) bc += t; }
            const float u = gi - bc; float pm = u;
#pragma unroll
            for (int o = 1; o < 64; o <<= 1) { const float t = __shfl_up(pm, o); if (lane >= o) pm = fmaxf(pm, t); }
            EIa[k * 64 + lane] = bc; RTa[k * 64 + lane] = pm; WSa[k * 64 + lane] = u;
            if (lane == 63) { Gk[k] = bc; Ak[k] = pm; } }
        __syncthreads();
        if (tid == 0) { float m = NEGM; for (int k = 0; k < 32; ++k) { MPk[k] = m; m = Gk[k] + fmaxf(Ak[k], m); } MPk[32] = m; }
        __syncthreads();
#pragma unroll 1
        for (int k = w; k < 32; k += 8) { const float mp = MPk[k], M63 = fmaxf(Ak[k], mp); const float bc = EIa[k * 64 + lane], pm = RTa[k * 64 + lane], u = WSa[k * 64 + lane]; const float M = fmaxf(pm, mp);
            RTa[k * 64 + lane] = expf(M63 - M); WSa[k * 64 + lane] = expf(u - M63); EIa[k * 64 + lane] = expf(-(bc + M)); if (lane == 0) DEC[k] = expf(mp - M63); }
        f32x4_t cacc[5];
#pragma unroll
        for (int i = 0; i < 5; ++i) cacc[i] = (f32x4_t){0.f, 0.f, 0.f, 0.f};
        u32x4_t rq[3], rk[3], rv;
#define ML_LOAD(c_) do { const size_t rb_ = row0 + 64 * (c_); \
            _Pragma("unroll") for (int i_ = 0; i_ < 3; ++i_) { const int ch_ = tid + NT_ * i_, r_ = ch_ / 24, cc_ = ch_ % 24; const bf16_t* src_ = P16 + (rb_ + r_) * LDA_ + h * 192 + cc_ * 8; rq[i_] = *(const u32x4_t*)src_; rk[i_] = *(const u32x4_t*)(src_ + 768); } \
            if (tid < 256) { const int r_ = tid >> 2, cc_ = tid & 3; rv = *(const u32x4_t*)(P16 + (rb_ + r_) * LDA_ + 1536 + h * 192 + es * 32 + cc_ * 8); } } while (0)
#define ML_STORE(c_) do { \
            _Pragma("unroll") for (int i_ = 0; i_ < 3; ++i_) { const int ch_ = tid + NT_ * i_, r_ = ch_ / 24, cc_ = ch_ % 24; *(LAS u32x4_t*)(Ql + r_ * ML_QP + cc_ * 16) = rq[i_]; *(LAS u32x4_t*)(Kl + r_ * ML_QP + cc_ * 16) = rk[i_]; } \
            if (tid < 256) { const int r_ = tid >> 2, cc_ = tid & 3; *(LAS u32x4_t*)(Vl + r_ * ML_VP + cc_ * 16) = rv; const float wv_ = WSa[(c_) * 64 + r_]; \
                u32x4_t y_; y_.x = cvtpk(bflo(rv.x) * wv_, bfhi(rv.x) * wv_); y_.y = cvtpk(bflo(rv.y) * wv_, bfhi(rv.y) * wv_); y_.z = cvtpk(bflo(rv.z) * wv_, bfhi(rv.z) * wv_); y_.w = cvtpk(bflo(rv.w) * wv_, bfhi(rv.w) * wv_); \
                *(LAS u32x4_t*)(Wl + r_ * ML_WP + cc_ * 16) = y_; if (cc_ == 0) *(LAS bf16_t*)(Wl + r_ * ML_WP + 64) = (bf16_t)f2bf(wv_); } } while (0)
        ML_LOAD(0);
        __syncthreads();
        ML_STORE(0);
#pragma unroll 1
        for (int c = 0; c < 32; ++c) {
            __syncthreads();
            if (c + 1 < 32) ML_LOAD(c + 1);
            f32x4_t hin[2]; float rsum = 0.f;
            hin[0] = (f32x4_t){0.f, 0.f, 0.f, 0.f}; hin[1] = hin[0];
            if (w < 4) {
                const int tt = w;
                f32x4_t S[4];
#pragma unroll
                for (int st = 0; st < 4; ++st) { S[st] = (f32x4_t){0.f, 0.f, 0.f, 0.f};
                    if (st <= tt) {
#pragma unroll
                        for (int ks = 0; ks < 6; ++ks) { const bf16x8_t kf = *(const LAS bf16x8_t*)(Kl + (16 * st + fr) * ML_QP + (32 * ks + 8 * fg) * 2), qf = *(const LAS bf16x8_t*)(Ql + (16 * tt + fr) * ML_QP + (32 * ks + 8 * fg) * 2);
                            S[st] = mfma16(kf, qf, S[st]); }
                        const f32x4_t wv = *(const LAS f32x4_t*)(WSa + c * 64 + 16 * st + 4 * fg); S[st] = S[st] * wv;
                        if (st == tt) {
#pragma unroll
                            for (int jj = 0; jj < 4; ++jj) if (4 * fg + jj > fr) S[st][jj] = 0.f; }
                        rsum += (S[st][0] + S[st][1]) + (S[st][2] + S[st][3]);
                    } }
                rsum = xsum4(rsum);
#pragma unroll
                for (int kk = 0; kk < 2; ++kk) { if (2 * kk <= tt) { const bf16x8_t pf = pack8(S[2 * kk], S[2 * kk + 1]);
#pragma unroll
                    for (int et = 0; et < 2; ++et) { const LAS unsigned char* vp = Vl + (32 * kk + 4 * fg + (fr >> 2)) * ML_VP + (16 * et + 4 * (fr & 3)) * 2; hin[et] = mfma16(ldtr2(vp, vp + 16 * ML_VP), pf, hin[et]); } } }
            } else {
                const int tt = w - 4;
                f32x4_t I[3];
#pragma unroll
                for (int e3 = 0; e3 < 3; ++e3) { I[e3] = (f32x4_t){0.f, 0.f, 0.f, 0.f};
#pragma unroll
                    for (int ks = 0; ks < 6; ++ks) { const bf16x8_t cf = *(const LAS bf16x8_t*)(CT + (16 * e3 + fr) * ML_QP + (32 * ks + 8 * fg) * 2), qf = *(const LAS bf16x8_t*)(Ql + (16 * tt + fr) * ML_QP + (32 * ks + 8 * fg) * 2);
                        I[e3] = mfma16(cf, qf, I[e3]); } }
                *(LAS f32x4_t*)(INTER + (16 * tt + fr) * 36 + 4 * fg) = I[0]; *(LAS f32x4_t*)(INTER + (16 * tt + fr) * 36 + 16 + 4 * fg) = I[1];
                if (fg == 0) QN[16 * tt + fr] = I[2][0];
            }
            __syncthreads();
            const float decay = DEC[c];
            if (w < 4) {
                const int t = 16 * w + fr; const float r = RTa[c * 64 + t], einv = EIa[c * 64 + t], qn = QN[t];
                const float den = r * (rsum + decay * qn); const float inv = 1.0f / fmaxf(fabsf(den), einv);
                float* hp = HR + (row0 + 64 * c + t) * 768 + h * 192 + es * 32;
#pragma unroll
                for (int et = 0; et < 2; ++et) { const f32x4_t in2 = *(const LAS f32x4_t*)(INTER + t * 36 + 16 * et + 4 * fg); const f32x4_t num = (hin[et] + in2 * decay) * r; *(f32x4_t*)(hp + 16 * et + 4 * fg) = num * inv; }
            }
#pragma unroll
            for (int i = 0; i < 5; ++i) { const int idx = w + 8 * i; if (idx < 36) { const int dtile = idx / 3, et = idx % 3; cacc[i] = cacc[i] * decay;
#pragma unroll
                for (int ks = 0; ks < 2; ++ks) { const LAS unsigned char* kp = Kl + (32 * ks + 8 * fg + (fr >> 2)) * ML_QP + (16 * dtile + 4 * (fr & 3)) * 2; const LAS unsigned char* vp = Wl + (32 * ks + 8 * fg + (fr >> 2)) * ML_WP + (16 * et + 4 * (fr & 3)) * 2;
                    cacc[i] = mfma16(ldtr2(kp, kp + 4 * ML_QP), ldtr2(vp, vp + 4 * ML_WP), cacc[i]); } } }
            __syncthreads();
#pragma unroll
            for (int i = 0; i < 5; ++i) { const int idx = w + 8 * i; if (idx < 36) { const int dtile = idx / 3, et = idx % 3;
                typedef unsigned u32x2_t __attribute__((ext_vector_type(2))); u32x2_t wv; wv.x = cvtpk(cacc[i][0], cacc[i][1]); wv.y = cvtpk(cacc[i][2], cacc[i][3]);
                *(LAS u32x2_t*)(CT + (16 * et + fr) * ML_QP + (16 * dtile + 4 * fg) * 2) = wv; } }
            if (c + 1 < 32) ML_STORE(c + 1);
        }
#pragma unroll
        for (int i = 0; i < 5; ++i) { const int idx = w + 8 * i; if (idx < 36) { const int dtile = idx / 3, et = idx % 3;
            if (et < 2) { float* co = p.out + O_PC + ((size_t)((l * 8 + b) * 4 + h) * 192 + 16 * dtile + 4 * fg) * 192 + es * 32 + 16 * et + fr;
#pragma unroll
                for (int jj = 0; jj < 4; ++jj) co[(size_t)jj * 192] = cacc[i][jj]; }
            else if (es == 0 && fr == 0) { float* no = p.out + O_PN + (size_t)((l * 8 + b) * 4 + h) * 192 + 16 * dtile + 4 * fg;
#pragma unroll
                for (int jj = 0; jj < 4; ++jj) no[jj] = cacc[i][jj]; } } }
        if (es == 0 && tid == 0) p.out[O_PM + (l * 8 + b) * 4 + h] = MPk[32];
#undef ML_LOAD
#undef ML_STORE
    }
}
__device__ __forceinline__ void ph_mem_attn_fast(const Params& p, int l, LAS unsigned char* lds, int u0, int ucnt, int ustep) {
    const int tid = ltid(), lane0 = tid & 63, w = tid >> 6;
    const int ldp = l < 2 ? LDA_ : LDB_, qoff = l < 2 ? 3072 : 768;
    const bf16_t* P16 = (const bf16_t*)(p.ws + B_P16); bf16_t* CATB = (bf16_t*)(p.ws + B_CATB); const float* gq = p.in[I_GMEMQ] + l * 64;
    LAS unsigned char* Km = lds;
    LAS unsigned char* Vm = lds + 36864;
    const float* gmk = p.in[I_GMEMK] + l * 64;
    for (int ui = 0; ui < ucnt; ++ui) { const int unit = u0 + ui * ustep; if (unit >= 256) break;
        int lane_a = lane0; asm volatile("" : "+v"(lane_a)); const int lane = lane_a, fr = lane & 15, fg = lane >> 4;
        const int oct = unit & 7, hh = (unit >> 3) & 3, b = unit >> 5;
        const float* kv = (const float*)(p.ws + B_MEMR) + (size_t)(l * 8 + b) * 256 * 512 + hh * 64;
        __syncthreads();
        {
            f32x4_t x[16];
#pragma unroll
            for (int k = 0; k < 16; ++k) { const int i = tid + NT_ * k, tsel = i >> 12, m = (i >> 4) & 255, ch = i & 15; x[k] = *(const f32x4_t*)(kv + (size_t)m * 512 + tsel * 256 + ch * 4); }
#pragma unroll
            for (int k = 0; k < 16; ++k) { const int i = tid + NT_ * k, tsel = i >> 12, m = (i >> 4) & 255, ch = i & 15;
                if (k < 8) { float ss = (x[k][0] * x[k][0] + x[k][1] * x[k][1]) + (x[k][2] * x[k][2] + x[k][3] * x[k][3]);
                    ss += __shfl_xor(ss, 1); ss += __shfl_xor(ss, 2); ss += __shfl_xor(ss, 4); ss += __shfl_xor(ss, 8);
                    const float rs = rsqrtf(ss * (1.0f / 64) + EPS); const f32x4_t gk = *(const f32x4_t*)(gmk + ch * 4); x[k] = x[k] * rs * gk; }
                typedef unsigned u32x2_t __attribute__((ext_vector_type(2))); u32x2_t y; y.x = cvtpk(x[k][0], x[k][1]); y.y = cvtpk(x[k][2], x[k][3]);
                *(LAS u32x2_t*)((tsel ? Vm : Km) + m * KROW + ch * 8) = y; }
        }
        __syncthreads();
#pragma unroll 1
        for (int ps = 0; ps < 2; ++ps) {
            const size_t row = (size_t)b * SP + oct * 256 + ps * 128 + w * 16 + fr;
            bf16x8_t qf[2];
            { const bf16_t* qrow = P16 + row * ldp + qoff + hh * 64;
              const uint4 r0 = *(const uint4*)(qrow + fg * 8), r1 = *(const uint4*)(qrow + 32 + fg * 8);
              float v[16] = {bflo(r0.x), bfhi(r0.x), bflo(r0.y), bfhi(r0.y), bflo(r0.z), bfhi(r0.z), bflo(r0.w), bfhi(r0.w), bflo(r1.x), bfhi(r1.x), bflo(r1.y), bfhi(r1.y), bflo(r1.z), bfhi(r1.z), bflo(r1.w), bfhi(r1.w)};
              float ss = 0.f;
#pragma unroll
              for (int i = 0; i < 16; ++i) ss += v[i] * v[i];
              ss = xsum4(ss); const float rs = rsqrtf(ss * (1.0f / 64) + EPS) * (0.125f * LOG2E);
#pragma unroll
              for (int i = 0; i < 8; ++i) { v[i] *= rs * gq[fg * 8 + i]; v[8 + i] *= rs * gq[32 + fg * 8 + i]; }
              qf[0] = pack8((f32x4_t){v[0], v[1], v[2], v[3]}, (f32x4_t){v[4], v[5], v[6], v[7]});
              qf[1] = pack8((f32x4_t){v[8], v[9], v[10], v[11]}, (f32x4_t){v[12], v[13], v[14], v[15]}); }
            f32x4_t S[16]; float mx = NINF;
#pragma unroll
            for (int nt = 0; nt < 16; ++nt) { S[nt] = (f32x4_t){0.f, 0.f, 0.f, 0.f};
#pragma unroll
                for (int ks = 0; ks < 2; ++ks) { const bf16x8_t kf = *(const LAS bf16x8_t*)(Km + (16 * nt + fr) * KROW + (32 * ks + 8 * fg) * 2); S[nt] = mfma16(kf, qf[ks], S[nt]); }
                mx = fmaxf(mx, fmaxf(fmaxf(S[nt][0], S[nt][1]), fmaxf(S[nt][2], S[nt][3]))); }
            mx = xmax4(mx); float sum = 0.f;
#pragma unroll
            for (int nt = 0; nt < 16; ++nt)
#pragma unroll
                for (int jj = 0; jj < 4; ++jj) { const float e = ex2(S[nt][jj] - mx); S[nt][jj] = e; sum += e; }
            sum = xsum4(sum); const float inv = 1.0f / sum;
            f32x4_t o[4];
#pragma unroll
            for (int dt = 0; dt < 4; ++dt) o[dt] = (f32x4_t){0.f, 0.f, 0.f, 0.f};
#pragma unroll
            for (int c2 = 0; c2 < 8; ++c2) { const bf16x8_t pf = pack8(S[2 * c2], S[2 * c2 + 1]);
#pragma unroll
                for (int dt = 0; dt < 4; ++dt) { const LAS unsigned char* vp = Vm + (32 * c2 + 4 * fg + (fr >> 2)) * KROW + (16 * dt + 4 * (fr & 3)) * 2; o[dt] = mfma16(ldtr2(vp, vp + 16 * KROW), pf, o[dt]); } }
            bf16_t* orow = CATB + row * DM + 768 + hh * 64;
#pragma unroll
            for (int dt = 0; dt < 4; ++dt) { const f32x4_t v = o[dt] * inv; *(uint2*)(orow + 16 * dt + 4 * fg) = make_uint2(cvtpk(v[0], v[1]), cvtpk(v[2], v[3])); }
        }
    }
}
__device__ __forceinline__ void ph_mem_attn_sample(const Params& p, int l, LAS unsigned char* lds, int j0, int jcnt, int jstep) {
    const int tid = ltid(), lane = tid & 63, w = tid >> 6;
    const int ldp = l < 2 ? LDA_ : LDB_, qoff = l < 2 ? 3072 : 768;
    const bf16_t* P16 = (const bf16_t*)(p.ws + B_P16); bf16_t* CATB = (bf16_t*)(p.ws + B_CATB); const float* gq = p.in[I_GMEMQ] + l * 64;
    LAS float* qs = (LAS float*)(lds + w * 2048);
    LAS float* ps = qs + 64;
    __syncthreads();
    for (int ji = 0; ji < jcnt; ++ji) { const int item = (j0 + ji * jstep) * NW_ + w; if (item >= BS * 4) break;
        const int hh = item & 3, b = item >> 2; const size_t row = (size_t)MP + b;
        const float* kv = p.in[I_CMEM] + (size_t)(l * 128 + b) * 256 * 512 + hh * 64;
        { const float v = bf2f(P16[row * ldp + qoff + hh * 64 + lane]); const float ss = wave_sum(v * v); qs[lane] = v * rsqrtf(ss * (1.0f / 64) + EPS) * gq[lane] * (0.125f * LOG2E); }
        asm volatile("s_waitcnt lgkmcnt(0)" ::: "memory");
        float sc[4] = {0.f, 0.f, 0.f, 0.f};
#pragma unroll 4
        for (int d4 = 0; d4 < 16; ++d4) { const f32x4_t q4 = *(const LAS f32x4_t*)(qs + 4 * d4);
#pragma unroll
            for (int k = 0; k < 4; ++k) { const f32x4_t k4 = *(const f32x4_t*)(kv + (size_t)(lane + 64 * k) * 512 + 4 * d4); sc[k] += (q4[0] * k4[0] + q4[1] * k4[1]) + (q4[2] * k4[2] + q4[3] * k4[3]); } }
        float mx = wave_max(fmaxf(fmaxf(sc[0], sc[1]), fmaxf(sc[2], sc[3]))); float sum = 0.f;
#pragma unroll
        for (int k = 0; k < 4; ++k) { sc[k] = ex2(sc[k] - mx); sum += sc[k]; ps[lane + 64 * k] = sc[k]; }
        sum = wave_sum(sum);
        asm volatile("s_waitcnt lgkmcnt(0)" ::: "memory");
        { const int kg = lane >> 4, c4 = lane & 15; f32x4_t o4 = (f32x4_t){0.f, 0.f, 0.f, 0.f};
#pragma unroll 1
          for (int m0 = 0; m0 < 64; m0 += 16) { f32x4_t v[16];
#pragma unroll
              for (int i = 0; i < 16; ++i) v[i] = *(const f32x4_t*)(kv + (size_t)(4 * (m0 + i) + kg) * 512 + 256 + 4 * c4);
#pragma unroll
              for (int i = 0; i < 16; ++i) o4 = o4 + v[i] * ps[4 * (m0 + i) + kg]; }
#pragma unroll
          for (int jx = 0; jx < 4; ++jx) o4[jx] = xsum4(o4[jx]);
          if (kg == 0) { const float inv = 1.0f / sum; *(uint2*)(CATB + row * DM + 768 + hh * 64 + 4 * c4) = make_uint2(cvtpk(o4[0] * inv, o4[1] * inv), cvtpk(o4[2] * inv, o4[3] * inv)); } }
        asm volatile("s_waitcnt lgkmcnt(0)" ::: "memory");
    }
}
__device__ __forceinline__ void ph_nsa_sample(const Params& p, int j, LAS unsigned char* ldsb) {
    const int tid0 = ltid();
    float* lds = (float*)ldsb;
    float* qs = lds;
    float* sc = lds + 384;
    float* imp = sc + 3072;
    int* sel = (int*)(imp + 40);
    float* gate = (float*)(sel + 8);
    float* oacc = gate + 24;
    const float** kptr = (const float**)(oacc + 384);
    float* part = (float*)(kptr + 512);
    const bf16_t* P = (const bf16_t*)(p.ws + B_P16); const float* GT = (const float*)(p.ws + B_GT); const float* KVR = (const float*)(p.ws + B_KVR); bf16_t* CATB = (bf16_t*)(p.ws + B_CATB);
    const float* table = p.in[I_REL]; const int* pt = (const int*)p.in[I_PT];
    for (int item = blockIdx.x; item < BS * 2; item += gridDim.x) {
        int t_l = tid0; asm volatile("" : "+v"(t_l)); const int tid = t_l, lane = tid & 63, wid = tid >> 6;
        int pos_l = PAST; asm volatile("" : "+s"(pos_l)); const int pos = pos_l;
        const int b = item >> 1, g = item & 1, row = MP + b;
        const bf16_t* pr = P + (size_t)row * LDB_;
        __syncthreads();
        if (wid < 6) { const int z = wid; const float v = bf2f(pr[(g * 6 + z) * 64 + lane]); const float ss = wave_sum(v * v); qs[z * 64 + lane] = v * rsqrtf(ss * (1.0f / 64) + EPS) * p.in[I_GQ][j * 64 + lane]; }
        if (tid >= 384 && tid < 384 + 18) { const int t2 = tid - 384; const int br = t2 / 6, z = t2 % 6; gate[t2] = sigmoidf_(GT[(size_t)row * GTW + br * 12 + g * 6 + z] + p.in[I_BGATE][j * 36 + br * 12 + g * 6 + z]); }
        if (tid < 384) oacc[tid] = 0.f;
        __syncthreads();
        const float* ck = (const float*)(p.ws + B_CK) + (size_t)(8 + b) * 127 * 128; const float* cv = (const float*)(p.ws + B_CV) + (size_t)(8 + b) * 127 * 128;
        for (int i = tid; i < 6 * 127; i += NT_) {
            const int z = i / 127, n = i % 127; const int dist = pos - (16 * n + 31);
            const float4* kp = (const float4*)(ck + n * 128 + g * 64); const float4* qp = (const float4*)(qs + z * 64); float a = 0.f;
#pragma unroll 8
            for (int d = 0; d < 16; ++d) a += dot4(kp[d], qp[d]);
            sc[z * 128 + n] = a * 0.125f + table[rel_bucket_alu(dist) * 12 + g * 6 + z];
        }
        __syncthreads();
        if (wid < 6) row_softmax(sc + wid * 128, 127, lane);
        __syncthreads();
        const int cur = pos >> 6;
        if (tid < 33) { const int jb = tid; float s = 0.f;
            for (int z = 0; z < 6; ++z) { const float* pz = sc + z * 128;
                if (jb < 32) { s += 2.0f * (pz[4 * jb] + pz[4 * jb + 1] + pz[4 * jb + 2]); if (4 * jb + 3 < 127) s += pz[4 * jb + 3]; }
                if (jb >= 1 && jb < 32) s += pz[4 * jb - 1]; }
            imp[jb] = s; }
        __syncthreads();
        if (tid == 0) {
            int cnt = 3; sel[0] = 0; sel[1] = cur; sel[2] = cur - 1; unsigned long long taken = 0ull;
            for (int k = 0; k < 5; ++k) { int best = -1; float bv = -1.f;
                for (int jb = 1; jb <= cur - 2; ++jb) if (!((taken >> jb) & 1ull) && imp[jb] > bv) { bv = imp[jb]; best = jb; }
                if (best >= 0) { taken |= 1ull << best; sel[cnt++] = best; } }
            for (; cnt < 8; ++cnt) sel[cnt] = -1;
        }
        { const int kg = tid >> 4, c4 = tid & 15; f32x4_t v[4]; f32x4_t acc[6];
#pragma unroll
          for (int i = 0; i < 4; ++i) { const int n = kg + 32 * i; v[i] = *(const f32x4_t*)(cv + (n < 127 ? n : 126) * 128 + g * 64 + 4 * c4); }
#pragma unroll
          for (int z = 0; z < 6; ++z) { acc[z] = (f32x4_t){0.f, 0.f, 0.f, 0.f};
#pragma unroll
              for (int i = 0; i < 4; ++i) { const int n = kg + 32 * i; if (n < 127) acc[z] = acc[z] + v[i] * sc[z * 128 + n]; } }
#pragma unroll
          for (int z = 0; z < 6; ++z) *(f32x4_t*)(part + kg * 384 + z * 64 + 4 * c4) = acc[z]; }
        __syncthreads();
        if (tid < 384) { float o = 0.f;
#pragma unroll 8
            for (int kg = 0; kg < 32; ++kg) o += part[kg * 384 + tid];
            oacc[tid] += gate[0 * 6 + (tid >> 6)] * o; }
        __syncthreads();
#pragma unroll 1
        for (int br = 1; br <= 2; ++br) {
            int t_b = tid0; asm volatile("" : "+v"(t_b)); const int tid = t_b, lane = tid & 63, wid = tid >> 6;
            { const int t = tid; const float* kp = nullptr; int dist = -1;
                if (br == 1) { const int blk = sel[t >> 6];
                    if (blk >= 0) { const int tok = blk * 64 + (t & 63); dist = pos - tok;
                        if (dist >= 0) kp = tok < PAST ? p.in[I_CSLC] + ((size_t)pt[b * 16 + (tok >> 7)] * 128 + (tok & 127)) * 256 + g * 64 : KVR + (size_t)row * 768 + 256 + g * 64; }
                } else { const int kpos = pos - 511 + t; dist = 511 - t;
                    kp = kpos < PAST ? p.in[I_CWIN] + ((size_t)b * 512 + (kpos - (PAST - 512))) * 256 + g * 64 : KVR + (size_t)row * 768 + 512 + g * 64; }
                if (dist >= 0 && kp) {
                    float s[6] = {0.f, 0.f, 0.f, 0.f, 0.f, 0.f};
#pragma unroll 1
                    for (int dc = 0; dc < 2; ++dc) { f32x4_t kk[8];
#pragma unroll
                        for (int d = 0; d < 8; ++d) kk[d] = ((const f32x4_t*)kp)[8 * dc + d];
#pragma unroll
                        for (int d = 0; d < 8; ++d) {
#pragma unroll
                            for (int z = 0; z < 6; ++z) { const f32x4_t q4 = *(const f32x4_t*)(qs + z * 64 + 32 * dc + 4 * d); s[z] += (kk[d][0] * q4[0] + kk[d][1] * q4[1]) + (kk[d][2] * q4[2] + kk[d][3] * q4[3]); }
                            asm volatile("" ::: "memory"); } }
                    const int bk = rel_bucket_alu(dist);
#pragma unroll
                    for (int z = 0; z < 6; ++z) sc[z * 512 + t] = s[z] * 0.125f + table[bk * 12 + g * 6 + z];
                    kptr[t] = kp;
                } else {
#pragma unroll
                    for (int z = 0; z < 6; ++z) sc[z * 512 + t] = NEGM;
                    kptr[t] = KVR;
                }
            }
            __syncthreads();
            if (wid < 6) row_softmax(sc + wid * 512, 512, lane);
            __syncthreads();
            {
                const int kg = tid >> 4, c4 = tid & 15; f32x4_t acc[6];
#pragma unroll
                for (int z = 0; z < 6; ++z) acc[z] = (f32x4_t){0.f, 0.f, 0.f, 0.f};
#pragma unroll 1
                for (int i0 = 0; i0 < 16; i0 += 8) { f32x4_t v[8];
#pragma unroll
                    for (int i = 0; i < 8; ++i) v[i] = *(const f32x4_t*)(kptr[kg + 32 * (i0 + i)] + 128 + 4 * c4);
#pragma unroll
                    for (int i = 0; i < 8; ++i)
#pragma unroll
                        for (int z = 0; z < 6; ++z) acc[z] = acc[z] + v[i] * sc[z * 512 + kg + 32 * (i0 + i)]; }
#pragma unroll
                for (int z = 0; z < 6; ++z) *(f32x4_t*)(part + kg * 384 + z * 64 + 4 * c4) = acc[z];
            }
            __syncthreads();
            if (tid < 384) { float o = 0.f;
#pragma unroll 8
                for (int kg = 0; kg < 32; ++kg) o += part[kg * 384 + tid];
                oacc[tid] += gate[br * 6 + (tid >> 6)] * o; }
            __syncthreads();
        }
        if (tid < 384) CATB[(size_t)row * DM + g * 384 + tid] = (bf16_t)f2bf(oacc[tid]);
    }
}
__device__ __forceinline__ void ph_mlstm_sample_fast(const Params& p, int l, LAS unsigned char* ldsb) {
    const int tid = ltid(), lane = tid & 63, w = tid >> 6;
    float* lds = (float*)ldsb;
    float* qs = lds; float* ks = lds + 192; float* n1 = lds + 384; float* part = lds + 576;
    float* scal = part + 8 * 192;
    const bf16_t* P = (const bf16_t*)(p.ws + B_P16); const float* GT = (const float*)(p.ws + B_GT); const float* bif = p.in[I_BIF] + l * 8; float* HR = (float*)(p.ws + B_HRAW);
    for (int item = blockIdx.x; item < BS * 4; item += gridDim.x) {
        const int h = item & 3, b = item >> 2; const size_t row = (size_t)MP + b;
        const bf16_t* pr = P + row * LDA_; const float* gr = GT + row * GTW;
        const size_t sidx = (size_t)(l * 128 + b) * 4 + h;
        const float ig = gr[h] + bif[h], fg_ = gr[4 + h] + bif[4 + h];
        const float m0 = p.in[I_SM][sidx];
        const float logf = logsigmoidf_(fg_);
        const float m_new = fmaxf(logf + m0, ig);
        const float a = expf(logf + m0 - m_new), bb = expf(ig - m_new);
        __syncthreads();
        if (tid < 192) { const float q = bf2f(pr[h * 192 + tid]), k = bf2f(pr[768 + h * 192 + tid]); qs[tid] = q; ks[tid] = k;
            const float nn = a * p.in[I_SN][sidx * 192 + tid] + bb * k; n1[tid] = nn; p.out[O_SN + sidx * 192 + tid] = nn; }
        __syncthreads();
        if (w == 0) { float s = qs[lane] * n1[lane] + qs[lane + 64] * n1[lane + 64] + qs[lane + 128] * n1[lane + 128]; s = wave_sum(s); if (lane == 0) scal[0] = s; }
        const float* C0 = p.in[I_SC] + sidx * 192 * 192; float* C1 = p.out + O_SC + sidx * 192 * 192;
        float ve[3], num[3] = {0.f, 0.f, 0.f};
#pragma unroll
        for (int i = 0; i < 3; ++i) ve[i] = bf2f(pr[1536 + h * 192 + lane + 64 * i]) * bb;
#pragma unroll 1
        for (int d0 = 24 * w; d0 < 24 * w + 24; d0 += 12) {
            float c[12][3];
#pragma unroll
            for (int r = 0; r < 12; ++r)
#pragma unroll
                for (int i = 0; i < 3; ++i) c[r][i] = C0[(size_t)(d0 + r) * 192 + lane + 64 * i];
#pragma unroll
            for (int r = 0; r < 12; ++r) { const float kd = ks[d0 + r], qd = qs[d0 + r];
#pragma unroll
                for (int i = 0; i < 3; ++i) { const float cn = a * c[r][i] + kd * ve[i]; C1[(size_t)(d0 + r) * 192 + lane + 64 * i] = cn; num[i] = fmaf(qd, cn, num[i]); } }
        }
#pragma unroll
        for (int i = 0; i < 3; ++i) part[w * 192 + lane + 64 * i] = num[i];
        __syncthreads();
        if (tid < 192) { float s = 0.f;
#pragma unroll
            for (int ww = 0; ww < 8; ++ww) s += part[ww * 192 + tid];
            HR[row * 768 + h * 192 + tid] = s / fmaxf(fabsf(scal[0]), expf(-m_new)); }
        if (tid == 0) p.out[O_SM + sidx] = m_new;
    }
}
constexpr int RING_BYTES = 131072, MISC_OFF = RING_BYTES + 320, LDS_BYTES = 147456;
typedef float f32x4_ __attribute__((ext_vector_type(4)));

#define STRIP_JOBS(njobs) for (int job = (int)gridDim.x - 1 - (int)blockIdx.x; job < (njobs); job += (int)gridDim.x)
__device__ __forceinline__ void strips_inproj(const Params& p, int l, LAS unsigned char* lds) {
    unsigned char* ws = p.ws; const bf16_t* XB = (const bf16_t*)(ws + B_XB); bf16_t* P16 = (bf16_t*)(ws + B_P16); float* GT = (float*)(ws + B_GT);
    const float* ssq = (const float*)(ws + B_SSQ) + (size_t)(2 * l) * SSQS;
    const bool ka = l < 2; const int ldp = ka ? LDA_ : LDB_, nmain = ka ? 104 * 4 : 32 * 4;
    const bf16_t* Bt = ka ? (const bf16_t*)(ws + B_BTA) + (size_t)l * NBTA * DM : (const bf16_t*)(ws + B_BTB) + (size_t)(l - 2) * NBTB * DM;
    const int tid_ = ltid(); const int lane = tid_ & 63, wave = tid_ >> 6, fr = lane & 15, fq = lane >> 4;
    STRIP_JOBS(nmain + 516) {
        if (job < nmain) {
            const int st = job >> 2, r0 = MP + (job & 3) * 32;
            const int brow[2] = {st * 32, st * 32 + 16}; StripAcc<2> R; strip_gemm<2>(XB, DM, r0, Bt, brow, R, lds);
            if (wave < 2) { const int row = r0 + wave * 16 + fr; const float rs = rstd_of(ssq[row]);
#pragma unroll
                for (int t = 0; t < 2; ++t) { const f32x4_ v = R.a[t] * rs; *(uint2*)(P16 + (size_t)row * ldp + st * 32 + t * 16 + 4 * fq) = make_uint2(pk2(v[0], v[1]), pk2(v[2], v[3])); } }
        } else {
            const int r0 = (job - nmain) * 32, row = r0 + wave * 16 + fr;
            if (ka) { const int brow[1] = {3328}; StripAcc<1> R; strip_gemm<1>(XB, DM, r0, Bt, brow, R, lds); if (wave < 2) *(f32x4_*)(GT + (size_t)row * GTW + 4 * fq) = R.a[0] * rstd_of(ssq[row]); }
            else { const int brow[3] = {1024, 1040, 1056}; StripAcc<3> R; strip_gemm<3>(XB, DM, r0, Bt, brow, R, lds);
                if (wave < 2) { const float rs = rstd_of(ssq[row]);
#pragma unroll
                    for (int t = 0; t < 3; ++t) *(f32x4_*)(GT + (size_t)row * GTW + t * 16 + 4 * fq) = R.a[t] * rs; } }
        }
    }
}
__device__ __forceinline__ void strips_resid(const Params& p, const bf16_t* A, int K, const bf16_t* Bt, float* ssq, float* Y, LAS unsigned char* lds) {
    bf16_t* XB = (bf16_t*)(p.ws + B_XB);
    const int tid_ = ltid(); const int lane = tid_ & 63, wave = tid_ >> 6, fr = lane & 15, fq = lane >> 4;
    STRIP_JOBS(256) {
        const int st = job >> 2, r0 = MP + (job & 3) * 32;
        const int brow[1] = {st * 16}; StripAcc<1> R; strip_gemm<1>(A, K, r0, Bt, brow, R, lds);
        if (wave < 2) { const int row = r0 + wave * 16 + fr; bf16_t* bp = XB + (size_t)row * DM + st * 16 + 4 * fq; const uint2 o = *(const uint2*)bp;
            const f32x4_ x = (f32x4_){bflo(o.x), bfhi(o.x), bflo(o.y), bfhi(o.y)} + R.a[0];
            *(uint2*)bp = make_uint2(pk2(x[0], x[1]), pk2(x[2], x[3]));
            if (Y) *(f32x4_*)(Y + (size_t)row * DM + st * 16 + 4 * fq) = x;
            float ss = (x[0] * x[0] + x[1] * x[1]) + (x[2] * x[2] + x[3] * x[3]); ss += __shfl_xor(ss, 16); ss += __shfl_xor(ss, 32);
            if (fq == 0) (void)__hip_atomic_fetch_add(ssq + row, ss, __ATOMIC_RELAXED, __HIP_MEMORY_SCOPE_AGENT); }
    }
}
__device__ __forceinline__ void strips_gu(const Params& p, int l, LAS unsigned char* lds) {
    unsigned char* ws = p.ws; const bf16_t* XB = (const bf16_t*)(ws + B_XB); bf16_t* HID = (bf16_t*)(ws + B_HID);
    const float* ssq = (const float*)(ws + B_SSQ) + (size_t)(2 * l + 1) * SSQS; const bf16_t* Bt = (const bf16_t*)(ws + B_BTG) + (size_t)l * 2 * DFF * DM;
    const int tid_ = ltid(); const int lane = tid_ & 63, wave = tid_ >> 6, fr = lane & 15, fq = lane >> 4;
    STRIP_JOBS(176 * 4) {
        const int st = job >> 2, r0 = MP + (job & 3) * 32;
        const int brow[2] = {(st >> 3) * 256 + (st & 7) * 16, (st >> 3) * 256 + 128 + (st & 7) * 16}; StripAcc<2> R; strip_gemm<2>(XB, DM, r0, Bt, brow, R, lds);
        if (wave < 2) { const int row = r0 + wave * 16 + fr; const float rs = rstd_of(ssq[row]); float h[4];
#pragma unroll
            for (int j = 0; j < 4; ++j) { const float g = R.a[0][j] * rs, up = R.a[1][j] * rs; h[j] = g * pg8::fast_sigmoid(g) * up; }
            *(uint2*)(HID + (size_t)row * DFF + st * 16 + 4 * fq) = make_uint2(pk2(h[0], h[1]), pk2(h[2], h[3])); }
    }
}
__device__ __forceinline__ void strips_kv(const Params& p, LAS unsigned char* lds) {
    unsigned char* ws = p.ws; const bf16_t* XB = (const bf16_t*)(ws + B_XB); float* KVR = (float*)(ws + B_KVR);
    const float* ssq = (const float*)(ws + B_SSQ) + (size_t)4 * SSQS; const bf16_t* Bt = (const bf16_t*)(ws + B_BTK);
    const int tid_ = ltid(); const int lane = tid_ & 63, wave = tid_ >> 6, fr = lane & 15, fq = lane >> 4;
    STRIP_JOBS(48 * 4) {
        const int st = job >> 2, r0 = MP + (job & 3) * 32;
        const int brow[1] = {st * 16}; StripAcc<1> R; strip_gemm<1>(XB, DM, r0, Bt, brow, R, lds);
        if (wave < 2) { const int row = r0 + wave * 16 + fr; *(f32x4_*)(KVR + (size_t)row * 768 + st * 16 + 4 * fq) = R.a[0] * rstd_of(ssq[row]); }
    }
}

#ifndef COMPRESS_NAIVE
#define COMPRESS_NAIVE 0
#endif
#ifndef MLSTM_NAIVE
#define MLSTM_NAIVE 0
#endif
#ifndef MEMATT_NAIVE
#define MEMATT_NAIVE 0
#endif
#ifndef SAMPLE_ML_NAIVE
#define SAMPLE_ML_NAIVE 0
#endif
#ifndef SAMPLE_NSA_NAIVE
#define SAMPLE_NSA_NAIVE 0
#endif
#ifndef MK_MULTI
#define MK_MULTI 0
#endif
constexpr int PL = 9, NPH = 1 + 4 * PL;
__host__ __device__ constexpr bool phase_nonempty(int ph) {
    if (ph == 0) return true;
    const int l = (ph - 1) / PL, r = (ph - 1) % PL;
    if (r == 2) return l < 2;
    if (r == 7) return false;
    if (r >= 6) return l == 1;
    return true;
}
#ifndef TIME_MASK
#define TIME_MASK 0
#endif
__host__ __device__ constexpr int phase_group(int ph) { if (ph == 0) return 0; const int l = (ph - 1) / PL, r = (ph - 1) % PL; return r == 0 ? 1 : r == 1 ? (l < 2 ? 2 : 4) : r == 2 ? 3 : r == 3 ? 5 : r == 4 ? 6 : r == 5 ? 7 : r == 6 ? 8 : r == 7 ? 9 : 10; }
__global__ void __launch_bounds__(NT_, 2) fwd(Params p) {
    extern __shared__ __attribute__((aligned(16))) unsigned char lds_raw[];
    LAS unsigned char* lds = (LAS unsigned char*)lds_raw;
    float* ldsf = (float*)lds_raw;
    volatile LAS unsigned* MISC = (volatile LAS unsigned*)(lds + MISC_OFF);
    for (int u = threadIdx.x; u < (LDS_BYTES - RING_BYTES) / 4; u += NT_) ((LAS unsigned*)(lds + RING_BYTES))[u] = 0u;
    __syncthreads();
    unsigned char* ws = p.ws;
    XcdBarrier bar; bar.bar = (unsigned*)ws; bar.x = 0; bar.st = MISC + 8;
    const bool single = (p.ph_hi - p.ph_lo) > 1;
    if (single) bar = xcd_barrier_post((unsigned*)ws, MISC + 8);
    bf16_t* XB = (bf16_t*)(ws + B_XB); bf16_t* P16 = (bf16_t*)(ws + B_P16); bf16_t* CATB = (bf16_t*)(ws + B_CATB); bf16_t* HID = (bf16_t*)(ws + B_HID);
    float* SSQ = (float*)(ws + B_SSQ);
    const int G = gridDim.x, c = blockIdx.x;
    if (TIME_SUB && blockIdx.x == gridDim.x - 1 && threadIdx.x == 0) { g_tsub[0] = 0ull; g_tsub[1] = 0ull; g_tsub[2] = 0ull; g_tsub[3] = 0ull; }
    int ph = 0; unsigned long long t_acc = 0ull, t_ph = TIME_MASK ? __builtin_amdgcn_s_memrealtime() : 0ull;
#define ON() (ph >= p.ph_lo && ph < p.ph_hi)
#define NEXT() do { const bool ne_ = phase_nonempty(ph); const int grp_ = phase_group(ph); ++ph; if (ne_ && ph > p.ph_lo && ph < p.ph_hi) xcd_barrier(bar); \
        if (TIME_MASK) { const unsigned long long now_ = __builtin_amdgcn_s_memrealtime(); if ((TIME_MASK >> grp_) & 1) t_acc += now_ - t_ph; t_ph = now_; } } while (0)
#ifndef NO_PRO
    if (ON()) ph_prologue(p, lds);
#endif
    NEXT();
    for (int l = 0; l < 4; ++l) {
        if (ON()) {
            if (l == 0) { pg8::Gemm g{(const bf16_t*)(ws + B_MPB), (const bf16_t*)(ws + B_BTM), 2048, 2048, DM}; pg8::StaticOrder S; S.init(2048, 2048, G, c);
                pg8::EpiF32 E{(float*)(ws + B_MEMR), 512, nullptr, 512, (size_t)2048 * 512};
                pg8::gemm_phase<pg8::EpiF32, pg8::StaticOrder, true, true>(lds, g, S, E); }
            if (l < 2) { pg8::Gemm g{XB, (const bf16_t*)(ws + B_BTA) + (size_t)l * NBTA * DM, MAP, LDA_ + 256, DM}; pg8::StaticOrder S; S.init(MAP, LDA_ + 256, G, l == 0 ? (c + 192) % G : c);
                pg8::EpiBf16S E{P16, LDA_, SSQ + (size_t)(2 * l) * SSQS, 13, (float*)(ws + B_GT)};
                pg8::gemm_phase<pg8::EpiBf16S, pg8::StaticOrder, true, true>(lds, g, S, E); }
            else { pg8::Gemm g{XB, (const bf16_t*)(ws + B_BTB) + (size_t)(l - 2) * NBTB * DM, MP, LDB_, DM}; pg8::StaticOrder S; S.init(MP, LDB_, G, c);
                pg8::EpiBf16S E{P16, LDB_, SSQ + (size_t)(2 * l) * SSQS, -1, nullptr};
                pg8::gemm_phase<pg8::EpiBf16S, pg8::StaticOrder, true, true>(lds, g, S, E);
#ifndef NO_STRIPS
                strips_inproj(p, l, lds);
#endif
            }
        }
        NEXT();
#ifndef NO_NAIVE
        if (ON()) {
            if (l < 2) { if (MLSTM_NAIVE) ph_mlstm_prompt(p, l, ldsf); else ph_mlstm_fast(p, l, lds); if (G == 256) { if (c >= 192) { ph_mem_attn_fast(p, l, lds, c - 192, 4, 64); ph_mem_attn_sample(p, l, lds, c - 192, 1, 64); if (l == 1) ph_swin_copy(p, 192, 64); } }
                else { ph_mem_attn_fast(p, l, lds, c, (256 - c + G - 1) / G, G); if (c < 64) ph_mem_attn_sample(p, l, lds, c, (64 - c + G - 1) / G, G); if (l == 1) ph_swin_copy(p, 0, G); }      if (SAMPLE_ML_NAIVE) ph_mlstm_sample(p, l, ldsf); else ph_mlstm_sample_fast(p, l, lds); }
            else { if (!NSA_NAIVE_ALL) ph_nsa_fast(p, l - 2, lds); if (SAMPLE_NSA_NAIVE) ph_nsa(p, l - 2, ldsf); else ph_nsa_sample(p, l - 2, lds); if (MEMATT_NAIVE) ph_mem_attn(p, l); else if (G == 256) { if (c < 16) { ph_mem_attn_fast(p, l, lds, 8 * c, 8, 1); ph_mem_attn_sample(p, l, lds, 2 * c, 2, 1); } else if (c < 32) { ph_mem_attn_fast(p, l, lds, 128 + 5 * (c - 16), 5, 1); ph_mem_attn_sample(p, l, lds, 2 * c, 2, 1); } else if (c < 48) ph_mem_attn_fast(p, l, lds, 208 + 3 * (c - 32), 3, 1); }
                else { ph_mem_attn_fast(p, l, lds, c, (256 - c + G - 1) / G, G); if (c < 64) ph_mem_attn_sample(p, l, lds, c, (64 - c + G - 1) / G, G); } }
        }
#endif
        NEXT();
#ifndef NO_NAIVE
        if (ON()) { if (l < 2) { ph_mlstm_fin(p, l); if (l == 0) ph_memk_norm(p); } }
#endif
        NEXT();
        if (ON()) {
            const bf16_t* Bt = (const bf16_t*)(ws + B_BTO) + (size_t)l * DM * DM; float* sq = SSQ + (size_t)(2 * l + 1) * SSQS;
            pg8::Gemm g{CATB, Bt, MP, DM, DM}; pg8::StaticOrder S; S.init(MP, DM, G, c); pg8::EpiResid E{nullptr, XB, sq};
            pg8::gemm_phase<pg8::EpiResid, pg8::StaticOrder, true, true>(lds, g, S, E);
#ifndef NO_STRIPS
            strips_resid(p, CATB, DM, Bt, sq, nullptr, lds);
#endif
        }
        NEXT();
        if (ON()) {
            pg8::Gemm g{XB, (const bf16_t*)(ws + B_BTG) + (size_t)l * 2 * DFF * DM, MAP, 2 * DFF, DM}; pg8::StaticOrder S; S.init(MAP, 2 * DFF, G, c); pg8::EpiSwiglu E{HID, SSQ + (size_t)(2 * l + 1) * SSQS};
            pg8::gemm_phase<pg8::EpiSwiglu, pg8::StaticOrder, true, true>(lds, g, S, E);
            if (G == 256 && l < 3 && c >= 150) { __syncthreads(); ph_convert_layer(p, lds, l + 1, (c - 150) * NW_ + (ltid() >> 6), 106 * NW_, false); }
        }
        NEXT();
        if (ON()) {
            const bf16_t* Bt = (const bf16_t*)(ws + B_BTD) + (size_t)l * DM * DFF; float* sq = SSQ + (size_t)(2 * l + 2) * SSQS;
            pg8::Gemm g{HID, Bt, MP, DM, DFF}; pg8::StaticOrder S; S.init(MP, DM, G, c); float* Yo = l == 3 ? p.out : nullptr; pg8::EpiResid E{Yo, XB, sq};
            pg8::gemm_phase<pg8::EpiResid, pg8::StaticOrder, true, true>(lds, g, S, E);
#ifndef NO_STRIPS
            strips_resid(p, HID, DFF, Bt, sq, Yo, lds);
#endif
        }
        NEXT();
        if (ON()) { if (l == 1) {
            pg8::Gemm g{XB, (const bf16_t*)(ws + B_BTK), MAP, 768, DM}; pg8::StaticOrder S; S.init(MAP, 768, G, c); pg8::EpiF32 E{(float*)(ws + B_KVR), 768, SSQ + (size_t)4 * SSQS, 0, 0};
            pg8::gemm_phase<pg8::EpiF32, pg8::StaticOrder, true, true>(lds, g, S, E);
            asm volatile("s_waitcnt vmcnt(0)" ::: "memory"); __syncthreads();
            if (c < 195) {
                constexpr int nM = MAP / 256, nN = 3, nwg = nM * nN, q = nwg / 8, rr = nwg % 8; const int xcd = c % 8, off = c / 8;
                const int wgid = (xcd < rr ? xcd * (q + 1) : rr * (q + 1) + (xcd - rr) * q) + off; constexpr int nig = 8 * nN; const int gid = wgid / nig, fm = gid * 8, gsz = (nM - fm) < 8 ? (nM - fm) : 8;
                rows_post_tile(p, (fm + ((wgid % nig) % gsz)) * 256, (wgid % nig) / gsz); }
            } }
        NEXT();
        NEXT();
#ifndef NO_NAIVE
        if (ON()) { if (l == 1) { if (COMPRESS_NAIVE) ph_compress(p, ldsf); else ph_compress_fast(p, lds); } }
#endif
        NEXT();
    }
    if (TIME_SUB) t_acc = __hip_atomic_load(&g_tsub[TIME_SUB - 1], __ATOMIC_RELAXED, __HIP_MEMORY_SCOPE_AGENT);
    if (TIME_MASK || TIME_SUB) { if (blockIdx.x == 0 && threadIdx.x == 0) { const unsigned long long t0 = __builtin_amdgcn_s_memrealtime(); while (__builtin_amdgcn_s_memrealtime() - t0 < 10ull * t_acc) __builtin_amdgcn_s_sleep(8); } }
}

extern "C" void kernel_launch(void* const* d_in, const int* in_sizes, int n_in, void* d_out, int out_size, void* d_ws, size_t ws_size, hipStream_t stream) {
    static int grid = 0;
    if (!grid) {
        int dev = 0, cus = 0;
        (void)hipGetDevice(&dev); (void)hipDeviceGetAttribute(&cus, hipDeviceAttributeMultiprocessorCount, dev);
        if (cus < 1) cus = 256;
        if (hipFuncSetAttribute((const void*)fwd, hipFuncAttributeMaxDynamicSharedMemorySize, LDS_BYTES) != hipSuccess) fprintf(stderr, "kernel_launch: hipFuncSetAttribute failed\n");
        int per_cu = 0; (void)hipOccupancyMaxActiveBlocksPerMultiprocessor(&per_cu, (const void*)fwd, NT_, LDS_BYTES); (void)hipGetLastError();
        if (per_cu < 1) fprintf(stderr, "kernel_launch: occupancy query says %d\n", per_cu);
        grid = cus;
    }
    if (n_in != N_IN || (size_t)out_size != O_END || ws_size < B_END) fprintf(stderr, "kernel_launch: unexpected sizes n_in=%d out=%d ws=%zu need %zu\n", n_in, out_size, ws_size, (size_t)B_END);
    (void)hipMemsetAsync(d_ws, 0, CTL_BYTES, stream);
    Params p{};
    for (int i = 0; i < N_IN; ++i) p.in[i] = (const float*)d_in[i];
    p.out = (float*)d_out; p.ws = (unsigned char*)d_ws;
#if MK_MULTI
    for (int ph = 0; ph < NPH; ++ph) {
        if (!phase_nonempty(ph)) continue;
        p.ph_lo = ph; p.ph_hi = ph + 1;
        hipLaunchKernelGGL(fwd, dim3(grid), dim3(NT_), LDS_BYTES, stream, p);
    }
#else
    p.ph_lo = 0; p.ph_hi = NPH;
    hipLaunchKernelGGL(fwd, dim3(grid), dim3(NT_), LDS_BYTES, stream, p);
#endif
}

#ifdef REGTEST
__global__ void __launch_bounds__(NT_, 2) rt_nsa(Params p) { extern __shared__ __attribute__((aligned(16))) unsigned char l_[]; ph_nsa_fast(p, 0, (LAS unsigned char*)l_); }
__global__ void __launch_bounds__(NT_, 2) rt_mlstm(Params p) { extern __shared__ __attribute__((aligned(16))) unsigned char l_[]; ph_mlstm_fast(p, 0, (LAS unsigned char*)l_); }
__global__ void __launch_bounds__(NT_, 2) rt_nsas(Params p) { extern __shared__ __attribute__((aligned(16))) unsigned char l_[]; ph_nsa_sample(p, 0, (LAS unsigned char*)l_); }
__global__ void __launch_bounds__(NT_, 2) rt_mem(Params p) { extern __shared__ __attribute__((aligned(16))) unsigned char l_[]; ph_mem_attn_fast(p, 0, (LAS unsigned char*)l_, 0, 256, 1); }
__global__ void __launch_bounds__(NT_, 2) rt_cmp(Params p) { extern __shared__ __attribute__((aligned(16))) unsigned char l_[]; ph_compress_fast(p, (LAS unsigned char*)l_); }
#endif
```

```cpp
#include <hip/hip_runtime.h>
#include <cstdio>
#include <cstdint>

#define LAS __attribute__((address_space(3)))
#define GAS __attribute__((address_space(1)))
#define XB_TMO      128
#define XB_XCNT(j)  (256  + 64 * (j))
#define XB_XSUB(j)  (1280 + 64 * (j))
#define XB_XGEN(j)  (2304 + 64 * (j))
#define XB_TOP      3328
#define XB_TOPGEN   3392
#define XCD_BAR_WORDS 3456
#define XB_SPIN_CAP (1u << 23)
__device__ __forceinline__ unsigned xb_ld(unsigned* p)              { return __hip_atomic_load(p, __ATOMIC_RELAXED, __HIP_MEMORY_SCOPE_AGENT); }
__device__ __forceinline__ unsigned xb_add(unsigned* p, unsigned v) { return __hip_atomic_fetch_add(p, v, __ATOMIC_RELAXED, __HIP_MEMORY_SCOPE_AGENT); }
__device__ __forceinline__ unsigned xb_xcc_id() { return (unsigned)__builtin_amdgcn_s_getreg((3 << 11) | 20) & 0xFu; }
#define XB_SPIN(cond, bar) do { unsigned _sp = 0; while (cond) { __builtin_amdgcn_s_sleep(1); \
    if ((++_sp & 255u) == 0u) { if (xb_ld(&(bar)[XB_TMO])) break; if (_sp > XB_SPIN_CAP) { atomicAdd(&(bar)[XB_TMO], 1u); break; } } } } while (0)
struct XcdBarrier { unsigned* bar; unsigned x; volatile LAS unsigned* st; };
__device__ __forceinline__ XcdBarrier xcd_barrier_post(unsigned* bar, volatile LAS unsigned* st) {
    XcdBarrier b; b.bar = bar; b.x = xb_xcc_id(); b.st = st;
    if (threadIdx.x == 0) (void)xb_add(&bar[XB_XCNT(b.x)], 1u);
    return b;
}
__device__ __forceinline__ void xcd_barrier_complete(unsigned* bar, unsigned x, unsigned& nloc, unsigned& nx) {
    const unsigned G = gridDim.x * gridDim.y * gridDim.z;
    unsigned sum, cnt, mine, sp = 0u;
    for (;;) {
        sum = 0u; cnt = 0u; mine = 0u;
#pragma unroll
        for (unsigned j = 0; j < 16; ++j) { const unsigned c = xb_ld(&bar[XB_XCNT(j)]); sum += c; cnt += (c > 0u) ? 1u : 0u; mine = (j == x) ? c : mine; }
        if (sum == G) break;
        __builtin_amdgcn_s_sleep(1);
        if ((++sp & 255u) == 0u) { if (xb_ld(&bar[XB_TMO])) break; if (sp > XB_SPIN_CAP) { atomicAdd(&bar[XB_TMO], 1u); break; } }
    }
    nloc = mine > 0u ? mine : 1u; nx = cnt > 0u ? cnt : 1u;
}
__device__ __forceinline__ void xcd_barrier(const XcdBarrier& b) {
    asm volatile("s_waitcnt vmcnt(0)" ::: "memory");
    __syncthreads();
    if (threadIdx.x == 0) {
        unsigned* bar = b.bar;
        __builtin_amdgcn_s_waitcnt(0);
        unsigned nloc = b.st[0], nx = b.st[1];
        if (nloc == 0u) { xcd_barrier_complete(bar, b.x, nloc, nx); b.st[0] = nloc; b.st[1] = nx; }
        const unsigned old = xb_add(&bar[XB_XSUB(b.x)], 1u);
        const unsigned gen = old / nloc;
        if (old + 1u == (gen + 1u) * nloc) {
            __builtin_amdgcn_fence(__ATOMIC_RELEASE, "agent");
            asm volatile("s_waitcnt vmcnt(0)" ::: "memory");
            const unsigned og = xb_add(&bar[XB_TOP], 1u);
            const unsigned tg = og / nx;
            if (og + 1u == (tg + 1u) * nx) xb_add(&bar[XB_TOPGEN], 1u);
            else XB_SPIN(xb_ld(&bar[XB_TOPGEN]) == tg, bar);
            __builtin_amdgcn_fence(__ATOMIC_ACQUIRE, "agent");
            xb_add(&bar[XB_XGEN(b.x)], 1u);
            asm volatile("s_waitcnt vmcnt(0)" ::: "memory");
        } else {
            XB_SPIN(xb_ld(&bar[XB_XGEN(b.x)]) == gen, bar);
            __builtin_amdgcn_fence(__ATOMIC_ACQUIRE, "agent");
            asm volatile("s_waitcnt vmcnt(0)" ::: "memory");
        }
    }
    __syncthreads();
}

constexpr int NT_ = 512, NW_ = 8;
constexpr int DM = 1024, BP = 8, SP = 2048, MP = BP * SP, BS = 128, MA = MP + BS, MAP = MP + 256;
constexpr int ACOLS = 3336, BCOLS = 1060, DFF = 2816;
constexpr int LDA_ = 3328, LDB_ = 1024;
constexpr int NBTA = 3344, NBTB = 1072;
constexpr int PAST = 2048, GTW = 48;
constexpr float EPS = 1e-6f, NEGM = -1e30f;
typedef unsigned short bf16_t;

enum { I_XP = 0, I_XS, I_SC, I_SN, I_SM, I_CMEM, I_CCMP, I_CSLC, I_CWIN, I_PT, I_MEMP, I_GMIX, I_WINA, I_BIF, I_GHN, I_WINB, I_GQ, I_BGATE, I_REL,
       I_GKV, I_WKV, I_GKSLC, I_GKWIN, I_GKCMP, I_CPOS, I_CW1, I_CB1, I_CW2, I_CB2, I_WMEMKV, I_GMEMK, I_GMEMQ, I_WOUT, I_GFFN, I_WGU, I_WDOWN, N_IN };
constexpr size_t O_YP = 0, O_YS = O_YP + (size_t)MP * DM, O_PC = O_YS + (size_t)BS * DM, O_PN = O_PC + 2ull * 8 * 4 * 192 * 192, O_PM = O_PN + 2ull * 8 * 4 * 192,
    O_PMEM = O_PM + 64, O_PCMP = O_PMEM + 4ull * 8 * 256 * 512, O_PSLC = O_PCMP + (size_t)MP * 256, O_PWIN = O_PSLC + (size_t)MP * 256, O_SC = O_PWIN + 8ull * 512 * 256,
    O_SN = O_SC + 2ull * 128 * 4 * 192 * 192, O_SM = O_SN + 2ull * 128 * 4 * 192, O_SCMP = O_SM + 1024, O_SSLC = O_SCMP + 128 * 256, O_SWIN = O_SSLC + 128 * 256,
    O_END = O_SWIN + 128ull * 512 * 256;
static_assert(O_END == 87700544ull, "output size");
constexpr size_t CTL_BYTES = 2u << 20, B_SSQ = 65536;
constexpr size_t al256(size_t x) { return (x + 255) & ~(size_t)255; }
constexpr size_t B_XB = CTL_BYTES, B_P16 = al256(B_XB + (size_t)MAP * DM * 2), B_GT = al256(B_P16 + (size_t)MAP * LDA_ * 2), B_CATB = al256(B_GT + (size_t)MAP * GTW * 4),
    B_HID = al256(B_CATB + (size_t)MA * DM * 2), B_HRAW = al256(B_HID + (size_t)MAP * DFF * 2), B_KVR = al256(B_HRAW + (size_t)MA * 768 * 4), B_CK = al256(B_KVR + (size_t)MAP * 768 * 4),
    B_CV = al256(B_CK + 136ull * 127 * 128 * 4), B_MPB = al256(B_CV + 136ull * 127 * 128 * 4),
    B_BTA = al256(B_MPB + 2048ull * DM * 2), B_BTB = al256(B_BTA + 2ull * NBTA * DM * 2), B_BTO = al256(B_BTB + 2ull * NBTB * DM * 2), B_BTG = al256(B_BTO + 4ull * DM * DM * 2),
    B_BTD = al256(B_BTG + 4ull * 2 * DFF * DM * 2), B_BTK = al256(B_BTD + 4ull * DM * DFF * 2), B_BTM = al256(B_BTK + 768ull * DM * 2), B_KVB = al256(B_BTM + 2048ull * DM * 2), B_SKF = al256(B_KVB + 6ull * BP * 2 * SP * 64 * 2), B_SVF = al256(B_SKF + (size_t)BP * 2 * SP * 64 * 2), B_KC16 = al256(B_SVF + (size_t)BP * 2 * SP * 64 * 2),
    B_W1T = al256(B_KC16 + 136ull * 2 * 2 * 128 * 64 * 2), B_W2T = al256(B_W1T + 2ull * 128 * 2048 * 2), B_PEB = al256(B_W2T + 2ull * 64 * 128 * 2), B_MEMR = al256(B_PEB + 1024), B_CMPS = al256(B_MEMR + 4ull * 2048 * 512 * 4), B_END = al256(B_CMPS + (size_t)BS * 4 * SP * 64 * 2 + 8192);
constexpr int SSQS = MAP;
static_assert(9 * SSQS * 4 + B_SSQ <= CTL_BYTES, "ssq sites inside the control region");

#ifndef TIME_SUB
#define TIME_SUB 0
#endif
#ifndef TSUB_BLK
#define TSUB_BLK 10
#endif
__device__ unsigned long long g_tsub[8];
#define TSUB_BEGIN() unsigned long long tsub_t0_ = (TIME_SUB && blockIdx.x == TSUB_BLK && threadIdx.x == 0) ? __builtin_amdgcn_s_memrealtime() : 0ull
#define TSUB_END(k) do { if (TIME_SUB && blockIdx.x == TSUB_BLK && threadIdx.x == 0) { const unsigned long long n_ = __builtin_amdgcn_s_memrealtime(); g_tsub[k] += n_ - tsub_t0_; tsub_t0_ = n_; } } while (0)
struct Params { const float* in[N_IN]; float* out; unsigned char* ws; int ph_lo, ph_hi; };

__device__ const unsigned char REL_LUT[128] = {0, 1, 2, 3, 4, 5, 6, 7, 8, 9, 10, 11, 12, 13, 14, 15, 16, 16, 16, 17, 17, 18, 18, 18, 19, 19, 19, 20, 20, 20, 20, 21, 21, 21, 21, 22, 22, 22, 22, 22, 23, 23, 23, 23, 23, 23, 24, 24, 24, 24, 24, 24, 25, 25, 25, 25, 25, 25, 25, 26, 26, 26, 26, 26, 26, 26, 26, 27, 27, 27, 27, 27, 27, 27, 27, 27, 27, 28, 28, 28, 28, 28, 28, 28, 28, 28, 28, 29, 29, 29, 29, 29, 29, 29, 29, 29, 29, 29, 29, 30, 30, 30, 30, 30, 30, 30, 30, 30, 30, 30, 30, 30, 30, 31, 31, 31, 31, 31, 31, 31, 31, 31, 31, 31, 31, 31, 31, 31};
__device__ __forceinline__ int rel_bucket(int d) { return d >= 128 ? 31 : (int)REL_LUT[d < 0 ? 0 : d]; }
__device__ __forceinline__ int rel_bucket_alu(int d) { d = d < 0 ? 0 : d; if (d < 16) return d;
    return 16 + (d >= 19) + (d >= 21) + (d >= 24) + (d >= 27) + (d >= 31) + (d >= 35) + (d >= 40) + (d >= 46) + (d >= 52) + (d >= 59) + (d >= 67) + (d >= 77) + (d >= 87) + (d >= 99) + (d >= 113); }

__device__ __forceinline__ int opq(int i) { asm volatile("" : "+s"(i)); return i; }
#define BAR_LDS() do { asm volatile("s_waitcnt lgkmcnt(0)" ::: "memory"); __builtin_amdgcn_s_barrier(); asm volatile("" ::: "memory"); } while (0)
__device__ __forceinline__ int ltid() { int t = threadIdx.x; asm volatile("" : "+v"(t)); return t; }
__device__ __forceinline__ float wave_sum(float v) {
#pragma unroll
    for (int o = 32; o; o >>= 1) v += __shfl_xor(v, o);
    return v;
}
__device__ __forceinline__ float wave_max(float v) {
#pragma unroll
    for (int o = 32; o; o >>= 1) v = fmaxf(v, __shfl_xor(v, o));
    return v;
}
__device__ __forceinline__ float sigmoidf_(float x) { return 1.0f / (1.0f + expf(-x)); }
__device__ __forceinline__ float logsigmoidf_(float x) { return fminf(x, 0.f) - log1pf(expf(-fabsf(x))); }
__device__ __forceinline__ float dot4(float4 a, float4 b) { return a.x * b.x + a.y * b.y + a.z * b.z + a.w * b.w; }
__device__ __forceinline__ float bf2f(bf16_t u) { return __uint_as_float((unsigned)u << 16); }
__device__ __forceinline__ unsigned f2bf(float f) { unsigned u = __float_as_uint(f); return (u + 0x7fffu + ((u >> 16) & 1u)) >> 16; }
__device__ __forceinline__ unsigned pk2(float lo, float hi) { return f2bf(lo) | (f2bf(hi) << 16); }
__device__ __forceinline__ float bflo(unsigned w) { return __uint_as_float(w << 16); }
__device__ __forceinline__ float bfhi(unsigned w) { return __uint_as_float(w & 0xffff0000u); }
__device__ __forceinline__ float rstd_of(float ssq) { return rsqrtf(ssq * (1.0f / DM) + EPS); }

namespace pg8 {
#define PG8_LAS __attribute__((address_space(3)))
typedef unsigned short bf16_t;
typedef short bf16x8 __attribute__((ext_vector_type(8)));
typedef float f32x4 __attribute__((ext_vector_type(4)));
typedef unsigned u32x4 __attribute__((ext_vector_type(4)));
constexpr int BM = 256, BK = 64, HALF = 128, HTB = HALF * BK * 2  , STAGE_BYTES = 8 * HTB, NXCD = 8, WGM = 8;

__host__ __device__ __forceinline__ int lds_byte(int r, int c) { const int st = (r >> 4) * 2 + (c >> 5), rr = r & 15, cc = c & 31, ob = rr * 64 + cc * 2; return st * 1024 + (ob ^ (((ob >> 9) & 1) << 5)); }
__host__ __device__ __forceinline__ void stage_rc(int b, int& R, int& C) { const int st = b / 1024, sb = b % 1024, swz = sb ^ (((sb >> 9) & 1) << 5); R = (st >> 1) * 16 + swz / 64; C = (st & 1) * 32 + (swz % 64) / 2; }
__host__ __device__ __forceinline__ int perm32(int rho) { const int n = rho >> 4, i = rho & 15; return 8 * (i >> 2) + 4 * n + (i & 3); }

struct Unit { int pm, pn; };
struct Gemm { const bf16_t* A; const bf16_t* Bt; int M, N, K; };

struct StaticOrder {
    int nM, nN, nwg, G, c;
    __host__ __device__ void init(int M, int N, int G_, int c_) { nM = M / BM; nN = N / BM; nwg = nM * nN; G = G_; c = c_; }
    __host__ __device__ bool next(int i, Unit& u) const {
        const long L = (long)i * G + c; if (L >= nwg) return false;
        int wgid = (int)L; { const int q = nwg / NXCD, r = nwg % NXCD, xcd = wgid % NXCD, off = wgid / NXCD; wgid = (xcd < r ? xcd * (q + 1) : r * (q + 1) + (xcd - r) * q) + off; }
        const int nig = WGM * nN, gid = wgid / nig, fm = gid * WGM, gsz = (nM - fm) < WGM ? (nM - fm) : WGM;
        u.pm = fm + ((wgid % nig) % gsz); u.pn = (wgid % nig) / gsz; return true;
    }
    __device__ __forceinline__ void a_ready(const Unit&) const {}
    __device__ __forceinline__ void done(const Unit&) const {}
};

__device__ __forceinline__ unsigned cvt_pk_bf16(float lo, float hi) { unsigned r; asm volatile("v_cvt_pk_bf16_f32 %0, %1, %2" : "=v"(r) : "v"(lo), "v"(hi)); return r; }
typedef float f32x2 __attribute__((ext_vector_type(2)));
__device__ __forceinline__ float fast_sigmoid(float x) { return __builtin_amdgcn_rcpf(1.0f + __builtin_amdgcn_exp2f(-1.4426950408889634f * x)); }
struct EpiF32 {
    static constexpr bool PERM = false, AFTER_DRAIN = false;
    float* O; int ldc; const float* ssq; int split_cols; size_t split_stride;
    __device__ __forceinline__ void operator()(const f32x4 (&acc)[2][2][4][2], const Unit& u, int wr, int wc, int fr, int fq) const {
        int colt = u.pn * BM; float* base = O; if (split_cols) { const int t = colt / split_cols; base += (size_t)t * split_stride; colt -= t * split_cols; }
        const int row0 = u.pm * BM + wr * 64 + fr, col0 = colt + wc * 32 + 4 * fq;
#pragma unroll
        for (int ai = 0; ai < 2; ++ai)
#pragma unroll
            for (int m = 0; m < 4; ++m) { const int r = row0 + ai * HALF + m * 16; const float rs = ssq ? rstd_of(ssq[r]) : 1.0f; float* rowp = base + (size_t)r * ldc + col0;
#pragma unroll
                for (int bj = 0; bj < 2; ++bj)
#pragma unroll
                    for (int n = 0; n < 2; ++n) *(f32x4*)(rowp + bj * HALF + n * 16) = acc[ai][bj][m][n] * rs; }
    }
};
struct EpiBf16S {
    static constexpr bool PERM = true, AFTER_DRAIN = false;
    bf16_t* O; int ldc; const float* ssq; int gate_pn; float* GT;
    __device__ __forceinline__ void operator()(const f32x4 (&acc)[2][2][4][2], const Unit& u, int wr, int wc, int fr, int fq) const {
        const int row0 = u.pm * BM + wr * 64 + fr, col0 = u.pn * BM + wc * 32 + 8 * fq;
        if (u.pn == gate_pn) {
            if (wc == 0 && fq == 0) {
#pragma unroll
                for (int ai = 0; ai < 2; ++ai)
#pragma unroll
                    for (int m = 0; m < 4; ++m) { const int r = row0 + ai * HALF + m * 16; const float rs = rstd_of(ssq[r]);
                        *(f32x4*)(GT + (size_t)r * 48) = acc[ai][0][m][0] * rs; *(f32x4*)(GT + (size_t)r * 48 + 4) = acc[ai][0][m][1] * rs; } }
            return; }
#pragma unroll
        for (int ai = 0; ai < 2; ++ai)
#pragma unroll
            for (int m = 0; m < 4; ++m) { const int r = row0 + ai * HALF + m * 16; const float rs = rstd_of(ssq[r]); bf16_t* rowp = O + (size_t)r * ldc + col0;
#pragma unroll
                for (int bj = 0; bj < 2; ++bj) { const f32x4 v0 = acc[ai][bj][m][0] * rs, v1 = acc[ai][bj][m][1] * rs;
                    u32x4 w; w.x = cvt_pk_bf16(v0[0], v0[1]); w.y = cvt_pk_bf16(v0[2], v0[3]); w.z = cvt_pk_bf16(v1[0], v1[1]); w.w = cvt_pk_bf16(v1[2], v1[3]);
                    *(u32x4*)(rowp + bj * HALF) = w; } }
    }
};
struct EpiSwiglu {
    static constexpr bool PERM = true, AFTER_DRAIN = false;
    bf16_t* O; const float* ssq;
    __device__ __forceinline__ void operator()(const f32x4 (&acc)[2][2][4][2], const Unit& u, int wr, int wc, int fr, int fq) const {
        const int row0 = u.pm * BM + wr * 64 + fr, col0 = u.pn * HALF + wc * 32 + 8 * fq;
#pragma unroll
        for (int ai = 0; ai < 2; ++ai)
#pragma unroll
            for (int m = 0; m < 4; ++m) { const int r = row0 + ai * HALF + m * 16; const float rs = rstd_of(ssq[r]); float h[8];
#pragma unroll
                for (int n = 0; n < 2; ++n)
#pragma unroll
                    for (int j = 0; j < 4; ++j) { const float g = acc[ai][0][m][n][j] * rs, up = acc[ai][1][m][n][j] * rs; h[4 * n + j] = g * fast_sigmoid(g) * up; }
                u32x4 w; w.x = cvt_pk_bf16(h[0], h[1]); w.y = cvt_pk_bf16(h[2], h[3]); w.z = cvt_pk_bf16(h[4], h[5]); w.w = cvt_pk_bf16(h[6], h[7]);
                *(u32x4*)(O + (size_t)r * 2816 + col0) = w; }
    }
};
struct EpiResid {
    static constexpr bool PERM = false, AFTER_DRAIN = false;
    float* Y; bf16_t* XB; float* ssq;
    __device__ __forceinline__ void operator()(const f32x4 (&acc)[2][2][4][2], const Unit& u, int wr, int wc, int fr, int fq) const {
        const int row0 = u.pm * BM + wr * 64 + fr, col0 = u.pn * BM + wc * 32 + 4 * fq;
        typedef unsigned u32x2 __attribute__((ext_vector_type(2)));
#pragma unroll
        for (int ai = 0; ai < 2; ++ai)
#pragma unroll
            for (int m = 0; m < 4; ++m) { const int r = row0 + ai * HALF + m * 16; bf16_t* bp = XB + (size_t)r * 1024 + col0; float ss = 0.f; u32x2 old[2][2];
#pragma unroll
                for (int bj = 0; bj < 2; ++bj)
#pragma unroll
                    for (int n = 0; n < 2; ++n) old[bj][n] = *(const u32x2*)(bp + bj * HALF + n * 16);
#pragma unroll
                for (int bj = 0; bj < 2; ++bj)
#pragma unroll
                    for (int n = 0; n < 2; ++n) { const u32x2 o = old[bj][n]; f32x4 x = (f32x4){bflo(o.x), bfhi(o.x), bflo(o.y), bfhi(o.y)} + acc[ai][bj][m][n];
                        u32x2 w; w.x = cvt_pk_bf16(x[0], x[1]); w.y = cvt_pk_bf16(x[2], x[3]); *(u32x2*)(bp + bj * HALF + n * 16) = w;
                        if (Y) *(f32x4*)(Y + (size_t)r * 1024 + col0 + bj * HALF + n * 16) = x;
                        ss += (x[0] * x[0] + x[1] * x[1]) + (x[2] * x[2] + x[3] * x[3]); }
                ss += __shfl_xor(ss, 16); ss += __shfl_xor(ss, 32);
                if (fq == 0) (void)__hip_atomic_fetch_add(ssq + r, ss, __ATOMIC_RELAXED, __HIP_MEMORY_SCOPE_AGENT); }
    }
};
template <class Epi, class Sched, bool ALIGN_EPI = false, bool SP2 = false>
__device__ __forceinline__ void gemm_phase(PG8_LAS unsigned char* lds, const Gemm g, const Sched& S, const Epi& E) {
    int tid_l = threadIdx.x; asm volatile("" : "+v"(tid_l));
    const int tid = tid_l, wid = __builtin_amdgcn_readfirstlane(tid >> 6), lane = tid & 63, wr = wid >> 2, wc = wid & 3, fr = lane & 15, fq = lane >> 4;
    const int K = g.K, nt = K / BK;
    unsigned voffA[2], voffB[2];
#pragma unroll
    for (int i = 0; i < 2; ++i) { int R, C; stage_rc(tid * 16 + i * 8192, R, C); const int Rb = Epi::PERM ? ((R & ~31) + perm32(R & 31)) : R;
        voffA[i] = (unsigned)(R * K + C) * 2u; voffB[i] = (unsigned)(Rb * K + C) * 2u; }
    const size_t kstep = (size_t)(BK * 2);
    const size_t hstep = (size_t)HALF * K * 2;
    const size_t tstep = 2 * hstep;
    const unsigned ldsw = (unsigned)wid * 1024u;
    const int aoff = lds_byte(wr * 64 + fr, fq * 8), boff = lds_byte(wc * 32 + fr, fq * 8);
#define PG8_SA(b, h) (((b) * 2 + (h)) * HTB)
#define PG8_SB(b, h) ((4 + (b) * 2 + (h)) * HTB)
#define PG8_STAGE(bufoff, gbase, voff) do { _Pragma("unroll") for (int _i = 0; _i < 2; ++_i) \
        __builtin_amdgcn_global_load_lds((const unsigned*)((const char*)(gbase) + (voff)[_i]), (PG8_LAS unsigned*)(lds + (bufoff) + ldsw + _i * 8192), 16, 0, 0); } while (0)
#define PG8_LDA(dst, b, h) do { _Pragma("unroll") for (int m = 0; m < 4; ++m) _Pragma("unroll") for (int k = 0; k < 2; ++k) dst[m][k] = *(const PG8_LAS bf16x8*)(lds + PG8_SA(b, h) + aoff + m * 2048 + k * 1024); } while (0)
#define PG8_LDB(dst, b, h) do { _Pragma("unroll") for (int n = 0; n < 2; ++n) _Pragma("unroll") for (int k = 0; k < 2; ++k) dst[n][k] = *(const PG8_LAS bf16x8*)(lds + PG8_SB(b, h) + boff + n * 2048 + k * 1024); } while (0)
#define PG8_MMA(ai, bj, At, Bt) do { __builtin_amdgcn_s_setprio(1); _Pragma("unroll") for (int m = 0; m < 4; ++m) _Pragma("unroll") for (int n = 0; n < 2; ++n) _Pragma("unroll") for (int k = 0; k < 2; ++k) \
        acc[ai][bj][m][n] = __builtin_amdgcn_mfma_f32_16x16x32_bf16(Bt[n][k], At[m][k], acc[ai][bj][m][n], 0, 0, 0); __builtin_amdgcn_s_setprio(0); } while (0)
#define PG8_WAIT_V(n) asm volatile("s_waitcnt vmcnt(" #n ")" ::: "memory")
#define PG8_WAIT_L(n) asm volatile("s_waitcnt lgkmcnt(" #n ")" ::: "memory")
#define PG8_BAR __builtin_amdgcn_s_barrier()
#define PG8_SCHED __builtin_amdgcn_sched_barrier(0)
    Unit cur, nxt; int ui = 0;
    if (!S.next(0, cur)) return;
    f32x4 acc[2][2][4][2];
#pragma unroll
    for (int a = 0; a < 2; ++a)
#pragma unroll
        for (int b = 0; b < 2; ++b)
#pragma unroll
            for (int m = 0; m < 4; ++m)
#pragma unroll
                for (int n = 0; n < 2; ++n) acc[a][b][m][n] = (f32x4){0.f, 0.f, 0.f, 0.f};
    bf16x8 At[4][2], B0[2][2], B1[2][2];
    const char* cA = (const char*)g.A + (size_t)cur.pm * tstep; const char* cB = (const char*)g.Bt + (size_t)cur.pn * tstep;
    S.a_ready(cur);
    if constexpr (SP2) {
        PG8_STAGE(PG8_SB(0, 0), cB, voffB); PG8_STAGE(PG8_SB(0, 1), cB + hstep, voffB); PG8_STAGE(PG8_SA(0, 0), cA, voffA); PG8_STAGE(PG8_SA(0, 1), cA + hstep, voffA);
        if (wr == 1) PG8_BAR;
        PG8_WAIT_V(2); PG8_BAR;
        PG8_STAGE(PG8_SB(1, 0), cB + kstep, voffB); PG8_STAGE(PG8_SA(1, 0), cA + kstep, voffA); PG8_STAGE(PG8_SB(1, 1), cB + hstep + kstep, voffB);
        PG8_WAIT_V(6); PG8_BAR;
    } else {
        PG8_STAGE(PG8_SB(0, 0), cB, voffB); PG8_STAGE(PG8_SA(0, 0), cA, voffA); PG8_STAGE(PG8_SB(0, 1), cB + hstep, voffB); PG8_STAGE(PG8_SA(0, 1), cA + hstep, voffA);
        if (wr == 1) PG8_BAR;
        PG8_WAIT_V(4); PG8_BAR;
        PG8_STAGE(PG8_SB(1, 0), cB + kstep, voffB); PG8_STAGE(PG8_SA(1, 0), cA + kstep, voffA); PG8_STAGE(PG8_SB(1, 1), cB + hstep + kstep, voffB);
        PG8_WAIT_V(6); PG8_BAR;
    }
    for (;;) {
        const bool has_next = S.next(ui + 1, nxt);
        const char* nA = has_next ? (const char*)g.A + (size_t)nxt.pm * tstep : cA; const char* nB = has_next ? (const char*)g.Bt + (size_t)nxt.pn * tstep : cB;
        for (int t = 0; t < nt; t += 2) {
            const bool last = (t == nt - 2);
            const char* a1 = cA + (size_t)(t + 1) * kstep;
            const char* a2 = last ? nA : cA + (size_t)(t + 2) * kstep; const char* b2 = last ? nB : cB + (size_t)(t + 2) * kstep;
            const char* a3 = a2 + kstep; const char* b3 = b2 + kstep;
            if (last && has_next) S.a_ready(nxt);
            if constexpr (SP2) {
            PG8_LDB(B0, 0, 0); PG8_LDB(B1, 0, 1); PG8_SCHED; PG8_LDA(At, 0, 0); PG8_STAGE(PG8_SA(1, 1), a1 + hstep, voffA);
            PG8_WAIT_V(8); PG8_WAIT_L(0); PG8_BAR; PG8_MMA(0, 0, At, B0); PG8_MMA(0, 1, At, B1); PG8_BAR; PG8_SCHED;
            PG8_LDA(At, 0, 1); PG8_STAGE(PG8_SB(0, 0), b2, voffB); PG8_STAGE(PG8_SB(0, 1), b2 + hstep, voffB); PG8_STAGE(PG8_SA(0, 0), a2, voffA);
            PG8_WAIT_V(8); PG8_WAIT_L(0); PG8_BAR; PG8_MMA(1, 0, At, B0); PG8_MMA(1, 1, At, B1); PG8_BAR; PG8_SCHED;
            PG8_LDB(B0, 1, 0); PG8_LDB(B1, 1, 1); PG8_SCHED; PG8_LDA(At, 1, 0); PG8_STAGE(PG8_SA(0, 1), a2 + hstep, voffA);
            PG8_WAIT_V(8); PG8_WAIT_L(0); PG8_BAR; PG8_MMA(0, 0, At, B0); PG8_MMA(0, 1, At, B1); PG8_BAR; PG8_SCHED;
            PG8_LDA(At, 1, 1); PG8_STAGE(PG8_SB(1, 0), b3, voffB); PG8_STAGE(PG8_SB(1, 1), b3 + hstep, voffB); PG8_STAGE(PG8_SA(1, 0), a3, voffA);
            PG8_WAIT_V(8); PG8_WAIT_L(0); PG8_BAR; PG8_MMA(1, 0, At, B0); PG8_MMA(1, 1, At, B1); PG8_BAR; PG8_SCHED;
            } else {
            PG8_LDB(B0, 0, 0); PG8_SCHED; PG8_LDA(At, 0, 0); PG8_STAGE(PG8_SA(1, 1), a1 + hstep, voffA);
            PG8_WAIT_L(8); PG8_BAR; PG8_WAIT_L(0); PG8_MMA(0, 0, At, B0); PG8_BAR; PG8_SCHED;
            PG8_LDB(B1, 0, 1); PG8_STAGE(PG8_SB(0, 0), b2, voffB);
            PG8_BAR; PG8_WAIT_L(0); PG8_MMA(0, 1, At, B1); PG8_BAR;
            PG8_LDA(At, 0, 1); PG8_STAGE(PG8_SA(0, 0), a2, voffA);
            PG8_BAR; PG8_WAIT_L(0); PG8_MMA(1, 0, At, B0); PG8_BAR; PG8_SCHED;
            PG8_STAGE(PG8_SB(0, 1), b2 + hstep, voffB);
            PG8_WAIT_V(6); PG8_BAR; PG8_MMA(1, 1, At, B1); PG8_BAR;
            PG8_LDB(B0, 1, 0); PG8_SCHED; PG8_LDA(At, 1, 0); PG8_STAGE(PG8_SA(0, 1), a2 + hstep, voffA);
            PG8_WAIT_L(8); PG8_BAR; PG8_WAIT_L(0); PG8_MMA(0, 0, At, B0); PG8_BAR; PG8_SCHED;
            PG8_LDB(B1, 1, 1); PG8_STAGE(PG8_SB(1, 0), b3, voffB);
            PG8_BAR; PG8_WAIT_L(0); PG8_MMA(0, 1, At, B1); PG8_BAR;
            PG8_LDA(At, 1, 1); PG8_STAGE(PG8_SA(1, 0), a3, voffA);
            PG8_BAR; PG8_WAIT_L(0); PG8_MMA(1, 0, At, B0); PG8_BAR; PG8_SCHED;
            PG8_STAGE(PG8_SB(1, 1), b3 + hstep, voffB);
            PG8_WAIT_V(6); PG8_BAR; PG8_MMA(1, 1, At, B1); PG8_BAR;
            }
        }
        if constexpr (ALIGN_EPI) { if (wr == 0) PG8_BAR; }
        if constexpr (!Epi::AFTER_DRAIN) { E(acc, cur, wr, wc, fr, fq); S.done(cur); }
        if (!has_next) break;
#pragma unroll
        for (int a = 0; a < 2; ++a)
#pragma unroll
            for (int b = 0; b < 2; ++b)
#pragma unroll
                for (int m = 0; m < 4; ++m)
#pragma unroll
                    for (int n = 0; n < 2; ++n) acc[a][b][m][n] = (f32x4){0.f, 0.f, 0.f, 0.f};
        cur = nxt; cA = nA; cB = nB; ++ui;
        if constexpr (ALIGN_EPI) { if (wr == 1) PG8_BAR; }
    }
    PG8_WAIT_V(0);
    if constexpr (!ALIGN_EPI) { if (wr == 0) PG8_BAR; }
    PG8_BAR;
    if constexpr (Epi::AFTER_DRAIN) { E.fused(acc, cur, wr, wc, fr, fq, lds, wid, lane); S.done(cur); }
#undef PG8_SA
#undef PG8_SB
#undef PG8_STAGE
#undef PG8_LDA
#undef PG8_LDB
#undef PG8_MMA
#undef PG8_WAIT_V
#undef PG8_WAIT_L
#undef PG8_BAR
#undef PG8_SCHED
}
}
typedef short s_bf16x8 __attribute__((ext_vector_type(8)));
typedef float s_f32x4 __attribute__((ext_vector_type(4)));
template <int NT> struct StripAcc { s_f32x4 a[NT]; };
template <int NT> __device__ __forceinline__ void strip_gemm(const bf16_t* A, int K, int row0, const bf16_t* Bt, const int* brow  , StripAcc<NT>& R, LAS unsigned char* lds) {
    const int tid_ = ltid(), lane = tid_ & 63, wave = tid_ >> 6, fr = lane & 15, fq = lane >> 4, rt = wave & 1, kq = wave >> 1;
    LAS float* red = (LAS float*)lds;
    const int kw = K >> 2;
    const bf16_t* ap = A + (size_t)(row0 + 16 * rt + fr) * K + kq * kw + fq * 8;
    const bf16_t* bp[NT];
#pragma unroll
    for (int t = 0; t < NT; ++t) { bp[t] = Bt + (size_t)(brow[t] + fr) * K + kq * kw + fq * 8; R.a[t] = (s_f32x4){0.f, 0.f, 0.f, 0.f}; }
    int k0 = 0;
#pragma unroll 1
    for (; k0 + 256 <= kw; k0 += 256) {
        s_bf16x8 a[8], b[NT][8];
#pragma unroll
        for (int s2 = 0; s2 < 8; ++s2) { a[s2] = *(const s_bf16x8*)(ap + k0 + s2 * 32);
#pragma unroll
            for (int t = 0; t < NT; ++t) b[t][s2] = *(const s_bf16x8*)(bp[t] + k0 + s2 * 32); }
#pragma unroll
        for (int s2 = 0; s2 < 8; ++s2)
#pragma unroll
            for (int t = 0; t < NT; ++t) R.a[t] = __builtin_amdgcn_mfma_f32_16x16x32_bf16(b[t][s2], a[s2], R.a[t], 0, 0, 0);
    }
#pragma unroll 1
    for (; k0 < kw; k0 += 64) {
        s_bf16x8 a[2], b[NT][2];
#pragma unroll
        for (int s2 = 0; s2 < 2; ++s2) { a[s2] = *(const s_bf16x8*)(ap + k0 + s2 * 32);
#pragma unroll
            for (int t = 0; t < NT; ++t) b[t][s2] = *(const s_bf16x8*)(bp[t] + k0 + s2 * 32); }
#pragma unroll
        for (int s2 = 0; s2 < 2; ++s2)
#pragma unroll
            for (int t = 0; t < NT; ++t) R.a[t] = __builtin_amdgcn_mfma_f32_16x16x32_bf16(b[t][s2], a[s2], R.a[t], 0, 0, 0);
    }
    __syncthreads();
    if (kq > 0) {
#pragma unroll
        for (int t = 0; t < NT; ++t) *(LAS s_f32x4*)(red + ((((kq - 1) * 2 + rt) * NT + t) * 64 + lane) * 4) = R.a[t]; }
    __syncthreads();
    if (kq == 0) {
#pragma unroll
        for (int q = 0; q < 3; ++q)
#pragma unroll
            for (int t = 0; t < NT; ++t) R.a[t] = R.a[t] + *(const LAS s_f32x4*)(red + (((q * 2 + rt) * NT + t) * 64 + lane) * 4); }
}
enum { TR_ID = 0, TR_INA, TR_INB, TR_GU };
__device__ __forceinline__ int tr_rowmap(int kind, int n) {
    if (kind == TR_INA) return n < 3072 ? n : (n < 3080 ? 3328 + (n - 3072) : 3072 + (n - 3080));
    if (kind == TR_INB) return n < 768 ? n : (n < 804 ? 1024 + (n - 768) : 768 + (n - 804));
    if (kind == TR_GU) { if (n < DFF) return (n >> 7) * 256 + (n & 127); const int m = n - DFF; return (m >> 7) * 256 + 128 + (m & 127); }
    return n;
}
__device__ __forceinline__ void tr_item(const float* W, int K, int N, bf16_t* WT, const float* gain, int kind, LAS float* scr, int item, int lane) {
    const int nblk = (N + 31) >> 5, kb = item / nblk, nb = item % nblk, k0 = 64 * kb, n0 = 32 * nb;
    { float v[32]; const int n = n0 + (lane & 31); const bool ok = n < N; const float* wp = W + (size_t)(k0 + (lane >> 5)) * N + (ok ? n : 0);
#pragma unroll
      for (int i = 0; i < 32; ++i) v[i] = wp[(size_t)(2 * i) * N];
#pragma unroll
      for (int i = 0; i < 32; ++i) { const int kk = 2 * i + (lane >> 5); float x = ok ? v[i] : 0.f; if (gain) x *= gain[k0 + kk]; scr[kk * 33 + (lane & 31)] = x; } }
    asm volatile("s_waitcnt lgkmcnt(0)" ::: "memory");
    const int c = lane & 7;
#pragma unroll
    for (int j = 0; j < 4; ++j) { const int nn = (lane >> 3) + 8 * j, n = n0 + nn;
        if (n < N) { const int row = tr_rowmap(kind, n); const float sc = (kind == TR_INA && n >= 768 && n < 1536) ? 0.07216878364870322f : 1.0f;
            const LAS float* s = scr + (8 * c) * 33 + nn; uint4 o;
            o.x = pk2(s[0 * 33] * sc, s[1 * 33] * sc); o.y = pk2(s[2 * 33] * sc, s[3 * 33] * sc); o.z = pk2(s[4 * 33] * sc, s[5 * 33] * sc); o.w = pk2(s[6 * 33] * sc, s[7 * 33] * sc);
            *(uint4*)(WT + (size_t)row * K + k0 + 8 * c) = o; } }
    asm volatile("s_waitcnt lgkmcnt(0)" ::: "memory");
}
__device__ __forceinline__ void ph_prologue(const Params& p, LAS unsigned char* lds) {
    const int tid = ltid(), lane = tid & 63, wid = tid >> 6; const int gw = blockIdx.x * NW_ + wid, NGW = gridDim.x * NW_;
    LAS float* scr = (LAS float*)(lds + wid * 16384);
    unsigned char* ws = p.ws;
    for (int it = gw; ; it += NGW) {
        int r = it; bool done = false;
#define TRJ(Wp, K_, N_, WTp, gainp, kind_) if (!done) { const int cnt = ((K_) / 64) * (((N_) + 31) / 32); if (r < cnt) { tr_item(Wp, K_, N_, WTp, gainp, kind_, scr, r, lane); done = true; } else r -= cnt; }
        for (int l = 0; l < 4; ++l) TRJ(p.in[I_WGU] + (size_t)l * DM * 2 * DFF, DM, 2 * DFF, (bf16_t*)(ws + B_BTG) + (size_t)l * 2 * DFF * DM, p.in[I_GFFN] + l * DM, TR_GU)
        for (int l = 0; l < 4; ++l) TRJ(p.in[I_WDOWN] + (size_t)l * DFF * DM, DFF, DM, (bf16_t*)(ws + B_BTD) + (size_t)l * DM * DFF, (const float*)nullptr, TR_ID)
        for (int l = 0; l < 2; ++l) TRJ(p.in[I_WINA] + (size_t)l * DM * ACOLS, DM, ACOLS, (bf16_t*)(ws + B_BTA) + (size_t)l * NBTA * DM, p.in[I_GMIX] + l * DM, TR_INA)
        for (int l = 0; l < 2; ++l) TRJ(p.in[I_WINB] + (size_t)l * DM * BCOLS, DM, BCOLS, (bf16_t*)(ws + B_BTB) + (size_t)l * NBTB * DM, p.in[I_GMIX] + (2 + l) * DM, TR_INB)
        for (int l = 0; l < 4; ++l) TRJ(p.in[I_WOUT] + (size_t)l * DM * DM, DM, DM, (bf16_t*)(ws + B_BTO) + (size_t)l * DM * DM, (const float*)nullptr, TR_ID)
        TRJ(p.in[I_WKV], DM, 768, (bf16_t*)(ws + B_BTK), p.in[I_GKV], TR_ID)
        for (int l = 0; l < 4; ++l) TRJ(p.in[I_WMEMKV] + (size_t)l * DM * 512, DM, 512, (bf16_t*)(ws + B_BTM) + (size_t)l * 512 * DM, (const float*)nullptr, TR_ID)
        for (int c = 0; c < 2; ++c) TRJ(p.in[I_CW1] + (size_t)c * 2048 * 128, 2048, 128, (bf16_t*)(ws + B_W1T) + (size_t)c * 128 * 2048, (const float*)nullptr, TR_ID)
        for (int c = 0; c < 2; ++c) TRJ(p.in[I_CW2] + (size_t)c * 128 * 64, 128, 64, (bf16_t*)(ws + B_W2T) + (size_t)c * 64 * 128, (const float*)nullptr, TR_ID)
#undef TRJ
        if (!done) break;
    }
    for (int idx = gw; idx < 256; idx += NGW) { const int c = idx >> 7, h = idx & 127; float s = 0.f;
        for (int k = lane; k < 2048; k += 64) s += p.in[I_CPOS][((k >> 6) * 2 + c) * 64 + (k & 63)] * p.in[I_CW1][((size_t)c * 2048 + k) * 128 + h];
        s = wave_sum(s); if (lane == 0) ((float*)(ws + B_PEB))[idx] = s + p.in[I_CB1][idx]; }
    for (int i = blockIdx.x * NT_ + tid; i < 2 * 8 * 128 + 2 * 12 * 128; i += gridDim.x * NT_) {
        uint4 z = make_uint4(0u, 0u, 0u, 0u);
        if (i < 2048) { const int l = i >> 10, rr = (i >> 7) & 7, c = i & 127; ((uint4*)((bf16_t*)(ws + B_BTA) + ((size_t)l * NBTA + 3336 + rr) * DM))[c] = z; }
        else { const int k = i - 2048; const int l = k / 1536, rr = (k % 1536) >> 7, c = k & 127; ((uint4*)((bf16_t*)(ws + B_BTB) + ((size_t)l * NBTB + 1060 + rr) * DM))[c] = z; }
    }
    bf16_t* XB = (bf16_t*)(ws + B_XB); float* ssq0 = (float*)(ws + B_SSQ); bf16_t* MPB = (bf16_t*)(ws + B_MPB);
    for (int r0 = gw; r0 < MA + 2048; r0 += 2 * NGW) {
        float4 v[2][4]; const int r1 = r0 + NGW < MA + 2048 ? r0 + NGW : r0;
#pragma unroll
        for (int u = 0; u < 2; ++u) { const int r = u ? r1 : r0; const float* src = r < MA ? (r < MP ? p.in[I_XP] + (size_t)r * DM : p.in[I_XS] + (size_t)(r - MP) * DM) : p.in[I_MEMP] + (size_t)(r - MA) * DM;
#pragma unroll
            for (int j = 0; j < 4; ++j) v[u][j] = ((const float4*)src)[lane + 64 * j]; }
#pragma unroll
        for (int u = 0; u < 2; ++u) { const int r = u ? r1 : r0; if (u == 1 && r1 == r0) break; const bool isx = r < MA;
            bf16_t* dstb = isx ? XB + (size_t)r * DM : MPB + (size_t)(r - MA) * DM; float ss = 0.f;
#pragma unroll
            for (int j = 0; j < 4; ++j) { ss += dot4(v[u][j], v[u][j]); ((uint2*)dstb)[lane + 64 * j] = make_uint2(pk2(v[u][j].x, v[u][j].y), pk2(v[u][j].z, v[u][j].w)); }
            ss = wave_sum(ss); if (isx && lane == 0) ssq0[r] = ss; }
    }
}

__device__ __forceinline__ void ph_swin_copy(const Params& p, int blk0, int nblk) {
    if ((int)blockIdx.x < blk0 || (int)blockIdx.x >= blk0 + nblk) return;
    const int tid = ltid();
    {   const unsigned n4 = 128u * 511u * 64u, stride = nblk * NT_;
#define SW_SRC(i_) (((const float4*)(p.in[I_CWIN] + (size_t)((i_) / (511u * 64u)) * 512 * 256 + 256))[(i_) % (511u * 64u)])
#define SW_DST(i_) (((float4*)(p.out + O_SWIN + (size_t)((i_) / (511u * 64u)) * 512 * 256))[(i_) % (511u * 64u)])
        for (unsigned i0 = (blockIdx.x - blk0) * NT_ + tid; i0 < n4; i0 += 4 * stride) {
            const unsigned i1 = i0 + stride, i2 = i0 + 2 * stride, i3 = i0 + 3 * stride;
            const float4 v0 = SW_SRC(i0), v1 = SW_SRC(i1 < n4 ? i1 : i0), v2 = SW_SRC(i2 < n4 ? i2 : i0), v3 = SW_SRC(i3 < n4 ? i3 : i0);
            SW_DST(i0) = v0; if (i1 < n4) SW_DST(i1) = v1; if (i2 < n4) SW_DST(i2) = v2; if (i3 < n4) SW_DST(i3) = v3; }
#undef SW_SRC
#undef SW_DST
    }
}

__device__ __forceinline__ void ph_memk_norm(const Params& p) {
    const int tid_ = ltid(); const int lane = tid_ & 63, wid = tid_ >> 6;
    const float* raw = (const float*)(p.ws + B_MEMR);
    for (int it = blockIdx.x * NW_ + wid; it < 4 * 8 * 256; it += gridDim.x * NW_) {
        const int l = it / 2048;
        const float4* rr = (const float4*)(raw + (size_t)it * 512); float4* orow = (float4*)(p.out + O_PMEM + (size_t)it * 512);
        float4 v = rr[lane]; const float4 vv = rr[64 + lane]; float ss = dot4(v, v);
        ss += __shfl_xor(ss, 1); ss += __shfl_xor(ss, 2); ss += __shfl_xor(ss, 4); ss += __shfl_xor(ss, 8);
        const float rs = rsqrtf(ss * (1.0f / 64) + EPS);
        const float4 g = ((const float4*)(p.in[I_GMEMK] + l * 64))[lane & 15];
        v.x *= rs * g.x; v.y *= rs * g.y; v.z *= rs * g.z; v.w *= rs * g.w; orow[lane] = v; orow[64 + lane] = vv;
    }
}

__device__ __forceinline__ void ph_mlstm_prompt(const Params& p, int l, float* lds) {
    const bf16_t* P = (const bf16_t*)(p.ws + B_P16); const float* GT = (const float*)(p.ws + B_GT); const float* bif = p.in[I_BIF] + l * 8; float* HR = (float*)(p.ws + B_HRAW);
    const int tid = ltid(), lane = tid & 63, wid = tid >> 6;
    float* red = lds;
    for (int item = blockIdx.x; item < 256; item += gridDim.x) {
        const int es = item & 7, h = (item >> 3) & 3, b = item >> 5;
        const bool act = tid < 384; const int grp = tid >= 192 ? 1 : 0; const int d = act ? tid - grp * 192 : 0;
        const int col0 = h * 192 + es * 24 + (act ? grp : 0) * 12;
        float C[12]; float n = 0.f, m = NEGM;
#pragma unroll
        for (int e = 0; e < 12; ++e) C[e] = 0.f;
        const bf16_t* pr = P + (size_t)(b * SP) * LDA_; const float* gr = GT + (size_t)(b * SP) * GTW;
        float qn = act ? bf2f(pr[h * 192 + d]) : 0.f, kn = act ? bf2f(pr[768 + h * 192 + d]) : 0.f; uint2 vn[3];
#pragma unroll
        for (int e = 0; e < 3; ++e) vn[e] = *(const uint2*)(pr + 1536 + col0 + 4 * e);
        float in_ = gr[h] + bif[h], fn = gr[4 + h] + bif[4 + h];
        for (int t = 0; t < SP; ++t) {
            const float q = qn, k = kn, ig = in_, fg = fn; float v[12];
#pragma unroll
            for (int e = 0; e < 3; ++e) { v[4 * e] = bflo(vn[e].x); v[4 * e + 1] = bfhi(vn[e].x); v[4 * e + 2] = bflo(vn[e].y); v[4 * e + 3] = bfhi(vn[e].y); }
            if (t + 1 < SP) {
                pr += LDA_; gr += GTW;
                qn = act ? bf2f(pr[h * 192 + d]) : 0.f; kn = act ? bf2f(pr[768 + h * 192 + d]) : 0.f;
#pragma unroll
                for (int e = 0; e < 3; ++e) vn[e] = *(const uint2*)(pr + 1536 + col0 + 4 * e);
                in_ = gr[h] + bif[h]; fn = gr[4 + h] + bif[4 + h];
            }
            const float logf = logsigmoidf_(fg);
            const float m_new = fmaxf(logf + m, ig);
            const float a = expf(logf + m - m_new), bb = expf(ig - m_new);
            const float kb = bb * k;
            float part[13];
#pragma unroll
            for (int e = 0; e < 12; ++e) { C[e] = a * C[e] + kb * v[e]; part[e] = q * C[e]; }
            n = a * n + kb; part[12] = q * n;
#pragma unroll
            for (int e = 0; e < 13; ++e) part[e] = wave_sum(part[e]);
            float* rb = red + (t & 1) * 104;
            if (lane == 0) {
#pragma unroll
                for (int e = 0; e < 13; ++e) rb[wid * 13 + e] = part[e];
            }
            __syncthreads();
            if (tid < 24) {
                const int g2 = tid / 12, e = tid % 12;
                const float num = rb[(g2 * 3) * 13 + e] + rb[(g2 * 3 + 1) * 13 + e] + rb[(g2 * 3 + 2) * 13 + e];
                const float den = rb[12] + rb[13 + 12] + rb[26 + 12];
                HR[(size_t)(b * SP + t) * 768 + h * 192 + es * 24 + tid] = num / fmaxf(fabsf(den), expf(-m_new));
            }
            m = m_new;
        }
        if (act) {
            float* co = p.out + O_PC + ((size_t)((l * 8 + b) * 4 + h) * 192 + d) * 192 + es * 24 + grp * 12;
#pragma unroll
            for (int e = 0; e < 12; ++e) co[e] = C[e];
            if (es == 0 && grp == 0) p.out[O_PN + (size_t)((l * 8 + b) * 4 + h) * 192 + d] = n;
        }
        if (es == 0 && tid == 0) p.out[O_PM + (l * 8 + b) * 4 + h] = m;
        __syncthreads();
    }
}
__device__ __forceinline__ void ph_mlstm_sample(const Params& p, int l, float* lds) {
    const bf16_t* P = (const bf16_t*)(p.ws + B_P16); const float* GT = (const float*)(p.ws + B_GT); const float* bif = p.in[I_BIF] + l * 8; float* HR = (float*)(p.ws + B_HRAW);
    const int tid = ltid();
    float* qs = lds + 512; float* ks = lds + 512 + 192; float* n0s = lds + 512 + 384;
    for (int item = blockIdx.x; item < 128 * 4; item += gridDim.x) {
        const int h = item & 3, b = item >> 2; const int row = MP + b;
        const bf16_t* pr = P + (size_t)row * LDA_; const float* gr = GT + (size_t)row * GTW;
        const size_t sidx = (size_t)(l * 128 + b) * 4 + h;
        __syncthreads();
        if (tid < 192) { qs[tid] = bf2f(pr[h * 192 + tid]); ks[tid] = bf2f(pr[768 + h * 192 + tid]); n0s[tid] = p.in[I_SN][sidx * 192 + tid]; }
        __syncthreads();
        const float ig = gr[h] + bif[h], fg = gr[4 + h] + bif[4 + h];
        const float m0 = p.in[I_SM][sidx];
        const float logf = logsigmoidf_(fg);
        const float m_new = fmaxf(logf + m0, ig);
        const float a = expf(logf + m0 - m_new), bb = expf(ig - m_new);
        if (tid < 192) {
            const int e = tid; const float ve = bf2f(pr[1536 + h * 192 + e]);
            const float* C0 = p.in[I_SC] + sidx * 192 * 192; float* C1 = p.out + O_SC + sidx * 192 * 192;
            float num = 0.f, den = 0.f;
            for (int d = 0; d < 192; ++d) {
                const float c = a * C0[d * 192 + e] + bb * ks[d] * ve; C1[d * 192 + e] = c; num += qs[d] * c;
                const float nd = a * n0s[d] + bb * ks[d]; den += qs[d] * nd;
            }
            HR[(size_t)row * 768 + h * 192 + e] = num / fmaxf(fabsf(den), expf(-m_new));
            p.out[O_SN + sidx * 192 + e] = a * n0s[e] + bb * ks[e];
        }
        if (tid == 0) p.out[O_SM + sidx] = m_new;
    }
}
__device__ __forceinline__ void ph_mlstm_fin(const Params& p, int l) {
    const bf16_t* P = (const bf16_t*)(p.ws + B_P16); const float* HR = (const float*)(p.ws + B_HRAW); bf16_t* CATB = (bf16_t*)(p.ws + B_CATB); const float* g = p.in[I_GHN] + l * 192;
    const int tid_ = ltid(); const int lane = tid_ & 63, wid = tid_ >> 6;
    for (int row = blockIdx.x * NW_ + wid; row < MA; row += gridDim.x * NW_) {
        float v[4][3]; bf16_t og[4][3];
#pragma unroll
        for (int h = 0; h < 4; ++h)
#pragma unroll
            for (int i = 0; i < 3; ++i) { v[h][i] = HR[(size_t)row * 768 + h * 192 + lane + 64 * i]; og[h][i] = P[(size_t)row * LDA_ + 2304 + h * 192 + lane + 64 * i]; }
#pragma unroll
        for (int h = 0; h < 4; ++h) { float ss = v[h][0] * v[h][0] + v[h][1] * v[h][1] + v[h][2] * v[h][2]; ss = wave_sum(ss); const float rs = rsqrtf(ss * (1.0f / 192) + EPS);
#pragma unroll
            for (int i = 0; i < 3; ++i) { const int d = lane + 64 * i; CATB[(size_t)row * DM + h * 192 + d] = (bf16_t)f2bf(sigmoidf_(bf2f(og[h][i])) * (v[h][i] * rs * g[d])); } }
    }
}
__device__ __forceinline__ void ph_mem_attn(const Params& p, int l) {
    const int ldp = l < 2 ? LDA_ : LDB_, qoff = l < 2 ? 3072 : 768;
    const bf16_t* P = (const bf16_t*)(p.ws + B_P16); bf16_t* CATB = (bf16_t*)(p.ws + B_CATB); const float* gq = p.in[I_GMEMQ] + l * 64;
    for (int idx4 = blockIdx.x * NT_ + ltid(); idx4 < 16 * MA; idx4 += gridDim.x * NT_) {
        const int part = idx4 & 3, idx = idx4 >> 2;
        const int hh = idx / MA, row = idx % MA;
        const float* kvb = row < MP ? p.out + O_PMEM + (size_t)(l * 8 + row / SP) * 256 * 512 : p.in[I_CMEM] + (size_t)(l * 128 + (row - MP)) * 256 * 512;
        float q[16]; float ss = 0.f;
        const uint4* qp = (const uint4*)(P + (size_t)row * ldp + qoff + hh * 64 + part * 16);
#pragma unroll
        for (int i = 0; i < 2; ++i) { const uint4 t = qp[i]; q[8 * i] = bflo(t.x); q[8 * i + 1] = bfhi(t.x); q[8 * i + 2] = bflo(t.y); q[8 * i + 3] = bfhi(t.y); q[8 * i + 4] = bflo(t.z); q[8 * i + 5] = bfhi(t.z); q[8 * i + 6] = bflo(t.w); q[8 * i + 7] = bfhi(t.w); }
#pragma unroll
        for (int i = 0; i < 16; ++i) ss += q[i] * q[i];
        ss += __shfl_xor(ss, 1); ss += __shfl_xor(ss, 2);
        const float rs = rsqrtf(ss * (1.0f / 64) + EPS) * 0.125f;
#pragma unroll
        for (int i = 0; i < 16; ++i) q[i] *= rs * gq[part * 16 + i];
        float mx = -3e38f, den = 0.f; float o[16];
#pragma unroll
        for (int i = 0; i < 16; ++i) o[i] = 0.f;
        for (int m = 0; m < 256; ++m) {
            const float4* kp = (const float4*)(kvb + (size_t)m * 512 + hh * 64 + part * 16); const float4* vp = (const float4*)(kvb + (size_t)m * 512 + 256 + hh * 64 + part * 16);
            float s = 0.f;
#pragma unroll
            for (int i = 0; i < 4; ++i) { const float4 t = kp[i]; s += q[4 * i] * t.x + q[4 * i + 1] * t.y + q[4 * i + 2] * t.z + q[4 * i + 3] * t.w; }
            s += __shfl_xor(s, 1); s += __shfl_xor(s, 2);
            const float mn = fmaxf(mx, s); const float sc = expf(mx - mn), e = expf(s - mn); mx = mn; den = den * sc + e;
#pragma unroll
            for (int i = 0; i < 4; ++i) { const float4 t = vp[i]; o[4 * i] = o[4 * i] * sc + e * t.x; o[4 * i + 1] = o[4 * i + 1] * sc + e * t.y; o[4 * i + 2] = o[4 * i + 2] * sc + e * t.z; o[4 * i + 3] = o[4 * i + 3] * sc + e * t.w; }
        }
        const float inv = 1.0f / den; uint4* op = (uint4*)(CATB + (size_t)row * DM + 768 + hh * 64 + part * 16);
#pragma unroll
        for (int i = 0; i < 2; ++i) op[i] = make_uint4(pk2(o[8 * i] * inv, o[8 * i + 1] * inv), pk2(o[8 * i + 2] * inv, o[8 * i + 3] * inv), pk2(o[8 * i + 4] * inv, o[8 * i + 5] * inv), pk2(o[8 * i + 6] * inv, o[8 * i + 7] * inv));
    }
}
__device__ __forceinline__ void rows_post_tile(const Params& p, int row0, int t) {
    float* KVR = (float*)(p.ws + B_KVR); const int tid_ = ltid(); const int lane = tid_ & 63, wid = tid_ >> 6;
    const int c2 = lane >> 5, gg = (lane >> 4) & 1, d = (lane & 15) * 4; bf16_t* KVB = (bf16_t*)(p.ws + B_KVB); const size_t KT = (size_t)BP * 2 * SP * 64;
#pragma unroll 1
    for (int rr0 = wid; rr0 < 256; rr0 += 4 * NW_) {
      float4 vv[4];
#pragma unroll
      for (int k = 0; k < 4; ++k) { const int rowk = row0 + rr0 + k * NW_; vv[k] = ((const float4*)(KVR + (size_t)(rowk < MA ? rowk : MA - 1) * 768 + t * 256))[lane]; }
#pragma unroll
      for (int k = 0; k < 4; ++k) {
        const int row = row0 + rr0 + k * NW_; if (row >= MA) continue;
        float* r = KVR + (size_t)row * 768 + t * 256;
        float4 v = vv[k];
        if (t >= 1) {
            float ss = dot4(v, v);
            ss += __shfl_xor(ss, 1); ss += __shfl_xor(ss, 2); ss += __shfl_xor(ss, 4); ss += __shfl_xor(ss, 8);
            if (lane < 32) { const float rs = rsqrtf(ss * (1.0f / 64) + EPS); const float4 gk = ((const float4*)(t == 1 ? p.in[I_GKSLC] : p.in[I_GKWIN]))[lane & 15];
                v.x *= rs * gk.x; v.y *= rs * gk.y; v.z *= rs * gk.z; v.w *= rs * gk.w;
                if (row >= MP) ((float4*)r)[lane] = v; }
        }
        if (row < MP) {
            const int b = row / SP, sp = row % SP; const size_t off = (((size_t)b * 2 + gg) * SP + sp) * 64 + d;
            if (t == 0) { ((float4*)(p.out + O_PCMP + (size_t)row * 256))[lane] = v; *(uint2*)(KVB + (0 + c2) * KT + off) = make_uint2(pk2(v.x, v.y), pk2(v.z, v.w)); }
            else if (t == 2) { if (sp >= SP - 512) ((float4*)(p.out + O_PWIN + (size_t)(b * 512 + sp - (SP - 512)) * 256))[lane] = v; *(uint2*)(KVB + (4 + c2) * KT + off) = make_uint2(pk2(v.x, v.y), pk2(v.z, v.w)); }
            else {
                ((float4*)(p.out + O_PSLC + (size_t)row * 256))[lane] = v;
                const size_t blkbase = (((size_t)b * 2 + gg) * 32 + (sp >> 6)) * 4096;
                if (c2 == 0) { const int nt = (sp >> 4) & 3, fr2 = sp & 15, ks = d >> 5, fg2 = (d >> 3) & 3, e = d & 7;
                    *(uint2*)((bf16_t*)(p.ws + B_SKF) + blkbase + (size_t)(((nt * 2 + ks) * 64 + fg2 * 16 + fr2) * 8 + e)) = make_uint2(pk2(v.x, v.y), pk2(v.z, v.w)); }
                else { const int cs = (sp >> 5) & 1, kk = sp & 31, fg2 = (kk & 15) >> 2, e = (kk & 3) + (kk >= 16 ? 4 : 0), dt = d >> 4, fr2 = d & 15;
                    bf16_t* vf = (bf16_t*)(p.ws + B_SVF) + blkbase + (size_t)(((dt * 2 + cs) * 64 + fg2 * 16 + fr2) * 8 + e);
                    vf[0] = (bf16_t)f2bf(v.x); vf[8] = (bf16_t)f2bf(v.y); vf[16] = (bf16_t)f2bf(v.z); vf[24] = (bf16_t)f2bf(v.w); } }
        } else {
            const int b = row - MP;
            if (t == 0) ((float4*)(p.out + O_SCMP + (size_t)b * 256))[lane] = v; else if (t == 1) ((float4*)(p.out + O_SSLC + (size_t)b * 256))[lane] = v;
            else ((float4*)(p.out + O_SWIN + (size_t)(b * 512 + 511) * 256))[lane] = v;
        }
      }
    }
}
__device__ __forceinline__ float gelu_tanh(float x) { return 0.5f * x * (1.0f + tanhf(0.7978845608028654f * (x + 0.044715f * x * x * x))); }
__device__ __forceinline__ void ph_compress(const Params& p, float* lds) {
    const float* KVR = (const float*)(p.ws + B_KVR); const int tid = ltid();
    float* xs = lds;
    float* hs = lds + 4096;
    const float* w1 = p.in[I_CW1]; const float* w2 = p.in[I_CW2]; const int* pt = (const int*)p.in[I_PT];
    for (int item = blockIdx.x; item < 136 * 127 * 2; item += gridDim.x) {
        const int c = item & 1, n = (item >> 1) % 127, bb = (item >> 1) / 127;
        __syncthreads();
        for (int i = tid; i < 4096; i += NT_) {
            const int g = i >> 11, pp = (i >> 6) & 31, d = i & 63; const int tok = 16 * n + pp; float x;
            if (bb < 8) x = KVR[(size_t)(bb * SP + tok) * 768 + c * 128 + g * 64 + d];
            else { const int b = bb - 8; const int phys = pt[b * 16 + (tok >> 7)]; x = p.in[I_CCMP][((size_t)phys * 128 + (tok & 127)) * 256 + c * 128 + g * 64 + d]; }
            xs[i] = x + p.in[I_CPOS][(pp * 2 + c) * 64 + d];
        }
        __syncthreads();
        if (tid < 256) { const int g = tid >> 7, h = tid & 127; float pre = p.in[I_CB1][c * 128 + h]; const float* wp = w1 + (size_t)c * 2048 * 128 + h; const float* xp = xs + g * 2048;
          for (int i = 0; i < 2048; ++i) pre = fmaf(xp[i], wp[(size_t)i * 128], pre);
          hs[g * 128 + h] = gelu_tanh(pre); }
        __syncthreads();
        if (tid < 128) {
            const int g = tid >> 6, d = tid & 63; float o = p.in[I_CB2][c * 64 + d];
            for (int h = 0; h < 128; ++h) o = fmaf(hs[g * 128 + h], w2[(size_t)(c * 128 + h) * 64 + d], o);
            if (c == 0) { const float ss = wave_sum(o * o); o = o * rsqrtf(ss * (1.0f / 64) + EPS) * p.in[I_GKCMP][d]; }
            ((float*)(p.ws + (c == 0 ? B_CK : B_CV)))[((size_t)bb * 127 + n) * 128 + g * 64 + d] = o;
            bf16_t* kc = (bf16_t*)(p.ws + B_KC16) + ((((size_t)bb * 2 + c) * 2 + g) * 128 + n) * 64 + d; kc[0] = (bf16_t)f2bf(o); if (n == 126) kc[64] = 0;
        }
    }
}
#ifndef NSA_NAIVE_ALL
#define NSA_NAIVE_ALL 0
#endif
__device__ __forceinline__ void row_softmax(float* r, int n, int lane) {
    float mx = NEGM;
    for (int i = lane; i < n; i += 64) mx = fmaxf(mx, r[i]);
    mx = wave_max(mx);
    if (mx <= 0.5f * NEGM) { for (int i = lane; i < n; i += 64) r[i] = 0.f; return; }
    float s = 0.f;
    for (int i = lane; i < n; i += 64) { const float e = r[i] <= 0.5f * NEGM ? 0.f : expf(r[i] - mx); r[i] = e; s += e; }
    s = wave_sum(s); const float inv = 1.0f / s;
    for (int i = lane; i < n; i += 64) r[i] *= inv;
}
__device__ __forceinline__ void ph_nsa(const Params& p, int j, float* lds) {
    const int tid = ltid(), lane = tid & 63, wid = tid >> 6;
    float* qs = lds;
    float* sc = lds + 384;
    float* imp = sc + 3072;
    int* sel = (int*)(imp + 40);
    float* gate = (float*)(sel + 8);
    float* oacc = gate + 24;
    const bf16_t* P = (const bf16_t*)(p.ws + B_P16); const float* GT = (const float*)(p.ws + B_GT); const float* KVR = (const float*)(p.ws + B_KVR); bf16_t* CATB = (bf16_t*)(p.ws + B_CATB);
    const float* table = p.in[I_REL]; const int* pt = (const int*)p.in[I_PT];
    for (int item = blockIdx.x; item < (NSA_NAIVE_ALL ? MA : BS) * 2; item += gridDim.x) {
        const int row = (NSA_NAIVE_ALL ? 0 : MP) + (item >> 1), g = item & 1; const bool smp = row >= MP;
        const int b = smp ? row - MP : row / SP, pos = smp ? PAST : row % SP;
        const bf16_t* pr = P + (size_t)row * LDB_;
        __syncthreads();
        if (wid < 6) { const int z = wid; const float v = bf2f(pr[(g * 6 + z) * 64 + lane]); const float ss = wave_sum(v * v); qs[z * 64 + lane] = v * rsqrtf(ss * (1.0f / 64) + EPS) * p.in[I_GQ][j * 64 + lane]; }
        if (tid >= 384 && tid < 384 + 18) { const int t2 = tid - 384; const int br = t2 / 6, z = t2 % 6; gate[t2] = sigmoidf_(GT[(size_t)row * GTW + br * 12 + g * 6 + z] + p.in[I_BGATE][j * 36 + br * 12 + g * 6 + z]); }
        if (tid < 384) oacc[tid] = 0.f;
        __syncthreads();
        const float* ck = (const float*)(p.ws + B_CK) + (size_t)(smp ? 8 + b : b) * 127 * 128; const float* cv = (const float*)(p.ws + B_CV) + (size_t)(smp ? 8 + b : b) * 127 * 128;
        for (int i = tid; i < 6 * 127; i += NT_) {
            const int z = i / 127, n = i % 127; const int dist = pos - (16 * n + 31); float s = NEGM;
            if (dist >= 0) { const float4* kp = (const float4*)(ck + n * 128 + g * 64); const float4* qp = (const float4*)(qs + z * 64); float a = 0.f;
#pragma unroll 4
                for (int d = 0; d < 16; ++d) a += dot4(kp[d], qp[d]);
                s = a * 0.125f + table[rel_bucket(dist) * 12 + g * 6 + z]; }
            sc[z * 128 + n] = s;
        }
        __syncthreads();
        if (wid < 6) row_softmax(sc + wid * 128, 127, lane);
        __syncthreads();
        const int nslc = smp ? 33 : 32, cur = pos >> 6;
        if (tid < nslc) { const int jb = tid; float s = 0.f;
            for (int z = 0; z < 6; ++z) for (int n = 0; n < 127; ++n) { const int lo = max(16 * n, 64 * jb), hi = min(16 * n + 32, 64 * jb + 64); if (hi > lo) s += sc[z * 128 + n] * (float)(hi - lo) * (1.0f / 16); }
            imp[jb] = s; }
        __syncthreads();
        if (tid == 0) {
            int cnt = 0;
            if (cur + 1 <= 8) { for (int jb = 0; jb <= cur; ++jb) sel[cnt++] = jb; }
            else {
                sel[0] = 0; sel[1] = cur; sel[2] = cur - 1; cnt = 3; unsigned long long taken = 0ull;
                for (int k = 0; k < 5; ++k) { int best = -1; float bv = -1.f;
                    for (int jb = 1; jb <= cur - 2; ++jb) if (!((taken >> jb) & 1ull) && imp[jb] > bv) { bv = imp[jb]; best = jb; }
                    if (best >= 0) { taken |= 1ull << best; sel[cnt++] = best; } }
            }
            for (; cnt < 8; ++cnt) sel[cnt] = -1;
        }
        if (tid < 384) { const int z = tid >> 6, d = tid & 63; float o = 0.f;
            for (int n = 0; n < 127; ++n) o = fmaf(sc[z * 128 + n], cv[n * 128 + g * 64 + d], o);
            oacc[tid] += gate[0 * 6 + z] * o; }
        __syncthreads();
        for (int br = 1; br <= 2; ++br) {
            { const int t = tid;
                const float* kp = nullptr; int dist = -1;
                if (br == 1) {
                    const int blk = sel[t >> 6];
                    if (blk >= 0) { const int tok = blk * 64 + (t & 63); dist = pos - tok;
                        if (dist >= 0) { if (!smp) kp = KVR + (size_t)(b * SP + tok) * 768 + 256 + g * 64;
                            else if (tok < PAST) kp = p.in[I_CSLC] + ((size_t)pt[b * 16 + (tok >> 7)] * 128 + (tok & 127)) * 256 + g * 64;
                            else kp = KVR + (size_t)row * 768 + 256 + g * 64; } }
                } else {
                    const int kpos = pos - 511 + t; dist = 511 - t;
                    if (!smp) { if (kpos >= 0) kp = KVR + (size_t)(b * SP + kpos) * 768 + 512 + g * 64; else dist = -1; }
                    else { if (kpos < PAST) kp = p.in[I_CWIN] + ((size_t)b * 512 + (kpos - (PAST - 512))) * 256 + g * 64; else kp = KVR + (size_t)row * 768 + 512 + g * 64; }
                }
                if (dist >= 0 && kp) {
                    float s[6] = {0.f, 0.f, 0.f, 0.f, 0.f, 0.f};
#pragma unroll 2
                    for (int d = 0; d < 16; ++d) { const float4 kk = ((const float4*)kp)[d];
#pragma unroll
                        for (int z = 0; z < 6; ++z) s[z] += dot4(kk, ((const float4*)(qs + z * 64))[d]); }
                    const int bk = rel_bucket(dist);
#pragma unroll
                    for (int z = 0; z < 6; ++z) sc[z * 512 + t] = s[z] * 0.125f + table[bk * 12 + g * 6 + z];
                } else {
#pragma unroll
                    for (int z = 0; z < 6; ++z) sc[z * 512 + t] = NEGM;
                }
            }
            __syncthreads();
            if (wid < 6) row_softmax(sc + wid * 512, 512, lane);
            __syncthreads();
            if (tid < 384) { const int z = tid >> 6, d = tid & 63; float o = 0.f;
                for (int t = 0; t < 512; ++t) { const float pw = sc[z * 512 + t]; if (pw != 0.f) { const float* vp;
                    if (br == 1) { const int tok = sel[t >> 6] * 64 + (t & 63);
                        if (!smp) vp = KVR + (size_t)(b * SP + tok) * 768 + 256 + 128 + g * 64;
                        else if (tok < PAST) vp = p.in[I_CSLC] + ((size_t)pt[b * 16 + (tok >> 7)] * 128 + (tok & 127)) * 256 + 128 + g * 64;
                        else vp = KVR + (size_t)row * 768 + 256 + 128 + g * 64;
                    } else { const int kpos = pos - 511 + t;
                        if (!smp) vp = KVR + (size_t)(b * SP + kpos) * 768 + 512 + 128 + g * 64;
                        else if (kpos < PAST) vp = p.in[I_CWIN] + ((size_t)b * 512 + (kpos - (PAST - 512))) * 256 + 128 + g * 64;
                        else vp = KVR + (size_t)row * 768 + 512 + 128 + g * 64; }
                    o = fmaf(pw, vp[d], o); } }
                oacc[tid] += gate[br * 6 + z] * o; }
            __syncthreads();
        }
        if (tid < 384) CATB[(size_t)row * DM + g * 384 + tid] = (bf16_t)f2bf(oacc[tid]);
    }
}
constexpr size_t KVB_T = (size_t)BP * 2 * SP * 64;
typedef short v4i16_t __attribute__((ext_vector_type(4)));
typedef short bf16x8_t __attribute__((ext_vector_type(8)));
typedef float f32x4_t __attribute__((ext_vector_type(4)));
typedef unsigned u32x4_t __attribute__((ext_vector_type(4)));
__device__ __forceinline__ bf16x8_t ldtr2(const LAS unsigned char* p0, const LAS unsigned char* p1) {
    const v4i16_t a = __builtin_amdgcn_ds_read_tr16_b64_v4i16((LAS v4i16_t*)p0), b = __builtin_amdgcn_ds_read_tr16_b64_v4i16((LAS v4i16_t*)p1);
    return __builtin_shufflevector(a, b, 0, 1, 2, 3, 4, 5, 6, 7);
}
__device__ __forceinline__ unsigned cvtpk(float lo, float hi) { unsigned r; asm volatile("v_cvt_pk_bf16_f32 %0, %1, %2" : "=v"(r) : "v"(lo), "v"(hi)); return r; }
__device__ __forceinline__ bf16x8_t pack8(f32x4_t a, f32x4_t b) { uint4 w; w.x = cvtpk(a[0], a[1]); w.y = cvtpk(a[2], a[3]); w.z = cvtpk(b[0], b[1]); w.w = cvtpk(b[2], b[3]); return __builtin_bit_cast(bf16x8_t, w); }
__device__ __forceinline__ f32x4_t mfma16(bf16x8_t a, bf16x8_t b, f32x4_t c) { return __builtin_amdgcn_mfma_f32_16x16x32_bf16(a, b, c, 0, 0, 0); }
__device__ __forceinline__ float ex2(float x) { return __builtin_amdgcn_exp2f(x); }
__device__ __forceinline__ float xmax4(float v) { v = fmaxf(v, __shfl_xor(v, 16)); return fmaxf(v, __shfl_xor(v, 32)); }
__device__ __forceinline__ float xsum4(float v) { v += __shfl_xor(v, 16); return v + __shfl_xor(v, 32); }
constexpr float LOG2E = 1.4426950408889634f, NINF = -__builtin_inff();
constexpr int KROW = 144;

__device__ __forceinline__ void ph_nsa_fast(const Params& p, int j, LAS unsigned char* lds) {
    const int tid = ltid(), lane0 = tid & 63, w = tid >> 6;
    unsigned char* ws = p.ws;
    const bf16_t* P16 = (const bf16_t*)(ws + B_P16); const float* GT = (const float*)(ws + B_GT); bf16_t* CATB = (bf16_t*)(ws + B_CATB);
    const bf16_t* KVB = (const bf16_t*)(ws + B_KVB); const bf16_t* KC16 = (const bf16_t*)(ws + B_KC16);
    LAS unsigned char* Kw = lds;
    LAS unsigned char* Vw = lds + 18432;
    LAS unsigned char* Kc = lds + 36864;
    LAS unsigned char* Vc = lds + 55296;
    LAS float* biasT = (LAS float*)(lds + 73728);
    LAS float* impL = (LAS float*)(lds + 73728 + 3072);
    LAS int* selL = (LAS int*)(lds + 73728 + 3072 + 16384);
    const float* table = p.in[I_REL]; const float* gq = p.in[I_GQ] + j * 64; const float* bgate = p.in[I_BGATE] + j * 36;
    for (int unit = blockIdx.x; unit < 256; unit += gridDim.x) {
        int lane_a = lane0; asm volatile("" : "+v"(lane_a)); const int lane = lane_a, fr = lane & 15, fg = lane >> 4;
        const int g = unit & 1, b = (unit >> 1) & 7, tile = unit >> 4, t0 = tile * 128, tw = t0 + 16 * w, trow = tw + fr;
        TSUB_BEGIN();
        __syncthreads();
        for (int i = tid; i < 2048; i += NT_) { const int tsel = i >> 10, r = (i >> 3) & 127, ch = i & 7;
            const u32x4_t v = *(const u32x4_t*)(KC16 + (((size_t)b * 2 + tsel) * 2 + g) * 128 * 64 + r * 64 + ch * 8);
            *(LAS u32x4_t*)((tsel ? Vc : Kc) + r * KROW + ch * 16) = v; }
        for (int i = tid; i < 768; i += NT_) { const int d = i / 6, z = i % 6; biasT[i] = table[rel_bucket_alu(d) * 12 + g * 6 + z] * LOG2E; }
        if (tid < 64) ((LAS float*)(lds + 73728 + 3072 + 16384 + 4096))[tid] = gq[tid] * (0.125f * LOG2E);
        __syncthreads();
        const bf16_t* qrow = P16 + (size_t)(b * SP + trow) * LDB_ + g * 384;
        LAS float* gqL = (LAS float*)(lds + 73728 + 3072 + 16384 + 4096);
#define FETCH_Q(z_, ra_, rb_) do { ra_ = *(const uint4*)(qrow + (z_) * 64 + fg * 8); rb_ = *(const uint4*)(qrow + (z_) * 64 + 32 + fg * 8); } while (0)
#define LOAD_Q(z_, q0_, q1_) do { uint4 r0, r1; FETCH_Q(z_, r0, r1); FINISH_Q(r0, r1, q0_, q1_); } while (0)
#define FINISH_Q(r0, r1, q0_, q1_) do { \
            float v[16] = {bflo(r0.x), bfhi(r0.x), bflo(r0.y), bfhi(r0.y), bflo(r0.z), bfhi(r0.z), bflo(r0.w), bfhi(r0.w), bflo(r1.x), bfhi(r1.x), bflo(r1.y), bfhi(r1.y), bflo(r1.z), bfhi(r1.z), bflo(r1.w), bfhi(r1.w)}; \
            float ss = 0.f; _Pragma("unroll") for (int i = 0; i < 16; ++i) ss += v[i] * v[i]; \
            ss = xsum4(ss); const float rs = rsqrtf(ss * (1.0f / 64) + EPS); { const f32x4_t g0 = *(const LAS f32x4_t*)(gqL + fg * 8), g1 = *(const LAS f32x4_t*)(gqL + fg * 8 + 4), g2 = *(const LAS f32x4_t*)(gqL + 32 + fg * 8), g3 = *(const LAS f32x4_t*)(gqL + 32 + fg * 8 + 4); \
              _Pragma("unroll") for (int i = 0; i < 4; ++i) { v[i] *= rs * g0[i]; v[4 + i] *= rs * g1[i]; v[8 + i] *= rs * g2[i]; v[12 + i] *= rs * g3[i]; } } \
            q0_ = pack8((f32x4_t){v[0], v[1], v[2], v[3]}, (f32x4_t){v[4], v[5], v[6], v[7]}); q1_ = pack8((f32x4_t){v[8], v[9], v[10], v[11]}, (f32x4_t){v[12], v[13], v[14], v[15]}); } while (0)
        const float* gtrow = GT + (size_t)(b * SP + trow) * GTW;
#pragma unroll 1
        for (int hp = 0; hp < 2; ++hp) {
        bf16x8_t qf[3][2];
#pragma unroll
        for (int z = 0; z < 3; ++z) LOAD_Q(hp * 3 + z, qf[z][0], qf[z][1]);
        f32x4_t O[3][4]; float mrun[3], lrun[3];
#pragma unroll
        for (int z = 0; z < 3; ++z) { mrun[z] = NINF; lrun[z] = 0.f;
#pragma unroll
            for (int dt = 0; dt < 4; ++dt) O[z][dt] = (f32x4_t){0.f, 0.f, 0.f, 0.f}; }
        const bf16_t* WK = KVB + 4 * KVB_T + ((size_t)b * 2 + g) * SP * 64; const bf16_t* WV = KVB + 5 * KVB_T + ((size_t)b * 2 + g) * SP * 64;
        u32x4_t rst[4];
#define WIN_LOAD(it_) do { const int k128_ = t0 - 512 + 128 * (it_); _Pragma("unroll") for (int q_ = 0; q_ < 4; ++q_) { const int i_ = tid + NT_ * q_, tsel_ = i_ >> 10, r_ = (i_ >> 3) & 127, ch_ = i_ & 7; const int tok_ = k128_ + r_; \
            rst[q_] = (u32x4_t){0u, 0u, 0u, 0u}; if (tok_ >= 0) rst[q_] = *(const u32x4_t*)((tsel_ ? WV : WK) + (size_t)tok_ * 64 + ch_ * 8); } } while (0)
#define WIN_STORE() do { _Pragma("unroll") for (int q_ = 0; q_ < 4; ++q_) { const int i_ = tid + NT_ * q_, tsel_ = i_ >> 10, r_ = (i_ >> 3) & 127, ch_ = i_ & 7; *(LAS u32x4_t*)((tsel_ ? Vw : Kw) + r_ * KROW + ch_ * 16) = rst[q_]; } } while (0)
        WIN_LOAD(0);
        __syncthreads();
        WIN_STORE();
#pragma unroll 1
        for (int it = 0; it < 5; ++it) {
            const int k128 = t0 - 512 + 128 * it;
            BAR_LDS();
            if (it + 1 < 5) WIN_LOAD(it + 1);
#pragma unroll 1
            for (int sc = 0; sc < 4; ++sc) {
                const int kb = k128 + 32 * sc;
                if (kb > tw + 15 || kb + 31 < tw - 511 || kb + 31 < 0) continue;
                const bool fast = (kb + 31 <= tw - 113) && (kb >= tw + 15 - 511) && kb >= 0;
                bf16x8_t kf[2][2], vf[4];
#pragma unroll
                for (int nt = 0; nt < 2; ++nt)
#pragma unroll
                    for (int ks = 0; ks < 2; ++ks) kf[nt][ks] = *(const LAS bf16x8_t*)(Kw + (32 * sc + 16 * nt + fr) * KROW + (ks * 32 + fg * 8) * 2);
#pragma unroll
                for (int dt = 0; dt < 4; ++dt) { const LAS unsigned char* vp = Vw + (32 * sc + 4 * fg + (fr >> 2)) * KROW + (16 * dt + 4 * (fr & 3)) * 2; vf[dt] = ldtr2(vp, vp + 16 * KROW); }
#pragma unroll
                for (int z = 0; z < 3; ++z) {
                    f32x4_t s0 = (f32x4_t){0.f, 0.f, 0.f, 0.f}, s1 = s0;
                    s0 = mfma16(kf[0][0], qf[z][0], s0); s0 = mfma16(kf[0][1], qf[z][1], s0);
                    s1 = mfma16(kf[1][0], qf[z][0], s1); s1 = mfma16(kf[1][1], qf[z][1], s1);
                    if (fast) { const float cb = biasT[127 * 6 + hp * 3 + z]; s0 = s0 + cb; s1 = s1 + cb; }
                    else {
#pragma unroll
                        for (int jj = 0; jj < 4; ++jj) { const int key0 = kb + 4 * fg + jj, d0 = trow - key0, d1 = d0 - 16;
                            s0[jj] = (d0 >= 0 && d0 < 512 && key0 >= 0) ? s0[jj] + biasT[min(d0, 127) * 6 + hp * 3 + z] : NINF;
                            s1[jj] = (d1 >= 0 && d1 < 512 && key0 + 16 >= 0) ? s1[jj] + biasT[min(d1, 127) * 6 + hp * 3 + z] : NINF; }
                    }
                    float mx = fmaxf(fmaxf(fmaxf(s0[0], s0[1]), fmaxf(s0[2], s0[3])), fmaxf(fmaxf(s1[0], s1[1]), fmaxf(s1[2], s1[3])));
                    mx = xmax4(mx);
                    const float mnew = fmaxf(mrun[z], mx), msafe = mnew == NINF ? 0.f : mnew;
                    const float alpha = ex2(mrun[z] - msafe);
                    mrun[z] = mnew;
                    f32x4_t p0, p1;
#pragma unroll
                    for (int jj = 0; jj < 4; ++jj) { p0[jj] = ex2(s0[jj] - msafe); p1[jj] = ex2(s1[jj] - msafe); }
                    lrun[z] = lrun[z] * alpha + ((p0[0] + p0[1]) + (p0[2] + p0[3])) + ((p1[0] + p1[1]) + (p1[2] + p1[3]));
                    if (__any(alpha != 1.0f)) {
#pragma unroll
                        for (int dt = 0; dt < 4; ++dt) O[z][dt] = O[z][dt] * alpha; }
                    const bf16x8_t pf = pack8(p0, p1);
#pragma unroll
                    for (int dt = 0; dt < 4; ++dt) O[z][dt] = mfma16(vf[dt], pf, O[z][dt]);
                }
            }
            if (it + 1 < 5) { BAR_LDS(); WIN_STORE(); }
        }
#undef WIN_LOAD
#undef WIN_STORE
#pragma unroll
        for (int z = 0; z < 3; ++z) { const int hz2 = hp * 3 + z; const float lt = xsum4(lrun[z]); const float gw = sigmoidf_(gtrow[24 + g * 6 + hz2] + bgate[24 + g * 6 + hz2]); const float sc = gw / lt;
            bf16_t* orow = CATB + (size_t)(b * SP + trow) * DM + (g * 6 + hz2) * 64;
#pragma unroll
            for (int dt = 0; dt < 4; ++dt) { const f32x4_t v = O[z][dt] * sc; *(uint2*)(orow + 16 * dt + 4 * fg) = make_uint2(cvtpk(v[0], v[1]), cvtpk(v[2], v[3])); } }
        }
        asm volatile("s_waitcnt vmcnt(0)" ::: "memory");
        TSUB_END(0);
        float impacc[8];
#pragma unroll
        for (int nt = 0; nt < 8; ++nt) impacc[nt] = 0.f;
        const int nmax = trow >= 31 ? (trow - 31) >> 4 : -1;
        uint4 rqa_c, rqb_c; FETCH_Q(0, rqa_c, rqb_c);
#pragma unroll 1
        for (int z = 0; z < 6; ++z) {
            bf16_t* orow = CATB + (size_t)(b * SP + trow) * DM + (g * 6 + z) * 64; unsigned long long oldc[4];
#pragma unroll
            for (int dt = 0; dt < 4; ++dt) oldc[dt] = __hip_atomic_load((unsigned long long*)(orow + 16 * dt + 4 * fg), __ATOMIC_RELAXED, __HIP_MEMORY_SCOPE_AGENT);
            const float gcraw = gtrow[g * 6 + z];
            f32x4_t s[8]; bf16x8_t qz[2]; { const uint4 ra = rqa_c, rb = rqb_c; if (z + 1 < 6) FETCH_Q(z + 1, rqa_c, rqb_c); FINISH_Q(ra, rb, qz[0], qz[1]); }
#pragma unroll
            for (int nt = 0; nt < 8; ++nt) { s[nt] = (f32x4_t){0.f, 0.f, 0.f, 0.f};
#pragma unroll
                for (int ks = 0; ks < 2; ++ks) { const bf16x8_t kf = *(const LAS bf16x8_t*)(Kc + (16 * nt + fr) * KROW + (ks * 32 + fg * 8) * 2); s[nt] = mfma16(kf, qz[ks], s[nt]); } }
            float mx = NINF;
#pragma unroll
            for (int nt = 0; nt < 8; ++nt)
#pragma unroll
                for (int jj = 0; jj < 4; ++jj) { const int n = 16 * nt + 4 * fg + jj; const int dist = trow - 16 * n - 31;
                    const float v = (n <= nmax && n <= 126) ? s[nt][jj] + biasT[min(dist, 127) * 6 + z] : NINF; s[nt][jj] = v; mx = fmaxf(mx, v); }
            asm volatile("" ::: "memory");
            mx = xmax4(mx); const float msafe = mx == NINF ? 0.f : mx; float sum = 0.f;
#pragma unroll
            for (int nt = 0; nt < 8; ++nt)
#pragma unroll
                for (int jj = 0; jj < 4; ++jj) { const float e = ex2(s[nt][jj] - msafe); s[nt][jj] = e; sum += e; }
            sum = xsum4(sum); const float inv = sum > 0.f ? 1.0f / sum : 0.f;
            float p3prev = 0.f;
#pragma unroll
            for (int nt = 0; nt < 8; ++nt) { s[nt] = s[nt] * inv;
                const float p3 = s[nt][3]; const float up = __shfl(p3, (lane + 48) & 63);
                const float prev_tile = __shfl(p3prev, (lane + 48) & 63);
                impacc[nt] += 2.0f * (s[nt][0] + s[nt][1] + s[nt][2]) + p3 + (fg == 0 ? prev_tile : up);
                p3prev = p3; }
            f32x4_t oc[4];
#pragma unroll
            for (int dt = 0; dt < 4; ++dt) oc[dt] = (f32x4_t){0.f, 0.f, 0.f, 0.f};
#pragma unroll
            for (int c2 = 0; c2 < 4; ++c2) { const bf16x8_t pf = pack8(s[2 * c2], s[2 * c2 + 1]);
#pragma unroll
                for (int dt = 0; dt < 4; ++dt) { const LAS unsigned char* vp = Vc + (32 * c2 + 4 * fg + (fr >> 2)) * KROW + (16 * dt + 4 * (fr & 3)) * 2; oc[dt] = mfma16(ldtr2(vp, vp + 16 * KROW), pf, oc[dt]); }
                asm volatile("" ::: "memory"); }
            const float gc = sigmoidf_(gcraw + bgate[g * 6 + z]);
#pragma unroll
            for (int dt = 0; dt < 4; ++dt) { const unsigned long long o64 = oldc[dt];
                const f32x4_t v = oc[dt] * gc + (f32x4_t){bflo((unsigned)o64), bfhi((unsigned)o64), bflo((unsigned)(o64 >> 32)), bfhi((unsigned)(o64 >> 32))};
                *(uint2*)(orow + 16 * dt + 4 * fg) = make_uint2(cvtpk(v[0], v[1]), cvtpk(v[2], v[3])); }
        }
        TSUB_END(1);
#pragma unroll
        for (int nt = 0; nt < 8; ++nt) impL[(w * 16 + fr) * 32 + 4 * nt + fg] = impacc[nt];
        asm volatile("s_waitcnt lgkmcnt(0)" ::: "memory");
        if (lane < 16) {
            const int t = tw + lane, cur = t >> 6; LAS int* so = selL + (w * 16 + lane) * 8; const LAS float* im = impL + (w * 16 + lane) * 32;
            int cnt = 0;
            if (cur + 1 <= 8) { for (int jb = 0; jb <= cur; ++jb) so[cnt++] = jb; }
            else {
                so[1] = 0; so[3] = cur; so[5] = cur - 1; unsigned taken = 0u;
                for (int k = 0; k < 5; ++k) { int best = -1; float bv = -1.f;
                    for (int jb = 1; jb <= cur - 2; ++jb) { const float v = im[jb]; if (!((taken >> jb) & 1u) && v > bv) { bv = v; best = jb; } }
                    taken |= 1u << best; so[k < 3 ? 2 * k : 3 + k] = best; }
                cnt = 8; }
            for (; cnt < 8; ++cnt) so[cnt] = -1;
        }
        asm volatile("s_waitcnt vmcnt(0) lgkmcnt(0)" ::: "memory");
        const bf16_t* SKF = (const bf16_t*)(ws + B_SKF) + ((size_t)b * 2 + g) * 32 * 4096; const bf16_t* SVF = (const bf16_t*)(ws + B_SVF) + ((size_t)b * 2 + g) * 32 * 4096;
        const int c0 = 2 * tile;
        TSUB_END(2);
        __syncthreads();
        for (int i = tid; i < 4 * 1024; i += NT_) { const int slot = i >> 10, r = i & 1023; const int blk = slot == 0 ? 0 : c0 - 2 + slot;
            if (blk >= 0 && blk < 32) { const u32x4_t v = *(const u32x4_t*)((r < 512 ? SKF : SVF) + (size_t)blk * 4096 + (r & 511) * 8); *(LAS u32x4_t*)(lds + slot * 16384 + r * 16) = v; } }
        __syncthreads();
        { int lane_b = lane0; asm volatile("" : "+v"(lane_b)); const int lane = lane_b, fr = lane & 15, fg = lane >> 4;
        const int hz = fr < 6 ? fr : 5;
        uint4 rqa, rqb;
        { const bf16_t* qrow = P16 + ((size_t)b * SP + tw) * LDB_ + g * 384 + hz * 64; rqa = *(const uint4*)(qrow + fg * 8); rqb = *(const uint4*)(qrow + 32 + fg * 8); }
#pragma unroll 1
        for (int ti = 0; ti < 16; ++ti) {
            const int t = tw + ti; const size_t row = (size_t)b * SP + t;
            bf16x8_t qs[2];
            const uint4 r0 = rqa, r1 = rqb;
            if (ti + 1 < 16) { const bf16_t* qrow = P16 + (row + 1) * LDB_ + g * 384 + hz * 64; rqa = *(const uint4*)(qrow + fg * 8); rqb = *(const uint4*)(qrow + 32 + fg * 8); }
            bf16_t* orow = CATB + row * DM + (g * 6 + hz) * 64; unsigned long long oldv[4];
#pragma unroll
            for (int dt = 0; dt < 4; ++dt) oldv[dt] = __hip_atomic_load((unsigned long long*)(orow + 16 * dt + 4 * fg), __ATOMIC_RELAXED, __HIP_MEMORY_SCOPE_AGENT);
            const float graw = GT[row * GTW + 12 + g * 6 + hz];
            {
              float v[16] = {bflo(r0.x), bfhi(r0.x), bflo(r0.y), bfhi(r0.y), bflo(r0.z), bfhi(r0.z), bflo(r0.w), bfhi(r0.w), bflo(r1.x), bfhi(r1.x), bflo(r1.y), bfhi(r1.y), bflo(r1.z), bfhi(r1.z), bflo(r1.w), bfhi(r1.w)};
              float ss = 0.f;
#pragma unroll
              for (int i = 0; i < 16; ++i) ss += v[i] * v[i];
              ss = xsum4(ss); const float rs = rsqrtf(ss * (1.0f / 64) + EPS) * (0.125f * LOG2E);
#pragma unroll
              for (int i = 0; i < 8; ++i) { v[i] *= rs * gq[fg * 8 + i]; v[8 + i] *= rs * gq[32 + fg * 8 + i]; }
              qs[0] = pack8((f32x4_t){v[0], v[1], v[2], v[3]}, (f32x4_t){v[4], v[5], v[6], v[7]});
              qs[1] = pack8((f32x4_t){v[8], v[9], v[10], v[11]}, (f32x4_t){v[12], v[13], v[14], v[15]}); }
            f32x4_t os[4]; float ms = NINF, ls = 0.f;
#pragma unroll
            for (int dt = 0; dt < 4; ++dt) os[dt] = (f32x4_t){0.f, 0.f, 0.f, 0.f};
#define SLC_LOADK(KF, blk_) do { const int slot_ = (blk_) == 0 ? 0 : ((blk_) >= c0 - 1 ? (blk_) - c0 + 2 : -1); \
                if (slot_ >= 0) { const LAS unsigned char* fb_ = lds + slot_ * 16384 + lane * 16; \
                    _Pragma("unroll") for (int nt = 0; nt < 4; ++nt) _Pragma("unroll") for (int ks = 0; ks < 2; ++ks) KF[nt][ks] = *(const LAS bf16x8_t*)(fb_ + (nt * 2 + ks) * 1024); \
                } else { const bf16_t* kb_ = SKF + (size_t)(blk_) * 4096 + lane * 8; \
                    _Pragma("unroll") for (int nt = 0; nt < 4; ++nt) _Pragma("unroll") for (int ks = 0; ks < 2; ++ks) KF[nt][ks] = *(const bf16x8_t*)(kb_ + (nt * 2 + ks) * 512); } } while (0)
#define SLC_LOADV(VF, blk_) do { const int slot_ = (blk_) == 0 ? 0 : ((blk_) >= c0 - 1 ? (blk_) - c0 + 2 : -1); \
                if (slot_ >= 0) { const LAS unsigned char* fb_ = lds + slot_ * 16384 + lane * 16; \
                    _Pragma("unroll") for (int dt = 0; dt < 4; ++dt) _Pragma("unroll") for (int cs = 0; cs < 2; ++cs) VF[dt][cs] = *(const LAS bf16x8_t*)(fb_ + 8192 + (dt * 2 + cs) * 1024); \
                } else { const bf16_t* vb_ = SVF + (size_t)(blk_) * 4096 + lane * 8; \
                    _Pragma("unroll") for (int dt = 0; dt < 4; ++dt) _Pragma("unroll") for (int cs = 0; cs < 2; ++cs) VF[dt][cs] = *(const bf16x8_t*)(vb_ + (dt * 2 + cs) * 512); } } while (0)
#define SLC_COMPUTE(KF, VF, blk_, nblk_) do { const int tok0 = (blk_) * 64; f32x4_t s[4]; \
                _Pragma("unroll") for (int nt = 0; nt < 4; ++nt) { s[nt] = (f32x4_t){0.f, 0.f, 0.f, 0.f}; s[nt] = mfma16(KF[nt][0], qs[0], s[nt]); s[nt] = mfma16(KF[nt][1], qs[1], s[nt]); } \
                float mx = NINF; \
                if (tok0 + 63 <= t - 113) { const float cb = biasT[127 * 6 + hz]; \
                    _Pragma("unroll") for (int nt = 0; nt < 4; ++nt) { s[nt] = s[nt] + cb; mx = fmaxf(mx, fmaxf(fmaxf(s[nt][0], s[nt][1]), fmaxf(s[nt][2], s[nt][3]))); } } \
                else { _Pragma("unroll") for (int nt = 0; nt < 4; ++nt) _Pragma("unroll") for (int jj = 0; jj < 4; ++jj) { const int dist = t - (tok0 + 16 * nt + 4 * fg + jj); const float v = dist >= 0 ? s[nt][jj] + biasT[min(dist, 127) * 6 + hz] : NINF; s[nt][jj] = v; mx = fmaxf(mx, v); } } \
                mx = xmax4(mx); \
                const float mnew = fmaxf(ms, mx), msafe = mnew == NINF ? 0.f : mnew; const float alpha = ex2(ms - msafe); ms = mnew; \
                float sum = 0.f; \
                _Pragma("unroll") for (int nt = 0; nt < 4; ++nt) _Pragma("unroll") for (int jj = 0; jj < 4; ++jj) { const float e = ex2(s[nt][jj] - msafe); s[nt][jj] = e; sum += e; } \
                ls = ls * alpha + sum; \
                _Pragma("unroll") for (int dt = 0; dt < 4; ++dt) os[dt] = os[dt] * alpha; \
                _Pragma("unroll") for (int cs = 0; cs < 2; ++cs) { const bf16x8_t pf = pack8(s[2 * cs], s[2 * cs + 1]); \
                    _Pragma("unroll") for (int dt = 0; dt < 4; ++dt) os[dt] = mfma16(VF[dt][cs], pf, os[dt]); } \
                if ((nblk_) >= 0) SLC_LOADV(VF, nblk_); } while (0)
            const LAS int* sbl = selL + (w * 16 + ti) * 8; int nb = 0;
#pragma unroll
            for (int bi = 0; bi < 8; ++bi) nb += sbl[bi] >= 0 ? 1 : 0;
            bf16x8_t kfC[4][2], kfN[4][2], vfX[4][2];
            { const int b0 = sbl[0]; SLC_LOADK(kfN, b0); SLC_LOADV(vfX, b0); }
#pragma unroll 1
            for (int bi = 0; bi < nb; ++bi) {
                const int bA = sbl[bi], bB = bi + 1 < nb ? sbl[bi + 1] : -1;
#pragma unroll
                for (int nt = 0; nt < 4; ++nt) { kfC[nt][0] = kfN[nt][0]; kfC[nt][1] = kfN[nt][1]; }
                if (bB >= 0) SLC_LOADK(kfN, bB);
                SLC_COMPUTE(kfC, vfX, bA, bB);
            }
#undef SLC_LOADK
#undef SLC_LOADV
#undef SLC_COMPUTE
            const float lt = xsum4(ls);
            if (fr < 6) {
                const float gs = sigmoidf_(graw + bgate[12 + g * 6 + fr]); const float sc = lt > 0.f ? gs / lt : 0.f;
#pragma unroll
                for (int dt = 0; dt < 4; ++dt) { const unsigned long long o64 = oldv[dt]; const f32x4_t v = os[dt] * sc + (f32x4_t){bflo((unsigned)o64), bfhi((unsigned)o64), bflo((unsigned)(o64 >> 32)), bfhi((unsigned)(o64 >> 32))};
                    *(uint2*)(orow + 16 * dt + 4 * fg) = make_uint2(cvtpk(v[0], v[1]), cvtpk(v[2], v[3])); }
            }
        }
        }
        TSUB_END(3);
    }
}

constexpr int CW_P = 272, CW_BUF = 128 * CW_P;
template <bool SMP> __device__ __forceinline__ void compress_job(const Params& p, int bb, int c, int g, LAS unsigned char* lds) {
    const int tid = ltid(), lane = tid & 63, w = tid >> 6, fr = lane & 15, fg = lane >> 4, n = 16 * w + fr;
    unsigned char* ws = p.ws;
    const bf16_t* W1T = (const bf16_t*)(ws + B_W1T) + (size_t)c * 128 * 2048; const bf16_t* W2T = (const bf16_t*)(ws + B_W2T) + (size_t)c * 64 * 128;
    f32x4_t acc[8];
#pragma unroll
    for (int t = 0; t < 8; ++t) acc[t] = (f32x4_t){0.f, 0.f, 0.f, 0.f};
    const bf16_t* ap = (const bf16_t*)(ws + B_KVB) + (size_t)c * KVB_T + ((size_t)(SMP ? 0 : bb) * 2 + g) * SP * 64 + (size_t)n * 1024 + fg * 8;
    const float* pg0 = nullptr; const float* pg1 = nullptr; int tsplit = 0;
    if (SMP) { const int* pt = (const int*)p.in[I_PT] + (bb - 8) * 16; const int t0 = 16 * n > 2016 ? 2016 : 16 * n; const int pa = t0 >> 7, pb = (t0 + 31) >> 7;
        pg0 = p.in[I_CCMP] + (((size_t)pt[pa] * 128 + (t0 & 127)) * 4 + c * 2 + g) * 64 + fg * 8; tsplit = pb == pa ? 64 : 128 - (t0 & 127);
        pg1 = p.in[I_CCMP] + (((size_t)pt[pb] * 128) * 4 + c * 2 + g) * 64 + fg * 8 - (size_t)tsplit * 256; }
    u32x4_t rb[4]; bf16x8_t acur[4]; f32x4_t araw[SMP ? 8 : 1]; bf16x8_t anext[SMP ? 1 : 4];
#define CW_LOADB(st_) do { _Pragma("unroll") for (int i_ = 0; i_ < 4; ++i_) { const int ch_ = tid + NT_ * i_, r_ = ch_ >> 4, cc_ = ch_ & 15; rb[i_] = *(const u32x4_t*)(W1T + (size_t)r_ * 2048 + (st_) * 128 + cc_ * 8); } } while (0)
#define CW_STOREB(buf_) do { _Pragma("unroll") for (int i_ = 0; i_ < 4; ++i_) { const int ch_ = tid + NT_ * i_, r_ = ch_ >> 4, cc_ = ch_ & 15; *(LAS u32x4_t*)(lds + (buf_) * CW_BUF + r_ * CW_P + cc_ * 16) = rb[i_]; } } while (0)
#define CW_LOADA(st_) do { _Pragma("unroll") for (int u_ = 0; u_ < 4; ++u_) { const int s_ = (st_) * 4 + u_; \
        if (SMP) { const int tk_ = s_ >> 1; const float* src_ = (tk_ < tsplit ? pg0 : pg1) + (size_t)tk_ * 256 + (s_ & 1) * 32; araw[2 * u_] = *(const f32x4_t*)src_; araw[2 * u_ + 1] = *(const f32x4_t*)(src_ + 4); } \
        else anext[u_] = *(const bf16x8_t*)(ap + s_ * 32); } } while (0)
#define CW_TAKEA() do { _Pragma("unroll") for (int u_ = 0; u_ < 4; ++u_) { if (SMP) acur[u_] = pack8(araw[2 * u_], araw[2 * u_ + 1]); else acur[u_] = anext[u_]; } } while (0)
    __syncthreads();
    CW_LOADB(0); CW_LOADA(0); CW_STOREB(0); CW_TAKEA();
    BAR_LDS();
#pragma unroll 1
    for (int st = 0; st < 16; ++st) {
        if (st + 1 < 16) { CW_LOADB(st + 1); CW_LOADA(st + 1); }
        const LAS unsigned char* bb_ = lds + (st & 1) * CW_BUF + fr * CW_P + fg * 16;
#pragma unroll
        for (int u = 0; u < 4; ++u)
#pragma unroll
            for (int t = 0; t < 8; ++t) acc[t] = mfma16(*(const LAS bf16x8_t*)(bb_ + t * 16 * CW_P + u * 64), acur[u], acc[t]);
        if (st + 1 < 16) { CW_STOREB((st + 1) & 1); CW_TAKEA(); }
        BAR_LDS();
    }
#undef CW_LOADB
#undef CW_STOREB
#undef CW_LOADA
#undef CW_TAKEA
    const float* peb = (const float*)(ws + B_PEB) + c * 128;
#pragma unroll
    for (int t = 0; t < 8; ++t) { const f32x4_t pb = *(const f32x4_t*)(peb + 16 * t + 4 * fg);
#pragma unroll
        for (int j = 0; j < 4; ++j) { const float x = acc[t][j] + pb[j]; const float u2 = 1.5957691216057308f * (x + 0.044715f * x * x * x);
            const float th = 1.0f - 2.0f * __builtin_amdgcn_rcpf(1.0f + ex2(u2 * LOG2E)); acc[t][j] = 0.5f * x * (1.0f + th); } }
    f32x4_t o[4];
#pragma unroll
    for (int dt = 0; dt < 4; ++dt) o[dt] = (f32x4_t){0.f, 0.f, 0.f, 0.f};
#pragma unroll
    for (int ks = 0; ks < 4; ++ks) { const bf16x8_t gf = pack8(acc[2 * ks], acc[2 * ks + 1]);
#pragma unroll
        for (int dt = 0; dt < 4; ++dt) { const bf16_t* wp = W2T + (size_t)(16 * dt + fr) * 128 + 32 * ks + 4 * fg; const uint2 x0 = *(const uint2*)wp, x1 = *(const uint2*)(wp + 16);
            o[dt] = mfma16(__builtin_bit_cast(bf16x8_t, make_uint4(x0.x, x0.y, x1.x, x1.y)), gf, o[dt]); } }
    float ss = 0.f;
#pragma unroll
    for (int dt = 0; dt < 4; ++dt) { const f32x4_t b2 = *(const f32x4_t*)(p.in[I_CB2] + c * 64 + 16 * dt + 4 * fg); o[dt] = o[dt] + b2; ss += (o[dt][0] * o[dt][0] + o[dt][1] * o[dt][1]) + (o[dt][2] * o[dt][2] + o[dt][3] * o[dt][3]); }
    if (c == 0) { ss = xsum4(ss); const float rs = rsqrtf(ss * (1.0f / 64) + EPS);
#pragma unroll
        for (int dt = 0; dt < 4; ++dt) { const f32x4_t gk = *(const f32x4_t*)(p.in[I_GKCMP] + 16 * dt + 4 * fg); o[dt] = o[dt] * rs * gk; } }
    bf16_t* kc = (bf16_t*)(ws + B_KC16) + ((((size_t)bb * 2 + c) * 2 + g) * 128 + n) * 64;
    float* cf = (float*)(ws + (c == 0 ? B_CK : B_CV)) + ((size_t)bb * 127 + n) * 128 + g * 64;
#pragma unroll
    for (int dt = 0; dt < 4; ++dt) {
        if (n < 127) { *(f32x4_t*)(cf + 16 * dt + 4 * fg) = o[dt]; *(uint2*)(kc + 16 * dt + 4 * fg) = make_uint2(cvtpk(o[dt][0], o[dt][1]), cvtpk(o[dt][2], o[dt][3])); }
        else { unsigned z = 0u; asm volatile("" : "+v"(z)); *(uint2*)(kc + 16 * dt + 4 * fg) = make_uint2(z, z); }
    }
}
__device__ __forceinline__ void ph_compress_fast(const Params& p, LAS unsigned char* lds) {
    for (int job = blockIdx.x; job < 544; job += gridDim.x) { const int jj = job < 512 ? job + 32 : job - 512; const int bb = jj >> 2, c = (jj >> 1) & 1, g = jj & 1;
        if (bb < 8) compress_job<false>(p, bb, c, g, lds); else compress_job<true>(p, bb, c, g, lds); }
}
constexpr int ML_QP = 400, ML_VP = 80, ML_WP = 112;
__device__ __forceinline__ void ph_mlstm_fast(const Params& p, int l, LAS unsigned char* lds) {
    const int tid = ltid(), lane = tid & 63, w = tid >> 6, fr = lane & 15, fg = lane >> 4;
    unsigned char* ws = p.ws;
    const bf16_t* P16 = (const bf16_t*)(ws + B_P16); const float* GT = (const float*)(ws + B_GT); const float* bif = p.in[I_BIF] + l * 8; float* HR = (float*)(ws + B_HRAW);
    LAS unsigned char* Ql = lds;
    LAS unsigned char* Kl = lds + 25600;
    LAS unsigned char* Vl = lds + 51200;
    LAS unsigned char* Wl = lds + 56320;
    LAS unsigned char* CT = lds + 63488;
    LAS float* INTER = (LAS float*)(lds + 82688);
    LAS float* QN = (LAS float*)(lds + 91904);
    LAS float* RTa = (LAS float*)(lds + 92160);
    LAS float* WSa = RTa + 2048;
    LAS float* EIa = RTa + 4096;
    LAS float* DEC = RTa + 6144;
    LAS float* Gk = DEC + 32; LAS float* Ak = DEC + 64; LAS float* MPk = DEC + 96;
    for (int unit = blockIdx.x; unit < 192; unit += gridDim.x) {
        const int es = unit % 6, h = (unit / 6) & 3, b = unit / 24;
        const size_t row0 = (size_t)b * SP;
        __syncthreads();
        for (int i = tid; i < 48 * 100; i += NT_) ((LAS unsigned*)CT)[i] = 0u;
        for (int i = tid; i < 64 * 28; i += NT_) ((LAS unsigned*)Wl)[i] = 0u;
        float gia[4], gfa[4];
#pragma unroll
        for (int q = 0; q < 4; ++q) { const float* g_ = GT + (row0 + 64 * (w + 8 * q) + lane) * GTW; gia[q] = g_[h]; gfa[q] = g_[4 + h]; }
#pragma unroll
        for (int q = 0; q < 4; ++q) { const int k = w + 8 * q; const float gi = gia[q] + bif[h], gf = gfa[q] + bif[4 + h];
            float bc = logsigmoidf_(gf);
#pragma unroll
            for (int o = 1; o < 64; o <<= 1) { const float t = __shfl_up(bc, o); if (lane >= o) bc += t; }
            const float u = gi - bc; float pm = u;
#pragma unroll
            for (int o = 1; o < 64; o <<= 1) { const float t = __shfl_up(pm, o); if (lane >= o) pm = fmaxf(pm, t); }
            EIa[k * 64 + lane] = bc; RTa[k * 64 + lane] = pm; WSa[k * 64 + lane] = u;
            if (lane == 63) { Gk[k] = bc; Ak[k] = pm; } }
        __syncthreads();
        if (tid == 0) { float m = NEGM; for (int k = 0; k < 32; ++k) { MPk[k] = m; m = Gk[k] + fmaxf(Ak[k], m); } MPk[32] = m; }
        __syncthreads();
#pragma unroll 1
        for (int k = w; k < 32; k += 8) { const float mp = MPk[k], M63 = fmaxf(Ak[k], mp); const float bc = EIa[k * 64 + lane], pm = RTa[k * 64 + lane], u = WSa[k * 64 + lane]; const float M = fmaxf(pm, mp);
            RTa[k * 64 + lane] = expf(M63 - M); WSa[k * 64 + lane] = expf(u - M63); EIa[k * 64 + lane] = expf(-(bc + M)); if (lane == 0) DEC[k] = expf(mp - M63); }
        f32x4_t cacc[5];
#pragma unroll
        for (int i = 0; i < 5; ++i) cacc[i] = (f32x4_t){0.f, 0.f, 0.f, 0.f};
        u32x4_t rq[3], rk[3], rv;
#define ML_LOAD(c_) do { const size_t rb_ = row0 + 64 * (c_); \
            _Pragma("unroll") for (int i_ = 0; i_ < 3; ++i_) { const int ch_ = tid + NT_ * i_, r_ = ch_ / 24, cc_ = ch_ % 24; const bf16_t* src_ = P16 + (rb_ + r_) * LDA_ + h * 192 + cc_ * 8; rq[i_] = *(const u32x4_t*)src_; rk[i_] = *(const u32x4_t*)(src_ + 768); } \
            if (tid < 256) { const int r_ = tid >> 2, cc_ = tid & 3; rv = *(const u32x4_t*)(P16 + (rb_ + r_) * LDA_ + 1536 + h * 192 + es * 32 + cc_ * 8); } } while (0)
#define ML_STORE(c_) do { \
            _Pragma("unroll") for (int i_ = 0; i_ < 3; ++i_) { const int ch_ = tid + NT_ * i_, r_ = ch_ / 24, cc_ = ch_ % 24; *(LAS u32x4_t*)(Ql + r_ * ML_QP + cc_ * 16) = rq[i_]; *(LAS u32x4_t*)(Kl + r_ * ML_QP + cc_ * 16) = rk[i_]; } \
            if (tid < 256) { const int r_ = tid >> 2, cc_ = tid & 3; *(LAS u32x4_t*)(Vl + r_ * ML_VP + cc_ * 16) = rv; const float wv_ = WSa[(c_) * 64 + r_]; \
                u32x4_t y_; y_.x = cvtpk(bflo(rv.x) * wv_, bfhi(rv.x) * wv_); y_.y = cvtpk(bflo(rv.y) * wv_, bfhi(rv.y) * wv_); y_.z = cvtpk(bflo(rv.z) * wv_, bfhi(rv.z) * wv_); y_.w = cvtpk(bflo(rv.w) * wv_, bfhi(rv.w) * wv_); \
                *(LAS u32x4_t*)(Wl + r_ * ML_WP + cc_ * 16) = y_; if (cc_ == 0) *(LAS bf16_t*)(Wl + r_ * ML_WP + 64) = (bf16_t)f2bf(wv_); } } while (0)
        ML_LOAD(0);
        __syncthreads();
        ML_STORE(0);
#pragma unroll 1
        for (int c = 0; c < 32; ++c) {
            BAR_LDS();
            if (c + 1 < 32) ML_LOAD(c + 1);
            f32x4_t hin[2]; float rsum = 0.f;
            hin[0] = (f32x4_t){0.f, 0.f, 0.f, 0.f}; hin[1] = hin[0];
            if (w < 4) {
                const int tt = w;
                f32x4_t S[4];
#pragma unroll
                for (int st = 0; st < 4; ++st) { S[st] = (f32x4_t){0.f, 0.f, 0.f, 0.f};
                    if (st <= tt) {
#pragma unroll
                        for (int ks = 0; ks < 6; ++ks) { const bf16x8_t kf = *(const LAS bf16x8_t*)(Kl + (16 * st + fr) * ML_QP + (32 * ks + 8 * fg) * 2), qf = *(const LAS bf16x8_t*)(Ql + (16 * tt + fr) * ML_QP + (32 * ks + 8 * fg) * 2);
                            S[st] = mfma16(kf, qf, S[st]); }
                        const f32x4_t wv = *(const LAS f32x4_t*)(WSa + c * 64 + 16 * st + 4 * fg); S[st] = S[st] * wv;
                        if (st == tt) {
#pragma unroll
                            for (int jj = 0; jj < 4; ++jj) if (4 * fg + jj > fr) S[st][jj] = 0.f; }
                        rsum += (S[st][0] + S[st][1]) + (S[st][2] + S[st][3]);
                    } }
                rsum = xsum4(rsum);
#pragma unroll
                for (int kk = 0; kk < 2; ++kk) { if (2 * kk <= tt) { const bf16x8_t pf = pack8(S[2 * kk], S[2 * kk + 1]);
#pragma unroll
                    for (int et = 0; et < 2; ++et) { const LAS unsigned char* vp = Vl + (32 * kk + 4 * fg + (fr >> 2)) * ML_VP + (16 * et + 4 * (fr & 3)) * 2; hin[et] = mfma16(ldtr2(vp, vp + 16 * ML_VP), pf, hin[et]); } } }
            } else {
                const int tt = w - 4;
                f32x4_t I[3];
#pragma unroll
                for (int e3 = 0; e3 < 3; ++e3) { I[e3] = (f32x4_t){0.f, 0.f, 0.f, 0.f};
#pragma unroll
                    for (int ks = 0; ks < 6; ++ks) { const bf16x8_t cf = *(const LAS bf16x8_t*)(CT + (16 * e3 + fr) * ML_QP + (32 * ks + 8 * fg) * 2), qf = *(const LAS bf16x8_t*)(Ql + (16 * tt + fr) * ML_QP + (32 * ks + 8 * fg) * 2);
                        I[e3] = mfma16(cf, qf, I[e3]); } }
                *(LAS f32x4_t*)(INTER + (16 * tt + fr) * 36 + 4 * fg) = I[0]; *(LAS f32x4_t*)(INTER + (16 * tt + fr) * 36 + 16 + 4 * fg) = I[1];
                if (fg == 0) QN[16 * tt + fr] = I[2][0];
            }
            BAR_LDS();
            const float decay = DEC[c];
            if (w < 4) {
                const int t = 16 * w + fr; const float r = RTa[c * 64 + t], einv = EIa[c * 64 + t], qn = QN[t];
                const float den = r * (rsum + decay * qn); const float inv = 1.0f / fmaxf(fabsf(den), einv);
                float* hp = HR + (row0 + 64 * c + t) * 768 + h * 192 + es * 32;
#pragma unroll
                for (int et = 0; et < 2; ++et) { const f32x4_t in2 = *(const LAS f32x4_t*)(INTER + t * 36 + 16 * et + 4 * fg); const f32x4_t num = (hin[et] + in2 * decay) * r; *(f32x4_t*)(hp + 16 * et + 4 * fg) = num * inv; }
            }
#pragma unroll
            for (int i = 0; i < 5; ++i) { const int idx = w + 8 * i; if (idx < 36) { const int dtile = idx / 3, et = idx % 3; cacc[i] = cacc[i] * decay;
#pragma unroll
                for (int ks = 0; ks < 2; ++ks) { const LAS unsigned char* kp = Kl + (32 * ks + 8 * fg + (fr >> 2)) * ML_QP + (16 * dtile + 4 * (fr & 3)) * 2; const LAS unsigned char* vp = Wl + (32 * ks + 8 * fg + (fr >> 2)) * ML_WP + (16 * et + 4 * (fr & 3)) * 2;
                    cacc[i] = mfma16(ldtr2(kp, kp + 4 * ML_QP), ldtr2(vp, vp + 4 * ML_WP), cacc[i]); } } }
            BAR_LDS();
#pragma unroll
            for (int i = 0; i < 5; ++i) { const int idx = w + 8 * i; if (idx < 36) { const int dtile = idx / 3, et = idx % 3;
                typedef unsigned u32x2_t __attribute__((ext_vector_type(2))); u32x2_t wv; wv.x = cvtpk(cacc[i][0], cacc[i][1]); wv.y = cvtpk(cacc[i][2], cacc[i][3]);
                *(LAS u32x2_t*)(CT + (16 * et + fr) * ML_QP + (16 * dtile + 4 * fg) * 2) = wv; } }
            if (c + 1 < 32) ML_STORE(c + 1);
        }
#pragma unroll
        for (int i = 0; i < 5; ++i) { const int idx = w + 8 * i; if (idx < 36) { const int dtile = idx / 3, et = idx % 3;
            if (et < 2) { float* co = p.out + O_PC + ((size_t)((l * 8 + b) * 4 + h) * 192 + 16 * dtile + 4 * fg) * 192 + es * 32 + 16 * et + fr;
#pragma unroll
                for (int jj = 0; jj < 4; ++jj) co[(size_t)jj * 192] = cacc[i][jj]; }
            else if (es == 0 && fr == 0) { float* no = p.out + O_PN + (size_t)((l * 8 + b) * 4 + h) * 192 + 16 * dtile + 4 * fg;
#pragma unroll
                for (int jj = 0; jj < 4; ++jj) no[jj] = cacc[i][jj]; } } }
        if (es == 0 && tid == 0) p.out[O_PM + (l * 8 + b) * 4 + h] = MPk[32];
#undef ML_LOAD
#undef ML_STORE
    }
}
__device__ __forceinline__ void ph_mem_attn_fast(const Params& p, int l, LAS unsigned char* lds, int u0, int ucnt, int ustep) {
    const int tid = ltid(), lane0 = tid & 63, w = tid >> 6;
    const int ldp = l < 2 ? LDA_ : LDB_, qoff = l < 2 ? 3072 : 768;
    const bf16_t* P16 = (const bf16_t*)(p.ws + B_P16); bf16_t* CATB = (bf16_t*)(p.ws + B_CATB); const float* gq = p.in[I_GMEMQ] + l * 64;
    LAS unsigned char* Km = lds;
    LAS unsigned char* Vm = lds + 36864;
    const float* gmk = p.in[I_GMEMK] + l * 64;
    for (int ui = 0; ui < ucnt; ++ui) { const int unit = u0 + ui * ustep; if (unit >= 256) break;
        int lane_a = lane0; asm volatile("" : "+v"(lane_a)); const int lane = lane_a, fr = lane & 15, fg = lane >> 4;
        const int oct = unit & 7, hh = (unit >> 3) & 3, b = unit >> 5;
        const float* kv = (const float*)(p.ws + B_MEMR) + (size_t)(l * 8 + b) * 256 * 512 + hh * 64;
        __syncthreads();
        {
            f32x4_t x[16];
#pragma unroll
            for (int k = 0; k < 16; ++k) { const int i = tid + NT_ * k, tsel = i >> 12, m = (i >> 4) & 255, ch = i & 15; x[k] = *(const f32x4_t*)(kv + (size_t)m * 512 + tsel * 256 + ch * 4); }
#pragma unroll
            for (int k = 0; k < 16; ++k) { const int i = tid + NT_ * k, tsel = i >> 12, m = (i >> 4) & 255, ch = i & 15;
                if (k < 8) { float ss = (x[k][0] * x[k][0] + x[k][1] * x[k][1]) + (x[k][2] * x[k][2] + x[k][3] * x[k][3]);
                    ss += __shfl_xor(ss, 1); ss += __shfl_xor(ss, 2); ss += __shfl_xor(ss, 4); ss += __shfl_xor(ss, 8);
                    const float rs = rsqrtf(ss * (1.0f / 64) + EPS); const f32x4_t gk = *(const f32x4_t*)(gmk + ch * 4); x[k] = x[k] * rs * gk; }
                typedef unsigned u32x2_t __attribute__((ext_vector_type(2))); u32x2_t y; y.x = cvtpk(x[k][0], x[k][1]); y.y = cvtpk(x[k][2], x[k][3]);
                *(LAS u32x2_t*)((tsel ? Vm : Km) + m * KROW + ch * 8) = y; }
        }
        __syncthreads();
#pragma unroll 1
        for (int ps = 0; ps < 2; ++ps) {
            const size_t row = (size_t)b * SP + oct * 256 + ps * 128 + w * 16 + fr;
            bf16x8_t qf[2];
            { const bf16_t* qrow = P16 + row * ldp + qoff + hh * 64;
              const uint4 r0 = *(const uint4*)(qrow + fg * 8), r1 = *(const uint4*)(qrow + 32 + fg * 8);
              float v[16] = {bflo(r0.x), bfhi(r0.x), bflo(r0.y), bfhi(r0.y), bflo(r0.z), bfhi(r0.z), bflo(r0.w), bfhi(r0.w), bflo(r1.x), bfhi(r1.x), bflo(r1.y), bfhi(r1.y), bflo(r1.z), bfhi(r1.z), bflo(r1.w), bfhi(r1.w)};
              float ss = 0.f;
#pragma unroll
              for (int i = 0; i < 16; ++i) ss += v[i] * v[i];
              ss = xsum4(ss); const float rs = rsqrtf(ss * (1.0f / 64) + EPS) * (0.125f * LOG2E);
#pragma unroll
              for (int i = 0; i < 8; ++i) { v[i] *= rs * gq[fg * 8 + i]; v[8 + i] *= rs * gq[32 + fg * 8 + i]; }
              qf[0] = pack8((f32x4_t){v[0], v[1], v[2], v[3]}, (f32x4_t){v[4], v[5], v[6], v[7]});
              qf[1] = pack8((f32x4_t){v[8], v[9], v[10], v[11]}, (f32x4_t){v[12], v[13], v[14], v[15]}); }
            f32x4_t S[16]; float mx = NINF;
#pragma unroll
            for (int nt = 0; nt < 16; ++nt) { S[nt] = (f32x4_t){0.f, 0.f, 0.f, 0.f};
#pragma unroll
                for (int ks = 0; ks < 2; ++ks) { const bf16x8_t kf = *(const LAS bf16x8_t*)(Km + (16 * nt + fr) * KROW + (32 * ks + 8 * fg) * 2); S[nt] = mfma16(kf, qf[ks], S[nt]); }
                mx = fmaxf(mx, fmaxf(fmaxf(S[nt][0], S[nt][1]), fmaxf(S[nt][2], S[nt][3]))); }
            mx = xmax4(mx); float sum = 0.f;
#pragma unroll
            for (int nt = 0; nt < 16; ++nt)
#pragma unroll
                for (int jj = 0; jj < 4; ++jj) { const float e = ex2(S[nt][jj] - mx); S[nt][jj] = e; sum += e; }
            sum = xsum4(sum); const float inv = 1.0f / sum;
            f32x4_t o[4];
#pragma unroll
            for (int dt = 0; dt < 4; ++dt) o[dt] = (f32x4_t){0.f, 0.f, 0.f, 0.f};
#pragma unroll
            for (int c2 = 0; c2 < 8; ++c2) { const bf16x8_t pf = pack8(S[2 * c2], S[2 * c2 + 1]);
#pragma unroll
                for (int dt = 0; dt < 4; ++dt) { const LAS unsigned char* vp = Vm + (32 * c2 + 4 * fg + (fr >> 2)) * KROW + (16 * dt + 4 * (fr & 3)) * 2; o[dt] = mfma16(ldtr2(vp, vp + 16 * KROW), pf, o[dt]); } }
            bf16_t* orow = CATB + row * DM + 768 + hh * 64;
#pragma unroll
            for (int dt = 0; dt < 4; ++dt) { const f32x4_t v = o[dt] * inv; *(uint2*)(orow + 16 * dt + 4 * fg) = make_uint2(cvtpk(v[0], v[1]), cvtpk(v[2], v[3])); }
        }
    }
}
__device__ __forceinline__ void ph_mem_attn_sample(const Params& p, int l, LAS unsigned char* lds, int j0, int jcnt, int jstep) {
    const int tid = ltid(), lane = tid & 63, w = tid >> 6;
    const int ldp = l < 2 ? LDA_ : LDB_, qoff = l < 2 ? 3072 : 768;
    const bf16_t* P16 = (const bf16_t*)(p.ws + B_P16); bf16_t* CATB = (bf16_t*)(p.ws + B_CATB); const float* gq = p.in[I_GMEMQ] + l * 64;
    LAS float* qs = (LAS float*)(lds + w * 2048);
    LAS float* ps = qs + 64;
    __syncthreads();
    for (int ji = 0; ji < jcnt; ++ji) { const int item = (j0 + ji * jstep) * NW_ + w; if (item >= BS * 4) break;
        const int hh = item & 3, b = item >> 2; const size_t row = (size_t)MP + b;
        const float* kv = p.in[I_CMEM] + (size_t)(l * 128 + b) * 256 * 512 + hh * 64;
        { const float v = bf2f(P16[row * ldp + qoff + hh * 64 + lane]); const float ss = wave_sum(v * v); qs[lane] = v * rsqrtf(ss * (1.0f / 64) + EPS) * gq[lane] * (0.125f * LOG2E); }
        asm volatile("s_waitcnt lgkmcnt(0)" ::: "memory");
        float sc[4] = {0.f, 0.f, 0.f, 0.f};
#pragma unroll 4
        for (int d4 = 0; d4 < 16; ++d4) { const f32x4_t q4 = *(const LAS f32x4_t*)(qs + 4 * d4);
#pragma unroll
            for (int k = 0; k < 4; ++k) { const f32x4_t k4 = *(const f32x4_t*)(kv + (size_t)(lane + 64 * k) * 512 + 4 * d4); sc[k] += (q4[0] * k4[0] + q4[1] * k4[1]) + (q4[2] * k4[2] + q4[3] * k4[3]); } }
        float mx = wave_max(fmaxf(fmaxf(sc[0], sc[1]), fmaxf(sc[2], sc[3]))); float sum = 0.f;
#pragma unroll
        for (int k = 0; k < 4; ++k) { sc[k] = ex2(sc[k] - mx); sum += sc[k]; ps[lane + 64 * k] = sc[k]; }
        sum = wave_sum(sum);
        asm volatile("s_waitcnt lgkmcnt(0)" ::: "memory");
        { const int kg = lane >> 4, c4 = lane & 15; f32x4_t o4 = (f32x4_t){0.f, 0.f, 0.f, 0.f};
#pragma unroll 1
          for (int m0 = 0; m0 < 64; m0 += 16) { f32x4_t v[16];
#pragma unroll
              for (int i = 0; i < 16; ++i) v[i] = *(const f32x4_t*)(kv + (size_t)(4 * (m0 + i) + kg) * 512 + 256 + 4 * c4);
#pragma unroll
              for (int i = 0; i < 16; ++i) o4 = o4 + v[i] * ps[4 * (m0 + i) + kg]; }
#pragma unroll
          for (int jx = 0; jx < 4; ++jx) o4[jx] = xsum4(o4[jx]);
          if (kg == 0) { const float inv = 1.0f / sum; *(uint2*)(CATB + row * DM + 768 + hh * 64 + 4 * c4) = make_uint2(cvtpk(o4[0] * inv, o4[1] * inv), cvtpk(o4[2] * inv, o4[3] * inv)); } }
        asm volatile("s_waitcnt lgkmcnt(0)" ::: "memory");
    }
}
__device__ __forceinline__ void ph_nsa_sample(const Params& p, int j, LAS unsigned char* ldsb) {
    const int tid0 = ltid();
    float* lds = (float*)ldsb;
    float* qs = lds;
    float* sc = lds + 384;
    float* imp = sc + 3072;
    int* sel = (int*)(imp + 40);
    float* gate = (float*)(sel + 8);
    float* oacc = gate + 24;
    const float** kptr = (const float**)(oacc + 384);
    float* part = (float*)(kptr + 512);
    const bf16_t* P = (const bf16_t*)(p.ws + B_P16); const float* GT = (const float*)(p.ws + B_GT); const float* KVR = (const float*)(p.ws + B_KVR); bf16_t* CATB = (bf16_t*)(p.ws + B_CATB);
    const float* table = p.in[I_REL]; const int* pt = (const int*)p.in[I_PT];
    for (int item = blockIdx.x; item < BS * 2; item += gridDim.x) {
        int t_l = tid0; asm volatile("" : "+v"(t_l)); const int tid = t_l, lane = tid & 63, wid = tid >> 6;
        int pos_l = PAST; asm volatile("" : "+s"(pos_l)); const int pos = pos_l;
        const int b = item >> 1, g = item & 1, row = MP + b;
        const bf16_t* pr = P + (size_t)row * LDB_;
        __syncthreads();
        if (wid < 6) { const int z = wid; const float v = bf2f(pr[(g * 6 + z) * 64 + lane]); const float ss = wave_sum(v * v); qs[z * 64 + lane] = v * rsqrtf(ss * (1.0f / 64) + EPS) * p.in[I_GQ][j * 64 + lane]; }
        if (tid >= 384 && tid < 384 + 18) { const int t2 = tid - 384; const int br = t2 / 6, z = t2 % 6; gate[t2] = sigmoidf_(GT[(size_t)row * GTW + br * 12 + g * 6 + z] + p.in[I_BGATE][j * 36 + br * 12 + g * 6 + z]); }
        if (tid < 384) oacc[tid] = 0.f;
        __syncthreads();
        const float* ck = (const float*)(p.ws + B_CK) + (size_t)(8 + b) * 127 * 128; const float* cv = (const float*)(p.ws + B_CV) + (size_t)(8 + b) * 127 * 128;
        for (int i = tid; i < 6 * 127; i += NT_) {
            const int z = i / 127, n = i % 127; const int dist = pos - (16 * n + 31);
            const float4* kp = (const float4*)(ck + n * 128 + g * 64); const float4* qp = (const float4*)(qs + z * 64); float a = 0.f;
#pragma unroll 8
            for (int d = 0; d < 16; ++d) a += dot4(kp[d], qp[d]);
            sc[z * 128 + n] = a * 0.125f + table[rel_bucket_alu(dist) * 12 + g * 6 + z];
        }
        __syncthreads();
        if (wid < 6) row_softmax(sc + wid * 128, 127, lane);
        __syncthreads();
        const int cur = pos >> 6;
        if (tid < 33) { const int jb = tid; float s = 0.f;
            for (int z = 0; z < 6; ++z) { const float* pz = sc + z * 128;
                if (jb < 32) { s += 2.0f * (pz[4 * jb] + pz[4 * jb + 1] + pz[4 * jb + 2]); if (4 * jb + 3 < 127) s += pz[4 * jb + 3]; }
                if (jb >= 1 && jb < 32) s += pz[4 * jb - 1]; }
            imp[jb] = s; }
        __syncthreads();
        if (tid == 0) {
            int cnt = 3; sel[0] = 0; sel[1] = cur; sel[2] = cur - 1; unsigned long long taken = 0ull;
            for (int k = 0; k < 5; ++k) { int best = -1; float bv = -1.f;
                for (int jb = 1; jb <= cur - 2; ++jb) if (!((taken >> jb) & 1ull) && imp[jb] > bv) { bv = imp[jb]; best = jb; }
                if (best >= 0) { taken |= 1ull << best; sel[cnt++] = best; } }
            for (; cnt < 8; ++cnt) sel[cnt] = -1;
        }
        { const int kg = tid >> 4, c4 = tid & 15; f32x4_t v[4]; f32x4_t acc[6];
#pragma unroll
          for (int i = 0; i < 4; ++i) { const int n = kg + 32 * i; v[i] = *(const f32x4_t*)(cv + (n < 127 ? n : 126) * 128 + g * 64 + 4 * c4); }
#pragma unroll
          for (int z = 0; z < 6; ++z) { acc[z] = (f32x4_t){0.f, 0.f, 0.f, 0.f};
#pragma unroll
              for (int i = 0; i < 4; ++i) { const int n = kg + 32 * i; if (n < 127) acc[z] = acc[z] + v[i] * sc[z * 128 + n]; } }
#pragma unroll
          for (int z = 0; z < 6; ++z) *(f32x4_t*)(part + kg * 384 + z * 64 + 4 * c4) = acc[z]; }
        __syncthreads();
        if (tid < 384) { float o = 0.f;
#pragma unroll 8
            for (int kg = 0; kg < 32; ++kg) o += part[kg * 384 + tid];
            oacc[tid] += gate[0 * 6 + (tid >> 6)] * o; }
        __syncthreads();
#pragma unroll 1
        for (int br = 1; br <= 2; ++br) {
            int t_b = tid0; asm volatile("" : "+v"(t_b)); const int tid = t_b, lane = tid & 63, wid = tid >> 6;
            { const int t = tid; const float* kp = nullptr; int dist = -1;
                if (br == 1) { const int blk = sel[t >> 6];
                    if (blk >= 0) { const int tok = blk * 64 + (t & 63); dist = pos - tok;
                        if (dist >= 0) kp = tok < PAST ? p.in[I_CSLC] + ((size_t)pt[b * 16 + (tok >> 7)] * 128 + (tok & 127)) * 256 + g * 64 : KVR + (size_t)row * 768 + 256 + g * 64; }
                } else { const int kpos = pos - 511 + t; dist = 511 - t;
                    kp = kpos < PAST ? p.in[I_CWIN] + ((size_t)b * 512 + (kpos - (PAST - 512))) * 256 + g * 64 : KVR + (size_t)row * 768 + 512 + g * 64; }
                if (dist >= 0 && kp) {
                    float s[6] = {0.f, 0.f, 0.f, 0.f, 0.f, 0.f};
#pragma unroll 1
                    for (int dc = 0; dc < 2; ++dc) { f32x4_t kk[8];
#pragma unroll
                        for (int d = 0; d < 8; ++d) kk[d] = ((const f32x4_t*)kp)[8 * dc + d];
#pragma unroll
                        for (int d = 0; d < 8; ++d) {
#pragma unroll
                            for (int z = 0; z < 6; ++z) { const f32x4_t q4 = *(const f32x4_t*)(qs + z * 64 + 32 * dc + 4 * d); s[z] += (kk[d][0] * q4[0] + kk[d][1] * q4[1]) + (kk[d][2] * q4[2] + kk[d][3] * q4[3]); }
                            asm volatile("" ::: "memory"); } }
                    const int bk = rel_bucket_alu(dist);
#pragma unroll
                    for (int z = 0; z < 6; ++z) sc[z * 512 + t] = s[z] * 0.125f + table[bk * 12 + g * 6 + z];
                    kptr[t] = kp;
                } else {
#pragma unroll
                    for (int z = 0; z < 6; ++z) sc[z * 512 + t] = NEGM;
                    kptr[t] = KVR;
                }
            }
            __syncthreads();
            if (wid < 6) row_softmax(sc + wid * 512, 512, lane);
            __syncthreads();
            {
                const int kg = tid >> 4, c4 = tid & 15; f32x4_t acc[6];
#pragma unroll
                for (int z = 0; z < 6; ++z) acc[z] = (f32x4_t){0.f, 0.f, 0.f, 0.f};
#pragma unroll 1
                for (int i0 = 0; i0 < 16; i0 += 8) { f32x4_t v[8];
#pragma unroll
                    for (int i = 0; i < 8; ++i) v[i] = *(const f32x4_t*)(kptr[kg + 32 * (i0 + i)] + 128 + 4 * c4);
#pragma unroll
                    for (int i = 0; i < 8; ++i)
#pragma unroll
                        for (int z = 0; z < 6; ++z) acc[z] = acc[z] + v[i] * sc[z * 512 + kg + 32 * (i0 + i)]; }
#pragma unroll
                for (int z = 0; z < 6; ++z) *(f32x4_t*)(part + kg * 384 + z * 64 + 4 * c4) = acc[z];
            }
            __syncthreads();
            if (tid < 384) { float o = 0.f;
#pragma unroll 8
                for (int kg = 0; kg < 32; ++kg) o += part[kg * 384 + tid];
                oacc[tid] += gate[br * 6 + (tid >> 6)] * o; }
            __syncthreads();
        }
        if (tid < 384) CATB[(size_t)row * DM + g * 384 + tid] = (bf16_t)f2bf(oacc[tid]);
    }
}
__device__ __forceinline__ void ph_mlstm_sample_fast(const Params& p, int l, LAS unsigned char* ldsb) {
    const int tid = ltid(), lane = tid & 63, w = tid >> 6;
    float* lds = (float*)ldsb;
    float* qs = lds; float* ks = lds + 192; float* n1 = lds + 384; float* part = lds + 576;
    float* scal = part + 8 * 192;
    const bf16_t* P = (const bf16_t*)(p.ws + B_P16); const float* GT = (const float*)(p.ws + B_GT); const float* bif = p.in[I_BIF] + l * 8; float* HR = (float*)(p.ws + B_HRAW);
    for (int item = blockIdx.x; item < BS * 4; item += gridDim.x) {
        const int h = item & 3, b = item >> 2; const size_t row = (size_t)MP + b;
        const bf16_t* pr = P + row * LDA_; const float* gr = GT + row * GTW;
        const size_t sidx = (size_t)(l * 128 + b) * 4 + h;
        const float ig = gr[h] + bif[h], fg_ = gr[4 + h] + bif[4 + h];
        const float m0 = p.in[I_SM][sidx];
        const float logf = logsigmoidf_(fg_);
        const float m_new = fmaxf(logf + m0, ig);
        const float a = expf(logf + m0 - m_new), bb = expf(ig - m_new);
        __syncthreads();
        if (tid < 192) { const float q = bf2f(pr[h * 192 + tid]), k = bf2f(pr[768 + h * 192 + tid]); qs[tid] = q; ks[tid] = k;
            const float nn = a * p.in[I_SN][sidx * 192 + tid] + bb * k; n1[tid] = nn; p.out[O_SN + sidx * 192 + tid] = nn; }
        __syncthreads();
        if (w == 0) { float s = qs[lane] * n1[lane] + qs[lane + 64] * n1[lane + 64] + qs[lane + 128] * n1[lane + 128]; s = wave_sum(s); if (lane == 0) scal[0] = s; }
        const float* C0 = p.in[I_SC] + sidx * 192 * 192; float* C1 = p.out + O_SC + sidx * 192 * 192;
        float ve[3], num[3] = {0.f, 0.f, 0.f};
#pragma unroll
        for (int i = 0; i < 3; ++i) ve[i] = bf2f(pr[1536 + h * 192 + lane + 64 * i]) * bb;
#pragma unroll 1
        for (int d0 = 24 * w; d0 < 24 * w + 24; d0 += 12) {
            float c[12][3];
#pragma unroll
            for (int r = 0; r < 12; ++r)
#pragma unroll
                for (int i = 0; i < 3; ++i) c[r][i] = C0[(size_t)(d0 + r) * 192 + lane + 64 * i];
#pragma unroll
            for (int r = 0; r < 12; ++r) { const float kd = ks[d0 + r], qd = qs[d0 + r];
#pragma unroll
                for (int i = 0; i < 3; ++i) { const float cn = a * c[r][i] + kd * ve[i]; C1[(size_t)(d0 + r) * 192 + lane + 64 * i] = cn; num[i] = fmaf(qd, cn, num[i]); } }
        }
#pragma unroll
        for (int i = 0; i < 3; ++i) part[w * 192 + lane + 64 * i] = num[i];
        __syncthreads();
        if (tid < 192) { float s = 0.f;
#pragma unroll
            for (int ww = 0; ww < 8; ++ww) s += part[ww * 192 + tid];
            HR[row * 768 + h * 192 + tid] = s / fmaxf(fabsf(scal[0]), expf(-m_new)); }
        if (tid == 0) p.out[O_SM + sidx] = m_new;
    }
}
constexpr int RING_BYTES = 131072, MISC_OFF = RING_BYTES + 320, LDS_BYTES = 147456;
typedef float f32x4_ __attribute__((ext_vector_type(4)));

#define STRIP_JOBS(njobs) for (int job = (int)gridDim.x - 1 - (int)blockIdx.x; job < (njobs); job += (int)gridDim.x)
__device__ __forceinline__ void strips_inproj(const Params& p, int l, LAS unsigned char* lds) {
    unsigned char* ws = p.ws; const bf16_t* XB = (const bf16_t*)(ws + B_XB); bf16_t* P16 = (bf16_t*)(ws + B_P16); float* GT = (float*)(ws + B_GT);
    const float* ssq = (const float*)(ws + B_SSQ) + (size_t)(2 * l) * SSQS;
    const bool ka = l < 2; const int ldp = ka ? LDA_ : LDB_, nmain = ka ? 104 * 4 : 32 * 4;
    const bf16_t* Bt = ka ? (const bf16_t*)(ws + B_BTA) + (size_t)l * NBTA * DM : (const bf16_t*)(ws + B_BTB) + (size_t)(l - 2) * NBTB * DM;
    const int tid_ = ltid(); const int lane = tid_ & 63, wave = tid_ >> 6, fr = lane & 15, fq = lane >> 4;
    STRIP_JOBS(nmain + 516) {
        if (job < nmain) {
            const int st = job >> 2, r0 = MP + (job & 3) * 32;
            const int brow[2] = {st * 32, st * 32 + 16}; StripAcc<2> R; strip_gemm<2>(XB, DM, r0, Bt, brow, R, lds);
            if (wave < 2) { const int row = r0 + wave * 16 + fr; const float rs = rstd_of(ssq[row]);
#pragma unroll
                for (int t = 0; t < 2; ++t) { const f32x4_ v = R.a[t] * rs; *(uint2*)(P16 + (size_t)row * ldp + st * 32 + t * 16 + 4 * fq) = make_uint2(pk2(v[0], v[1]), pk2(v[2], v[3])); } }
        } else {
            const int r0 = (job - nmain) * 32, row = r0 + wave * 16 + fr;
            if (ka) { const int brow[1] = {3328}; StripAcc<1> R; strip_gemm<1>(XB, DM, r0, Bt, brow, R, lds); if (wave < 2) *(f32x4_*)(GT + (size_t)row * GTW + 4 * fq) = R.a[0] * rstd_of(ssq[row]); }
            else { const int brow[3] = {1024, 1040, 1056}; StripAcc<3> R; strip_gemm<3>(XB, DM, r0, Bt, brow, R, lds);
                if (wave < 2) { const float rs = rstd_of(ssq[row]);
#pragma unroll
                    for (int t = 0; t < 3; ++t) *(f32x4_*)(GT + (size_t)row * GTW + t * 16 + 4 * fq) = R.a[t] * rs; } }
        }
    }
}
__device__ __forceinline__ void strips_resid(const Params& p, const bf16_t* A, int K, const bf16_t* Bt, float* ssq, float* Y, LAS unsigned char* lds) {
    bf16_t* XB = (bf16_t*)(p.ws + B_XB);
    const int tid_ = ltid(); const int lane = tid_ & 63, wave = tid_ >> 6, fr = lane & 15, fq = lane >> 4;
    STRIP_JOBS(256) {
        const int st = job >> 2, r0 = MP + (job & 3) * 32;
        const int brow[1] = {st * 16}; StripAcc<1> R; strip_gemm<1>(A, K, r0, Bt, brow, R, lds);
        if (wave < 2) { const int row = r0 + wave * 16 + fr; bf16_t* bp = XB + (size_t)row * DM + st * 16 + 4 * fq; const uint2 o = *(const uint2*)bp;
            const f32x4_ x = (f32x4_){bflo(o.x), bfhi(o.x), bflo(o.y), bfhi(o.y)} + R.a[0];
            *(uint2*)bp = make_uint2(pk2(x[0], x[1]), pk2(x[2], x[3]));
            if (Y) *(f32x4_*)(Y + (size_t)row * DM + st * 16 + 4 * fq) = x;
            float ss = (x[0] * x[0] + x[1] * x[1]) + (x[2] * x[2] + x[3] * x[3]); ss += __shfl_xor(ss, 16); ss += __shfl_xor(ss, 32);
            if (fq == 0) (void)__hip_atomic_fetch_add(ssq + row, ss, __ATOMIC_RELAXED, __HIP_MEMORY_SCOPE_AGENT); }
    }
}
__device__ __forceinline__ void strips_gu(const Params& p, int l, LAS unsigned char* lds) {
    unsigned char* ws = p.ws; const bf16_t* XB = (const bf16_t*)(ws + B_XB); bf16_t* HID = (bf16_t*)(ws + B_HID);
    const float* ssq = (const float*)(ws + B_SSQ) + (size_t)(2 * l + 1) * SSQS; const bf16_t* Bt = (const bf16_t*)(ws + B_BTG) + (size_t)l * 2 * DFF * DM;
    const int tid_ = ltid(); const int lane = tid_ & 63, wave = tid_ >> 6, fr = lane & 15, fq = lane >> 4;
    STRIP_JOBS(176 * 4) {
        const int st = job >> 2, r0 = MP + (job & 3) * 32;
        const int brow[2] = {(st >> 3) * 256 + (st & 7) * 16, (st >> 3) * 256 + 128 + (st & 7) * 16}; StripAcc<2> R; strip_gemm<2>(XB, DM, r0, Bt, brow, R, lds);
        if (wave < 2) { const int row = r0 + wave * 16 + fr; const float rs = rstd_of(ssq[row]); float h[4];
#pragma unroll
            for (int j = 0; j < 4; ++j) { const float g = R.a[0][j] * rs, up = R.a[1][j] * rs; h[j] = g * pg8::fast_sigmoid(g) * up; }
            *(uint2*)(HID + (size_t)row * DFF + st * 16 + 4 * fq) = make_uint2(pk2(h[0], h[1]), pk2(h[2], h[3])); }
    }
}
__device__ __forceinline__ void strips_kv(const Params& p, LAS unsigned char* lds) {
    unsigned char* ws = p.ws; const bf16_t* XB = (const bf16_t*)(ws + B_XB); float* KVR = (float*)(ws + B_KVR);
    const float* ssq = (const float*)(ws + B_SSQ) + (size_t)4 * SSQS; const bf16_t* Bt = (const bf16_t*)(ws + B_BTK);
    const int tid_ = ltid(); const int lane = tid_ & 63, wave = tid_ >> 6, fr = lane & 15, fq = lane >> 4;
    STRIP_JOBS(48 * 4) {
        const int st = job >> 2, r0 = MP + (job & 3) * 32;
        const int brow[1] = {st * 16}; StripAcc<1> R; strip_gemm<1>(XB, DM, r0, Bt, brow, R, lds);
        if (wave < 2) { const int row = r0 + wave * 16 + fr; *(f32x4_*)(KVR + (size_t)row * 768 + st * 16 + 4 * fq) = R.a[0] * rstd_of(ssq[row]); }
    }
}

#ifndef COMPRESS_NAIVE
#define COMPRESS_NAIVE 0
#endif
#ifndef MLSTM_NAIVE
#define MLSTM_NAIVE 0
#endif
#ifndef MEMATT_NAIVE
#define MEMATT_NAIVE 0
#endif
#ifndef SAMPLE_ML_NAIVE
#define SAMPLE_ML_NAIVE 0
#endif
#ifndef SAMPLE_NSA_NAIVE
#define SAMPLE_NSA_NAIVE 0
#endif
#ifndef MK_MULTI
#define MK_MULTI 0
#endif
constexpr int PL = 9, NPH = 1 + 4 * PL;
__host__ __device__ constexpr bool phase_nonempty(int ph) {
    if (ph == 0) return true;
    const int l = (ph - 1) / PL, r = (ph - 1) % PL;
    if (r == 2) return l < 2;
    if (r == 7) return false;
    if (r >= 6) return l == 1;
    return true;
}
#ifndef TIME_MASK
#define TIME_MASK 0
#endif
__host__ __device__ constexpr int phase_group(int ph) { if (ph == 0) return 0; const int l = (ph - 1) / PL, r = (ph - 1) % PL; return r == 0 ? 1 : r == 1 ? (l < 2 ? 2 : 4) : r == 2 ? 3 : r == 3 ? 5 : r == 4 ? 6 : r == 5 ? 7 : r == 6 ? 8 : r == 7 ? 9 : 10; }
__global__ void __launch_bounds__(NT_, 2) fwd(Params p) {
    extern __shared__ __attribute__((aligned(16))) unsigned char lds_raw[];
    LAS unsigned char* lds = (LAS unsigned char*)lds_raw;
    float* ldsf = (float*)lds_raw;
    volatile LAS unsigned* MISC = (volatile LAS unsigned*)(lds + MISC_OFF);
    for (int u = threadIdx.x; u < (LDS_BYTES - RING_BYTES) / 4; u += NT_) ((LAS unsigned*)(lds + RING_BYTES))[u] = 0u;
    __syncthreads();
    unsigned char* ws = p.ws;
    XcdBarrier bar; bar.bar = (unsigned*)ws; bar.x = 0; bar.st = MISC + 8;
    const bool single = (p.ph_hi - p.ph_lo) > 1;
    if (single) bar = xcd_barrier_post((unsigned*)ws, MISC + 8);
    bf16_t* XB = (bf16_t*)(ws + B_XB); bf16_t* P16 = (bf16_t*)(ws + B_P16); bf16_t* CATB = (bf16_t*)(ws + B_CATB); bf16_t* HID = (bf16_t*)(ws + B_HID);
    float* SSQ = (float*)(ws + B_SSQ);
    const int G = gridDim.x, c = blockIdx.x;
    if (TIME_SUB && blockIdx.x == TSUB_BLK && threadIdx.x == 0) { for (int i = 0; i < 8; ++i) g_tsub[i] = 0ull; }
    int ph = 0; volatile LAS unsigned long long* TMR = (volatile LAS unsigned long long*)(lds + MISC_OFF + 64);
    if ((TIME_MASK || TIME_SUB) && blockIdx.x == 0 && threadIdx.x == 0) { TMR[0] = 0ull; TMR[1] = __builtin_amdgcn_s_memrealtime(); }
#define ON() (ph >= p.ph_lo && ph < p.ph_hi)
#define NEXT() do { const bool ne_ = phase_nonempty(ph); const int grp_ = phase_group(ph); ++ph; if (ne_ && ph > p.ph_lo && ph < p.ph_hi) xcd_barrier(bar); \
        if (TIME_MASK && blockIdx.x == 0 && threadIdx.x == 0) { const unsigned long long now_ = __builtin_amdgcn_s_memrealtime(); if ((TIME_MASK >> grp_) & 1) TMR[0] = TMR[0] + (now_ - TMR[1]); TMR[1] = now_; } } while (0)
#ifndef NO_PRO
    if (ON()) ph_prologue(p, lds);
#endif
    NEXT();
    for (int l = 0; l < 4; ++l) {
        if (ON()) {
            if (l == 0) { pg8::Gemm g{(const bf16_t*)(ws + B_MPB), (const bf16_t*)(ws + B_BTM), 2048, 2048, DM}; pg8::StaticOrder S; S.init(2048, 2048, G, c);
                pg8::EpiF32 E{(float*)(ws + B_MEMR), 512, nullptr, 512, (size_t)2048 * 512};
                pg8::gemm_phase<pg8::EpiF32, pg8::StaticOrder, true, true>(lds, g, S, E); }
            if (l < 2) { pg8::Gemm g{XB, (const bf16_t*)(ws + B_BTA) + (size_t)l * NBTA * DM, MAP, LDA_ + 256, DM}; pg8::StaticOrder S; S.init(MAP, LDA_ + 256, G, l == 0 ? (c + 192) % G : c);
                pg8::EpiBf16S E{P16, LDA_, SSQ + (size_t)(2 * l) * SSQS, 13, (float*)(ws + B_GT)};
                pg8::gemm_phase<pg8::EpiBf16S, pg8::StaticOrder, true, true>(lds, g, S, E); }
            else { pg8::Gemm g{XB, (const bf16_t*)(ws + B_BTB) + (size_t)(l - 2) * NBTB * DM, MP, LDB_, DM}; pg8::StaticOrder S; S.init(MP, LDB_, G, c);
                pg8::EpiBf16S E{P16, LDB_, SSQ + (size_t)(2 * l) * SSQS, -1, nullptr};
                pg8::gemm_phase<pg8::EpiBf16S, pg8::StaticOrder, true, true>(lds, g, S, E);
#ifndef NO_STRIPS
                strips_inproj(p, l, lds);
#endif
            }
        }
        NEXT();
#ifndef NO_NAIVE
        if (ON()) {
            if (l < 2) { if (MLSTM_NAIVE) ph_mlstm_prompt(p, l, ldsf); else ph_mlstm_fast(p, l, lds); if (G == 256) { if (c >= 192) { ph_mem_attn_fast(p, l, lds, c - 192, 4, 64); ph_mem_attn_sample(p, l, lds, c - 192, 1, 64); if (l == 1) ph_swin_copy(p, 192, 64); } }
                else { ph_mem_attn_fast(p, l, lds, c, (256 - c + G - 1) / G, G); if (c < 64) ph_mem_attn_sample(p, l, lds, c, (64 - c + G - 1) / G, G); if (l == 1) ph_swin_copy(p, 0, G); }      if (SAMPLE_ML_NAIVE) ph_mlstm_sample(p, l, ldsf); else ph_mlstm_sample_fast(p, l, lds); }
            else { if (!NSA_NAIVE_ALL) ph_nsa_fast(p, l - 2, lds); { TSUB_BEGIN(); if (SAMPLE_NSA_NAIVE) ph_nsa(p, l - 2, ldsf); else ph_nsa_sample(p, l - 2, lds); TSUB_END(4); } TSUB_BEGIN(); if (MEMATT_NAIVE) ph_mem_attn(p, l); else if (G == 256) { if (c < 16) { ph_mem_attn_fast(p, l, lds, 8 * c, 8, 1); ph_mem_attn_sample(p, l, lds, 2 * c, 2, 1); } else if (c < 32) { ph_mem_attn_fast(p, l, lds, 128 + 5 * (c - 16), 5, 1); ph_mem_attn_sample(p, l, lds, 2 * c, 2, 1); } else if (c < 48) ph_mem_attn_fast(p, l, lds, 208 + 3 * (c - 32), 3, 1); }
                else { ph_mem_attn_fast(p, l, lds, c, (256 - c + G - 1) / G, G); if (c < 64) ph_mem_attn_sample(p, l, lds, c, (64 - c + G - 1) / G, G); } TSUB_END(5); }
        }
#endif
        NEXT();
#ifndef NO_NAIVE
        if (ON()) { if (l < 2) { ph_mlstm_fin(p, l); if (l == 0) ph_memk_norm(p); } }
#endif
        NEXT();
        if (ON()) {
            const bf16_t* Bt = (const bf16_t*)(ws + B_BTO) + (size_t)l * DM * DM; float* sq = SSQ + (size_t)(2 * l + 1) * SSQS;
            pg8::Gemm g{CATB, Bt, MP, DM, DM}; pg8::StaticOrder S; S.init(MP, DM, G, c); pg8::EpiResid E{nullptr, XB, sq};
            pg8::gemm_phase<pg8::EpiResid, pg8::StaticOrder, true, true>(lds, g, S, E);
#ifndef NO_STRIPS
            strips_resid(p, CATB, DM, Bt, sq, nullptr, lds);
#endif
        }
        NEXT();
        if (ON()) {
            pg8::Gemm g{XB, (const bf16_t*)(ws + B_BTG) + (size_t)l * 2 * DFF * DM, MAP, 2 * DFF, DM}; pg8::StaticOrder S; S.init(MAP, 2 * DFF, G, c); pg8::EpiSwiglu E{HID, SSQ + (size_t)(2 * l + 1) * SSQS};
            pg8::gemm_phase<pg8::EpiSwiglu, pg8::StaticOrder, true, true>(lds, g, S, E);
        }
        NEXT();
        if (ON()) {
            const bf16_t* Bt = (const bf16_t*)(ws + B_BTD) + (size_t)l * DM * DFF; float* sq = SSQ + (size_t)(2 * l + 2) * SSQS;
            pg8::Gemm g{HID, Bt, MP, DM, DFF}; pg8::StaticOrder S; S.init(MP, DM, G, c); float* Yo = l == 3 ? p.out : nullptr; pg8::EpiResid E{Yo, XB, sq};
            pg8::gemm_phase<pg8::EpiResid, pg8::StaticOrder, true, true>(lds, g, S, E);
#ifndef NO_STRIPS
            strips_resid(p, HID, DFF, Bt, sq, Yo, lds);
#endif
        }
        NEXT();
        if (ON()) { if (l == 1) {
            pg8::Gemm g{XB, (const bf16_t*)(ws + B_BTK), MAP, 768, DM}; pg8::StaticOrder S; S.init(MAP, 768, G, c); pg8::EpiF32 E{(float*)(ws + B_KVR), 768, SSQ + (size_t)4 * SSQS, 0, 0};
            pg8::gemm_phase<pg8::EpiF32, pg8::StaticOrder, true, true>(lds, g, S, E);
            asm volatile("s_waitcnt vmcnt(0)" ::: "memory"); __syncthreads();
            if (c < 195) {
                constexpr int nM = MAP / 256, nN = 3, nwg = nM * nN, q = nwg / 8, rr = nwg % 8; const int xcd = c % 8, off = c / 8;
                const int wgid = (xcd < rr ? xcd * (q + 1) : rr * (q + 1) + (xcd - rr) * q) + off; constexpr int nig = 8 * nN; const int gid = wgid / nig, fm = gid * 8, gsz = (nM - fm) < 8 ? (nM - fm) : 8;
                rows_post_tile(p, (fm + ((wgid % nig) % gsz)) * 256, (wgid % nig) / gsz); }
            } }
        NEXT();
        NEXT();
#ifndef NO_NAIVE
        if (ON()) { if (l == 1) { if (COMPRESS_NAIVE) ph_compress(p, ldsf); else ph_compress_fast(p, lds); } }
#endif
        NEXT();
    }
    if (TIME_MASK || TIME_SUB) { if (blockIdx.x == 0 && threadIdx.x == 0) { const unsigned long long t_acc = TIME_SUB ? __hip_atomic_load(&g_tsub[TIME_SUB > 0 ? TIME_SUB - 1 : 0], __ATOMIC_RELAXED, __HIP_MEMORY_SCOPE_AGENT) : TMR[0]; const unsigned long long t0 = __builtin_amdgcn_s_memrealtime(); while (__builtin_amdgcn_s_memrealtime() - t0 < 10ull * t_acc) __builtin_amdgcn_s_sleep(8); } }
}

extern "C" void kernel_launch(void* const* d_in, const int* in_sizes, int n_in, void* d_out, int out_size, void* d_ws, size_t ws_size, hipStream_t stream) {
    static int grid = 0;
    if (!grid) {
        int dev = 0, cus = 0;
        (void)hipGetDevice(&dev); (void)hipDeviceGetAttribute(&cus, hipDeviceAttributeMultiprocessorCount, dev);
        if (cus < 1) cus = 256;
        if (hipFuncSetAttribute((const void*)fwd, hipFuncAttributeMaxDynamicSharedMemorySize, LDS_BYTES) != hipSuccess) fprintf(stderr, "kernel_launch: hipFuncSetAttribute failed\n");
        int per_cu = 0; (void)hipOccupancyMaxActiveBlocksPerMultiprocessor(&per_cu, (const void*)fwd, NT_, LDS_BYTES); (void)hipGetLastError();
        if (per_cu < 1) fprintf(stderr, "kernel_launch: occupancy query says %d\n", per_cu);
        grid = cus;
    }
    if (n_in != N_IN || (size_t)out_size != O_END || ws_size < B_END) fprintf(stderr, "kernel_launch: unexpected sizes n_in=%d out=%d ws=%zu need %zu\n", n_in, out_size, ws_size, (size_t)B_END);
    (void)hipMemsetAsync(d_ws, 0, CTL_BYTES, stream);
    Params p{};
    for (int i = 0; i < N_IN; ++i) p.in[i] = (const float*)d_in[i];
    p.out = (float*)d_out; p.ws = (unsigned char*)d_ws;
#if MK_MULTI
    for (int ph = 0; ph < NPH; ++ph) {
        if (!phase_nonempty(ph)) continue;
        p.ph_lo = ph; p.ph_hi = ph + 1;
        hipLaunchKernelGGL(fwd, dim3(grid), dim3(NT_), LDS_BYTES, stream, p);
    }
#else
    p.ph_lo = 0; p.ph_hi = NPH;
    hipLaunchKernelGGL(fwd, dim3(grid), dim3(NT_), LDS_BYTES, stream, p);
#endif
}

#ifdef REGTEST
__global__ void __launch_bounds__(NT_, 2) rt_nsa(Params p) { extern __shared__ __attribute__((aligned(16))) unsigned char l_[]; ph_nsa_fast(p, 0, (LAS unsigned char*)l_); }
__global__ void __launch_bounds__(NT_, 2) rt_mlstm(Params p) { extern __shared__ __attribute__((aligned(16))) unsigned char l_[]; ph_mlstm_fast(p, 0, (LAS unsigned char*)l_); }
__global__ void __launch_bounds__(NT_, 2) rt_nsas(Params p) { extern __shared__ __attribute__((aligned(16))) unsigned char l_[]; ph_nsa_sample(p, 0, (LAS unsigned char*)l_); }
__global__ void __launch_bounds__(NT_, 2) rt_mem(Params p) { extern __shared__ __attribute__((aligned(16))) unsigned char l_[]; ph_mem_attn_fast(p, 0, (LAS unsigned char*)l_, 0, 256, 1); }
__global__ void __launch_bounds__(NT_, 2) rt_cmp(Params p) { extern __shared__ __attribute__((aligned(16))) unsigned char l_[]; ph_compress_fast(p, (LAS unsigned char*)l_); }
#endif
```

```cpp
#include <hip/hip_runtime.h>
#include <cstdio>
#include <cstdint>

#define LAS __attribute__((address_space(3)))
#define GAS __attribute__((address_space(1)))
#define XB_TMO      128
#define XB_XCNT(j)  (256  + 64 * (j))
#define XB_XSUB(j)  (1280 + 64 * (j))
#define XB_XGEN(j)  (2304 + 64 * (j))
#define XB_TOP      3328
#define XB_TOPGEN   3392
#define XCD_BAR_WORDS 3456
#define XB_SPIN_CAP (1u << 23)
__device__ __forceinline__ unsigned xb_ld(unsigned* p)              { return __hip_atomic_load(p, __ATOMIC_RELAXED, __HIP_MEMORY_SCOPE_AGENT); }
__device__ __forceinline__ unsigned xb_add(unsigned* p, unsigned v) { return __hip_atomic_fetch_add(p, v, __ATOMIC_RELAXED, __HIP_MEMORY_SCOPE_AGENT); }
__device__ __forceinline__ unsigned xb_xcc_id() { return (unsigned)__builtin_amdgcn_s_getreg((3 << 11) | 20) & 0xFu; }
#define XB_SPIN(cond, bar) do { unsigned _sp = 0; while (cond) { __builtin_amdgcn_s_sleep(1); \
    if ((++_sp & 255u) == 0u) { if (xb_ld(&(bar)[XB_TMO])) break; if (_sp > XB_SPIN_CAP) { atomicAdd(&(bar)[XB_TMO], 1u); break; } } } } while (0)
struct XcdBarrier { unsigned* bar; unsigned x; volatile LAS unsigned* st; };
__device__ __forceinline__ XcdBarrier xcd_barrier_post(unsigned* bar, volatile LAS unsigned* st) {
    XcdBarrier b; b.bar = bar; b.x = xb_xcc_id(); b.st = st;
    if (threadIdx.x == 0) (void)xb_add(&bar[XB_XCNT(b.x)], 1u);
    return b;
}
__device__ __forceinline__ void xcd_barrier_complete(unsigned* bar, unsigned x, unsigned& nloc, unsigned& nx) {
    const unsigned G = gridDim.x * gridDim.y * gridDim.z;
    unsigned sum, cnt, mine, sp = 0u;
    for (;;) {
        sum = 0u; cnt = 0u; mine = 0u;
#pragma unroll
        for (unsigned j = 0; j < 16; ++j) { const unsigned c = xb_ld(&bar[XB_XCNT(j)]); sum += c; cnt += (c > 0u) ? 1u : 0u; mine = (j == x) ? c : mine; }
        if (sum == G) break;
        __builtin_amdgcn_s_sleep(1);
        if ((++sp & 255u) == 0u) { if (xb_ld(&bar[XB_TMO])) break; if (sp > XB_SPIN_CAP) { atomicAdd(&bar[XB_TMO], 1u); break; } }
    }
    nloc = mine > 0u ? mine : 1u; nx = cnt > 0u ? cnt : 1u;
}
__device__ __forceinline__ void xcd_barrier(const XcdBarrier& b) {
    asm volatile("s_waitcnt vmcnt(0)" ::: "memory");
    __syncthreads();
    if (threadIdx.x == 0) {
        unsigned* bar = b.bar;
        __builtin_amdgcn_s_waitcnt(0);
        unsigned nloc = b.st[0], nx = b.st[1];
        if (nloc == 0u) { xcd_barrier_complete(bar, b.x, nloc, nx); b.st[0] = nloc; b.st[1] = nx; }
        const unsigned old = xb_add(&bar[XB_XSUB(b.x)], 1u);
        const unsigned gen = old / nloc;
        if (old + 1u == (gen + 1u) * nloc) {
            __builtin_amdgcn_fence(__ATOMIC_RELEASE, "agent");
            asm volatile("s_waitcnt vmcnt(0)" ::: "memory");
            const unsigned og = xb_add(&bar[XB_TOP], 1u);
            const unsigned tg = og / nx;
            if (og + 1u == (tg + 1u) * nx) xb_add(&bar[XB_TOPGEN], 1u);
            else XB_SPIN(xb_ld(&bar[XB_TOPGEN]) == tg, bar);
            __builtin_amdgcn_fence(__ATOMIC_ACQUIRE, "agent");
            xb_add(&bar[XB_XGEN(b.x)], 1u);
            asm volatile("s_waitcnt vmcnt(0)" ::: "memory");
        } else {
            XB_SPIN(xb_ld(&bar[XB_XGEN(b.x)]) == gen, bar);
            __builtin_amdgcn_fence(__ATOMIC_ACQUIRE, "agent");
            asm volatile("s_waitcnt vmcnt(0)" ::: "memory");
        }
    }
    __syncthreads();
}

constexpr int NT_ = 512, NW_ = 8;
constexpr int DM = 1024, BP = 8, SP = 2048, MP = BP * SP, BS = 128, MA = MP + BS, MAP = MP + 256;
constexpr int ACOLS = 3336, BCOLS = 1060, DFF = 2816;
constexpr int LDA_ = 3328, LDB_ = 1024;
constexpr int NBTA = 3344, NBTB = 1072;
constexpr int PAST = 2048, GTW = 48;
constexpr float EPS = 1e-6f, NEGM = -1e30f;
typedef unsigned short bf16_t;

enum { I_XP = 0, I_XS, I_SC, I_SN, I_SM, I_CMEM, I_CCMP, I_CSLC, I_CWIN, I_PT, I_MEMP, I_GMIX, I_WINA, I_BIF, I_GHN, I_WINB, I_GQ, I_BGATE, I_REL,
       I_GKV, I_WKV, I_GKSLC, I_GKWIN, I_GKCMP, I_CPOS, I_CW1, I_CB1, I_CW2, I_CB2, I_WMEMKV, I_GMEMK, I_GMEMQ, I_WOUT, I_GFFN, I_WGU, I_WDOWN, N_IN };
constexpr size_t O_YP = 0, O_YS = O_YP + (size_t)MP * DM, O_PC = O_YS + (size_t)BS * DM, O_PN = O_PC + 2ull * 8 * 4 * 192 * 192, O_PM = O_PN + 2ull * 8 * 4 * 192,
    O_PMEM = O_PM + 64, O_PCMP = O_PMEM + 4ull * 8 * 256 * 512, O_PSLC = O_PCMP + (size_t)MP * 256, O_PWIN = O_PSLC + (size_t)MP * 256, O_SC = O_PWIN + 8ull * 512 * 256,
    O_SN = O_SC + 2ull * 128 * 4 * 192 * 192, O_SM = O_SN + 2ull * 128 * 4 * 192, O_SCMP = O_SM + 1024, O_SSLC = O_SCMP + 128 * 256, O_SWIN = O_SSLC + 128 * 256,
    O_END = O_SWIN + 128ull * 512 * 256;
static_assert(O_END == 87700544ull, "output size");
constexpr size_t CTL_BYTES = 2u << 20, B_SSQ = 65536;
constexpr size_t al256(size_t x) { return (x + 255) & ~(size_t)255; }
constexpr size_t B_XB = CTL_BYTES, B_P16 = al256(B_XB + (size_t)MAP * DM * 2), B_GT = al256(B_P16 + (size_t)MAP * LDA_ * 2), B_CATB = al256(B_GT + (size_t)MAP * GTW * 4),
    B_HID = al256(B_CATB + (size_t)MA * DM * 2), B_HRAW = al256(B_HID + (size_t)MAP * DFF * 2), B_KVR = al256(B_HRAW + (size_t)MA * 768 * 4), B_CK = al256(B_KVR + (size_t)MAP * 768 * 4),
    B_CV = al256(B_CK + 136ull * 127 * 128 * 4), B_MPB = al256(B_CV + 136ull * 127 * 128 * 4),
    B_BTA = al256(B_MPB + 2048ull * DM * 2), B_BTB = al256(B_BTA + 2ull * NBTA * DM * 2), B_BTO = al256(B_BTB + 2ull * NBTB * DM * 2), B_BTG = al256(B_BTO + 4ull * DM * DM * 2),
    B_BTD = al256(B_BTG + 4ull * 2 * DFF * DM * 2), B_BTK = al256(B_BTD + 4ull * DM * DFF * 2), B_BTM = al256(B_BTK + 768ull * DM * 2), B_KVB = al256(B_BTM + 2048ull * DM * 2), B_SKF = al256(B_KVB + 6ull * BP * 2 * SP * 64 * 2), B_SVF = al256(B_SKF + (size_t)BP * 2 * SP * 64 * 2), B_KC16 = al256(B_SVF + (size_t)BP * 2 * SP * 64 * 2),
    B_W1T = al256(B_KC16 + 136ull * 2 * 2 * 128 * 64 * 2), B_W2T = al256(B_W1T + 2ull * 128 * 2048 * 2), B_PEB = al256(B_W2T + 2ull * 64 * 128 * 2), B_MEMR = al256(B_PEB + 1024), B_CMPS = al256(B_MEMR + 4ull * 2048 * 512 * 4), B_END = al256(B_CMPS + (size_t)BS * 4 * SP * 64 * 2 + 8192);
constexpr int SSQS = MAP;
static_assert(9 * SSQS * 4 + B_SSQ <= CTL_BYTES, "ssq sites inside the control region");

#ifndef TIME_SUB
#define TIME_SUB 0
#endif
#ifndef TSUB_BLK
#define TSUB_BLK 10
#endif
__device__ unsigned long long g_tsub[8];
#define TSUB_BEGIN() unsigned long long tsub_t0_ = (TIME_SUB && blockIdx.x == TSUB_BLK && threadIdx.x == 0) ? __builtin_amdgcn_s_memrealtime() : 0ull
#define TSUB_END(k) do { if (TIME_SUB && blockIdx.x == TSUB_BLK && threadIdx.x == 0) { const unsigned long long n_ = __builtin_amdgcn_s_memrealtime(); g_tsub[k] += n_ - tsub_t0_; tsub_t0_ = n_; } } while (0)
struct Params { const float* in[N_IN]; float* out; unsigned char* ws; int ph_lo, ph_hi; };

__device__ const unsigned char REL_LUT[128] = {0, 1, 2, 3, 4, 5, 6, 7, 8, 9, 10, 11, 12, 13, 14, 15, 16, 16, 16, 17, 17, 18, 18, 18, 19, 19, 19, 20, 20, 20, 20, 21, 21, 21, 21, 22, 22, 22, 22, 22, 23, 23, 23, 23, 23, 23, 24, 24, 24, 24, 24, 24, 25, 25, 25, 25, 25, 25, 25, 26, 26, 26, 26, 26, 26, 26, 26, 27, 27, 27, 27, 27, 27, 27, 27, 27, 27, 28, 28, 28, 28, 28, 28, 28, 28, 28, 28, 29, 29, 29, 29, 29, 29, 29, 29, 29, 29, 29, 29, 30, 30, 30, 30, 30, 30, 30, 30, 30, 30, 30, 30, 30, 30, 31, 31, 31, 31, 31, 31, 31, 31, 31, 31, 31, 31, 31, 31, 31};
__device__ __forceinline__ int rel_bucket(int d) { return d >= 128 ? 31 : (int)REL_LUT[d < 0 ? 0 : d]; }
__device__ __forceinline__ int rel_bucket_alu(int d) { d = d < 0 ? 0 : d; if (d < 16) return d;
    return 16 + (d >= 19) + (d >= 21) + (d >= 24) + (d >= 27) + (d >= 31) + (d >= 35) + (d >= 40) + (d >= 46) + (d >= 52) + (d >= 59) + (d >= 67) + (d >= 77) + (d >= 87) + (d >= 99) + (d >= 113); }

__device__ __forceinline__ int opq(int i) { asm volatile("" : "+s"(i)); return i; }
#define BAR_LDS() do { asm volatile("s_waitcnt lgkmcnt(0)" ::: "memory"); __builtin_amdgcn_s_barrier(); asm volatile("" ::: "memory"); } while (0)
__device__ __forceinline__ int ltid() { int t = threadIdx.x; asm volatile("" : "+v"(t)); return t; }
__device__ __forceinline__ float wave_sum(float v) {
#pragma unroll
    for (int o = 32; o; o >>= 1) v += __shfl_xor(v, o);
    return v;
}
__device__ __forceinline__ float wave_max(float v) {
#pragma unroll
    for (int o = 32; o; o >>= 1) v = fmaxf(v, __shfl_xor(v, o));
    return v;
}
__device__ __forceinline__ float sigmoidf_(float x) { return 1.0f / (1.0f + expf(-x)); }
__device__ __forceinline__ float logsigmoidf_(float x) { return fminf(x, 0.f) - log1pf(expf(-fabsf(x))); }
__device__ __forceinline__ float dot4(float4 a, float4 b) { return a.x * b.x + a.y * b.y + a.z * b.z + a.w * b.w; }
__device__ __forceinline__ float bf2f(bf16_t u) { return __uint_as_float((unsigned)u << 16); }
__device__ __forceinline__ unsigned f2bf(float f) { unsigned u = __float_as_uint(f); return (u + 0x7fffu + ((u >> 16) & 1u)) >> 16; }
__device__ __forceinline__ unsigned pk2(float lo, float hi) { return f2bf(lo) | (f2bf(hi) << 16); }
__device__ __forceinline__ float bflo(unsigned w) { return __uint_as_float(w << 16); }
__device__ __forceinline__ float bfhi(unsigned w) { return __uint_as_float(w & 0xffff0000u); }
__device__ __forceinline__ float rstd_of(float ssq) { return rsqrtf(ssq * (1.0f / DM) + EPS); }

namespace pg8 {
#define PG8_LAS __attribute__((address_space(3)))
typedef unsigned short bf16_t;
typedef short bf16x8 __attribute__((ext_vector_type(8)));
typedef float f32x4 __attribute__((ext_vector_type(4)));
typedef unsigned u32x4 __attribute__((ext_vector_type(4)));
constexpr int BM = 256, BK = 64, HALF = 128, HTB = HALF * BK * 2  , STAGE_BYTES = 8 * HTB, NXCD = 8, WGM = 8;

__host__ __device__ __forceinline__ int lds_byte(int r, int c) { const int st = (r >> 4) * 2 + (c >> 5), rr = r & 15, cc = c & 31, ob = rr * 64 + cc * 2; return st * 1024 + (ob ^ (((ob >> 9) & 1) << 5)); }
__host__ __device__ __forceinline__ void stage_rc(int b, int& R, int& C) { const int st = b / 1024, sb = b % 1024, swz = sb ^ (((sb >> 9) & 1) << 5); R = (st >> 1) * 16 + swz / 64; C = (st & 1) * 32 + (swz % 64) / 2; }
__host__ __device__ __forceinline__ int perm32(int rho) { const int n = rho >> 4, i = rho & 15; return 8 * (i >> 2) + 4 * n + (i & 3); }

struct Unit { int pm, pn; };
struct Gemm { const bf16_t* A; const bf16_t* Bt; int M, N, K; };

struct StaticOrder {
    int nM, nN, nwg, G, c;
    __host__ __device__ void init(int M, int N, int G_, int c_) { nM = M / BM; nN = N / BM; nwg = nM * nN; G = G_; c = c_; }
    __host__ __device__ bool next(int i, Unit& u) const {
        const long L = (long)i * G + c; if (L >= nwg) return false;
        int wgid = (int)L; { const int q = nwg / NXCD, r = nwg % NXCD, xcd = wgid % NXCD, off = wgid / NXCD; wgid = (xcd < r ? xcd * (q + 1) : r * (q + 1) + (xcd - r) * q) + off; }
        const int nig = WGM * nN, gid = wgid / nig, fm = gid * WGM, gsz = (nM - fm) < WGM ? (nM - fm) : WGM;
        u.pm = fm + ((wgid % nig) % gsz); u.pn = (wgid % nig) / gsz; return true;
    }
    __device__ __forceinline__ void a_ready(const Unit&) const {}
    __device__ __forceinline__ void done(const Unit&) const {}
};

__device__ __forceinline__ unsigned cvt_pk_bf16(float lo, float hi) { unsigned r; asm volatile("v_cvt_pk_bf16_f32 %0, %1, %2" : "=v"(r) : "v"(lo), "v"(hi)); return r; }
typedef float f32x2 __attribute__((ext_vector_type(2)));
__device__ __forceinline__ float fast_sigmoid(float x) { return __builtin_amdgcn_rcpf(1.0f + __builtin_amdgcn_exp2f(-1.4426950408889634f * x)); }
struct EpiF32 {
    static constexpr bool PERM = false, AFTER_DRAIN = false;
    float* O; int ldc; const float* ssq; int split_cols; size_t split_stride;
    __device__ __forceinline__ void operator()(const f32x4 (&acc)[2][2][4][2], const Unit& u, int wr, int wc, int fr, int fq) const {
        int colt = u.pn * BM; float* base = O; if (split_cols) { const int t = colt / split_cols; base += (size_t)t * split_stride; colt -= t * split_cols; }
        const int row0 = u.pm * BM + wr * 64 + fr, col0 = colt + wc * 32 + 4 * fq;
#pragma unroll
        for (int ai = 0; ai < 2; ++ai)
#pragma unroll
            for (int m = 0; m < 4; ++m) { const int r = row0 + ai * HALF + m * 16; const float rs = ssq ? rstd_of(ssq[r]) : 1.0f; float* rowp = base + (size_t)r * ldc + col0;
#pragma unroll
                for (int bj = 0; bj < 2; ++bj)
#pragma unroll
                    for (int n = 0; n < 2; ++n) *(f32x4*)(rowp + bj * HALF + n * 16) = acc[ai][bj][m][n] * rs; }
    }
};
struct EpiBf16S {
    static constexpr bool PERM = true, AFTER_DRAIN = false;
    bf16_t* O; int ldc; const float* ssq; int gate_pn; float* GT;
    __device__ __forceinline__ void operator()(const f32x4 (&acc)[2][2][4][2], const Unit& u, int wr, int wc, int fr, int fq) const {
        const int row0 = u.pm * BM + wr * 64 + fr, col0 = u.pn * BM + wc * 32 + 8 * fq;
        if (u.pn == gate_pn) {
            if (wc == 0 && fq == 0) {
#pragma unroll
                for (int ai = 0; ai < 2; ++ai)
#pragma unroll
                    for (int m = 0; m < 4; ++m) { const int r = row0 + ai * HALF + m * 16; const float rs = rstd_of(ssq[r]);
                        *(f32x4*)(GT + (size_t)r * 48) = acc[ai][0][m][0] * rs; *(f32x4*)(GT + (size_t)r * 48 + 4) = acc[ai][0][m][1] * rs; } }
            return; }
#pragma unroll
        for (int ai = 0; ai < 2; ++ai)
#pragma unroll
            for (int m = 0; m < 4; ++m) { const int r = row0 + ai * HALF + m * 16; const float rs = rstd_of(ssq[r]); bf16_t* rowp = O + (size_t)r * ldc + col0;
#pragma unroll
                for (int bj = 0; bj < 2; ++bj) { const f32x4 v0 = acc[ai][bj][m][0] * rs, v1 = acc[ai][bj][m][1] * rs;
                    u32x4 w; w.x = cvt_pk_bf16(v0[0], v0[1]); w.y = cvt_pk_bf16(v0[2], v0[3]); w.z = cvt_pk_bf16(v1[0], v1[1]); w.w = cvt_pk_bf16(v1[2], v1[3]);
                    *(u32x4*)(rowp + bj * HALF) = w; } }
    }
};
struct EpiSwiglu {
    static constexpr bool PERM = true, AFTER_DRAIN = false;
    bf16_t* O; const float* ssq;
    __device__ __forceinline__ void operator()(const f32x4 (&acc)[2][2][4][2], const Unit& u, int wr, int wc, int fr, int fq) const {
        const int row0 = u.pm * BM + wr * 64 + fr, col0 = u.pn * HALF + wc * 32 + 8 * fq;
#pragma unroll
        for (int ai = 0; ai < 2; ++ai)
#pragma unroll
            for (int m = 0; m < 4; ++m) { const int r = row0 + ai * HALF + m * 16; const float rs = rstd_of(ssq[r]); float h[8];
#pragma unroll
                for (int n = 0; n < 2; ++n)
#pragma unroll
                    for (int j = 0; j < 4; ++j) { const float g = acc[ai][0][m][n][j] * rs, up = acc[ai][1][m][n][j] * rs; h[4 * n + j] = g * fast_sigmoid(g) * up; }
                u32x4 w; w.x = cvt_pk_bf16(h[0], h[1]); w.y = cvt_pk_bf16(h[2], h[3]); w.z = cvt_pk_bf16(h[4], h[5]); w.w = cvt_pk_bf16(h[6], h[7]);
                *(u32x4*)(O + (size_t)r * 2816 + col0) = w; }
    }
};
struct EpiResid {
    static constexpr bool PERM = false, AFTER_DRAIN = false;
    float* Y; bf16_t* XB; float* ssq;
    __device__ __forceinline__ void operator()(const f32x4 (&acc)[2][2][4][2], const Unit& u, int wr, int wc, int fr, int fq) const {
        const int row0 = u.pm * BM + wr * 64 + fr, col0 = u.pn * BM + wc * 32 + 4 * fq;
        typedef unsigned u32x2 __attribute__((ext_vector_type(2)));
#pragma unroll
        for (int ai = 0; ai < 2; ++ai)
#pragma unroll
            for (int m = 0; m < 4; ++m) { const int r = row0 + ai * HALF + m * 16; bf16_t* bp = XB + (size_t)r * 1024 + col0; float ss = 0.f; u32x2 old[2][2];
#pragma unroll
                for (int bj = 0; bj < 2; ++bj)
#pragma unroll
                    for (int n = 0; n < 2; ++n) old[bj][n] = *(const u32x2*)(bp + bj * HALF + n * 16);
#pragma unroll
                for (int bj = 0; bj < 2; ++bj)
#pragma unroll
                    for (int n = 0; n < 2; ++n) { const u32x2 o = old[bj][n]; f32x4 x = (f32x4){bflo(o.x), bfhi(o.x), bflo(o.y), bfhi(o.y)} + acc[ai][bj][m][n];
                        u32x2 w; w.x = cvt_pk_bf16(x[0], x[1]); w.y = cvt_pk_bf16(x[2], x[3]); *(u32x2*)(bp + bj * HALF + n * 16) = w;
                        if (Y) *(f32x4*)(Y + (size_t)r * 1024 + col0 + bj * HALF + n * 16) = x;
                        ss += (x[0] * x[0] + x[1] * x[1]) + (x[2] * x[2] + x[3] * x[3]); }
                ss += __shfl_xor(ss, 16); ss += __shfl_xor(ss, 32);
                if (fq == 0) (void)__hip_atomic_fetch_add(ssq + r, ss, __ATOMIC_RELAXED, __HIP_MEMORY_SCOPE_AGENT); }
    }
};
template <class Epi, class Sched, bool ALIGN_EPI = false, bool SP2 = false>
__device__ __forceinline__ void gemm_phase(PG8_LAS unsigned char* lds, const Gemm g, const Sched& S, const Epi& E) {
    int tid_l = threadIdx.x; asm volatile("" : "+v"(tid_l));
    const int tid = tid_l, wid = __builtin_amdgcn_readfirstlane(tid >> 6), lane = tid & 63, wr = wid >> 2, wc = wid & 3, fr = lane & 15, fq = lane >> 4;
    const int K = g.K, nt = K / BK;
    unsigned voffA[2], voffB[2];
#pragma unroll
    for (int i = 0; i < 2; ++i) { int R, C; stage_rc(tid * 16 + i * 8192, R, C); const int Rb = Epi::PERM ? ((R & ~31) + perm32(R & 31)) : R;
        voffA[i] = (unsigned)(R * K + C) * 2u; voffB[i] = (unsigned)(Rb * K + C) * 2u; }
    const size_t kstep = (size_t)(BK * 2);
    const size_t hstep = (size_t)HALF * K * 2;
    const size_t tstep = 2 * hstep;
    const unsigned ldsw = (unsigned)wid * 1024u;
    const int aoff = lds_byte(wr * 64 + fr, fq * 8), boff = lds_byte(wc * 32 + fr, fq * 8);
#define PG8_SA(b, h) (((b) * 2 + (h)) * HTB)
#define PG8_SB(b, h) ((4 + (b) * 2 + (h)) * HTB)
#define PG8_STAGE(bufoff, gbase, voff) do { _Pragma("unroll") for (int _i = 0; _i < 2; ++_i) \
        __builtin_amdgcn_global_load_lds((const unsigned*)((const char*)(gbase) + (voff)[_i]), (PG8_LAS unsigned*)(lds + (bufoff) + ldsw + _i * 8192), 16, 0, 0); } while (0)
#define PG8_LDA(dst, b, h) do { _Pragma("unroll") for (int m = 0; m < 4; ++m) _Pragma("unroll") for (int k = 0; k < 2; ++k) dst[m][k] = *(const PG8_LAS bf16x8*)(lds + PG8_SA(b, h) + aoff + m * 2048 + k * 1024); } while (0)
#define PG8_LDB(dst, b, h) do { _Pragma("unroll") for (int n = 0; n < 2; ++n) _Pragma("unroll") for (int k = 0; k < 2; ++k) dst[n][k] = *(const PG8_LAS bf16x8*)(lds + PG8_SB(b, h) + boff + n * 2048 + k * 1024); } while (0)
#define PG8_MMA(ai, bj, At, Bt) do { __builtin_amdgcn_s_setprio(1); _Pragma("unroll") for (int m = 0; m < 4; ++m) _Pragma("unroll") for (int n = 0; n < 2; ++n) _Pragma("unroll") for (int k = 0; k < 2; ++k) \
        acc[ai][bj][m][n] = __builtin_amdgcn_mfma_f32_16x16x32_bf16(Bt[n][k], At[m][k], acc[ai][bj][m][n], 0, 0, 0); __builtin_amdgcn_s_setprio(0); } while (0)
#define PG8_WAIT_V(n) asm volatile("s_waitcnt vmcnt(" #n ")" ::: "memory")
#define PG8_WAIT_L(n) asm volatile("s_waitcnt lgkmcnt(" #n ")" ::: "memory")
#define PG8_BAR __builtin_amdgcn_s_barrier()
#define PG8_SCHED __builtin_amdgcn_sched_barrier(0)
    Unit cur, nxt; int ui = 0;
    if (!S.next(0, cur)) return;
    f32x4 acc[2][2][4][2];
#pragma unroll
    for (int a = 0; a < 2; ++a)
#pragma unroll
        for (int b = 0; b < 2; ++b)
#pragma unroll
            for (int m = 0; m < 4; ++m)
#pragma unroll
                for (int n = 0; n < 2; ++n) acc[a][b][m][n] = (f32x4){0.f, 0.f, 0.f, 0.f};
    bf16x8 At[4][2], B0[2][2], B1[2][2];
    const char* cA = (const char*)g.A + (size_t)cur.pm * tstep; const char* cB = (const char*)g.Bt + (size_t)cur.pn * tstep;
    S.a_ready(cur);
    if constexpr (SP2) {
        PG8_STAGE(PG8_SB(0, 0), cB, voffB); PG8_STAGE(PG8_SB(0, 1), cB + hstep, voffB); PG8_STAGE(PG8_SA(0, 0), cA, voffA); PG8_STAGE(PG8_SA(0, 1), cA + hstep, voffA);
        if (wr == 1) PG8_BAR;
        PG8_WAIT_V(2); PG8_BAR;
        PG8_STAGE(PG8_SB(1, 0), cB + kstep, voffB); PG8_STAGE(PG8_SA(1, 0), cA + kstep, voffA); PG8_STAGE(PG8_SB(1, 1), cB + hstep + kstep, voffB);
        PG8_WAIT_V(6); PG8_BAR;
    } else {
        PG8_STAGE(PG8_SB(0, 0), cB, voffB); PG8_STAGE(PG8_SA(0, 0), cA, voffA); PG8_STAGE(PG8_SB(0, 1), cB + hstep, voffB); PG8_STAGE(PG8_SA(0, 1), cA + hstep, voffA);
        if (wr == 1) PG8_BAR;
        PG8_WAIT_V(4); PG8_BAR;
        PG8_STAGE(PG8_SB(1, 0), cB + kstep, voffB); PG8_STAGE(PG8_SA(1, 0), cA + kstep, voffA); PG8_STAGE(PG8_SB(1, 1), cB + hstep + kstep, voffB);
        PG8_WAIT_V(6); PG8_BAR;
    }
    for (;;) {
        const bool has_next = S.next(ui + 1, nxt);
        const char* nA = has_next ? (const char*)g.A + (size_t)nxt.pm * tstep : cA; const char* nB = has_next ? (const char*)g.Bt + (size_t)nxt.pn * tstep : cB;
        for (int t = 0; t < nt; t += 2) {
            const bool last = (t == nt - 2);
            const char* a1 = cA + (size_t)(t + 1) * kstep;
            const char* a2 = last ? nA : cA + (size_t)(t + 2) * kstep; const char* b2 = last ? nB : cB + (size_t)(t + 2) * kstep;
            const char* a3 = a2 + kstep; const char* b3 = b2 + kstep;
            if (last && has_next) S.a_ready(nxt);
            if constexpr (SP2) {
            PG8_LDB(B0, 0, 0); PG8_LDB(B1, 0, 1); PG8_SCHED; PG8_LDA(At, 0, 0); PG8_STAGE(PG8_SA(1, 1), a1 + hstep, voffA);
            PG8_WAIT_V(8); PG8_WAIT_L(0); PG8_BAR; PG8_MMA(0, 0, At, B0); PG8_MMA(0, 1, At, B1); PG8_BAR; PG8_SCHED;
            PG8_LDA(At, 0, 1); PG8_STAGE(PG8_SB(0, 0), b2, voffB); PG8_STAGE(PG8_SB(0, 1), b2 + hstep, voffB); PG8_STAGE(PG8_SA(0, 0), a2, voffA);
            PG8_WAIT_V(8); PG8_WAIT_L(0); PG8_BAR; PG8_MMA(1, 0, At, B0); PG8_MMA(1, 1, At, B1); PG8_BAR; PG8_SCHED;
            PG8_LDB(B0, 1, 0); PG8_LDB(B1, 1, 1); PG8_SCHED; PG8_LDA(At, 1, 0); PG8_STAGE(PG8_SA(0, 1), a2 + hstep, voffA);
            PG8_WAIT_V(8); PG8_WAIT_L(0); PG8_BAR; PG8_MMA(0, 0, At, B0); PG8_MMA(0, 1, At, B1); PG8_BAR; PG8_SCHED;
            PG8_LDA(At, 1, 1); PG8_STAGE(PG8_SB(1, 0), b3, voffB); PG8_STAGE(PG8_SB(1, 1), b3 + hstep, voffB); PG8_STAGE(PG8_SA(1, 0), a3, voffA);
            PG8_WAIT_V(8); PG8_WAIT_L(0); PG8_BAR; PG8_MMA(1, 0, At, B0); PG8_MMA(1, 1, At, B1); PG8_BAR; PG8_SCHED;
            } else {
            PG8_LDB(B0, 0, 0); PG8_SCHED; PG8_LDA(At, 0, 0); PG8_STAGE(PG8_SA(1, 1), a1 + hstep, voffA);
            PG8_WAIT_L(8); PG8_BAR; PG8_WAIT_L(0); PG8_MMA(0, 0, At, B0); PG8_BAR; PG8_SCHED;
            PG8_LDB(B1, 0, 1); PG8_STAGE(PG8_SB(0, 0), b2, voffB);
            PG8_BAR; PG8_WAIT_L(0); PG8_MMA(0, 1, At, B1); PG8_BAR;
            PG8_LDA(At, 0, 1); PG8_STAGE(PG8_SA(0, 0), a2, voffA);
            PG8_BAR; PG8_WAIT_L(0); PG8_MMA(1, 0, At, B0); PG8_BAR; PG8_SCHED;
            PG8_STAGE(PG8_SB(0, 1), b2 + hstep, voffB);
            PG8_WAIT_V(6); PG8_BAR; PG8_MMA(1, 1, At, B1); PG8_BAR;
            PG8_LDB(B0, 1, 0); PG8_SCHED; PG8_LDA(At, 1, 0); PG8_STAGE(PG8_SA(0, 1), a2 + hstep, voffA);
            PG8_WAIT_L(8); PG8_BAR; PG8_WAIT_L(0); PG8_MMA(0, 0, At, B0); PG8_BAR; PG8_SCHED;
            PG8_LDB(B1, 1, 1); PG8_STAGE(PG8_SB(1, 0), b3, voffB);
            PG8_BAR; PG8_WAIT_L(0); PG8_MMA(0, 1, At, B1); PG8_BAR;
            PG8_LDA(At, 1, 1); PG8_STAGE(PG8_SA(1, 0), a3, voffA);
            PG8_BAR; PG8_WAIT_L(0); PG8_MMA(1, 0, At, B0); PG8_BAR; PG8_SCHED;
            PG8_STAGE(PG8_SB(1, 1), b3 + hstep, voffB);
            PG8_WAIT_V(6); PG8_BAR; PG8_MMA(1, 1, At, B1); PG8_BAR;
            }
        }
        if constexpr (ALIGN_EPI) { if (wr == 0) PG8_BAR; }
        if constexpr (!Epi::AFTER_DRAIN) { E(acc, cur, wr, wc, fr, fq); S.done(cur); }
        if (!has_next) break;
#pragma unroll
        for (int a = 0; a < 2; ++a)
#pragma unroll
            for (int b = 0; b < 2; ++b)
#pragma unroll
                for (int m = 0; m < 4; ++m)
#pragma unroll
                    for (int n = 0; n < 2; ++n) acc[a][b][m][n] = (f32x4){0.f, 0.f, 0.f, 0.f};
        cur = nxt; cA = nA; cB = nB; ++ui;
        if constexpr (ALIGN_EPI) { if (wr == 1) PG8_BAR; }
    }
    PG8_WAIT_V(0);
    if constexpr (!ALIGN_EPI) { if (wr == 0) PG8_BAR; }
    PG8_BAR;
    if constexpr (Epi::AFTER_DRAIN) { E.fused(acc, cur, wr, wc, fr, fq, lds, wid, lane); S.done(cur); }
#undef PG8_SA
#undef PG8_SB
#undef PG8_STAGE
#undef PG8_LDA
#undef PG8_LDB
#undef PG8_MMA
#undef PG8_WAIT_V
#undef PG8_WAIT_L
#undef PG8_BAR
#undef PG8_SCHED
}
}
typedef short s_bf16x8 __attribute__((ext_vector_type(8)));
typedef float s_f32x4 __attribute__((ext_vector_type(4)));
template <int NT> struct StripAcc { s_f32x4 a[NT]; };
template <int NT> __device__ __forceinline__ void strip_gemm(const bf16_t* A, int K, int row0, const bf16_t* Bt, const int* brow  , StripAcc<NT>& R, LAS unsigned char* lds) {
    const int tid_ = ltid(), lane = tid_ & 63, wave = tid_ >> 6, fr = lane & 15, fq = lane >> 4, rt = wave & 1, kq = wave >> 1;
    LAS float* red = (LAS float*)lds;
    const int kw = K >> 2;
    const bf16_t* ap = A + (size_t)(row0 + 16 * rt + fr) * K + kq * kw + fq * 8;
    const bf16_t* bp[NT];
#pragma unroll
    for (int t = 0; t < NT; ++t) { bp[t] = Bt + (size_t)(brow[t] + fr) * K + kq * kw + fq * 8; R.a[t] = (s_f32x4){0.f, 0.f, 0.f, 0.f}; }
    int k0 = 0;
#pragma unroll 1
    for (; k0 + 256 <= kw; k0 += 256) {
        s_bf16x8 a[8], b[NT][8];
#pragma unroll
        for (int s2 = 0; s2 < 8; ++s2) { a[s2] = *(const s_bf16x8*)(ap + k0 + s2 * 32);
#pragma unroll
            for (int t = 0; t < NT; ++t) b[t][s2] = *(const s_bf16x8*)(bp[t] + k0 + s2 * 32); }
#pragma unroll
        for (int s2 = 0; s2 < 8; ++s2)
#pragma unroll
            for (int t = 0; t < NT; ++t) R.a[t] = __builtin_amdgcn_mfma_f32_16x16x32_bf16(b[t][s2], a[s2], R.a[t], 0, 0, 0);
    }
#pragma unroll 1
    for (; k0 < kw; k0 += 64) {
        s_bf16x8 a[2], b[NT][2];
#pragma unroll
        for (int s2 = 0; s2 < 2; ++s2) { a[s2] = *(const s_bf16x8*)(ap + k0 + s2 * 32);
#pragma unroll
            for (int t = 0; t < NT; ++t) b[t][s2] = *(const s_bf16x8*)(bp[t] + k0 + s2 * 32); }
#pragma unroll
        for (int s2 = 0; s2 < 2; ++s2)
#pragma unroll
            for (int t = 0; t < NT; ++t) R.a[t] = __builtin_amdgcn_mfma_f32_16x16x32_bf16(b[t][s2], a[s2], R.a[t], 0, 0, 0);
    }
    __syncthreads();
    if (kq > 0) {
#pragma unroll
        for (int t = 0; t < NT; ++t) *(LAS s_f32x4*)(red + ((((kq - 1) * 2 + rt) * NT + t) * 64 + lane) * 4) = R.a[t]; }
    __syncthreads();
    if (kq == 0) {
#pragma unroll
        for (int q = 0; q < 3; ++q)
#pragma unroll
            for (int t = 0; t < NT; ++t) R.a[t] = R.a[t] + *(const LAS s_f32x4*)(red + (((q * 2 + rt) * NT + t) * 64 + lane) * 4); }
}
enum { TR_ID = 0, TR_INA, TR_INB, TR_GU };
__device__ __forceinline__ int tr_rowmap(int kind, int n) {
    if (kind == TR_INA) return n < 3072 ? n : (n < 3080 ? 3328 + (n - 3072) : 3072 + (n - 3080));
    if (kind == TR_INB) return n < 768 ? n : (n < 804 ? 1024 + (n - 768) : 768 + (n - 804));
    if (kind == TR_GU) { if (n < DFF) return (n >> 7) * 256 + (n & 127); const int m = n - DFF; return (m >> 7) * 256 + 128 + (m & 127); }
    return n;
}
__device__ __forceinline__ void tr_item(const float* W, int K, int N, bf16_t* WT, const float* gain, int kind, LAS float* scr, int item, int lane) {
    const int nblk = (N + 31) >> 5, kb = item / nblk, nb = item % nblk, k0 = 64 * kb, n0 = 32 * nb;
    { float v[32]; const int n = n0 + (lane & 31); const bool ok = n < N; const float* wp = W + (size_t)(k0 + (lane >> 5)) * N + (ok ? n : 0);
#pragma unroll
      for (int i = 0; i < 32; ++i) v[i] = wp[(size_t)(2 * i) * N];
#pragma unroll
      for (int i = 0; i < 32; ++i) { const int kk = 2 * i + (lane >> 5); float x = ok ? v[i] : 0.f; if (gain) x *= gain[k0 + kk]; scr[kk * 33 + (lane & 31)] = x; } }
    asm volatile("s_waitcnt lgkmcnt(0)" ::: "memory");
    const int c = lane & 7;
#pragma unroll
    for (int j = 0; j < 4; ++j) { const int nn = (lane >> 3) + 8 * j, n = n0 + nn;
        if (n < N) { const int row = tr_rowmap(kind, n); const float sc = (kind == TR_INA && n >= 768 && n < 1536) ? 0.07216878364870322f : 1.0f;
            const LAS float* s = scr + (8 * c) * 33 + nn; uint4 o;
            o.x = pk2(s[0 * 33] * sc, s[1 * 33] * sc); o.y = pk2(s[2 * 33] * sc, s[3 * 33] * sc); o.z = pk2(s[4 * 33] * sc, s[5 * 33] * sc); o.w = pk2(s[6 * 33] * sc, s[7 * 33] * sc);
            *(uint4*)(WT + (size_t)row * K + k0 + 8 * c) = o; } }
    asm volatile("s_waitcnt lgkmcnt(0)" ::: "memory");
}
__device__ __forceinline__ void ph_prologue(const Params& p, LAS unsigned char* lds) {
    const int tid = ltid(), lane = tid & 63, wid = tid >> 6; const int gw = blockIdx.x * NW_ + wid, NGW = gridDim.x * NW_;
    LAS float* scr = (LAS float*)(lds + wid * 16384);
    unsigned char* ws = p.ws;
    for (int it = gw; ; it += NGW) {
        int r = it; bool done = false;
#define TRJ(Wp, K_, N_, WTp, gainp, kind_) if (!done) { const int cnt = ((K_) / 64) * (((N_) + 31) / 32); if (r < cnt) { tr_item(Wp, K_, N_, WTp, gainp, kind_, scr, r, lane); done = true; } else r -= cnt; }
        for (int l = 0; l < 4; ++l) TRJ(p.in[I_WGU] + (size_t)l * DM * 2 * DFF, DM, 2 * DFF, (bf16_t*)(ws + B_BTG) + (size_t)l * 2 * DFF * DM, p.in[I_GFFN] + l * DM, TR_GU)
        for (int l = 0; l < 4; ++l) TRJ(p.in[I_WDOWN] + (size_t)l * DFF * DM, DFF, DM, (bf16_t*)(ws + B_BTD) + (size_t)l * DM * DFF, (const float*)nullptr, TR_ID)
        for (int l = 0; l < 2; ++l) TRJ(p.in[I_WINA] + (size_t)l * DM * ACOLS, DM, ACOLS, (bf16_t*)(ws + B_BTA) + (size_t)l * NBTA * DM, p.in[I_GMIX] + l * DM, TR_INA)
        for (int l = 0; l < 2; ++l) TRJ(p.in[I_WINB] + (size_t)l * DM * BCOLS, DM, BCOLS, (bf16_t*)(ws + B_BTB) + (size_t)l * NBTB * DM, p.in[I_GMIX] + (2 + l) * DM, TR_INB)
        for (int l = 0; l < 4; ++l) TRJ(p.in[I_WOUT] + (size_t)l * DM * DM, DM, DM, (bf16_t*)(ws + B_BTO) + (size_t)l * DM * DM, (const float*)nullptr, TR_ID)
        TRJ(p.in[I_WKV], DM, 768, (bf16_t*)(ws + B_BTK), p.in[I_GKV], TR_ID)
        for (int l = 0; l < 4; ++l) TRJ(p.in[I_WMEMKV] + (size_t)l * DM * 512, DM, 512, (bf16_t*)(ws + B_BTM) + (size_t)l * 512 * DM, (const float*)nullptr, TR_ID)
        for (int c = 0; c < 2; ++c) TRJ(p.in[I_CW1] + (size_t)c * 2048 * 128, 2048, 128, (bf16_t*)(ws + B_W1T) + (size_t)c * 128 * 2048, (const float*)nullptr, TR_ID)
        for (int c = 0; c < 2; ++c) TRJ(p.in[I_CW2] + (size_t)c * 128 * 64, 128, 64, (bf16_t*)(ws + B_W2T) + (size_t)c * 64 * 128, (const float*)nullptr, TR_ID)
#undef TRJ
        if (!done) break;
    }
    for (int idx = gw; idx < 256; idx += NGW) { const int c = idx >> 7, h = idx & 127; float s = 0.f;
        for (int k = lane; k < 2048; k += 64) s += p.in[I_CPOS][((k >> 6) * 2 + c) * 64 + (k & 63)] * p.in[I_CW1][((size_t)c * 2048 + k) * 128 + h];
        s = wave_sum(s); if (lane == 0) ((float*)(ws + B_PEB))[idx] = s + p.in[I_CB1][idx]; }
    for (int i = blockIdx.x * NT_ + tid; i < 2 * 8 * 128 + 2 * 12 * 128; i += gridDim.x * NT_) {
        uint4 z = make_uint4(0u, 0u, 0u, 0u);
        if (i < 2048) { const int l = i >> 10, rr = (i >> 7) & 7, c = i & 127; ((uint4*)((bf16_t*)(ws + B_BTA) + ((size_t)l * NBTA + 3336 + rr) * DM))[c] = z; }
        else { const int k = i - 2048; const int l = k / 1536, rr = (k % 1536) >> 7, c = k & 127; ((uint4*)((bf16_t*)(ws + B_BTB) + ((size_t)l * NBTB + 1060 + rr) * DM))[c] = z; }
    }
    bf16_t* XB = (bf16_t*)(ws + B_XB); float* ssq0 = (float*)(ws + B_SSQ); bf16_t* MPB = (bf16_t*)(ws + B_MPB);
    for (int r0 = gw; r0 < MA + 2048; r0 += 2 * NGW) {
        float4 v[2][4]; const int r1 = r0 + NGW < MA + 2048 ? r0 + NGW : r0;
#pragma unroll
        for (int u = 0; u < 2; ++u) { const int r = u ? r1 : r0; const float* src = r < MA ? (r < MP ? p.in[I_XP] + (size_t)r * DM : p.in[I_XS] + (size_t)(r - MP) * DM) : p.in[I_MEMP] + (size_t)(r - MA) * DM;
#pragma unroll
            for (int j = 0; j < 4; ++j) v[u][j] = ((const float4*)src)[lane + 64 * j]; }
#pragma unroll
        for (int u = 0; u < 2; ++u) { const int r = u ? r1 : r0; if (u == 1 && r1 == r0) break; const bool isx = r < MA;
            bf16_t* dstb = isx ? XB + (size_t)r * DM : MPB + (size_t)(r - MA) * DM; float ss = 0.f;
#pragma unroll
            for (int j = 0; j < 4; ++j) { ss += dot4(v[u][j], v[u][j]); ((uint2*)dstb)[lane + 64 * j] = make_uint2(pk2(v[u][j].x, v[u][j].y), pk2(v[u][j].z, v[u][j].w)); }
            ss = wave_sum(ss); if (isx && lane == 0) ssq0[r] = ss; }
    }
}

__device__ __forceinline__ void ph_swin_copy(const Params& p, int blk0, int nblk) {
    if ((int)blockIdx.x < blk0 || (int)blockIdx.x >= blk0 + nblk) return;
    const int tid = ltid();
    {   const unsigned n4 = 128u * 511u * 64u, stride = nblk * NT_;
#define SW_SRC(i_) (((const float4*)(p.in[I_CWIN] + (size_t)((i_) / (511u * 64u)) * 512 * 256 + 256))[(i_) % (511u * 64u)])
#define SW_DST(i_) (((float4*)(p.out + O_SWIN + (size_t)((i_) / (511u * 64u)) * 512 * 256))[(i_) % (511u * 64u)])
        for (unsigned i0 = (blockIdx.x - blk0) * NT_ + tid; i0 < n4; i0 += 4 * stride) {
            const unsigned i1 = i0 + stride, i2 = i0 + 2 * stride, i3 = i0 + 3 * stride;
            const float4 v0 = SW_SRC(i0), v1 = SW_SRC(i1 < n4 ? i1 : i0), v2 = SW_SRC(i2 < n4 ? i2 : i0), v3 = SW_SRC(i3 < n4 ? i3 : i0);
            SW_DST(i0) = v0; if (i1 < n4) SW_DST(i1) = v1; if (i2 < n4) SW_DST(i2) = v2; if (i3 < n4) SW_DST(i3) = v3; }
#undef SW_SRC
#undef SW_DST
    }
}

__device__ __forceinline__ void ph_memk_norm(const Params& p) {
    const int tid_ = ltid(); const int lane = tid_ & 63, wid = tid_ >> 6;
    const float* raw = (const float*)(p.ws + B_MEMR);
    for (int it = blockIdx.x * NW_ + wid; it < 4 * 8 * 256; it += gridDim.x * NW_) {
        const int l = it / 2048;
        const float4* rr = (const float4*)(raw + (size_t)it * 512); float4* orow = (float4*)(p.out + O_PMEM + (size_t)it * 512);
        float4 v = rr[lane]; const float4 vv = rr[64 + lane]; float ss = dot4(v, v);
        ss += __shfl_xor(ss, 1); ss += __shfl_xor(ss, 2); ss += __shfl_xor(ss, 4); ss += __shfl_xor(ss, 8);
        const float rs = rsqrtf(ss * (1.0f / 64) + EPS);
        const float4 g = ((const float4*)(p.in[I_GMEMK] + l * 64))[lane & 15];
        v.x *= rs * g.x; v.y *= rs * g.y; v.z *= rs * g.z; v.w *= rs * g.w; orow[lane] = v; orow[64 + lane] = vv;
    }
}

__device__ __forceinline__ void ph_mlstm_prompt(const Params& p, int l, float* lds) {
    const bf16_t* P = (const bf16_t*)(p.ws + B_P16); const float* GT = (const float*)(p.ws + B_GT); const float* bif = p.in[I_BIF] + l * 8; float* HR = (float*)(p.ws + B_HRAW);
    const int tid = ltid(), lane = tid & 63, wid = tid >> 6;
    float* red = lds;
    for (int item = blockIdx.x; item < 256; item += gridDim.x) {
        const int es = item & 7, h = (item >> 3) & 3, b = item >> 5;
        const bool act = tid < 384; const int grp = tid >= 192 ? 1 : 0; const int d = act ? tid - grp * 192 : 0;
        const int col0 = h * 192 + es * 24 + (act ? grp : 0) * 12;
        float C[12]; float n = 0.f, m = NEGM;
#pragma unroll
        for (int e = 0; e < 12; ++e) C[e] = 0.f;
        const bf16_t* pr = P + (size_t)(b * SP) * LDA_; const float* gr = GT + (size_t)(b * SP) * GTW;
        float qn = act ? bf2f(pr[h * 192 + d]) : 0.f, kn = act ? bf2f(pr[768 + h * 192 + d]) : 0.f; uint2 vn[3];
#pragma unroll
        for (int e = 0; e < 3; ++e) vn[e] = *(const uint2*)(pr + 1536 + col0 + 4 * e);
        float in_ = gr[h] + bif[h], fn = gr[4 + h] + bif[4 + h];
        for (int t = 0; t < SP; ++t) {
            const float q = qn, k = kn, ig = in_, fg = fn; float v[12];
#pragma unroll
            for (int e = 0; e < 3; ++e) { v[4 * e] = bflo(vn[e].x); v[4 * e + 1] = bfhi(vn[e].x); v[4 * e + 2] = bflo(vn[e].y); v[4 * e + 3] = bfhi(vn[e].y); }
            if (t + 1 < SP) {
                pr += LDA_; gr += GTW;
                qn = act ? bf2f(pr[h * 192 + d]) : 0.f; kn = act ? bf2f(pr[768 + h * 192 + d]) : 0.f;
#pragma unroll
                for (int e = 0; e < 3; ++e) vn[e] = *(const uint2*)(pr + 1536 + col0 + 4 * e);
                in_ = gr[h] + bif[h]; fn = gr[4 + h] + bif[4 + h];
            }
            const float logf = logsigmoidf_(fg);
            const float m_new = fmaxf(logf + m, ig);
            const float a = expf(logf + m - m_new), bb = expf(ig - m_new);
            const float kb = bb * k;
            float part[13];
#pragma unroll
            for (int e = 0; e < 12; ++e) { C[e] = a * C[e] + kb * v[e]; part[e] = q * C[e]; }
            n = a * n + kb; part[12] = q * n;
#pragma unroll
            for (int e = 0; e < 13; ++e) part[e] = wave_sum(part[e]);
            float* rb = red + (t & 1) * 104;
            if (lane == 0) {
#pragma unroll
                for (int e = 0; e < 13; ++e) rb[wid * 13 + e] = part[e];
            }
            __syncthreads();
            if (tid < 24) {
                const int g2 = tid / 12, e = tid % 12;
                const float num = rb[(g2 * 3) * 13 + e] + rb[(g2 * 3 + 1) * 13 + e] + rb[(g2 * 3 + 2) * 13 + e];
                const float den = rb[12] + rb[13 + 12] + rb[26 + 12];
                HR[(size_t)(b * SP + t) * 768 + h * 192 + es * 24 + tid] = num / fmaxf(fabsf(den), expf(-m_new));
            }
            m = m_new;
        }
        if (act) {
            float* co = p.out + O_PC + ((size_t)((l * 8 + b) * 4 + h) * 192 + d) * 192 + es * 24 + grp * 12;
#pragma unroll
            for (int e = 0; e < 12; ++e) co[e] = C[e];
            if (es == 0 && grp == 0) p.out[O_PN + (size_t)((l * 8 + b) * 4 + h) * 192 + d] = n;
        }
        if (es == 0 && tid == 0) p.out[O_PM + (l * 8 + b) * 4 + h] = m;
        __syncthreads();
    }
}
__device__ __forceinline__ void ph_mlstm_sample(const Params& p, int l, float* lds) {
    const bf16_t* P = (const bf16_t*)(p.ws + B_P16); const float* GT = (const float*)(p.ws + B_GT); const float* bif = p.in[I_BIF] + l * 8; float* HR = (float*)(p.ws + B_HRAW);
    const int tid = ltid();
    float* qs = lds + 512; float* ks = lds + 512 + 192; float* n0s = lds + 512 + 384;
    for (int item = blockIdx.x; item < 128 * 4; item += gridDim.x) {
        const int h = item & 3, b = item >> 2; const int row = MP + b;
        const bf16_t* pr = P + (size_t)row * LDA_; const float* gr = GT + (size_t)row * GTW;
        const size_t sidx = (size_t)(l * 128 + b) * 4 + h;
        __syncthreads();
        if (tid < 192) { qs[tid] = bf2f(pr[h * 192 + tid]); ks[tid] = bf2f(pr[768 + h * 192 + tid]); n0s[tid] = p.in[I_SN][sidx * 192 + tid]; }
        __syncthreads();
        const float ig = gr[h] + bif[h], fg = gr[4 + h] + bif[4 + h];
        const float m0 = p.in[I_SM][sidx];
        const float logf = logsigmoidf_(fg);
        const float m_new = fmaxf(logf + m0, ig);
        const float a = expf(logf + m0 - m_new), bb = expf(ig - m_new);
        if (tid < 192) {
            const int e = tid; const float ve = bf2f(pr[1536 + h * 192 + e]);
            const float* C0 = p.in[I_SC] + sidx * 192 * 192; float* C1 = p.out + O_SC + sidx * 192 * 192;
            float num = 0.f, den = 0.f;
            for (int d = 0; d < 192; ++d) {
                const float c = a * C0[d * 192 + e] + bb * ks[d] * ve; C1[d * 192 + e] = c; num += qs[d] * c;
                const float nd = a * n0s[d] + bb * ks[d]; den += qs[d] * nd;
            }
            HR[(size_t)row * 768 + h * 192 + e] = num / fmaxf(fabsf(den), expf(-m_new));
            p.out[O_SN + sidx * 192 + e] = a * n0s[e] + bb * ks[e];
        }
        if (tid == 0) p.out[O_SM + sidx] = m_new;
    }
}
__device__ __forceinline__ void ph_mlstm_fin(const Params& p, int l) {
    const bf16_t* P = (const bf16_t*)(p.ws + B_P16); const float* HR = (const float*)(p.ws + B_HRAW); bf16_t* CATB = (bf16_t*)(p.ws + B_CATB); const float* g = p.in[I_GHN] + l * 192;
    const int tid_ = ltid(); const int lane = tid_ & 63, wid = tid_ >> 6;
    for (int row = blockIdx.x * NW_ + wid; row < MA; row += gridDim.x * NW_) {
        float v[4][3]; bf16_t og[4][3];
#pragma unroll
        for (int h = 0; h < 4; ++h)
#pragma unroll
            for (int i = 0; i < 3; ++i) { v[h][i] = HR[(size_t)row * 768 + h * 192 + lane + 64 * i]; og[h][i] = P[(size_t)row * LDA_ + 2304 + h * 192 + lane + 64 * i]; }
#pragma unroll
        for (int h = 0; h < 4; ++h) { float ss = v[h][0] * v[h][0] + v[h][1] * v[h][1] + v[h][2] * v[h][2]; ss = wave_sum(ss); const float rs = rsqrtf(ss * (1.0f / 192) + EPS);
#pragma unroll
            for (int i = 0; i < 3; ++i) { const int d = lane + 64 * i; CATB[(size_t)row * DM + h * 192 + d] = (bf16_t)f2bf(sigmoidf_(bf2f(og[h][i])) * (v[h][i] * rs * g[d])); } }
    }
}
__device__ __forceinline__ void ph_mem_attn(const Params& p, int l) {
    const int ldp = l < 2 ? LDA_ : LDB_, qoff = l < 2 ? 3072 : 768;
    const bf16_t* P = (const bf16_t*)(p.ws + B_P16); bf16_t* CATB = (bf16_t*)(p.ws + B_CATB); const float* gq = p.in[I_GMEMQ] + l * 64;
    for (int idx4 = blockIdx.x * NT_ + ltid(); idx4 < 16 * MA; idx4 += gridDim.x * NT_) {
        const int part = idx4 & 3, idx = idx4 >> 2;
        const int hh = idx / MA, row = idx % MA;
        const float* kvb = row < MP ? p.out + O_PMEM + (size_t)(l * 8 + row / SP) * 256 * 512 : p.in[I_CMEM] + (size_t)(l * 128 + (row - MP)) * 256 * 512;
        float q[16]; float ss = 0.f;
        const uint4* qp = (const uint4*)(P + (size_t)row * ldp + qoff + hh * 64 + part * 16);
#pragma unroll
        for (int i = 0; i < 2; ++i) { const uint4 t = qp[i]; q[8 * i] = bflo(t.x); q[8 * i + 1] = bfhi(t.x); q[8 * i + 2] = bflo(t.y); q[8 * i + 3] = bfhi(t.y); q[8 * i + 4] = bflo(t.z); q[8 * i + 5] = bfhi(t.z); q[8 * i + 6] = bflo(t.w); q[8 * i + 7] = bfhi(t.w); }
#pragma unroll
        for (int i = 0; i < 16; ++i) ss += q[i] * q[i];
        ss += __shfl_xor(ss, 1); ss += __shfl_xor(ss, 2);
        const float rs = rsqrtf(ss * (1.0f / 64) + EPS) * 0.125f;
#pragma unroll
        for (int i = 0; i < 16; ++i) q[i] *= rs * gq[part * 16 + i];
        float mx = -3e38f, den = 0.f; float o[16];
#pragma unroll
        for (int i = 0; i < 16; ++i) o[i] = 0.f;
        for (int m = 0; m < 256; ++m) {
            const float4* kp = (const float4*)(kvb + (size_t)m * 512 + hh * 64 + part * 16); const float4* vp = (const float4*)(kvb + (size_t)m * 512 + 256 + hh * 64 + part * 16);
            float s = 0.f;
#pragma unroll
            for (int i = 0; i < 4; ++i) { const float4 t = kp[i]; s += q[4 * i] * t.x + q[4 * i + 1] * t.y + q[4 * i + 2] * t.z + q[4 * i + 3] * t.w; }
            s += __shfl_xor(s, 1); s += __shfl_xor(s, 2);
            const float mn = fmaxf(mx, s); const float sc = expf(mx - mn), e = expf(s - mn); mx = mn; den = den * sc + e;
#pragma unroll
            for (int i = 0; i < 4; ++i) { const float4 t = vp[i]; o[4 * i] = o[4 * i] * sc + e * t.x; o[4 * i + 1] = o[4 * i + 1] * sc + e * t.y; o[4 * i + 2] = o[4 * i + 2] * sc + e * t.z; o[4 * i + 3] = o[4 * i + 3] * sc + e * t.w; }
        }
        const float inv = 1.0f / den; uint4* op = (uint4*)(CATB + (size_t)row * DM + 768 + hh * 64 + part * 16);
#pragma unroll
        for (int i = 0; i < 2; ++i) op[i] = make_uint4(pk2(o[8 * i] * inv, o[8 * i + 1] * inv), pk2(o[8 * i + 2] * inv, o[8 * i + 3] * inv), pk2(o[8 * i + 4] * inv, o[8 * i + 5] * inv), pk2(o[8 * i + 6] * inv, o[8 * i + 7] * inv));
    }
}
__device__ __forceinline__ void rows_post_tile(const Params& p, int row0, int t) {
    float* KVR = (float*)(p.ws + B_KVR); const int tid_ = ltid(); const int lane = tid_ & 63, wid = tid_ >> 6;
    const int c2 = lane >> 5, gg = (lane >> 4) & 1, d = (lane & 15) * 4; bf16_t* KVB = (bf16_t*)(p.ws + B_KVB); const size_t KT = (size_t)BP * 2 * SP * 64;
#pragma unroll 1
    for (int rr0 = wid; rr0 < 256; rr0 += 4 * NW_) {
      float4 vv[4];
#pragma unroll
      for (int k = 0; k < 4; ++k) { const int rowk = row0 + rr0 + k * NW_; vv[k] = ((const float4*)(KVR + (size_t)(rowk < MA ? rowk : MA - 1) * 768 + t * 256))[lane]; }
#pragma unroll
      for (int k = 0; k < 4; ++k) {
        const int row = row0 + rr0 + k * NW_; if (row >= MA) continue;
        float* r = KVR + (size_t)row * 768 + t * 256;
        float4 v = vv[k];
        if (t >= 1) {
            float ss = dot4(v, v);
            ss += __shfl_xor(ss, 1); ss += __shfl_xor(ss, 2); ss += __shfl_xor(ss, 4); ss += __shfl_xor(ss, 8);
            if (lane < 32) { const float rs = rsqrtf(ss * (1.0f / 64) + EPS); const float4 gk = ((const float4*)(t == 1 ? p.in[I_GKSLC] : p.in[I_GKWIN]))[lane & 15];
                v.x *= rs * gk.x; v.y *= rs * gk.y; v.z *= rs * gk.z; v.w *= rs * gk.w;
                if (row >= MP) ((float4*)r)[lane] = v; }
        }
        if (row < MP) {
            const int b = row / SP, sp = row % SP; const size_t off = (((size_t)b * 2 + gg) * SP + sp) * 64 + d;
            if (t == 0) { ((float4*)(p.out + O_PCMP + (size_t)row * 256))[lane] = v; *(uint2*)(KVB + (0 + c2) * KT + off) = make_uint2(pk2(v.x, v.y), pk2(v.z, v.w)); }
            else if (t == 2) { if (sp >= SP - 512) ((float4*)(p.out + O_PWIN + (size_t)(b * 512 + sp - (SP - 512)) * 256))[lane] = v; *(uint2*)(KVB + (4 + c2) * KT + off) = make_uint2(pk2(v.x, v.y), pk2(v.z, v.w)); }
            else {
                ((float4*)(p.out + O_PSLC + (size_t)row * 256))[lane] = v;
                const size_t blkbase = (((size_t)b * 2 + gg) * 32 + (sp >> 6)) * 4096;
                if (c2 == 0) { const int nt = (sp >> 4) & 3, fr2 = sp & 15, ks = d >> 5, fg2 = (d >> 3) & 3, e = d & 7;
                    *(uint2*)((bf16_t*)(p.ws + B_SKF) + blkbase + (size_t)(((nt * 2 + ks) * 64 + fg2 * 16 + fr2) * 8 + e)) = make_uint2(pk2(v.x, v.y), pk2(v.z, v.w)); }
                else { const int cs = (sp >> 5) & 1, kk = sp & 31, fg2 = (kk & 15) >> 2, e = (kk & 3) + (kk >= 16 ? 4 : 0), dt = d >> 4, fr2 = d & 15;
                    bf16_t* vf = (bf16_t*)(p.ws + B_SVF) + blkbase + (size_t)(((dt * 2 + cs) * 64 + fg2 * 16 + fr2) * 8 + e);
                    vf[0] = (bf16_t)f2bf(v.x); vf[8] = (bf16_t)f2bf(v.y); vf[16] = (bf16_t)f2bf(v.z); vf[24] = (bf16_t)f2bf(v.w); } }
        } else {
            const int b = row - MP;
            if (t == 0) ((float4*)(p.out + O_SCMP + (size_t)b * 256))[lane] = v; else if (t == 1) ((float4*)(p.out + O_SSLC + (size_t)b * 256))[lane] = v;
            else ((float4*)(p.out + O_SWIN + (size_t)(b * 512 + 511) * 256))[lane] = v;
        }
      }
    }
}
__device__ __forceinline__ float gelu_tanh(float x) { return 0.5f * x * (1.0f + tanhf(0.7978845608028654f * (x + 0.044715f * x * x * x))); }
__device__ __forceinline__ void ph_compress(const Params& p, float* lds) {
    const float* KVR = (const float*)(p.ws + B_KVR); const int tid = ltid();
    float* xs = lds;
    float* hs = lds + 4096;
    const float* w1 = p.in[I_CW1]; const float* w2 = p.in[I_CW2]; const int* pt = (const int*)p.in[I_PT];
    for (int item = blockIdx.x; item < 136 * 127 * 2; item += gridDim.x) {
        const int c = item & 1, n = (item >> 1) % 127, bb = (item >> 1) / 127;
        __syncthreads();
        for (int i = tid; i < 4096; i += NT_) {
            const int g = i >> 11, pp = (i >> 6) & 31, d = i & 63; const int tok = 16 * n + pp; float x;
            if (bb < 8) x = KVR[(size_t)(bb * SP + tok) * 768 + c * 128 + g * 64 + d];
            else { const int b = bb - 8; const int phys = pt[b * 16 + (tok >> 7)]; x = p.in[I_CCMP][((size_t)phys * 128 + (tok & 127)) * 256 + c * 128 + g * 64 + d]; }
            xs[i] = x + p.in[I_CPOS][(pp * 2 + c) * 64 + d];
        }
        __syncthreads();
        if (tid < 256) { const int g = tid >> 7, h = tid & 127; float pre = p.in[I_CB1][c * 128 + h]; const float* wp = w1 + (size_t)c * 2048 * 128 + h; const float* xp = xs + g * 2048;
          for (int i = 0; i < 2048; ++i) pre = fmaf(xp[i], wp[(size_t)i * 128], pre);
          hs[g * 128 + h] = gelu_tanh(pre); }
        __syncthreads();
        if (tid < 128) {
            const int g = tid >> 6, d = tid & 63; float o = p.in[I_CB2][c * 64 + d];
            for (int h = 0; h < 128; ++h) o = fmaf(hs[g * 128 + h], w2[(size_t)(c * 128 + h) * 64 + d], o);
            if (c == 0) { const float ss = wave_sum(o * o); o = o * rsqrtf(ss * (1.0f / 64) + EPS) * p.in[I_GKCMP][d]; }
            ((float*)(p.ws + (c == 0 ? B_CK : B_CV)))[((size_t)bb * 127 + n) * 128 + g * 64 + d] = o;
            bf16_t* kc = (bf16_t*)(p.ws + B_KC16) + ((((size_t)bb * 2 + c) * 2 + g) * 128 + n) * 64 + d; kc[0] = (bf16_t)f2bf(o); if (n == 126) kc[64] = 0;
        }
    }
}
#ifndef NSA_NAIVE_ALL
#define NSA_NAIVE_ALL 0
#endif
__device__ __forceinline__ void row_softmax(float* r, int n, int lane) {
    float mx = NEGM;
    for (int i = lane; i < n; i += 64) mx = fmaxf(mx, r[i]);
    mx = wave_max(mx);
    if (mx <= 0.5f * NEGM) { for (int i = lane; i < n; i += 64) r[i] = 0.f; return; }
    float s = 0.f;
    for (int i = lane; i < n; i += 64) { const float e = r[i] <= 0.5f * NEGM ? 0.f : expf(r[i] - mx); r[i] = e; s += e; }
    s = wave_sum(s); const float inv = 1.0f / s;
    for (int i = lane; i < n; i += 64) r[i] *= inv;
}
__device__ __forceinline__ void ph_nsa(const Params& p, int j, float* lds) {
    const int tid = ltid(), lane = tid & 63, wid = tid >> 6;
    float* qs = lds;
    float* sc = lds + 384;
    float* imp = sc + 3072;
    int* sel = (int*)(imp + 40);
    float* gate = (float*)(sel + 8);
    float* oacc = gate + 24;
    const bf16_t* P = (const bf16_t*)(p.ws + B_P16); const float* GT = (const float*)(p.ws + B_GT); const float* KVR = (const float*)(p.ws + B_KVR); bf16_t* CATB = (bf16_t*)(p.ws + B_CATB);
    const float* table = p.in[I_REL]; const int* pt = (const int*)p.in[I_PT];
    for (int item = blockIdx.x; item < (NSA_NAIVE_ALL ? MA : BS) * 2; item += gridDim.x) {
        const int row = (NSA_NAIVE_ALL ? 0 : MP) + (item >> 1), g = item & 1; const bool smp = row >= MP;
        const int b = smp ? row - MP : row / SP, pos = smp ? PAST : row % SP;
        const bf16_t* pr = P + (size_t)row * LDB_;
        __syncthreads();
        if (wid < 6) { const int z = wid; const float v = bf2f(pr[(g * 6 + z) * 64 + lane]); const float ss = wave_sum(v * v); qs[z * 64 + lane] = v * rsqrtf(ss * (1.0f / 64) + EPS) * p.in[I_GQ][j * 64 + lane]; }
        if (tid >= 384 && tid < 384 + 18) { const int t2 = tid - 384; const int br = t2 / 6, z = t2 % 6; gate[t2] = sigmoidf_(GT[(size_t)row * GTW + br * 12 + g * 6 + z] + p.in[I_BGATE][j * 36 + br * 12 + g * 6 + z]); }
        if (tid < 384) oacc[tid] = 0.f;
        __syncthreads();
        const float* ck = (const float*)(p.ws + B_CK) + (size_t)(smp ? 8 + b : b) * 127 * 128; const float* cv = (const float*)(p.ws + B_CV) + (size_t)(smp ? 8 + b : b) * 127 * 128;
        for (int i = tid; i < 6 * 127; i += NT_) {
            const int z = i / 127, n = i % 127; const int dist = pos - (16 * n + 31); float s = NEGM;
            if (dist >= 0) { const float4* kp = (const float4*)(ck + n * 128 + g * 64); const float4* qp = (const float4*)(qs + z * 64); float a = 0.f;
#pragma unroll 4
                for (int d = 0; d < 16; ++d) a += dot4(kp[d], qp[d]);
                s = a * 0.125f + table[rel_bucket(dist) * 12 + g * 6 + z]; }
            sc[z * 128 + n] = s;
        }
        __syncthreads();
        if (wid < 6) row_softmax(sc + wid * 128, 127, lane);
        __syncthreads();
        const int nslc = smp ? 33 : 32, cur = pos >> 6;
        if (tid < nslc) { const int jb = tid; float s = 0.f;
            for (int z = 0; z < 6; ++z) for (int n = 0; n < 127; ++n) { const int lo = max(16 * n, 64 * jb), hi = min(16 * n + 32, 64 * jb + 64); if (hi > lo) s += sc[z * 128 + n] * (float)(hi - lo) * (1.0f / 16); }
            imp[jb] = s; }
        __syncthreads();
        if (tid == 0) {
            int cnt = 0;
            if (cur + 1 <= 8) { for (int jb = 0; jb <= cur; ++jb) sel[cnt++] = jb; }
            else {
                sel[0] = 0; sel[1] = cur; sel[2] = cur - 1; cnt = 3; unsigned long long taken = 0ull;
                for (int k = 0; k < 5; ++k) { int best = -1; float bv = -1.f;
                    for (int jb = 1; jb <= cur - 2; ++jb) if (!((taken >> jb) & 1ull) && imp[jb] > bv) { bv = imp[jb]; best = jb; }
                    if (best >= 0) { taken |= 1ull << best; sel[cnt++] = best; } }
            }
            for (; cnt < 8; ++cnt) sel[cnt] = -1;
        }
        if (tid < 384) { const int z = tid >> 6, d = tid & 63; float o = 0.f;
            for (int n = 0; n < 127; ++n) o = fmaf(sc[z * 128 + n], cv[n * 128 + g * 64 + d], o);
            oacc[tid] += gate[0 * 6 + z] * o; }
        __syncthreads();
        for (int br = 1; br <= 2; ++br) {
            { const int t = tid;
                const float* kp = nullptr; int dist = -1;
                if (br == 1) {
                    const int blk = sel[t >> 6];
                    if (blk >= 0) { const int tok = blk * 64 + (t & 63); dist = pos - tok;
                        if (dist >= 0) { if (!smp) kp = KVR + (size_t)(b * SP + tok) * 768 + 256 + g * 64;
                            else if (tok < PAST) kp = p.in[I_CSLC] + ((size_t)pt[b * 16 + (tok >> 7)] * 128 + (tok & 127)) * 256 + g * 64;
                            else kp = KVR + (size_t)row * 768 + 256 + g * 64; } }
                } else {
                    const int kpos = pos - 511 + t; dist = 511 - t;
                    if (!smp) { if (kpos >= 0) kp = KVR + (size_t)(b * SP + kpos) * 768 + 512 + g * 64; else dist = -1; }
                    else { if (kpos < PAST) kp = p.in[I_CWIN] + ((size_t)b * 512 + (kpos - (PAST - 512))) * 256 + g * 64; else kp = KVR + (size_t)row * 768 + 512 + g * 64; }
                }
                if (dist >= 0 && kp) {
                    float s[6] = {0.f, 0.f, 0.f, 0.f, 0.f, 0.f};
#pragma unroll 2
                    for (int d = 0; d < 16; ++d) { const float4 kk = ((const float4*)kp)[d];
#pragma unroll
                        for (int z = 0; z < 6; ++z) s[z] += dot4(kk, ((const float4*)(qs + z * 64))[d]); }
                    const int bk = rel_bucket(dist);
#pragma unroll
                    for (int z = 0; z < 6; ++z) sc[z * 512 + t] = s[z] * 0.125f + table[bk * 12 + g * 6 + z];
                } else {
#pragma unroll
                    for (int z = 0; z < 6; ++z) sc[z * 512 + t] = NEGM;
                }
            }
            __syncthreads();
            if (wid < 6) row_softmax(sc + wid * 512, 512, lane);
            __syncthreads();
            if (tid < 384) { const int z = tid >> 6, d = tid & 63; float o = 0.f;
                for (int t = 0; t < 512; ++t) { const float pw = sc[z * 512 + t]; if (pw != 0.f) { const float* vp;
                    if (br == 1) { const int tok = sel[t >> 6] * 64 + (t & 63);
                        if (!smp) vp = KVR + (size_t)(b * SP + tok) * 768 + 256 + 128 + g * 64;
                        else if (tok < PAST) vp = p.in[I_CSLC] + ((size_t)pt[b * 16 + (tok >> 7)] * 128 + (tok & 127)) * 256 + 128 + g * 64;
                        else vp = KVR + (size_t)row * 768 + 256 + 128 + g * 64;
                    } else { const int kpos = pos - 511 + t;
                        if (!smp) vp = KVR + (size_t)(b * SP + kpos) * 768 + 512 + 128 + g * 64;
                        else if (kpos < PAST) vp = p.in[I_CWIN] + ((size_t)b * 512 + (kpos - (PAST - 512))) * 256 + 128 + g * 64;
                        else vp = KVR + (size_t)row * 768 + 512 + 128 + g * 64; }
                    o = fmaf(pw, vp[d], o); } }
                oacc[tid] += gate[br * 6 + z] * o; }
            __syncthreads();
        }
        if (tid < 384) CATB[(size_t)row * DM + g * 384 + tid] = (bf16_t)f2bf(oacc[tid]);
    }
}
constexpr size_t KVB_T = (size_t)BP * 2 * SP * 64;
typedef short v4i16_t __attribute__((ext_vector_type(4)));
typedef short bf16x8_t __attribute__((ext_vector_type(8)));
typedef float f32x4_t __attribute__((ext_vector_type(4)));
typedef unsigned u32x4_t __attribute__((ext_vector_type(4)));
__device__ __forceinline__ bf16x8_t ldtr2(const LAS unsigned char* p0, const LAS unsigned char* p1) {
    const v4i16_t a = __builtin_amdgcn_ds_read_tr16_b64_v4i16((LAS v4i16_t*)p0), b = __builtin_amdgcn_ds_read_tr16_b64_v4i16((LAS v4i16_t*)p1);
    return __builtin_shufflevector(a, b, 0, 1, 2, 3, 4, 5, 6, 7);
}
__device__ __forceinline__ unsigned cvtpk(float lo, float hi) { unsigned r; asm volatile("v_cvt_pk_bf16_f32 %0, %1, %2" : "=v"(r) : "v"(lo), "v"(hi)); return r; }
__device__ __forceinline__ bf16x8_t pack8(f32x4_t a, f32x4_t b) { uint4 w; w.x = cvtpk(a[0], a[1]); w.y = cvtpk(a[2], a[3]); w.z = cvtpk(b[0], b[1]); w.w = cvtpk(b[2], b[3]); return __builtin_bit_cast(bf16x8_t, w); }
__device__ __forceinline__ f32x4_t mfma16(bf16x8_t a, bf16x8_t b, f32x4_t c) { return __builtin_amdgcn_mfma_f32_16x16x32_bf16(a, b, c, 0, 0, 0); }
__device__ __forceinline__ float ex2(float x) { return __builtin_amdgcn_exp2f(x); }
__device__ __forceinline__ float xmax4(float x) {
    auto s = __builtin_amdgcn_permlane16_swap(__float_as_uint(x), __float_as_uint(x), false, false);
    x = fmaxf(__uint_as_float(s[0]), __uint_as_float(s[1]));
    auto t = __builtin_amdgcn_permlane32_swap(__float_as_uint(x), __float_as_uint(x), false, false);
    return fmaxf(__uint_as_float(t[0]), __uint_as_float(t[1]));
}
__device__ __forceinline__ float xsum4(float x) {
    auto s = __builtin_amdgcn_permlane16_swap(__float_as_uint(x), __float_as_uint(x), false, false);
    x = __uint_as_float(s[0]) + __uint_as_float(s[1]);
    auto t = __builtin_amdgcn_permlane32_swap(__float_as_uint(x), __float_as_uint(x), false, false);
    return __uint_as_float(t[0]) + __uint_as_float(t[1]);
}
constexpr float LOG2E = 1.4426950408889634f, NINF = -__builtin_inff();
constexpr int KROW = 144;

__device__ __forceinline__ void ph_nsa_fast(const Params& p, int j, LAS unsigned char* lds) {
    const int tid = ltid(), lane0 = tid & 63, w = tid >> 6;
    unsigned char* ws = p.ws;
    const bf16_t* P16 = (const bf16_t*)(ws + B_P16); const float* GT = (const float*)(ws + B_GT); bf16_t* CATB = (bf16_t*)(ws + B_CATB);
    const bf16_t* KVB = (const bf16_t*)(ws + B_KVB); const bf16_t* KC16 = (const bf16_t*)(ws + B_KC16);
    LAS unsigned char* Kw = lds;
    LAS unsigned char* Vw = lds + 18432;
    LAS unsigned char* Kc = lds + 36864;
    LAS unsigned char* Vc = lds + 55296;
    LAS float* biasT = (LAS float*)(lds + 73728);
    LAS float* impL = (LAS float*)(lds + 73728 + 3072);
    LAS int* selL = (LAS int*)(lds + 73728 + 3072 + 16384);
    const float* table = p.in[I_REL]; const float* gq = p.in[I_GQ] + j * 64; const float* bgate = p.in[I_BGATE] + j * 36;
    for (int unit = blockIdx.x; unit < 256; unit += gridDim.x) {
        int lane_a = lane0; asm volatile("" : "+v"(lane_a)); const int lane = lane_a, fr = lane & 15, fg = lane >> 4;
        const int g = unit & 1, b = (unit >> 1) & 7, tile = unit >> 4, t0 = tile * 128, tw = t0 + 16 * w, trow = tw + fr;
        TSUB_BEGIN();
        __syncthreads();
        for (int i = tid; i < 2048; i += NT_) { const int tsel = i >> 10, r = (i >> 3) & 127, ch = i & 7;
            const u32x4_t v = *(const u32x4_t*)(KC16 + (((size_t)b * 2 + tsel) * 2 + g) * 128 * 64 + r * 64 + ch * 8);
            *(LAS u32x4_t*)((tsel ? Vc : Kc) + r * KROW + ch * 16) = v; }
        for (int i = tid; i < 768; i += NT_) { const int d = i / 6, z = i % 6; biasT[i] = table[rel_bucket_alu(d) * 12 + g * 6 + z] * LOG2E; }
        if (tid < 64) ((LAS float*)(lds + 73728 + 3072 + 16384 + 4096))[tid] = gq[tid] * (0.125f * LOG2E);
        __syncthreads();
        const bf16_t* qrow = P16 + (size_t)(b * SP + trow) * LDB_ + g * 384;
        LAS float* gqL = (LAS float*)(lds + 73728 + 3072 + 16384 + 4096);
#define FETCH_Q(z_, ra_, rb_) do { ra_ = *(const uint4*)(qrow + (z_) * 64 + fg * 8); rb_ = *(const uint4*)(qrow + (z_) * 64 + 32 + fg * 8); } while (0)
#define LOAD_Q(z_, q0_, q1_) do { uint4 r0, r1; FETCH_Q(z_, r0, r1); FINISH_Q(r0, r1, q0_, q1_); } while (0)
#define FINISH_Q(r0, r1, q0_, q1_) do { \
            float v[16] = {bflo(r0.x), bfhi(r0.x), bflo(r0.y), bfhi(r0.y), bflo(r0.z), bfhi(r0.z), bflo(r0.w), bfhi(r0.w), bflo(r1.x), bfhi(r1.x), bflo(r1.y), bfhi(r1.y), bflo(r1.z), bfhi(r1.z), bflo(r1.w), bfhi(r1.w)}; \
            float ss = 0.f; _Pragma("unroll") for (int i = 0; i < 16; ++i) ss += v[i] * v[i]; \
            ss = xsum4(ss); const float rs = rsqrtf(ss * (1.0f / 64) + EPS); { const f32x4_t g0 = *(const LAS f32x4_t*)(gqL + fg * 8), g1 = *(const LAS f32x4_t*)(gqL + fg * 8 + 4), g2 = *(const LAS f32x4_t*)(gqL + 32 + fg * 8), g3 = *(const LAS f32x4_t*)(gqL + 32 + fg * 8 + 4); \
              _Pragma("unroll") for (int i = 0; i < 4; ++i) { v[i] *= rs * g0[i]; v[4 + i] *= rs * g1[i]; v[8 + i] *= rs * g2[i]; v[12 + i] *= rs * g3[i]; } } \
            q0_ = pack8((f32x4_t){v[0], v[1], v[2], v[3]}, (f32x4_t){v[4], v[5], v[6], v[7]}); q1_ = pack8((f32x4_t){v[8], v[9], v[10], v[11]}, (f32x4_t){v[12], v[13], v[14], v[15]}); } while (0)
        const float* gtrow = GT + (size_t)(b * SP + trow) * GTW;
#pragma unroll 1
        for (int hp = 0; hp < 2; ++hp) {
        bf16x8_t qf[3][2];
#pragma unroll
        for (int z = 0; z < 3; ++z) LOAD_Q(hp * 3 + z, qf[z][0], qf[z][1]);
        f32x4_t O[3][4]; float mrun[3], lrun[3];
#pragma unroll
        for (int z = 0; z < 3; ++z) { mrun[z] = NINF; lrun[z] = 0.f;
#pragma unroll
            for (int dt = 0; dt < 4; ++dt) O[z][dt] = (f32x4_t){0.f, 0.f, 0.f, 0.f}; }
        const bf16_t* WK = KVB + 4 * KVB_T + ((size_t)b * 2 + g) * SP * 64; const bf16_t* WV = KVB + 5 * KVB_T + ((size_t)b * 2 + g) * SP * 64;
        u32x4_t rst[4];
#define WIN_LOAD(it_) do { const int k128_ = t0 - 512 + 128 * (it_); _Pragma("unroll") for (int q_ = 0; q_ < 4; ++q_) { const int i_ = tid + NT_ * q_, tsel_ = i_ >> 10, r_ = (i_ >> 3) & 127, ch_ = i_ & 7; const int tok_ = k128_ + r_; \
            rst[q_] = (u32x4_t){0u, 0u, 0u, 0u}; if (tok_ >= 0) rst[q_] = *(const u32x4_t*)((tsel_ ? WV : WK) + (size_t)tok_ * 64 + ch_ * 8); } } while (0)
#define WIN_STORE() do { _Pragma("unroll") for (int q_ = 0; q_ < 4; ++q_) { const int i_ = tid + NT_ * q_, tsel_ = i_ >> 10, r_ = (i_ >> 3) & 127, ch_ = i_ & 7; *(LAS u32x4_t*)((tsel_ ? Vw : Kw) + r_ * KROW + ch_ * 16) = rst[q_]; } } while (0)
        WIN_LOAD(0);
        __syncthreads();
        WIN_STORE();
#pragma unroll 1
        for (int it = 0; it < 5; ++it) {
            const int k128 = t0 - 512 + 128 * it;
            BAR_LDS();
            if (it + 1 < 5) WIN_LOAD(it + 1);
#pragma unroll 1
            for (int sc = 0; sc < 4; ++sc) {
                const int kb = k128 + 32 * sc;
                if (kb > tw + 15 || kb + 31 < tw - 511 || kb + 31 < 0) continue;
                const bool fast = (kb + 31 <= tw - 113) && (kb >= tw + 15 - 511) && kb >= 0;
                bf16x8_t kf[2][2], vf[4];
#pragma unroll
                for (int nt = 0; nt < 2; ++nt)
#pragma unroll
                    for (int ks = 0; ks < 2; ++ks) kf[nt][ks] = *(const LAS bf16x8_t*)(Kw + (32 * sc + 16 * nt + fr) * KROW + (ks * 32 + fg * 8) * 2);
#pragma unroll
                for (int dt = 0; dt < 4; ++dt) { const LAS unsigned char* vp = Vw + (32 * sc + 4 * fg + (fr >> 2)) * KROW + (16 * dt + 4 * (fr & 3)) * 2; vf[dt] = ldtr2(vp, vp + 16 * KROW); }
#pragma unroll
                for (int z = 0; z < 3; ++z) {
                    f32x4_t s0 = (f32x4_t){0.f, 0.f, 0.f, 0.f}, s1 = s0;
                    s0 = mfma16(kf[0][0], qf[z][0], s0); s0 = mfma16(kf[0][1], qf[z][1], s0);
                    s1 = mfma16(kf[1][0], qf[z][0], s1); s1 = mfma16(kf[1][1], qf[z][1], s1);
                    if (fast) { const float cb = biasT[127 * 6 + hp * 3 + z]; s0 = s0 + cb; s1 = s1 + cb; }
                    else {
#pragma unroll
                        for (int jj = 0; jj < 4; ++jj) { const int key0 = kb + 4 * fg + jj, d0 = trow - key0, d1 = d0 - 16;
                            s0[jj] = (d0 >= 0 && d0 < 512 && key0 >= 0) ? s0[jj] + biasT[min(d0, 127) * 6 + hp * 3 + z] : NINF;
                            s1[jj] = (d1 >= 0 && d1 < 512 && key0 + 16 >= 0) ? s1[jj] + biasT[min(d1, 127) * 6 + hp * 3 + z] : NINF; }
                    }
                    float mx = fmaxf(fmaxf(fmaxf(s0[0], s0[1]), fmaxf(s0[2], s0[3])), fmaxf(fmaxf(s1[0], s1[1]), fmaxf(s1[2], s1[3])));
                    mx = xmax4(mx);
                    const float mnew = fmaxf(mrun[z], mx), msafe = mnew == NINF ? 0.f : mnew;
                    const float alpha = ex2(mrun[z] - msafe);
                    mrun[z] = mnew;
                    f32x4_t p0, p1;
#pragma unroll
                    for (int jj = 0; jj < 4; ++jj) { p0[jj] = ex2(s0[jj] - msafe); p1[jj] = ex2(s1[jj] - msafe); }
                    lrun[z] = lrun[z] * alpha + ((p0[0] + p0[1]) + (p0[2] + p0[3])) + ((p1[0] + p1[1]) + (p1[2] + p1[3]));
                    if (__any(alpha != 1.0f)) {
#pragma unroll
                        for (int dt = 0; dt < 4; ++dt) O[z][dt] = O[z][dt] * alpha; }
                    const bf16x8_t pf = pack8(p0, p1);
#pragma unroll
                    for (int dt = 0; dt < 4; ++dt) O[z][dt] = mfma16(vf[dt], pf, O[z][dt]);
                }
            }
            if (it + 1 < 5) { BAR_LDS(); WIN_STORE(); }
        }
#undef WIN_LOAD
#undef WIN_STORE
#pragma unroll
        for (int z = 0; z < 3; ++z) { const int hz2 = hp * 3 + z; const float lt = xsum4(lrun[z]); const float gw = sigmoidf_(gtrow[24 + g * 6 + hz2] + bgate[24 + g * 6 + hz2]); const float sc = gw / lt;
            bf16_t* orow = CATB + (size_t)(b * SP + trow) * DM + (g * 6 + hz2) * 64;
#pragma unroll
            for (int dt = 0; dt < 4; ++dt) { const f32x4_t v = O[z][dt] * sc; *(uint2*)(orow + 16 * dt + 4 * fg) = make_uint2(cvtpk(v[0], v[1]), cvtpk(v[2], v[3])); } }
        }
        asm volatile("s_waitcnt vmcnt(0)" ::: "memory");
        TSUB_END(0);
        float impacc[8];
#pragma unroll
        for (int nt = 0; nt < 8; ++nt) impacc[nt] = 0.f;
        const int nmax = trow >= 31 ? (trow - 31) >> 4 : -1;
        uint4 rqa_c, rqb_c; FETCH_Q(0, rqa_c, rqb_c);
#pragma unroll 1
        for (int z = 0; z < 6; ++z) {
            bf16_t* orow = CATB + (size_t)(b * SP + trow) * DM + (g * 6 + z) * 64; unsigned long long oldc[4];
#pragma unroll
            for (int dt = 0; dt < 4; ++dt) oldc[dt] = __hip_atomic_load((unsigned long long*)(orow + 16 * dt + 4 * fg), __ATOMIC_RELAXED, __HIP_MEMORY_SCOPE_AGENT);
            const float gcraw = gtrow[g * 6 + z];
            f32x4_t s[8]; bf16x8_t qz[2]; { const uint4 ra = rqa_c, rb = rqb_c; if (z + 1 < 6) FETCH_Q(z + 1, rqa_c, rqb_c); FINISH_Q(ra, rb, qz[0], qz[1]); }
#pragma unroll
            for (int nt = 0; nt < 8; ++nt) { s[nt] = (f32x4_t){0.f, 0.f, 0.f, 0.f};
#pragma unroll
                for (int ks = 0; ks < 2; ++ks) { const bf16x8_t kf = *(const LAS bf16x8_t*)(Kc + (16 * nt + fr) * KROW + (ks * 32 + fg * 8) * 2); s[nt] = mfma16(kf, qz[ks], s[nt]); } }
            float mx = NINF;
#pragma unroll
            for (int nt = 0; nt < 8; ++nt)
#pragma unroll
                for (int jj = 0; jj < 4; ++jj) { const int n = 16 * nt + 4 * fg + jj; const int dist = trow - 16 * n - 31;
                    const float v = (n <= nmax && n <= 126) ? s[nt][jj] + biasT[min(dist, 127) * 6 + z] : NINF; s[nt][jj] = v; mx = fmaxf(mx, v); }
            asm volatile("" ::: "memory");
            mx = xmax4(mx); const float msafe = mx == NINF ? 0.f : mx; float sum = 0.f;
#pragma unroll
            for (int nt = 0; nt < 8; ++nt)
#pragma unroll
                for (int jj = 0; jj < 4; ++jj) { const float e = ex2(s[nt][jj] - msafe); s[nt][jj] = e; sum += e; }
            sum = xsum4(sum); const float inv = sum > 0.f ? 1.0f / sum : 0.f;
            float p3prev = 0.f;
#pragma unroll
            for (int nt = 0; nt < 8; ++nt) { s[nt] = s[nt] * inv;
                const float p3 = s[nt][3]; const float up = __shfl(p3, (lane + 48) & 63);
                const float prev_tile = __shfl(p3prev, (lane + 48) & 63);
                impacc[nt] += 2.0f * (s[nt][0] + s[nt][1] + s[nt][2]) + p3 + (fg == 0 ? prev_tile : up);
                p3prev = p3; }
            f32x4_t oc[4];
#pragma unroll
            for (int dt = 0; dt < 4; ++dt) oc[dt] = (f32x4_t){0.f, 0.f, 0.f, 0.f};
#pragma unroll
            for (int c2 = 0; c2 < 4; ++c2) { const bf16x8_t pf = pack8(s[2 * c2], s[2 * c2 + 1]);
#pragma unroll
                for (int dt = 0; dt < 4; ++dt) { const LAS unsigned char* vp = Vc + (32 * c2 + 4 * fg + (fr >> 2)) * KROW + (16 * dt + 4 * (fr & 3)) * 2; oc[dt] = mfma16(ldtr2(vp, vp + 16 * KROW), pf, oc[dt]); }
                asm volatile("" ::: "memory"); }
            const float gc = sigmoidf_(gcraw + bgate[g * 6 + z]);
#pragma unroll
            for (int dt = 0; dt < 4; ++dt) { const unsigned long long o64 = oldc[dt];
                const f32x4_t v = oc[dt] * gc + (f32x4_t){bflo((unsigned)o64), bfhi((unsigned)o64), bflo((unsigned)(o64 >> 32)), bfhi((unsigned)(o64 >> 32))};
                *(uint2*)(orow + 16 * dt + 4 * fg) = make_uint2(cvtpk(v[0], v[1]), cvtpk(v[2], v[3])); }
        }
        TSUB_END(1);
#pragma unroll
        for (int nt = 0; nt < 8; ++nt) impL[(w * 16 + fr) * 32 + 4 * nt + fg] = impacc[nt];
        asm volatile("s_waitcnt lgkmcnt(0)" ::: "memory");
        if (lane < 16) {
            const int t = tw + lane, cur = t >> 6; LAS int* so = selL + (w * 16 + lane) * 8; const LAS float* im = impL + (w * 16 + lane) * 32;
            int cnt = 0;
            if (cur + 1 <= 8) { for (int jb = 0; jb <= cur; ++jb) so[cnt++] = jb; }
            else {
                so[1] = 0; so[3] = cur; so[5] = cur - 1; unsigned taken = 0u;
                for (int k = 0; k < 5; ++k) { int best = -1; float bv = -1.f;
                    for (int jb = 1; jb <= cur - 2; ++jb) { const float v = im[jb]; if (!((taken >> jb) & 1u) && v > bv) { bv = v; best = jb; } }
                    taken |= 1u << best; so[k < 3 ? 2 * k : 3 + k] = best; }
                cnt = 8; }
            for (; cnt < 8; ++cnt) so[cnt] = -1;
        }
        asm volatile("s_waitcnt vmcnt(0) lgkmcnt(0)" ::: "memory");
        const bf16_t* SKF = (const bf16_t*)(ws + B_SKF) + ((size_t)b * 2 + g) * 32 * 4096; const bf16_t* SVF = (const bf16_t*)(ws + B_SVF) + ((size_t)b * 2 + g) * 32 * 4096;
        const int c0 = 2 * tile;
        TSUB_END(2);
        __syncthreads();
        for (int i = tid; i < 4 * 1024; i += NT_) { const int slot = i >> 10, r = i & 1023; const int blk = slot == 0 ? 0 : c0 - 2 + slot;
            if (blk >= 0 && blk < 32) { const u32x4_t v = *(const u32x4_t*)((r < 512 ? SKF : SVF) + (size_t)blk * 4096 + (r & 511) * 8); *(LAS u32x4_t*)(lds + slot * 16384 + r * 16) = v; } }
        __syncthreads();
        { int lane_b = lane0; asm volatile("" : "+v"(lane_b)); const int lane = lane_b, fr = lane & 15, fg = lane >> 4;
        const int hz = fr < 6 ? fr : 5;
        uint4 rqa, rqb;
        { const bf16_t* qrow = P16 + ((size_t)b * SP + tw) * LDB_ + g * 384 + hz * 64; rqa = *(const uint4*)(qrow + fg * 8); rqb = *(const uint4*)(qrow + 32 + fg * 8); }
#pragma unroll 1
        for (int ti = 0; ti < 16; ++ti) {
            const int t = tw + ti; const size_t row = (size_t)b * SP + t;
            bf16x8_t qs[2];
            const uint4 r0 = rqa, r1 = rqb;
            if (ti + 1 < 16) { const bf16_t* qrow = P16 + (row + 1) * LDB_ + g * 384 + hz * 64; rqa = *(const uint4*)(qrow + fg * 8); rqb = *(const uint4*)(qrow + 32 + fg * 8); }
            bf16_t* orow = CATB + row * DM + (g * 6 + hz) * 64; unsigned long long oldv[4];
#pragma unroll
            for (int dt = 0; dt < 4; ++dt) oldv[dt] = __hip_atomic_load((unsigned long long*)(orow + 16 * dt + 4 * fg), __ATOMIC_RELAXED, __HIP_MEMORY_SCOPE_AGENT);
            const float graw = GT[row * GTW + 12 + g * 6 + hz];
            {
              float v[16] = {bflo(r0.x), bfhi(r0.x), bflo(r0.y), bfhi(r0.y), bflo(r0.z), bfhi(r0.z), bflo(r0.w), bfhi(r0.w), bflo(r1.x), bfhi(r1.x), bflo(r1.y), bfhi(r1.y), bflo(r1.z), bfhi(r1.z), bflo(r1.w), bfhi(r1.w)};
              float ss = 0.f;
#pragma unroll
              for (int i = 0; i < 16; ++i) ss += v[i] * v[i];
              ss = xsum4(ss); const float rs = rsqrtf(ss * (1.0f / 64) + EPS) * (0.125f * LOG2E);
#pragma unroll
              for (int i = 0; i < 8; ++i) { v[i] *= rs * gq[fg * 8 + i]; v[8 + i] *= rs * gq[32 + fg * 8 + i]; }
              qs[0] = pack8((f32x4_t){v[0], v[1], v[2], v[3]}, (f32x4_t){v[4], v[5], v[6], v[7]});
              qs[1] = pack8((f32x4_t){v[8], v[9], v[10], v[11]}, (f32x4_t){v[12], v[13], v[14], v[15]}); }
            f32x4_t os[4]; float ms = NINF, ls = 0.f;
#pragma unroll
            for (int dt = 0; dt < 4; ++dt) os[dt] = (f32x4_t){0.f, 0.f, 0.f, 0.f};
#define SLC_LOADK(KF, blk_) do { const int slot_ = (blk_) == 0 ? 0 : ((blk_) >= c0 - 1 ? (blk_) - c0 + 2 : -1); \
                if (slot_ >= 0) { const LAS unsigned char* fb_ = lds + slot_ * 16384 + lane * 16; \
                    _Pragma("unroll") for (int nt = 0; nt < 4; ++nt) _Pragma("unroll") for (int ks = 0; ks < 2; ++ks) KF[nt][ks] = *(const LAS bf16x8_t*)(fb_ + (nt * 2 + ks) * 1024); \
                } else { const bf16_t* kb_ = SKF + (size_t)(blk_) * 4096 + lane * 8; \
                    _Pragma("unroll") for (int nt = 0; nt < 4; ++nt) _Pragma("unroll") for (int ks = 0; ks < 2; ++ks) KF[nt][ks] = *(const bf16x8_t*)(kb_ + (nt * 2 + ks) * 512); } } while (0)
#define SLC_LOADV(VF, blk_) do { const int slot_ = (blk_) == 0 ? 0 : ((blk_) >= c0 - 1 ? (blk_) - c0 + 2 : -1); \
                if (slot_ >= 0) { const LAS unsigned char* fb_ = lds + slot_ * 16384 + lane * 16; \
                    _Pragma("unroll") for (int dt = 0; dt < 4; ++dt) _Pragma("unroll") for (int cs = 0; cs < 2; ++cs) VF[dt][cs] = *(const LAS bf16x8_t*)(fb_ + 8192 + (dt * 2 + cs) * 1024); \
                } else { const bf16_t* vb_ = SVF + (size_t)(blk_) * 4096 + lane * 8; \
                    _Pragma("unroll") for (int dt = 0; dt < 4; ++dt) _Pragma("unroll") for (int cs = 0; cs < 2; ++cs) VF[dt][cs] = *(const bf16x8_t*)(vb_ + (dt * 2 + cs) * 512); } } while (0)
#define SLC_COMPUTE(KF, VF, blk_, nblk_) do { const int tok0 = (blk_) * 64; f32x4_t s[4]; \
                _Pragma("unroll") for (int nt = 0; nt < 4; ++nt) { s[nt] = (f32x4_t){0.f, 0.f, 0.f, 0.f}; s[nt] = mfma16(KF[nt][0], qs[0], s[nt]); s[nt] = mfma16(KF[nt][1], qs[1], s[nt]); } \
                float mx = NINF; \
                if (tok0 + 63 <= t - 113) { const float cb = biasT[127 * 6 + hz]; \
                    _Pragma("unroll") for (int nt = 0; nt < 4; ++nt) { s[nt] = s[nt] + cb; mx = fmaxf(mx, fmaxf(fmaxf(s[nt][0], s[nt][1]), fmaxf(s[nt][2], s[nt][3]))); } } \
                else { _Pragma("unroll") for (int nt = 0; nt < 4; ++nt) _Pragma("unroll") for (int jj = 0; jj < 4; ++jj) { const int dist = t - (tok0 + 16 * nt + 4 * fg + jj); const float v = dist >= 0 ? s[nt][jj] + biasT[min(dist, 127) * 6 + hz] : NINF; s[nt][jj] = v; mx = fmaxf(mx, v); } } \
                mx = xmax4(mx); \
                const float mnew = fmaxf(ms, mx), msafe = mnew == NINF ? 0.f : mnew; const float alpha = ex2(ms - msafe); ms = mnew; \
                float sum = 0.f; \
                _Pragma("unroll") for (int nt = 0; nt < 4; ++nt) _Pragma("unroll") for (int jj = 0; jj < 4; ++jj) { const float e = ex2(s[nt][jj] - msafe); s[nt][jj] = e; sum += e; } \
                ls = ls * alpha + sum; \
                _Pragma("unroll") for (int dt = 0; dt < 4; ++dt) os[dt] = os[dt] * alpha; \
                _Pragma("unroll") for (int cs = 0; cs < 2; ++cs) { const bf16x8_t pf = pack8(s[2 * cs], s[2 * cs + 1]); \
                    _Pragma("unroll") for (int dt = 0; dt < 4; ++dt) os[dt] = mfma16(VF[dt][cs], pf, os[dt]); } \
                if ((nblk_) >= 0) SLC_LOADV(VF, nblk_); } while (0)
            const LAS int* sbl = selL + (w * 16 + ti) * 8; int nb = 0;
#pragma unroll
            for (int bi = 0; bi < 8; ++bi) nb += sbl[bi] >= 0 ? 1 : 0;
            bf16x8_t kfC[4][2], kfN[4][2], vfX[4][2];
            { const int b0 = sbl[0]; SLC_LOADK(kfN, b0); SLC_LOADV(vfX, b0); }
#pragma unroll 1
            for (int bi = 0; bi < nb; ++bi) {
                const int bA = sbl[bi], bB = bi + 1 < nb ? sbl[bi + 1] : -1;
#pragma unroll
                for (int nt = 0; nt < 4; ++nt) { kfC[nt][0] = kfN[nt][0]; kfC[nt][1] = kfN[nt][1]; }
                if (bB >= 0) SLC_LOADK(kfN, bB);
                SLC_COMPUTE(kfC, vfX, bA, bB);
            }
#undef SLC_LOADK
#undef SLC_LOADV
#undef SLC_COMPUTE
            const float lt = xsum4(ls);
            if (fr < 6) {
                const float gs = sigmoidf_(graw + bgate[12 + g * 6 + fr]); const float sc = lt > 0.f ? gs / lt : 0.f;
#pragma unroll
                for (int dt = 0; dt < 4; ++dt) { const unsigned long long o64 = oldv[dt]; const f32x4_t v = os[dt] * sc + (f32x4_t){bflo((unsigned)o64), bfhi((unsigned)o64), bflo((unsigned)(o64 >> 32)), bfhi((unsigned)(o64 >> 32))};
                    *(uint2*)(orow + 16 * dt + 4 * fg) = make_uint2(cvtpk(v[0], v[1]), cvtpk(v[2], v[3])); }
            }
        }
        }
        TSUB_END(3);
    }
}

constexpr int CW_P = 272, CW_BUF = 128 * CW_P;
template <bool SMP> __device__ __forceinline__ void compress_job(const Params& p, int bb, int c, int g, LAS unsigned char* lds) {
    const int tid = ltid(), lane = tid & 63, w = tid >> 6, fr = lane & 15, fg = lane >> 4, n = 16 * w + fr;
    unsigned char* ws = p.ws;
    const bf16_t* W1T = (const bf16_t*)(ws + B_W1T) + (size_t)c * 128 * 2048; const bf16_t* W2T = (const bf16_t*)(ws + B_W2T) + (size_t)c * 64 * 128;
    f32x4_t acc[8];
#pragma unroll
    for (int t = 0; t < 8; ++t) acc[t] = (f32x4_t){0.f, 0.f, 0.f, 0.f};
    const bf16_t* ap = (const bf16_t*)(ws + B_KVB) + (size_t)c * KVB_T + ((size_t)(SMP ? 0 : bb) * 2 + g) * SP * 64 + (size_t)n * 1024 + fg * 8;
    const float* pg0 = nullptr; const float* pg1 = nullptr; int tsplit = 0;
    if (SMP) { const int* pt = (const int*)p.in[I_PT] + (bb - 8) * 16; const int t0 = 16 * n > 2016 ? 2016 : 16 * n; const int pa = t0 >> 7, pb = (t0 + 31) >> 7;
        pg0 = p.in[I_CCMP] + (((size_t)pt[pa] * 128 + (t0 & 127)) * 4 + c * 2 + g) * 64 + fg * 8; tsplit = pb == pa ? 64 : 128 - (t0 & 127);
        pg1 = p.in[I_CCMP] + (((size_t)pt[pb] * 128) * 4 + c * 2 + g) * 64 + fg * 8 - (size_t)tsplit * 256; }
    u32x4_t rb[4]; bf16x8_t acur[4]; f32x4_t araw[SMP ? 8 : 1]; bf16x8_t anext[SMP ? 1 : 4];
#define CW_LOADB(st_) do { _Pragma("unroll") for (int i_ = 0; i_ < 4; ++i_) { const int ch_ = tid + NT_ * i_, r_ = ch_ >> 4, cc_ = ch_ & 15; rb[i_] = *(const u32x4_t*)(W1T + (size_t)r_ * 2048 + (st_) * 128 + cc_ * 8); } } while (0)
#define CW_STOREB(buf_) do { _Pragma("unroll") for (int i_ = 0; i_ < 4; ++i_) { const int ch_ = tid + NT_ * i_, r_ = ch_ >> 4, cc_ = ch_ & 15; *(LAS u32x4_t*)(lds + (buf_) * CW_BUF + r_ * CW_P + cc_ * 16) = rb[i_]; } } while (0)
#define CW_LOADA(st_) do { _Pragma("unroll") for (int u_ = 0; u_ < 4; ++u_) { const int s_ = (st_) * 4 + u_; \
        if (SMP) { const int tk_ = s_ >> 1; const float* src_ = (tk_ < tsplit ? pg0 : pg1) + (size_t)tk_ * 256 + (s_ & 1) * 32; araw[2 * u_] = *(const f32x4_t*)src_; araw[2 * u_ + 1] = *(const f32x4_t*)(src_ + 4); } \
        else anext[u_] = *(const bf16x8_t*)(ap + s_ * 32); } } while (0)
#define CW_TAKEA() do { _Pragma("unroll") for (int u_ = 0; u_ < 4; ++u_) { if (SMP) acur[u_] = pack8(araw[2 * u_], araw[2 * u_ + 1]); else acur[u_] = anext[u_]; } } while (0)
    __syncthreads();
    CW_LOADB(0); CW_LOADA(0); CW_STOREB(0); CW_TAKEA();
    BAR_LDS();
#pragma unroll 1
    for (int st = 0; st < 16; ++st) {
        if (st + 1 < 16) { CW_LOADB(st + 1); CW_LOADA(st + 1); }
        const LAS unsigned char* bb_ = lds + (st & 1) * CW_BUF + fr * CW_P + fg * 16;
#pragma unroll
        for (int u = 0; u < 4; ++u)
#pragma unroll
            for (int t = 0; t < 8; ++t) acc[t] = mfma16(*(const LAS bf16x8_t*)(bb_ + t * 16 * CW_P + u * 64), acur[u], acc[t]);
        if (st + 1 < 16) { CW_STOREB((st + 1) & 1); CW_TAKEA(); }
        BAR_LDS();
    }
#undef CW_LOADB
#undef CW_STOREB
#undef CW_LOADA
#undef CW_TAKEA
    const float* peb = (const float*)(ws + B_PEB) + c * 128;
#pragma unroll
    for (int t = 0; t < 8; ++t) { const f32x4_t pb = *(const f32x4_t*)(peb + 16 * t + 4 * fg);
#pragma unroll
        for (int j = 0; j < 4; ++j) { const float x = acc[t][j] + pb[j]; const float u2 = 1.5957691216057308f * (x + 0.044715f * x * x * x);
            const float th = 1.0f - 2.0f * __builtin_amdgcn_rcpf(1.0f + ex2(u2 * LOG2E)); acc[t][j] = 0.5f * x * (1.0f + th); } }
    f32x4_t o[4];
#pragma unroll
    for (int dt = 0; dt < 4; ++dt) o[dt] = (f32x4_t){0.f, 0.f, 0.f, 0.f};
#pragma unroll
    for (int ks = 0; ks < 4; ++ks) { const bf16x8_t gf = pack8(acc[2 * ks], acc[2 * ks + 1]);
#pragma unroll
        for (int dt = 0; dt < 4; ++dt) { const bf16_t* wp = W2T + (size_t)(16 * dt + fr) * 128 + 32 * ks + 4 * fg; const uint2 x0 = *(const uint2*)wp, x1 = *(const uint2*)(wp + 16);
            o[dt] = mfma16(__builtin_bit_cast(bf16x8_t, make_uint4(x0.x, x0.y, x1.x, x1.y)), gf, o[dt]); } }
    float ss = 0.f;
#pragma unroll
    for (int dt = 0; dt < 4; ++dt) { const f32x4_t b2 = *(const f32x4_t*)(p.in[I_CB2] + c * 64 + 16 * dt + 4 * fg); o[dt] = o[dt] + b2; ss += (o[dt][0] * o[dt][0] + o[dt][1] * o[dt][1]) + (o[dt][2] * o[dt][2] + o[dt][3] * o[dt][3]); }
    if (c == 0) { ss = xsum4(ss); const float rs = rsqrtf(ss * (1.0f / 64) + EPS);
#pragma unroll
        for (int dt = 0; dt < 4; ++dt) { const f32x4_t gk = *(const f32x4_t*)(p.in[I_GKCMP] + 16 * dt + 4 * fg); o[dt] = o[dt] * rs * gk; } }
    bf16_t* kc = (bf16_t*)(ws + B_KC16) + ((((size_t)bb * 2 + c) * 2 + g) * 128 + n) * 64;
    float* cf = (float*)(ws + (c == 0 ? B_CK : B_CV)) + ((size_t)bb * 127 + n) * 128 + g * 64;
#pragma unroll
    for (int dt = 0; dt < 4; ++dt) {
        if (n < 127) { *(f32x4_t*)(cf + 16 * dt + 4 * fg) = o[dt]; *(uint2*)(kc + 16 * dt + 4 * fg) = make_uint2(cvtpk(o[dt][0], o[dt][1]), cvtpk(o[dt][2], o[dt][3])); }
        else { unsigned z = 0u; asm volatile("" : "+v"(z)); *(uint2*)(kc + 16 * dt + 4 * fg) = make_uint2(z, z); }
    }
}
__device__ __forceinline__ void ph_compress_fast(const Params& p, LAS unsigned char* lds) {
    for (int job = blockIdx.x; job < 544; job += gridDim.x) { const int jj = job < 512 ? job + 32 : job - 512; const int bb = jj >> 2, c = (jj >> 1) & 1, g = jj & 1;
        if (bb < 8) compress_job<false>(p, bb, c, g, lds); else compress_job<true>(p, bb, c, g, lds); }
}
constexpr int ML_QP = 400, ML_VP = 80, ML_WP = 112;
__device__ __forceinline__ void ph_mlstm_fast(const Params& p, int l, LAS unsigned char* lds) {
    const int tid = ltid(), lane = tid & 63, w = tid >> 6, fr = lane & 15, fg = lane >> 4;
    unsigned char* ws = p.ws;
    const bf16_t* P16 = (const bf16_t*)(ws + B_P16); const float* GT = (const float*)(ws + B_GT); const float* bif = p.in[I_BIF] + l * 8; float* HR = (float*)(ws + B_HRAW);
    LAS unsigned char* Ql = lds;
    LAS unsigned char* Kl = lds + 25600;
    LAS unsigned char* Vl = lds + 51200;
    LAS unsigned char* Wl = lds + 56320;
    LAS unsigned char* CT = lds + 63488;
    LAS float* INTER = (LAS float*)(lds + 82688);
    LAS float* QN = (LAS float*)(lds + 91904);
    LAS float* RTa = (LAS float*)(lds + 92160);
    LAS float* WSa = RTa + 2048;
    LAS float* EIa = RTa + 4096;
    LAS float* DEC = RTa + 6144;
    LAS float* Gk = DEC + 32; LAS float* Ak = DEC + 64; LAS float* MPk = DEC + 96;
    for (int unit = blockIdx.x; unit < 192; unit += gridDim.x) {
        const int es = unit % 6, h = (unit / 6) & 3, b = unit / 24;
        const size_t row0 = (size_t)b * SP;
        __syncthreads();
        for (int i = tid; i < 48 * 100; i += NT_) ((LAS unsigned*)CT)[i] = 0u;
        for (int i = tid; i < 64 * 28; i += NT_) ((LAS unsigned*)Wl)[i] = 0u;
        float gia[4], gfa[4];
#pragma unroll
        for (int q = 0; q < 4; ++q) { const float* g_ = GT + (row0 + 64 * (w + 8 * q) + lane) * GTW; gia[q] = g_[h]; gfa[q] = g_[4 + h]; }
#pragma unroll
        for (int q = 0; q < 4; ++q) { const int k = w + 8 * q; const float gi = gia[q] + bif[h], gf = gfa[q] + bif[4 + h];
            float bc = logsigmoidf_(gf);
#pragma unroll
            for (int o = 1; o < 64; o <<= 1) { const float t = __shfl_up(bc, o); if (lane >= o) bc += t; }
            const float u = gi - bc; float pm = u;
#pragma unroll
            for (int o = 1; o < 64; o <<= 1) { const float t = __shfl_up(pm, o); if (lane >= o) pm = fmaxf(pm, t); }
            EIa[k * 64 + lane] = bc; RTa[k * 64 + lane] = pm; WSa[k * 64 + lane] = u;
            if (lane == 63) { Gk[k] = bc; Ak[k] = pm; } }
        __syncthreads();
        if (tid == 0) { float m = NEGM; for (int k = 0; k < 32; ++k) { MPk[k] = m; m = Gk[k] + fmaxf(Ak[k], m); } MPk[32] = m; }
        __syncthreads();
#pragma unroll 1
        for (int k = w; k < 32; k += 8) { const float mp = MPk[k], M63 = fmaxf(Ak[k], mp); const float bc = EIa[k * 64 + lane], pm = RTa[k * 64 + lane], u = WSa[k * 64 + lane]; const float M = fmaxf(pm, mp);
            RTa[k * 64 + lane] = expf(M63 - M); WSa[k * 64 + lane] = expf(u - M63); EIa[k * 64 + lane] = expf(-(bc + M)); if (lane == 0) DEC[k] = expf(mp - M63); }
        f32x4_t cacc[5];
#pragma unroll
        for (int i = 0; i < 5; ++i) cacc[i] = (f32x4_t){0.f, 0.f, 0.f, 0.f};
        u32x4_t rq[3], rk[3], rv;
#define ML_LOAD(c_) do { const size_t rb_ = row0 + 64 * (c_); \
            _Pragma("unroll") for (int i_ = 0; i_ < 3; ++i_) { const int ch_ = tid + NT_ * i_, r_ = ch_ / 24, cc_ = ch_ % 24; const bf16_t* src_ = P16 + (rb_ + r_) * LDA_ + h * 192 + cc_ * 8; rq[i_] = *(const u32x4_t*)src_; rk[i_] = *(const u32x4_t*)(src_ + 768); } \
            if (tid < 256) { const int r_ = tid >> 2, cc_ = tid & 3; rv = *(const u32x4_t*)(P16 + (rb_ + r_) * LDA_ + 1536 + h * 192 + es * 32 + cc_ * 8); } } while (0)
#define ML_STORE(c_) do { \
            _Pragma("unroll") for (int i_ = 0; i_ < 3; ++i_) { const int ch_ = tid + NT_ * i_, r_ = ch_ / 24, cc_ = ch_ % 24; *(LAS u32x4_t*)(Ql + r_ * ML_QP + cc_ * 16) = rq[i_]; *(LAS u32x4_t*)(Kl + r_ * ML_QP + cc_ * 16) = rk[i_]; } \
            if (tid < 256) { const int r_ = tid >> 2, cc_ = tid & 3; *(LAS u32x4_t*)(Vl + r_ * ML_VP + cc_ * 16) = rv; const float wv_ = WSa[(c_) * 64 + r_]; \
                u32x4_t y_; y_.x = cvtpk(bflo(rv.x) * wv_, bfhi(rv.x) * wv_); y_.y = cvtpk(bflo(rv.y) * wv_, bfhi(rv.y) * wv_); y_.z = cvtpk(bflo(rv.z) * wv_, bfhi(rv.z) * wv_); y_.w = cvtpk(bflo(rv.w) * wv_, bfhi(rv.w) * wv_); \
                *(LAS u32x4_t*)(Wl + r_ * ML_WP + cc_ * 16) = y_; if (cc_ == 0) *(LAS bf16_t*)(Wl + r_ * ML_WP + 64) = (bf16_t)f2bf(wv_); } } while (0)
        ML_LOAD(0);
        __syncthreads();
        ML_STORE(0);
#pragma unroll 1
        for (int c = 0; c < 32; ++c) {
            BAR_LDS();
            if (c + 1 < 32) ML_LOAD(c + 1);
            f32x4_t hin[2]; float rsum = 0.f;
            hin[0] = (f32x4_t){0.f, 0.f, 0.f, 0.f}; hin[1] = hin[0];
            if (w < 4) {
                const int tt = w;
                f32x4_t S[4];
#pragma unroll
                for (int st = 0; st < 4; ++st) { S[st] = (f32x4_t){0.f, 0.f, 0.f, 0.f};
                    if (st <= tt) {
#pragma unroll
                        for (int ks = 0; ks < 6; ++ks) { const bf16x8_t kf = *(const LAS bf16x8_t*)(Kl + (16 * st + fr) * ML_QP + (32 * ks + 8 * fg) * 2), qf = *(const LAS bf16x8_t*)(Ql + (16 * tt + fr) * ML_QP + (32 * ks + 8 * fg) * 2);
                            S[st] = mfma16(kf, qf, S[st]); }
                        const f32x4_t wv = *(const LAS f32x4_t*)(WSa + c * 64 + 16 * st + 4 * fg); S[st] = S[st] * wv;
                        if (st == tt) {
#pragma unroll
                            for (int jj = 0; jj < 4; ++jj) if (4 * fg + jj > fr) S[st][jj] = 0.f; }
                        rsum += (S[st][0] + S[st][1]) + (S[st][2] + S[st][3]);
                    } }
                rsum = xsum4(rsum);
#pragma unroll
                for (int kk = 0; kk < 2; ++kk) { if (2 * kk <= tt) { const bf16x8_t pf = pack8(S[2 * kk], S[2 * kk + 1]);
#pragma unroll
                    for (int et = 0; et < 2; ++et) { const LAS unsigned char* vp = Vl + (32 * kk + 4 * fg + (fr >> 2)) * ML_VP + (16 * et + 4 * (fr & 3)) * 2; hin[et] = mfma16(ldtr2(vp, vp + 16 * ML_VP), pf, hin[et]); } } }
            } else {
                const int tt = w - 4;
                f32x4_t I[3];
#pragma unroll
                for (int e3 = 0; e3 < 3; ++e3) { I[e3] = (f32x4_t){0.f, 0.f, 0.f, 0.f};
#pragma unroll
                    for (int ks = 0; ks < 6; ++ks) { const bf16x8_t cf = *(const LAS bf16x8_t*)(CT + (16 * e3 + fr) * ML_QP + (32 * ks + 8 * fg) * 2), qf = *(const LAS bf16x8_t*)(Ql + (16 * tt + fr) * ML_QP + (32 * ks + 8 * fg) * 2);
                        I[e3] = mfma16(cf, qf, I[e3]); } }
                *(LAS f32x4_t*)(INTER + (16 * tt + fr) * 36 + 4 * fg) = I[0]; *(LAS f32x4_t*)(INTER + (16 * tt + fr) * 36 + 16 + 4 * fg) = I[1];
                if (fg == 0) QN[16 * tt + fr] = I[2][0];
            }
            BAR_LDS();
            const float decay = DEC[c];
            if (w < 4) {
                const int t = 16 * w + fr; const float r = RTa[c * 64 + t], einv = EIa[c * 64 + t], qn = QN[t];
                const float den = r * (rsum + decay * qn); const float inv = 1.0f / fmaxf(fabsf(den), einv);
                float* hp = HR + (row0 + 64 * c + t) * 768 + h * 192 + es * 32;
#pragma unroll
                for (int et = 0; et < 2; ++et) { const f32x4_t in2 = *(const LAS f32x4_t*)(INTER + t * 36 + 16 * et + 4 * fg); const f32x4_t num = (hin[et] + in2 * decay) * r; *(f32x4_t*)(hp + 16 * et + 4 * fg) = num * inv; }
            }
#pragma unroll
            for (int i = 0; i < 5; ++i) { const int idx = w + 8 * i; if (idx < 36) { const int dtile = idx / 3, et = idx % 3; cacc[i] = cacc[i] * decay;
#pragma unroll
                for (int ks = 0; ks < 2; ++ks) { const LAS unsigned char* kp = Kl + (32 * ks + 8 * fg + (fr >> 2)) * ML_QP + (16 * dtile + 4 * (fr & 3)) * 2; const LAS unsigned char* vp = Wl + (32 * ks + 8 * fg + (fr >> 2)) * ML_WP + (16 * et + 4 * (fr & 3)) * 2;
                    cacc[i] = mfma16(ldtr2(kp, kp + 4 * ML_QP), ldtr2(vp, vp + 4 * ML_WP), cacc[i]); } } }
            BAR_LDS();
#pragma unroll
            for (int i = 0; i < 5; ++i) { const int idx = w + 8 * i; if (idx < 36) { const int dtile = idx / 3, et = idx % 3;
                typedef unsigned u32x2_t __attribute__((ext_vector_type(2))); u32x2_t wv; wv.x = cvtpk(cacc[i][0], cacc[i][1]); wv.y = cvtpk(cacc[i][2], cacc[i][3]);
                *(LAS u32x2_t*)(CT + (16 * et + fr) * ML_QP + (16 * dtile + 4 * fg) * 2) = wv; } }
            if (c + 1 < 32) ML_STORE(c + 1);
        }
#pragma unroll
        for (int i = 0; i < 5; ++i) { const int idx = w + 8 * i; if (idx < 36) { const int dtile = idx / 3, et = idx % 3;
            if (et < 2) { float* co = p.out + O_PC + ((size_t)((l * 8 + b) * 4 + h) * 192 + 16 * dtile + 4 * fg) * 192 + es * 32 + 16 * et + fr;
#pragma unroll
                for (int jj = 0; jj < 4; ++jj) co[(size_t)jj * 192] = cacc[i][jj]; }
            else if (es == 0 && fr == 0) { float* no = p.out + O_PN + (size_t)((l * 8 + b) * 4 + h) * 192 + 16 * dtile + 4 * fg;
#pragma unroll
                for (int jj = 0; jj < 4; ++jj) no[jj] = cacc[i][jj]; } } }
        if (es == 0 && tid == 0) p.out[O_PM + (l * 8 + b) * 4 + h] = MPk[32];
#undef ML_LOAD
#undef ML_STORE
    }
}
__device__ __forceinline__ void ph_mem_attn_fast(const Params& p, int l, LAS unsigned char* lds, int u0, int ucnt, int ustep) {
    const int tid = ltid(), lane0 = tid & 63, w = tid >> 6;
    const int ldp = l < 2 ? LDA_ : LDB_, qoff = l < 2 ? 3072 : 768;
    const bf16_t* P16 = (const bf16_t*)(p.ws + B_P16); bf16_t* CATB = (bf16_t*)(p.ws + B_CATB); const float* gq = p.in[I_GMEMQ] + l * 64;
    LAS unsigned char* Km = lds;
    LAS unsigned char* Vm = lds + 36864;
    const float* gmk = p.in[I_GMEMK] + l * 64;
    for (int ui = 0; ui < ucnt; ++ui) { const int unit = u0 + ui * ustep; if (unit >= 256) break;
        int lane_a = lane0; asm volatile("" : "+v"(lane_a)); const int lane = lane_a, fr = lane & 15, fg = lane >> 4;
        const int oct = unit & 7, hh = (unit >> 3) & 3, b = unit >> 5;
        const float* kv = (const float*)(p.ws + B_MEMR) + (size_t)(l * 8 + b) * 256 * 512 + hh * 64;
        __syncthreads();
        {
            f32x4_t x[16];
#pragma unroll
            for (int k = 0; k < 16; ++k) { const int i = tid + NT_ * k, tsel = i >> 12, m = (i >> 4) & 255, ch = i & 15; x[k] = *(const f32x4_t*)(kv + (size_t)m * 512 + tsel * 256 + ch * 4); }
#pragma unroll
            for (int k = 0; k < 16; ++k) { const int i = tid + NT_ * k, tsel = i >> 12, m = (i >> 4) & 255, ch = i & 15;
                if (k < 8) { float ss = (x[k][0] * x[k][0] + x[k][1] * x[k][1]) + (x[k][2] * x[k][2] + x[k][3] * x[k][3]);
                    ss += __shfl_xor(ss, 1); ss += __shfl_xor(ss, 2); ss += __shfl_xor(ss, 4); ss += __shfl_xor(ss, 8);
                    const float rs = rsqrtf(ss * (1.0f / 64) + EPS); const f32x4_t gk = *(const f32x4_t*)(gmk + ch * 4); x[k] = x[k] * rs * gk; }
                typedef unsigned u32x2_t __attribute__((ext_vector_type(2))); u32x2_t y; y.x = cvtpk(x[k][0], x[k][1]); y.y = cvtpk(x[k][2], x[k][3]);
                *(LAS u32x2_t*)((tsel ? Vm : Km) + m * KROW + ch * 8) = y; }
        }
        __syncthreads();
#pragma unroll 1
        for (int ps = 0; ps < 2; ++ps) {
            const size_t row = (size_t)b * SP + oct * 256 + ps * 128 + w * 16 + fr;
            bf16x8_t qf[2];
            { const bf16_t* qrow = P16 + row * ldp + qoff + hh * 64;
              const uint4 r0 = *(const uint4*)(qrow + fg * 8), r1 = *(const uint4*)(qrow + 32 + fg * 8);
              float v[16] = {bflo(r0.x), bfhi(r0.x), bflo(r0.y), bfhi(r0.y), bflo(r0.z), bfhi(r0.z), bflo(r0.w), bfhi(r0.w), bflo(r1.x), bfhi(r1.x), bflo(r1.y), bfhi(r1.y), bflo(r1.z), bfhi(r1.z), bflo(r1.w), bfhi(r1.w)};
              float ss = 0.f;
#pragma unroll
              for (int i = 0; i < 16; ++i) ss += v[i] * v[i];
              ss = xsum4(ss); const float rs = rsqrtf(ss * (1.0f / 64) + EPS) * (0.125f * LOG2E);
#pragma unroll
              for (int i = 0; i < 8; ++i) { v[i] *= rs * gq[fg * 8 + i]; v[8 + i] *= rs * gq[32 + fg * 8 + i]; }
              qf[0] = pack8((f32x4_t){v[0], v[1], v[2], v[3]}, (f32x4_t){v[4], v[5], v[6], v[7]});
              qf[1] = pack8((f32x4_t){v[8], v[9], v[10], v[11]}, (f32x4_t){v[12], v[13], v[14], v[15]}); }
            f32x4_t S[16]; float mx = NINF;
#pragma unroll
            for (int nt = 0; nt < 16; ++nt) { S[nt] = (f32x4_t){0.f, 0.f, 0.f, 0.f};
#pragma unroll
                for (int ks = 0; ks < 2; ++ks) { const bf16x8_t kf = *(const LAS bf16x8_t*)(Km + (16 * nt + fr) * KROW + (32 * ks + 8 * fg) * 2); S[nt] = mfma16(kf, qf[ks], S[nt]); }
                mx = fmaxf(mx, fmaxf(fmaxf(S[nt][0], S[nt][1]), fmaxf(S[nt][2], S[nt][3]))); }
            mx = xmax4(mx); float sum = 0.f;
#pragma unroll
            for (int nt = 0; nt < 16; ++nt)
#pragma unroll
                for (int jj = 0; jj < 4; ++jj) { const float e = ex2(S[nt][jj] - mx); S[nt][jj] = e; sum += e; }
            sum = xsum4(sum); const float inv = 1.0f / sum;
            f32x4_t o[4];
#pragma unroll
            for (int dt = 0; dt < 4; ++dt) o[dt] = (f32x4_t){0.f, 0.f, 0.f, 0.f};
#pragma unroll
            for (int c2 = 0; c2 < 8; ++c2) { const bf16x8_t pf = pack8(S[2 * c2], S[2 * c2 + 1]);
#pragma unroll
                for (int dt = 0; dt < 4; ++dt) { const LAS unsigned char* vp = Vm + (32 * c2 + 4 * fg + (fr >> 2)) * KROW + (16 * dt + 4 * (fr & 3)) * 2; o[dt] = mfma16(ldtr2(vp, vp + 16 * KROW), pf, o[dt]); } }
            bf16_t* orow = CATB + row * DM + 768 + hh * 64;
#pragma unroll
            for (int dt = 0; dt < 4; ++dt) { const f32x4_t v = o[dt] * inv; *(uint2*)(orow + 16 * dt + 4 * fg) = make_uint2(cvtpk(v[0], v[1]), cvtpk(v[2], v[3])); }
        }
    }
}
__device__ __forceinline__ void ph_mem_attn_sample(const Params& p, int l, LAS unsigned char* lds, int j0, int jcnt, int jstep) {
    const int tid = ltid(), lane = tid & 63, w = tid >> 6;
    const int ldp = l < 2 ? LDA_ : LDB_, qoff = l < 2 ? 3072 : 768;
    const bf16_t* P16 = (const bf16_t*)(p.ws + B_P16); bf16_t* CATB = (bf16_t*)(p.ws + B_CATB); const float* gq = p.in[I_GMEMQ] + l * 64;
    LAS float* qs = (LAS float*)(lds + w * 2048);
    LAS float* ps = qs + 64;
    __syncthreads();
    for (int ji = 0; ji < jcnt; ++ji) { const int item = (j0 + ji * jstep) * NW_ + w; if (item >= BS * 4) break;
        const int hh = item & 3, b = item >> 2; const size_t row = (size_t)MP + b;
        const float* kv = p.in[I_CMEM] + (size_t)(l * 128 + b) * 256 * 512 + hh * 64;
        { const float v = bf2f(P16[row * ldp + qoff + hh * 64 + lane]); const float ss = wave_sum(v * v); qs[lane] = v * rsqrtf(ss * (1.0f / 64) + EPS) * gq[lane] * (0.125f * LOG2E); }
        asm volatile("s_waitcnt lgkmcnt(0)" ::: "memory");
        float sc[4] = {0.f, 0.f, 0.f, 0.f};
#pragma unroll 4
        for (int d4 = 0; d4 < 16; ++d4) { const f32x4_t q4 = *(const LAS f32x4_t*)(qs + 4 * d4);
#pragma unroll
            for (int k = 0; k < 4; ++k) { const f32x4_t k4 = *(const f32x4_t*)(kv + (size_t)(lane + 64 * k) * 512 + 4 * d4); sc[k] += (q4[0] * k4[0] + q4[1] * k4[1]) + (q4[2] * k4[2] + q4[3] * k4[3]); } }
        float mx = wave_max(fmaxf(fmaxf(sc[0], sc[1]), fmaxf(sc[2], sc[3]))); float sum = 0.f;
#pragma unroll
        for (int k = 0; k < 4; ++k) { sc[k] = ex2(sc[k] - mx); sum += sc[k]; ps[lane + 64 * k] = sc[k]; }
        sum = wave_sum(sum);
        asm volatile("s_waitcnt lgkmcnt(0)" ::: "memory");
        { const int kg = lane >> 4, c4 = lane & 15; f32x4_t o4 = (f32x4_t){0.f, 0.f, 0.f, 0.f};
#pragma unroll 1
          for (int m0 = 0; m0 < 64; m0 += 16) { f32x4_t v[16];
#pragma unroll
              for (int i = 0; i < 16; ++i) v[i] = *(const f32x4_t*)(kv + (size_t)(4 * (m0 + i) + kg) * 512 + 256 + 4 * c4);
#pragma unroll
              for (int i = 0; i < 16; ++i) o4 = o4 + v[i] * ps[4 * (m0 + i) + kg]; }
#pragma unroll
          for (int jx = 0; jx < 4; ++jx) o4[jx] = xsum4(o4[jx]);
          if (kg == 0) { const float inv = 1.0f / sum; *(uint2*)(CATB + row * DM + 768 + hh * 64 + 4 * c4) = make_uint2(cvtpk(o4[0] * inv, o4[1] * inv), cvtpk(o4[2] * inv, o4[3] * inv)); } }
        asm volatile("s_waitcnt lgkmcnt(0)" ::: "memory");
    }
}
__device__ __forceinline__ void ph_nsa_sample(const Params& p, int j, LAS unsigned char* ldsb) {
    const int tid0 = ltid();
    float* lds = (float*)ldsb;
    float* qs = lds;
    float* sc = lds + 384;
    float* imp = sc + 3072;
    int* sel = (int*)(imp + 40);
    float* gate = (float*)(sel + 8);
    float* oacc = gate + 24;
    const float** kptr = (const float**)(oacc + 384);
    float* part = (float*)(kptr + 512);
    float* tbl = part + 32 * 384;
    int* pts = (int*)(tbl + 192);
    const bf16_t* P = (const bf16_t*)(p.ws + B_P16); const float* GT = (const float*)(p.ws + B_GT); const float* KVR = (const float*)(p.ws + B_KVR); bf16_t* CATB = (bf16_t*)(p.ws + B_CATB);
    const float* table = p.in[I_REL]; const int* pt = (const int*)p.in[I_PT];
    for (int item = blockIdx.x; item < BS * 2; item += gridDim.x) {
        int t_l = tid0; asm volatile("" : "+v"(t_l)); const int tid = t_l, lane = tid & 63, wid = tid >> 6;
        int pos_l = PAST; asm volatile("" : "+s"(pos_l)); const int pos = pos_l;
        const int b = item >> 1, g = item & 1, row = MP + b;
        const bf16_t* pr = P + (size_t)row * LDB_;
        __syncthreads();
        if (wid < 6) { const int z = wid; const float v = bf2f(pr[(g * 6 + z) * 64 + lane]); const float ss = wave_sum(v * v); qs[z * 64 + lane] = v * rsqrtf(ss * (1.0f / 64) + EPS) * p.in[I_GQ][j * 64 + lane]; }
        if (tid >= 384 && tid < 384 + 18) { const int t2 = tid - 384; const int br = t2 / 6, z = t2 % 6; gate[t2] = sigmoidf_(GT[(size_t)row * GTW + br * 12 + g * 6 + z] + p.in[I_BGATE][j * 36 + br * 12 + g * 6 + z]); }
        if (tid < 384) oacc[tid] = 0.f;
        if (tid >= 416 && tid < 432) pts[tid - 416] = pt[b * 16 + (tid - 416)];
        if (tid >= 192 && tid < 384) { const int i = tid - 192; tbl[i] = table[(i / 6) * 12 + g * 6 + (i % 6)]; }
        __syncthreads();
        const float* ck = (const float*)(p.ws + B_CK) + (size_t)(8 + b) * 127 * 128; const float* cv = (const float*)(p.ws + B_CV) + (size_t)(8 + b) * 127 * 128;
        for (int i = tid; i < 6 * 127; i += NT_) {
            const int z = i / 127, n = i % 127; const int dist = pos - (16 * n + 31);
            const float4* kp = (const float4*)(ck + n * 128 + g * 64); const float4* qp = (const float4*)(qs + z * 64); float a = 0.f;
#pragma unroll 8
            for (int d = 0; d < 16; ++d) a += dot4(kp[d], qp[d]);
            sc[z * 128 + n] = a * 0.125f + tbl[rel_bucket_alu(dist) * 6 + z];
        }
        __syncthreads();
        if (wid < 6) row_softmax(sc + wid * 128, 127, lane);
        __syncthreads();
        const int cur = pos >> 6;
        if (tid < 33) { const int jb = tid; float s = 0.f;
            for (int z = 0; z < 6; ++z) { const float* pz = sc + z * 128;
                if (jb < 32) { s += 2.0f * (pz[4 * jb] + pz[4 * jb + 1] + pz[4 * jb + 2]); if (4 * jb + 3 < 127) s += pz[4 * jb + 3]; }
                if (jb >= 1 && jb < 32) s += pz[4 * jb - 1]; }
            imp[jb] = s; }
        __syncthreads();
        if (tid == 0) { sel[0] = 0; sel[1] = cur; sel[2] = cur - 1; }
        if (tid >= 1 && tid <= cur - 2) { const float mine = imp[tid]; int rank = 0;
            for (int j2 = 1; j2 <= cur - 2; ++j2) { const float o = imp[j2]; rank += (o > mine || (o == mine && j2 < tid)) ? 1 : 0; }
            if (rank < 5) sel[3 + rank] = tid; }
        { const int kg = tid >> 4, c4 = tid & 15; f32x4_t v[4]; f32x4_t acc[6];
#pragma unroll
          for (int i = 0; i < 4; ++i) { const int n = kg + 32 * i; v[i] = *(const f32x4_t*)(cv + (n < 127 ? n : 126) * 128 + g * 64 + 4 * c4); }
#pragma unroll
          for (int z = 0; z < 6; ++z) { acc[z] = (f32x4_t){0.f, 0.f, 0.f, 0.f};
#pragma unroll
              for (int i = 0; i < 4; ++i) { const int n = kg + 32 * i; if (n < 127) acc[z] = acc[z] + v[i] * sc[z * 128 + n]; } }
#pragma unroll
          for (int z = 0; z < 6; ++z) *(f32x4_t*)(part + kg * 384 + z * 64 + 4 * c4) = acc[z]; }
        __syncthreads();
        if (tid < 384) { float o = 0.f;
#pragma unroll 8
            for (int kg = 0; kg < 32; ++kg) o += part[kg * 384 + tid];
            oacc[tid] += gate[0 * 6 + (tid >> 6)] * o; }
        __syncthreads();
#pragma unroll 1
        for (int br = 1; br <= 2; ++br) {
            int t_b = tid0; asm volatile("" : "+v"(t_b)); const int tid = t_b, lane = tid & 63, wid = tid >> 6;
            { const int t = tid; const float* kp = nullptr; int dist = -1;
                if (br == 1) { const int blk = sel[t >> 6];
                    if (blk >= 0) { const int tok = blk * 64 + (t & 63); dist = pos - tok;
                        if (dist >= 0) kp = tok < PAST ? p.in[I_CSLC] + ((size_t)pts[tok >> 7] * 128 + (tok & 127)) * 256 + g * 64 : KVR + (size_t)row * 768 + 256 + g * 64; }
                } else { const int kpos = pos - 511 + t; dist = 511 - t;
                    kp = kpos < PAST ? p.in[I_CWIN] + ((size_t)b * 512 + (kpos - (PAST - 512))) * 256 + g * 64 : KVR + (size_t)row * 768 + 512 + g * 64; }
                if (dist >= 0 && kp) {
                    float s[6] = {0.f, 0.f, 0.f, 0.f, 0.f, 0.f};
#pragma unroll 1
                    for (int dc = 0; dc < 2; ++dc) { f32x4_t kk[8];
#pragma unroll
                        for (int d = 0; d < 8; ++d) kk[d] = ((const f32x4_t*)kp)[8 * dc + d];
#pragma unroll
                        for (int d = 0; d < 8; ++d) {
#pragma unroll
                            for (int z = 0; z < 6; ++z) { const f32x4_t q4 = *(const f32x4_t*)(qs + z * 64 + 32 * dc + 4 * d); s[z] += (kk[d][0] * q4[0] + kk[d][1] * q4[1]) + (kk[d][2] * q4[2] + kk[d][3] * q4[3]); }
                            asm volatile("" ::: "memory"); } }
                    const int bk = rel_bucket_alu(dist);
#pragma unroll
                    for (int z = 0; z < 6; ++z) sc[z * 512 + t] = s[z] * 0.125f + tbl[bk * 6 + z];
                    kptr[t] = kp;
                } else {
#pragma unroll
                    for (int z = 0; z < 6; ++z) sc[z * 512 + t] = NEGM;
                    kptr[t] = KVR;
                }
            }
            __syncthreads();
            if (wid < 6) row_softmax(sc + wid * 512, 512, lane);
            __syncthreads();
            {
                const int kg = tid >> 4, c4 = tid & 15; f32x4_t acc[6];
#pragma unroll
                for (int z = 0; z < 6; ++z) acc[z] = (f32x4_t){0.f, 0.f, 0.f, 0.f};
#pragma unroll 1
                for (int i0 = 0; i0 < 16; i0 += 8) { f32x4_t v[8];
#pragma unroll
                    for (int i = 0; i < 8; ++i) v[i] = *(const f32x4_t*)(kptr[kg + 32 * (i0 + i)] + 128 + 4 * c4);
#pragma unroll
                    for (int i = 0; i < 8; ++i)
#pragma unroll
                        for (int z = 0; z < 6; ++z) acc[z] = acc[z] + v[i] * sc[z * 512 + kg + 32 * (i0 + i)]; }
#pragma unroll
                for (int z = 0; z < 6; ++z) *(f32x4_t*)(part + kg * 384 + z * 64 + 4 * c4) = acc[z];
            }
            __syncthreads();
            if (tid < 384) { float o = 0.f;
#pragma unroll 8
                for (int kg = 0; kg < 32; ++kg) o += part[kg * 384 + tid];
                oacc[tid] += gate[br * 6 + (tid >> 6)] * o; }
            __syncthreads();
        }
        if (tid < 384) CATB[(size_t)row * DM + g * 384 + tid] = (bf16_t)f2bf(oacc[tid]);
    }
}
__device__ __forceinline__ void ph_mlstm_sample_fast(const Params& p, int l, LAS unsigned char* ldsb) {
    const int tid = ltid(), lane = tid & 63, w = tid >> 6;
    float* lds = (float*)ldsb;
    float* qs = lds; float* ks = lds + 192; float* n1 = lds + 384; float* part = lds + 576;
    float* scal = part + 8 * 192;
    const bf16_t* P = (const bf16_t*)(p.ws + B_P16); const float* GT = (const float*)(p.ws + B_GT); const float* bif = p.in[I_BIF] + l * 8; float* HR = (float*)(p.ws + B_HRAW);
    for (int item = blockIdx.x; item < BS * 4; item += gridDim.x) {
        const int h = item & 3, b = item >> 2; const size_t row = (size_t)MP + b;
        const bf16_t* pr = P + row * LDA_; const float* gr = GT + row * GTW;
        const size_t sidx = (size_t)(l * 128 + b) * 4 + h;
        const float ig = gr[h] + bif[h], fg_ = gr[4 + h] + bif[4 + h];
        const float m0 = p.in[I_SM][sidx];
        const float logf = logsigmoidf_(fg_);
        const float m_new = fmaxf(logf + m0, ig);
        const float a = expf(logf + m0 - m_new), bb = expf(ig - m_new);
        __syncthreads();
        if (tid < 192) { const float q = bf2f(pr[h * 192 + tid]), k = bf2f(pr[768 + h * 192 + tid]); qs[tid] = q; ks[tid] = k;
            const float nn = a * p.in[I_SN][sidx * 192 + tid] + bb * k; n1[tid] = nn; p.out[O_SN + sidx * 192 + tid] = nn; }
        __syncthreads();
        if (w == 0) { float s = qs[lane] * n1[lane] + qs[lane + 64] * n1[lane + 64] + qs[lane + 128] * n1[lane + 128]; s = wave_sum(s); if (lane == 0) scal[0] = s; }
        const float* C0 = p.in[I_SC] + sidx * 192 * 192; float* C1 = p.out + O_SC + sidx * 192 * 192;
        float ve[3], num[3] = {0.f, 0.f, 0.f};
#pragma unroll
        for (int i = 0; i < 3; ++i) ve[i] = bf2f(pr[1536 + h * 192 + lane + 64 * i]) * bb;
#pragma unroll 1
        for (int d0 = 24 * w; d0 < 24 * w + 24; d0 += 12) {
            float c[12][3];
#pragma unroll
            for (int r = 0; r < 12; ++r)
#pragma unroll
                for (int i = 0; i < 3; ++i) c[r][i] = C0[(size_t)(d0 + r) * 192 + lane + 64 * i];
#pragma unroll
            for (int r = 0; r < 12; ++r) { const float kd = ks[d0 + r], qd = qs[d0 + r];
#pragma unroll
                for (int i = 0; i < 3; ++i) { const float cn = a * c[r][i] + kd * ve[i]; C1[(size_t)(d0 + r) * 192 + lane + 64 * i] = cn; num[i] = fmaf(qd, cn, num[i]); } }
        }
#pragma unroll
        for (int i = 0; i < 3; ++i) part[w * 192 + lane + 64 * i] = num[i];
        __syncthreads();
        if (tid < 192) { float s = 0.f;
#pragma unroll
            for (int ww = 0; ww < 8; ++ww) s += part[ww * 192 + tid];
            HR[row * 768 + h * 192 + tid] = s / fmaxf(fabsf(scal[0]), expf(-m_new)); }
        if (tid == 0) p.out[O_SM + sidx] = m_new;
    }
}
constexpr int RING_BYTES = 131072, MISC_OFF = RING_BYTES + 320, LDS_BYTES = 147456;
typedef float f32x4_ __attribute__((ext_vector_type(4)));

#define STRIP_JOBS(njobs) for (int job = (int)gridDim.x - 1 - (int)blockIdx.x; job < (njobs); job += (int)gridDim.x)
__device__ __forceinline__ void strips_inproj(const Params& p, int l, LAS unsigned char* lds) {
    unsigned char* ws = p.ws; const bf16_t* XB = (const bf16_t*)(ws + B_XB); bf16_t* P16 = (bf16_t*)(ws + B_P16); float* GT = (float*)(ws + B_GT);
    const float* ssq = (const float*)(ws + B_SSQ) + (size_t)(2 * l) * SSQS;
    const bool ka = l < 2; const int ldp = ka ? LDA_ : LDB_, nmain = ka ? 104 * 4 : 32 * 4;
    const bf16_t* Bt = ka ? (const bf16_t*)(ws + B_BTA) + (size_t)l * NBTA * DM : (const bf16_t*)(ws + B_BTB) + (size_t)(l - 2) * NBTB * DM;
    const int tid_ = ltid(); const int lane = tid_ & 63, wave = tid_ >> 6, fr = lane & 15, fq = lane >> 4;
    STRIP_JOBS(nmain + 516) {
        if (job < nmain) {
            const int st = job >> 2, r0 = MP + (job & 3) * 32;
            const int brow[2] = {st * 32, st * 32 + 16}; StripAcc<2> R; strip_gemm<2>(XB, DM, r0, Bt, brow, R, lds);
            if (wave < 2) { const int row = r0 + wave * 16 + fr; const float rs = rstd_of(ssq[row]);
#pragma unroll
                for (int t = 0; t < 2; ++t) { const f32x4_ v = R.a[t] * rs; *(uint2*)(P16 + (size_t)row * ldp + st * 32 + t * 16 + 4 * fq) = make_uint2(pk2(v[0], v[1]), pk2(v[2], v[3])); } }
        } else {
            const int r0 = (job - nmain) * 32, row = r0 + wave * 16 + fr;
            if (ka) { const int brow[1] = {3328}; StripAcc<1> R; strip_gemm<1>(XB, DM, r0, Bt, brow, R, lds); if (wave < 2) *(f32x4_*)(GT + (size_t)row * GTW + 4 * fq) = R.a[0] * rstd_of(ssq[row]); }
            else { const int brow[3] = {1024, 1040, 1056}; StripAcc<3> R; strip_gemm<3>(XB, DM, r0, Bt, brow, R, lds);
                if (wave < 2) { const float rs = rstd_of(ssq[row]);
#pragma unroll
                    for (int t = 0; t < 3; ++t) *(f32x4_*)(GT + (size_t)row * GTW + t * 16 + 4 * fq) = R.a[t] * rs; } }
        }
    }
}
__device__ __forceinline__ void strips_resid(const Params& p, const bf16_t* A, int K, const bf16_t* Bt, float* ssq, float* Y, LAS unsigned char* lds) {
    bf16_t* XB = (bf16_t*)(p.ws + B_XB);
    const int tid_ = ltid(); const int lane = tid_ & 63, wave = tid_ >> 6, fr = lane & 15, fq = lane >> 4;
    STRIP_JOBS(256) {
        const int st = job >> 2, r0 = MP + (job & 3) * 32;
        const int brow[1] = {st * 16}; StripAcc<1> R; strip_gemm<1>(A, K, r0, Bt, brow, R, lds);
        if (wave < 2) { const int row = r0 + wave * 16 + fr; bf16_t* bp = XB + (size_t)row * DM + st * 16 + 4 * fq; const uint2 o = *(const uint2*)bp;
            const f32x4_ x = (f32x4_){bflo(o.x), bfhi(o.x), bflo(o.y), bfhi(o.y)} + R.a[0];
            *(uint2*)bp = make_uint2(pk2(x[0], x[1]), pk2(x[2], x[3]));
            if (Y) *(f32x4_*)(Y + (size_t)row * DM + st * 16 + 4 * fq) = x;
            float ss = (x[0] * x[0] + x[1] * x[1]) + (x[2] * x[2] + x[3] * x[3]); ss += __shfl_xor(ss, 16); ss += __shfl_xor(ss, 32);
            if (fq == 0) (void)__hip_atomic_fetch_add(ssq + row, ss, __ATOMIC_RELAXED, __HIP_MEMORY_SCOPE_AGENT); }
    }
}
__device__ __forceinline__ void strips_gu(const Params& p, int l, LAS unsigned char* lds) {
    unsigned char* ws = p.ws; const bf16_t* XB = (const bf16_t*)(ws + B_XB); bf16_t* HID = (bf16_t*)(ws + B_HID);
    const float* ssq = (const float*)(ws + B_SSQ) + (size_t)(2 * l + 1) * SSQS; const bf16_t* Bt = (const bf16_t*)(ws + B_BTG) + (size_t)l * 2 * DFF * DM;
    const int tid_ = ltid(); const int lane = tid_ & 63, wave = tid_ >> 6, fr = lane & 15, fq = lane >> 4;
    STRIP_JOBS(176 * 4) {
        const int st = job >> 2, r0 = MP + (job & 3) * 32;
        const int brow[2] = {(st >> 3) * 256 + (st & 7) * 16, (st >> 3) * 256 + 128 + (st & 7) * 16}; StripAcc<2> R; strip_gemm<2>(XB, DM, r0, Bt, brow, R, lds);
        if (wave < 2) { const int row = r0 + wave * 16 + fr; const float rs = rstd_of(ssq[row]); float h[4];
#pragma unroll
            for (int j = 0; j < 4; ++j) { const float g = R.a[0][j] * rs, up = R.a[1][j] * rs; h[j] = g * pg8::fast_sigmoid(g) * up; }
            *(uint2*)(HID + (size_t)row * DFF + st * 16 + 4 * fq) = make_uint2(pk2(h[0], h[1]), pk2(h[2], h[3])); }
    }
}
__device__ __forceinline__ void strips_kv(const Params& p, LAS unsigned char* lds) {
    unsigned char* ws = p.ws; const bf16_t* XB = (const bf16_t*)(ws + B_XB); float* KVR = (float*)(ws + B_KVR);
    const float* ssq = (const float*)(ws + B_SSQ) + (size_t)4 * SSQS; const bf16_t* Bt = (const bf16_t*)(ws + B_BTK);
    const int tid_ = ltid(); const int lane = tid_ & 63, wave = tid_ >> 6, fr = lane & 15, fq = lane >> 4;
    STRIP_JOBS(48 * 4) {
        const int st = job >> 2, r0 = MP + (job & 3) * 32;
        const int brow[1] = {st * 16}; StripAcc<1> R; strip_gemm<1>(XB, DM, r0, Bt, brow, R, lds);
        if (wave < 2) { const int row = r0 + wave * 16 + fr; *(f32x4_*)(KVR + (size_t)row * 768 + st * 16 + 4 * fq) = R.a[0] * rstd_of(ssq[row]); }
    }
}

#ifndef COMPRESS_NAIVE
#define COMPRESS_NAIVE 0
#endif
#ifndef MLSTM_NAIVE
#define MLSTM_NAIVE 0
#endif
#ifndef MEMATT_NAIVE
#define MEMATT_NAIVE 0
#endif
#ifndef SAMPLE_ML_NAIVE
#define SAMPLE_ML_NAIVE 0
#endif
#ifndef SAMPLE_NSA_NAIVE
#define SAMPLE_NSA_NAIVE 0
#endif
#ifndef MK_MULTI
#define MK_MULTI 0
#endif
constexpr int PL = 9, NPH = 1 + 4 * PL;
__host__ __device__ constexpr bool phase_nonempty(int ph) {
    if (ph == 0) return true;
    const int l = (ph - 1) / PL, r = (ph - 1) % PL;
    if (r == 2) return l < 2;
    if (r == 7) return false;
    if (r >= 6) return l == 1;
    return true;
}
#ifndef TIME_MASK
#define TIME_MASK 0
#endif
__host__ __device__ constexpr int phase_group(int ph) { if (ph == 0) return 0; const int l = (ph - 1) / PL, r = (ph - 1) % PL; return r == 0 ? 1 : r == 1 ? (l < 2 ? 2 : 4) : r == 2 ? 3 : r == 3 ? 5 : r == 4 ? 6 : r == 5 ? 7 : r == 6 ? 8 : r == 7 ? 9 : 10; }
__global__ void __launch_bounds__(NT_, 2) fwd(Params p) {
    extern __shared__ __attribute__((aligned(16))) unsigned char lds_raw[];
    LAS unsigned char* lds = (LAS unsigned char*)lds_raw;
    float* ldsf = (float*)lds_raw;
    volatile LAS unsigned* MISC = (volatile LAS unsigned*)(lds + MISC_OFF);
    for (int u = threadIdx.x; u < (LDS_BYTES - RING_BYTES) / 4; u += NT_) ((LAS unsigned*)(lds + RING_BYTES))[u] = 0u;
    __syncthreads();
    unsigned char* ws = p.ws;
    XcdBarrier bar; bar.bar = (unsigned*)ws; bar.x = 0; bar.st = MISC + 8;
    const bool single = (p.ph_hi - p.ph_lo) > 1;
    if (single) bar = xcd_barrier_post((unsigned*)ws, MISC + 8);
    bf16_t* XB = (bf16_t*)(ws + B_XB); bf16_t* P16 = (bf16_t*)(ws + B_P16); bf16_t* CATB = (bf16_t*)(ws + B_CATB); bf16_t* HID = (bf16_t*)(ws + B_HID);
    float* SSQ = (float*)(ws + B_SSQ);
    const int G = gridDim.x, c = blockIdx.x;
    if (TIME_SUB && blockIdx.x == TSUB_BLK && threadIdx.x == 0) { for (int i = 0; i < 8; ++i) g_tsub[i] = 0ull; }
    int ph = 0; volatile LAS unsigned long long* TMR = (volatile LAS unsigned long long*)(lds + MISC_OFF + 64);
    if ((TIME_MASK || TIME_SUB) && blockIdx.x == 0 && threadIdx.x == 0) { TMR[0] = 0ull; TMR[1] = __builtin_amdgcn_s_memrealtime(); }
#define ON() (ph >= p.ph_lo && ph < p.ph_hi)
#define NEXT() do { const bool ne_ = phase_nonempty(ph); const int grp_ = phase_group(ph); ++ph; if (ne_ && ph > p.ph_lo && ph < p.ph_hi) xcd_barrier(bar); \
        if (TIME_MASK && blockIdx.x == 0 && threadIdx.x == 0) { const unsigned long long now_ = __builtin_amdgcn_s_memrealtime(); if ((TIME_MASK >> grp_) & 1) TMR[0] = TMR[0] + (now_ - TMR[1]); TMR[1] = now_; } } while (0)
#ifndef NO_PRO
    if (ON()) ph_prologue(p, lds);
#endif
    NEXT();
    for (int l = 0; l < 4; ++l) {
        if (ON()) {
            if (l == 0) { pg8::Gemm g{(const bf16_t*)(ws + B_MPB), (const bf16_t*)(ws + B_BTM), 2048, 2048, DM}; pg8::StaticOrder S; S.init(2048, 2048, G, c);
                pg8::EpiF32 E{(float*)(ws + B_MEMR), 512, nullptr, 512, (size_t)2048 * 512};
                pg8::gemm_phase<pg8::EpiF32, pg8::StaticOrder, true, true>(lds, g, S, E); }
            if (l < 2) { pg8::Gemm g{XB, (const bf16_t*)(ws + B_BTA) + (size_t)l * NBTA * DM, MAP, LDA_ + 256, DM}; pg8::StaticOrder S; S.init(MAP, LDA_ + 256, G, l == 0 ? (c + 192) % G : c);
                pg8::EpiBf16S E{P16, LDA_, SSQ + (size_t)(2 * l) * SSQS, 13, (float*)(ws + B_GT)};
                pg8::gemm_phase<pg8::EpiBf16S, pg8::StaticOrder, true, true>(lds, g, S, E); }
            else { pg8::Gemm g{XB, (const bf16_t*)(ws + B_BTB) + (size_t)(l - 2) * NBTB * DM, MP, LDB_, DM}; pg8::StaticOrder S; S.init(MP, LDB_, G, c);
                pg8::EpiBf16S E{P16, LDB_, SSQ + (size_t)(2 * l) * SSQS, -1, nullptr};
                pg8::gemm_phase<pg8::EpiBf16S, pg8::StaticOrder, true, true>(lds, g, S, E);
#ifndef NO_STRIPS
                strips_inproj(p, l, lds);
#endif
            }
        }
        NEXT();
#ifndef NO_NAIVE
        if (ON()) {
            if (l < 2) { if (MLSTM_NAIVE) ph_mlstm_prompt(p, l, ldsf); else ph_mlstm_fast(p, l, lds); if (G == 256) { if (c >= 192) { ph_mem_attn_fast(p, l, lds, c - 192, 4, 64); ph_mem_attn_sample(p, l, lds, c - 192, 1, 64); if (l == 1) ph_swin_copy(p, 192, 64); } }
                else { ph_mem_attn_fast(p, l, lds, c, (256 - c + G - 1) / G, G); if (c < 64) ph_mem_attn_sample(p, l, lds, c, (64 - c + G - 1) / G, G); if (l == 1) ph_swin_copy(p, 0, G); }      if (SAMPLE_ML_NAIVE) ph_mlstm_sample(p, l, ldsf); else ph_mlstm_sample_fast(p, l, lds); }
            else { if (!NSA_NAIVE_ALL) ph_nsa_fast(p, l - 2, lds); { TSUB_BEGIN(); if (SAMPLE_NSA_NAIVE) ph_nsa(p, l - 2, ldsf); else ph_nsa_sample(p, l - 2, lds); TSUB_END(4); } TSUB_BEGIN(); if (MEMATT_NAIVE) ph_mem_attn(p, l); else if (G == 256) { if (c < 16) { ph_mem_attn_fast(p, l, lds, 8 * c, 8, 1); ph_mem_attn_sample(p, l, lds, 2 * c, 2, 1); } else if (c < 32) { ph_mem_attn_fast(p, l, lds, 128 + 5 * (c - 16), 5, 1); ph_mem_attn_sample(p, l, lds, 2 * c, 2, 1); } else if (c < 48) ph_mem_attn_fast(p, l, lds, 208 + 3 * (c - 32), 3, 1); }
                else { ph_mem_attn_fast(p, l, lds, c, (256 - c + G - 1) / G, G); if (c < 64) ph_mem_attn_sample(p, l, lds, c, (64 - c + G - 1) / G, G); } TSUB_END(5); }
        }
#endif
        NEXT();
#ifndef NO_NAIVE
        if (ON()) { if (l < 2) { ph_mlstm_fin(p, l); if (l == 0) ph_memk_norm(p); } }
#endif
        NEXT();
        if (ON()) {
            const bf16_t* Bt = (const bf16_t*)(ws + B_BTO) + (size_t)l * DM * DM; float* sq = SSQ + (size_t)(2 * l + 1) * SSQS;
            pg8::Gemm g{CATB, Bt, MP, DM, DM}; pg8::StaticOrder S; S.init(MP, DM, G, c); pg8::EpiResid E{nullptr, XB, sq};
            pg8::gemm_phase<pg8::EpiResid, pg8::StaticOrder, true, true>(lds, g, S, E);
#ifndef NO_STRIPS
            strips_resid(p, CATB, DM, Bt, sq, nullptr, lds);
#endif
        }
        NEXT();
        if (ON()) {
            pg8::Gemm g{XB, (const bf16_t*)(ws + B_BTG) + (size_t)l * 2 * DFF * DM, MAP, 2 * DFF, DM}; pg8::StaticOrder S; S.init(MAP, 2 * DFF, G, c); pg8::EpiSwiglu E{HID, SSQ + (size_t)(2 * l + 1) * SSQS};
            pg8::gemm_phase<pg8::EpiSwiglu, pg8::StaticOrder, true, true>(lds, g, S, E);
        }
        NEXT();
        if (ON()) {
            const bf16_t* Bt = (const bf16_t*)(ws + B_BTD) + (size_t)l * DM * DFF; float* sq = SSQ + (size_t)(2 * l + 2) * SSQS;
            pg8::Gemm g{HID, Bt, MP, DM, DFF}; pg8::StaticOrder S; S.init(MP, DM, G, c); float* Yo = l == 3 ? p.out : nullptr; pg8::EpiResid E{Yo, XB, sq};
            pg8::gemm_phase<pg8::EpiResid, pg8::StaticOrder, true, true>(lds, g, S, E);
#ifndef NO_STRIPS
            strips_resid(p, HID, DFF, Bt, sq, Yo, lds);
#endif
        }
        NEXT();
        if (ON()) { if (l == 1) {
            pg8::Gemm g{XB, (const bf16_t*)(ws + B_BTK), MAP, 768, DM}; pg8::StaticOrder S; S.init(MAP, 768, G, c); pg8::EpiF32 E{(float*)(ws + B_KVR), 768, SSQ + (size_t)4 * SSQS, 0, 0};
            pg8::gemm_phase<pg8::EpiF32, pg8::StaticOrder, true, true>(lds, g, S, E);
            asm volatile("s_waitcnt vmcnt(0)" ::: "memory"); __syncthreads();
            if (c < 195) {
                constexpr int nM = MAP / 256, nN = 3, nwg = nM * nN, q = nwg / 8, rr = nwg % 8; const int xcd = c % 8, off = c / 8;
                const int wgid = (xcd < rr ? xcd * (q + 1) : rr * (q + 1) + (xcd - rr) * q) + off; constexpr int nig = 8 * nN; const int gid = wgid / nig, fm = gid * 8, gsz = (nM - fm) < 8 ? (nM - fm) : 8;
                rows_post_tile(p, (fm + ((wgid % nig) % gsz)) * 256, (wgid % nig) / gsz); }
            } }
        NEXT();
        NEXT();
#ifndef NO_NAIVE
        if (ON()) { if (l == 1) { if (COMPRESS_NAIVE) ph_compress(p, ldsf); else ph_compress_fast(p, lds); } }
#endif
        NEXT();
    }
    if (TIME_MASK || TIME_SUB) { if (blockIdx.x == 0 && threadIdx.x == 0) { const unsigned long long t_acc = TIME_SUB ? __hip_atomic_load(&g_tsub[TIME_SUB > 0 ? TIME_SUB - 1 : 0], __ATOMIC_RELAXED, __HIP_MEMORY_SCOPE_AGENT) : TMR[0]; const unsigned long long t0 = __builtin_amdgcn_s_memrealtime(); while (__builtin_amdgcn_s_memrealtime() - t0 < 10ull * t_acc) __builtin_amdgcn_s_sleep(8); } }
}

extern "C" void kernel_launch(void* const* d_in, const int* in_sizes, int n_in, void* d_out, int out_size, void* d_ws, size_t ws_size, hipStream_t stream) {
    static int grid = 0;
    if (!grid) {
        int dev = 0, cus = 0;
        (void)hipGetDevice(&dev); (void)hipDeviceGetAttribute(&cus, hipDeviceAttributeMultiprocessorCount, dev);
        if (cus < 1) cus = 256;
        if (hipFuncSetAttribute((const void*)fwd, hipFuncAttributeMaxDynamicSharedMemorySize, LDS_BYTES) != hipSuccess) fprintf(stderr, "kernel_launch: hipFuncSetAttribute failed\n");
        int per_cu = 0; (void)hipOccupancyMaxActiveBlocksPerMultiprocessor(&per_cu, (const void*)fwd, NT_, LDS_BYTES); (void)hipGetLastError();
        if (per_cu < 1) fprintf(stderr, "kernel_launch: occupancy query says %d\n", per_cu);
        grid = cus;
    }
    if (n_in != N_IN || (size_t)out_size != O_END || ws_size < B_END) fprintf(stderr, "kernel_launch: unexpected sizes n_in=%d out=%d ws=%zu need %zu\n", n_in, out_size, ws_size, (size_t)B_END);
    (void)hipMemsetAsync(d_ws, 0, CTL_BYTES, stream);
    Params p{};
    for (int i = 0; i < N_IN; ++i) p.in[i] = (const float*)d_in[i];
    p.out = (float*)d_out; p.ws = (unsigned char*)d_ws;
#if MK_MULTI
    for (int ph = 0; ph < NPH; ++ph) {
        if (!phase_nonempty(ph)) continue;
        p.ph_lo = ph; p.ph_hi = ph + 1;
        hipLaunchKernelGGL(fwd, dim3(grid), dim3(NT_), LDS_BYTES, stream, p);
    }
#else
    p.ph_lo = 0; p.ph_hi = NPH;
    hipLaunchKernelGGL(fwd, dim3(grid), dim3(NT_), LDS_BYTES, stream, p);
#endif
}

#ifdef REGTEST
__global__ void __launch_bounds__(NT_, 2) rt_nsa(Params p) { extern __shared__ __attribute__((aligned(16))) unsigned char l_[]; ph_nsa_fast(p, 0, (LAS unsigned char*)l_); }
__global__ void __launch_bounds__(NT_, 2) rt_mlstm(Params p) { extern __shared__ __attribute__((aligned(16))) unsigned char l_[]; ph_mlstm_fast(p, 0, (LAS unsigned char*)l_); }
__global__ void __launch_bounds__(NT_, 2) rt_nsas(Params p) { extern __shared__ __attribute__((aligned(16))) unsigned char l_[]; ph_nsa_sample(p, 0, (LAS unsigned char*)l_); }
__global__ void __launch_bounds__(NT_, 2) rt_mem(Params p) { extern __shared__ __attribute__((aligned(16))) unsigned char l_[]; ph_mem_attn_fast(p, 0, (LAS unsigned char*)l_, 0, 256, 1); }
__global__ void __launch_bounds__(NT_, 2) rt_cmp(Params p) { extern __shared__ __attribute__((aligned(16))) unsigned char l_[]; ph_compress_fast(p, (LAS unsigned char*)l_); }
#endif
```

```cpp
#include <hip/hip_runtime.h>
#include <cstdio>
#include <cstdint>

#define LAS __attribute__((address_space(3)))
#define GAS __attribute__((address_space(1)))
#define XB_TMO      128
#define XB_XCNT(j)  (256  + 64 * (j))
#define XB_XSUB(j)  (1280 + 64 * (j))
#define XB_XGEN(j)  (2304 + 64 * (j))
#define XB_TOP      3328
#define XB_TOPGEN   3392
#define XCD_BAR_WORDS 3456
#define XB_SPIN_CAP (1u << 23)
__device__ __forceinline__ unsigned xb_ld(unsigned* p)              { return __hip_atomic_load(p, __ATOMIC_RELAXED, __HIP_MEMORY_SCOPE_AGENT); }
__device__ __forceinline__ unsigned xb_add(unsigned* p, unsigned v) { return __hip_atomic_fetch_add(p, v, __ATOMIC_RELAXED, __HIP_MEMORY_SCOPE_AGENT); }
__device__ __forceinline__ unsigned xb_xcc_id() { return (unsigned)__builtin_amdgcn_s_getreg((3 << 11) | 20) & 0xFu; }
#define XB_SPIN(cond, bar) do { unsigned _sp = 0; while (cond) { __builtin_amdgcn_s_sleep(1); \
    if ((++_sp & 255u) == 0u) { if (xb_ld(&(bar)[XB_TMO])) break; if (_sp > XB_SPIN_CAP) { atomicAdd(&(bar)[XB_TMO], 1u); break; } } } } while (0)
struct XcdBarrier { unsigned* bar; unsigned x; volatile LAS unsigned* st; };
__device__ __forceinline__ XcdBarrier xcd_barrier_post(unsigned* bar, volatile LAS unsigned* st) {
    XcdBarrier b; b.bar = bar; b.x = xb_xcc_id(); b.st = st;
    if (threadIdx.x == 0) (void)xb_add(&bar[XB_XCNT(b.x)], 1u);
    return b;
}
__device__ __forceinline__ void xcd_barrier_complete(unsigned* bar, unsigned x, unsigned& nloc, unsigned& nx) {
    const unsigned G = gridDim.x * gridDim.y * gridDim.z;
    unsigned sum, cnt, mine, sp = 0u;
    for (;;) {
        sum = 0u; cnt = 0u; mine = 0u;
#pragma unroll
        for (unsigned j = 0; j < 16; ++j) { const unsigned c = xb_ld(&bar[XB_XCNT(j)]); sum += c; cnt += (c > 0u) ? 1u : 0u; mine = (j == x) ? c : mine; }
        if (sum == G) break;
        __builtin_amdgcn_s_sleep(1);
        if ((++sp & 255u) == 0u) { if (xb_ld(&bar[XB_TMO])) break; if (sp > XB_SPIN_CAP) { atomicAdd(&bar[XB_TMO], 1u); break; } }
    }
    nloc = mine > 0u ? mine : 1u; nx = cnt > 0u ? cnt : 1u;
}
__device__ __forceinline__ void xcd_barrier(const XcdBarrier& b) {
    asm volatile("s_waitcnt vmcnt(0)" ::: "memory");
    __syncthreads();
    if (threadIdx.x == 0) {
        unsigned* bar = b.bar;
        __builtin_amdgcn_s_waitcnt(0);
        unsigned nloc = b.st[0], nx = b.st[1];
        if (nloc == 0u) { xcd_barrier_complete(bar, b.x, nloc, nx); b.st[0] = nloc; b.st[1] = nx; }
        const unsigned old = xb_add(&bar[XB_XSUB(b.x)], 1u);
        const unsigned gen = old / nloc;
        if (old + 1u == (gen + 1u) * nloc) {
            __builtin_amdgcn_fence(__ATOMIC_RELEASE, "agent");
            asm volatile("s_waitcnt vmcnt(0)" ::: "memory");
            const unsigned og = xb_add(&bar[XB_TOP], 1u);
            const unsigned tg = og / nx;
            if (og + 1u == (tg + 1u) * nx) xb_add(&bar[XB_TOPGEN], 1u);
            else XB_SPIN(xb_ld(&bar[XB_TOPGEN]) == tg, bar);
            __builtin_amdgcn_fence(__ATOMIC_ACQUIRE, "agent");
            xb_add(&bar[XB_XGEN(b.x)], 1u);
            asm volatile("s_waitcnt vmcnt(0)" ::: "memory");
        } else {
            XB_SPIN(xb_ld(&bar[XB_XGEN(b.x)]) == gen, bar);
            __builtin_amdgcn_fence(__ATOMIC_ACQUIRE, "agent");
            asm volatile("s_waitcnt vmcnt(0)" ::: "memory");
        }
    }
    __syncthreads();
}

constexpr int NT_ = 512, NW_ = 8;
constexpr int DM = 1024, BP = 8, SP = 2048, MP = BP * SP, BS = 128, MA = MP + BS, MAP = MP + 256;
constexpr int ACOLS = 3336, BCOLS = 1060, DFF = 2816;
constexpr int LDA_ = 3328, LDB_ = 1024;
constexpr int NBTA = 3344, NBTB = 1072;
constexpr int PAST = 2048, GTW = 48;
constexpr float EPS = 1e-6f, NEGM = -1e30f;
typedef unsigned short bf16_t;

enum { I_XP = 0, I_XS, I_SC, I_SN, I_SM, I_CMEM, I_CCMP, I_CSLC, I_CWIN, I_PT, I_MEMP, I_GMIX, I_WINA, I_BIF, I_GHN, I_WINB, I_GQ, I_BGATE, I_REL,
       I_GKV, I_WKV, I_GKSLC, I_GKWIN, I_GKCMP, I_CPOS, I_CW1, I_CB1, I_CW2, I_CB2, I_WMEMKV, I_GMEMK, I_GMEMQ, I_WOUT, I_GFFN, I_WGU, I_WDOWN, N_IN };
constexpr size_t O_YP = 0, O_YS = O_YP + (size_t)MP * DM, O_PC = O_YS + (size_t)BS * DM, O_PN = O_PC + 2ull * 8 * 4 * 192 * 192, O_PM = O_PN + 2ull * 8 * 4 * 192,
    O_PMEM = O_PM + 64, O_PCMP = O_PMEM + 4ull * 8 * 256 * 512, O_PSLC = O_PCMP + (size_t)MP * 256, O_PWIN = O_PSLC + (size_t)MP * 256, O_SC = O_PWIN + 8ull * 512 * 256,
    O_SN = O_SC + 2ull * 128 * 4 * 192 * 192, O_SM = O_SN + 2ull * 128 * 4 * 192, O_SCMP = O_SM + 1024, O_SSLC = O_SCMP + 128 * 256, O_SWIN = O_SSLC + 128 * 256,
    O_END = O_SWIN + 128ull * 512 * 256;
static_assert(O_END == 87700544ull, "output size");
constexpr size_t CTL_BYTES = 2u << 20, B_SSQ = 65536;
constexpr size_t al256(size_t x) { return (x + 255) & ~(size_t)255; }
constexpr size_t B_XB = CTL_BYTES, B_P16 = al256(B_XB + (size_t)MAP * DM * 2), B_GT = al256(B_P16 + (size_t)MAP * LDA_ * 2), B_CATB = al256(B_GT + (size_t)MAP * GTW * 4),
    B_HID = al256(B_CATB + (size_t)MA * DM * 2), B_HRAW = al256(B_HID + (size_t)MAP * DFF * 2), B_KVR = al256(B_HRAW + (size_t)MA * 768 * 4), B_CK = al256(B_KVR + (size_t)MAP * 768 * 4),
    B_CV = al256(B_CK + 136ull * 127 * 128 * 4), B_MPB = al256(B_CV + 136ull * 127 * 128 * 4),
    B_BTA = al256(B_MPB + 2048ull * DM * 2), B_BTB = al256(B_BTA + 2ull * NBTA * DM * 2), B_BTO = al256(B_BTB + 2ull * NBTB * DM * 2), B_BTG = al256(B_BTO + 4ull * DM * DM * 2),
    B_BTD = al256(B_BTG + 4ull * 2 * DFF * DM * 2), B_BTK = al256(B_BTD + 4ull * DM * DFF * 2), B_BTM = al256(B_BTK + 768ull * DM * 2), B_KVB = al256(B_BTM + 2048ull * DM * 2), B_SKF = al256(B_KVB + 6ull * BP * 2 * SP * 64 * 2), B_SVF = al256(B_SKF + (size_t)BP * 2 * SP * 64 * 2), B_KC16 = al256(B_SVF + (size_t)BP * 2 * SP * 64 * 2),
    B_W1T = al256(B_KC16 + 136ull * 2 * 2 * 128 * 64 * 2), B_W2T = al256(B_W1T + 2ull * 128 * 2048 * 2), B_PEB = al256(B_W2T + 2ull * 64 * 128 * 2), B_MEMR = al256(B_PEB + 1024), B_CMPS = al256(B_MEMR + 4ull * 2048 * 512 * 4), B_END = al256(B_CMPS + (size_t)BS * 4 * SP * 64 * 2 + 8192);
constexpr int SSQS = MAP;
static_assert(9 * SSQS * 4 + B_SSQ <= CTL_BYTES, "ssq sites inside the control region");

#ifndef TIME_SUB
#define TIME_SUB 0
#endif
#ifndef TSUB_BLK
#define TSUB_BLK 10
#endif
__device__ unsigned long long g_tsub[8];
#define TSUB_BEGIN() unsigned long long tsub_t0_ = (TIME_SUB && blockIdx.x == TSUB_BLK && threadIdx.x == 0) ? __builtin_amdgcn_s_memrealtime() : 0ull
#define TSUB_END(k) do { if (TIME_SUB && blockIdx.x == TSUB_BLK && threadIdx.x == 0) { const unsigned long long n_ = __builtin_amdgcn_s_memrealtime(); g_tsub[k] += n_ - tsub_t0_; tsub_t0_ = n_; } } while (0)
struct Params { const float* in[N_IN]; float* out; unsigned char* ws; int ph_lo, ph_hi; };

__device__ const unsigned char REL_LUT[128] = {0, 1, 2, 3, 4, 5, 6, 7, 8, 9, 10, 11, 12, 13, 14, 15, 16, 16, 16, 17, 17, 18, 18, 18, 19, 19, 19, 20, 20, 20, 20, 21, 21, 21, 21, 22, 22, 22, 22, 22, 23, 23, 23, 23, 23, 23, 24, 24, 24, 24, 24, 24, 25, 25, 25, 25, 25, 25, 25, 26, 26, 26, 26, 26, 26, 26, 26, 27, 27, 27, 27, 27, 27, 27, 27, 27, 27, 28, 28, 28, 28, 28, 28, 28, 28, 28, 28, 29, 29, 29, 29, 29, 29, 29, 29, 29, 29, 29, 29, 30, 30, 30, 30, 30, 30, 30, 30, 30, 30, 30, 30, 30, 30, 31, 31, 31, 31, 31, 31, 31, 31, 31, 31, 31, 31, 31, 31, 31};
__device__ __forceinline__ int rel_bucket(int d) { return d >= 128 ? 31 : (int)REL_LUT[d < 0 ? 0 : d]; }
__device__ __forceinline__ int rel_bucket_alu(int d) { d = d < 0 ? 0 : d; if (d < 16) return d;
    return 16 + (d >= 19) + (d >= 21) + (d >= 24) + (d >= 27) + (d >= 31) + (d >= 35) + (d >= 40) + (d >= 46) + (d >= 52) + (d >= 59) + (d >= 67) + (d >= 77) + (d >= 87) + (d >= 99) + (d >= 113); }

__device__ __forceinline__ int opq(int i) { asm volatile("" : "+s"(i)); return i; }
#define BAR_LDS() do { asm volatile("s_waitcnt lgkmcnt(0)" ::: "memory"); __builtin_amdgcn_s_barrier(); asm volatile("" ::: "memory"); } while (0)
__device__ __forceinline__ int ltid() { int t = threadIdx.x; asm volatile("" : "+v"(t)); return t; }
__device__ __forceinline__ float wave_sum(float v) {
#pragma unroll
    for (int o = 32; o; o >>= 1) v += __shfl_xor(v, o);
    return v;
}
__device__ __forceinline__ float wave_max(float v) {
#pragma unroll
    for (int o = 32; o; o >>= 1) v = fmaxf(v, __shfl_xor(v, o));
    return v;
}
__device__ __forceinline__ float sigmoidf_(float x) { return 1.0f / (1.0f + expf(-x)); }
__device__ __forceinline__ float logsigmoidf_(float x) { return fminf(x, 0.f) - log1pf(expf(-fabsf(x))); }
__device__ __forceinline__ float dot4(float4 a, float4 b) { return a.x * b.x + a.y * b.y + a.z * b.z + a.w * b.w; }
__device__ __forceinline__ float bf2f(bf16_t u) { return __uint_as_float((unsigned)u << 16); }
__device__ __forceinline__ unsigned f2bf(float f) { unsigned u = __float_as_uint(f); return (u + 0x7fffu + ((u >> 16) & 1u)) >> 16; }
__device__ __forceinline__ unsigned pk2(float lo, float hi) { return f2bf(lo) | (f2bf(hi) << 16); }
__device__ __forceinline__ float bflo(unsigned w) { return __uint_as_float(w << 16); }
__device__ __forceinline__ float bfhi(unsigned w) { return __uint_as_float(w & 0xffff0000u); }
__device__ __forceinline__ float rstd_of(float ssq) { return rsqrtf(ssq * (1.0f / DM) + EPS); }

namespace pg8 {
#define PG8_LAS __attribute__((address_space(3)))
typedef unsigned short bf16_t;
typedef short bf16x8 __attribute__((ext_vector_type(8)));
typedef float f32x4 __attribute__((ext_vector_type(4)));
typedef unsigned u32x4 __attribute__((ext_vector_type(4)));
constexpr int BM = 256, BK = 64, HALF = 128, HTB = HALF * BK * 2  , STAGE_BYTES = 8 * HTB, NXCD = 8, WGM = 8;

__host__ __device__ __forceinline__ int lds_byte(int r, int c) { const int st = (r >> 4) * 2 + (c >> 5), rr = r & 15, cc = c & 31, ob = rr * 64 + cc * 2; return st * 1024 + (ob ^ (((ob >> 9) & 1) << 5)); }
__host__ __device__ __forceinline__ void stage_rc(int b, int& R, int& C) { const int st = b / 1024, sb = b % 1024, swz = sb ^ (((sb >> 9) & 1) << 5); R = (st >> 1) * 16 + swz / 64; C = (st & 1) * 32 + (swz % 64) / 2; }
__host__ __device__ __forceinline__ int perm32(int rho) { const int n = rho >> 4, i = rho & 15; return 8 * (i >> 2) + 4 * n + (i & 3); }

struct Unit { int pm, pn; };
struct Gemm { const bf16_t* A; const bf16_t* Bt; int M, N, K; };

struct StaticOrder {
    int nM, nN, nwg, G, c;
    __host__ __device__ void init(int M, int N, int G_, int c_) { nM = M / BM; nN = N / BM; nwg = nM * nN; G = G_; c = c_; }
    __host__ __device__ bool next(int i, Unit& u) const {
        const long L = (long)i * G + c; if (L >= nwg) return false;
        int wgid = (int)L; { const int q = nwg / NXCD, r = nwg % NXCD, xcd = wgid % NXCD, off = wgid / NXCD; wgid = (xcd < r ? xcd * (q + 1) : r * (q + 1) + (xcd - r) * q) + off; }
        const int nig = WGM * nN, gid = wgid / nig, fm = gid * WGM, gsz = (nM - fm) < WGM ? (nM - fm) : WGM;
        u.pm = fm + ((wgid % nig) % gsz); u.pn = (wgid % nig) / gsz; return true;
    }
    __device__ __forceinline__ void a_ready(const Unit&) const {}
    __device__ __forceinline__ void done(const Unit&) const {}
};

__device__ __forceinline__ unsigned cvt_pk_bf16(float lo, float hi) { unsigned r; asm volatile("v_cvt_pk_bf16_f32 %0, %1, %2" : "=v"(r) : "v"(lo), "v"(hi)); return r; }
typedef float f32x2 __attribute__((ext_vector_type(2)));
__device__ __forceinline__ float fast_sigmoid(float x) { return __builtin_amdgcn_rcpf(1.0f + __builtin_amdgcn_exp2f(-1.4426950408889634f * x)); }
struct EpiF32 {
    static constexpr bool PERM = false, AFTER_DRAIN = false;
    float* O; int ldc; const float* ssq; int split_cols; size_t split_stride;
    __device__ __forceinline__ void operator()(const f32x4 (&acc)[2][2][4][2], const Unit& u, int wr, int wc, int fr, int fq) const {
        int colt = u.pn * BM; float* base = O; if (split_cols) { const int t = colt / split_cols; base += (size_t)t * split_stride; colt -= t * split_cols; }
        const int row0 = u.pm * BM + wr * 64 + fr, col0 = colt + wc * 32 + 4 * fq;
#pragma unroll
        for (int ai = 0; ai < 2; ++ai)
#pragma unroll
            for (int m = 0; m < 4; ++m) { const int r = row0 + ai * HALF + m * 16; const float rs = ssq ? rstd_of(ssq[r]) : 1.0f; float* rowp = base + (size_t)r * ldc + col0;
#pragma unroll
                for (int bj = 0; bj < 2; ++bj)
#pragma unroll
                    for (int n = 0; n < 2; ++n) *(f32x4*)(rowp + bj * HALF + n * 16) = acc[ai][bj][m][n] * rs; }
    }
};
struct EpiBf16S {
    static constexpr bool PERM = true, AFTER_DRAIN = false;
    bf16_t* O; int ldc; const float* ssq; int gate_pn; float* GT;
    __device__ __forceinline__ void operator()(const f32x4 (&acc)[2][2][4][2], const Unit& u, int wr, int wc, int fr, int fq) const {
        const int row0 = u.pm * BM + wr * 64 + fr, col0 = u.pn * BM + wc * 32 + 8 * fq;
        if (u.pn == gate_pn) {
            if (wc == 0 && fq == 0) {
#pragma unroll
                for (int ai = 0; ai < 2; ++ai)
#pragma unroll
                    for (int m = 0; m < 4; ++m) { const int r = row0 + ai * HALF + m * 16; const float rs = rstd_of(ssq[r]);
                        *(f32x4*)(GT + (size_t)r * 48) = acc[ai][0][m][0] * rs; *(f32x4*)(GT + (size_t)r * 48 + 4) = acc[ai][0][m][1] * rs; } }
            return; }
#pragma unroll
        for (int ai = 0; ai < 2; ++ai)
#pragma unroll
            for (int m = 0; m < 4; ++m) { const int r = row0 + ai * HALF + m * 16; const float rs = rstd_of(ssq[r]); bf16_t* rowp = O + (size_t)r * ldc + col0;
#pragma unroll
                for (int bj = 0; bj < 2; ++bj) { const f32x4 v0 = acc[ai][bj][m][0] * rs, v1 = acc[ai][bj][m][1] * rs;
                    u32x4 w; w.x = cvt_pk_bf16(v0[0], v0[1]); w.y = cvt_pk_bf16(v0[2], v0[3]); w.z = cvt_pk_bf16(v1[0], v1[1]); w.w = cvt_pk_bf16(v1[2], v1[3]);
                    *(u32x4*)(rowp + bj * HALF) = w; } }
    }
};
struct EpiSwiglu {
    static constexpr bool PERM = true, AFTER_DRAIN = false;
    bf16_t* O; const float* ssq;
    __device__ __forceinline__ void operator()(const f32x4 (&acc)[2][2][4][2], const Unit& u, int wr, int wc, int fr, int fq) const {
        const int row0 = u.pm * BM + wr * 64 + fr, col0 = u.pn * HALF + wc * 32 + 8 * fq;
#pragma unroll
        for (int ai = 0; ai < 2; ++ai)
#pragma unroll
            for (int m = 0; m < 4; ++m) { const int r = row0 + ai * HALF + m * 16; const float rs = rstd_of(ssq[r]); float h[8];
#pragma unroll
                for (int n = 0; n < 2; ++n)
#pragma unroll
                    for (int j = 0; j < 4; ++j) { const float g = acc[ai][0][m][n][j] * rs, up = acc[ai][1][m][n][j] * rs; h[4 * n + j] = g * fast_sigmoid(g) * up; }
                u32x4 w; w.x = cvt_pk_bf16(h[0], h[1]); w.y = cvt_pk_bf16(h[2], h[3]); w.z = cvt_pk_bf16(h[4], h[5]); w.w = cvt_pk_bf16(h[6], h[7]);
                *(u32x4*)(O + (size_t)r * 2816 + col0) = w; }
    }
};
struct EpiResid {
    static constexpr bool PERM = false, AFTER_DRAIN = false;
    float* Y; bf16_t* XB; float* ssq;
    __device__ __forceinline__ void operator()(const f32x4 (&acc)[2][2][4][2], const Unit& u, int wr, int wc, int fr, int fq) const {
        const int row0 = u.pm * BM + wr * 64 + fr, col0 = u.pn * BM + wc * 32 + 4 * fq;
        typedef unsigned u32x2 __attribute__((ext_vector_type(2)));
#pragma unroll
        for (int ai = 0; ai < 2; ++ai)
#pragma unroll
            for (int m = 0; m < 4; ++m) { const int r = row0 + ai * HALF + m * 16; bf16_t* bp = XB + (size_t)r * 1024 + col0; float ss = 0.f; u32x2 old[2][2];
#pragma unroll
                for (int bj = 0; bj < 2; ++bj)
#pragma unroll
                    for (int n = 0; n < 2; ++n) old[bj][n] = *(const u32x2*)(bp + bj * HALF + n * 16);
#pragma unroll
                for (int bj = 0; bj < 2; ++bj)
#pragma unroll
                    for (int n = 0; n < 2; ++n) { const u32x2 o = old[bj][n]; f32x4 x = (f32x4){bflo(o.x), bfhi(o.x), bflo(o.y), bfhi(o.y)} + acc[ai][bj][m][n];
                        u32x2 w; w.x = cvt_pk_bf16(x[0], x[1]); w.y = cvt_pk_bf16(x[2], x[3]); *(u32x2*)(bp + bj * HALF + n * 16) = w;
                        if (Y) *(f32x4*)(Y + (size_t)r * 1024 + col0 + bj * HALF + n * 16) = x;
                        ss += (x[0] * x[0] + x[1] * x[1]) + (x[2] * x[2] + x[3] * x[3]); }
                ss += __shfl_xor(ss, 16); ss += __shfl_xor(ss, 32);
                if (fq == 0) (void)__hip_atomic_fetch_add(ssq + r, ss, __ATOMIC_RELAXED, __HIP_MEMORY_SCOPE_AGENT); }
    }
};
template <class Epi, class Sched, bool ALIGN_EPI = false, bool SP2 = false>
__device__ __forceinline__ void gemm_phase(PG8_LAS unsigned char* lds, const Gemm g, const Sched& S, const Epi& E) {
    int tid_l = threadIdx.x; asm volatile("" : "+v"(tid_l));
    const int tid = tid_l, wid = __builtin_amdgcn_readfirstlane(tid >> 6), lane = tid & 63, wr = wid >> 2, wc = wid & 3, fr = lane & 15, fq = lane >> 4;
    const int K = g.K, nt = K / BK;
    unsigned voffA[2], voffB[2];
#pragma unroll
    for (int i = 0; i < 2; ++i) { int R, C; stage_rc(tid * 16 + i * 8192, R, C); const int Rb = Epi::PERM ? ((R & ~31) + perm32(R & 31)) : R;
        voffA[i] = (unsigned)(R * K + C) * 2u; voffB[i] = (unsigned)(Rb * K + C) * 2u; }
    const size_t kstep = (size_t)(BK * 2);
    const size_t hstep = (size_t)HALF * K * 2;
    const size_t tstep = 2 * hstep;
    const unsigned ldsw = (unsigned)wid * 1024u;
    const int aoff = lds_byte(wr * 64 + fr, fq * 8), boff = lds_byte(wc * 32 + fr, fq * 8);
#define PG8_SA(b, h) (((b) * 2 + (h)) * HTB)
#define PG8_SB(b, h) ((4 + (b) * 2 + (h)) * HTB)
#define PG8_STAGE(bufoff, gbase, voff) do { _Pragma("unroll") for (int _i = 0; _i < 2; ++_i) \
        __builtin_amdgcn_global_load_lds((const unsigned*)((const char*)(gbase) + (voff)[_i]), (PG8_LAS unsigned*)(lds + (bufoff) + ldsw + _i * 8192), 16, 0, 0); } while (0)
#define PG8_LDA(dst, b, h) do { _Pragma("unroll") for (int m = 0; m < 4; ++m) _Pragma("unroll") for (int k = 0; k < 2; ++k) dst[m][k] = *(const PG8_LAS bf16x8*)(lds + PG8_SA(b, h) + aoff + m * 2048 + k * 1024); } while (0)
#define PG8_LDB(dst, b, h) do { _Pragma("unroll") for (int n = 0; n < 2; ++n) _Pragma("unroll") for (int k = 0; k < 2; ++k) dst[n][k] = *(const PG8_LAS bf16x8*)(lds + PG8_SB(b, h) + boff + n * 2048 + k * 1024); } while (0)
#define PG8_MMA(ai, bj, At, Bt) do { __builtin_amdgcn_s_setprio(1); _Pragma("unroll") for (int m = 0; m < 4; ++m) _Pragma("unroll") for (int n = 0; n < 2; ++n) _Pragma("unroll") for (int k = 0; k < 2; ++k) \
        acc[ai][bj][m][n] = __builtin_amdgcn_mfma_f32_16x16x32_bf16(Bt[n][k], At[m][k], acc[ai][bj][m][n], 0, 0, 0); __builtin_amdgcn_s_setprio(0); } while (0)
#define PG8_WAIT_V(n) asm volatile("s_waitcnt vmcnt(" #n ")" ::: "memory")
#define PG8_WAIT_L(n) asm volatile("s_waitcnt lgkmcnt(" #n ")" ::: "memory")
#define PG8_BAR __builtin_amdgcn_s_barrier()
#define PG8_SCHED __builtin_amdgcn_sched_barrier(0)
    Unit cur, nxt; int ui = 0;
    if (!S.next(0, cur)) return;
    f32x4 acc[2][2][4][2];
#pragma unroll
    for (int a = 0; a < 2; ++a)
#pragma unroll
        for (int b = 0; b < 2; ++b)
#pragma unroll
            for (int m = 0; m < 4; ++m)
#pragma unroll
                for (int n = 0; n < 2; ++n) acc[a][b][m][n] = (f32x4){0.f, 0.f, 0.f, 0.f};
    bf16x8 At[4][2], B0[2][2], B1[2][2];
    const char* cA = (const char*)g.A + (size_t)cur.pm * tstep; const char* cB = (const char*)g.Bt + (size_t)cur.pn * tstep;
    S.a_ready(cur);
    if constexpr (SP2) {
        PG8_STAGE(PG8_SB(0, 0), cB, voffB); PG8_STAGE(PG8_SB(0, 1), cB + hstep, voffB); PG8_STAGE(PG8_SA(0, 0), cA, voffA); PG8_STAGE(PG8_SA(0, 1), cA + hstep, voffA);
        if (wr == 1) PG8_BAR;
        PG8_WAIT_V(2); PG8_BAR;
        PG8_STAGE(PG8_SB(1, 0), cB + kstep, voffB); PG8_STAGE(PG8_SA(1, 0), cA + kstep, voffA); PG8_STAGE(PG8_SB(1, 1), cB + hstep + kstep, voffB);
        PG8_WAIT_V(6); PG8_BAR;
    } else {
        PG8_STAGE(PG8_SB(0, 0), cB, voffB); PG8_STAGE(PG8_SA(0, 0), cA, voffA); PG8_STAGE(PG8_SB(0, 1), cB + hstep, voffB); PG8_STAGE(PG8_SA(0, 1), cA + hstep, voffA);
        if (wr == 1) PG8_BAR;
        PG8_WAIT_V(4); PG8_BAR;
        PG8_STAGE(PG8_SB(1, 0), cB + kstep, voffB); PG8_STAGE(PG8_SA(1, 0), cA + kstep, voffA); PG8_STAGE(PG8_SB(1, 1), cB + hstep + kstep, voffB);
        PG8_WAIT_V(6); PG8_BAR;
    }
    for (;;) {
        const bool has_next = S.next(ui + 1, nxt);
        const char* nA = has_next ? (const char*)g.A + (size_t)nxt.pm * tstep : cA; const char* nB = has_next ? (const char*)g.Bt + (size_t)nxt.pn * tstep : cB;
        for (int t = 0; t < nt; t += 2) {
            const bool last = (t == nt - 2);
            const char* a1 = cA + (size_t)(t + 1) * kstep;
            const char* a2 = last ? nA : cA + (size_t)(t + 2) * kstep; const char* b2 = last ? nB : cB + (size_t)(t + 2) * kstep;
            const char* a3 = a2 + kstep; const char* b3 = b2 + kstep;
            if (last && has_next) S.a_ready(nxt);
            if constexpr (SP2) {
            PG8_LDB(B0, 0, 0); PG8_LDB(B1, 0, 1); PG8_SCHED; PG8_LDA(At, 0, 0); PG8_STAGE(PG8_SA(1, 1), a1 + hstep, voffA);
            PG8_WAIT_V(8); PG8_WAIT_L(0); PG8_BAR; PG8_MMA(0, 0, At, B0); PG8_MMA(0, 1, At, B1); PG8_BAR; PG8_SCHED;
            PG8_LDA(At, 0, 1); PG8_STAGE(PG8_SB(0, 0), b2, voffB); PG8_STAGE(PG8_SB(0, 1), b2 + hstep, voffB); PG8_STAGE(PG8_SA(0, 0), a2, voffA);
            PG8_WAIT_V(8); PG8_WAIT_L(0); PG8_BAR; PG8_MMA(1, 0, At, B0); PG8_MMA(1, 1, At, B1); PG8_BAR; PG8_SCHED;
            PG8_LDB(B0, 1, 0); PG8_LDB(B1, 1, 1); PG8_SCHED; PG8_LDA(At, 1, 0); PG8_STAGE(PG8_SA(0, 1), a2 + hstep, voffA);
            PG8_WAIT_V(8); PG8_WAIT_L(0); PG8_BAR; PG8_MMA(0, 0, At, B0); PG8_MMA(0, 1, At, B1); PG8_BAR; PG8_SCHED;
            PG8_LDA(At, 1, 1); PG8_STAGE(PG8_SB(1, 0), b3, voffB); PG8_STAGE(PG8_SB(1, 1), b3 + hstep, voffB); PG8_STAGE(PG8_SA(1, 0), a3, voffA);
            PG8_WAIT_V(8); PG8_WAIT_L(0); PG8_BAR; PG8_MMA(1, 0, At, B0); PG8_MMA(1, 1, At, B1); PG8_BAR; PG8_SCHED;
            } else {
            PG8_LDB(B0, 0, 0); PG8_SCHED; PG8_LDA(At, 0, 0); PG8_STAGE(PG8_SA(1, 1), a1 + hstep, voffA);
            PG8_WAIT_L(8); PG8_BAR; PG8_WAIT_L(0); PG8_MMA(0, 0, At, B0); PG8_BAR; PG8_SCHED;
            PG8_LDB(B1, 0, 1); PG8_STAGE(PG8_SB(0, 0), b2, voffB);
            PG8_BAR; PG8_WAIT_L(0); PG8_MMA(0, 1, At, B1); PG8_BAR;
            PG8_LDA(At, 0, 1); PG8_STAGE(PG8_SA(0, 0), a2, voffA);
            PG8_BAR; PG8_WAIT_L(0); PG8_MMA(1, 0, At, B0); PG8_BAR; PG8_SCHED;
            PG8_STAGE(PG8_SB(0, 1), b2 + hstep, voffB);
            PG8_WAIT_V(6); PG8_BAR; PG8_MMA(1, 1, At, B1); PG8_BAR;
            PG8_LDB(B0, 1, 0); PG8_SCHED; PG8_LDA(At, 1, 0); PG8_STAGE(PG8_SA(0, 1), a2 + hstep, voffA);
            PG8_WAIT_L(8); PG8_BAR; PG8_WAIT_L(0); PG8_MMA(0, 0, At, B0); PG8_BAR; PG8_SCHED;
            PG8_LDB(B1, 1, 1); PG8_STAGE(PG8_SB(1, 0), b3, voffB);
            PG8_BAR; PG8_WAIT_L(0); PG8_MMA(0, 1, At, B1); PG8_BAR;
            PG8_LDA(At, 1, 1); PG8_STAGE(PG8_SA(1, 0), a3, voffA);
            PG8_BAR; PG8_WAIT_L(0); PG8_MMA(1, 0, At, B0); PG8_BAR; PG8_SCHED;
            PG8_STAGE(PG8_SB(1, 1), b3 + hstep, voffB);
            PG8_WAIT_V(6); PG8_BAR; PG8_MMA(1, 1, At, B1); PG8_BAR;
            }
        }
        if constexpr (ALIGN_EPI) { if (wr == 0) PG8_BAR; }
        if constexpr (!Epi::AFTER_DRAIN) { E(acc, cur, wr, wc, fr, fq); S.done(cur); }
        if (!has_next) break;
#pragma unroll
        for (int a = 0; a < 2; ++a)
#pragma unroll
            for (int b = 0; b < 2; ++b)
#pragma unroll
                for (int m = 0; m < 4; ++m)
#pragma unroll
                    for (int n = 0; n < 2; ++n) acc[a][b][m][n] = (f32x4){0.f, 0.f, 0.f, 0.f};
        cur = nxt; cA = nA; cB = nB; ++ui;
        if constexpr (ALIGN_EPI) { if (wr == 1) PG8_BAR; }
    }
    PG8_WAIT_V(0);
    if constexpr (!ALIGN_EPI) { if (wr == 0) PG8_BAR; }
    PG8_BAR;
    if constexpr (Epi::AFTER_DRAIN) { E.fused(acc, cur, wr, wc, fr, fq, lds, wid, lane); S.done(cur); }
#undef PG8_SA
#undef PG8_SB
#undef PG8_STAGE
#undef PG8_LDA
#undef PG8_LDB
#undef PG8_MMA
#undef PG8_WAIT_V
#undef PG8_WAIT_L
#undef PG8_BAR
#undef PG8_SCHED
}
}
typedef short s_bf16x8 __attribute__((ext_vector_type(8)));
typedef float s_f32x4 __attribute__((ext_vector_type(4)));
template <int NT> struct StripAcc { s_f32x4 a[NT]; };
template <int NT> __device__ __forceinline__ void strip_gemm(const bf16_t* A, int K, int row0, const bf16_t* Bt, const int* brow  , StripAcc<NT>& R, LAS unsigned char* lds) {
    const int tid_ = ltid(), lane = tid_ & 63, wave = tid_ >> 6, fr = lane & 15, fq = lane >> 4, rt = wave & 1, kq = wave >> 1;
    LAS float* red = (LAS float*)lds;
    const int kw = K >> 2;
    const bf16_t* ap = A + (size_t)(row0 + 16 * rt + fr) * K + kq * kw + fq * 8;
    const bf16_t* bp[NT];
#pragma unroll
    for (int t = 0; t < NT; ++t) { bp[t] = Bt + (size_t)(brow[t] + fr) * K + kq * kw + fq * 8; R.a[t] = (s_f32x4){0.f, 0.f, 0.f, 0.f}; }
    int k0 = 0;
#pragma unroll 1
    for (; k0 + 256 <= kw; k0 += 256) {
        s_bf16x8 a[8], b[NT][8];
#pragma unroll
        for (int s2 = 0; s2 < 8; ++s2) { a[s2] = *(const s_bf16x8*)(ap + k0 + s2 * 32);
#pragma unroll
            for (int t = 0; t < NT; ++t) b[t][s2] = *(const s_bf16x8*)(bp[t] + k0 + s2 * 32); }
#pragma unroll
        for (int s2 = 0; s2 < 8; ++s2)
#pragma unroll
            for (int t = 0; t < NT; ++t) R.a[t] = __builtin_amdgcn_mfma_f32_16x16x32_bf16(b[t][s2], a[s2], R.a[t], 0, 0, 0);
    }
#pragma unroll 1
    for (; k0 < kw; k0 += 64) {
        s_bf16x8 a[2], b[NT][2];
#pragma unroll
        for (int s2 = 0; s2 < 2; ++s2) { a[s2] = *(const s_bf16x8*)(ap + k0 + s2 * 32);
#pragma unroll
            for (int t = 0; t < NT; ++t) b[t][s2] = *(const s_bf16x8*)(bp[t] + k0 + s2 * 32); }
#pragma unroll
        for (int s2 = 0; s2 < 2; ++s2)
#pragma unroll
            for (int t = 0; t < NT; ++t) R.a[t] = __builtin_amdgcn_mfma_f32_16x16x32_bf16(b[t][s2], a[s2], R.a[t], 0, 0, 0);
    }
    __syncthreads();
    if (kq > 0) {
#pragma unroll
        for (int t = 0; t < NT; ++t) *(LAS s_f32x4*)(red + ((((kq - 1) * 2 + rt) * NT + t) * 64 + lane) * 4) = R.a[t]; }
    __syncthreads();
    if (kq == 0) {
#pragma unroll
        for (int q = 0; q < 3; ++q)
#pragma unroll
            for (int t = 0; t < NT; ++t) R.a[t] = R.a[t] + *(const LAS s_f32x4*)(red + (((q * 2 + rt) * NT + t) * 64 + lane) * 4); }
}
enum { TR_ID = 0, TR_INA, TR_INB, TR_GU };
__device__ __forceinline__ int tr_rowmap(int kind, int n) {
    if (kind == TR_INA) return n < 3072 ? n : (n < 3080 ? 3328 + (n - 3072) : 3072 + (n - 3080));
    if (kind == TR_INB) return n < 768 ? n : (n < 804 ? 1024 + (n - 768) : 768 + (n - 804));
    if (kind == TR_GU) { if (n < DFF) return (n >> 7) * 256 + (n & 127); const int m = n - DFF; return (m >> 7) * 256 + 128 + (m & 127); }
    return n;
}
__device__ __forceinline__ void tr_item(const float* W, int K, int N, bf16_t* WT, const float* gain, int kind, LAS float* scr, int item, int lane) {
    const int nblk = (N + 31) >> 5, kb = item / nblk, nb = item % nblk, k0 = 64 * kb, n0 = 32 * nb;
    { float v[32]; const int n = n0 + (lane & 31); const bool ok = n < N; const float* wp = W + (size_t)(k0 + (lane >> 5)) * N + (ok ? n : 0);
#pragma unroll
      for (int i = 0; i < 32; ++i) v[i] = wp[(size_t)(2 * i) * N];
#pragma unroll
      for (int i = 0; i < 32; ++i) { const int kk = 2 * i + (lane >> 5); float x = ok ? v[i] : 0.f; if (gain) x *= gain[k0 + kk]; scr[kk * 33 + (lane & 31)] = x; } }
    asm volatile("s_waitcnt lgkmcnt(0)" ::: "memory");
    const int c = lane & 7;
#pragma unroll
    for (int j = 0; j < 4; ++j) { const int nn = (lane >> 3) + 8 * j, n = n0 + nn;
        if (n < N) { const int row = tr_rowmap(kind, n); const float sc = (kind == TR_INA && n >= 768 && n < 1536) ? 0.07216878364870322f : 1.0f;
            const LAS float* s = scr + (8 * c) * 33 + nn; uint4 o;
            o.x = pk2(s[0 * 33] * sc, s[1 * 33] * sc); o.y = pk2(s[2 * 33] * sc, s[3 * 33] * sc); o.z = pk2(s[4 * 33] * sc, s[5 * 33] * sc); o.w = pk2(s[6 * 33] * sc, s[7 * 33] * sc);
            *(uint4*)(WT + (size_t)row * K + k0 + 8 * c) = o; } }
    asm volatile("s_waitcnt lgkmcnt(0)" ::: "memory");
}
__device__ __forceinline__ void ph_prologue(const Params& p, LAS unsigned char* lds) {
    const int tid = ltid(), lane = tid & 63, wid = tid >> 6; const int gw = blockIdx.x * NW_ + wid, NGW = gridDim.x * NW_;
    LAS float* scr = (LAS float*)(lds + wid * 16384);
    unsigned char* ws = p.ws;
    for (int it = gw; ; it += NGW) {
        int r = it; bool done = false;
#define TRJ(Wp, K_, N_, WTp, gainp, kind_) if (!done) { const int cnt = ((K_) / 64) * (((N_) + 31) / 32); if (r < cnt) { tr_item(Wp, K_, N_, WTp, gainp, kind_, scr, r, lane); done = true; } else r -= cnt; }
        for (int l = 0; l < 4; ++l) TRJ(p.in[I_WGU] + (size_t)l * DM * 2 * DFF, DM, 2 * DFF, (bf16_t*)(ws + B_BTG) + (size_t)l * 2 * DFF * DM, p.in[I_GFFN] + l * DM, TR_GU)
        for (int l = 0; l < 4; ++l) TRJ(p.in[I_WDOWN] + (size_t)l * DFF * DM, DFF, DM, (bf16_t*)(ws + B_BTD) + (size_t)l * DM * DFF, (const float*)nullptr, TR_ID)
        for (int l = 0; l < 2; ++l) TRJ(p.in[I_WINA] + (size_t)l * DM * ACOLS, DM, ACOLS, (bf16_t*)(ws + B_BTA) + (size_t)l * NBTA * DM, p.in[I_GMIX] + l * DM, TR_INA)
        for (int l = 0; l < 2; ++l) TRJ(p.in[I_WINB] + (size_t)l * DM * BCOLS, DM, BCOLS, (bf16_t*)(ws + B_BTB) + (size_t)l * NBTB * DM, p.in[I_GMIX] + (2 + l) * DM, TR_INB)
        for (int l = 0; l < 4; ++l) TRJ(p.in[I_WOUT] + (size_t)l * DM * DM, DM, DM, (bf16_t*)(ws + B_BTO) + (size_t)l * DM * DM, (const float*)nullptr, TR_ID)
        TRJ(p.in[I_WKV], DM, 768, (bf16_t*)(ws + B_BTK), p.in[I_GKV], TR_ID)
        for (int l = 0; l < 4; ++l) TRJ(p.in[I_WMEMKV] + (size_t)l * DM * 512, DM, 512, (bf16_t*)(ws + B_BTM) + (size_t)l * 512 * DM, (const float*)nullptr, TR_ID)
        for (int c = 0; c < 2; ++c) TRJ(p.in[I_CW1] + (size_t)c * 2048 * 128, 2048, 128, (bf16_t*)(ws + B_W1T) + (size_t)c * 128 * 2048, (const float*)nullptr, TR_ID)
        for (int c = 0; c < 2; ++c) TRJ(p.in[I_CW2] + (size_t)c * 128 * 64, 128, 64, (bf16_t*)(ws + B_W2T) + (size_t)c * 64 * 128, (const float*)nullptr, TR_ID)
#undef TRJ
        if (!done) break;
    }
    for (int idx = gw; idx < 256; idx += NGW) { const int c = idx >> 7, h = idx & 127; float s = 0.f;
        for (int k = lane; k < 2048; k += 64) s += p.in[I_CPOS][((k >> 6) * 2 + c) * 64 + (k & 63)] * p.in[I_CW1][((size_t)c * 2048 + k) * 128 + h];
        s = wave_sum(s); if (lane == 0) ((float*)(ws + B_PEB))[idx] = s + p.in[I_CB1][idx]; }
    for (int i = blockIdx.x * NT_ + tid; i < 2 * 8 * 128 + 2 * 12 * 128; i += gridDim.x * NT_) {
        uint4 z = make_uint4(0u, 0u, 0u, 0u);
        if (i < 2048) { const int l = i >> 10, rr = (i >> 7) & 7, c = i & 127; ((uint4*)((bf16_t*)(ws + B_BTA) + ((size_t)l * NBTA + 3336 + rr) * DM))[c] = z; }
        else { const int k = i - 2048; const int l = k / 1536, rr = (k % 1536) >> 7, c = k & 127; ((uint4*)((bf16_t*)(ws + B_BTB) + ((size_t)l * NBTB + 1060 + rr) * DM))[c] = z; }
    }
    bf16_t* XB = (bf16_t*)(ws + B_XB); float* ssq0 = (float*)(ws + B_SSQ); bf16_t* MPB = (bf16_t*)(ws + B_MPB);
    for (int r0 = gw; r0 < MA + 2048; r0 += 2 * NGW) {
        float4 v[2][4]; const int r1 = r0 + NGW < MA + 2048 ? r0 + NGW : r0;
#pragma unroll
        for (int u = 0; u < 2; ++u) { const int r = u ? r1 : r0; const float* src = r < MA ? (r < MP ? p.in[I_XP] + (size_t)r * DM : p.in[I_XS] + (size_t)(r - MP) * DM) : p.in[I_MEMP] + (size_t)(r - MA) * DM;
#pragma unroll
            for (int j = 0; j < 4; ++j) v[u][j] = ((const float4*)src)[lane + 64 * j]; }
#pragma unroll
        for (int u = 0; u < 2; ++u) { const int r = u ? r1 : r0; if (u == 1 && r1 == r0) break; const bool isx = r < MA;
            bf16_t* dstb = isx ? XB + (size_t)r * DM : MPB + (size_t)(r - MA) * DM; float ss = 0.f;
#pragma unroll
            for (int j = 0; j < 4; ++j) { ss += dot4(v[u][j], v[u][j]); ((uint2*)dstb)[lane + 64 * j] = make_uint2(pk2(v[u][j].x, v[u][j].y), pk2(v[u][j].z, v[u][j].w)); }
            ss = wave_sum(ss); if (isx && lane == 0) ssq0[r] = ss; }
    }
}

__device__ __forceinline__ void ph_swin_copy(const Params& p, int blk0, int nblk) {
    if ((int)blockIdx.x < blk0 || (int)blockIdx.x >= blk0 + nblk) return;
    const int tid = ltid();
    {   const unsigned n4 = 128u * 511u * 64u, stride = nblk * NT_;
#define SW_SRC(i_) (((const float4*)(p.in[I_CWIN] + (size_t)((i_) / (511u * 64u)) * 512 * 256 + 256))[(i_) % (511u * 64u)])
#define SW_DST(i_) (((float4*)(p.out + O_SWIN + (size_t)((i_) / (511u * 64u)) * 512 * 256))[(i_) % (511u * 64u)])
        for (unsigned i0 = (blockIdx.x - blk0) * NT_ + tid; i0 < n4; i0 += 4 * stride) {
            const unsigned i1 = i0 + stride, i2 = i0 + 2 * stride, i3 = i0 + 3 * stride;
            const float4 v0 = SW_SRC(i0), v1 = SW_SRC(i1 < n4 ? i1 : i0), v2 = SW_SRC(i2 < n4 ? i2 : i0), v3 = SW_SRC(i3 < n4 ? i3 : i0);
            SW_DST(i0) = v0; if (i1 < n4) SW_DST(i1) = v1; if (i2 < n4) SW_DST(i2) = v2; if (i3 < n4) SW_DST(i3) = v3; }
#undef SW_SRC
#undef SW_DST
    }
}

__device__ __forceinline__ void ph_memk_norm(const Params& p) {
    const int tid_ = ltid(); const int lane = tid_ & 63, wid = tid_ >> 6;
    const float* raw = (const float*)(p.ws + B_MEMR);
    for (int it = blockIdx.x * NW_ + wid; it < 4 * 8 * 256; it += gridDim.x * NW_) {
        const int l = it / 2048;
        const float4* rr = (const float4*)(raw + (size_t)it * 512); float4* orow = (float4*)(p.out + O_PMEM + (size_t)it * 512);
        float4 v = rr[lane]; const float4 vv = rr[64 + lane]; float ss = dot4(v, v);
        ss += __shfl_xor(ss, 1); ss += __shfl_xor(ss, 2); ss += __shfl_xor(ss, 4); ss += __shfl_xor(ss, 8);
        const float rs = rsqrtf(ss * (1.0f / 64) + EPS);
        const float4 g = ((const float4*)(p.in[I_GMEMK] + l * 64))[lane & 15];
        v.x *= rs * g.x; v.y *= rs * g.y; v.z *= rs * g.z; v.w *= rs * g.w; orow[lane] = v; orow[64 + lane] = vv;
    }
}

__device__ __forceinline__ void ph_mlstm_prompt(const Params& p, int l, float* lds) {
    const bf16_t* P = (const bf16_t*)(p.ws + B_P16); const float* GT = (const float*)(p.ws + B_GT); const float* bif = p.in[I_BIF] + l * 8; float* HR = (float*)(p.ws + B_HRAW);
    const int tid = ltid(), lane = tid & 63, wid = tid >> 6;
    float* red = lds;
    for (int item = blockIdx.x; item < 256; item += gridDim.x) {
        const int es = item & 7, h = (item >> 3) & 3, b = item >> 5;
        const bool act = tid < 384; const int grp = tid >= 192 ? 1 : 0; const int d = act ? tid - grp * 192 : 0;
        const int col0 = h * 192 + es * 24 + (act ? grp : 0) * 12;
        float C[12]; float n = 0.f, m = NEGM;
#pragma unroll
        for (int e = 0; e < 12; ++e) C[e] = 0.f;
        const bf16_t* pr = P + (size_t)(b * SP) * LDA_; const float* gr = GT + (size_t)(b * SP) * GTW;
        float qn = act ? bf2f(pr[h * 192 + d]) : 0.f, kn = act ? bf2f(pr[768 + h * 192 + d]) : 0.f; uint2 vn[3];
#pragma unroll
        for (int e = 0; e < 3; ++e) vn[e] = *(const uint2*)(pr + 1536 + col0 + 4 * e);
        float in_ = gr[h] + bif[h], fn = gr[4 + h] + bif[4 + h];
        for (int t = 0; t < SP; ++t) {
            const float q = qn, k = kn, ig = in_, fg = fn; float v[12];
#pragma unroll
            for (int e = 0; e < 3; ++e) { v[4 * e] = bflo(vn[e].x); v[4 * e + 1] = bfhi(vn[e].x); v[4 * e + 2] = bflo(vn[e].y); v[4 * e + 3] = bfhi(vn[e].y); }
            if (t + 1 < SP) {
                pr += LDA_; gr += GTW;
                qn = act ? bf2f(pr[h * 192 + d]) : 0.f; kn = act ? bf2f(pr[768 + h * 192 + d]) : 0.f;
#pragma unroll
                for (int e = 0; e < 3; ++e) vn[e] = *(const uint2*)(pr + 1536 + col0 + 4 * e);
                in_ = gr[h] + bif[h]; fn = gr[4 + h] + bif[4 + h];
            }
            const float logf = logsigmoidf_(fg);
            const float m_new = fmaxf(logf + m, ig);
            const float a = expf(logf + m - m_new), bb = expf(ig - m_new);
            const float kb = bb * k;
            float part[13];
#pragma unroll
            for (int e = 0; e < 12; ++e) { C[e] = a * C[e] + kb * v[e]; part[e] = q * C[e]; }
            n = a * n + kb; part[12] = q * n;
#pragma unroll
            for (int e = 0; e < 13; ++e) part[e] = wave_sum(part[e]);
            float* rb = red + (t & 1) * 104;
            if (lane == 0) {
#pragma unroll
                for (int e = 0; e < 13; ++e) rb[wid * 13 + e] = part[e];
            }
            __syncthreads();
            if (tid < 24) {
                const int g2 = tid / 12, e = tid % 12;
                const float num = rb[(g2 * 3) * 13 + e] + rb[(g2 * 3 + 1) * 13 + e] + rb[(g2 * 3 + 2) * 13 + e];
                const float den = rb[12] + rb[13 + 12] + rb[26 + 12];
                HR[(size_t)(b * SP + t) * 768 + h * 192 + es * 24 + tid] = num / fmaxf(fabsf(den), expf(-m_new));
            }
            m = m_new;
        }
        if (act) {
            float* co = p.out + O_PC + ((size_t)((l * 8 + b) * 4 + h) * 192 + d) * 192 + es * 24 + grp * 12;
#pragma unroll
            for (int e = 0; e < 12; ++e) co[e] = C[e];
            if (es == 0 && grp == 0) p.out[O_PN + (size_t)((l * 8 + b) * 4 + h) * 192 + d] = n;
        }
        if (es == 0 && tid == 0) p.out[O_PM + (l * 8 + b) * 4 + h] = m;
        __syncthreads();
    }
}
__device__ __forceinline__ void ph_mlstm_sample(const Params& p, int l, float* lds) {
    const bf16_t* P = (const bf16_t*)(p.ws + B_P16); const float* GT = (const float*)(p.ws + B_GT); const float* bif = p.in[I_BIF] + l * 8; float* HR = (float*)(p.ws + B_HRAW);
    const int tid = ltid();
    float* qs = lds + 512; float* ks = lds + 512 + 192; float* n0s = lds + 512 + 384;
    for (int item = blockIdx.x; item < 128 * 4; item += gridDim.x) {
        const int h = item & 3, b = item >> 2; const int row = MP + b;
        const bf16_t* pr = P + (size_t)row * LDA_; const float* gr = GT + (size_t)row * GTW;
        const size_t sidx = (size_t)(l * 128 + b) * 4 + h;
        __syncthreads();
        if (tid < 192) { qs[tid] = bf2f(pr[h * 192 + tid]); ks[tid] = bf2f(pr[768 + h * 192 + tid]); n0s[tid] = p.in[I_SN][sidx * 192 + tid]; }
        __syncthreads();
        const float ig = gr[h] + bif[h], fg = gr[4 + h] + bif[4 + h];
        const float m0 = p.in[I_SM][sidx];
        const float logf = logsigmoidf_(fg);
        const float m_new = fmaxf(logf + m0, ig);
        const float a = expf(logf + m0 - m_new), bb = expf(ig - m_new);
        if (tid < 192) {
            const int e = tid; const float ve = bf2f(pr[1536 + h * 192 + e]);
            const float* C0 = p.in[I_SC] + sidx * 192 * 192; float* C1 = p.out + O_SC + sidx * 192 * 192;
            float num = 0.f, den = 0.f;
            for (int d = 0; d < 192; ++d) {
                const float c = a * C0[d * 192 + e] + bb * ks[d] * ve; C1[d * 192 + e] = c; num += qs[d] * c;
                const float nd = a * n0s[d] + bb * ks[d]; den += qs[d] * nd;
            }
            HR[(size_t)row * 768 + h * 192 + e] = num / fmaxf(fabsf(den), expf(-m_new));
            p.out[O_SN + sidx * 192 + e] = a * n0s[e] + bb * ks[e];
        }
        if (tid == 0) p.out[O_SM + sidx] = m_new;
    }
}
__device__ __forceinline__ void ph_mlstm_fin(const Params& p, int l) {
    const bf16_t* P = (const bf16_t*)(p.ws + B_P16); const float* HR = (const float*)(p.ws + B_HRAW); bf16_t* CATB = (bf16_t*)(p.ws + B_CATB); const float* g = p.in[I_GHN] + l * 192;
    const int tid_ = ltid(); const int lane = tid_ & 63, wid = tid_ >> 6;
    for (int row = blockIdx.x * NW_ + wid; row < MA; row += gridDim.x * NW_) {
        float v[4][3]; bf16_t og[4][3];
#pragma unroll
        for (int h = 0; h < 4; ++h)
#pragma unroll
            for (int i = 0; i < 3; ++i) { v[h][i] = HR[(size_t)row * 768 + h * 192 + lane + 64 * i]; og[h][i] = P[(size_t)row * LDA_ + 2304 + h * 192 + lane + 64 * i]; }
#pragma unroll
        for (int h = 0; h < 4; ++h) { float ss = v[h][0] * v[h][0] + v[h][1] * v[h][1] + v[h][2] * v[h][2]; ss = wave_sum(ss); const float rs = rsqrtf(ss * (1.0f / 192) + EPS);
#pragma unroll
            for (int i = 0; i < 3; ++i) { const int d = lane + 64 * i; CATB[(size_t)row * DM + h * 192 + d] = (bf16_t)f2bf(sigmoidf_(bf2f(og[h][i])) * (v[h][i] * rs * g[d])); } }
    }
}
__device__ __forceinline__ void ph_mem_attn(const Params& p, int l) {
    const int ldp = l < 2 ? LDA_ : LDB_, qoff = l < 2 ? 3072 : 768;
    const bf16_t* P = (const bf16_t*)(p.ws + B_P16); bf16_t* CATB = (bf16_t*)(p.ws + B_CATB); const float* gq = p.in[I_GMEMQ] + l * 64;
    for (int idx4 = blockIdx.x * NT_ + ltid(); idx4 < 16 * MA; idx4 += gridDim.x * NT_) {
        const int part = idx4 & 3, idx = idx4 >> 2;
        const int hh = idx / MA, row = idx % MA;
        const float* kvb = row < MP ? p.out + O_PMEM + (size_t)(l * 8 + row / SP) * 256 * 512 : p.in[I_CMEM] + (size_t)(l * 128 + (row - MP)) * 256 * 512;
        float q[16]; float ss = 0.f;
        const uint4* qp = (const uint4*)(P + (size_t)row * ldp + qoff + hh * 64 + part * 16);
#pragma unroll
        for (int i = 0; i < 2; ++i) { const uint4 t = qp[i]; q[8 * i] = bflo(t.x); q[8 * i + 1] = bfhi(t.x); q[8 * i + 2] = bflo(t.y); q[8 * i + 3] = bfhi(t.y); q[8 * i + 4] = bflo(t.z); q[8 * i + 5] = bfhi(t.z); q[8 * i + 6] = bflo(t.w); q[8 * i + 7] = bfhi(t.w); }
#pragma unroll
        for (int i = 0; i < 16; ++i) ss += q[i] * q[i];
        ss += __shfl_xor(ss, 1); ss += __shfl_xor(ss, 2);
        const float rs = rsqrtf(ss * (1.0f / 64) + EPS) * 0.125f;
#pragma unroll
        for (int i = 0; i < 16; ++i) q[i] *= rs * gq[part * 16 + i];
        float mx = -3e38f, den = 0.f; float o[16];
#pragma unroll
        for (int i = 0; i < 16; ++i) o[i] = 0.f;
        for (int m = 0; m < 256; ++m) {
            const float4* kp = (const float4*)(kvb + (size_t)m * 512 + hh * 64 + part * 16); const float4* vp = (const float4*)(kvb + (size_t)m * 512 + 256 + hh * 64 + part * 16);
            float s = 0.f;
#pragma unroll
            for (int i = 0; i < 4; ++i) { const float4 t = kp[i]; s += q[4 * i] * t.x + q[4 * i + 1] * t.y + q[4 * i + 2] * t.z + q[4 * i + 3] * t.w; }
            s += __shfl_xor(s, 1); s += __shfl_xor(s, 2);
            const float mn = fmaxf(mx, s); const float sc = expf(mx - mn), e = expf(s - mn); mx = mn; den = den * sc + e;
#pragma unroll
            for (int i = 0; i < 4; ++i) { const float4 t = vp[i]; o[4 * i] = o[4 * i] * sc + e * t.x; o[4 * i + 1] = o[4 * i + 1] * sc + e * t.y; o[4 * i + 2] = o[4 * i + 2] * sc + e * t.z; o[4 * i + 3] = o[4 * i + 3] * sc + e * t.w; }
        }
        const float inv = 1.0f / den; uint4* op = (uint4*)(CATB + (size_t)row * DM + 768 + hh * 64 + part * 16);
#pragma unroll
        for (int i = 0; i < 2; ++i) op[i] = make_uint4(pk2(o[8 * i] * inv, o[8 * i + 1] * inv), pk2(o[8 * i + 2] * inv, o[8 * i + 3] * inv), pk2(o[8 * i + 4] * inv, o[8 * i + 5] * inv), pk2(o[8 * i + 6] * inv, o[8 * i + 7] * inv));
    }
}
__device__ __forceinline__ void rows_post_tile(const Params& p, int row0, int t) {
    float* KVR = (float*)(p.ws + B_KVR); const int tid_ = ltid(); const int lane = tid_ & 63, wid = tid_ >> 6;
    const int c2 = lane >> 5, gg = (lane >> 4) & 1, d = (lane & 15) * 4; bf16_t* KVB = (bf16_t*)(p.ws + B_KVB); const size_t KT = (size_t)BP * 2 * SP * 64;
#pragma unroll 1
    for (int rr0 = wid; rr0 < 256; rr0 += 4 * NW_) {
      float4 vv[4];
#pragma unroll
      for (int k = 0; k < 4; ++k) { const int rowk = row0 + rr0 + k * NW_; vv[k] = ((const float4*)(KVR + (size_t)(rowk < MA ? rowk : MA - 1) * 768 + t * 256))[lane]; }
#pragma unroll
      for (int k = 0; k < 4; ++k) {
        const int row = row0 + rr0 + k * NW_; if (row >= MA) continue;
        float* r = KVR + (size_t)row * 768 + t * 256;
        float4 v = vv[k];
        if (t >= 1) {
            float ss = dot4(v, v);
            ss += __shfl_xor(ss, 1); ss += __shfl_xor(ss, 2); ss += __shfl_xor(ss, 4); ss += __shfl_xor(ss, 8);
            if (lane < 32) { const float rs = rsqrtf(ss * (1.0f / 64) + EPS); const float4 gk = ((const float4*)(t == 1 ? p.in[I_GKSLC] : p.in[I_GKWIN]))[lane & 15];
                v.x *= rs * gk.x; v.y *= rs * gk.y; v.z *= rs * gk.z; v.w *= rs * gk.w;
                if (row >= MP) ((float4*)r)[lane] = v; }
        }
        if (row < MP) {
            const int b = row / SP, sp = row % SP; const size_t off = (((size_t)b * 2 + gg) * SP + sp) * 64 + d;
            if (t == 0) { ((float4*)(p.out + O_PCMP + (size_t)row * 256))[lane] = v; *(uint2*)(KVB + (0 + c2) * KT + off) = make_uint2(pk2(v.x, v.y), pk2(v.z, v.w)); }
            else if (t == 2) { if (sp >= SP - 512) ((float4*)(p.out + O_PWIN + (size_t)(b * 512 + sp - (SP - 512)) * 256))[lane] = v; *(uint2*)(KVB + (4 + c2) * KT + off) = make_uint2(pk2(v.x, v.y), pk2(v.z, v.w)); }
            else {
                ((float4*)(p.out + O_PSLC + (size_t)row * 256))[lane] = v;
                const size_t blkbase = (((size_t)b * 2 + gg) * 32 + (sp >> 6)) * 4096;
                if (c2 == 0) { const int nt = (sp >> 4) & 3, fr2 = sp & 15, ks = d >> 5, fg2 = (d >> 3) & 3, e = d & 7;
                    *(uint2*)((bf16_t*)(p.ws + B_SKF) + blkbase + (size_t)(((nt * 2 + ks) * 64 + fg2 * 16 + fr2) * 8 + e)) = make_uint2(pk2(v.x, v.y), pk2(v.z, v.w)); }
                else { const int cs = (sp >> 5) & 1, kk = sp & 31, fg2 = (kk & 15) >> 2, e = (kk & 3) + (kk >= 16 ? 4 : 0), dt = d >> 4, fr2 = d & 15;
                    bf16_t* vf = (bf16_t*)(p.ws + B_SVF) + blkbase + (size_t)(((dt * 2 + cs) * 64 + fg2 * 16 + fr2) * 8 + e);
                    vf[0] = (bf16_t)f2bf(v.x); vf[8] = (bf16_t)f2bf(v.y); vf[16] = (bf16_t)f2bf(v.z); vf[24] = (bf16_t)f2bf(v.w); } }
        } else {
            const int b = row - MP;
            if (t == 0) ((float4*)(p.out + O_SCMP + (size_t)b * 256))[lane] = v; else if (t == 1) ((float4*)(p.out + O_SSLC + (size_t)b * 256))[lane] = v;
            else ((float4*)(p.out + O_SWIN + (size_t)(b * 512 + 511) * 256))[lane] = v;
        }
      }
    }
}
__device__ __forceinline__ float gelu_tanh(float x) { return 0.5f * x * (1.0f + tanhf(0.7978845608028654f * (x + 0.044715f * x * x * x))); }
__device__ __forceinline__ void ph_compress(const Params& p, float* lds) {
    const float* KVR = (const float*)(p.ws + B_KVR); const int tid = ltid();
    float* xs = lds;
    float* hs = lds + 4096;
    const float* w1 = p.in[I_CW1]; const float* w2 = p.in[I_CW2]; const int* pt = (const int*)p.in[I_PT];
    for (int item = blockIdx.x; item < 136 * 127 * 2; item += gridDim.x) {
        const int c = item & 1, n = (item >> 1) % 127, bb = (item >> 1) / 127;
        __syncthreads();
        for (int i = tid; i < 4096; i += NT_) {
            const int g = i >> 11, pp = (i >> 6) & 31, d = i & 63; const int tok = 16 * n + pp; float x;
            if (bb < 8) x = KVR[(size_t)(bb * SP + tok) * 768 + c * 128 + g * 64 + d];
            else { const int b = bb - 8; const int phys = pt[b * 16 + (tok >> 7)]; x = p.in[I_CCMP][((size_t)phys * 128 + (tok & 127)) * 256 + c * 128 + g * 64 + d]; }
            xs[i] = x + p.in[I_CPOS][(pp * 2 + c) * 64 + d];
        }
        __syncthreads();
        if (tid < 256) { const int g = tid >> 7, h = tid & 127; float pre = p.in[I_CB1][c * 128 + h]; const float* wp = w1 + (size_t)c * 2048 * 128 + h; const float* xp = xs + g * 2048;
          for (int i = 0; i < 2048; ++i) pre = fmaf(xp[i], wp[(size_t)i * 128], pre);
          hs[g * 128 + h] = gelu_tanh(pre); }
        __syncthreads();
        if (tid < 128) {
            const int g = tid >> 6, d = tid & 63; float o = p.in[I_CB2][c * 64 + d];
            for (int h = 0; h < 128; ++h) o = fmaf(hs[g * 128 + h], w2[(size_t)(c * 128 + h) * 64 + d], o);
            if (c == 0) { const float ss = wave_sum(o * o); o = o * rsqrtf(ss * (1.0f / 64) + EPS) * p.in[I_GKCMP][d]; }
            ((float*)(p.ws + (c == 0 ? B_CK : B_CV)))[((size_t)bb * 127 + n) * 128 + g * 64 + d] = o;
            bf16_t* kc = (bf16_t*)(p.ws + B_KC16) + ((((size_t)bb * 2 + c) * 2 + g) * 128 + n) * 64 + d; kc[0] = (bf16_t)f2bf(o); if (n == 126) kc[64] = 0;
        }
    }
}
#ifndef NSA_NAIVE_ALL
#define NSA_NAIVE_ALL 0
#endif
__device__ __forceinline__ void row_softmax(float* r, int n, int lane) {
    float mx = NEGM;
    for (int i = lane; i < n; i += 64) mx = fmaxf(mx, r[i]);
    mx = wave_max(mx);
    if (mx <= 0.5f * NEGM) { for (int i = lane; i < n; i += 64) r[i] = 0.f; return; }
    float s = 0.f;
    for (int i = lane; i < n; i += 64) { const float e = r[i] <= 0.5f * NEGM ? 0.f : expf(r[i] - mx); r[i] = e; s += e; }
    s = wave_sum(s); const float inv = 1.0f / s;
    for (int i = lane; i < n; i += 64) r[i] *= inv;
}
__device__ __forceinline__ void ph_nsa(const Params& p, int j, float* lds) {
    const int tid = ltid(), lane = tid & 63, wid = tid >> 6;
    float* qs = lds;
    float* sc = lds + 384;
    float* imp = sc + 3072;
    int* sel = (int*)(imp + 40);
    float* gate = (float*)(sel + 8);
    float* oacc = gate + 24;
    const bf16_t* P = (const bf16_t*)(p.ws + B_P16); const float* GT = (const float*)(p.ws + B_GT); const float* KVR = (const float*)(p.ws + B_KVR); bf16_t* CATB = (bf16_t*)(p.ws + B_CATB);
    const float* table = p.in[I_REL]; const int* pt = (const int*)p.in[I_PT];
    for (int item = blockIdx.x; item < (NSA_NAIVE_ALL ? MA : BS) * 2; item += gridDim.x) {
        const int row = (NSA_NAIVE_ALL ? 0 : MP) + (item >> 1), g = item & 1; const bool smp = row >= MP;
        const int b = smp ? row - MP : row / SP, pos = smp ? PAST : row % SP;
        const bf16_t* pr = P + (size_t)row * LDB_;
        __syncthreads();
        if (wid < 6) { const int z = wid; const float v = bf2f(pr[(g * 6 + z) * 64 + lane]); const float ss = wave_sum(v * v); qs[z * 64 + lane] = v * rsqrtf(ss * (1.0f / 64) + EPS) * p.in[I_GQ][j * 64 + lane]; }
        if (tid >= 384 && tid < 384 + 18) { const int t2 = tid - 384; const int br = t2 / 6, z = t2 % 6; gate[t2] = sigmoidf_(GT[(size_t)row * GTW + br * 12 + g * 6 + z] + p.in[I_BGATE][j * 36 + br * 12 + g * 6 + z]); }
        if (tid < 384) oacc[tid] = 0.f;
        __syncthreads();
        const float* ck = (const float*)(p.ws + B_CK) + (size_t)(smp ? 8 + b : b) * 127 * 128; const float* cv = (const float*)(p.ws + B_CV) + (size_t)(smp ? 8 + b : b) * 127 * 128;
        for (int i = tid; i < 6 * 127; i += NT_) {
            const int z = i / 127, n = i % 127; const int dist = pos - (16 * n + 31); float s = NEGM;
            if (dist >= 0) { const float4* kp = (const float4*)(ck + n * 128 + g * 64); const float4* qp = (const float4*)(qs + z * 64); float a = 0.f;
#pragma unroll 4
                for (int d = 0; d < 16; ++d) a += dot4(kp[d], qp[d]);
                s = a * 0.125f + table[rel_bucket(dist) * 12 + g * 6 + z]; }
            sc[z * 128 + n] = s;
        }
        __syncthreads();
        if (wid < 6) row_softmax(sc + wid * 128, 127, lane);
        __syncthreads();
        const int nslc = smp ? 33 : 32, cur = pos >> 6;
        if (tid < nslc) { const int jb = tid; float s = 0.f;
            for (int z = 0; z < 6; ++z) for (int n = 0; n < 127; ++n) { const int lo = max(16 * n, 64 * jb), hi = min(16 * n + 32, 64 * jb + 64); if (hi > lo) s += sc[z * 128 + n] * (float)(hi - lo) * (1.0f / 16); }
            imp[jb] = s; }
        __syncthreads();
        if (tid == 0) {
            int cnt = 0;
            if (cur + 1 <= 8) { for (int jb = 0; jb <= cur; ++jb) sel[cnt++] = jb; }
            else {
                sel[0] = 0; sel[1] = cur; sel[2] = cur - 1; cnt = 3; unsigned long long taken = 0ull;
                for (int k = 0; k < 5; ++k) { int best = -1; float bv = -1.f;
                    for (int jb = 1; jb <= cur - 2; ++jb) if (!((taken >> jb) & 1ull) && imp[jb] > bv) { bv = imp[jb]; best = jb; }
                    if (best >= 0) { taken |= 1ull << best; sel[cnt++] = best; } }
            }
            for (; cnt < 8; ++cnt) sel[cnt] = -1;
        }
        if (tid < 384) { const int z = tid >> 6, d = tid & 63; float o = 0.f;
            for (int n = 0; n < 127; ++n) o = fmaf(sc[z * 128 + n], cv[n * 128 + g * 64 + d], o);
            oacc[tid] += gate[0 * 6 + z] * o; }
        __syncthreads();
        for (int br = 1; br <= 2; ++br) {
            { const int t = tid;
                const float* kp = nullptr; int dist = -1;
                if (br == 1) {
                    const int blk = sel[t >> 6];
                    if (blk >= 0) { const int tok = blk * 64 + (t & 63); dist = pos - tok;
                        if (dist >= 0) { if (!smp) kp = KVR + (size_t)(b * SP + tok) * 768 + 256 + g * 64;
                            else if (tok < PAST) kp = p.in[I_CSLC] + ((size_t)pt[b * 16 + (tok >> 7)] * 128 + (tok & 127)) * 256 + g * 64;
                            else kp = KVR + (size_t)row * 768 + 256 + g * 64; } }
                } else {
                    const int kpos = pos - 511 + t; dist = 511 - t;
                    if (!smp) { if (kpos >= 0) kp = KVR + (size_t)(b * SP + kpos) * 768 + 512 + g * 64; else dist = -1; }
                    else { if (kpos < PAST) kp = p.in[I_CWIN] + ((size_t)b * 512 + (kpos - (PAST - 512))) * 256 + g * 64; else kp = KVR + (size_t)row * 768 + 512 + g * 64; }
                }
                if (dist >= 0 && kp) {
                    float s[6] = {0.f, 0.f, 0.f, 0.f, 0.f, 0.f};
#pragma unroll 2
                    for (int d = 0; d < 16; ++d) { const float4 kk = ((const float4*)kp)[d];
#pragma unroll
                        for (int z = 0; z < 6; ++z) s[z] += dot4(kk, ((const float4*)(qs + z * 64))[d]); }
                    const int bk = rel_bucket(dist);
#pragma unroll
                    for (int z = 0; z < 6; ++z) sc[z * 512 + t] = s[z] * 0.125f + table[bk * 12 + g * 6 + z];
                } else {
#pragma unroll
                    for (int z = 0; z < 6; ++z) sc[z * 512 + t] = NEGM;
                }
            }
            __syncthreads();
            if (wid < 6) row_softmax(sc + wid * 512, 512, lane);
            __syncthreads();
            if (tid < 384) { const int z = tid >> 6, d = tid & 63; float o = 0.f;
                for (int t = 0; t < 512; ++t) { const float pw = sc[z * 512 + t]; if (pw != 0.f) { const float* vp;
                    if (br == 1) { const int tok = sel[t >> 6] * 64 + (t & 63);
                        if (!smp) vp = KVR + (size_t)(b * SP + tok) * 768 + 256 + 128 + g * 64;
                        else if (tok < PAST) vp = p.in[I_CSLC] + ((size_t)pt[b * 16 + (tok >> 7)] * 128 + (tok & 127)) * 256 + 128 + g * 64;
                        else vp = KVR + (size_t)row * 768 + 256 + 128 + g * 64;
                    } else { const int kpos = pos - 511 + t;
                        if (!smp) vp = KVR + (size_t)(b * SP + kpos) * 768 + 512 + 128 + g * 64;
                        else if (kpos < PAST) vp = p.in[I_CWIN] + ((size_t)b * 512 + (kpos - (PAST - 512))) * 256 + 128 + g * 64;
                        else vp = KVR + (size_t)row * 768 + 512 + 128 + g * 64; }
                    o = fmaf(pw, vp[d], o); } }
                oacc[tid] += gate[br * 6 + z] * o; }
            __syncthreads();
        }
        if (tid < 384) CATB[(size_t)row * DM + g * 384 + tid] = (bf16_t)f2bf(oacc[tid]);
    }
}
constexpr size_t KVB_T = (size_t)BP * 2 * SP * 64;
typedef short v4i16_t __attribute__((ext_vector_type(4)));
typedef short bf16x8_t __attribute__((ext_vector_type(8)));
typedef float f32x4_t __attribute__((ext_vector_type(4)));
typedef unsigned u32x4_t __attribute__((ext_vector_type(4)));
__device__ __forceinline__ bf16x8_t ldtr2(const LAS unsigned char* p0, const LAS unsigned char* p1) {
    const v4i16_t a = __builtin_amdgcn_ds_read_tr16_b64_v4i16((LAS v4i16_t*)p0), b = __builtin_amdgcn_ds_read_tr16_b64_v4i16((LAS v4i16_t*)p1);
    return __builtin_shufflevector(a, b, 0, 1, 2, 3, 4, 5, 6, 7);
}
__device__ __forceinline__ unsigned cvtpk(float lo, float hi) { unsigned r; asm volatile("v_cvt_pk_bf16_f32 %0, %1, %2" : "=v"(r) : "v"(lo), "v"(hi)); return r; }
__device__ __forceinline__ bf16x8_t pack8(f32x4_t a, f32x4_t b) { uint4 w; w.x = cvtpk(a[0], a[1]); w.y = cvtpk(a[2], a[3]); w.z = cvtpk(b[0], b[1]); w.w = cvtpk(b[2], b[3]); return __builtin_bit_cast(bf16x8_t, w); }
__device__ __forceinline__ f32x4_t mfma16(bf16x8_t a, bf16x8_t b, f32x4_t c) { return __builtin_amdgcn_mfma_f32_16x16x32_bf16(a, b, c, 0, 0, 0); }
__device__ __forceinline__ float ex2(float x) { return __builtin_amdgcn_exp2f(x); }
__device__ __forceinline__ float xmax4(float x) {
    auto s = __builtin_amdgcn_permlane16_swap(__float_as_uint(x), __float_as_uint(x), false, false);
    x = fmaxf(__uint_as_float(s[0]), __uint_as_float(s[1]));
    auto t = __builtin_amdgcn_permlane32_swap(__float_as_uint(x), __float_as_uint(x), false, false);
    return fmaxf(__uint_as_float(t[0]), __uint_as_float(t[1]));
}
__device__ __forceinline__ float xsum4(float x) {
    auto s = __builtin_amdgcn_permlane16_swap(__float_as_uint(x), __float_as_uint(x), false, false);
    x = __uint_as_float(s[0]) + __uint_as_float(s[1]);
    auto t = __builtin_amdgcn_permlane32_swap(__float_as_uint(x), __float_as_uint(x), false, false);
    return __uint_as_float(t[0]) + __uint_as_float(t[1]);
}
constexpr float LOG2E = 1.4426950408889634f, NINF = -__builtin_inff();
constexpr int KROW = 144;

__device__ __forceinline__ void ph_nsa_fast(const Params& p, int j, LAS unsigned char* lds) {
    const int tid = ltid(), lane0 = tid & 63, w = tid >> 6;
    unsigned char* ws = p.ws;
    const bf16_t* P16 = (const bf16_t*)(ws + B_P16); const float* GT = (const float*)(ws + B_GT); bf16_t* CATB = (bf16_t*)(ws + B_CATB);
    const bf16_t* KVB = (const bf16_t*)(ws + B_KVB); const bf16_t* KC16 = (const bf16_t*)(ws + B_KC16);
    LAS unsigned char* Kw = lds;
    LAS unsigned char* Vw = lds + 18432;
    LAS unsigned char* Kc = lds + 36864;
    LAS unsigned char* Vc = lds + 55296;
    LAS float* biasT = (LAS float*)(lds + 73728);
    LAS float* impL = (LAS float*)(lds + 73728 + 3072);
    LAS int* selL = (LAS int*)(lds + 73728 + 3072 + 16384);
    const float* table = p.in[I_REL]; const float* gq = p.in[I_GQ] + j * 64; const float* bgate = p.in[I_BGATE] + j * 36;
    for (int unit = blockIdx.x; unit < 256; unit += gridDim.x) {
        int lane_a = lane0; asm volatile("" : "+v"(lane_a)); const int lane = lane_a, fr = lane & 15, fg = lane >> 4;
        const int g = unit & 1, b = (unit >> 1) & 7, tile = unit >> 4, t0 = tile * 128, tw = t0 + 16 * w, trow = tw + fr;
        TSUB_BEGIN();
        __syncthreads();
        for (int i = tid; i < 2048; i += NT_) { const int tsel = i >> 10, r = (i >> 3) & 127, ch = i & 7;
            const u32x4_t v = *(const u32x4_t*)(KC16 + (((size_t)b * 2 + tsel) * 2 + g) * 128 * 64 + r * 64 + ch * 8);
            *(LAS u32x4_t*)((tsel ? Vc : Kc) + r * KROW + ch * 16) = v; }
        for (int i = tid; i < 768; i += NT_) { const int d = i / 6, z = i % 6; biasT[i] = table[rel_bucket_alu(d) * 12 + g * 6 + z] * LOG2E; }
        if (tid < 64) ((LAS float*)(lds + 73728 + 3072 + 16384 + 4096))[tid] = gq[tid] * (0.125f * LOG2E);
        __syncthreads();
        const bf16_t* qrow = P16 + (size_t)(b * SP + trow) * LDB_ + g * 384;
        LAS float* gqL = (LAS float*)(lds + 73728 + 3072 + 16384 + 4096);
#define FETCH_Q(z_, ra_, rb_) do { ra_ = *(const uint4*)(qrow + (z_) * 64 + fg * 8); rb_ = *(const uint4*)(qrow + (z_) * 64 + 32 + fg * 8); } while (0)
#define LOAD_Q(z_, q0_, q1_) do { uint4 r0, r1; FETCH_Q(z_, r0, r1); FINISH_Q(r0, r1, q0_, q1_); } while (0)
#define FINISH_Q(r0, r1, q0_, q1_) do { \
            float v[16] = {bflo(r0.x), bfhi(r0.x), bflo(r0.y), bfhi(r0.y), bflo(r0.z), bfhi(r0.z), bflo(r0.w), bfhi(r0.w), bflo(r1.x), bfhi(r1.x), bflo(r1.y), bfhi(r1.y), bflo(r1.z), bfhi(r1.z), bflo(r1.w), bfhi(r1.w)}; \
            float ss = 0.f; _Pragma("unroll") for (int i = 0; i < 16; ++i) ss += v[i] * v[i]; \
            ss = xsum4(ss); const float rs = rsqrtf(ss * (1.0f / 64) + EPS); { const f32x4_t g0 = *(const LAS f32x4_t*)(gqL + fg * 8), g1 = *(const LAS f32x4_t*)(gqL + fg * 8 + 4), g2 = *(const LAS f32x4_t*)(gqL + 32 + fg * 8), g3 = *(const LAS f32x4_t*)(gqL + 32 + fg * 8 + 4); \
              _Pragma("unroll") for (int i = 0; i < 4; ++i) { v[i] *= rs * g0[i]; v[4 + i] *= rs * g1[i]; v[8 + i] *= rs * g2[i]; v[12 + i] *= rs * g3[i]; } } \
            q0_ = pack8((f32x4_t){v[0], v[1], v[2], v[3]}, (f32x4_t){v[4], v[5], v[6], v[7]}); q1_ = pack8((f32x4_t){v[8], v[9], v[10], v[11]}, (f32x4_t){v[12], v[13], v[14], v[15]}); } while (0)
        const float* gtrow = GT + (size_t)(b * SP + trow) * GTW;
#pragma unroll 1
        for (int hp = 0; hp < 2; ++hp) {
        bf16x8_t qf[3][2];
#pragma unroll
        for (int z = 0; z < 3; ++z) LOAD_Q(hp * 3 + z, qf[z][0], qf[z][1]);
        f32x4_t O[3][4]; float mrun[3], lrun[3];
#pragma unroll
        for (int z = 0; z < 3; ++z) { mrun[z] = NINF; lrun[z] = 0.f;
#pragma unroll
            for (int dt = 0; dt < 4; ++dt) O[z][dt] = (f32x4_t){0.f, 0.f, 0.f, 0.f}; }
        const bf16_t* WK = KVB + 4 * KVB_T + ((size_t)b * 2 + g) * SP * 64; const bf16_t* WV = KVB + 5 * KVB_T + ((size_t)b * 2 + g) * SP * 64;
        u32x4_t rst[4];
#define WIN_LOAD(it_) do { const int k128_ = t0 - 512 + 128 * (it_); _Pragma("unroll") for (int q_ = 0; q_ < 4; ++q_) { const int i_ = tid + NT_ * q_, tsel_ = i_ >> 10, r_ = (i_ >> 3) & 127, ch_ = i_ & 7; const int tok_ = k128_ + r_; \
            rst[q_] = (u32x4_t){0u, 0u, 0u, 0u}; if (tok_ >= 0) rst[q_] = *(const u32x4_t*)((tsel_ ? WV : WK) + (size_t)tok_ * 64 + ch_ * 8); } } while (0)
#define WIN_STORE() do { _Pragma("unroll") for (int q_ = 0; q_ < 4; ++q_) { const int i_ = tid + NT_ * q_, tsel_ = i_ >> 10, r_ = (i_ >> 3) & 127, ch_ = i_ & 7; *(LAS u32x4_t*)((tsel_ ? Vw : Kw) + r_ * KROW + ch_ * 16) = rst[q_]; } } while (0)
        WIN_LOAD(0);
        __syncthreads();
        WIN_STORE();
#pragma unroll 1
        for (int it = 0; it < 5; ++it) {
            const int k128 = t0 - 512 + 128 * it;
            BAR_LDS();
            if (it + 1 < 5) WIN_LOAD(it + 1);
#pragma unroll 1
            for (int sc = 0; sc < 4; ++sc) {
                const int kb = k128 + 32 * sc;
                if (kb > tw + 15 || kb + 31 < tw - 511 || kb + 31 < 0) continue;
                const bool fast = (kb + 31 <= tw - 113) && (kb >= tw + 15 - 511) && kb >= 0;
                bf16x8_t kf[2][2], vf[4];
#pragma unroll
                for (int nt = 0; nt < 2; ++nt)
#pragma unroll
                    for (int ks = 0; ks < 2; ++ks) kf[nt][ks] = *(const LAS bf16x8_t*)(Kw + (32 * sc + 16 * nt + fr) * KROW + (ks * 32 + fg * 8) * 2);
#pragma unroll
                for (int dt = 0; dt < 4; ++dt) { const LAS unsigned char* vp = Vw + (32 * sc + 4 * fg + (fr >> 2)) * KROW + (16 * dt + 4 * (fr & 3)) * 2; vf[dt] = ldtr2(vp, vp + 16 * KROW); }
#pragma unroll
                for (int z = 0; z < 3; ++z) {
                    f32x4_t s0 = (f32x4_t){0.f, 0.f, 0.f, 0.f}, s1 = s0;
                    s0 = mfma16(kf[0][0], qf[z][0], s0); s0 = mfma16(kf[0][1], qf[z][1], s0);
                    s1 = mfma16(kf[1][0], qf[z][0], s1); s1 = mfma16(kf[1][1], qf[z][1], s1);
                    if (fast) { const float cb = biasT[127 * 6 + hp * 3 + z]; s0 = s0 + cb; s1 = s1 + cb; }
                    else {
#pragma unroll
                        for (int jj = 0; jj < 4; ++jj) { const int key0 = kb + 4 * fg + jj, d0 = trow - key0, d1 = d0 - 16;
                            s0[jj] = (d0 >= 0 && d0 < 512 && key0 >= 0) ? s0[jj] + biasT[min(d0, 127) * 6 + hp * 3 + z] : NINF;
                            s1[jj] = (d1 >= 0 && d1 < 512 && key0 + 16 >= 0) ? s1[jj] + biasT[min(d1, 127) * 6 + hp * 3 + z] : NINF; }
                    }
                    float mx = fmaxf(fmaxf(fmaxf(s0[0], s0[1]), fmaxf(s0[2], s0[3])), fmaxf(fmaxf(s1[0], s1[1]), fmaxf(s1[2], s1[3])));
                    mx = xmax4(mx);
                    float msafe;
                    if (__any(mx > mrun[z] + 8.f)) {
                        const float mnew = fmaxf(mrun[z], mx); msafe = mnew == NINF ? 0.f : mnew;
                        const float alpha = ex2(mrun[z] - msafe);
                        mrun[z] = mnew; lrun[z] = lrun[z] * alpha;
#pragma unroll
                        for (int dt = 0; dt < 4; ++dt) O[z][dt] = O[z][dt] * alpha;
                    } else msafe = mrun[z] == NINF ? 0.f : mrun[z];
                    f32x4_t p0, p1;
#pragma unroll
                    for (int jj = 0; jj < 4; ++jj) { p0[jj] = ex2(s0[jj] - msafe); p1[jj] = ex2(s1[jj] - msafe); }
                    lrun[z] = lrun[z] + (((p0[0] + p0[1]) + (p0[2] + p0[3])) + ((p1[0] + p1[1]) + (p1[2] + p1[3])));
                    const bf16x8_t pf = pack8(p0, p1);
#pragma unroll
                    for (int dt = 0; dt < 4; ++dt) O[z][dt] = mfma16(vf[dt], pf, O[z][dt]);
                }
            }
            if (it + 1 < 5) { BAR_LDS(); WIN_STORE(); }
        }
#undef WIN_LOAD
#undef WIN_STORE
#pragma unroll
        for (int z = 0; z < 3; ++z) { const int hz2 = hp * 3 + z; const float lt = xsum4(lrun[z]); const float gw = sigmoidf_(gtrow[24 + g * 6 + hz2] + bgate[24 + g * 6 + hz2]); const float sc = gw / lt;
            bf16_t* orow = CATB + (size_t)(b * SP + trow) * DM + (g * 6 + hz2) * 64;
#pragma unroll
            for (int dt = 0; dt < 4; ++dt) { const f32x4_t v = O[z][dt] * sc; *(uint2*)(orow + 16 * dt + 4 * fg) = make_uint2(cvtpk(v[0], v[1]), cvtpk(v[2], v[3])); } }
        }
        asm volatile("s_waitcnt vmcnt(0)" ::: "memory");
        TSUB_END(0);
        float impacc[8];
#pragma unroll
        for (int nt = 0; nt < 8; ++nt) impacc[nt] = 0.f;
        const int nmax = trow >= 31 ? (trow - 31) >> 4 : -1;
        uint4 rqa_c, rqb_c; FETCH_Q(0, rqa_c, rqb_c);
#pragma unroll 1
        for (int z = 0; z < 6; ++z) {
            bf16_t* orow = CATB + (size_t)(b * SP + trow) * DM + (g * 6 + z) * 64; unsigned long long oldc[4];
#pragma unroll
            for (int dt = 0; dt < 4; ++dt) oldc[dt] = __hip_atomic_load((unsigned long long*)(orow + 16 * dt + 4 * fg), __ATOMIC_RELAXED, __HIP_MEMORY_SCOPE_AGENT);
            const float gcraw = gtrow[g * 6 + z];
            f32x4_t s[8]; bf16x8_t qz[2]; { const uint4 ra = rqa_c, rb = rqb_c; if (z + 1 < 6) FETCH_Q(z + 1, rqa_c, rqb_c); FINISH_Q(ra, rb, qz[0], qz[1]); }
#pragma unroll
            for (int nt = 0; nt < 8; ++nt) { s[nt] = (f32x4_t){0.f, 0.f, 0.f, 0.f};
#pragma unroll
                for (int ks = 0; ks < 2; ++ks) { const bf16x8_t kf = *(const LAS bf16x8_t*)(Kc + (16 * nt + fr) * KROW + (ks * 32 + fg * 8) * 2); s[nt] = mfma16(kf, qz[ks], s[nt]); } }
            float mx = NINF;
#pragma unroll
            for (int nt = 0; nt < 8; ++nt)
#pragma unroll
                for (int jj = 0; jj < 4; ++jj) { const int n = 16 * nt + 4 * fg + jj; const int dist = trow - 16 * n - 31;
                    const float v = (n <= nmax && n <= 126) ? s[nt][jj] + biasT[min(dist, 127) * 6 + z] : NINF; s[nt][jj] = v; mx = fmaxf(mx, v); }
            asm volatile("" ::: "memory");
            mx = xmax4(mx); const float msafe = mx == NINF ? 0.f : mx; float sum = 0.f;
#pragma unroll
            for (int nt = 0; nt < 8; ++nt)
#pragma unroll
                for (int jj = 0; jj < 4; ++jj) { const float e = ex2(s[nt][jj] - msafe); s[nt][jj] = e; sum += e; }
            sum = xsum4(sum); const float inv = sum > 0.f ? 1.0f / sum : 0.f;
            float p3prev = 0.f;
#pragma unroll
            for (int nt = 0; nt < 8; ++nt) { s[nt] = s[nt] * inv;
                const float p3 = s[nt][3]; const float up = __shfl(p3, (lane + 48) & 63);
                const float prev_tile = __shfl(p3prev, (lane + 48) & 63);
                impacc[nt] += 2.0f * (s[nt][0] + s[nt][1] + s[nt][2]) + p3 + (fg == 0 ? prev_tile : up);
                p3prev = p3; }
            f32x4_t oc[4];
#pragma unroll
            for (int dt = 0; dt < 4; ++dt) oc[dt] = (f32x4_t){0.f, 0.f, 0.f, 0.f};
#pragma unroll
            for (int c2 = 0; c2 < 4; ++c2) { const bf16x8_t pf = pack8(s[2 * c2], s[2 * c2 + 1]);
#pragma unroll
                for (int dt = 0; dt < 4; ++dt) { const LAS unsigned char* vp = Vc + (32 * c2 + 4 * fg + (fr >> 2)) * KROW + (16 * dt + 4 * (fr & 3)) * 2; oc[dt] = mfma16(ldtr2(vp, vp + 16 * KROW), pf, oc[dt]); }
                asm volatile("" ::: "memory"); }
            const float gc = sigmoidf_(gcraw + bgate[g * 6 + z]);
#pragma unroll
            for (int dt = 0; dt < 4; ++dt) { const unsigned long long o64 = oldc[dt];
                const f32x4_t v = oc[dt] * gc + (f32x4_t){bflo((unsigned)o64), bfhi((unsigned)o64), bflo((unsigned)(o64 >> 32)), bfhi((unsigned)(o64 >> 32))};
                *(uint2*)(orow + 16 * dt + 4 * fg) = make_uint2(cvtpk(v[0], v[1]), cvtpk(v[2], v[3])); }
        }
        TSUB_END(1);
#pragma unroll
        for (int nt = 0; nt < 8; ++nt) impL[(w * 16 + fr) * 32 + 4 * nt + fg] = impacc[nt];
        asm volatile("s_waitcnt lgkmcnt(0)" ::: "memory");
        if (lane < 16) {
            const int t = tw + lane, cur = t >> 6; LAS int* so = selL + (w * 16 + lane) * 8; const LAS float* im = impL + (w * 16 + lane) * 32;
            int cnt = 0;
            if (cur + 1 <= 8) { for (int jb = 0; jb <= cur; ++jb) so[cnt++] = jb; }
            else {
                so[1] = 0; so[3] = cur; so[5] = cur - 1; unsigned taken = 0u;
                for (int k = 0; k < 5; ++k) { int best = -1; float bv = -1.f;
                    for (int jb = 1; jb <= cur - 2; ++jb) { const float v = im[jb]; if (!((taken >> jb) & 1u) && v > bv) { bv = v; best = jb; } }
                    taken |= 1u << best; so[k < 3 ? 2 * k : 3 + k] = best; }
                cnt = 8; }
            for (; cnt < 8; ++cnt) so[cnt] = -1;
        }
        asm volatile("s_waitcnt vmcnt(0) lgkmcnt(0)" ::: "memory");
        const bf16_t* SKF = (const bf16_t*)(ws + B_SKF) + ((size_t)b * 2 + g) * 32 * 4096; const bf16_t* SVF = (const bf16_t*)(ws + B_SVF) + ((size_t)b * 2 + g) * 32 * 4096;
        const int c0 = 2 * tile;
        TSUB_END(2);
        __syncthreads();
        for (int i = tid; i < 4 * 1024; i += NT_) { const int slot = i >> 10, r = i & 1023; const int blk = slot == 0 ? 0 : c0 - 2 + slot;
            if (blk >= 0 && blk < 32) { const u32x4_t v = *(const u32x4_t*)((r < 512 ? SKF : SVF) + (size_t)blk * 4096 + (r & 511) * 8); *(LAS u32x4_t*)(lds + slot * 16384 + r * 16) = v; } }
        __syncthreads();
        { int lane_b = lane0; asm volatile("" : "+v"(lane_b)); const int lane = lane_b, fr = lane & 15, fg = lane >> 4;
        const int hz = fr < 6 ? fr : 5;
        uint4 rqa, rqb;
        { const bf16_t* qrow = P16 + ((size_t)b * SP + tw) * LDB_ + g * 384 + hz * 64; rqa = *(const uint4*)(qrow + fg * 8); rqb = *(const uint4*)(qrow + 32 + fg * 8); }
#pragma unroll 1
        for (int ti = 0; ti < 16; ++ti) {
            const int t = tw + ti; const size_t row = (size_t)b * SP + t;
            bf16x8_t qs[2];
            const uint4 r0 = rqa, r1 = rqb;
            if (ti + 1 < 16) { const bf16_t* qrow = P16 + (row + 1) * LDB_ + g * 384 + hz * 64; rqa = *(const uint4*)(qrow + fg * 8); rqb = *(const uint4*)(qrow + 32 + fg * 8); }
            bf16_t* orow = CATB + row * DM + (g * 6 + hz) * 64; unsigned long long oldv[4];
#pragma unroll
            for (int dt = 0; dt < 4; ++dt) oldv[dt] = __hip_atomic_load((unsigned long long*)(orow + 16 * dt + 4 * fg), __ATOMIC_RELAXED, __HIP_MEMORY_SCOPE_AGENT);
            const float graw = GT[row * GTW + 12 + g * 6 + hz];
            {
              float v[16] = {bflo(r0.x), bfhi(r0.x), bflo(r0.y), bfhi(r0.y), bflo(r0.z), bfhi(r0.z), bflo(r0.w), bfhi(r0.w), bflo(r1.x), bfhi(r1.x), bflo(r1.y), bfhi(r1.y), bflo(r1.z), bfhi(r1.z), bflo(r1.w), bfhi(r1.w)};
              float ss = 0.f;
#pragma unroll
              for (int i = 0; i < 16; ++i) ss += v[i] * v[i];
              ss = xsum4(ss); const float rs = rsqrtf(ss * (1.0f / 64) + EPS) * (0.125f * LOG2E);
#pragma unroll
              for (int i = 0; i < 8; ++i) { v[i] *= rs * gq[fg * 8 + i]; v[8 + i] *= rs * gq[32 + fg * 8 + i]; }
              qs[0] = pack8((f32x4_t){v[0], v[1], v[2], v[3]}, (f32x4_t){v[4], v[5], v[6], v[7]});
              qs[1] = pack8((f32x4_t){v[8], v[9], v[10], v[11]}, (f32x4_t){v[12], v[13], v[14], v[15]}); }
            f32x4_t os[4]; float ms = NINF, ls = 0.f;
#pragma unroll
            for (int dt = 0; dt < 4; ++dt) os[dt] = (f32x4_t){0.f, 0.f, 0.f, 0.f};
#define SLC_LOADK(KF, blk_) do { const int slot_ = (blk_) == 0 ? 0 : ((blk_) >= c0 - 1 ? (blk_) - c0 + 2 : -1); \
                if (slot_ >= 0) { const LAS unsigned char* fb_ = lds + slot_ * 16384 + lane * 16; \
                    _Pragma("unroll") for (int nt = 0; nt < 4; ++nt) _Pragma("unroll") for (int ks = 0; ks < 2; ++ks) KF[nt][ks] = *(const LAS bf16x8_t*)(fb_ + (nt * 2 + ks) * 1024); \
                } else { const bf16_t* kb_ = SKF + (size_t)(blk_) * 4096 + lane * 8; \
                    _Pragma("unroll") for (int nt = 0; nt < 4; ++nt) _Pragma("unroll") for (int ks = 0; ks < 2; ++ks) KF[nt][ks] = *(const bf16x8_t*)(kb_ + (nt * 2 + ks) * 512); } } while (0)
#define SLC_LOADV(VF, blk_) do { const int slot_ = (blk_) == 0 ? 0 : ((blk_) >= c0 - 1 ? (blk_) - c0 + 2 : -1); \
                if (slot_ >= 0) { const LAS unsigned char* fb_ = lds + slot_ * 16384 + lane * 16; \
                    _Pragma("unroll") for (int dt = 0; dt < 4; ++dt) _Pragma("unroll") for (int cs = 0; cs < 2; ++cs) VF[dt][cs] = *(const LAS bf16x8_t*)(fb_ + 8192 + (dt * 2 + cs) * 1024); \
                } else { const bf16_t* vb_ = SVF + (size_t)(blk_) * 4096 + lane * 8; \
                    _Pragma("unroll") for (int dt = 0; dt < 4; ++dt) _Pragma("unroll") for (int cs = 0; cs < 2; ++cs) VF[dt][cs] = *(const bf16x8_t*)(vb_ + (dt * 2 + cs) * 512); } } while (0)
#define SLC_COMPUTE(KF, VF, blk_, nblk_) do { const int tok0 = (blk_) * 64; f32x4_t s[4]; \
                _Pragma("unroll") for (int nt = 0; nt < 4; ++nt) { s[nt] = (f32x4_t){0.f, 0.f, 0.f, 0.f}; s[nt] = mfma16(KF[nt][0], qs[0], s[nt]); s[nt] = mfma16(KF[nt][1], qs[1], s[nt]); } \
                float mx = NINF; \
                if (tok0 + 63 <= t - 113) { const float cb = biasT[127 * 6 + hz]; \
                    _Pragma("unroll") for (int nt = 0; nt < 4; ++nt) { s[nt] = s[nt] + cb; mx = fmaxf(mx, fmaxf(fmaxf(s[nt][0], s[nt][1]), fmaxf(s[nt][2], s[nt][3]))); } } \
                else { _Pragma("unroll") for (int nt = 0; nt < 4; ++nt) _Pragma("unroll") for (int jj = 0; jj < 4; ++jj) { const int dist = t - (tok0 + 16 * nt + 4 * fg + jj); const float v = dist >= 0 ? s[nt][jj] + biasT[min(dist, 127) * 6 + hz] : NINF; s[nt][jj] = v; mx = fmaxf(mx, v); } } \
                mx = xmax4(mx); \
                float msafe; \
                if (__any(mx > ms + 8.f)) { const float mnew = fmaxf(ms, mx); msafe = mnew == NINF ? 0.f : mnew; const float alpha = ex2(ms - msafe); ms = mnew; ls = ls * alpha; \
                    _Pragma("unroll") for (int dt = 0; dt < 4; ++dt) os[dt] = os[dt] * alpha; } \
                else msafe = ms == NINF ? 0.f : ms; \
                float sum = 0.f; \
                _Pragma("unroll") for (int nt = 0; nt < 4; ++nt) _Pragma("unroll") for (int jj = 0; jj < 4; ++jj) { const float e = ex2(s[nt][jj] - msafe); s[nt][jj] = e; sum += e; } \
                ls = ls + sum; \
                _Pragma("unroll") for (int cs = 0; cs < 2; ++cs) { const bf16x8_t pf = pack8(s[2 * cs], s[2 * cs + 1]); \
                    _Pragma("unroll") for (int dt = 0; dt < 4; ++dt) os[dt] = mfma16(VF[dt][cs], pf, os[dt]); } \
                if ((nblk_) >= 0) SLC_LOADV(VF, nblk_); } while (0)
            const LAS int* sbl = selL + (w * 16 + ti) * 8; int nb = 0;
#pragma unroll
            for (int bi = 0; bi < 8; ++bi) nb += sbl[bi] >= 0 ? 1 : 0;
            bf16x8_t kfC[4][2], kfN[4][2], vfX[4][2];
            { const int b0 = sbl[0]; SLC_LOADK(kfN, b0); SLC_LOADV(vfX, b0); }
#pragma unroll 1
            for (int bi = 0; bi < nb; ++bi) {
                const int bA = sbl[bi], bB = bi + 1 < nb ? sbl[bi + 1] : -1;
#pragma unroll
                for (int nt = 0; nt < 4; ++nt) { kfC[nt][0] = kfN[nt][0]; kfC[nt][1] = kfN[nt][1]; }
                if (bB >= 0) SLC_LOADK(kfN, bB);
                SLC_COMPUTE(kfC, vfX, bA, bB);
            }
#undef SLC_LOADK
#undef SLC_LOADV
#undef SLC_COMPUTE
            const float lt = xsum4(ls);
            if (fr < 6) {
                const float gs = sigmoidf_(graw + bgate[12 + g * 6 + fr]); const float sc = lt > 0.f ? gs / lt : 0.f;
#pragma unroll
                for (int dt = 0; dt < 4; ++dt) { const unsigned long long o64 = oldv[dt]; const f32x4_t v = os[dt] * sc + (f32x4_t){bflo((unsigned)o64), bfhi((unsigned)o64), bflo((unsigned)(o64 >> 32)), bfhi((unsigned)(o64 >> 32))};
                    *(uint2*)(orow + 16 * dt + 4 * fg) = make_uint2(cvtpk(v[0], v[1]), cvtpk(v[2], v[3])); }
            }
        }
        }
        TSUB_END(3);
    }
}

constexpr int CW_P = 272, CW_BUF = 128 * CW_P;
template <bool SMP> __device__ __forceinline__ void compress_job(const Params& p, int bb, int c, int g, LAS unsigned char* lds) {
    const int tid = ltid(), lane = tid & 63, w = tid >> 6, fr = lane & 15, fg = lane >> 4, n = 16 * w + fr;
    unsigned char* ws = p.ws;
    const bf16_t* W1T = (const bf16_t*)(ws + B_W1T) + (size_t)c * 128 * 2048; const bf16_t* W2T = (const bf16_t*)(ws + B_W2T) + (size_t)c * 64 * 128;
    f32x4_t acc[8];
#pragma unroll
    for (int t = 0; t < 8; ++t) acc[t] = (f32x4_t){0.f, 0.f, 0.f, 0.f};
    const bf16_t* ap = (const bf16_t*)(ws + B_KVB) + (size_t)c * KVB_T + ((size_t)(SMP ? 0 : bb) * 2 + g) * SP * 64 + (size_t)n * 1024 + fg * 8;
    const float* pg0 = nullptr; const float* pg1 = nullptr; int tsplit = 0;
    if (SMP) { const int* pt = (const int*)p.in[I_PT] + (bb - 8) * 16; const int t0 = 16 * n > 2016 ? 2016 : 16 * n; const int pa = t0 >> 7, pb = (t0 + 31) >> 7;
        pg0 = p.in[I_CCMP] + (((size_t)pt[pa] * 128 + (t0 & 127)) * 4 + c * 2 + g) * 64 + fg * 8; tsplit = pb == pa ? 64 : 128 - (t0 & 127);
        pg1 = p.in[I_CCMP] + (((size_t)pt[pb] * 128) * 4 + c * 2 + g) * 64 + fg * 8 - (size_t)tsplit * 256; }
    u32x4_t rb[4]; bf16x8_t acur[4]; f32x4_t araw[SMP ? 8 : 1]; bf16x8_t anext[SMP ? 1 : 4];
#define CW_LOADB(st_) do { _Pragma("unroll") for (int i_ = 0; i_ < 4; ++i_) { const int ch_ = tid + NT_ * i_, r_ = ch_ >> 4, cc_ = ch_ & 15; rb[i_] = *(const u32x4_t*)(W1T + (size_t)r_ * 2048 + (st_) * 128 + cc_ * 8); } } while (0)
#define CW_STOREB(buf_) do { _Pragma("unroll") for (int i_ = 0; i_ < 4; ++i_) { const int ch_ = tid + NT_ * i_, r_ = ch_ >> 4, cc_ = ch_ & 15; *(LAS u32x4_t*)(lds + (buf_) * CW_BUF + r_ * CW_P + cc_ * 16) = rb[i_]; } } while (0)
#define CW_LOADA(st_) do { _Pragma("unroll") for (int u_ = 0; u_ < 4; ++u_) { const int s_ = (st_) * 4 + u_; \
        if (SMP) { const int tk_ = s_ >> 1; const float* src_ = (tk_ < tsplit ? pg0 : pg1) + (size_t)tk_ * 256 + (s_ & 1) * 32; araw[2 * u_] = *(const f32x4_t*)src_; araw[2 * u_ + 1] = *(const f32x4_t*)(src_ + 4); } \
        else anext[u_] = *(const bf16x8_t*)(ap + s_ * 32); } } while (0)
#define CW_TAKEA() do { _Pragma("unroll") for (int u_ = 0; u_ < 4; ++u_) { if (SMP) acur[u_] = pack8(araw[2 * u_], araw[2 * u_ + 1]); else acur[u_] = anext[u_]; } } while (0)
    __syncthreads();
    CW_LOADB(0); CW_LOADA(0); CW_STOREB(0); CW_TAKEA();
    BAR_LDS();
#pragma unroll 1
    for (int st = 0; st < 16; ++st) {
        if (st + 1 < 16) { CW_LOADB(st + 1); CW_LOADA(st + 1); }
        const LAS unsigned char* bb_ = lds + (st & 1) * CW_BUF + fr * CW_P + fg * 16;
#pragma unroll
        for (int u = 0; u < 4; ++u)
#pragma unroll
            for (int t = 0; t < 8; ++t) acc[t] = mfma16(*(const LAS bf16x8_t*)(bb_ + t * 16 * CW_P + u * 64), acur[u], acc[t]);
        if (st + 1 < 16) { CW_STOREB((st + 1) & 1); CW_TAKEA(); }
        BAR_LDS();
    }
#undef CW_LOADB
#undef CW_STOREB
#undef CW_LOADA
#undef CW_TAKEA
    const float* peb = (const float*)(ws + B_PEB) + c * 128;
#pragma unroll
    for (int t = 0; t < 8; ++t) { const f32x4_t pb = *(const f32x4_t*)(peb + 16 * t + 4 * fg);
#pragma unroll
        for (int j = 0; j < 4; ++j) { const float x = acc[t][j] + pb[j]; const float u2 = 1.5957691216057308f * (x + 0.044715f * x * x * x);
            const float th = 1.0f - 2.0f * __builtin_amdgcn_rcpf(1.0f + ex2(u2 * LOG2E)); acc[t][j] = 0.5f * x * (1.0f + th); } }
    f32x4_t o[4];
#pragma unroll
    for (int dt = 0; dt < 4; ++dt) o[dt] = (f32x4_t){0.f, 0.f, 0.f, 0.f};
#pragma unroll
    for (int ks = 0; ks < 4; ++ks) { const bf16x8_t gf = pack8(acc[2 * ks], acc[2 * ks + 1]);
#pragma unroll
        for (int dt = 0; dt < 4; ++dt) { const bf16_t* wp = W2T + (size_t)(16 * dt + fr) * 128 + 32 * ks + 4 * fg; const uint2 x0 = *(const uint2*)wp, x1 = *(const uint2*)(wp + 16);
            o[dt] = mfma16(__builtin_bit_cast(bf16x8_t, make_uint4(x0.x, x0.y, x1.x, x1.y)), gf, o[dt]); } }
    float ss = 0.f;
#pragma unroll
    for (int dt = 0; dt < 4; ++dt) { const f32x4_t b2 = *(const f32x4_t*)(p.in[I_CB2] + c * 64 + 16 * dt + 4 * fg); o[dt] = o[dt] + b2; ss += (o[dt][0] * o[dt][0] + o[dt][1] * o[dt][1]) + (o[dt][2] * o[dt][2] + o[dt][3] * o[dt][3]); }
    if (c == 0) { ss = xsum4(ss); const float rs = rsqrtf(ss * (1.0f / 64) + EPS);
#pragma unroll
        for (int dt = 0; dt < 4; ++dt) { const f32x4_t gk = *(const f32x4_t*)(p.in[I_GKCMP] + 16 * dt + 4 * fg); o[dt] = o[dt] * rs * gk; } }
    bf16_t* kc = (bf16_t*)(ws + B_KC16) + ((((size_t)bb * 2 + c) * 2 + g) * 128 + n) * 64;
    float* cf = (float*)(ws + (c == 0 ? B_CK : B_CV)) + ((size_t)bb * 127 + n) * 128 + g * 64;
#pragma unroll
    for (int dt = 0; dt < 4; ++dt) {
        if (n < 127) { *(f32x4_t*)(cf + 16 * dt + 4 * fg) = o[dt]; *(uint2*)(kc + 16 * dt + 4 * fg) = make_uint2(cvtpk(o[dt][0], o[dt][1]), cvtpk(o[dt][2], o[dt][3])); }
        else { unsigned z = 0u; asm volatile("" : "+v"(z)); *(uint2*)(kc + 16 * dt + 4 * fg) = make_uint2(z, z); }
    }
}
__device__ __forceinline__ void ph_compress_fast(const Params& p, LAS unsigned char* lds) {
    for (int job = blockIdx.x; job < 544; job += gridDim.x) { const int jj = job < 512 ? job + 32 : job - 512; const int bb = jj >> 2, c = (jj >> 1) & 1, g = jj & 1;
        if (bb < 8) compress_job<false>(p, bb, c, g, lds); else compress_job<true>(p, bb, c, g, lds); }
}
constexpr int ML_QP = 400, ML_VP = 80, ML_WP = 112;
__device__ __forceinline__ void ph_mlstm_fast(const Params& p, int l, LAS unsigned char* lds) {
    const int tid = ltid(), lane = tid & 63, w = tid >> 6, fr = lane & 15, fg = lane >> 4;
    unsigned char* ws = p.ws;
    const bf16_t* P16 = (const bf16_t*)(ws + B_P16); const float* GT = (const float*)(ws + B_GT); const float* bif = p.in[I_BIF] + l * 8; float* HR = (float*)(ws + B_HRAW);
    LAS unsigned char* Ql = lds;
    LAS unsigned char* Kl = lds + 25600;
    LAS unsigned char* Vl = lds + 51200;
    LAS unsigned char* Wl = lds + 56320;
    LAS unsigned char* CT = lds + 63488;
    LAS float* INTER = (LAS float*)(lds + 82688);
    LAS float* QN = (LAS float*)(lds + 91904);
    LAS float* RTa = (LAS float*)(lds + 92160);
    LAS float* WSa = RTa + 2048;
    LAS float* EIa = RTa + 4096;
    LAS float* DEC = RTa + 6144;
    LAS float* Gk = DEC + 32; LAS float* Ak = DEC + 64; LAS float* MPk = DEC + 96;
    for (int unit = blockIdx.x; unit < 192; unit += gridDim.x) {
        const int es = unit % 6, h = (unit / 6) & 3, b = unit / 24;
        const size_t row0 = (size_t)b * SP;
        __syncthreads();
        for (int i = tid; i < 48 * 100; i += NT_) ((LAS unsigned*)CT)[i] = 0u;
        for (int i = tid; i < 64 * 28; i += NT_) ((LAS unsigned*)Wl)[i] = 0u;
        float gia[4], gfa[4];
#pragma unroll
        for (int q = 0; q < 4; ++q) { const float* g_ = GT + (row0 + 64 * (w + 8 * q) + lane) * GTW; gia[q] = g_[h]; gfa[q] = g_[4 + h]; }
#pragma unroll
        for (int q = 0; q < 4; ++q) { const int k = w + 8 * q; const float gi = gia[q] + bif[h], gf = gfa[q] + bif[4 + h];
            float bc = logsigmoidf_(gf);
#pragma unroll
            for (int o = 1; o < 64; o <<= 1) { const float t = __shfl_up(bc, o); if (lane >= o) bc += t; }
            const float u = gi - bc; float pm = u;
#pragma unroll
            for (int o = 1; o < 64; o <<= 1) { const float t = __shfl_up(pm, o); if (lane >= o) pm = fmaxf(pm, t); }
            EIa[k * 64 + lane] = bc; RTa[k * 64 + lane] = pm; WSa[k * 64 + lane] = u;
            if (lane == 63) { Gk[k] = bc; Ak[k] = pm; } }
        __syncthreads();
        if (tid == 0) { float m = NEGM; for (int k = 0; k < 32; ++k) { MPk[k] = m; m = Gk[k] + fmaxf(Ak[k], m); } MPk[32] = m; }
        __syncthreads();
#pragma unroll 1
        for (int k = w; k < 32; k += 8) { const float mp = MPk[k], M63 = fmaxf(Ak[k], mp); const float bc = EIa[k * 64 + lane], pm = RTa[k * 64 + lane], u = WSa[k * 64 + lane]; const float M = fmaxf(pm, mp);
            RTa[k * 64 + lane] = expf(M63 - M); WSa[k * 64 + lane] = expf(u - M63); EIa[k * 64 + lane] = expf(-(bc + M)); if (lane == 0) DEC[k] = expf(mp - M63); }
        f32x4_t cacc[5];
#pragma unroll
        for (int i = 0; i < 5; ++i) cacc[i] = (f32x4_t){0.f, 0.f, 0.f, 0.f};
        u32x4_t rq[3], rk[3], rv;
#define ML_LOAD(c_) do { const size_t rb_ = row0 + 64 * (c_); \
            _Pragma("unroll") for (int i_ = 0; i_ < 3; ++i_) { const int ch_ = tid + NT_ * i_, r_ = ch_ / 24, cc_ = ch_ % 24; const bf16_t* src_ = P16 + (rb_ + r_) * LDA_ + h * 192 + cc_ * 8; rq[i_] = *(const u32x4_t*)src_; rk[i_] = *(const u32x4_t*)(src_ + 768); } \
            if (tid < 256) { const int r_ = tid >> 2, cc_ = tid & 3; rv = *(const u32x4_t*)(P16 + (rb_ + r_) * LDA_ + 1536 + h * 192 + es * 32 + cc_ * 8); } } while (0)
#define ML_STORE(c_) do { \
            _Pragma("unroll") for (int i_ = 0; i_ < 3; ++i_) { const int ch_ = tid + NT_ * i_, r_ = ch_ / 24, cc_ = ch_ % 24; *(LAS u32x4_t*)(Ql + r_ * ML_QP + cc_ * 16) = rq[i_]; *(LAS u32x4_t*)(Kl + r_ * ML_QP + cc_ * 16) = rk[i_]; } \
            if (tid < 256) { const int r_ = tid >> 2, cc_ = tid & 3; *(LAS u32x4_t*)(Vl + r_ * ML_VP + cc_ * 16) = rv; const float wv_ = WSa[(c_) * 64 + r_]; \
                u32x4_t y_; y_.x = cvtpk(bflo(rv.x) * wv_, bfhi(rv.x) * wv_); y_.y = cvtpk(bflo(rv.y) * wv_, bfhi(rv.y) * wv_); y_.z = cvtpk(bflo(rv.z) * wv_, bfhi(rv.z) * wv_); y_.w = cvtpk(bflo(rv.w) * wv_, bfhi(rv.w) * wv_); \
                *(LAS u32x4_t*)(Wl + r_ * ML_WP + cc_ * 16) = y_; if (cc_ == 0) *(LAS bf16_t*)(Wl + r_ * ML_WP + 64) = (bf16_t)f2bf(wv_); } } while (0)
        ML_LOAD(0);
        __syncthreads();
        ML_STORE(0);
#pragma unroll 1
        for (int c = 0; c < 32; ++c) {
            BAR_LDS();
            if (c + 1 < 32) ML_LOAD(c + 1);
            f32x4_t hin[2]; float rsum = 0.f;
            hin[0] = (f32x4_t){0.f, 0.f, 0.f, 0.f}; hin[1] = hin[0];
            if (w < 4) {
                const int tt = w;
                f32x4_t S[4];
#pragma unroll
                for (int st = 0; st < 4; ++st) { S[st] = (f32x4_t){0.f, 0.f, 0.f, 0.f};
                    if (st <= tt) {
#pragma unroll
                        for (int ks = 0; ks < 6; ++ks) { const bf16x8_t kf = *(const LAS bf16x8_t*)(Kl + (16 * st + fr) * ML_QP + (32 * ks + 8 * fg) * 2), qf = *(const LAS bf16x8_t*)(Ql + (16 * tt + fr) * ML_QP + (32 * ks + 8 * fg) * 2);
                            S[st] = mfma16(kf, qf, S[st]); }
                        const f32x4_t wv = *(const LAS f32x4_t*)(WSa + c * 64 + 16 * st + 4 * fg); S[st] = S[st] * wv;
                        if (st == tt) {
#pragma unroll
                            for (int jj = 0; jj < 4; ++jj) if (4 * fg + jj > fr) S[st][jj] = 0.f; }
                        rsum += (S[st][0] + S[st][1]) + (S[st][2] + S[st][3]);
                    } }
                rsum = xsum4(rsum);
#pragma unroll
                for (int kk = 0; kk < 2; ++kk) { if (2 * kk <= tt) { const bf16x8_t pf = pack8(S[2 * kk], S[2 * kk + 1]);
#pragma unroll
                    for (int et = 0; et < 2; ++et) { const LAS unsigned char* vp = Vl + (32 * kk + 4 * fg + (fr >> 2)) * ML_VP + (16 * et + 4 * (fr & 3)) * 2; hin[et] = mfma16(ldtr2(vp, vp + 16 * ML_VP), pf, hin[et]); } } }
            } else {
                const int tt = w - 4;
                f32x4_t I[3];
#pragma unroll
                for (int e3 = 0; e3 < 3; ++e3) { I[e3] = (f32x4_t){0.f, 0.f, 0.f, 0.f};
#pragma unroll
                    for (int ks = 0; ks < 6; ++ks) { const bf16x8_t cf = *(const LAS bf16x8_t*)(CT + (16 * e3 + fr) * ML_QP + (32 * ks + 8 * fg) * 2), qf = *(const LAS bf16x8_t*)(Ql + (16 * tt + fr) * ML_QP + (32 * ks + 8 * fg) * 2);
                        I[e3] = mfma16(cf, qf, I[e3]); } }
                *(LAS f32x4_t*)(INTER + (16 * tt + fr) * 36 + 4 * fg) = I[0]; *(LAS f32x4_t*)(INTER + (16 * tt + fr) * 36 + 16 + 4 * fg) = I[1];
                if (fg == 0) QN[16 * tt + fr] = I[2][0];
            }
            BAR_LDS();
            const float decay = DEC[c];
            if (w < 4) {
                const int t = 16 * w + fr; const float r = RTa[c * 64 + t], einv = EIa[c * 64 + t], qn = QN[t];
                const float den = r * (rsum + decay * qn); const float inv = 1.0f / fmaxf(fabsf(den), einv);
                float* hp = HR + (row0 + 64 * c + t) * 768 + h * 192 + es * 32;
#pragma unroll
                for (int et = 0; et < 2; ++et) { const f32x4_t in2 = *(const LAS f32x4_t*)(INTER + t * 36 + 16 * et + 4 * fg); const f32x4_t num = (hin[et] + in2 * decay) * r; *(f32x4_t*)(hp + 16 * et + 4 * fg) = num * inv; }
            }
#pragma unroll
            for (int i = 0; i < 5; ++i) { const int idx = w + 8 * i; if (idx < 36) { const int dtile = idx / 3, et = idx % 3; cacc[i] = cacc[i] * decay;
#pragma unroll
                for (int ks = 0; ks < 2; ++ks) { const LAS unsigned char* kp = Kl + (32 * ks + 8 * fg + (fr >> 2)) * ML_QP + (16 * dtile + 4 * (fr & 3)) * 2; const LAS unsigned char* vp = Wl + (32 * ks + 8 * fg + (fr >> 2)) * ML_WP + (16 * et + 4 * (fr & 3)) * 2;
                    cacc[i] = mfma16(ldtr2(kp, kp + 4 * ML_QP), ldtr2(vp, vp + 4 * ML_WP), cacc[i]); } } }
            BAR_LDS();
#pragma unroll
            for (int i = 0; i < 5; ++i) { const int idx = w + 8 * i; if (idx < 36) { const int dtile = idx / 3, et = idx % 3;
                typedef unsigned u32x2_t __attribute__((ext_vector_type(2))); u32x2_t wv; wv.x = cvtpk(cacc[i][0], cacc[i][1]); wv.y = cvtpk(cacc[i][2], cacc[i][3]);
                *(LAS u32x2_t*)(CT + (16 * et + fr) * ML_QP + (16 * dtile + 4 * fg) * 2) = wv; } }
            if (c + 1 < 32) ML_STORE(c + 1);
        }
#pragma unroll
        for (int i = 0; i < 5; ++i) { const int idx = w + 8 * i; if (idx < 36) { const int dtile = idx / 3, et = idx % 3;
            if (et < 2) { float* co = p.out + O_PC + ((size_t)((l * 8 + b) * 4 + h) * 192 + 16 * dtile + 4 * fg) * 192 + es * 32 + 16 * et + fr;
#pragma unroll
                for (int jj = 0; jj < 4; ++jj) co[(size_t)jj * 192] = cacc[i][jj]; }
            else if (es == 0 && fr == 0) { float* no = p.out + O_PN + (size_t)((l * 8 + b) * 4 + h) * 192 + 16 * dtile + 4 * fg;
#pragma unroll
                for (int jj = 0; jj < 4; ++jj) no[jj] = cacc[i][jj]; } } }
        if (es == 0 && tid == 0) p.out[O_PM + (l * 8 + b) * 4 + h] = MPk[32];
#undef ML_LOAD
#undef ML_STORE
    }
}
__device__ __forceinline__ void ph_mem_attn_fast(const Params& p, int l, LAS unsigned char* lds, int u0, int ucnt, int ustep) {
    const int tid = ltid(), lane0 = tid & 63, w = tid >> 6;
    const int ldp = l < 2 ? LDA_ : LDB_, qoff = l < 2 ? 3072 : 768;
    const bf16_t* P16 = (const bf16_t*)(p.ws + B_P16); bf16_t* CATB = (bf16_t*)(p.ws + B_CATB); const float* gq = p.in[I_GMEMQ] + l * 64;
    LAS unsigned char* Km = lds;
    LAS unsigned char* Vm = lds + 36864;
    const float* gmk = p.in[I_GMEMK] + l * 64;
    for (int ui = 0; ui < ucnt; ++ui) { const int unit = u0 + ui * ustep; if (unit >= 256) break;
        int lane_a = lane0; asm volatile("" : "+v"(lane_a)); const int lane = lane_a, fr = lane & 15, fg = lane >> 4;
        const int oct = unit & 7, hh = (unit >> 3) & 3, b = unit >> 5;
        const float* kv = (const float*)(p.ws + B_MEMR) + (size_t)(l * 8 + b) * 256 * 512 + hh * 64;
        __syncthreads();
        {
            f32x4_t x[16];
#pragma unroll
            for (int k = 0; k < 16; ++k) { const int i = tid + NT_ * k, tsel = i >> 12, m = (i >> 4) & 255, ch = i & 15; x[k] = *(const f32x4_t*)(kv + (size_t)m * 512 + tsel * 256 + ch * 4); }
#pragma unroll
            for (int k = 0; k < 16; ++k) { const int i = tid + NT_ * k, tsel = i >> 12, m = (i >> 4) & 255, ch = i & 15;
                if (k < 8) { float ss = (x[k][0] * x[k][0] + x[k][1] * x[k][1]) + (x[k][2] * x[k][2] + x[k][3] * x[k][3]);
                    ss += __shfl_xor(ss, 1); ss += __shfl_xor(ss, 2); ss += __shfl_xor(ss, 4); ss += __shfl_xor(ss, 8);
                    const float rs = rsqrtf(ss * (1.0f / 64) + EPS); const f32x4_t gk = *(const f32x4_t*)(gmk + ch * 4); x[k] = x[k] * rs * gk; }
                typedef unsigned u32x2_t __attribute__((ext_vector_type(2))); u32x2_t y; y.x = cvtpk(x[k][0], x[k][1]); y.y = cvtpk(x[k][2], x[k][3]);
                *(LAS u32x2_t*)((tsel ? Vm : Km) + m * KROW + ch * 8) = y; }
        }
        __syncthreads();
#pragma unroll 1
        for (int ps = 0; ps < 2; ++ps) {
            const size_t row = (size_t)b * SP + oct * 256 + ps * 128 + w * 16 + fr;
            bf16x8_t qf[2];
            { const bf16_t* qrow = P16 + row * ldp + qoff + hh * 64;
              const uint4 r0 = *(const uint4*)(qrow + fg * 8), r1 = *(const uint4*)(qrow + 32 + fg * 8);
              float v[16] = {bflo(r0.x), bfhi(r0.x), bflo(r0.y), bfhi(r0.y), bflo(r0.z), bfhi(r0.z), bflo(r0.w), bfhi(r0.w), bflo(r1.x), bfhi(r1.x), bflo(r1.y), bfhi(r1.y), bflo(r1.z), bfhi(r1.z), bflo(r1.w), bfhi(r1.w)};
              float ss = 0.f;
#pragma unroll
              for (int i = 0; i < 16; ++i) ss += v[i] * v[i];
              ss = xsum4(ss); const float rs = rsqrtf(ss * (1.0f / 64) + EPS) * (0.125f * LOG2E);
#pragma unroll
              for (int i = 0; i < 8; ++i) { v[i] *= rs * gq[fg * 8 + i]; v[8 + i] *= rs * gq[32 + fg * 8 + i]; }
              qf[0] = pack8((f32x4_t){v[0], v[1], v[2], v[3]}, (f32x4_t){v[4], v[5], v[6], v[7]});
              qf[1] = pack8((f32x4_t){v[8], v[9], v[10], v[11]}, (f32x4_t){v[12], v[13], v[14], v[15]}); }
            f32x4_t S[16]; float mx = NINF;
#pragma unroll
            for (int nt = 0; nt < 16; ++nt) { S[nt] = (f32x4_t){0.f, 0.f, 0.f, 0.f};
#pragma unroll
                for (int ks = 0; ks < 2; ++ks) { const bf16x8_t kf = *(const LAS bf16x8_t*)(Km + (16 * nt + fr) * KROW + (32 * ks + 8 * fg) * 2); S[nt] = mfma16(kf, qf[ks], S[nt]); }
                mx = fmaxf(mx, fmaxf(fmaxf(S[nt][0], S[nt][1]), fmaxf(S[nt][2], S[nt][3]))); }
            mx = xmax4(mx); float sum = 0.f;
#pragma unroll
            for (int nt = 0; nt < 16; ++nt)
#pragma unroll
                for (int jj = 0; jj < 4; ++jj) { const float e = ex2(S[nt][jj] - mx); S[nt][jj] = e; sum += e; }
            sum = xsum4(sum); const float inv = 1.0f / sum;
            f32x4_t o[4];
#pragma unroll
            for (int dt = 0; dt < 4; ++dt) o[dt] = (f32x4_t){0.f, 0.f, 0.f, 0.f};
#pragma unroll
            for (int c2 = 0; c2 < 8; ++c2) { const bf16x8_t pf = pack8(S[2 * c2], S[2 * c2 + 1]);
#pragma unroll
                for (int dt = 0; dt < 4; ++dt) { const LAS unsigned char* vp = Vm + (32 * c2 + 4 * fg + (fr >> 2)) * KROW + (16 * dt + 4 * (fr & 3)) * 2; o[dt] = mfma16(ldtr2(vp, vp + 16 * KROW), pf, o[dt]); } }
            bf16_t* orow = CATB + row * DM + 768 + hh * 64;
#pragma unroll
            for (int dt = 0; dt < 4; ++dt) { const f32x4_t v = o[dt] * inv; *(uint2*)(orow + 16 * dt + 4 * fg) = make_uint2(cvtpk(v[0], v[1]), cvtpk(v[2], v[3])); }
        }
    }
}
__device__ __forceinline__ void ph_mem_attn_sample(const Params& p, int l, LAS unsigned char* lds, int j0, int jcnt, int jstep) {
    const int tid = ltid(), lane = tid & 63, w = tid >> 6;
    const int ldp = l < 2 ? LDA_ : LDB_, qoff = l < 2 ? 3072 : 768;
    const bf16_t* P16 = (const bf16_t*)(p.ws + B_P16); bf16_t* CATB = (bf16_t*)(p.ws + B_CATB); const float* gq = p.in[I_GMEMQ] + l * 64;
    LAS float* qs = (LAS float*)(lds + w * 2048);
    LAS float* ps = qs + 64;
    __syncthreads();
    for (int ji = 0; ji < jcnt; ++ji) { const int item = (j0 + ji * jstep) * NW_ + w; if (item >= BS * 4) break;
        const int hh = item & 3, b = item >> 2; const size_t row = (size_t)MP + b;
        const float* kv = p.in[I_CMEM] + (size_t)(l * 128 + b) * 256 * 512 + hh * 64;
        { const float v = bf2f(P16[row * ldp + qoff + hh * 64 + lane]); const float ss = wave_sum(v * v); qs[lane] = v * rsqrtf(ss * (1.0f / 64) + EPS) * gq[lane] * (0.125f * LOG2E); }
        asm volatile("s_waitcnt lgkmcnt(0)" ::: "memory");
        float sc[4] = {0.f, 0.f, 0.f, 0.f};
#pragma unroll 4
        for (int d4 = 0; d4 < 16; ++d4) { const f32x4_t q4 = *(const LAS f32x4_t*)(qs + 4 * d4);
#pragma unroll
            for (int k = 0; k < 4; ++k) { const f32x4_t k4 = *(const f32x4_t*)(kv + (size_t)(lane + 64 * k) * 512 + 4 * d4); sc[k] += (q4[0] * k4[0] + q4[1] * k4[1]) + (q4[2] * k4[2] + q4[3] * k4[3]); } }
        float mx = wave_max(fmaxf(fmaxf(sc[0], sc[1]), fmaxf(sc[2], sc[3]))); float sum = 0.f;
#pragma unroll
        for (int k = 0; k < 4; ++k) { sc[k] = ex2(sc[k] - mx); sum += sc[k]; ps[lane + 64 * k] = sc[k]; }
        sum = wave_sum(sum);
        asm volatile("s_waitcnt lgkmcnt(0)" ::: "memory");
        { const int kg = lane >> 4, c4 = lane & 15; f32x4_t o4 = (f32x4_t){0.f, 0.f, 0.f, 0.f};
#pragma unroll 1
          for (int m0 = 0; m0 < 64; m0 += 16) { f32x4_t v[16];
#pragma unroll
              for (int i = 0; i < 16; ++i) v[i] = *(const f32x4_t*)(kv + (size_t)(4 * (m0 + i) + kg) * 512 + 256 + 4 * c4);
#pragma unroll
              for (int i = 0; i < 16; ++i) o4 = o4 + v[i] * ps[4 * (m0 + i) + kg]; }
#pragma unroll
          for (int jx = 0; jx < 4; ++jx) o4[jx] = xsum4(o4[jx]);
          if (kg == 0) { const float inv = 1.0f / sum; *(uint2*)(CATB + row * DM + 768 + hh * 64 + 4 * c4) = make_uint2(cvtpk(o4[0] * inv, o4[1] * inv), cvtpk(o4[2] * inv, o4[3] * inv)); } }
        asm volatile("s_waitcnt lgkmcnt(0)" ::: "memory");
    }
}
__device__ __forceinline__ void ph_nsa_sample(const Params& p, int j, LAS unsigned char* ldsb) {
    const int tid0 = ltid();
    float* lds = (float*)ldsb;
    float* qs = lds;
    float* sc = lds + 384;
    float* imp = sc + 3072;
    int* sel = (int*)(imp + 40);
    float* gate = (float*)(sel + 8);
    float* oacc = gate + 24;
    const float** kptr = (const float**)(oacc + 384);
    float* part = (float*)(kptr + 512);
    float* tbl = part + 32 * 384;
    int* pts = (int*)(tbl + 192);
    const bf16_t* P = (const bf16_t*)(p.ws + B_P16); const float* GT = (const float*)(p.ws + B_GT); const float* KVR = (const float*)(p.ws + B_KVR); bf16_t* CATB = (bf16_t*)(p.ws + B_CATB);
    const float* table = p.in[I_REL]; const int* pt = (const int*)p.in[I_PT];
    for (int item = blockIdx.x; item < BS * 2; item += gridDim.x) {
        int t_l = tid0; asm volatile("" : "+v"(t_l)); const int tid = t_l, lane = tid & 63, wid = tid >> 6;
        int pos_l = PAST; asm volatile("" : "+s"(pos_l)); const int pos = pos_l;
        const int b = item >> 1, g = item & 1, row = MP + b;
        const bf16_t* pr = P + (size_t)row * LDB_;
        __syncthreads();
        if (wid < 6) { const int z = wid; const float v = bf2f(pr[(g * 6 + z) * 64 + lane]); const float ss = wave_sum(v * v); qs[z * 64 + lane] = v * rsqrtf(ss * (1.0f / 64) + EPS) * p.in[I_GQ][j * 64 + lane]; }
        if (tid >= 384 && tid < 384 + 18) { const int t2 = tid - 384; const int br = t2 / 6, z = t2 % 6; gate[t2] = sigmoidf_(GT[(size_t)row * GTW + br * 12 + g * 6 + z] + p.in[I_BGATE][j * 36 + br * 12 + g * 6 + z]); }
        if (tid < 384) oacc[tid] = 0.f;
        if (tid >= 416 && tid < 432) pts[tid - 416] = pt[b * 16 + (tid - 416)];
        if (tid >= 192 && tid < 384) { const int i = tid - 192; tbl[i] = table[(i / 6) * 12 + g * 6 + (i % 6)]; }
        __syncthreads();
        const float* ck = (const float*)(p.ws + B_CK) + (size_t)(8 + b) * 127 * 128; const float* cv = (const float*)(p.ws + B_CV) + (size_t)(8 + b) * 127 * 128;
        for (int i = tid; i < 6 * 127; i += NT_) {
            const int z = i / 127, n = i % 127; const int dist = pos - (16 * n + 31);
            const float4* kp = (const float4*)(ck + n * 128 + g * 64); const float4* qp = (const float4*)(qs + z * 64); float a = 0.f;
#pragma unroll 8
            for (int d = 0; d < 16; ++d) a += dot4(kp[d], qp[d]);
            sc[z * 128 + n] = a * 0.125f + tbl[rel_bucket_alu(dist) * 6 + z];
        }
        __syncthreads();
        if (wid < 6) row_softmax(sc + wid * 128, 127, lane);
        __syncthreads();
        const int cur = pos >> 6;
        if (tid < 33) { const int jb = tid; float s = 0.f;
            for (int z = 0; z < 6; ++z) { const float* pz = sc + z * 128;
                if (jb < 32) { s += 2.0f * (pz[4 * jb] + pz[4 * jb + 1] + pz[4 * jb + 2]); if (4 * jb + 3 < 127) s += pz[4 * jb + 3]; }
                if (jb >= 1 && jb < 32) s += pz[4 * jb - 1]; }
            imp[jb] = s; }
        __syncthreads();
        if (tid == 0) { sel[0] = 0; sel[1] = cur; sel[2] = cur - 1; }
        if (tid >= 1 && tid <= cur - 2) { const float mine = imp[tid]; int rank = 0;
            for (int j2 = 1; j2 <= cur - 2; ++j2) { const float o = imp[j2]; rank += (o > mine || (o == mine && j2 < tid)) ? 1 : 0; }
            if (rank < 5) sel[3 + rank] = tid; }
        { const int kg = tid >> 4, c4 = tid & 15; f32x4_t v[4]; f32x4_t acc[6];
#pragma unroll
          for (int i = 0; i < 4; ++i) { const int n = kg + 32 * i; v[i] = *(const f32x4_t*)(cv + (n < 127 ? n : 126) * 128 + g * 64 + 4 * c4); }
#pragma unroll
          for (int z = 0; z < 6; ++z) { acc[z] = (f32x4_t){0.f, 0.f, 0.f, 0.f};
#pragma unroll
              for (int i = 0; i < 4; ++i) { const int n = kg + 32 * i; if (n < 127) acc[z] = acc[z] + v[i] * sc[z * 128 + n]; } }
#pragma unroll
          for (int z = 0; z < 6; ++z) *(f32x4_t*)(part + kg * 384 + z * 64 + 4 * c4) = acc[z]; }
        __syncthreads();
        if (tid < 384) { float o = 0.f;
#pragma unroll 8
            for (int kg = 0; kg < 32; ++kg) o += part[kg * 384 + tid];
            oacc[tid] += gate[0 * 6 + (tid >> 6)] * o; }
        __syncthreads();
#pragma unroll 1
        for (int br = 1; br <= 2; ++br) {
            int t_b = tid0; asm volatile("" : "+v"(t_b)); const int tid = t_b, lane = tid & 63, wid = tid >> 6;
            { const int t = tid; const float* kp = nullptr; int dist = -1;
                if (br == 1) { const int blk = sel[t >> 6];
                    if (blk >= 0) { const int tok = blk * 64 + (t & 63); dist = pos - tok;
                        if (dist >= 0) kp = tok < PAST ? p.in[I_CSLC] + ((size_t)pts[tok >> 7] * 128 + (tok & 127)) * 256 + g * 64 : KVR + (size_t)row * 768 + 256 + g * 64; }
                } else { const int kpos = pos - 511 + t; dist = 511 - t;
                    kp = kpos < PAST ? p.in[I_CWIN] + ((size_t)b * 512 + (kpos - (PAST - 512))) * 256 + g * 64 : KVR + (size_t)row * 768 + 512 + g * 64; }
                if (dist >= 0 && kp) {
                    float s[6] = {0.f, 0.f, 0.f, 0.f, 0.f, 0.f};
#pragma unroll 1
                    for (int dc = 0; dc < 2; ++dc) { f32x4_t kk[8];
#pragma unroll
                        for (int d = 0; d < 8; ++d) kk[d] = ((const f32x4_t*)kp)[8 * dc + d];
#pragma unroll
                        for (int d = 0; d < 8; ++d) {
#pragma unroll
                            for (int z = 0; z < 6; ++z) { const f32x4_t q4 = *(const f32x4_t*)(qs + z * 64 + 32 * dc + 4 * d); s[z] += (kk[d][0] * q4[0] + kk[d][1] * q4[1]) + (kk[d][2] * q4[2] + kk[d][3] * q4[3]); }
                            asm volatile("" ::: "memory"); } }
                    const int bk = rel_bucket_alu(dist);
#pragma unroll
                    for (int z = 0; z < 6; ++z) sc[z * 512 + t] = s[z] * 0.125f + tbl[bk * 6 + z];
                    kptr[t] = kp;
                } else {
#pragma unroll
                    for (int z = 0; z < 6; ++z) sc[z * 512 + t] = NEGM;
                    kptr[t] = KVR;
                }
            }
            __syncthreads();
            if (wid < 6) row_softmax(sc + wid * 512, 512, lane);
            __syncthreads();
            {
                const int kg = tid >> 4, c4 = tid & 15; f32x4_t acc[6];
#pragma unroll
                for (int z = 0; z < 6; ++z) acc[z] = (f32x4_t){0.f, 0.f, 0.f, 0.f};
#pragma unroll 1
                for (int i0 = 0; i0 < 16; i0 += 8) { f32x4_t v[8];
#pragma unroll
                    for (int i = 0; i < 8; ++i) v[i] = *(const f32x4_t*)(kptr[kg + 32 * (i0 + i)] + 128 + 4 * c4);
#pragma unroll
                    for (int i = 0; i < 8; ++i)
#pragma unroll
                        for (int z = 0; z < 6; ++z) acc[z] = acc[z] + v[i] * sc[z * 512 + kg + 32 * (i0 + i)]; }
#pragma unroll
                for (int z = 0; z < 6; ++z) *(f32x4_t*)(part + kg * 384 + z * 64 + 4 * c4) = acc[z];
            }
            __syncthreads();
            if (tid < 384) { float o = 0.f;
#pragma unroll 8
                for (int kg = 0; kg < 32; ++kg) o += part[kg * 384 + tid];
                oacc[tid] += gate[br * 6 + (tid >> 6)] * o; }
            __syncthreads();
        }
        if (tid < 384) CATB[(size_t)row * DM + g * 384 + tid] = (bf16_t)f2bf(oacc[tid]);
    }
}
__device__ __forceinline__ void ph_mlstm_sample_fast(const Params& p, int l, LAS unsigned char* ldsb) {
    const int tid = ltid(), lane = tid & 63, w = tid >> 6;
    float* lds = (float*)ldsb;
    float* qs = lds; float* ks = lds + 192; float* n1 = lds + 384; float* part = lds + 576;
    float* scal = part + 8 * 192;
    const bf16_t* P = (const bf16_t*)(p.ws + B_P16); const float* GT = (const float*)(p.ws + B_GT); const float* bif = p.in[I_BIF] + l * 8; float* HR = (float*)(p.ws + B_HRAW);
    for (int item = blockIdx.x; item < BS * 4; item += gridDim.x) {
        const int h = item & 3, b = item >> 2; const size_t row = (size_t)MP + b;
        const bf16_t* pr = P + row * LDA_; const float* gr = GT + row * GTW;
        const size_t sidx = (size_t)(l * 128 + b) * 4 + h;
        const float ig = gr[h] + bif[h], fg_ = gr[4 + h] + bif[4 + h];
        const float m0 = p.in[I_SM][sidx];
        const float logf = logsigmoidf_(fg_);
        const float m_new = fmaxf(logf + m0, ig);
        const float a = expf(logf + m0 - m_new), bb = expf(ig - m_new);
        __syncthreads();
        if (tid < 192) { const float q = bf2f(pr[h * 192 + tid]), k = bf2f(pr[768 + h * 192 + tid]); qs[tid] = q; ks[tid] = k;
            const float nn = a * p.in[I_SN][sidx * 192 + tid] + bb * k; n1[tid] = nn; p.out[O_SN + sidx * 192 + tid] = nn; }
        __syncthreads();
        if (w == 0) { float s = qs[lane] * n1[lane] + qs[lane + 64] * n1[lane + 64] + qs[lane + 128] * n1[lane + 128]; s = wave_sum(s); if (lane == 0) scal[0] = s; }
        const float* C0 = p.in[I_SC] + sidx * 192 * 192; float* C1 = p.out + O_SC + sidx * 192 * 192;
        float ve[3], num[3] = {0.f, 0.f, 0.f};
#pragma unroll
        for (int i = 0; i < 3; ++i) ve[i] = bf2f(pr[1536 + h * 192 + lane + 64 * i]) * bb;
#pragma unroll 1
        for (int d0 = 24 * w; d0 < 24 * w + 24; d0 += 12) {
            float c[12][3];
#pragma unroll
            for (int r = 0; r < 12; ++r)
#pragma unroll
                for (int i = 0; i < 3; ++i) c[r][i] = C0[(size_t)(d0 + r) * 192 + lane + 64 * i];
#pragma unroll
            for (int r = 0; r < 12; ++r) { const float kd = ks[d0 + r], qd = qs[d0 + r];
#pragma unroll
                for (int i = 0; i < 3; ++i) { const float cn = a * c[r][i] + kd * ve[i]; C1[(size_t)(d0 + r) * 192 + lane + 64 * i] = cn; num[i] = fmaf(qd, cn, num[i]); } }
        }
#pragma unroll
        for (int i = 0; i < 3; ++i) part[w * 192 + lane + 64 * i] = num[i];
        __syncthreads();
        if (tid < 192) { float s = 0.f;
#pragma unroll
            for (int ww = 0; ww < 8; ++ww) s += part[ww * 192 + tid];
            HR[row * 768 + h * 192 + tid] = s / fmaxf(fabsf(scal[0]), expf(-m_new)); }
        if (tid == 0) p.out[O_SM + sidx] = m_new;
    }
}
constexpr int RING_BYTES = 131072, MISC_OFF = RING_BYTES + 320, LDS_BYTES = 147456;
typedef float f32x4_ __attribute__((ext_vector_type(4)));

#define STRIP_JOBS(njobs) for (int job = (int)gridDim.x - 1 - (int)blockIdx.x; job < (njobs); job += (int)gridDim.x)
__device__ __forceinline__ void strips_inproj(const Params& p, int l, LAS unsigned char* lds) {
    unsigned char* ws = p.ws; const bf16_t* XB = (const bf16_t*)(ws + B_XB); bf16_t* P16 = (bf16_t*)(ws + B_P16); float* GT = (float*)(ws + B_GT);
    const float* ssq = (const float*)(ws + B_SSQ) + (size_t)(2 * l) * SSQS;
    const bool ka = l < 2; const int ldp = ka ? LDA_ : LDB_, nmain = ka ? 104 * 4 : 32 * 4;
    const bf16_t* Bt = ka ? (const bf16_t*)(ws + B_BTA) + (size_t)l * NBTA * DM : (const bf16_t*)(ws + B_BTB) + (size_t)(l - 2) * NBTB * DM;
    const int tid_ = ltid(); const int lane = tid_ & 63, wave = tid_ >> 6, fr = lane & 15, fq = lane >> 4;
    STRIP_JOBS(nmain + 516) {
        if (job < nmain) {
            const int st = job >> 2, r0 = MP + (job & 3) * 32;
            const int brow[2] = {st * 32, st * 32 + 16}; StripAcc<2> R; strip_gemm<2>(XB, DM, r0, Bt, brow, R, lds);
            if (wave < 2) { const int row = r0 + wave * 16 + fr; const float rs = rstd_of(ssq[row]);
#pragma unroll
                for (int t = 0; t < 2; ++t) { const f32x4_ v = R.a[t] * rs; *(uint2*)(P16 + (size_t)row * ldp + st * 32 + t * 16 + 4 * fq) = make_uint2(pk2(v[0], v[1]), pk2(v[2], v[3])); } }
        } else {
            const int r0 = (job - nmain) * 32, row = r0 + wave * 16 + fr;
            if (ka) { const int brow[1] = {3328}; StripAcc<1> R; strip_gemm<1>(XB, DM, r0, Bt, brow, R, lds); if (wave < 2) *(f32x4_*)(GT + (size_t)row * GTW + 4 * fq) = R.a[0] * rstd_of(ssq[row]); }
            else { const int brow[3] = {1024, 1040, 1056}; StripAcc<3> R; strip_gemm<3>(XB, DM, r0, Bt, brow, R, lds);
                if (wave < 2) { const float rs = rstd_of(ssq[row]);
#pragma unroll
                    for (int t = 0; t < 3; ++t) *(f32x4_*)(GT + (size_t)row * GTW + t * 16 + 4 * fq) = R.a[t] * rs; } }
        }
    }
}
__device__ __forceinline__ void strips_resid(const Params& p, const bf16_t* A, int K, const bf16_t* Bt, float* ssq, float* Y, LAS unsigned char* lds) {
    bf16_t* XB = (bf16_t*)(p.ws + B_XB);
    const int tid_ = ltid(); const int lane = tid_ & 63, wave = tid_ >> 6, fr = lane & 15, fq = lane >> 4;
    STRIP_JOBS(256) {
        const int st = job >> 2, r0 = MP + (job & 3) * 32;
        const int brow[1] = {st * 16}; StripAcc<1> R; strip_gemm<1>(A, K, r0, Bt, brow, R, lds);
        if (wave < 2) { const int row = r0 + wave * 16 + fr; bf16_t* bp = XB + (size_t)row * DM + st * 16 + 4 * fq; const uint2 o = *(const uint2*)bp;
            const f32x4_ x = (f32x4_){bflo(o.x), bfhi(o.x), bflo(o.y), bfhi(o.y)} + R.a[0];
            *(uint2*)bp = make_uint2(pk2(x[0], x[1]), pk2(x[2], x[3]));
            if (Y) *(f32x4_*)(Y + (size_t)row * DM + st * 16 + 4 * fq) = x;
            float ss = (x[0] * x[0] + x[1] * x[1]) + (x[2] * x[2] + x[3] * x[3]); ss += __shfl_xor(ss, 16); ss += __shfl_xor(ss, 32);
            if (fq == 0) (void)__hip_atomic_fetch_add(ssq + row, ss, __ATOMIC_RELAXED, __HIP_MEMORY_SCOPE_AGENT); }
    }
}
__device__ __forceinline__ void strips_gu(const Params& p, int l, LAS unsigned char* lds) {
    unsigned char* ws = p.ws; const bf16_t* XB = (const bf16_t*)(ws + B_XB); bf16_t* HID = (bf16_t*)(ws + B_HID);
    const float* ssq = (const float*)(ws + B_SSQ) + (size_t)(2 * l + 1) * SSQS; const bf16_t* Bt = (const bf16_t*)(ws + B_BTG) + (size_t)l * 2 * DFF * DM;
    const int tid_ = ltid(); const int lane = tid_ & 63, wave = tid_ >> 6, fr = lane & 15, fq = lane >> 4;
    STRIP_JOBS(176 * 4) {
        const int st = job >> 2, r0 = MP + (job & 3) * 32;
        const int brow[2] = {(st >> 3) * 256 + (st & 7) * 16, (st >> 3) * 256 + 128 + (st & 7) * 16}; StripAcc<2> R; strip_gemm<2>(XB, DM, r0, Bt, brow, R, lds);
        if (wave < 2) { const int row = r0 + wave * 16 + fr; const float rs = rstd_of(ssq[row]); float h[4];
#pragma unroll
            for (int j = 0; j < 4; ++j) { const float g = R.a[0][j] * rs, up = R.a[1][j] * rs; h[j] = g * pg8::fast_sigmoid(g) * up; }
            *(uint2*)(HID + (size_t)row * DFF + st * 16 + 4 * fq) = make_uint2(pk2(h[0], h[1]), pk2(h[2], h[3])); }
    }
}
__device__ __forceinline__ void strips_kv(const Params& p, LAS unsigned char* lds) {
    unsigned char* ws = p.ws; const bf16_t* XB = (const bf16_t*)(ws + B_XB); float* KVR = (float*)(ws + B_KVR);
    const float* ssq = (const float*)(ws + B_SSQ) + (size_t)4 * SSQS; const bf16_t* Bt = (const bf16_t*)(ws + B_BTK);
    const int tid_ = ltid(); const int lane = tid_ & 63, wave = tid_ >> 6, fr = lane & 15, fq = lane >> 4;
    STRIP_JOBS(48 * 4) {
        const int st = job >> 2, r0 = MP + (job & 3) * 32;
        const int brow[1] = {st * 16}; StripAcc<1> R; strip_gemm<1>(XB, DM, r0, Bt, brow, R, lds);
        if (wave < 2) { const int row = r0 + wave * 16 + fr; *(f32x4_*)(KVR + (size_t)row * 768 + st * 16 + 4 * fq) = R.a[0] * rstd_of(ssq[row]); }
    }
}

#ifndef COMPRESS_NAIVE
#define COMPRESS_NAIVE 0
#endif
#ifndef MLSTM_NAIVE
#define MLSTM_NAIVE 0
#endif
#ifndef MEMATT_NAIVE
#define MEMATT_NAIVE 0
#endif
#ifndef SAMPLE_ML_NAIVE
#define SAMPLE_ML_NAIVE 0
#endif
#ifndef SAMPLE_NSA_NAIVE
#define SAMPLE_NSA_NAIVE 0
#endif
#ifndef MK_MULTI
#define MK_MULTI 0
#endif
constexpr int PL = 9, NPH = 1 + 4 * PL;
__host__ __device__ constexpr bool phase_nonempty(int ph) {
    if (ph == 0) return true;
    const int l = (ph - 1) / PL, r = (ph - 1) % PL;
    if (r == 2) return l < 2;
    if (r == 7) return false;
    if (r >= 6) return l == 1;
    return true;
}
#ifndef TIME_MASK
#define TIME_MASK 0
#endif
__host__ __device__ constexpr int phase_group(int ph) { if (ph == 0) return 0; const int l = (ph - 1) / PL, r = (ph - 1) % PL; return r == 0 ? 1 : r == 1 ? (l < 2 ? 2 : 4) : r == 2 ? 3 : r == 3 ? 5 : r == 4 ? 6 : r == 5 ? 7 : r == 6 ? 8 : r == 7 ? 9 : 10; }
__global__ void __launch_bounds__(NT_, 2) fwd(Params p) {
    extern __shared__ __attribute__((aligned(16))) unsigned char lds_raw[];
    LAS unsigned char* lds = (LAS unsigned char*)lds_raw;
    float* ldsf = (float*)lds_raw;
    volatile LAS unsigned* MISC = (volatile LAS unsigned*)(lds + MISC_OFF);
    for (int u = threadIdx.x; u < (LDS_BYTES - RING_BYTES) / 4; u += NT_) ((LAS unsigned*)(lds + RING_BYTES))[u] = 0u;
    __syncthreads();
    unsigned char* ws = p.ws;
    XcdBarrier bar; bar.bar = (unsigned*)ws; bar.x = 0; bar.st = MISC + 8;
    const bool single = (p.ph_hi - p.ph_lo) > 1;
    if (single) bar = xcd_barrier_post((unsigned*)ws, MISC + 8);
    bf16_t* XB = (bf16_t*)(ws + B_XB); bf16_t* P16 = (bf16_t*)(ws + B_P16); bf16_t* CATB = (bf16_t*)(ws + B_CATB); bf16_t* HID = (bf16_t*)(ws + B_HID);
    float* SSQ = (float*)(ws + B_SSQ);
    const int G = gridDim.x, c = blockIdx.x;
    if (TIME_SUB && blockIdx.x == TSUB_BLK && threadIdx.x == 0) { for (int i = 0; i < 8; ++i) g_tsub[i] = 0ull; }
    int ph = 0; volatile LAS unsigned long long* TMR = (volatile LAS unsigned long long*)(lds + MISC_OFF + 64);
    if ((TIME_MASK || TIME_SUB) && blockIdx.x == 0 && threadIdx.x == 0) { TMR[0] = 0ull; TMR[1] = __builtin_amdgcn_s_memrealtime(); }
#define ON() (ph >= p.ph_lo && ph < p.ph_hi)
#define NEXT() do { const bool ne_ = phase_nonempty(ph); const int grp_ = phase_group(ph); ++ph; if (ne_ && ph > p.ph_lo && ph < p.ph_hi) xcd_barrier(bar); \
        if (TIME_MASK && blockIdx.x == 0 && threadIdx.x == 0) { const unsigned long long now_ = __builtin_amdgcn_s_memrealtime(); if ((TIME_MASK >> grp_) & 1) TMR[0] = TMR[0] + (now_ - TMR[1]); TMR[1] = now_; } } while (0)
#ifndef NO_PRO
    if (ON()) ph_prologue(p, lds);
#endif
    NEXT();
    for (int l = 0; l < 4; ++l) {
        if (ON()) {
            if (l == 0) { pg8::Gemm g{(const bf16_t*)(ws + B_MPB), (const bf16_t*)(ws + B_BTM), 2048, 2048, DM}; pg8::StaticOrder S; S.init(2048, 2048, G, c);
                pg8::EpiF32 E{(float*)(ws + B_MEMR), 512, nullptr, 512, (size_t)2048 * 512};
                pg8::gemm_phase<pg8::EpiF32, pg8::StaticOrder, true, true>(lds, g, S, E); }
            if (l < 2) { pg8::Gemm g{XB, (const bf16_t*)(ws + B_BTA) + (size_t)l * NBTA * DM, MAP, LDA_ + 256, DM}; pg8::StaticOrder S; S.init(MAP, LDA_ + 256, G, l == 0 ? (c + 192) % G : c);
                pg8::EpiBf16S E{P16, LDA_, SSQ + (size_t)(2 * l) * SSQS, 13, (float*)(ws + B_GT)};
                pg8::gemm_phase<pg8::EpiBf16S, pg8::StaticOrder, true, true>(lds, g, S, E); }
            else { pg8::Gemm g{XB, (const bf16_t*)(ws + B_BTB) + (size_t)(l - 2) * NBTB * DM, MP, LDB_, DM}; pg8::StaticOrder S; S.init(MP, LDB_, G, c);
                pg8::EpiBf16S E{P16, LDB_, SSQ + (size_t)(2 * l) * SSQS, -1, nullptr};
                pg8::gemm_phase<pg8::EpiBf16S, pg8::StaticOrder, true, true>(lds, g, S, E);
#ifndef NO_STRIPS
                strips_inproj(p, l, lds);
#endif
            }
        }
        NEXT();
#ifndef NO_NAIVE
        if (ON()) {
            if (l < 2) { if (MLSTM_NAIVE) ph_mlstm_prompt(p, l, ldsf); else ph_mlstm_fast(p, l, lds); if (G == 256) { if (c >= 192) { ph_mem_attn_fast(p, l, lds, c - 192, 4, 64); ph_mem_attn_sample(p, l, lds, c - 192, 1, 64); if (l == 1) ph_swin_copy(p, 192, 64); } }
                else { ph_mem_attn_fast(p, l, lds, c, (256 - c + G - 1) / G, G); if (c < 64) ph_mem_attn_sample(p, l, lds, c, (64 - c + G - 1) / G, G); if (l == 1) ph_swin_copy(p, 0, G); }      if (SAMPLE_ML_NAIVE) ph_mlstm_sample(p, l, ldsf); else ph_mlstm_sample_fast(p, l, lds); }
            else { if (!NSA_NAIVE_ALL) ph_nsa_fast(p, l - 2, lds); { TSUB_BEGIN(); if (SAMPLE_NSA_NAIVE) ph_nsa(p, l - 2, ldsf); else ph_nsa_sample(p, l - 2, lds); TSUB_END(4); } TSUB_BEGIN(); if (MEMATT_NAIVE) ph_mem_attn(p, l); else if (G == 256) { if (c < 16) { ph_mem_attn_fast(p, l, lds, 8 * c, 8, 1); ph_mem_attn_sample(p, l, lds, 2 * c, 2, 1); } else if (c < 32) { ph_mem_attn_fast(p, l, lds, 128 + 5 * (c - 16), 5, 1); ph_mem_attn_sample(p, l, lds, 2 * c, 2, 1); } else if (c < 48) ph_mem_attn_fast(p, l, lds, 208 + 3 * (c - 32), 3, 1); }
                else { ph_mem_attn_fast(p, l, lds, c, (256 - c + G - 1) / G, G); if (c < 64) ph_mem_attn_sample(p, l, lds, c, (64 - c + G - 1) / G, G); } TSUB_END(5); }
        }
#endif
        NEXT();
#ifndef NO_NAIVE
        if (ON()) { if (l < 2) { ph_mlstm_fin(p, l); if (l == 0) ph_memk_norm(p); } }
#endif
        NEXT();
        if (ON()) {
            const bf16_t* Bt = (const bf16_t*)(ws + B_BTO) + (size_t)l * DM * DM; float* sq = SSQ + (size_t)(2 * l + 1) * SSQS;
            pg8::Gemm g{CATB, Bt, MP, DM, DM}; pg8::StaticOrder S; S.init(MP, DM, G, c); pg8::EpiResid E{nullptr, XB, sq};
            pg8::gemm_phase<pg8::EpiResid, pg8::StaticOrder, true, true>(lds, g, S, E);
#ifndef NO_STRIPS
            strips_resid(p, CATB, DM, Bt, sq, nullptr, lds);
#endif
        }
        NEXT();
        if (ON()) {
            pg8::Gemm g{XB, (const bf16_t*)(ws + B_BTG) + (size_t)l * 2 * DFF * DM, MAP, 2 * DFF, DM}; pg8::StaticOrder S; S.init(MAP, 2 * DFF, G, c); pg8::EpiSwiglu E{HID, SSQ + (size_t)(2 * l + 1) * SSQS};
            pg8::gemm_phase<pg8::EpiSwiglu, pg8::StaticOrder, true, true>(lds, g, S, E);
        }
        NEXT();
        if (ON()) {
            const bf16_t* Bt = (const bf16_t*)(ws + B_BTD) + (size_t)l * DM * DFF; float* sq = SSQ + (size_t)(2 * l + 2) * SSQS;
            pg8::Gemm g{HID, Bt, MP, DM, DFF}; pg8::StaticOrder S; S.init(MP, DM, G, c); float* Yo = l == 3 ? p.out : nullptr; pg8::EpiResid E{Yo, XB, sq};
            pg8::gemm_phase<pg8::EpiResid, pg8::StaticOrder, true, true>(lds, g, S, E);
#ifndef NO_STRIPS
            strips_resid(p, HID, DFF, Bt, sq, Yo, lds);
#endif
        }
        NEXT();
        if (ON()) { if (l == 1) {
            pg8::Gemm g{XB, (const bf16_t*)(ws + B_BTK), MAP, 768, DM}; pg8::StaticOrder S; S.init(MAP, 768, G, c); pg8::EpiF32 E{(float*)(ws + B_KVR), 768, SSQ + (size_t)4 * SSQS, 0, 0};
            pg8::gemm_phase<pg8::EpiF32, pg8::StaticOrder, true, true>(lds, g, S, E);
            asm volatile("s_waitcnt vmcnt(0)" ::: "memory"); __syncthreads();
            if (c < 195) {
                constexpr int nM = MAP / 256, nN = 3, nwg = nM * nN, q = nwg / 8, rr = nwg % 8; const int xcd = c % 8, off = c / 8;
                const int wgid = (xcd < rr ? xcd * (q + 1) : rr * (q + 1) + (xcd - rr) * q) + off; constexpr int nig = 8 * nN; const int gid = wgid / nig, fm = gid * 8, gsz = (nM - fm) < 8 ? (nM - fm) : 8;
                rows_post_tile(p, (fm + ((wgid % nig) % gsz)) * 256, (wgid % nig) / gsz); }
            } }
        NEXT();
        NEXT();
#ifndef NO_NAIVE
        if (ON()) { if (l == 1) { if (COMPRESS_NAIVE) ph_compress(p, ldsf); else ph_compress_fast(p, lds); } }
#endif
        NEXT();
    }
    if (TIME_MASK || TIME_SUB) { if (blockIdx.x == 0 && threadIdx.x == 0) { const unsigned long long t_acc = TIME_SUB ? __hip_atomic_load(&g_tsub[TIME_SUB > 0 ? TIME_SUB - 1 : 0], __ATOMIC_RELAXED, __HIP_MEMORY_SCOPE_AGENT) : TMR[0]; const unsigned long long t0 = __builtin_amdgcn_s_memrealtime(); while (__builtin_amdgcn_s_memrealtime() - t0 < 10ull * t_acc) __builtin_amdgcn_s_sleep(8); } }
}

extern "C" void kernel_launch(void* const* d_in, const int* in_sizes, int n_in, void* d_out, int out_size, void* d_ws, size_t ws_size, hipStream_t stream) {
    static int grid = 0;
    if (!grid) {
        int dev = 0, cus = 0;
        (void)hipGetDevice(&dev); (void)hipDeviceGetAttribute(&cus, hipDeviceAttributeMultiprocessorCount, dev);
        if (cus < 1) cus = 256;
        if (hipFuncSetAttribute((const void*)fwd, hipFuncAttributeMaxDynamicSharedMemorySize, LDS_BYTES) != hipSuccess) fprintf(stderr, "kernel_launch: hipFuncSetAttribute failed\n");
        int per_cu = 0; (void)hipOccupancyMaxActiveBlocksPerMultiprocessor(&per_cu, (const void*)fwd, NT_, LDS_BYTES); (void)hipGetLastError();
        if (per_cu < 1) fprintf(stderr, "kernel_launch: occupancy query says %d\n", per_cu);
        grid = cus;
    }
    if (n_in != N_IN || (size_t)out_size != O_END || ws_size < B_END) fprintf(stderr, "kernel_launch: unexpected sizes n_in=%d out=%d ws=%zu need %zu\n", n_in, out_size, ws_size, (size_t)B_END);
    (void)hipMemsetAsync(d_ws, 0, CTL_BYTES, stream);
    Params p{};
    for (int i = 0; i < N_IN; ++i) p.in[i] = (const float*)d_in[i];
    p.out = (float*)d_out; p.ws = (unsigned char*)d_ws;
#if MK_MULTI
    for (int ph = 0; ph < NPH; ++ph) {
        if (!phase_nonempty(ph)) continue;
        p.ph_lo = ph; p.ph_hi = ph + 1;
        hipLaunchKernelGGL(fwd, dim3(grid), dim3(NT_), LDS_BYTES, stream, p);
    }
#else
    p.ph_lo = 0; p.ph_hi = NPH;
    hipLaunchKernelGGL(fwd, dim3(grid), dim3(NT_), LDS_BYTES, stream, p);
#endif
}

#ifdef REGTEST
__global__ void __launch_bounds__(NT_, 2) rt_nsa(Params p) { extern __shared__ __attribute__((aligned(16))) unsigned char l_[]; ph_nsa_fast(p, 0, (LAS unsigned char*)l_); }
__global__ void __launch_bounds__(NT_, 2) rt_mlstm(Params p) { extern __shared__ __attribute__((aligned(16))) unsigned char l_[]; ph_mlstm_fast(p, 0, (LAS unsigned char*)l_); }
__global__ void __launch_bounds__(NT_, 2) rt_nsas(Params p) { extern __shared__ __attribute__((aligned(16))) unsigned char l_[]; ph_nsa_sample(p, 0, (LAS unsigned char*)l_); }
__global__ void __launch_bounds__(NT_, 2) rt_mem(Params p) { extern __shared__ __attribute__((aligned(16))) unsigned char l_[]; ph_mem_attn_fast(p, 0, (LAS unsigned char*)l_, 0, 256, 1); }
__global__ void __launch_bounds__(NT_, 2) rt_cmp(Params p) { extern __shared__ __attribute__((aligned(16))) unsigned char l_[]; ph_compress_fast(p, (LAS unsigned char*)l_); }
#endif
```

```cpp
#include <hip/hip_runtime.h>
#include <cstdio>
#include <cstdint>

#define LAS __attribute__((address_space(3)))
#define GAS __attribute__((address_space(1)))
#define XB_TMO      128
#define XB_XCNT(j)  (256  + 64 * (j))
#define XB_XSUB(j)  (1280 + 64 * (j))
#define XB_XGEN(j)  (2304 + 64 * (j))
#define XB_TOP      3328
#define XB_TOPGEN   3392
#define XCD_BAR_WORDS 3456
#define XB_SPIN_CAP (1u << 23)
__device__ __forceinline__ unsigned xb_ld(unsigned* p)              { return __hip_atomic_load(p, __ATOMIC_RELAXED, __HIP_MEMORY_SCOPE_AGENT); }
__device__ __forceinline__ unsigned xb_add(unsigned* p, unsigned v) { return __hip_atomic_fetch_add(p, v, __ATOMIC_RELAXED, __HIP_MEMORY_SCOPE_AGENT); }
__device__ __forceinline__ unsigned xb_xcc_id() { return (unsigned)__builtin_amdgcn_s_getreg((3 << 11) | 20) & 0xFu; }
#define XB_SPIN(cond, bar) do { unsigned _sp = 0; while (cond) { __builtin_amdgcn_s_sleep(1); \
    if ((++_sp & 255u) == 0u) { if (xb_ld(&(bar)[XB_TMO])) break; if (_sp > XB_SPIN_CAP) { atomicAdd(&(bar)[XB_TMO], 1u); break; } } } } while (0)
struct XcdBarrier { unsigned* bar; unsigned x; volatile LAS unsigned* st; };
__device__ __forceinline__ XcdBarrier xcd_barrier_post(unsigned* bar, volatile LAS unsigned* st) {
    XcdBarrier b; b.bar = bar; b.x = xb_xcc_id(); b.st = st;
    if (threadIdx.x == 0) (void)xb_add(&bar[XB_XCNT(b.x)], 1u);
    return b;
}
__device__ __forceinline__ void xcd_barrier_complete(unsigned* bar, unsigned x, unsigned& nloc, unsigned& nx) {
    const unsigned G = gridDim.x * gridDim.y * gridDim.z;
    unsigned sum, cnt, mine, sp = 0u;
    for (;;) {
        sum = 0u; cnt = 0u; mine = 0u;
#pragma unroll
        for (unsigned j = 0; j < 16; ++j) { const unsigned c = xb_ld(&bar[XB_XCNT(j)]); sum += c; cnt += (c > 0u) ? 1u : 0u; mine = (j == x) ? c : mine; }
        if (sum == G) break;
        __builtin_amdgcn_s_sleep(1);
        if ((++sp & 255u) == 0u) { if (xb_ld(&bar[XB_TMO])) break; if (sp > XB_SPIN_CAP) { atomicAdd(&bar[XB_TMO], 1u); break; } }
    }
    nloc = mine > 0u ? mine : 1u; nx = cnt > 0u ? cnt : 1u;
}
__device__ __forceinline__ void xcd_barrier(const XcdBarrier& b) {
    asm volatile("s_waitcnt vmcnt(0)" ::: "memory");
    __syncthreads();
    if (threadIdx.x == 0) {
        unsigned* bar = b.bar;
        __builtin_amdgcn_s_waitcnt(0);
        unsigned nloc = b.st[0], nx = b.st[1];
        if (nloc == 0u) { xcd_barrier_complete(bar, b.x, nloc, nx); b.st[0] = nloc; b.st[1] = nx; }
        const unsigned old = xb_add(&bar[XB_XSUB(b.x)], 1u);
        const unsigned gen = old / nloc;
        if (old + 1u == (gen + 1u) * nloc) {
            __builtin_amdgcn_fence(__ATOMIC_RELEASE, "agent");
            asm volatile("s_waitcnt vmcnt(0)" ::: "memory");
            const unsigned og = xb_add(&bar[XB_TOP], 1u);
            const unsigned tg = og / nx;
            if (og + 1u == (tg + 1u) * nx) xb_add(&bar[XB_TOPGEN], 1u);
            else XB_SPIN(xb_ld(&bar[XB_TOPGEN]) == tg, bar);
            __builtin_amdgcn_fence(__ATOMIC_ACQUIRE, "agent");
            xb_add(&bar[XB_XGEN(b.x)], 1u);
            asm volatile("s_waitcnt vmcnt(0)" ::: "memory");
        } else {
            XB_SPIN(xb_ld(&bar[XB_XGEN(b.x)]) == gen, bar);
            __builtin_amdgcn_fence(__ATOMIC_ACQUIRE, "agent");
            asm volatile("s_waitcnt vmcnt(0)" ::: "memory");
        }
    }
    __syncthreads();
}

constexpr int NT_ = 512, NW_ = 8;
constexpr int DM = 1024, BP = 8, SP = 2048, MP = BP * SP, BS = 128, MA = MP + BS, MAP = MP + 256;
constexpr int ACOLS = 3336, BCOLS = 1060, DFF = 2816;
constexpr int LDA_ = 3328, LDB_ = 1024;
constexpr int NBTA = 3344, NBTB = 1072;
constexpr int PAST = 2048, GTW = 48;
constexpr float EPS = 1e-6f, NEGM = -1e30f;
typedef unsigned short bf16_t;

enum { I_XP = 0, I_XS, I_SC, I_SN, I_SM, I_CMEM, I_CCMP, I_CSLC, I_CWIN, I_PT, I_MEMP, I_GMIX, I_WINA, I_BIF, I_GHN, I_WINB, I_GQ, I_BGATE, I_REL,
       I_GKV, I_WKV, I_GKSLC, I_GKWIN, I_GKCMP, I_CPOS, I_CW1, I_CB1, I_CW2, I_CB2, I_WMEMKV, I_GMEMK, I_GMEMQ, I_WOUT, I_GFFN, I_WGU, I_WDOWN, N_IN };
constexpr size_t O_YP = 0, O_YS = O_YP + (size_t)MP * DM, O_PC = O_YS + (size_t)BS * DM, O_PN = O_PC + 2ull * 8 * 4 * 192 * 192, O_PM = O_PN + 2ull * 8 * 4 * 192,
    O_PMEM = O_PM + 64, O_PCMP = O_PMEM + 4ull * 8 * 256 * 512, O_PSLC = O_PCMP + (size_t)MP * 256, O_PWIN = O_PSLC + (size_t)MP * 256, O_SC = O_PWIN + 8ull * 512 * 256,
    O_SN = O_SC + 2ull * 128 * 4 * 192 * 192, O_SM = O_SN + 2ull * 128 * 4 * 192, O_SCMP = O_SM + 1024, O_SSLC = O_SCMP + 128 * 256, O_SWIN = O_SSLC + 128 * 256,
    O_END = O_SWIN + 128ull * 512 * 256;
static_assert(O_END == 87700544ull, "output size");
constexpr size_t CTL_BYTES = 2u << 20, B_SSQ = 65536;
constexpr size_t al256(size_t x) { return (x + 255) & ~(size_t)255; }
constexpr size_t B_XB = CTL_BYTES, B_P16 = al256(B_XB + (size_t)MAP * DM * 2), B_GT = al256(B_P16 + (size_t)MAP * LDA_ * 2), B_CATB = al256(B_GT + (size_t)MAP * GTW * 4),
    B_HID = al256(B_CATB + (size_t)MA * DM * 2), B_HRAW = al256(B_HID + (size_t)MAP * DFF * 2), B_KVR = al256(B_HRAW + (size_t)MA * 768 * 4), B_CK = al256(B_KVR + (size_t)MAP * 768 * 4),
    B_CV = al256(B_CK + 136ull * 127 * 128 * 4), B_MPB = al256(B_CV + 136ull * 127 * 128 * 4),
    B_BTA = al256(B_MPB + 2048ull * DM * 2), B_BTB = al256(B_BTA + 2ull * NBTA * DM * 2), B_BTO = al256(B_BTB + 2ull * NBTB * DM * 2), B_BTG = al256(B_BTO + 4ull * DM * DM * 2),
    B_BTD = al256(B_BTG + 4ull * 2 * DFF * DM * 2), B_BTK = al256(B_BTD + 4ull * DM * DFF * 2), B_BTM = al256(B_BTK + 768ull * DM * 2), B_KVB = al256(B_BTM + 2048ull * DM * 2), B_SKF = al256(B_KVB + 6ull * BP * 2 * SP * 64 * 2), B_SVF = al256(B_SKF + (size_t)BP * 2 * SP * 64 * 2), B_KC16 = al256(B_SVF + (size_t)BP * 2 * SP * 64 * 2),
    B_W1T = al256(B_KC16 + 136ull * 2 * 2 * 128 * 64 * 2), B_W2T = al256(B_W1T + 2ull * 128 * 2048 * 2), B_PEB = al256(B_W2T + 2ull * 64 * 128 * 2), B_MEMR = al256(B_PEB + 1024), B_CMPS = al256(B_MEMR + 4ull * 2048 * 512 * 4), B_END = al256(B_CMPS + (size_t)BS * 4 * SP * 64 * 2 + 8192);
constexpr int SSQS = MAP;
static_assert(9 * SSQS * 4 + B_SSQ <= CTL_BYTES, "ssq sites inside the control region");

#ifndef TIME_SUB
#define TIME_SUB 0
#endif
#ifndef TSUB_BLK
#define TSUB_BLK 10
#endif
__device__ unsigned long long g_tsub[8];
#define TSUB_BEGIN() unsigned long long tsub_t0_ = (TIME_SUB && blockIdx.x == TSUB_BLK && threadIdx.x == 0) ? __builtin_amdgcn_s_memrealtime() : 0ull
#define TSUB_END(k) do { if (TIME_SUB && blockIdx.x == TSUB_BLK && threadIdx.x == 0) { const unsigned long long n_ = __builtin_amdgcn_s_memrealtime(); g_tsub[k] += n_ - tsub_t0_; tsub_t0_ = n_; } } while (0)
struct Params { const float* in[N_IN]; float* out; unsigned char* ws; int ph_lo, ph_hi; };

__device__ const unsigned char REL_LUT[128] = {0, 1, 2, 3, 4, 5, 6, 7, 8, 9, 10, 11, 12, 13, 14, 15, 16, 16, 16, 17, 17, 18, 18, 18, 19, 19, 19, 20, 20, 20, 20, 21, 21, 21, 21, 22, 22, 22, 22, 22, 23, 23, 23, 23, 23, 23, 24, 24, 24, 24, 24, 24, 25, 25, 25, 25, 25, 25, 25, 26, 26, 26, 26, 26, 26, 26, 26, 27, 27, 27, 27, 27, 27, 27, 27, 27, 27, 28, 28, 28, 28, 28, 28, 28, 28, 28, 28, 29, 29, 29, 29, 29, 29, 29, 29, 29, 29, 29, 29, 30, 30, 30, 30, 30, 30, 30, 30, 30, 30, 30, 30, 30, 30, 31, 31, 31, 31, 31, 31, 31, 31, 31, 31, 31, 31, 31, 31, 31};
__device__ __forceinline__ int rel_bucket(int d) { return d >= 128 ? 31 : (int)REL_LUT[d < 0 ? 0 : d]; }
__device__ __forceinline__ int rel_bucket_alu(int d) { d = d < 0 ? 0 : d; if (d < 16) return d;
    return 16 + (d >= 19) + (d >= 21) + (d >= 24) + (d >= 27) + (d >= 31) + (d >= 35) + (d >= 40) + (d >= 46) + (d >= 52) + (d >= 59) + (d >= 67) + (d >= 77) + (d >= 87) + (d >= 99) + (d >= 113); }

__device__ __forceinline__ int opq(int i) { asm volatile("" : "+s"(i)); return i; }
#define BAR_LDS() do { asm volatile("s_waitcnt lgkmcnt(0)" ::: "memory"); __builtin_amdgcn_s_barrier(); asm volatile("" ::: "memory"); } while (0)
__device__ __forceinline__ int ltid() { int t = threadIdx.x; asm volatile("" : "+v"(t)); return t; }
__device__ __forceinline__ float wave_sum(float v) {
#pragma unroll
    for (int o = 32; o; o >>= 1) v += __shfl_xor(v, o);
    return v;
}
__device__ __forceinline__ float wave_max(float v) {
#pragma unroll
    for (int o = 32; o; o >>= 1) v = fmaxf(v, __shfl_xor(v, o));
    return v;
}
__device__ __forceinline__ float sigmoidf_(float x) { return 1.0f / (1.0f + expf(-x)); }
__device__ __forceinline__ float logsigmoidf_(float x) { return fminf(x, 0.f) - log1pf(expf(-fabsf(x))); }
__device__ __forceinline__ float dot4(float4 a, float4 b) { return a.x * b.x + a.y * b.y + a.z * b.z + a.w * b.w; }
__device__ __forceinline__ float bf2f(bf16_t u) { return __uint_as_float((unsigned)u << 16); }
__device__ __forceinline__ unsigned f2bf(float f) { unsigned u = __float_as_uint(f); return (u + 0x7fffu + ((u >> 16) & 1u)) >> 16; }
__device__ __forceinline__ unsigned pk2(float lo, float hi) { return f2bf(lo) | (f2bf(hi) << 16); }
__device__ __forceinline__ float bflo(unsigned w) { return __uint_as_float(w << 16); }
__device__ __forceinline__ float bfhi(unsigned w) { return __uint_as_float(w & 0xffff0000u); }
__device__ __forceinline__ float rstd_of(float ssq) { return rsqrtf(ssq * (1.0f / DM) + EPS); }

namespace pg8 {
#define PG8_LAS __attribute__((address_space(3)))
typedef unsigned short bf16_t;
typedef short bf16x8 __attribute__((ext_vector_type(8)));
typedef float f32x4 __attribute__((ext_vector_type(4)));
typedef unsigned u32x4 __attribute__((ext_vector_type(4)));
constexpr int BM = 256, BK = 64, HALF = 128, HTB = HALF * BK * 2  , STAGE_BYTES = 8 * HTB, NXCD = 8, WGM = 8;

__host__ __device__ __forceinline__ int lds_byte(int r, int c) { const int st = (r >> 4) * 2 + (c >> 5), rr = r & 15, cc = c & 31, ob = rr * 64 + cc * 2; return st * 1024 + (ob ^ (((ob >> 9) & 1) << 5)); }
__host__ __device__ __forceinline__ void stage_rc(int b, int& R, int& C) { const int st = b / 1024, sb = b % 1024, swz = sb ^ (((sb >> 9) & 1) << 5); R = (st >> 1) * 16 + swz / 64; C = (st & 1) * 32 + (swz % 64) / 2; }
__host__ __device__ __forceinline__ int perm32(int rho) { const int n = rho >> 4, i = rho & 15; return 8 * (i >> 2) + 4 * n + (i & 3); }

struct Unit { int pm, pn; };
struct Gemm { const bf16_t* A; const bf16_t* Bt; int M, N, K; };

struct StaticOrder {
    int nM, nN, nwg, G, c;
    __host__ __device__ void init(int M, int N, int G_, int c_) { nM = M / BM; nN = N / BM; nwg = nM * nN; G = G_; c = c_; }
    __host__ __device__ bool next(int i, Unit& u) const {
        const long L = (long)i * G + c; if (L >= nwg) return false;
        int wgid = (int)L; { const int q = nwg / NXCD, r = nwg % NXCD, xcd = wgid % NXCD, off = wgid / NXCD; wgid = (xcd < r ? xcd * (q + 1) : r * (q + 1) + (xcd - r) * q) + off; }
        const int nig = WGM * nN, gid = wgid / nig, fm = gid * WGM, gsz = (nM - fm) < WGM ? (nM - fm) : WGM;
        u.pm = fm + ((wgid % nig) % gsz); u.pn = (wgid % nig) / gsz; return true;
    }
    __device__ __forceinline__ void a_ready(const Unit&) const {}
    __device__ __forceinline__ void done(const Unit&) const {}
};

__device__ __forceinline__ unsigned cvt_pk_bf16(float lo, float hi) { unsigned r; asm volatile("v_cvt_pk_bf16_f32 %0, %1, %2" : "=v"(r) : "v"(lo), "v"(hi)); return r; }
typedef float f32x2 __attribute__((ext_vector_type(2)));
__device__ __forceinline__ float fast_sigmoid(float x) { return __builtin_amdgcn_rcpf(1.0f + __builtin_amdgcn_exp2f(-1.4426950408889634f * x)); }
struct EpiF32 {
    static constexpr bool PERM = false, AFTER_DRAIN = false;
    float* O; int ldc; const float* ssq; int split_cols; size_t split_stride;
    __device__ __forceinline__ void operator()(const f32x4 (&acc)[2][2][4][2], const Unit& u, int wr, int wc, int fr, int fq) const {
        int colt = u.pn * BM; float* base = O; if (split_cols) { const int t = colt / split_cols; base += (size_t)t * split_stride; colt -= t * split_cols; }
        const int row0 = u.pm * BM + wr * 64 + fr, col0 = colt + wc * 32 + 4 * fq;
#pragma unroll
        for (int ai = 0; ai < 2; ++ai)
#pragma unroll
            for (int m = 0; m < 4; ++m) { const int r = row0 + ai * HALF + m * 16; const float rs = ssq ? rstd_of(ssq[r]) : 1.0f; float* rowp = base + (size_t)r * ldc + col0;
#pragma unroll
                for (int bj = 0; bj < 2; ++bj)
#pragma unroll
                    for (int n = 0; n < 2; ++n) *(f32x4*)(rowp + bj * HALF + n * 16) = acc[ai][bj][m][n] * rs; }
    }
};
struct EpiBf16S {
    static constexpr bool PERM = true, AFTER_DRAIN = false;
    bf16_t* O; int ldc; const float* ssq; int gate_pn; float* GT;
    __device__ __forceinline__ void operator()(const f32x4 (&acc)[2][2][4][2], const Unit& u, int wr, int wc, int fr, int fq) const {
        const int row0 = u.pm * BM + wr * 64 + fr, col0 = u.pn * BM + wc * 32 + 8 * fq;
        if (u.pn == gate_pn) {
            if (wc == 0 && fq == 0) {
#pragma unroll
                for (int ai = 0; ai < 2; ++ai)
#pragma unroll
                    for (int m = 0; m < 4; ++m) { const int r = row0 + ai * HALF + m * 16; const float rs = rstd_of(ssq[r]);
                        *(f32x4*)(GT + (size_t)r * 48) = acc[ai][0][m][0] * rs; *(f32x4*)(GT + (size_t)r * 48 + 4) = acc[ai][0][m][1] * rs; } }
            return; }
#pragma unroll
        for (int ai = 0; ai < 2; ++ai)
#pragma unroll
            for (int m = 0; m < 4; ++m) { const int r = row0 + ai * HALF + m * 16; const float rs = rstd_of(ssq[r]); bf16_t* rowp = O + (size_t)r * ldc + col0;
#pragma unroll
                for (int bj = 0; bj < 2; ++bj) { const f32x4 v0 = acc[ai][bj][m][0] * rs, v1 = acc[ai][bj][m][1] * rs;
                    u32x4 w; w.x = cvt_pk_bf16(v0[0], v0[1]); w.y = cvt_pk_bf16(v0[2], v0[3]); w.z = cvt_pk_bf16(v1[0], v1[1]); w.w = cvt_pk_bf16(v1[2], v1[3]);
                    *(u32x4*)(rowp + bj * HALF) = w; } }
    }
};
struct EpiSwiglu {
    static constexpr bool PERM = true, AFTER_DRAIN = false;
    bf16_t* O; const float* ssq;
    __device__ __forceinline__ void operator()(const f32x4 (&acc)[2][2][4][2], const Unit& u, int wr, int wc, int fr, int fq) const {
        const int row0 = u.pm * BM + wr * 64 + fr, col0 = u.pn * HALF + wc * 32 + 8 * fq;
#pragma unroll
        for (int ai = 0; ai < 2; ++ai)
#pragma unroll
            for (int m = 0; m < 4; ++m) { const int r = row0 + ai * HALF + m * 16; const float rs = rstd_of(ssq[r]); float h[8];
#pragma unroll
                for (int n = 0; n < 2; ++n)
#pragma unroll
                    for (int j = 0; j < 4; ++j) { const float g = acc[ai][0][m][n][j] * rs, up = acc[ai][1][m][n][j] * rs; h[4 * n + j] = g * fast_sigmoid(g) * up; }
                u32x4 w; w.x = cvt_pk_bf16(h[0], h[1]); w.y = cvt_pk_bf16(h[2], h[3]); w.z = cvt_pk_bf16(h[4], h[5]); w.w = cvt_pk_bf16(h[6], h[7]);
                *(u32x4*)(O + (size_t)r * 2816 + col0) = w; }
    }
};
struct EpiResid {
    static constexpr bool PERM = false, AFTER_DRAIN = false;
    float* Y; bf16_t* XB; float* ssq;
    __device__ __forceinline__ void operator()(const f32x4 (&acc)[2][2][4][2], const Unit& u, int wr, int wc, int fr, int fq) const {
        const int row0 = u.pm * BM + wr * 64 + fr, col0 = u.pn * BM + wc * 32 + 4 * fq;
        typedef unsigned u32x2 __attribute__((ext_vector_type(2)));
#pragma unroll
        for (int ai = 0; ai < 2; ++ai)
#pragma unroll
            for (int m = 0; m < 4; ++m) { const int r = row0 + ai * HALF + m * 16; bf16_t* bp = XB + (size_t)r * 1024 + col0; float ss = 0.f; u32x2 old[2][2];
#pragma unroll
                for (int bj = 0; bj < 2; ++bj)
#pragma unroll
                    for (int n = 0; n < 2; ++n) old[bj][n] = *(const u32x2*)(bp + bj * HALF + n * 16);
#pragma unroll
                for (int bj = 0; bj < 2; ++bj)
#pragma unroll
                    for (int n = 0; n < 2; ++n) { const u32x2 o = old[bj][n]; f32x4 x = (f32x4){bflo(o.x), bfhi(o.x), bflo(o.y), bfhi(o.y)} + acc[ai][bj][m][n];
                        u32x2 w; w.x = cvt_pk_bf16(x[0], x[1]); w.y = cvt_pk_bf16(x[2], x[3]); *(u32x2*)(bp + bj * HALF + n * 16) = w;
                        if (Y) *(f32x4*)(Y + (size_t)r * 1024 + col0 + bj * HALF + n * 16) = x;
                        ss += (x[0] * x[0] + x[1] * x[1]) + (x[2] * x[2] + x[3] * x[3]); }
                ss += __shfl_xor(ss, 16); ss += __shfl_xor(ss, 32);
                if (fq == 0) (void)__hip_atomic_fetch_add(ssq + r, ss, __ATOMIC_RELAXED, __HIP_MEMORY_SCOPE_AGENT); }
    }
};
template <class Epi, class Sched, bool ALIGN_EPI = false, bool SP2 = false>
__device__ __forceinline__ void gemm_phase(PG8_LAS unsigned char* lds, const Gemm g, const Sched& S, const Epi& E) {
    int tid_l = threadIdx.x; asm volatile("" : "+v"(tid_l));
    const int tid = tid_l, wid = __builtin_amdgcn_readfirstlane(tid >> 6), lane = tid & 63, wr = wid >> 2, wc = wid & 3, fr = lane & 15, fq = lane >> 4;
    const int K = g.K, nt = K / BK;
    unsigned voffA[2], voffB[2];
#pragma unroll
    for (int i = 0; i < 2; ++i) { int R, C; stage_rc(tid * 16 + i * 8192, R, C); const int Rb = Epi::PERM ? ((R & ~31) + perm32(R & 31)) : R;
        voffA[i] = (unsigned)(R * K + C) * 2u; voffB[i] = (unsigned)(Rb * K + C) * 2u; }
    const size_t kstep = (size_t)(BK * 2);
    const size_t hstep = (size_t)HALF * K * 2;
    const size_t tstep = 2 * hstep;
    const unsigned ldsw = (unsigned)wid * 1024u;
    const int aoff = lds_byte(wr * 64 + fr, fq * 8), boff = lds_byte(wc * 32 + fr, fq * 8);
#define PG8_SA(b, h) (((b) * 2 + (h)) * HTB)
#define PG8_SB(b, h) ((4 + (b) * 2 + (h)) * HTB)
#define PG8_STAGE(bufoff, gbase, voff) do { _Pragma("unroll") for (int _i = 0; _i < 2; ++_i) \
        __builtin_amdgcn_global_load_lds((const unsigned*)((const char*)(gbase) + (voff)[_i]), (PG8_LAS unsigned*)(lds + (bufoff) + ldsw + _i * 8192), 16, 0, 0); } while (0)
#define PG8_LDA(dst, b, h) do { _Pragma("unroll") for (int m = 0; m < 4; ++m) _Pragma("unroll") for (int k = 0; k < 2; ++k) dst[m][k] = *(const PG8_LAS bf16x8*)(lds + PG8_SA(b, h) + aoff + m * 2048 + k * 1024); } while (0)
#define PG8_LDB(dst, b, h) do { _Pragma("unroll") for (int n = 0; n < 2; ++n) _Pragma("unroll") for (int k = 0; k < 2; ++k) dst[n][k] = *(const PG8_LAS bf16x8*)(lds + PG8_SB(b, h) + boff + n * 2048 + k * 1024); } while (0)
#define PG8_MMA(ai, bj, At, Bt) do { __builtin_amdgcn_s_setprio(1); _Pragma("unroll") for (int m = 0; m < 4; ++m) _Pragma("unroll") for (int n = 0; n < 2; ++n) _Pragma("unroll") for (int k = 0; k < 2; ++k) \
        acc[ai][bj][m][n] = __builtin_amdgcn_mfma_f32_16x16x32_bf16(Bt[n][k], At[m][k], acc[ai][bj][m][n], 0, 0, 0); __builtin_amdgcn_s_setprio(0); } while (0)
#define PG8_WAIT_V(n) asm volatile("s_waitcnt vmcnt(" #n ")" ::: "memory")
#define PG8_WAIT_L(n) asm volatile("s_waitcnt lgkmcnt(" #n ")" ::: "memory")
#define PG8_BAR __builtin_amdgcn_s_barrier()
#define PG8_SCHED __builtin_amdgcn_sched_barrier(0)
    Unit cur, nxt; int ui = 0;
    if (!S.next(0, cur)) return;
    f32x4 acc[2][2][4][2];
#pragma unroll
    for (int a = 0; a < 2; ++a)
#pragma unroll
        for (int b = 0; b < 2; ++b)
#pragma unroll
            for (int m = 0; m < 4; ++m)
#pragma unroll
                for (int n = 0; n < 2; ++n) acc[a][b][m][n] = (f32x4){0.f, 0.f, 0.f, 0.f};
    bf16x8 At[4][2], B0[2][2], B1[2][2];
    const char* cA = (const char*)g.A + (size_t)cur.pm * tstep; const char* cB = (const char*)g.Bt + (size_t)cur.pn * tstep;
    S.a_ready(cur);
    if constexpr (SP2) {
        PG8_STAGE(PG8_SB(0, 0), cB, voffB); PG8_STAGE(PG8_SB(0, 1), cB + hstep, voffB); PG8_STAGE(PG8_SA(0, 0), cA, voffA); PG8_STAGE(PG8_SA(0, 1), cA + hstep, voffA);
        if (wr == 1) PG8_BAR;
        PG8_WAIT_V(2); PG8_BAR;
        PG8_STAGE(PG8_SB(1, 0), cB + kstep, voffB); PG8_STAGE(PG8_SA(1, 0), cA + kstep, voffA); PG8_STAGE(PG8_SB(1, 1), cB + hstep + kstep, voffB);
        PG8_WAIT_V(6); PG8_BAR;
    } else {
        PG8_STAGE(PG8_SB(0, 0), cB, voffB); PG8_STAGE(PG8_SA(0, 0), cA, voffA); PG8_STAGE(PG8_SB(0, 1), cB + hstep, voffB); PG8_STAGE(PG8_SA(0, 1), cA + hstep, voffA);
        if (wr == 1) PG8_BAR;
        PG8_WAIT_V(4); PG8_BAR;
        PG8_STAGE(PG8_SB(1, 0), cB + kstep, voffB); PG8_STAGE(PG8_SA(1, 0), cA + kstep, voffA); PG8_STAGE(PG8_SB(1, 1), cB + hstep + kstep, voffB);
        PG8_WAIT_V(6); PG8_BAR;
    }
    for (;;) {
        const bool has_next = S.next(ui + 1, nxt);
        const char* nA = has_next ? (const char*)g.A + (size_t)nxt.pm * tstep : cA; const char* nB = has_next ? (const char*)g.Bt + (size_t)nxt.pn * tstep : cB;
        for (int t = 0; t < nt; t += 2) {
            const bool last = (t == nt - 2);
            const char* a1 = cA + (size_t)(t + 1) * kstep;
            const char* a2 = last ? nA : cA + (size_t)(t + 2) * kstep; const char* b2 = last ? nB : cB + (size_t)(t + 2) * kstep;
            const char* a3 = a2 + kstep; const char* b3 = b2 + kstep;
            if (last && has_next) S.a_ready(nxt);
            if constexpr (SP2) {
            PG8_LDB(B0, 0, 0); PG8_LDB(B1, 0, 1); PG8_SCHED; PG8_LDA(At, 0, 0); PG8_STAGE(PG8_SA(1, 1), a1 + hstep, voffA);
            PG8_WAIT_V(8); PG8_WAIT_L(0); PG8_BAR; PG8_MMA(0, 0, At, B0); PG8_MMA(0, 1, At, B1); PG8_BAR; PG8_SCHED;
            PG8_LDA(At, 0, 1); PG8_STAGE(PG8_SB(0, 0), b2, voffB); PG8_STAGE(PG8_SB(0, 1), b2 + hstep, voffB); PG8_STAGE(PG8_SA(0, 0), a2, voffA);
            PG8_WAIT_V(8); PG8_WAIT_L(0); PG8_BAR; PG8_MMA(1, 0, At, B0); PG8_MMA(1, 1, At, B1); PG8_BAR; PG8_SCHED;
            PG8_LDB(B0, 1, 0); PG8_LDB(B1, 1, 1); PG8_SCHED; PG8_LDA(At, 1, 0); PG8_STAGE(PG8_SA(0, 1), a2 + hstep, voffA);
            PG8_WAIT_V(8); PG8_WAIT_L(0); PG8_BAR; PG8_MMA(0, 0, At, B0); PG8_MMA(0, 1, At, B1); PG8_BAR; PG8_SCHED;
            PG8_LDA(At, 1, 1); PG8_STAGE(PG8_SB(1, 0), b3, voffB); PG8_STAGE(PG8_SB(1, 1), b3 + hstep, voffB); PG8_STAGE(PG8_SA(1, 0), a3, voffA);
            PG8_WAIT_V(8); PG8_WAIT_L(0); PG8_BAR; PG8_MMA(1, 0, At, B0); PG8_MMA(1, 1, At, B1); PG8_BAR; PG8_SCHED;
            } else {
            PG8_LDB(B0, 0, 0); PG8_SCHED; PG8_LDA(At, 0, 0); PG8_STAGE(PG8_SA(1, 1), a1 + hstep, voffA);
            PG8_WAIT_L(8); PG8_BAR; PG8_WAIT_L(0); PG8_MMA(0, 0, At, B0); PG8_BAR; PG8_SCHED;
            PG8_LDB(B1, 0, 1); PG8_STAGE(PG8_SB(0, 0), b2, voffB);
            PG8_BAR; PG8_WAIT_L(0); PG8_MMA(0, 1, At, B1); PG8_BAR;
            PG8_LDA(At, 0, 1); PG8_STAGE(PG8_SA(0, 0), a2, voffA);
            PG8_BAR; PG8_WAIT_L(0); PG8_MMA(1, 0, At, B0); PG8_BAR; PG8_SCHED;
            PG8_STAGE(PG8_SB(0, 1), b2 + hstep, voffB);
            PG8_WAIT_V(6); PG8_BAR; PG8_MMA(1, 1, At, B1); PG8_BAR;
            PG8_LDB(B0, 1, 0); PG8_SCHED; PG8_LDA(At, 1, 0); PG8_STAGE(PG8_SA(0, 1), a2 + hstep, voffA);
            PG8_WAIT_L(8); PG8_BAR; PG8_WAIT_L(0); PG8_MMA(0, 0, At, B0); PG8_BAR; PG8_SCHED;
            PG8_LDB(B1, 1, 1); PG8_STAGE(PG8_SB(1, 0), b3, voffB);
            PG8_BAR; PG8_WAIT_L(0); PG8_MMA(0, 1, At, B1); PG8_BAR;
            PG8_LDA(At, 1, 1); PG8_STAGE(PG8_SA(1, 0), a3, voffA);
            PG8_BAR; PG8_WAIT_L(0); PG8_MMA(1, 0, At, B0); PG8_BAR; PG8_SCHED;
            PG8_STAGE(PG8_SB(1, 1), b3 + hstep, voffB);
            PG8_WAIT_V(6); PG8_BAR; PG8_MMA(1, 1, At, B1); PG8_BAR;
            }
        }
        if constexpr (ALIGN_EPI) { if (wr == 0) PG8_BAR; }
        if constexpr (!Epi::AFTER_DRAIN) { E(acc, cur, wr, wc, fr, fq); S.done(cur); }
        if (!has_next) break;
#pragma unroll
        for (int a = 0; a < 2; ++a)
#pragma unroll
            for (int b = 0; b < 2; ++b)
#pragma unroll
                for (int m = 0; m < 4; ++m)
#pragma unroll
                    for (int n = 0; n < 2; ++n) acc[a][b][m][n] = (f32x4){0.f, 0.f, 0.f, 0.f};
        cur = nxt; cA = nA; cB = nB; ++ui;
        if constexpr (ALIGN_EPI) { if (wr == 1) PG8_BAR; }
    }
    PG8_WAIT_V(0);
    if constexpr (!ALIGN_EPI) { if (wr == 0) PG8_BAR; }
    PG8_BAR;
    if constexpr (Epi::AFTER_DRAIN) { E.fused(acc, cur, wr, wc, fr, fq, lds, wid, lane); S.done(cur); }
#undef PG8_SA
#undef PG8_SB
#undef PG8_STAGE
#undef PG8_LDA
#undef PG8_LDB
#undef PG8_MMA
#undef PG8_WAIT_V
#undef PG8_WAIT_L
#undef PG8_BAR
#undef PG8_SCHED
}
}
typedef short s_bf16x8 __attribute__((ext_vector_type(8)));
typedef float s_f32x4 __attribute__((ext_vector_type(4)));
template <int NT> struct StripAcc { s_f32x4 a[NT]; };
template <int NT> __device__ __forceinline__ void strip_gemm(const bf16_t* A, int K, int row0, const bf16_t* Bt, const int* brow  , StripAcc<NT>& R, LAS unsigned char* lds) {
    const int tid_ = ltid(), lane = tid_ & 63, wave = tid_ >> 6, fr = lane & 15, fq = lane >> 4, rt = wave & 1, kq = wave >> 1;
    LAS float* red = (LAS float*)lds;
    const int kw = K >> 2;
    const bf16_t* ap = A + (size_t)(row0 + 16 * rt + fr) * K + kq * kw + fq * 8;
    const bf16_t* bp[NT];
#pragma unroll
    for (int t = 0; t < NT; ++t) { bp[t] = Bt + (size_t)(brow[t] + fr) * K + kq * kw + fq * 8; R.a[t] = (s_f32x4){0.f, 0.f, 0.f, 0.f}; }
    int k0 = 0;
#pragma unroll 1
    for (; k0 + 256 <= kw; k0 += 256) {
        s_bf16x8 a[8], b[NT][8];
#pragma unroll
        for (int s2 = 0; s2 < 8; ++s2) { a[s2] = *(const s_bf16x8*)(ap + k0 + s2 * 32);
#pragma unroll
            for (int t = 0; t < NT; ++t) b[t][s2] = *(const s_bf16x8*)(bp[t] + k0 + s2 * 32); }
#pragma unroll
        for (int s2 = 0; s2 < 8; ++s2)
#pragma unroll
            for (int t = 0; t < NT; ++t) R.a[t] = __builtin_amdgcn_mfma_f32_16x16x32_bf16(b[t][s2], a[s2], R.a[t], 0, 0, 0);
    }
#pragma unroll 1
    for (; k0 < kw; k0 += 64) {
        s_bf16x8 a[2], b[NT][2];
#pragma unroll
        for (int s2 = 0; s2 < 2; ++s2) { a[s2] = *(const s_bf16x8*)(ap + k0 + s2 * 32);
#pragma unroll
            for (int t = 0; t < NT; ++t) b[t][s2] = *(const s_bf16x8*)(bp[t] + k0 + s2 * 32); }
#pragma unroll
        for (int s2 = 0; s2 < 2; ++s2)
#pragma unroll
            for (int t = 0; t < NT; ++t) R.a[t] = __builtin_amdgcn_mfma_f32_16x16x32_bf16(b[t][s2], a[s2], R.a[t], 0, 0, 0);
    }
    __syncthreads();
    if (kq > 0) {
#pragma unroll
        for (int t = 0; t < NT; ++t) *(LAS s_f32x4*)(red + ((((kq - 1) * 2 + rt) * NT + t) * 64 + lane) * 4) = R.a[t]; }
    __syncthreads();
    if (kq == 0) {
#pragma unroll
        for (int q = 0; q < 3; ++q)
#pragma unroll
            for (int t = 0; t < NT; ++t) R.a[t] = R.a[t] + *(const LAS s_f32x4*)(red + (((q * 2 + rt) * NT + t) * 64 + lane) * 4); }
}
enum { TR_ID = 0, TR_INA, TR_INB, TR_GU };
__device__ __forceinline__ int tr_rowmap(int kind, int n) {
    if (kind == TR_INA) return n < 3072 ? n : (n < 3080 ? 3328 + (n - 3072) : 3072 + (n - 3080));
    if (kind == TR_INB) return n < 768 ? n : (n < 804 ? 1024 + (n - 768) : 768 + (n - 804));
    if (kind == TR_GU) { if (n < DFF) return (n >> 7) * 256 + (n & 127); const int m = n - DFF; return (m >> 7) * 256 + 128 + (m & 127); }
    return n;
}
__device__ __forceinline__ void tr_item(const float* W, int K, int N, bf16_t* WT, const float* gain, int kind, LAS float* scr, int item, int lane) {
    const int nblk = (N + 31) >> 5, kb = item / nblk, nb = item % nblk, k0 = 64 * kb, n0 = 32 * nb;
    { float v[32]; const int n = n0 + (lane & 31); const bool ok = n < N; const float* wp = W + (size_t)(k0 + (lane >> 5)) * N + (ok ? n : 0);
#pragma unroll
      for (int i = 0; i < 32; ++i) v[i] = wp[(size_t)(2 * i) * N];
#pragma unroll
      for (int i = 0; i < 32; ++i) { const int kk = 2 * i + (lane >> 5); float x = ok ? v[i] : 0.f; if (gain) x *= gain[k0 + kk]; scr[kk * 33 + (lane & 31)] = x; } }
    asm volatile("s_waitcnt lgkmcnt(0)" ::: "memory");
    const int c = lane & 7;
#pragma unroll
    for (int j = 0; j < 4; ++j) { const int nn = (lane >> 3) + 8 * j, n = n0 + nn;
        if (n < N) { const int row = tr_rowmap(kind, n); const float sc = (kind == TR_INA && n >= 768 && n < 1536) ? 0.07216878364870322f : 1.0f;
            const LAS float* s = scr + (8 * c) * 33 + nn; uint4 o;
            o.x = pk2(s[0 * 33] * sc, s[1 * 33] * sc); o.y = pk2(s[2 * 33] * sc, s[3 * 33] * sc); o.z = pk2(s[4 * 33] * sc, s[5 * 33] * sc); o.w = pk2(s[6 * 33] * sc, s[7 * 33] * sc);
            *(uint4*)(WT + (size_t)row * K + k0 + 8 * c) = o; } }
    asm volatile("s_waitcnt lgkmcnt(0)" ::: "memory");
}
__device__ __forceinline__ void ph_prologue(const Params& p, LAS unsigned char* lds) {
    const int tid = ltid(), lane = tid & 63, wid = tid >> 6; const int gw = blockIdx.x * NW_ + wid, NGW = gridDim.x * NW_;
    LAS float* scr = (LAS float*)(lds + wid * 16384);
    unsigned char* ws = p.ws;
    for (int it = gw; ; it += NGW) {
        int r = it; bool done = false;
#define TRJ(Wp, K_, N_, WTp, gainp, kind_) if (!done) { const int cnt = ((K_) / 64) * (((N_) + 31) / 32); if (r < cnt) { tr_item(Wp, K_, N_, WTp, gainp, kind_, scr, r, lane); done = true; } else r -= cnt; }
        for (int l = 0; l < 4; ++l) TRJ(p.in[I_WGU] + (size_t)l * DM * 2 * DFF, DM, 2 * DFF, (bf16_t*)(ws + B_BTG) + (size_t)l * 2 * DFF * DM, p.in[I_GFFN] + l * DM, TR_GU)
        for (int l = 0; l < 4; ++l) TRJ(p.in[I_WDOWN] + (size_t)l * DFF * DM, DFF, DM, (bf16_t*)(ws + B_BTD) + (size_t)l * DM * DFF, (const float*)nullptr, TR_ID)
        for (int l = 0; l < 2; ++l) TRJ(p.in[I_WINA] + (size_t)l * DM * ACOLS, DM, ACOLS, (bf16_t*)(ws + B_BTA) + (size_t)l * NBTA * DM, p.in[I_GMIX] + l * DM, TR_INA)
        for (int l = 0; l < 2; ++l) TRJ(p.in[I_WINB] + (size_t)l * DM * BCOLS, DM, BCOLS, (bf16_t*)(ws + B_BTB) + (size_t)l * NBTB * DM, p.in[I_GMIX] + (2 + l) * DM, TR_INB)
        for (int l = 0; l < 4; ++l) TRJ(p.in[I_WOUT] + (size_t)l * DM * DM, DM, DM, (bf16_t*)(ws + B_BTO) + (size_t)l * DM * DM, (const float*)nullptr, TR_ID)
        TRJ(p.in[I_WKV], DM, 768, (bf16_t*)(ws + B_BTK), p.in[I_GKV], TR_ID)
        for (int l = 0; l < 4; ++l) TRJ(p.in[I_WMEMKV] + (size_t)l * DM * 512, DM, 512, (bf16_t*)(ws + B_BTM) + (size_t)l * 512 * DM, (const float*)nullptr, TR_ID)
        for (int c = 0; c < 2; ++c) TRJ(p.in[I_CW1] + (size_t)c * 2048 * 128, 2048, 128, (bf16_t*)(ws + B_W1T) + (size_t)c * 128 * 2048, (const float*)nullptr, TR_ID)
        for (int c = 0; c < 2; ++c) TRJ(p.in[I_CW2] + (size_t)c * 128 * 64, 128, 64, (bf16_t*)(ws + B_W2T) + (size_t)c * 64 * 128, (const float*)nullptr, TR_ID)
#undef TRJ
        if (!done) break;
    }
    for (int idx = gw; idx < 256; idx += NGW) { const int c = idx >> 7, h = idx & 127; float s = 0.f;
        for (int k = lane; k < 2048; k += 64) s += p.in[I_CPOS][((k >> 6) * 2 + c) * 64 + (k & 63)] * p.in[I_CW1][((size_t)c * 2048 + k) * 128 + h];
        s = wave_sum(s); if (lane == 0) ((float*)(ws + B_PEB))[idx] = s + p.in[I_CB1][idx]; }
    for (int i = blockIdx.x * NT_ + tid; i < 2 * 8 * 128 + 2 * 12 * 128; i += gridDim.x * NT_) {
        uint4 z = make_uint4(0u, 0u, 0u, 0u);
        if (i < 2048) { const int l = i >> 10, rr = (i >> 7) & 7, c = i & 127; ((uint4*)((bf16_t*)(ws + B_BTA) + ((size_t)l * NBTA + 3336 + rr) * DM))[c] = z; }
        else { const int k = i - 2048; const int l = k / 1536, rr = (k % 1536) >> 7, c = k & 127; ((uint4*)((bf16_t*)(ws + B_BTB) + ((size_t)l * NBTB + 1060 + rr) * DM))[c] = z; }
    }
    bf16_t* XB = (bf16_t*)(ws + B_XB); float* ssq0 = (float*)(ws + B_SSQ); bf16_t* MPB = (bf16_t*)(ws + B_MPB);
    for (int r0 = gw; r0 < MA + 2048; r0 += 2 * NGW) {
        float4 v[2][4]; const int r1 = r0 + NGW < MA + 2048 ? r0 + NGW : r0;
#pragma unroll
        for (int u = 0; u < 2; ++u) { const int r = u ? r1 : r0; const float* src = r < MA ? (r < MP ? p.in[I_XP] + (size_t)r * DM : p.in[I_XS] + (size_t)(r - MP) * DM) : p.in[I_MEMP] + (size_t)(r - MA) * DM;
#pragma unroll
            for (int j = 0; j < 4; ++j) v[u][j] = ((const float4*)src)[lane + 64 * j]; }
#pragma unroll
        for (int u = 0; u < 2; ++u) { const int r = u ? r1 : r0; if (u == 1 && r1 == r0) break; const bool isx = r < MA;
            bf16_t* dstb = isx ? XB + (size_t)r * DM : MPB + (size_t)(r - MA) * DM; float ss = 0.f;
#pragma unroll
            for (int j = 0; j < 4; ++j) { ss += dot4(v[u][j], v[u][j]); ((uint2*)dstb)[lane + 64 * j] = make_uint2(pk2(v[u][j].x, v[u][j].y), pk2(v[u][j].z, v[u][j].w)); }
            ss = wave_sum(ss); if (isx && lane == 0) ssq0[r] = ss; }
    }
}

__device__ __forceinline__ void ph_swin_copy(const Params& p, int blk0, int nblk) {
    if ((int)blockIdx.x < blk0 || (int)blockIdx.x >= blk0 + nblk) return;
    const int tid = ltid();
    {   const unsigned n4 = 128u * 511u * 64u, stride = nblk * NT_;
#define SW_SRC(i_) (((const float4*)(p.in[I_CWIN] + (size_t)((i_) / (511u * 64u)) * 512 * 256 + 256))[(i_) % (511u * 64u)])
#define SW_DST(i_) (((float4*)(p.out + O_SWIN + (size_t)((i_) / (511u * 64u)) * 512 * 256))[(i_) % (511u * 64u)])
        for (unsigned i0 = (blockIdx.x - blk0) * NT_ + tid; i0 < n4; i0 += 4 * stride) {
            const unsigned i1 = i0 + stride, i2 = i0 + 2 * stride, i3 = i0 + 3 * stride;
            const float4 v0 = SW_SRC(i0), v1 = SW_SRC(i1 < n4 ? i1 : i0), v2 = SW_SRC(i2 < n4 ? i2 : i0), v3 = SW_SRC(i3 < n4 ? i3 : i0);
            SW_DST(i0) = v0; if (i1 < n4) SW_DST(i1) = v1; if (i2 < n4) SW_DST(i2) = v2; if (i3 < n4) SW_DST(i3) = v3; }
#undef SW_SRC
#undef SW_DST
    }
}

__device__ __forceinline__ void ph_memk_norm(const Params& p) {
    const int tid_ = ltid(); const int lane = tid_ & 63, wid = tid_ >> 6;
    const float* raw = (const float*)(p.ws + B_MEMR);
    for (int it = blockIdx.x * NW_ + wid; it < 4 * 8 * 256; it += gridDim.x * NW_) {
        const int l = it / 2048;
        const float4* rr = (const float4*)(raw + (size_t)it * 512); float4* orow = (float4*)(p.out + O_PMEM + (size_t)it * 512);
        float4 v = rr[lane]; const float4 vv = rr[64 + lane]; float ss = dot4(v, v);
        ss += __shfl_xor(ss, 1); ss += __shfl_xor(ss, 2); ss += __shfl_xor(ss, 4); ss += __shfl_xor(ss, 8);
        const float rs = rsqrtf(ss * (1.0f / 64) + EPS);
        const float4 g = ((const float4*)(p.in[I_GMEMK] + l * 64))[lane & 15];
        v.x *= rs * g.x; v.y *= rs * g.y; v.z *= rs * g.z; v.w *= rs * g.w; orow[lane] = v; orow[64 + lane] = vv;
    }
}

__device__ __forceinline__ void ph_mlstm_prompt(const Params& p, int l, float* lds) {
    const bf16_t* P = (const bf16_t*)(p.ws + B_P16); const float* GT = (const float*)(p.ws + B_GT); const float* bif = p.in[I_BIF] + l * 8; float* HR = (float*)(p.ws + B_HRAW);
    const int tid = ltid(), lane = tid & 63, wid = tid >> 6;
    float* red = lds;
    for (int item = blockIdx.x; item < 256; item += gridDim.x) {
        const int es = item & 7, h = (item >> 3) & 3, b = item >> 5;
        const bool act = tid < 384; const int grp = tid >= 192 ? 1 : 0; const int d = act ? tid - grp * 192 : 0;
        const int col0 = h * 192 + es * 24 + (act ? grp : 0) * 12;
        float C[12]; float n = 0.f, m = NEGM;
#pragma unroll
        for (int e = 0; e < 12; ++e) C[e] = 0.f;
        const bf16_t* pr = P + (size_t)(b * SP) * LDA_; const float* gr = GT + (size_t)(b * SP) * GTW;
        float qn = act ? bf2f(pr[h * 192 + d]) : 0.f, kn = act ? bf2f(pr[768 + h * 192 + d]) : 0.f; uint2 vn[3];
#pragma unroll
        for (int e = 0; e < 3; ++e) vn[e] = *(const uint2*)(pr + 1536 + col0 + 4 * e);
        float in_ = gr[h] + bif[h], fn = gr[4 + h] + bif[4 + h];
        for (int t = 0; t < SP; ++t) {
            const float q = qn, k = kn, ig = in_, fg = fn; float v[12];
#pragma unroll
            for (int e = 0; e < 3; ++e) { v[4 * e] = bflo(vn[e].x); v[4 * e + 1] = bfhi(vn[e].x); v[4 * e + 2] = bflo(vn[e].y); v[4 * e + 3] = bfhi(vn[e].y); }
            if (t + 1 < SP) {
                pr += LDA_; gr += GTW;
                qn = act ? bf2f(pr[h * 192 + d]) : 0.f; kn = act ? bf2f(pr[768 + h * 192 + d]) : 0.f;
#pragma unroll
                for (int e = 0; e < 3; ++e) vn[e] = *(const uint2*)(pr + 1536 + col0 + 4 * e);
                in_ = gr[h] + bif[h]; fn = gr[4 + h] + bif[4 + h];
            }
            const float logf = logsigmoidf_(fg);
            const float m_new = fmaxf(logf + m, ig);
            const float a = expf(logf + m - m_new), bb = expf(ig - m_new);
            const float kb = bb * k;
            float part[13];
#pragma unroll
            for (int e = 0; e < 12; ++e) { C[e] = a * C[e] + kb * v[e]; part[e] = q * C[e]; }
            n = a * n + kb; part[12] = q * n;
#pragma unroll
            for (int e = 0; e < 13; ++e) part[e] = wave_sum(part[e]);
            float* rb = red + (t & 1) * 104;
            if (lane == 0) {
#pragma unroll
                for (int e = 0; e < 13; ++e) rb[wid * 13 + e] = part[e];
            }
            __syncthreads();
            if (tid < 24) {
                const int g2 = tid / 12, e = tid % 12;
                const float num = rb[(g2 * 3) * 13 + e] + rb[(g2 * 3 + 1) * 13 + e] + rb[(g2 * 3 + 2) * 13 + e];
                const float den = rb[12] + rb[13 + 12] + rb[26 + 12];
                HR[(size_t)(b * SP + t) * 768 + h * 192 + es * 24 + tid] = num / fmaxf(fabsf(den), expf(-m_new));
            }
            m = m_new;
        }
        if (act) {
            float* co = p.out + O_PC + ((size_t)((l * 8 + b) * 4 + h) * 192 + d) * 192 + es * 24 + grp * 12;
#pragma unroll
            for (int e = 0; e < 12; ++e) co[e] = C[e];
            if (es == 0 && grp == 0) p.out[O_PN + (size_t)((l * 8 + b) * 4 + h) * 192 + d] = n;
        }
        if (es == 0 && tid == 0) p.out[O_PM + (l * 8 + b) * 4 + h] = m;
        __syncthreads();
    }
}
__device__ __forceinline__ void ph_mlstm_sample(const Params& p, int l, float* lds) {
    const bf16_t* P = (const bf16_t*)(p.ws + B_P16); const float* GT = (const float*)(p.ws + B_GT); const float* bif = p.in[I_BIF] + l * 8; float* HR = (float*)(p.ws + B_HRAW);
    const int tid = ltid();
    float* qs = lds + 512; float* ks = lds + 512 + 192; float* n0s = lds + 512 + 384;
    for (int item = blockIdx.x; item < 128 * 4; item += gridDim.x) {
        const int h = item & 3, b = item >> 2; const int row = MP + b;
        const bf16_t* pr = P + (size_t)row * LDA_; const float* gr = GT + (size_t)row * GTW;
        const size_t sidx = (size_t)(l * 128 + b) * 4 + h;
        __syncthreads();
        if (tid < 192) { qs[tid] = bf2f(pr[h * 192 + tid]); ks[tid] = bf2f(pr[768 + h * 192 + tid]); n0s[tid] = p.in[I_SN][sidx * 192 + tid]; }
        __syncthreads();
        const float ig = gr[h] + bif[h], fg = gr[4 + h] + bif[4 + h];
        const float m0 = p.in[I_SM][sidx];
        const float logf = logsigmoidf_(fg);
        const float m_new = fmaxf(logf + m0, ig);
        const float a = expf(logf + m0 - m_new), bb = expf(ig - m_new);
        if (tid < 192) {
            const int e = tid; const float ve = bf2f(pr[1536 + h * 192 + e]);
            const float* C0 = p.in[I_SC] + sidx * 192 * 192; float* C1 = p.out + O_SC + sidx * 192 * 192;
            float num = 0.f, den = 0.f;
            for (int d = 0; d < 192; ++d) {
                const float c = a * C0[d * 192 + e] + bb * ks[d] * ve; C1[d * 192 + e] = c; num += qs[d] * c;
                const float nd = a * n0s[d] + bb * ks[d]; den += qs[d] * nd;
            }
            HR[(size_t)row * 768 + h * 192 + e] = num / fmaxf(fabsf(den), expf(-m_new));
            p.out[O_SN + sidx * 192 + e] = a * n0s[e] + bb * ks[e];
        }
        if (tid == 0) p.out[O_SM + sidx] = m_new;
    }
}
__device__ __forceinline__ void ph_mlstm_fin(const Params& p, int l) {
    const bf16_t* P = (const bf16_t*)(p.ws + B_P16); const float* HR = (const float*)(p.ws + B_HRAW); bf16_t* CATB = (bf16_t*)(p.ws + B_CATB); const float* g = p.in[I_GHN] + l * 192;
    const int tid_ = ltid(); const int lane = tid_ & 63, wid = tid_ >> 6;
    for (int row = blockIdx.x * NW_ + wid; row < MA; row += gridDim.x * NW_) {
        float v[4][3]; bf16_t og[4][3];
#pragma unroll
        for (int h = 0; h < 4; ++h)
#pragma unroll
            for (int i = 0; i < 3; ++i) { v[h][i] = HR[(size_t)row * 768 + h * 192 + lane + 64 * i]; og[h][i] = P[(size_t)row * LDA_ + 2304 + h * 192 + lane + 64 * i]; }
#pragma unroll
        for (int h = 0; h < 4; ++h) { float ss = v[h][0] * v[h][0] + v[h][1] * v[h][1] + v[h][2] * v[h][2]; ss = wave_sum(ss); const float rs = rsqrtf(ss * (1.0f / 192) + EPS);
#pragma unroll
            for (int i = 0; i < 3; ++i) { const int d = lane + 64 * i; CATB[(size_t)row * DM + h * 192 + d] = (bf16_t)f2bf(sigmoidf_(bf2f(og[h][i])) * (v[h][i] * rs * g[d])); } }
    }
}
__device__ __forceinline__ void ph_mem_attn(const Params& p, int l) {
    const int ldp = l < 2 ? LDA_ : LDB_, qoff = l < 2 ? 3072 : 768;
    const bf16_t* P = (const bf16_t*)(p.ws + B_P16); bf16_t* CATB = (bf16_t*)(p.ws + B_CATB); const float* gq = p.in[I_GMEMQ] + l * 64;
    for (int idx4 = blockIdx.x * NT_ + ltid(); idx4 < 16 * MA; idx4 += gridDim.x * NT_) {
        const int part = idx4 & 3, idx = idx4 >> 2;
        const int hh = idx / MA, row = idx % MA;
        const float* kvb = row < MP ? p.out + O_PMEM + (size_t)(l * 8 + row / SP) * 256 * 512 : p.in[I_CMEM] + (size_t)(l * 128 + (row - MP)) * 256 * 512;
        float q[16]; float ss = 0.f;
        const uint4* qp = (const uint4*)(P + (size_t)row * ldp + qoff + hh * 64 + part * 16);
#pragma unroll
        for (int i = 0; i < 2; ++i) { const uint4 t = qp[i]; q[8 * i] = bflo(t.x); q[8 * i + 1] = bfhi(t.x); q[8 * i + 2] = bflo(t.y); q[8 * i + 3] = bfhi(t.y); q[8 * i + 4] = bflo(t.z); q[8 * i + 5] = bfhi(t.z); q[8 * i + 6] = bflo(t.w); q[8 * i + 7] = bfhi(t.w); }
#pragma unroll
        for (int i = 0; i < 16; ++i) ss += q[i] * q[i];
        ss += __shfl_xor(ss, 1); ss += __shfl_xor(ss, 2);
        const float rs = rsqrtf(ss * (1.0f / 64) + EPS) * 0.125f;
#pragma unroll
        for (int i = 0; i < 16; ++i) q[i] *= rs * gq[part * 16 + i];
        float mx = -3e38f, den = 0.f; float o[16];
#pragma unroll
        for (int i = 0; i < 16; ++i) o[i] = 0.f;
        for (int m = 0; m < 256; ++m) {
            const float4* kp = (const float4*)(kvb + (size_t)m * 512 + hh * 64 + part * 16); const float4* vp = (const float4*)(kvb + (size_t)m * 512 + 256 + hh * 64 + part * 16);
            float s = 0.f;
#pragma unroll
            for (int i = 0; i < 4; ++i) { const float4 t = kp[i]; s += q[4 * i] * t.x + q[4 * i + 1] * t.y + q[4 * i + 2] * t.z + q[4 * i + 3] * t.w; }
            s += __shfl_xor(s, 1); s += __shfl_xor(s, 2);
            const float mn = fmaxf(mx, s); const float sc = expf(mx - mn), e = expf(s - mn); mx = mn; den = den * sc + e;
#pragma unroll
            for (int i = 0; i < 4; ++i) { const float4 t = vp[i]; o[4 * i] = o[4 * i] * sc + e * t.x; o[4 * i + 1] = o[4 * i + 1] * sc + e * t.y; o[4 * i + 2] = o[4 * i + 2] * sc + e * t.z; o[4 * i + 3] = o[4 * i + 3] * sc + e * t.w; }
        }
        const float inv = 1.0f / den; uint4* op = (uint4*)(CATB + (size_t)row * DM + 768 + hh * 64 + part * 16);
#pragma unroll
        for (int i = 0; i < 2; ++i) op[i] = make_uint4(pk2(o[8 * i] * inv, o[8 * i + 1] * inv), pk2(o[8 * i + 2] * inv, o[8 * i + 3] * inv), pk2(o[8 * i + 4] * inv, o[8 * i + 5] * inv), pk2(o[8 * i + 6] * inv, o[8 * i + 7] * inv));
    }
}
__device__ __forceinline__ void rows_post_tile(const Params& p, int row0, int t) {
    float* KVR = (float*)(p.ws + B_KVR); const int tid_ = ltid(); const int lane = tid_ & 63, wid = tid_ >> 6;
    const int c2 = lane >> 5, gg = (lane >> 4) & 1, d = (lane & 15) * 4; bf16_t* KVB = (bf16_t*)(p.ws + B_KVB); const size_t KT = (size_t)BP * 2 * SP * 64;
#pragma unroll 1
    for (int rr0 = wid; rr0 < 256; rr0 += 4 * NW_) {
      float4 vv[4];
#pragma unroll
      for (int k = 0; k < 4; ++k) { const int rowk = row0 + rr0 + k * NW_; vv[k] = ((const float4*)(KVR + (size_t)(rowk < MA ? rowk : MA - 1) * 768 + t * 256))[lane]; }
#pragma unroll
      for (int k = 0; k < 4; ++k) {
        const int row = row0 + rr0 + k * NW_; if (row >= MA) continue;
        float* r = KVR + (size_t)row * 768 + t * 256;
        float4 v = vv[k];
        if (t >= 1) {
            float ss = dot4(v, v);
            ss += __shfl_xor(ss, 1); ss += __shfl_xor(ss, 2); ss += __shfl_xor(ss, 4); ss += __shfl_xor(ss, 8);
            if (lane < 32) { const float rs = rsqrtf(ss * (1.0f / 64) + EPS); const float4 gk = ((const float4*)(t == 1 ? p.in[I_GKSLC] : p.in[I_GKWIN]))[lane & 15];
                v.x *= rs * gk.x; v.y *= rs * gk.y; v.z *= rs * gk.z; v.w *= rs * gk.w;
                if (row >= MP) ((float4*)r)[lane] = v; }
        }
        if (row < MP) {
            const int b = row / SP, sp = row % SP; const size_t off = (((size_t)b * 2 + gg) * SP + sp) * 64 + d;
            if (t == 0) { ((float4*)(p.out + O_PCMP + (size_t)row * 256))[lane] = v; *(uint2*)(KVB + (0 + c2) * KT + off) = make_uint2(pk2(v.x, v.y), pk2(v.z, v.w)); }
            else if (t == 2) { if (sp >= SP - 512) ((float4*)(p.out + O_PWIN + (size_t)(b * 512 + sp - (SP - 512)) * 256))[lane] = v; *(uint2*)(KVB + (4 + c2) * KT + off) = make_uint2(pk2(v.x, v.y), pk2(v.z, v.w)); }
            else {
                ((float4*)(p.out + O_PSLC + (size_t)row * 256))[lane] = v;
                const size_t blkbase = (((size_t)b * 2 + gg) * 32 + (sp >> 6)) * 4096;
                if (c2 == 0) { const int nt = (sp >> 4) & 3, fr2 = sp & 15, ks = d >> 5, fg2 = (d >> 3) & 3, e = d & 7;
                    *(uint2*)((bf16_t*)(p.ws + B_SKF) + blkbase + (size_t)(((nt * 2 + ks) * 64 + fg2 * 16 + fr2) * 8 + e)) = make_uint2(pk2(v.x, v.y), pk2(v.z, v.w)); }
                else { const int cs = (sp >> 5) & 1, kk = sp & 31, fg2 = (kk & 15) >> 2, e = (kk & 3) + (kk >= 16 ? 4 : 0), dt = d >> 4, fr2 = d & 15;
                    bf16_t* vf = (bf16_t*)(p.ws + B_SVF) + blkbase + (size_t)(((dt * 2 + cs) * 64 + fg2 * 16 + fr2) * 8 + e);
                    vf[0] = (bf16_t)f2bf(v.x); vf[8] = (bf16_t)f2bf(v.y); vf[16] = (bf16_t)f2bf(v.z); vf[24] = (bf16_t)f2bf(v.w); } }
        } else {
            const int b = row - MP;
            if (t == 0) ((float4*)(p.out + O_SCMP + (size_t)b * 256))[lane] = v; else if (t == 1) ((float4*)(p.out + O_SSLC + (size_t)b * 256))[lane] = v;
            else ((float4*)(p.out + O_SWIN + (size_t)(b * 512 + 511) * 256))[lane] = v;
        }
      }
    }
}
__device__ __forceinline__ float gelu_tanh(float x) { return 0.5f * x * (1.0f + tanhf(0.7978845608028654f * (x + 0.044715f * x * x * x))); }
__device__ __forceinline__ void ph_compress(const Params& p, float* lds) {
    const float* KVR = (const float*)(p.ws + B_KVR); const int tid = ltid();
    float* xs = lds;
    float* hs = lds + 4096;
    const float* w1 = p.in[I_CW1]; const float* w2 = p.in[I_CW2]; const int* pt = (const int*)p.in[I_PT];
    for (int item = blockIdx.x; item < 136 * 127 * 2; item += gridDim.x) {
        const int c = item & 1, n = (item >> 1) % 127, bb = (item >> 1) / 127;
        __syncthreads();
        for (int i = tid; i < 4096; i += NT_) {
            const int g = i >> 11, pp = (i >> 6) & 31, d = i & 63; const int tok = 16 * n + pp; float x;
            if (bb < 8) x = KVR[(size_t)(bb * SP + tok) * 768 + c * 128 + g * 64 + d];
            else { const int b = bb - 8; const int phys = pt[b * 16 + (tok >> 7)]; x = p.in[I_CCMP][((size_t)phys * 128 + (tok & 127)) * 256 + c * 128 + g * 64 + d]; }
            xs[i] = x + p.in[I_CPOS][(pp * 2 + c) * 64 + d];
        }
        __syncthreads();
        if (tid < 256) { const int g = tid >> 7, h = tid & 127; float pre = p.in[I_CB1][c * 128 + h]; const float* wp = w1 + (size_t)c * 2048 * 128 + h; const float* xp = xs + g * 2048;
          for (int i = 0; i < 2048; ++i) pre = fmaf(xp[i], wp[(size_t)i * 128], pre);
          hs[g * 128 + h] = gelu_tanh(pre); }
        __syncthreads();
        if (tid < 128) {
            const int g = tid >> 6, d = tid & 63; float o = p.in[I_CB2][c * 64 + d];
            for (int h = 0; h < 128; ++h) o = fmaf(hs[g * 128 + h], w2[(size_t)(c * 128 + h) * 64 + d], o);
            if (c == 0) { const float ss = wave_sum(o * o); o = o * rsqrtf(ss * (1.0f / 64) + EPS) * p.in[I_GKCMP][d]; }
            ((float*)(p.ws + (c == 0 ? B_CK : B_CV)))[((size_t)bb * 127 + n) * 128 + g * 64 + d] = o;
            bf16_t* kc = (bf16_t*)(p.ws + B_KC16) + ((((size_t)bb * 2 + c) * 2 + g) * 128 + n) * 64 + d; kc[0] = (bf16_t)f2bf(o); if (n == 126) kc[64] = 0;
        }
    }
}
#ifndef NSA_NAIVE_ALL
#define NSA_NAIVE_ALL 0
#endif
__device__ __forceinline__ void row_softmax(float* r, int n, int lane) {
    float mx = NEGM;
    for (int i = lane; i < n; i += 64) mx = fmaxf(mx, r[i]);
    mx = wave_max(mx);
    if (mx <= 0.5f * NEGM) { for (int i = lane; i < n; i += 64) r[i] = 0.f; return; }
    float s = 0.f;
    for (int i = lane; i < n; i += 64) { const float e = r[i] <= 0.5f * NEGM ? 0.f : expf(r[i] - mx); r[i] = e; s += e; }
    s = wave_sum(s); const float inv = 1.0f / s;
    for (int i = lane; i < n; i += 64) r[i] *= inv;
}
__device__ __forceinline__ void ph_nsa(const Params& p, int j, float* lds) {
    const int tid = ltid(), lane = tid & 63, wid = tid >> 6;
    float* qs = lds;
    float* sc = lds + 384;
    float* imp = sc + 3072;
    int* sel = (int*)(imp + 40);
    float* gate = (float*)(sel + 8);
    float* oacc = gate + 24;
    const bf16_t* P = (const bf16_t*)(p.ws + B_P16); const float* GT = (const float*)(p.ws + B_GT); const float* KVR = (const float*)(p.ws + B_KVR); bf16_t* CATB = (bf16_t*)(p.ws + B_CATB);
    const float* table = p.in[I_REL]; const int* pt = (const int*)p.in[I_PT];
    for (int item = blockIdx.x; item < (NSA_NAIVE_ALL ? MA : BS) * 2; item += gridDim.x) {
        const int row = (NSA_NAIVE_ALL ? 0 : MP) + (item >> 1), g = item & 1; const bool smp = row >= MP;
        const int b = smp ? row - MP : row / SP, pos = smp ? PAST : row % SP;
        const bf16_t* pr = P + (size_t)row * LDB_;
        __syncthreads();
        if (wid < 6) { const int z = wid; const float v = bf2f(pr[(g * 6 + z) * 64 + lane]); const float ss = wave_sum(v * v); qs[z * 64 + lane] = v * rsqrtf(ss * (1.0f / 64) + EPS) * p.in[I_GQ][j * 64 + lane]; }
        if (tid >= 384 && tid < 384 + 18) { const int t2 = tid - 384; const int br = t2 / 6, z = t2 % 6; gate[t2] = sigmoidf_(GT[(size_t)row * GTW + br * 12 + g * 6 + z] + p.in[I_BGATE][j * 36 + br * 12 + g * 6 + z]); }
        if (tid < 384) oacc[tid] = 0.f;
        __syncthreads();
        const float* ck = (const float*)(p.ws + B_CK) + (size_t)(smp ? 8 + b : b) * 127 * 128; const float* cv = (const float*)(p.ws + B_CV) + (size_t)(smp ? 8 + b : b) * 127 * 128;
        for (int i = tid; i < 6 * 127; i += NT_) {
            const int z = i / 127, n = i % 127; const int dist = pos - (16 * n + 31); float s = NEGM;
            if (dist >= 0) { const float4* kp = (const float4*)(ck + n * 128 + g * 64); const float4* qp = (const float4*)(qs + z * 64); float a = 0.f;
#pragma unroll 4
                for (int d = 0; d < 16; ++d) a += dot4(kp[d], qp[d]);
                s = a * 0.125f + table[rel_bucket(dist) * 12 + g * 6 + z]; }
            sc[z * 128 + n] = s;
        }
        __syncthreads();
        if (wid < 6) row_softmax(sc + wid * 128, 127, lane);
        __syncthreads();
        const int nslc = smp ? 33 : 32, cur = pos >> 6;
        if (tid < nslc) { const int jb = tid; float s = 0.f;
            for (int z = 0; z < 6; ++z) for (int n = 0; n < 127; ++n) { const int lo = max(16 * n, 64 * jb), hi = min(16 * n + 32, 64 * jb + 64); if (hi > lo) s += sc[z * 128 + n] * (float)(hi - lo) * (1.0f / 16); }
            imp[jb] = s; }
        __syncthreads();
        if (tid == 0) {
            int cnt = 0;
            if (cur + 1 <= 8) { for (int jb = 0; jb <= cur; ++jb) sel[cnt++] = jb; }
            else {
                sel[0] = 0; sel[1] = cur; sel[2] = cur - 1; cnt = 3; unsigned long long taken = 0ull;
                for (int k = 0; k < 5; ++k) { int best = -1; float bv = -1.f;
                    for (int jb = 1; jb <= cur - 2; ++jb) if (!((taken >> jb) & 1ull) && imp[jb] > bv) { bv = imp[jb]; best = jb; }
                    if (best >= 0) { taken |= 1ull << best; sel[cnt++] = best; } }
            }
            for (; cnt < 8; ++cnt) sel[cnt] = -1;
        }
        if (tid < 384) { const int z = tid >> 6, d = tid & 63; float o = 0.f;
            for (int n = 0; n < 127; ++n) o = fmaf(sc[z * 128 + n], cv[n * 128 + g * 64 + d], o);
            oacc[tid] += gate[0 * 6 + z] * o; }
        __syncthreads();
        for (int br = 1; br <= 2; ++br) {
            { const int t = tid;
                const float* kp = nullptr; int dist = -1;
                if (br == 1) {
                    const int blk = sel[t >> 6];
                    if (blk >= 0) { const int tok = blk * 64 + (t & 63); dist = pos - tok;
                        if (dist >= 0) { if (!smp) kp = KVR + (size_t)(b * SP + tok) * 768 + 256 + g * 64;
                            else if (tok < PAST) kp = p.in[I_CSLC] + ((size_t)pt[b * 16 + (tok >> 7)] * 128 + (tok & 127)) * 256 + g * 64;
                            else kp = KVR + (size_t)row * 768 + 256 + g * 64; } }
                } else {
                    const int kpos = pos - 511 + t; dist = 511 - t;
                    if (!smp) { if (kpos >= 0) kp = KVR + (size_t)(b * SP + kpos) * 768 + 512 + g * 64; else dist = -1; }
                    else { if (kpos < PAST) kp = p.in[I_CWIN] + ((size_t)b * 512 + (kpos - (PAST - 512))) * 256 + g * 64; else kp = KVR + (size_t)row * 768 + 512 + g * 64; }
                }
                if (dist >= 0 && kp) {
                    float s[6] = {0.f, 0.f, 0.f, 0.f, 0.f, 0.f};
#pragma unroll 2
                    for (int d = 0; d < 16; ++d) { const float4 kk = ((const float4*)kp)[d];
#pragma unroll
                        for (int z = 0; z < 6; ++z) s[z] += dot4(kk, ((const float4*)(qs + z * 64))[d]); }
                    const int bk = rel_bucket(dist);
#pragma unroll
                    for (int z = 0; z < 6; ++z) sc[z * 512 + t] = s[z] * 0.125f + table[bk * 12 + g * 6 + z];
                } else {
#pragma unroll
                    for (int z = 0; z < 6; ++z) sc[z * 512 + t] = NEGM;
                }
            }
            __syncthreads();
            if (wid < 6) row_softmax(sc + wid * 512, 512, lane);
            __syncthreads();
            if (tid < 384) { const int z = tid >> 6, d = tid & 63; float o = 0.f;
                for (int t = 0; t < 512; ++t) { const float pw = sc[z * 512 + t]; if (pw != 0.f) { const float* vp;
                    if (br == 1) { const int tok = sel[t >> 6] * 64 + (t & 63);
                        if (!smp) vp = KVR + (size_t)(b * SP + tok) * 768 + 256 + 128 + g * 64;
                        else if (tok < PAST) vp = p.in[I_CSLC] + ((size_t)pt[b * 16 + (tok >> 7)] * 128 + (tok & 127)) * 256 + 128 + g * 64;
                        else vp = KVR + (size_t)row * 768 + 256 + 128 + g * 64;
                    } else { const int kpos = pos - 511 + t;
                        if (!smp) vp = KVR + (size_t)(b * SP + kpos) * 768 + 512 + 128 + g * 64;
                        else if (kpos < PAST) vp = p.in[I_CWIN] + ((size_t)b * 512 + (kpos - (PAST - 512))) * 256 + 128 + g * 64;
                        else vp = KVR + (size_t)row * 768 + 512 + 128 + g * 64; }
                    o = fmaf(pw, vp[d], o); } }
                oacc[tid] += gate[br * 6 + z] * o; }
            __syncthreads();
        }
        if (tid < 384) CATB[(size_t)row * DM + g * 384 + tid] = (bf16_t)f2bf(oacc[tid]);
    }
}
constexpr size_t KVB_T = (size_t)BP * 2 * SP * 64;
typedef short v4i16_t __attribute__((ext_vector_type(4)));
typedef short bf16x8_t __attribute__((ext_vector_type(8)));
typedef float f32x4_t __attribute__((ext_vector_type(4)));
typedef unsigned u32x4_t __attribute__((ext_vector_type(4)));
__device__ __forceinline__ bf16x8_t ldtr2(const LAS unsigned char* p0, const LAS unsigned char* p1) {
    const v4i16_t a = __builtin_amdgcn_ds_read_tr16_b64_v4i16((LAS v4i16_t*)p0), b = __builtin_amdgcn_ds_read_tr16_b64_v4i16((LAS v4i16_t*)p1);
    return __builtin_shufflevector(a, b, 0, 1, 2, 3, 4, 5, 6, 7);
}
__device__ __forceinline__ unsigned cvtpk(float lo, float hi) { unsigned r; asm volatile("v_cvt_pk_bf16_f32 %0, %1, %2" : "=v"(r) : "v"(lo), "v"(hi)); return r; }
__device__ __forceinline__ bf16x8_t pack8(f32x4_t a, f32x4_t b) { uint4 w; w.x = cvtpk(a[0], a[1]); w.y = cvtpk(a[2], a[3]); w.z = cvtpk(b[0], b[1]); w.w = cvtpk(b[2], b[3]); return __builtin_bit_cast(bf16x8_t, w); }
__device__ __forceinline__ f32x4_t mfma16(bf16x8_t a, bf16x8_t b, f32x4_t c) { return __builtin_amdgcn_mfma_f32_16x16x32_bf16(a, b, c, 0, 0, 0); }
__device__ __forceinline__ float ex2(float x) { return __builtin_amdgcn_exp2f(x); }
__device__ __forceinline__ float xmax4(float x) {
    auto s = __builtin_amdgcn_permlane16_swap(__float_as_uint(x), __float_as_uint(x), false, false);
    x = fmaxf(__uint_as_float(s[0]), __uint_as_float(s[1]));
    auto t = __builtin_amdgcn_permlane32_swap(__float_as_uint(x), __float_as_uint(x), false, false);
    return fmaxf(__uint_as_float(t[0]), __uint_as_float(t[1]));
}
__device__ __forceinline__ float xsum4(float x) {
    auto s = __builtin_amdgcn_permlane16_swap(__float_as_uint(x), __float_as_uint(x), false, false);
    x = __uint_as_float(s[0]) + __uint_as_float(s[1]);
    auto t = __builtin_amdgcn_permlane32_swap(__float_as_uint(x), __float_as_uint(x), false, false);
    return __uint_as_float(t[0]) + __uint_as_float(t[1]);
}
constexpr float LOG2E = 1.4426950408889634f, NINF = -__builtin_inff();
constexpr int KROW = 144;

__device__ __forceinline__ void ph_nsa_fast(const Params& p, int j, LAS unsigned char* lds) {
    const int tid = ltid(), lane0 = tid & 63, w = tid >> 6;
    unsigned char* ws = p.ws;
    const bf16_t* P16 = (const bf16_t*)(ws + B_P16); const float* GT = (const float*)(ws + B_GT); bf16_t* CATB = (bf16_t*)(ws + B_CATB);
    const bf16_t* KVB = (const bf16_t*)(ws + B_KVB); const bf16_t* KC16 = (const bf16_t*)(ws + B_KC16);
    LAS unsigned char* Kw = lds;
    LAS unsigned char* Vw = lds + 18432;
    LAS unsigned char* Kc = lds + 36864;
    LAS unsigned char* Vc = lds + 55296;
    LAS float* biasT = (LAS float*)(lds + 73728);
    LAS float* impL = (LAS float*)(lds + 73728 + 3072);
    LAS int* selL = (LAS int*)(lds + 73728 + 3072 + 16384);
    const float* table = p.in[I_REL]; const float* gq = p.in[I_GQ] + j * 64; const float* bgate = p.in[I_BGATE] + j * 36;
    for (int unit = blockIdx.x; unit < 256; unit += gridDim.x) {
        int lane_a = lane0; asm volatile("" : "+v"(lane_a)); const int lane = lane_a, fr = lane & 15, fg = lane >> 4;
        const int g = unit & 1, b = (unit >> 1) & 7, tile = unit >> 4, t0 = tile * 128, tw = t0 + 16 * w, trow = tw + fr;
        TSUB_BEGIN();
        __syncthreads();
        for (int i = tid; i < 2048; i += NT_) { const int tsel = i >> 10, r = (i >> 3) & 127, ch = i & 7;
            const u32x4_t v = *(const u32x4_t*)(KC16 + (((size_t)b * 2 + tsel) * 2 + g) * 128 * 64 + r * 64 + ch * 8);
            *(LAS u32x4_t*)((tsel ? Vc : Kc) + r * KROW + ch * 16) = v; }
        for (int i = tid; i < 768; i += NT_) { const int d = i / 6, z = i % 6; biasT[i] = table[rel_bucket_alu(d) * 12 + g * 6 + z] * LOG2E; }
        if (tid < 64) ((LAS float*)(lds + 73728 + 3072 + 16384 + 4096))[tid] = gq[tid] * (0.125f * LOG2E);
        __syncthreads();
        const bf16_t* qrow = P16 + (size_t)(b * SP + trow) * LDB_ + g * 384;
        LAS float* gqL = (LAS float*)(lds + 73728 + 3072 + 16384 + 4096);
#define FETCH_Q(z_, ra_, rb_) do { ra_ = *(const uint4*)(qrow + (z_) * 64 + fg * 8); rb_ = *(const uint4*)(qrow + (z_) * 64 + 32 + fg * 8); } while (0)
#define LOAD_Q(z_, q0_, q1_) do { uint4 r0, r1; FETCH_Q(z_, r0, r1); FINISH_Q(r0, r1, q0_, q1_); } while (0)
#define FINISH_Q(r0, r1, q0_, q1_) do { \
            float v[16] = {bflo(r0.x), bfhi(r0.x), bflo(r0.y), bfhi(r0.y), bflo(r0.z), bfhi(r0.z), bflo(r0.w), bfhi(r0.w), bflo(r1.x), bfhi(r1.x), bflo(r1.y), bfhi(r1.y), bflo(r1.z), bfhi(r1.z), bflo(r1.w), bfhi(r1.w)}; \
            float ss = 0.f; _Pragma("unroll") for (int i = 0; i < 16; ++i) ss += v[i] * v[i]; \
            ss = xsum4(ss); const float rs = rsqrtf(ss * (1.0f / 64) + EPS); { const f32x4_t g0 = *(const LAS f32x4_t*)(gqL + fg * 8), g1 = *(const LAS f32x4_t*)(gqL + fg * 8 + 4), g2 = *(const LAS f32x4_t*)(gqL + 32 + fg * 8), g3 = *(const LAS f32x4_t*)(gqL + 32 + fg * 8 + 4); \
              _Pragma("unroll") for (int i = 0; i < 4; ++i) { v[i] *= rs * g0[i]; v[4 + i] *= rs * g1[i]; v[8 + i] *= rs * g2[i]; v[12 + i] *= rs * g3[i]; } } \
            q0_ = pack8((f32x4_t){v[0], v[1], v[2], v[3]}, (f32x4_t){v[4], v[5], v[6], v[7]}); q1_ = pack8((f32x4_t){v[8], v[9], v[10], v[11]}, (f32x4_t){v[12], v[13], v[14], v[15]}); } while (0)
        const float* gtrow = GT + (size_t)(b * SP + trow) * GTW;
#pragma unroll 1
        for (int hp = 0; hp < 2; ++hp) {
        bf16x8_t qf[3][2];
#pragma unroll
        for (int z = 0; z < 3; ++z) LOAD_Q(hp * 3 + z, qf[z][0], qf[z][1]);
        f32x4_t O[3][4]; float mrun[3], lrun[3];
#pragma unroll
        for (int z = 0; z < 3; ++z) { mrun[z] = NINF; lrun[z] = 0.f;
#pragma unroll
            for (int dt = 0; dt < 4; ++dt) O[z][dt] = (f32x4_t){0.f, 0.f, 0.f, 0.f}; }
        const bf16_t* WK = KVB + 4 * KVB_T + ((size_t)b * 2 + g) * SP * 64; const bf16_t* WV = KVB + 5 * KVB_T + ((size_t)b * 2 + g) * SP * 64;
        u32x4_t rst[4];
#define WIN_LOAD(it_) do { const int k128_ = t0 - 512 + 128 * (it_); _Pragma("unroll") for (int q_ = 0; q_ < 4; ++q_) { const int i_ = tid + NT_ * q_, tsel_ = i_ >> 10, r_ = (i_ >> 3) & 127, ch_ = i_ & 7; const int tok_ = k128_ + r_; \
            rst[q_] = (u32x4_t){0u, 0u, 0u, 0u}; if (tok_ >= 0) rst[q_] = *(const u32x4_t*)((tsel_ ? WV : WK) + (size_t)tok_ * 64 + ch_ * 8); } } while (0)
#define WIN_STORE() do { _Pragma("unroll") for (int q_ = 0; q_ < 4; ++q_) { const int i_ = tid + NT_ * q_, tsel_ = i_ >> 10, r_ = (i_ >> 3) & 127, ch_ = i_ & 7; *(LAS u32x4_t*)((tsel_ ? Vw : Kw) + r_ * KROW + ch_ * 16) = rst[q_]; } } while (0)
        WIN_LOAD(0);
        __syncthreads();
        WIN_STORE();
#pragma unroll 1
        for (int it = 0; it < 5; ++it) {
            const int k128 = t0 - 512 + 128 * it;
            BAR_LDS();
            if (it + 1 < 5) WIN_LOAD(it + 1);
#pragma unroll 1
            for (int sc = 0; sc < 4; ++sc) {
                const int kb = k128 + 32 * sc;
                if (kb > tw + 15 || kb + 31 < tw - 511 || kb + 31 < 0) continue;
                const bool fast = (kb + 31 <= tw - 113) && (kb >= tw + 15 - 511) && kb >= 0;
                bf16x8_t kf[2][2], vf[4];
#pragma unroll
                for (int nt = 0; nt < 2; ++nt)
#pragma unroll
                    for (int ks = 0; ks < 2; ++ks) kf[nt][ks] = *(const LAS bf16x8_t*)(Kw + (32 * sc + 16 * nt + fr) * KROW + (ks * 32 + fg * 8) * 2);
#pragma unroll
                for (int dt = 0; dt < 4; ++dt) { const LAS unsigned char* vp = Vw + (32 * sc + 4 * fg + (fr >> 2)) * KROW + (16 * dt + 4 * (fr & 3)) * 2; vf[dt] = ldtr2(vp, vp + 16 * KROW); }
#pragma unroll
                for (int z = 0; z < 3; ++z) {
                    f32x4_t s0 = (f32x4_t){0.f, 0.f, 0.f, 0.f}, s1 = s0;
                    s0 = mfma16(kf[0][0], qf[z][0], s0); s0 = mfma16(kf[0][1], qf[z][1], s0);
                    s1 = mfma16(kf[1][0], qf[z][0], s1); s1 = mfma16(kf[1][1], qf[z][1], s1);
                    if (fast) { const float cb = biasT[127 * 6 + hp * 3 + z]; s0 = s0 + cb; s1 = s1 + cb; }
                    else {
#pragma unroll
                        for (int jj = 0; jj < 4; ++jj) { const int key0 = kb + 4 * fg + jj, d0 = trow - key0, d1 = d0 - 16;
                            s0[jj] = (d0 >= 0 && d0 < 512 && key0 >= 0) ? s0[jj] + biasT[min(d0, 127) * 6 + hp * 3 + z] : NINF;
                            s1[jj] = (d1 >= 0 && d1 < 512 && key0 + 16 >= 0) ? s1[jj] + biasT[min(d1, 127) * 6 + hp * 3 + z] : NINF; }
                    }
                    float mx = fmaxf(fmaxf(fmaxf(s0[0], s0[1]), fmaxf(s0[2], s0[3])), fmaxf(fmaxf(s1[0], s1[1]), fmaxf(s1[2], s1[3])));
                    mx = xmax4(mx);
                    float msafe;
                    if (__any(mx > mrun[z] + 8.f)) {
                        const float mnew = fmaxf(mrun[z], mx); msafe = mnew == NINF ? 0.f : mnew;
                        const float alpha = ex2(mrun[z] - msafe);
                        mrun[z] = mnew; lrun[z] = lrun[z] * alpha;
#pragma unroll
                        for (int dt = 0; dt < 4; ++dt) O[z][dt] = O[z][dt] * alpha;
                    } else msafe = mrun[z] == NINF ? 0.f : mrun[z];
                    f32x4_t p0, p1;
#pragma unroll
                    for (int jj = 0; jj < 4; ++jj) { p0[jj] = ex2(s0[jj] - msafe); p1[jj] = ex2(s1[jj] - msafe); }
                    lrun[z] = lrun[z] + (((p0[0] + p0[1]) + (p0[2] + p0[3])) + ((p1[0] + p1[1]) + (p1[2] + p1[3])));
                    const bf16x8_t pf = pack8(p0, p1);
#pragma unroll
                    for (int dt = 0; dt < 4; ++dt) O[z][dt] = mfma16(vf[dt], pf, O[z][dt]);
                }
            }
            if (it + 1 < 5) { BAR_LDS(); WIN_STORE(); }
        }
#undef WIN_LOAD
#undef WIN_STORE
#pragma unroll
        for (int z = 0; z < 3; ++z) { const int hz2 = hp * 3 + z; const float lt = xsum4(lrun[z]); const float gw = sigmoidf_(gtrow[24 + g * 6 + hz2] + bgate[24 + g * 6 + hz2]); const float sc = gw / lt;
            bf16_t* orow = CATB + (size_t)(b * SP + trow) * DM + (g * 6 + hz2) * 64;
#pragma unroll
            for (int dt = 0; dt < 4; ++dt) { const f32x4_t v = O[z][dt] * sc; *(uint2*)(orow + 16 * dt + 4 * fg) = make_uint2(cvtpk(v[0], v[1]), cvtpk(v[2], v[3])); } }
        }
        asm volatile("s_waitcnt vmcnt(0)" ::: "memory");
        TSUB_END(0);
        float impacc[8];
#pragma unroll
        for (int nt = 0; nt < 8; ++nt) impacc[nt] = 0.f;
        const int nmax = trow >= 31 ? (trow - 31) >> 4 : -1;
        uint4 rqa_c, rqb_c; FETCH_Q(0, rqa_c, rqb_c);
#pragma unroll 1
        for (int z = 0; z < 6; ++z) {
            bf16_t* orow = CATB + (size_t)(b * SP + trow) * DM + (g * 6 + z) * 64; unsigned long long oldc[4];
#pragma unroll
            for (int dt = 0; dt < 4; ++dt) oldc[dt] = __hip_atomic_load((unsigned long long*)(orow + 16 * dt + 4 * fg), __ATOMIC_RELAXED, __HIP_MEMORY_SCOPE_AGENT);
            const float gcraw = gtrow[g * 6 + z];
            f32x4_t s[8]; bf16x8_t qz[2]; { const uint4 ra = rqa_c, rb = rqb_c; if (z + 1 < 6) FETCH_Q(z + 1, rqa_c, rqb_c); FINISH_Q(ra, rb, qz[0], qz[1]); }
#pragma unroll
            for (int nt = 0; nt < 8; ++nt) { s[nt] = (f32x4_t){0.f, 0.f, 0.f, 0.f};
#pragma unroll
                for (int ks = 0; ks < 2; ++ks) { const bf16x8_t kf = *(const LAS bf16x8_t*)(Kc + (16 * nt + fr) * KROW + (ks * 32 + fg * 8) * 2); s[nt] = mfma16(kf, qz[ks], s[nt]); } }
            float mx = NINF;
#pragma unroll
            for (int nt = 0; nt < 8; ++nt)
#pragma unroll
                for (int jj = 0; jj < 4; ++jj) { const int n = 16 * nt + 4 * fg + jj; const int dist = trow - 16 * n - 31;
                    const float v = (n <= nmax && n <= 126) ? s[nt][jj] + biasT[min(dist, 127) * 6 + z] : NINF; s[nt][jj] = v; mx = fmaxf(mx, v); }
            asm volatile("" ::: "memory");
            mx = xmax4(mx); const float msafe = mx == NINF ? 0.f : mx; float sum = 0.f;
#pragma unroll
            for (int nt = 0; nt < 8; ++nt)
#pragma unroll
                for (int jj = 0; jj < 4; ++jj) { const float e = ex2(s[nt][jj] - msafe); s[nt][jj] = e; sum += e; }
            sum = xsum4(sum); const float inv = sum > 0.f ? 1.0f / sum : 0.f;
            float p3prev = 0.f;
#pragma unroll
            for (int nt = 0; nt < 8; ++nt) { s[nt] = s[nt] * inv;
                const float p3 = s[nt][3]; const float up = __shfl(p3, (lane + 48) & 63);
                const float prev_tile = __shfl(p3prev, (lane + 48) & 63);
                impacc[nt] += 2.0f * (s[nt][0] + s[nt][1] + s[nt][2]) + p3 + (fg == 0 ? prev_tile : up);
                p3prev = p3; }
            f32x4_t oc[4];
#pragma unroll
            for (int dt = 0; dt < 4; ++dt) oc[dt] = (f32x4_t){0.f, 0.f, 0.f, 0.f};
#pragma unroll
            for (int c2 = 0; c2 < 4; ++c2) { const bf16x8_t pf = pack8(s[2 * c2], s[2 * c2 + 1]);
#pragma unroll
                for (int dt = 0; dt < 4; ++dt) { const LAS unsigned char* vp = Vc + (32 * c2 + 4 * fg + (fr >> 2)) * KROW + (16 * dt + 4 * (fr & 3)) * 2; oc[dt] = mfma16(ldtr2(vp, vp + 16 * KROW), pf, oc[dt]); }
                asm volatile("" ::: "memory"); }
            const float gc = sigmoidf_(gcraw + bgate[g * 6 + z]);
#pragma unroll
            for (int dt = 0; dt < 4; ++dt) { const unsigned long long o64 = oldc[dt];
                const f32x4_t v = oc[dt] * gc + (f32x4_t){bflo((unsigned)o64), bfhi((unsigned)o64), bflo((unsigned)(o64 >> 32)), bfhi((unsigned)(o64 >> 32))};
                *(uint2*)(orow + 16 * dt + 4 * fg) = make_uint2(cvtpk(v[0], v[1]), cvtpk(v[2], v[3])); }
        }
        TSUB_END(1);
#pragma unroll
        for (int nt = 0; nt < 8; ++nt) impL[(w * 16 + fr) * 32 + 4 * nt + fg] = impacc[nt];
        asm volatile("s_waitcnt lgkmcnt(0)" ::: "memory");
        if (lane < 16) {
            const int t = tw + lane, cur = t >> 6; LAS int* so = selL + (w * 16 + lane) * 8; const LAS float* im = impL + (w * 16 + lane) * 32;
            int cnt = 0;
            if (cur + 1 <= 8) { for (int jb = 0; jb <= cur; ++jb) so[cnt++] = jb; }
            else {
                so[1] = 0; so[3] = cur; so[5] = cur - 1; unsigned taken = 0u;
                for (int k = 0; k < 5; ++k) { int best = -1; float bv = -1.f;
                    for (int jb = 1; jb <= cur - 2; ++jb) { const float v = im[jb]; if (!((taken >> jb) & 1u) && v > bv) { bv = v; best = jb; } }
                    taken |= 1u << best; so[k < 3 ? 2 * k : 3 + k] = best; }
                cnt = 8; }
            for (; cnt < 8; ++cnt) so[cnt] = -1;
        }
        asm volatile("s_waitcnt vmcnt(0) lgkmcnt(0)" ::: "memory");
        const bf16_t* SKF = (const bf16_t*)(ws + B_SKF) + ((size_t)b * 2 + g) * 32 * 4096; const bf16_t* SVF = (const bf16_t*)(ws + B_SVF) + ((size_t)b * 2 + g) * 32 * 4096;
        const int c0 = 2 * tile;
        TSUB_END(2);
        __syncthreads();
        for (int i = tid; i < 4 * 1024; i += NT_) { const int slot = i >> 10, r = i & 1023; const int blk = slot == 0 ? 0 : c0 - 2 + slot;
            if (blk >= 0 && blk < 32) { const u32x4_t v = *(const u32x4_t*)((r < 512 ? SKF : SVF) + (size_t)blk * 4096 + (r & 511) * 8); *(LAS u32x4_t*)(lds + slot * 16384 + r * 16) = v; } }
        __syncthreads();
        { int lane_b = lane0; asm volatile("" : "+v"(lane_b)); const int lane = lane_b, fr = lane & 15, fg = lane >> 4;
        const int hz = fr < 6 ? fr : 5;
        uint4 rqa, rqb;
        { const bf16_t* qrow = P16 + ((size_t)b * SP + tw) * LDB_ + g * 384 + hz * 64; rqa = *(const uint4*)(qrow + fg * 8); rqb = *(const uint4*)(qrow + 32 + fg * 8); }
#pragma unroll 1
        for (int ti = 0; ti < 16; ++ti) {
            const int t = tw + ti; const size_t row = (size_t)b * SP + t;
            bf16x8_t qs[2];
            const uint4 r0 = rqa, r1 = rqb;
            if (ti + 1 < 16) { const bf16_t* qrow = P16 + (row + 1) * LDB_ + g * 384 + hz * 64; rqa = *(const uint4*)(qrow + fg * 8); rqb = *(const uint4*)(qrow + 32 + fg * 8); }
            bf16_t* orow = CATB + row * DM + (g * 6 + hz) * 64; unsigned long long oldv[4];
#pragma unroll
            for (int dt = 0; dt < 4; ++dt) oldv[dt] = __hip_atomic_load((unsigned long long*)(orow + 16 * dt + 4 * fg), __ATOMIC_RELAXED, __HIP_MEMORY_SCOPE_AGENT);
            const float graw = GT[row * GTW + 12 + g * 6 + hz];
            {
              float v[16] = {bflo(r0.x), bfhi(r0.x), bflo(r0.y), bfhi(r0.y), bflo(r0.z), bfhi(r0.z), bflo(r0.w), bfhi(r0.w), bflo(r1.x), bfhi(r1.x), bflo(r1.y), bfhi(r1.y), bflo(r1.z), bfhi(r1.z), bflo(r1.w), bfhi(r1.w)};
              float ss = 0.f;
#pragma unroll
              for (int i = 0; i < 16; ++i) ss += v[i] * v[i];
              ss = xsum4(ss); const float rs = rsqrtf(ss * (1.0f / 64) + EPS) * (0.125f * LOG2E);
#pragma unroll
              for (int i = 0; i < 8; ++i) { v[i] *= rs * gq[fg * 8 + i]; v[8 + i] *= rs * gq[32 + fg * 8 + i]; }
              qs[0] = pack8((f32x4_t){v[0], v[1], v[2], v[3]}, (f32x4_t){v[4], v[5], v[6], v[7]});
              qs[1] = pack8((f32x4_t){v[8], v[9], v[10], v[11]}, (f32x4_t){v[12], v[13], v[14], v[15]}); }
            f32x4_t os[4]; float ms = NINF, ls = 0.f;
#pragma unroll
            for (int dt = 0; dt < 4; ++dt) os[dt] = (f32x4_t){0.f, 0.f, 0.f, 0.f};
#define SLC_LOADK(KF, blk_) do { const int slot_ = (blk_) == 0 ? 0 : ((blk_) >= c0 - 1 ? (blk_) - c0 + 2 : -1); \
                if (slot_ >= 0) { const LAS unsigned char* fb_ = lds + slot_ * 16384 + lane * 16; \
                    _Pragma("unroll") for (int nt = 0; nt < 4; ++nt) _Pragma("unroll") for (int ks = 0; ks < 2; ++ks) KF[nt][ks] = *(const LAS bf16x8_t*)(fb_ + (nt * 2 + ks) * 1024); \
                } else { const bf16_t* kb_ = SKF + (size_t)(blk_) * 4096 + lane * 8; \
                    _Pragma("unroll") for (int nt = 0; nt < 4; ++nt) _Pragma("unroll") for (int ks = 0; ks < 2; ++ks) KF[nt][ks] = *(const bf16x8_t*)(kb_ + (nt * 2 + ks) * 512); } } while (0)
#define SLC_LOADV(VF, blk_) do { const int slot_ = (blk_) == 0 ? 0 : ((blk_) >= c0 - 1 ? (blk_) - c0 + 2 : -1); \
                if (slot_ >= 0) { const LAS unsigned char* fb_ = lds + slot_ * 16384 + lane * 16; \
                    _Pragma("unroll") for (int dt = 0; dt < 4; ++dt) _Pragma("unroll") for (int cs = 0; cs < 2; ++cs) VF[dt][cs] = *(const LAS bf16x8_t*)(fb_ + 8192 + (dt * 2 + cs) * 1024); \
                } else { const bf16_t* vb_ = SVF + (size_t)(blk_) * 4096 + lane * 8; \
                    _Pragma("unroll") for (int dt = 0; dt < 4; ++dt) _Pragma("unroll") for (int cs = 0; cs < 2; ++cs) VF[dt][cs] = *(const bf16x8_t*)(vb_ + (dt * 2 + cs) * 512); } } while (0)
#define SLC_COMPUTE(KF, VF, blk_, nblk_) do { const int tok0 = (blk_) * 64; f32x4_t s[4]; \
                _Pragma("unroll") for (int nt = 0; nt < 4; ++nt) { s[nt] = (f32x4_t){0.f, 0.f, 0.f, 0.f}; s[nt] = mfma16(KF[nt][0], qs[0], s[nt]); s[nt] = mfma16(KF[nt][1], qs[1], s[nt]); } \
                float mx = NINF; \
                if (tok0 + 63 <= t - 113) { const float cb = biasT[127 * 6 + hz]; \
                    _Pragma("unroll") for (int nt = 0; nt < 4; ++nt) { s[nt] = s[nt] + cb; mx = fmaxf(mx, fmaxf(fmaxf(s[nt][0], s[nt][1]), fmaxf(s[nt][2], s[nt][3]))); } } \
                else { _Pragma("unroll") for (int nt = 0; nt < 4; ++nt) _Pragma("unroll") for (int jj = 0; jj < 4; ++jj) { const int dist = t - (tok0 + 16 * nt + 4 * fg + jj); const float v = dist >= 0 ? s[nt][jj] + biasT[min(dist, 127) * 6 + hz] : NINF; s[nt][jj] = v; mx = fmaxf(mx, v); } } \
                mx = xmax4(mx); \
                float msafe; \
                if (__any(mx > ms + 8.f)) { const float mnew = fmaxf(ms, mx); msafe = mnew == NINF ? 0.f : mnew; const float alpha = ex2(ms - msafe); ms = mnew; ls = ls * alpha; \
                    _Pragma("unroll") for (int dt = 0; dt < 4; ++dt) os[dt] = os[dt] * alpha; } \
                else msafe = ms == NINF ? 0.f : ms; \
                float sum = 0.f; \
                _Pragma("unroll") for (int nt = 0; nt < 4; ++nt) _Pragma("unroll") for (int jj = 0; jj < 4; ++jj) { const float e = ex2(s[nt][jj] - msafe); s[nt][jj] = e; sum += e; } \
                ls = ls + sum; \
                _Pragma("unroll") for (int cs = 0; cs < 2; ++cs) { const bf16x8_t pf = pack8(s[2 * cs], s[2 * cs + 1]); \
                    _Pragma("unroll") for (int dt = 0; dt < 4; ++dt) os[dt] = mfma16(VF[dt][cs], pf, os[dt]); } \
                if ((nblk_) >= 0) SLC_LOADV(VF, nblk_); } while (0)
            const LAS int* sbl = selL + (w * 16 + ti) * 8; int nb = 0;
#pragma unroll
            for (int bi = 0; bi < 8; ++bi) nb += sbl[bi] >= 0 ? 1 : 0;
            bf16x8_t kfC[4][2], kfN[4][2], vfX[4][2];
            { const int b0 = sbl[0]; SLC_LOADK(kfN, b0); SLC_LOADV(vfX, b0); }
#pragma unroll 1
            for (int bi = 0; bi < nb; ++bi) {
                const int bA = sbl[bi], bB = bi + 1 < nb ? sbl[bi + 1] : -1;
#pragma unroll
                for (int nt = 0; nt < 4; ++nt) { kfC[nt][0] = kfN[nt][0]; kfC[nt][1] = kfN[nt][1]; }
                if (bB >= 0) SLC_LOADK(kfN, bB);
                SLC_COMPUTE(kfC, vfX, bA, bB);
            }
#undef SLC_LOADK
#undef SLC_LOADV
#undef SLC_COMPUTE
            const float lt = xsum4(ls);
            if (fr < 6) {
                const float gs = sigmoidf_(graw + bgate[12 + g * 6 + fr]); const float sc = lt > 0.f ? gs / lt : 0.f;
#pragma unroll
                for (int dt = 0; dt < 4; ++dt) { const unsigned long long o64 = oldv[dt]; const f32x4_t v = os[dt] * sc + (f32x4_t){bflo((unsigned)o64), bfhi((unsigned)o64), bflo((unsigned)(o64 >> 32)), bfhi((unsigned)(o64 >> 32))};
                    *(uint2*)(orow + 16 * dt + 4 * fg) = make_uint2(cvtpk(v[0], v[1]), cvtpk(v[2], v[3])); }
            }
        }
        }
        TSUB_END(3);
    }
}

constexpr int CW_P = 272, CW_BUF = 128 * CW_P;
template <bool SMP> __device__ __forceinline__ void compress_job(const Params& p, int bb, int c, int g, LAS unsigned char* lds) {
    const int tid = ltid(), lane = tid & 63, w = tid >> 6, fr = lane & 15, fg = lane >> 4, n = 16 * w + fr;
    unsigned char* ws = p.ws;
    const bf16_t* W1T = (const bf16_t*)(ws + B_W1T) + (size_t)c * 128 * 2048; const bf16_t* W2T = (const bf16_t*)(ws + B_W2T) + (size_t)c * 64 * 128;
    f32x4_t acc[8];
#pragma unroll
    for (int t = 0; t < 8; ++t) acc[t] = (f32x4_t){0.f, 0.f, 0.f, 0.f};
    const bf16_t* ap = (const bf16_t*)(ws + B_KVB) + (size_t)c * KVB_T + ((size_t)(SMP ? 0 : bb) * 2 + g) * SP * 64 + (size_t)n * 1024 + fg * 8;
    const float* pg0 = nullptr; const float* pg1 = nullptr; int tsplit = 0;
    if (SMP) { const int* pt = (const int*)p.in[I_PT] + (bb - 8) * 16; const int t0 = 16 * n > 2016 ? 2016 : 16 * n; const int pa = t0 >> 7, pb = (t0 + 31) >> 7;
        pg0 = p.in[I_CCMP] + (((size_t)pt[pa] * 128 + (t0 & 127)) * 4 + c * 2 + g) * 64 + fg * 8; tsplit = pb == pa ? 64 : 128 - (t0 & 127);
        pg1 = p.in[I_CCMP] + (((size_t)pt[pb] * 128) * 4 + c * 2 + g) * 64 + fg * 8 - (size_t)tsplit * 256; }
    u32x4_t rb[4]; bf16x8_t acur[4]; f32x4_t araw[SMP ? 8 : 1]; bf16x8_t anext[SMP ? 1 : 4];
#define CW_LOADB(st_) do { _Pragma("unroll") for (int i_ = 0; i_ < 4; ++i_) { const int ch_ = tid + NT_ * i_, r_ = ch_ >> 4, cc_ = ch_ & 15; rb[i_] = *(const u32x4_t*)(W1T + (size_t)r_ * 2048 + (st_) * 128 + cc_ * 8); } } while (0)
#define CW_STOREB(buf_) do { _Pragma("unroll") for (int i_ = 0; i_ < 4; ++i_) { const int ch_ = tid + NT_ * i_, r_ = ch_ >> 4, cc_ = ch_ & 15; *(LAS u32x4_t*)(lds + (buf_) * CW_BUF + r_ * CW_P + cc_ * 16) = rb[i_]; } } while (0)
#define CW_LOADA(st_) do { _Pragma("unroll") for (int u_ = 0; u_ < 4; ++u_) { const int s_ = (st_) * 4 + u_; \
        if (SMP) { const int tk_ = s_ >> 1; const float* src_ = (tk_ < tsplit ? pg0 : pg1) + (size_t)tk_ * 256 + (s_ & 1) * 32; araw[2 * u_] = *(const f32x4_t*)src_; araw[2 * u_ + 1] = *(const f32x4_t*)(src_ + 4); } \
        else anext[u_] = *(const bf16x8_t*)(ap + s_ * 32); } } while (0)
#define CW_TAKEA() do { _Pragma("unroll") for (int u_ = 0; u_ < 4; ++u_) { if (SMP) acur[u_] = pack8(araw[2 * u_], araw[2 * u_ + 1]); else acur[u_] = anext[u_]; } } while (0)
    __syncthreads();
    CW_LOADB(0); CW_LOADA(0); CW_STOREB(0); CW_TAKEA();
    BAR_LDS();
#pragma unroll 1
    for (int st = 0; st < 16; ++st) {
        if (st + 1 < 16) { CW_LOADB(st + 1); CW_LOADA(st + 1); }
        const LAS unsigned char* bb_ = lds + (st & 1) * CW_BUF + fr * CW_P + fg * 16;
#pragma unroll
        for (int u = 0; u < 4; ++u)
#pragma unroll
            for (int t = 0; t < 8; ++t) acc[t] = mfma16(*(const LAS bf16x8_t*)(bb_ + t * 16 * CW_P + u * 64), acur[u], acc[t]);
        if (st + 1 < 16) { CW_STOREB((st + 1) & 1); CW_TAKEA(); }
        BAR_LDS();
    }
#undef CW_LOADB
#undef CW_STOREB
#undef CW_LOADA
#undef CW_TAKEA
    const float* peb = (const float*)(ws + B_PEB) + c * 128;
#pragma unroll
    for (int t = 0; t < 8; ++t) { const f32x4_t pb = *(const f32x4_t*)(peb + 16 * t + 4 * fg);
#pragma unroll
        for (int j = 0; j < 4; ++j) { const float x = acc[t][j] + pb[j]; const float u2 = 1.5957691216057308f * (x + 0.044715f * x * x * x);
            const float th = 1.0f - 2.0f * __builtin_amdgcn_rcpf(1.0f + ex2(u2 * LOG2E)); acc[t][j] = 0.5f * x * (1.0f + th); } }
    f32x4_t o[4];
#pragma unroll
    for (int dt = 0; dt < 4; ++dt) o[dt] = (f32x4_t){0.f, 0.f, 0.f, 0.f};
#pragma unroll
    for (int ks = 0; ks < 4; ++ks) { const bf16x8_t gf = pack8(acc[2 * ks], acc[2 * ks + 1]);
#pragma unroll
        for (int dt = 0; dt < 4; ++dt) { const bf16_t* wp = W2T + (size_t)(16 * dt + fr) * 128 + 32 * ks + 4 * fg; const uint2 x0 = *(const uint2*)wp, x1 = *(const uint2*)(wp + 16);
            o[dt] = mfma16(__builtin_bit_cast(bf16x8_t, make_uint4(x0.x, x0.y, x1.x, x1.y)), gf, o[dt]); } }
    float ss = 0.f;
#pragma unroll
    for (int dt = 0; dt < 4; ++dt) { const f32x4_t b2 = *(const f32x4_t*)(p.in[I_CB2] + c * 64 + 16 * dt + 4 * fg); o[dt] = o[dt] + b2; ss += (o[dt][0] * o[dt][0] + o[dt][1] * o[dt][1]) + (o[dt][2] * o[dt][2] + o[dt][3] * o[dt][3]); }
    if (c == 0) { ss = xsum4(ss); const float rs = rsqrtf(ss * (1.0f / 64) + EPS);
#pragma unroll
        for (int dt = 0; dt < 4; ++dt) { const f32x4_t gk = *(const f32x4_t*)(p.in[I_GKCMP] + 16 * dt + 4 * fg); o[dt] = o[dt] * rs * gk; } }
    bf16_t* kc = (bf16_t*)(ws + B_KC16) + ((((size_t)bb * 2 + c) * 2 + g) * 128 + n) * 64;
    float* cf = (float*)(ws + (c == 0 ? B_CK : B_CV)) + ((size_t)bb * 127 + n) * 128 + g * 64;
#pragma unroll
    for (int dt = 0; dt < 4; ++dt) {
        if (n < 127) { *(f32x4_t*)(cf + 16 * dt + 4 * fg) = o[dt]; *(uint2*)(kc + 16 * dt + 4 * fg) = make_uint2(cvtpk(o[dt][0], o[dt][1]), cvtpk(o[dt][2], o[dt][3])); }
        else { unsigned z = 0u; asm volatile("" : "+v"(z)); *(uint2*)(kc + 16 * dt + 4 * fg) = make_uint2(z, z); }
    }
}
__device__ __forceinline__ void ph_compress_fast(const Params& p, LAS unsigned char* lds) {
    for (int job = blockIdx.x; job < 544; job += gridDim.x) { const int jj = job < 512 ? job + 32 : job - 512; const int bb = jj >> 2, c = (jj >> 1) & 1, g = jj & 1;
        if (bb < 8) compress_job<false>(p, bb, c, g, lds); else compress_job<true>(p, bb, c, g, lds); }
}
constexpr int ML_QP = 400, ML_VP = 80, ML_WP = 112;
__device__ __forceinline__ void ph_mlstm_fast(const Params& p, int l, LAS unsigned char* lds) {
    const int tid = ltid(), lane = tid & 63, w = tid >> 6, fr = lane & 15, fg = lane >> 4;
    unsigned char* ws = p.ws;
    const bf16_t* P16 = (const bf16_t*)(ws + B_P16); const float* GT = (const float*)(ws + B_GT); const float* bif = p.in[I_BIF] + l * 8; float* HR = (float*)(ws + B_HRAW);
    LAS unsigned char* Ql = lds;
    LAS unsigned char* Kl = lds + 25600;
    LAS unsigned char* Vl = lds + 51200;
    LAS unsigned char* Wl = lds + 56320;
    LAS unsigned char* CT = lds + 63488;
    LAS float* INTER = (LAS float*)(lds + 82688);
    LAS float* QN = (LAS float*)(lds + 91904);
    LAS float* RTa = (LAS float*)(lds + 92160);
    LAS float* WSa = RTa + 2048;
    LAS float* EIa = RTa + 4096;
    LAS float* DEC = RTa + 6144;
    LAS float* Gk = DEC + 32; LAS float* Ak = DEC + 64; LAS float* MPk = DEC + 96;
    for (int unit = blockIdx.x; unit < 192; unit += gridDim.x) {
        const int xy_ = unit >> 3, bh_ = (unit & 7) + 8 * (xy_ / 6);
        const int es = xy_ % 6, h = bh_ & 3, b = bh_ >> 2;
        const size_t row0 = (size_t)b * SP;
        __syncthreads();
        for (int i = tid; i < 48 * 100; i += NT_) ((LAS unsigned*)CT)[i] = 0u;
        for (int i = tid; i < 64 * 28; i += NT_) ((LAS unsigned*)Wl)[i] = 0u;
        float gia[4], gfa[4];
#pragma unroll
        for (int q = 0; q < 4; ++q) { const float* g_ = GT + (row0 + 64 * (w + 8 * q) + lane) * GTW; gia[q] = g_[h]; gfa[q] = g_[4 + h]; }
#pragma unroll
        for (int q = 0; q < 4; ++q) { const int k = w + 8 * q; const float gi = gia[q] + bif[h], gf = gfa[q] + bif[4 + h];
            float bc = logsigmoidf_(gf);
#pragma unroll
            for (int o = 1; o < 64; o <<= 1) { const float t = __shfl_up(bc, o); if (lane >= o) bc += t; }
            const float u = gi - bc; float pm = u;
#pragma unroll
            for (int o = 1; o < 64; o <<= 1) { const float t = __shfl_up(pm, o); if (lane >= o) pm = fmaxf(pm, t); }
            EIa[k * 64 + lane] = bc; RTa[k * 64 + lane] = pm; WSa[k * 64 + lane] = u;
            if (lane == 63) { Gk[k] = bc; Ak[k] = pm; } }
        __syncthreads();
        if (tid == 0) { float m = NEGM; for (int k = 0; k < 32; ++k) { MPk[k] = m; m = Gk[k] + fmaxf(Ak[k], m); } MPk[32] = m; }
        __syncthreads();
#pragma unroll 1
        for (int k = w; k < 32; k += 8) { const float mp = MPk[k], M63 = fmaxf(Ak[k], mp); const float bc = EIa[k * 64 + lane], pm = RTa[k * 64 + lane], u = WSa[k * 64 + lane]; const float M = fmaxf(pm, mp);
            RTa[k * 64 + lane] = expf(M63 - M); WSa[k * 64 + lane] = expf(u - M63); EIa[k * 64 + lane] = expf(-(bc + M)); if (lane == 0) DEC[k] = expf(mp - M63); }
        f32x4_t cacc[5];
#pragma unroll
        for (int i = 0; i < 5; ++i) cacc[i] = (f32x4_t){0.f, 0.f, 0.f, 0.f};
        u32x4_t rq[3], rk[3], rv;
#define ML_LOAD(c_) do { const size_t rb_ = row0 + 64 * (c_); \
            _Pragma("unroll") for (int i_ = 0; i_ < 3; ++i_) { const int ch_ = tid + NT_ * i_, r_ = ch_ / 24, cc_ = ch_ % 24; const bf16_t* src_ = P16 + (rb_ + r_) * LDA_ + h * 192 + cc_ * 8; rq[i_] = *(const u32x4_t*)src_; rk[i_] = *(const u32x4_t*)(src_ + 768); } \
            if (tid < 256) { const int r_ = tid >> 2, cc_ = tid & 3; rv = *(const u32x4_t*)(P16 + (rb_ + r_) * LDA_ + 1536 + h * 192 + es * 32 + cc_ * 8); } } while (0)
#define ML_STORE(c_) do { \
            _Pragma("unroll") for (int i_ = 0; i_ < 3; ++i_) { const int ch_ = tid + NT_ * i_, r_ = ch_ / 24, cc_ = ch_ % 24; *(LAS u32x4_t*)(Ql + r_ * ML_QP + cc_ * 16) = rq[i_]; *(LAS u32x4_t*)(Kl + r_ * ML_QP + cc_ * 16) = rk[i_]; } \
            if (tid < 256) { const int r_ = tid >> 2, cc_ = tid & 3; *(LAS u32x4_t*)(Vl + r_ * ML_VP + cc_ * 16) = rv; const float wv_ = WSa[(c_) * 64 + r_]; \
                u32x4_t y_; y_.x = cvtpk(bflo(rv.x) * wv_, bfhi(rv.x) * wv_); y_.y = cvtpk(bflo(rv.y) * wv_, bfhi(rv.y) * wv_); y_.z = cvtpk(bflo(rv.z) * wv_, bfhi(rv.z) * wv_); y_.w = cvtpk(bflo(rv.w) * wv_, bfhi(rv.w) * wv_); \
                *(LAS u32x4_t*)(Wl + r_ * ML_WP + cc_ * 16) = y_; if (cc_ == 0) *(LAS bf16_t*)(Wl + r_ * ML_WP + 64) = (bf16_t)f2bf(wv_); } } while (0)
        ML_LOAD(0);
        __syncthreads();
        ML_STORE(0);
#pragma unroll 1
        for (int c = 0; c < 32; ++c) {
            BAR_LDS();
            if (c + 1 < 32) ML_LOAD(c + 1);
            f32x4_t hin[2]; float rsum = 0.f;
            hin[0] = (f32x4_t){0.f, 0.f, 0.f, 0.f}; hin[1] = hin[0];
            if (w < 4) {
                const int tt = w;
                f32x4_t S[4];
#pragma unroll
                for (int st = 0; st < 4; ++st) { S[st] = (f32x4_t){0.f, 0.f, 0.f, 0.f};
                    if (st <= tt) {
#pragma unroll
                        for (int ks = 0; ks < 6; ++ks) { const bf16x8_t kf = *(const LAS bf16x8_t*)(Kl + (16 * st + fr) * ML_QP + (32 * ks + 8 * fg) * 2), qf = *(const LAS bf16x8_t*)(Ql + (16 * tt + fr) * ML_QP + (32 * ks + 8 * fg) * 2);
                            S[st] = mfma16(kf, qf, S[st]); }
                        const f32x4_t wv = *(const LAS f32x4_t*)(WSa + c * 64 + 16 * st + 4 * fg); S[st] = S[st] * wv;
                        if (st == tt) {
#pragma unroll
                            for (int jj = 0; jj < 4; ++jj) if (4 * fg + jj > fr) S[st][jj] = 0.f; }
                        rsum += (S[st][0] + S[st][1]) + (S[st][2] + S[st][3]);
                    } }
                rsum = xsum4(rsum);
#pragma unroll
                for (int kk = 0; kk < 2; ++kk) { if (2 * kk <= tt) { const bf16x8_t pf = pack8(S[2 * kk], S[2 * kk + 1]);
#pragma unroll
                    for (int et = 0; et < 2; ++et) { const LAS unsigned char* vp = Vl + (32 * kk + 4 * fg + (fr >> 2)) * ML_VP + (16 * et + 4 * (fr & 3)) * 2; hin[et] = mfma16(ldtr2(vp, vp + 16 * ML_VP), pf, hin[et]); } } }
            } else {
                const int tt = w - 4;
                f32x4_t I[3];
#pragma unroll
                for (int e3 = 0; e3 < 3; ++e3) { I[e3] = (f32x4_t){0.f, 0.f, 0.f, 0.f};
#pragma unroll
                    for (int ks = 0; ks < 6; ++ks) { const bf16x8_t cf = *(const LAS bf16x8_t*)(CT + (16 * e3 + fr) * ML_QP + (32 * ks + 8 * fg) * 2), qf = *(const LAS bf16x8_t*)(Ql + (16 * tt + fr) * ML_QP + (32 * ks + 8 * fg) * 2);
                        I[e3] = mfma16(cf, qf, I[e3]); } }
                *(LAS f32x4_t*)(INTER + (16 * tt + fr) * 36 + 4 * fg) = I[0]; *(LAS f32x4_t*)(INTER + (16 * tt + fr) * 36 + 16 + 4 * fg) = I[1];
                if (fg == 0) QN[16 * tt + fr] = I[2][0];
            }
            BAR_LDS();
            const float decay = DEC[c];
            if (w < 4) {
                const int t = 16 * w + fr; const float r = RTa[c * 64 + t], einv = EIa[c * 64 + t], qn = QN[t];
                const float den = r * (rsum + decay * qn); const float inv = 1.0f / fmaxf(fabsf(den), einv);
                float* hp = HR + (row0 + 64 * c + t) * 768 + h * 192 + es * 32;
#pragma unroll
                for (int et = 0; et < 2; ++et) { const f32x4_t in2 = *(const LAS f32x4_t*)(INTER + t * 36 + 16 * et + 4 * fg); const f32x4_t num = (hin[et] + in2 * decay) * r; *(f32x4_t*)(hp + 16 * et + 4 * fg) = num * inv; }
            }
#pragma unroll
            for (int i = 0; i < 5; ++i) { const int idx = w + 8 * i; if (idx < 36) { const int dtile = idx / 3, et = idx % 3; cacc[i] = cacc[i] * decay;
#pragma unroll
                for (int ks = 0; ks < 2; ++ks) { const LAS unsigned char* kp = Kl + (32 * ks + 8 * fg + (fr >> 2)) * ML_QP + (16 * dtile + 4 * (fr & 3)) * 2; const LAS unsigned char* vp = Wl + (32 * ks + 8 * fg + (fr >> 2)) * ML_WP + (16 * et + 4 * (fr & 3)) * 2;
                    cacc[i] = mfma16(ldtr2(kp, kp + 4 * ML_QP), ldtr2(vp, vp + 4 * ML_WP), cacc[i]); } } }
            BAR_LDS();
#pragma unroll
            for (int i = 0; i < 5; ++i) { const int idx = w + 8 * i; if (idx < 36) { const int dtile = idx / 3, et = idx % 3;
                typedef unsigned u32x2_t __attribute__((ext_vector_type(2))); u32x2_t wv; wv.x = cvtpk(cacc[i][0], cacc[i][1]); wv.y = cvtpk(cacc[i][2], cacc[i][3]);
                *(LAS u32x2_t*)(CT + (16 * et + fr) * ML_QP + (16 * dtile + 4 * fg) * 2) = wv; } }
            if (c + 1 < 32) ML_STORE(c + 1);
        }
#pragma unroll
        for (int i = 0; i < 5; ++i) { const int idx = w + 8 * i; if (idx < 36) { const int dtile = idx / 3, et = idx % 3;
            if (et < 2) { float* co = p.out + O_PC + ((size_t)((l * 8 + b) * 4 + h) * 192 + 16 * dtile + 4 * fg) * 192 + es * 32 + 16 * et + fr;
#pragma unroll
                for (int jj = 0; jj < 4; ++jj) co[(size_t)jj * 192] = cacc[i][jj]; }
            else if (es == 0 && fr == 0) { float* no = p.out + O_PN + (size_t)((l * 8 + b) * 4 + h) * 192 + 16 * dtile + 4 * fg;
#pragma unroll
                for (int jj = 0; jj < 4; ++jj) no[jj] = cacc[i][jj]; } } }
        if (es == 0 && tid == 0) p.out[O_PM + (l * 8 + b) * 4 + h] = MPk[32];
#undef ML_LOAD
#undef ML_STORE
    }
}
__device__ __forceinline__ void ph_mem_attn_fast(const Params& p, int l, LAS unsigned char* lds, int u0, int ucnt, int ustep) {
    const int tid = ltid(), lane0 = tid & 63, w = tid >> 6;
    const int ldp = l < 2 ? LDA_ : LDB_, qoff = l < 2 ? 3072 : 768;
    const bf16_t* P16 = (const bf16_t*)(p.ws + B_P16); bf16_t* CATB = (bf16_t*)(p.ws + B_CATB); const float* gq = p.in[I_GMEMQ] + l * 64;
    LAS unsigned char* Km = lds;
    LAS unsigned char* Vm = lds + 36864;
    const float* gmk = p.in[I_GMEMK] + l * 64;
    for (int ui = 0; ui < ucnt; ++ui) { const int unit = u0 + ui * ustep; if (unit >= 256) break;
        int lane_a = lane0; asm volatile("" : "+v"(lane_a)); const int lane = lane_a, fr = lane & 15, fg = lane >> 4;
        const int oct = unit & 7, hh = (unit >> 3) & 3, b = unit >> 5;
        const float* kv = (const float*)(p.ws + B_MEMR) + (size_t)(l * 8 + b) * 256 * 512 + hh * 64;
        __syncthreads();
        {
            f32x4_t x[16];
#pragma unroll
            for (int k = 0; k < 16; ++k) { const int i = tid + NT_ * k, tsel = i >> 12, m = (i >> 4) & 255, ch = i & 15; x[k] = *(const f32x4_t*)(kv + (size_t)m * 512 + tsel * 256 + ch * 4); }
#pragma unroll
            for (int k = 0; k < 16; ++k) { const int i = tid + NT_ * k, tsel = i >> 12, m = (i >> 4) & 255, ch = i & 15;
                if (k < 8) { float ss = (x[k][0] * x[k][0] + x[k][1] * x[k][1]) + (x[k][2] * x[k][2] + x[k][3] * x[k][3]);
                    ss += __shfl_xor(ss, 1); ss += __shfl_xor(ss, 2); ss += __shfl_xor(ss, 4); ss += __shfl_xor(ss, 8);
                    const float rs = rsqrtf(ss * (1.0f / 64) + EPS); const f32x4_t gk = *(const f32x4_t*)(gmk + ch * 4); x[k] = x[k] * rs * gk; }
                typedef unsigned u32x2_t __attribute__((ext_vector_type(2))); u32x2_t y; y.x = cvtpk(x[k][0], x[k][1]); y.y = cvtpk(x[k][2], x[k][3]);
                *(LAS u32x2_t*)((tsel ? Vm : Km) + m * KROW + ch * 8) = y; }
        }
        __syncthreads();
#pragma unroll 1
        for (int ps = 0; ps < 2; ++ps) {
            const size_t row = (size_t)b * SP + oct * 256 + ps * 128 + w * 16 + fr;
            bf16x8_t qf[2];
            { const bf16_t* qrow = P16 + row * ldp + qoff + hh * 64;
              const uint4 r0 = *(const uint4*)(qrow + fg * 8), r1 = *(const uint4*)(qrow + 32 + fg * 8);
              float v[16] = {bflo(r0.x), bfhi(r0.x), bflo(r0.y), bfhi(r0.y), bflo(r0.z), bfhi(r0.z), bflo(r0.w), bfhi(r0.w), bflo(r1.x), bfhi(r1.x), bflo(r1.y), bfhi(r1.y), bflo(r1.z), bfhi(r1.z), bflo(r1.w), bfhi(r1.w)};
              float ss = 0.f;
#pragma unroll
              for (int i = 0; i < 16; ++i) ss += v[i] * v[i];
              ss = xsum4(ss); const float rs = rsqrtf(ss * (1.0f / 64) + EPS) * (0.125f * LOG2E);
#pragma unroll
              for (int i = 0; i < 8; ++i) { v[i] *= rs * gq[fg * 8 + i]; v[8 + i] *= rs * gq[32 + fg * 8 + i]; }
              qf[0] = pack8((f32x4_t){v[0], v[1], v[2], v[3]}, (f32x4_t){v[4], v[5], v[6], v[7]});
              qf[1] = pack8((f32x4_t){v[8], v[9], v[10], v[11]}, (f32x4_t){v[12], v[13], v[14], v[15]}); }
            f32x4_t S[16]; float mx = NINF;
#pragma unroll
            for (int nt = 0; nt < 16; ++nt) { S[nt] = (f32x4_t){0.f, 0.f, 0.f, 0.f};
#pragma unroll
                for (int ks = 0; ks < 2; ++ks) { const bf16x8_t kf = *(const LAS bf16x8_t*)(Km + (16 * nt + fr) * KROW + (32 * ks + 8 * fg) * 2); S[nt] = mfma16(kf, qf[ks], S[nt]); }
                mx = fmaxf(mx, fmaxf(fmaxf(S[nt][0], S[nt][1]), fmaxf(S[nt][2], S[nt][3]))); }
            mx = xmax4(mx); float sum = 0.f;
#pragma unroll
            for (int nt = 0; nt < 16; ++nt)
#pragma unroll
                for (int jj = 0; jj < 4; ++jj) { const float e = ex2(S[nt][jj] - mx); S[nt][jj] = e; sum += e; }
            sum = xsum4(sum); const float inv = 1.0f / sum;
            f32x4_t o[4];
#pragma unroll
            for (int dt = 0; dt < 4; ++dt) o[dt] = (f32x4_t){0.f, 0.f, 0.f, 0.f};
#pragma unroll
            for (int c2 = 0; c2 < 8; ++c2) { const bf16x8_t pf = pack8(S[2 * c2], S[2 * c2 + 1]);
#pragma unroll
                for (int dt = 0; dt < 4; ++dt) { const LAS unsigned char* vp = Vm + (32 * c2 + 4 * fg + (fr >> 2)) * KROW + (16 * dt + 4 * (fr & 3)) * 2; o[dt] = mfma16(ldtr2(vp, vp + 16 * KROW), pf, o[dt]); } }
            bf16_t* orow = CATB + row * DM + 768 + hh * 64;
#pragma unroll
            for (int dt = 0; dt < 4; ++dt) { const f32x4_t v = o[dt] * inv; *(uint2*)(orow + 16 * dt + 4 * fg) = make_uint2(cvtpk(v[0], v[1]), cvtpk(v[2], v[3])); }
        }
    }
}
__device__ __forceinline__ void ph_mem_attn_sample(const Params& p, int l, LAS unsigned char* lds, int j0, int jcnt, int jstep) {
    const int tid = ltid(), lane = tid & 63, w = tid >> 6;
    const int ldp = l < 2 ? LDA_ : LDB_, qoff = l < 2 ? 3072 : 768;
    const bf16_t* P16 = (const bf16_t*)(p.ws + B_P16); bf16_t* CATB = (bf16_t*)(p.ws + B_CATB); const float* gq = p.in[I_GMEMQ] + l * 64;
    LAS float* qs = (LAS float*)(lds + w * 2048);
    LAS float* ps = qs + 64;
    __syncthreads();
    for (int ji = 0; ji < jcnt; ++ji) { const int item = (j0 + ji * jstep) * NW_ + w; if (item >= BS * 4) break;
        const int hh = item & 3, b = item >> 2; const size_t row = (size_t)MP + b;
        const float* kv = p.in[I_CMEM] + (size_t)(l * 128 + b) * 256 * 512 + hh * 64;
        { const float v = bf2f(P16[row * ldp + qoff + hh * 64 + lane]); const float ss = wave_sum(v * v); qs[lane] = v * rsqrtf(ss * (1.0f / 64) + EPS) * gq[lane] * (0.125f * LOG2E); }
        asm volatile("s_waitcnt lgkmcnt(0)" ::: "memory");
        float sc[4] = {0.f, 0.f, 0.f, 0.f};
#pragma unroll 4
        for (int d4 = 0; d4 < 16; ++d4) { const f32x4_t q4 = *(const LAS f32x4_t*)(qs + 4 * d4);
#pragma unroll
            for (int k = 0; k < 4; ++k) { const f32x4_t k4 = *(const f32x4_t*)(kv + (size_t)(lane + 64 * k) * 512 + 4 * d4); sc[k] += (q4[0] * k4[0] + q4[1] * k4[1]) + (q4[2] * k4[2] + q4[3] * k4[3]); } }
        float mx = wave_max(fmaxf(fmaxf(sc[0], sc[1]), fmaxf(sc[2], sc[3]))); float sum = 0.f;
#pragma unroll
        for (int k = 0; k < 4; ++k) { sc[k] = ex2(sc[k] - mx); sum += sc[k]; ps[lane + 64 * k] = sc[k]; }
        sum = wave_sum(sum);
        asm volatile("s_waitcnt lgkmcnt(0)" ::: "memory");
        { const int kg = lane >> 4, c4 = lane & 15; f32x4_t o4 = (f32x4_t){0.f, 0.f, 0.f, 0.f};
#pragma unroll 1
          for (int m0 = 0; m0 < 64; m0 += 16) { f32x4_t v[16];
#pragma unroll
              for (int i = 0; i < 16; ++i) v[i] = *(const f32x4_t*)(kv + (size_t)(4 * (m0 + i) + kg) * 512 + 256 + 4 * c4);
#pragma unroll
              for (int i = 0; i < 16; ++i) o4 = o4 + v[i] * ps[4 * (m0 + i) + kg]; }
#pragma unroll
          for (int jx = 0; jx < 4; ++jx) o4[jx] = xsum4(o4[jx]);
          if (kg == 0) { const float inv = 1.0f / sum; *(uint2*)(CATB + row * DM + 768 + hh * 64 + 4 * c4) = make_uint2(cvtpk(o4[0] * inv, o4[1] * inv), cvtpk(o4[2] * inv, o4[3] * inv)); } }
        asm volatile("s_waitcnt lgkmcnt(0)" ::: "memory");
    }
}
__device__ __forceinline__ void ph_nsa_sample(const Params& p, int j, LAS unsigned char* ldsb) {
    const int tid0 = ltid();
    float* lds = (float*)ldsb;
    float* qs = lds;
    float* sc = lds + 384;
    float* imp = sc + 3072;
    int* sel = (int*)(imp + 40);
    float* gate = (float*)(sel + 8);
    float* oacc = gate + 24;
    const float** kptr = (const float**)(oacc + 384);
    float* part = (float*)(kptr + 512);
    float* tbl = part + 32 * 384;
    int* pts = (int*)(tbl + 192);
    const bf16_t* P = (const bf16_t*)(p.ws + B_P16); const float* GT = (const float*)(p.ws + B_GT); const float* KVR = (const float*)(p.ws + B_KVR); bf16_t* CATB = (bf16_t*)(p.ws + B_CATB);
    const float* table = p.in[I_REL]; const int* pt = (const int*)p.in[I_PT];
    for (int item = blockIdx.x; item < BS * 2; item += gridDim.x) {
        int t_l = tid0; asm volatile("" : "+v"(t_l)); const int tid = t_l, lane = tid & 63, wid = tid >> 6;
        int pos_l = PAST; asm volatile("" : "+s"(pos_l)); const int pos = pos_l;
        const int b = item >> 1, g = item & 1, row = MP + b;
        const bf16_t* pr = P + (size_t)row * LDB_;
        __syncthreads();
        if (wid < 6) { const int z = wid; const float v = bf2f(pr[(g * 6 + z) * 64 + lane]); const float ss = wave_sum(v * v); qs[z * 64 + lane] = v * rsqrtf(ss * (1.0f / 64) + EPS) * p.in[I_GQ][j * 64 + lane]; }
        if (tid >= 384 && tid < 384 + 18) { const int t2 = tid - 384; const int br = t2 / 6, z = t2 % 6; gate[t2] = sigmoidf_(GT[(size_t)row * GTW + br * 12 + g * 6 + z] + p.in[I_BGATE][j * 36 + br * 12 + g * 6 + z]); }
        if (tid < 384) oacc[tid] = 0.f;
        if (tid >= 416 && tid < 432) pts[tid - 416] = pt[b * 16 + (tid - 416)];
        if (tid >= 192 && tid < 384) { const int i = tid - 192; tbl[i] = table[(i / 6) * 12 + g * 6 + (i % 6)]; }
        __syncthreads();
        const float* ck = (const float*)(p.ws + B_CK) + (size_t)(8 + b) * 127 * 128; const float* cv = (const float*)(p.ws + B_CV) + (size_t)(8 + b) * 127 * 128;
        for (int i = tid; i < 6 * 127; i += NT_) {
            const int z = i / 127, n = i % 127; const int dist = pos - (16 * n + 31);
            const float4* kp = (const float4*)(ck + n * 128 + g * 64); const float4* qp = (const float4*)(qs + z * 64); float a = 0.f;
#pragma unroll 8
            for (int d = 0; d < 16; ++d) a += dot4(kp[d], qp[d]);
            sc[z * 128 + n] = a * 0.125f + tbl[rel_bucket_alu(dist) * 6 + z];
        }
        __syncthreads();
        if (wid < 6) row_softmax(sc + wid * 128, 127, lane);
        __syncthreads();
        const int cur = pos >> 6;
        if (tid < 33) { const int jb = tid; float s = 0.f;
            for (int z = 0; z < 6; ++z) { const float* pz = sc + z * 128;
                if (jb < 32) { s += 2.0f * (pz[4 * jb] + pz[4 * jb + 1] + pz[4 * jb + 2]); if (4 * jb + 3 < 127) s += pz[4 * jb + 3]; }
                if (jb >= 1 && jb < 32) s += pz[4 * jb - 1]; }
            imp[jb] = s; }
        __syncthreads();
        if (tid == 0) { sel[0] = 0; sel[1] = cur; sel[2] = cur - 1; }
        if (tid >= 1 && tid <= cur - 2) { const float mine = imp[tid]; int rank = 0;
            for (int j2 = 1; j2 <= cur - 2; ++j2) { const float o = imp[j2]; rank += (o > mine || (o == mine && j2 < tid)) ? 1 : 0; }
            if (rank < 5) sel[3 + rank] = tid; }
        { const int kg = tid >> 4, c4 = tid & 15; f32x4_t v[4]; f32x4_t acc[6];
#pragma unroll
          for (int i = 0; i < 4; ++i) { const int n = kg + 32 * i; v[i] = *(const f32x4_t*)(cv + (n < 127 ? n : 126) * 128 + g * 64 + 4 * c4); }
#pragma unroll
          for (int z = 0; z < 6; ++z) { acc[z] = (f32x4_t){0.f, 0.f, 0.f, 0.f};
#pragma unroll
              for (int i = 0; i < 4; ++i) { const int n = kg + 32 * i; if (n < 127) acc[z] = acc[z] + v[i] * sc[z * 128 + n]; } }
#pragma unroll
          for (int z = 0; z < 6; ++z) *(f32x4_t*)(part + kg * 384 + z * 64 + 4 * c4) = acc[z]; }
        __syncthreads();
        if (tid < 384) { float o = 0.f;
#pragma unroll 8
            for (int kg = 0; kg < 32; ++kg) o += part[kg * 384 + tid];
            oacc[tid] += gate[0 * 6 + (tid >> 6)] * o; }
        __syncthreads();
#pragma unroll 1
        for (int br = 1; br <= 2; ++br) {
            int t_b = tid0; asm volatile("" : "+v"(t_b)); const int tid = t_b, lane = tid & 63, wid = tid >> 6;
            { const int t = tid; const float* kp = nullptr; int dist = -1;
                if (br == 1) { const int blk = sel[t >> 6];
                    if (blk >= 0) { const int tok = blk * 64 + (t & 63); dist = pos - tok;
                        if (dist >= 0) kp = tok < PAST ? p.in[I_CSLC] + ((size_t)pts[tok >> 7] * 128 + (tok & 127)) * 256 + g * 64 : KVR + (size_t)row * 768 + 256 + g * 64; }
                } else { const int kpos = pos - 511 + t; dist = 511 - t;
                    kp = kpos < PAST ? p.in[I_CWIN] + ((size_t)b * 512 + (kpos - (PAST - 512))) * 256 + g * 64 : KVR + (size_t)row * 768 + 512 + g * 64; }
                if (dist >= 0 && kp) {
                    float s[6] = {0.f, 0.f, 0.f, 0.f, 0.f, 0.f};
#pragma unroll 1
                    for (int dc = 0; dc < 2; ++dc) { f32x4_t kk[8];
#pragma unroll
                        for (int d = 0; d < 8; ++d) kk[d] = ((const f32x4_t*)kp)[8 * dc + d];
#pragma unroll
                        for (int d = 0; d < 8; ++d) {
#pragma unroll
                            for (int z = 0; z < 6; ++z) { const f32x4_t q4 = *(const f32x4_t*)(qs + z * 64 + 32 * dc + 4 * d); s[z] += (kk[d][0] * q4[0] + kk[d][1] * q4[1]) + (kk[d][2] * q4[2] + kk[d][3] * q4[3]); }
                            asm volatile("" ::: "memory"); } }
                    const int bk = rel_bucket_alu(dist);
#pragma unroll
                    for (int z = 0; z < 6; ++z) sc[z * 512 + t] = s[z] * 0.125f + tbl[bk * 6 + z];
                    kptr[t] = kp;
                } else {
#pragma unroll
                    for (int z = 0; z < 6; ++z) sc[z * 512 + t] = NEGM;
                    kptr[t] = KVR;
                }
            }
            __syncthreads();
            if (wid < 6) row_softmax(sc + wid * 512, 512, lane);
            __syncthreads();
            {
                const int kg = tid >> 4, c4 = tid & 15; f32x4_t acc[6];
#pragma unroll
                for (int z = 0; z < 6; ++z) acc[z] = (f32x4_t){0.f, 0.f, 0.f, 0.f};
#pragma unroll 1
                for (int i0 = 0; i0 < 16; i0 += 8) { f32x4_t v[8];
#pragma unroll
                    for (int i = 0; i < 8; ++i) v[i] = *(const f32x4_t*)(kptr[kg + 32 * (i0 + i)] + 128 + 4 * c4);
#pragma unroll
                    for (int i = 0; i < 8; ++i)
#pragma unroll
                        for (int z = 0; z < 6; ++z) acc[z] = acc[z] + v[i] * sc[z * 512 + kg + 32 * (i0 + i)]; }
#pragma unroll
                for (int z = 0; z < 6; ++z) *(f32x4_t*)(part + kg * 384 + z * 64 + 4 * c4) = acc[z];
            }
            __syncthreads();
            if (tid < 384) { float o = 0.f;
#pragma unroll 8
                for (int kg = 0; kg < 32; ++kg) o += part[kg * 384 + tid];
                oacc[tid] += gate[br * 6 + (tid >> 6)] * o; }
            __syncthreads();
        }
        if (tid < 384) CATB[(size_t)row * DM + g * 384 + tid] = (bf16_t)f2bf(oacc[tid]);
    }
}
__device__ __forceinline__ void ph_mlstm_sample_fast(const Params& p, int l, LAS unsigned char* ldsb) {
    const int tid = ltid(), lane = tid & 63, w = tid >> 6;
    float* lds = (float*)ldsb;
    float* qs = lds; float* ks = lds + 192; float* n1 = lds + 384; float* part = lds + 576;
    float* scal = part + 8 * 192;
    const bf16_t* P = (const bf16_t*)(p.ws + B_P16); const float* GT = (const float*)(p.ws + B_GT); const float* bif = p.in[I_BIF] + l * 8; float* HR = (float*)(p.ws + B_HRAW);
    for (int item = blockIdx.x; item < BS * 4; item += gridDim.x) {
        const int h = item & 3, b = item >> 2; const size_t row = (size_t)MP + b;
        const bf16_t* pr = P + row * LDA_; const float* gr = GT + row * GTW;
        const size_t sidx = (size_t)(l * 128 + b) * 4 + h;
        const float ig = gr[h] + bif[h], fg_ = gr[4 + h] + bif[4 + h];
        const float m0 = p.in[I_SM][sidx];
        const float logf = logsigmoidf_(fg_);
        const float m_new = fmaxf(logf + m0, ig);
        const float a = expf(logf + m0 - m_new), bb = expf(ig - m_new);
        __syncthreads();
        if (tid < 192) { const float q = bf2f(pr[h * 192 + tid]), k = bf2f(pr[768 + h * 192 + tid]); qs[tid] = q; ks[tid] = k;
            const float nn = a * p.in[I_SN][sidx * 192 + tid] + bb * k; n1[tid] = nn; p.out[O_SN + sidx * 192 + tid] = nn; }
        __syncthreads();
        if (w == 0) { float s = qs[lane] * n1[lane] + qs[lane + 64] * n1[lane + 64] + qs[lane + 128] * n1[lane + 128]; s = wave_sum(s); if (lane == 0) scal[0] = s; }
        const float* C0 = p.in[I_SC] + sidx * 192 * 192; float* C1 = p.out + O_SC + sidx * 192 * 192;
        float ve[3], num[3] = {0.f, 0.f, 0.f};
#pragma unroll
        for (int i = 0; i < 3; ++i) ve[i] = bf2f(pr[1536 + h * 192 + lane + 64 * i]) * bb;
#pragma unroll 1
        for (int d0 = 24 * w; d0 < 24 * w + 24; d0 += 12) {
            float c[12][3];
#pragma unroll
            for (int r = 0; r < 12; ++r)
#pragma unroll
                for (int i = 0; i < 3; ++i) c[r][i] = C0[(size_t)(d0 + r) * 192 + lane + 64 * i];
#pragma unroll
            for (int r = 0; r < 12; ++r) { const float kd = ks[d0 + r], qd = qs[d0 + r];
#pragma unroll
                for (int i = 0; i < 3; ++i) { const float cn = a * c[r][i] + kd * ve[i]; C1[(size_t)(d0 + r) * 192 + lane + 64 * i] = cn; num[i] = fmaf(qd, cn, num[i]); } }
        }
#pragma unroll
        for (int i = 0; i < 3; ++i) part[w * 192 + lane + 64 * i] = num[i];
        __syncthreads();
        if (tid < 192) { float s = 0.f;
#pragma unroll
            for (int ww = 0; ww < 8; ++ww) s += part[ww * 192 + tid];
            HR[row * 768 + h * 192 + tid] = s / fmaxf(fabsf(scal[0]), expf(-m_new)); }
        if (tid == 0) p.out[O_SM + sidx] = m_new;
    }
}
constexpr int RING_BYTES = 131072, MISC_OFF = RING_BYTES + 320, LDS_BYTES = 147456;
typedef float f32x4_ __attribute__((ext_vector_type(4)));

#define STRIP_JOBS(njobs) for (int job = (int)gridDim.x - 1 - (int)blockIdx.x; job < (njobs); job += (int)gridDim.x)
__device__ __forceinline__ void strips_inproj(const Params& p, int l, LAS unsigned char* lds) {
    unsigned char* ws = p.ws; const bf16_t* XB = (const bf16_t*)(ws + B_XB); bf16_t* P16 = (bf16_t*)(ws + B_P16); float* GT = (float*)(ws + B_GT);
    const float* ssq = (const float*)(ws + B_SSQ) + (size_t)(2 * l) * SSQS;
    const bool ka = l < 2; const int ldp = ka ? LDA_ : LDB_, nmain = ka ? 104 * 4 : 32 * 4;
    const bf16_t* Bt = ka ? (const bf16_t*)(ws + B_BTA) + (size_t)l * NBTA * DM : (const bf16_t*)(ws + B_BTB) + (size_t)(l - 2) * NBTB * DM;
    const int tid_ = ltid(); const int lane = tid_ & 63, wave = tid_ >> 6, fr = lane & 15, fq = lane >> 4;
    STRIP_JOBS(nmain + 516) {
        if (job < nmain) {
            const int st = job >> 2, r0 = MP + (job & 3) * 32;
            const int brow[2] = {st * 32, st * 32 + 16}; StripAcc<2> R; strip_gemm<2>(XB, DM, r0, Bt, brow, R, lds);
            if (wave < 2) { const int row = r0 + wave * 16 + fr; const float rs = rstd_of(ssq[row]);
#pragma unroll
                for (int t = 0; t < 2; ++t) { const f32x4_ v = R.a[t] * rs; *(uint2*)(P16 + (size_t)row * ldp + st * 32 + t * 16 + 4 * fq) = make_uint2(pk2(v[0], v[1]), pk2(v[2], v[3])); } }
        } else {
            const int r0 = (job - nmain) * 32, row = r0 + wave * 16 + fr;
            if (ka) { const int brow[1] = {3328}; StripAcc<1> R; strip_gemm<1>(XB, DM, r0, Bt, brow, R, lds); if (wave < 2) *(f32x4_*)(GT + (size_t)row * GTW + 4 * fq) = R.a[0] * rstd_of(ssq[row]); }
            else { const int brow[3] = {1024, 1040, 1056}; StripAcc<3> R; strip_gemm<3>(XB, DM, r0, Bt, brow, R, lds);
                if (wave < 2) { const float rs = rstd_of(ssq[row]);
#pragma unroll
                    for (int t = 0; t < 3; ++t) *(f32x4_*)(GT + (size_t)row * GTW + t * 16 + 4 * fq) = R.a[t] * rs; } }
        }
    }
}
__device__ __forceinline__ void strips_resid(const Params& p, const bf16_t* A, int K, const bf16_t* Bt, float* ssq, float* Y, LAS unsigned char* lds) {
    bf16_t* XB = (bf16_t*)(p.ws + B_XB);
    const int tid_ = ltid(); const int lane = tid_ & 63, wave = tid_ >> 6, fr = lane & 15, fq = lane >> 4;
    STRIP_JOBS(256) {
        const int st = job >> 2, r0 = MP + (job & 3) * 32;
        const int brow[1] = {st * 16}; StripAcc<1> R; strip_gemm<1>(A, K, r0, Bt, brow, R, lds);
        if (wave < 2) { const int row = r0 + wave * 16 + fr; bf16_t* bp = XB + (size_t)row * DM + st * 16 + 4 * fq; const uint2 o = *(const uint2*)bp;
            const f32x4_ x = (f32x4_){bflo(o.x), bfhi(o.x), bflo(o.y), bfhi(o.y)} + R.a[0];
            *(uint2*)bp = make_uint2(pk2(x[0], x[1]), pk2(x[2], x[3]));
            if (Y) *(f32x4_*)(Y + (size_t)row * DM + st * 16 + 4 * fq) = x;
            float ss = (x[0] * x[0] + x[1] * x[1]) + (x[2] * x[2] + x[3] * x[3]); ss += __shfl_xor(ss, 16); ss += __shfl_xor(ss, 32);
            if (fq == 0) (void)__hip_atomic_fetch_add(ssq + row, ss, __ATOMIC_RELAXED, __HIP_MEMORY_SCOPE_AGENT); }
    }
}
__device__ __forceinline__ void strips_gu(const Params& p, int l, LAS unsigned char* lds) {
    unsigned char* ws = p.ws; const bf16_t* XB = (const bf16_t*)(ws + B_XB); bf16_t* HID = (bf16_t*)(ws + B_HID);
    const float* ssq = (const float*)(ws + B_SSQ) + (size_t)(2 * l + 1) * SSQS; const bf16_t* Bt = (const bf16_t*)(ws + B_BTG) + (size_t)l * 2 * DFF * DM;
    const int tid_ = ltid(); const int lane = tid_ & 63, wave = tid_ >> 6, fr = lane & 15, fq = lane >> 4;
    STRIP_JOBS(176 * 4) {
        const int st = job >> 2, r0 = MP + (job & 3) * 32;
        const int brow[2] = {(st >> 3) * 256 + (st & 7) * 16, (st >> 3) * 256 + 128 + (st & 7) * 16}; StripAcc<2> R; strip_gemm<2>(XB, DM, r0, Bt, brow, R, lds);
        if (wave < 2) { const int row = r0 + wave * 16 + fr; const float rs = rstd_of(ssq[row]); float h[4];
#pragma unroll
            for (int j = 0; j < 4; ++j) { const float g = R.a[0][j] * rs, up = R.a[1][j] * rs; h[j] = g * pg8::fast_sigmoid(g) * up; }
            *(uint2*)(HID + (size_t)row * DFF + st * 16 + 4 * fq) = make_uint2(pk2(h[0], h[1]), pk2(h[2], h[3])); }
    }
}
__device__ __forceinline__ void strips_kv(const Params& p, LAS unsigned char* lds) {
    unsigned char* ws = p.ws; const bf16_t* XB = (const bf16_t*)(ws + B_XB); float* KVR = (float*)(ws + B_KVR);
    const float* ssq = (const float*)(ws + B_SSQ) + (size_t)4 * SSQS; const bf16_t* Bt = (const bf16_t*)(ws + B_BTK);
    const int tid_ = ltid(); const int lane = tid_ & 63, wave = tid_ >> 6, fr = lane & 15, fq = lane >> 4;
    STRIP_JOBS(48 * 4) {
        const int st = job >> 2, r0 = MP + (job & 3) * 32;
        const int brow[1] = {st * 16}; StripAcc<1> R; strip_gemm<1>(XB, DM, r0, Bt, brow, R, lds);
        if (wave < 2) { const int row = r0 + wave * 16 + fr; *(f32x4_*)(KVR + (size_t)row * 768 + st * 16 + 4 * fq) = R.a[0] * rstd_of(ssq[row]); }
    }
}

#ifndef COMPRESS_NAIVE
#define COMPRESS_NAIVE 0
#endif
#ifndef MLSTM_NAIVE
#define MLSTM_NAIVE 0
#endif
#ifndef MEMATT_NAIVE
#define MEMATT_NAIVE 0
#endif
#ifndef SAMPLE_ML_NAIVE
#define SAMPLE_ML_NAIVE 0
#endif
#ifndef SAMPLE_NSA_NAIVE
#define SAMPLE_NSA_NAIVE 0
#endif
#ifndef MK_MULTI
#define MK_MULTI 0
#endif
constexpr int PL = 9, NPH = 1 + 4 * PL;
__host__ __device__ constexpr bool phase_nonempty(int ph) {
    if (ph == 0) return true;
    const int l = (ph - 1) / PL, r = (ph - 1) % PL;
    if (r == 2) return l < 2;
    if (r == 7) return false;
    if (r >= 6) return l == 1;
    return true;
}
#ifndef TIME_MASK
#define TIME_MASK 0
#endif
__host__ __device__ constexpr int phase_group(int ph) { if (ph == 0) return 0; const int l = (ph - 1) / PL, r = (ph - 1) % PL; return r == 0 ? 1 : r == 1 ? (l < 2 ? 2 : 4) : r == 2 ? 3 : r == 3 ? 5 : r == 4 ? 6 : r == 5 ? 7 : r == 6 ? 8 : r == 7 ? 9 : 10; }
__global__ void __launch_bounds__(NT_, 2) fwd(Params p) {
    extern __shared__ __attribute__((aligned(16))) unsigned char lds_raw[];
    LAS unsigned char* lds = (LAS unsigned char*)lds_raw;
    float* ldsf = (float*)lds_raw;
    volatile LAS unsigned* MISC = (volatile LAS unsigned*)(lds + MISC_OFF);
    for (int u = threadIdx.x; u < (LDS_BYTES - RING_BYTES) / 4; u += NT_) ((LAS unsigned*)(lds + RING_BYTES))[u] = 0u;
    __syncthreads();
    unsigned char* ws = p.ws;
    XcdBarrier bar; bar.bar = (unsigned*)ws; bar.x = 0; bar.st = MISC + 8;
    const bool single = (p.ph_hi - p.ph_lo) > 1;
    if (single) bar = xcd_barrier_post((unsigned*)ws, MISC + 8);
    bf16_t* XB = (bf16_t*)(ws + B_XB); bf16_t* P16 = (bf16_t*)(ws + B_P16); bf16_t* CATB = (bf16_t*)(ws + B_CATB); bf16_t* HID = (bf16_t*)(ws + B_HID);
    float* SSQ = (float*)(ws + B_SSQ);
    const int G = gridDim.x, c = blockIdx.x;
    if (TIME_SUB && blockIdx.x == TSUB_BLK && threadIdx.x == 0) { for (int i = 0; i < 8; ++i) g_tsub[i] = 0ull; }
    int ph = 0; volatile LAS unsigned long long* TMR = (volatile LAS unsigned long long*)(lds + MISC_OFF + 64);
    if ((TIME_MASK || TIME_SUB) && blockIdx.x == 0 && threadIdx.x == 0) { TMR[0] = 0ull; TMR[1] = __builtin_amdgcn_s_memrealtime(); }
#define ON() (ph >= p.ph_lo && ph < p.ph_hi)
#define NEXT() do { const bool ne_ = phase_nonempty(ph); const int grp_ = phase_group(ph); ++ph; if (ne_ && ph > p.ph_lo && ph < p.ph_hi) xcd_barrier(bar); \
        if (TIME_MASK && blockIdx.x == 0 && threadIdx.x == 0) { const unsigned long long now_ = __builtin_amdgcn_s_memrealtime(); if ((TIME_MASK >> grp_) & 1) TMR[0] = TMR[0] + (now_ - TMR[1]); TMR[1] = now_; } } while (0)
#ifndef NO_PRO
    if (ON()) ph_prologue(p, lds);
#endif
    NEXT();
    for (int l = 0; l < 4; ++l) {
        if (ON()) {
            if (l == 0) { pg8::Gemm g{(const bf16_t*)(ws + B_MPB), (const bf16_t*)(ws + B_BTM), 2048, 2048, DM}; pg8::StaticOrder S; S.init(2048, 2048, G, c);
                pg8::EpiF32 E{(float*)(ws + B_MEMR), 512, nullptr, 512, (size_t)2048 * 512};
                pg8::gemm_phase<pg8::EpiF32, pg8::StaticOrder, true, true>(lds, g, S, E); }
            if (l < 2) { pg8::Gemm g{XB, (const bf16_t*)(ws + B_BTA) + (size_t)l * NBTA * DM, MAP, LDA_ + 256, DM}; pg8::StaticOrder S; S.init(MAP, LDA_ + 256, G, l == 0 ? (c + 192) % G : c);
                pg8::EpiBf16S E{P16, LDA_, SSQ + (size_t)(2 * l) * SSQS, 13, (float*)(ws + B_GT)};
                pg8::gemm_phase<pg8::EpiBf16S, pg8::StaticOrder, true, true>(lds, g, S, E); }
            else { pg8::Gemm g{XB, (const bf16_t*)(ws + B_BTB) + (size_t)(l - 2) * NBTB * DM, MP, LDB_, DM}; pg8::StaticOrder S; S.init(MP, LDB_, G, c);
                pg8::EpiBf16S E{P16, LDB_, SSQ + (size_t)(2 * l) * SSQS, -1, nullptr};
                pg8::gemm_phase<pg8::EpiBf16S, pg8::StaticOrder, true, true>(lds, g, S, E);
#ifndef NO_STRIPS
                strips_inproj(p, l, lds);
#endif
            }
        }
        NEXT();
#ifndef NO_NAIVE
        if (ON()) {
            if (l < 2) { if (MLSTM_NAIVE) ph_mlstm_prompt(p, l, ldsf); else ph_mlstm_fast(p, l, lds); if (G == 256) { if (c >= 192) { ph_mem_attn_fast(p, l, lds, c - 192, 4, 64); ph_mem_attn_sample(p, l, lds, c - 192, 1, 64); if (l == 1) ph_swin_copy(p, 192, 64); } }
                else { ph_mem_attn_fast(p, l, lds, c, (256 - c + G - 1) / G, G); if (c < 64) ph_mem_attn_sample(p, l, lds, c, (64 - c + G - 1) / G, G); if (l == 1) ph_swin_copy(p, 0, G); }      if (SAMPLE_ML_NAIVE) ph_mlstm_sample(p, l, ldsf); else ph_mlstm_sample_fast(p, l, lds); }
            else { if (!NSA_NAIVE_ALL) ph_nsa_fast(p, l - 2, lds); { TSUB_BEGIN(); if (SAMPLE_NSA_NAIVE) ph_nsa(p, l - 2, ldsf); else ph_nsa_sample(p, l - 2, lds); TSUB_END(4); } TSUB_BEGIN(); if (MEMATT_NAIVE) ph_mem_attn(p, l); else if (G == 256) { if (c < 16) { ph_mem_attn_fast(p, l, lds, 8 * c, 8, 1); ph_mem_attn_sample(p, l, lds, 2 * c, 2, 1); } else if (c < 32) { ph_mem_attn_fast(p, l, lds, 128 + 5 * (c - 16), 5, 1); ph_mem_attn_sample(p, l, lds, 2 * c, 2, 1); } else if (c < 48) ph_mem_attn_fast(p, l, lds, 208 + 3 * (c - 32), 3, 1); }
                else { ph_mem_attn_fast(p, l, lds, c, (256 - c + G - 1) / G, G); if (c < 64) ph_mem_attn_sample(p, l, lds, c, (64 - c + G - 1) / G, G); } TSUB_END(5); }
        }
#endif
        NEXT();
#ifndef NO_NAIVE
        if (ON()) { if (l < 2) { ph_mlstm_fin(p, l); if (l == 0) ph_memk_norm(p); } }
#endif
        NEXT();
        if (ON()) {
            const bf16_t* Bt = (const bf16_t*)(ws + B_BTO) + (size_t)l * DM * DM; float* sq = SSQ + (size_t)(2 * l + 1) * SSQS;
            pg8::Gemm g{CATB, Bt, MP, DM, DM}; pg8::StaticOrder S; S.init(MP, DM, G, c); pg8::EpiResid E{nullptr, XB, sq};
            pg8::gemm_phase<pg8::EpiResid, pg8::StaticOrder, true, true>(lds, g, S, E);
#ifndef NO_STRIPS
            strips_resid(p, CATB, DM, Bt, sq, nullptr, lds);
#endif
        }
        NEXT();
        if (ON()) {
            pg8::Gemm g{XB, (const bf16_t*)(ws + B_BTG) + (size_t)l * 2 * DFF * DM, MAP, 2 * DFF, DM}; pg8::StaticOrder S; S.init(MAP, 2 * DFF, G, c); pg8::EpiSwiglu E{HID, SSQ + (size_t)(2 * l + 1) * SSQS};
            pg8::gemm_phase<pg8::EpiSwiglu, pg8::StaticOrder, true, true>(lds, g, S, E);
        }
        NEXT();
        if (ON()) {
            const bf16_t* Bt = (const bf16_t*)(ws + B_BTD) + (size_t)l * DM * DFF; float* sq = SSQ + (size_t)(2 * l + 2) * SSQS;
            pg8::Gemm g{HID, Bt, MP, DM, DFF}; pg8::StaticOrder S; S.init(MP, DM, G, c); float* Yo = l == 3 ? p.out : nullptr; pg8::EpiResid E{Yo, XB, sq};
            pg8::gemm_phase<pg8::EpiResid, pg8::StaticOrder, true, true>(lds, g, S, E);
#ifndef NO_STRIPS
            strips_resid(p, HID, DFF, Bt, sq, Yo, lds);
#endif
        }
        NEXT();
        if (ON()) { if (l == 1) {
            pg8::Gemm g{XB, (const bf16_t*)(ws + B_BTK), MAP, 768, DM}; pg8::StaticOrder S; S.init(MAP, 768, G, c); pg8::EpiF32 E{(float*)(ws + B_KVR), 768, SSQ + (size_t)4 * SSQS, 0, 0};
            pg8::gemm_phase<pg8::EpiF32, pg8::StaticOrder, true, true>(lds, g, S, E);
            asm volatile("s_waitcnt vmcnt(0)" ::: "memory"); __syncthreads();
            if (c < 195) {
                constexpr int nM = MAP / 256, nN = 3, nwg = nM * nN, q = nwg / 8, rr = nwg % 8; const int xcd = c % 8, off = c / 8;
                const int wgid = (xcd < rr ? xcd * (q + 1) : rr * (q + 1) + (xcd - rr) * q) + off; constexpr int nig = 8 * nN; const int gid = wgid / nig, fm = gid * 8, gsz = (nM - fm) < 8 ? (nM - fm) : 8;
                rows_post_tile(p, (fm + ((wgid % nig) % gsz)) * 256, (wgid % nig) / gsz); }
            } }
        NEXT();
        NEXT();
#ifndef NO_NAIVE
        if (ON()) { if (l == 1) { if (COMPRESS_NAIVE) ph_compress(p, ldsf); else ph_compress_fast(p, lds); } }
#endif
        NEXT();
    }
    if (TIME_MASK || TIME_SUB) { if (blockIdx.x == 0 && threadIdx.x == 0) { const unsigned long long t_acc = TIME_SUB ? __hip_atomic_load(&g_tsub[TIME_SUB > 0 ? TIME_SUB - 1 : 0], __ATOMIC_RELAXED, __HIP_MEMORY_SCOPE_AGENT) : TMR[0]; const unsigned long long t0 = __builtin_amdgcn_s_memrealtime(); while (__builtin_amdgcn_s_memrealtime() - t0 < 10ull * t_acc) __builtin_amdgcn_s_sleep(8); } }
}

extern "C" void kernel_launch(void* const* d_in, const int* in_sizes, int n_in, void* d_out, int out_size, void* d_ws, size_t ws_size, hipStream_t stream) {
    static int grid = 0;
    if (!grid) {
        int dev = 0, cus = 0;
        (void)hipGetDevice(&dev); (void)hipDeviceGetAttribute(&cus, hipDeviceAttributeMultiprocessorCount, dev);
        if (cus < 1) cus = 256;
        if (hipFuncSetAttribute((const void*)fwd, hipFuncAttributeMaxDynamicSharedMemorySize, LDS_BYTES) != hipSuccess) fprintf(stderr, "kernel_launch: hipFuncSetAttribute failed\n");
        int per_cu = 0; (void)hipOccupancyMaxActiveBlocksPerMultiprocessor(&per_cu, (const void*)fwd, NT_, LDS_BYTES); (void)hipGetLastError();
        if (per_cu < 1) fprintf(stderr, "kernel_launch: occupancy query says %d\n", per_cu);
        grid = cus;
    }
    if (n_in != N_IN || (size_t)out_size != O_END || ws_size < B_END) fprintf(stderr, "kernel_launch: unexpected sizes n_in=%d out=%d ws=%zu need %zu\n", n_in, out_size, ws_size, (size_t)B_END);
    (void)hipMemsetAsync(d_ws, 0, CTL_BYTES, stream);
    Params p{};
    for (int i = 0; i < N_IN; ++i) p.in[i] = (const float*)d_in[i];
    p.out = (float*)d_out; p.ws = (unsigned char*)d_ws;
#if MK_MULTI
    for (int ph = 0; ph < NPH; ++ph) {
        if (!phase_nonempty(ph)) continue;
        p.ph_lo = ph; p.ph_hi = ph + 1;
        hipLaunchKernelGGL(fwd, dim3(grid), dim3(NT_), LDS_BYTES, stream, p);
    }
#else
    p.ph_lo = 0; p.ph_hi = NPH;
    hipLaunchKernelGGL(fwd, dim3(grid), dim3(NT_), LDS_BYTES, stream, p);
#endif
}

#ifdef REGTEST
__global__ void __launch_bounds__(NT_, 2) rt_nsa(Params p) { extern __shared__ __attribute__((aligned(16))) unsigned char l_[]; ph_nsa_fast(p, 0, (LAS unsigned char*)l_); }
__global__ void __launch_bounds__(NT_, 2) rt_mlstm(Params p) { extern __shared__ __attribute__((aligned(16))) unsigned char l_[]; ph_mlstm_fast(p, 0, (LAS unsigned char*)l_); }
__global__ void __launch_bounds__(NT_, 2) rt_nsas(Params p) { extern __shared__ __attribute__((aligned(16))) unsigned char l_[]; ph_nsa_sample(p, 0, (LAS unsigned char*)l_); }
__global__ void __launch_bounds__(NT_, 2) rt_mem(Params p) { extern __shared__ __attribute__((aligned(16))) unsigned char l_[]; ph_mem_attn_fast(p, 0, (LAS unsigned char*)l_, 0, 256, 1); }
__global__ void __launch_bounds__(NT_, 2) rt_cmp(Params p) { extern __shared__ __attribute__((aligned(16))) unsigned char l_[]; ph_compress_fast(p, (LAS unsigned char*)l_); }
#endif
```

```cpp
#include <hip/hip_runtime.h>
#include <cstdio>
#include <cstdint>

#define LAS __attribute__((address_space(3)))
#define GAS __attribute__((address_space(1)))
#define XB_TMO      128
#define XB_XCNT(j)  (256  + 64 * (j))
#define XB_XSUB(j)  (1280 + 64 * (j))
#define XB_XGEN(j)  (2304 + 64 * (j))
#define XB_TOP      3328
#define XB_TOPGEN   3392
#define XCD_BAR_WORDS 3456
#define XB_SPIN_CAP (1u << 23)
__device__ __forceinline__ unsigned xb_ld(unsigned* p)              { return __hip_atomic_load(p, __ATOMIC_RELAXED, __HIP_MEMORY_SCOPE_AGENT); }
__device__ __forceinline__ unsigned xb_add(unsigned* p, unsigned v) { return __hip_atomic_fetch_add(p, v, __ATOMIC_RELAXED, __HIP_MEMORY_SCOPE_AGENT); }
__device__ __forceinline__ unsigned xb_xcc_id() { return (unsigned)__builtin_amdgcn_s_getreg((3 << 11) | 20) & 0xFu; }
#define XB_SPIN(cond, bar) do { unsigned _sp = 0; while (cond) { __builtin_amdgcn_s_sleep(1); \
    if ((++_sp & 255u) == 0u) { if (xb_ld(&(bar)[XB_TMO])) break; if (_sp > XB_SPIN_CAP) { atomicAdd(&(bar)[XB_TMO], 1u); break; } } } } while (0)
struct XcdBarrier { unsigned* bar; unsigned x; volatile LAS unsigned* st; };
__device__ __forceinline__ XcdBarrier xcd_barrier_post(unsigned* bar, volatile LAS unsigned* st) {
    XcdBarrier b; b.bar = bar; b.x = xb_xcc_id(); b.st = st;
    if (threadIdx.x == 0) (void)xb_add(&bar[XB_XCNT(b.x)], 1u);
    return b;
}
__device__ __forceinline__ void xcd_barrier_complete(unsigned* bar, unsigned x, unsigned& nloc, unsigned& nx) {
    const unsigned G = gridDim.x * gridDim.y * gridDim.z;
    unsigned sum, cnt, mine, sp = 0u;
    for (;;) {
        sum = 0u; cnt = 0u; mine = 0u;
#pragma unroll
        for (unsigned j = 0; j < 16; ++j) { const unsigned c = xb_ld(&bar[XB_XCNT(j)]); sum += c; cnt += (c > 0u) ? 1u : 0u; mine = (j == x) ? c : mine; }
        if (sum == G) break;
        __builtin_amdgcn_s_sleep(1);
        if ((++sp & 255u) == 0u) { if (xb_ld(&bar[XB_TMO])) break; if (sp > XB_SPIN_CAP) { atomicAdd(&bar[XB_TMO], 1u); break; } }
    }
    nloc = mine > 0u ? mine : 1u; nx = cnt > 0u ? cnt : 1u;
}
__device__ __forceinline__ void xcd_barrier(const XcdBarrier& b) {
    asm volatile("s_waitcnt vmcnt(0)" ::: "memory");
    __syncthreads();
    if (threadIdx.x == 0) {
        unsigned* bar = b.bar;
        __builtin_amdgcn_s_waitcnt(0);
        unsigned nloc = b.st[0], nx = b.st[1];
        if (nloc == 0u) { xcd_barrier_complete(bar, b.x, nloc, nx); b.st[0] = nloc; b.st[1] = nx; }
        const unsigned old = xb_add(&bar[XB_XSUB(b.x)], 1u);
        const unsigned gen = old / nloc;
        if (old + 1u == (gen + 1u) * nloc) {
            __builtin_amdgcn_fence(__ATOMIC_RELEASE, "agent");
            asm volatile("s_waitcnt vmcnt(0)" ::: "memory");
            const unsigned og = xb_add(&bar[XB_TOP], 1u);
            const unsigned tg = og / nx;
            if (og + 1u == (tg + 1u) * nx) xb_add(&bar[XB_TOPGEN], 1u);
            else XB_SPIN(xb_ld(&bar[XB_TOPGEN]) == tg, bar);
            __builtin_amdgcn_fence(__ATOMIC_ACQUIRE, "agent");
            xb_add(&bar[XB_XGEN(b.x)], 1u);
            asm volatile("s_waitcnt vmcnt(0)" ::: "memory");
        } else {
            XB_SPIN(xb_ld(&bar[XB_XGEN(b.x)]) == gen, bar);
            __builtin_amdgcn_fence(__ATOMIC_ACQUIRE, "agent");
            asm volatile("s_waitcnt vmcnt(0)" ::: "memory");
        }
    }
    __syncthreads();
}

constexpr int NT_ = 512, NW_ = 8;
constexpr int DM = 1024, BP = 8, SP = 2048, MP = BP * SP, BS = 128, MA = MP + BS, MAP = MP + 256;
constexpr int ACOLS = 3336, BCOLS = 1060, DFF = 2816;
constexpr int LDA_ = 3328, LDB_ = 1024;
constexpr int NBTA = 3344, NBTB = 1072;
constexpr int PAST = 2048, GTW = 48;
constexpr float EPS = 1e-6f, NEGM = -1e30f;
typedef unsigned short bf16_t;

enum { I_XP = 0, I_XS, I_SC, I_SN, I_SM, I_CMEM, I_CCMP, I_CSLC, I_CWIN, I_PT, I_MEMP, I_GMIX, I_WINA, I_BIF, I_GHN, I_WINB, I_GQ, I_BGATE, I_REL,
       I_GKV, I_WKV, I_GKSLC, I_GKWIN, I_GKCMP, I_CPOS, I_CW1, I_CB1, I_CW2, I_CB2, I_WMEMKV, I_GMEMK, I_GMEMQ, I_WOUT, I_GFFN, I_WGU, I_WDOWN, N_IN };
constexpr size_t O_YP = 0, O_YS = O_YP + (size_t)MP * DM, O_PC = O_YS + (size_t)BS * DM, O_PN = O_PC + 2ull * 8 * 4 * 192 * 192, O_PM = O_PN + 2ull * 8 * 4 * 192,
    O_PMEM = O_PM + 64, O_PCMP = O_PMEM + 4ull * 8 * 256 * 512, O_PSLC = O_PCMP + (size_t)MP * 256, O_PWIN = O_PSLC + (size_t)MP * 256, O_SC = O_PWIN + 8ull * 512 * 256,
    O_SN = O_SC + 2ull * 128 * 4 * 192 * 192, O_SM = O_SN + 2ull * 128 * 4 * 192, O_SCMP = O_SM + 1024, O_SSLC = O_SCMP + 128 * 256, O_SWIN = O_SSLC + 128 * 256,
    O_END = O_SWIN + 128ull * 512 * 256;
static_assert(O_END == 87700544ull, "output size");
constexpr size_t CTL_BYTES = 2u << 20, B_SSQ = 65536;
constexpr size_t al256(size_t x) { return (x + 255) & ~(size_t)255; }
constexpr size_t B_XB = CTL_BYTES, B_P16 = al256(B_XB + (size_t)MAP * DM * 2), B_GT = al256(B_P16 + (size_t)MAP * LDA_ * 2), B_CATB = al256(B_GT + (size_t)MAP * GTW * 4),
    B_HID = al256(B_CATB + (size_t)MA * DM * 2), B_HRAW = al256(B_HID + (size_t)MAP * DFF * 2), B_KVR = al256(B_HRAW + (size_t)MA * 768 * 4), B_CK = al256(B_KVR + (size_t)MAP * 768 * 4),
    B_CV = al256(B_CK + 136ull * 127 * 128 * 4), B_MPB = al256(B_CV + 136ull * 127 * 128 * 4),
    B_BTA = al256(B_MPB + 2048ull * DM * 2), B_BTB = al256(B_BTA + 2ull * NBTA * DM * 2), B_BTO = al256(B_BTB + 2ull * NBTB * DM * 2), B_BTG = al256(B_BTO + 4ull * DM * DM * 2),
    B_BTD = al256(B_BTG + 4ull * 2 * DFF * DM * 2), B_BTK = al256(B_BTD + 4ull * DM * DFF * 2), B_BTM = al256(B_BTK + 768ull * DM * 2), B_KVB = al256(B_BTM + 2048ull * DM * 2), B_SKF = al256(B_KVB + 6ull * BP * 2 * SP * 64 * 2), B_SVF = al256(B_SKF + (size_t)BP * 2 * SP * 64 * 2), B_KC16 = al256(B_SVF + (size_t)BP * 2 * SP * 64 * 2),
    B_W1T = al256(B_KC16 + 136ull * 2 * 2 * 128 * 64 * 2), B_W2T = al256(B_W1T + 2ull * 128 * 2048 * 2), B_PEB = al256(B_W2T + 2ull * 64 * 128 * 2), B_MEMR = al256(B_PEB + 1024), B_CMPS = al256(B_MEMR + 4ull * 2048 * 512 * 4), B_END = al256(B_CMPS + (size_t)BS * 4 * SP * 64 * 2 + 8192);
constexpr int SSQS = MAP;
static_assert(9 * SSQS * 4 + B_SSQ <= CTL_BYTES, "ssq sites inside the control region");

#ifndef TIME_SUB
#define TIME_SUB 0
#endif
#ifndef TSUB_BLK
#define TSUB_BLK 200
#endif
__device__ unsigned long long g_tsub[8];
#define TSUB_BEGIN() unsigned long long tsub_t0_ = (TIME_SUB && blockIdx.x == TSUB_BLK && threadIdx.x == 0) ? __builtin_amdgcn_s_memrealtime() : 0ull
#define TSUB_END(k) do { if (TIME_SUB && blockIdx.x == TSUB_BLK && threadIdx.x == 0) { const unsigned long long n_ = __builtin_amdgcn_s_memrealtime(); g_tsub[k] += n_ - tsub_t0_; tsub_t0_ = n_; } } while (0)
struct Params { const float* in[N_IN]; float* out; unsigned char* ws; int ph_lo, ph_hi; };

__device__ const unsigned char REL_LUT[128] = {0, 1, 2, 3, 4, 5, 6, 7, 8, 9, 10, 11, 12, 13, 14, 15, 16, 16, 16, 17, 17, 18, 18, 18, 19, 19, 19, 20, 20, 20, 20, 21, 21, 21, 21, 22, 22, 22, 22, 22, 23, 23, 23, 23, 23, 23, 24, 24, 24, 24, 24, 24, 25, 25, 25, 25, 25, 25, 25, 26, 26, 26, 26, 26, 26, 26, 26, 27, 27, 27, 27, 27, 27, 27, 27, 27, 27, 28, 28, 28, 28, 28, 28, 28, 28, 28, 28, 29, 29, 29, 29, 29, 29, 29, 29, 29, 29, 29, 29, 30, 30, 30, 30, 30, 30, 30, 30, 30, 30, 30, 30, 30, 30, 31, 31, 31, 31, 31, 31, 31, 31, 31, 31, 31, 31, 31, 31, 31};
__device__ __forceinline__ int rel_bucket(int d) { return d >= 128 ? 31 : (int)REL_LUT[d < 0 ? 0 : d]; }
__device__ __forceinline__ int rel_bucket_alu(int d) { d = d < 0 ? 0 : d; if (d < 16) return d;
    return 16 + (d >= 19) + (d >= 21) + (d >= 24) + (d >= 27) + (d >= 31) + (d >= 35) + (d >= 40) + (d >= 46) + (d >= 52) + (d >= 59) + (d >= 67) + (d >= 77) + (d >= 87) + (d >= 99) + (d >= 113); }

__device__ __forceinline__ int opq(int i) { asm volatile("" : "+s"(i)); return i; }
#define BAR_LDS() do { asm volatile("s_waitcnt lgkmcnt(0)" ::: "memory"); __builtin_amdgcn_s_barrier(); asm volatile("" ::: "memory"); } while (0)
__device__ __forceinline__ int ltid() { int t = threadIdx.x; asm volatile("" : "+v"(t)); return t; }
__device__ __forceinline__ float wave_sum(float v) {
#pragma unroll
    for (int o = 32; o; o >>= 1) v += __shfl_xor(v, o);
    return v;
}
__device__ __forceinline__ float wave_max(float v) {
#pragma unroll
    for (int o = 32; o; o >>= 1) v = fmaxf(v, __shfl_xor(v, o));
    return v;
}
__device__ __forceinline__ float sigmoidf_(float x) { return 1.0f / (1.0f + expf(-x)); }
__device__ __forceinline__ float logsigmoidf_(float x) { return fminf(x, 0.f) - log1pf(expf(-fabsf(x))); }
__device__ __forceinline__ float dot4(float4 a, float4 b) { return a.x * b.x + a.y * b.y + a.z * b.z + a.w * b.w; }
__device__ __forceinline__ float bf2f(bf16_t u) { return __uint_as_float((unsigned)u << 16); }
__device__ __forceinline__ unsigned f2bf(float f) { unsigned u = __float_as_uint(f); return (u + 0x7fffu + ((u >> 16) & 1u)) >> 16; }
__device__ __forceinline__ unsigned pk2(float lo, float hi) { return f2bf(lo) | (f2bf(hi) << 16); }
__device__ __forceinline__ float bflo(unsigned w) { return __uint_as_float(w << 16); }
__device__ __forceinline__ float bfhi(unsigned w) { return __uint_as_float(w & 0xffff0000u); }
__device__ __forceinline__ float rstd_of(float ssq) { return rsqrtf(ssq * (1.0f / DM) + EPS); }

namespace pg8 {
#define PG8_LAS __attribute__((address_space(3)))
typedef unsigned short bf16_t;
typedef short bf16x8 __attribute__((ext_vector_type(8)));
typedef float f32x4 __attribute__((ext_vector_type(4)));
typedef unsigned u32x4 __attribute__((ext_vector_type(4)));
constexpr int BM = 256, BK = 64, HALF = 128, HTB = HALF * BK * 2  , STAGE_BYTES = 8 * HTB, NXCD = 8, WGM = 8;

__host__ __device__ __forceinline__ int lds_byte(int r, int c) { const int st = (r >> 4) * 2 + (c >> 5), rr = r & 15, cc = c & 31, ob = rr * 64 + cc * 2; return st * 1024 + (ob ^ (((ob >> 9) & 1) << 5)); }
__host__ __device__ __forceinline__ void stage_rc(int b, int& R, int& C) { const int st = b / 1024, sb = b % 1024, swz = sb ^ (((sb >> 9) & 1) << 5); R = (st >> 1) * 16 + swz / 64; C = (st & 1) * 32 + (swz % 64) / 2; }
__host__ __device__ __forceinline__ int perm32(int rho) { const int n = rho >> 4, i = rho & 15; return 8 * (i >> 2) + 4 * n + (i & 3); }

struct Unit { int pm, pn; };
struct Gemm { const bf16_t* A; const bf16_t* Bt; int M, N, K; };

struct StaticOrder {
    int nM, nN, nwg, G, c;
    __host__ __device__ void init(int M, int N, int G_, int c_) { nM = M / BM; nN = N / BM; nwg = nM * nN; G = G_; c = c_; }
    __host__ __device__ bool next(int i, Unit& u) const {
        const long L = (long)i * G + c; if (L >= nwg) return false;
        int wgid = (int)L; { const int q = nwg / NXCD, r = nwg % NXCD, xcd = wgid % NXCD, off = wgid / NXCD; wgid = (xcd < r ? xcd * (q + 1) : r * (q + 1) + (xcd - r) * q) + off; }
        const int nig = WGM * nN, gid = wgid / nig, fm = gid * WGM, gsz = (nM - fm) < WGM ? (nM - fm) : WGM;
        u.pm = fm + ((wgid % nig) % gsz); u.pn = (wgid % nig) / gsz; return true;
    }
    __device__ __forceinline__ void a_ready(const Unit&) const {}
    __device__ __forceinline__ void done(const Unit&) const {}
};

__device__ __forceinline__ unsigned cvt_pk_bf16(float lo, float hi) { unsigned r; asm volatile("v_cvt_pk_bf16_f32 %0, %1, %2" : "=v"(r) : "v"(lo), "v"(hi)); return r; }
typedef float f32x2 __attribute__((ext_vector_type(2)));
__device__ __forceinline__ float fast_sigmoid(float x) { return __builtin_amdgcn_rcpf(1.0f + __builtin_amdgcn_exp2f(-1.4426950408889634f * x)); }
struct EpiF32 {
    static constexpr bool PERM = false, AFTER_DRAIN = false;
    float* O; int ldc; const float* ssq; int split_cols; size_t split_stride;
    __device__ __forceinline__ void operator()(const f32x4 (&acc)[2][2][4][2], const Unit& u, int wr, int wc, int fr, int fq) const {
        int colt = u.pn * BM; float* base = O; if (split_cols) { const int t = colt / split_cols; base += (size_t)t * split_stride; colt -= t * split_cols; }
        const int row0 = u.pm * BM + wr * 64 + fr, col0 = colt + wc * 32 + 4 * fq;
#pragma unroll
        for (int ai = 0; ai < 2; ++ai)
#pragma unroll
            for (int m = 0; m < 4; ++m) { const int r = row0 + ai * HALF + m * 16; const float rs = ssq ? rstd_of(ssq[r]) : 1.0f; float* rowp = base + (size_t)r * ldc + col0;
#pragma unroll
                for (int bj = 0; bj < 2; ++bj)
#pragma unroll
                    for (int n = 0; n < 2; ++n) *(f32x4*)(rowp + bj * HALF + n * 16) = acc[ai][bj][m][n] * rs; }
    }
};
struct EpiBf16S {
    static constexpr bool PERM = true, AFTER_DRAIN = false;
    bf16_t* O; int ldc; const float* ssq; int gate_pn; float* GT;
    __device__ __forceinline__ void operator()(const f32x4 (&acc)[2][2][4][2], const Unit& u, int wr, int wc, int fr, int fq) const {
        const int row0 = u.pm * BM + wr * 64 + fr, col0 = u.pn * BM + wc * 32 + 8 * fq;
        if (u.pn == gate_pn) {
            if (wc == 0 && fq == 0) {
#pragma unroll
                for (int ai = 0; ai < 2; ++ai)
#pragma unroll
                    for (int m = 0; m < 4; ++m) { const int r = row0 + ai * HALF + m * 16; const float rs = rstd_of(ssq[r]);
                        *(f32x4*)(GT + (size_t)r * 48) = acc[ai][0][m][0] * rs; *(f32x4*)(GT + (size_t)r * 48 + 4) = acc[ai][0][m][1] * rs; } }
            return; }
#pragma unroll
        for (int ai = 0; ai < 2; ++ai)
#pragma unroll
            for (int m = 0; m < 4; ++m) { const int r = row0 + ai * HALF + m * 16; const float rs = rstd_of(ssq[r]); bf16_t* rowp = O + (size_t)r * ldc + col0;
#pragma unroll
                for (int bj = 0; bj < 2; ++bj) { const f32x4 v0 = acc[ai][bj][m][0] * rs, v1 = acc[ai][bj][m][1] * rs;
                    u32x4 w; w.x = cvt_pk_bf16(v0[0], v0[1]); w.y = cvt_pk_bf16(v0[2], v0[3]); w.z = cvt_pk_bf16(v1[0], v1[1]); w.w = cvt_pk_bf16(v1[2], v1[3]);
                    *(u32x4*)(rowp + bj * HALF) = w; } }
    }
};
struct EpiSwiglu {
    static constexpr bool PERM = true, AFTER_DRAIN = false;
    bf16_t* O; const float* ssq;
    __device__ __forceinline__ void operator()(const f32x4 (&acc)[2][2][4][2], const Unit& u, int wr, int wc, int fr, int fq) const {
        const int row0 = u.pm * BM + wr * 64 + fr, col0 = u.pn * HALF + wc * 32 + 8 * fq;
#pragma unroll
        for (int ai = 0; ai < 2; ++ai)
#pragma unroll
            for (int m = 0; m < 4; ++m) { const int r = row0 + ai * HALF + m * 16; const float rs = rstd_of(ssq[r]); float h[8];
#pragma unroll
                for (int n = 0; n < 2; ++n)
#pragma unroll
                    for (int j = 0; j < 4; ++j) { const float g = acc[ai][0][m][n][j] * rs, up = acc[ai][1][m][n][j] * rs; h[4 * n + j] = g * fast_sigmoid(g) * up; }
                u32x4 w; w.x = cvt_pk_bf16(h[0], h[1]); w.y = cvt_pk_bf16(h[2], h[3]); w.z = cvt_pk_bf16(h[4], h[5]); w.w = cvt_pk_bf16(h[6], h[7]);
                *(u32x4*)(O + (size_t)r * 2816 + col0) = w; }
    }
};
struct EpiResid {
    static constexpr bool PERM = false, AFTER_DRAIN = false;
    float* Y; bf16_t* XB; float* ssq;
    __device__ __forceinline__ void operator()(const f32x4 (&acc)[2][2][4][2], const Unit& u, int wr, int wc, int fr, int fq) const {
        const int row0 = u.pm * BM + wr * 64 + fr, col0 = u.pn * BM + wc * 32 + 4 * fq;
        typedef unsigned u32x2 __attribute__((ext_vector_type(2)));
#pragma unroll
        for (int ai = 0; ai < 2; ++ai)
#pragma unroll
            for (int m = 0; m < 4; ++m) { const int r = row0 + ai * HALF + m * 16; bf16_t* bp = XB + (size_t)r * 1024 + col0; float ss = 0.f; u32x2 old[2][2];
#pragma unroll
                for (int bj = 0; bj < 2; ++bj)
#pragma unroll
                    for (int n = 0; n < 2; ++n) old[bj][n] = *(const u32x2*)(bp + bj * HALF + n * 16);
#pragma unroll
                for (int bj = 0; bj < 2; ++bj)
#pragma unroll
                    for (int n = 0; n < 2; ++n) { const u32x2 o = old[bj][n]; f32x4 x = (f32x4){bflo(o.x), bfhi(o.x), bflo(o.y), bfhi(o.y)} + acc[ai][bj][m][n];
                        u32x2 w; w.x = cvt_pk_bf16(x[0], x[1]); w.y = cvt_pk_bf16(x[2], x[3]); *(u32x2*)(bp + bj * HALF + n * 16) = w;
                        if (Y) *(f32x4*)(Y + (size_t)r * 1024 + col0 + bj * HALF + n * 16) = x;
                        ss += (x[0] * x[0] + x[1] * x[1]) + (x[2] * x[2] + x[3] * x[3]); }
                ss += __shfl_xor(ss, 16); ss += __shfl_xor(ss, 32);
                if (fq == 0) (void)__hip_atomic_fetch_add(ssq + r, ss, __ATOMIC_RELAXED, __HIP_MEMORY_SCOPE_AGENT); }
    }
};
template <class Epi, class Sched, bool ALIGN_EPI = false, bool SP2 = false>
__device__ __forceinline__ void gemm_phase(PG8_LAS unsigned char* lds, const Gemm g, const Sched& S, const Epi& E) {
    int tid_l = threadIdx.x; asm volatile("" : "+v"(tid_l));
    const int tid = tid_l, wid = __builtin_amdgcn_readfirstlane(tid >> 6), lane = tid & 63, wr = wid >> 2, wc = wid & 3, fr = lane & 15, fq = lane >> 4;
    const int K = g.K, nt = K / BK;
    unsigned voffA[2], voffB[2];
#pragma unroll
    for (int i = 0; i < 2; ++i) { int R, C; stage_rc(tid * 16 + i * 8192, R, C); const int Rb = Epi::PERM ? ((R & ~31) + perm32(R & 31)) : R;
        voffA[i] = (unsigned)(R * K + C) * 2u; voffB[i] = (unsigned)(Rb * K + C) * 2u; }
    const size_t kstep = (size_t)(BK * 2);
    const size_t hstep = (size_t)HALF * K * 2;
    const size_t tstep = 2 * hstep;
    const unsigned ldsw = (unsigned)wid * 1024u;
    const int aoff = lds_byte(wr * 64 + fr, fq * 8), boff = lds_byte(wc * 32 + fr, fq * 8);
#define PG8_SA(b, h) (((b) * 2 + (h)) * HTB)
#define PG8_SB(b, h) ((4 + (b) * 2 + (h)) * HTB)
#define PG8_STAGE(bufoff, gbase, voff) do { _Pragma("unroll") for (int _i = 0; _i < 2; ++_i) \
        __builtin_amdgcn_global_load_lds((const unsigned*)((const char*)(gbase) + (voff)[_i]), (PG8_LAS unsigned*)(lds + (bufoff) + ldsw + _i * 8192), 16, 0, 0); } while (0)
#define PG8_LDA(dst, b, h) do { _Pragma("unroll") for (int m = 0; m < 4; ++m) _Pragma("unroll") for (int k = 0; k < 2; ++k) dst[m][k] = *(const PG8_LAS bf16x8*)(lds + PG8_SA(b, h) + aoff + m * 2048 + k * 1024); } while (0)
#define PG8_LDB(dst, b, h) do { _Pragma("unroll") for (int n = 0; n < 2; ++n) _Pragma("unroll") for (int k = 0; k < 2; ++k) dst[n][k] = *(const PG8_LAS bf16x8*)(lds + PG8_SB(b, h) + boff + n * 2048 + k * 1024); } while (0)
#define PG8_MMA(ai, bj, At, Bt) do { __builtin_amdgcn_s_setprio(1); _Pragma("unroll") for (int m = 0; m < 4; ++m) _Pragma("unroll") for (int n = 0; n < 2; ++n) _Pragma("unroll") for (int k = 0; k < 2; ++k) \
        acc[ai][bj][m][n] = __builtin_amdgcn_mfma_f32_16x16x32_bf16(Bt[n][k], At[m][k], acc[ai][bj][m][n], 0, 0, 0); __builtin_amdgcn_s_setprio(0); } while (0)
#define PG8_WAIT_V(n) asm volatile("s_waitcnt vmcnt(" #n ")" ::: "memory")
#define PG8_WAIT_L(n) asm volatile("s_waitcnt lgkmcnt(" #n ")" ::: "memory")
#define PG8_BAR __builtin_amdgcn_s_barrier()
#define PG8_SCHED __builtin_amdgcn_sched_barrier(0)
    Unit cur, nxt; int ui = 0;
    if (!S.next(0, cur)) return;
    f32x4 acc[2][2][4][2];
#pragma unroll
    for (int a = 0; a < 2; ++a)
#pragma unroll
        for (int b = 0; b < 2; ++b)
#pragma unroll
            for (int m = 0; m < 4; ++m)
#pragma unroll
                for (int n = 0; n < 2; ++n) acc[a][b][m][n] = (f32x4){0.f, 0.f, 0.f, 0.f};
    bf16x8 At[4][2], B0[2][2], B1[2][2];
    const char* cA = (const char*)g.A + (size_t)cur.pm * tstep; const char* cB = (const char*)g.Bt + (size_t)cur.pn * tstep;
    S.a_ready(cur);
    if constexpr (SP2) {
        PG8_STAGE(PG8_SB(0, 0), cB, voffB); PG8_STAGE(PG8_SB(0, 1), cB + hstep, voffB); PG8_STAGE(PG8_SA(0, 0), cA, voffA); PG8_STAGE(PG8_SA(0, 1), cA + hstep, voffA);
        if (wr == 1) PG8_BAR;
        PG8_WAIT_V(2); PG8_BAR;
        PG8_STAGE(PG8_SB(1, 0), cB + kstep, voffB); PG8_STAGE(PG8_SA(1, 0), cA + kstep, voffA); PG8_STAGE(PG8_SB(1, 1), cB + hstep + kstep, voffB);
        PG8_WAIT_V(6); PG8_BAR;
    } else {
        PG8_STAGE(PG8_SB(0, 0), cB, voffB); PG8_STAGE(PG8_SA(0, 0), cA, voffA); PG8_STAGE(PG8_SB(0, 1), cB + hstep, voffB); PG8_STAGE(PG8_SA(0, 1), cA + hstep, voffA);
        if (wr == 1) PG8_BAR;
        PG8_WAIT_V(4); PG8_BAR;
        PG8_STAGE(PG8_SB(1, 0), cB + kstep, voffB); PG8_STAGE(PG8_SA(1, 0), cA + kstep, voffA); PG8_STAGE(PG8_SB(1, 1), cB + hstep + kstep, voffB);
        PG8_WAIT_V(6); PG8_BAR;
    }
    for (;;) {
        const bool has_next = S.next(ui + 1, nxt);
        const char* nA = has_next ? (const char*)g.A + (size_t)nxt.pm * tstep : cA; const char* nB = has_next ? (const char*)g.Bt + (size_t)nxt.pn * tstep : cB;
        for (int t = 0; t < nt; t += 2) {
            const bool last = (t == nt - 2);
            const char* a1 = cA + (size_t)(t + 1) * kstep;
            const char* a2 = last ? nA : cA + (size_t)(t + 2) * kstep; const char* b2 = last ? nB : cB + (size_t)(t + 2) * kstep;
            const char* a3 = a2 + kstep; const char* b3 = b2 + kstep;
            if (last && has_next) S.a_ready(nxt);
            if constexpr (SP2) {
            PG8_LDB(B0, 0, 0); PG8_LDB(B1, 0, 1); PG8_SCHED; PG8_LDA(At, 0, 0); PG8_STAGE(PG8_SA(1, 1), a1 + hstep, voffA);
            PG8_WAIT_V(8); PG8_WAIT_L(0); PG8_BAR; PG8_MMA(0, 0, At, B0); PG8_MMA(0, 1, At, B1); PG8_BAR; PG8_SCHED;
            PG8_LDA(At, 0, 1); PG8_STAGE(PG8_SB(0, 0), b2, voffB); PG8_STAGE(PG8_SB(0, 1), b2 + hstep, voffB); PG8_STAGE(PG8_SA(0, 0), a2, voffA);
            PG8_WAIT_V(8); PG8_WAIT_L(0); PG8_BAR; PG8_MMA(1, 0, At, B0); PG8_MMA(1, 1, At, B1); PG8_BAR; PG8_SCHED;
            PG8_LDB(B0, 1, 0); PG8_LDB(B1, 1, 1); PG8_SCHED; PG8_LDA(At, 1, 0); PG8_STAGE(PG8_SA(0, 1), a2 + hstep, voffA);
            PG8_WAIT_V(8); PG8_WAIT_L(0); PG8_BAR; PG8_MMA(0, 0, At, B0); PG8_MMA(0, 1, At, B1); PG8_BAR; PG8_SCHED;
            PG8_LDA(At, 1, 1); PG8_STAGE(PG8_SB(1, 0), b3, voffB); PG8_STAGE(PG8_SB(1, 1), b3 + hstep, voffB); PG8_STAGE(PG8_SA(1, 0), a3, voffA);
            PG8_WAIT_V(8); PG8_WAIT_L(0); PG8_BAR; PG8_MMA(1, 0, At, B0); PG8_MMA(1, 1, At, B1); PG8_BAR; PG8_SCHED;
            } else {
            PG8_LDB(B0, 0, 0); PG8_SCHED; PG8_LDA(At, 0, 0); PG8_STAGE(PG8_SA(1, 1), a1 + hstep, voffA);
            PG8_WAIT_L(8); PG8_BAR; PG8_WAIT_L(0); PG8_MMA(0, 0, At, B0); PG8_BAR; PG8_SCHED;
            PG8_LDB(B1, 0, 1); PG8_STAGE(PG8_SB(0, 0), b2, voffB);
            PG8_BAR; PG8_WAIT_L(0); PG8_MMA(0, 1, At, B1); PG8_BAR;
            PG8_LDA(At, 0, 1); PG8_STAGE(PG8_SA(0, 0), a2, voffA);
            PG8_BAR; PG8_WAIT_L(0); PG8_MMA(1, 0, At, B0); PG8_BAR; PG8_SCHED;
            PG8_STAGE(PG8_SB(0, 1), b2 + hstep, voffB);
            PG8_WAIT_V(6); PG8_BAR; PG8_MMA(1, 1, At, B1); PG8_BAR;
            PG8_LDB(B0, 1, 0); PG8_SCHED; PG8_LDA(At, 1, 0); PG8_STAGE(PG8_SA(0, 1), a2 + hstep, voffA);
            PG8_WAIT_L(8); PG8_BAR; PG8_WAIT_L(0); PG8_MMA(0, 0, At, B0); PG8_BAR; PG8_SCHED;
            PG8_LDB(B1, 1, 1); PG8_STAGE(PG8_SB(1, 0), b3, voffB);
            PG8_BAR; PG8_WAIT_L(0); PG8_MMA(0, 1, At, B1); PG8_BAR;
            PG8_LDA(At, 1, 1); PG8_STAGE(PG8_SA(1, 0), a3, voffA);
            PG8_BAR; PG8_WAIT_L(0); PG8_MMA(1, 0, At, B0); PG8_BAR; PG8_SCHED;
            PG8_STAGE(PG8_SB(1, 1), b3 + hstep, voffB);
            PG8_WAIT_V(6); PG8_BAR; PG8_MMA(1, 1, At, B1); PG8_BAR;
            }
        }
        if constexpr (ALIGN_EPI) { if (wr == 0) PG8_BAR; }
        if constexpr (!Epi::AFTER_DRAIN) { E(acc, cur, wr, wc, fr, fq); S.done(cur); }
        if (!has_next) break;
#pragma unroll
        for (int a = 0; a < 2; ++a)
#pragma unroll
            for (int b = 0; b < 2; ++b)
#pragma unroll
                for (int m = 0; m < 4; ++m)
#pragma unroll
                    for (int n = 0; n < 2; ++n) acc[a][b][m][n] = (f32x4){0.f, 0.f, 0.f, 0.f};
        cur = nxt; cA = nA; cB = nB; ++ui;
        if constexpr (ALIGN_EPI) { if (wr == 1) PG8_BAR; }
    }
    PG8_WAIT_V(0);
    if constexpr (!ALIGN_EPI) { if (wr == 0) PG8_BAR; }
    PG8_BAR;
    if constexpr (Epi::AFTER_DRAIN) { E.fused(acc, cur, wr, wc, fr, fq, lds, wid, lane); S.done(cur); }
#undef PG8_SA
#undef PG8_SB
#undef PG8_STAGE
#undef PG8_LDA
#undef PG8_LDB
#undef PG8_MMA
#undef PG8_WAIT_V
#undef PG8_WAIT_L
#undef PG8_BAR
#undef PG8_SCHED
}
}
typedef short s_bf16x8 __attribute__((ext_vector_type(8)));
typedef float s_f32x4 __attribute__((ext_vector_type(4)));
template <int NT> struct StripAcc { s_f32x4 a[NT]; };
template <int NT> __device__ __forceinline__ void strip_gemm(const bf16_t* A, int K, int row0, const bf16_t* Bt, const int* brow  , StripAcc<NT>& R, LAS unsigned char* lds) {
    const int tid_ = ltid(), lane = tid_ & 63, wave = tid_ >> 6, fr = lane & 15, fq = lane >> 4, rt = wave & 1, kq = wave >> 1;
    LAS float* red = (LAS float*)lds;
    const int kw = K >> 2;
    const bf16_t* ap = A + (size_t)(row0 + 16 * rt + fr) * K + kq * kw + fq * 8;
    const bf16_t* bp[NT];
#pragma unroll
    for (int t = 0; t < NT; ++t) { bp[t] = Bt + (size_t)(brow[t] + fr) * K + kq * kw + fq * 8; R.a[t] = (s_f32x4){0.f, 0.f, 0.f, 0.f}; }
    int k0 = 0;
#pragma unroll 1
    for (; k0 + 256 <= kw; k0 += 256) {
        s_bf16x8 a[8], b[NT][8];
#pragma unroll
        for (int s2 = 0; s2 < 8; ++s2) { a[s2] = *(const s_bf16x8*)(ap + k0 + s2 * 32);
#pragma unroll
            for (int t = 0; t < NT; ++t) b[t][s2] = *(const s_bf16x8*)(bp[t] + k0 + s2 * 32); }
#pragma unroll
        for (int s2 = 0; s2 < 8; ++s2)
#pragma unroll
            for (int t = 0; t < NT; ++t) R.a[t] = __builtin_amdgcn_mfma_f32_16x16x32_bf16(b[t][s2], a[s2], R.a[t], 0, 0, 0);
    }
#pragma unroll 1
    for (; k0 < kw; k0 += 64) {
        s_bf16x8 a[2], b[NT][2];
#pragma unroll
        for (int s2 = 0; s2 < 2; ++s2) { a[s2] = *(const s_bf16x8*)(ap + k0 + s2 * 32);
#pragma unroll
            for (int t = 0; t < NT; ++t) b[t][s2] = *(const s_bf16x8*)(bp[t] + k0 + s2 * 32); }
#pragma unroll
        for (int s2 = 0; s2 < 2; ++s2)
#pragma unroll
            for (int t = 0; t < NT; ++t) R.a[t] = __builtin_amdgcn_mfma_f32_16x16x32_bf16(b[t][s2], a[s2], R.a[t], 0, 0, 0);
    }
    __syncthreads();
    if (kq > 0) {
#pragma unroll
        for (int t = 0; t < NT; ++t) *(LAS s_f32x4*)(red + ((((kq - 1) * 2 + rt) * NT + t) * 64 + lane) * 4) = R.a[t]; }
    __syncthreads();
    if (kq == 0) {
#pragma unroll
        for (int q = 0; q < 3; ++q)
#pragma unroll
            for (int t = 0; t < NT; ++t) R.a[t] = R.a[t] + *(const LAS s_f32x4*)(red + (((q * 2 + rt) * NT + t) * 64 + lane) * 4); }
}
enum { TR_ID = 0, TR_INA, TR_INB, TR_GU };
__device__ __forceinline__ int tr_rowmap(int kind, int n) {
    if (kind == TR_INA) return n < 3072 ? n : (n < 3080 ? 3328 + (n - 3072) : 3072 + (n - 3080));
    if (kind == TR_INB) return n < 768 ? n : (n < 804 ? 1024 + (n - 768) : 768 + (n - 804));
    if (kind == TR_GU) { if (n < DFF) return (n >> 7) * 256 + (n & 127); const int m = n - DFF; return (m >> 7) * 256 + 128 + (m & 127); }
    return n;
}
__device__ __forceinline__ void tr_item(const float* W, int K, int N, bf16_t* WT, const float* gain, int kind, LAS float* scr, int item, int lane) {
    const int nblk = (N + 31) >> 5, kb = item / nblk, nb = item % nblk, k0 = 64 * kb, n0 = 32 * nb;
    { float v[32]; const int n = n0 + (lane & 31); const bool ok = n < N; const float* wp = W + (size_t)(k0 + (lane >> 5)) * N + (ok ? n : 0);
#pragma unroll
      for (int i = 0; i < 32; ++i) v[i] = wp[(size_t)(2 * i) * N];
#pragma unroll
      for (int i = 0; i < 32; ++i) { const int kk = 2 * i + (lane >> 5); float x = ok ? v[i] : 0.f; if (gain) x *= gain[k0 + kk]; scr[kk * 33 + (lane & 31)] = x; } }
    asm volatile("s_waitcnt lgkmcnt(0)" ::: "memory");
    const int c = lane & 7;
#pragma unroll
    for (int j = 0; j < 4; ++j) { const int nn = (lane >> 3) + 8 * j, n = n0 + nn;
        if (n < N) { const int row = tr_rowmap(kind, n); const float sc = (kind == TR_INA && n >= 768 && n < 1536) ? 0.07216878364870322f : 1.0f;
            const LAS float* s = scr + (8 * c) * 33 + nn; uint4 o;
            o.x = pk2(s[0 * 33] * sc, s[1 * 33] * sc); o.y = pk2(s[2 * 33] * sc, s[3 * 33] * sc); o.z = pk2(s[4 * 33] * sc, s[5 * 33] * sc); o.w = pk2(s[6 * 33] * sc, s[7 * 33] * sc);
            *(uint4*)(WT + (size_t)row * K + k0 + 8 * c) = o; } }
    asm volatile("s_waitcnt lgkmcnt(0)" ::: "memory");
}
__device__ __forceinline__ void ph_prologue(const Params& p, LAS unsigned char* lds) {
    const int tid = ltid(), lane = tid & 63, wid = tid >> 6; const int gw = blockIdx.x * NW_ + wid, NGW = gridDim.x * NW_;
    LAS float* scr = (LAS float*)(lds + wid * 16384);
    unsigned char* ws = p.ws;
    for (int it = gw; ; it += NGW) {
        int r = it; bool done = false;
#define TRJ(Wp, K_, N_, WTp, gainp, kind_) if (!done) { const int cnt = ((K_) / 64) * (((N_) + 31) / 32); if (r < cnt) { tr_item(Wp, K_, N_, WTp, gainp, kind_, scr, r, lane); done = true; } else r -= cnt; }
        for (int l = 0; l < 4; ++l) TRJ(p.in[I_WGU] + (size_t)l * DM * 2 * DFF, DM, 2 * DFF, (bf16_t*)(ws + B_BTG) + (size_t)l * 2 * DFF * DM, p.in[I_GFFN] + l * DM, TR_GU)
        for (int l = 0; l < 4; ++l) TRJ(p.in[I_WDOWN] + (size_t)l * DFF * DM, DFF, DM, (bf16_t*)(ws + B_BTD) + (size_t)l * DM * DFF, (const float*)nullptr, TR_ID)
        for (int l = 0; l < 2; ++l) TRJ(p.in[I_WINA] + (size_t)l * DM * ACOLS, DM, ACOLS, (bf16_t*)(ws + B_BTA) + (size_t)l * NBTA * DM, p.in[I_GMIX] + l * DM, TR_INA)
        for (int l = 0; l < 2; ++l) TRJ(p.in[I_WINB] + (size_t)l * DM * BCOLS, DM, BCOLS, (bf16_t*)(ws + B_BTB) + (size_t)l * NBTB * DM, p.in[I_GMIX] + (2 + l) * DM, TR_INB)
        for (int l = 0; l < 4; ++l) TRJ(p.in[I_WOUT] + (size_t)l * DM * DM, DM, DM, (bf16_t*)(ws + B_BTO) + (size_t)l * DM * DM, (const float*)nullptr, TR_ID)
        TRJ(p.in[I_WKV], DM, 768, (bf16_t*)(ws + B_BTK), p.in[I_GKV], TR_ID)
        for (int l = 0; l < 4; ++l) TRJ(p.in[I_WMEMKV] + (size_t)l * DM * 512, DM, 512, (bf16_t*)(ws + B_BTM) + (size_t)l * 512 * DM, (const float*)nullptr, TR_ID)
        for (int c = 0; c < 2; ++c) TRJ(p.in[I_CW1] + (size_t)c * 2048 * 128, 2048, 128, (bf16_t*)(ws + B_W1T) + (size_t)c * 128 * 2048, (const float*)nullptr, TR_ID)
        for (int c = 0; c < 2; ++c) TRJ(p.in[I_CW2] + (size_t)c * 128 * 64, 128, 64, (bf16_t*)(ws + B_W2T) + (size_t)c * 64 * 128, (const float*)nullptr, TR_ID)
#undef TRJ
        if (!done) break;
    }
    for (int idx = gw; idx < 256; idx += NGW) { const int c = idx >> 7, h = idx & 127; float s = 0.f;
        for (int k = lane; k < 2048; k += 64) s += p.in[I_CPOS][((k >> 6) * 2 + c) * 64 + (k & 63)] * p.in[I_CW1][((size_t)c * 2048 + k) * 128 + h];
        s = wave_sum(s); if (lane == 0) ((float*)(ws + B_PEB))[idx] = s + p.in[I_CB1][idx]; }
    for (int i = blockIdx.x * NT_ + tid; i < 2 * 8 * 128 + 2 * 12 * 128; i += gridDim.x * NT_) {
        uint4 z = make_uint4(0u, 0u, 0u, 0u);
        if (i < 2048) { const int l = i >> 10, rr = (i >> 7) & 7, c = i & 127; ((uint4*)((bf16_t*)(ws + B_BTA) + ((size_t)l * NBTA + 3336 + rr) * DM))[c] = z; }
        else { const int k = i - 2048; const int l = k / 1536, rr = (k % 1536) >> 7, c = k & 127; ((uint4*)((bf16_t*)(ws + B_BTB) + ((size_t)l * NBTB + 1060 + rr) * DM))[c] = z; }
    }
    bf16_t* XB = (bf16_t*)(ws + B_XB); float* ssq0 = (float*)(ws + B_SSQ); bf16_t* MPB = (bf16_t*)(ws + B_MPB);
    for (int r0 = gw; r0 < MA + 2048; r0 += 2 * NGW) {
        float4 v[2][4]; const int r1 = r0 + NGW < MA + 2048 ? r0 + NGW : r0;
#pragma unroll
        for (int u = 0; u < 2; ++u) { const int r = u ? r1 : r0; const float* src = r < MA ? (r < MP ? p.in[I_XP] + (size_t)r * DM : p.in[I_XS] + (size_t)(r - MP) * DM) : p.in[I_MEMP] + (size_t)(r - MA) * DM;
#pragma unroll
            for (int j = 0; j < 4; ++j) v[u][j] = ((const float4*)src)[lane + 64 * j]; }
#pragma unroll
        for (int u = 0; u < 2; ++u) { const int r = u ? r1 : r0; if (u == 1 && r1 == r0) break; const bool isx = r < MA;
            bf16_t* dstb = isx ? XB + (size_t)r * DM : MPB + (size_t)(r - MA) * DM; float ss = 0.f;
#pragma unroll
            for (int j = 0; j < 4; ++j) { ss += dot4(v[u][j], v[u][j]); ((uint2*)dstb)[lane + 64 * j] = make_uint2(pk2(v[u][j].x, v[u][j].y), pk2(v[u][j].z, v[u][j].w)); }
            ss = wave_sum(ss); if (isx && lane == 0) ssq0[r] = ss; }
    }
}

__device__ __forceinline__ void ph_swin_copy(const Params& p, int blk0, int nblk) {
    if ((int)blockIdx.x < blk0 || (int)blockIdx.x >= blk0 + nblk) return;
    const int tid = ltid();
    {   const unsigned n4 = 128u * 511u * 64u, stride = nblk * NT_;
#define SW_SRC(i_) (((const float4*)(p.in[I_CWIN] + (size_t)((i_) / (511u * 64u)) * 512 * 256 + 256))[(i_) % (511u * 64u)])
#define SW_DST(i_) (((float4*)(p.out + O_SWIN + (size_t)((i_) / (511u * 64u)) * 512 * 256))[(i_) % (511u * 64u)])
        for (unsigned i0 = (blockIdx.x - blk0) * NT_ + tid; i0 < n4; i0 += 4 * stride) {
            const unsigned i1 = i0 + stride, i2 = i0 + 2 * stride, i3 = i0 + 3 * stride;
            const float4 v0 = SW_SRC(i0), v1 = SW_SRC(i1 < n4 ? i1 : i0), v2 = SW_SRC(i2 < n4 ? i2 : i0), v3 = SW_SRC(i3 < n4 ? i3 : i0);
            SW_DST(i0) = v0; if (i1 < n4) SW_DST(i1) = v1; if (i2 < n4) SW_DST(i2) = v2; if (i3 < n4) SW_DST(i3) = v3; }
#undef SW_SRC
#undef SW_DST
    }
}

__device__ __forceinline__ void ph_memk_norm(const Params& p) {
    const int tid_ = ltid(); const int lane = tid_ & 63, wid = tid_ >> 6;
    const float* raw = (const float*)(p.ws + B_MEMR);
    for (int it = blockIdx.x * NW_ + wid; it < 4 * 8 * 256; it += gridDim.x * NW_) {
        const int l = it / 2048;
        const float4* rr = (const float4*)(raw + (size_t)it * 512); float4* orow = (float4*)(p.out + O_PMEM + (size_t)it * 512);
        float4 v = rr[lane]; const float4 vv = rr[64 + lane]; float ss = dot4(v, v);
        ss += __shfl_xor(ss, 1); ss += __shfl_xor(ss, 2); ss += __shfl_xor(ss, 4); ss += __shfl_xor(ss, 8);
        const float rs = rsqrtf(ss * (1.0f / 64) + EPS);
        const float4 g = ((const float4*)(p.in[I_GMEMK] + l * 64))[lane & 15];
        v.x *= rs * g.x; v.y *= rs * g.y; v.z *= rs * g.z; v.w *= rs * g.w; orow[lane] = v; orow[64 + lane] = vv;
    }
}

__device__ __forceinline__ void ph_mlstm_prompt(const Params& p, int l, float* lds) {
    const bf16_t* P = (const bf16_t*)(p.ws + B_P16); const float* GT = (const float*)(p.ws + B_GT); const float* bif = p.in[I_BIF] + l * 8; float* HR = (float*)(p.ws + B_HRAW);
    const int tid = ltid(), lane = tid & 63, wid = tid >> 6;
    float* red = lds;
    for (int item = blockIdx.x; item < 256; item += gridDim.x) {
        const int es = item & 7, h = (item >> 3) & 3, b = item >> 5;
        const bool act = tid < 384; const int grp = tid >= 192 ? 1 : 0; const int d = act ? tid - grp * 192 : 0;
        const int col0 = h * 192 + es * 24 + (act ? grp : 0) * 12;
        float C[12]; float n = 0.f, m = NEGM;
#pragma unroll
        for (int e = 0; e < 12; ++e) C[e] = 0.f;
        const bf16_t* pr = P + (size_t)(b * SP) * LDA_; const float* gr = GT + (size_t)(b * SP) * GTW;
        float qn = act ? bf2f(pr[h * 192 + d]) : 0.f, kn = act ? bf2f(pr[768 + h * 192 + d]) : 0.f; uint2 vn[3];
#pragma unroll
        for (int e = 0; e < 3; ++e) vn[e] = *(const uint2*)(pr + 1536 + col0 + 4 * e);
        float in_ = gr[h] + bif[h], fn = gr[4 + h] + bif[4 + h];
        for (int t = 0; t < SP; ++t) {
            const float q = qn, k = kn, ig = in_, fg = fn; float v[12];
#pragma unroll
            for (int e = 0; e < 3; ++e) { v[4 * e] = bflo(vn[e].x); v[4 * e + 1] = bfhi(vn[e].x); v[4 * e + 2] = bflo(vn[e].y); v[4 * e + 3] = bfhi(vn[e].y); }
            if (t + 1 < SP) {
                pr += LDA_; gr += GTW;
                qn = act ? bf2f(pr[h * 192 + d]) : 0.f; kn = act ? bf2f(pr[768 + h * 192 + d]) : 0.f;
#pragma unroll
                for (int e = 0; e < 3; ++e) vn[e] = *(const uint2*)(pr + 1536 + col0 + 4 * e);
                in_ = gr[h] + bif[h]; fn = gr[4 + h] + bif[4 + h];
            }
            const float logf = logsigmoidf_(fg);
            const float m_new = fmaxf(logf + m, ig);
            const float a = expf(logf + m - m_new), bb = expf(ig - m_new);
            const float kb = bb * k;
            float part[13];
#pragma unroll
            for (int e = 0; e < 12; ++e) { C[e] = a * C[e] + kb * v[e]; part[e] = q * C[e]; }
            n = a * n + kb; part[12] = q * n;
#pragma unroll
            for (int e = 0; e < 13; ++e) part[e] = wave_sum(part[e]);
            float* rb = red + (t & 1) * 104;
            if (lane == 0) {
#pragma unroll
                for (int e = 0; e < 13; ++e) rb[wid * 13 + e] = part[e];
            }
            __syncthreads();
            if (tid < 24) {
                const int g2 = tid / 12, e = tid % 12;
                const float num = rb[(g2 * 3) * 13 + e] + rb[(g2 * 3 + 1) * 13 + e] + rb[(g2 * 3 + 2) * 13 + e];
                const float den = rb[12] + rb[13 + 12] + rb[26 + 12];
                HR[(size_t)(b * SP + t) * 768 + h * 192 + es * 24 + tid] = num / fmaxf(fabsf(den), expf(-m_new));
            }
            m = m_new;
        }
        if (act) {
            float* co = p.out + O_PC + ((size_t)((l * 8 + b) * 4 + h) * 192 + d) * 192 + es * 24 + grp * 12;
#pragma unroll
            for (int e = 0; e < 12; ++e) co[e] = C[e];
            if (es == 0 && grp == 0) p.out[O_PN + (size_t)((l * 8 + b) * 4 + h) * 192 + d] = n;
        }
        if (es == 0 && tid == 0) p.out[O_PM + (l * 8 + b) * 4 + h] = m;
        __syncthreads();
    }
}
__device__ __forceinline__ void ph_mlstm_sample(const Params& p, int l, float* lds) {
    const bf16_t* P = (const bf16_t*)(p.ws + B_P16); const float* GT = (const float*)(p.ws + B_GT); const float* bif = p.in[I_BIF] + l * 8; float* HR = (float*)(p.ws + B_HRAW);
    const int tid = ltid();
    float* qs = lds + 512; float* ks = lds + 512 + 192; float* n0s = lds + 512 + 384;
    for (int item = blockIdx.x; item < 128 * 4; item += gridDim.x) {
        const int h = item & 3, b = item >> 2; const int row = MP + b;
        const bf16_t* pr = P + (size_t)row * LDA_; const float* gr = GT + (size_t)row * GTW;
        const size_t sidx = (size_t)(l * 128 + b) * 4 + h;
        __syncthreads();
        if (tid < 192) { qs[tid] = bf2f(pr[h * 192 + tid]); ks[tid] = bf2f(pr[768 + h * 192 + tid]); n0s[tid] = p.in[I_SN][sidx * 192 + tid]; }
        __syncthreads();
        const float ig = gr[h] + bif[h], fg = gr[4 + h] + bif[4 + h];
        const float m0 = p.in[I_SM][sidx];
        const float logf = logsigmoidf_(fg);
        const float m_new = fmaxf(logf + m0, ig);
        const float a = expf(logf + m0 - m_new), bb = expf(ig - m_new);
        if (tid < 192) {
            const int e = tid; const float ve = bf2f(pr[1536 + h * 192 + e]);
            const float* C0 = p.in[I_SC] + sidx * 192 * 192; float* C1 = p.out + O_SC + sidx * 192 * 192;
            float num = 0.f, den = 0.f;
            for (int d = 0; d < 192; ++d) {
                const float c = a * C0[d * 192 + e] + bb * ks[d] * ve; C1[d * 192 + e] = c; num += qs[d] * c;
                const float nd = a * n0s[d] + bb * ks[d]; den += qs[d] * nd;
            }
            HR[(size_t)row * 768 + h * 192 + e] = num / fmaxf(fabsf(den), expf(-m_new));
            p.out[O_SN + sidx * 192 + e] = a * n0s[e] + bb * ks[e];
        }
        if (tid == 0) p.out[O_SM + sidx] = m_new;
    }
}
__device__ __forceinline__ void ph_mlstm_fin(const Params& p, int l) {
    const bf16_t* P = (const bf16_t*)(p.ws + B_P16); const float* HR = (const float*)(p.ws + B_HRAW); bf16_t* CATB = (bf16_t*)(p.ws + B_CATB); const float* g = p.in[I_GHN] + l * 192;
    const int tid_ = ltid(); const int lane = tid_ & 63, wid = tid_ >> 6;
    for (int row = blockIdx.x * NW_ + wid; row < MA; row += gridDim.x * NW_) {
        float v[4][3]; bf16_t og[4][3];
#pragma unroll
        for (int h = 0; h < 4; ++h)
#pragma unroll
            for (int i = 0; i < 3; ++i) { v[h][i] = HR[(size_t)row * 768 + h * 192 + lane + 64 * i]; og[h][i] = P[(size_t)row * LDA_ + 2304 + h * 192 + lane + 64 * i]; }
#pragma unroll
        for (int h = 0; h < 4; ++h) { float ss = v[h][0] * v[h][0] + v[h][1] * v[h][1] + v[h][2] * v[h][2]; ss = wave_sum(ss); const float rs = rsqrtf(ss * (1.0f / 192) + EPS);
#pragma unroll
            for (int i = 0; i < 3; ++i) { const int d = lane + 64 * i; CATB[(size_t)row * DM + h * 192 + d] = (bf16_t)f2bf(sigmoidf_(bf2f(og[h][i])) * (v[h][i] * rs * g[d])); } }
    }
}
__device__ __forceinline__ void ph_mem_attn(const Params& p, int l) {
    const int ldp = l < 2 ? LDA_ : LDB_, qoff = l < 2 ? 3072 : 768;
    const bf16_t* P = (const bf16_t*)(p.ws + B_P16); bf16_t* CATB = (bf16_t*)(p.ws + B_CATB); const float* gq = p.in[I_GMEMQ] + l * 64;
    for (int idx4 = blockIdx.x * NT_ + ltid(); idx4 < 16 * MA; idx4 += gridDim.x * NT_) {
        const int part = idx4 & 3, idx = idx4 >> 2;
        const int hh = idx / MA, row = idx % MA;
        const float* kvb = row < MP ? p.out + O_PMEM + (size_t)(l * 8 + row / SP) * 256 * 512 : p.in[I_CMEM] + (size_t)(l * 128 + (row - MP)) * 256 * 512;
        float q[16]; float ss = 0.f;
        const uint4* qp = (const uint4*)(P + (size_t)row * ldp + qoff + hh * 64 + part * 16);
#pragma unroll
        for (int i = 0; i < 2; ++i) { const uint4 t = qp[i]; q[8 * i] = bflo(t.x); q[8 * i + 1] = bfhi(t.x); q[8 * i + 2] = bflo(t.y); q[8 * i + 3] = bfhi(t.y); q[8 * i + 4] = bflo(t.z); q[8 * i + 5] = bfhi(t.z); q[8 * i + 6] = bflo(t.w); q[8 * i + 7] = bfhi(t.w); }
#pragma unroll
        for (int i = 0; i < 16; ++i) ss += q[i] * q[i];
        ss += __shfl_xor(ss, 1); ss += __shfl_xor(ss, 2);
        const float rs = rsqrtf(ss * (1.0f / 64) + EPS) * 0.125f;
#pragma unroll
        for (int i = 0; i < 16; ++i) q[i] *= rs * gq[part * 16 + i];
        float mx = -3e38f, den = 0.f; float o[16];
#pragma unroll
        for (int i = 0; i < 16; ++i) o[i] = 0.f;
        for (int m = 0; m < 256; ++m) {
            const float4* kp = (const float4*)(kvb + (size_t)m * 512 + hh * 64 + part * 16); const float4* vp = (const float4*)(kvb + (size_t)m * 512 + 256 + hh * 64 + part * 16);
            float s = 0.f;
#pragma unroll
            for (int i = 0; i < 4; ++i) { const float4 t = kp[i]; s += q[4 * i] * t.x + q[4 * i + 1] * t.y + q[4 * i + 2] * t.z + q[4 * i + 3] * t.w; }
            s += __shfl_xor(s, 1); s += __shfl_xor(s, 2);
            const float mn = fmaxf(mx, s); const float sc = expf(mx - mn), e = expf(s - mn); mx = mn; den = den * sc + e;
#pragma unroll
            for (int i = 0; i < 4; ++i) { const float4 t = vp[i]; o[4 * i] = o[4 * i] * sc + e * t.x; o[4 * i + 1] = o[4 * i + 1] * sc + e * t.y; o[4 * i + 2] = o[4 * i + 2] * sc + e * t.z; o[4 * i + 3] = o[4 * i + 3] * sc + e * t.w; }
        }
        const float inv = 1.0f / den; uint4* op = (uint4*)(CATB + (size_t)row * DM + 768 + hh * 64 + part * 16);
#pragma unroll
        for (int i = 0; i < 2; ++i) op[i] = make_uint4(pk2(o[8 * i] * inv, o[8 * i + 1] * inv), pk2(o[8 * i + 2] * inv, o[8 * i + 3] * inv), pk2(o[8 * i + 4] * inv, o[8 * i + 5] * inv), pk2(o[8 * i + 6] * inv, o[8 * i + 7] * inv));
    }
}
__device__ __forceinline__ void rows_post_tile(const Params& p, int row0, int t) {
    float* KVR = (float*)(p.ws + B_KVR); const int tid_ = ltid(); const int lane = tid_ & 63, wid = tid_ >> 6;
    const int c2 = lane >> 5, gg = (lane >> 4) & 1, d = (lane & 15) * 4; bf16_t* KVB = (bf16_t*)(p.ws + B_KVB); const size_t KT = (size_t)BP * 2 * SP * 64;
#pragma unroll 1
    for (int rr0 = wid; rr0 < 256; rr0 += 4 * NW_) {
      float4 vv[4];
#pragma unroll
      for (int k = 0; k < 4; ++k) { const int rowk = row0 + rr0 + k * NW_; vv[k] = ((const float4*)(KVR + (size_t)(rowk < MA ? rowk : MA - 1) * 768 + t * 256))[lane]; }
#pragma unroll
      for (int k = 0; k < 4; ++k) {
        const int row = row0 + rr0 + k * NW_; if (row >= MA) continue;
        float* r = KVR + (size_t)row * 768 + t * 256;
        float4 v = vv[k];
        if (t >= 1) {
            float ss = dot4(v, v);
            ss += __shfl_xor(ss, 1); ss += __shfl_xor(ss, 2); ss += __shfl_xor(ss, 4); ss += __shfl_xor(ss, 8);
            if (lane < 32) { const float rs = rsqrtf(ss * (1.0f / 64) + EPS); const float4 gk = ((const float4*)(t == 1 ? p.in[I_GKSLC] : p.in[I_GKWIN]))[lane & 15];
                v.x *= rs * gk.x; v.y *= rs * gk.y; v.z *= rs * gk.z; v.w *= rs * gk.w;
                if (row >= MP) ((float4*)r)[lane] = v; }
        }
        if (row < MP) {
            const int b = row / SP, sp = row % SP; const size_t off = (((size_t)b * 2 + gg) * SP + sp) * 64 + d;
            if (t == 0) { ((float4*)(p.out + O_PCMP + (size_t)row * 256))[lane] = v; *(uint2*)(KVB + (0 + c2) * KT + off) = make_uint2(pk2(v.x, v.y), pk2(v.z, v.w)); }
            else if (t == 2) { if (sp >= SP - 512) ((float4*)(p.out + O_PWIN + (size_t)(b * 512 + sp - (SP - 512)) * 256))[lane] = v; *(uint2*)(KVB + (4 + c2) * KT + off) = make_uint2(pk2(v.x, v.y), pk2(v.z, v.w)); }
            else {
                ((float4*)(p.out + O_PSLC + (size_t)row * 256))[lane] = v;
                const size_t blkbase = (((size_t)b * 2 + gg) * 32 + (sp >> 6)) * 4096;
                if (c2 == 0) { const int nt = (sp >> 4) & 3, fr2 = sp & 15, ks = d >> 5, fg2 = (d >> 3) & 3, e = d & 7;
                    *(uint2*)((bf16_t*)(p.ws + B_SKF) + blkbase + (size_t)(((nt * 2 + ks) * 64 + fg2 * 16 + fr2) * 8 + e)) = make_uint2(pk2(v.x, v.y), pk2(v.z, v.w)); }
                else { const int cs = (sp >> 5) & 1, kk = sp & 31, fg2 = (kk & 15) >> 2, e = (kk & 3) + (kk >= 16 ? 4 : 0), dt = d >> 4, fr2 = d & 15;
                    bf16_t* vf = (bf16_t*)(p.ws + B_SVF) + blkbase + (size_t)(((dt * 2 + cs) * 64 + fg2 * 16 + fr2) * 8 + e);
                    vf[0] = (bf16_t)f2bf(v.x); vf[8] = (bf16_t)f2bf(v.y); vf[16] = (bf16_t)f2bf(v.z); vf[24] = (bf16_t)f2bf(v.w); } }
        } else {
            const int b = row - MP;
            if (t == 0) ((float4*)(p.out + O_SCMP + (size_t)b * 256))[lane] = v; else if (t == 1) ((float4*)(p.out + O_SSLC + (size_t)b * 256))[lane] = v;
            else ((float4*)(p.out + O_SWIN + (size_t)(b * 512 + 511) * 256))[lane] = v;
        }
      }
    }
}
__device__ __forceinline__ float gelu_tanh(float x) { return 0.5f * x * (1.0f + tanhf(0.7978845608028654f * (x + 0.044715f * x * x * x))); }
__device__ __forceinline__ void ph_compress(const Params& p, float* lds) {
    const float* KVR = (const float*)(p.ws + B_KVR); const int tid = ltid();
    float* xs = lds;
    float* hs = lds + 4096;
    const float* w1 = p.in[I_CW1]; const float* w2 = p.in[I_CW2]; const int* pt = (const int*)p.in[I_PT];
    for (int item = blockIdx.x; item < 136 * 127 * 2; item += gridDim.x) {
        const int c = item & 1, n = (item >> 1) % 127, bb = (item >> 1) / 127;
        __syncthreads();
        for (int i = tid; i < 4096; i += NT_) {
            const int g = i >> 11, pp = (i >> 6) & 31, d = i & 63; const int tok = 16 * n + pp; float x;
            if (bb < 8) x = KVR[(size_t)(bb * SP + tok) * 768 + c * 128 + g * 64 + d];
            else { const int b = bb - 8; const int phys = pt[b * 16 + (tok >> 7)]; x = p.in[I_CCMP][((size_t)phys * 128 + (tok & 127)) * 256 + c * 128 + g * 64 + d]; }
            xs[i] = x + p.in[I_CPOS][(pp * 2 + c) * 64 + d];
        }
        __syncthreads();
        if (tid < 256) { const int g = tid >> 7, h = tid & 127; float pre = p.in[I_CB1][c * 128 + h]; const float* wp = w1 + (size_t)c * 2048 * 128 + h; const float* xp = xs + g * 2048;
          for (int i = 0; i < 2048; ++i) pre = fmaf(xp[i], wp[(size_t)i * 128], pre);
          hs[g * 128 + h] = gelu_tanh(pre); }
        __syncthreads();
        if (tid < 128) {
            const int g = tid >> 6, d = tid & 63; float o = p.in[I_CB2][c * 64 + d];
            for (int h = 0; h < 128; ++h) o = fmaf(hs[g * 128 + h], w2[(size_t)(c * 128 + h) * 64 + d], o);
            if (c == 0) { const float ss = wave_sum(o * o); o = o * rsqrtf(ss * (1.0f / 64) + EPS) * p.in[I_GKCMP][d]; }
            ((float*)(p.ws + (c == 0 ? B_CK : B_CV)))[((size_t)bb * 127 + n) * 128 + g * 64 + d] = o;
            bf16_t* kc = (bf16_t*)(p.ws + B_KC16) + ((((size_t)bb * 2 + c) * 2 + g) * 128 + n) * 64 + d; kc[0] = (bf16_t)f2bf(o); if (n == 126) kc[64] = 0;
        }
    }
}
#ifndef NSA_NAIVE_ALL
#define NSA_NAIVE_ALL 0
#endif
__device__ __forceinline__ void row_softmax(float* r, int n, int lane) {
    float mx = NEGM;
    for (int i = lane; i < n; i += 64) mx = fmaxf(mx, r[i]);
    mx = wave_max(mx);
    if (mx <= 0.5f * NEGM) { for (int i = lane; i < n; i += 64) r[i] = 0.f; return; }
    float s = 0.f;
    for (int i = lane; i < n; i += 64) { const float e = r[i] <= 0.5f * NEGM ? 0.f : expf(r[i] - mx); r[i] = e; s += e; }
    s = wave_sum(s); const float inv = 1.0f / s;
    for (int i = lane; i < n; i += 64) r[i] *= inv;
}
__device__ __forceinline__ void ph_nsa(const Params& p, int j, float* lds) {
    const int tid = ltid(), lane = tid & 63, wid = tid >> 6;
    float* qs = lds;
    float* sc = lds + 384;
    float* imp = sc + 3072;
    int* sel = (int*)(imp + 40);
    float* gate = (float*)(sel + 8);
    float* oacc = gate + 24;
    const bf16_t* P = (const bf16_t*)(p.ws + B_P16); const float* GT = (const float*)(p.ws + B_GT); const float* KVR = (const float*)(p.ws + B_KVR); bf16_t* CATB = (bf16_t*)(p.ws + B_CATB);
    const float* table = p.in[I_REL]; const int* pt = (const int*)p.in[I_PT];
    for (int item = blockIdx.x; item < (NSA_NAIVE_ALL ? MA : BS) * 2; item += gridDim.x) {
        const int row = (NSA_NAIVE_ALL ? 0 : MP) + (item >> 1), g = item & 1; const bool smp = row >= MP;
        const int b = smp ? row - MP : row / SP, pos = smp ? PAST : row % SP;
        const bf16_t* pr = P + (size_t)row * LDB_;
        __syncthreads();
        if (wid < 6) { const int z = wid; const float v = bf2f(pr[(g * 6 + z) * 64 + lane]); const float ss = wave_sum(v * v); qs[z * 64 + lane] = v * rsqrtf(ss * (1.0f / 64) + EPS) * p.in[I_GQ][j * 64 + lane]; }
        if (tid >= 384 && tid < 384 + 18) { const int t2 = tid - 384; const int br = t2 / 6, z = t2 % 6; gate[t2] = sigmoidf_(GT[(size_t)row * GTW + br * 12 + g * 6 + z] + p.in[I_BGATE][j * 36 + br * 12 + g * 6 + z]); }
        if (tid < 384) oacc[tid] = 0.f;
        __syncthreads();
        const float* ck = (const float*)(p.ws + B_CK) + (size_t)(smp ? 8 + b : b) * 127 * 128; const float* cv = (const float*)(p.ws + B_CV) + (size_t)(smp ? 8 + b : b) * 127 * 128;
        for (int i = tid; i < 6 * 127; i += NT_) {
            const int z = i / 127, n = i % 127; const int dist = pos - (16 * n + 31); float s = NEGM;
            if (dist >= 0) { const float4* kp = (const float4*)(ck + n * 128 + g * 64); const float4* qp = (const float4*)(qs + z * 64); float a = 0.f;
#pragma unroll 4
                for (int d = 0; d < 16; ++d) a += dot4(kp[d], qp[d]);
                s = a * 0.125f + table[rel_bucket(dist) * 12 + g * 6 + z]; }
            sc[z * 128 + n] = s;
        }
        __syncthreads();
        if (wid < 6) row_softmax(sc + wid * 128, 127, lane);
        __syncthreads();
        const int nslc = smp ? 33 : 32, cur = pos >> 6;
        if (tid < nslc) { const int jb = tid; float s = 0.f;
            for (int z = 0; z < 6; ++z) for (int n = 0; n < 127; ++n) { const int lo = max(16 * n, 64 * jb), hi = min(16 * n + 32, 64 * jb + 64); if (hi > lo) s += sc[z * 128 + n] * (float)(hi - lo) * (1.0f / 16); }
            imp[jb] = s; }
        __syncthreads();
        if (tid == 0) {
            int cnt = 0;
            if (cur + 1 <= 8) { for (int jb = 0; jb <= cur; ++jb) sel[cnt++] = jb; }
            else {
                sel[0] = 0; sel[1] = cur; sel[2] = cur - 1; cnt = 3; unsigned long long taken = 0ull;
                for (int k = 0; k < 5; ++k) { int best = -1; float bv = -1.f;
                    for (int jb = 1; jb <= cur - 2; ++jb) if (!((taken >> jb) & 1ull) && imp[jb] > bv) { bv = imp[jb]; best = jb; }
                    if (best >= 0) { taken |= 1ull << best; sel[cnt++] = best; } }
            }
            for (; cnt < 8; ++cnt) sel[cnt] = -1;
        }
        if (tid < 384) { const int z = tid >> 6, d = tid & 63; float o = 0.f;
            for (int n = 0; n < 127; ++n) o = fmaf(sc[z * 128 + n], cv[n * 128 + g * 64 + d], o);
            oacc[tid] += gate[0 * 6 + z] * o; }
        __syncthreads();
        for (int br = 1; br <= 2; ++br) {
            { const int t = tid;
                const float* kp = nullptr; int dist = -1;
                if (br == 1) {
                    const int blk = sel[t >> 6];
                    if (blk >= 0) { const int tok = blk * 64 + (t & 63); dist = pos - tok;
                        if (dist >= 0) { if (!smp) kp = KVR + (size_t)(b * SP + tok) * 768 + 256 + g * 64;
                            else if (tok < PAST) kp = p.in[I_CSLC] + ((size_t)pt[b * 16 + (tok >> 7)] * 128 + (tok & 127)) * 256 + g * 64;
                            else kp = KVR + (size_t)row * 768 + 256 + g * 64; } }
                } else {
                    const int kpos = pos - 511 + t; dist = 511 - t;
                    if (!smp) { if (kpos >= 0) kp = KVR + (size_t)(b * SP + kpos) * 768 + 512 + g * 64; else dist = -1; }
                    else { if (kpos < PAST) kp = p.in[I_CWIN] + ((size_t)b * 512 + (kpos - (PAST - 512))) * 256 + g * 64; else kp = KVR + (size_t)row * 768 + 512 + g * 64; }
                }
                if (dist >= 0 && kp) {
                    float s[6] = {0.f, 0.f, 0.f, 0.f, 0.f, 0.f};
#pragma unroll 2
                    for (int d = 0; d < 16; ++d) { const float4 kk = ((const float4*)kp)[d];
#pragma unroll
                        for (int z = 0; z < 6; ++z) s[z] += dot4(kk, ((const float4*)(qs + z * 64))[d]); }
                    const int bk = rel_bucket(dist);
#pragma unroll
                    for (int z = 0; z < 6; ++z) sc[z * 512 + t] = s[z] * 0.125f + table[bk * 12 + g * 6 + z];
                } else {
#pragma unroll
                    for (int z = 0; z < 6; ++z) sc[z * 512 + t] = NEGM;
                }
            }
            __syncthreads();
            if (wid < 6) row_softmax(sc + wid * 512, 512, lane);
            __syncthreads();
            if (tid < 384) { const int z = tid >> 6, d = tid & 63; float o = 0.f;
                for (int t = 0; t < 512; ++t) { const float pw = sc[z * 512 + t]; if (pw != 0.f) { const float* vp;
                    if (br == 1) { const int tok = sel[t >> 6] * 64 + (t & 63);
                        if (!smp) vp = KVR + (size_t)(b * SP + tok) * 768 + 256 + 128 + g * 64;
                        else if (tok < PAST) vp = p.in[I_CSLC] + ((size_t)pt[b * 16 + (tok >> 7)] * 128 + (tok & 127)) * 256 + 128 + g * 64;
                        else vp = KVR + (size_t)row * 768 + 256 + 128 + g * 64;
                    } else { const int kpos = pos - 511 + t;
                        if (!smp) vp = KVR + (size_t)(b * SP + kpos) * 768 + 512 + 128 + g * 64;
                        else if (kpos < PAST) vp = p.in[I_CWIN] + ((size_t)b * 512 + (kpos - (PAST - 512))) * 256 + 128 + g * 64;
                        else vp = KVR + (size_t)row * 768 + 512 + 128 + g * 64; }
                    o = fmaf(pw, vp[d], o); } }
                oacc[tid] += gate[br * 6 + z] * o; }
            __syncthreads();
        }
        if (tid < 384) CATB[(size_t)row * DM + g * 384 + tid] = (bf16_t)f2bf(oacc[tid]);
    }
}
constexpr size_t KVB_T = (size_t)BP * 2 * SP * 64;
typedef short v4i16_t __attribute__((ext_vector_type(4)));
typedef short bf16x8_t __attribute__((ext_vector_type(8)));
typedef float f32x4_t __attribute__((ext_vector_type(4)));
typedef unsigned u32x4_t __attribute__((ext_vector_type(4)));
__device__ __forceinline__ bf16x8_t ldtr2(const LAS unsigned char* p0, const LAS unsigned char* p1) {
    const v4i16_t a = __builtin_amdgcn_ds_read_tr16_b64_v4i16((LAS v4i16_t*)p0), b = __builtin_amdgcn_ds_read_tr16_b64_v4i16((LAS v4i16_t*)p1);
    return __builtin_shufflevector(a, b, 0, 1, 2, 3, 4, 5, 6, 7);
}
__device__ __forceinline__ unsigned cvtpk(float lo, float hi) { unsigned r; asm volatile("v_cvt_pk_bf16_f32 %0, %1, %2" : "=v"(r) : "v"(lo), "v"(hi)); return r; }
__device__ __forceinline__ bf16x8_t pack8(f32x4_t a, f32x4_t b) { uint4 w; w.x = cvtpk(a[0], a[1]); w.y = cvtpk(a[2], a[3]); w.z = cvtpk(b[0], b[1]); w.w = cvtpk(b[2], b[3]); return __builtin_bit_cast(bf16x8_t, w); }
__device__ __forceinline__ f32x4_t mfma16(bf16x8_t a, bf16x8_t b, f32x4_t c) { return __builtin_amdgcn_mfma_f32_16x16x32_bf16(a, b, c, 0, 0, 0); }
__device__ __forceinline__ float ex2(float x) { return __builtin_amdgcn_exp2f(x); }
__device__ __forceinline__ float xmax4(float x) {
    auto s = __builtin_amdgcn_permlane16_swap(__float_as_uint(x), __float_as_uint(x), false, false);
    x = fmaxf(__uint_as_float(s[0]), __uint_as_float(s[1]));
    auto t = __builtin_amdgcn_permlane32_swap(__float_as_uint(x), __float_as_uint(x), false, false);
    return fmaxf(__uint_as_float(t[0]), __uint_as_float(t[1]));
}
__device__ __forceinline__ float xsum4(float x) {
    auto s = __builtin_amdgcn_permlane16_swap(__float_as_uint(x), __float_as_uint(x), false, false);
    x = __uint_as_float(s[0]) + __uint_as_float(s[1]);
    auto t = __builtin_amdgcn_permlane32_swap(__float_as_uint(x), __float_as_uint(x), false, false);
    return __uint_as_float(t[0]) + __uint_as_float(t[1]);
}
constexpr float LOG2E = 1.4426950408889634f, NINF = -__builtin_inff();
constexpr int KROW = 144;

__device__ __forceinline__ void ph_nsa_fast(const Params& p, int j, LAS unsigned char* lds) {
    const int tid = ltid(), lane0 = tid & 63, w = tid >> 6;
    unsigned char* ws = p.ws;
    const bf16_t* P16 = (const bf16_t*)(ws + B_P16); const float* GT = (const float*)(ws + B_GT); bf16_t* CATB = (bf16_t*)(ws + B_CATB);
    const bf16_t* KVB = (const bf16_t*)(ws + B_KVB); const bf16_t* KC16 = (const bf16_t*)(ws + B_KC16);
    LAS unsigned char* Kw = lds;
    LAS unsigned char* Vw = lds + 18432;
    LAS unsigned char* Kc = lds + 36864;
    LAS unsigned char* Vc = lds + 55296;
    LAS float* biasT = (LAS float*)(lds + 73728);
    LAS float* impL = (LAS float*)(lds + 73728 + 3072);
    LAS int* selL = (LAS int*)(lds + 73728 + 3072 + 16384);
    const float* table = p.in[I_REL]; const float* gq = p.in[I_GQ] + j * 64; const float* bgate = p.in[I_BGATE] + j * 36;
    for (int unit = blockIdx.x; unit < 256; unit += gridDim.x) {
        int lane_a = lane0; asm volatile("" : "+v"(lane_a)); const int lane = lane_a, fr = lane & 15, fg = lane >> 4;
        const int g = unit & 1, b = (unit >> 1) & 7, tile = unit >> 4, t0 = tile * 128, tw = t0 + 16 * w, trow = tw + fr;
        TSUB_BEGIN();
        __syncthreads();
        for (int i = tid; i < 2048; i += NT_) { const int tsel = i >> 10, r = (i >> 3) & 127, ch = i & 7;
            const u32x4_t v = *(const u32x4_t*)(KC16 + (((size_t)b * 2 + tsel) * 2 + g) * 128 * 64 + r * 64 + ch * 8);
            *(LAS u32x4_t*)((tsel ? Vc : Kc) + r * KROW + ch * 16) = v; }
        for (int i = tid; i < 768; i += NT_) { const int d = i / 6, z = i % 6; biasT[i] = table[rel_bucket_alu(d) * 12 + g * 6 + z] * LOG2E; }
        if (tid < 64) ((LAS float*)(lds + 73728 + 3072 + 16384 + 4096))[tid] = gq[tid] * (0.125f * LOG2E);
        __syncthreads();
        const bf16_t* qrow = P16 + (size_t)(b * SP + trow) * LDB_ + g * 384;
        LAS float* gqL = (LAS float*)(lds + 73728 + 3072 + 16384 + 4096);
#define FETCH_Q(z_, ra_, rb_) do { ra_ = *(const uint4*)(qrow + (z_) * 64 + fg * 8); rb_ = *(const uint4*)(qrow + (z_) * 64 + 32 + fg * 8); } while (0)
#define LOAD_Q(z_, q0_, q1_) do { uint4 r0, r1; FETCH_Q(z_, r0, r1); FINISH_Q(r0, r1, q0_, q1_); } while (0)
#define FINISH_Q(r0, r1, q0_, q1_) do { \
            float v[16] = {bflo(r0.x), bfhi(r0.x), bflo(r0.y), bfhi(r0.y), bflo(r0.z), bfhi(r0.z), bflo(r0.w), bfhi(r0.w), bflo(r1.x), bfhi(r1.x), bflo(r1.y), bfhi(r1.y), bflo(r1.z), bfhi(r1.z), bflo(r1.w), bfhi(r1.w)}; \
            float ss = 0.f; _Pragma("unroll") for (int i = 0; i < 16; ++i) ss += v[i] * v[i]; \
            ss = xsum4(ss); const float rs = rsqrtf(ss * (1.0f / 64) + EPS); { const f32x4_t g0 = *(const LAS f32x4_t*)(gqL + fg * 8), g1 = *(const LAS f32x4_t*)(gqL + fg * 8 + 4), g2 = *(const LAS f32x4_t*)(gqL + 32 + fg * 8), g3 = *(const LAS f32x4_t*)(gqL + 32 + fg * 8 + 4); \
              _Pragma("unroll") for (int i = 0; i < 4; ++i) { v[i] *= rs * g0[i]; v[4 + i] *= rs * g1[i]; v[8 + i] *= rs * g2[i]; v[12 + i] *= rs * g3[i]; } } \
            q0_ = pack8((f32x4_t){v[0], v[1], v[2], v[3]}, (f32x4_t){v[4], v[5], v[6], v[7]}); q1_ = pack8((f32x4_t){v[8], v[9], v[10], v[11]}, (f32x4_t){v[12], v[13], v[14], v[15]}); } while (0)
        const float* gtrow = GT + (size_t)(b * SP + trow) * GTW;
#pragma unroll 1
        for (int hp = 0; hp < 2; ++hp) {
        bf16x8_t qf[3][2];
#pragma unroll
        for (int z = 0; z < 3; ++z) LOAD_Q(hp * 3 + z, qf[z][0], qf[z][1]);
        f32x4_t O[3][4]; float mrun[3], lrun[3];
#pragma unroll
        for (int z = 0; z < 3; ++z) { mrun[z] = NINF; lrun[z] = 0.f;
#pragma unroll
            for (int dt = 0; dt < 4; ++dt) O[z][dt] = (f32x4_t){0.f, 0.f, 0.f, 0.f}; }
        const bf16_t* WK = KVB + 4 * KVB_T + ((size_t)b * 2 + g) * SP * 64; const bf16_t* WV = KVB + 5 * KVB_T + ((size_t)b * 2 + g) * SP * 64;
        u32x4_t rst[4];
#define WIN_LOAD(it_) do { const int k128_ = t0 - 512 + 128 * (it_); _Pragma("unroll") for (int q_ = 0; q_ < 4; ++q_) { const int i_ = tid + NT_ * q_, tsel_ = i_ >> 10, r_ = (i_ >> 3) & 127, ch_ = i_ & 7; const int tok_ = k128_ + r_; \
            rst[q_] = (u32x4_t){0u, 0u, 0u, 0u}; if (tok_ >= 0) rst[q_] = *(const u32x4_t*)((tsel_ ? WV : WK) + (size_t)tok_ * 64 + ch_ * 8); } } while (0)
#define WIN_STORE() do { _Pragma("unroll") for (int q_ = 0; q_ < 4; ++q_) { const int i_ = tid + NT_ * q_, tsel_ = i_ >> 10, r_ = (i_ >> 3) & 127, ch_ = i_ & 7; *(LAS u32x4_t*)((tsel_ ? Vw : Kw) + r_ * KROW + ch_ * 16) = rst[q_]; } } while (0)
        WIN_LOAD(0);
        __syncthreads();
        WIN_STORE();
#pragma unroll 1
        for (int it = 0; it < 5; ++it) {
            const int k128 = t0 - 512 + 128 * it;
            BAR_LDS();
            if (it + 1 < 5) WIN_LOAD(it + 1);
#pragma unroll 1
            for (int sc = 0; sc < 4; ++sc) {
                const int kb = k128 + 32 * sc;
                if (kb > tw + 15 || kb + 31 < tw - 511 || kb + 31 < 0) continue;
                const bool fast = (kb + 31 <= tw - 113) && (kb >= tw + 15 - 511) && kb >= 0;
                bf16x8_t kf[2][2], vf[4];
#pragma unroll
                for (int nt = 0; nt < 2; ++nt)
#pragma unroll
                    for (int ks = 0; ks < 2; ++ks) kf[nt][ks] = *(const LAS bf16x8_t*)(Kw + (32 * sc + 16 * nt + fr) * KROW + (ks * 32 + fg * 8) * 2);
#pragma unroll
                for (int dt = 0; dt < 4; ++dt) { const LAS unsigned char* vp = Vw + (32 * sc + 4 * fg + (fr >> 2)) * KROW + (16 * dt + 4 * (fr & 3)) * 2; vf[dt] = ldtr2(vp, vp + 16 * KROW); }
#pragma unroll
                for (int z = 0; z < 3; ++z) {
                    f32x4_t s0 = (f32x4_t){0.f, 0.f, 0.f, 0.f}, s1 = s0;
                    s0 = mfma16(kf[0][0], qf[z][0], s0); s0 = mfma16(kf[0][1], qf[z][1], s0);
                    s1 = mfma16(kf[1][0], qf[z][0], s1); s1 = mfma16(kf[1][1], qf[z][1], s1);
                    if (fast) { const float cb = biasT[127 * 6 + hp * 3 + z]; s0 = s0 + cb; s1 = s1 + cb; }
                    else {
#pragma unroll
                        for (int jj = 0; jj < 4; ++jj) { const int key0 = kb + 4 * fg + jj, d0 = trow - key0, d1 = d0 - 16;
                            s0[jj] = (d0 >= 0 && d0 < 512 && key0 >= 0) ? s0[jj] + biasT[min(d0, 127) * 6 + hp * 3 + z] : NINF;
                            s1[jj] = (d1 >= 0 && d1 < 512 && key0 + 16 >= 0) ? s1[jj] + biasT[min(d1, 127) * 6 + hp * 3 + z] : NINF; }
                    }
                    float mx = fmaxf(fmaxf(fmaxf(s0[0], s0[1]), fmaxf(s0[2], s0[3])), fmaxf(fmaxf(s1[0], s1[1]), fmaxf(s1[2], s1[3])));
                    mx = xmax4(mx);
                    float msafe;
                    if (__any(mx > mrun[z] + 8.f)) {
                        const float mnew = fmaxf(mrun[z], mx); msafe = mnew == NINF ? 0.f : mnew;
                        const float alpha = ex2(mrun[z] - msafe);
                        mrun[z] = mnew; lrun[z] = lrun[z] * alpha;
#pragma unroll
                        for (int dt = 0; dt < 4; ++dt) O[z][dt] = O[z][dt] * alpha;
                    } else msafe = mrun[z] == NINF ? 0.f : mrun[z];
                    f32x4_t p0, p1;
#pragma unroll
                    for (int jj = 0; jj < 4; ++jj) { p0[jj] = ex2(s0[jj] - msafe); p1[jj] = ex2(s1[jj] - msafe); }
                    lrun[z] = lrun[z] + (((p0[0] + p0[1]) + (p0[2] + p0[3])) + ((p1[0] + p1[1]) + (p1[2] + p1[3])));
                    const bf16x8_t pf = pack8(p0, p1);
#pragma unroll
                    for (int dt = 0; dt < 4; ++dt) O[z][dt] = mfma16(vf[dt], pf, O[z][dt]);
                }
            }
            if (it + 1 < 5) { BAR_LDS(); WIN_STORE(); }
        }
#undef WIN_LOAD
#undef WIN_STORE
#pragma unroll
        for (int z = 0; z < 3; ++z) { const int hz2 = hp * 3 + z; const float lt = xsum4(lrun[z]); const float gw = sigmoidf_(gtrow[24 + g * 6 + hz2] + bgate[24 + g * 6 + hz2]); const float sc = gw / lt;
            bf16_t* orow = CATB + (size_t)(b * SP + trow) * DM + (g * 6 + hz2) * 64;
#pragma unroll
            for (int dt = 0; dt < 4; ++dt) { const f32x4_t v = O[z][dt] * sc; *(uint2*)(orow + 16 * dt + 4 * fg) = make_uint2(cvtpk(v[0], v[1]), cvtpk(v[2], v[3])); } }
        }
        asm volatile("s_waitcnt vmcnt(0)" ::: "memory");
        TSUB_END(0);
        float impacc[8];
#pragma unroll
        for (int nt = 0; nt < 8; ++nt) impacc[nt] = 0.f;
        const int nmax = trow >= 31 ? (trow - 31) >> 4 : -1;
        uint4 rqa_c, rqb_c; FETCH_Q(0, rqa_c, rqb_c);
#pragma unroll 1
        for (int z = 0; z < 6; ++z) {
            bf16_t* orow = CATB + (size_t)(b * SP + trow) * DM + (g * 6 + z) * 64; unsigned long long oldc[4];
#pragma unroll
            for (int dt = 0; dt < 4; ++dt) oldc[dt] = __hip_atomic_load((unsigned long long*)(orow + 16 * dt + 4 * fg), __ATOMIC_RELAXED, __HIP_MEMORY_SCOPE_AGENT);
            const float gcraw = gtrow[g * 6 + z];
            f32x4_t s[8]; bf16x8_t qz[2]; { const uint4 ra = rqa_c, rb = rqb_c; if (z + 1 < 6) FETCH_Q(z + 1, rqa_c, rqb_c); FINISH_Q(ra, rb, qz[0], qz[1]); }
#pragma unroll
            for (int nt = 0; nt < 8; ++nt) { s[nt] = (f32x4_t){0.f, 0.f, 0.f, 0.f};
#pragma unroll
                for (int ks = 0; ks < 2; ++ks) { const bf16x8_t kf = *(const LAS bf16x8_t*)(Kc + (16 * nt + fr) * KROW + (ks * 32 + fg * 8) * 2); s[nt] = mfma16(kf, qz[ks], s[nt]); } }
            float mx = NINF;
#pragma unroll
            for (int nt = 0; nt < 8; ++nt)
#pragma unroll
                for (int jj = 0; jj < 4; ++jj) { const int n = 16 * nt + 4 * fg + jj; const int dist = trow - 16 * n - 31;
                    const float v = (n <= nmax && n <= 126) ? s[nt][jj] + biasT[min(dist, 127) * 6 + z] : NINF; s[nt][jj] = v; mx = fmaxf(mx, v); }
            asm volatile("" ::: "memory");
            mx = xmax4(mx); const float msafe = mx == NINF ? 0.f : mx; float sum = 0.f;
#pragma unroll
            for (int nt = 0; nt < 8; ++nt)
#pragma unroll
                for (int jj = 0; jj < 4; ++jj) { const float e = ex2(s[nt][jj] - msafe); s[nt][jj] = e; sum += e; }
            sum = xsum4(sum); const float inv = sum > 0.f ? 1.0f / sum : 0.f;
            float p3prev = 0.f;
#pragma unroll
            for (int nt = 0; nt < 8; ++nt) { s[nt] = s[nt] * inv;
                const float p3 = s[nt][3]; const float up = __shfl(p3, (lane + 48) & 63);
                const float prev_tile = __shfl(p3prev, (lane + 48) & 63);
                impacc[nt] += 2.0f * (s[nt][0] + s[nt][1] + s[nt][2]) + p3 + (fg == 0 ? prev_tile : up);
                p3prev = p3; }
            f32x4_t oc[4];
#pragma unroll
            for (int dt = 0; dt < 4; ++dt) oc[dt] = (f32x4_t){0.f, 0.f, 0.f, 0.f};
#pragma unroll
            for (int c2 = 0; c2 < 4; ++c2) { const bf16x8_t pf = pack8(s[2 * c2], s[2 * c2 + 1]);
#pragma unroll
                for (int dt = 0; dt < 4; ++dt) { const LAS unsigned char* vp = Vc + (32 * c2 + 4 * fg + (fr >> 2)) * KROW + (16 * dt + 4 * (fr & 3)) * 2; oc[dt] = mfma16(ldtr2(vp, vp + 16 * KROW), pf, oc[dt]); }
                asm volatile("" ::: "memory"); }
            const float gc = sigmoidf_(gcraw + bgate[g * 6 + z]);
#pragma unroll
            for (int dt = 0; dt < 4; ++dt) { const unsigned long long o64 = oldc[dt];
                const f32x4_t v = oc[dt] * gc + (f32x4_t){bflo((unsigned)o64), bfhi((unsigned)o64), bflo((unsigned)(o64 >> 32)), bfhi((unsigned)(o64 >> 32))};
                *(uint2*)(orow + 16 * dt + 4 * fg) = make_uint2(cvtpk(v[0], v[1]), cvtpk(v[2], v[3])); }
        }
        TSUB_END(1);
#pragma unroll
        for (int nt = 0; nt < 8; ++nt) impL[(w * 16 + fr) * 32 + 4 * nt + fg] = impacc[nt];
        asm volatile("s_waitcnt lgkmcnt(0)" ::: "memory");
        if (lane < 16) {
            const int t = tw + lane, cur = t >> 6; LAS int* so = selL + (w * 16 + lane) * 8; const LAS float* im = impL + (w * 16 + lane) * 32;
            int cnt = 0;
            if (cur + 1 <= 8) { for (int jb = 0; jb <= cur; ++jb) so[cnt++] = jb; }
            else {
                so[1] = 0; so[3] = cur; so[5] = cur - 1; unsigned taken = 0u;
                for (int k = 0; k < 5; ++k) { int best = -1; float bv = -1.f;
                    for (int jb = 1; jb <= cur - 2; ++jb) { const float v = im[jb]; if (!((taken >> jb) & 1u) && v > bv) { bv = v; best = jb; } }
                    taken |= 1u << best; so[k < 3 ? 2 * k : 3 + k] = best; }
                cnt = 8; }
            for (; cnt < 8; ++cnt) so[cnt] = -1;
        }
        asm volatile("s_waitcnt vmcnt(0) lgkmcnt(0)" ::: "memory");
        const bf16_t* SKF = (const bf16_t*)(ws + B_SKF) + ((size_t)b * 2 + g) * 32 * 4096; const bf16_t* SVF = (const bf16_t*)(ws + B_SVF) + ((size_t)b * 2 + g) * 32 * 4096;
        const int c0 = 2 * tile;
        TSUB_END(2);
        __syncthreads();
        for (int i = tid; i < 4 * 1024; i += NT_) { const int slot = i >> 10, r = i & 1023; const int blk = slot == 0 ? 0 : c0 - 2 + slot;
            if (blk >= 0 && blk < 32) { const u32x4_t v = *(const u32x4_t*)((r < 512 ? SKF : SVF) + (size_t)blk * 4096 + (r & 511) * 8); *(LAS u32x4_t*)(lds + slot * 16384 + r * 16) = v; } }
        __syncthreads();
        { int lane_b = lane0; asm volatile("" : "+v"(lane_b)); const int lane = lane_b, fr = lane & 15, fg = lane >> 4;
        const int hz = fr < 6 ? fr : 5;
        uint4 rqa, rqb;
        { const bf16_t* qrow = P16 + ((size_t)b * SP + tw) * LDB_ + g * 384 + hz * 64; rqa = *(const uint4*)(qrow + fg * 8); rqb = *(const uint4*)(qrow + 32 + fg * 8); }
#pragma unroll 1
        for (int ti = 0; ti < 16; ++ti) {
            const int t = tw + ti; const size_t row = (size_t)b * SP + t;
            bf16x8_t qs[2];
            const uint4 r0 = rqa, r1 = rqb;
            if (ti + 1 < 16) { const bf16_t* qrow = P16 + (row + 1) * LDB_ + g * 384 + hz * 64; rqa = *(const uint4*)(qrow + fg * 8); rqb = *(const uint4*)(qrow + 32 + fg * 8); }
            bf16_t* orow = CATB + row * DM + (g * 6 + hz) * 64; unsigned long long oldv[4];
#pragma unroll
            for (int dt = 0; dt < 4; ++dt) oldv[dt] = __hip_atomic_load((unsigned long long*)(orow + 16 * dt + 4 * fg), __ATOMIC_RELAXED, __HIP_MEMORY_SCOPE_AGENT);
            const float graw = GT[row * GTW + 12 + g * 6 + hz];
            {
              float v[16] = {bflo(r0.x), bfhi(r0.x), bflo(r0.y), bfhi(r0.y), bflo(r0.z), bfhi(r0.z), bflo(r0.w), bfhi(r0.w), bflo(r1.x), bfhi(r1.x), bflo(r1.y), bfhi(r1.y), bflo(r1.z), bfhi(r1.z), bflo(r1.w), bfhi(r1.w)};
              float ss = 0.f;
#pragma unroll
              for (int i = 0; i < 16; ++i) ss += v[i] * v[i];
              ss = xsum4(ss); const float rs = rsqrtf(ss * (1.0f / 64) + EPS) * (0.125f * LOG2E);
#pragma unroll
              for (int i = 0; i < 8; ++i) { v[i] *= rs * gq[fg * 8 + i]; v[8 + i] *= rs * gq[32 + fg * 8 + i]; }
              qs[0] = pack8((f32x4_t){v[0], v[1], v[2], v[3]}, (f32x4_t){v[4], v[5], v[6], v[7]});
              qs[1] = pack8((f32x4_t){v[8], v[9], v[10], v[11]}, (f32x4_t){v[12], v[13], v[14], v[15]}); }
            f32x4_t os[4]; float ms = NINF, ls = 0.f;
#pragma unroll
            for (int dt = 0; dt < 4; ++dt) os[dt] = (f32x4_t){0.f, 0.f, 0.f, 0.f};
#define SLC_LOADK(KF, blk_) do { const int slot_ = (blk_) == 0 ? 0 : ((blk_) >= c0 - 1 ? (blk_) - c0 + 2 : -1); \
                if (slot_ >= 0) { const LAS unsigned char* fb_ = lds + slot_ * 16384 + lane * 16; \
                    _Pragma("unroll") for (int nt = 0; nt < 4; ++nt) _Pragma("unroll") for (int ks = 0; ks < 2; ++ks) KF[nt][ks] = *(const LAS bf16x8_t*)(fb_ + (nt * 2 + ks) * 1024); \
                } else { const bf16_t* kb_ = SKF + (size_t)(blk_) * 4096 + lane * 8; \
                    _Pragma("unroll") for (int nt = 0; nt < 4; ++nt) _Pragma("unroll") for (int ks = 0; ks < 2; ++ks) KF[nt][ks] = *(const bf16x8_t*)(kb_ + (nt * 2 + ks) * 512); } } while (0)
#define SLC_LOADV(VF, blk_) do { const int slot_ = (blk_) == 0 ? 0 : ((blk_) >= c0 - 1 ? (blk_) - c0 + 2 : -1); \
                if (slot_ >= 0) { const LAS unsigned char* fb_ = lds + slot_ * 16384 + lane * 16; \
                    _Pragma("unroll") for (int dt = 0; dt < 4; ++dt) _Pragma("unroll") for (int cs = 0; cs < 2; ++cs) VF[dt][cs] = *(const LAS bf16x8_t*)(fb_ + 8192 + (dt * 2 + cs) * 1024); \
                } else { const bf16_t* vb_ = SVF + (size_t)(blk_) * 4096 + lane * 8; \
                    _Pragma("unroll") for (int dt = 0; dt < 4; ++dt) _Pragma("unroll") for (int cs = 0; cs < 2; ++cs) VF[dt][cs] = *(const bf16x8_t*)(vb_ + (dt * 2 + cs) * 512); } } while (0)
#define SLC_COMPUTE(KF, VF, blk_, nblk_) do { const int tok0 = (blk_) * 64; f32x4_t s[4]; \
                _Pragma("unroll") for (int nt = 0; nt < 4; ++nt) { s[nt] = (f32x4_t){0.f, 0.f, 0.f, 0.f}; s[nt] = mfma16(KF[nt][0], qs[0], s[nt]); s[nt] = mfma16(KF[nt][1], qs[1], s[nt]); } \
                float mx = NINF; \
                if (tok0 + 63 <= t - 113) { const float cb = biasT[127 * 6 + hz]; \
                    _Pragma("unroll") for (int nt = 0; nt < 4; ++nt) { s[nt] = s[nt] + cb; mx = fmaxf(mx, fmaxf(fmaxf(s[nt][0], s[nt][1]), fmaxf(s[nt][2], s[nt][3]))); } } \
                else { _Pragma("unroll") for (int nt = 0; nt < 4; ++nt) _Pragma("unroll") for (int jj = 0; jj < 4; ++jj) { const int dist = t - (tok0 + 16 * nt + 4 * fg + jj); const float v = dist >= 0 ? s[nt][jj] + biasT[min(dist, 127) * 6 + hz] : NINF; s[nt][jj] = v; mx = fmaxf(mx, v); } } \
                mx = xmax4(mx); \
                float msafe; \
                if (__any(mx > ms + 8.f)) { const float mnew = fmaxf(ms, mx); msafe = mnew == NINF ? 0.f : mnew; const float alpha = ex2(ms - msafe); ms = mnew; ls = ls * alpha; \
                    _Pragma("unroll") for (int dt = 0; dt < 4; ++dt) os[dt] = os[dt] * alpha; } \
                else msafe = ms == NINF ? 0.f : ms; \
                float sum = 0.f; \
                _Pragma("unroll") for (int nt = 0; nt < 4; ++nt) _Pragma("unroll") for (int jj = 0; jj < 4; ++jj) { const float e = ex2(s[nt][jj] - msafe); s[nt][jj] = e; sum += e; } \
                ls = ls + sum; \
                _Pragma("unroll") for (int cs = 0; cs < 2; ++cs) { const bf16x8_t pf = pack8(s[2 * cs], s[2 * cs + 1]); \
                    _Pragma("unroll") for (int dt = 0; dt < 4; ++dt) os[dt] = mfma16(VF[dt][cs], pf, os[dt]); } \
                if ((nblk_) >= 0) SLC_LOADV(VF, nblk_); } while (0)
            const LAS int* sbl = selL + (w * 16 + ti) * 8; int nb = 0;
#pragma unroll
            for (int bi = 0; bi < 8; ++bi) nb += sbl[bi] >= 0 ? 1 : 0;
            bf16x8_t kfC[4][2], kfN[4][2], vfX[4][2];
            { const int b0 = sbl[0]; SLC_LOADK(kfN, b0); SLC_LOADV(vfX, b0); }
#pragma unroll 1
            for (int bi = 0; bi < nb; ++bi) {
                const int bA = sbl[bi], bB = bi + 1 < nb ? sbl[bi + 1] : -1;
#pragma unroll
                for (int nt = 0; nt < 4; ++nt) { kfC[nt][0] = kfN[nt][0]; kfC[nt][1] = kfN[nt][1]; }
                if (bB >= 0) SLC_LOADK(kfN, bB);
                SLC_COMPUTE(kfC, vfX, bA, bB);
            }
#undef SLC_LOADK
#undef SLC_LOADV
#undef SLC_COMPUTE
            const float lt = xsum4(ls);
            if (fr < 6) {
                const float gs = sigmoidf_(graw + bgate[12 + g * 6 + fr]); const float sc = lt > 0.f ? gs / lt : 0.f;
#pragma unroll
                for (int dt = 0; dt < 4; ++dt) { const unsigned long long o64 = oldv[dt]; const f32x4_t v = os[dt] * sc + (f32x4_t){bflo((unsigned)o64), bfhi((unsigned)o64), bflo((unsigned)(o64 >> 32)), bfhi((unsigned)(o64 >> 32))};
                    *(uint2*)(orow + 16 * dt + 4 * fg) = make_uint2(cvtpk(v[0], v[1]), cvtpk(v[2], v[3])); }
            }
        }
        }
        TSUB_END(3);
    }
}

constexpr int CW_P = 272, CW_BUF = 128 * CW_P;
template <bool SMP> __device__ __forceinline__ void compress_job(const Params& p, int bb, int c, int g, LAS unsigned char* lds) {
    const int tid = ltid(), lane = tid & 63, w = tid >> 6, fr = lane & 15, fg = lane >> 4, n = 16 * w + fr;
    unsigned char* ws = p.ws;
    const bf16_t* W1T = (const bf16_t*)(ws + B_W1T) + (size_t)c * 128 * 2048; const bf16_t* W2T = (const bf16_t*)(ws + B_W2T) + (size_t)c * 64 * 128;
    f32x4_t acc[8];
#pragma unroll
    for (int t = 0; t < 8; ++t) acc[t] = (f32x4_t){0.f, 0.f, 0.f, 0.f};
    const bf16_t* ap = (const bf16_t*)(ws + B_KVB) + (size_t)c * KVB_T + ((size_t)(SMP ? 0 : bb) * 2 + g) * SP * 64 + (size_t)n * 1024 + fg * 8;
    const float* pg0 = nullptr; const float* pg1 = nullptr; int tsplit = 0;
    if (SMP) { const int* pt = (const int*)p.in[I_PT] + (bb - 8) * 16; const int t0 = 16 * n > 2016 ? 2016 : 16 * n; const int pa = t0 >> 7, pb = (t0 + 31) >> 7;
        pg0 = p.in[I_CCMP] + (((size_t)pt[pa] * 128 + (t0 & 127)) * 4 + c * 2 + g) * 64 + fg * 8; tsplit = pb == pa ? 64 : 128 - (t0 & 127);
        pg1 = p.in[I_CCMP] + (((size_t)pt[pb] * 128) * 4 + c * 2 + g) * 64 + fg * 8 - (size_t)tsplit * 256; }
    u32x4_t rb[4]; bf16x8_t acur[4]; f32x4_t araw[SMP ? 8 : 1]; bf16x8_t anext[SMP ? 1 : 4];
#define CW_LOADB(st_) do { _Pragma("unroll") for (int i_ = 0; i_ < 4; ++i_) { const int ch_ = tid + NT_ * i_, r_ = ch_ >> 4, cc_ = ch_ & 15; rb[i_] = *(const u32x4_t*)(W1T + (size_t)r_ * 2048 + (st_) * 128 + cc_ * 8); } } while (0)
#define CW_STOREB(buf_) do { _Pragma("unroll") for (int i_ = 0; i_ < 4; ++i_) { const int ch_ = tid + NT_ * i_, r_ = ch_ >> 4, cc_ = ch_ & 15; *(LAS u32x4_t*)(lds + (buf_) * CW_BUF + r_ * CW_P + cc_ * 16) = rb[i_]; } } while (0)
#define CW_LOADA(st_) do { _Pragma("unroll") for (int u_ = 0; u_ < 4; ++u_) { const int s_ = (st_) * 4 + u_; \
        if (SMP) { const int tk_ = s_ >> 1; const float* src_ = (tk_ < tsplit ? pg0 : pg1) + (size_t)tk_ * 256 + (s_ & 1) * 32; araw[2 * u_] = *(const f32x4_t*)src_; araw[2 * u_ + 1] = *(const f32x4_t*)(src_ + 4); } \
        else anext[u_] = *(const bf16x8_t*)(ap + s_ * 32); } } while (0)
#define CW_TAKEA() do { _Pragma("unroll") for (int u_ = 0; u_ < 4; ++u_) { if (SMP) acur[u_] = pack8(araw[2 * u_], araw[2 * u_ + 1]); else acur[u_] = anext[u_]; } } while (0)
    __syncthreads();
    CW_LOADB(0); CW_LOADA(0); CW_STOREB(0); CW_TAKEA();
    BAR_LDS();
#pragma unroll 1
    for (int st = 0; st < 16; ++st) {
        if (st + 1 < 16) { CW_LOADB(st + 1); CW_LOADA(st + 1); }
        const LAS unsigned char* bb_ = lds + (st & 1) * CW_BUF + fr * CW_P + fg * 16;
#pragma unroll
        for (int u = 0; u < 4; ++u)
#pragma unroll
            for (int t = 0; t < 8; ++t) acc[t] = mfma16(*(const LAS bf16x8_t*)(bb_ + t * 16 * CW_P + u * 64), acur[u], acc[t]);
        if (st + 1 < 16) { CW_STOREB((st + 1) & 1); CW_TAKEA(); }
        BAR_LDS();
    }
#undef CW_LOADB
#undef CW_STOREB
#undef CW_LOADA
#undef CW_TAKEA
    const float* peb = (const float*)(ws + B_PEB) + c * 128;
#pragma unroll
    for (int t = 0; t < 8; ++t) { const f32x4_t pb = *(const f32x4_t*)(peb + 16 * t + 4 * fg);
#pragma unroll
        for (int j = 0; j < 4; ++j) { const float x = acc[t][j] + pb[j]; const float u2 = 1.5957691216057308f * (x + 0.044715f * x * x * x);
            const float th = 1.0f - 2.0f * __builtin_amdgcn_rcpf(1.0f + ex2(u2 * LOG2E)); acc[t][j] = 0.5f * x * (1.0f + th); } }
    f32x4_t o[4];
#pragma unroll
    for (int dt = 0; dt < 4; ++dt) o[dt] = (f32x4_t){0.f, 0.f, 0.f, 0.f};
#pragma unroll
    for (int ks = 0; ks < 4; ++ks) { const bf16x8_t gf = pack8(acc[2 * ks], acc[2 * ks + 1]);
#pragma unroll
        for (int dt = 0; dt < 4; ++dt) { const bf16_t* wp = W2T + (size_t)(16 * dt + fr) * 128 + 32 * ks + 4 * fg; const uint2 x0 = *(const uint2*)wp, x1 = *(const uint2*)(wp + 16);
            o[dt] = mfma16(__builtin_bit_cast(bf16x8_t, make_uint4(x0.x, x0.y, x1.x, x1.y)), gf, o[dt]); } }
    float ss = 0.f;
#pragma unroll
    for (int dt = 0; dt < 4; ++dt) { const f32x4_t b2 = *(const f32x4_t*)(p.in[I_CB2] + c * 64 + 16 * dt + 4 * fg); o[dt] = o[dt] + b2; ss += (o[dt][0] * o[dt][0] + o[dt][1] * o[dt][1]) + (o[dt][2] * o[dt][2] + o[dt][3] * o[dt][3]); }
    if (c == 0) { ss = xsum4(ss); const float rs = rsqrtf(ss * (1.0f / 64) + EPS);
#pragma unroll
        for (int dt = 0; dt < 4; ++dt) { const f32x4_t gk = *(const f32x4_t*)(p.in[I_GKCMP] + 16 * dt + 4 * fg); o[dt] = o[dt] * rs * gk; } }
    bf16_t* kc = (bf16_t*)(ws + B_KC16) + ((((size_t)bb * 2 + c) * 2 + g) * 128 + n) * 64;
    float* cf = (float*)(ws + (c == 0 ? B_CK : B_CV)) + ((size_t)bb * 127 + n) * 128 + g * 64;
#pragma unroll
    for (int dt = 0; dt < 4; ++dt) {
        if (n < 127) { *(f32x4_t*)(cf + 16 * dt + 4 * fg) = o[dt]; *(uint2*)(kc + 16 * dt + 4 * fg) = make_uint2(cvtpk(o[dt][0], o[dt][1]), cvtpk(o[dt][2], o[dt][3])); }
        else { unsigned z = 0u; asm volatile("" : "+v"(z)); *(uint2*)(kc + 16 * dt + 4 * fg) = make_uint2(z, z); }
    }
}
__device__ __forceinline__ void ph_compress_fast(const Params& p, LAS unsigned char* lds) {
    for (int job = blockIdx.x; job < 544; job += gridDim.x) { const int jj = job < 512 ? job + 32 : job - 512; const int bb = jj >> 2, c = (jj >> 1) & 1, g = jj & 1;
        if (bb < 8) compress_job<false>(p, bb, c, g, lds); else compress_job<true>(p, bb, c, g, lds); }
}
constexpr int ML_QP = 400, ML_VP = 80, ML_WP = 112;
__device__ __forceinline__ void ph_mlstm_fast(const Params& p, int l, LAS unsigned char* lds) {
    const int tid = ltid(), lane = tid & 63, w = tid >> 6, fr = lane & 15, fg = lane >> 4;
    unsigned char* ws = p.ws;
    const bf16_t* P16 = (const bf16_t*)(ws + B_P16); const float* GT = (const float*)(ws + B_GT); const float* bif = p.in[I_BIF] + l * 8; float* HR = (float*)(ws + B_HRAW);
    LAS unsigned char* Ql = lds;
    LAS unsigned char* Kl = lds + 25600;
    LAS unsigned char* Vl = lds + 51200;
    LAS unsigned char* Wl = lds + 56320;
    LAS unsigned char* CT = lds + 63488;
    LAS float* INTER = (LAS float*)(lds + 82688);
    LAS float* QN = (LAS float*)(lds + 91904);
    LAS float* RTa = (LAS float*)(lds + 92160);
    LAS float* WSa = RTa + 2048;
    LAS float* EIa = RTa + 4096;
    LAS float* DEC = RTa + 6144;
    LAS float* Gk = DEC + 32; LAS float* Ak = DEC + 64; LAS float* MPk = DEC + 96;
    for (int unit = blockIdx.x; unit < 192; unit += gridDim.x) {
        const int xy_ = unit >> 3, bh_ = (unit & 7) + 8 * (xy_ / 6);
        const int es = xy_ % 6, h = bh_ & 3, b = bh_ >> 2;
        const size_t row0 = (size_t)b * SP;
        __syncthreads();
        for (int i = tid; i < 48 * 100; i += NT_) ((LAS unsigned*)CT)[i] = 0u;
        for (int i = tid; i < 64 * 28; i += NT_) ((LAS unsigned*)Wl)[i] = 0u;
        float gia[4], gfa[4];
#pragma unroll
        for (int q = 0; q < 4; ++q) { const float* g_ = GT + (row0 + 64 * (w + 8 * q) + lane) * GTW; gia[q] = g_[h]; gfa[q] = g_[4 + h]; }
#pragma unroll
        for (int q = 0; q < 4; ++q) { const int k = w + 8 * q; const float gi = gia[q] + bif[h], gf = gfa[q] + bif[4 + h];
            float bc = logsigmoidf_(gf);
#pragma unroll
            for (int o = 1; o < 64; o <<= 1) { const float t = __shfl_up(bc, o); if (lane >= o) bc += t; }
            const float u = gi - bc; float pm = u;
#pragma unroll
            for (int o = 1; o < 64; o <<= 1) { const float t = __shfl_up(pm, o); if (lane >= o) pm = fmaxf(pm, t); }
            EIa[k * 64 + lane] = bc; RTa[k * 64 + lane] = pm; WSa[k * 64 + lane] = u;
            if (lane == 63) { Gk[k] = bc; Ak[k] = pm; } }
        __syncthreads();
        if (tid == 0) { float m = NEGM; for (int k = 0; k < 32; ++k) { MPk[k] = m; m = Gk[k] + fmaxf(Ak[k], m); } MPk[32] = m; }
        __syncthreads();
#pragma unroll 1
        for (int k = w; k < 32; k += 8) { const float mp = MPk[k], M63 = fmaxf(Ak[k], mp); const float bc = EIa[k * 64 + lane], pm = RTa[k * 64 + lane], u = WSa[k * 64 + lane]; const float M = fmaxf(pm, mp);
            RTa[k * 64 + lane] = expf(M63 - M); WSa[k * 64 + lane] = expf(u - M63); EIa[k * 64 + lane] = expf(-(bc + M)); if (lane == 0) DEC[k] = expf(mp - M63); }
        f32x4_t cacc[5];
#pragma unroll
        for (int i = 0; i < 5; ++i) cacc[i] = (f32x4_t){0.f, 0.f, 0.f, 0.f};
        u32x4_t rq[3], rk[3], rv;
#define ML_LOAD(c_) do { const size_t rb_ = row0 + 64 * (c_); \
            _Pragma("unroll") for (int i_ = 0; i_ < 3; ++i_) { const int ch_ = tid + NT_ * i_, r_ = ch_ / 24, cc_ = ch_ % 24; const bf16_t* src_ = P16 + (rb_ + r_) * LDA_ + h * 192 + cc_ * 8; rq[i_] = *(const u32x4_t*)src_; rk[i_] = *(const u32x4_t*)(src_ + 768); } \
            if (tid < 256) { const int r_ = tid >> 2, cc_ = tid & 3; rv = *(const u32x4_t*)(P16 + (rb_ + r_) * LDA_ + 1536 + h * 192 + es * 32 + cc_ * 8); } } while (0)
#define ML_STORE(c_) do { \
            _Pragma("unroll") for (int i_ = 0; i_ < 3; ++i_) { const int ch_ = tid + NT_ * i_, r_ = ch_ / 24, cc_ = ch_ % 24; *(LAS u32x4_t*)(Ql + r_ * ML_QP + cc_ * 16) = rq[i_]; *(LAS u32x4_t*)(Kl + r_ * ML_QP + cc_ * 16) = rk[i_]; } \
            if (tid < 256) { const int r_ = tid >> 2, cc_ = tid & 3; *(LAS u32x4_t*)(Vl + r_ * ML_VP + cc_ * 16) = rv; const float wv_ = WSa[(c_) * 64 + r_]; \
                u32x4_t y_; y_.x = cvtpk(bflo(rv.x) * wv_, bfhi(rv.x) * wv_); y_.y = cvtpk(bflo(rv.y) * wv_, bfhi(rv.y) * wv_); y_.z = cvtpk(bflo(rv.z) * wv_, bfhi(rv.z) * wv_); y_.w = cvtpk(bflo(rv.w) * wv_, bfhi(rv.w) * wv_); \
                *(LAS u32x4_t*)(Wl + r_ * ML_WP + cc_ * 16) = y_; if (cc_ == 0) *(LAS bf16_t*)(Wl + r_ * ML_WP + 64) = (bf16_t)f2bf(wv_); } } while (0)
        ML_LOAD(0);
        __syncthreads();
        ML_STORE(0);
#pragma unroll 1
        for (int c = 0; c < 32; ++c) {
            BAR_LDS();
            if (c + 1 < 32) ML_LOAD(c + 1);
            f32x4_t hin[2]; float rsum = 0.f;
            hin[0] = (f32x4_t){0.f, 0.f, 0.f, 0.f}; hin[1] = hin[0];
            if (w < 4) {
                const int tt = w;
                f32x4_t S[4];
#pragma unroll
                for (int st = 0; st < 4; ++st) { S[st] = (f32x4_t){0.f, 0.f, 0.f, 0.f};
                    if (st <= tt) {
#pragma unroll
                        for (int ks = 0; ks < 6; ++ks) { const bf16x8_t kf = *(const LAS bf16x8_t*)(Kl + (16 * st + fr) * ML_QP + (32 * ks + 8 * fg) * 2), qf = *(const LAS bf16x8_t*)(Ql + (16 * tt + fr) * ML_QP + (32 * ks + 8 * fg) * 2);
                            S[st] = mfma16(kf, qf, S[st]); }
                        const f32x4_t wv = *(const LAS f32x4_t*)(WSa + c * 64 + 16 * st + 4 * fg); S[st] = S[st] * wv;
                        if (st == tt) {
#pragma unroll
                            for (int jj = 0; jj < 4; ++jj) if (4 * fg + jj > fr) S[st][jj] = 0.f; }
                        rsum += (S[st][0] + S[st][1]) + (S[st][2] + S[st][3]);
                    } }
                rsum = xsum4(rsum);
#pragma unroll
                for (int kk = 0; kk < 2; ++kk) { if (2 * kk <= tt) { const bf16x8_t pf = pack8(S[2 * kk], S[2 * kk + 1]);
#pragma unroll
                    for (int et = 0; et < 2; ++et) { const LAS unsigned char* vp = Vl + (32 * kk + 4 * fg + (fr >> 2)) * ML_VP + (16 * et + 4 * (fr & 3)) * 2; hin[et] = mfma16(ldtr2(vp, vp + 16 * ML_VP), pf, hin[et]); } } }
            } else {
                const int tt = w - 4;
                f32x4_t I[3];
#pragma unroll
                for (int e3 = 0; e3 < 3; ++e3) { I[e3] = (f32x4_t){0.f, 0.f, 0.f, 0.f};
#pragma unroll
                    for (int ks = 0; ks < 6; ++ks) { const bf16x8_t cf = *(const LAS bf16x8_t*)(CT + (16 * e3 + fr) * ML_QP + (32 * ks + 8 * fg) * 2), qf = *(const LAS bf16x8_t*)(Ql + (16 * tt + fr) * ML_QP + (32 * ks + 8 * fg) * 2);
                        I[e3] = mfma16(cf, qf, I[e3]); } }
                *(LAS f32x4_t*)(INTER + (16 * tt + fr) * 36 + 4 * fg) = I[0]; *(LAS f32x4_t*)(INTER + (16 * tt + fr) * 36 + 16 + 4 * fg) = I[1];
                if (fg == 0) QN[16 * tt + fr] = I[2][0];
            }
            BAR_LDS();
            const float decay = DEC[c];
            if (w < 4) {
                const int t = 16 * w + fr; const float r = RTa[c * 64 + t], einv = EIa[c * 64 + t], qn = QN[t];
                const float den = r * (rsum + decay * qn); const float inv = 1.0f / fmaxf(fabsf(den), einv);
                float* hp = HR + (row0 + 64 * c + t) * 768 + h * 192 + es * 32;
#pragma unroll
                for (int et = 0; et < 2; ++et) { const f32x4_t in2 = *(const LAS f32x4_t*)(INTER + t * 36 + 16 * et + 4 * fg); const f32x4_t num = (hin[et] + in2 * decay) * r; *(f32x4_t*)(hp + 16 * et + 4 * fg) = num * inv; }
            }
#pragma unroll
            for (int i = 0; i < 5; ++i) { const int idx = w + 8 * i; if (idx < 36) { const int dtile = idx / 3, et = idx % 3; cacc[i] = cacc[i] * decay;
#pragma unroll
                for (int ks = 0; ks < 2; ++ks) { const LAS unsigned char* kp = Kl + (32 * ks + 8 * fg + (fr >> 2)) * ML_QP + (16 * dtile + 4 * (fr & 3)) * 2; const LAS unsigned char* vp = Wl + (32 * ks + 8 * fg + (fr >> 2)) * ML_WP + (16 * et + 4 * (fr & 3)) * 2;
                    cacc[i] = mfma16(ldtr2(kp, kp + 4 * ML_QP), ldtr2(vp, vp + 4 * ML_WP), cacc[i]); } } }
            BAR_LDS();
#pragma unroll
            for (int i = 0; i < 5; ++i) { const int idx = w + 8 * i; if (idx < 36) { const int dtile = idx / 3, et = idx % 3;
                typedef unsigned u32x2_t __attribute__((ext_vector_type(2))); u32x2_t wv; wv.x = cvtpk(cacc[i][0], cacc[i][1]); wv.y = cvtpk(cacc[i][2], cacc[i][3]);
                *(LAS u32x2_t*)(CT + (16 * et + fr) * ML_QP + (16 * dtile + 4 * fg) * 2) = wv; } }
            if (c + 1 < 32) ML_STORE(c + 1);
        }
#pragma unroll
        for (int i = 0; i < 5; ++i) { const int idx = w + 8 * i; if (idx < 36) { const int dtile = idx / 3, et = idx % 3;
            if (et < 2) { float* co = p.out + O_PC + ((size_t)((l * 8 + b) * 4 + h) * 192 + 16 * dtile + 4 * fg) * 192 + es * 32 + 16 * et + fr;
#pragma unroll
                for (int jj = 0; jj < 4; ++jj) co[(size_t)jj * 192] = cacc[i][jj]; }
            else if (es == 0 && fr == 0) { float* no = p.out + O_PN + (size_t)((l * 8 + b) * 4 + h) * 192 + 16 * dtile + 4 * fg;
#pragma unroll
                for (int jj = 0; jj < 4; ++jj) no[jj] = cacc[i][jj]; } } }
        if (es == 0 && tid == 0) p.out[O_PM + (l * 8 + b) * 4 + h] = MPk[32];
#undef ML_LOAD
#undef ML_STORE
    }
}
__device__ __forceinline__ void ph_mem_attn_fast(const Params& p, int l, LAS unsigned char* lds, int u0, int ucnt, int ustep) {
    const int tid = ltid(), lane0 = tid & 63, w = tid >> 6;
    const int ldp = l < 2 ? LDA_ : LDB_, qoff = l < 2 ? 3072 : 768;
    const bf16_t* P16 = (const bf16_t*)(p.ws + B_P16); bf16_t* CATB = (bf16_t*)(p.ws + B_CATB); const float* gq = p.in[I_GMEMQ] + l * 64;
    LAS unsigned char* Km = lds;
    LAS unsigned char* Vm = lds + 36864;
    const float* gmk = p.in[I_GMEMK] + l * 64;
    int staged = -1;
    for (int ui = 0; ui < ucnt; ++ui) { const int unit = u0 + ui * ustep; if (unit >= 256) break;
        int lane_a = lane0; asm volatile("" : "+v"(lane_a)); const int lane = lane_a, fr = lane & 15, fg = lane >> 4;
        const int oct = unit & 7, hh = (unit >> 3) & 3, b = unit >> 5;
        const float* kv = (const float*)(p.ws + B_MEMR) + (size_t)(l * 8 + b) * 256 * 512 + hh * 64;
        uint4 qc0, qc1, qn0, qn1;
        { const bf16_t* qrow = P16 + ((size_t)b * SP + oct * 256 + w * 16 + fr) * ldp + qoff + hh * 64;
          qc0 = *(const uint4*)(qrow + fg * 8); qc1 = *(const uint4*)(qrow + 32 + fg * 8); qn0 = *(const uint4*)(qrow + (size_t)128 * ldp + fg * 8); qn1 = *(const uint4*)(qrow + (size_t)128 * ldp + 32 + fg * 8); }
        if ((unit >> 3) != staged) { staged = unit >> 3;
        __syncthreads();
        {
            f32x4_t x[16];
#pragma unroll
            for (int k = 0; k < 16; ++k) { const int i = tid + NT_ * k, tsel = i >> 12, m = (i >> 4) & 255, ch = i & 15; x[k] = *(const f32x4_t*)(kv + (size_t)m * 512 + tsel * 256 + ch * 4); }
#pragma unroll
            for (int k = 0; k < 16; ++k) { const int i = tid + NT_ * k, tsel = i >> 12, m = (i >> 4) & 255, ch = i & 15;
                if (k < 8) { float ss = (x[k][0] * x[k][0] + x[k][1] * x[k][1]) + (x[k][2] * x[k][2] + x[k][3] * x[k][3]);
                    ss += __shfl_xor(ss, 1); ss += __shfl_xor(ss, 2); ss += __shfl_xor(ss, 4); ss += __shfl_xor(ss, 8);
                    const float rs = rsqrtf(ss * (1.0f / 64) + EPS); const f32x4_t gk = *(const f32x4_t*)(gmk + ch * 4); x[k] = x[k] * rs * gk; }
                typedef unsigned u32x2_t __attribute__((ext_vector_type(2))); u32x2_t y; y.x = cvtpk(x[k][0], x[k][1]); y.y = cvtpk(x[k][2], x[k][3]);
                *(LAS u32x2_t*)((tsel ? Vm : Km) + m * KROW + ch * 8) = y; }
        }
        __syncthreads(); }
#pragma unroll 1
        for (int ps = 0; ps < 2; ++ps) {
            const size_t row = (size_t)b * SP + oct * 256 + ps * 128 + w * 16 + fr;
            bf16x8_t qf[2];
            { const uint4 r0 = qc0, r1 = qc1; qc0 = qn0; qc1 = qn1;
              float v[16] = {bflo(r0.x), bfhi(r0.x), bflo(r0.y), bfhi(r0.y), bflo(r0.z), bfhi(r0.z), bflo(r0.w), bfhi(r0.w), bflo(r1.x), bfhi(r1.x), bflo(r1.y), bfhi(r1.y), bflo(r1.z), bfhi(r1.z), bflo(r1.w), bfhi(r1.w)};
              float ss = 0.f;
#pragma unroll
              for (int i = 0; i < 16; ++i) ss += v[i] * v[i];
              ss = xsum4(ss); const float rs = rsqrtf(ss * (1.0f / 64) + EPS) * (0.125f * LOG2E);
#pragma unroll
              for (int i = 0; i < 8; ++i) { v[i] *= rs * gq[fg * 8 + i]; v[8 + i] *= rs * gq[32 + fg * 8 + i]; }
              qf[0] = pack8((f32x4_t){v[0], v[1], v[2], v[3]}, (f32x4_t){v[4], v[5], v[6], v[7]});
              qf[1] = pack8((f32x4_t){v[8], v[9], v[10], v[11]}, (f32x4_t){v[12], v[13], v[14], v[15]}); }
            f32x4_t S[16]; float mx = NINF;
#pragma unroll
            for (int nt = 0; nt < 16; ++nt) { S[nt] = (f32x4_t){0.f, 0.f, 0.f, 0.f};
#pragma unroll
                for (int ks = 0; ks < 2; ++ks) { const bf16x8_t kf = *(const LAS bf16x8_t*)(Km + (16 * nt + fr) * KROW + (32 * ks + 8 * fg) * 2); S[nt] = mfma16(kf, qf[ks], S[nt]); }
                mx = fmaxf(mx, fmaxf(fmaxf(S[nt][0], S[nt][1]), fmaxf(S[nt][2], S[nt][3]))); }
            mx = xmax4(mx); float sum = 0.f;
#pragma unroll
            for (int nt = 0; nt < 16; ++nt)
#pragma unroll
                for (int jj = 0; jj < 4; ++jj) { const float e = ex2(S[nt][jj] - mx); S[nt][jj] = e; sum += e; }
            sum = xsum4(sum); const float inv = 1.0f / sum;
            f32x4_t o[4];
#pragma unroll
            for (int dt = 0; dt < 4; ++dt) o[dt] = (f32x4_t){0.f, 0.f, 0.f, 0.f};
#pragma unroll
            for (int c2 = 0; c2 < 8; ++c2) { const bf16x8_t pf = pack8(S[2 * c2], S[2 * c2 + 1]);
#pragma unroll
                for (int dt = 0; dt < 4; ++dt) { const LAS unsigned char* vp = Vm + (32 * c2 + 4 * fg + (fr >> 2)) * KROW + (16 * dt + 4 * (fr & 3)) * 2; o[dt] = mfma16(ldtr2(vp, vp + 16 * KROW), pf, o[dt]); } }
            bf16_t* orow = CATB + row * DM + 768 + hh * 64;
#pragma unroll
            for (int dt = 0; dt < 4; ++dt) { const f32x4_t v = o[dt] * inv; *(uint2*)(orow + 16 * dt + 4 * fg) = make_uint2(cvtpk(v[0], v[1]), cvtpk(v[2], v[3])); }
        }
    }
}
__device__ __forceinline__ void ph_mem_attn_sample(const Params& p, int l, LAS unsigned char* lds, int j0, int jcnt, int jstep) {
    const int tid = ltid(), lane = tid & 63, w = tid >> 6;
    const int ldp = l < 2 ? LDA_ : LDB_, qoff = l < 2 ? 3072 : 768;
    const bf16_t* P16 = (const bf16_t*)(p.ws + B_P16); bf16_t* CATB = (bf16_t*)(p.ws + B_CATB); const float* gq = p.in[I_GMEMQ] + l * 64;
    LAS float* qs = (LAS float*)(lds + w * 2048);
    LAS float* ps = qs + 64;
    __syncthreads();
    for (int ji = 0; ji < jcnt; ++ji) { const int item = (j0 + ji * jstep) * NW_ + w; if (item >= BS * 4) break;
        const int hh = item & 3, b = item >> 2; const size_t row = (size_t)MP + b;
        const float* kv = p.in[I_CMEM] + (size_t)(l * 128 + b) * 256 * 512 + hh * 64;
        { const float v = bf2f(P16[row * ldp + qoff + hh * 64 + lane]); const float ss = wave_sum(v * v); qs[lane] = v * rsqrtf(ss * (1.0f / 64) + EPS) * gq[lane] * (0.125f * LOG2E); }
        asm volatile("s_waitcnt lgkmcnt(0)" ::: "memory");
        float sc[4] = {0.f, 0.f, 0.f, 0.f};
#pragma unroll 4
        for (int d4 = 0; d4 < 16; ++d4) { const f32x4_t q4 = *(const LAS f32x4_t*)(qs + 4 * d4);
#pragma unroll
            for (int k = 0; k < 4; ++k) { const f32x4_t k4 = *(const f32x4_t*)(kv + (size_t)(lane + 64 * k) * 512 + 4 * d4); sc[k] += (q4[0] * k4[0] + q4[1] * k4[1]) + (q4[2] * k4[2] + q4[3] * k4[3]); } }
        float mx = wave_max(fmaxf(fmaxf(sc[0], sc[1]), fmaxf(sc[2], sc[3]))); float sum = 0.f;
#pragma unroll
        for (int k = 0; k < 4; ++k) { sc[k] = ex2(sc[k] - mx); sum += sc[k]; ps[lane + 64 * k] = sc[k]; }
        sum = wave_sum(sum);
        asm volatile("s_waitcnt lgkmcnt(0)" ::: "memory");
        { const int kg = lane >> 4, c4 = lane & 15; f32x4_t o4 = (f32x4_t){0.f, 0.f, 0.f, 0.f};
#pragma unroll 1
          for (int m0 = 0; m0 < 64; m0 += 16) { f32x4_t v[16];
#pragma unroll
              for (int i = 0; i < 16; ++i) v[i] = *(const f32x4_t*)(kv + (size_t)(4 * (m0 + i) + kg) * 512 + 256 + 4 * c4);
#pragma unroll
              for (int i = 0; i < 16; ++i) o4 = o4 + v[i] * ps[4 * (m0 + i) + kg]; }
#pragma unroll
          for (int jx = 0; jx < 4; ++jx) o4[jx] = xsum4(o4[jx]);
          if (kg == 0) { const float inv = 1.0f / sum; *(uint2*)(CATB + row * DM + 768 + hh * 64 + 4 * c4) = make_uint2(cvtpk(o4[0] * inv, o4[1] * inv), cvtpk(o4[2] * inv, o4[3] * inv)); } }
        asm volatile("s_waitcnt lgkmcnt(0)" ::: "memory");
    }
}
__device__ __forceinline__ void ph_nsa_sample(const Params& p, int j, LAS unsigned char* ldsb) {
    const int tid0 = ltid();
    float* lds = (float*)ldsb;
    float* qs = lds;
    float* sc = lds + 384;
    float* imp = sc + 3072;
    int* sel = (int*)(imp + 40);
    float* gate = (float*)(sel + 8);
    float* oacc = gate + 24;
    const float** kptr = (const float**)(oacc + 384);
    float* part = (float*)(kptr + 512);
    float* tbl = part + 32 * 384;
    int* pts = (int*)(tbl + 192);
    const bf16_t* P = (const bf16_t*)(p.ws + B_P16); const float* GT = (const float*)(p.ws + B_GT); const float* KVR = (const float*)(p.ws + B_KVR); bf16_t* CATB = (bf16_t*)(p.ws + B_CATB);
    const float* table = p.in[I_REL]; const int* pt = (const int*)p.in[I_PT];
    for (int item = blockIdx.x; item < BS * 2; item += gridDim.x) {
        int t_l = tid0; asm volatile("" : "+v"(t_l)); const int tid = t_l, lane = tid & 63, wid = tid >> 6;
        int pos_l = PAST; asm volatile("" : "+s"(pos_l)); const int pos = pos_l;
        const int b = item >> 1, g = item & 1, row = MP + b;
        const bf16_t* pr = P + (size_t)row * LDB_;
        __syncthreads();
        if (wid < 6) { const int z = wid; const float v = bf2f(pr[(g * 6 + z) * 64 + lane]); const float ss = wave_sum(v * v); qs[z * 64 + lane] = v * rsqrtf(ss * (1.0f / 64) + EPS) * p.in[I_GQ][j * 64 + lane]; }
        if (tid >= 384 && tid < 384 + 18) { const int t2 = tid - 384; const int br = t2 / 6, z = t2 % 6; gate[t2] = sigmoidf_(GT[(size_t)row * GTW + br * 12 + g * 6 + z] + p.in[I_BGATE][j * 36 + br * 12 + g * 6 + z]); }
        if (tid < 384) oacc[tid] = 0.f;
        if (tid >= 416 && tid < 432) pts[tid - 416] = pt[b * 16 + (tid - 416)];
        if (tid >= 192 && tid < 384) { const int i = tid - 192; tbl[i] = table[(i / 6) * 12 + g * 6 + (i % 6)]; }
        __syncthreads();
        const float* ck = (const float*)(p.ws + B_CK) + (size_t)(8 + b) * 127 * 128; const float* cv = (const float*)(p.ws + B_CV) + (size_t)(8 + b) * 127 * 128;
        for (int i = tid; i < 6 * 127; i += NT_) {
            const int z = i / 127, n = i % 127; const int dist = pos - (16 * n + 31);
            const float4* kp = (const float4*)(ck + n * 128 + g * 64); const float4* qp = (const float4*)(qs + z * 64); float a = 0.f;
#pragma unroll 8
            for (int d = 0; d < 16; ++d) a += dot4(kp[d], qp[d]);
            sc[z * 128 + n] = a * 0.125f + tbl[rel_bucket_alu(dist) * 6 + z];
        }
        __syncthreads();
        if (wid < 6) row_softmax(sc + wid * 128, 127, lane);
        __syncthreads();
        const int cur = pos >> 6;
        if (tid < 33) { const int jb = tid; float s = 0.f;
            for (int z = 0; z < 6; ++z) { const float* pz = sc + z * 128;
                if (jb < 32) { s += 2.0f * (pz[4 * jb] + pz[4 * jb + 1] + pz[4 * jb + 2]); if (4 * jb + 3 < 127) s += pz[4 * jb + 3]; }
                if (jb >= 1 && jb < 32) s += pz[4 * jb - 1]; }
            imp[jb] = s; }
        __syncthreads();
        if (tid == 0) { sel[0] = 0; sel[1] = cur; sel[2] = cur - 1; }
        if (tid >= 1 && tid <= cur - 2) { const float mine = imp[tid]; int rank = 0;
            for (int j2 = 1; j2 <= cur - 2; ++j2) { const float o = imp[j2]; rank += (o > mine || (o == mine && j2 < tid)) ? 1 : 0; }
            if (rank < 5) sel[3 + rank] = tid; }
        { const int kg = tid >> 4, c4 = tid & 15; f32x4_t v[4]; f32x4_t acc[6];
#pragma unroll
          for (int i = 0; i < 4; ++i) { const int n = kg + 32 * i; v[i] = *(const f32x4_t*)(cv + (n < 127 ? n : 126) * 128 + g * 64 + 4 * c4); }
#pragma unroll
          for (int z = 0; z < 6; ++z) { acc[z] = (f32x4_t){0.f, 0.f, 0.f, 0.f};
#pragma unroll
              for (int i = 0; i < 4; ++i) { const int n = kg + 32 * i; if (n < 127) acc[z] = acc[z] + v[i] * sc[z * 128 + n]; } }
#pragma unroll
          for (int z = 0; z < 6; ++z) *(f32x4_t*)(part + kg * 384 + z * 64 + 4 * c4) = acc[z]; }
        __syncthreads();
        if (tid < 384) { float o = 0.f;
#pragma unroll 8
            for (int kg = 0; kg < 32; ++kg) o += part[kg * 384 + tid];
            oacc[tid] += gate[0 * 6 + (tid >> 6)] * o; }
        __syncthreads();
#pragma unroll 1
        for (int br = 1; br <= 2; ++br) {
            int t_b = tid0; asm volatile("" : "+v"(t_b)); const int tid = t_b, lane = tid & 63, wid = tid >> 6;
            { const int t = tid; const float* kp = nullptr; int dist = -1;
                if (br == 1) { const int blk = sel[t >> 6];
                    if (blk >= 0) { const int tok = blk * 64 + (t & 63); dist = pos - tok;
                        if (dist >= 0) kp = tok < PAST ? p.in[I_CSLC] + ((size_t)pts[tok >> 7] * 128 + (tok & 127)) * 256 + g * 64 : KVR + (size_t)row * 768 + 256 + g * 64; }
                } else { const int kpos = pos - 511 + t; dist = 511 - t;
                    kp = kpos < PAST ? p.in[I_CWIN] + ((size_t)b * 512 + (kpos - (PAST - 512))) * 256 + g * 64 : KVR + (size_t)row * 768 + 512 + g * 64; }
                if (dist >= 0 && kp) {
                    float s[6] = {0.f, 0.f, 0.f, 0.f, 0.f, 0.f};
#pragma unroll 1
                    for (int dc = 0; dc < 2; ++dc) { f32x4_t kk[8];
#pragma unroll
                        for (int d = 0; d < 8; ++d) kk[d] = ((const f32x4_t*)kp)[8 * dc + d];
#pragma unroll
                        for (int d = 0; d < 8; ++d) {
#pragma unroll
                            for (int z = 0; z < 6; ++z) { const f32x4_t q4 = *(const f32x4_t*)(qs + z * 64 + 32 * dc + 4 * d); s[z] += (kk[d][0] * q4[0] + kk[d][1] * q4[1]) + (kk[d][2] * q4[2] + kk[d][3] * q4[3]); }
                            asm volatile("" ::: "memory"); } }
                    const int bk = rel_bucket_alu(dist);
#pragma unroll
                    for (int z = 0; z < 6; ++z) sc[z * 512 + t] = s[z] * 0.125f + tbl[bk * 6 + z];
                    kptr[t] = kp;
                } else {
#pragma unroll
                    for (int z = 0; z < 6; ++z) sc[z * 512 + t] = NEGM;
                    kptr[t] = KVR;
                }
            }
            __syncthreads();
            if (wid < 6) row_softmax(sc + wid * 512, 512, lane);
            __syncthreads();
            {
                const int kg = tid >> 4, c4 = tid & 15; f32x4_t acc[6];
#pragma unroll
                for (int z = 0; z < 6; ++z) acc[z] = (f32x4_t){0.f, 0.f, 0.f, 0.f};
#pragma unroll 1
                for (int i0 = 0; i0 < 16; i0 += 8) { f32x4_t v[8];
#pragma unroll
                    for (int i = 0; i < 8; ++i) v[i] = *(const f32x4_t*)(kptr[kg + 32 * (i0 + i)] + 128 + 4 * c4);
#pragma unroll
                    for (int i = 0; i < 8; ++i)
#pragma unroll
                        for (int z = 0; z < 6; ++z) acc[z] = acc[z] + v[i] * sc[z * 512 + kg + 32 * (i0 + i)]; }
#pragma unroll
                for (int z = 0; z < 6; ++z) *(f32x4_t*)(part + kg * 384 + z * 64 + 4 * c4) = acc[z];
            }
            __syncthreads();
            if (tid < 384) { float o = 0.f;
#pragma unroll 8
                for (int kg = 0; kg < 32; ++kg) o += part[kg * 384 + tid];
                oacc[tid] += gate[br * 6 + (tid >> 6)] * o; }
            __syncthreads();
        }
        if (tid < 384) CATB[(size_t)row * DM + g * 384 + tid] = (bf16_t)f2bf(oacc[tid]);
    }
}
__device__ __forceinline__ void ph_mlstm_sample_fast(const Params& p, int l, LAS unsigned char* ldsb) {
    const int tid = ltid(), lane = tid & 63, w = tid >> 6;
    float* lds = (float*)ldsb;
    float* qs = lds; float* ks = lds + 192; float* n1 = lds + 384; float* part = lds + 576;
    float* scal = part + 8 * 192;
    const bf16_t* P = (const bf16_t*)(p.ws + B_P16); const float* GT = (const float*)(p.ws + B_GT); const float* bif = p.in[I_BIF] + l * 8; float* HR = (float*)(p.ws + B_HRAW);
    for (int item = blockIdx.x; item < BS * 4; item += gridDim.x) {
        const int h = item & 3, b = item >> 2; const size_t row = (size_t)MP + b;
        const bf16_t* pr = P + row * LDA_; const float* gr = GT + row * GTW;
        const size_t sidx = (size_t)(l * 128 + b) * 4 + h;
        const float ig = gr[h] + bif[h], fg_ = gr[4 + h] + bif[4 + h];
        const float m0 = p.in[I_SM][sidx];
        const float logf = logsigmoidf_(fg_);
        const float m_new = fmaxf(logf + m0, ig);
        const float a = expf(logf + m0 - m_new), bb = expf(ig - m_new);
        __syncthreads();
        if (tid < 192) { const float q = bf2f(pr[h * 192 + tid]), k = bf2f(pr[768 + h * 192 + tid]); qs[tid] = q; ks[tid] = k;
            const float nn = a * p.in[I_SN][sidx * 192 + tid] + bb * k; n1[tid] = nn; p.out[O_SN + sidx * 192 + tid] = nn; }
        __syncthreads();
        if (w == 0) { float s = qs[lane] * n1[lane] + qs[lane + 64] * n1[lane + 64] + qs[lane + 128] * n1[lane + 128]; s = wave_sum(s); if (lane == 0) scal[0] = s; }
        const float* C0 = p.in[I_SC] + sidx * 192 * 192; float* C1 = p.out + O_SC + sidx * 192 * 192;
        float ve[3], num[3] = {0.f, 0.f, 0.f};
#pragma unroll
        for (int i = 0; i < 3; ++i) ve[i] = bf2f(pr[1536 + h * 192 + lane + 64 * i]) * bb;
#pragma unroll 1
        for (int d0 = 24 * w; d0 < 24 * w + 24; d0 += 12) {
            float c[12][3];
#pragma unroll
            for (int r = 0; r < 12; ++r)
#pragma unroll
                for (int i = 0; i < 3; ++i) c[r][i] = C0[(size_t)(d0 + r) * 192 + lane + 64 * i];
#pragma unroll
            for (int r = 0; r < 12; ++r) { const float kd = ks[d0 + r], qd = qs[d0 + r];
#pragma unroll
                for (int i = 0; i < 3; ++i) { const float cn = a * c[r][i] + kd * ve[i]; C1[(size_t)(d0 + r) * 192 + lane + 64 * i] = cn; num[i] = fmaf(qd, cn, num[i]); } }
        }
#pragma unroll
        for (int i = 0; i < 3; ++i) part[w * 192 + lane + 64 * i] = num[i];
        __syncthreads();
        if (tid < 192) { float s = 0.f;
#pragma unroll
            for (int ww = 0; ww < 8; ++ww) s += part[ww * 192 + tid];
            HR[row * 768 + h * 192 + tid] = s / fmaxf(fabsf(scal[0]), expf(-m_new)); }
        if (tid == 0) p.out[O_SM + sidx] = m_new;
    }
}
constexpr int RING_BYTES = 131072, MISC_OFF = RING_BYTES + 320, LDS_BYTES = 147456;
typedef float f32x4_ __attribute__((ext_vector_type(4)));

#define STRIP_JOBS(njobs) for (int job = (int)gridDim.x - 1 - (int)blockIdx.x; job < (njobs); job += (int)gridDim.x)
__device__ __forceinline__ void strips_inproj(const Params& p, int l, LAS unsigned char* lds) {
    unsigned char* ws = p.ws; const bf16_t* XB = (const bf16_t*)(ws + B_XB); bf16_t* P16 = (bf16_t*)(ws + B_P16); float* GT = (float*)(ws + B_GT);
    const float* ssq = (const float*)(ws + B_SSQ) + (size_t)(2 * l) * SSQS;
    const bool ka = l < 2; const int ldp = ka ? LDA_ : LDB_, nmain = ka ? 104 * 4 : 32 * 4;
    const bf16_t* Bt = ka ? (const bf16_t*)(ws + B_BTA) + (size_t)l * NBTA * DM : (const bf16_t*)(ws + B_BTB) + (size_t)(l - 2) * NBTB * DM;
    const int tid_ = ltid(); const int lane = tid_ & 63, wave = tid_ >> 6, fr = lane & 15, fq = lane >> 4;
    STRIP_JOBS(nmain + 516) {
        if (job < nmain) {
            const int st = job >> 2, r0 = MP + (job & 3) * 32;
            const int brow[2] = {st * 32, st * 32 + 16}; StripAcc<2> R; strip_gemm<2>(XB, DM, r0, Bt, brow, R, lds);
            if (wave < 2) { const int row = r0 + wave * 16 + fr; const float rs = rstd_of(ssq[row]);
#pragma unroll
                for (int t = 0; t < 2; ++t) { const f32x4_ v = R.a[t] * rs; *(uint2*)(P16 + (size_t)row * ldp + st * 32 + t * 16 + 4 * fq) = make_uint2(pk2(v[0], v[1]), pk2(v[2], v[3])); } }
        } else {
            const int r0 = (job - nmain) * 32, row = r0 + wave * 16 + fr;
            if (ka) { const int brow[1] = {3328}; StripAcc<1> R; strip_gemm<1>(XB, DM, r0, Bt, brow, R, lds); if (wave < 2) *(f32x4_*)(GT + (size_t)row * GTW + 4 * fq) = R.a[0] * rstd_of(ssq[row]); }
            else { const int brow[3] = {1024, 1040, 1056}; StripAcc<3> R; strip_gemm<3>(XB, DM, r0, Bt, brow, R, lds);
                if (wave < 2) { const float rs = rstd_of(ssq[row]);
#pragma unroll
                    for (int t = 0; t < 3; ++t) *(f32x4_*)(GT + (size_t)row * GTW + t * 16 + 4 * fq) = R.a[t] * rs; } }
        }
    }
}
__device__ __forceinline__ void strips_resid(const Params& p, const bf16_t* A, int K, const bf16_t* Bt, float* ssq, float* Y, LAS unsigned char* lds) {
    bf16_t* XB = (bf16_t*)(p.ws + B_XB);
    const int tid_ = ltid(); const int lane = tid_ & 63, wave = tid_ >> 6, fr = lane & 15, fq = lane >> 4;
    STRIP_JOBS(256) {
        const int st = job >> 2, r0 = MP + (job & 3) * 32;
        const int brow[1] = {st * 16}; StripAcc<1> R; strip_gemm<1>(A, K, r0, Bt, brow, R, lds);
        if (wave < 2) { const int row = r0 + wave * 16 + fr; bf16_t* bp = XB + (size_t)row * DM + st * 16 + 4 * fq; const uint2 o = *(const uint2*)bp;
            const f32x4_ x = (f32x4_){bflo(o.x), bfhi(o.x), bflo(o.y), bfhi(o.y)} + R.a[0];
            *(uint2*)bp = make_uint2(pk2(x[0], x[1]), pk2(x[2], x[3]));
            if (Y) *(f32x4_*)(Y + (size_t)row * DM + st * 16 + 4 * fq) = x;
            float ss = (x[0] * x[0] + x[1] * x[1]) + (x[2] * x[2] + x[3] * x[3]); ss += __shfl_xor(ss, 16); ss += __shfl_xor(ss, 32);
            if (fq == 0) (void)__hip_atomic_fetch_add(ssq + row, ss, __ATOMIC_RELAXED, __HIP_MEMORY_SCOPE_AGENT); }
    }
}
__device__ __forceinline__ void strips_gu(const Params& p, int l, LAS unsigned char* lds) {
    unsigned char* ws = p.ws; const bf16_t* XB = (const bf16_t*)(ws + B_XB); bf16_t* HID = (bf16_t*)(ws + B_HID);
    const float* ssq = (const float*)(ws + B_SSQ) + (size_t)(2 * l + 1) * SSQS; const bf16_t* Bt = (const bf16_t*)(ws + B_BTG) + (size_t)l * 2 * DFF * DM;
    const int tid_ = ltid(); const int lane = tid_ & 63, wave = tid_ >> 6, fr = lane & 15, fq = lane >> 4;
    STRIP_JOBS(176 * 4) {
        const int st = job >> 2, r0 = MP + (job & 3) * 32;
        const int brow[2] = {(st >> 3) * 256 + (st & 7) * 16, (st >> 3) * 256 + 128 + (st & 7) * 16}; StripAcc<2> R; strip_gemm<2>(XB, DM, r0, Bt, brow, R, lds);
        if (wave < 2) { const int row = r0 + wave * 16 + fr; const float rs = rstd_of(ssq[row]); float h[4];
#pragma unroll
            for (int j = 0; j < 4; ++j) { const float g = R.a[0][j] * rs, up = R.a[1][j] * rs; h[j] = g * pg8::fast_sigmoid(g) * up; }
            *(uint2*)(HID + (size_t)row * DFF + st * 16 + 4 * fq) = make_uint2(pk2(h[0], h[1]), pk2(h[2], h[3])); }
    }
}
__device__ __forceinline__ void strips_kv(const Params& p, LAS unsigned char* lds) {
    unsigned char* ws = p.ws; const bf16_t* XB = (const bf16_t*)(ws + B_XB); float* KVR = (float*)(ws + B_KVR);
    const float* ssq = (const float*)(ws + B_SSQ) + (size_t)4 * SSQS; const bf16_t* Bt = (const bf16_t*)(ws + B_BTK);
    const int tid_ = ltid(); const int lane = tid_ & 63, wave = tid_ >> 6, fr = lane & 15, fq = lane >> 4;
    STRIP_JOBS(48 * 4) {
        const int st = job >> 2, r0 = MP + (job & 3) * 32;
        const int brow[1] = {st * 16}; StripAcc<1> R; strip_gemm<1>(XB, DM, r0, Bt, brow, R, lds);
        if (wave < 2) { const int row = r0 + wave * 16 + fr; *(f32x4_*)(KVR + (size_t)row * 768 + st * 16 + 4 * fq) = R.a[0] * rstd_of(ssq[row]); }
    }
}

#ifndef COMPRESS_NAIVE
#define COMPRESS_NAIVE 0
#endif
#ifndef MLSTM_NAIVE
#define MLSTM_NAIVE 0
#endif
#ifndef MEMATT_NAIVE
#define MEMATT_NAIVE 0
#endif
#ifndef SAMPLE_ML_NAIVE
#define SAMPLE_ML_NAIVE 0
#endif
#ifndef SAMPLE_NSA_NAIVE
#define SAMPLE_NSA_NAIVE 0
#endif
#ifndef MK_MULTI
#define MK_MULTI 0
#endif
constexpr int PL = 9, NPH = 1 + 4 * PL;
__host__ __device__ constexpr bool phase_nonempty(int ph) {
    if (ph == 0) return true;
    const int l = (ph - 1) / PL, r = (ph - 1) % PL;
    if (r == 2) return l < 2;
    if (r == 7) return false;
    if (r >= 6) return l == 1;
    return true;
}
#ifndef TIME_MASK
#define TIME_MASK 0
#endif
__host__ __device__ constexpr int phase_group(int ph) { if (ph == 0) return 0; const int l = (ph - 1) / PL, r = (ph - 1) % PL; return r == 0 ? 1 : r == 1 ? (l < 2 ? 2 : 4) : r == 2 ? 3 : r == 3 ? 5 : r == 4 ? 6 : r == 5 ? 7 : r == 6 ? 8 : r == 7 ? 9 : 10; }
__global__ void __launch_bounds__(NT_, 2) fwd(Params p) {
    extern __shared__ __attribute__((aligned(16))) unsigned char lds_raw[];
    LAS unsigned char* lds = (LAS unsigned char*)lds_raw;
    float* ldsf = (float*)lds_raw;
    volatile LAS unsigned* MISC = (volatile LAS unsigned*)(lds + MISC_OFF);
    for (int u = threadIdx.x; u < (LDS_BYTES - RING_BYTES) / 4; u += NT_) ((LAS unsigned*)(lds + RING_BYTES))[u] = 0u;
    __syncthreads();
    unsigned char* ws = p.ws;
    XcdBarrier bar; bar.bar = (unsigned*)ws; bar.x = 0; bar.st = MISC + 8;
    const bool single = (p.ph_hi - p.ph_lo) > 1;
    if (single) bar = xcd_barrier_post((unsigned*)ws, MISC + 8);
    bf16_t* XB = (bf16_t*)(ws + B_XB); bf16_t* P16 = (bf16_t*)(ws + B_P16); bf16_t* CATB = (bf16_t*)(ws + B_CATB); bf16_t* HID = (bf16_t*)(ws + B_HID);
    float* SSQ = (float*)(ws + B_SSQ);
    const int G = gridDim.x, c = blockIdx.x;
    if (TIME_SUB && blockIdx.x == TSUB_BLK && threadIdx.x == 0) { for (int i = 0; i < 8; ++i) g_tsub[i] = 0ull; }
    int ph = 0; volatile LAS unsigned long long* TMR = (volatile LAS unsigned long long*)(lds + MISC_OFF + 64);
    if ((TIME_MASK || TIME_SUB) && blockIdx.x == 0 && threadIdx.x == 0) { TMR[0] = 0ull; TMR[1] = __builtin_amdgcn_s_memrealtime(); }
#define ON() (ph >= p.ph_lo && ph < p.ph_hi)
#define NEXT() do { const bool ne_ = phase_nonempty(ph); const int grp_ = phase_group(ph); ++ph; if (ne_ && ph > p.ph_lo && ph < p.ph_hi) xcd_barrier(bar); \
        if (TIME_MASK && blockIdx.x == 0 && threadIdx.x == 0) { const unsigned long long now_ = __builtin_amdgcn_s_memrealtime(); if ((TIME_MASK >> grp_) & 1) TMR[0] = TMR[0] + (now_ - TMR[1]); TMR[1] = now_; } } while (0)
#ifndef NO_PRO
    if (ON()) ph_prologue(p, lds);
#endif
    NEXT();
    for (int l = 0; l < 4; ++l) {
        if (ON()) {
            if (l == 0) { pg8::Gemm g{(const bf16_t*)(ws + B_MPB), (const bf16_t*)(ws + B_BTM), 2048, 2048, DM}; pg8::StaticOrder S; S.init(2048, 2048, G, c);
                pg8::EpiF32 E{(float*)(ws + B_MEMR), 512, nullptr, 512, (size_t)2048 * 512};
                pg8::gemm_phase<pg8::EpiF32, pg8::StaticOrder, true, true>(lds, g, S, E); }
            if (l < 2) { pg8::Gemm g{XB, (const bf16_t*)(ws + B_BTA) + (size_t)l * NBTA * DM, MAP, LDA_ + 256, DM}; pg8::StaticOrder S; S.init(MAP, LDA_ + 256, G, l == 0 ? (c + 192) % G : c);
                pg8::EpiBf16S E{P16, LDA_, SSQ + (size_t)(2 * l) * SSQS, 13, (float*)(ws + B_GT)};
                pg8::gemm_phase<pg8::EpiBf16S, pg8::StaticOrder, true, true>(lds, g, S, E); }
            else { pg8::Gemm g{XB, (const bf16_t*)(ws + B_BTB) + (size_t)(l - 2) * NBTB * DM, MP, LDB_, DM}; pg8::StaticOrder S; S.init(MP, LDB_, G, c);
                pg8::EpiBf16S E{P16, LDB_, SSQ + (size_t)(2 * l) * SSQS, -1, nullptr};
                pg8::gemm_phase<pg8::EpiBf16S, pg8::StaticOrder, true, true>(lds, g, S, E);
#ifndef NO_STRIPS
                strips_inproj(p, l, lds);
#endif
            }
        }
        NEXT();
#ifndef NO_NAIVE
        if (ON()) {
            if (l < 2) { TSUB_BEGIN(); if (MLSTM_NAIVE) ph_mlstm_prompt(p, l, ldsf); else ph_mlstm_fast(p, l, lds); TSUB_END(6); if (G == 256) { if (c >= 192) { ph_mem_attn_fast(p, l, lds, 4 * (c - 192), 4, 1); ph_mem_attn_sample(p, l, lds, c - 192, 1, 64); if (l == 1) ph_swin_copy(p, 192, 64); } TSUB_END(7); }
                else { ph_mem_attn_fast(p, l, lds, c, (256 - c + G - 1) / G, G); if (c < 64) ph_mem_attn_sample(p, l, lds, c, (64 - c + G - 1) / G, G); if (l == 1) ph_swin_copy(p, 0, G); }      if (SAMPLE_ML_NAIVE) ph_mlstm_sample(p, l, ldsf); else ph_mlstm_sample_fast(p, l, lds); }
            else { if (!NSA_NAIVE_ALL) ph_nsa_fast(p, l - 2, lds); { TSUB_BEGIN(); if (SAMPLE_NSA_NAIVE) ph_nsa(p, l - 2, ldsf); else ph_nsa_sample(p, l - 2, lds); TSUB_END(4); } TSUB_BEGIN(); if (MEMATT_NAIVE) ph_mem_attn(p, l); else if (G == 256) { if (c < 16) { ph_mem_attn_fast(p, l, lds, 8 * c, 8, 1); ph_mem_attn_sample(p, l, lds, 2 * c, 2, 1); } else if (c < 32) { ph_mem_attn_fast(p, l, lds, 128 + 5 * (c - 16), 5, 1); ph_mem_attn_sample(p, l, lds, 2 * c, 2, 1); } else if (c < 48) ph_mem_attn_fast(p, l, lds, 208 + 3 * (c - 32), 3, 1); }
                else { ph_mem_attn_fast(p, l, lds, c, (256 - c + G - 1) / G, G); if (c < 64) ph_mem_attn_sample(p, l, lds, c, (64 - c + G - 1) / G, G); } TSUB_END(5); }
        }
#endif
        NEXT();
#ifndef NO_NAIVE
        if (ON()) { if (l < 2) { ph_mlstm_fin(p, l); if (l == 0) ph_memk_norm(p); } }
#endif
        NEXT();
        if (ON()) {
            const bf16_t* Bt = (const bf16_t*)(ws + B_BTO) + (size_t)l * DM * DM; float* sq = SSQ + (size_t)(2 * l + 1) * SSQS;
            pg8::Gemm g{CATB, Bt, MP, DM, DM}; pg8::StaticOrder S; S.init(MP, DM, G, c); pg8::EpiResid E{nullptr, XB, sq};
            pg8::gemm_phase<pg8::EpiResid, pg8::StaticOrder, true, true>(lds, g, S, E);
#ifndef NO_STRIPS
            strips_resid(p, CATB, DM, Bt, sq, nullptr, lds);
#endif
        }
        NEXT();
        if (ON()) {
            pg8::Gemm g{XB, (const bf16_t*)(ws + B_BTG) + (size_t)l * 2 * DFF * DM, MAP, 2 * DFF, DM}; pg8::StaticOrder S; S.init(MAP, 2 * DFF, G, c); pg8::EpiSwiglu E{HID, SSQ + (size_t)(2 * l + 1) * SSQS};
            pg8::gemm_phase<pg8::EpiSwiglu, pg8::StaticOrder, true, true>(lds, g, S, E);
        }
        NEXT();
        if (ON()) {
            const bf16_t* Bt = (const bf16_t*)(ws + B_BTD) + (size_t)l * DM * DFF; float* sq = SSQ + (size_t)(2 * l + 2) * SSQS;
            pg8::Gemm g{HID, Bt, MP, DM, DFF}; pg8::StaticOrder S; S.init(MP, DM, G, c); float* Yo = l == 3 ? p.out : nullptr; pg8::EpiResid E{Yo, XB, sq};
            pg8::gemm_phase<pg8::EpiResid, pg8::StaticOrder, true, true>(lds, g, S, E);
#ifndef NO_STRIPS
            strips_resid(p, HID, DFF, Bt, sq, Yo, lds);
#endif
        }
        NEXT();
        if (ON()) { if (l == 1) {
            pg8::Gemm g{XB, (const bf16_t*)(ws + B_BTK), MAP, 768, DM}; pg8::StaticOrder S; S.init(MAP, 768, G, c); pg8::EpiF32 E{(float*)(ws + B_KVR), 768, SSQ + (size_t)4 * SSQS, 0, 0};
            pg8::gemm_phase<pg8::EpiF32, pg8::StaticOrder, true, true>(lds, g, S, E);
            asm volatile("s_waitcnt vmcnt(0)" ::: "memory"); __syncthreads();
            if (c < 195) {
                constexpr int nM = MAP / 256, nN = 3, nwg = nM * nN, q = nwg / 8, rr = nwg % 8; const int xcd = c % 8, off = c / 8;
                const int wgid = (xcd < rr ? xcd * (q + 1) : rr * (q + 1) + (xcd - rr) * q) + off; constexpr int nig = 8 * nN; const int gid = wgid / nig, fm = gid * 8, gsz = (nM - fm) < 8 ? (nM - fm) : 8;
                rows_post_tile(p, (fm + ((wgid % nig) % gsz)) * 256, (wgid % nig) / gsz); }
            } }
        NEXT();
        NEXT();
#ifndef NO_NAIVE
        if (ON()) { if (l == 1) { if (COMPRESS_NAIVE) ph_compress(p, ldsf); else ph_compress_fast(p, lds); } }
#endif
        NEXT();
    }
    if (TIME_MASK || TIME_SUB) { if (blockIdx.x == 0 && threadIdx.x == 0) { const unsigned long long t_acc = TIME_SUB ? __hip_atomic_load(&g_tsub[TIME_SUB > 0 ? TIME_SUB - 1 : 0], __ATOMIC_RELAXED, __HIP_MEMORY_SCOPE_AGENT) : TMR[0]; const unsigned long long t0 = __builtin_amdgcn_s_memrealtime(); while (__builtin_amdgcn_s_memrealtime() - t0 < 10ull * t_acc) __builtin_amdgcn_s_sleep(8); } }
}

extern "C" void kernel_launch(void* const* d_in, const int* in_sizes, int n_in, void* d_out, int out_size, void* d_ws, size_t ws_size, hipStream_t stream) {
    static int grid = 0;
    if (!grid) {
        int dev = 0, cus = 0;
        (void)hipGetDevice(&dev); (void)hipDeviceGetAttribute(&cus, hipDeviceAttributeMultiprocessorCount, dev);
        if (cus < 1) cus = 256;
        if (hipFuncSetAttribute((const void*)fwd, hipFuncAttributeMaxDynamicSharedMemorySize, LDS_BYTES) != hipSuccess) fprintf(stderr, "kernel_launch: hipFuncSetAttribute failed\n");
        int per_cu = 0; (void)hipOccupancyMaxActiveBlocksPerMultiprocessor(&per_cu, (const void*)fwd, NT_, LDS_BYTES); (void)hipGetLastError();
        if (per_cu < 1) fprintf(stderr, "kernel_launch: occupancy query says %d\n", per_cu);
        grid = cus;
    }
    if (n_in != N_IN || (size_t)out_size != O_END || ws_size < B_END) fprintf(stderr, "kernel_launch: unexpected sizes n_in=%d out=%d ws=%zu need %zu\n", n_in, out_size, ws_size, (size_t)B_END);
    (void)hipMemsetAsync(d_ws, 0, CTL_BYTES, stream);
    Params p{};
    for (int i = 0; i < N_IN; ++i) p.in[i] = (const float*)d_in[i];
    p.out = (float*)d_out; p.ws = (unsigned char*)d_ws;
#if MK_MULTI
    for (int ph = 0; ph < NPH; ++ph) {
        if (!phase_nonempty(ph)) continue;
        p.ph_lo = ph; p.ph_hi = ph + 1;
        hipLaunchKernelGGL(fwd, dim3(grid), dim3(NT_), LDS_BYTES, stream, p);
    }
#else
    p.ph_lo = 0; p.ph_hi = NPH;
    hipLaunchKernelGGL(fwd, dim3(grid), dim3(NT_), LDS_BYTES, stream, p);
#endif
}

#ifdef REGTEST
__global__ void __launch_bounds__(NT_, 2) rt_nsa(Params p) { extern __shared__ __attribute__((aligned(16))) unsigned char l_[]; ph_nsa_fast(p, 0, (LAS unsigned char*)l_); }
__global__ void __launch_bounds__(NT_, 2) rt_mlstm(Params p) { extern __shared__ __attribute__((aligned(16))) unsigned char l_[]; ph_mlstm_fast(p, 0, (LAS unsigned char*)l_); }
__global__ void __launch_bounds__(NT_, 2) rt_nsas(Params p) { extern __shared__ __attribute__((aligned(16))) unsigned char l_[]; ph_nsa_sample(p, 0, (LAS unsigned char*)l_); }
__global__ void __launch_bounds__(NT_, 2) rt_mem(Params p) { extern __shared__ __attribute__((aligned(16))) unsigned char l_[]; ph_mem_attn_fast(p, 0, (LAS unsigned char*)l_, 0, 256, 1); }
__global__ void __launch_bounds__(NT_, 2) rt_cmp(Params p) { extern __shared__ __attribute__((aligned(16))) unsigned char l_[]; ph_compress_fast(p, (LAS unsigned char*)l_); }
#endif
```

```cpp
#include <hip/hip_runtime.h>
#include <cstdio>
#include <cstdint>

#define LAS __attribute__((address_space(3)))
#define GAS __attribute__((address_space(1)))
#define XB_TMO      128
#define XB_XCNT(j)  (256  + 64 * (j))
#define XB_XSUB(j)  (1280 + 64 * (j))
#define XB_XGEN(j)  (2304 + 64 * (j))
#define XB_TOP      3328
#define XB_TOPGEN   3392
#define XCD_BAR_WORDS 3456
#define XB_SPIN_CAP (1u << 23)
__device__ __forceinline__ unsigned xb_ld(unsigned* p)              { return __hip_atomic_load(p, __ATOMIC_RELAXED, __HIP_MEMORY_SCOPE_AGENT); }
__device__ __forceinline__ unsigned xb_add(unsigned* p, unsigned v) { return __hip_atomic_fetch_add(p, v, __ATOMIC_RELAXED, __HIP_MEMORY_SCOPE_AGENT); }
__device__ __forceinline__ unsigned xb_xcc_id() { return (unsigned)__builtin_amdgcn_s_getreg((3 << 11) | 20) & 0xFu; }
#define XB_SPIN(cond, bar) do { unsigned _sp = 0; while (cond) { __builtin_amdgcn_s_sleep(1); \
    if ((++_sp & 255u) == 0u) { if (xb_ld(&(bar)[XB_TMO])) break; if (_sp > XB_SPIN_CAP) { atomicAdd(&(bar)[XB_TMO], 1u); break; } } } } while (0)
struct XcdBarrier { unsigned* bar; unsigned x; volatile LAS unsigned* st; };
__device__ __forceinline__ XcdBarrier xcd_barrier_post(unsigned* bar, volatile LAS unsigned* st) {
    XcdBarrier b; b.bar = bar; b.x = xb_xcc_id(); b.st = st;
    if (threadIdx.x == 0) (void)xb_add(&bar[XB_XCNT(b.x)], 1u);
    return b;
}
__device__ __forceinline__ void xcd_barrier_complete(unsigned* bar, unsigned x, unsigned& nloc, unsigned& nx) {
    const unsigned G = gridDim.x * gridDim.y * gridDim.z;
    unsigned sum, cnt, mine, sp = 0u;
    for (;;) {
        sum = 0u; cnt = 0u; mine = 0u;
#pragma unroll
        for (unsigned j = 0; j < 16; ++j) { const unsigned c = xb_ld(&bar[XB_XCNT(j)]); sum += c; cnt += (c > 0u) ? 1u : 0u; mine = (j == x) ? c : mine; }
        if (sum == G) break;
        __builtin_amdgcn_s_sleep(1);
        if ((++sp & 255u) == 0u) { if (xb_ld(&bar[XB_TMO])) break; if (sp > XB_SPIN_CAP) { atomicAdd(&bar[XB_TMO], 1u); break; } }
    }
    nloc = mine > 0u ? mine : 1u; nx = cnt > 0u ? cnt : 1u;
}
__device__ __forceinline__ void xcd_barrier(const XcdBarrier& b) {
    asm volatile("s_waitcnt vmcnt(0)" ::: "memory");
    __syncthreads();
    if (threadIdx.x == 0) {
        unsigned* bar = b.bar;
        __builtin_amdgcn_s_waitcnt(0);
        unsigned nloc = b.st[0], nx = b.st[1];
        if (nloc == 0u) { xcd_barrier_complete(bar, b.x, nloc, nx); b.st[0] = nloc; b.st[1] = nx; }
        const unsigned old = xb_add(&bar[XB_XSUB(b.x)], 1u);
        const unsigned gen = old / nloc;
        if (old + 1u == (gen + 1u) * nloc) {
            __builtin_amdgcn_fence(__ATOMIC_RELEASE, "agent");
            asm volatile("s_waitcnt vmcnt(0)" ::: "memory");
            const unsigned og = xb_add(&bar[XB_TOP], 1u);
            const unsigned tg = og / nx;
            if (og + 1u == (tg + 1u) * nx) xb_add(&bar[XB_TOPGEN], 1u);
            else XB_SPIN(xb_ld(&bar[XB_TOPGEN]) == tg, bar);
            __builtin_amdgcn_fence(__ATOMIC_ACQUIRE, "agent");
            xb_add(&bar[XB_XGEN(b.x)], 1u);
            asm volatile("s_waitcnt vmcnt(0)" ::: "memory");
        } else {
            XB_SPIN(xb_ld(&bar[XB_XGEN(b.x)]) == gen, bar);
            __builtin_amdgcn_fence(__ATOMIC_ACQUIRE, "agent");
            asm volatile("s_waitcnt vmcnt(0)" ::: "memory");
        }
    }
    __syncthreads();
}

constexpr int NT_ = 512, NW_ = 8;
constexpr int DM = 1024, BP = 8, SP = 2048, MP = BP * SP, BS = 128, MA = MP + BS, MAP = MP + 256;
constexpr int ACOLS = 3336, BCOLS = 1060, DFF = 2816;
constexpr int LDA_ = 3328, LDB_ = 1024;
constexpr int NBTA = 3344, NBTB = 1072;
constexpr int PAST = 2048, GTW = 48;
constexpr float EPS = 1e-6f, NEGM = -1e30f;
typedef unsigned short bf16_t;

enum { I_XP = 0, I_XS, I_SC, I_SN, I_SM, I_CMEM, I_CCMP, I_CSLC, I_CWIN, I_PT, I_MEMP, I_GMIX, I_WINA, I_BIF, I_GHN, I_WINB, I_GQ, I_BGATE, I_REL,
       I_GKV, I_WKV, I_GKSLC, I_GKWIN, I_GKCMP, I_CPOS, I_CW1, I_CB1, I_CW2, I_CB2, I_WMEMKV, I_GMEMK, I_GMEMQ, I_WOUT, I_GFFN, I_WGU, I_WDOWN, N_IN };
constexpr size_t O_YP = 0, O_YS = O_YP + (size_t)MP * DM, O_PC = O_YS + (size_t)BS * DM, O_PN = O_PC + 2ull * 8 * 4 * 192 * 192, O_PM = O_PN + 2ull * 8 * 4 * 192,
    O_PMEM = O_PM + 64, O_PCMP = O_PMEM + 4ull * 8 * 256 * 512, O_PSLC = O_PCMP + (size_t)MP * 256, O_PWIN = O_PSLC + (size_t)MP * 256, O_SC = O_PWIN + 8ull * 512 * 256,
    O_SN = O_SC + 2ull * 128 * 4 * 192 * 192, O_SM = O_SN + 2ull * 128 * 4 * 192, O_SCMP = O_SM + 1024, O_SSLC = O_SCMP + 128 * 256, O_SWIN = O_SSLC + 128 * 256,
    O_END = O_SWIN + 128ull * 512 * 256;
static_assert(O_END == 87700544ull, "output size");
constexpr size_t CTL_BYTES = 2u << 20, B_SSQ = 65536;
constexpr size_t al256(size_t x) { return (x + 255) & ~(size_t)255; }
constexpr size_t B_XB = CTL_BYTES, B_P16 = al256(B_XB + (size_t)MAP * DM * 2), B_GT = al256(B_P16 + (size_t)MAP * LDA_ * 2), B_CATB = al256(B_GT + (size_t)MAP * GTW * 4),
    B_HID = al256(B_CATB + (size_t)MA * DM * 2), B_HRAW = al256(B_HID + (size_t)MAP * DFF * 2), B_KVR = al256(B_HRAW + (size_t)MA * 768 * 4), B_CK = al256(B_KVR + (size_t)MAP * 768 * 4),
    B_CV = al256(B_CK + 136ull * 127 * 128 * 4), B_MPB = al256(B_CV + 136ull * 127 * 128 * 4),
    B_BTA = al256(B_MPB + 2048ull * DM * 2), B_BTB = al256(B_BTA + 2ull * NBTA * DM * 2), B_BTO = al256(B_BTB + 2ull * NBTB * DM * 2), B_BTG = al256(B_BTO + 4ull * DM * DM * 2),
    B_BTD = al256(B_BTG + 4ull * 2 * DFF * DM * 2), B_BTK = al256(B_BTD + 4ull * DM * DFF * 2), B_BTM = al256(B_BTK + 768ull * DM * 2), B_KVB = al256(B_BTM + 2048ull * DM * 2), B_SKF = al256(B_KVB + 6ull * BP * 2 * SP * 64 * 2), B_SVF = al256(B_SKF + (size_t)BP * 2 * SP * 64 * 2), B_KC16 = al256(B_SVF + (size_t)BP * 2 * SP * 64 * 2),
    B_W1T = al256(B_KC16 + 136ull * 2 * 2 * 128 * 64 * 2), B_W2T = al256(B_W1T + 2ull * 128 * 2048 * 2), B_PEB = al256(B_W2T + 2ull * 64 * 128 * 2), B_MEMR = al256(B_PEB + 1024), B_CMPS = al256(B_MEMR + 4ull * 2048 * 512 * 4), B_END = al256(B_CMPS + (size_t)BS * 4 * SP * 64 * 2 + 8192);
constexpr int SSQS = MAP;
static_assert(9 * SSQS * 4 + B_SSQ <= CTL_BYTES, "ssq sites inside the control region");

#ifndef TIME_SUB
#define TIME_SUB 0
#endif
#ifndef TSUB_BLK
#define TSUB_BLK 200
#endif
__device__ unsigned long long g_tsub[8];
#define TSUB_BEGIN() unsigned long long tsub_t0_ = (TIME_SUB && blockIdx.x == TSUB_BLK && threadIdx.x == 0) ? __builtin_amdgcn_s_memrealtime() : 0ull
#define TSUB_END(k) do { if (TIME_SUB && blockIdx.x == TSUB_BLK && threadIdx.x == 0) { const unsigned long long n_ = __builtin_amdgcn_s_memrealtime(); g_tsub[k] += n_ - tsub_t0_; tsub_t0_ = n_; } } while (0)
struct Params { const float* in[N_IN]; float* out; unsigned char* ws; int ph_lo, ph_hi; };

__device__ const unsigned char REL_LUT[128] = {0, 1, 2, 3, 4, 5, 6, 7, 8, 9, 10, 11, 12, 13, 14, 15, 16, 16, 16, 17, 17, 18, 18, 18, 19, 19, 19, 20, 20, 20, 20, 21, 21, 21, 21, 22, 22, 22, 22, 22, 23, 23, 23, 23, 23, 23, 24, 24, 24, 24, 24, 24, 25, 25, 25, 25, 25, 25, 25, 26, 26, 26, 26, 26, 26, 26, 26, 27, 27, 27, 27, 27, 27, 27, 27, 27, 27, 28, 28, 28, 28, 28, 28, 28, 28, 28, 28, 29, 29, 29, 29, 29, 29, 29, 29, 29, 29, 29, 29, 30, 30, 30, 30, 30, 30, 30, 30, 30, 30, 30, 30, 30, 30, 31, 31, 31, 31, 31, 31, 31, 31, 31, 31, 31, 31, 31, 31, 31};
__device__ __forceinline__ int rel_bucket(int d) { return d >= 128 ? 31 : (int)REL_LUT[d < 0 ? 0 : d]; }
__device__ __forceinline__ int rel_bucket_alu(int d) { d = d < 0 ? 0 : d; if (d < 16) return d;
    return 16 + (d >= 19) + (d >= 21) + (d >= 24) + (d >= 27) + (d >= 31) + (d >= 35) + (d >= 40) + (d >= 46) + (d >= 52) + (d >= 59) + (d >= 67) + (d >= 77) + (d >= 87) + (d >= 99) + (d >= 113); }

__device__ __forceinline__ int opq(int i) { asm volatile("" : "+s"(i)); return i; }
#define BAR_LDS() do { asm volatile("s_waitcnt lgkmcnt(0)" ::: "memory"); __builtin_amdgcn_s_barrier(); asm volatile("" ::: "memory"); } while (0)
__device__ __forceinline__ int ltid() { int t = threadIdx.x; asm volatile("" : "+v"(t)); return t; }
__device__ __forceinline__ float wave_sum(float v) {
#pragma unroll
    for (int o = 32; o; o >>= 1) v += __shfl_xor(v, o);
    return v;
}
__device__ __forceinline__ float wave_max(float v) {
#pragma unroll
    for (int o = 32; o; o >>= 1) v = fmaxf(v, __shfl_xor(v, o));
    return v;
}
__device__ __forceinline__ float sigmoidf_(float x) { return 1.0f / (1.0f + expf(-x)); }
__device__ __forceinline__ float logsigmoidf_(float x) { return fminf(x, 0.f) - log1pf(expf(-fabsf(x))); }
__device__ __forceinline__ float dot4(float4 a, float4 b) { return a.x * b.x + a.y * b.y + a.z * b.z + a.w * b.w; }
__device__ __forceinline__ float bf2f(bf16_t u) { return __uint_as_float((unsigned)u << 16); }
__device__ __forceinline__ unsigned f2bf(float f) { unsigned u = __float_as_uint(f); return (u + 0x7fffu + ((u >> 16) & 1u)) >> 16; }
__device__ __forceinline__ unsigned pk2(float lo, float hi) { return f2bf(lo) | (f2bf(hi) << 16); }
__device__ __forceinline__ float bflo(unsigned w) { return __uint_as_float(w << 16); }
__device__ __forceinline__ float bfhi(unsigned w) { return __uint_as_float(w & 0xffff0000u); }
__device__ __forceinline__ float rstd_of(float ssq) { return rsqrtf(ssq * (1.0f / DM) + EPS); }

namespace pg8 {
#define PG8_LAS __attribute__((address_space(3)))
typedef unsigned short bf16_t;
typedef short bf16x8 __attribute__((ext_vector_type(8)));
typedef float f32x4 __attribute__((ext_vector_type(4)));
typedef unsigned u32x4 __attribute__((ext_vector_type(4)));
constexpr int BM = 256, BK = 64, HALF = 128, HTB = HALF * BK * 2  , STAGE_BYTES = 8 * HTB, NXCD = 8, WGM = 8;

__host__ __device__ __forceinline__ int lds_byte(int r, int c) { const int st = (r >> 4) * 2 + (c >> 5), rr = r & 15, cc = c & 31, ob = rr * 64 + cc * 2; return st * 1024 + (ob ^ (((ob >> 9) & 1) << 5)); }
__host__ __device__ __forceinline__ void stage_rc(int b, int& R, int& C) { const int st = b / 1024, sb = b % 1024, swz = sb ^ (((sb >> 9) & 1) << 5); R = (st >> 1) * 16 + swz / 64; C = (st & 1) * 32 + (swz % 64) / 2; }
__host__ __device__ __forceinline__ int perm32(int rho) { const int n = rho >> 4, i = rho & 15; return 8 * (i >> 2) + 4 * n + (i & 3); }

struct Unit { int pm, pn; };
struct Gemm { const bf16_t* A; const bf16_t* Bt; int M, N, K; };

struct StaticOrder {
    int nM, nN, nwg, G, c;
    __host__ __device__ void init(int M, int N, int G_, int c_) { nM = M / BM; nN = N / BM; nwg = nM * nN; G = G_; c = c_; }
    __host__ __device__ bool next(int i, Unit& u) const {
        const long L = (long)i * G + c; if (L >= nwg) return false;
        int wgid = (int)L; { const int q = nwg / NXCD, r = nwg % NXCD, xcd = wgid % NXCD, off = wgid / NXCD; wgid = (xcd < r ? xcd * (q + 1) : r * (q + 1) + (xcd - r) * q) + off; }
        const int nig = WGM * nN, gid = wgid / nig, fm = gid * WGM, gsz = (nM - fm) < WGM ? (nM - fm) : WGM;
        u.pm = fm + ((wgid % nig) % gsz); u.pn = (wgid % nig) / gsz; return true;
    }
    __device__ __forceinline__ void a_ready(const Unit&) const {}
    __device__ __forceinline__ void done(const Unit&) const {}
};

__device__ __forceinline__ unsigned cvt_pk_bf16(float lo, float hi) { unsigned r; asm volatile("v_cvt_pk_bf16_f32 %0, %1, %2" : "=v"(r) : "v"(lo), "v"(hi)); return r; }
typedef float f32x2 __attribute__((ext_vector_type(2)));
__device__ __forceinline__ float fast_sigmoid(float x) { return __builtin_amdgcn_rcpf(1.0f + __builtin_amdgcn_exp2f(-1.4426950408889634f * x)); }
struct EpiF32 {
    static constexpr bool PERM = false, AFTER_DRAIN = false;
    float* O; int ldc; const float* ssq; int split_cols; size_t split_stride;
    __device__ __forceinline__ void operator()(const f32x4 (&acc)[2][2][4][2], const Unit& u, int wr, int wc, int fr, int fq) const {
        int colt = u.pn * BM; float* base = O; if (split_cols) { const int t = colt / split_cols; base += (size_t)t * split_stride; colt -= t * split_cols; }
        const int row0 = u.pm * BM + wr * 64 + fr, col0 = colt + wc * 32 + 4 * fq;
#pragma unroll
        for (int ai = 0; ai < 2; ++ai)
#pragma unroll
            for (int m = 0; m < 4; ++m) { const int r = row0 + ai * HALF + m * 16; const float rs = ssq ? rstd_of(ssq[r]) : 1.0f; float* rowp = base + (size_t)r * ldc + col0;
#pragma unroll
                for (int bj = 0; bj < 2; ++bj)
#pragma unroll
                    for (int n = 0; n < 2; ++n) *(f32x4*)(rowp + bj * HALF + n * 16) = acc[ai][bj][m][n] * rs; }
    }
};
struct EpiBf16S {
    static constexpr bool PERM = true, AFTER_DRAIN = false;
    bf16_t* O; int ldc; const float* ssq; int gate_pn; float* GT;
    __device__ __forceinline__ void operator()(const f32x4 (&acc)[2][2][4][2], const Unit& u, int wr, int wc, int fr, int fq) const {
        const int row0 = u.pm * BM + wr * 64 + fr, col0 = u.pn * BM + wc * 32 + 8 * fq;
        if (u.pn == gate_pn) {
            if (wc == 0 && fq == 0) {
#pragma unroll
                for (int ai = 0; ai < 2; ++ai)
#pragma unroll
                    for (int m = 0; m < 4; ++m) { const int r = row0 + ai * HALF + m * 16; const float rs = rstd_of(ssq[r]);
                        *(f32x4*)(GT + (size_t)r * 48) = acc[ai][0][m][0] * rs; *(f32x4*)(GT + (size_t)r * 48 + 4) = acc[ai][0][m][1] * rs; } }
            return; }
#pragma unroll
        for (int ai = 0; ai < 2; ++ai)
#pragma unroll
            for (int m = 0; m < 4; ++m) { const int r = row0 + ai * HALF + m * 16; const float rs = rstd_of(ssq[r]); bf16_t* rowp = O + (size_t)r * ldc + col0;
#pragma unroll
                for (int bj = 0; bj < 2; ++bj) { const f32x4 v0 = acc[ai][bj][m][0] * rs, v1 = acc[ai][bj][m][1] * rs;
                    u32x4 w; w.x = cvt_pk_bf16(v0[0], v0[1]); w.y = cvt_pk_bf16(v0[2], v0[3]); w.z = cvt_pk_bf16(v1[0], v1[1]); w.w = cvt_pk_bf16(v1[2], v1[3]);
                    *(u32x4*)(rowp + bj * HALF) = w; } }
    }
};
struct EpiSwiglu {
    static constexpr bool PERM = true, AFTER_DRAIN = false;
    bf16_t* O; const float* ssq;
    __device__ __forceinline__ void operator()(const f32x4 (&acc)[2][2][4][2], const Unit& u, int wr, int wc, int fr, int fq) const {
        const int row0 = u.pm * BM + wr * 64 + fr, col0 = u.pn * HALF + wc * 32 + 8 * fq;
#pragma unroll
        for (int ai = 0; ai < 2; ++ai)
#pragma unroll
            for (int m = 0; m < 4; ++m) { const int r = row0 + ai * HALF + m * 16; const float rs = rstd_of(ssq[r]); float h[8];
#pragma unroll
                for (int n = 0; n < 2; ++n)
#pragma unroll
                    for (int j = 0; j < 4; ++j) { const float g = acc[ai][0][m][n][j] * rs, up = acc[ai][1][m][n][j] * rs; h[4 * n + j] = g * fast_sigmoid(g) * up; }
                u32x4 w; w.x = cvt_pk_bf16(h[0], h[1]); w.y = cvt_pk_bf16(h[2], h[3]); w.z = cvt_pk_bf16(h[4], h[5]); w.w = cvt_pk_bf16(h[6], h[7]);
                *(u32x4*)(O + (size_t)r * 2816 + col0) = w; }
    }
};
struct EpiResid {
    static constexpr bool PERM = false, AFTER_DRAIN = false;
    float* Y; bf16_t* XB; float* ssq;
    __device__ __forceinline__ void operator()(const f32x4 (&acc)[2][2][4][2], const Unit& u, int wr, int wc, int fr, int fq) const {
        const int row0 = u.pm * BM + wr * 64 + fr, col0 = u.pn * BM + wc * 32 + 4 * fq;
        typedef unsigned u32x2 __attribute__((ext_vector_type(2)));
#pragma unroll
        for (int ai = 0; ai < 2; ++ai)
#pragma unroll
            for (int m = 0; m < 4; ++m) { const int r = row0 + ai * HALF + m * 16; bf16_t* bp = XB + (size_t)r * 1024 + col0; float ss = 0.f; u32x2 old[2][2];
#pragma unroll
                for (int bj = 0; bj < 2; ++bj)
#pragma unroll
                    for (int n = 0; n < 2; ++n) old[bj][n] = *(const u32x2*)(bp + bj * HALF + n * 16);
#pragma unroll
                for (int bj = 0; bj < 2; ++bj)
#pragma unroll
                    for (int n = 0; n < 2; ++n) { const u32x2 o = old[bj][n]; f32x4 x = (f32x4){bflo(o.x), bfhi(o.x), bflo(o.y), bfhi(o.y)} + acc[ai][bj][m][n];
                        u32x2 w; w.x = cvt_pk_bf16(x[0], x[1]); w.y = cvt_pk_bf16(x[2], x[3]); *(u32x2*)(bp + bj * HALF + n * 16) = w;
                        if (Y) *(f32x4*)(Y + (size_t)r * 1024 + col0 + bj * HALF + n * 16) = x;
                        ss += (x[0] * x[0] + x[1] * x[1]) + (x[2] * x[2] + x[3] * x[3]); }
                ss += __shfl_xor(ss, 16); ss += __shfl_xor(ss, 32);
                if (fq == 0) (void)__hip_atomic_fetch_add(ssq + r, ss, __ATOMIC_RELAXED, __HIP_MEMORY_SCOPE_AGENT); }
    }
};
template <class Epi, class Sched, bool ALIGN_EPI = false, bool SP2 = false>
__device__ __forceinline__ void gemm_phase(PG8_LAS unsigned char* lds, const Gemm g, const Sched& S, const Epi& E) {
    int tid_l = threadIdx.x; asm volatile("" : "+v"(tid_l));
    const int tid = tid_l, wid = __builtin_amdgcn_readfirstlane(tid >> 6), lane = tid & 63, wr = wid >> 2, wc = wid & 3, fr = lane & 15, fq = lane >> 4;
    const int K = g.K, nt = K / BK;
    unsigned voffA[2], voffB[2];
#pragma unroll
    for (int i = 0; i < 2; ++i) { int R, C; stage_rc(tid * 16 + i * 8192, R, C); const int Rb = Epi::PERM ? ((R & ~31) + perm32(R & 31)) : R;
        voffA[i] = (unsigned)(R * K + C) * 2u; voffB[i] = (unsigned)(Rb * K + C) * 2u; }
    const size_t kstep = (size_t)(BK * 2);
    const size_t hstep = (size_t)HALF * K * 2;
    const size_t tstep = 2 * hstep;
    const unsigned ldsw = (unsigned)wid * 1024u;
    const int aoff = lds_byte(wr * 64 + fr, fq * 8), boff = lds_byte(wc * 32 + fr, fq * 8);
#define PG8_SA(b, h) (((b) * 2 + (h)) * HTB)
#define PG8_SB(b, h) ((4 + (b) * 2 + (h)) * HTB)
#define PG8_STAGE(bufoff, gbase, voff) do { _Pragma("unroll") for (int _i = 0; _i < 2; ++_i) \
        __builtin_amdgcn_global_load_lds((const unsigned*)((const char*)(gbase) + (voff)[_i]), (PG8_LAS unsigned*)(lds + (bufoff) + ldsw + _i * 8192), 16, 0, 0); } while (0)
#define PG8_LDA(dst, b, h) do { _Pragma("unroll") for (int m = 0; m < 4; ++m) _Pragma("unroll") for (int k = 0; k < 2; ++k) dst[m][k] = *(const PG8_LAS bf16x8*)(lds + PG8_SA(b, h) + aoff + m * 2048 + k * 1024); } while (0)
#define PG8_LDB(dst, b, h) do { _Pragma("unroll") for (int n = 0; n < 2; ++n) _Pragma("unroll") for (int k = 0; k < 2; ++k) dst[n][k] = *(const PG8_LAS bf16x8*)(lds + PG8_SB(b, h) + boff + n * 2048 + k * 1024); } while (0)
#define PG8_MMA(ai, bj, At, Bt) do { __builtin_amdgcn_s_setprio(1); _Pragma("unroll") for (int m = 0; m < 4; ++m) _Pragma("unroll") for (int n = 0; n < 2; ++n) _Pragma("unroll") for (int k = 0; k < 2; ++k) \
        acc[ai][bj][m][n] = __builtin_amdgcn_mfma_f32_16x16x32_bf16(Bt[n][k], At[m][k], acc[ai][bj][m][n], 0, 0, 0); __builtin_amdgcn_s_setprio(0); } while (0)
#define PG8_WAIT_V(n) asm volatile("s_waitcnt vmcnt(" #n ")" ::: "memory")
#define PG8_WAIT_L(n) asm volatile("s_waitcnt lgkmcnt(" #n ")" ::: "memory")
#define PG8_BAR __builtin_amdgcn_s_barrier()
#define PG8_SCHED __builtin_amdgcn_sched_barrier(0)
    Unit cur, nxt; int ui = 0;
    if (!S.next(0, cur)) return;
    f32x4 acc[2][2][4][2];
#pragma unroll
    for (int a = 0; a < 2; ++a)
#pragma unroll
        for (int b = 0; b < 2; ++b)
#pragma unroll
            for (int m = 0; m < 4; ++m)
#pragma unroll
                for (int n = 0; n < 2; ++n) acc[a][b][m][n] = (f32x4){0.f, 0.f, 0.f, 0.f};
    bf16x8 At[4][2], B0[2][2], B1[2][2];
    const char* cA = (const char*)g.A + (size_t)cur.pm * tstep; const char* cB = (const char*)g.Bt + (size_t)cur.pn * tstep;
    S.a_ready(cur);
    if constexpr (SP2) {
        PG8_STAGE(PG8_SB(0, 0), cB, voffB); PG8_STAGE(PG8_SB(0, 1), cB + hstep, voffB); PG8_STAGE(PG8_SA(0, 0), cA, voffA); PG8_STAGE(PG8_SA(0, 1), cA + hstep, voffA);
        if (wr == 1) PG8_BAR;
        PG8_WAIT_V(2); PG8_BAR;
        PG8_STAGE(PG8_SB(1, 0), cB + kstep, voffB); PG8_STAGE(PG8_SA(1, 0), cA + kstep, voffA); PG8_STAGE(PG8_SB(1, 1), cB + hstep + kstep, voffB);
        PG8_WAIT_V(6); PG8_BAR;
    } else {
        PG8_STAGE(PG8_SB(0, 0), cB, voffB); PG8_STAGE(PG8_SA(0, 0), cA, voffA); PG8_STAGE(PG8_SB(0, 1), cB + hstep, voffB); PG8_STAGE(PG8_SA(0, 1), cA + hstep, voffA);
        if (wr == 1) PG8_BAR;
        PG8_WAIT_V(4); PG8_BAR;
        PG8_STAGE(PG8_SB(1, 0), cB + kstep, voffB); PG8_STAGE(PG8_SA(1, 0), cA + kstep, voffA); PG8_STAGE(PG8_SB(1, 1), cB + hstep + kstep, voffB);
        PG8_WAIT_V(6); PG8_BAR;
    }
    for (;;) {
        const bool has_next = S.next(ui + 1, nxt);
        const char* nA = has_next ? (const char*)g.A + (size_t)nxt.pm * tstep : cA; const char* nB = has_next ? (const char*)g.Bt + (size_t)nxt.pn * tstep : cB;
        for (int t = 0; t < nt; t += 2) {
            const bool last = (t == nt - 2);
            const char* a1 = cA + (size_t)(t + 1) * kstep;
            const char* a2 = last ? nA : cA + (size_t)(t + 2) * kstep; const char* b2 = last ? nB : cB + (size_t)(t + 2) * kstep;
            const char* a3 = a2 + kstep; const char* b3 = b2 + kstep;
            if (last && has_next) S.a_ready(nxt);
            if constexpr (SP2) {
            PG8_LDB(B0, 0, 0); PG8_LDB(B1, 0, 1); PG8_SCHED; PG8_LDA(At, 0, 0); PG8_STAGE(PG8_SA(1, 1), a1 + hstep, voffA);
            PG8_WAIT_V(8); PG8_WAIT_L(0); PG8_BAR; PG8_MMA(0, 0, At, B0); PG8_MMA(0, 1, At, B1); PG8_BAR; PG8_SCHED;
            PG8_LDA(At, 0, 1); PG8_STAGE(PG8_SB(0, 0), b2, voffB); PG8_STAGE(PG8_SB(0, 1), b2 + hstep, voffB); PG8_STAGE(PG8_SA(0, 0), a2, voffA);
            PG8_WAIT_V(8); PG8_WAIT_L(0); PG8_BAR; PG8_MMA(1, 0, At, B0); PG8_MMA(1, 1, At, B1); PG8_BAR; PG8_SCHED;
            PG8_LDB(B0, 1, 0); PG8_LDB(B1, 1, 1); PG8_SCHED; PG8_LDA(At, 1, 0); PG8_STAGE(PG8_SA(0, 1), a2 + hstep, voffA);
            PG8_WAIT_V(8); PG8_WAIT_L(0); PG8_BAR; PG8_MMA(0, 0, At, B0); PG8_MMA(0, 1, At, B1); PG8_BAR; PG8_SCHED;
            PG8_LDA(At, 1, 1); PG8_STAGE(PG8_SB(1, 0), b3, voffB); PG8_STAGE(PG8_SB(1, 1), b3 + hstep, voffB); PG8_STAGE(PG8_SA(1, 0), a3, voffA);
            PG8_WAIT_V(8); PG8_WAIT_L(0); PG8_BAR; PG8_MMA(1, 0, At, B0); PG8_MMA(1, 1, At, B1); PG8_BAR; PG8_SCHED;
            } else {
            PG8_LDB(B0, 0, 0); PG8_SCHED; PG8_LDA(At, 0, 0); PG8_STAGE(PG8_SA(1, 1), a1 + hstep, voffA);
            PG8_WAIT_L(8); PG8_BAR; PG8_WAIT_L(0); PG8_MMA(0, 0, At, B0); PG8_BAR; PG8_SCHED;
            PG8_LDB(B1, 0, 1); PG8_STAGE(PG8_SB(0, 0), b2, voffB);
            PG8_BAR; PG8_WAIT_L(0); PG8_MMA(0, 1, At, B1); PG8_BAR;
            PG8_LDA(At, 0, 1); PG8_STAGE(PG8_SA(0, 0), a2, voffA);
            PG8_BAR; PG8_WAIT_L(0); PG8_MMA(1, 0, At, B0); PG8_BAR; PG8_SCHED;
            PG8_STAGE(PG8_SB(0, 1), b2 + hstep, voffB);
            PG8_WAIT_V(6); PG8_BAR; PG8_MMA(1, 1, At, B1); PG8_BAR;
            PG8_LDB(B0, 1, 0); PG8_SCHED; PG8_LDA(At, 1, 0); PG8_STAGE(PG8_SA(0, 1), a2 + hstep, voffA);
            PG8_WAIT_L(8); PG8_BAR; PG8_WAIT_L(0); PG8_MMA(0, 0, At, B0); PG8_BAR; PG8_SCHED;
            PG8_LDB(B1, 1, 1); PG8_STAGE(PG8_SB(1, 0), b3, voffB);
            PG8_BAR; PG8_WAIT_L(0); PG8_MMA(0, 1, At, B1); PG8_BAR;
            PG8_LDA(At, 1, 1); PG8_STAGE(PG8_SA(1, 0), a3, voffA);
            PG8_BAR; PG8_WAIT_L(0); PG8_MMA(1, 0, At, B0); PG8_BAR; PG8_SCHED;
            PG8_STAGE(PG8_SB(1, 1), b3 + hstep, voffB);
            PG8_WAIT_V(6); PG8_BAR; PG8_MMA(1, 1, At, B1); PG8_BAR;
            }
        }
        if constexpr (ALIGN_EPI) { if (wr == 0) PG8_BAR; }
        if constexpr (!Epi::AFTER_DRAIN) { E(acc, cur, wr, wc, fr, fq); S.done(cur); }
        if (!has_next) break;
#pragma unroll
        for (int a = 0; a < 2; ++a)
#pragma unroll
            for (int b = 0; b < 2; ++b)
#pragma unroll
                for (int m = 0; m < 4; ++m)
#pragma unroll
                    for (int n = 0; n < 2; ++n) acc[a][b][m][n] = (f32x4){0.f, 0.f, 0.f, 0.f};
        cur = nxt; cA = nA; cB = nB; ++ui;
        if constexpr (ALIGN_EPI) { if (wr == 1) PG8_BAR; }
    }
    PG8_WAIT_V(0);
    if constexpr (!ALIGN_EPI) { if (wr == 0) PG8_BAR; }
    PG8_BAR;
    if constexpr (Epi::AFTER_DRAIN) { E.fused(acc, cur, wr, wc, fr, fq, lds, wid, lane); S.done(cur); }
#undef PG8_SA
#undef PG8_SB
#undef PG8_STAGE
#undef PG8_LDA
#undef PG8_LDB
#undef PG8_MMA
#undef PG8_WAIT_V
#undef PG8_WAIT_L
#undef PG8_BAR
#undef PG8_SCHED
}
}
typedef short s_bf16x8 __attribute__((ext_vector_type(8)));
typedef float s_f32x4 __attribute__((ext_vector_type(4)));
template <int NT> struct StripAcc { s_f32x4 a[NT]; };
template <int NT> __device__ __forceinline__ void strip_gemm(const bf16_t* A, int K, int row0, const bf16_t* Bt, const int* brow  , StripAcc<NT>& R, LAS unsigned char* lds) {
    const int tid_ = ltid(), lane = tid_ & 63, wave = tid_ >> 6, fr = lane & 15, fq = lane >> 4, rt = wave & 1, kq = wave >> 1;
    LAS float* red = (LAS float*)lds;
    const int kw = K >> 2;
    const bf16_t* ap = A + (size_t)(row0 + 16 * rt + fr) * K + kq * kw + fq * 8;
    const bf16_t* bp[NT];
#pragma unroll
    for (int t = 0; t < NT; ++t) { bp[t] = Bt + (size_t)(brow[t] + fr) * K + kq * kw + fq * 8; R.a[t] = (s_f32x4){0.f, 0.f, 0.f, 0.f}; }
    int k0 = 0;
#pragma unroll 1
    for (; k0 + 256 <= kw; k0 += 256) {
        s_bf16x8 a[8], b[NT][8];
#pragma unroll
        for (int s2 = 0; s2 < 8; ++s2) { a[s2] = *(const s_bf16x8*)(ap + k0 + s2 * 32);
#pragma unroll
            for (int t = 0; t < NT; ++t) b[t][s2] = *(const s_bf16x8*)(bp[t] + k0 + s2 * 32); }
#pragma unroll
        for (int s2 = 0; s2 < 8; ++s2)
#pragma unroll
            for (int t = 0; t < NT; ++t) R.a[t] = __builtin_amdgcn_mfma_f32_16x16x32_bf16(b[t][s2], a[s2], R.a[t], 0, 0, 0);
    }
#pragma unroll 1
    for (; k0 < kw; k0 += 64) {
        s_bf16x8 a[2], b[NT][2];
#pragma unroll
        for (int s2 = 0; s2 < 2; ++s2) { a[s2] = *(const s_bf16x8*)(ap + k0 + s2 * 32);
#pragma unroll
            for (int t = 0; t < NT; ++t) b[t][s2] = *(const s_bf16x8*)(bp[t] + k0 + s2 * 32); }
#pragma unroll
        for (int s2 = 0; s2 < 2; ++s2)
#pragma unroll
            for (int t = 0; t < NT; ++t) R.a[t] = __builtin_amdgcn_mfma_f32_16x16x32_bf16(b[t][s2], a[s2], R.a[t], 0, 0, 0);
    }
    __syncthreads();
    if (kq > 0) {
#pragma unroll
        for (int t = 0; t < NT; ++t) *(LAS s_f32x4*)(red + ((((kq - 1) * 2 + rt) * NT + t) * 64 + lane) * 4) = R.a[t]; }
    __syncthreads();
    if (kq == 0) {
#pragma unroll
        for (int q = 0; q < 3; ++q)
#pragma unroll
            for (int t = 0; t < NT; ++t) R.a[t] = R.a[t] + *(const LAS s_f32x4*)(red + (((q * 2 + rt) * NT + t) * 64 + lane) * 4); }
}
enum { TR_ID = 0, TR_INA, TR_INB, TR_GU };
__device__ __forceinline__ int tr_rowmap(int kind, int n) {
    if (kind == TR_INA) return n < 3072 ? n : (n < 3080 ? 3328 + (n - 3072) : 3072 + (n - 3080));
    if (kind == TR_INB) return n < 768 ? n : (n < 804 ? 1024 + (n - 768) : 768 + (n - 804));
    if (kind == TR_GU) { if (n < DFF) return (n >> 7) * 256 + (n & 127); const int m = n - DFF; return (m >> 7) * 256 + 128 + (m & 127); }
    return n;
}
__device__ __forceinline__ void tr_item(const float* W, int K, int N, bf16_t* WT, const float* gain, int kind, LAS float* scr, int item, int lane) {
    const int nblk = (N + 31) >> 5, kb = item / nblk, nb = item % nblk, k0 = 64 * kb, n0 = 32 * nb;
    { float v[32]; const int n = n0 + (lane & 31); const bool ok = n < N; const float* wp = W + (size_t)(k0 + (lane >> 5)) * N + (ok ? n : 0);
#pragma unroll
      for (int i = 0; i < 32; ++i) v[i] = wp[(size_t)(2 * i) * N];
#pragma unroll
      for (int i = 0; i < 32; ++i) { const int kk = 2 * i + (lane >> 5); float x = ok ? v[i] : 0.f; if (gain) x *= gain[k0 + kk]; scr[kk * 33 + (lane & 31)] = x; } }
    asm volatile("s_waitcnt lgkmcnt(0)" ::: "memory");
    const int c = lane & 7;
#pragma unroll
    for (int j = 0; j < 4; ++j) { const int nn = (lane >> 3) + 8 * j, n = n0 + nn;
        if (n < N) { const int row = tr_rowmap(kind, n); const float sc = (kind == TR_INA && n >= 768 && n < 1536) ? 0.07216878364870322f : 1.0f;
            const LAS float* s = scr + (8 * c) * 33 + nn; uint4 o;
            o.x = pk2(s[0 * 33] * sc, s[1 * 33] * sc); o.y = pk2(s[2 * 33] * sc, s[3 * 33] * sc); o.z = pk2(s[4 * 33] * sc, s[5 * 33] * sc); o.w = pk2(s[6 * 33] * sc, s[7 * 33] * sc);
            *(uint4*)(WT + (size_t)row * K + k0 + 8 * c) = o; } }
    asm volatile("s_waitcnt lgkmcnt(0)" ::: "memory");
}
__device__ __forceinline__ void ph_prologue(const Params& p, LAS unsigned char* lds) {
    const int tid = ltid(), lane = tid & 63, wid = tid >> 6; const int gw = blockIdx.x * NW_ + wid, NGW = gridDim.x * NW_;
    LAS float* scr = (LAS float*)(lds + wid * 16384);
    unsigned char* ws = p.ws;
    for (int it = gw; ; it += NGW) {
        int r = it; bool done = false;
#define TRJ(Wp, K_, N_, WTp, gainp, kind_) if (!done) { const int cnt = ((K_) / 64) * (((N_) + 31) / 32); if (r < cnt) { tr_item(Wp, K_, N_, WTp, gainp, kind_, scr, r, lane); done = true; } else r -= cnt; }
        for (int l = 0; l < 4; ++l) TRJ(p.in[I_WGU] + (size_t)l * DM * 2 * DFF, DM, 2 * DFF, (bf16_t*)(ws + B_BTG) + (size_t)l * 2 * DFF * DM, p.in[I_GFFN] + l * DM, TR_GU)
        for (int l = 0; l < 4; ++l) TRJ(p.in[I_WDOWN] + (size_t)l * DFF * DM, DFF, DM, (bf16_t*)(ws + B_BTD) + (size_t)l * DM * DFF, (const float*)nullptr, TR_ID)
        for (int l = 0; l < 2; ++l) TRJ(p.in[I_WINA] + (size_t)l * DM * ACOLS, DM, ACOLS, (bf16_t*)(ws + B_BTA) + (size_t)l * NBTA * DM, p.in[I_GMIX] + l * DM, TR_INA)
        for (int l = 0; l < 2; ++l) TRJ(p.in[I_WINB] + (size_t)l * DM * BCOLS, DM, BCOLS, (bf16_t*)(ws + B_BTB) + (size_t)l * NBTB * DM, p.in[I_GMIX] + (2 + l) * DM, TR_INB)
        for (int l = 0; l < 4; ++l) TRJ(p.in[I_WOUT] + (size_t)l * DM * DM, DM, DM, (bf16_t*)(ws + B_BTO) + (size_t)l * DM * DM, (const float*)nullptr, TR_ID)
        TRJ(p.in[I_WKV], DM, 768, (bf16_t*)(ws + B_BTK), p.in[I_GKV], TR_ID)
        for (int l = 0; l < 4; ++l) TRJ(p.in[I_WMEMKV] + (size_t)l * DM * 512, DM, 512, (bf16_t*)(ws + B_BTM) + (size_t)l * 512 * DM, (const float*)nullptr, TR_ID)
        for (int c = 0; c < 2; ++c) TRJ(p.in[I_CW1] + (size_t)c * 2048 * 128, 2048, 128, (bf16_t*)(ws + B_W1T) + (size_t)c * 128 * 2048, (const float*)nullptr, TR_ID)
        for (int c = 0; c < 2; ++c) TRJ(p.in[I_CW2] + (size_t)c * 128 * 64, 128, 64, (bf16_t*)(ws + B_W2T) + (size_t)c * 64 * 128, (const float*)nullptr, TR_ID)
#undef TRJ
        if (!done) break;
    }
    for (int idx = gw; idx < 256; idx += NGW) { const int c = idx >> 7, h = idx & 127; float s = 0.f;
        for (int k = lane; k < 2048; k += 64) s += p.in[I_CPOS][((k >> 6) * 2 + c) * 64 + (k & 63)] * p.in[I_CW1][((size_t)c * 2048 + k) * 128 + h];
        s = wave_sum(s); if (lane == 0) ((float*)(ws + B_PEB))[idx] = s + p.in[I_CB1][idx]; }
    for (int i = blockIdx.x * NT_ + tid; i < 2 * 8 * 128 + 2 * 12 * 128; i += gridDim.x * NT_) {
        uint4 z = make_uint4(0u, 0u, 0u, 0u);
        if (i < 2048) { const int l = i >> 10, rr = (i >> 7) & 7, c = i & 127; ((uint4*)((bf16_t*)(ws + B_BTA) + ((size_t)l * NBTA + 3336 + rr) * DM))[c] = z; }
        else { const int k = i - 2048; const int l = k / 1536, rr = (k % 1536) >> 7, c = k & 127; ((uint4*)((bf16_t*)(ws + B_BTB) + ((size_t)l * NBTB + 1060 + rr) * DM))[c] = z; }
    }
    bf16_t* XB = (bf16_t*)(ws + B_XB); float* ssq0 = (float*)(ws + B_SSQ); bf16_t* MPB = (bf16_t*)(ws + B_MPB);
    for (int r0 = gw; r0 < MA + 2048; r0 += 2 * NGW) {
        float4 v[2][4]; const int r1 = r0 + NGW < MA + 2048 ? r0 + NGW : r0;
#pragma unroll
        for (int u = 0; u < 2; ++u) { const int r = u ? r1 : r0; const float* src = r < MA ? (r < MP ? p.in[I_XP] + (size_t)r * DM : p.in[I_XS] + (size_t)(r - MP) * DM) : p.in[I_MEMP] + (size_t)(r - MA) * DM;
#pragma unroll
            for (int j = 0; j < 4; ++j) v[u][j] = ((const float4*)src)[lane + 64 * j]; }
#pragma unroll
        for (int u = 0; u < 2; ++u) { const int r = u ? r1 : r0; if (u == 1 && r1 == r0) break; const bool isx = r < MA;
            bf16_t* dstb = isx ? XB + (size_t)r * DM : MPB + (size_t)(r - MA) * DM; float ss = 0.f;
#pragma unroll
            for (int j = 0; j < 4; ++j) { ss += dot4(v[u][j], v[u][j]); ((uint2*)dstb)[lane + 64 * j] = make_uint2(pk2(v[u][j].x, v[u][j].y), pk2(v[u][j].z, v[u][j].w)); }
            ss = wave_sum(ss); if (isx && lane == 0) ssq0[r] = ss; }
    }
}

__device__ __forceinline__ void ph_swin_copy(const Params& p, int blk0, int nblk) {
    if ((int)blockIdx.x < blk0 || (int)blockIdx.x >= blk0 + nblk) return;
    const int tid = ltid();
    {   const unsigned n4 = 128u * 511u * 64u, stride = nblk * NT_;
#define SW_SRC(i_) (((const float4*)(p.in[I_CWIN] + (size_t)((i_) / (511u * 64u)) * 512 * 256 + 256))[(i_) % (511u * 64u)])
#define SW_DST(i_) (((float4*)(p.out + O_SWIN + (size_t)((i_) / (511u * 64u)) * 512 * 256))[(i_) % (511u * 64u)])
        for (unsigned i0 = (blockIdx.x - blk0) * NT_ + tid; i0 < n4; i0 += 4 * stride) {
            const unsigned i1 = i0 + stride, i2 = i0 + 2 * stride, i3 = i0 + 3 * stride;
            const float4 v0 = SW_SRC(i0), v1 = SW_SRC(i1 < n4 ? i1 : i0), v2 = SW_SRC(i2 < n4 ? i2 : i0), v3 = SW_SRC(i3 < n4 ? i3 : i0);
            SW_DST(i0) = v0; if (i1 < n4) SW_DST(i1) = v1; if (i2 < n4) SW_DST(i2) = v2; if (i3 < n4) SW_DST(i3) = v3; }
#undef SW_SRC
#undef SW_DST
    }
}

__device__ __forceinline__ void ph_memk_norm(const Params& p) {
    const int tid_ = ltid(); const int lane = tid_ & 63, wid = tid_ >> 6;
    const float* raw = (const float*)(p.ws + B_MEMR);
    for (int it = blockIdx.x * NW_ + wid; it < 4 * 8 * 256; it += gridDim.x * NW_) {
        const int l = it / 2048;
        const float4* rr = (const float4*)(raw + (size_t)it * 512); float4* orow = (float4*)(p.out + O_PMEM + (size_t)it * 512);
        float4 v = rr[lane]; const float4 vv = rr[64 + lane]; float ss = dot4(v, v);
        ss += __shfl_xor(ss, 1); ss += __shfl_xor(ss, 2); ss += __shfl_xor(ss, 4); ss += __shfl_xor(ss, 8);
        const float rs = rsqrtf(ss * (1.0f / 64) + EPS);
        const float4 g = ((const float4*)(p.in[I_GMEMK] + l * 64))[lane & 15];
        v.x *= rs * g.x; v.y *= rs * g.y; v.z *= rs * g.z; v.w *= rs * g.w; orow[lane] = v; orow[64 + lane] = vv;
    }
}

__device__ __forceinline__ void ph_mlstm_prompt(const Params& p, int l, float* lds) {
    const bf16_t* P = (const bf16_t*)(p.ws + B_P16); const float* GT = (const float*)(p.ws + B_GT); const float* bif = p.in[I_BIF] + l * 8; float* HR = (float*)(p.ws + B_HRAW);
    const int tid = ltid(), lane = tid & 63, wid = tid >> 6;
    float* red = lds;
    for (int item = blockIdx.x; item < 256; item += gridDim.x) {
        const int es = item & 7, h = (item >> 3) & 3, b = item >> 5;
        const bool act = tid < 384; const int grp = tid >= 192 ? 1 : 0; const int d = act ? tid - grp * 192 : 0;
        const int col0 = h * 192 + es * 24 + (act ? grp : 0) * 12;
        float C[12]; float n = 0.f, m = NEGM;
#pragma unroll
        for (int e = 0; e < 12; ++e) C[e] = 0.f;
        const bf16_t* pr = P + (size_t)(b * SP) * LDA_; const float* gr = GT + (size_t)(b * SP) * GTW;
        float qn = act ? bf2f(pr[h * 192 + d]) : 0.f, kn = act ? bf2f(pr[768 + h * 192 + d]) : 0.f; uint2 vn[3];
#pragma unroll
        for (int e = 0; e < 3; ++e) vn[e] = *(const uint2*)(pr + 1536 + col0 + 4 * e);
        float in_ = gr[h] + bif[h], fn = gr[4 + h] + bif[4 + h];
        for (int t = 0; t < SP; ++t) {
            const float q = qn, k = kn, ig = in_, fg = fn; float v[12];
#pragma unroll
            for (int e = 0; e < 3; ++e) { v[4 * e] = bflo(vn[e].x); v[4 * e + 1] = bfhi(vn[e].x); v[4 * e + 2] = bflo(vn[e].y); v[4 * e + 3] = bfhi(vn[e].y); }
            if (t + 1 < SP) {
                pr += LDA_; gr += GTW;
                qn = act ? bf2f(pr[h * 192 + d]) : 0.f; kn = act ? bf2f(pr[768 + h * 192 + d]) : 0.f;
#pragma unroll
                for (int e = 0; e < 3; ++e) vn[e] = *(const uint2*)(pr + 1536 + col0 + 4 * e);
                in_ = gr[h] + bif[h]; fn = gr[4 + h] + bif[4 + h];
            }
            const float logf = logsigmoidf_(fg);
            const float m_new = fmaxf(logf + m, ig);
            const float a = expf(logf + m - m_new), bb = expf(ig - m_new);
            const float kb = bb * k;
            float part[13];
#pragma unroll
            for (int e = 0; e < 12; ++e) { C[e] = a * C[e] + kb * v[e]; part[e] = q * C[e]; }
            n = a * n + kb; part[12] = q * n;
#pragma unroll
            for (int e = 0; e < 13; ++e) part[e] = wave_sum(part[e]);
            float* rb = red + (t & 1) * 104;
            if (lane == 0) {
#pragma unroll
                for (int e = 0; e < 13; ++e) rb[wid * 13 + e] = part[e];
            }
            __syncthreads();
            if (tid < 24) {
                const int g2 = tid / 12, e = tid % 12;
                const float num = rb[(g2 * 3) * 13 + e] + rb[(g2 * 3 + 1) * 13 + e] + rb[(g2 * 3 + 2) * 13 + e];
                const float den = rb[12] + rb[13 + 12] + rb[26 + 12];
                HR[(size_t)(b * SP + t) * 768 + h * 192 + es * 24 + tid] = num / fmaxf(fabsf(den), expf(-m_new));
            }
            m = m_new;
        }
        if (act) {
            float* co = p.out + O_PC + ((size_t)((l * 8 + b) * 4 + h) * 192 + d) * 192 + es * 24 + grp * 12;
#pragma unroll
            for (int e = 0; e < 12; ++e) co[e] = C[e];
            if (es == 0 && grp == 0) p.out[O_PN + (size_t)((l * 8 + b) * 4 + h) * 192 + d] = n;
        }
        if (es == 0 && tid == 0) p.out[O_PM + (l * 8 + b) * 4 + h] = m;
        __syncthreads();
    }
}
__device__ __forceinline__ void ph_mlstm_sample(const Params& p, int l, float* lds) {
    const bf16_t* P = (const bf16_t*)(p.ws + B_P16); const float* GT = (const float*)(p.ws + B_GT); const float* bif = p.in[I_BIF] + l * 8; float* HR = (float*)(p.ws + B_HRAW);
    const int tid = ltid();
    float* qs = lds + 512; float* ks = lds + 512 + 192; float* n0s = lds + 512 + 384;
    for (int item = blockIdx.x; item < 128 * 4; item += gridDim.x) {
        const int h = item & 3, b = item >> 2; const int row = MP + b;
        const bf16_t* pr = P + (size_t)row * LDA_; const float* gr = GT + (size_t)row * GTW;
        const size_t sidx = (size_t)(l * 128 + b) * 4 + h;
        __syncthreads();
        if (tid < 192) { qs[tid] = bf2f(pr[h * 192 + tid]); ks[tid] = bf2f(pr[768 + h * 192 + tid]); n0s[tid] = p.in[I_SN][sidx * 192 + tid]; }
        __syncthreads();
        const float ig = gr[h] + bif[h], fg = gr[4 + h] + bif[4 + h];
        const float m0 = p.in[I_SM][sidx];
        const float logf = logsigmoidf_(fg);
        const float m_new = fmaxf(logf + m0, ig);
        const float a = expf(logf + m0 - m_new), bb = expf(ig - m_new);
        if (tid < 192) {
            const int e = tid; const float ve = bf2f(pr[1536 + h * 192 + e]);
            const float* C0 = p.in[I_SC] + sidx * 192 * 192; float* C1 = p.out + O_SC + sidx * 192 * 192;
            float num = 0.f, den = 0.f;
            for (int d = 0; d < 192; ++d) {
                const float c = a * C0[d * 192 + e] + bb * ks[d] * ve; C1[d * 192 + e] = c; num += qs[d] * c;
                const float nd = a * n0s[d] + bb * ks[d]; den += qs[d] * nd;
            }
            HR[(size_t)row * 768 + h * 192 + e] = num / fmaxf(fabsf(den), expf(-m_new));
            p.out[O_SN + sidx * 192 + e] = a * n0s[e] + bb * ks[e];
        }
        if (tid == 0) p.out[O_SM + sidx] = m_new;
    }
}
__device__ __forceinline__ void ph_mlstm_fin(const Params& p, int l) {
    const bf16_t* P = (const bf16_t*)(p.ws + B_P16); const float* HR = (const float*)(p.ws + B_HRAW); bf16_t* CATB = (bf16_t*)(p.ws + B_CATB); const float* g = p.in[I_GHN] + l * 192;
    const int tid_ = ltid(); const int lane = tid_ & 63, wid = tid_ >> 6;
    for (int row = blockIdx.x * NW_ + wid; row < MA; row += gridDim.x * NW_) {
        float v[4][3]; bf16_t og[4][3];
#pragma unroll
        for (int h = 0; h < 4; ++h)
#pragma unroll
            for (int i = 0; i < 3; ++i) { v[h][i] = HR[(size_t)row * 768 + h * 192 + lane + 64 * i]; og[h][i] = P[(size_t)row * LDA_ + 2304 + h * 192 + lane + 64 * i]; }
#pragma unroll
        for (int h = 0; h < 4; ++h) { float ss = v[h][0] * v[h][0] + v[h][1] * v[h][1] + v[h][2] * v[h][2]; ss = wave_sum(ss); const float rs = rsqrtf(ss * (1.0f / 192) + EPS);
#pragma unroll
            for (int i = 0; i < 3; ++i) { const int d = lane + 64 * i; CATB[(size_t)row * DM + h * 192 + d] = (bf16_t)f2bf(sigmoidf_(bf2f(og[h][i])) * (v[h][i] * rs * g[d])); } }
    }
}
__device__ __forceinline__ void ph_mem_attn(const Params& p, int l) {
    const int ldp = l < 2 ? LDA_ : LDB_, qoff = l < 2 ? 3072 : 768;
    const bf16_t* P = (const bf16_t*)(p.ws + B_P16); bf16_t* CATB = (bf16_t*)(p.ws + B_CATB); const float* gq = p.in[I_GMEMQ] + l * 64;
    for (int idx4 = blockIdx.x * NT_ + ltid(); idx4 < 16 * MA; idx4 += gridDim.x * NT_) {
        const int part = idx4 & 3, idx = idx4 >> 2;
        const int hh = idx / MA, row = idx % MA;
        const float* kvb = row < MP ? p.out + O_PMEM + (size_t)(l * 8 + row / SP) * 256 * 512 : p.in[I_CMEM] + (size_t)(l * 128 + (row - MP)) * 256 * 512;
        float q[16]; float ss = 0.f;
        const uint4* qp = (const uint4*)(P + (size_t)row * ldp + qoff + hh * 64 + part * 16);
#pragma unroll
        for (int i = 0; i < 2; ++i) { const uint4 t = qp[i]; q[8 * i] = bflo(t.x); q[8 * i + 1] = bfhi(t.x); q[8 * i + 2] = bflo(t.y); q[8 * i + 3] = bfhi(t.y); q[8 * i + 4] = bflo(t.z); q[8 * i + 5] = bfhi(t.z); q[8 * i + 6] = bflo(t.w); q[8 * i + 7] = bfhi(t.w); }
#pragma unroll
        for (int i = 0; i < 16; ++i) ss += q[i] * q[i];
        ss += __shfl_xor(ss, 1); ss += __shfl_xor(ss, 2);
        const float rs = rsqrtf(ss * (1.0f / 64) + EPS) * 0.125f;
#pragma unroll
        for (int i = 0; i < 16; ++i) q[i] *= rs * gq[part * 16 + i];
        float mx = -3e38f, den = 0.f; float o[16];
#pragma unroll
        for (int i = 0; i < 16; ++i) o[i] = 0.f;
        for (int m = 0; m < 256; ++m) {
            const float4* kp = (const float4*)(kvb + (size_t)m * 512 + hh * 64 + part * 16); const float4* vp = (const float4*)(kvb + (size_t)m * 512 + 256 + hh * 64 + part * 16);
            float s = 0.f;
#pragma unroll
            for (int i = 0; i < 4; ++i) { const float4 t = kp[i]; s += q[4 * i] * t.x + q[4 * i + 1] * t.y + q[4 * i + 2] * t.z + q[4 * i + 3] * t.w; }
            s += __shfl_xor(s, 1); s += __shfl_xor(s, 2);
            const float mn = fmaxf(mx, s); const float sc = expf(mx - mn), e = expf(s - mn); mx = mn; den = den * sc + e;
#pragma unroll
            for (int i = 0; i < 4; ++i) { const float4 t = vp[i]; o[4 * i] = o[4 * i] * sc + e * t.x; o[4 * i + 1] = o[4 * i + 1] * sc + e * t.y; o[4 * i + 2] = o[4 * i + 2] * sc + e * t.z; o[4 * i + 3] = o[4 * i + 3] * sc + e * t.w; }
        }
        const float inv = 1.0f / den; uint4* op = (uint4*)(CATB + (size_t)row * DM + 768 + hh * 64 + part * 16);
#pragma unroll
        for (int i = 0; i < 2; ++i) op[i] = make_uint4(pk2(o[8 * i] * inv, o[8 * i + 1] * inv), pk2(o[8 * i + 2] * inv, o[8 * i + 3] * inv), pk2(o[8 * i + 4] * inv, o[8 * i + 5] * inv), pk2(o[8 * i + 6] * inv, o[8 * i + 7] * inv));
    }
}
__device__ __forceinline__ void rows_post_tile(const Params& p, int row0, int t) {
    float* KVR = (float*)(p.ws + B_KVR); const int tid_ = ltid(); const int lane = tid_ & 63, wid = tid_ >> 6;
    const int c2 = lane >> 5, gg = (lane >> 4) & 1, d = (lane & 15) * 4; bf16_t* KVB = (bf16_t*)(p.ws + B_KVB); const size_t KT = (size_t)BP * 2 * SP * 64;
#pragma unroll 1
    for (int rr0 = wid; rr0 < 256; rr0 += 4 * NW_) {
      float4 vv[4];
#pragma unroll
      for (int k = 0; k < 4; ++k) { const int rowk = row0 + rr0 + k * NW_; vv[k] = ((const float4*)(KVR + (size_t)(rowk < MA ? rowk : MA - 1) * 768 + t * 256))[lane]; }
#pragma unroll
      for (int k = 0; k < 4; ++k) {
        const int row = row0 + rr0 + k * NW_; if (row >= MA) continue;
        float* r = KVR + (size_t)row * 768 + t * 256;
        float4 v = vv[k];
        if (t >= 1) {
            float ss = dot4(v, v);
            ss += __shfl_xor(ss, 1); ss += __shfl_xor(ss, 2); ss += __shfl_xor(ss, 4); ss += __shfl_xor(ss, 8);
            if (lane < 32) { const float rs = rsqrtf(ss * (1.0f / 64) + EPS); const float4 gk = ((const float4*)(t == 1 ? p.in[I_GKSLC] : p.in[I_GKWIN]))[lane & 15];
                v.x *= rs * gk.x; v.y *= rs * gk.y; v.z *= rs * gk.z; v.w *= rs * gk.w;
                if (row >= MP) ((float4*)r)[lane] = v; }
        }
        if (row < MP) {
            const int b = row / SP, sp = row % SP; const size_t off = (((size_t)b * 2 + gg) * SP + sp) * 64 + d;
            if (t == 0) { ((float4*)(p.out + O_PCMP + (size_t)row * 256))[lane] = v; *(uint2*)(KVB + (0 + c2) * KT + off) = make_uint2(pk2(v.x, v.y), pk2(v.z, v.w)); }
            else if (t == 2) { if (sp >= SP - 512) ((float4*)(p.out + O_PWIN + (size_t)(b * 512 + sp - (SP - 512)) * 256))[lane] = v; *(uint2*)(KVB + (4 + c2) * KT + off) = make_uint2(pk2(v.x, v.y), pk2(v.z, v.w)); }
            else {
                ((float4*)(p.out + O_PSLC + (size_t)row * 256))[lane] = v;
                const size_t blkbase = (((size_t)b * 2 + gg) * 32 + (sp >> 6)) * 4096;
                if (c2 == 0) { const int nt = (sp >> 4) & 3, fr2 = sp & 15, ks = d >> 5, fg2 = (d >> 3) & 3, e = d & 7;
                    *(uint2*)((bf16_t*)(p.ws + B_SKF) + blkbase + (size_t)(((nt * 2 + ks) * 64 + fg2 * 16 + fr2) * 8 + e)) = make_uint2(pk2(v.x, v.y), pk2(v.z, v.w)); }
                else { const int cs = (sp >> 5) & 1, kk = sp & 31, fg2 = (kk & 15) >> 2, e = (kk & 3) + (kk >= 16 ? 4 : 0), dt = d >> 4, fr2 = d & 15;
                    bf16_t* vf = (bf16_t*)(p.ws + B_SVF) + blkbase + (size_t)(((dt * 2 + cs) * 64 + fg2 * 16 + fr2) * 8 + e);
                    vf[0] = (bf16_t)f2bf(v.x); vf[8] = (bf16_t)f2bf(v.y); vf[16] = (bf16_t)f2bf(v.z); vf[24] = (bf16_t)f2bf(v.w); } }
        } else {
            const int b = row - MP;
            if (t == 0) ((float4*)(p.out + O_SCMP + (size_t)b * 256))[lane] = v; else if (t == 1) ((float4*)(p.out + O_SSLC + (size_t)b * 256))[lane] = v;
            else ((float4*)(p.out + O_SWIN + (size_t)(b * 512 + 511) * 256))[lane] = v;
        }
      }
    }
}
__device__ __forceinline__ float gelu_tanh(float x) { return 0.5f * x * (1.0f + tanhf(0.7978845608028654f * (x + 0.044715f * x * x * x))); }
__device__ __forceinline__ void ph_compress(const Params& p, float* lds) {
    const float* KVR = (const float*)(p.ws + B_KVR); const int tid = ltid();
    float* xs = lds;
    float* hs = lds + 4096;
    const float* w1 = p.in[I_CW1]; const float* w2 = p.in[I_CW2]; const int* pt = (const int*)p.in[I_PT];
    for (int item = blockIdx.x; item < 136 * 127 * 2; item += gridDim.x) {
        const int c = item & 1, n = (item >> 1) % 127, bb = (item >> 1) / 127;
        __syncthreads();
        for (int i = tid; i < 4096; i += NT_) {
            const int g = i >> 11, pp = (i >> 6) & 31, d = i & 63; const int tok = 16 * n + pp; float x;
            if (bb < 8) x = KVR[(size_t)(bb * SP + tok) * 768 + c * 128 + g * 64 + d];
            else { const int b = bb - 8; const int phys = pt[b * 16 + (tok >> 7)]; x = p.in[I_CCMP][((size_t)phys * 128 + (tok & 127)) * 256 + c * 128 + g * 64 + d]; }
            xs[i] = x + p.in[I_CPOS][(pp * 2 + c) * 64 + d];
        }
        __syncthreads();
        if (tid < 256) { const int g = tid >> 7, h = tid & 127; float pre = p.in[I_CB1][c * 128 + h]; const float* wp = w1 + (size_t)c * 2048 * 128 + h; const float* xp = xs + g * 2048;
          for (int i = 0; i < 2048; ++i) pre = fmaf(xp[i], wp[(size_t)i * 128], pre);
          hs[g * 128 + h] = gelu_tanh(pre); }
        __syncthreads();
        if (tid < 128) {
            const int g = tid >> 6, d = tid & 63; float o = p.in[I_CB2][c * 64 + d];
            for (int h = 0; h < 128; ++h) o = fmaf(hs[g * 128 + h], w2[(size_t)(c * 128 + h) * 64 + d], o);
            if (c == 0) { const float ss = wave_sum(o * o); o = o * rsqrtf(ss * (1.0f / 64) + EPS) * p.in[I_GKCMP][d]; }
            ((float*)(p.ws + (c == 0 ? B_CK : B_CV)))[((size_t)bb * 127 + n) * 128 + g * 64 + d] = o;
            bf16_t* kc = (bf16_t*)(p.ws + B_KC16) + ((((size_t)bb * 2 + c) * 2 + g) * 128 + n) * 64 + d; kc[0] = (bf16_t)f2bf(o); if (n == 126) kc[64] = 0;
        }
    }
}
#ifndef NSA_NAIVE_ALL
#define NSA_NAIVE_ALL 0
#endif
__device__ __forceinline__ void row_softmax(float* r, int n, int lane) {
    float mx = NEGM;
    for (int i = lane; i < n; i += 64) mx = fmaxf(mx, r[i]);
    mx = wave_max(mx);
    if (mx <= 0.5f * NEGM) { for (int i = lane; i < n; i += 64) r[i] = 0.f; return; }
    float s = 0.f;
    for (int i = lane; i < n; i += 64) { const float e = r[i] <= 0.5f * NEGM ? 0.f : expf(r[i] - mx); r[i] = e; s += e; }
    s = wave_sum(s); const float inv = 1.0f / s;
    for (int i = lane; i < n; i += 64) r[i] *= inv;
}
__device__ __forceinline__ void ph_nsa(const Params& p, int j, float* lds) {
    const int tid = ltid(), lane = tid & 63, wid = tid >> 6;
    float* qs = lds;
    float* sc = lds + 384;
    float* imp = sc + 3072;
    int* sel = (int*)(imp + 40);
    float* gate = (float*)(sel + 8);
    float* oacc = gate + 24;
    const bf16_t* P = (const bf16_t*)(p.ws + B_P16); const float* GT = (const float*)(p.ws + B_GT); const float* KVR = (const float*)(p.ws + B_KVR); bf16_t* CATB = (bf16_t*)(p.ws + B_CATB);
    const float* table = p.in[I_REL]; const int* pt = (const int*)p.in[I_PT];
    for (int item = blockIdx.x; item < (NSA_NAIVE_ALL ? MA : BS) * 2; item += gridDim.x) {
        const int row = (NSA_NAIVE_ALL ? 0 : MP) + (item >> 1), g = item & 1; const bool smp = row >= MP;
        const int b = smp ? row - MP : row / SP, pos = smp ? PAST : row % SP;
        const bf16_t* pr = P + (size_t)row * LDB_;
        __syncthreads();
        if (wid < 6) { const int z = wid; const float v = bf2f(pr[(g * 6 + z) * 64 + lane]); const float ss = wave_sum(v * v); qs[z * 64 + lane] = v * rsqrtf(ss * (1.0f / 64) + EPS) * p.in[I_GQ][j * 64 + lane]; }
        if (tid >= 384 && tid < 384 + 18) { const int t2 = tid - 384; const int br = t2 / 6, z = t2 % 6; gate[t2] = sigmoidf_(GT[(size_t)row * GTW + br * 12 + g * 6 + z] + p.in[I_BGATE][j * 36 + br * 12 + g * 6 + z]); }
        if (tid < 384) oacc[tid] = 0.f;
        __syncthreads();
        const float* ck = (const float*)(p.ws + B_CK) + (size_t)(smp ? 8 + b : b) * 127 * 128; const float* cv = (const float*)(p.ws + B_CV) + (size_t)(smp ? 8 + b : b) * 127 * 128;
        for (int i = tid; i < 6 * 127; i += NT_) {
            const int z = i / 127, n = i % 127; const int dist = pos - (16 * n + 31); float s = NEGM;
            if (dist >= 0) { const float4* kp = (const float4*)(ck + n * 128 + g * 64); const float4* qp = (const float4*)(qs + z * 64); float a = 0.f;
#pragma unroll 4
                for (int d = 0; d < 16; ++d) a += dot4(kp[d], qp[d]);
                s = a * 0.125f + table[rel_bucket(dist) * 12 + g * 6 + z]; }
            sc[z * 128 + n] = s;
        }
        __syncthreads();
        if (wid < 6) row_softmax(sc + wid * 128, 127, lane);
        __syncthreads();
        const int nslc = smp ? 33 : 32, cur = pos >> 6;
        if (tid < nslc) { const int jb = tid; float s = 0.f;
            for (int z = 0; z < 6; ++z) for (int n = 0; n < 127; ++n) { const int lo = max(16 * n, 64 * jb), hi = min(16 * n + 32, 64 * jb + 64); if (hi > lo) s += sc[z * 128 + n] * (float)(hi - lo) * (1.0f / 16); }
            imp[jb] = s; }
        __syncthreads();
        if (tid == 0) {
            int cnt = 0;
            if (cur + 1 <= 8) { for (int jb = 0; jb <= cur; ++jb) sel[cnt++] = jb; }
            else {
                sel[0] = 0; sel[1] = cur; sel[2] = cur - 1; cnt = 3; unsigned long long taken = 0ull;
                for (int k = 0; k < 5; ++k) { int best = -1; float bv = -1.f;
                    for (int jb = 1; jb <= cur - 2; ++jb) if (!((taken >> jb) & 1ull) && imp[jb] > bv) { bv = imp[jb]; best = jb; }
                    if (best >= 0) { taken |= 1ull << best; sel[cnt++] = best; } }
            }
            for (; cnt < 8; ++cnt) sel[cnt] = -1;
        }
        if (tid < 384) { const int z = tid >> 6, d = tid & 63; float o = 0.f;
            for (int n = 0; n < 127; ++n) o = fmaf(sc[z * 128 + n], cv[n * 128 + g * 64 + d], o);
            oacc[tid] += gate[0 * 6 + z] * o; }
        __syncthreads();
        for (int br = 1; br <= 2; ++br) {
            { const int t = tid;
                const float* kp = nullptr; int dist = -1;
                if (br == 1) {
                    const int blk = sel[t >> 6];
                    if (blk >= 0) { const int tok = blk * 64 + (t & 63); dist = pos - tok;
                        if (dist >= 0) { if (!smp) kp = KVR + (size_t)(b * SP + tok) * 768 + 256 + g * 64;
                            else if (tok < PAST) kp = p.in[I_CSLC] + ((size_t)pt[b * 16 + (tok >> 7)] * 128 + (tok & 127)) * 256 + g * 64;
                            else kp = KVR + (size_t)row * 768 + 256 + g * 64; } }
                } else {
                    const int kpos = pos - 511 + t; dist = 511 - t;
                    if (!smp) { if (kpos >= 0) kp = KVR + (size_t)(b * SP + kpos) * 768 + 512 + g * 64; else dist = -1; }
                    else { if (kpos < PAST) kp = p.in[I_CWIN] + ((size_t)b * 512 + (kpos - (PAST - 512))) * 256 + g * 64; else kp = KVR + (size_t)row * 768 + 512 + g * 64; }
                }
                if (dist >= 0 && kp) {
                    float s[6] = {0.f, 0.f, 0.f, 0.f, 0.f, 0.f};
#pragma unroll 2
                    for (int d = 0; d < 16; ++d) { const float4 kk = ((const float4*)kp)[d];
#pragma unroll
                        for (int z = 0; z < 6; ++z) s[z] += dot4(kk, ((const float4*)(qs + z * 64))[d]); }
                    const int bk = rel_bucket(dist);
#pragma unroll
                    for (int z = 0; z < 6; ++z) sc[z * 512 + t] = s[z] * 0.125f + table[bk * 12 + g * 6 + z];
                } else {
#pragma unroll
                    for (int z = 0; z < 6; ++z) sc[z * 512 + t] = NEGM;
                }
            }
            __syncthreads();
            if (wid < 6) row_softmax(sc + wid * 512, 512, lane);
            __syncthreads();
            if (tid < 384) { const int z = tid >> 6, d = tid & 63; float o = 0.f;
                for (int t = 0; t < 512; ++t) { const float pw = sc[z * 512 + t]; if (pw != 0.f) { const float* vp;
                    if (br == 1) { const int tok = sel[t >> 6] * 64 + (t & 63);
                        if (!smp) vp = KVR + (size_t)(b * SP + tok) * 768 + 256 + 128 + g * 64;
                        else if (tok < PAST) vp = p.in[I_CSLC] + ((size_t)pt[b * 16 + (tok >> 7)] * 128 + (tok & 127)) * 256 + 128 + g * 64;
                        else vp = KVR + (size_t)row * 768 + 256 + 128 + g * 64;
                    } else { const int kpos = pos - 511 + t;
                        if (!smp) vp = KVR + (size_t)(b * SP + kpos) * 768 + 512 + 128 + g * 64;
                        else if (kpos < PAST) vp = p.in[I_CWIN] + ((size_t)b * 512 + (kpos - (PAST - 512))) * 256 + 128 + g * 64;
                        else vp = KVR + (size_t)row * 768 + 512 + 128 + g * 64; }
                    o = fmaf(pw, vp[d], o); } }
                oacc[tid] += gate[br * 6 + z] * o; }
            __syncthreads();
        }
        if (tid < 384) CATB[(size_t)row * DM + g * 384 + tid] = (bf16_t)f2bf(oacc[tid]);
    }
}
constexpr size_t KVB_T = (size_t)BP * 2 * SP * 64;
typedef short v4i16_t __attribute__((ext_vector_type(4)));
typedef short bf16x8_t __attribute__((ext_vector_type(8)));
typedef float f32x4_t __attribute__((ext_vector_type(4)));
typedef unsigned u32x4_t __attribute__((ext_vector_type(4)));
__device__ __forceinline__ bf16x8_t ldtr2(const LAS unsigned char* p0, const LAS unsigned char* p1) {
    const v4i16_t a = __builtin_amdgcn_ds_read_tr16_b64_v4i16((LAS v4i16_t*)p0), b = __builtin_amdgcn_ds_read_tr16_b64_v4i16((LAS v4i16_t*)p1);
    return __builtin_shufflevector(a, b, 0, 1, 2, 3, 4, 5, 6, 7);
}
__device__ __forceinline__ unsigned cvtpk(float lo, float hi) { unsigned r; asm volatile("v_cvt_pk_bf16_f32 %0, %1, %2" : "=v"(r) : "v"(lo), "v"(hi)); return r; }
__device__ __forceinline__ bf16x8_t pack8(f32x4_t a, f32x4_t b) { uint4 w; w.x = cvtpk(a[0], a[1]); w.y = cvtpk(a[2], a[3]); w.z = cvtpk(b[0], b[1]); w.w = cvtpk(b[2], b[3]); return __builtin_bit_cast(bf16x8_t, w); }
__device__ __forceinline__ f32x4_t mfma16(bf16x8_t a, bf16x8_t b, f32x4_t c) { return __builtin_amdgcn_mfma_f32_16x16x32_bf16(a, b, c, 0, 0, 0); }
__device__ __forceinline__ float ex2(float x) { return __builtin_amdgcn_exp2f(x); }
__device__ __forceinline__ float xmax4(float x) {
    auto s = __builtin_amdgcn_permlane16_swap(__float_as_uint(x), __float_as_uint(x), false, false);
    x = fmaxf(__uint_as_float(s[0]), __uint_as_float(s[1]));
    auto t = __builtin_amdgcn_permlane32_swap(__float_as_uint(x), __float_as_uint(x), false, false);
    return fmaxf(__uint_as_float(t[0]), __uint_as_float(t[1]));
}
__device__ __forceinline__ float xsum4(float x) {
    auto s = __builtin_amdgcn_permlane16_swap(__float_as_uint(x), __float_as_uint(x), false, false);
    x = __uint_as_float(s[0]) + __uint_as_float(s[1]);
    auto t = __builtin_amdgcn_permlane32_swap(__float_as_uint(x), __float_as_uint(x), false, false);
    return __uint_as_float(t[0]) + __uint_as_float(t[1]);
}
constexpr float LOG2E = 1.4426950408889634f, NINF = -__builtin_inff();
constexpr int KROW = 144;

__device__ __forceinline__ void ph_nsa_fast(const Params& p, int j, LAS unsigned char* lds) {
    const int tid = ltid(), lane0 = tid & 63, w = tid >> 6;
    unsigned char* ws = p.ws;
    const bf16_t* P16 = (const bf16_t*)(ws + B_P16); const float* GT = (const float*)(ws + B_GT); bf16_t* CATB = (bf16_t*)(ws + B_CATB);
    const bf16_t* KVB = (const bf16_t*)(ws + B_KVB); const bf16_t* KC16 = (const bf16_t*)(ws + B_KC16);
    LAS unsigned char* Kw = lds;
    LAS unsigned char* Vw = lds + 18432;
    LAS unsigned char* Kc = lds + 36864;
    LAS unsigned char* Vc = lds + 55296;
    LAS float* biasT = (LAS float*)(lds + 73728);
    LAS float* impL = (LAS float*)(lds + 73728 + 3072);
    LAS int* selL = (LAS int*)(lds + 73728 + 3072 + 16384);
    const float* table = p.in[I_REL]; const float* gq = p.in[I_GQ] + j * 64; const float* bgate = p.in[I_BGATE] + j * 36;
    for (int unit = blockIdx.x; unit < 256; unit += gridDim.x) {
        int lane_a = lane0; asm volatile("" : "+v"(lane_a)); const int lane = lane_a, fr = lane & 15, fg = lane >> 4;
        const int g = unit & 1, b = (unit >> 1) & 7, tile = unit >> 4, t0 = tile * 128, tw = t0 + 16 * w, trow = tw + fr;
        TSUB_BEGIN();
        __syncthreads();
        for (int i = tid; i < 2048; i += NT_) { const int tsel = i >> 10, r = (i >> 3) & 127, ch = i & 7;
            const u32x4_t v = *(const u32x4_t*)(KC16 + (((size_t)b * 2 + tsel) * 2 + g) * 128 * 64 + r * 64 + ch * 8);
            *(LAS u32x4_t*)((tsel ? Vc : Kc) + r * KROW + ch * 16) = v; }
        for (int i = tid; i < 768; i += NT_) { const int d = i / 6, z = i % 6; biasT[i] = table[rel_bucket_alu(d) * 12 + g * 6 + z] * LOG2E; }
        if (tid < 64) ((LAS float*)(lds + 73728 + 3072 + 16384 + 4096))[tid] = gq[tid] * (0.125f * LOG2E);
        __syncthreads();
        const bf16_t* qrow = P16 + (size_t)(b * SP + trow) * LDB_ + g * 384;
        LAS float* gqL = (LAS float*)(lds + 73728 + 3072 + 16384 + 4096);
#define FETCH_Q(z_, ra_, rb_) do { ra_ = *(const uint4*)(qrow + (z_) * 64 + fg * 8); rb_ = *(const uint4*)(qrow + (z_) * 64 + 32 + fg * 8); } while (0)
#define LOAD_Q(z_, q0_, q1_) do { uint4 r0, r1; FETCH_Q(z_, r0, r1); FINISH_Q(r0, r1, q0_, q1_); } while (0)
#define FINISH_Q(r0, r1, q0_, q1_) do { \
            float v[16] = {bflo(r0.x), bfhi(r0.x), bflo(r0.y), bfhi(r0.y), bflo(r0.z), bfhi(r0.z), bflo(r0.w), bfhi(r0.w), bflo(r1.x), bfhi(r1.x), bflo(r1.y), bfhi(r1.y), bflo(r1.z), bfhi(r1.z), bflo(r1.w), bfhi(r1.w)}; \
            float ss = 0.f; _Pragma("unroll") for (int i = 0; i < 16; ++i) ss += v[i] * v[i]; \
            ss = xsum4(ss); const float rs = rsqrtf(ss * (1.0f / 64) + EPS); { const f32x4_t g0 = *(const LAS f32x4_t*)(gqL + fg * 8), g1 = *(const LAS f32x4_t*)(gqL + fg * 8 + 4), g2 = *(const LAS f32x4_t*)(gqL + 32 + fg * 8), g3 = *(const LAS f32x4_t*)(gqL + 32 + fg * 8 + 4); \
              _Pragma("unroll") for (int i = 0; i < 4; ++i) { v[i] *= rs * g0[i]; v[4 + i] *= rs * g1[i]; v[8 + i] *= rs * g2[i]; v[12 + i] *= rs * g3[i]; } } \
            q0_ = pack8((f32x4_t){v[0], v[1], v[2], v[3]}, (f32x4_t){v[4], v[5], v[6], v[7]}); q1_ = pack8((f32x4_t){v[8], v[9], v[10], v[11]}, (f32x4_t){v[12], v[13], v[14], v[15]}); } while (0)
        const float* gtrow = GT + (size_t)(b * SP + trow) * GTW;
#pragma unroll 1
        for (int hp = 0; hp < 2; ++hp) {
        bf16x8_t qf[3][2];
#pragma unroll
        for (int z = 0; z < 3; ++z) LOAD_Q(hp * 3 + z, qf[z][0], qf[z][1]);
        f32x4_t O[3][4]; float mrun[3], lrun[3];
#pragma unroll
        for (int z = 0; z < 3; ++z) { mrun[z] = NINF; lrun[z] = 0.f;
#pragma unroll
            for (int dt = 0; dt < 4; ++dt) O[z][dt] = (f32x4_t){0.f, 0.f, 0.f, 0.f}; }
        const bf16_t* WK = KVB + 4 * KVB_T + ((size_t)b * 2 + g) * SP * 64; const bf16_t* WV = KVB + 5 * KVB_T + ((size_t)b * 2 + g) * SP * 64;
        u32x4_t rst[4];
#define WIN_LOAD(it_) do { const int k128_ = t0 - 512 + 128 * (it_); _Pragma("unroll") for (int q_ = 0; q_ < 4; ++q_) { const int i_ = tid + NT_ * q_, tsel_ = i_ >> 10, r_ = (i_ >> 3) & 127, ch_ = i_ & 7; const int tok_ = k128_ + r_; \
            rst[q_] = (u32x4_t){0u, 0u, 0u, 0u}; if (tok_ >= 0) rst[q_] = *(const u32x4_t*)((tsel_ ? WV : WK) + (size_t)tok_ * 64 + ch_ * 8); } } while (0)
#define WIN_STORE() do { _Pragma("unroll") for (int q_ = 0; q_ < 4; ++q_) { const int i_ = tid + NT_ * q_, tsel_ = i_ >> 10, r_ = (i_ >> 3) & 127, ch_ = i_ & 7; *(LAS u32x4_t*)((tsel_ ? Vw : Kw) + r_ * KROW + ch_ * 16) = rst[q_]; } } while (0)
        WIN_LOAD(0);
        __syncthreads();
        WIN_STORE();
#pragma unroll 1
        for (int it = 0; it < 5; ++it) {
            const int k128 = t0 - 512 + 128 * it;
            BAR_LDS();
            if (it + 1 < 5) WIN_LOAD(it + 1);
#pragma unroll 1
            for (int sc = 0; sc < 4; ++sc) {
                const int kb = k128 + 32 * sc;
                if (kb > tw + 15 || kb + 31 < tw - 511 || kb + 31 < 0) continue;
                const bool fast = (kb + 31 <= tw - 113) && (kb >= tw + 15 - 511) && kb >= 0;
                bf16x8_t kf[2][2], vf[4];
#pragma unroll
                for (int nt = 0; nt < 2; ++nt)
#pragma unroll
                    for (int ks = 0; ks < 2; ++ks) kf[nt][ks] = *(const LAS bf16x8_t*)(Kw + (32 * sc + 16 * nt + fr) * KROW + (ks * 32 + fg * 8) * 2);
#pragma unroll
                for (int dt = 0; dt < 4; ++dt) { const LAS unsigned char* vp = Vw + (32 * sc + 4 * fg + (fr >> 2)) * KROW + (16 * dt + 4 * (fr & 3)) * 2; vf[dt] = ldtr2(vp, vp + 16 * KROW); }
#pragma unroll
                for (int z = 0; z < 3; ++z) {
                    f32x4_t s0 = (f32x4_t){0.f, 0.f, 0.f, 0.f}, s1 = s0;
                    s0 = mfma16(kf[0][0], qf[z][0], s0); s0 = mfma16(kf[0][1], qf[z][1], s0);
                    s1 = mfma16(kf[1][0], qf[z][0], s1); s1 = mfma16(kf[1][1], qf[z][1], s1);
                    if (fast) { const float cb = biasT[127 * 6 + hp * 3 + z]; s0 = s0 + cb; s1 = s1 + cb; }
                    else {
#pragma unroll
                        for (int jj = 0; jj < 4; ++jj) { const int key0 = kb + 4 * fg + jj, d0 = trow - key0, d1 = d0 - 16;
                            s0[jj] = (d0 >= 0 && d0 < 512 && key0 >= 0) ? s0[jj] + biasT[min(d0, 127) * 6 + hp * 3 + z] : NINF;
                            s1[jj] = (d1 >= 0 && d1 < 512 && key0 + 16 >= 0) ? s1[jj] + biasT[min(d1, 127) * 6 + hp * 3 + z] : NINF; }
                    }
                    float mx = fmaxf(fmaxf(fmaxf(s0[0], s0[1]), fmaxf(s0[2], s0[3])), fmaxf(fmaxf(s1[0], s1[1]), fmaxf(s1[2], s1[3])));
                    mx = xmax4(mx);
                    float msafe;
                    if (__any(mx > mrun[z] + 8.f)) {
                        const float mnew = fmaxf(mrun[z], mx); msafe = mnew == NINF ? 0.f : mnew;
                        const float alpha = ex2(mrun[z] - msafe);
                        mrun[z] = mnew; lrun[z] = lrun[z] * alpha;
#pragma unroll
                        for (int dt = 0; dt < 4; ++dt) O[z][dt] = O[z][dt] * alpha;
                    } else msafe = mrun[z] == NINF ? 0.f : mrun[z];
                    f32x4_t p0, p1;
#pragma unroll
                    for (int jj = 0; jj < 4; ++jj) { p0[jj] = ex2(s0[jj] - msafe); p1[jj] = ex2(s1[jj] - msafe); }
                    lrun[z] = lrun[z] + (((p0[0] + p0[1]) + (p0[2] + p0[3])) + ((p1[0] + p1[1]) + (p1[2] + p1[3])));
                    const bf16x8_t pf = pack8(p0, p1);
#pragma unroll
                    for (int dt = 0; dt < 4; ++dt) O[z][dt] = mfma16(vf[dt], pf, O[z][dt]);
                }
            }
            if (it + 1 < 5) { BAR_LDS(); WIN_STORE(); }
        }
#undef WIN_LOAD
#undef WIN_STORE
#pragma unroll
        for (int z = 0; z < 3; ++z) { const int hz2 = hp * 3 + z; const float lt = xsum4(lrun[z]); const float gw = sigmoidf_(gtrow[24 + g * 6 + hz2] + bgate[24 + g * 6 + hz2]); const float sc = gw / lt;
            bf16_t* orow = CATB + (size_t)(b * SP + trow) * DM + (g * 6 + hz2) * 64;
#pragma unroll
            for (int dt = 0; dt < 4; ++dt) { const f32x4_t v = O[z][dt] * sc; *(uint2*)(orow + 16 * dt + 4 * fg) = make_uint2(cvtpk(v[0], v[1]), cvtpk(v[2], v[3])); } }
        }
        asm volatile("s_waitcnt vmcnt(0)" ::: "memory");
        TSUB_END(0);
        float impacc[8];
#pragma unroll
        for (int nt = 0; nt < 8; ++nt) impacc[nt] = 0.f;
        const int nmax = trow >= 31 ? (trow - 31) >> 4 : -1;
        uint4 rqa_c, rqb_c; FETCH_Q(0, rqa_c, rqb_c);
#pragma unroll 1
        for (int z = 0; z < 6; ++z) {
            bf16_t* orow = CATB + (size_t)(b * SP + trow) * DM + (g * 6 + z) * 64; unsigned long long oldc[4];
#pragma unroll
            for (int dt = 0; dt < 4; ++dt) oldc[dt] = __hip_atomic_load((unsigned long long*)(orow + 16 * dt + 4 * fg), __ATOMIC_RELAXED, __HIP_MEMORY_SCOPE_AGENT);
            const float gcraw = gtrow[g * 6 + z];
            f32x4_t s[8]; bf16x8_t qz[2]; { const uint4 ra = rqa_c, rb = rqb_c; if (z + 1 < 6) FETCH_Q(z + 1, rqa_c, rqb_c); FINISH_Q(ra, rb, qz[0], qz[1]); }
#pragma unroll
            for (int nt = 0; nt < 8; ++nt) { s[nt] = (f32x4_t){0.f, 0.f, 0.f, 0.f};
#pragma unroll
                for (int ks = 0; ks < 2; ++ks) { const bf16x8_t kf = *(const LAS bf16x8_t*)(Kc + (16 * nt + fr) * KROW + (ks * 32 + fg * 8) * 2); s[nt] = mfma16(kf, qz[ks], s[nt]); } }
            float mx = NINF;
#pragma unroll
            for (int nt = 0; nt < 8; ++nt)
#pragma unroll
                for (int jj = 0; jj < 4; ++jj) { const int n = 16 * nt + 4 * fg + jj; const int dist = trow - 16 * n - 31;
                    const float v = (n <= nmax && n <= 126) ? s[nt][jj] + biasT[min(dist, 127) * 6 + z] : NINF; s[nt][jj] = v; mx = fmaxf(mx, v); }
            asm volatile("" ::: "memory");
            mx = xmax4(mx); const float msafe = mx == NINF ? 0.f : mx; float sum = 0.f;
#pragma unroll
            for (int nt = 0; nt < 8; ++nt)
#pragma unroll
                for (int jj = 0; jj < 4; ++jj) { const float e = ex2(s[nt][jj] - msafe); s[nt][jj] = e; sum += e; }
            sum = xsum4(sum); const float inv = sum > 0.f ? 1.0f / sum : 0.f;
            float p3prev = 0.f;
#pragma unroll
            for (int nt = 0; nt < 8; ++nt) { s[nt] = s[nt] * inv;
                const float p3 = s[nt][3]; const float up = __shfl(p3, (lane + 48) & 63);
                const float prev_tile = __shfl(p3prev, (lane + 48) & 63);
                impacc[nt] += 2.0f * (s[nt][0] + s[nt][1] + s[nt][2]) + p3 + (fg == 0 ? prev_tile : up);
                p3prev = p3; }
            f32x4_t oc[4];
#pragma unroll
            for (int dt = 0; dt < 4; ++dt) oc[dt] = (f32x4_t){0.f, 0.f, 0.f, 0.f};
#pragma unroll
            for (int c2 = 0; c2 < 4; ++c2) { const bf16x8_t pf = pack8(s[2 * c2], s[2 * c2 + 1]);
#pragma unroll
                for (int dt = 0; dt < 4; ++dt) { const LAS unsigned char* vp = Vc + (32 * c2 + 4 * fg + (fr >> 2)) * KROW + (16 * dt + 4 * (fr & 3)) * 2; oc[dt] = mfma16(ldtr2(vp, vp + 16 * KROW), pf, oc[dt]); }
                asm volatile("" ::: "memory"); }
            const float gc = sigmoidf_(gcraw + bgate[g * 6 + z]);
#pragma unroll
            for (int dt = 0; dt < 4; ++dt) { const unsigned long long o64 = oldc[dt];
                const f32x4_t v = oc[dt] * gc + (f32x4_t){bflo((unsigned)o64), bfhi((unsigned)o64), bflo((unsigned)(o64 >> 32)), bfhi((unsigned)(o64 >> 32))};
                *(uint2*)(orow + 16 * dt + 4 * fg) = make_uint2(cvtpk(v[0], v[1]), cvtpk(v[2], v[3])); }
        }
        TSUB_END(1);
#pragma unroll
        for (int nt = 0; nt < 8; ++nt) impL[(w * 16 + fr) * 32 + 4 * nt + fg] = impacc[nt];
        asm volatile("s_waitcnt lgkmcnt(0)" ::: "memory");
        if (lane < 16) {
            const int t = tw + lane, cur = t >> 6; LAS int* so = selL + (w * 16 + lane) * 8; const LAS float* im = impL + (w * 16 + lane) * 32;
            int cnt = 0;
            if (cur + 1 <= 8) { for (int jb = 0; jb <= cur; ++jb) so[cnt++] = jb; }
            else {
                so[1] = 0; so[3] = cur; so[5] = cur - 1; unsigned taken = 0u;
                for (int k = 0; k < 5; ++k) { int best = -1; float bv = -1.f;
                    for (int jb = 1; jb <= cur - 2; ++jb) { const float v = im[jb]; if (!((taken >> jb) & 1u) && v > bv) { bv = v; best = jb; } }
                    taken |= 1u << best; so[k < 3 ? 2 * k : 3 + k] = best; }
                cnt = 8; }
            for (; cnt < 8; ++cnt) so[cnt] = -1;
        }
        asm volatile("s_waitcnt vmcnt(0) lgkmcnt(0)" ::: "memory");
        const bf16_t* SKF = (const bf16_t*)(ws + B_SKF) + ((size_t)b * 2 + g) * 32 * 4096; const bf16_t* SVF = (const bf16_t*)(ws + B_SVF) + ((size_t)b * 2 + g) * 32 * 4096;
        const int c0 = 2 * tile;
        TSUB_END(2);
        __syncthreads();
        for (int i = tid; i < 4 * 1024; i += NT_) { const int slot = i >> 10, r = i & 1023; const int blk = slot == 0 ? 0 : c0 - 2 + slot;
            if (blk >= 0 && blk < 32) { const u32x4_t v = *(const u32x4_t*)((r < 512 ? SKF : SVF) + (size_t)blk * 4096 + (r & 511) * 8); *(LAS u32x4_t*)(lds + slot * 16384 + r * 16) = v; } }
        __syncthreads();
        { int lane_b = lane0; asm volatile("" : "+v"(lane_b)); const int lane = lane_b, fr = lane & 15, fg = lane >> 4;
        const int hz = fr < 6 ? fr : 5;
        uint4 rqa, rqb;
        { const bf16_t* qrow = P16 + ((size_t)b * SP + tw) * LDB_ + g * 384 + hz * 64; rqa = *(const uint4*)(qrow + fg * 8); rqb = *(const uint4*)(qrow + 32 + fg * 8); }
#pragma unroll 1
        for (int ti = 0; ti < 16; ++ti) {
            const int t = tw + ti; const size_t row = (size_t)b * SP + t;
            bf16x8_t qs[2];
            const uint4 r0 = rqa, r1 = rqb;
            if (ti + 1 < 16) { const bf16_t* qrow = P16 + (row + 1) * LDB_ + g * 384 + hz * 64; rqa = *(const uint4*)(qrow + fg * 8); rqb = *(const uint4*)(qrow + 32 + fg * 8); }
            bf16_t* orow = CATB + row * DM + (g * 6 + hz) * 64; unsigned long long oldv[4];
#pragma unroll
            for (int dt = 0; dt < 4; ++dt) oldv[dt] = __hip_atomic_load((unsigned long long*)(orow + 16 * dt + 4 * fg), __ATOMIC_RELAXED, __HIP_MEMORY_SCOPE_AGENT);
            const float graw = GT[row * GTW + 12 + g * 6 + hz];
            {
              float v[16] = {bflo(r0.x), bfhi(r0.x), bflo(r0.y), bfhi(r0.y), bflo(r0.z), bfhi(r0.z), bflo(r0.w), bfhi(r0.w), bflo(r1.x), bfhi(r1.x), bflo(r1.y), bfhi(r1.y), bflo(r1.z), bfhi(r1.z), bflo(r1.w), bfhi(r1.w)};
              float ss = 0.f;
#pragma unroll
              for (int i = 0; i < 16; ++i) ss += v[i] * v[i];
              ss = xsum4(ss); const float rs = rsqrtf(ss * (1.0f / 64) + EPS) * (0.125f * LOG2E);
#pragma unroll
              for (int i = 0; i < 8; ++i) { v[i] *= rs * gq[fg * 8 + i]; v[8 + i] *= rs * gq[32 + fg * 8 + i]; }
              qs[0] = pack8((f32x4_t){v[0], v[1], v[2], v[3]}, (f32x4_t){v[4], v[5], v[6], v[7]});
              qs[1] = pack8((f32x4_t){v[8], v[9], v[10], v[11]}, (f32x4_t){v[12], v[13], v[14], v[15]}); }
            f32x4_t os[4]; float ms = NINF, ls = 0.f;
#pragma unroll
            for (int dt = 0; dt < 4; ++dt) os[dt] = (f32x4_t){0.f, 0.f, 0.f, 0.f};
#define SLC_LOADK(KF, blk_) do { const int slot_ = (blk_) == 0 ? 0 : ((blk_) >= c0 - 1 ? (blk_) - c0 + 2 : -1); \
                if (slot_ >= 0) { const LAS unsigned char* fb_ = lds + slot_ * 16384 + lane * 16; \
                    _Pragma("unroll") for (int nt = 0; nt < 4; ++nt) _Pragma("unroll") for (int ks = 0; ks < 2; ++ks) KF[nt][ks] = *(const LAS bf16x8_t*)(fb_ + (nt * 2 + ks) * 1024); \
                } else { const bf16_t* kb_ = SKF + (size_t)(blk_) * 4096 + lane * 8; \
                    _Pragma("unroll") for (int nt = 0; nt < 4; ++nt) _Pragma("unroll") for (int ks = 0; ks < 2; ++ks) KF[nt][ks] = *(const bf16x8_t*)(kb_ + (nt * 2 + ks) * 512); } } while (0)
#define SLC_LOADV(VF, blk_) do { const int slot_ = (blk_) == 0 ? 0 : ((blk_) >= c0 - 1 ? (blk_) - c0 + 2 : -1); \
                if (slot_ >= 0) { const LAS unsigned char* fb_ = lds + slot_ * 16384 + lane * 16; \
                    _Pragma("unroll") for (int dt = 0; dt < 4; ++dt) _Pragma("unroll") for (int cs = 0; cs < 2; ++cs) VF[dt][cs] = *(const LAS bf16x8_t*)(fb_ + 8192 + (dt * 2 + cs) * 1024); \
                } else { const bf16_t* vb_ = SVF + (size_t)(blk_) * 4096 + lane * 8; \
                    _Pragma("unroll") for (int dt = 0; dt < 4; ++dt) _Pragma("unroll") for (int cs = 0; cs < 2; ++cs) VF[dt][cs] = *(const bf16x8_t*)(vb_ + (dt * 2 + cs) * 512); } } while (0)
#define SLC_COMPUTE(KF, VF, blk_, nblk_) do { const int tok0 = (blk_) * 64; f32x4_t s[4]; \
                _Pragma("unroll") for (int nt = 0; nt < 4; ++nt) { s[nt] = (f32x4_t){0.f, 0.f, 0.f, 0.f}; s[nt] = mfma16(KF[nt][0], qs[0], s[nt]); s[nt] = mfma16(KF[nt][1], qs[1], s[nt]); } \
                float mx = NINF; \
                if (tok0 + 63 <= t - 113) { const float cb = biasT[127 * 6 + hz]; \
                    _Pragma("unroll") for (int nt = 0; nt < 4; ++nt) { s[nt] = s[nt] + cb; mx = fmaxf(mx, fmaxf(fmaxf(s[nt][0], s[nt][1]), fmaxf(s[nt][2], s[nt][3]))); } } \
                else { _Pragma("unroll") for (int nt = 0; nt < 4; ++nt) _Pragma("unroll") for (int jj = 0; jj < 4; ++jj) { const int dist = t - (tok0 + 16 * nt + 4 * fg + jj); const float v = dist >= 0 ? s[nt][jj] + biasT[min(dist, 127) * 6 + hz] : NINF; s[nt][jj] = v; mx = fmaxf(mx, v); } } \
                mx = xmax4(mx); \
                float msafe; \
                if (__any(mx > ms + 8.f)) { const float mnew = fmaxf(ms, mx); msafe = mnew == NINF ? 0.f : mnew; const float alpha = ex2(ms - msafe); ms = mnew; ls = ls * alpha; \
                    _Pragma("unroll") for (int dt = 0; dt < 4; ++dt) os[dt] = os[dt] * alpha; } \
                else msafe = ms == NINF ? 0.f : ms; \
                float sum = 0.f; \
                _Pragma("unroll") for (int nt = 0; nt < 4; ++nt) _Pragma("unroll") for (int jj = 0; jj < 4; ++jj) { const float e = ex2(s[nt][jj] - msafe); s[nt][jj] = e; sum += e; } \
                ls = ls + sum; \
                _Pragma("unroll") for (int cs = 0; cs < 2; ++cs) { const bf16x8_t pf = pack8(s[2 * cs], s[2 * cs + 1]); \
                    _Pragma("unroll") for (int dt = 0; dt < 4; ++dt) os[dt] = mfma16(VF[dt][cs], pf, os[dt]); } \
                if ((nblk_) >= 0) SLC_LOADV(VF, nblk_); } while (0)
            const LAS int* sbl = selL + (w * 16 + ti) * 8; int nb = 0;
#pragma unroll
            for (int bi = 0; bi < 8; ++bi) nb += sbl[bi] >= 0 ? 1 : 0;
            bf16x8_t kfC[4][2], kfN[4][2], vfX[4][2];
            { const int b0 = sbl[0]; SLC_LOADK(kfN, b0); SLC_LOADV(vfX, b0); }
#pragma unroll 1
            for (int bi = 0; bi < nb; ++bi) {
                const int bA = sbl[bi], bB = bi + 1 < nb ? sbl[bi + 1] : -1;
#pragma unroll
                for (int nt = 0; nt < 4; ++nt) { kfC[nt][0] = kfN[nt][0]; kfC[nt][1] = kfN[nt][1]; }
                if (bB >= 0) SLC_LOADK(kfN, bB);
                SLC_COMPUTE(kfC, vfX, bA, bB);
            }
#undef SLC_LOADK
#undef SLC_LOADV
#undef SLC_COMPUTE
            const float lt = xsum4(ls);
            if (fr < 6) {
                const float gs = sigmoidf_(graw + bgate[12 + g * 6 + fr]); const float sc = lt > 0.f ? gs / lt : 0.f;
#pragma unroll
                for (int dt = 0; dt < 4; ++dt) { const unsigned long long o64 = oldv[dt]; const f32x4_t v = os[dt] * sc + (f32x4_t){bflo((unsigned)o64), bfhi((unsigned)o64), bflo((unsigned)(o64 >> 32)), bfhi((unsigned)(o64 >> 32))};
                    *(uint2*)(orow + 16 * dt + 4 * fg) = make_uint2(cvtpk(v[0], v[1]), cvtpk(v[2], v[3])); }
            }
        }
        }
        TSUB_END(3);
    }
}

constexpr int CW_P = 272, CW_BUF = 128 * CW_P;
template <bool SMP> __device__ __forceinline__ void compress_job(const Params& p, int bb, int c, int g, LAS unsigned char* lds) {
    const int tid = ltid(), lane = tid & 63, w = tid >> 6, fr = lane & 15, fg = lane >> 4, n = 16 * w + fr;
    unsigned char* ws = p.ws;
    const bf16_t* W1T = (const bf16_t*)(ws + B_W1T) + (size_t)c * 128 * 2048; const bf16_t* W2T = (const bf16_t*)(ws + B_W2T) + (size_t)c * 64 * 128;
    f32x4_t acc[8];
#pragma unroll
    for (int t = 0; t < 8; ++t) acc[t] = (f32x4_t){0.f, 0.f, 0.f, 0.f};
    const bf16_t* ap = (const bf16_t*)(ws + B_KVB) + (size_t)c * KVB_T + ((size_t)(SMP ? 0 : bb) * 2 + g) * SP * 64 + (size_t)n * 1024 + fg * 8;
    const float* pg0 = nullptr; const float* pg1 = nullptr; int tsplit = 0;
    if (SMP) { const int* pt = (const int*)p.in[I_PT] + (bb - 8) * 16; const int t0 = 16 * n > 2016 ? 2016 : 16 * n; const int pa = t0 >> 7, pb = (t0 + 31) >> 7;
        pg0 = p.in[I_CCMP] + (((size_t)pt[pa] * 128 + (t0 & 127)) * 4 + c * 2 + g) * 64 + fg * 8; tsplit = pb == pa ? 64 : 128 - (t0 & 127);
        pg1 = p.in[I_CCMP] + (((size_t)pt[pb] * 128) * 4 + c * 2 + g) * 64 + fg * 8 - (size_t)tsplit * 256; }
    u32x4_t rb[4]; bf16x8_t acur[4]; f32x4_t araw[SMP ? 8 : 1]; bf16x8_t anext[SMP ? 1 : 4];
#define CW_LOADB(st_) do { _Pragma("unroll") for (int i_ = 0; i_ < 4; ++i_) { const int ch_ = tid + NT_ * i_, r_ = ch_ >> 4, cc_ = ch_ & 15; rb[i_] = *(const u32x4_t*)(W1T + (size_t)r_ * 2048 + (st_) * 128 + cc_ * 8); } } while (0)
#define CW_STOREB(buf_) do { _Pragma("unroll") for (int i_ = 0; i_ < 4; ++i_) { const int ch_ = tid + NT_ * i_, r_ = ch_ >> 4, cc_ = ch_ & 15; *(LAS u32x4_t*)(lds + (buf_) * CW_BUF + r_ * CW_P + cc_ * 16) = rb[i_]; } } while (0)
#define CW_LOADA(st_) do { _Pragma("unroll") for (int u_ = 0; u_ < 4; ++u_) { const int s_ = (st_) * 4 + u_; \
        if (SMP) { const int tk_ = s_ >> 1; const float* src_ = (tk_ < tsplit ? pg0 : pg1) + (size_t)tk_ * 256 + (s_ & 1) * 32; araw[2 * u_] = *(const f32x4_t*)src_; araw[2 * u_ + 1] = *(const f32x4_t*)(src_ + 4); } \
        else anext[u_] = *(const bf16x8_t*)(ap + s_ * 32); } } while (0)
#define CW_TAKEA() do { _Pragma("unroll") for (int u_ = 0; u_ < 4; ++u_) { if (SMP) acur[u_] = pack8(araw[2 * u_], araw[2 * u_ + 1]); else acur[u_] = anext[u_]; } } while (0)
    __syncthreads();
    CW_LOADB(0); CW_LOADA(0); CW_STOREB(0); CW_TAKEA();
    BAR_LDS();
#pragma unroll 1
    for (int st = 0; st < 16; ++st) {
        if (st + 1 < 16) { CW_LOADB(st + 1); CW_LOADA(st + 1); }
        const LAS unsigned char* bb_ = lds + (st & 1) * CW_BUF + fr * CW_P + fg * 16;
#pragma unroll
        for (int u = 0; u < 4; ++u)
#pragma unroll
            for (int t = 0; t < 8; ++t) acc[t] = mfma16(*(const LAS bf16x8_t*)(bb_ + t * 16 * CW_P + u * 64), acur[u], acc[t]);
        if (st + 1 < 16) { CW_STOREB((st + 1) & 1); CW_TAKEA(); }
        BAR_LDS();
    }
#undef CW_LOADB
#undef CW_STOREB
#undef CW_LOADA
#undef CW_TAKEA
    const float* peb = (const float*)(ws + B_PEB) + c * 128;
#pragma unroll
    for (int t = 0; t < 8; ++t) { const f32x4_t pb = *(const f32x4_t*)(peb + 16 * t + 4 * fg);
#pragma unroll
        for (int j = 0; j < 4; ++j) { const float x = acc[t][j] + pb[j]; const float u2 = 1.5957691216057308f * (x + 0.044715f * x * x * x);
            const float th = 1.0f - 2.0f * __builtin_amdgcn_rcpf(1.0f + ex2(u2 * LOG2E)); acc[t][j] = 0.5f * x * (1.0f + th); } }
    f32x4_t o[4];
#pragma unroll
    for (int dt = 0; dt < 4; ++dt) o[dt] = (f32x4_t){0.f, 0.f, 0.f, 0.f};
#pragma unroll
    for (int ks = 0; ks < 4; ++ks) { const bf16x8_t gf = pack8(acc[2 * ks], acc[2 * ks + 1]);
#pragma unroll
        for (int dt = 0; dt < 4; ++dt) { const bf16_t* wp = W2T + (size_t)(16 * dt + fr) * 128 + 32 * ks + 4 * fg; const uint2 x0 = *(const uint2*)wp, x1 = *(const uint2*)(wp + 16);
            o[dt] = mfma16(__builtin_bit_cast(bf16x8_t, make_uint4(x0.x, x0.y, x1.x, x1.y)), gf, o[dt]); } }
    float ss = 0.f;
#pragma unroll
    for (int dt = 0; dt < 4; ++dt) { const f32x4_t b2 = *(const f32x4_t*)(p.in[I_CB2] + c * 64 + 16 * dt + 4 * fg); o[dt] = o[dt] + b2; ss += (o[dt][0] * o[dt][0] + o[dt][1] * o[dt][1]) + (o[dt][2] * o[dt][2] + o[dt][3] * o[dt][3]); }
    if (c == 0) { ss = xsum4(ss); const float rs = rsqrtf(ss * (1.0f / 64) + EPS);
#pragma unroll
        for (int dt = 0; dt < 4; ++dt) { const f32x4_t gk = *(const f32x4_t*)(p.in[I_GKCMP] + 16 * dt + 4 * fg); o[dt] = o[dt] * rs * gk; } }
    bf16_t* kc = (bf16_t*)(ws + B_KC16) + ((((size_t)bb * 2 + c) * 2 + g) * 128 + n) * 64;
    float* cf = (float*)(ws + (c == 0 ? B_CK : B_CV)) + ((size_t)bb * 127 + n) * 128 + g * 64;
#pragma unroll
    for (int dt = 0; dt < 4; ++dt) {
        if (n < 127) { *(f32x4_t*)(cf + 16 * dt + 4 * fg) = o[dt]; *(uint2*)(kc + 16 * dt + 4 * fg) = make_uint2(cvtpk(o[dt][0], o[dt][1]), cvtpk(o[dt][2], o[dt][3])); }
        else { unsigned z = 0u; asm volatile("" : "+v"(z)); *(uint2*)(kc + 16 * dt + 4 * fg) = make_uint2(z, z); }
    }
}
__device__ __forceinline__ void ph_compress_fast(const Params& p, LAS unsigned char* lds) {
    for (int job = blockIdx.x; job < 544; job += gridDim.x) { const int jj = job < 512 ? job + 32 : job - 512; const int bb = jj >> 2, c = (jj >> 1) & 1, g = jj & 1;
        if (bb < 8) compress_job<false>(p, bb, c, g, lds); else compress_job<true>(p, bb, c, g, lds); }
}
constexpr int ML_QP = 416, ML_VP = 80, ML_WP = 112;
__device__ __forceinline__ void ph_mlstm_fast(const Params& p, int l, LAS unsigned char* lds) {
    const int tid = ltid(), lane = tid & 63, w = tid >> 6, fr = lane & 15, fg = lane >> 4;
    unsigned char* ws = p.ws;
    const bf16_t* P16 = (const bf16_t*)(ws + B_P16); const float* GT = (const float*)(ws + B_GT); const float* bif = p.in[I_BIF] + l * 8; float* HR = (float*)(ws + B_HRAW);
    LAS unsigned char* Ql = lds;
    LAS unsigned char* Kl = lds + 26624;
    LAS unsigned char* Vl = lds + 53248;
    LAS unsigned char* Wl = lds + 58368;
    LAS unsigned char* CT = lds + 65536;
    LAS float* INTER = (LAS float*)(lds + 85504);
    LAS float* QN = (LAS float*)(lds + 94720);
    LAS float* RTa = (LAS float*)(lds + 94976);
    LAS float* WSa = RTa + 2048;
    LAS float* EIa = RTa + 4096;
    LAS float* DEC = RTa + 6144;
    LAS float* Gk = DEC + 32; LAS float* Ak = DEC + 64; LAS float* MPk = DEC + 96;
    for (int unit = blockIdx.x; unit < 192; unit += gridDim.x) {
        const int xy_ = unit >> 3, bh_ = (unit & 7) + 8 * (xy_ / 6);
        const int es = xy_ % 6, h = bh_ & 3, b = bh_ >> 2;
        const size_t row0 = (size_t)b * SP;
        __syncthreads();
        for (int i = tid; i < 48 * (ML_QP / 4); i += NT_) ((LAS unsigned*)CT)[i] = 0u;
        for (int i = tid; i < 64 * 28; i += NT_) ((LAS unsigned*)Wl)[i] = 0u;
        float gia[4], gfa[4];
#pragma unroll
        for (int q = 0; q < 4; ++q) { const float* g_ = GT + (row0 + 64 * (w + 8 * q) + lane) * GTW; gia[q] = g_[h]; gfa[q] = g_[4 + h]; }
#pragma unroll
        for (int q = 0; q < 4; ++q) { const int k = w + 8 * q; const float gi = gia[q] + bif[h], gf = gfa[q] + bif[4 + h];
            float bc = logsigmoidf_(gf);
#pragma unroll
            for (int o = 1; o < 64; o <<= 1) { const float t = __shfl_up(bc, o); if (lane >= o) bc += t; }
            const float u = gi - bc; float pm = u;
#pragma unroll
            for (int o = 1; o < 64; o <<= 1) { const float t = __shfl_up(pm, o); if (lane >= o) pm = fmaxf(pm, t); }
            EIa[k * 64 + lane] = bc; RTa[k * 64 + lane] = pm; WSa[k * 64 + lane] = u;
            if (lane == 63) { Gk[k] = bc; Ak[k] = pm; } }
        __syncthreads();
        if (tid == 0) { float m = NEGM; for (int k = 0; k < 32; ++k) { MPk[k] = m; m = Gk[k] + fmaxf(Ak[k], m); } MPk[32] = m; }
        __syncthreads();
#pragma unroll 1
        for (int k = w; k < 32; k += 8) { const float mp = MPk[k], M63 = fmaxf(Ak[k], mp); const float bc = EIa[k * 64 + lane], pm = RTa[k * 64 + lane], u = WSa[k * 64 + lane]; const float M = fmaxf(pm, mp);
            RTa[k * 64 + lane] = expf(M63 - M); WSa[k * 64 + lane] = expf(u - M63); EIa[k * 64 + lane] = expf(-(bc + M)); if (lane == 0) DEC[k] = expf(mp - M63); }
        f32x4_t cacc[5];
#pragma unroll
        for (int i = 0; i < 5; ++i) cacc[i] = (f32x4_t){0.f, 0.f, 0.f, 0.f};
        u32x4_t rq[3], rk[3], rv;
#define ML_LOAD(c_) do { const size_t rb_ = row0 + 64 * (c_); \
            _Pragma("unroll") for (int i_ = 0; i_ < 3; ++i_) { const int ch_ = tid + NT_ * i_, r_ = ch_ / 24, cc_ = ch_ % 24; const bf16_t* src_ = P16 + (rb_ + r_) * LDA_ + h * 192 + cc_ * 8; rq[i_] = *(const u32x4_t*)src_; rk[i_] = *(const u32x4_t*)(src_ + 768); } \
            if (tid < 256) { const int r_ = tid >> 2, cc_ = tid & 3; rv = *(const u32x4_t*)(P16 + (rb_ + r_) * LDA_ + 1536 + h * 192 + es * 32 + cc_ * 8); } } while (0)
#define ML_STORE(c_) do { \
            _Pragma("unroll") for (int i_ = 0; i_ < 3; ++i_) { const int ch_ = tid + NT_ * i_, r_ = ch_ / 24, cc_ = ch_ % 24; *(LAS u32x4_t*)(Ql + r_ * ML_QP + cc_ * 16) = rq[i_]; *(LAS u32x4_t*)(Kl + r_ * ML_QP + cc_ * 16) = rk[i_]; } \
            if (tid < 256) { const int r_ = tid >> 2, cc_ = tid & 3; *(LAS u32x4_t*)(Vl + r_ * ML_VP + cc_ * 16) = rv; const float wv_ = WSa[(c_) * 64 + r_]; \
                u32x4_t y_; y_.x = cvtpk(bflo(rv.x) * wv_, bfhi(rv.x) * wv_); y_.y = cvtpk(bflo(rv.y) * wv_, bfhi(rv.y) * wv_); y_.z = cvtpk(bflo(rv.z) * wv_, bfhi(rv.z) * wv_); y_.w = cvtpk(bflo(rv.w) * wv_, bfhi(rv.w) * wv_); \
                *(LAS u32x4_t*)(Wl + r_ * ML_WP + cc_ * 16) = y_; if (cc_ == 0) *(LAS bf16_t*)(Wl + r_ * ML_WP + 64) = (bf16_t)f2bf(wv_); } } while (0)
        ML_LOAD(0);
        __syncthreads();
        ML_STORE(0);
#pragma unroll 1
        for (int c = 0; c < 32; ++c) {
            BAR_LDS();
            if (c + 1 < 32) ML_LOAD(c + 1);
            f32x4_t hin[2]; float rsum = 0.f;
            hin[0] = (f32x4_t){0.f, 0.f, 0.f, 0.f}; hin[1] = hin[0];
            if (w < 4) {
                const int tt = w;
                f32x4_t S[4];
#pragma unroll
                for (int st = 0; st < 4; ++st) { S[st] = (f32x4_t){0.f, 0.f, 0.f, 0.f};
                    if (st <= tt) {
#pragma unroll
                        for (int ks = 0; ks < 6; ++ks) { const bf16x8_t kf = *(const LAS bf16x8_t*)(Kl + (16 * st + fr) * ML_QP + (32 * ks + 8 * fg) * 2), qf = *(const LAS bf16x8_t*)(Ql + (16 * tt + fr) * ML_QP + (32 * ks + 8 * fg) * 2);
                            S[st] = mfma16(kf, qf, S[st]); }
                        const f32x4_t wv = *(const LAS f32x4_t*)(WSa + c * 64 + 16 * st + 4 * fg); S[st] = S[st] * wv;
                        if (st == tt) {
#pragma unroll
                            for (int jj = 0; jj < 4; ++jj) if (4 * fg + jj > fr) S[st][jj] = 0.f; }
                        rsum += (S[st][0] + S[st][1]) + (S[st][2] + S[st][3]);
                    } }
                rsum = xsum4(rsum);
#pragma unroll
                for (int kk = 0; kk < 2; ++kk) { if (2 * kk <= tt) { const bf16x8_t pf = pack8(S[2 * kk], S[2 * kk + 1]);
#pragma unroll
                    for (int et = 0; et < 2; ++et) { const LAS unsigned char* vp = Vl + (32 * kk + 4 * fg + (fr >> 2)) * ML_VP + (16 * et + 4 * (fr & 3)) * 2; hin[et] = mfma16(ldtr2(vp, vp + 16 * ML_VP), pf, hin[et]); } } }
            } else {
                const int tt = w - 4;
                f32x4_t I[3];
#pragma unroll
                for (int e3 = 0; e3 < 3; ++e3) { I[e3] = (f32x4_t){0.f, 0.f, 0.f, 0.f};
#pragma unroll
                    for (int ks = 0; ks < 6; ++ks) { const bf16x8_t cf = *(const LAS bf16x8_t*)(CT + (16 * e3 + fr) * ML_QP + (32 * ks + 8 * fg) * 2), qf = *(const LAS bf16x8_t*)(Ql + (16 * tt + fr) * ML_QP + (32 * ks + 8 * fg) * 2);
                        I[e3] = mfma16(cf, qf, I[e3]); } }
                *(LAS f32x4_t*)(INTER + (16 * tt + fr) * 36 + 4 * fg) = I[0]; *(LAS f32x4_t*)(INTER + (16 * tt + fr) * 36 + 16 + 4 * fg) = I[1];
                if (fg == 0) QN[16 * tt + fr] = I[2][0];
            }
            BAR_LDS();
            const float decay = DEC[c];
            if (w < 4) {
                const int t = 16 * w + fr; const float r = RTa[c * 64 + t], einv = EIa[c * 64 + t], qn = QN[t];
                const float den = r * (rsum + decay * qn); const float inv = 1.0f / fmaxf(fabsf(den), einv);
                float* hp = HR + (row0 + 64 * c + t) * 768 + h * 192 + es * 32;
#pragma unroll
                for (int et = 0; et < 2; ++et) { const f32x4_t in2 = *(const LAS f32x4_t*)(INTER + t * 36 + 16 * et + 4 * fg); const f32x4_t num = (hin[et] + in2 * decay) * r; *(f32x4_t*)(hp + 16 * et + 4 * fg) = num * inv; }
            }
#pragma unroll
            for (int i = 0; i < 5; ++i) { const int idx = w + 8 * i; if (idx < 36) { const int dtile = idx / 3, et = idx % 3; cacc[i] = cacc[i] * decay;
#pragma unroll
                for (int ks = 0; ks < 2; ++ks) { const LAS unsigned char* kp = Kl + (32 * ks + 8 * fg + (fr >> 2)) * ML_QP + (16 * dtile + 4 * (fr & 3)) * 2; const LAS unsigned char* vp = Wl + (32 * ks + 8 * fg + (fr >> 2)) * ML_WP + (16 * et + 4 * (fr & 3)) * 2;
                    cacc[i] = mfma16(ldtr2(kp, kp + 4 * ML_QP), ldtr2(vp, vp + 4 * ML_WP), cacc[i]); } } }
            BAR_LDS();
#pragma unroll
            for (int i = 0; i < 5; ++i) { const int idx = w + 8 * i; if (idx < 36) { const int dtile = idx / 3, et = idx % 3;
                typedef unsigned u32x2_t __attribute__((ext_vector_type(2))); u32x2_t wv; wv.x = cvtpk(cacc[i][0], cacc[i][1]); wv.y = cvtpk(cacc[i][2], cacc[i][3]);
                *(LAS u32x2_t*)(CT + (16 * et + fr) * ML_QP + (16 * dtile + 4 * fg) * 2) = wv; } }
            if (c + 1 < 32) ML_STORE(c + 1);
        }
#pragma unroll
        for (int i = 0; i < 5; ++i) { const int idx = w + 8 * i; if (idx < 36) { const int dtile = idx / 3, et = idx % 3;
            if (et < 2) { float* co = p.out + O_PC + ((size_t)((l * 8 + b) * 4 + h) * 192 + 16 * dtile + 4 * fg) * 192 + es * 32 + 16 * et + fr;
#pragma unroll
                for (int jj = 0; jj < 4; ++jj) co[(size_t)jj * 192] = cacc[i][jj]; }
            else if (es == 0 && fr == 0) { float* no = p.out + O_PN + (size_t)((l * 8 + b) * 4 + h) * 192 + 16 * dtile + 4 * fg;
#pragma unroll
                for (int jj = 0; jj < 4; ++jj) no[jj] = cacc[i][jj]; } } }
        if (es == 0 && tid == 0) p.out[O_PM + (l * 8 + b) * 4 + h] = MPk[32];
#undef ML_LOAD
#undef ML_STORE
    }
}
__device__ __forceinline__ void ph_mem_attn_fast(const Params& p, int l, LAS unsigned char* lds, int u0, int ucnt, int ustep) {
    const int tid = ltid(), lane0 = tid & 63, w = tid >> 6;
    const int ldp = l < 2 ? LDA_ : LDB_, qoff = l < 2 ? 3072 : 768;
    const bf16_t* P16 = (const bf16_t*)(p.ws + B_P16); bf16_t* CATB = (bf16_t*)(p.ws + B_CATB); const float* gq = p.in[I_GMEMQ] + l * 64;
    LAS unsigned char* Km = lds;
    LAS unsigned char* Vm = lds + 36864;
    const float* gmk = p.in[I_GMEMK] + l * 64;
    int staged = -1;
    for (int ui = 0; ui < ucnt; ++ui) { const int unit = u0 + ui * ustep; if (unit >= 256) break;
        int lane_a = lane0; asm volatile("" : "+v"(lane_a)); const int lane = lane_a, fr = lane & 15, fg = lane >> 4;
        const int oct = unit & 7, hh = (unit >> 3) & 3, b = unit >> 5;
        const float* kv = (const float*)(p.ws + B_MEMR) + (size_t)(l * 8 + b) * 256 * 512 + hh * 64;
        uint4 qc0, qc1, qn0, qn1;
        { const bf16_t* qrow = P16 + ((size_t)b * SP + oct * 256 + w * 16 + fr) * ldp + qoff + hh * 64;
          qc0 = *(const uint4*)(qrow + fg * 8); qc1 = *(const uint4*)(qrow + 32 + fg * 8); qn0 = *(const uint4*)(qrow + (size_t)128 * ldp + fg * 8); qn1 = *(const uint4*)(qrow + (size_t)128 * ldp + 32 + fg * 8); }
        if ((unit >> 3) != staged) { staged = unit >> 3;
        __syncthreads();
        {
            f32x4_t x[16];
#pragma unroll
            for (int k = 0; k < 16; ++k) { const int i = tid + NT_ * k, tsel = i >> 12, m = (i >> 4) & 255, ch = i & 15; x[k] = *(const f32x4_t*)(kv + (size_t)m * 512 + tsel * 256 + ch * 4); }
#pragma unroll
            for (int k = 0; k < 16; ++k) { const int i = tid + NT_ * k, tsel = i >> 12, m = (i >> 4) & 255, ch = i & 15;
                if (k < 8) { float ss = (x[k][0] * x[k][0] + x[k][1] * x[k][1]) + (x[k][2] * x[k][2] + x[k][3] * x[k][3]);
                    ss += __shfl_xor(ss, 1); ss += __shfl_xor(ss, 2); ss += __shfl_xor(ss, 4); ss += __shfl_xor(ss, 8);
                    const float rs = rsqrtf(ss * (1.0f / 64) + EPS); const f32x4_t gk = *(const f32x4_t*)(gmk + ch * 4); x[k] = x[k] * rs * gk; }
                typedef unsigned u32x2_t __attribute__((ext_vector_type(2))); u32x2_t y; y.x = cvtpk(x[k][0], x[k][1]); y.y = cvtpk(x[k][2], x[k][3]);
                *(LAS u32x2_t*)((tsel ? Vm : Km) + m * KROW + ch * 8) = y; }
        }
        __syncthreads(); }
#pragma unroll 1
        for (int ps = 0; ps < 2; ++ps) {
            const size_t row = (size_t)b * SP + oct * 256 + ps * 128 + w * 16 + fr;
            bf16x8_t qf[2];
            { const uint4 r0 = qc0, r1 = qc1; qc0 = qn0; qc1 = qn1;
              float v[16] = {bflo(r0.x), bfhi(r0.x), bflo(r0.y), bfhi(r0.y), bflo(r0.z), bfhi(r0.z), bflo(r0.w), bfhi(r0.w), bflo(r1.x), bfhi(r1.x), bflo(r1.y), bfhi(r1.y), bflo(r1.z), bfhi(r1.z), bflo(r1.w), bfhi(r1.w)};
              float ss = 0.f;
#pragma unroll
              for (int i = 0; i < 16; ++i) ss += v[i] * v[i];
              ss = xsum4(ss); const float rs = rsqrtf(ss * (1.0f / 64) + EPS) * (0.125f * LOG2E);
#pragma unroll
              for (int i = 0; i < 8; ++i) { v[i] *= rs * gq[fg * 8 + i]; v[8 + i] *= rs * gq[32 + fg * 8 + i]; }
              qf[0] = pack8((f32x4_t){v[0], v[1], v[2], v[3]}, (f32x4_t){v[4], v[5], v[6], v[7]});
              qf[1] = pack8((f32x4_t){v[8], v[9], v[10], v[11]}, (f32x4_t){v[12], v[13], v[14], v[15]}); }
            f32x4_t S[16]; float mx = NINF;
#pragma unroll
            for (int nt = 0; nt < 16; ++nt) { S[nt] = (f32x4_t){0.f, 0.f, 0.f, 0.f};
#pragma unroll
                for (int ks = 0; ks < 2; ++ks) { const bf16x8_t kf = *(const LAS bf16x8_t*)(Km + (16 * nt + fr) * KROW + (32 * ks + 8 * fg) * 2); S[nt] = mfma16(kf, qf[ks], S[nt]); }
                mx = fmaxf(mx, fmaxf(fmaxf(S[nt][0], S[nt][1]), fmaxf(S[nt][2], S[nt][3]))); }
            mx = xmax4(mx); float sum = 0.f;
#pragma unroll
            for (int nt = 0; nt < 16; ++nt)
#pragma unroll
                for (int jj = 0; jj < 4; ++jj) { const float e = ex2(S[nt][jj] - mx); S[nt][jj] = e; sum += e; }
            sum = xsum4(sum); const float inv = 1.0f / sum;
            f32x4_t o[4];
#pragma unroll
            for (int dt = 0; dt < 4; ++dt) o[dt] = (f32x4_t){0.f, 0.f, 0.f, 0.f};
#pragma unroll
            for (int c2 = 0; c2 < 8; ++c2) { const bf16x8_t pf = pack8(S[2 * c2], S[2 * c2 + 1]);
#pragma unroll
                for (int dt = 0; dt < 4; ++dt) { const LAS unsigned char* vp = Vm + (32 * c2 + 4 * fg + (fr >> 2)) * KROW + (16 * dt + 4 * (fr & 3)) * 2; o[dt] = mfma16(ldtr2(vp, vp + 16 * KROW), pf, o[dt]); } }
            bf16_t* orow = CATB + row * DM + 768 + hh * 64;
#pragma unroll
            for (int dt = 0; dt < 4; ++dt) { const f32x4_t v = o[dt] * inv; *(uint2*)(orow + 16 * dt + 4 * fg) = make_uint2(cvtpk(v[0], v[1]), cvtpk(v[2], v[3])); }
        }
    }
}
__device__ __forceinline__ void ph_mem_attn_sample(const Params& p, int l, LAS unsigned char* lds, int j0, int jcnt, int jstep) {
    const int tid = ltid(), lane = tid & 63, w = tid >> 6;
    const int ldp = l < 2 ? LDA_ : LDB_, qoff = l < 2 ? 3072 : 768;
    const bf16_t* P16 = (const bf16_t*)(p.ws + B_P16); bf16_t* CATB = (bf16_t*)(p.ws + B_CATB); const float* gq = p.in[I_GMEMQ] + l * 64;
    LAS float* qs = (LAS float*)(lds + w * 2048);
    LAS float* ps = qs + 64;
    __syncthreads();
    for (int ji = 0; ji < jcnt; ++ji) { const int item = (j0 + ji * jstep) * NW_ + w; if (item >= BS * 4) break;
        const int hh = item & 3, b = item >> 2; const size_t row = (size_t)MP + b;
        const float* kv = p.in[I_CMEM] + (size_t)(l * 128 + b) * 256 * 512 + hh * 64;
        { const float v = bf2f(P16[row * ldp + qoff + hh * 64 + lane]); const float ss = wave_sum(v * v); qs[lane] = v * rsqrtf(ss * (1.0f / 64) + EPS) * gq[lane] * (0.125f * LOG2E); }
        asm volatile("s_waitcnt lgkmcnt(0)" ::: "memory");
        float sc[4] = {0.f, 0.f, 0.f, 0.f};
#pragma unroll 4
        for (int d4 = 0; d4 < 16; ++d4) { const f32x4_t q4 = *(const LAS f32x4_t*)(qs + 4 * d4);
#pragma unroll
            for (int k = 0; k < 4; ++k) { const f32x4_t k4 = *(const f32x4_t*)(kv + (size_t)(lane + 64 * k) * 512 + 4 * d4); sc[k] += (q4[0] * k4[0] + q4[1] * k4[1]) + (q4[2] * k4[2] + q4[3] * k4[3]); } }
        float mx = wave_max(fmaxf(fmaxf(sc[0], sc[1]), fmaxf(sc[2], sc[3]))); float sum = 0.f;
#pragma unroll
        for (int k = 0; k < 4; ++k) { sc[k] = ex2(sc[k] - mx); sum += sc[k]; ps[lane + 64 * k] = sc[k]; }
        sum = wave_sum(sum);
        asm volatile("s_waitcnt lgkmcnt(0)" ::: "memory");
        { const int kg = lane >> 4, c4 = lane & 15; f32x4_t o4 = (f32x4_t){0.f, 0.f, 0.f, 0.f};
#pragma unroll 1
          for (int m0 = 0; m0 < 64; m0 += 16) { f32x4_t v[16];
#pragma unroll
              for (int i = 0; i < 16; ++i) v[i] = *(const f32x4_t*)(kv + (size_t)(4 * (m0 + i) + kg) * 512 + 256 + 4 * c4);
#pragma unroll
              for (int i = 0; i < 16; ++i) o4 = o4 + v[i] * ps[4 * (m0 + i) + kg]; }
#pragma unroll
          for (int jx = 0; jx < 4; ++jx) o4[jx] = xsum4(o4[jx]);
          if (kg == 0) { const float inv = 1.0f / sum; *(uint2*)(CATB + row * DM + 768 + hh * 64 + 4 * c4) = make_uint2(cvtpk(o4[0] * inv, o4[1] * inv), cvtpk(o4[2] * inv, o4[3] * inv)); } }
        asm volatile("s_waitcnt lgkmcnt(0)" ::: "memory");
    }
}
__device__ __forceinline__ void ph_nsa_sample(const Params& p, int j, LAS unsigned char* ldsb) {
    const int tid0 = ltid();
    float* lds = (float*)ldsb;
    float* qs = lds;
    float* sc = lds + 384;
    float* imp = sc + 3072;
    int* sel = (int*)(imp + 40);
    float* gate = (float*)(sel + 8);
    float* oacc = gate + 24;
    const float** kptr = (const float**)(oacc + 384);
    float* part = (float*)(kptr + 512);
    float* tbl = part + 32 * 384;
    int* pts = (int*)(tbl + 192);
    const bf16_t* P = (const bf16_t*)(p.ws + B_P16); const float* GT = (const float*)(p.ws + B_GT); const float* KVR = (const float*)(p.ws + B_KVR); bf16_t* CATB = (bf16_t*)(p.ws + B_CATB);
    const float* table = p.in[I_REL]; const int* pt = (const int*)p.in[I_PT];
    for (int item = blockIdx.x; item < BS * 2; item += gridDim.x) {
        int t_l = tid0; asm volatile("" : "+v"(t_l)); const int tid = t_l, lane = tid & 63, wid = tid >> 6;
        int pos_l = PAST; asm volatile("" : "+s"(pos_l)); const int pos = pos_l;
        const int b = item >> 1, g = item & 1, row = MP + b;
        const bf16_t* pr = P + (size_t)row * LDB_;
        __syncthreads();
        if (wid < 6) { const int z = wid; const float v = bf2f(pr[(g * 6 + z) * 64 + lane]); const float ss = wave_sum(v * v); qs[z * 64 + lane] = v * rsqrtf(ss * (1.0f / 64) + EPS) * p.in[I_GQ][j * 64 + lane]; }
        if (tid >= 384 && tid < 384 + 18) { const int t2 = tid - 384; const int br = t2 / 6, z = t2 % 6; gate[t2] = sigmoidf_(GT[(size_t)row * GTW + br * 12 + g * 6 + z] + p.in[I_BGATE][j * 36 + br * 12 + g * 6 + z]); }
        if (tid < 384) oacc[tid] = 0.f;
        if (tid >= 416 && tid < 432) pts[tid - 416] = pt[b * 16 + (tid - 416)];
        if (tid >= 192 && tid < 384) { const int i = tid - 192; tbl[i] = table[(i / 6) * 12 + g * 6 + (i % 6)]; }
        __syncthreads();
        const float* ck = (const float*)(p.ws + B_CK) + (size_t)(8 + b) * 127 * 128; const float* cv = (const float*)(p.ws + B_CV) + (size_t)(8 + b) * 127 * 128;
        for (int i = tid; i < 6 * 127; i += NT_) {
            const int z = i / 127, n = i % 127; const int dist = pos - (16 * n + 31);
            const float4* kp = (const float4*)(ck + n * 128 + g * 64); const float4* qp = (const float4*)(qs + z * 64); float a = 0.f;
#pragma unroll 8
            for (int d = 0; d < 16; ++d) a += dot4(kp[d], qp[d]);
            sc[z * 128 + n] = a * 0.125f + tbl[rel_bucket_alu(dist) * 6 + z];
        }
        __syncthreads();
        if (wid < 6) row_softmax(sc + wid * 128, 127, lane);
        __syncthreads();
        const int cur = pos >> 6;
        if (tid < 33) { const int jb = tid; float s = 0.f;
            for (int z = 0; z < 6; ++z) { const float* pz = sc + z * 128;
                if (jb < 32) { s += 2.0f * (pz[4 * jb] + pz[4 * jb + 1] + pz[4 * jb + 2]); if (4 * jb + 3 < 127) s += pz[4 * jb + 3]; }
                if (jb >= 1 && jb < 32) s += pz[4 * jb - 1]; }
            imp[jb] = s; }
        __syncthreads();
        if (tid == 0) { sel[0] = 0; sel[1] = cur; sel[2] = cur - 1; }
        if (tid >= 1 && tid <= cur - 2) { const float mine = imp[tid]; int rank = 0;
            for (int j2 = 1; j2 <= cur - 2; ++j2) { const float o = imp[j2]; rank += (o > mine || (o == mine && j2 < tid)) ? 1 : 0; }
            if (rank < 5) sel[3 + rank] = tid; }
        { const int kg = tid >> 4, c4 = tid & 15; f32x4_t v[4]; f32x4_t acc[6];
#pragma unroll
          for (int i = 0; i < 4; ++i) { const int n = kg + 32 * i; v[i] = *(const f32x4_t*)(cv + (n < 127 ? n : 126) * 128 + g * 64 + 4 * c4); }
#pragma unroll
          for (int z = 0; z < 6; ++z) { acc[z] = (f32x4_t){0.f, 0.f, 0.f, 0.f};
#pragma unroll
              for (int i = 0; i < 4; ++i) { const int n = kg + 32 * i; if (n < 127) acc[z] = acc[z] + v[i] * sc[z * 128 + n]; } }
#pragma unroll
          for (int z = 0; z < 6; ++z) *(f32x4_t*)(part + kg * 384 + z * 64 + 4 * c4) = acc[z]; }
        __syncthreads();
        if (tid < 384) { float o = 0.f;
#pragma unroll 8
            for (int kg = 0; kg < 32; ++kg) o += part[kg * 384 + tid];
            oacc[tid] += gate[0 * 6 + (tid >> 6)] * o; }
        __syncthreads();
#pragma unroll 1
        for (int br = 1; br <= 2; ++br) {
            int t_b = tid0; asm volatile("" : "+v"(t_b)); const int tid = t_b, lane = tid & 63, wid = tid >> 6;
            { const int t = tid; const float* kp = nullptr; int dist = -1;
                if (br == 1) { const int blk = sel[t >> 6];
                    if (blk >= 0) { const int tok = blk * 64 + (t & 63); dist = pos - tok;
                        if (dist >= 0) kp = tok < PAST ? p.in[I_CSLC] + ((size_t)pts[tok >> 7] * 128 + (tok & 127)) * 256 + g * 64 : KVR + (size_t)row * 768 + 256 + g * 64; }
                } else { const int kpos = pos - 511 + t; dist = 511 - t;
                    kp = kpos < PAST ? p.in[I_CWIN] + ((size_t)b * 512 + (kpos - (PAST - 512))) * 256 + g * 64 : KVR + (size_t)row * 768 + 512 + g * 64; }
                if (dist >= 0 && kp) {
                    float s[6] = {0.f, 0.f, 0.f, 0.f, 0.f, 0.f};
#pragma unroll 1
                    for (int dc = 0; dc < 2; ++dc) { f32x4_t kk[8];
#pragma unroll
                        for (int d = 0; d < 8; ++d) kk[d] = ((const f32x4_t*)kp)[8 * dc + d];
#pragma unroll
                        for (int d = 0; d < 8; ++d) {
#pragma unroll
                            for (int z = 0; z < 6; ++z) { const f32x4_t q4 = *(const f32x4_t*)(qs + z * 64 + 32 * dc + 4 * d); s[z] += (kk[d][0] * q4[0] + kk[d][1] * q4[1]) + (kk[d][2] * q4[2] + kk[d][3] * q4[3]); }
                            asm volatile("" ::: "memory"); } }
                    const int bk = rel_bucket_alu(dist);
#pragma unroll
                    for (int z = 0; z < 6; ++z) sc[z * 512 + t] = s[z] * 0.125f + tbl[bk * 6 + z];
                    kptr[t] = kp;
                } else {
#pragma unroll
                    for (int z = 0; z < 6; ++z) sc[z * 512 + t] = NEGM;
                    kptr[t] = KVR;
                }
            }
            __syncthreads();
            if (wid < 6) row_softmax(sc + wid * 512, 512, lane);
            __syncthreads();
            {
                const int kg = tid >> 4, c4 = tid & 15; f32x4_t acc[6];
#pragma unroll
                for (int z = 0; z < 6; ++z) acc[z] = (f32x4_t){0.f, 0.f, 0.f, 0.f};
#pragma unroll 1
                for (int i0 = 0; i0 < 16; i0 += 8) { f32x4_t v[8];
#pragma unroll
                    for (int i = 0; i < 8; ++i) v[i] = *(const f32x4_t*)(kptr[kg + 32 * (i0 + i)] + 128 + 4 * c4);
#pragma unroll
                    for (int i = 0; i < 8; ++i)
#pragma unroll
                        for (int z = 0; z < 6; ++z) acc[z] = acc[z] + v[i] * sc[z * 512 + kg + 32 * (i0 + i)]; }
#pragma unroll
                for (int z = 0; z < 6; ++z) *(f32x4_t*)(part + kg * 384 + z * 64 + 4 * c4) = acc[z];
            }
            __syncthreads();
            if (tid < 384) { float o = 0.f;
#pragma unroll 8
                for (int kg = 0; kg < 32; ++kg) o += part[kg * 384 + tid];
                oacc[tid] += gate[br * 6 + (tid >> 6)] * o; }
            __syncthreads();
        }
        if (tid < 384) CATB[(size_t)row * DM + g * 384 + tid] = (bf16_t)f2bf(oacc[tid]);
    }
}
__device__ __forceinline__ void ph_mlstm_sample_fast(const Params& p, int l, LAS unsigned char* ldsb) {
    const int tid = ltid(), lane = tid & 63, w = tid >> 6;
    float* lds = (float*)ldsb;
    float* qs = lds; float* ks = lds + 192; float* n1 = lds + 384; float* part = lds + 576;
    float* scal = part + 8 * 192;
    const bf16_t* P = (const bf16_t*)(p.ws + B_P16); const float* GT = (const float*)(p.ws + B_GT); const float* bif = p.in[I_BIF] + l * 8; float* HR = (float*)(p.ws + B_HRAW);
    for (int item = blockIdx.x; item < BS * 4; item += gridDim.x) {
        const int h = item & 3, b = item >> 2; const size_t row = (size_t)MP + b;
        const bf16_t* pr = P + row * LDA_; const float* gr = GT + row * GTW;
        const size_t sidx = (size_t)(l * 128 + b) * 4 + h;
        const float ig = gr[h] + bif[h], fg_ = gr[4 + h] + bif[4 + h];
        const float m0 = p.in[I_SM][sidx];
        const float logf = logsigmoidf_(fg_);
        const float m_new = fmaxf(logf + m0, ig);
        const float a = expf(logf + m0 - m_new), bb = expf(ig - m_new);
        __syncthreads();
        if (tid < 192) { const float q = bf2f(pr[h * 192 + tid]), k = bf2f(pr[768 + h * 192 + tid]); qs[tid] = q; ks[tid] = k;
            const float nn = a * p.in[I_SN][sidx * 192 + tid] + bb * k; n1[tid] = nn; p.out[O_SN + sidx * 192 + tid] = nn; }
        __syncthreads();
        if (w == 0) { float s = qs[lane] * n1[lane] + qs[lane + 64] * n1[lane + 64] + qs[lane + 128] * n1[lane + 128]; s = wave_sum(s); if (lane == 0) scal[0] = s; }
        const float* C0 = p.in[I_SC] + sidx * 192 * 192; float* C1 = p.out + O_SC + sidx * 192 * 192;
        float ve[3], num[3] = {0.f, 0.f, 0.f};
#pragma unroll
        for (int i = 0; i < 3; ++i) ve[i] = bf2f(pr[1536 + h * 192 + lane + 64 * i]) * bb;
#pragma unroll 1
        for (int d0 = 24 * w; d0 < 24 * w + 24; d0 += 12) {
            float c[12][3];
#pragma unroll
            for (int r = 0; r < 12; ++r)
#pragma unroll
                for (int i = 0; i < 3; ++i) c[r][i] = C0[(size_t)(d0 + r) * 192 + lane + 64 * i];
#pragma unroll
            for (int r = 0; r < 12; ++r) { const float kd = ks[d0 + r], qd = qs[d0 + r];
#pragma unroll
                for (int i = 0; i < 3; ++i) { const float cn = a * c[r][i] + kd * ve[i]; C1[(size_t)(d0 + r) * 192 + lane + 64 * i] = cn; num[i] = fmaf(qd, cn, num[i]); } }
        }
#pragma unroll
        for (int i = 0; i < 3; ++i) part[w * 192 + lane + 64 * i] = num[i];
        __syncthreads();
        if (tid < 192) { float s = 0.f;
#pragma unroll
            for (int ww = 0; ww < 8; ++ww) s += part[ww * 192 + tid];
            HR[row * 768 + h * 192 + tid] = s / fmaxf(fabsf(scal[0]), expf(-m_new)); }
        if (tid == 0) p.out[O_SM + sidx] = m_new;
    }
}
constexpr int RING_BYTES = 131072, MISC_OFF = RING_BYTES + 320, LDS_BYTES = 147456;
typedef float f32x4_ __attribute__((ext_vector_type(4)));

#define STRIP_JOBS(njobs) for (int job = (int)gridDim.x - 1 - (int)blockIdx.x; job < (njobs); job += (int)gridDim.x)
__device__ __forceinline__ void strips_inproj(const Params& p, int l, LAS unsigned char* lds) {
    unsigned char* ws = p.ws; const bf16_t* XB = (const bf16_t*)(ws + B_XB); bf16_t* P16 = (bf16_t*)(ws + B_P16); float* GT = (float*)(ws + B_GT);
    const float* ssq = (const float*)(ws + B_SSQ) + (size_t)(2 * l) * SSQS;
    const bool ka = l < 2; const int ldp = ka ? LDA_ : LDB_, nmain = ka ? 104 * 4 : 32 * 4;
    const bf16_t* Bt = ka ? (const bf16_t*)(ws + B_BTA) + (size_t)l * NBTA * DM : (const bf16_t*)(ws + B_BTB) + (size_t)(l - 2) * NBTB * DM;
    const int tid_ = ltid(); const int lane = tid_ & 63, wave = tid_ >> 6, fr = lane & 15, fq = lane >> 4;
    STRIP_JOBS(nmain + 516) {
        if (job < nmain) {
            const int st = job >> 2, r0 = MP + (job & 3) * 32;
            const int brow[2] = {st * 32, st * 32 + 16}; StripAcc<2> R; strip_gemm<2>(XB, DM, r0, Bt, brow, R, lds);
            if (wave < 2) { const int row = r0 + wave * 16 + fr; const float rs = rstd_of(ssq[row]);
#pragma unroll
                for (int t = 0; t < 2; ++t) { const f32x4_ v = R.a[t] * rs; *(uint2*)(P16 + (size_t)row * ldp + st * 32 + t * 16 + 4 * fq) = make_uint2(pk2(v[0], v[1]), pk2(v[2], v[3])); } }
        } else {
            const int r0 = (job - nmain) * 32, row = r0 + wave * 16 + fr;
            if (ka) { const int brow[1] = {3328}; StripAcc<1> R; strip_gemm<1>(XB, DM, r0, Bt, brow, R, lds); if (wave < 2) *(f32x4_*)(GT + (size_t)row * GTW + 4 * fq) = R.a[0] * rstd_of(ssq[row]); }
            else { const int brow[3] = {1024, 1040, 1056}; StripAcc<3> R; strip_gemm<3>(XB, DM, r0, Bt, brow, R, lds);
                if (wave < 2) { const float rs = rstd_of(ssq[row]);
#pragma unroll
                    for (int t = 0; t < 3; ++t) *(f32x4_*)(GT + (size_t)row * GTW + t * 16 + 4 * fq) = R.a[t] * rs; } }
        }
    }
}
__device__ __forceinline__ void strips_resid(const Params& p, const bf16_t* A, int K, const bf16_t* Bt, float* ssq, float* Y, LAS unsigned char* lds) {
    bf16_t* XB = (bf16_t*)(p.ws + B_XB);
    const int tid_ = ltid(); const int lane = tid_ & 63, wave = tid_ >> 6, fr = lane & 15, fq = lane >> 4;
    STRIP_JOBS(256) {
        const int st = job >> 2, r0 = MP + (job & 3) * 32;
        const int brow[1] = {st * 16}; StripAcc<1> R; strip_gemm<1>(A, K, r0, Bt, brow, R, lds);
        if (wave < 2) { const int row = r0 + wave * 16 + fr; bf16_t* bp = XB + (size_t)row * DM + st * 16 + 4 * fq; const uint2 o = *(const uint2*)bp;
            const f32x4_ x = (f32x4_){bflo(o.x), bfhi(o.x), bflo(o.y), bfhi(o.y)} + R.a[0];
            *(uint2*)bp = make_uint2(pk2(x[0], x[1]), pk2(x[2], x[3]));
            if (Y) *(f32x4_*)(Y + (size_t)row * DM + st * 16 + 4 * fq) = x;
            float ss = (x[0] * x[0] + x[1] * x[1]) + (x[2] * x[2] + x[3] * x[3]); ss += __shfl_xor(ss, 16); ss += __shfl_xor(ss, 32);
            if (fq == 0) (void)__hip_atomic_fetch_add(ssq + row, ss, __ATOMIC_RELAXED, __HIP_MEMORY_SCOPE_AGENT); }
    }
}
__device__ __forceinline__ void strips_gu(const Params& p, int l, LAS unsigned char* lds) {
    unsigned char* ws = p.ws; const bf16_t* XB = (const bf16_t*)(ws + B_XB); bf16_t* HID = (bf16_t*)(ws + B_HID);
    const float* ssq = (const float*)(ws + B_SSQ) + (size_t)(2 * l + 1) * SSQS; const bf16_t* Bt = (const bf16_t*)(ws + B_BTG) + (size_t)l * 2 * DFF * DM;
    const int tid_ = ltid(); const int lane = tid_ & 63, wave = tid_ >> 6, fr = lane & 15, fq = lane >> 4;
    STRIP_JOBS(176 * 4) {
        const int st = job >> 2, r0 = MP + (job & 3) * 32;
        const int brow[2] = {(st >> 3) * 256 + (st & 7) * 16, (st >> 3) * 256 + 128 + (st & 7) * 16}; StripAcc<2> R; strip_gemm<2>(XB, DM, r0, Bt, brow, R, lds);
        if (wave < 2) { const int row = r0 + wave * 16 + fr; const float rs = rstd_of(ssq[row]); float h[4];
#pragma unroll
            for (int j = 0; j < 4; ++j) { const float g = R.a[0][j] * rs, up = R.a[1][j] * rs; h[j] = g * pg8::fast_sigmoid(g) * up; }
            *(uint2*)(HID + (size_t)row * DFF + st * 16 + 4 * fq) = make_uint2(pk2(h[0], h[1]), pk2(h[2], h[3])); }
    }
}
__device__ __forceinline__ void strips_kv(const Params& p, LAS unsigned char* lds) {
    unsigned char* ws = p.ws; const bf16_t* XB = (const bf16_t*)(ws + B_XB); float* KVR = (float*)(ws + B_KVR);
    const float* ssq = (const float*)(ws + B_SSQ) + (size_t)4 * SSQS; const bf16_t* Bt = (const bf16_t*)(ws + B_BTK);
    const int tid_ = ltid(); const int lane = tid_ & 63, wave = tid_ >> 6, fr = lane & 15, fq = lane >> 4;
    STRIP_JOBS(48 * 4) {
        const int st = job >> 2, r0 = MP + (job & 3) * 32;
        const int brow[1] = {st * 16}; StripAcc<1> R; strip_gemm<1>(XB, DM, r0, Bt, brow, R, lds);
        if (wave < 2) { const int row = r0 + wave * 16 + fr; *(f32x4_*)(KVR + (size_t)row * 768 + st * 16 + 4 * fq) = R.a[0] * rstd_of(ssq[row]); }
    }
}

#ifndef COMPRESS_NAIVE
#define COMPRESS_NAIVE 0
#endif
#ifndef MLSTM_NAIVE
#define MLSTM_NAIVE 0
#endif
#ifndef MEMATT_NAIVE
#define MEMATT_NAIVE 0
#endif
#ifndef SAMPLE_ML_NAIVE
#define SAMPLE_ML_NAIVE 0
#endif
#ifndef SAMPLE_NSA_NAIVE
#define SAMPLE_NSA_NAIVE 0
#endif
#ifndef MK_MULTI
#define MK_MULTI 0
#endif
constexpr int PL = 9, NPH = 1 + 4 * PL;
__host__ __device__ constexpr bool phase_nonempty(int ph) {
    if (ph == 0) return true;
    const int l = (ph - 1) / PL, r = (ph - 1) % PL;
    if (r == 2) return l < 2;
    if (r == 7) return false;
    if (r >= 6) return l == 1;
    return true;
}
#ifndef TIME_MASK
#define TIME_MASK 0
#endif
__host__ __device__ constexpr int phase_group(int ph) { if (ph == 0) return 0; const int l = (ph - 1) / PL, r = (ph - 1) % PL; return r == 0 ? 1 : r == 1 ? (l < 2 ? 2 : 4) : r == 2 ? 3 : r == 3 ? 5 : r == 4 ? 6 : r == 5 ? 7 : r == 6 ? 8 : r == 7 ? 9 : 10; }
__global__ void __launch_bounds__(NT_, 2) fwd(Params p) {
    extern __shared__ __attribute__((aligned(16))) unsigned char lds_raw[];
    LAS unsigned char* lds = (LAS unsigned char*)lds_raw;
    float* ldsf = (float*)lds_raw;
    volatile LAS unsigned* MISC = (volatile LAS unsigned*)(lds + MISC_OFF);
    for (int u = threadIdx.x; u < (LDS_BYTES - RING_BYTES) / 4; u += NT_) ((LAS unsigned*)(lds + RING_BYTES))[u] = 0u;
    __syncthreads();
    unsigned char* ws = p.ws;
    XcdBarrier bar; bar.bar = (unsigned*)ws; bar.x = 0; bar.st = MISC + 8;
    const bool single = (p.ph_hi - p.ph_lo) > 1;
    if (single) bar = xcd_barrier_post((unsigned*)ws, MISC + 8);
    bf16_t* XB = (bf16_t*)(ws + B_XB); bf16_t* P16 = (bf16_t*)(ws + B_P16); bf16_t* CATB = (bf16_t*)(ws + B_CATB); bf16_t* HID = (bf16_t*)(ws + B_HID);
    float* SSQ = (float*)(ws + B_SSQ);
    const int G = gridDim.x, c = blockIdx.x;
    if (TIME_SUB && blockIdx.x == TSUB_BLK && threadIdx.x == 0) { for (int i = 0; i < 8; ++i) g_tsub[i] = 0ull; }
    int ph = 0; volatile LAS unsigned long long* TMR = (volatile LAS unsigned long long*)(lds + MISC_OFF + 64);
    if ((TIME_MASK || TIME_SUB) && blockIdx.x == 0 && threadIdx.x == 0) { TMR[0] = 0ull; TMR[1] = __builtin_amdgcn_s_memrealtime(); }
#define ON() (ph >= p.ph_lo && ph < p.ph_hi)
#define NEXT() do { const bool ne_ = phase_nonempty(ph); const int grp_ = phase_group(ph); ++ph; if (ne_ && ph > p.ph_lo && ph < p.ph_hi) xcd_barrier(bar); \
        if (TIME_MASK && blockIdx.x == 0 && threadIdx.x == 0) { const unsigned long long now_ = __builtin_amdgcn_s_memrealtime(); if ((TIME_MASK >> grp_) & 1) TMR[0] = TMR[0] + (now_ - TMR[1]); TMR[1] = now_; } } while (0)
#ifndef NO_PRO
    if (ON()) ph_prologue(p, lds);
#endif
    NEXT();
    for (int l = 0; l < 4; ++l) {
        if (ON()) {
            if (l == 0) { pg8::Gemm g{(const bf16_t*)(ws + B_MPB), (const bf16_t*)(ws + B_BTM), 2048, 2048, DM}; pg8::StaticOrder S; S.init(2048, 2048, G, c);
                pg8::EpiF32 E{(float*)(ws + B_MEMR), 512, nullptr, 512, (size_t)2048 * 512};
                pg8::gemm_phase<pg8::EpiF32, pg8::StaticOrder, true, true>(lds, g, S, E); }
            if (l < 2) { pg8::Gemm g{XB, (const bf16_t*)(ws + B_BTA) + (size_t)l * NBTA * DM, MAP, LDA_ + 256, DM}; pg8::StaticOrder S; S.init(MAP, LDA_ + 256, G, l == 0 ? (c + 192) % G : c);
                pg8::EpiBf16S E{P16, LDA_, SSQ + (size_t)(2 * l) * SSQS, 13, (float*)(ws + B_GT)};
                pg8::gemm_phase<pg8::EpiBf16S, pg8::StaticOrder, true, true>(lds, g, S, E); }
            else { pg8::Gemm g{XB, (const bf16_t*)(ws + B_BTB) + (size_t)(l - 2) * NBTB * DM, MP, LDB_, DM}; pg8::StaticOrder S; S.init(MP, LDB_, G, c);
                pg8::EpiBf16S E{P16, LDB_, SSQ + (size_t)(2 * l) * SSQS, -1, nullptr};
                pg8::gemm_phase<pg8::EpiBf16S, pg8::StaticOrder, true, true>(lds, g, S, E);
#ifndef NO_STRIPS
                strips_inproj(p, l, lds);
#endif
            }
        }
        NEXT();
#ifndef NO_NAIVE
        if (ON()) {
            if (l < 2) { TSUB_BEGIN(); if (MLSTM_NAIVE) ph_mlstm_prompt(p, l, ldsf); else ph_mlstm_fast(p, l, lds); TSUB_END(6); if (G == 256) { if (c >= 192) { ph_mem_attn_fast(p, l, lds, 4 * (c - 192), 4, 1); ph_mem_attn_sample(p, l, lds, c - 192, 1, 64); if (l == 1) ph_swin_copy(p, 192, 64); } TSUB_END(7); }
                else { ph_mem_attn_fast(p, l, lds, c, (256 - c + G - 1) / G, G); if (c < 64) ph_mem_attn_sample(p, l, lds, c, (64 - c + G - 1) / G, G); if (l == 1) ph_swin_copy(p, 0, G); }      if (SAMPLE_ML_NAIVE) ph_mlstm_sample(p, l, ldsf); else ph_mlstm_sample_fast(p, l, lds); }
            else { if (!NSA_NAIVE_ALL) ph_nsa_fast(p, l - 2, lds); { TSUB_BEGIN(); if (SAMPLE_NSA_NAIVE) ph_nsa(p, l - 2, ldsf); else ph_nsa_sample(p, l - 2, lds); TSUB_END(4); } TSUB_BEGIN(); if (MEMATT_NAIVE) ph_mem_attn(p, l); else if (G == 256) { if (c < 16) { ph_mem_attn_fast(p, l, lds, 8 * c, 8, 1); ph_mem_attn_sample(p, l, lds, 2 * c, 2, 1); } else if (c < 32) { ph_mem_attn_fast(p, l, lds, 128 + 5 * (c - 16), 5, 1); ph_mem_attn_sample(p, l, lds, 2 * c, 2, 1); } else if (c < 48) ph_mem_attn_fast(p, l, lds, 208 + 3 * (c - 32), 3, 1); }
                else { ph_mem_attn_fast(p, l, lds, c, (256 - c + G - 1) / G, G); if (c < 64) ph_mem_attn_sample(p, l, lds, c, (64 - c + G - 1) / G, G); } TSUB_END(5); }
        }
#endif
        NEXT();
#ifndef NO_NAIVE
        if (ON()) { if (l < 2) { ph_mlstm_fin(p, l); if (l == 0) ph_memk_norm(p); } }
#endif
        NEXT();
        if (ON()) {
            const bf16_t* Bt = (const bf16_t*)(ws + B_BTO) + (size_t)l * DM * DM; float* sq = SSQ + (size_t)(2 * l + 1) * SSQS;
            pg8::Gemm g{CATB, Bt, MP, DM, DM}; pg8::StaticOrder S; S.init(MP, DM, G, c); pg8::EpiResid E{nullptr, XB, sq};
            pg8::gemm_phase<pg8::EpiResid, pg8::StaticOrder, true, true>(lds, g, S, E);
#ifndef NO_STRIPS
            strips_resid(p, CATB, DM, Bt, sq, nullptr, lds);
#endif
        }
        NEXT();
        if (ON()) {
            pg8::Gemm g{XB, (const bf16_t*)(ws + B_BTG) + (size_t)l * 2 * DFF * DM, MAP, 2 * DFF, DM}; pg8::StaticOrder S; S.init(MAP, 2 * DFF, G, c); pg8::EpiSwiglu E{HID, SSQ + (size_t)(2 * l + 1) * SSQS};
            pg8::gemm_phase<pg8::EpiSwiglu, pg8::StaticOrder, true, true>(lds, g, S, E);
        }
        NEXT();
        if (ON()) {
            const bf16_t* Bt = (const bf16_t*)(ws + B_BTD) + (size_t)l * DM * DFF; float* sq = SSQ + (size_t)(2 * l + 2) * SSQS;
            pg8::Gemm g{HID, Bt, MP, DM, DFF}; pg8::StaticOrder S; S.init(MP, DM, G, c); float* Yo = l == 3 ? p.out : nullptr; pg8::EpiResid E{Yo, XB, sq};
            pg8::gemm_phase<pg8::EpiResid, pg8::StaticOrder, true, true>(lds, g, S, E);
#ifndef NO_STRIPS
            strips_resid(p, HID, DFF, Bt, sq, Yo, lds);
#endif
        }
        NEXT();
        if (ON()) { if (l == 1) {
            pg8::Gemm g{XB, (const bf16_t*)(ws + B_BTK), MAP, 768, DM}; pg8::StaticOrder S; S.init(MAP, 768, G, c); pg8::EpiF32 E{(float*)(ws + B_KVR), 768, SSQ + (size_t)4 * SSQS, 0, 0};
            pg8::gemm_phase<pg8::EpiF32, pg8::StaticOrder, true, true>(lds, g, S, E);
            asm volatile("s_waitcnt vmcnt(0)" ::: "memory"); __syncthreads();
            if (c < 195) {
                constexpr int nM = MAP / 256, nN = 3, nwg = nM * nN, q = nwg / 8, rr = nwg % 8; const int xcd = c % 8, off = c / 8;
                const int wgid = (xcd < rr ? xcd * (q + 1) : rr * (q + 1) + (xcd - rr) * q) + off; constexpr int nig = 8 * nN; const int gid = wgid / nig, fm = gid * 8, gsz = (nM - fm) < 8 ? (nM - fm) : 8;
                rows_post_tile(p, (fm + ((wgid % nig) % gsz)) * 256, (wgid % nig) / gsz); }
            } }
        NEXT();
        NEXT();
#ifndef NO_NAIVE
        if (ON()) { if (l == 1) { if (COMPRESS_NAIVE) ph_compress(p, ldsf); else ph_compress_fast(p, lds); } }
#endif
        NEXT();
    }
    if (TIME_MASK || TIME_SUB) { if (blockIdx.x == 0 && threadIdx.x == 0) { const unsigned long long t_acc = TIME_SUB ? __hip_atomic_load(&g_tsub[TIME_SUB > 0 ? TIME_SUB - 1 : 0], __ATOMIC_RELAXED, __HIP_MEMORY_SCOPE_AGENT) : TMR[0]; const unsigned long long t0 = __builtin_amdgcn_s_memrealtime(); while (__builtin_amdgcn_s_memrealtime() - t0 < 10ull * t_acc) __builtin_amdgcn_s_sleep(8); } }
}

extern "C" void kernel_launch(void* const* d_in, const int* in_sizes, int n_in, void* d_out, int out_size, void* d_ws, size_t ws_size, hipStream_t stream) {
    static int grid = 0;
    if (!grid) {
        int dev = 0, cus = 0;
        (void)hipGetDevice(&dev); (void)hipDeviceGetAttribute(&cus, hipDeviceAttributeMultiprocessorCount, dev);
        if (cus < 1) cus = 256;
        if (hipFuncSetAttribute((const void*)fwd, hipFuncAttributeMaxDynamicSharedMemorySize, LDS_BYTES) != hipSuccess) fprintf(stderr, "kernel_launch: hipFuncSetAttribute failed\n");
        int per_cu = 0; (void)hipOccupancyMaxActiveBlocksPerMultiprocessor(&per_cu, (const void*)fwd, NT_, LDS_BYTES); (void)hipGetLastError();
        if (per_cu < 1) fprintf(stderr, "kernel_launch: occupancy query says %d\n", per_cu);
        grid = cus;
    }
    if (n_in != N_IN || (size_t)out_size != O_END || ws_size < B_END) fprintf(stderr, "kernel_launch: unexpected sizes n_in=%d out=%d ws=%zu need %zu\n", n_in, out_size, ws_size, (size_t)B_END);
    (void)hipMemsetAsync(d_ws, 0, CTL_BYTES, stream);
    Params p{};
    for (int i = 0; i < N_IN; ++i) p.in[i] = (const float*)d_in[i];
    p.out = (float*)d_out; p.ws = (unsigned char*)d_ws;
#if MK_MULTI
    for (int ph = 0; ph < NPH; ++ph) {
        if (!phase_nonempty(ph)) continue;
        p.ph_lo = ph; p.ph_hi = ph + 1;
        hipLaunchKernelGGL(fwd, dim3(grid), dim3(NT_), LDS_BYTES, stream, p);
    }
#else
    p.ph_lo = 0; p.ph_hi = NPH;
    hipLaunchKernelGGL(fwd, dim3(grid), dim3(NT_), LDS_BYTES, stream, p);
#endif
}

#ifdef REGTEST
__global__ void __launch_bounds__(NT_, 2) rt_nsa(Params p) { extern __shared__ __attribute__((aligned(16))) unsigned char l_[]; ph_nsa_fast(p, 0, (LAS unsigned char*)l_); }
__global__ void __launch_bounds__(NT_, 2) rt_mlstm(Params p) { extern __shared__ __attribute__((aligned(16))) unsigned char l_[]; ph_mlstm_fast(p, 0, (LAS unsigned char*)l_); }
__global__ void __launch_bounds__(NT_, 2) rt_nsas(Params p) { extern __shared__ __attribute__((aligned(16))) unsigned char l_[]; ph_nsa_sample(p, 0, (LAS unsigned char*)l_); }
__global__ void __launch_bounds__(NT_, 2) rt_mem(Params p) { extern __shared__ __attribute__((aligned(16))) unsigned char l_[]; ph_mem_attn_fast(p, 0, (LAS unsigned char*)l_, 0, 256, 1); }
__global__ void __launch_bounds__(NT_, 2) rt_cmp(Params p) { extern __shared__ __attribute__((aligned(16))) unsigned char l_[]; ph_compress_fast(p, (LAS unsigned char*)l_); }
#endif
```

```cpp
#include <hip/hip_runtime.h>
#include <cstdio>
#include <cstdint>

#define LAS __attribute__((address_space(3)))
#define GAS __attribute__((address_space(1)))
#define XB_TMO      128
#define XB_XCNT(j)  (256  + 64 * (j))
#define XB_XSUB(j)  (1280 + 64 * (j))
#define XB_XGEN(j)  (2304 + 64 * (j))
#define XB_TOP      3328
#define XB_TOPGEN   3392
#define XCD_BAR_WORDS 3456
#define XB_SPIN_CAP (1u << 23)
__device__ __forceinline__ unsigned xb_ld(unsigned* p)              { return __hip_atomic_load(p, __ATOMIC_RELAXED, __HIP_MEMORY_SCOPE_AGENT); }
__device__ __forceinline__ unsigned xb_add(unsigned* p, unsigned v) { return __hip_atomic_fetch_add(p, v, __ATOMIC_RELAXED, __HIP_MEMORY_SCOPE_AGENT); }
__device__ __forceinline__ unsigned xb_xcc_id() { return (unsigned)__builtin_amdgcn_s_getreg((3 << 11) | 20) & 0xFu; }
#define XB_SPIN(cond, bar) do { unsigned _sp = 0; while (cond) { __builtin_amdgcn_s_sleep(1); \
    if ((++_sp & 255u) == 0u) { if (xb_ld(&(bar)[XB_TMO])) break; if (_sp > XB_SPIN_CAP) { atomicAdd(&(bar)[XB_TMO], 1u); break; } } } } while (0)
struct XcdBarrier { unsigned* bar; unsigned x; volatile LAS unsigned* st; };
__device__ __forceinline__ XcdBarrier xcd_barrier_post(unsigned* bar, volatile LAS unsigned* st) {
    XcdBarrier b; b.bar = bar; b.x = xb_xcc_id(); b.st = st;
    if (threadIdx.x == 0) (void)xb_add(&bar[XB_XCNT(b.x)], 1u);
    return b;
}
__device__ __forceinline__ void xcd_barrier_complete(unsigned* bar, unsigned x, unsigned& nloc, unsigned& nx) {
    const unsigned G = gridDim.x * gridDim.y * gridDim.z;
    unsigned sum, cnt, mine, sp = 0u;
    for (;;) {
        sum = 0u; cnt = 0u; mine = 0u;
#pragma unroll
        for (unsigned j = 0; j < 16; ++j) { const unsigned c = xb_ld(&bar[XB_XCNT(j)]); sum += c; cnt += (c > 0u) ? 1u : 0u; mine = (j == x) ? c : mine; }
        if (sum == G) break;
        __builtin_amdgcn_s_sleep(1);
        if ((++sp & 255u) == 0u) { if (xb_ld(&bar[XB_TMO])) break; if (sp > XB_SPIN_CAP) { atomicAdd(&bar[XB_TMO], 1u); break; } }
    }
    nloc = mine > 0u ? mine : 1u; nx = cnt > 0u ? cnt : 1u;
}
__device__ __forceinline__ void xcd_barrier(const XcdBarrier& b) {
    asm volatile("s_waitcnt vmcnt(0)" ::: "memory");
    __syncthreads();
    if (threadIdx.x == 0) {
        unsigned* bar = b.bar;
        __builtin_amdgcn_s_waitcnt(0);
        unsigned nloc = b.st[0], nx = b.st[1];
        if (nloc == 0u) { xcd_barrier_complete(bar, b.x, nloc, nx); b.st[0] = nloc; b.st[1] = nx; }
        const unsigned old = xb_add(&bar[XB_XSUB(b.x)], 1u);
        const unsigned gen = old / nloc;
        if (old + 1u == (gen + 1u) * nloc) {
            __builtin_amdgcn_fence(__ATOMIC_RELEASE, "agent");
            asm volatile("s_waitcnt vmcnt(0)" ::: "memory");
            const unsigned og = xb_add(&bar[XB_TOP], 1u);
            const unsigned tg = og / nx;
            if (og + 1u == (tg + 1u) * nx) xb_add(&bar[XB_TOPGEN], 1u);
            else XB_SPIN(xb_ld(&bar[XB_TOPGEN]) == tg, bar);
            __builtin_amdgcn_fence(__ATOMIC_ACQUIRE, "agent");
            xb_add(&bar[XB_XGEN(b.x)], 1u);
            asm volatile("s_waitcnt vmcnt(0)" ::: "memory");
        } else {
            XB_SPIN(xb_ld(&bar[XB_XGEN(b.x)]) == gen, bar);
            __builtin_amdgcn_fence(__ATOMIC_ACQUIRE, "agent");
            asm volatile("s_waitcnt vmcnt(0)" ::: "memory");
        }
    }
    __syncthreads();
}

constexpr int NT_ = 512, NW_ = 8;
constexpr int DM = 1024, BP = 8, SP = 2048, MP = BP * SP, BS = 128, MA = MP + BS, MAP = MP + 256;
constexpr int ACOLS = 3336, BCOLS = 1060, DFF = 2816;
constexpr int LDA_ = 3328, LDB_ = 1024;
constexpr int NBTA = 3344, NBTB = 1072;
constexpr int PAST = 2048, GTW = 48;
constexpr float EPS = 1e-6f, NEGM = -1e30f;
typedef unsigned short bf16_t;

enum { I_XP = 0, I_XS, I_SC, I_SN, I_SM, I_CMEM, I_CCMP, I_CSLC, I_CWIN, I_PT, I_MEMP, I_GMIX, I_WINA, I_BIF, I_GHN, I_WINB, I_GQ, I_BGATE, I_REL,
       I_GKV, I_WKV, I_GKSLC, I_GKWIN, I_GKCMP, I_CPOS, I_CW1, I_CB1, I_CW2, I_CB2, I_WMEMKV, I_GMEMK, I_GMEMQ, I_WOUT, I_GFFN, I_WGU, I_WDOWN, N_IN };
constexpr size_t O_YP = 0, O_YS = O_YP + (size_t)MP * DM, O_PC = O_YS + (size_t)BS * DM, O_PN = O_PC + 2ull * 8 * 4 * 192 * 192, O_PM = O_PN + 2ull * 8 * 4 * 192,
    O_PMEM = O_PM + 64, O_PCMP = O_PMEM + 4ull * 8 * 256 * 512, O_PSLC = O_PCMP + (size_t)MP * 256, O_PWIN = O_PSLC + (size_t)MP * 256, O_SC = O_PWIN + 8ull * 512 * 256,
    O_SN = O_SC + 2ull * 128 * 4 * 192 * 192, O_SM = O_SN + 2ull * 128 * 4 * 192, O_SCMP = O_SM + 1024, O_SSLC = O_SCMP + 128 * 256, O_SWIN = O_SSLC + 128 * 256,
    O_END = O_SWIN + 128ull * 512 * 256;
static_assert(O_END == 87700544ull, "output size");
constexpr size_t CTL_BYTES = 2u << 20, B_SSQ = 65536;
constexpr size_t al256(size_t x) { return (x + 255) & ~(size_t)255; }
constexpr size_t B_XB = CTL_BYTES, B_P16 = al256(B_XB + (size_t)MAP * DM * 2), B_GT = al256(B_P16 + (size_t)MAP * LDA_ * 2), B_CATB = al256(B_GT + (size_t)MAP * GTW * 4),
    B_HID = al256(B_CATB + (size_t)MA * DM * 2), B_HRAW = al256(B_HID + (size_t)MAP * DFF * 2), B_KVR = al256(B_HRAW + (size_t)MA * 768 * 4), B_CK = al256(B_KVR + (size_t)MAP * 768 * 4),
    B_CV = al256(B_CK + 136ull * 127 * 128 * 4), B_MPB = al256(B_CV + 136ull * 127 * 128 * 4),
    B_BTA = al256(B_MPB + 2048ull * DM * 2), B_BTB = al256(B_BTA + 2ull * NBTA * DM * 2), B_BTO = al256(B_BTB + 2ull * NBTB * DM * 2), B_BTG = al256(B_BTO + 4ull * DM * DM * 2),
    B_BTD = al256(B_BTG + 4ull * 2 * DFF * DM * 2), B_BTK = al256(B_BTD + 4ull * DM * DFF * 2), B_BTM = al256(B_BTK + 768ull * DM * 2), B_KVB = al256(B_BTM + 2048ull * DM * 2), B_SKF = al256(B_KVB + 6ull * BP * 2 * SP * 64 * 2), B_SVF = al256(B_SKF + (size_t)BP * 2 * SP * 64 * 2), B_KC16 = al256(B_SVF + (size_t)BP * 2 * SP * 64 * 2),
    B_W1T = al256(B_KC16 + 136ull * 2 * 2 * 128 * 64 * 2), B_W2T = al256(B_W1T + 2ull * 128 * 2048 * 2), B_PEB = al256(B_W2T + 2ull * 64 * 128 * 2), B_MEMR = al256(B_PEB + 1024), B_CMPS = al256(B_MEMR + 4ull * 2048 * 512 * 4), B_END = al256(B_CMPS + (size_t)BS * 4 * SP * 64 * 2 + 8192);
constexpr int SSQS = MAP;
static_assert(9 * SSQS * 4 + B_SSQ <= CTL_BYTES, "ssq sites inside the control region");

#ifndef TIME_SUB
#define TIME_SUB 0
#endif
#ifndef TSUB_BLK
#define TSUB_BLK 200
#endif
__device__ unsigned long long g_tsub[8];
#define TSUB_BEGIN() unsigned long long tsub_t0_ = (TIME_SUB && blockIdx.x == TSUB_BLK && threadIdx.x == 0) ? __builtin_amdgcn_s_memrealtime() : 0ull
#define TSUB_END(k) do { if (TIME_SUB && blockIdx.x == TSUB_BLK && threadIdx.x == 0) { const unsigned long long n_ = __builtin_amdgcn_s_memrealtime(); g_tsub[k] += n_ - tsub_t0_; tsub_t0_ = n_; } } while (0)
struct Params { const float* in[N_IN]; float* out; unsigned char* ws; int ph_lo, ph_hi; };

__device__ const unsigned char REL_LUT[128] = {0, 1, 2, 3, 4, 5, 6, 7, 8, 9, 10, 11, 12, 13, 14, 15, 16, 16, 16, 17, 17, 18, 18, 18, 19, 19, 19, 20, 20, 20, 20, 21, 21, 21, 21, 22, 22, 22, 22, 22, 23, 23, 23, 23, 23, 23, 24, 24, 24, 24, 24, 24, 25, 25, 25, 25, 25, 25, 25, 26, 26, 26, 26, 26, 26, 26, 26, 27, 27, 27, 27, 27, 27, 27, 27, 27, 27, 28, 28, 28, 28, 28, 28, 28, 28, 28, 28, 29, 29, 29, 29, 29, 29, 29, 29, 29, 29, 29, 29, 30, 30, 30, 30, 30, 30, 30, 30, 30, 30, 30, 30, 30, 30, 31, 31, 31, 31, 31, 31, 31, 31, 31, 31, 31, 31, 31, 31, 31};
__device__ __forceinline__ int rel_bucket(int d) { return d >= 128 ? 31 : (int)REL_LUT[d < 0 ? 0 : d]; }
__device__ __forceinline__ int rel_bucket_alu(int d) { d = d < 0 ? 0 : d; if (d < 16) return d;
    return 16 + (d >= 19) + (d >= 21) + (d >= 24) + (d >= 27) + (d >= 31) + (d >= 35) + (d >= 40) + (d >= 46) + (d >= 52) + (d >= 59) + (d >= 67) + (d >= 77) + (d >= 87) + (d >= 99) + (d >= 113); }

__device__ __forceinline__ int opq(int i) { asm volatile("" : "+s"(i)); return i; }
#define BAR_LDS() do { asm volatile("s_waitcnt lgkmcnt(0)" ::: "memory"); __builtin_amdgcn_s_barrier(); asm volatile("" ::: "memory"); } while (0)
__device__ __forceinline__ int ltid() { int t = threadIdx.x; asm volatile("" : "+v"(t)); return t; }
__device__ __forceinline__ float wave_sum(float v) {
#pragma unroll
    for (int o = 32; o; o >>= 1) v += __shfl_xor(v, o);
    return v;
}
__device__ __forceinline__ float wave_max(float v) {
#pragma unroll
    for (int o = 32; o; o >>= 1) v = fmaxf(v, __shfl_xor(v, o));
    return v;
}
__device__ __forceinline__ float sigmoidf_(float x) { return 1.0f / (1.0f + expf(-x)); }
__device__ __forceinline__ float logsigmoidf_(float x) { return fminf(x, 0.f) - log1pf(expf(-fabsf(x))); }
__device__ __forceinline__ float dot4(float4 a, float4 b) { return a.x * b.x + a.y * b.y + a.z * b.z + a.w * b.w; }
__device__ __forceinline__ float bf2f(bf16_t u) { return __uint_as_float((unsigned)u << 16); }
__device__ __forceinline__ unsigned f2bf(float f) { unsigned u = __float_as_uint(f); return (u + 0x7fffu + ((u >> 16) & 1u)) >> 16; }
__device__ __forceinline__ unsigned pk2(float lo, float hi) { return f2bf(lo) | (f2bf(hi) << 16); }
__device__ __forceinline__ float bflo(unsigned w) { return __uint_as_float(w << 16); }
__device__ __forceinline__ float bfhi(unsigned w) { return __uint_as_float(w & 0xffff0000u); }
__device__ __forceinline__ float rstd_of(float ssq) { return rsqrtf(ssq * (1.0f / DM) + EPS); }

namespace pg8 {
#define PG8_LAS __attribute__((address_space(3)))
typedef unsigned short bf16_t;
typedef short bf16x8 __attribute__((ext_vector_type(8)));
typedef float f32x4 __attribute__((ext_vector_type(4)));
typedef unsigned u32x4 __attribute__((ext_vector_type(4)));
constexpr int BM = 256, BK = 64, HALF = 128, HTB = HALF * BK * 2  , STAGE_BYTES = 8 * HTB, NXCD = 8, WGM = 8;

__host__ __device__ __forceinline__ int lds_byte(int r, int c) { const int st = (r >> 4) * 2 + (c >> 5), rr = r & 15, cc = c & 31, ob = rr * 64 + cc * 2; return st * 1024 + (ob ^ (((ob >> 9) & 1) << 5)); }
__host__ __device__ __forceinline__ void stage_rc(int b, int& R, int& C) { const int st = b / 1024, sb = b % 1024, swz = sb ^ (((sb >> 9) & 1) << 5); R = (st >> 1) * 16 + swz / 64; C = (st & 1) * 32 + (swz % 64) / 2; }
__host__ __device__ __forceinline__ int perm32(int rho) { const int n = rho >> 4, i = rho & 15; return 8 * (i >> 2) + 4 * n + (i & 3); }

struct Unit { int pm, pn; };
struct Gemm { const bf16_t* A; const bf16_t* Bt; int M, N, K; };

struct StaticOrder {
    int nM, nN, nwg, G, c;
    __host__ __device__ void init(int M, int N, int G_, int c_) { nM = M / BM; nN = N / BM; nwg = nM * nN; G = G_; c = c_; }
    __host__ __device__ bool next(int i, Unit& u) const {
        const long L = (long)i * G + c; if (L >= nwg) return false;
        int wgid = (int)L; { const int q = nwg / NXCD, r = nwg % NXCD, xcd = wgid % NXCD, off = wgid / NXCD; wgid = (xcd < r ? xcd * (q + 1) : r * (q + 1) + (xcd - r) * q) + off; }
        const int nig = WGM * nN, gid = wgid / nig, fm = gid * WGM, gsz = (nM - fm) < WGM ? (nM - fm) : WGM;
        u.pm = fm + ((wgid % nig) % gsz); u.pn = (wgid % nig) / gsz; return true;
    }
    __device__ __forceinline__ void a_ready(const Unit&) const {}
    __device__ __forceinline__ void done(const Unit&) const {}
};

__device__ __forceinline__ unsigned cvt_pk_bf16(float lo, float hi) { unsigned r; asm volatile("v_cvt_pk_bf16_f32 %0, %1, %2" : "=v"(r) : "v"(lo), "v"(hi)); return r; }
typedef float f32x2 __attribute__((ext_vector_type(2)));
__device__ __forceinline__ float fast_sigmoid(float x) { return __builtin_amdgcn_rcpf(1.0f + __builtin_amdgcn_exp2f(-1.4426950408889634f * x)); }
struct EpiF32 {
    static constexpr bool PERM = false, AFTER_DRAIN = false;
    float* O; int ldc; const float* ssq; int split_cols; size_t split_stride;
    __device__ __forceinline__ void operator()(const f32x4 (&acc)[2][2][4][2], const Unit& u, int wr, int wc, int fr, int fq) const {
        int colt = u.pn * BM; float* base = O; if (split_cols) { const int t = colt / split_cols; base += (size_t)t * split_stride; colt -= t * split_cols; }
        const int row0 = u.pm * BM + wr * 64 + fr, col0 = colt + wc * 32 + 4 * fq;
#pragma unroll
        for (int ai = 0; ai < 2; ++ai)
#pragma unroll
            for (int m = 0; m < 4; ++m) { const int r = row0 + ai * HALF + m * 16; const float rs = ssq ? rstd_of(ssq[r]) : 1.0f; float* rowp = base + (size_t)r * ldc + col0;
#pragma unroll
                for (int bj = 0; bj < 2; ++bj)
#pragma unroll
                    for (int n = 0; n < 2; ++n) *(f32x4*)(rowp + bj * HALF + n * 16) = acc[ai][bj][m][n] * rs; }
    }
};
struct EpiBf16S {
    static constexpr bool PERM = true, AFTER_DRAIN = false;
    bf16_t* O; int ldc; const float* ssq; int gate_pn; float* GT;
    __device__ __forceinline__ void operator()(const f32x4 (&acc)[2][2][4][2], const Unit& u, int wr, int wc, int fr, int fq) const {
        const int row0 = u.pm * BM + wr * 64 + fr, col0 = u.pn * BM + wc * 32 + 8 * fq;
        if (u.pn == gate_pn) {
            if (wc == 0 && fq == 0) {
#pragma unroll
                for (int ai = 0; ai < 2; ++ai)
#pragma unroll
                    for (int m = 0; m < 4; ++m) { const int r = row0 + ai * HALF + m * 16; const float rs = rstd_of(ssq[r]);
                        *(f32x4*)(GT + (size_t)r * 48) = acc[ai][0][m][0] * rs; *(f32x4*)(GT + (size_t)r * 48 + 4) = acc[ai][0][m][1] * rs; } }
            return; }
#pragma unroll
        for (int ai = 0; ai < 2; ++ai)
#pragma unroll
            for (int m = 0; m < 4; ++m) { const int r = row0 + ai * HALF + m * 16; const float rs = rstd_of(ssq[r]); bf16_t* rowp = O + (size_t)r * ldc + col0;
#pragma unroll
                for (int bj = 0; bj < 2; ++bj) { const f32x4 v0 = acc[ai][bj][m][0] * rs, v1 = acc[ai][bj][m][1] * rs;
                    u32x4 w; w.x = cvt_pk_bf16(v0[0], v0[1]); w.y = cvt_pk_bf16(v0[2], v0[3]); w.z = cvt_pk_bf16(v1[0], v1[1]); w.w = cvt_pk_bf16(v1[2], v1[3]);
                    *(u32x4*)(rowp + bj * HALF) = w; } }
    }
};
struct EpiSwiglu {
    static constexpr bool PERM = true, AFTER_DRAIN = false;
    bf16_t* O; const float* ssq;
    __device__ __forceinline__ void operator()(const f32x4 (&acc)[2][2][4][2], const Unit& u, int wr, int wc, int fr, int fq) const {
        const int row0 = u.pm * BM + wr * 64 + fr, col0 = u.pn * HALF + wc * 32 + 8 * fq;
#pragma unroll
        for (int ai = 0; ai < 2; ++ai)
#pragma unroll
            for (int m = 0; m < 4; ++m) { const int r = row0 + ai * HALF + m * 16; const float rs = rstd_of(ssq[r]); float h[8];
#pragma unroll
                for (int n = 0; n < 2; ++n)
#pragma unroll
                    for (int j = 0; j < 4; ++j) { const float g = acc[ai][0][m][n][j] * rs, up = acc[ai][1][m][n][j] * rs; h[4 * n + j] = g * fast_sigmoid(g) * up; }
                u32x4 w; w.x = cvt_pk_bf16(h[0], h[1]); w.y = cvt_pk_bf16(h[2], h[3]); w.z = cvt_pk_bf16(h[4], h[5]); w.w = cvt_pk_bf16(h[6], h[7]);
                *(u32x4*)(O + (size_t)r * 2816 + col0) = w; }
    }
};
struct EpiResid {
    static constexpr bool PERM = false, AFTER_DRAIN = false;
    float* Y; bf16_t* XB; float* ssq;
    __device__ __forceinline__ void operator()(const f32x4 (&acc)[2][2][4][2], const Unit& u, int wr, int wc, int fr, int fq) const {
        const int row0 = u.pm * BM + wr * 64 + fr, col0 = u.pn * BM + wc * 32 + 4 * fq;
        typedef unsigned u32x2 __attribute__((ext_vector_type(2)));
#pragma unroll
        for (int ai = 0; ai < 2; ++ai)
#pragma unroll
            for (int m = 0; m < 4; ++m) { const int r = row0 + ai * HALF + m * 16; bf16_t* bp = XB + (size_t)r * 1024 + col0; float ss = 0.f; u32x2 old[2][2];
#pragma unroll
                for (int bj = 0; bj < 2; ++bj)
#pragma unroll
                    for (int n = 0; n < 2; ++n) old[bj][n] = *(const u32x2*)(bp + bj * HALF + n * 16);
#pragma unroll
                for (int bj = 0; bj < 2; ++bj)
#pragma unroll
                    for (int n = 0; n < 2; ++n) { const u32x2 o = old[bj][n]; f32x4 x = (f32x4){bflo(o.x), bfhi(o.x), bflo(o.y), bfhi(o.y)} + acc[ai][bj][m][n];
                        u32x2 w; w.x = cvt_pk_bf16(x[0], x[1]); w.y = cvt_pk_bf16(x[2], x[3]); *(u32x2*)(bp + bj * HALF + n * 16) = w;
                        if (Y) *(f32x4*)(Y + (size_t)r * 1024 + col0 + bj * HALF + n * 16) = x;
                        ss += (x[0] * x[0] + x[1] * x[1]) + (x[2] * x[2] + x[3] * x[3]); }
                ss += __shfl_xor(ss, 16); ss += __shfl_xor(ss, 32);
                if (fq == 0) (void)__hip_atomic_fetch_add(ssq + r, ss, __ATOMIC_RELAXED, __HIP_MEMORY_SCOPE_AGENT); }
    }
};
template <class Epi, class Sched, bool ALIGN_EPI = false, bool SP2 = false>
__device__ __forceinline__ void gemm_phase(PG8_LAS unsigned char* lds, const Gemm g, const Sched& S, const Epi& E) {
    int tid_l = threadIdx.x; asm volatile("" : "+v"(tid_l));
    const int tid = tid_l, wid = __builtin_amdgcn_readfirstlane(tid >> 6), lane = tid & 63, wr = wid >> 2, wc = wid & 3, fr = lane & 15, fq = lane >> 4;
    const int K = g.K, nt = K / BK;
    unsigned voffA[2], voffB[2];
#pragma unroll
    for (int i = 0; i < 2; ++i) { int R, C; stage_rc(tid * 16 + i * 8192, R, C); const int Rb = Epi::PERM ? ((R & ~31) + perm32(R & 31)) : R;
        voffA[i] = (unsigned)(R * K + C) * 2u; voffB[i] = (unsigned)(Rb * K + C) * 2u; }
    const size_t kstep = (size_t)(BK * 2);
    const size_t hstep = (size_t)HALF * K * 2;
    const size_t tstep = 2 * hstep;
    const unsigned ldsw = (unsigned)wid * 1024u;
    const int aoff = lds_byte(wr * 64 + fr, fq * 8), boff = lds_byte(wc * 32 + fr, fq * 8);
#define PG8_SA(b, h) (((b) * 2 + (h)) * HTB)
#define PG8_SB(b, h) ((4 + (b) * 2 + (h)) * HTB)
#define PG8_STAGE(bufoff, gbase, voff) do { _Pragma("unroll") for (int _i = 0; _i < 2; ++_i) \
        __builtin_amdgcn_global_load_lds((const unsigned*)((const char*)(gbase) + (voff)[_i]), (PG8_LAS unsigned*)(lds + (bufoff) + ldsw + _i * 8192), 16, 0, 0); } while (0)
#define PG8_LDA(dst, b, h) do { _Pragma("unroll") for (int m = 0; m < 4; ++m) _Pragma("unroll") for (int k = 0; k < 2; ++k) dst[m][k] = *(const PG8_LAS bf16x8*)(lds + PG8_SA(b, h) + aoff + m * 2048 + k * 1024); } while (0)
#define PG8_LDB(dst, b, h) do { _Pragma("unroll") for (int n = 0; n < 2; ++n) _Pragma("unroll") for (int k = 0; k < 2; ++k) dst[n][k] = *(const PG8_LAS bf16x8*)(lds + PG8_SB(b, h) + boff + n * 2048 + k * 1024); } while (0)
#define PG8_MMA(ai, bj, At, Bt) do { __builtin_amdgcn_s_setprio(1); _Pragma("unroll") for (int m = 0; m < 4; ++m) _Pragma("unroll") for (int n = 0; n < 2; ++n) _Pragma("unroll") for (int k = 0; k < 2; ++k) \
        acc[ai][bj][m][n] = __builtin_amdgcn_mfma_f32_16x16x32_bf16(Bt[n][k], At[m][k], acc[ai][bj][m][n], 0, 0, 0); __builtin_amdgcn_s_setprio(0); } while (0)
#define PG8_WAIT_V(n) asm volatile("s_waitcnt vmcnt(" #n ")" ::: "memory")
#define PG8_WAIT_L(n) asm volatile("s_waitcnt lgkmcnt(" #n ")" ::: "memory")
#define PG8_BAR __builtin_amdgcn_s_barrier()
#define PG8_SCHED __builtin_amdgcn_sched_barrier(0)
    Unit cur, nxt; int ui = 0;
    if (!S.next(0, cur)) return;
    f32x4 acc[2][2][4][2];
#pragma unroll
    for (int a = 0; a < 2; ++a)
#pragma unroll
        for (int b = 0; b < 2; ++b)
#pragma unroll
            for (int m = 0; m < 4; ++m)
#pragma unroll
                for (int n = 0; n < 2; ++n) acc[a][b][m][n] = (f32x4){0.f, 0.f, 0.f, 0.f};
    bf16x8 At[4][2], B0[2][2], B1[2][2];
    const char* cA = (const char*)g.A + (size_t)cur.pm * tstep; const char* cB = (const char*)g.Bt + (size_t)cur.pn * tstep;
    S.a_ready(cur);
    if constexpr (SP2) {
        PG8_STAGE(PG8_SB(0, 0), cB, voffB); PG8_STAGE(PG8_SB(0, 1), cB + hstep, voffB); PG8_STAGE(PG8_SA(0, 0), cA, voffA); PG8_STAGE(PG8_SA(0, 1), cA + hstep, voffA);
        if (wr == 1) PG8_BAR;
        PG8_WAIT_V(2); PG8_BAR;
        PG8_STAGE(PG8_SB(1, 0), cB + kstep, voffB); PG8_STAGE(PG8_SA(1, 0), cA + kstep, voffA); PG8_STAGE(PG8_SB(1, 1), cB + hstep + kstep, voffB);
        PG8_WAIT_V(6); PG8_BAR;
    } else {
        PG8_STAGE(PG8_SB(0, 0), cB, voffB); PG8_STAGE(PG8_SA(0, 0), cA, voffA); PG8_STAGE(PG8_SB(0, 1), cB + hstep, voffB); PG8_STAGE(PG8_SA(0, 1), cA + hstep, voffA);
        if (wr == 1) PG8_BAR;
        PG8_WAIT_V(4); PG8_BAR;
        PG8_STAGE(PG8_SB(1, 0), cB + kstep, voffB); PG8_STAGE(PG8_SA(1, 0), cA + kstep, voffA); PG8_STAGE(PG8_SB(1, 1), cB + hstep + kstep, voffB);
        PG8_WAIT_V(6); PG8_BAR;
    }
    for (;;) {
        const bool has_next = S.next(ui + 1, nxt);
        const char* nA = has_next ? (const char*)g.A + (size_t)nxt.pm * tstep : cA; const char* nB = has_next ? (const char*)g.Bt + (size_t)nxt.pn * tstep : cB;
        for (int t = 0; t < nt; t += 2) {
            const bool last = (t == nt - 2);
            const char* a1 = cA + (size_t)(t + 1) * kstep;
            const char* a2 = last ? nA : cA + (size_t)(t + 2) * kstep; const char* b2 = last ? nB : cB + (size_t)(t + 2) * kstep;
            const char* a3 = a2 + kstep; const char* b3 = b2 + kstep;
            if (last && has_next) S.a_ready(nxt);
            if constexpr (SP2) {
            PG8_LDB(B0, 0, 0); PG8_LDB(B1, 0, 1); PG8_SCHED; PG8_LDA(At, 0, 0); PG8_STAGE(PG8_SA(1, 1), a1 + hstep, voffA);
            PG8_WAIT_V(8); PG8_WAIT_L(0); PG8_BAR; PG8_MMA(0, 0, At, B0); PG8_MMA(0, 1, At, B1); PG8_BAR; PG8_SCHED;
            PG8_LDA(At, 0, 1); PG8_STAGE(PG8_SB(0, 0), b2, voffB); PG8_STAGE(PG8_SB(0, 1), b2 + hstep, voffB); PG8_STAGE(PG8_SA(0, 0), a2, voffA);
            PG8_WAIT_V(8); PG8_WAIT_L(0); PG8_BAR; PG8_MMA(1, 0, At, B0); PG8_MMA(1, 1, At, B1); PG8_BAR; PG8_SCHED;
            PG8_LDB(B0, 1, 0); PG8_LDB(B1, 1, 1); PG8_SCHED; PG8_LDA(At, 1, 0); PG8_STAGE(PG8_SA(0, 1), a2 + hstep, voffA);
            PG8_WAIT_V(8); PG8_WAIT_L(0); PG8_BAR; PG8_MMA(0, 0, At, B0); PG8_MMA(0, 1, At, B1); PG8_BAR; PG8_SCHED;
            PG8_LDA(At, 1, 1); PG8_STAGE(PG8_SB(1, 0), b3, voffB); PG8_STAGE(PG8_SB(1, 1), b3 + hstep, voffB); PG8_STAGE(PG8_SA(1, 0), a3, voffA);
            PG8_WAIT_V(8); PG8_WAIT_L(0); PG8_BAR; PG8_MMA(1, 0, At, B0); PG8_MMA(1, 1, At, B1); PG8_BAR; PG8_SCHED;
            } else {
            PG8_LDB(B0, 0, 0); PG8_SCHED; PG8_LDA(At, 0, 0); PG8_STAGE(PG8_SA(1, 1), a1 + hstep, voffA);
            PG8_WAIT_L(8); PG8_BAR; PG8_WAIT_L(0); PG8_MMA(0, 0, At, B0); PG8_BAR; PG8_SCHED;
            PG8_LDB(B1, 0, 1); PG8_STAGE(PG8_SB(0, 0), b2, voffB);
            PG8_BAR; PG8_WAIT_L(0); PG8_MMA(0, 1, At, B1); PG8_BAR;
            PG8_LDA(At, 0, 1); PG8_STAGE(PG8_SA(0, 0), a2, voffA);
            PG8_BAR; PG8_WAIT_L(0); PG8_MMA(1, 0, At, B0); PG8_BAR; PG8_SCHED;
            PG8_STAGE(PG8_SB(0, 1), b2 + hstep, voffB);
            PG8_WAIT_V(6); PG8_BAR; PG8_MMA(1, 1, At, B1); PG8_BAR;
            PG8_LDB(B0, 1, 0); PG8_SCHED; PG8_LDA(At, 1, 0); PG8_STAGE(PG8_SA(0, 1), a2 + hstep, voffA);
            PG8_WAIT_L(8); PG8_BAR; PG8_WAIT_L(0); PG8_MMA(0, 0, At, B0); PG8_BAR; PG8_SCHED;
            PG8_LDB(B1, 1, 1); PG8_STAGE(PG8_SB(1, 0), b3, voffB);
            PG8_BAR; PG8_WAIT_L(0); PG8_MMA(0, 1, At, B1); PG8_BAR;
            PG8_LDA(At, 1, 1); PG8_STAGE(PG8_SA(1, 0), a3, voffA);
            PG8_BAR; PG8_WAIT_L(0); PG8_MMA(1, 0, At, B0); PG8_BAR; PG8_SCHED;
            PG8_STAGE(PG8_SB(1, 1), b3 + hstep, voffB);
            PG8_WAIT_V(6); PG8_BAR; PG8_MMA(1, 1, At, B1); PG8_BAR;
            }
        }
        if constexpr (ALIGN_EPI) { if (wr == 0) PG8_BAR; }
        if constexpr (!Epi::AFTER_DRAIN) { E(acc, cur, wr, wc, fr, fq); S.done(cur); }
        if (!has_next) break;
#pragma unroll
        for (int a = 0; a < 2; ++a)
#pragma unroll
            for (int b = 0; b < 2; ++b)
#pragma unroll
                for (int m = 0; m < 4; ++m)
#pragma unroll
                    for (int n = 0; n < 2; ++n) acc[a][b][m][n] = (f32x4){0.f, 0.f, 0.f, 0.f};
        cur = nxt; cA = nA; cB = nB; ++ui;
        if constexpr (ALIGN_EPI) { if (wr == 1) PG8_BAR; }
    }
    PG8_WAIT_V(0);
    if constexpr (!ALIGN_EPI) { if (wr == 0) PG8_BAR; }
    PG8_BAR;
    if constexpr (Epi::AFTER_DRAIN) { E.fused(acc, cur, wr, wc, fr, fq, lds, wid, lane); S.done(cur); }
#undef PG8_SA
#undef PG8_SB
#undef PG8_STAGE
#undef PG8_LDA
#undef PG8_LDB
#undef PG8_MMA
#undef PG8_WAIT_V
#undef PG8_WAIT_L
#undef PG8_BAR
#undef PG8_SCHED
}
}
typedef short s_bf16x8 __attribute__((ext_vector_type(8)));
typedef float s_f32x4 __attribute__((ext_vector_type(4)));
template <int NT> struct StripAcc { s_f32x4 a[NT]; };
template <int NT> __device__ __forceinline__ void strip_gemm(const bf16_t* A, int K, int row0, const bf16_t* Bt, const int* brow  , StripAcc<NT>& R, LAS unsigned char* lds) {
    const int tid_ = ltid(), lane = tid_ & 63, wave = tid_ >> 6, fr = lane & 15, fq = lane >> 4, rt = wave & 1, kq = wave >> 1;
    LAS float* red = (LAS float*)lds;
    const int kw = K >> 2;
    const bf16_t* ap = A + (size_t)(row0 + 16 * rt + fr) * K + kq * kw + fq * 8;
    const bf16_t* bp[NT];
#pragma unroll
    for (int t = 0; t < NT; ++t) { bp[t] = Bt + (size_t)(brow[t] + fr) * K + kq * kw + fq * 8; R.a[t] = (s_f32x4){0.f, 0.f, 0.f, 0.f}; }
    int k0 = 0;
#pragma unroll 1
    for (; k0 + 256 <= kw; k0 += 256) {
        s_bf16x8 a[8], b[NT][8];
#pragma unroll
        for (int s2 = 0; s2 < 8; ++s2) { a[s2] = *(const s_bf16x8*)(ap + k0 + s2 * 32);
#pragma unroll
            for (int t = 0; t < NT; ++t) b[t][s2] = *(const s_bf16x8*)(bp[t] + k0 + s2 * 32); }
#pragma unroll
        for (int s2 = 0; s2 < 8; ++s2)
#pragma unroll
            for (int t = 0; t < NT; ++t) R.a[t] = __builtin_amdgcn_mfma_f32_16x16x32_bf16(b[t][s2], a[s2], R.a[t], 0, 0, 0);
    }
#pragma unroll 1
    for (; k0 < kw; k0 += 64) {
        s_bf16x8 a[2], b[NT][2];
#pragma unroll
        for (int s2 = 0; s2 < 2; ++s2) { a[s2] = *(const s_bf16x8*)(ap + k0 + s2 * 32);
#pragma unroll
            for (int t = 0; t < NT; ++t) b[t][s2] = *(const s_bf16x8*)(bp[t] + k0 + s2 * 32); }
#pragma unroll
        for (int s2 = 0; s2 < 2; ++s2)
#pragma unroll
            for (int t = 0; t < NT; ++t) R.a[t] = __builtin_amdgcn_mfma_f32_16x16x32_bf16(b[t][s2], a[s2], R.a[t], 0, 0, 0);
    }
    __syncthreads();
    if (kq > 0) {
#pragma unroll
        for (int t = 0; t < NT; ++t) *(LAS s_f32x4*)(red + ((((kq - 1) * 2 + rt) * NT + t) * 64 + lane) * 4) = R.a[t]; }
    __syncthreads();
    if (kq == 0) {
#pragma unroll
        for (int q = 0; q < 3; ++q)
#pragma unroll
            for (int t = 0; t < NT; ++t) R.a[t] = R.a[t] + *(const LAS s_f32x4*)(red + (((q * 2 + rt) * NT + t) * 64 + lane) * 4); }
}
enum { TR_ID = 0, TR_INA, TR_INB, TR_GU };
__device__ __forceinline__ int tr_rowmap(int kind, int n) {
    if (kind == TR_INA) return n < 3072 ? n : (n < 3080 ? 3328 + (n - 3072) : 3072 + (n - 3080));
    if (kind == TR_INB) return n < 768 ? n : (n < 804 ? 1024 + (n - 768) : 768 + (n - 804));
    if (kind == TR_GU) { if (n < DFF) return (n >> 7) * 256 + (n & 127); const int m = n - DFF; return (m >> 7) * 256 + 128 + (m & 127); }
    return n;
}
__device__ __forceinline__ void tr_item(const float* W, int K, int N, bf16_t* WT, const float* gain, int kind, LAS float* scr, int item, int lane) {
    const int nblk = (N + 31) >> 5, kb = item / nblk, nb = item % nblk, k0 = 64 * kb, n0 = 32 * nb;
    { float v[32]; const int n = n0 + (lane & 31); const bool ok = n < N; const float* wp = W + (size_t)(k0 + (lane >> 5)) * N + (ok ? n : 0);
#pragma unroll
      for (int i = 0; i < 32; ++i) v[i] = wp[(size_t)(2 * i) * N];
#pragma unroll
      for (int i = 0; i < 32; ++i) { const int kk = 2 * i + (lane >> 5); float x = ok ? v[i] : 0.f; if (gain) x *= gain[k0 + kk]; scr[kk * 33 + (lane & 31)] = x; } }
    asm volatile("s_waitcnt lgkmcnt(0)" ::: "memory");
    const int c = lane & 7;
#pragma unroll
    for (int j = 0; j < 4; ++j) { const int nn = (lane >> 3) + 8 * j, n = n0 + nn;
        if (n < N) { const int row = tr_rowmap(kind, n); const float sc = (kind == TR_INA && n >= 768 && n < 1536) ? 0.07216878364870322f : 1.0f;
            const LAS float* s = scr + (8 * c) * 33 + nn; uint4 o;
            o.x = pk2(s[0 * 33] * sc, s[1 * 33] * sc); o.y = pk2(s[2 * 33] * sc, s[3 * 33] * sc); o.z = pk2(s[4 * 33] * sc, s[5 * 33] * sc); o.w = pk2(s[6 * 33] * sc, s[7 * 33] * sc);
            *(uint4*)(WT + (size_t)row * K + k0 + 8 * c) = o; } }
    asm volatile("s_waitcnt lgkmcnt(0)" ::: "memory");
}
__device__ __forceinline__ void ph_prologue(const Params& p, LAS unsigned char* lds) {
    const int tid = ltid(), lane = tid & 63, wid = tid >> 6; const int gw = blockIdx.x * NW_ + wid, NGW = gridDim.x * NW_;
    LAS float* scr = (LAS float*)(lds + wid * 16384);
    unsigned char* ws = p.ws;
    for (int it = gw; ; it += NGW) {
        int r = it; bool done = false;
#define TRJ(Wp, K_, N_, WTp, gainp, kind_) if (!done) { const int cnt = ((K_) / 64) * (((N_) + 31) / 32); if (r < cnt) { tr_item(Wp, K_, N_, WTp, gainp, kind_, scr, r, lane); done = true; } else r -= cnt; }
        for (int l = 0; l < 4; ++l) TRJ(p.in[I_WGU] + (size_t)l * DM * 2 * DFF, DM, 2 * DFF, (bf16_t*)(ws + B_BTG) + (size_t)l * 2 * DFF * DM, p.in[I_GFFN] + l * DM, TR_GU)
        for (int l = 0; l < 4; ++l) TRJ(p.in[I_WDOWN] + (size_t)l * DFF * DM, DFF, DM, (bf16_t*)(ws + B_BTD) + (size_t)l * DM * DFF, (const float*)nullptr, TR_ID)
        for (int l = 0; l < 2; ++l) TRJ(p.in[I_WINA] + (size_t)l * DM * ACOLS, DM, ACOLS, (bf16_t*)(ws + B_BTA) + (size_t)l * NBTA * DM, p.in[I_GMIX] + l * DM, TR_INA)
        for (int l = 0; l < 2; ++l) TRJ(p.in[I_WINB] + (size_t)l * DM * BCOLS, DM, BCOLS, (bf16_t*)(ws + B_BTB) + (size_t)l * NBTB * DM, p.in[I_GMIX] + (2 + l) * DM, TR_INB)
        for (int l = 0; l < 4; ++l) TRJ(p.in[I_WOUT] + (size_t)l * DM * DM, DM, DM, (bf16_t*)(ws + B_BTO) + (size_t)l * DM * DM, (const float*)nullptr, TR_ID)
        TRJ(p.in[I_WKV], DM, 768, (bf16_t*)(ws + B_BTK), p.in[I_GKV], TR_ID)
        for (int l = 0; l < 4; ++l) TRJ(p.in[I_WMEMKV] + (size_t)l * DM * 512, DM, 512, (bf16_t*)(ws + B_BTM) + (size_t)l * 512 * DM, (const float*)nullptr, TR_ID)
        for (int c = 0; c < 2; ++c) TRJ(p.in[I_CW1] + (size_t)c * 2048 * 128, 2048, 128, (bf16_t*)(ws + B_W1T) + (size_t)c * 128 * 2048, (const float*)nullptr, TR_ID)
        for (int c = 0; c < 2; ++c) TRJ(p.in[I_CW2] + (size_t)c * 128 * 64, 128, 64, (bf16_t*)(ws + B_W2T) + (size_t)c * 64 * 128, (const float*)nullptr, TR_ID)
#undef TRJ
        if (!done) break;
    }
    for (int idx = gw; idx < 256; idx += NGW) { const int c = idx >> 7, h = idx & 127; float s = 0.f;
        for (int k = lane; k < 2048; k += 64) s += p.in[I_CPOS][((k >> 6) * 2 + c) * 64 + (k & 63)] * p.in[I_CW1][((size_t)c * 2048 + k) * 128 + h];
        s = wave_sum(s); if (lane == 0) ((float*)(ws + B_PEB))[idx] = s + p.in[I_CB1][idx]; }
    for (int i = blockIdx.x * NT_ + tid; i < 2 * 8 * 128 + 2 * 12 * 128; i += gridDim.x * NT_) {
        uint4 z = make_uint4(0u, 0u, 0u, 0u);
        if (i < 2048) { const int l = i >> 10, rr = (i >> 7) & 7, c = i & 127; ((uint4*)((bf16_t*)(ws + B_BTA) + ((size_t)l * NBTA + 3336 + rr) * DM))[c] = z; }
        else { const int k = i - 2048; const int l = k / 1536, rr = (k % 1536) >> 7, c = k & 127; ((uint4*)((bf16_t*)(ws + B_BTB) + ((size_t)l * NBTB + 1060 + rr) * DM))[c] = z; }
    }
    bf16_t* XB = (bf16_t*)(ws + B_XB); float* ssq0 = (float*)(ws + B_SSQ); bf16_t* MPB = (bf16_t*)(ws + B_MPB);
    for (int r0 = gw; r0 < MA + 2048; r0 += 2 * NGW) {
        float4 v[2][4]; const int r1 = r0 + NGW < MA + 2048 ? r0 + NGW : r0;
#pragma unroll
        for (int u = 0; u < 2; ++u) { const int r = u ? r1 : r0; const float* src = r < MA ? (r < MP ? p.in[I_XP] + (size_t)r * DM : p.in[I_XS] + (size_t)(r - MP) * DM) : p.in[I_MEMP] + (size_t)(r - MA) * DM;
#pragma unroll
            for (int j = 0; j < 4; ++j) v[u][j] = ((const float4*)src)[lane + 64 * j]; }
#pragma unroll
        for (int u = 0; u < 2; ++u) { const int r = u ? r1 : r0; if (u == 1 && r1 == r0) break; const bool isx = r < MA;
            bf16_t* dstb = isx ? XB + (size_t)r * DM : MPB + (size_t)(r - MA) * DM; float ss = 0.f;
#pragma unroll
            for (int j = 0; j < 4; ++j) { ss += dot4(v[u][j], v[u][j]); ((uint2*)dstb)[lane + 64 * j] = make_uint2(pk2(v[u][j].x, v[u][j].y), pk2(v[u][j].z, v[u][j].w)); }
            ss = wave_sum(ss); if (isx && lane == 0) ssq0[r] = ss; }
    }
}

__device__ __forceinline__ void ph_swin_copy(const Params& p, int blk0, int nblk) {
    if ((int)blockIdx.x < blk0 || (int)blockIdx.x >= blk0 + nblk) return;
    const int tid = ltid();
    {   const unsigned n4 = 128u * 511u * 64u, stride = nblk * NT_;
#define SW_SRC(i_) (((const float4*)(p.in[I_CWIN] + (size_t)((i_) / (511u * 64u)) * 512 * 256 + 256))[(i_) % (511u * 64u)])
#define SW_DST(i_) (((float4*)(p.out + O_SWIN + (size_t)((i_) / (511u * 64u)) * 512 * 256))[(i_) % (511u * 64u)])
        for (unsigned i0 = (blockIdx.x - blk0) * NT_ + tid; i0 < n4; i0 += 4 * stride) {
            const unsigned i1 = i0 + stride, i2 = i0 + 2 * stride, i3 = i0 + 3 * stride;
            const float4 v0 = SW_SRC(i0), v1 = SW_SRC(i1 < n4 ? i1 : i0), v2 = SW_SRC(i2 < n4 ? i2 : i0), v3 = SW_SRC(i3 < n4 ? i3 : i0);
            SW_DST(i0) = v0; if (i1 < n4) SW_DST(i1) = v1; if (i2 < n4) SW_DST(i2) = v2; if (i3 < n4) SW_DST(i3) = v3; }
#undef SW_SRC
#undef SW_DST
    }
}

__device__ __forceinline__ void ph_memk_norm(const Params& p) {
    const int tid_ = ltid(); const int lane = tid_ & 63, wid = tid_ >> 6;
    const float* raw = (const float*)(p.ws + B_MEMR);
    for (int it = blockIdx.x * NW_ + wid; it < 4 * 8 * 256; it += gridDim.x * NW_) {
        const int l = it / 2048;
        const float4* rr = (const float4*)(raw + (size_t)it * 512); float4* orow = (float4*)(p.out + O_PMEM + (size_t)it * 512);
        float4 v = rr[lane]; const float4 vv = rr[64 + lane]; float ss = dot4(v, v);
        ss += __shfl_xor(ss, 1); ss += __shfl_xor(ss, 2); ss += __shfl_xor(ss, 4); ss += __shfl_xor(ss, 8);
        const float rs = rsqrtf(ss * (1.0f / 64) + EPS);
        const float4 g = ((const float4*)(p.in[I_GMEMK] + l * 64))[lane & 15];
        v.x *= rs * g.x; v.y *= rs * g.y; v.z *= rs * g.z; v.w *= rs * g.w; orow[lane] = v; orow[64 + lane] = vv;
    }
}

__device__ __forceinline__ void ph_mlstm_prompt(const Params& p, int l, float* lds) {
    const bf16_t* P = (const bf16_t*)(p.ws + B_P16); const float* GT = (const float*)(p.ws + B_GT); const float* bif = p.in[I_BIF] + l * 8; float* HR = (float*)(p.ws + B_HRAW);
    const int tid = ltid(), lane = tid & 63, wid = tid >> 6;
    float* red = lds;
    for (int item = blockIdx.x; item < 256; item += gridDim.x) {
        const int es = item & 7, h = (item >> 3) & 3, b = item >> 5;
        const bool act = tid < 384; const int grp = tid >= 192 ? 1 : 0; const int d = act ? tid - grp * 192 : 0;
        const int col0 = h * 192 + es * 24 + (act ? grp : 0) * 12;
        float C[12]; float n = 0.f, m = NEGM;
#pragma unroll
        for (int e = 0; e < 12; ++e) C[e] = 0.f;
        const bf16_t* pr = P + (size_t)(b * SP) * LDA_; const float* gr = GT + (size_t)(b * SP) * GTW;
        float qn = act ? bf2f(pr[h * 192 + d]) : 0.f, kn = act ? bf2f(pr[768 + h * 192 + d]) : 0.f; uint2 vn[3];
#pragma unroll
        for (int e = 0; e < 3; ++e) vn[e] = *(const uint2*)(pr + 1536 + col0 + 4 * e);
        float in_ = gr[h] + bif[h], fn = gr[4 + h] + bif[4 + h];
        for (int t = 0; t < SP; ++t) {
            const float q = qn, k = kn, ig = in_, fg = fn; float v[12];
#pragma unroll
            for (int e = 0; e < 3; ++e) { v[4 * e] = bflo(vn[e].x); v[4 * e + 1] = bfhi(vn[e].x); v[4 * e + 2] = bflo(vn[e].y); v[4 * e + 3] = bfhi(vn[e].y); }
            if (t + 1 < SP) {
                pr += LDA_; gr += GTW;
                qn = act ? bf2f(pr[h * 192 + d]) : 0.f; kn = act ? bf2f(pr[768 + h * 192 + d]) : 0.f;
#pragma unroll
                for (int e = 0; e < 3; ++e) vn[e] = *(const uint2*)(pr + 1536 + col0 + 4 * e);
                in_ = gr[h] + bif[h]; fn = gr[4 + h] + bif[4 + h];
            }
            const float logf = logsigmoidf_(fg);
            const float m_new = fmaxf(logf + m, ig);
            const float a = expf(logf + m - m_new), bb = expf(ig - m_new);
            const float kb = bb * k;
            float part[13];
#pragma unroll
            for (int e = 0; e < 12; ++e) { C[e] = a * C[e] + kb * v[e]; part[e] = q * C[e]; }
            n = a * n + kb; part[12] = q * n;
#pragma unroll
            for (int e = 0; e < 13; ++e) part[e] = wave_sum(part[e]);
            float* rb = red + (t & 1) * 104;
            if (lane == 0) {
#pragma unroll
                for (int e = 0; e < 13; ++e) rb[wid * 13 + e] = part[e];
            }
            __syncthreads();
            if (tid < 24) {
                const int g2 = tid / 12, e = tid % 12;
                const float num = rb[(g2 * 3) * 13 + e] + rb[(g2 * 3 + 1) * 13 + e] + rb[(g2 * 3 + 2) * 13 + e];
                const float den = rb[12] + rb[13 + 12] + rb[26 + 12];
                HR[(size_t)(b * SP + t) * 768 + h * 192 + es * 24 + tid] = num / fmaxf(fabsf(den), expf(-m_new));
            }
            m = m_new;
        }
        if (act) {
            float* co = p.out + O_PC + ((size_t)((l * 8 + b) * 4 + h) * 192 + d) * 192 + es * 24 + grp * 12;
#pragma unroll
            for (int e = 0; e < 12; ++e) co[e] = C[e];
            if (es == 0 && grp == 0) p.out[O_PN + (size_t)((l * 8 + b) * 4 + h) * 192 + d] = n;
        }
        if (es == 0 && tid == 0) p.out[O_PM + (l * 8 + b) * 4 + h] = m;
        __syncthreads();
    }
}
__device__ __forceinline__ void ph_mlstm_sample(const Params& p, int l, float* lds) {
    const bf16_t* P = (const bf16_t*)(p.ws + B_P16); const float* GT = (const float*)(p.ws + B_GT); const float* bif = p.in[I_BIF] + l * 8; float* HR = (float*)(p.ws + B_HRAW);
    const int tid = ltid();
    float* qs = lds + 512; float* ks = lds + 512 + 192; float* n0s = lds + 512 + 384;
    for (int item = blockIdx.x; item < 128 * 4; item += gridDim.x) {
        const int h = item & 3, b = item >> 2; const int row = MP + b;
        const bf16_t* pr = P + (size_t)row * LDA_; const float* gr = GT + (size_t)row * GTW;
        const size_t sidx = (size_t)(l * 128 + b) * 4 + h;
        __syncthreads();
        if (tid < 192) { qs[tid] = bf2f(pr[h * 192 + tid]); ks[tid] = bf2f(pr[768 + h * 192 + tid]); n0s[tid] = p.in[I_SN][sidx * 192 + tid]; }
        __syncthreads();
        const float ig = gr[h] + bif[h], fg = gr[4 + h] + bif[4 + h];
        const float m0 = p.in[I_SM][sidx];
        const float logf = logsigmoidf_(fg);
        const float m_new = fmaxf(logf + m0, ig);
        const float a = expf(logf + m0 - m_new), bb = expf(ig - m_new);
        if (tid < 192) {
            const int e = tid; const float ve = bf2f(pr[1536 + h * 192 + e]);
            const float* C0 = p.in[I_SC] + sidx * 192 * 192; float* C1 = p.out + O_SC + sidx * 192 * 192;
            float num = 0.f, den = 0.f;
            for (int d = 0; d < 192; ++d) {
                const float c = a * C0[d * 192 + e] + bb * ks[d] * ve; C1[d * 192 + e] = c; num += qs[d] * c;
                const float nd = a * n0s[d] + bb * ks[d]; den += qs[d] * nd;
            }
            HR[(size_t)row * 768 + h * 192 + e] = num / fmaxf(fabsf(den), expf(-m_new));
            p.out[O_SN + sidx * 192 + e] = a * n0s[e] + bb * ks[e];
        }
        if (tid == 0) p.out[O_SM + sidx] = m_new;
    }
}
__device__ __forceinline__ void ph_mlstm_fin(const Params& p, int l) {
    const bf16_t* P = (const bf16_t*)(p.ws + B_P16); const float* HR = (const float*)(p.ws + B_HRAW); bf16_t* CATB = (bf16_t*)(p.ws + B_CATB); const float* g = p.in[I_GHN] + l * 192;
    const int tid_ = ltid(); const int lane = tid_ & 63, wid = tid_ >> 6;
    for (int row = blockIdx.x * NW_ + wid; row < MA; row += gridDim.x * NW_) {
        float v[4][3]; bf16_t og[4][3];
#pragma unroll
        for (int h = 0; h < 4; ++h)
#pragma unroll
            for (int i = 0; i < 3; ++i) { v[h][i] = HR[(size_t)row * 768 + h * 192 + lane + 64 * i]; og[h][i] = P[(size_t)row * LDA_ + 2304 + h * 192 + lane + 64 * i]; }
#pragma unroll
        for (int h = 0; h < 4; ++h) { float ss = v[h][0] * v[h][0] + v[h][1] * v[h][1] + v[h][2] * v[h][2]; ss = wave_sum(ss); const float rs = rsqrtf(ss * (1.0f / 192) + EPS);
#pragma unroll
            for (int i = 0; i < 3; ++i) { const int d = lane + 64 * i; CATB[(size_t)row * DM + h * 192 + d] = (bf16_t)f2bf(sigmoidf_(bf2f(og[h][i])) * (v[h][i] * rs * g[d])); } }
    }
}
__device__ __forceinline__ void ph_mem_attn(const Params& p, int l) {
    const int ldp = l < 2 ? LDA_ : LDB_, qoff = l < 2 ? 3072 : 768;
    const bf16_t* P = (const bf16_t*)(p.ws + B_P16); bf16_t* CATB = (bf16_t*)(p.ws + B_CATB); const float* gq = p.in[I_GMEMQ] + l * 64;
    for (int idx4 = blockIdx.x * NT_ + ltid(); idx4 < 16 * MA; idx4 += gridDim.x * NT_) {
        const int part = idx4 & 3, idx = idx4 >> 2;
        const int hh = idx / MA, row = idx % MA;
        const float* kvb = row < MP ? p.out + O_PMEM + (size_t)(l * 8 + row / SP) * 256 * 512 : p.in[I_CMEM] + (size_t)(l * 128 + (row - MP)) * 256 * 512;
        float q[16]; float ss = 0.f;
        const uint4* qp = (const uint4*)(P + (size_t)row * ldp + qoff + hh * 64 + part * 16);
#pragma unroll
        for (int i = 0; i < 2; ++i) { const uint4 t = qp[i]; q[8 * i] = bflo(t.x); q[8 * i + 1] = bfhi(t.x); q[8 * i + 2] = bflo(t.y); q[8 * i + 3] = bfhi(t.y); q[8 * i + 4] = bflo(t.z); q[8 * i + 5] = bfhi(t.z); q[8 * i + 6] = bflo(t.w); q[8 * i + 7] = bfhi(t.w); }
#pragma unroll
        for (int i = 0; i < 16; ++i) ss += q[i] * q[i];
        ss += __shfl_xor(ss, 1); ss += __shfl_xor(ss, 2);
        const float rs = rsqrtf(ss * (1.0f / 64) + EPS) * 0.125f;
#pragma unroll
        for (int i = 0; i < 16; ++i) q[i] *= rs * gq[part * 16 + i];
        float mx = -3e38f, den = 0.f; float o[16];
#pragma unroll
        for (int i = 0; i < 16; ++i) o[i] = 0.f;
        for (int m = 0; m < 256; ++m) {
            const float4* kp = (const float4*)(kvb + (size_t)m * 512 + hh * 64 + part * 16); const float4* vp = (const float4*)(kvb + (size_t)m * 512 + 256 + hh * 64 + part * 16);
            float s = 0.f;
#pragma unroll
            for (int i = 0; i < 4; ++i) { const float4 t = kp[i]; s += q[4 * i] * t.x + q[4 * i + 1] * t.y + q[4 * i + 2] * t.z + q[4 * i + 3] * t.w; }
            s += __shfl_xor(s, 1); s += __shfl_xor(s, 2);
            const float mn = fmaxf(mx, s); const float sc = expf(mx - mn), e = expf(s - mn); mx = mn; den = den * sc + e;
#pragma unroll
            for (int i = 0; i < 4; ++i) { const float4 t = vp[i]; o[4 * i] = o[4 * i] * sc + e * t.x; o[4 * i + 1] = o[4 * i + 1] * sc + e * t.y; o[4 * i + 2] = o[4 * i + 2] * sc + e * t.z; o[4 * i + 3] = o[4 * i + 3] * sc + e * t.w; }
        }
        const float inv = 1.0f / den; uint4* op = (uint4*)(CATB + (size_t)row * DM + 768 + hh * 64 + part * 16);
#pragma unroll
        for (int i = 0; i < 2; ++i) op[i] = make_uint4(pk2(o[8 * i] * inv, o[8 * i + 1] * inv), pk2(o[8 * i + 2] * inv, o[8 * i + 3] * inv), pk2(o[8 * i + 4] * inv, o[8 * i + 5] * inv), pk2(o[8 * i + 6] * inv, o[8 * i + 7] * inv));
    }
}
__device__ __forceinline__ void rows_post_tile(const Params& p, int row0, int t) {
    float* KVR = (float*)(p.ws + B_KVR); const int tid_ = ltid(); const int lane = tid_ & 63, wid = tid_ >> 6;
    const int c2 = lane >> 5, gg = (lane >> 4) & 1, d = (lane & 15) * 4; bf16_t* KVB = (bf16_t*)(p.ws + B_KVB); const size_t KT = (size_t)BP * 2 * SP * 64;
#pragma unroll 1
    for (int rr0 = wid; rr0 < 256; rr0 += 4 * NW_) {
      float4 vv[4];
#pragma unroll
      for (int k = 0; k < 4; ++k) { const int rowk = row0 + rr0 + k * NW_; vv[k] = ((const float4*)(KVR + (size_t)(rowk < MA ? rowk : MA - 1) * 768 + t * 256))[lane]; }
#pragma unroll
      for (int k = 0; k < 4; ++k) {
        const int row = row0 + rr0 + k * NW_; if (row >= MA) continue;
        float* r = KVR + (size_t)row * 768 + t * 256;
        float4 v = vv[k];
        if (t >= 1) {
            float ss = dot4(v, v);
            ss += __shfl_xor(ss, 1); ss += __shfl_xor(ss, 2); ss += __shfl_xor(ss, 4); ss += __shfl_xor(ss, 8);
            if (lane < 32) { const float rs = rsqrtf(ss * (1.0f / 64) + EPS); const float4 gk = ((const float4*)(t == 1 ? p.in[I_GKSLC] : p.in[I_GKWIN]))[lane & 15];
                v.x *= rs * gk.x; v.y *= rs * gk.y; v.z *= rs * gk.z; v.w *= rs * gk.w;
                if (row >= MP) ((float4*)r)[lane] = v; }
        }
        if (row < MP) {
            const int b = row / SP, sp = row % SP; const size_t off = (((size_t)b * 2 + gg) * SP + sp) * 64 + d;
            if (t == 0) { ((float4*)(p.out + O_PCMP + (size_t)row * 256))[lane] = v; *(uint2*)(KVB + (0 + c2) * KT + off) = make_uint2(pk2(v.x, v.y), pk2(v.z, v.w)); }
            else if (t == 2) { if (sp >= SP - 512) ((float4*)(p.out + O_PWIN + (size_t)(b * 512 + sp - (SP - 512)) * 256))[lane] = v; *(uint2*)(KVB + (4 + c2) * KT + off) = make_uint2(pk2(v.x, v.y), pk2(v.z, v.w)); }
            else {
                ((float4*)(p.out + O_PSLC + (size_t)row * 256))[lane] = v;
                const size_t blkbase = (((size_t)b * 2 + gg) * 32 + (sp >> 6)) * 4096;
                if (c2 == 0) { const int nt = (sp >> 4) & 3, fr2 = sp & 15, ks = d >> 5, fg2 = (d >> 3) & 3, e = d & 7;
                    *(uint2*)((bf16_t*)(p.ws + B_SKF) + blkbase + (size_t)(((nt * 2 + ks) * 64 + fg2 * 16 + fr2) * 8 + e)) = make_uint2(pk2(v.x, v.y), pk2(v.z, v.w)); }
                else { const int cs = (sp >> 5) & 1, kk = sp & 31, fg2 = (kk & 15) >> 2, e = (kk & 3) + (kk >= 16 ? 4 : 0), dt = d >> 4, fr2 = d & 15;
                    bf16_t* vf = (bf16_t*)(p.ws + B_SVF) + blkbase + (size_t)(((dt * 2 + cs) * 64 + fg2 * 16 + fr2) * 8 + e);
                    vf[0] = (bf16_t)f2bf(v.x); vf[8] = (bf16_t)f2bf(v.y); vf[16] = (bf16_t)f2bf(v.z); vf[24] = (bf16_t)f2bf(v.w); } }
        } else {
            const int b = row - MP;
            if (t == 0) ((float4*)(p.out + O_SCMP + (size_t)b * 256))[lane] = v; else if (t == 1) ((float4*)(p.out + O_SSLC + (size_t)b * 256))[lane] = v;
            else ((float4*)(p.out + O_SWIN + (size_t)(b * 512 + 511) * 256))[lane] = v;
        }
      }
    }
}
__device__ __forceinline__ float gelu_tanh(float x) { return 0.5f * x * (1.0f + tanhf(0.7978845608028654f * (x + 0.044715f * x * x * x))); }
__device__ __forceinline__ void ph_compress(const Params& p, float* lds) {
    const float* KVR = (const float*)(p.ws + B_KVR); const int tid = ltid();
    float* xs = lds;
    float* hs = lds + 4096;
    const float* w1 = p.in[I_CW1]; const float* w2 = p.in[I_CW2]; const int* pt = (const int*)p.in[I_PT];
    for (int item = blockIdx.x; item < 136 * 127 * 2; item += gridDim.x) {
        const int c = item & 1, n = (item >> 1) % 127, bb = (item >> 1) / 127;
        __syncthreads();
        for (int i = tid; i < 4096; i += NT_) {
            const int g = i >> 11, pp = (i >> 6) & 31, d = i & 63; const int tok = 16 * n + pp; float x;
            if (bb < 8) x = KVR[(size_t)(bb * SP + tok) * 768 + c * 128 + g * 64 + d];
            else { const int b = bb - 8; const int phys = pt[b * 16 + (tok >> 7)]; x = p.in[I_CCMP][((size_t)phys * 128 + (tok & 127)) * 256 + c * 128 + g * 64 + d]; }
            xs[i] = x + p.in[I_CPOS][(pp * 2 + c) * 64 + d];
        }
        __syncthreads();
        if (tid < 256) { const int g = tid >> 7, h = tid & 127; float pre = p.in[I_CB1][c * 128 + h]; const float* wp = w1 + (size_t)c * 2048 * 128 + h; const float* xp = xs + g * 2048;
          for (int i = 0; i < 2048; ++i) pre = fmaf(xp[i], wp[(size_t)i * 128], pre);
          hs[g * 128 + h] = gelu_tanh(pre); }
        __syncthreads();
        if (tid < 128) {
            const int g = tid >> 6, d = tid & 63; float o = p.in[I_CB2][c * 64 + d];
            for (int h = 0; h < 128; ++h) o = fmaf(hs[g * 128 + h], w2[(size_t)(c * 128 + h) * 64 + d], o);
            if (c == 0) { const float ss = wave_sum(o * o); o = o * rsqrtf(ss * (1.0f / 64) + EPS) * p.in[I_GKCMP][d]; }
            ((float*)(p.ws + (c == 0 ? B_CK : B_CV)))[((size_t)bb * 127 + n) * 128 + g * 64 + d] = o;
            bf16_t* kc = (bf16_t*)(p.ws + B_KC16) + ((((size_t)bb * 2 + c) * 2 + g) * 128 + n) * 64 + d; kc[0] = (bf16_t)f2bf(o); if (n == 126) kc[64] = 0;
        }
    }
}
#ifndef NSA_NAIVE_ALL
#define NSA_NAIVE_ALL 0
#endif
__device__ __forceinline__ void row_softmax(float* r, int n, int lane) {
    float mx = NEGM;
    for (int i = lane; i < n; i += 64) mx = fmaxf(mx, r[i]);
    mx = wave_max(mx);
    if (mx <= 0.5f * NEGM) { for (int i = lane; i < n; i += 64) r[i] = 0.f; return; }
    float s = 0.f;
    for (int i = lane; i < n; i += 64) { const float e = r[i] <= 0.5f * NEGM ? 0.f : expf(r[i] - mx); r[i] = e; s += e; }
    s = wave_sum(s); const float inv = 1.0f / s;
    for (int i = lane; i < n; i += 64) r[i] *= inv;
}
__device__ __forceinline__ void ph_nsa(const Params& p, int j, float* lds) {
    const int tid = ltid(), lane = tid & 63, wid = tid >> 6;
    float* qs = lds;
    float* sc = lds + 384;
    float* imp = sc + 3072;
    int* sel = (int*)(imp + 40);
    float* gate = (float*)(sel + 8);
    float* oacc = gate + 24;
    const bf16_t* P = (const bf16_t*)(p.ws + B_P16); const float* GT = (const float*)(p.ws + B_GT); const float* KVR = (const float*)(p.ws + B_KVR); bf16_t* CATB = (bf16_t*)(p.ws + B_CATB);
    const float* table = p.in[I_REL]; const int* pt = (const int*)p.in[I_PT];
    for (int item = blockIdx.x; item < (NSA_NAIVE_ALL ? MA : BS) * 2; item += gridDim.x) {
        const int row = (NSA_NAIVE_ALL ? 0 : MP) + (item >> 1), g = item & 1; const bool smp = row >= MP;
        const int b = smp ? row - MP : row / SP, pos = smp ? PAST : row % SP;
        const bf16_t* pr = P + (size_t)row * LDB_;
        __syncthreads();
        if (wid < 6) { const int z = wid; const float v = bf2f(pr[(g * 6 + z) * 64 + lane]); const float ss = wave_sum(v * v); qs[z * 64 + lane] = v * rsqrtf(ss * (1.0f / 64) + EPS) * p.in[I_GQ][j * 64 + lane]; }
        if (tid >= 384 && tid < 384 + 18) { const int t2 = tid - 384; const int br = t2 / 6, z = t2 % 6; gate[t2] = sigmoidf_(GT[(size_t)row * GTW + br * 12 + g * 6 + z] + p.in[I_BGATE][j * 36 + br * 12 + g * 6 + z]); }
        if (tid < 384) oacc[tid] = 0.f;
        __syncthreads();
        const float* ck = (const float*)(p.ws + B_CK) + (size_t)(smp ? 8 + b : b) * 127 * 128; const float* cv = (const float*)(p.ws + B_CV) + (size_t)(smp ? 8 + b : b) * 127 * 128;
        for (int i = tid; i < 6 * 127; i += NT_) {
            const int z = i / 127, n = i % 127; const int dist = pos - (16 * n + 31); float s = NEGM;
            if (dist >= 0) { const float4* kp = (const float4*)(ck + n * 128 + g * 64); const float4* qp = (const float4*)(qs + z * 64); float a = 0.f;
#pragma unroll 4
                for (int d = 0; d < 16; ++d) a += dot4(kp[d], qp[d]);
                s = a * 0.125f + table[rel_bucket(dist) * 12 + g * 6 + z]; }
            sc[z * 128 + n] = s;
        }
        __syncthreads();
        if (wid < 6) row_softmax(sc + wid * 128, 127, lane);
        __syncthreads();
        const int nslc = smp ? 33 : 32, cur = pos >> 6;
        if (tid < nslc) { const int jb = tid; float s = 0.f;
            for (int z = 0; z < 6; ++z) for (int n = 0; n < 127; ++n) { const int lo = max(16 * n, 64 * jb), hi = min(16 * n + 32, 64 * jb + 64); if (hi > lo) s += sc[z * 128 + n] * (float)(hi - lo) * (1.0f / 16); }
            imp[jb] = s; }
        __syncthreads();
        if (tid == 0) {
            int cnt = 0;
            if (cur + 1 <= 8) { for (int jb = 0; jb <= cur; ++jb) sel[cnt++] = jb; }
            else {
                sel[0] = 0; sel[1] = cur; sel[2] = cur - 1; cnt = 3; unsigned long long taken = 0ull;
                for (int k = 0; k < 5; ++k) { int best = -1; float bv = -1.f;
                    for (int jb = 1; jb <= cur - 2; ++jb) if (!((taken >> jb) & 1ull) && imp[jb] > bv) { bv = imp[jb]; best = jb; }
                    if (best >= 0) { taken |= 1ull << best; sel[cnt++] = best; } }
            }
            for (; cnt < 8; ++cnt) sel[cnt] = -1;
        }
        if (tid < 384) { const int z = tid >> 6, d = tid & 63; float o = 0.f;
            for (int n = 0; n < 127; ++n) o = fmaf(sc[z * 128 + n], cv[n * 128 + g * 64 + d], o);
            oacc[tid] += gate[0 * 6 + z] * o; }
        __syncthreads();
        for (int br = 1; br <= 2; ++br) {
            { const int t = tid;
                const float* kp = nullptr; int dist = -1;
                if (br == 1) {
                    const int blk = sel[t >> 6];
                    if (blk >= 0) { const int tok = blk * 64 + (t & 63); dist = pos - tok;
                        if (dist >= 0) { if (!smp) kp = KVR + (size_t)(b * SP + tok) * 768 + 256 + g * 64;
                            else if (tok < PAST) kp = p.in[I_CSLC] + ((size_t)pt[b * 16 + (tok >> 7)] * 128 + (tok & 127)) * 256 + g * 64;
                            else kp = KVR + (size_t)row * 768 + 256 + g * 64; } }
                } else {
                    const int kpos = pos - 511 + t; dist = 511 - t;
                    if (!smp) { if (kpos >= 0) kp = KVR + (size_t)(b * SP + kpos) * 768 + 512 + g * 64; else dist = -1; }
                    else { if (kpos < PAST) kp = p.in[I_CWIN] + ((size_t)b * 512 + (kpos - (PAST - 512))) * 256 + g * 64; else kp = KVR + (size_t)row * 768 + 512 + g * 64; }
                }
                if (dist >= 0 && kp) {
                    float s[6] = {0.f, 0.f, 0.f, 0.f, 0.f, 0.f};
#pragma unroll 2
                    for (int d = 0; d < 16; ++d) { const float4 kk = ((const float4*)kp)[d];
#pragma unroll
                        for (int z = 0; z < 6; ++z) s[z] += dot4(kk, ((const float4*)(qs + z * 64))[d]); }
                    const int bk = rel_bucket(dist);
#pragma unroll
                    for (int z = 0; z < 6; ++z) sc[z * 512 + t] = s[z] * 0.125f + table[bk * 12 + g * 6 + z];
                } else {
#pragma unroll
                    for (int z = 0; z < 6; ++z) sc[z * 512 + t] = NEGM;
                }
            }
            __syncthreads();
            if (wid < 6) row_softmax(sc + wid * 512, 512, lane);
            __syncthreads();
            if (tid < 384) { const int z = tid >> 6, d = tid & 63; float o = 0.f;
                for (int t = 0; t < 512; ++t) { const float pw = sc[z * 512 + t]; if (pw != 0.f) { const float* vp;
                    if (br == 1) { const int tok = sel[t >> 6] * 64 + (t & 63);
                        if (!smp) vp = KVR + (size_t)(b * SP + tok) * 768 + 256 + 128 + g * 64;
                        else if (tok < PAST) vp = p.in[I_CSLC] + ((size_t)pt[b * 16 + (tok >> 7)] * 128 + (tok & 127)) * 256 + 128 + g * 64;
                        else vp = KVR + (size_t)row * 768 + 256 + 128 + g * 64;
                    } else { const int kpos = pos - 511 + t;
                        if (!smp) vp = KVR + (size_t)(b * SP + kpos) * 768 + 512 + 128 + g * 64;
                        else if (kpos < PAST) vp = p.in[I_CWIN] + ((size_t)b * 512 + (kpos - (PAST - 512))) * 256 + 128 + g * 64;
                        else vp = KVR + (size_t)row * 768 + 512 + 128 + g * 64; }
                    o = fmaf(pw, vp[d], o); } }
                oacc[tid] += gate[br * 6 + z] * o; }
            __syncthreads();
        }
        if (tid < 384) CATB[(size_t)row * DM + g * 384 + tid] = (bf16_t)f2bf(oacc[tid]);
    }
}
constexpr size_t KVB_T = (size_t)BP * 2 * SP * 64;
typedef short v4i16_t __attribute__((ext_vector_type(4)));
typedef short bf16x8_t __attribute__((ext_vector_type(8)));
typedef float f32x4_t __attribute__((ext_vector_type(4)));
typedef unsigned u32x4_t __attribute__((ext_vector_type(4)));
__device__ __forceinline__ bf16x8_t ldtr2(const LAS unsigned char* p0, const LAS unsigned char* p1) {
    const v4i16_t a = __builtin_amdgcn_ds_read_tr16_b64_v4i16((LAS v4i16_t*)p0), b = __builtin_amdgcn_ds_read_tr16_b64_v4i16((LAS v4i16_t*)p1);
    return __builtin_shufflevector(a, b, 0, 1, 2, 3, 4, 5, 6, 7);
}
__device__ __forceinline__ unsigned cvtpk(float lo, float hi) { unsigned r; asm volatile("v_cvt_pk_bf16_f32 %0, %1, %2" : "=v"(r) : "v"(lo), "v"(hi)); return r; }
__device__ __forceinline__ bf16x8_t pack8(f32x4_t a, f32x4_t b) { uint4 w; w.x = cvtpk(a[0], a[1]); w.y = cvtpk(a[2], a[3]); w.z = cvtpk(b[0], b[1]); w.w = cvtpk(b[2], b[3]); return __builtin_bit_cast(bf16x8_t, w); }
__device__ __forceinline__ f32x4_t mfma16(bf16x8_t a, bf16x8_t b, f32x4_t c) { return __builtin_amdgcn_mfma_f32_16x16x32_bf16(a, b, c, 0, 0, 0); }
__device__ __forceinline__ float ex2(float x) { return __builtin_amdgcn_exp2f(x); }
__device__ __forceinline__ float xmax4(float x) {
    auto s = __builtin_amdgcn_permlane16_swap(__float_as_uint(x), __float_as_uint(x), false, false);
    x = fmaxf(__uint_as_float(s[0]), __uint_as_float(s[1]));
    auto t = __builtin_amdgcn_permlane32_swap(__float_as_uint(x), __float_as_uint(x), false, false);
    return fmaxf(__uint_as_float(t[0]), __uint_as_float(t[1]));
}
__device__ __forceinline__ float xsum4(float x) {
    auto s = __builtin_amdgcn_permlane16_swap(__float_as_uint(x), __float_as_uint(x), false, false);
    x = __uint_as_float(s[0]) + __uint_as_float(s[1]);
    auto t = __builtin_amdgcn_permlane32_swap(__float_as_uint(x), __float_as_uint(x), false, false);
    return __uint_as_float(t[0]) + __uint_as_float(t[1]);
}
constexpr float LOG2E = 1.4426950408889634f, NINF = -__builtin_inff();
constexpr int KROW = 144;

__device__ __forceinline__ void ph_nsa_fast(const Params& p, int j, LAS unsigned char* lds) {
    const int tid = ltid(), lane0 = tid & 63, w = tid >> 6;
    unsigned char* ws = p.ws;
    const bf16_t* P16 = (const bf16_t*)(ws + B_P16); const float* GT = (const float*)(ws + B_GT); bf16_t* CATB = (bf16_t*)(ws + B_CATB);
    const bf16_t* KVB = (const bf16_t*)(ws + B_KVB); const bf16_t* KC16 = (const bf16_t*)(ws + B_KC16);
    LAS unsigned char* Kw = lds;
    LAS unsigned char* Vw = lds + 18432;
    LAS unsigned char* Kc = lds + 36864;
    LAS unsigned char* Vc = lds + 55296;
    LAS float* biasT = (LAS float*)(lds + 73728);
    LAS float* impL = (LAS float*)(lds + 73728 + 3072);
    LAS int* selL = (LAS int*)(lds + 73728 + 3072 + 16384);
    const float* table = p.in[I_REL]; const float* gq = p.in[I_GQ] + j * 64; const float* bgate = p.in[I_BGATE] + j * 36;
    for (int unit = blockIdx.x; unit < 256; unit += gridDim.x) {
        int lane_a = lane0; asm volatile("" : "+v"(lane_a)); const int lane = lane_a, fr = lane & 15, fg = lane >> 4;
        const int g = unit & 1, b = (unit >> 1) & 7, tile = unit >> 4, t0 = tile * 128, tw = t0 + 16 * w, trow = tw + fr;
        TSUB_BEGIN();
        __syncthreads();
        for (int i = tid; i < 2048; i += NT_) { const int tsel = i >> 10, r = (i >> 3) & 127, ch = i & 7;
            const u32x4_t v = *(const u32x4_t*)(KC16 + (((size_t)b * 2 + tsel) * 2 + g) * 128 * 64 + r * 64 + ch * 8);
            *(LAS u32x4_t*)((tsel ? Vc : Kc) + r * KROW + ch * 16) = v; }
        for (int i = tid; i < 768; i += NT_) { const int d = i / 6, z = i % 6; biasT[i] = table[rel_bucket_alu(d) * 12 + g * 6 + z] * LOG2E; }
        if (tid < 64) ((LAS float*)(lds + 73728 + 3072 + 16384 + 4096))[tid] = gq[tid] * (0.125f * LOG2E);
        __syncthreads();
        const bf16_t* qrow = P16 + (size_t)(b * SP + trow) * LDB_ + g * 384;
        LAS float* gqL = (LAS float*)(lds + 73728 + 3072 + 16384 + 4096);
#define FETCH_Q(z_, ra_, rb_) do { ra_ = *(const uint4*)(qrow + (z_) * 64 + fg * 8); rb_ = *(const uint4*)(qrow + (z_) * 64 + 32 + fg * 8); } while (0)
#define LOAD_Q(z_, q0_, q1_) do { uint4 r0, r1; FETCH_Q(z_, r0, r1); FINISH_Q(r0, r1, q0_, q1_); } while (0)
#define FINISH_Q(r0, r1, q0_, q1_) do { \
            float v[16] = {bflo(r0.x), bfhi(r0.x), bflo(r0.y), bfhi(r0.y), bflo(r0.z), bfhi(r0.z), bflo(r0.w), bfhi(r0.w), bflo(r1.x), bfhi(r1.x), bflo(r1.y), bfhi(r1.y), bflo(r1.z), bfhi(r1.z), bflo(r1.w), bfhi(r1.w)}; \
            float ss = 0.f; _Pragma("unroll") for (int i = 0; i < 16; ++i) ss += v[i] * v[i]; \
            ss = xsum4(ss); const float rs = rsqrtf(ss * (1.0f / 64) + EPS); { const f32x4_t g0 = *(const LAS f32x4_t*)(gqL + fg * 8), g1 = *(const LAS f32x4_t*)(gqL + fg * 8 + 4), g2 = *(const LAS f32x4_t*)(gqL + 32 + fg * 8), g3 = *(const LAS f32x4_t*)(gqL + 32 + fg * 8 + 4); \
              _Pragma("unroll") for (int i = 0; i < 4; ++i) { v[i] *= rs * g0[i]; v[4 + i] *= rs * g1[i]; v[8 + i] *= rs * g2[i]; v[12 + i] *= rs * g3[i]; } } \
            q0_ = pack8((f32x4_t){v[0], v[1], v[2], v[3]}, (f32x4_t){v[4], v[5], v[6], v[7]}); q1_ = pack8((f32x4_t){v[8], v[9], v[10], v[11]}, (f32x4_t){v[12], v[13], v[14], v[15]}); } while (0)
        const float* gtrow = GT + (size_t)(b * SP + trow) * GTW;
#pragma unroll 1
        for (int hp = 0; hp < 2; ++hp) {
        bf16x8_t qf[3][2];
#pragma unroll
        for (int z = 0; z < 3; ++z) LOAD_Q(hp * 3 + z, qf[z][0], qf[z][1]);
        f32x4_t O[3][4]; float mrun[3], lrun[3];
#pragma unroll
        for (int z = 0; z < 3; ++z) { mrun[z] = NINF; lrun[z] = 0.f;
#pragma unroll
            for (int dt = 0; dt < 4; ++dt) O[z][dt] = (f32x4_t){0.f, 0.f, 0.f, 0.f}; }
        const bf16_t* WK = KVB + 4 * KVB_T + ((size_t)b * 2 + g) * SP * 64; const bf16_t* WV = KVB + 5 * KVB_T + ((size_t)b * 2 + g) * SP * 64;
        u32x4_t rst[4];
#define WIN_LOAD(it_) do { const int k128_ = t0 - 512 + 128 * (it_); _Pragma("unroll") for (int q_ = 0; q_ < 4; ++q_) { const int i_ = tid + NT_ * q_, tsel_ = i_ >> 10, r_ = (i_ >> 3) & 127, ch_ = i_ & 7; const int tok_ = k128_ + r_; \
            rst[q_] = (u32x4_t){0u, 0u, 0u, 0u}; if (tok_ >= 0) rst[q_] = *(const u32x4_t*)((tsel_ ? WV : WK) + (size_t)tok_ * 64 + ch_ * 8); } } while (0)
#define WIN_STORE() do { _Pragma("unroll") for (int q_ = 0; q_ < 4; ++q_) { const int i_ = tid + NT_ * q_, tsel_ = i_ >> 10, r_ = (i_ >> 3) & 127, ch_ = i_ & 7; *(LAS u32x4_t*)((tsel_ ? Vw : Kw) + r_ * KROW + ch_ * 16) = rst[q_]; } } while (0)
        WIN_LOAD(0);
        __syncthreads();
        WIN_STORE();
#pragma unroll 1
        for (int it = 0; it < 5; ++it) {
            const int k128 = t0 - 512 + 128 * it;
            BAR_LDS();
            if (it + 1 < 5) WIN_LOAD(it + 1);
#pragma unroll 1
            for (int sc = 0; sc < 4; ++sc) {
                const int kb = k128 + 32 * sc;
                if (kb > tw + 15 || kb + 31 < tw - 511 || kb + 31 < 0) continue;
                const bool fast = (kb + 31 <= tw - 113) && (kb >= tw + 15 - 511) && kb >= 0;
                bf16x8_t kf[2][2], vf[4];
#pragma unroll
                for (int nt = 0; nt < 2; ++nt)
#pragma unroll
                    for (int ks = 0; ks < 2; ++ks) kf[nt][ks] = *(const LAS bf16x8_t*)(Kw + (32 * sc + 16 * nt + fr) * KROW + (ks * 32 + fg * 8) * 2);
#pragma unroll
                for (int dt = 0; dt < 4; ++dt) { const LAS unsigned char* vp = Vw + (32 * sc + 4 * fg + (fr >> 2)) * KROW + (16 * dt + 4 * (fr & 3)) * 2; vf[dt] = ldtr2(vp, vp + 16 * KROW); }
#pragma unroll
                for (int z = 0; z < 3; ++z) {
                    f32x4_t s0 = (f32x4_t){0.f, 0.f, 0.f, 0.f}, s1 = s0;
                    s0 = mfma16(kf[0][0], qf[z][0], s0); s0 = mfma16(kf[0][1], qf[z][1], s0);
                    s1 = mfma16(kf[1][0], qf[z][0], s1); s1 = mfma16(kf[1][1], qf[z][1], s1);
                    if (fast) { const float cb = biasT[127 * 6 + hp * 3 + z]; s0 = s0 + cb; s1 = s1 + cb; }
                    else {
#pragma unroll
                        for (int jj = 0; jj < 4; ++jj) { const int key0 = kb + 4 * fg + jj, d0 = trow - key0, d1 = d0 - 16;
                            s0[jj] = (d0 >= 0 && d0 < 512 && key0 >= 0) ? s0[jj] + biasT[min(d0, 127) * 6 + hp * 3 + z] : NINF;
                            s1[jj] = (d1 >= 0 && d1 < 512 && key0 + 16 >= 0) ? s1[jj] + biasT[min(d1, 127) * 6 + hp * 3 + z] : NINF; }
                    }
                    float mx = fmaxf(fmaxf(fmaxf(s0[0], s0[1]), fmaxf(s0[2], s0[3])), fmaxf(fmaxf(s1[0], s1[1]), fmaxf(s1[2], s1[3])));
                    mx = xmax4(mx);
                    float msafe;
                    if (__any(mx > mrun[z] + 8.f)) {
                        const float mnew = fmaxf(mrun[z], mx); msafe = mnew == NINF ? 0.f : mnew;
                        const float alpha = ex2(mrun[z] - msafe);
                        mrun[z] = mnew; lrun[z] = lrun[z] * alpha;
#pragma unroll
                        for (int dt = 0; dt < 4; ++dt) O[z][dt] = O[z][dt] * alpha;
                    } else msafe = mrun[z] == NINF ? 0.f : mrun[z];
                    f32x4_t p0, p1;
#pragma unroll
                    for (int jj = 0; jj < 4; ++jj) { p0[jj] = ex2(s0[jj] - msafe); p1[jj] = ex2(s1[jj] - msafe); }
                    lrun[z] = lrun[z] + (((p0[0] + p0[1]) + (p0[2] + p0[3])) + ((p1[0] + p1[1]) + (p1[2] + p1[3])));
                    const bf16x8_t pf = pack8(p0, p1);
#pragma unroll
                    for (int dt = 0; dt < 4; ++dt) O[z][dt] = mfma16(vf[dt], pf, O[z][dt]);
                }
            }
            if (it + 1 < 5) { BAR_LDS(); WIN_STORE(); }
        }
#undef WIN_LOAD
#undef WIN_STORE
#pragma unroll
        for (int z = 0; z < 3; ++z) { const int hz2 = hp * 3 + z; const float lt = xsum4(lrun[z]); const float gw = sigmoidf_(gtrow[24 + g * 6 + hz2] + bgate[24 + g * 6 + hz2]); const float sc = gw / lt;
            bf16_t* orow = CATB + (size_t)(b * SP + trow) * DM + (g * 6 + hz2) * 64;
#pragma unroll
            for (int dt = 0; dt < 4; ++dt) { const f32x4_t v = O[z][dt] * sc; *(uint2*)(orow + 16 * dt + 4 * fg) = make_uint2(cvtpk(v[0], v[1]), cvtpk(v[2], v[3])); } }
        }
        asm volatile("s_waitcnt vmcnt(0)" ::: "memory");
        TSUB_END(0);
        float impacc[8];
#pragma unroll
        for (int nt = 0; nt < 8; ++nt) impacc[nt] = 0.f;
        const int nmax = trow >= 31 ? (trow - 31) >> 4 : -1;
        uint4 rqa_c, rqb_c; FETCH_Q(0, rqa_c, rqb_c);
#pragma unroll 1
        for (int z = 0; z < 6; ++z) {
            bf16_t* orow = CATB + (size_t)(b * SP + trow) * DM + (g * 6 + z) * 64; unsigned long long oldc[4];
#pragma unroll
            for (int dt = 0; dt < 4; ++dt) oldc[dt] = __hip_atomic_load((unsigned long long*)(orow + 16 * dt + 4 * fg), __ATOMIC_RELAXED, __HIP_MEMORY_SCOPE_AGENT);
            const float gcraw = gtrow[g * 6 + z];
            f32x4_t s[8]; bf16x8_t qz[2]; { const uint4 ra = rqa_c, rb = rqb_c; if (z + 1 < 6) FETCH_Q(z + 1, rqa_c, rqb_c); FINISH_Q(ra, rb, qz[0], qz[1]); }
#pragma unroll
            for (int nt = 0; nt < 8; ++nt) { s[nt] = (f32x4_t){0.f, 0.f, 0.f, 0.f};
#pragma unroll
                for (int ks = 0; ks < 2; ++ks) { const bf16x8_t kf = *(const LAS bf16x8_t*)(Kc + (16 * nt + fr) * KROW + (ks * 32 + fg * 8) * 2); s[nt] = mfma16(kf, qz[ks], s[nt]); } }
            float mx = NINF;
#pragma unroll
            for (int nt = 0; nt < 8; ++nt)
#pragma unroll
                for (int jj = 0; jj < 4; ++jj) { const int n = 16 * nt + 4 * fg + jj; const int dist = trow - 16 * n - 31;
                    const float v = (n <= nmax && n <= 126) ? s[nt][jj] + biasT[min(dist, 127) * 6 + z] : NINF; s[nt][jj] = v; mx = fmaxf(mx, v); }
            asm volatile("" ::: "memory");
            mx = xmax4(mx); const float msafe = mx == NINF ? 0.f : mx; float sum = 0.f;
#pragma unroll
            for (int nt = 0; nt < 8; ++nt)
#pragma unroll
                for (int jj = 0; jj < 4; ++jj) { const float e = ex2(s[nt][jj] - msafe); s[nt][jj] = e; sum += e; }
            sum = xsum4(sum); const float inv = sum > 0.f ? 1.0f / sum : 0.f;
            float p3prev = 0.f;
#pragma unroll
            for (int nt = 0; nt < 8; ++nt) { s[nt] = s[nt] * inv;
                const float p3 = s[nt][3]; const float up = __shfl(p3, (lane + 48) & 63);
                const float prev_tile = __shfl(p3prev, (lane + 48) & 63);
                impacc[nt] += 2.0f * (s[nt][0] + s[nt][1] + s[nt][2]) + p3 + (fg == 0 ? prev_tile : up);
                p3prev = p3; }
            f32x4_t oc[4];
#pragma unroll
            for (int dt = 0; dt < 4; ++dt) oc[dt] = (f32x4_t){0.f, 0.f, 0.f, 0.f};
#pragma unroll
            for (int c2 = 0; c2 < 4; ++c2) { const bf16x8_t pf = pack8(s[2 * c2], s[2 * c2 + 1]);
#pragma unroll
                for (int dt = 0; dt < 4; ++dt) { const LAS unsigned char* vp = Vc + (32 * c2 + 4 * fg + (fr >> 2)) * KROW + (16 * dt + 4 * (fr & 3)) * 2; oc[dt] = mfma16(ldtr2(vp, vp + 16 * KROW), pf, oc[dt]); }
                asm volatile("" ::: "memory"); }
            const float gc = sigmoidf_(gcraw + bgate[g * 6 + z]);
#pragma unroll
            for (int dt = 0; dt < 4; ++dt) { const unsigned long long o64 = oldc[dt];
                const f32x4_t v = oc[dt] * gc + (f32x4_t){bflo((unsigned)o64), bfhi((unsigned)o64), bflo((unsigned)(o64 >> 32)), bfhi((unsigned)(o64 >> 32))};
                *(uint2*)(orow + 16 * dt + 4 * fg) = make_uint2(cvtpk(v[0], v[1]), cvtpk(v[2], v[3])); }
        }
        TSUB_END(1);
#pragma unroll
        for (int nt = 0; nt < 8; ++nt) impL[(w * 16 + fr) * 32 + 4 * nt + fg] = impacc[nt];
        asm volatile("s_waitcnt lgkmcnt(0)" ::: "memory");
        if (lane < 16) {
            const int t = tw + lane, cur = t >> 6; LAS int* so = selL + (w * 16 + lane) * 8; const LAS float* im = impL + (w * 16 + lane) * 32;
            int cnt = 0;
            if (cur + 1 <= 8) { for (int jb = 0; jb <= cur; ++jb) so[cnt++] = jb; }
            else {
                so[1] = 0; so[3] = cur; so[5] = cur - 1; unsigned taken = 0u;
                for (int k = 0; k < 5; ++k) { int best = -1; float bv = -1.f;
                    for (int jb = 1; jb <= cur - 2; ++jb) { const float v = im[jb]; if (!((taken >> jb) & 1u) && v > bv) { bv = v; best = jb; } }
                    taken |= 1u << best; so[k < 3 ? 2 * k : 3 + k] = best; }
                cnt = 8; }
            for (; cnt < 8; ++cnt) so[cnt] = -1;
        }
        asm volatile("s_waitcnt vmcnt(0) lgkmcnt(0)" ::: "memory");
        const bf16_t* SKF = (const bf16_t*)(ws + B_SKF) + ((size_t)b * 2 + g) * 32 * 4096; const bf16_t* SVF = (const bf16_t*)(ws + B_SVF) + ((size_t)b * 2 + g) * 32 * 4096;
        const int c0 = 2 * tile;
        TSUB_END(2);
        __syncthreads();
        for (int i = tid; i < 4 * 1024; i += NT_) { const int slot = i >> 10, r = i & 1023; const int blk = slot == 0 ? 0 : c0 - 2 + slot;
            if (blk >= 0 && blk < 32) { const u32x4_t v = *(const u32x4_t*)((r < 512 ? SKF : SVF) + (size_t)blk * 4096 + (r & 511) * 8); *(LAS u32x4_t*)(lds + slot * 16384 + r * 16) = v; } }
        __syncthreads();
        { int lane_b = lane0; asm volatile("" : "+v"(lane_b)); const int lane = lane_b, fr = lane & 15, fg = lane >> 4;
        const int hz = fr < 6 ? fr : 5;
        uint4 rqa, rqb;
        { const bf16_t* qrow = P16 + ((size_t)b * SP + tw) * LDB_ + g * 384 + hz * 64; rqa = *(const uint4*)(qrow + fg * 8); rqb = *(const uint4*)(qrow + 32 + fg * 8); }
#pragma unroll 1
        for (int ti = 0; ti < 16; ++ti) {
            const int t = tw + ti; const size_t row = (size_t)b * SP + t;
            bf16x8_t qs[2];
            const uint4 r0 = rqa, r1 = rqb;
            if (ti + 1 < 16) { const bf16_t* qrow = P16 + (row + 1) * LDB_ + g * 384 + hz * 64; rqa = *(const uint4*)(qrow + fg * 8); rqb = *(const uint4*)(qrow + 32 + fg * 8); }
            bf16_t* orow = CATB + row * DM + (g * 6 + hz) * 64; unsigned long long oldv[4];
#pragma unroll
            for (int dt = 0; dt < 4; ++dt) oldv[dt] = __hip_atomic_load((unsigned long long*)(orow + 16 * dt + 4 * fg), __ATOMIC_RELAXED, __HIP_MEMORY_SCOPE_AGENT);
            const float graw = GT[row * GTW + 12 + g * 6 + hz];
            {
              float v[16] = {bflo(r0.x), bfhi(r0.x), bflo(r0.y), bfhi(r0.y), bflo(r0.z), bfhi(r0.z), bflo(r0.w), bfhi(r0.w), bflo(r1.x), bfhi(r1.x), bflo(r1.y), bfhi(r1.y), bflo(r1.z), bfhi(r1.z), bflo(r1.w), bfhi(r1.w)};
              float ss = 0.f;
#pragma unroll
              for (int i = 0; i < 16; ++i) ss += v[i] * v[i];
              ss = xsum4(ss); const float rs = rsqrtf(ss * (1.0f / 64) + EPS) * (0.125f * LOG2E);
#pragma unroll
              for (int i = 0; i < 8; ++i) { v[i] *= rs * gq[fg * 8 + i]; v[8 + i] *= rs * gq[32 + fg * 8 + i]; }
              qs[0] = pack8((f32x4_t){v[0], v[1], v[2], v[3]}, (f32x4_t){v[4], v[5], v[6], v[7]});
              qs[1] = pack8((f32x4_t){v[8], v[9], v[10], v[11]}, (f32x4_t){v[12], v[13], v[14], v[15]}); }
            f32x4_t os[4]; float ms = NINF, ls = 0.f;
#pragma unroll
            for (int dt = 0; dt < 4; ++dt) os[dt] = (f32x4_t){0.f, 0.f, 0.f, 0.f};
#define SLC_LOADK(KF, blk_) do { const int slot_ = (blk_) == 0 ? 0 : ((blk_) >= c0 - 1 ? (blk_) - c0 + 2 : -1); \
                if (slot_ >= 0) { const LAS unsigned char* fb_ = lds + slot_ * 16384 + lane * 16; \
                    _Pragma("unroll") for (int nt = 0; nt < 4; ++nt) _Pragma("unroll") for (int ks = 0; ks < 2; ++ks) KF[nt][ks] = *(const LAS bf16x8_t*)(fb_ + (nt * 2 + ks) * 1024); \
                } else { const bf16_t* kb_ = SKF + (size_t)(blk_) * 4096 + lane * 8; \
                    _Pragma("unroll") for (int nt = 0; nt < 4; ++nt) _Pragma("unroll") for (int ks = 0; ks < 2; ++ks) KF[nt][ks] = *(const bf16x8_t*)(kb_ + (nt * 2 + ks) * 512); } } while (0)
#define SLC_LOADV(VF, blk_) do { const int slot_ = (blk_) == 0 ? 0 : ((blk_) >= c0 - 1 ? (blk_) - c0 + 2 : -1); \
                if (slot_ >= 0) { const LAS unsigned char* fb_ = lds + slot_ * 16384 + lane * 16; \
                    _Pragma("unroll") for (int dt = 0; dt < 4; ++dt) _Pragma("unroll") for (int cs = 0; cs < 2; ++cs) VF[dt][cs] = *(const LAS bf16x8_t*)(fb_ + 8192 + (dt * 2 + cs) * 1024); \
                } else { const bf16_t* vb_ = SVF + (size_t)(blk_) * 4096 + lane * 8; \
                    _Pragma("unroll") for (int dt = 0; dt < 4; ++dt) _Pragma("unroll") for (int cs = 0; cs < 2; ++cs) VF[dt][cs] = *(const bf16x8_t*)(vb_ + (dt * 2 + cs) * 512); } } while (0)
#define SLC_COMPUTE(KF, VF, blk_, nblk_) do { const int tok0 = (blk_) * 64; f32x4_t s[4]; \
                _Pragma("unroll") for (int nt = 0; nt < 4; ++nt) { s[nt] = (f32x4_t){0.f, 0.f, 0.f, 0.f}; s[nt] = mfma16(KF[nt][0], qs[0], s[nt]); s[nt] = mfma16(KF[nt][1], qs[1], s[nt]); } \
                float mx = NINF; \
                if (tok0 + 63 <= t - 113) { const float cb = biasT[127 * 6 + hz]; \
                    _Pragma("unroll") for (int nt = 0; nt < 4; ++nt) { s[nt] = s[nt] + cb; mx = fmaxf(mx, fmaxf(fmaxf(s[nt][0], s[nt][1]), fmaxf(s[nt][2], s[nt][3]))); } } \
                else { _Pragma("unroll") for (int nt = 0; nt < 4; ++nt) _Pragma("unroll") for (int jj = 0; jj < 4; ++jj) { const int dist = t - (tok0 + 16 * nt + 4 * fg + jj); const float v = dist >= 0 ? s[nt][jj] + biasT[min(dist, 127) * 6 + hz] : NINF; s[nt][jj] = v; mx = fmaxf(mx, v); } } \
                mx = xmax4(mx); \
                float msafe; \
                if (__any(mx > ms + 8.f)) { const float mnew = fmaxf(ms, mx); msafe = mnew == NINF ? 0.f : mnew; const float alpha = ex2(ms - msafe); ms = mnew; ls = ls * alpha; \
                    _Pragma("unroll") for (int dt = 0; dt < 4; ++dt) os[dt] = os[dt] * alpha; } \
                else msafe = ms == NINF ? 0.f : ms; \
                float sum = 0.f; \
                _Pragma("unroll") for (int nt = 0; nt < 4; ++nt) _Pragma("unroll") for (int jj = 0; jj < 4; ++jj) { const float e = ex2(s[nt][jj] - msafe); s[nt][jj] = e; sum += e; } \
                ls = ls + sum; \
                _Pragma("unroll") for (int cs = 0; cs < 2; ++cs) { const bf16x8_t pf = pack8(s[2 * cs], s[2 * cs + 1]); \
                    _Pragma("unroll") for (int dt = 0; dt < 4; ++dt) os[dt] = mfma16(VF[dt][cs], pf, os[dt]); } \
                if ((nblk_) >= 0) SLC_LOADV(VF, nblk_); } while (0)
            const LAS int* sbl = selL + (w * 16 + ti) * 8; int nb = 0;
#pragma unroll
            for (int bi = 0; bi < 8; ++bi) nb += sbl[bi] >= 0 ? 1 : 0;
            bf16x8_t kfC[4][2], kfN[4][2], vfX[4][2];
            { const int b0 = sbl[0]; SLC_LOADK(kfN, b0); SLC_LOADV(vfX, b0); }
#pragma unroll 1
            for (int bi = 0; bi < nb; ++bi) {
                const int bA = sbl[bi], bB = bi + 1 < nb ? sbl[bi + 1] : -1;
#pragma unroll
                for (int nt = 0; nt < 4; ++nt) { kfC[nt][0] = kfN[nt][0]; kfC[nt][1] = kfN[nt][1]; }
                if (bB >= 0) SLC_LOADK(kfN, bB);
                SLC_COMPUTE(kfC, vfX, bA, bB);
            }
#undef SLC_LOADK
#undef SLC_LOADV
#undef SLC_COMPUTE
            const float lt = xsum4(ls);
            if (fr < 6) {
                const float gs = sigmoidf_(graw + bgate[12 + g * 6 + fr]); const float sc = lt > 0.f ? gs / lt : 0.f;
#pragma unroll
                for (int dt = 0; dt < 4; ++dt) { const unsigned long long o64 = oldv[dt]; const f32x4_t v = os[dt] * sc + (f32x4_t){bflo((unsigned)o64), bfhi((unsigned)o64), bflo((unsigned)(o64 >> 32)), bfhi((unsigned)(o64 >> 32))};
                    *(uint2*)(orow + 16 * dt + 4 * fg) = make_uint2(cvtpk(v[0], v[1]), cvtpk(v[2], v[3])); }
            }
        }
        }
        TSUB_END(3);
    }
}

constexpr int CW_P = 272, CW_BUF = 128 * CW_P;
template <bool SMP> __device__ __forceinline__ void compress_job(const Params& p, int bb, int c, int g, LAS unsigned char* lds) {
    const int tid = ltid(), lane = tid & 63, w = tid >> 6, fr = lane & 15, fg = lane >> 4, n = 16 * w + fr;
    unsigned char* ws = p.ws;
    const bf16_t* W1T = (const bf16_t*)(ws + B_W1T) + (size_t)c * 128 * 2048; const bf16_t* W2T = (const bf16_t*)(ws + B_W2T) + (size_t)c * 64 * 128;
    f32x4_t acc[8];
#pragma unroll
    for (int t = 0; t < 8; ++t) acc[t] = (f32x4_t){0.f, 0.f, 0.f, 0.f};
    const bf16_t* ap = (const bf16_t*)(ws + B_KVB) + (size_t)c * KVB_T + ((size_t)(SMP ? 0 : bb) * 2 + g) * SP * 64 + (size_t)n * 1024 + fg * 8;
    const float* pg0 = nullptr; const float* pg1 = nullptr; int tsplit = 0;
    if (SMP) { const int* pt = (const int*)p.in[I_PT] + (bb - 8) * 16; const int t0 = 16 * n > 2016 ? 2016 : 16 * n; const int pa = t0 >> 7, pb = (t0 + 31) >> 7;
        pg0 = p.in[I_CCMP] + (((size_t)pt[pa] * 128 + (t0 & 127)) * 4 + c * 2 + g) * 64 + fg * 8; tsplit = pb == pa ? 64 : 128 - (t0 & 127);
        pg1 = p.in[I_CCMP] + (((size_t)pt[pb] * 128) * 4 + c * 2 + g) * 64 + fg * 8 - (size_t)tsplit * 256; }
    u32x4_t rb[4]; bf16x8_t acur[4]; f32x4_t araw[SMP ? 8 : 1]; bf16x8_t anext[SMP ? 1 : 4];
#define CW_LOADB(st_) do { _Pragma("unroll") for (int i_ = 0; i_ < 4; ++i_) { const int ch_ = tid + NT_ * i_, r_ = ch_ >> 4, cc_ = ch_ & 15; rb[i_] = *(const u32x4_t*)(W1T + (size_t)r_ * 2048 + (st_) * 128 + cc_ * 8); } } while (0)
#define CW_STOREB(buf_) do { _Pragma("unroll") for (int i_ = 0; i_ < 4; ++i_) { const int ch_ = tid + NT_ * i_, r_ = ch_ >> 4, cc_ = ch_ & 15; *(LAS u32x4_t*)(lds + (buf_) * CW_BUF + r_ * CW_P + cc_ * 16) = rb[i_]; } } while (0)
#define CW_LOADA(st_) do { _Pragma("unroll") for (int u_ = 0; u_ < 4; ++u_) { const int s_ = (st_) * 4 + u_; \
        if (SMP) { const int tk_ = s_ >> 1; const float* src_ = (tk_ < tsplit ? pg0 : pg1) + (size_t)tk_ * 256 + (s_ & 1) * 32; araw[2 * u_] = *(const f32x4_t*)src_; araw[2 * u_ + 1] = *(const f32x4_t*)(src_ + 4); } \
        else anext[u_] = *(const bf16x8_t*)(ap + s_ * 32); } } while (0)
#define CW_TAKEA() do { _Pragma("unroll") for (int u_ = 0; u_ < 4; ++u_) { if (SMP) acur[u_] = pack8(araw[2 * u_], araw[2 * u_ + 1]); else acur[u_] = anext[u_]; } } while (0)
    __syncthreads();
    CW_LOADB(0); CW_LOADA(0); CW_STOREB(0); CW_TAKEA();
    BAR_LDS();
#pragma unroll 1
    for (int st = 0; st < 16; ++st) {
        if (st + 1 < 16) { CW_LOADB(st + 1); CW_LOADA(st + 1); }
        const LAS unsigned char* bb_ = lds + (st & 1) * CW_BUF + fr * CW_P + fg * 16;
#pragma unroll
        for (int u = 0; u < 4; ++u)
#pragma unroll
            for (int t = 0; t < 8; ++t) acc[t] = mfma16(*(const LAS bf16x8_t*)(bb_ + t * 16 * CW_P + u * 64), acur[u], acc[t]);
        if (st + 1 < 16) { CW_STOREB((st + 1) & 1); CW_TAKEA(); }
        BAR_LDS();
    }
#undef CW_LOADB
#undef CW_STOREB
#undef CW_LOADA
#undef CW_TAKEA
    const float* peb = (const float*)(ws + B_PEB) + c * 128;
#pragma unroll
    for (int t = 0; t < 8; ++t) { const f32x4_t pb = *(const f32x4_t*)(peb + 16 * t + 4 * fg);
#pragma unroll
        for (int j = 0; j < 4; ++j) { const float x = acc[t][j] + pb[j]; const float u2 = 1.5957691216057308f * (x + 0.044715f * x * x * x);
            const float th = 1.0f - 2.0f * __builtin_amdgcn_rcpf(1.0f + ex2(u2 * LOG2E)); acc[t][j] = 0.5f * x * (1.0f + th); } }
    f32x4_t o[4];
#pragma unroll
    for (int dt = 0; dt < 4; ++dt) o[dt] = (f32x4_t){0.f, 0.f, 0.f, 0.f};
#pragma unroll
    for (int ks = 0; ks < 4; ++ks) { const bf16x8_t gf = pack8(acc[2 * ks], acc[2 * ks + 1]);
#pragma unroll
        for (int dt = 0; dt < 4; ++dt) { const bf16_t* wp = W2T + (size_t)(16 * dt + fr) * 128 + 32 * ks + 4 * fg; const uint2 x0 = *(const uint2*)wp, x1 = *(const uint2*)(wp + 16);
            o[dt] = mfma16(__builtin_bit_cast(bf16x8_t, make_uint4(x0.x, x0.y, x1.x, x1.y)), gf, o[dt]); } }
    float ss = 0.f;
#pragma unroll
    for (int dt = 0; dt < 4; ++dt) { const f32x4_t b2 = *(const f32x4_t*)(p.in[I_CB2] + c * 64 + 16 * dt + 4 * fg); o[dt] = o[dt] + b2; ss += (o[dt][0] * o[dt][0] + o[dt][1] * o[dt][1]) + (o[dt][2] * o[dt][2] + o[dt][3] * o[dt][3]); }
    if (c == 0) { ss = xsum4(ss); const float rs = rsqrtf(ss * (1.0f / 64) + EPS);
#pragma unroll
        for (int dt = 0; dt < 4; ++dt) { const f32x4_t gk = *(const f32x4_t*)(p.in[I_GKCMP] + 16 * dt + 4 * fg); o[dt] = o[dt] * rs * gk; } }
    bf16_t* kc = (bf16_t*)(ws + B_KC16) + ((((size_t)bb * 2 + c) * 2 + g) * 128 + n) * 64;
    float* cf = (float*)(ws + (c == 0 ? B_CK : B_CV)) + ((size_t)bb * 127 + n) * 128 + g * 64;
#pragma unroll
    for (int dt = 0; dt < 4; ++dt) {
        if (n < 127) { *(f32x4_t*)(cf + 16 * dt + 4 * fg) = o[dt]; *(uint2*)(kc + 16 * dt + 4 * fg) = make_uint2(cvtpk(o[dt][0], o[dt][1]), cvtpk(o[dt][2], o[dt][3])); }
        else { unsigned z = 0u; asm volatile("" : "+v"(z)); *(uint2*)(kc + 16 * dt + 4 * fg) = make_uint2(z, z); }
    }
}
__device__ __forceinline__ void ph_compress_fast(const Params& p, LAS unsigned char* lds) {
    for (int job = blockIdx.x; job < 544; job += gridDim.x) { const int jj = job < 512 ? job + 32 : job - 512; const int bb = jj >> 2, c = (jj >> 1) & 1, g = jj & 1;
        if (bb < 8) compress_job<false>(p, bb, c, g, lds); else compress_job<true>(p, bb, c, g, lds); }
}
constexpr int ML_QP = 416, ML_VP = 80, ML_WP = 112;
__device__ __forceinline__ void ph_mlstm_fast(const Params& p, int l, LAS unsigned char* lds) {
    const int tid = ltid(), lane = tid & 63, w = tid >> 6, fr = lane & 15, fg = lane >> 4;
    unsigned char* ws = p.ws;
    const bf16_t* P16 = (const bf16_t*)(ws + B_P16); const float* GT = (const float*)(ws + B_GT); const float* bif = p.in[I_BIF] + l * 8; float* HR = (float*)(ws + B_HRAW);
    LAS unsigned char* Ql = lds;
    LAS unsigned char* Kl = lds + 26624;
    LAS unsigned char* Vl = lds + 53248;
    LAS unsigned char* Wl = lds + 58368;
    LAS unsigned char* CT = lds + 65536;
    LAS float* INTER = (LAS float*)(lds + 85504);
    LAS float* QN = (LAS float*)(lds + 94720);
    LAS float* RTa = (LAS float*)(lds + 94976);
    LAS float* WSa = RTa + 2048;
    LAS float* EIa = RTa + 4096;
    LAS float* DEC = RTa + 6144;
    LAS float* Gk = DEC + 32; LAS float* Ak = DEC + 64; LAS float* MPk = DEC + 96;
    for (int unit = blockIdx.x; unit < 192; unit += gridDim.x) {
        const int xy_ = unit >> 3, bh_ = (unit & 7) + 8 * (xy_ / 6);
        const int es = xy_ % 6, h = bh_ & 3, b = bh_ >> 2;
        const size_t row0 = (size_t)b * SP;
        __syncthreads();
        for (int i = tid; i < 48 * (ML_QP / 4); i += NT_) ((LAS unsigned*)CT)[i] = 0u;
        for (int i = tid; i < 64 * 28; i += NT_) ((LAS unsigned*)Wl)[i] = 0u;
        float gia[4], gfa[4];
#pragma unroll
        for (int q = 0; q < 4; ++q) { const float* g_ = GT + (row0 + 64 * (w + 8 * q) + lane) * GTW; gia[q] = g_[h]; gfa[q] = g_[4 + h]; }
#pragma unroll
        for (int q = 0; q < 4; ++q) { const int k = w + 8 * q; const float gi = gia[q] + bif[h], gf = gfa[q] + bif[4 + h];
            float bc = logsigmoidf_(gf);
#pragma unroll
            for (int o = 1; o < 64; o <<= 1) { const float t = __shfl_up(bc, o); if (lane >= o) bc += t; }
            const float u = gi - bc; float pm = u;
#pragma unroll
            for (int o = 1; o < 64; o <<= 1) { const float t = __shfl_up(pm, o); if (lane >= o) pm = fmaxf(pm, t); }
            EIa[k * 64 + lane] = bc; RTa[k * 64 + lane] = pm; WSa[k * 64 + lane] = u;
            if (lane == 63) { Gk[k] = bc; Ak[k] = pm; } }
        __syncthreads();
        if (tid == 0) { float m = NEGM; for (int k = 0; k < 32; ++k) { MPk[k] = m; m = Gk[k] + fmaxf(Ak[k], m); } MPk[32] = m; }
        __syncthreads();
#pragma unroll 1
        for (int k = w; k < 32; k += 8) { const float mp = MPk[k], M63 = fmaxf(Ak[k], mp); const float bc = EIa[k * 64 + lane], pm = RTa[k * 64 + lane], u = WSa[k * 64 + lane]; const float M = fmaxf(pm, mp);
            RTa[k * 64 + lane] = expf(M63 - M); WSa[k * 64 + lane] = expf(u - M63); EIa[k * 64 + lane] = expf(-(bc + M)); if (lane == 0) DEC[k] = expf(mp - M63); }
        f32x4_t cacc[5];
#pragma unroll
        for (int i = 0; i < 5; ++i) cacc[i] = (f32x4_t){0.f, 0.f, 0.f, 0.f};
        u32x4_t rq[3], rk[3], rv;
#define ML_LOAD(c_) do { const size_t rb_ = row0 + 64 * (c_); \
            _Pragma("unroll") for (int i_ = 0; i_ < 3; ++i_) { const int ch_ = tid + NT_ * i_, r_ = ch_ / 24, cc_ = ch_ % 24; const bf16_t* src_ = P16 + (rb_ + r_) * LDA_ + h * 192 + cc_ * 8; rq[i_] = *(const u32x4_t*)src_; rk[i_] = *(const u32x4_t*)(src_ + 768); } \
            if (tid < 256) { const int r_ = tid >> 2, cc_ = tid & 3; rv = *(const u32x4_t*)(P16 + (rb_ + r_) * LDA_ + 1536 + h * 192 + es * 32 + cc_ * 8); } } while (0)
#define ML_STORE(c_) do { \
            _Pragma("unroll") for (int i_ = 0; i_ < 3; ++i_) { const int ch_ = tid + NT_ * i_, r_ = ch_ / 24, cc_ = ch_ % 24; *(LAS u32x4_t*)(Ql + r_ * ML_QP + cc_ * 16) = rq[i_]; *(LAS u32x4_t*)(Kl + r_ * ML_QP + cc_ * 16) = rk[i_]; } \
            if (tid < 256) { const int r_ = tid >> 2, cc_ = tid & 3; *(LAS u32x4_t*)(Vl + r_ * ML_VP + cc_ * 16) = rv; const float wv_ = WSa[(c_) * 64 + r_]; \
                u32x4_t y_; y_.x = cvtpk(bflo(rv.x) * wv_, bfhi(rv.x) * wv_); y_.y = cvtpk(bflo(rv.y) * wv_, bfhi(rv.y) * wv_); y_.z = cvtpk(bflo(rv.z) * wv_, bfhi(rv.z) * wv_); y_.w = cvtpk(bflo(rv.w) * wv_, bfhi(rv.w) * wv_); \
                *(LAS u32x4_t*)(Wl + r_ * ML_WP + cc_ * 16) = y_; if (cc_ == 0) *(LAS bf16_t*)(Wl + r_ * ML_WP + 64) = (bf16_t)f2bf(wv_); } } while (0)
        ML_LOAD(0);
        __syncthreads();
        ML_STORE(0);
#pragma unroll 1
        for (int c = 0; c < 32; ++c) {
            BAR_LDS();
            if (c + 1 < 32) ML_LOAD(c + 1);
            f32x4_t hin[2]; float rsum = 0.f;
            hin[0] = (f32x4_t){0.f, 0.f, 0.f, 0.f}; hin[1] = hin[0];
            if (w < 4) {
                const int tt = w;
                f32x4_t S[4];
#pragma unroll
                for (int st = 0; st < 4; ++st) { S[st] = (f32x4_t){0.f, 0.f, 0.f, 0.f};
                    if (st <= tt) {
#pragma unroll
                        for (int ks = 0; ks < 6; ++ks) { const bf16x8_t kf = *(const LAS bf16x8_t*)(Kl + (16 * st + fr) * ML_QP + (32 * ks + 8 * fg) * 2), qf = *(const LAS bf16x8_t*)(Ql + (16 * tt + fr) * ML_QP + (32 * ks + 8 * fg) * 2);
                            S[st] = mfma16(kf, qf, S[st]); }
                        const f32x4_t wv = *(const LAS f32x4_t*)(WSa + c * 64 + 16 * st + 4 * fg); S[st] = S[st] * wv;
                        if (st == tt) {
#pragma unroll
                            for (int jj = 0; jj < 4; ++jj) if (4 * fg + jj > fr) S[st][jj] = 0.f; }
                        rsum += (S[st][0] + S[st][1]) + (S[st][2] + S[st][3]);
                    } }
                rsum = xsum4(rsum);
#pragma unroll
                for (int kk = 0; kk < 2; ++kk) { if (2 * kk <= tt) { const bf16x8_t pf = pack8(S[2 * kk], S[2 * kk + 1]);
#pragma unroll
                    for (int et = 0; et < 2; ++et) { const LAS unsigned char* vp = Vl + (32 * kk + 4 * fg + (fr >> 2)) * ML_VP + (16 * et + 4 * (fr & 3)) * 2; hin[et] = mfma16(ldtr2(vp, vp + 16 * ML_VP), pf, hin[et]); } } }
            } else {
                const int tt = w - 4;
                f32x4_t I[3];
#pragma unroll
                for (int e3 = 0; e3 < 3; ++e3) { I[e3] = (f32x4_t){0.f, 0.f, 0.f, 0.f};
#pragma unroll
                    for (int ks = 0; ks < 6; ++ks) { const bf16x8_t cf = *(const LAS bf16x8_t*)(CT + (16 * e3 + fr) * ML_QP + (32 * ks + 8 * fg) * 2), qf = *(const LAS bf16x8_t*)(Ql + (16 * tt + fr) * ML_QP + (32 * ks + 8 * fg) * 2);
                        I[e3] = mfma16(cf, qf, I[e3]); } }
                *(LAS f32x4_t*)(INTER + (16 * tt + fr) * 36 + 4 * fg) = I[0]; *(LAS f32x4_t*)(INTER + (16 * tt + fr) * 36 + 16 + 4 * fg) = I[1];
                if (fg == 0) QN[16 * tt + fr] = I[2][0];
            }
            BAR_LDS();
            const float decay = DEC[c];
            if (w < 4) {
                const int t = 16 * w + fr; const float r = RTa[c * 64 + t], einv = EIa[c * 64 + t], qn = QN[t];
                const float den = r * (rsum + decay * qn); const float inv = 1.0f / fmaxf(fabsf(den), einv);
                float* hp = HR + (row0 + 64 * c + t) * 768 + h * 192 + es * 32;
#pragma unroll
                for (int et = 0; et < 2; ++et) { const f32x4_t in2 = *(const LAS f32x4_t*)(INTER + t * 36 + 16 * et + 4 * fg); const f32x4_t num = (hin[et] + in2 * decay) * r; *(f32x4_t*)(hp + 16 * et + 4 * fg) = num * inv; }
            }
#pragma unroll
            for (int i = 0; i < 5; ++i) { const int idx = w + 8 * i; if (idx < 36) { const int dtile = idx / 3, et = idx % 3; cacc[i] = cacc[i] * decay;
#pragma unroll
                for (int ks = 0; ks < 2; ++ks) { const LAS unsigned char* kp = Kl + (32 * ks + 8 * fg + (fr >> 2)) * ML_QP + (16 * dtile + 4 * (fr & 3)) * 2; const LAS unsigned char* vp = Wl + (32 * ks + 8 * fg + (fr >> 2)) * ML_WP + (16 * et + 4 * (fr & 3)) * 2;
                    cacc[i] = mfma16(ldtr2(kp, kp + 4 * ML_QP), ldtr2(vp, vp + 4 * ML_WP), cacc[i]); } } }
            BAR_LDS();
#pragma unroll
            for (int i = 0; i < 5; ++i) { const int idx = w + 8 * i; if (idx < 36) { const int dtile = idx / 3, et = idx % 3;
                typedef unsigned u32x2_t __attribute__((ext_vector_type(2))); u32x2_t wv; wv.x = cvtpk(cacc[i][0], cacc[i][1]); wv.y = cvtpk(cacc[i][2], cacc[i][3]);
                *(LAS u32x2_t*)(CT + (16 * et + fr) * ML_QP + (16 * dtile + 4 * fg) * 2) = wv; } }
            if (c + 1 < 32) ML_STORE(c + 1);
        }
#pragma unroll
        for (int i = 0; i < 5; ++i) { const int idx = w + 8 * i; if (idx < 36) { const int dtile = idx / 3, et = idx % 3;
            if (et < 2) { float* co = p.out + O_PC + ((size_t)((l * 8 + b) * 4 + h) * 192 + 16 * dtile + 4 * fg) * 192 + es * 32 + 16 * et + fr;
#pragma unroll
                for (int jj = 0; jj < 4; ++jj) co[(size_t)jj * 192] = cacc[i][jj]; }
            else if (es == 0 && fr == 0) { float* no = p.out + O_PN + (size_t)((l * 8 + b) * 4 + h) * 192 + 16 * dtile + 4 * fg;
#pragma unroll
                for (int jj = 0; jj < 4; ++jj) no[jj] = cacc[i][jj]; } } }
        if (es == 0 && tid == 0) p.out[O_PM + (l * 8 + b) * 4 + h] = MPk[32];
#undef ML_LOAD
#undef ML_STORE
    }
}
__device__ __forceinline__ void ph_mem_attn_fast(const Params& p, int l, LAS unsigned char* lds, int u0, int ucnt, int ustep) {
    const int tid = ltid(), lane0 = tid & 63, w = tid >> 6;
    const int ldp = l < 2 ? LDA_ : LDB_, qoff = l < 2 ? 3072 : 768;
    const bf16_t* P16 = (const bf16_t*)(p.ws + B_P16); bf16_t* CATB = (bf16_t*)(p.ws + B_CATB); const float* gq = p.in[I_GMEMQ] + l * 64;
    LAS unsigned char* Km = lds;
    LAS unsigned char* Vm = lds + 36864;
    const float* gmk = p.in[I_GMEMK] + l * 64;
    int staged = -1;
    for (int ui = 0; ui < ucnt; ++ui) { const int unit = u0 + ui * ustep; if (unit >= 256) break;
        int lane_a = lane0; asm volatile("" : "+v"(lane_a)); const int lane = lane_a, fr = lane & 15, fg = lane >> 4;
        const int oct = unit & 7, hh = (unit >> 3) & 3, b = unit >> 5;
        const float* kv = (const float*)(p.ws + B_MEMR) + (size_t)(l * 8 + b) * 256 * 512 + hh * 64;
        uint4 qc0, qc1, qn0, qn1;
        { const bf16_t* qrow = P16 + ((size_t)b * SP + oct * 256 + w * 16 + fr) * ldp + qoff + hh * 64;
          qc0 = *(const uint4*)(qrow + fg * 8); qc1 = *(const uint4*)(qrow + 32 + fg * 8); qn0 = *(const uint4*)(qrow + (size_t)128 * ldp + fg * 8); qn1 = *(const uint4*)(qrow + (size_t)128 * ldp + 32 + fg * 8); }
        if ((unit >> 3) != staged) { staged = unit >> 3;
        __syncthreads();
        {
            f32x4_t x[16];
#pragma unroll
            for (int k = 0; k < 16; ++k) { const int i = tid + NT_ * k, tsel = i >> 12, m = (i >> 4) & 255, ch = i & 15; x[k] = *(const f32x4_t*)(kv + (size_t)m * 512 + tsel * 256 + ch * 4); }
#pragma unroll
            for (int k = 0; k < 16; ++k) { const int i = tid + NT_ * k, tsel = i >> 12, m = (i >> 4) & 255, ch = i & 15;
                if (k < 8) { float ss = (x[k][0] * x[k][0] + x[k][1] * x[k][1]) + (x[k][2] * x[k][2] + x[k][3] * x[k][3]);
                    ss += __shfl_xor(ss, 1); ss += __shfl_xor(ss, 2); ss += __shfl_xor(ss, 4); ss += __shfl_xor(ss, 8);
                    const float rs = rsqrtf(ss * (1.0f / 64) + EPS); const f32x4_t gk = *(const f32x4_t*)(gmk + ch * 4); x[k] = x[k] * rs * gk; }
                typedef unsigned u32x2_t __attribute__((ext_vector_type(2))); u32x2_t y; y.x = cvtpk(x[k][0], x[k][1]); y.y = cvtpk(x[k][2], x[k][3]);
                *(LAS u32x2_t*)((tsel ? Vm : Km) + m * KROW + ch * 8) = y; }
        }
        __syncthreads(); }
#pragma unroll 1
        for (int ps = 0; ps < 2; ++ps) {
            const size_t row = (size_t)b * SP + oct * 256 + ps * 128 + w * 16 + fr;
            bf16x8_t qf[2];
            { const uint4 r0 = qc0, r1 = qc1; qc0 = qn0; qc1 = qn1;
              float v[16] = {bflo(r0.x), bfhi(r0.x), bflo(r0.y), bfhi(r0.y), bflo(r0.z), bfhi(r0.z), bflo(r0.w), bfhi(r0.w), bflo(r1.x), bfhi(r1.x), bflo(r1.y), bfhi(r1.y), bflo(r1.z), bfhi(r1.z), bflo(r1.w), bfhi(r1.w)};
              float ss = 0.f;
#pragma unroll
              for (int i = 0; i < 16; ++i) ss += v[i] * v[i];
              ss = xsum4(ss); const float rs = rsqrtf(ss * (1.0f / 64) + EPS) * (0.125f * LOG2E);
#pragma unroll
              for (int i = 0; i < 8; ++i) { v[i] *= rs * gq[fg * 8 + i]; v[8 + i] *= rs * gq[32 + fg * 8 + i]; }
              qf[0] = pack8((f32x4_t){v[0], v[1], v[2], v[3]}, (f32x4_t){v[4], v[5], v[6], v[7]});
              qf[1] = pack8((f32x4_t){v[8], v[9], v[10], v[11]}, (f32x4_t){v[12], v[13], v[14], v[15]}); }
            f32x4_t S[16]; float mx = NINF;
#pragma unroll
            for (int nt = 0; nt < 16; ++nt) { S[nt] = (f32x4_t){0.f, 0.f, 0.f, 0.f};
#pragma unroll
                for (int ks = 0; ks < 2; ++ks) { const bf16x8_t kf = *(const LAS bf16x8_t*)(Km + (16 * nt + fr) * KROW + (32 * ks + 8 * fg) * 2); S[nt] = mfma16(kf, qf[ks], S[nt]); }
                mx = fmaxf(mx, fmaxf(fmaxf(S[nt][0], S[nt][1]), fmaxf(S[nt][2], S[nt][3]))); }
            mx = xmax4(mx); float sum = 0.f;
#pragma unroll
            for (int nt = 0; nt < 16; ++nt)
#pragma unroll
                for (int jj = 0; jj < 4; ++jj) { const float e = ex2(S[nt][jj] - mx); S[nt][jj] = e; sum += e; }
            sum = xsum4(sum); const float inv = 1.0f / sum;
            f32x4_t o[4];
#pragma unroll
            for (int dt = 0; dt < 4; ++dt) o[dt] = (f32x4_t){0.f, 0.f, 0.f, 0.f};
#pragma unroll
            for (int c2 = 0; c2 < 8; ++c2) { const bf16x8_t pf = pack8(S[2 * c2], S[2 * c2 + 1]);
#pragma unroll
                for (int dt = 0; dt < 4; ++dt) { const LAS unsigned char* vp = Vm + (32 * c2 + 4 * fg + (fr >> 2)) * KROW + (16 * dt + 4 * (fr & 3)) * 2; o[dt] = mfma16(ldtr2(vp, vp + 16 * KROW), pf, o[dt]); } }
            bf16_t* orow = CATB + row * DM + 768 + hh * 64;
#pragma unroll
            for (int dt = 0; dt < 4; ++dt) { const f32x4_t v = o[dt] * inv; *(uint2*)(orow + 16 * dt + 4 * fg) = make_uint2(cvtpk(v[0], v[1]), cvtpk(v[2], v[3])); }
        }
    }
}
__device__ __forceinline__ void ph_mem_attn_sample(const Params& p, int l, LAS unsigned char* lds, int j0, int jcnt, int jstep) {
    const int tid = ltid(), lane = tid & 63, w = tid >> 6;
    const int ldp = l < 2 ? LDA_ : LDB_, qoff = l < 2 ? 3072 : 768;
    const bf16_t* P16 = (const bf16_t*)(p.ws + B_P16); bf16_t* CATB = (bf16_t*)(p.ws + B_CATB); const float* gq = p.in[I_GMEMQ] + l * 64;
    LAS float* qs = (LAS float*)(lds + w * 2048);
    LAS float* ps = qs + 64;
    __syncthreads();
    for (int ji = 0; ji < jcnt; ++ji) { const int item = (j0 + ji * jstep) * NW_ + w; if (item >= BS * 4) break;
        const int hh = item & 3, b = item >> 2; const size_t row = (size_t)MP + b;
        const float* kv = p.in[I_CMEM] + (size_t)(l * 128 + b) * 256 * 512 + hh * 64;
        { const float v = bf2f(P16[row * ldp + qoff + hh * 64 + lane]); const float ss = wave_sum(v * v); qs[lane] = v * rsqrtf(ss * (1.0f / 64) + EPS) * gq[lane] * (0.125f * LOG2E); }
        asm volatile("s_waitcnt lgkmcnt(0)" ::: "memory");
        float sc[4] = {0.f, 0.f, 0.f, 0.f};
#pragma unroll 4
        for (int d4 = 0; d4 < 16; ++d4) { const f32x4_t q4 = *(const LAS f32x4_t*)(qs + 4 * d4);
#pragma unroll
            for (int k = 0; k < 4; ++k) { const f32x4_t k4 = *(const f32x4_t*)(kv + (size_t)(lane + 64 * k) * 512 + 4 * d4); sc[k] += (q4[0] * k4[0] + q4[1] * k4[1]) + (q4[2] * k4[2] + q4[3] * k4[3]); } }
        float mx = wave_max(fmaxf(fmaxf(sc[0], sc[1]), fmaxf(sc[2], sc[3]))); float sum = 0.f;
#pragma unroll
        for (int k = 0; k < 4; ++k) { sc[k] = ex2(sc[k] - mx); sum += sc[k]; ps[lane + 64 * k] = sc[k]; }
        sum = wave_sum(sum);
        asm volatile("s_waitcnt lgkmcnt(0)" ::: "memory");
        { const int kg = lane >> 4, c4 = lane & 15; f32x4_t o4 = (f32x4_t){0.f, 0.f, 0.f, 0.f};
#pragma unroll 1
          for (int m0 = 0; m0 < 64; m0 += 16) { f32x4_t v[16];
#pragma unroll
              for (int i = 0; i < 16; ++i) v[i] = *(const f32x4_t*)(kv + (size_t)(4 * (m0 + i) + kg) * 512 + 256 + 4 * c4);
#pragma unroll
              for (int i = 0; i < 16; ++i) o4 = o4 + v[i] * ps[4 * (m0 + i) + kg]; }
#pragma unroll
          for (int jx = 0; jx < 4; ++jx) o4[jx] = xsum4(o4[jx]);
          if (kg == 0) { const float inv = 1.0f / sum; *(uint2*)(CATB + row * DM + 768 + hh * 64 + 4 * c4) = make_uint2(cvtpk(o4[0] * inv, o4[1] * inv), cvtpk(o4[2] * inv, o4[3] * inv)); } }
        asm volatile("s_waitcnt lgkmcnt(0)" ::: "memory");
    }
}
__device__ __forceinline__ float row_sum16(float x) {
    x += __int_as_float(__builtin_amdgcn_update_dpp(0, __float_as_int(x), 0x128, 0xf, 0xf, false));
    x += __int_as_float(__builtin_amdgcn_update_dpp(0, __float_as_int(x), 0x124, 0xf, 0xf, false));
    x += __int_as_float(__builtin_amdgcn_update_dpp(0, __float_as_int(x), 0x122, 0xf, 0xf, false));
    x += __int_as_float(__builtin_amdgcn_update_dpp(0, __float_as_int(x), 0x121, 0xf, 0xf, false));
    return x;
}
#define SMP_SCORE(NI, STRIDE) do { const int kq_ = tid >> 4, c_ = tid & 15; f32x4_t q4_[6]; \
        _Pragma("unroll") for (int z = 0; z < 6; ++z) q4_[z] = *(const f32x4_t*)(qs + z * 64 + 4 * c_); \
        f32x4_t kk_[NI]; \
        _Pragma("unroll") for (int i = 0; i < NI; ++i) kk_[i] = *(const f32x4_t*)(kptr[kq_ + 32 * i] + 4 * c_); \
        _Pragma("unroll") for (int i = 0; i < NI; ++i) { const int key_ = kq_ + 32 * i; float sv_ = 0.f; \
            _Pragma("unroll") for (int z = 0; z < 6; ++z) { float a_ = (kk_[i][0] * q4_[z][0] + kk_[i][1] * q4_[z][1]) + (kk_[i][2] * q4_[z][2] + kk_[i][3] * q4_[z][3]); a_ = row_sum16(a_); sv_ = c_ == z ? a_ : sv_; } \
            const int dist_ = kdist[key_]; \
            if (c_ < 6) sc[c_ * (STRIDE) + key_] = dist_ >= 0 ? sv_ * 0.125f + tbl[rel_bucket_alu(dist_) * 6 + c_] : NEGM; } } while (0)
__device__ __forceinline__ void ph_nsa_sample(const Params& p, int j, LAS unsigned char* ldsb) {
    const int tid0 = ltid();
    float* lds = (float*)ldsb;
    float* qs = lds;
    float* sc = lds + 384;
    float* imp = sc + 3072;
    int* sel = (int*)(imp + 40);
    float* gate = (float*)(sel + 8);
    float* oacc = gate + 24;
    const float** kptr = (const float**)(oacc + 384);
    float* part = (float*)(kptr + 512);
    float* tbl = part + 32 * 384;
    int* pts = (int*)(tbl + 192);
    int* kdist = pts + 16;
    const bf16_t* P = (const bf16_t*)(p.ws + B_P16); const float* GT = (const float*)(p.ws + B_GT); const float* KVR = (const float*)(p.ws + B_KVR); bf16_t* CATB = (bf16_t*)(p.ws + B_CATB);
    const float* table = p.in[I_REL]; const int* pt = (const int*)p.in[I_PT];
    for (int item = blockIdx.x; item < BS * 2; item += gridDim.x) {
        int t_l = tid0; asm volatile("" : "+v"(t_l)); const int tid = t_l, lane = tid & 63, wid = tid >> 6;
        int pos_l = PAST; asm volatile("" : "+s"(pos_l)); const int pos = pos_l;
        const int b = item >> 1, g = item & 1, row = MP + b;
        const bf16_t* pr = P + (size_t)row * LDB_;
        __syncthreads();
        if (wid < 6) { const int z = wid; const float v = bf2f(pr[(g * 6 + z) * 64 + lane]); const float ss = wave_sum(v * v); qs[z * 64 + lane] = v * rsqrtf(ss * (1.0f / 64) + EPS) * p.in[I_GQ][j * 64 + lane]; }
        if (tid >= 384 && tid < 384 + 18) { const int t2 = tid - 384; const int br = t2 / 6, z = t2 % 6; gate[t2] = sigmoidf_(GT[(size_t)row * GTW + br * 12 + g * 6 + z] + p.in[I_BGATE][j * 36 + br * 12 + g * 6 + z]); }
        if (tid < 384) oacc[tid] = 0.f;
        if (tid >= 416 && tid < 432) pts[tid - 416] = pt[b * 16 + (tid - 416)];
        if (tid >= 192 && tid < 384) { const int i = tid - 192; tbl[i] = table[(i / 6) * 12 + g * 6 + (i % 6)]; }
        const float* ck = (const float*)(p.ws + B_CK) + (size_t)(8 + b) * 127 * 128; const float* cv = (const float*)(p.ws + B_CV) + (size_t)(8 + b) * 127 * 128;
        if (tid >= 256 && tid < 384) { const int n = tid - 256; kptr[n] = n < 127 ? ck + n * 128 + g * 64 : KVR; kdist[n] = n < 127 ? pos - (16 * n + 31) : -1; }
        __syncthreads();
        SMP_SCORE(4, 128);
        __syncthreads();
        if (wid < 6) row_softmax(sc + wid * 128, 127, lane);
        __syncthreads();
        const int cur = pos >> 6;
        if (tid < 33) { const int jb = tid; float s = 0.f;
            for (int z = 0; z < 6; ++z) { const float* pz = sc + z * 128;
                if (jb < 32) { s += 2.0f * (pz[4 * jb] + pz[4 * jb + 1] + pz[4 * jb + 2]); if (4 * jb + 3 < 127) s += pz[4 * jb + 3]; }
                if (jb >= 1 && jb < 32) s += pz[4 * jb - 1]; }
            imp[jb] = s; }
        __syncthreads();
        if (tid == 0) { sel[0] = 0; sel[1] = cur; sel[2] = cur - 1; }
        if (tid >= 1 && tid <= cur - 2) { const float mine = imp[tid]; int rank = 0;
            for (int j2 = 1; j2 <= cur - 2; ++j2) { const float o = imp[j2]; rank += (o > mine || (o == mine && j2 < tid)) ? 1 : 0; }
            if (rank < 5) sel[3 + rank] = tid; }
        { const int kg = tid >> 4, c4 = tid & 15; f32x4_t v[4]; f32x4_t acc[6];
#pragma unroll
          for (int i = 0; i < 4; ++i) { const int n = kg + 32 * i; v[i] = *(const f32x4_t*)(cv + (n < 127 ? n : 126) * 128 + g * 64 + 4 * c4); }
#pragma unroll
          for (int z = 0; z < 6; ++z) { acc[z] = (f32x4_t){0.f, 0.f, 0.f, 0.f};
#pragma unroll
              for (int i = 0; i < 4; ++i) { const int n = kg + 32 * i; if (n < 127) acc[z] = acc[z] + v[i] * sc[z * 128 + n]; } }
#pragma unroll
          for (int z = 0; z < 6; ++z) *(f32x4_t*)(part + kg * 384 + z * 64 + 4 * c4) = acc[z]; }
        __syncthreads();
        if (tid < 384) { float o = 0.f;
#pragma unroll 8
            for (int kg = 0; kg < 32; ++kg) o += part[kg * 384 + tid];
            oacc[tid] += gate[0 * 6 + (tid >> 6)] * o; }
        __syncthreads();
#pragma unroll 1
        for (int br = 1; br <= 2; ++br) {
            int t_b = tid0; asm volatile("" : "+v"(t_b)); const int tid = t_b, lane = tid & 63, wid = tid >> 6;
            { const int t = tid; const float* kp = nullptr; int dist = -1;
                if (br == 1) { const int blk = sel[t >> 6];
                    if (blk >= 0) { const int tok = blk * 64 + (t & 63); dist = pos - tok;
                        if (dist >= 0) kp = tok < PAST ? p.in[I_CSLC] + ((size_t)pts[tok >> 7] * 128 + (tok & 127)) * 256 + g * 64 : KVR + (size_t)row * 768 + 256 + g * 64; }
                } else { const int kpos = pos - 511 + t; dist = 511 - t;
                    kp = kpos < PAST ? p.in[I_CWIN] + ((size_t)b * 512 + (kpos - (PAST - 512))) * 256 + g * 64 : KVR + (size_t)row * 768 + 512 + g * 64; }
                const bool ok = dist >= 0 && kp; kptr[t] = ok ? kp : KVR; kdist[t] = ok ? dist : -1;
            }
            __syncthreads();
            SMP_SCORE(16, 512);
            __syncthreads();
            if (wid < 6) row_softmax(sc + wid * 512, 512, lane);
            __syncthreads();
            {
                const int kg = tid >> 4, c4 = tid & 15; f32x4_t acc[6];
#pragma unroll
                for (int z = 0; z < 6; ++z) acc[z] = (f32x4_t){0.f, 0.f, 0.f, 0.f};
#pragma unroll 1
                for (int i0 = 0; i0 < 16; i0 += 8) { f32x4_t v[8];
#pragma unroll
                    for (int i = 0; i < 8; ++i) v[i] = *(const f32x4_t*)(kptr[kg + 32 * (i0 + i)] + 128 + 4 * c4);
#pragma unroll
                    for (int i = 0; i < 8; ++i)
#pragma unroll
                        for (int z = 0; z < 6; ++z) acc[z] = acc[z] + v[i] * sc[z * 512 + kg + 32 * (i0 + i)]; }
#pragma unroll
                for (int z = 0; z < 6; ++z) *(f32x4_t*)(part + kg * 384 + z * 64 + 4 * c4) = acc[z];
            }
            __syncthreads();
            if (tid < 384) { float o = 0.f;
#pragma unroll 8
                for (int kg = 0; kg < 32; ++kg) o += part[kg * 384 + tid];
                oacc[tid] += gate[br * 6 + (tid >> 6)] * o; }
            __syncthreads();
        }
        if (tid < 384) CATB[(size_t)row * DM + g * 384 + tid] = (bf16_t)f2bf(oacc[tid]);
    }
}
__device__ __forceinline__ void ph_mlstm_sample_fast(const Params& p, int l, LAS unsigned char* ldsb) {
    const int tid = ltid(), lane = tid & 63, w = tid >> 6;
    float* lds = (float*)ldsb;
    float* qs = lds; float* ks = lds + 192; float* n1 = lds + 384; float* part = lds + 576;
    float* scal = part + 8 * 192;
    const bf16_t* P = (const bf16_t*)(p.ws + B_P16); const float* GT = (const float*)(p.ws + B_GT); const float* bif = p.in[I_BIF] + l * 8; float* HR = (float*)(p.ws + B_HRAW);
    for (int item = blockIdx.x; item < BS * 4; item += gridDim.x) {
        const int h = item & 3, b = item >> 2; const size_t row = (size_t)MP + b;
        const bf16_t* pr = P + row * LDA_; const float* gr = GT + row * GTW;
        const size_t sidx = (size_t)(l * 128 + b) * 4 + h;
        const float ig = gr[h] + bif[h], fg_ = gr[4 + h] + bif[4 + h];
        const float m0 = p.in[I_SM][sidx];
        const float logf = logsigmoidf_(fg_);
        const float m_new = fmaxf(logf + m0, ig);
        const float a = expf(logf + m0 - m_new), bb = expf(ig - m_new);
        __syncthreads();
        if (tid < 192) { const float q = bf2f(pr[h * 192 + tid]), k = bf2f(pr[768 + h * 192 + tid]); qs[tid] = q; ks[tid] = k;
            const float nn = a * p.in[I_SN][sidx * 192 + tid] + bb * k; n1[tid] = nn; p.out[O_SN + sidx * 192 + tid] = nn; }
        __syncthreads();
        if (w == 0) { float s = qs[lane] * n1[lane] + qs[lane + 64] * n1[lane + 64] + qs[lane + 128] * n1[lane + 128]; s = wave_sum(s); if (lane == 0) scal[0] = s; }
        const float* C0 = p.in[I_SC] + sidx * 192 * 192; float* C1 = p.out + O_SC + sidx * 192 * 192;
        float ve[3], num[3] = {0.f, 0.f, 0.f};
#pragma unroll
        for (int i = 0; i < 3; ++i) ve[i] = bf2f(pr[1536 + h * 192 + lane + 64 * i]) * bb;
#pragma unroll 1
        for (int d0 = 24 * w; d0 < 24 * w + 24; d0 += 12) {
            float c[12][3];
#pragma unroll
            for (int r = 0; r < 12; ++r)
#pragma unroll
                for (int i = 0; i < 3; ++i) c[r][i] = C0[(size_t)(d0 + r) * 192 + lane + 64 * i];
#pragma unroll
            for (int r = 0; r < 12; ++r) { const float kd = ks[d0 + r], qd = qs[d0 + r];
#pragma unroll
                for (int i = 0; i < 3; ++i) { const float cn = a * c[r][i] + kd * ve[i]; C1[(size_t)(d0 + r) * 192 + lane + 64 * i] = cn; num[i] = fmaf(qd, cn, num[i]); } }
        }
#pragma unroll
        for (int i = 0; i < 3; ++i) part[w * 192 + lane + 64 * i] = num[i];
        __syncthreads();
        if (tid < 192) { float s = 0.f;
#pragma unroll
            for (int ww = 0; ww < 8; ++ww) s += part[ww * 192 + tid];
            HR[row * 768 + h * 192 + tid] = s / fmaxf(fabsf(scal[0]), expf(-m_new)); }
        if (tid == 0) p.out[O_SM + sidx] = m_new;
    }
}
constexpr int RING_BYTES = 131072, MISC_OFF = RING_BYTES + 320, LDS_BYTES = 147456;
typedef float f32x4_ __attribute__((ext_vector_type(4)));

#define STRIP_JOBS(njobs) for (int job = (int)gridDim.x - 1 - (int)blockIdx.x; job < (njobs); job += (int)gridDim.x)
__device__ __forceinline__ void strips_inproj(const Params& p, int l, LAS unsigned char* lds) {
    unsigned char* ws = p.ws; const bf16_t* XB = (const bf16_t*)(ws + B_XB); bf16_t* P16 = (bf16_t*)(ws + B_P16); float* GT = (float*)(ws + B_GT);
    const float* ssq = (const float*)(ws + B_SSQ) + (size_t)(2 * l) * SSQS;
    const bool ka = l < 2; const int ldp = ka ? LDA_ : LDB_, nmain = ka ? 104 * 4 : 32 * 4;
    const bf16_t* Bt = ka ? (const bf16_t*)(ws + B_BTA) + (size_t)l * NBTA * DM : (const bf16_t*)(ws + B_BTB) + (size_t)(l - 2) * NBTB * DM;
    const int tid_ = ltid(); const int lane = tid_ & 63, wave = tid_ >> 6, fr = lane & 15, fq = lane >> 4;
    STRIP_JOBS(nmain + 516) {
        if (job < nmain) {
            const int st = job >> 2, r0 = MP + (job & 3) * 32;
            const int brow[2] = {st * 32, st * 32 + 16}; StripAcc<2> R; strip_gemm<2>(XB, DM, r0, Bt, brow, R, lds);
            if (wave < 2) { const int row = r0 + wave * 16 + fr; const float rs = rstd_of(ssq[row]);
#pragma unroll
                for (int t = 0; t < 2; ++t) { const f32x4_ v = R.a[t] * rs; *(uint2*)(P16 + (size_t)row * ldp + st * 32 + t * 16 + 4 * fq) = make_uint2(pk2(v[0], v[1]), pk2(v[2], v[3])); } }
        } else {
            const int r0 = (job - nmain) * 32, row = r0 + wave * 16 + fr;
            if (ka) { const int brow[1] = {3328}; StripAcc<1> R; strip_gemm<1>(XB, DM, r0, Bt, brow, R, lds); if (wave < 2) *(f32x4_*)(GT + (size_t)row * GTW + 4 * fq) = R.a[0] * rstd_of(ssq[row]); }
            else { const int brow[3] = {1024, 1040, 1056}; StripAcc<3> R; strip_gemm<3>(XB, DM, r0, Bt, brow, R, lds);
                if (wave < 2) { const float rs = rstd_of(ssq[row]);
#pragma unroll
                    for (int t = 0; t < 3; ++t) *(f32x4_*)(GT + (size_t)row * GTW + t * 16 + 4 * fq) = R.a[t] * rs; } }
        }
    }
}
__device__ __forceinline__ void strips_resid(const Params& p, const bf16_t* A, int K, const bf16_t* Bt, float* ssq, float* Y, LAS unsigned char* lds) {
    bf16_t* XB = (bf16_t*)(p.ws + B_XB);
    const int tid_ = ltid(); const int lane = tid_ & 63, wave = tid_ >> 6, fr = lane & 15, fq = lane >> 4;
    STRIP_JOBS(256) {
        const int st = job >> 2, r0 = MP + (job & 3) * 32;
        const int brow[1] = {st * 16}; StripAcc<1> R; strip_gemm<1>(A, K, r0, Bt, brow, R, lds);
        if (wave < 2) { const int row = r0 + wave * 16 + fr; bf16_t* bp = XB + (size_t)row * DM + st * 16 + 4 * fq; const uint2 o = *(const uint2*)bp;
            const f32x4_ x = (f32x4_){bflo(o.x), bfhi(o.x), bflo(o.y), bfhi(o.y)} + R.a[0];
            *(uint2*)bp = make_uint2(pk2(x[0], x[1]), pk2(x[2], x[3]));
            if (Y) *(f32x4_*)(Y + (size_t)row * DM + st * 16 + 4 * fq) = x;
            float ss = (x[0] * x[0] + x[1] * x[1]) + (x[2] * x[2] + x[3] * x[3]); ss += __shfl_xor(ss, 16); ss += __shfl_xor(ss, 32);
            if (fq == 0) (void)__hip_atomic_fetch_add(ssq + row, ss, __ATOMIC_RELAXED, __HIP_MEMORY_SCOPE_AGENT); }
    }
}
__device__ __forceinline__ void strips_gu(const Params& p, int l, LAS unsigned char* lds) {
    unsigned char* ws = p.ws; const bf16_t* XB = (const bf16_t*)(ws + B_XB); bf16_t* HID = (bf16_t*)(ws + B_HID);
    const float* ssq = (const float*)(ws + B_SSQ) + (size_t)(2 * l + 1) * SSQS; const bf16_t* Bt = (const bf16_t*)(ws + B_BTG) + (size_t)l * 2 * DFF * DM;
    const int tid_ = ltid(); const int lane = tid_ & 63, wave = tid_ >> 6, fr = lane & 15, fq = lane >> 4;
    STRIP_JOBS(176 * 4) {
        const int st = job >> 2, r0 = MP + (job & 3) * 32;
        const int brow[2] = {(st >> 3) * 256 + (st & 7) * 16, (st >> 3) * 256 + 128 + (st & 7) * 16}; StripAcc<2> R; strip_gemm<2>(XB, DM, r0, Bt, brow, R, lds);
        if (wave < 2) { const int row = r0 + wave * 16 + fr; const float rs = rstd_of(ssq[row]); float h[4];
#pragma unroll
            for (int j = 0; j < 4; ++j) { const float g = R.a[0][j] * rs, up = R.a[1][j] * rs; h[j] = g * pg8::fast_sigmoid(g) * up; }
            *(uint2*)(HID + (size_t)row * DFF + st * 16 + 4 * fq) = make_uint2(pk2(h[0], h[1]), pk2(h[2], h[3])); }
    }
}
__device__ __forceinline__ void strips_kv(const Params& p, LAS unsigned char* lds) {
    unsigned char* ws = p.ws; const bf16_t* XB = (const bf16_t*)(ws + B_XB); float* KVR = (float*)(ws + B_KVR);
    const float* ssq = (const float*)(ws + B_SSQ) + (size_t)4 * SSQS; const bf16_t* Bt = (const bf16_t*)(ws + B_BTK);
    const int tid_ = ltid(); const int lane = tid_ & 63, wave = tid_ >> 6, fr = lane & 15, fq = lane >> 4;
    STRIP_JOBS(48 * 4) {
        const int st = job >> 2, r0 = MP + (job & 3) * 32;
        const int brow[1] = {st * 16}; StripAcc<1> R; strip_gemm<1>(XB, DM, r0, Bt, brow, R, lds);
        if (wave < 2) { const int row = r0 + wave * 16 + fr; *(f32x4_*)(KVR + (size_t)row * 768 + st * 16 + 4 * fq) = R.a[0] * rstd_of(ssq[row]); }
    }
}

#ifndef COMPRESS_NAIVE
#define COMPRESS_NAIVE 0
#endif
#ifndef MLSTM_NAIVE
#define MLSTM_NAIVE 0
#endif
#ifndef MEMATT_NAIVE
#define MEMATT_NAIVE 0
#endif
#ifndef SAMPLE_ML_NAIVE
#define SAMPLE_ML_NAIVE 0
#endif
#ifndef SAMPLE_NSA_NAIVE
#define SAMPLE_NSA_NAIVE 0
#endif
#ifndef MK_MULTI
#define MK_MULTI 0
#endif
constexpr int PL = 9, NPH = 1 + 4 * PL;
__host__ __device__ constexpr bool phase_nonempty(int ph) {
    if (ph == 0) return true;
    const int l = (ph - 1) / PL, r = (ph - 1) % PL;
    if (r == 2) return l < 2;
    if (r == 7) return false;
    if (r >= 6) return l == 1;
    return true;
}
#ifndef TIME_MASK
#define TIME_MASK 0
#endif
__host__ __device__ constexpr int phase_group(int ph) { if (ph == 0) return 0; const int l = (ph - 1) / PL, r = (ph - 1) % PL; return r == 0 ? 1 : r == 1 ? (l < 2 ? 2 : 4) : r == 2 ? 3 : r == 3 ? 5 : r == 4 ? 6 : r == 5 ? 7 : r == 6 ? 8 : r == 7 ? 9 : 10; }
__global__ void __launch_bounds__(NT_, 2) fwd(Params p) {
    extern __shared__ __attribute__((aligned(16))) unsigned char lds_raw[];
    LAS unsigned char* lds = (LAS unsigned char*)lds_raw;
    float* ldsf = (float*)lds_raw;
    volatile LAS unsigned* MISC = (volatile LAS unsigned*)(lds + MISC_OFF);
    for (int u = threadIdx.x; u < (LDS_BYTES - RING_BYTES) / 4; u += NT_) ((LAS unsigned*)(lds + RING_BYTES))[u] = 0u;
    __syncthreads();
    unsigned char* ws = p.ws;
    XcdBarrier bar; bar.bar = (unsigned*)ws; bar.x = 0; bar.st = MISC + 8;
    const bool single = (p.ph_hi - p.ph_lo) > 1;
    if (single) bar = xcd_barrier_post((unsigned*)ws, MISC + 8);
    bf16_t* XB = (bf16_t*)(ws + B_XB); bf16_t* P16 = (bf16_t*)(ws + B_P16); bf16_t* CATB = (bf16_t*)(ws + B_CATB); bf16_t* HID = (bf16_t*)(ws + B_HID);
    float* SSQ = (float*)(ws + B_SSQ);
    const int G = gridDim.x, c = blockIdx.x;
    if (TIME_SUB && blockIdx.x == TSUB_BLK && threadIdx.x == 0) { for (int i = 0; i < 8; ++i) g_tsub[i] = 0ull; }
    int ph = 0; volatile LAS unsigned long long* TMR = (volatile LAS unsigned long long*)(lds + MISC_OFF + 64);
    if ((TIME_MASK || TIME_SUB) && blockIdx.x == 0 && threadIdx.x == 0) { TMR[0] = 0ull; TMR[1] = __builtin_amdgcn_s_memrealtime(); }
#define ON() (ph >= p.ph_lo && ph < p.ph_hi)
#define NEXT() do { const bool ne_ = phase_nonempty(ph); const int grp_ = phase_group(ph); ++ph; if (ne_ && ph > p.ph_lo && ph < p.ph_hi) xcd_barrier(bar); \
        if (TIME_MASK && blockIdx.x == 0 && threadIdx.x == 0) { const unsigned long long now_ = __builtin_amdgcn_s_memrealtime(); if ((TIME_MASK >> grp_) & 1) TMR[0] = TMR[0] + (now_ - TMR[1]); TMR[1] = now_; } } while (0)
#ifndef NO_PRO
    if (ON()) ph_prologue(p, lds);
#endif
    NEXT();
    for (int l = 0; l < 4; ++l) {
        if (ON()) {
            if (l == 0) { pg8::Gemm g{(const bf16_t*)(ws + B_MPB), (const bf16_t*)(ws + B_BTM), 2048, 2048, DM}; pg8::StaticOrder S; S.init(2048, 2048, G, c);
                pg8::EpiF32 E{(float*)(ws + B_MEMR), 512, nullptr, 512, (size_t)2048 * 512};
                pg8::gemm_phase<pg8::EpiF32, pg8::StaticOrder, true, true>(lds, g, S, E); }
            if (l < 2) { pg8::Gemm g{XB, (const bf16_t*)(ws + B_BTA) + (size_t)l * NBTA * DM, MAP, LDA_ + 256, DM}; pg8::StaticOrder S; S.init(MAP, LDA_ + 256, G, l == 0 ? (c + 192) % G : c);
                pg8::EpiBf16S E{P16, LDA_, SSQ + (size_t)(2 * l) * SSQS, 13, (float*)(ws + B_GT)};
                pg8::gemm_phase<pg8::EpiBf16S, pg8::StaticOrder, true, true>(lds, g, S, E); }
            else { pg8::Gemm g{XB, (const bf16_t*)(ws + B_BTB) + (size_t)(l - 2) * NBTB * DM, MP, LDB_, DM}; pg8::StaticOrder S; S.init(MP, LDB_, G, c);
                pg8::EpiBf16S E{P16, LDB_, SSQ + (size_t)(2 * l) * SSQS, -1, nullptr};
                pg8::gemm_phase<pg8::EpiBf16S, pg8::StaticOrder, true, true>(lds, g, S, E);
#ifndef NO_STRIPS
                strips_inproj(p, l, lds);
#endif
            }
        }
        NEXT();
#ifndef NO_NAIVE
        if (ON()) {
            if (l < 2) { TSUB_BEGIN(); if (MLSTM_NAIVE) ph_mlstm_prompt(p, l, ldsf); else ph_mlstm_fast(p, l, lds); TSUB_END(6); if (G == 256) { if (c >= 192) { ph_mem_attn_fast(p, l, lds, 4 * (c - 192), 4, 1); ph_mem_attn_sample(p, l, lds, c - 192, 1, 64); if (l == 1) ph_swin_copy(p, 192, 64); } TSUB_END(7); }
                else { ph_mem_attn_fast(p, l, lds, c, (256 - c + G - 1) / G, G); if (c < 64) ph_mem_attn_sample(p, l, lds, c, (64 - c + G - 1) / G, G); if (l == 1) ph_swin_copy(p, 0, G); }      if (SAMPLE_ML_NAIVE) ph_mlstm_sample(p, l, ldsf); else ph_mlstm_sample_fast(p, l, lds); }
            else { if (!NSA_NAIVE_ALL) ph_nsa_fast(p, l - 2, lds); { TSUB_BEGIN(); if (SAMPLE_NSA_NAIVE) ph_nsa(p, l - 2, ldsf); else ph_nsa_sample(p, l - 2, lds); TSUB_END(4); } TSUB_BEGIN(); if (MEMATT_NAIVE) ph_mem_attn(p, l); else if (G == 256) { if (c < 16) { ph_mem_attn_fast(p, l, lds, 8 * c, 8, 1); ph_mem_attn_sample(p, l, lds, 2 * c, 2, 1); } else if (c < 32) { ph_mem_attn_fast(p, l, lds, 128 + 5 * (c - 16), 5, 1); ph_mem_attn_sample(p, l, lds, 2 * c, 2, 1); } else if (c < 48) ph_mem_attn_fast(p, l, lds, 208 + 3 * (c - 32), 3, 1); }
                else { ph_mem_attn_fast(p, l, lds, c, (256 - c + G - 1) / G, G); if (c < 64) ph_mem_attn_sample(p, l, lds, c, (64 - c + G - 1) / G, G); } TSUB_END(5); }
        }
#endif
        NEXT();
#ifndef NO_NAIVE
        if (ON()) { if (l < 2) { ph_mlstm_fin(p, l); if (l == 0) ph_memk_norm(p); } }
#endif
        NEXT();
        if (ON()) {
            const bf16_t* Bt = (const bf16_t*)(ws + B_BTO) + (size_t)l * DM * DM; float* sq = SSQ + (size_t)(2 * l + 1) * SSQS;
            pg8::Gemm g{CATB, Bt, MP, DM, DM}; pg8::StaticOrder S; S.init(MP, DM, G, c); pg8::EpiResid E{nullptr, XB, sq};
            pg8::gemm_phase<pg8::EpiResid, pg8::StaticOrder, true, true>(lds, g, S, E);
#ifndef NO_STRIPS
            strips_resid(p, CATB, DM, Bt, sq, nullptr, lds);
#endif
        }
        NEXT();
        if (ON()) {
            pg8::Gemm g{XB, (const bf16_t*)(ws + B_BTG) + (size_t)l * 2 * DFF * DM, MAP, 2 * DFF, DM}; pg8::StaticOrder S; S.init(MAP, 2 * DFF, G, c); pg8::EpiSwiglu E{HID, SSQ + (size_t)(2 * l + 1) * SSQS};
            pg8::gemm_phase<pg8::EpiSwiglu, pg8::StaticOrder, true, true>(lds, g, S, E);
        }
        NEXT();
        if (ON()) {
            const bf16_t* Bt = (const bf16_t*)(ws + B_BTD) + (size_t)l * DM * DFF; float* sq = SSQ + (size_t)(2 * l + 2) * SSQS;
            pg8::Gemm g{HID, Bt, MP, DM, DFF}; pg8::StaticOrder S; S.init(MP, DM, G, c); float* Yo = l == 3 ? p.out : nullptr; pg8::EpiResid E{Yo, XB, sq};
            pg8::gemm_phase<pg8::EpiResid, pg8::StaticOrder, true, true>(lds, g, S, E);
#ifndef NO_STRIPS
            strips_resid(p, HID, DFF, Bt, sq, Yo, lds);
#endif
        }
        NEXT();
        if (ON()) { if (l == 1) {
            pg8::Gemm g{XB, (const bf16_t*)(ws + B_BTK), MAP, 768, DM}; pg8::StaticOrder S; S.init(MAP, 768, G, c); pg8::EpiF32 E{(float*)(ws + B_KVR), 768, SSQ + (size_t)4 * SSQS, 0, 0};
            pg8::gemm_phase<pg8::EpiF32, pg8::StaticOrder, true, true>(lds, g, S, E);
            asm volatile("s_waitcnt vmcnt(0)" ::: "memory"); __syncthreads();
            if (c < 195) {
                constexpr int nM = MAP / 256, nN = 3, nwg = nM * nN, q = nwg / 8, rr = nwg % 8; const int xcd = c % 8, off = c / 8;
                const int wgid = (xcd < rr ? xcd * (q + 1) : rr * (q + 1) + (xcd - rr) * q) + off; constexpr int nig = 8 * nN; const int gid = wgid / nig, fm = gid * 8, gsz = (nM - fm) < 8 ? (nM - fm) : 8;
                rows_post_tile(p, (fm + ((wgid % nig) % gsz)) * 256, (wgid % nig) / gsz); }
            } }
        NEXT();
        NEXT();
#ifndef NO_NAIVE
        if (ON()) { if (l == 1) { if (COMPRESS_NAIVE) ph_compress(p, ldsf); else ph_compress_fast(p, lds); } }
#endif
        NEXT();
    }
    if (TIME_MASK || TIME_SUB) { if (blockIdx.x == 0 && threadIdx.x == 0) { const unsigned long long t_acc = TIME_SUB ? __hip_atomic_load(&g_tsub[TIME_SUB > 0 ? TIME_SUB - 1 : 0], __ATOMIC_RELAXED, __HIP_MEMORY_SCOPE_AGENT) : TMR[0]; const unsigned long long t0 = __builtin_amdgcn_s_memrealtime(); while (__builtin_amdgcn_s_memrealtime() - t0 < 10ull * t_acc) __builtin_amdgcn_s_sleep(8); } }
}

extern "C" void kernel_launch(void* const* d_in, const int* in_sizes, int n_in, void* d_out, int out_size, void* d_ws, size_t ws_size, hipStream_t stream) {
    static int grid = 0;
    if (!grid) {
        int dev = 0, cus = 0;
        (void)hipGetDevice(&dev); (void)hipDeviceGetAttribute(&cus, hipDeviceAttributeMultiprocessorCount, dev);
        if (cus < 1) cus = 256;
        if (hipFuncSetAttribute((const void*)fwd, hipFuncAttributeMaxDynamicSharedMemorySize, LDS_BYTES) != hipSuccess) fprintf(stderr, "kernel_launch: hipFuncSetAttribute failed\n");
        int per_cu = 0; (void)hipOccupancyMaxActiveBlocksPerMultiprocessor(&per_cu, (const void*)fwd, NT_, LDS_BYTES); (void)hipGetLastError();
        if (per_cu < 1) fprintf(stderr, "kernel_launch: occupancy query says %d\n", per_cu);
        grid = cus;
    }
    if (n_in != N_IN || (size_t)out_size != O_END || ws_size < B_END) fprintf(stderr, "kernel_launch: unexpected sizes n_in=%d out=%d ws=%zu need %zu\n", n_in, out_size, ws_size, (size_t)B_END);
    (void)hipMemsetAsync(d_ws, 0, CTL_BYTES, stream);
    Params p{};
    for (int i = 0; i < N_IN; ++i) p.in[i] = (const float*)d_in[i];
    p.out = (float*)d_out; p.ws = (unsigned char*)d_ws;
#if MK_MULTI
    for (int ph = 0; ph < NPH; ++ph) {
        if (!phase_nonempty(ph)) continue;
        p.ph_lo = ph; p.ph_hi = ph + 1;
        hipLaunchKernelGGL(fwd, dim3(grid), dim3(NT_), LDS_BYTES, stream, p);
    }
#else
    p.ph_lo = 0; p.ph_hi = NPH;
    hipLaunchKernelGGL(fwd, dim3(grid), dim3(NT_), LDS_BYTES, stream, p);
#endif
}

#ifdef REGTEST
__global__ void __launch_bounds__(NT_, 2) rt_nsa(Params p) { extern __shared__ __attribute__((aligned(16))) unsigned char l_[]; ph_nsa_fast(p, 0, (LAS unsigned char*)l_); }
__global__ void __launch_bounds__(NT_, 2) rt_mlstm(Params p) { extern __shared__ __attribute__((aligned(16))) unsigned char l_[]; ph_mlstm_fast(p, 0, (LAS unsigned char*)l_); }
__global__ void __launch_bounds__(NT_, 2) rt_nsas(Params p) { extern __shared__ __attribute__((aligned(16))) unsigned char l_[]; ph_nsa_sample(p, 0, (LAS unsigned char*)l_); }
__global__ void __launch_bounds__(NT_, 2) rt_mem(Params p) { extern __shared__ __attribute__((aligned(16))) unsigned char l_[]; ph_mem_attn_fast(p, 0, (LAS unsigned char*)l_, 0, 256, 1); }
__global__ void __launch_bounds__(NT_, 2) rt_cmp(Params p) { extern __shared__ __attribute__((aligned(16))) unsigned char l_[]; ph_compress_fast(p, (LAS unsigned char*)l_); }
#endif
```

```cpp
#include <hip/hip_runtime.h>
#include <cstdio>
#include <cstdint>

#define LAS __attribute__((address_space(3)))
#define GAS __attribute__((address_space(1)))
#define XB_TMO      128
#define XB_XCNT(j)  (256  + 64 * (j))
#define XB_XSUB(j)  (1280 + 64 * (j))
#define XB_XGEN(j)  (2304 + 64 * (j))
#define XB_TOP      3328
#define XB_TOPGEN   3392
#define XCD_BAR_WORDS 3456
#define XB_SPIN_CAP (1u << 23)
__device__ __forceinline__ unsigned xb_ld(unsigned* p)              { return __hip_atomic_load(p, __ATOMIC_RELAXED, __HIP_MEMORY_SCOPE_AGENT); }
__device__ __forceinline__ unsigned xb_add(unsigned* p, unsigned v) { return __hip_atomic_fetch_add(p, v, __ATOMIC_RELAXED, __HIP_MEMORY_SCOPE_AGENT); }
__device__ __forceinline__ unsigned xb_xcc_id() { return (unsigned)__builtin_amdgcn_s_getreg((3 << 11) | 20) & 0xFu; }
#define XB_SPIN(cond, bar) do { unsigned _sp = 0; while (cond) { __builtin_amdgcn_s_sleep(1); \
    if ((++_sp & 255u) == 0u) { if (xb_ld(&(bar)[XB_TMO])) break; if (_sp > XB_SPIN_CAP) { atomicAdd(&(bar)[XB_TMO], 1u); break; } } } } while (0)
struct XcdBarrier { unsigned* bar; unsigned x; volatile LAS unsigned* st; };
__device__ __forceinline__ XcdBarrier xcd_barrier_post(unsigned* bar, volatile LAS unsigned* st) {
    XcdBarrier b; b.bar = bar; b.x = xb_xcc_id(); b.st = st;
    if (threadIdx.x == 0) (void)xb_add(&bar[XB_XCNT(b.x)], 1u);
    return b;
}
__device__ __forceinline__ void xcd_barrier_complete(unsigned* bar, unsigned x, unsigned& nloc, unsigned& nx) {
    const unsigned G = gridDim.x * gridDim.y * gridDim.z;
    unsigned sum, cnt, mine, sp = 0u;
    for (;;) {
        sum = 0u; cnt = 0u; mine = 0u;
#pragma unroll
        for (unsigned j = 0; j < 16; ++j) { const unsigned c = xb_ld(&bar[XB_XCNT(j)]); sum += c; cnt += (c > 0u) ? 1u : 0u; mine = (j == x) ? c : mine; }
        if (sum == G) break;
        __builtin_amdgcn_s_sleep(1);
        if ((++sp & 255u) == 0u) { if (xb_ld(&bar[XB_TMO])) break; if (sp > XB_SPIN_CAP) { atomicAdd(&bar[XB_TMO], 1u); break; } }
    }
    nloc = mine > 0u ? mine : 1u; nx = cnt > 0u ? cnt : 1u;
}
__device__ __forceinline__ void xcd_barrier(const XcdBarrier& b) {
    asm volatile("s_waitcnt vmcnt(0)" ::: "memory");
    __syncthreads();
    if (threadIdx.x == 0) {
        unsigned* bar = b.bar;
        __builtin_amdgcn_s_waitcnt(0);
        unsigned nloc = b.st[0], nx = b.st[1];
        if (nloc == 0u) { xcd_barrier_complete(bar, b.x, nloc, nx); b.st[0] = nloc; b.st[1] = nx; }
        const unsigned old = xb_add(&bar[XB_XSUB(b.x)], 1u);
        const unsigned gen = old / nloc;
        if (old + 1u == (gen + 1u) * nloc) {
            __builtin_amdgcn_fence(__ATOMIC_RELEASE, "agent");
            asm volatile("s_waitcnt vmcnt(0)" ::: "memory");
            const unsigned og = xb_add(&bar[XB_TOP], 1u);
            const unsigned tg = og / nx;
            if (og + 1u == (tg + 1u) * nx) xb_add(&bar[XB_TOPGEN], 1u);
            else XB_SPIN(xb_ld(&bar[XB_TOPGEN]) == tg, bar);
            __builtin_amdgcn_fence(__ATOMIC_ACQUIRE, "agent");
            xb_add(&bar[XB_XGEN(b.x)], 1u);
            asm volatile("s_waitcnt vmcnt(0)" ::: "memory");
        } else {
            XB_SPIN(xb_ld(&bar[XB_XGEN(b.x)]) == gen, bar);
            __builtin_amdgcn_fence(__ATOMIC_ACQUIRE, "agent");
            asm volatile("s_waitcnt vmcnt(0)" ::: "memory");
        }
    }
    __syncthreads();
}

constexpr int NT_ = 512, NW_ = 8;
constexpr int DM = 1024, BP = 8, SP = 2048, MP = BP * SP, BS = 128, MA = MP + BS, MAP = MP + 256;
constexpr int ACOLS = 3336, BCOLS = 1060, DFF = 2816;
constexpr int LDA_ = 3328, LDB_ = 1024;
constexpr int NBTA = 3344, NBTB = 1072;
constexpr int PAST = 2048, GTW = 48;
constexpr float EPS = 1e-6f, NEGM = -1e30f;
typedef unsigned short bf16_t;

enum { I_XP = 0, I_XS, I_SC, I_SN, I_SM, I_CMEM, I_CCMP, I_CSLC, I_CWIN, I_PT, I_MEMP, I_GMIX, I_WINA, I_BIF, I_GHN, I_WINB, I_GQ, I_BGATE, I_REL,
       I_GKV, I_WKV, I_GKSLC, I_GKWIN, I_GKCMP, I_CPOS, I_CW1, I_CB1, I_CW2, I_CB2, I_WMEMKV, I_GMEMK, I_GMEMQ, I_WOUT, I_GFFN, I_WGU, I_WDOWN, N_IN };
constexpr size_t O_YP = 0, O_YS = O_YP + (size_t)MP * DM, O_PC = O_YS + (size_t)BS * DM, O_PN = O_PC + 2ull * 8 * 4 * 192 * 192, O_PM = O_PN + 2ull * 8 * 4 * 192,
    O_PMEM = O_PM + 64, O_PCMP = O_PMEM + 4ull * 8 * 256 * 512, O_PSLC = O_PCMP + (size_t)MP * 256, O_PWIN = O_PSLC + (size_t)MP * 256, O_SC = O_PWIN + 8ull * 512 * 256,
    O_SN = O_SC + 2ull * 128 * 4 * 192 * 192, O_SM = O_SN + 2ull * 128 * 4 * 192, O_SCMP = O_SM + 1024, O_SSLC = O_SCMP + 128 * 256, O_SWIN = O_SSLC + 128 * 256,
    O_END = O_SWIN + 128ull * 512 * 256;
static_assert(O_END == 87700544ull, "output size");
constexpr size_t CTL_BYTES = 2u << 20, B_SSQ = 65536;
constexpr size_t al256(size_t x) { return (x + 255) & ~(size_t)255; }
constexpr size_t B_XB = CTL_BYTES, B_P16 = al256(B_XB + (size_t)MAP * DM * 2), B_GT = al256(B_P16 + (size_t)MAP * LDA_ * 2), B_CATB = al256(B_GT + (size_t)MAP * GTW * 4),
    B_HID = al256(B_CATB + (size_t)MA * DM * 2), B_HRAW = al256(B_HID + (size_t)MAP * DFF * 2), B_KVR = al256(B_HRAW + (size_t)MA * 768 * 4), B_CK = al256(B_KVR + (size_t)MAP * 768 * 4),
    B_CV = al256(B_CK + 136ull * 127 * 128 * 4), B_MPB = al256(B_CV + 136ull * 127 * 128 * 4),
    B_BTA = al256(B_MPB + 2048ull * DM * 2), B_BTB = al256(B_BTA + 2ull * NBTA * DM * 2), B_BTO = al256(B_BTB + 2ull * NBTB * DM * 2), B_BTG = al256(B_BTO + 4ull * DM * DM * 2),
    B_BTD = al256(B_BTG + 4ull * 2 * DFF * DM * 2), B_BTK = al256(B_BTD + 4ull * DM * DFF * 2), B_BTM = al256(B_BTK + 768ull * DM * 2), B_KVB = al256(B_BTM + 2048ull * DM * 2), B_SKF = al256(B_KVB + 6ull * BP * 2 * SP * 64 * 2), B_SVF = al256(B_SKF + (size_t)BP * 2 * SP * 64 * 2), B_KC16 = al256(B_SVF + (size_t)BP * 2 * SP * 64 * 2),
    B_W1T = al256(B_KC16 + 136ull * 2 * 2 * 128 * 64 * 2), B_W2T = al256(B_W1T + 2ull * 128 * 2048 * 2), B_PEB = al256(B_W2T + 2ull * 64 * 128 * 2), B_MEMR = al256(B_PEB + 1024), B_CMPS = al256(B_MEMR + 4ull * 2048 * 512 * 4), B_END = al256(B_CMPS + (size_t)BS * 4 * SP * 64 * 2 + 8192);
constexpr int SSQS = MAP;
static_assert(9 * SSQS * 4 + B_SSQ <= CTL_BYTES, "ssq sites inside the control region");

#ifndef TIME_SUB
#define TIME_SUB 0
#endif
#ifndef TSUB_BLK
#define TSUB_BLK 200
#endif
__device__ unsigned long long g_tsub[8];
#define TSUB_BEGIN() unsigned long long tsub_t0_ = (TIME_SUB && blockIdx.x == TSUB_BLK && threadIdx.x == 0) ? __builtin_amdgcn_s_memrealtime() : 0ull
#define TSUB_END(k) do { if (TIME_SUB && blockIdx.x == TSUB_BLK && threadIdx.x == 0) { const unsigned long long n_ = __builtin_amdgcn_s_memrealtime(); g_tsub[k] += n_ - tsub_t0_; tsub_t0_ = n_; } } while (0)
struct Params { const float* in[N_IN]; float* out; unsigned char* ws; int ph_lo, ph_hi; };

__device__ const unsigned char REL_LUT[128] = {0, 1, 2, 3, 4, 5, 6, 7, 8, 9, 10, 11, 12, 13, 14, 15, 16, 16, 16, 17, 17, 18, 18, 18, 19, 19, 19, 20, 20, 20, 20, 21, 21, 21, 21, 22, 22, 22, 22, 22, 23, 23, 23, 23, 23, 23, 24, 24, 24, 24, 24, 24, 25, 25, 25, 25, 25, 25, 25, 26, 26, 26, 26, 26, 26, 26, 26, 27, 27, 27, 27, 27, 27, 27, 27, 27, 27, 28, 28, 28, 28, 28, 28, 28, 28, 28, 28, 29, 29, 29, 29, 29, 29, 29, 29, 29, 29, 29, 29, 30, 30, 30, 30, 30, 30, 30, 30, 30, 30, 30, 30, 30, 30, 31, 31, 31, 31, 31, 31, 31, 31, 31, 31, 31, 31, 31, 31, 31};
__device__ __forceinline__ int rel_bucket(int d) { return d >= 128 ? 31 : (int)REL_LUT[d < 0 ? 0 : d]; }
__device__ __forceinline__ int rel_bucket_alu(int d) { d = d < 0 ? 0 : d; if (d < 16) return d;
    return 16 + (d >= 19) + (d >= 21) + (d >= 24) + (d >= 27) + (d >= 31) + (d >= 35) + (d >= 40) + (d >= 46) + (d >= 52) + (d >= 59) + (d >= 67) + (d >= 77) + (d >= 87) + (d >= 99) + (d >= 113); }

__device__ __forceinline__ int opq(int i) { asm volatile("" : "+s"(i)); return i; }
#define BAR_LDS() do { asm volatile("s_waitcnt lgkmcnt(0)" ::: "memory"); __builtin_amdgcn_s_barrier(); asm volatile("" ::: "memory"); } while (0)
__device__ __forceinline__ int ltid() { int t = threadIdx.x; asm volatile("" : "+v"(t)); return t; }
__device__ __forceinline__ float wave_sum(float v) {
#pragma unroll
    for (int o = 32; o; o >>= 1) v += __shfl_xor(v, o);
    return v;
}
__device__ __forceinline__ float wave_max(float v) {
#pragma unroll
    for (int o = 32; o; o >>= 1) v = fmaxf(v, __shfl_xor(v, o));
    return v;
}
__device__ __forceinline__ float sigmoidf_(float x) { return 1.0f / (1.0f + expf(-x)); }
__device__ __forceinline__ float logsigmoidf_(float x) { return fminf(x, 0.f) - log1pf(expf(-fabsf(x))); }
__device__ __forceinline__ float dot4(float4 a, float4 b) { return a.x * b.x + a.y * b.y + a.z * b.z + a.w * b.w; }
__device__ __forceinline__ float bf2f(bf16_t u) { return __uint_as_float((unsigned)u << 16); }
__device__ __forceinline__ unsigned f2bf(float f) { unsigned u = __float_as_uint(f); return (u + 0x7fffu + ((u >> 16) & 1u)) >> 16; }
__device__ __forceinline__ unsigned pk2(float lo, float hi) { return f2bf(lo) | (f2bf(hi) << 16); }
__device__ __forceinline__ float bflo(unsigned w) { return __uint_as_float(w << 16); }
__device__ __forceinline__ float bfhi(unsigned w) { return __uint_as_float(w & 0xffff0000u); }
__device__ __forceinline__ float rstd_of(float ssq) { return rsqrtf(ssq * (1.0f / DM) + EPS); }

namespace pg8 {
#define PG8_LAS __attribute__((address_space(3)))
typedef unsigned short bf16_t;
typedef short bf16x8 __attribute__((ext_vector_type(8)));
typedef float f32x4 __attribute__((ext_vector_type(4)));
typedef unsigned u32x4 __attribute__((ext_vector_type(4)));
constexpr int BM = 256, BK = 64, HALF = 128, HTB = HALF * BK * 2  , STAGE_BYTES = 8 * HTB, NXCD = 8, WGM = 8;

__host__ __device__ __forceinline__ int lds_byte(int r, int c) { const int st = (r >> 4) * 2 + (c >> 5), rr = r & 15, cc = c & 31, ob = rr * 64 + cc * 2; return st * 1024 + (ob ^ (((ob >> 9) & 1) << 5)); }
__host__ __device__ __forceinline__ void stage_rc(int b, int& R, int& C) { const int st = b / 1024, sb = b % 1024, swz = sb ^ (((sb >> 9) & 1) << 5); R = (st >> 1) * 16 + swz / 64; C = (st & 1) * 32 + (swz % 64) / 2; }
__host__ __device__ __forceinline__ int perm32(int rho) { const int n = rho >> 4, i = rho & 15; return 8 * (i >> 2) + 4 * n + (i & 3); }

struct Unit { int pm, pn; };
struct Gemm { const bf16_t* A; const bf16_t* Bt; int M, N, K; };

struct StaticOrder {
    int nM, nN, nwg, G, c;
    __host__ __device__ void init(int M, int N, int G_, int c_) { nM = M / BM; nN = N / BM; nwg = nM * nN; G = G_; c = c_; }
    __host__ __device__ bool next(int i, Unit& u) const {
        const long L = (long)i * G + c; if (L >= nwg) return false;
        int wgid = (int)L; { const int q = nwg / NXCD, r = nwg % NXCD, xcd = wgid % NXCD, off = wgid / NXCD; wgid = (xcd < r ? xcd * (q + 1) : r * (q + 1) + (xcd - r) * q) + off; }
        const int nig = WGM * nN, gid = wgid / nig, fm = gid * WGM, gsz = (nM - fm) < WGM ? (nM - fm) : WGM;
        u.pm = fm + ((wgid % nig) % gsz); u.pn = (wgid % nig) / gsz; return true;
    }
    __device__ __forceinline__ void a_ready(const Unit&) const {}
    __device__ __forceinline__ void done(const Unit&) const {}
};

__device__ __forceinline__ unsigned cvt_pk_bf16(float lo, float hi) { unsigned r; asm volatile("v_cvt_pk_bf16_f32 %0, %1, %2" : "=v"(r) : "v"(lo), "v"(hi)); return r; }
typedef float f32x2 __attribute__((ext_vector_type(2)));
__device__ __forceinline__ float fast_sigmoid(float x) { return __builtin_amdgcn_rcpf(1.0f + __builtin_amdgcn_exp2f(-1.4426950408889634f * x)); }
struct EpiF32 {
    static constexpr bool PERM = false, AFTER_DRAIN = false;
    float* O; int ldc; const float* ssq; int split_cols; size_t split_stride;
    __device__ __forceinline__ void operator()(const f32x4 (&acc)[2][2][4][2], const Unit& u, int wr, int wc, int fr, int fq) const {
        int colt = u.pn * BM; float* base = O; if (split_cols) { const int t = colt / split_cols; base += (size_t)t * split_stride; colt -= t * split_cols; }
        const int row0 = u.pm * BM + wr * 64 + fr, col0 = colt + wc * 32 + 4 * fq;
#pragma unroll
        for (int ai = 0; ai < 2; ++ai)
#pragma unroll
            for (int m = 0; m < 4; ++m) { const int r = row0 + ai * HALF + m * 16; const float rs = ssq ? rstd_of(ssq[r]) : 1.0f; float* rowp = base + (size_t)r * ldc + col0;
#pragma unroll
                for (int bj = 0; bj < 2; ++bj)
#pragma unroll
                    for (int n = 0; n < 2; ++n) *(f32x4*)(rowp + bj * HALF + n * 16) = acc[ai][bj][m][n] * rs; }
    }
};
struct EpiBf16S {
    static constexpr bool PERM = true, AFTER_DRAIN = false;
    bf16_t* O; int ldc; const float* ssq; int gate_pn; float* GT;
    __device__ __forceinline__ void operator()(const f32x4 (&acc)[2][2][4][2], const Unit& u, int wr, int wc, int fr, int fq) const {
        const int row0 = u.pm * BM + wr * 64 + fr, col0 = u.pn * BM + wc * 32 + 8 * fq;
        if (u.pn == gate_pn) {
            if (wc == 0 && fq == 0) {
#pragma unroll
                for (int ai = 0; ai < 2; ++ai)
#pragma unroll
                    for (int m = 0; m < 4; ++m) { const int r = row0 + ai * HALF + m * 16; const float rs = rstd_of(ssq[r]);
                        *(f32x4*)(GT + (size_t)r * 48) = acc[ai][0][m][0] * rs; *(f32x4*)(GT + (size_t)r * 48 + 4) = acc[ai][0][m][1] * rs; } }
            return; }
#pragma unroll
        for (int ai = 0; ai < 2; ++ai)
#pragma unroll
            for (int m = 0; m < 4; ++m) { const int r = row0 + ai * HALF + m * 16; const float rs = rstd_of(ssq[r]); bf16_t* rowp = O + (size_t)r * ldc + col0;
#pragma unroll
                for (int bj = 0; bj < 2; ++bj) { const f32x4 v0 = acc[ai][bj][m][0] * rs, v1 = acc[ai][bj][m][1] * rs;
                    u32x4 w; w.x = cvt_pk_bf16(v0[0], v0[1]); w.y = cvt_pk_bf16(v0[2], v0[3]); w.z = cvt_pk_bf16(v1[0], v1[1]); w.w = cvt_pk_bf16(v1[2], v1[3]);
                    *(u32x4*)(rowp + bj * HALF) = w; } }
    }
};
struct EpiSwiglu {
    static constexpr bool PERM = true, AFTER_DRAIN = false;
    bf16_t* O; const float* ssq;
    __device__ __forceinline__ void operator()(const f32x4 (&acc)[2][2][4][2], const Unit& u, int wr, int wc, int fr, int fq) const {
        const int row0 = u.pm * BM + wr * 64 + fr, col0 = u.pn * HALF + wc * 32 + 8 * fq;
#pragma unroll
        for (int ai = 0; ai < 2; ++ai)
#pragma unroll
            for (int m = 0; m < 4; ++m) { const int r = row0 + ai * HALF + m * 16; const float rs = rstd_of(ssq[r]); float h[8];
#pragma unroll
                for (int n = 0; n < 2; ++n)
#pragma unroll
                    for (int j = 0; j < 4; ++j) { const float g = acc[ai][0][m][n][j] * rs, up = acc[ai][1][m][n][j] * rs; h[4 * n + j] = g * fast_sigmoid(g) * up; }
                u32x4 w; w.x = cvt_pk_bf16(h[0], h[1]); w.y = cvt_pk_bf16(h[2], h[3]); w.z = cvt_pk_bf16(h[4], h[5]); w.w = cvt_pk_bf16(h[6], h[7]);
                *(u32x4*)(O + (size_t)r * 2816 + col0) = w; }
    }
};
struct EpiResid {
    static constexpr bool PERM = false, AFTER_DRAIN = false;
    float* Y; bf16_t* XB; float* ssq;
    __device__ __forceinline__ void operator()(const f32x4 (&acc)[2][2][4][2], const Unit& u, int wr, int wc, int fr, int fq) const {
        const int row0 = u.pm * BM + wr * 64 + fr, col0 = u.pn * BM + wc * 32 + 4 * fq;
        typedef unsigned u32x2 __attribute__((ext_vector_type(2)));
#pragma unroll
        for (int ai = 0; ai < 2; ++ai)
#pragma unroll
            for (int m = 0; m < 4; ++m) { const int r = row0 + ai * HALF + m * 16; bf16_t* bp = XB + (size_t)r * 1024 + col0; float ss = 0.f; u32x2 old[2][2];
#pragma unroll
                for (int bj = 0; bj < 2; ++bj)
#pragma unroll
                    for (int n = 0; n < 2; ++n) old[bj][n] = *(const u32x2*)(bp + bj * HALF + n * 16);
#pragma unroll
                for (int bj = 0; bj < 2; ++bj)
#pragma unroll
                    for (int n = 0; n < 2; ++n) { const u32x2 o = old[bj][n]; f32x4 x = (f32x4){bflo(o.x), bfhi(o.x), bflo(o.y), bfhi(o.y)} + acc[ai][bj][m][n];
                        u32x2 w; w.x = cvt_pk_bf16(x[0], x[1]); w.y = cvt_pk_bf16(x[2], x[3]); *(u32x2*)(bp + bj * HALF + n * 16) = w;
                        if (Y) *(f32x4*)(Y + (size_t)r * 1024 + col0 + bj * HALF + n * 16) = x;
                        ss += (x[0] * x[0] + x[1] * x[1]) + (x[2] * x[2] + x[3] * x[3]); }
                ss += __shfl_xor(ss, 16); ss += __shfl_xor(ss, 32);
                if (fq == 0) (void)__hip_atomic_fetch_add(ssq + r, ss, __ATOMIC_RELAXED, __HIP_MEMORY_SCOPE_AGENT); }
    }
};
template <class Epi, class Sched, bool ALIGN_EPI = false, bool SP2 = false>
__device__ __forceinline__ void gemm_phase(PG8_LAS unsigned char* lds, const Gemm g, const Sched& S, const Epi& E) {
    int tid_l = threadIdx.x; asm volatile("" : "+v"(tid_l));
    const int tid = tid_l, wid = __builtin_amdgcn_readfirstlane(tid >> 6), lane = tid & 63, wr = wid >> 2, wc = wid & 3, fr = lane & 15, fq = lane >> 4;
    const int K = g.K, nt = K / BK;
    unsigned voffA[2], voffB[2];
#pragma unroll
    for (int i = 0; i < 2; ++i) { int R, C; stage_rc(tid * 16 + i * 8192, R, C); const int Rb = Epi::PERM ? ((R & ~31) + perm32(R & 31)) : R;
        voffA[i] = (unsigned)(R * K + C) * 2u; voffB[i] = (unsigned)(Rb * K + C) * 2u; }
    const size_t kstep = (size_t)(BK * 2);
    const size_t hstep = (size_t)HALF * K * 2;
    const size_t tstep = 2 * hstep;
    const unsigned ldsw = (unsigned)wid * 1024u;
    const int aoff = lds_byte(wr * 64 + fr, fq * 8), boff = lds_byte(wc * 32 + fr, fq * 8);
#define PG8_SA(b, h) (((b) * 2 + (h)) * HTB)
#define PG8_SB(b, h) ((4 + (b) * 2 + (h)) * HTB)
#define PG8_STAGE(bufoff, gbase, voff) do { _Pragma("unroll") for (int _i = 0; _i < 2; ++_i) \
        __builtin_amdgcn_global_load_lds((const unsigned*)((const char*)(gbase) + (voff)[_i]), (PG8_LAS unsigned*)(lds + (bufoff) + ldsw + _i * 8192), 16, 0, 0); } while (0)
#define PG8_LDA(dst, b, h) do { _Pragma("unroll") for (int m = 0; m < 4; ++m) _Pragma("unroll") for (int k = 0; k < 2; ++k) dst[m][k] = *(const PG8_LAS bf16x8*)(lds + PG8_SA(b, h) + aoff + m * 2048 + k * 1024); } while (0)
#define PG8_LDB(dst, b, h) do { _Pragma("unroll") for (int n = 0; n < 2; ++n) _Pragma("unroll") for (int k = 0; k < 2; ++k) dst[n][k] = *(const PG8_LAS bf16x8*)(lds + PG8_SB(b, h) + boff + n * 2048 + k * 1024); } while (0)
#define PG8_MMA(ai, bj, At, Bt) do { __builtin_amdgcn_s_setprio(1); _Pragma("unroll") for (int m = 0; m < 4; ++m) _Pragma("unroll") for (int n = 0; n < 2; ++n) _Pragma("unroll") for (int k = 0; k < 2; ++k) \
        acc[ai][bj][m][n] = __builtin_amdgcn_mfma_f32_16x16x32_bf16(Bt[n][k], At[m][k], acc[ai][bj][m][n], 0, 0, 0); __builtin_amdgcn_s_setprio(0); } while (0)
#define PG8_WAIT_V(n) asm volatile("s_waitcnt vmcnt(" #n ")" ::: "memory")
#define PG8_WAIT_L(n) asm volatile("s_waitcnt lgkmcnt(" #n ")" ::: "memory")
#define PG8_BAR __builtin_amdgcn_s_barrier()
#define PG8_SCHED __builtin_amdgcn_sched_barrier(0)
    Unit cur, nxt; int ui = 0;
    if (!S.next(0, cur)) return;
    f32x4 acc[2][2][4][2];
#pragma unroll
    for (int a = 0; a < 2; ++a)
#pragma unroll
        for (int b = 0; b < 2; ++b)
#pragma unroll
            for (int m = 0; m < 4; ++m)
#pragma unroll
                for (int n = 0; n < 2; ++n) acc[a][b][m][n] = (f32x4){0.f, 0.f, 0.f, 0.f};
    bf16x8 At[4][2], B0[2][2], B1[2][2];
    const char* cA = (const char*)g.A + (size_t)cur.pm * tstep; const char* cB = (const char*)g.Bt + (size_t)cur.pn * tstep;
    S.a_ready(cur);
    if constexpr (SP2) {
        PG8_STAGE(PG8_SB(0, 0), cB, voffB); PG8_STAGE(PG8_SB(0, 1), cB + hstep, voffB); PG8_STAGE(PG8_SA(0, 0), cA, voffA); PG8_STAGE(PG8_SA(0, 1), cA + hstep, voffA);
        if (wr == 1) PG8_BAR;
        PG8_WAIT_V(2); PG8_BAR;
        PG8_STAGE(PG8_SB(1, 0), cB + kstep, voffB); PG8_STAGE(PG8_SA(1, 0), cA + kstep, voffA); PG8_STAGE(PG8_SB(1, 1), cB + hstep + kstep, voffB);
        PG8_WAIT_V(6); PG8_BAR;
    } else {
        PG8_STAGE(PG8_SB(0, 0), cB, voffB); PG8_STAGE(PG8_SA(0, 0), cA, voffA); PG8_STAGE(PG8_SB(0, 1), cB + hstep, voffB); PG8_STAGE(PG8_SA(0, 1), cA + hstep, voffA);
        if (wr == 1) PG8_BAR;
        PG8_WAIT_V(4); PG8_BAR;
        PG8_STAGE(PG8_SB(1, 0), cB + kstep, voffB); PG8_STAGE(PG8_SA(1, 0), cA + kstep, voffA); PG8_STAGE(PG8_SB(1, 1), cB + hstep + kstep, voffB);
        PG8_WAIT_V(6); PG8_BAR;
    }
    for (;;) {
        const bool has_next = S.next(ui + 1, nxt);
        const char* nA = has_next ? (const char*)g.A + (size_t)nxt.pm * tstep : cA; const char* nB = has_next ? (const char*)g.Bt + (size_t)nxt.pn * tstep : cB;
        for (int t = 0; t < nt; t += 2) {
            const bool last = (t == nt - 2);
            const char* a1 = cA + (size_t)(t + 1) * kstep;
            const char* a2 = last ? nA : cA + (size_t)(t + 2) * kstep; const char* b2 = last ? nB : cB + (size_t)(t + 2) * kstep;
            const char* a3 = a2 + kstep; const char* b3 = b2 + kstep;
            if (last && has_next) S.a_ready(nxt);
            if constexpr (SP2) {
            PG8_LDB(B0, 0, 0); PG8_LDB(B1, 0, 1); PG8_SCHED; PG8_LDA(At, 0, 0); PG8_STAGE(PG8_SA(1, 1), a1 + hstep, voffA);
            PG8_WAIT_V(8); PG8_WAIT_L(0); PG8_BAR; PG8_MMA(0, 0, At, B0); PG8_MMA(0, 1, At, B1); PG8_BAR; PG8_SCHED;
            PG8_LDA(At, 0, 1); PG8_STAGE(PG8_SB(0, 0), b2, voffB); PG8_STAGE(PG8_SB(0, 1), b2 + hstep, voffB); PG8_STAGE(PG8_SA(0, 0), a2, voffA);
            PG8_WAIT_V(8); PG8_WAIT_L(0); PG8_BAR; PG8_MMA(1, 0, At, B0); PG8_MMA(1, 1, At, B1); PG8_BAR; PG8_SCHED;
            PG8_LDB(B0, 1, 0); PG8_LDB(B1, 1, 1); PG8_SCHED; PG8_LDA(At, 1, 0); PG8_STAGE(PG8_SA(0, 1), a2 + hstep, voffA);
            PG8_WAIT_V(8); PG8_WAIT_L(0); PG8_BAR; PG8_MMA(0, 0, At, B0); PG8_MMA(0, 1, At, B1); PG8_BAR; PG8_SCHED;
            PG8_LDA(At, 1, 1); PG8_STAGE(PG8_SB(1, 0), b3, voffB); PG8_STAGE(PG8_SB(1, 1), b3 + hstep, voffB); PG8_STAGE(PG8_SA(1, 0), a3, voffA);
            PG8_WAIT_V(8); PG8_WAIT_L(0); PG8_BAR; PG8_MMA(1, 0, At, B0); PG8_MMA(1, 1, At, B1); PG8_BAR; PG8_SCHED;
            } else {
            PG8_LDB(B0, 0, 0); PG8_SCHED; PG8_LDA(At, 0, 0); PG8_STAGE(PG8_SA(1, 1), a1 + hstep, voffA);
            PG8_WAIT_L(8); PG8_BAR; PG8_WAIT_L(0); PG8_MMA(0, 0, At, B0); PG8_BAR; PG8_SCHED;
            PG8_LDB(B1, 0, 1); PG8_STAGE(PG8_SB(0, 0), b2, voffB);
            PG8_BAR; PG8_WAIT_L(0); PG8_MMA(0, 1, At, B1); PG8_BAR;
            PG8_LDA(At, 0, 1); PG8_STAGE(PG8_SA(0, 0), a2, voffA);
            PG8_BAR; PG8_WAIT_L(0); PG8_MMA(1, 0, At, B0); PG8_BAR; PG8_SCHED;
            PG8_STAGE(PG8_SB(0, 1), b2 + hstep, voffB);
            PG8_WAIT_V(6); PG8_BAR; PG8_MMA(1, 1, At, B1); PG8_BAR;
            PG8_LDB(B0, 1, 0); PG8_SCHED; PG8_LDA(At, 1, 0); PG8_STAGE(PG8_SA(0, 1), a2 + hstep, voffA);
            PG8_WAIT_L(8); PG8_BAR; PG8_WAIT_L(0); PG8_MMA(0, 0, At, B0); PG8_BAR; PG8_SCHED;
            PG8_LDB(B1, 1, 1); PG8_STAGE(PG8_SB(1, 0), b3, voffB);
            PG8_BAR; PG8_WAIT_L(0); PG8_MMA(0, 1, At, B1); PG8_BAR;
            PG8_LDA(At, 1, 1); PG8_STAGE(PG8_SA(1, 0), a3, voffA);
            PG8_BAR; PG8_WAIT_L(0); PG8_MMA(1, 0, At, B0); PG8_BAR; PG8_SCHED;
            PG8_STAGE(PG8_SB(1, 1), b3 + hstep, voffB);
            PG8_WAIT_V(6); PG8_BAR; PG8_MMA(1, 1, At, B1); PG8_BAR;
            }
        }
        if constexpr (ALIGN_EPI) { if (wr == 0) PG8_BAR; }
        if constexpr (!Epi::AFTER_DRAIN) { E(acc, cur, wr, wc, fr, fq); S.done(cur); }
        if (!has_next) break;
#pragma unroll
        for (int a = 0; a < 2; ++a)
#pragma unroll
            for (int b = 0; b < 2; ++b)
#pragma unroll
                for (int m = 0; m < 4; ++m)
#pragma unroll
                    for (int n = 0; n < 2; ++n) acc[a][b][m][n] = (f32x4){0.f, 0.f, 0.f, 0.f};
        cur = nxt; cA = nA; cB = nB; ++ui;
        if constexpr (ALIGN_EPI) { if (wr == 1) PG8_BAR; }
    }
    PG8_WAIT_V(0);
    if constexpr (!ALIGN_EPI) { if (wr == 0) PG8_BAR; }
    PG8_BAR;
    if constexpr (Epi::AFTER_DRAIN) { E.fused(acc, cur, wr, wc, fr, fq, lds, wid, lane); S.done(cur); }
#undef PG8_SA
#undef PG8_SB
#undef PG8_STAGE
#undef PG8_LDA
#undef PG8_LDB
#undef PG8_MMA
#undef PG8_WAIT_V
#undef PG8_WAIT_L
#undef PG8_BAR
#undef PG8_SCHED
}
}
typedef short s_bf16x8 __attribute__((ext_vector_type(8)));
typedef float s_f32x4 __attribute__((ext_vector_type(4)));
template <int NT> struct StripAcc { s_f32x4 a[NT]; };
template <int NT> __device__ __forceinline__ void strip_gemm(const bf16_t* A, int K, int row0, const bf16_t* Bt, const int* brow  , StripAcc<NT>& R, LAS unsigned char* lds) {
    const int tid_ = ltid(), lane = tid_ & 63, wave = tid_ >> 6, fr = lane & 15, fq = lane >> 4, rt = wave & 1, kq = wave >> 1;
    LAS float* red = (LAS float*)lds;
    const int kw = K >> 2;
    const bf16_t* ap = A + (size_t)(row0 + 16 * rt + fr) * K + kq * kw + fq * 8;
    const bf16_t* bp[NT];
#pragma unroll
    for (int t = 0; t < NT; ++t) { bp[t] = Bt + (size_t)(brow[t] + fr) * K + kq * kw + fq * 8; R.a[t] = (s_f32x4){0.f, 0.f, 0.f, 0.f}; }
    int k0 = 0;
#pragma unroll 1
    for (; k0 + 256 <= kw; k0 += 256) {
        s_bf16x8 a[8], b[NT][8];
#pragma unroll
        for (int s2 = 0; s2 < 8; ++s2) { a[s2] = *(const s_bf16x8*)(ap + k0 + s2 * 32);
#pragma unroll
            for (int t = 0; t < NT; ++t) b[t][s2] = *(const s_bf16x8*)(bp[t] + k0 + s2 * 32); }
#pragma unroll
        for (int s2 = 0; s2 < 8; ++s2)
#pragma unroll
            for (int t = 0; t < NT; ++t) R.a[t] = __builtin_amdgcn_mfma_f32_16x16x32_bf16(b[t][s2], a[s2], R.a[t], 0, 0, 0);
    }
#pragma unroll 1
    for (; k0 < kw; k0 += 64) {
        s_bf16x8 a[2], b[NT][2];
#pragma unroll
        for (int s2 = 0; s2 < 2; ++s2) { a[s2] = *(const s_bf16x8*)(ap + k0 + s2 * 32);
#pragma unroll
            for (int t = 0; t < NT; ++t) b[t][s2] = *(const s_bf16x8*)(bp[t] + k0 + s2 * 32); }
#pragma unroll
        for (int s2 = 0; s2 < 2; ++s2)
#pragma unroll
            for (int t = 0; t < NT; ++t) R.a[t] = __builtin_amdgcn_mfma_f32_16x16x32_bf16(b[t][s2], a[s2], R.a[t], 0, 0, 0);
    }
    __syncthreads();
    if (kq > 0) {
#pragma unroll
        for (int t = 0; t < NT; ++t) *(LAS s_f32x4*)(red + ((((kq - 1) * 2 + rt) * NT + t) * 64 + lane) * 4) = R.a[t]; }
    __syncthreads();
    if (kq == 0) {
#pragma unroll
        for (int q = 0; q < 3; ++q)
#pragma unroll
            for (int t = 0; t < NT; ++t) R.a[t] = R.a[t] + *(const LAS s_f32x4*)(red + (((q * 2 + rt) * NT + t) * 64 + lane) * 4); }
}
enum { TR_ID = 0, TR_INA, TR_INB, TR_GU };
__device__ __forceinline__ int tr_rowmap(int kind, int n) {
    if (kind == TR_INA) return n < 3072 ? n : (n < 3080 ? 3328 + (n - 3072) : 3072 + (n - 3080));
    if (kind == TR_INB) return n < 768 ? n : (n < 804 ? 1024 + (n - 768) : 768 + (n - 804));
    if (kind == TR_GU) { if (n < DFF) return (n >> 7) * 256 + (n & 127); const int m = n - DFF; return (m >> 7) * 256 + 128 + (m & 127); }
    return n;
}
__device__ __forceinline__ void tr_item(const float* W, int K, int N, bf16_t* WT, const float* gain, int kind, LAS float* scr, int item, int lane) {
    const int nblk = (N + 31) >> 5, kb = item / nblk, nb = item % nblk, k0 = 64 * kb, n0 = 32 * nb;
    { float v[32]; const int n = n0 + (lane & 31); const bool ok = n < N; const float* wp = W + (size_t)(k0 + (lane >> 5)) * N + (ok ? n : 0);
#pragma unroll
      for (int i = 0; i < 32; ++i) v[i] = wp[(size_t)(2 * i) * N];
#pragma unroll
      for (int i = 0; i < 32; ++i) { const int kk = 2 * i + (lane >> 5); float x = ok ? v[i] : 0.f; if (gain) x *= gain[k0 + kk]; scr[kk * 33 + (lane & 31)] = x; } }
    asm volatile("s_waitcnt lgkmcnt(0)" ::: "memory");
    const int c = lane & 7;
#pragma unroll
    for (int j = 0; j < 4; ++j) { const int nn = (lane >> 3) + 8 * j, n = n0 + nn;
        if (n < N) { const int row = tr_rowmap(kind, n); const float sc = (kind == TR_INA && n >= 768 && n < 1536) ? 0.07216878364870322f : 1.0f;
            const LAS float* s = scr + (8 * c) * 33 + nn; uint4 o;
            o.x = pk2(s[0 * 33] * sc, s[1 * 33] * sc); o.y = pk2(s[2 * 33] * sc, s[3 * 33] * sc); o.z = pk2(s[4 * 33] * sc, s[5 * 33] * sc); o.w = pk2(s[6 * 33] * sc, s[7 * 33] * sc);
            *(uint4*)(WT + (size_t)row * K + k0 + 8 * c) = o; } }
    asm volatile("s_waitcnt lgkmcnt(0)" ::: "memory");
}
__device__ __forceinline__ void ph_prologue(const Params& p, LAS unsigned char* lds) {
    const int tid = ltid(), lane = tid & 63, wid = tid >> 6; const int gw = blockIdx.x * NW_ + wid, NGW = gridDim.x * NW_;
    LAS float* scr = (LAS float*)(lds + wid * 16384);
    unsigned char* ws = p.ws;
    for (int it = gw; ; it += NGW) {
        int r = it; bool done = false;
#define TRJ(Wp, K_, N_, WTp, gainp, kind_) if (!done) { const int cnt = ((K_) / 64) * (((N_) + 31) / 32); if (r < cnt) { tr_item(Wp, K_, N_, WTp, gainp, kind_, scr, r, lane); done = true; } else r -= cnt; }
        for (int l = 0; l < 4; ++l) TRJ(p.in[I_WGU] + (size_t)l * DM * 2 * DFF, DM, 2 * DFF, (bf16_t*)(ws + B_BTG) + (size_t)l * 2 * DFF * DM, p.in[I_GFFN] + l * DM, TR_GU)
        for (int l = 0; l < 4; ++l) TRJ(p.in[I_WDOWN] + (size_t)l * DFF * DM, DFF, DM, (bf16_t*)(ws + B_BTD) + (size_t)l * DM * DFF, (const float*)nullptr, TR_ID)
        for (int l = 0; l < 2; ++l) TRJ(p.in[I_WINA] + (size_t)l * DM * ACOLS, DM, ACOLS, (bf16_t*)(ws + B_BTA) + (size_t)l * NBTA * DM, p.in[I_GMIX] + l * DM, TR_INA)
        for (int l = 0; l < 2; ++l) TRJ(p.in[I_WINB] + (size_t)l * DM * BCOLS, DM, BCOLS, (bf16_t*)(ws + B_BTB) + (size_t)l * NBTB * DM, p.in[I_GMIX] + (2 + l) * DM, TR_INB)
        for (int l = 0; l < 4; ++l) TRJ(p.in[I_WOUT] + (size_t)l * DM * DM, DM, DM, (bf16_t*)(ws + B_BTO) + (size_t)l * DM * DM, (const float*)nullptr, TR_ID)
        TRJ(p.in[I_WKV], DM, 768, (bf16_t*)(ws + B_BTK), p.in[I_GKV], TR_ID)
        for (int l = 0; l < 4; ++l) TRJ(p.in[I_WMEMKV] + (size_t)l * DM * 512, DM, 512, (bf16_t*)(ws + B_BTM) + (size_t)l * 512 * DM, (const float*)nullptr, TR_ID)
        for (int c = 0; c < 2; ++c) TRJ(p.in[I_CW1] + (size_t)c * 2048 * 128, 2048, 128, (bf16_t*)(ws + B_W1T) + (size_t)c * 128 * 2048, (const float*)nullptr, TR_ID)
        for (int c = 0; c < 2; ++c) TRJ(p.in[I_CW2] + (size_t)c * 128 * 64, 128, 64, (bf16_t*)(ws + B_W2T) + (size_t)c * 64 * 128, (const float*)nullptr, TR_ID)
#undef TRJ
        if (!done) break;
    }
    for (int idx = gw; idx < 256; idx += NGW) { const int c = idx >> 7, h = idx & 127; float s = 0.f;
        for (int k = lane; k < 2048; k += 64) s += p.in[I_CPOS][((k >> 6) * 2 + c) * 64 + (k & 63)] * p.in[I_CW1][((size_t)c * 2048 + k) * 128 + h];
        s = wave_sum(s); if (lane == 0) ((float*)(ws + B_PEB))[idx] = s + p.in[I_CB1][idx]; }
    for (int i = blockIdx.x * NT_ + tid; i < 2 * 8 * 128 + 2 * 12 * 128; i += gridDim.x * NT_) {
        uint4 z = make_uint4(0u, 0u, 0u, 0u);
        if (i < 2048) { const int l = i >> 10, rr = (i >> 7) & 7, c = i & 127; ((uint4*)((bf16_t*)(ws + B_BTA) + ((size_t)l * NBTA + 3336 + rr) * DM))[c] = z; }
        else { const int k = i - 2048; const int l = k / 1536, rr = (k % 1536) >> 7, c = k & 127; ((uint4*)((bf16_t*)(ws + B_BTB) + ((size_t)l * NBTB + 1060 + rr) * DM))[c] = z; }
    }
    bf16_t* XB = (bf16_t*)(ws + B_XB); float* ssq0 = (float*)(ws + B_SSQ); bf16_t* MPB = (bf16_t*)(ws + B_MPB);
    for (int r0 = gw; r0 < MA + 2048; r0 += 2 * NGW) {
        float4 v[2][4]; const int r1 = r0 + NGW < MA + 2048 ? r0 + NGW : r0;
#pragma unroll
        for (int u = 0; u < 2; ++u) { const int r = u ? r1 : r0; const float* src = r < MA ? (r < MP ? p.in[I_XP] + (size_t)r * DM : p.in[I_XS] + (size_t)(r - MP) * DM) : p.in[I_MEMP] + (size_t)(r - MA) * DM;
#pragma unroll
            for (int j = 0; j < 4; ++j) v[u][j] = ((const float4*)src)[lane + 64 * j]; }
#pragma unroll
        for (int u = 0; u < 2; ++u) { const int r = u ? r1 : r0; if (u == 1 && r1 == r0) break; const bool isx = r < MA;
            bf16_t* dstb = isx ? XB + (size_t)r * DM : MPB + (size_t)(r - MA) * DM; float ss = 0.f;
#pragma unroll
            for (int j = 0; j < 4; ++j) { ss += dot4(v[u][j], v[u][j]); ((uint2*)dstb)[lane + 64 * j] = make_uint2(pk2(v[u][j].x, v[u][j].y), pk2(v[u][j].z, v[u][j].w)); }
            ss = wave_sum(ss); if (isx && lane == 0) ssq0[r] = ss; }
    }
}

__device__ __forceinline__ void ph_swin_copy(const Params& p, int blk0, int nblk) {
    if ((int)blockIdx.x < blk0 || (int)blockIdx.x >= blk0 + nblk) return;
    const int tid = ltid();
    {   const unsigned n4 = 128u * 511u * 64u, stride = nblk * NT_;
#define SW_SRC(i_) (((const float4*)(p.in[I_CWIN] + (size_t)((i_) / (511u * 64u)) * 512 * 256 + 256))[(i_) % (511u * 64u)])
#define SW_DST(i_) (((float4*)(p.out + O_SWIN + (size_t)((i_) / (511u * 64u)) * 512 * 256))[(i_) % (511u * 64u)])
        for (unsigned i0 = (blockIdx.x - blk0) * NT_ + tid; i0 < n4; i0 += 4 * stride) {
            const unsigned i1 = i0 + stride, i2 = i0 + 2 * stride, i3 = i0 + 3 * stride;
            const float4 v0 = SW_SRC(i0), v1 = SW_SRC(i1 < n4 ? i1 : i0), v2 = SW_SRC(i2 < n4 ? i2 : i0), v3 = SW_SRC(i3 < n4 ? i3 : i0);
            SW_DST(i0) = v0; if (i1 < n4) SW_DST(i1) = v1; if (i2 < n4) SW_DST(i2) = v2; if (i3 < n4) SW_DST(i3) = v3; }
#undef SW_SRC
#undef SW_DST
    }
}

__device__ __forceinline__ void ph_memk_norm(const Params& p) {
    const int tid_ = ltid(); const int lane = tid_ & 63, wid = tid_ >> 6;
    const float* raw = (const float*)(p.ws + B_MEMR);
    for (int it = blockIdx.x * NW_ + wid; it < 4 * 8 * 256; it += gridDim.x * NW_) {
        const int l = it / 2048;
        const float4* rr = (const float4*)(raw + (size_t)it * 512); float4* orow = (float4*)(p.out + O_PMEM + (size_t)it * 512);
        float4 v = rr[lane]; const float4 vv = rr[64 + lane]; float ss = dot4(v, v);
        ss += __shfl_xor(ss, 1); ss += __shfl_xor(ss, 2); ss += __shfl_xor(ss, 4); ss += __shfl_xor(ss, 8);
        const float rs = rsqrtf(ss * (1.0f / 64) + EPS);
        const float4 g = ((const float4*)(p.in[I_GMEMK] + l * 64))[lane & 15];
        v.x *= rs * g.x; v.y *= rs * g.y; v.z *= rs * g.z; v.w *= rs * g.w; orow[lane] = v; orow[64 + lane] = vv;
    }
}

__device__ __forceinline__ void ph_mlstm_prompt(const Params& p, int l, float* lds) {
    const bf16_t* P = (const bf16_t*)(p.ws + B_P16); const float* GT = (const float*)(p.ws + B_GT); const float* bif = p.in[I_BIF] + l * 8; float* HR = (float*)(p.ws + B_HRAW);
    const int tid = ltid(), lane = tid & 63, wid = tid >> 6;
    float* red = lds;
    for (int item = blockIdx.x; item < 256; item += gridDim.x) {
        const int es = item & 7, h = (item >> 3) & 3, b = item >> 5;
        const bool act = tid < 384; const int grp = tid >= 192 ? 1 : 0; const int d = act ? tid - grp * 192 : 0;
        const int col0 = h * 192 + es * 24 + (act ? grp : 0) * 12;
        float C[12]; float n = 0.f, m = NEGM;
#pragma unroll
        for (int e = 0; e < 12; ++e) C[e] = 0.f;
        const bf16_t* pr = P + (size_t)(b * SP) * LDA_; const float* gr = GT + (size_t)(b * SP) * GTW;
        float qn = act ? bf2f(pr[h * 192 + d]) : 0.f, kn = act ? bf2f(pr[768 + h * 192 + d]) : 0.f; uint2 vn[3];
#pragma unroll
        for (int e = 0; e < 3; ++e) vn[e] = *(const uint2*)(pr + 1536 + col0 + 4 * e);
        float in_ = gr[h] + bif[h], fn = gr[4 + h] + bif[4 + h];
        for (int t = 0; t < SP; ++t) {
            const float q = qn, k = kn, ig = in_, fg = fn; float v[12];
#pragma unroll
            for (int e = 0; e < 3; ++e) { v[4 * e] = bflo(vn[e].x); v[4 * e + 1] = bfhi(vn[e].x); v[4 * e + 2] = bflo(vn[e].y); v[4 * e + 3] = bfhi(vn[e].y); }
            if (t + 1 < SP) {
                pr += LDA_; gr += GTW;
                qn = act ? bf2f(pr[h * 192 + d]) : 0.f; kn = act ? bf2f(pr[768 + h * 192 + d]) : 0.f;
#pragma unroll
                for (int e = 0; e < 3; ++e) vn[e] = *(const uint2*)(pr + 1536 + col0 + 4 * e);
                in_ = gr[h] + bif[h]; fn = gr[4 + h] + bif[4 + h];
            }
            const float logf = logsigmoidf_(fg);
            const float m_new = fmaxf(logf + m, ig);
            const float a = expf(logf + m - m_new), bb = expf(ig - m_new);
            const float kb = bb * k;
            float part[13];
#pragma unroll
            for (int e = 0; e < 12; ++e) { C[e] = a * C[e] + kb * v[e]; part[e] = q * C[e]; }
            n = a * n + kb; part[12] = q * n;
#pragma unroll
            for (int e = 0; e < 13; ++e) part[e] = wave_sum(part[e]);
            float* rb = red + (t & 1) * 104;
            if (lane == 0) {
#pragma unroll
                for (int e = 0; e < 13; ++e) rb[wid * 13 + e] = part[e];
            }
            __syncthreads();
            if (tid < 24) {
                const int g2 = tid / 12, e = tid % 12;
                const float num = rb[(g2 * 3) * 13 + e] + rb[(g2 * 3 + 1) * 13 + e] + rb[(g2 * 3 + 2) * 13 + e];
                const float den = rb[12] + rb[13 + 12] + rb[26 + 12];
                HR[(size_t)(b * SP + t) * 768 + h * 192 + es * 24 + tid] = num / fmaxf(fabsf(den), expf(-m_new));
            }
            m = m_new;
        }
        if (act) {
            float* co = p.out + O_PC + ((size_t)((l * 8 + b) * 4 + h) * 192 + d) * 192 + es * 24 + grp * 12;
#pragma unroll
            for (int e = 0; e < 12; ++e) co[e] = C[e];
            if (es == 0 && grp == 0) p.out[O_PN + (size_t)((l * 8 + b) * 4 + h) * 192 + d] = n;
        }
        if (es == 0 && tid == 0) p.out[O_PM + (l * 8 + b) * 4 + h] = m;
        __syncthreads();
    }
}
__device__ __forceinline__ void ph_mlstm_sample(const Params& p, int l, float* lds) {
    const bf16_t* P = (const bf16_t*)(p.ws + B_P16); const float* GT = (const float*)(p.ws + B_GT); const float* bif = p.in[I_BIF] + l * 8; float* HR = (float*)(p.ws + B_HRAW);
    const int tid = ltid();
    float* qs = lds + 512; float* ks = lds + 512 + 192; float* n0s = lds + 512 + 384;
    for (int item = blockIdx.x; item < 128 * 4; item += gridDim.x) {
        const int h = item & 3, b = item >> 2; const int row = MP + b;
        const bf16_t* pr = P + (size_t)row * LDA_; const float* gr = GT + (size_t)row * GTW;
        const size_t sidx = (size_t)(l * 128 + b) * 4 + h;
        __syncthreads();
        if (tid < 192) { qs[tid] = bf2f(pr[h * 192 + tid]); ks[tid] = bf2f(pr[768 + h * 192 + tid]); n0s[tid] = p.in[I_SN][sidx * 192 + tid]; }
        __syncthreads();
        const float ig = gr[h] + bif[h], fg = gr[4 + h] + bif[4 + h];
        const float m0 = p.in[I_SM][sidx];
        const float logf = logsigmoidf_(fg);
        const float m_new = fmaxf(logf + m0, ig);
        const float a = expf(logf + m0 - m_new), bb = expf(ig - m_new);
        if (tid < 192) {
            const int e = tid; const float ve = bf2f(pr[1536 + h * 192 + e]);
            const float* C0 = p.in[I_SC] + sidx * 192 * 192; float* C1 = p.out + O_SC + sidx * 192 * 192;
            float num = 0.f, den = 0.f;
            for (int d = 0; d < 192; ++d) {
                const float c = a * C0[d * 192 + e] + bb * ks[d] * ve; C1[d * 192 + e] = c; num += qs[d] * c;
                const float nd = a * n0s[d] + bb * ks[d]; den += qs[d] * nd;
            }
            HR[(size_t)row * 768 + h * 192 + e] = num / fmaxf(fabsf(den), expf(-m_new));
            p.out[O_SN + sidx * 192 + e] = a * n0s[e] + bb * ks[e];
        }
        if (tid == 0) p.out[O_SM + sidx] = m_new;
    }
}
__device__ __forceinline__ void ph_mlstm_fin(const Params& p, int l) {
    const bf16_t* P = (const bf16_t*)(p.ws + B_P16); const float* HR = (const float*)(p.ws + B_HRAW); bf16_t* CATB = (bf16_t*)(p.ws + B_CATB); const float* g = p.in[I_GHN] + l * 192;
    const int tid_ = ltid(); const int lane = tid_ & 63, wid = tid_ >> 6;
    for (int row = blockIdx.x * NW_ + wid; row < MA; row += gridDim.x * NW_) {
        float v[4][3]; bf16_t og[4][3];
#pragma unroll
        for (int h = 0; h < 4; ++h)
#pragma unroll
            for (int i = 0; i < 3; ++i) { v[h][i] = HR[(size_t)row * 768 + h * 192 + lane + 64 * i]; og[h][i] = P[(size_t)row * LDA_ + 2304 + h * 192 + lane + 64 * i]; }
#pragma unroll
        for (int h = 0; h < 4; ++h) { float ss = v[h][0] * v[h][0] + v[h][1] * v[h][1] + v[h][2] * v[h][2]; ss = wave_sum(ss); const float rs = rsqrtf(ss * (1.0f / 192) + EPS);
#pragma unroll
            for (int i = 0; i < 3; ++i) { const int d = lane + 64 * i; CATB[(size_t)row * DM + h * 192 + d] = (bf16_t)f2bf(sigmoidf_(bf2f(og[h][i])) * (v[h][i] * rs * g[d])); } }
    }
}
__device__ __forceinline__ void ph_mem_attn(const Params& p, int l) {
    const int ldp = l < 2 ? LDA_ : LDB_, qoff = l < 2 ? 3072 : 768;
    const bf16_t* P = (const bf16_t*)(p.ws + B_P16); bf16_t* CATB = (bf16_t*)(p.ws + B_CATB); const float* gq = p.in[I_GMEMQ] + l * 64;
    for (int idx4 = blockIdx.x * NT_ + ltid(); idx4 < 16 * MA; idx4 += gridDim.x * NT_) {
        const int part = idx4 & 3, idx = idx4 >> 2;
        const int hh = idx / MA, row = idx % MA;
        const float* kvb = row < MP ? p.out + O_PMEM + (size_t)(l * 8 + row / SP) * 256 * 512 : p.in[I_CMEM] + (size_t)(l * 128 + (row - MP)) * 256 * 512;
        float q[16]; float ss = 0.f;
        const uint4* qp = (const uint4*)(P + (size_t)row * ldp + qoff + hh * 64 + part * 16);
#pragma unroll
        for (int i = 0; i < 2; ++i) { const uint4 t = qp[i]; q[8 * i] = bflo(t.x); q[8 * i + 1] = bfhi(t.x); q[8 * i + 2] = bflo(t.y); q[8 * i + 3] = bfhi(t.y); q[8 * i + 4] = bflo(t.z); q[8 * i + 5] = bfhi(t.z); q[8 * i + 6] = bflo(t.w); q[8 * i + 7] = bfhi(t.w); }
#pragma unroll
        for (int i = 0; i < 16; ++i) ss += q[i] * q[i];
        ss += __shfl_xor(ss, 1); ss += __shfl_xor(ss, 2);
        const float rs = rsqrtf(ss * (1.0f / 64) + EPS) * 0.125f;
#pragma unroll
        for (int i = 0; i < 16; ++i) q[i] *= rs * gq[part * 16 + i];
        float mx = -3e38f, den = 0.f; float o[16];
#pragma unroll
        for (int i = 0; i < 16; ++i) o[i] = 0.f;
        for (int m = 0; m < 256; ++m) {
            const float4* kp = (const float4*)(kvb + (size_t)m * 512 + hh * 64 + part * 16); const float4* vp = (const float4*)(kvb + (size_t)m * 512 + 256 + hh * 64 + part * 16);
            float s = 0.f;
#pragma unroll
            for (int i = 0; i < 4; ++i) { const float4 t = kp[i]; s += q[4 * i] * t.x + q[4 * i + 1] * t.y + q[4 * i + 2] * t.z + q[4 * i + 3] * t.w; }
            s += __shfl_xor(s, 1); s += __shfl_xor(s, 2);
            const float mn = fmaxf(mx, s); const float sc = expf(mx - mn), e = expf(s - mn); mx = mn; den = den * sc + e;
#pragma unroll
            for (int i = 0; i < 4; ++i) { const float4 t = vp[i]; o[4 * i] = o[4 * i] * sc + e * t.x; o[4 * i + 1] = o[4 * i + 1] * sc + e * t.y; o[4 * i + 2] = o[4 * i + 2] * sc + e * t.z; o[4 * i + 3] = o[4 * i + 3] * sc + e * t.w; }
        }
        const float inv = 1.0f / den; uint4* op = (uint4*)(CATB + (size_t)row * DM + 768 + hh * 64 + part * 16);
#pragma unroll
        for (int i = 0; i < 2; ++i) op[i] = make_uint4(pk2(o[8 * i] * inv, o[8 * i + 1] * inv), pk2(o[8 * i + 2] * inv, o[8 * i + 3] * inv), pk2(o[8 * i + 4] * inv, o[8 * i + 5] * inv), pk2(o[8 * i + 6] * inv, o[8 * i + 7] * inv));
    }
}
__device__ __forceinline__ void rows_post_tile(const Params& p, int row0, int t) {
    float* KVR = (float*)(p.ws + B_KVR); const int tid_ = ltid(); const int lane = tid_ & 63, wid = tid_ >> 6;
    const int c2 = lane >> 5, gg = (lane >> 4) & 1, d = (lane & 15) * 4; bf16_t* KVB = (bf16_t*)(p.ws + B_KVB); const size_t KT = (size_t)BP * 2 * SP * 64;
#pragma unroll 1
    for (int rr0 = wid; rr0 < 256; rr0 += 4 * NW_) {
      float4 vv[4];
#pragma unroll
      for (int k = 0; k < 4; ++k) { const int rowk = row0 + rr0 + k * NW_; vv[k] = ((const float4*)(KVR + (size_t)(rowk < MA ? rowk : MA - 1) * 768 + t * 256))[lane]; }
#pragma unroll
      for (int k = 0; k < 4; ++k) {
        const int row = row0 + rr0 + k * NW_; if (row >= MA) continue;
        float* r = KVR + (size_t)row * 768 + t * 256;
        float4 v = vv[k];
        if (t >= 1) {
            float ss = dot4(v, v);
            ss += __shfl_xor(ss, 1); ss += __shfl_xor(ss, 2); ss += __shfl_xor(ss, 4); ss += __shfl_xor(ss, 8);
            if (lane < 32) { const float rs = rsqrtf(ss * (1.0f / 64) + EPS); const float4 gk = ((const float4*)(t == 1 ? p.in[I_GKSLC] : p.in[I_GKWIN]))[lane & 15];
                v.x *= rs * gk.x; v.y *= rs * gk.y; v.z *= rs * gk.z; v.w *= rs * gk.w;
                if (row >= MP) ((float4*)r)[lane] = v; }
        }
        if (row < MP) {
            const int b = row / SP, sp = row % SP; const size_t off = (((size_t)b * 2 + gg) * SP + sp) * 64 + d;
            if (t == 0) { ((float4*)(p.out + O_PCMP + (size_t)row * 256))[lane] = v; *(uint2*)(KVB + (0 + c2) * KT + off) = make_uint2(pk2(v.x, v.y), pk2(v.z, v.w)); }
            else if (t == 2) { if (sp >= SP - 512) ((float4*)(p.out + O_PWIN + (size_t)(b * 512 + sp - (SP - 512)) * 256))[lane] = v; *(uint2*)(KVB + (4 + c2) * KT + off) = make_uint2(pk2(v.x, v.y), pk2(v.z, v.w)); }
            else {
                ((float4*)(p.out + O_PSLC + (size_t)row * 256))[lane] = v;
                const size_t blkbase = (((size_t)b * 2 + gg) * 32 + (sp >> 6)) * 4096;
                if (c2 == 0) { const int nt = (sp >> 4) & 3, fr2 = sp & 15, ks = d >> 5, fg2 = (d >> 3) & 3, e = d & 7;
                    *(uint2*)((bf16_t*)(p.ws + B_SKF) + blkbase + (size_t)(((nt * 2 + ks) * 64 + fg2 * 16 + fr2) * 8 + e)) = make_uint2(pk2(v.x, v.y), pk2(v.z, v.w)); }
                else { const int cs = (sp >> 5) & 1, kk = sp & 31, fg2 = (kk & 15) >> 2, e = (kk & 3) + (kk >= 16 ? 4 : 0), dt = d >> 4, fr2 = d & 15;
                    bf16_t* vf = (bf16_t*)(p.ws + B_SVF) + blkbase + (size_t)(((dt * 2 + cs) * 64 + fg2 * 16 + fr2) * 8 + e);
                    vf[0] = (bf16_t)f2bf(v.x); vf[8] = (bf16_t)f2bf(v.y); vf[16] = (bf16_t)f2bf(v.z); vf[24] = (bf16_t)f2bf(v.w); } }
        } else {
            const int b = row - MP;
            if (t == 0) ((float4*)(p.out + O_SCMP + (size_t)b * 256))[lane] = v; else if (t == 1) ((float4*)(p.out + O_SSLC + (size_t)b * 256))[lane] = v;
            else ((float4*)(p.out + O_SWIN + (size_t)(b * 512 + 511) * 256))[lane] = v;
        }
      }
    }
}
__device__ __forceinline__ float gelu_tanh(float x) { return 0.5f * x * (1.0f + tanhf(0.7978845608028654f * (x + 0.044715f * x * x * x))); }
__device__ __forceinline__ void ph_compress(const Params& p, float* lds) {
    const float* KVR = (const float*)(p.ws + B_KVR); const int tid = ltid();
    float* xs = lds;
    float* hs = lds + 4096;
    const float* w1 = p.in[I_CW1]; const float* w2 = p.in[I_CW2]; const int* pt = (const int*)p.in[I_PT];
    for (int item = blockIdx.x; item < 136 * 127 * 2; item += gridDim.x) {
        const int c = item & 1, n = (item >> 1) % 127, bb = (item >> 1) / 127;
        __syncthreads();
        for (int i = tid; i < 4096; i += NT_) {
            const int g = i >> 11, pp = (i >> 6) & 31, d = i & 63; const int tok = 16 * n + pp; float x;
            if (bb < 8) x = KVR[(size_t)(bb * SP + tok) * 768 + c * 128 + g * 64 + d];
            else { const int b = bb - 8; const int phys = pt[b * 16 + (tok >> 7)]; x = p.in[I_CCMP][((size_t)phys * 128 + (tok & 127)) * 256 + c * 128 + g * 64 + d]; }
            xs[i] = x + p.in[I_CPOS][(pp * 2 + c) * 64 + d];
        }
        __syncthreads();
        if (tid < 256) { const int g = tid >> 7, h = tid & 127; float pre = p.in[I_CB1][c * 128 + h]; const float* wp = w1 + (size_t)c * 2048 * 128 + h; const float* xp = xs + g * 2048;
          for (int i = 0; i < 2048; ++i) pre = fmaf(xp[i], wp[(size_t)i * 128], pre);
          hs[g * 128 + h] = gelu_tanh(pre); }
        __syncthreads();
        if (tid < 128) {
            const int g = tid >> 6, d = tid & 63; float o = p.in[I_CB2][c * 64 + d];
            for (int h = 0; h < 128; ++h) o = fmaf(hs[g * 128 + h], w2[(size_t)(c * 128 + h) * 64 + d], o);
            if (c == 0) { const float ss = wave_sum(o * o); o = o * rsqrtf(ss * (1.0f / 64) + EPS) * p.in[I_GKCMP][d]; }
            ((float*)(p.ws + (c == 0 ? B_CK : B_CV)))[((size_t)bb * 127 + n) * 128 + g * 64 + d] = o;
            bf16_t* kc = (bf16_t*)(p.ws + B_KC16) + ((((size_t)bb * 2 + c) * 2 + g) * 128 + n) * 64 + d; kc[0] = (bf16_t)f2bf(o); if (n == 126) kc[64] = 0;
        }
    }
}
#ifndef NSA_NAIVE_ALL
#define NSA_NAIVE_ALL 0
#endif
__device__ __forceinline__ void row_softmax(float* r, int n, int lane) {
    float mx = NEGM;
    for (int i = lane; i < n; i += 64) mx = fmaxf(mx, r[i]);
    mx = wave_max(mx);
    if (mx <= 0.5f * NEGM) { for (int i = lane; i < n; i += 64) r[i] = 0.f; return; }
    float s = 0.f;
    for (int i = lane; i < n; i += 64) { const float e = r[i] <= 0.5f * NEGM ? 0.f : expf(r[i] - mx); r[i] = e; s += e; }
    s = wave_sum(s); const float inv = 1.0f / s;
    for (int i = lane; i < n; i += 64) r[i] *= inv;
}
__device__ __forceinline__ void ph_nsa(const Params& p, int j, float* lds) {
    const int tid = ltid(), lane = tid & 63, wid = tid >> 6;
    float* qs = lds;
    float* sc = lds + 384;
    float* imp = sc + 3072;
    int* sel = (int*)(imp + 40);
    float* gate = (float*)(sel + 8);
    float* oacc = gate + 24;
    const bf16_t* P = (const bf16_t*)(p.ws + B_P16); const float* GT = (const float*)(p.ws + B_GT); const float* KVR = (const float*)(p.ws + B_KVR); bf16_t* CATB = (bf16_t*)(p.ws + B_CATB);
    const float* table = p.in[I_REL]; const int* pt = (const int*)p.in[I_PT];
    for (int item = blockIdx.x; item < (NSA_NAIVE_ALL ? MA : BS) * 2; item += gridDim.x) {
        const int row = (NSA_NAIVE_ALL ? 0 : MP) + (item >> 1), g = item & 1; const bool smp = row >= MP;
        const int b = smp ? row - MP : row / SP, pos = smp ? PAST : row % SP;
        const bf16_t* pr = P + (size_t)row * LDB_;
        __syncthreads();
        if (wid < 6) { const int z = wid; const float v = bf2f(pr[(g * 6 + z) * 64 + lane]); const float ss = wave_sum(v * v); qs[z * 64 + lane] = v * rsqrtf(ss * (1.0f / 64) + EPS) * p.in[I_GQ][j * 64 + lane]; }
        if (tid >= 384 && tid < 384 + 18) { const int t2 = tid - 384; const int br = t2 / 6, z = t2 % 6; gate[t2] = sigmoidf_(GT[(size_t)row * GTW + br * 12 + g * 6 + z] + p.in[I_BGATE][j * 36 + br * 12 + g * 6 + z]); }
        if (tid < 384) oacc[tid] = 0.f;
        __syncthreads();
        const float* ck = (const float*)(p.ws + B_CK) + (size_t)(smp ? 8 + b : b) * 127 * 128; const float* cv = (const float*)(p.ws + B_CV) + (size_t)(smp ? 8 + b : b) * 127 * 128;
        for (int i = tid; i < 6 * 127; i += NT_) {
            const int z = i / 127, n = i % 127; const int dist = pos - (16 * n + 31); float s = NEGM;
            if (dist >= 0) { const float4* kp = (const float4*)(ck + n * 128 + g * 64); const float4* qp = (const float4*)(qs + z * 64); float a = 0.f;
#pragma unroll 4
                for (int d = 0; d < 16; ++d) a += dot4(kp[d], qp[d]);
                s = a * 0.125f + table[rel_bucket(dist) * 12 + g * 6 + z]; }
            sc[z * 128 + n] = s;
        }
        __syncthreads();
        if (wid < 6) row_softmax(sc + wid * 128, 127, lane);
        __syncthreads();
        const int nslc = smp ? 33 : 32, cur = pos >> 6;
        if (tid < nslc) { const int jb = tid; float s = 0.f;
            for (int z = 0; z < 6; ++z) for (int n = 0; n < 127; ++n) { const int lo = max(16 * n, 64 * jb), hi = min(16 * n + 32, 64 * jb + 64); if (hi > lo) s += sc[z * 128 + n] * (float)(hi - lo) * (1.0f / 16); }
            imp[jb] = s; }
        __syncthreads();
        if (tid == 0) {
            int cnt = 0;
            if (cur + 1 <= 8) { for (int jb = 0; jb <= cur; ++jb) sel[cnt++] = jb; }
            else {
                sel[0] = 0; sel[1] = cur; sel[2] = cur - 1; cnt = 3; unsigned long long taken = 0ull;
                for (int k = 0; k < 5; ++k) { int best = -1; float bv = -1.f;
                    for (int jb = 1; jb <= cur - 2; ++jb) if (!((taken >> jb) & 1ull) && imp[jb] > bv) { bv = imp[jb]; best = jb; }
                    if (best >= 0) { taken |= 1ull << best; sel[cnt++] = best; } }
            }
            for (; cnt < 8; ++cnt) sel[cnt] = -1;
        }
        if (tid < 384) { const int z = tid >> 6, d = tid & 63; float o = 0.f;
            for (int n = 0; n < 127; ++n) o = fmaf(sc[z * 128 + n], cv[n * 128 + g * 64 + d], o);
            oacc[tid] += gate[0 * 6 + z] * o; }
        __syncthreads();
        for (int br = 1; br <= 2; ++br) {
            { const int t = tid;
                const float* kp = nullptr; int dist = -1;
                if (br == 1) {
                    const int blk = sel[t >> 6];
                    if (blk >= 0) { const int tok = blk * 64 + (t & 63); dist = pos - tok;
                        if (dist >= 0) { if (!smp) kp = KVR + (size_t)(b * SP + tok) * 768 + 256 + g * 64;
                            else if (tok < PAST) kp = p.in[I_CSLC] + ((size_t)pt[b * 16 + (tok >> 7)] * 128 + (tok & 127)) * 256 + g * 64;
                            else kp = KVR + (size_t)row * 768 + 256 + g * 64; } }
                } else {
                    const int kpos = pos - 511 + t; dist = 511 - t;
                    if (!smp) { if (kpos >= 0) kp = KVR + (size_t)(b * SP + kpos) * 768 + 512 + g * 64; else dist = -1; }
                    else { if (kpos < PAST) kp = p.in[I_CWIN] + ((size_t)b * 512 + (kpos - (PAST - 512))) * 256 + g * 64; else kp = KVR + (size_t)row * 768 + 512 + g * 64; }
                }
                if (dist >= 0 && kp) {
                    float s[6] = {0.f, 0.f, 0.f, 0.f, 0.f, 0.f};
#pragma unroll 2
                    for (int d = 0; d < 16; ++d) { const float4 kk = ((const float4*)kp)[d];
#pragma unroll
                        for (int z = 0; z < 6; ++z) s[z] += dot4(kk, ((const float4*)(qs + z * 64))[d]); }
                    const int bk = rel_bucket(dist);
#pragma unroll
                    for (int z = 0; z < 6; ++z) sc[z * 512 + t] = s[z] * 0.125f + table[bk * 12 + g * 6 + z];
                } else {
#pragma unroll
                    for (int z = 0; z < 6; ++z) sc[z * 512 + t] = NEGM;
                }
            }
            __syncthreads();
            if (wid < 6) row_softmax(sc + wid * 512, 512, lane);
            __syncthreads();
            if (tid < 384) { const int z = tid >> 6, d = tid & 63; float o = 0.f;
                for (int t = 0; t < 512; ++t) { const float pw = sc[z * 512 + t]; if (pw != 0.f) { const float* vp;
                    if (br == 1) { const int tok = sel[t >> 6] * 64 + (t & 63);
                        if (!smp) vp = KVR + (size_t)(b * SP + tok) * 768 + 256 + 128 + g * 64;
                        else if (tok < PAST) vp = p.in[I_CSLC] + ((size_t)pt[b * 16 + (tok >> 7)] * 128 + (tok & 127)) * 256 + 128 + g * 64;
                        else vp = KVR + (size_t)row * 768 + 256 + 128 + g * 64;
                    } else { const int kpos = pos - 511 + t;
                        if (!smp) vp = KVR + (size_t)(b * SP + kpos) * 768 + 512 + 128 + g * 64;
                        else if (kpos < PAST) vp = p.in[I_CWIN] + ((size_t)b * 512 + (kpos - (PAST - 512))) * 256 + 128 + g * 64;
                        else vp = KVR + (size_t)row * 768 + 512 + 128 + g * 64; }
                    o = fmaf(pw, vp[d], o); } }
                oacc[tid] += gate[br * 6 + z] * o; }
            __syncthreads();
        }
        if (tid < 384) CATB[(size_t)row * DM + g * 384 + tid] = (bf16_t)f2bf(oacc[tid]);
    }
}
constexpr size_t KVB_T = (size_t)BP * 2 * SP * 64;
typedef short v4i16_t __attribute__((ext_vector_type(4)));
typedef short bf16x8_t __attribute__((ext_vector_type(8)));
typedef float f32x4_t __attribute__((ext_vector_type(4)));
typedef unsigned u32x4_t __attribute__((ext_vector_type(4)));
__device__ __forceinline__ bf16x8_t ldtr2(const LAS unsigned char* p0, const LAS unsigned char* p1) {
    const v4i16_t a = __builtin_amdgcn_ds_read_tr16_b64_v4i16((LAS v4i16_t*)p0), b = __builtin_amdgcn_ds_read_tr16_b64_v4i16((LAS v4i16_t*)p1);
    return __builtin_shufflevector(a, b, 0, 1, 2, 3, 4, 5, 6, 7);
}
__device__ __forceinline__ unsigned cvtpk(float lo, float hi) { unsigned r; asm volatile("v_cvt_pk_bf16_f32 %0, %1, %2" : "=v"(r) : "v"(lo), "v"(hi)); return r; }
__device__ __forceinline__ bf16x8_t pack8(f32x4_t a, f32x4_t b) { uint4 w; w.x = cvtpk(a[0], a[1]); w.y = cvtpk(a[2], a[3]); w.z = cvtpk(b[0], b[1]); w.w = cvtpk(b[2], b[3]); return __builtin_bit_cast(bf16x8_t, w); }
__device__ __forceinline__ f32x4_t mfma16(bf16x8_t a, bf16x8_t b, f32x4_t c) { return __builtin_amdgcn_mfma_f32_16x16x32_bf16(a, b, c, 0, 0, 0); }
__device__ __forceinline__ float ex2(float x) { return __builtin_amdgcn_exp2f(x); }
__device__ __forceinline__ float xmax4(float x) {
    auto s = __builtin_amdgcn_permlane16_swap(__float_as_uint(x), __float_as_uint(x), false, false);
    x = fmaxf(__uint_as_float(s[0]), __uint_as_float(s[1]));
    auto t = __builtin_amdgcn_permlane32_swap(__float_as_uint(x), __float_as_uint(x), false, false);
    return fmaxf(__uint_as_float(t[0]), __uint_as_float(t[1]));
}
__device__ __forceinline__ float xsum4(float x) {
    auto s = __builtin_amdgcn_permlane16_swap(__float_as_uint(x), __float_as_uint(x), false, false);
    x = __uint_as_float(s[0]) + __uint_as_float(s[1]);
    auto t = __builtin_amdgcn_permlane32_swap(__float_as_uint(x), __float_as_uint(x), false, false);
    return __uint_as_float(t[0]) + __uint_as_float(t[1]);
}
constexpr float LOG2E = 1.4426950408889634f, NINF = -__builtin_inff();
constexpr int KROW = 144;

__device__ __forceinline__ void ph_nsa_fast(const Params& p, int j, LAS unsigned char* lds) {
    const int tid = ltid(), lane0 = tid & 63, w = tid >> 6;
    unsigned char* ws = p.ws;
    const bf16_t* P16 = (const bf16_t*)(ws + B_P16); const float* GT = (const float*)(ws + B_GT); bf16_t* CATB = (bf16_t*)(ws + B_CATB);
    const bf16_t* KVB = (const bf16_t*)(ws + B_KVB); const bf16_t* KC16 = (const bf16_t*)(ws + B_KC16);
    LAS unsigned char* Kw = lds;
    LAS unsigned char* Vw = lds + 18432;
    LAS unsigned char* Kc = lds + 36864;
    LAS unsigned char* Vc = lds + 55296;
    LAS float* biasT = (LAS float*)(lds + 73728);
    LAS float* impL = (LAS float*)(lds + 73728 + 3072);
    LAS int* selL = (LAS int*)(lds + 73728 + 3072 + 16384);
    const float* table = p.in[I_REL]; const float* gq = p.in[I_GQ] + j * 64; const float* bgate = p.in[I_BGATE] + j * 36;
    for (int unit = blockIdx.x; unit < 256; unit += gridDim.x) {
        int lane_a = lane0; asm volatile("" : "+v"(lane_a)); const int lane = lane_a, fr = lane & 15, fg = lane >> 4;
        const int g = unit & 1, b = (unit >> 1) & 7, tile = unit >> 4, t0 = tile * 128, tw = t0 + 16 * w, trow = tw + fr;
        TSUB_BEGIN();
        __syncthreads();
        for (int i = tid; i < 2048; i += NT_) { const int tsel = i >> 10, r = (i >> 3) & 127, ch = i & 7;
            const u32x4_t v = *(const u32x4_t*)(KC16 + (((size_t)b * 2 + tsel) * 2 + g) * 128 * 64 + r * 64 + ch * 8);
            *(LAS u32x4_t*)((tsel ? Vc : Kc) + r * KROW + ch * 16) = v; }
        for (int i = tid; i < 768; i += NT_) { const int d = i / 6, z = i % 6; biasT[i] = table[rel_bucket_alu(d) * 12 + g * 6 + z] * LOG2E; }
        if (tid < 64) ((LAS float*)(lds + 73728 + 3072 + 16384 + 4096))[tid] = gq[tid] * (0.125f * LOG2E);
        __syncthreads();
        const bf16_t* qrow = P16 + (size_t)(b * SP + trow) * LDB_ + g * 384;
        LAS float* gqL = (LAS float*)(lds + 73728 + 3072 + 16384 + 4096);
#define FETCH_Q(z_, ra_, rb_) do { ra_ = *(const uint4*)(qrow + (z_) * 64 + fg * 8); rb_ = *(const uint4*)(qrow + (z_) * 64 + 32 + fg * 8); } while (0)
#define LOAD_Q(z_, q0_, q1_) do { uint4 r0, r1; FETCH_Q(z_, r0, r1); FINISH_Q(r0, r1, q0_, q1_); } while (0)
#define FINISH_Q(r0, r1, q0_, q1_) do { \
            float v[16] = {bflo(r0.x), bfhi(r0.x), bflo(r0.y), bfhi(r0.y), bflo(r0.z), bfhi(r0.z), bflo(r0.w), bfhi(r0.w), bflo(r1.x), bfhi(r1.x), bflo(r1.y), bfhi(r1.y), bflo(r1.z), bfhi(r1.z), bflo(r1.w), bfhi(r1.w)}; \
            float ss = 0.f; _Pragma("unroll") for (int i = 0; i < 16; ++i) ss += v[i] * v[i]; \
            ss = xsum4(ss); const float rs = rsqrtf(ss * (1.0f / 64) + EPS); { const f32x4_t g0 = *(const LAS f32x4_t*)(gqL + fg * 8), g1 = *(const LAS f32x4_t*)(gqL + fg * 8 + 4), g2 = *(const LAS f32x4_t*)(gqL + 32 + fg * 8), g3 = *(const LAS f32x4_t*)(gqL + 32 + fg * 8 + 4); \
              _Pragma("unroll") for (int i = 0; i < 4; ++i) { v[i] *= rs * g0[i]; v[4 + i] *= rs * g1[i]; v[8 + i] *= rs * g2[i]; v[12 + i] *= rs * g3[i]; } } \
            q0_ = pack8((f32x4_t){v[0], v[1], v[2], v[3]}, (f32x4_t){v[4], v[5], v[6], v[7]}); q1_ = pack8((f32x4_t){v[8], v[9], v[10], v[11]}, (f32x4_t){v[12], v[13], v[14], v[15]}); } while (0)
        const float* gtrow = GT + (size_t)(b * SP + trow) * GTW;
#pragma unroll 1
        for (int hp = 0; hp < 2; ++hp) {
        bf16x8_t qf[3][2];
#pragma unroll
        for (int z = 0; z < 3; ++z) LOAD_Q(hp * 3 + z, qf[z][0], qf[z][1]);
        f32x4_t O[3][4]; float mrun[3], lrun[3];
#pragma unroll
        for (int z = 0; z < 3; ++z) { mrun[z] = NINF; lrun[z] = 0.f;
#pragma unroll
            for (int dt = 0; dt < 4; ++dt) O[z][dt] = (f32x4_t){0.f, 0.f, 0.f, 0.f}; }
        const bf16_t* WK = KVB + 4 * KVB_T + ((size_t)b * 2 + g) * SP * 64; const bf16_t* WV = KVB + 5 * KVB_T + ((size_t)b * 2 + g) * SP * 64;
        u32x4_t rst[4];
#define WIN_LOAD(it_) do { const int k128_ = t0 - 512 + 128 * (it_); _Pragma("unroll") for (int q_ = 0; q_ < 4; ++q_) { const int i_ = tid + NT_ * q_, tsel_ = i_ >> 10, r_ = (i_ >> 3) & 127, ch_ = i_ & 7; const int tok_ = k128_ + r_; \
            rst[q_] = (u32x4_t){0u, 0u, 0u, 0u}; if (tok_ >= 0) rst[q_] = *(const u32x4_t*)((tsel_ ? WV : WK) + (size_t)tok_ * 64 + ch_ * 8); } } while (0)
#define WIN_STORE() do { _Pragma("unroll") for (int q_ = 0; q_ < 4; ++q_) { const int i_ = tid + NT_ * q_, tsel_ = i_ >> 10, r_ = (i_ >> 3) & 127, ch_ = i_ & 7; *(LAS u32x4_t*)((tsel_ ? Vw : Kw) + r_ * KROW + ch_ * 16) = rst[q_]; } } while (0)
        WIN_LOAD(0);
        __syncthreads();
        WIN_STORE();
#pragma unroll 1
        for (int it = 0; it < 5; ++it) {
            const int k128 = t0 - 512 + 128 * it;
            BAR_LDS();
            if (it + 1 < 5) WIN_LOAD(it + 1);
#pragma unroll 1
            for (int sc = 0; sc < 4; ++sc) {
                const int kb = k128 + 32 * sc;
                if (kb > tw + 15 || kb + 31 < tw - 511 || kb + 31 < 0) continue;
                const bool fast = (kb + 31 <= tw - 113) && (kb >= tw + 15 - 511) && kb >= 0;
                bf16x8_t kf[2][2], vf[4];
#pragma unroll
                for (int nt = 0; nt < 2; ++nt)
#pragma unroll
                    for (int ks = 0; ks < 2; ++ks) kf[nt][ks] = *(const LAS bf16x8_t*)(Kw + (32 * sc + 16 * nt + fr) * KROW + (ks * 32 + fg * 8) * 2);
#pragma unroll
                for (int dt = 0; dt < 4; ++dt) { const LAS unsigned char* vp = Vw + (32 * sc + 4 * fg + (fr >> 2)) * KROW + (16 * dt + 4 * (fr & 3)) * 2; vf[dt] = ldtr2(vp, vp + 16 * KROW); }
#pragma unroll
                for (int z = 0; z < 3; ++z) {
                    f32x4_t s0 = (f32x4_t){0.f, 0.f, 0.f, 0.f}, s1 = s0;
                    s0 = mfma16(kf[0][0], qf[z][0], s0); s0 = mfma16(kf[0][1], qf[z][1], s0);
                    s1 = mfma16(kf[1][0], qf[z][0], s1); s1 = mfma16(kf[1][1], qf[z][1], s1);
                    if (fast) { const float cb = biasT[127 * 6 + hp * 3 + z]; s0 = s0 + cb; s1 = s1 + cb; }
                    else {
#pragma unroll
                        for (int jj = 0; jj < 4; ++jj) { const int key0 = kb + 4 * fg + jj, d0 = trow - key0, d1 = d0 - 16;
                            s0[jj] = (d0 >= 0 && d0 < 512 && key0 >= 0) ? s0[jj] + biasT[min(d0, 127) * 6 + hp * 3 + z] : NINF;
                            s1[jj] = (d1 >= 0 && d1 < 512 && key0 + 16 >= 0) ? s1[jj] + biasT[min(d1, 127) * 6 + hp * 3 + z] : NINF; }
                    }
                    float mx = fmaxf(fmaxf(fmaxf(s0[0], s0[1]), fmaxf(s0[2], s0[3])), fmaxf(fmaxf(s1[0], s1[1]), fmaxf(s1[2], s1[3])));
                    mx = xmax4(mx);
                    float msafe;
                    if (__any(mx > mrun[z] + 8.f)) {
                        const float mnew = fmaxf(mrun[z], mx); msafe = mnew == NINF ? 0.f : mnew;
                        const float alpha = ex2(mrun[z] - msafe);
                        mrun[z] = mnew; lrun[z] = lrun[z] * alpha;
#pragma unroll
                        for (int dt = 0; dt < 4; ++dt) O[z][dt] = O[z][dt] * alpha;
                    } else msafe = mrun[z] == NINF ? 0.f : mrun[z];
                    f32x4_t p0, p1;
#pragma unroll
                    for (int jj = 0; jj < 4; ++jj) { p0[jj] = ex2(s0[jj] - msafe); p1[jj] = ex2(s1[jj] - msafe); }
                    lrun[z] = lrun[z] + (((p0[0] + p0[1]) + (p0[2] + p0[3])) + ((p1[0] + p1[1]) + (p1[2] + p1[3])));
                    const bf16x8_t pf = pack8(p0, p1);
#pragma unroll
                    for (int dt = 0; dt < 4; ++dt) O[z][dt] = mfma16(vf[dt], pf, O[z][dt]);
                }
            }
            if (it + 1 < 5) { BAR_LDS(); WIN_STORE(); }
        }
#undef WIN_LOAD
#undef WIN_STORE
#pragma unroll
        for (int z = 0; z < 3; ++z) { const int hz2 = hp * 3 + z; const float lt = xsum4(lrun[z]); const float gw = sigmoidf_(gtrow[24 + g * 6 + hz2] + bgate[24 + g * 6 + hz2]); const float sc = gw / lt;
            bf16_t* orow = CATB + (size_t)(b * SP + trow) * DM + (g * 6 + hz2) * 64;
#pragma unroll
            for (int dt = 0; dt < 4; ++dt) { const f32x4_t v = O[z][dt] * sc; *(uint2*)(orow + 16 * dt + 4 * fg) = make_uint2(cvtpk(v[0], v[1]), cvtpk(v[2], v[3])); } }
        }
        asm volatile("s_waitcnt vmcnt(0)" ::: "memory");
        TSUB_END(0);
        float impacc[8];
#pragma unroll
        for (int nt = 0; nt < 8; ++nt) impacc[nt] = 0.f;
        const int nmax = trow >= 31 ? (trow - 31) >> 4 : -1;
        uint4 rqa_c, rqb_c; FETCH_Q(0, rqa_c, rqb_c);
#pragma unroll 1
        for (int z = 0; z < 6; ++z) {
            bf16_t* orow = CATB + (size_t)(b * SP + trow) * DM + (g * 6 + z) * 64; unsigned long long oldc[4];
#pragma unroll
            for (int dt = 0; dt < 4; ++dt) oldc[dt] = __hip_atomic_load((unsigned long long*)(orow + 16 * dt + 4 * fg), __ATOMIC_RELAXED, __HIP_MEMORY_SCOPE_AGENT);
            const float gcraw = gtrow[g * 6 + z];
            f32x4_t s[8]; bf16x8_t qz[2]; { const uint4 ra = rqa_c, rb = rqb_c; if (z + 1 < 6) FETCH_Q(z + 1, rqa_c, rqb_c); FINISH_Q(ra, rb, qz[0], qz[1]); }
#pragma unroll
            for (int nt = 0; nt < 8; ++nt) { s[nt] = (f32x4_t){0.f, 0.f, 0.f, 0.f};
#pragma unroll
                for (int ks = 0; ks < 2; ++ks) { const bf16x8_t kf = *(const LAS bf16x8_t*)(Kc + (16 * nt + fr) * KROW + (ks * 32 + fg * 8) * 2); s[nt] = mfma16(kf, qz[ks], s[nt]); } }
            float mx = NINF;
#pragma unroll
            for (int nt = 0; nt < 8; ++nt)
#pragma unroll
                for (int jj = 0; jj < 4; ++jj) { const int n = 16 * nt + 4 * fg + jj; const int dist = trow - 16 * n - 31;
                    const float v = (n <= nmax && n <= 126) ? s[nt][jj] + biasT[min(dist, 127) * 6 + z] : NINF; s[nt][jj] = v; mx = fmaxf(mx, v); }
            asm volatile("" ::: "memory");
            mx = xmax4(mx); const float msafe = mx == NINF ? 0.f : mx; float sum = 0.f;
#pragma unroll
            for (int nt = 0; nt < 8; ++nt)
#pragma unroll
                for (int jj = 0; jj < 4; ++jj) { const float e = ex2(s[nt][jj] - msafe); s[nt][jj] = e; sum += e; }
            sum = xsum4(sum); const float inv = sum > 0.f ? 1.0f / sum : 0.f;
            float p3prev = 0.f;
#pragma unroll
            for (int nt = 0; nt < 8; ++nt) { s[nt] = s[nt] * inv;
                const float p3 = s[nt][3]; const float up = __shfl(p3, (lane + 48) & 63);
                const float prev_tile = __shfl(p3prev, (lane + 48) & 63);
                impacc[nt] += 2.0f * (s[nt][0] + s[nt][1] + s[nt][2]) + p3 + (fg == 0 ? prev_tile : up);
                p3prev = p3; }
            f32x4_t oc[4];
#pragma unroll
            for (int dt = 0; dt < 4; ++dt) oc[dt] = (f32x4_t){0.f, 0.f, 0.f, 0.f};
#pragma unroll
            for (int c2 = 0; c2 < 4; ++c2) { const bf16x8_t pf = pack8(s[2 * c2], s[2 * c2 + 1]);
#pragma unroll
                for (int dt = 0; dt < 4; ++dt) { const LAS unsigned char* vp = Vc + (32 * c2 + 4 * fg + (fr >> 2)) * KROW + (16 * dt + 4 * (fr & 3)) * 2; oc[dt] = mfma16(ldtr2(vp, vp + 16 * KROW), pf, oc[dt]); }
                asm volatile("" ::: "memory"); }
            const float gc = sigmoidf_(gcraw + bgate[g * 6 + z]);
#pragma unroll
            for (int dt = 0; dt < 4; ++dt) { const unsigned long long o64 = oldc[dt];
                const f32x4_t v = oc[dt] * gc + (f32x4_t){bflo((unsigned)o64), bfhi((unsigned)o64), bflo((unsigned)(o64 >> 32)), bfhi((unsigned)(o64 >> 32))};
                *(uint2*)(orow + 16 * dt + 4 * fg) = make_uint2(cvtpk(v[0], v[1]), cvtpk(v[2], v[3])); }
        }
        TSUB_END(1);
#pragma unroll
        for (int nt = 0; nt < 8; ++nt) impL[(w * 16 + fr) * 32 + 4 * nt + fg] = impacc[nt];
        asm volatile("s_waitcnt lgkmcnt(0)" ::: "memory");
        if (lane < 16) {
            const int t = tw + lane, cur = t >> 6; LAS int* so = selL + (w * 16 + lane) * 8; const LAS float* im = impL + (w * 16 + lane) * 32;
            int cnt = 0;
            if (cur + 1 <= 8) { for (int jb = 0; jb <= cur; ++jb) so[cnt++] = jb; }
            else {
                so[1] = 0; so[3] = cur; so[5] = cur - 1; unsigned taken = 0u;
                for (int k = 0; k < 5; ++k) { int best = -1; float bv = -1.f;
                    for (int jb = 1; jb <= cur - 2; ++jb) { const float v = im[jb]; if (!((taken >> jb) & 1u) && v > bv) { bv = v; best = jb; } }
                    taken |= 1u << best; so[k < 3 ? 2 * k : 3 + k] = best; }
                cnt = 8; }
            for (; cnt < 8; ++cnt) so[cnt] = -1;
        }
        asm volatile("s_waitcnt vmcnt(0) lgkmcnt(0)" ::: "memory");
        const bf16_t* SKF = (const bf16_t*)(ws + B_SKF) + ((size_t)b * 2 + g) * 32 * 4096; const bf16_t* SVF = (const bf16_t*)(ws + B_SVF) + ((size_t)b * 2 + g) * 32 * 4096;
        const int c0 = 2 * tile;
        TSUB_END(2);
        __syncthreads();
        for (int i = tid; i < 4 * 1024; i += NT_) { const int slot = i >> 10, r = i & 1023; const int blk = slot == 0 ? 0 : c0 - 2 + slot;
            if (blk >= 0 && blk < 32) { const u32x4_t v = *(const u32x4_t*)((r < 512 ? SKF : SVF) + (size_t)blk * 4096 + (r & 511) * 8); *(LAS u32x4_t*)(lds + slot * 16384 + r * 16) = v; } }
        __syncthreads();
        { int lane_b = lane0; asm volatile("" : "+v"(lane_b)); const int lane = lane_b, fr = lane & 15, fg = lane >> 4;
        const int hz = fr < 6 ? fr : 5;
        uint4 rqa, rqb;
        { const bf16_t* qrow = P16 + ((size_t)b * SP + tw) * LDB_ + g * 384 + hz * 64; rqa = *(const uint4*)(qrow + fg * 8); rqb = *(const uint4*)(qrow + 32 + fg * 8); }
#pragma unroll 1
        for (int ti = 0; ti < 16; ++ti) {
            const int t = tw + ti; const size_t row = (size_t)b * SP + t;
            bf16x8_t qs[2];
            const uint4 r0 = rqa, r1 = rqb;
            if (ti + 1 < 16) { const bf16_t* qrow = P16 + (row + 1) * LDB_ + g * 384 + hz * 64; rqa = *(const uint4*)(qrow + fg * 8); rqb = *(const uint4*)(qrow + 32 + fg * 8); }
            bf16_t* orow = CATB + row * DM + (g * 6 + hz) * 64; unsigned long long oldv[4];
#pragma unroll
            for (int dt = 0; dt < 4; ++dt) oldv[dt] = __hip_atomic_load((unsigned long long*)(orow + 16 * dt + 4 * fg), __ATOMIC_RELAXED, __HIP_MEMORY_SCOPE_AGENT);
            const float graw = GT[row * GTW + 12 + g * 6 + hz];
            {
              float v[16] = {bflo(r0.x), bfhi(r0.x), bflo(r0.y), bfhi(r0.y), bflo(r0.z), bfhi(r0.z), bflo(r0.w), bfhi(r0.w), bflo(r1.x), bfhi(r1.x), bflo(r1.y), bfhi(r1.y), bflo(r1.z), bfhi(r1.z), bflo(r1.w), bfhi(r1.w)};
              float ss = 0.f;
#pragma unroll
              for (int i = 0; i < 16; ++i) ss += v[i] * v[i];
              ss = xsum4(ss); const float rs = rsqrtf(ss * (1.0f / 64) + EPS) * (0.125f * LOG2E);
#pragma unroll
              for (int i = 0; i < 8; ++i) { v[i] *= rs * gq[fg * 8 + i]; v[8 + i] *= rs * gq[32 + fg * 8 + i]; }
              qs[0] = pack8((f32x4_t){v[0], v[1], v[2], v[3]}, (f32x4_t){v[4], v[5], v[6], v[7]});
              qs[1] = pack8((f32x4_t){v[8], v[9], v[10], v[11]}, (f32x4_t){v[12], v[13], v[14], v[15]}); }
            f32x4_t os[4]; float ms = NINF, ls = 0.f;
#pragma unroll
            for (int dt = 0; dt < 4; ++dt) os[dt] = (f32x4_t){0.f, 0.f, 0.f, 0.f};
#define SLC_LOADK(KF, blk_) do { const int slot_ = (blk_) == 0 ? 0 : ((blk_) >= c0 - 1 ? (blk_) - c0 + 2 : -1); \
                if (slot_ >= 0) { const LAS unsigned char* fb_ = lds + slot_ * 16384 + lane * 16; \
                    _Pragma("unroll") for (int nt = 0; nt < 4; ++nt) _Pragma("unroll") for (int ks = 0; ks < 2; ++ks) KF[nt][ks] = *(const LAS bf16x8_t*)(fb_ + (nt * 2 + ks) * 1024); \
                } else { const bf16_t* kb_ = SKF + (size_t)(blk_) * 4096 + lane * 8; \
                    _Pragma("unroll") for (int nt = 0; nt < 4; ++nt) _Pragma("unroll") for (int ks = 0; ks < 2; ++ks) KF[nt][ks] = *(const bf16x8_t*)(kb_ + (nt * 2 + ks) * 512); } } while (0)
#define SLC_LOADV(VF, blk_) do { const int slot_ = (blk_) == 0 ? 0 : ((blk_) >= c0 - 1 ? (blk_) - c0 + 2 : -1); \
                if (slot_ >= 0) { const LAS unsigned char* fb_ = lds + slot_ * 16384 + lane * 16; \
                    _Pragma("unroll") for (int dt = 0; dt < 4; ++dt) _Pragma("unroll") for (int cs = 0; cs < 2; ++cs) VF[dt][cs] = *(const LAS bf16x8_t*)(fb_ + 8192 + (dt * 2 + cs) * 1024); \
                } else { const bf16_t* vb_ = SVF + (size_t)(blk_) * 4096 + lane * 8; \
                    _Pragma("unroll") for (int dt = 0; dt < 4; ++dt) _Pragma("unroll") for (int cs = 0; cs < 2; ++cs) VF[dt][cs] = *(const bf16x8_t*)(vb_ + (dt * 2 + cs) * 512); } } while (0)
#define SLC_COMPUTE(KF, VF, blk_, nblk_) do { const int tok0 = (blk_) * 64; f32x4_t s[4]; \
                _Pragma("unroll") for (int nt = 0; nt < 4; ++nt) { s[nt] = (f32x4_t){0.f, 0.f, 0.f, 0.f}; s[nt] = mfma16(KF[nt][0], qs[0], s[nt]); s[nt] = mfma16(KF[nt][1], qs[1], s[nt]); } \
                float mx = NINF; \
                if (tok0 + 63 <= t - 113) { const float cb = biasT[127 * 6 + hz]; \
                    _Pragma("unroll") for (int nt = 0; nt < 4; ++nt) { s[nt] = s[nt] + cb; mx = fmaxf(mx, fmaxf(fmaxf(s[nt][0], s[nt][1]), fmaxf(s[nt][2], s[nt][3]))); } } \
                else { _Pragma("unroll") for (int nt = 0; nt < 4; ++nt) _Pragma("unroll") for (int jj = 0; jj < 4; ++jj) { const int dist = t - (tok0 + 16 * nt + 4 * fg + jj); const float v = dist >= 0 ? s[nt][jj] + biasT[min(dist, 127) * 6 + hz] : NINF; s[nt][jj] = v; mx = fmaxf(mx, v); } } \
                mx = xmax4(mx); \
                float msafe; \
                if (__any(mx > ms + 8.f)) { const float mnew = fmaxf(ms, mx); msafe = mnew == NINF ? 0.f : mnew; const float alpha = ex2(ms - msafe); ms = mnew; ls = ls * alpha; \
                    _Pragma("unroll") for (int dt = 0; dt < 4; ++dt) os[dt] = os[dt] * alpha; } \
                else msafe = ms == NINF ? 0.f : ms; \
                float sum = 0.f; \
                _Pragma("unroll") for (int nt = 0; nt < 4; ++nt) _Pragma("unroll") for (int jj = 0; jj < 4; ++jj) { const float e = ex2(s[nt][jj] - msafe); s[nt][jj] = e; sum += e; } \
                ls = ls + sum; \
                _Pragma("unroll") for (int cs = 0; cs < 2; ++cs) { const bf16x8_t pf = pack8(s[2 * cs], s[2 * cs + 1]); \
                    _Pragma("unroll") for (int dt = 0; dt < 4; ++dt) os[dt] = mfma16(VF[dt][cs], pf, os[dt]); } \
                if ((nblk_) >= 0) SLC_LOADV(VF, nblk_); } while (0)
            const LAS int* sbl = selL + (w * 16 + ti) * 8; int nb = 0;
#pragma unroll
            for (int bi = 0; bi < 8; ++bi) nb += sbl[bi] >= 0 ? 1 : 0;
            bf16x8_t kfC[4][2], kfN[4][2], vfX[4][2];
            { const int b0 = sbl[0]; SLC_LOADK(kfN, b0); SLC_LOADV(vfX, b0); }
#pragma unroll 1
            for (int bi = 0; bi < nb; ++bi) {
                const int bA = sbl[bi], bB = bi + 1 < nb ? sbl[bi + 1] : -1;
#pragma unroll
                for (int nt = 0; nt < 4; ++nt) { kfC[nt][0] = kfN[nt][0]; kfC[nt][1] = kfN[nt][1]; }
                if (bB >= 0) SLC_LOADK(kfN, bB);
                SLC_COMPUTE(kfC, vfX, bA, bB);
            }
#undef SLC_LOADK
#undef SLC_LOADV
#undef SLC_COMPUTE
            const float lt = xsum4(ls);
            if (fr < 6) {
                const float gs = sigmoidf_(graw + bgate[12 + g * 6 + fr]); const float sc = lt > 0.f ? gs / lt : 0.f;
#pragma unroll
                for (int dt = 0; dt < 4; ++dt) { const unsigned long long o64 = oldv[dt]; const f32x4_t v = os[dt] * sc + (f32x4_t){bflo((unsigned)o64), bfhi((unsigned)o64), bflo((unsigned)(o64 >> 32)), bfhi((unsigned)(o64 >> 32))};
                    *(uint2*)(orow + 16 * dt + 4 * fg) = make_uint2(cvtpk(v[0], v[1]), cvtpk(v[2], v[3])); }
            }
        }
        }
        TSUB_END(3);
    }
}

constexpr int CW_P = 272, CW_BUF = 128 * CW_P;
template <bool SMP> __device__ __forceinline__ void compress_job(const Params& p, int bb, int c, int g, LAS unsigned char* lds) {
    const int tid = ltid(), lane = tid & 63, w = tid >> 6, fr = lane & 15, fg = lane >> 4, n = 16 * w + fr;
    unsigned char* ws = p.ws;
    const bf16_t* W1T = (const bf16_t*)(ws + B_W1T) + (size_t)c * 128 * 2048; const bf16_t* W2T = (const bf16_t*)(ws + B_W2T) + (size_t)c * 64 * 128;
    f32x4_t acc[8];
#pragma unroll
    for (int t = 0; t < 8; ++t) acc[t] = (f32x4_t){0.f, 0.f, 0.f, 0.f};
    const bf16_t* ap = (const bf16_t*)(ws + B_KVB) + (size_t)c * KVB_T + ((size_t)(SMP ? 0 : bb) * 2 + g) * SP * 64 + (size_t)n * 1024 + fg * 8;
    const float* pg0 = nullptr; const float* pg1 = nullptr; int tsplit = 0;
    if (SMP) { const int* pt = (const int*)p.in[I_PT] + (bb - 8) * 16; const int t0 = 16 * n > 2016 ? 2016 : 16 * n; const int pa = t0 >> 7, pb = (t0 + 31) >> 7;
        pg0 = p.in[I_CCMP] + (((size_t)pt[pa] * 128 + (t0 & 127)) * 4 + c * 2 + g) * 64 + fg * 8; tsplit = pb == pa ? 64 : 128 - (t0 & 127);
        pg1 = p.in[I_CCMP] + (((size_t)pt[pb] * 128) * 4 + c * 2 + g) * 64 + fg * 8 - (size_t)tsplit * 256; }
    u32x4_t rb[4]; bf16x8_t acur[4]; f32x4_t araw[SMP ? 8 : 1]; bf16x8_t anext[SMP ? 1 : 4];
#define CW_LOADB(st_) do { _Pragma("unroll") for (int i_ = 0; i_ < 4; ++i_) { const int ch_ = tid + NT_ * i_, r_ = ch_ >> 4, cc_ = ch_ & 15; rb[i_] = *(const u32x4_t*)(W1T + (size_t)r_ * 2048 + (st_) * 128 + cc_ * 8); } } while (0)
#define CW_STOREB(buf_) do { _Pragma("unroll") for (int i_ = 0; i_ < 4; ++i_) { const int ch_ = tid + NT_ * i_, r_ = ch_ >> 4, cc_ = ch_ & 15; *(LAS u32x4_t*)(lds + (buf_) * CW_BUF + r_ * CW_P + cc_ * 16) = rb[i_]; } } while (0)
#define CW_LOADA(st_) do { _Pragma("unroll") for (int u_ = 0; u_ < 4; ++u_) { const int s_ = (st_) * 4 + u_; \
        if (SMP) { const int tk_ = s_ >> 1; const float* src_ = (tk_ < tsplit ? pg0 : pg1) + (size_t)tk_ * 256 + (s_ & 1) * 32; araw[2 * u_] = *(const f32x4_t*)src_; araw[2 * u_ + 1] = *(const f32x4_t*)(src_ + 4); } \
        else anext[u_] = *(const bf16x8_t*)(ap + s_ * 32); } } while (0)
#define CW_TAKEA() do { _Pragma("unroll") for (int u_ = 0; u_ < 4; ++u_) { if (SMP) acur[u_] = pack8(araw[2 * u_], araw[2 * u_ + 1]); else acur[u_] = anext[u_]; } } while (0)
    __syncthreads();
    CW_LOADB(0); CW_LOADA(0); CW_STOREB(0); CW_TAKEA();
    BAR_LDS();
#pragma unroll 1
    for (int st = 0; st < 16; ++st) {
        if (st + 1 < 16) { CW_LOADB(st + 1); CW_LOADA(st + 1); }
        const LAS unsigned char* bb_ = lds + (st & 1) * CW_BUF + fr * CW_P + fg * 16;
#pragma unroll
        for (int u = 0; u < 4; ++u)
#pragma unroll
            for (int t = 0; t < 8; ++t) acc[t] = mfma16(*(const LAS bf16x8_t*)(bb_ + t * 16 * CW_P + u * 64), acur[u], acc[t]);
        if (st + 1 < 16) { CW_STOREB((st + 1) & 1); CW_TAKEA(); }
        BAR_LDS();
    }
#undef CW_LOADB
#undef CW_STOREB
#undef CW_LOADA
#undef CW_TAKEA
    const float* peb = (const float*)(ws + B_PEB) + c * 128;
#pragma unroll
    for (int t = 0; t < 8; ++t) { const f32x4_t pb = *(const f32x4_t*)(peb + 16 * t + 4 * fg);
#pragma unroll
        for (int j = 0; j < 4; ++j) { const float x = acc[t][j] + pb[j]; const float u2 = 1.5957691216057308f * (x + 0.044715f * x * x * x);
            const float th = 1.0f - 2.0f * __builtin_amdgcn_rcpf(1.0f + ex2(u2 * LOG2E)); acc[t][j] = 0.5f * x * (1.0f + th); } }
    f32x4_t o[4];
#pragma unroll
    for (int dt = 0; dt < 4; ++dt) o[dt] = (f32x4_t){0.f, 0.f, 0.f, 0.f};
#pragma unroll
    for (int ks = 0; ks < 4; ++ks) { const bf16x8_t gf = pack8(acc[2 * ks], acc[2 * ks + 1]);
#pragma unroll
        for (int dt = 0; dt < 4; ++dt) { const bf16_t* wp = W2T + (size_t)(16 * dt + fr) * 128 + 32 * ks + 4 * fg; const uint2 x0 = *(const uint2*)wp, x1 = *(const uint2*)(wp + 16);
            o[dt] = mfma16(__builtin_bit_cast(bf16x8_t, make_uint4(x0.x, x0.y, x1.x, x1.y)), gf, o[dt]); } }
    float ss = 0.f;
#pragma unroll
    for (int dt = 0; dt < 4; ++dt) { const f32x4_t b2 = *(const f32x4_t*)(p.in[I_CB2] + c * 64 + 16 * dt + 4 * fg); o[dt] = o[dt] + b2; ss += (o[dt][0] * o[dt][0] + o[dt][1] * o[dt][1]) + (o[dt][2] * o[dt][2] + o[dt][3] * o[dt][3]); }
    if (c == 0) { ss = xsum4(ss); const float rs = rsqrtf(ss * (1.0f / 64) + EPS);
#pragma unroll
        for (int dt = 0; dt < 4; ++dt) { const f32x4_t gk = *(const f32x4_t*)(p.in[I_GKCMP] + 16 * dt + 4 * fg); o[dt] = o[dt] * rs * gk; } }
    bf16_t* kc = (bf16_t*)(ws + B_KC16) + ((((size_t)bb * 2 + c) * 2 + g) * 128 + n) * 64;
    float* cf = (float*)(ws + (c == 0 ? B_CK : B_CV)) + ((size_t)bb * 127 + n) * 128 + g * 64;
#pragma unroll
    for (int dt = 0; dt < 4; ++dt) {
        if (n < 127) { *(f32x4_t*)(cf + 16 * dt + 4 * fg) = o[dt]; *(uint2*)(kc + 16 * dt + 4 * fg) = make_uint2(cvtpk(o[dt][0], o[dt][1]), cvtpk(o[dt][2], o[dt][3])); }
        else { unsigned z = 0u; asm volatile("" : "+v"(z)); *(uint2*)(kc + 16 * dt + 4 * fg) = make_uint2(z, z); }
    }
}
__device__ __forceinline__ void ph_compress_fast(const Params& p, LAS unsigned char* lds) {
    for (int job = blockIdx.x; job < 544; job += gridDim.x) { const int jj = job < 512 ? job + 32 : job - 512; const int bb = jj >> 2, c = (jj >> 1) & 1, g = jj & 1;
        if (bb < 8) compress_job<false>(p, bb, c, g, lds); else compress_job<true>(p, bb, c, g, lds); }
}
constexpr int ML_QP = 416, ML_VP = 80, ML_WP = 112;
__device__ __forceinline__ void ph_mlstm_fast(const Params& p, int l, LAS unsigned char* lds) {
    const int tid = ltid(), lane = tid & 63, w = tid >> 6, fr = lane & 15, fg = lane >> 4;
    unsigned char* ws = p.ws;
    const bf16_t* P16 = (const bf16_t*)(ws + B_P16); const float* GT = (const float*)(ws + B_GT); const float* bif = p.in[I_BIF] + l * 8; float* HR = (float*)(ws + B_HRAW);
    LAS unsigned char* Ql = lds;
    LAS unsigned char* Kl = lds + 26624;
    LAS unsigned char* Vl = lds + 53248;
    LAS unsigned char* Wl = lds + 58368;
    LAS unsigned char* CT = lds + 65536;
    LAS float* INTER = (LAS float*)(lds + 85504);
    LAS float* QN = (LAS float*)(lds + 94720);
    LAS float* RTa = (LAS float*)(lds + 94976);
    LAS float* WSa = RTa + 2048;
    LAS float* EIa = RTa + 4096;
    LAS float* DEC = RTa + 6144;
    LAS float* Gk = DEC + 32; LAS float* Ak = DEC + 64; LAS float* MPk = DEC + 96;
    for (int unit = blockIdx.x; unit < 192; unit += gridDim.x) {
        const int xy_ = unit >> 3, bh_ = (unit & 7) + 8 * (xy_ / 6);
        const int es = xy_ % 6, h = bh_ & 3, b = bh_ >> 2;
        const size_t row0 = (size_t)b * SP;
        __syncthreads();
        for (int i = tid; i < 48 * (ML_QP / 4); i += NT_) ((LAS unsigned*)CT)[i] = 0u;
        for (int i = tid; i < 64 * 28; i += NT_) ((LAS unsigned*)Wl)[i] = 0u;
        float gia[4], gfa[4];
#pragma unroll
        for (int q = 0; q < 4; ++q) { const float* g_ = GT + (row0 + 64 * (w + 8 * q) + lane) * GTW; gia[q] = g_[h]; gfa[q] = g_[4 + h]; }
#pragma unroll
        for (int q = 0; q < 4; ++q) { const int k = w + 8 * q; const float gi = gia[q] + bif[h], gf = gfa[q] + bif[4 + h];
            float bc = logsigmoidf_(gf);
#pragma unroll
            for (int o = 1; o < 64; o <<= 1) { const float t = __shfl_up(bc, o); if (lane >= o) bc += t; }
            const float u = gi - bc; float pm = u;
#pragma unroll
            for (int o = 1; o < 64; o <<= 1) { const float t = __shfl_up(pm, o); if (lane >= o) pm = fmaxf(pm, t); }
            EIa[k * 64 + lane] = bc; RTa[k * 64 + lane] = pm; WSa[k * 64 + lane] = u;
            if (lane == 63) { Gk[k] = bc; Ak[k] = pm; } }
        __syncthreads();
        if (tid == 0) { float m = NEGM; for (int k = 0; k < 32; ++k) { MPk[k] = m; m = Gk[k] + fmaxf(Ak[k], m); } MPk[32] = m; }
        __syncthreads();
#pragma unroll 1
        for (int k = w; k < 32; k += 8) { const float mp = MPk[k], M63 = fmaxf(Ak[k], mp); const float bc = EIa[k * 64 + lane], pm = RTa[k * 64 + lane], u = WSa[k * 64 + lane]; const float M = fmaxf(pm, mp);
            RTa[k * 64 + lane] = expf(M63 - M); WSa[k * 64 + lane] = expf(u - M63); EIa[k * 64 + lane] = expf(-(bc + M)); if (lane == 0) DEC[k] = expf(mp - M63); }
        f32x4_t cacc[5];
#pragma unroll
        for (int i = 0; i < 5; ++i) cacc[i] = (f32x4_t){0.f, 0.f, 0.f, 0.f};
        u32x4_t rq[3], rk[3], rv;
#define ML_LOAD(c_) do { const size_t rb_ = row0 + 64 * (c_); \
            _Pragma("unroll") for (int i_ = 0; i_ < 3; ++i_) { const int ch_ = tid + NT_ * i_, r_ = ch_ / 24, cc_ = ch_ % 24; const bf16_t* src_ = P16 + (rb_ + r_) * LDA_ + h * 192 + cc_ * 8; rq[i_] = *(const u32x4_t*)src_; rk[i_] = *(const u32x4_t*)(src_ + 768); } \
            if (tid < 256) { const int r_ = tid >> 2, cc_ = tid & 3; rv = *(const u32x4_t*)(P16 + (rb_ + r_) * LDA_ + 1536 + h * 192 + es * 32 + cc_ * 8); } } while (0)
#define ML_STORE(c_) do { \
            _Pragma("unroll") for (int i_ = 0; i_ < 3; ++i_) { const int ch_ = tid + NT_ * i_, r_ = ch_ / 24, cc_ = ch_ % 24; *(LAS u32x4_t*)(Ql + r_ * ML_QP + cc_ * 16) = rq[i_]; *(LAS u32x4_t*)(Kl + r_ * ML_QP + cc_ * 16) = rk[i_]; } \
            if (tid < 256) { const int r_ = tid >> 2, cc_ = tid & 3; *(LAS u32x4_t*)(Vl + r_ * ML_VP + cc_ * 16) = rv; const float wv_ = WSa[(c_) * 64 + r_]; \
                u32x4_t y_; y_.x = cvtpk(bflo(rv.x) * wv_, bfhi(rv.x) * wv_); y_.y = cvtpk(bflo(rv.y) * wv_, bfhi(rv.y) * wv_); y_.z = cvtpk(bflo(rv.z) * wv_, bfhi(rv.z) * wv_); y_.w = cvtpk(bflo(rv.w) * wv_, bfhi(rv.w) * wv_); \
                *(LAS u32x4_t*)(Wl + r_ * ML_WP + cc_ * 16) = y_; if (cc_ == 0) *(LAS bf16_t*)(Wl + r_ * ML_WP + 64) = (bf16_t)f2bf(wv_); } } while (0)
        ML_LOAD(0);
        __syncthreads();
        ML_STORE(0);
#pragma unroll 1
        for (int c = 0; c < 32; ++c) {
            BAR_LDS();
            if (c + 1 < 32) ML_LOAD(c + 1);
            f32x4_t hin[2]; float rsum = 0.f;
            hin[0] = (f32x4_t){0.f, 0.f, 0.f, 0.f}; hin[1] = hin[0];
            if (w < 4) {
                const int tt = w;
                f32x4_t S[4];
#pragma unroll
                for (int st = 0; st < 4; ++st) { S[st] = (f32x4_t){0.f, 0.f, 0.f, 0.f};
                    if (st <= tt) {
#pragma unroll
                        for (int ks = 0; ks < 6; ++ks) { const bf16x8_t kf = *(const LAS bf16x8_t*)(Kl + (16 * st + fr) * ML_QP + (32 * ks + 8 * fg) * 2), qf = *(const LAS bf16x8_t*)(Ql + (16 * tt + fr) * ML_QP + (32 * ks + 8 * fg) * 2);
                            S[st] = mfma16(kf, qf, S[st]); }
                        const f32x4_t wv = *(const LAS f32x4_t*)(WSa + c * 64 + 16 * st + 4 * fg); S[st] = S[st] * wv;
                        if (st == tt) {
#pragma unroll
                            for (int jj = 0; jj < 4; ++jj) if (4 * fg + jj > fr) S[st][jj] = 0.f; }
                        rsum += (S[st][0] + S[st][1]) + (S[st][2] + S[st][3]);
                    } }
                rsum = xsum4(rsum);
#pragma unroll
                for (int kk = 0; kk < 2; ++kk) { if (2 * kk <= tt) { const bf16x8_t pf = pack8(S[2 * kk], S[2 * kk + 1]);
#pragma unroll
                    for (int et = 0; et < 2; ++et) { const LAS unsigned char* vp = Vl + (32 * kk + 4 * fg + (fr >> 2)) * ML_VP + (16 * et + 4 * (fr & 3)) * 2; hin[et] = mfma16(ldtr2(vp, vp + 16 * ML_VP), pf, hin[et]); } } }
            } else {
                const int tt = w - 4;
                f32x4_t I[3];
#pragma unroll
                for (int e3 = 0; e3 < 3; ++e3) { I[e3] = (f32x4_t){0.f, 0.f, 0.f, 0.f};
#pragma unroll
                    for (int ks = 0; ks < 6; ++ks) { const bf16x8_t cf = *(const LAS bf16x8_t*)(CT + (16 * e3 + fr) * ML_QP + (32 * ks + 8 * fg) * 2), qf = *(const LAS bf16x8_t*)(Ql + (16 * tt + fr) * ML_QP + (32 * ks + 8 * fg) * 2);
                        I[e3] = mfma16(cf, qf, I[e3]); } }
                *(LAS f32x4_t*)(INTER + (16 * tt + fr) * 36 + 4 * fg) = I[0]; *(LAS f32x4_t*)(INTER + (16 * tt + fr) * 36 + 16 + 4 * fg) = I[1];
                if (fg == 0) QN[16 * tt + fr] = I[2][0];
            }
            BAR_LDS();
            const float decay = DEC[c];
            if (w < 4) {
                const int t = 16 * w + fr; const float r = RTa[c * 64 + t], einv = EIa[c * 64 + t], qn = QN[t];
                const float den = r * (rsum + decay * qn); const float inv = 1.0f / fmaxf(fabsf(den), einv);
                float* hp = HR + (row0 + 64 * c + t) * 768 + h * 192 + es * 32;
#pragma unroll
                for (int et = 0; et < 2; ++et) { const f32x4_t in2 = *(const LAS f32x4_t*)(INTER + t * 36 + 16 * et + 4 * fg); const f32x4_t num = (hin[et] + in2 * decay) * r; *(f32x4_t*)(hp + 16 * et + 4 * fg) = num * inv; }
            }
#pragma unroll
            for (int i = 0; i < 5; ++i) { const int idx = w + 8 * i; if (idx < 36) { const int dtile = idx / 3, et = idx % 3; cacc[i] = cacc[i] * decay;
#pragma unroll
                for (int ks = 0; ks < 2; ++ks) { const LAS unsigned char* kp = Kl + (32 * ks + 8 * fg + (fr >> 2)) * ML_QP + (16 * dtile + 4 * (fr & 3)) * 2; const LAS unsigned char* vp = Wl + (32 * ks + 8 * fg + (fr >> 2)) * ML_WP + (16 * et + 4 * (fr & 3)) * 2;
                    cacc[i] = mfma16(ldtr2(kp, kp + 4 * ML_QP), ldtr2(vp, vp + 4 * ML_WP), cacc[i]); } } }
            BAR_LDS();
#pragma unroll
            for (int i = 0; i < 5; ++i) { const int idx = w + 8 * i; if (idx < 36) { const int dtile = idx / 3, et = idx % 3;
                typedef unsigned u32x2_t __attribute__((ext_vector_type(2))); u32x2_t wv; wv.x = cvtpk(cacc[i][0], cacc[i][1]); wv.y = cvtpk(cacc[i][2], cacc[i][3]);
                *(LAS u32x2_t*)(CT + (16 * et + fr) * ML_QP + (16 * dtile + 4 * fg) * 2) = wv; } }
            if (c + 1 < 32) ML_STORE(c + 1);
        }
#pragma unroll
        for (int i = 0; i < 5; ++i) { const int idx = w + 8 * i; if (idx < 36) { const int dtile = idx / 3, et = idx % 3;
            if (et < 2) { float* co = p.out + O_PC + ((size_t)((l * 8 + b) * 4 + h) * 192 + 16 * dtile + 4 * fg) * 192 + es * 32 + 16 * et + fr;
#pragma unroll
                for (int jj = 0; jj < 4; ++jj) co[(size_t)jj * 192] = cacc[i][jj]; }
            else if (es == 0 && fr == 0) { float* no = p.out + O_PN + (size_t)((l * 8 + b) * 4 + h) * 192 + 16 * dtile + 4 * fg;
#pragma unroll
                for (int jj = 0; jj < 4; ++jj) no[jj] = cacc[i][jj]; } } }
        if (es == 0 && tid == 0) p.out[O_PM + (l * 8 + b) * 4 + h] = MPk[32];
#undef ML_LOAD
#undef ML_STORE
    }
}
__device__ __forceinline__ void ph_mem_attn_fast(const Params& p, int l, LAS unsigned char* lds, int u0, int ucnt, int ustep) {
    const int tid = ltid(), lane0 = tid & 63, w = tid >> 6;
    const int ldp = l < 2 ? LDA_ : LDB_, qoff = l < 2 ? 3072 : 768;
    const bf16_t* P16 = (const bf16_t*)(p.ws + B_P16); bf16_t* CATB = (bf16_t*)(p.ws + B_CATB); const float* gq = p.in[I_GMEMQ] + l * 64;
    LAS unsigned char* Km = lds;
    LAS unsigned char* Vm = lds + 36864;
    const float* gmk = p.in[I_GMEMK] + l * 64;
    int staged = -1;
    for (int ui = 0; ui < ucnt; ++ui) { const int unit = u0 + ui * ustep; if (unit >= 256) break;
        int lane_a = lane0; asm volatile("" : "+v"(lane_a)); const int lane = lane_a, fr = lane & 15, fg = lane >> 4;
        const int oct = unit & 7, hh = (unit >> 3) & 3, b = unit >> 5;
        const float* kv = (const float*)(p.ws + B_MEMR) + (size_t)(l * 8 + b) * 256 * 512 + hh * 64;
        uint4 qc0, qc1, qn0, qn1;
        { const bf16_t* qrow = P16 + ((size_t)b * SP + oct * 256 + w * 16 + fr) * ldp + qoff + hh * 64;
          qc0 = *(const uint4*)(qrow + fg * 8); qc1 = *(const uint4*)(qrow + 32 + fg * 8); qn0 = *(const uint4*)(qrow + (size_t)128 * ldp + fg * 8); qn1 = *(const uint4*)(qrow + (size_t)128 * ldp + 32 + fg * 8); }
        if ((unit >> 3) != staged) { staged = unit >> 3;
        __syncthreads();
        {
            f32x4_t x[16];
#pragma unroll
            for (int k = 0; k < 16; ++k) { const int i = tid + NT_ * k, tsel = i >> 12, m = (i >> 4) & 255, ch = i & 15; x[k] = *(const f32x4_t*)(kv + (size_t)m * 512 + tsel * 256 + ch * 4); }
#pragma unroll
            for (int k = 0; k < 16; ++k) { const int i = tid + NT_ * k, tsel = i >> 12, m = (i >> 4) & 255, ch = i & 15;
                if (k < 8) { float ss = (x[k][0] * x[k][0] + x[k][1] * x[k][1]) + (x[k][2] * x[k][2] + x[k][3] * x[k][3]);
                    ss += __shfl_xor(ss, 1); ss += __shfl_xor(ss, 2); ss += __shfl_xor(ss, 4); ss += __shfl_xor(ss, 8);
                    const float rs = rsqrtf(ss * (1.0f / 64) + EPS); const f32x4_t gk = *(const f32x4_t*)(gmk + ch * 4); x[k] = x[k] * rs * gk; }
                typedef unsigned u32x2_t __attribute__((ext_vector_type(2))); u32x2_t y; y.x = cvtpk(x[k][0], x[k][1]); y.y = cvtpk(x[k][2], x[k][3]);
                *(LAS u32x2_t*)((tsel ? Vm : Km) + m * KROW + ch * 8) = y; }
        }
        __syncthreads(); }
#pragma unroll 1
        for (int ps = 0; ps < 2; ++ps) {
            const size_t row = (size_t)b * SP + oct * 256 + ps * 128 + w * 16 + fr;
            bf16x8_t qf[2];
            { const uint4 r0 = qc0, r1 = qc1; qc0 = qn0; qc1 = qn1;
              float v[16] = {bflo(r0.x), bfhi(r0.x), bflo(r0.y), bfhi(r0.y), bflo(r0.z), bfhi(r0.z), bflo(r0.w), bfhi(r0.w), bflo(r1.x), bfhi(r1.x), bflo(r1.y), bfhi(r1.y), bflo(r1.z), bfhi(r1.z), bflo(r1.w), bfhi(r1.w)};
              float ss = 0.f;
#pragma unroll
              for (int i = 0; i < 16; ++i) ss += v[i] * v[i];
              ss = xsum4(ss); const float rs = rsqrtf(ss * (1.0f / 64) + EPS) * (0.125f * LOG2E);
#pragma unroll
              for (int i = 0; i < 8; ++i) { v[i] *= rs * gq[fg * 8 + i]; v[8 + i] *= rs * gq[32 + fg * 8 + i]; }
              qf[0] = pack8((f32x4_t){v[0], v[1], v[2], v[3]}, (f32x4_t){v[4], v[5], v[6], v[7]});
              qf[1] = pack8((f32x4_t){v[8], v[9], v[10], v[11]}, (f32x4_t){v[12], v[13], v[14], v[15]}); }
            f32x4_t S[16]; float mx = NINF;
#pragma unroll
            for (int nt = 0; nt < 16; ++nt) { S[nt] = (f32x4_t){0.f, 0.f, 0.f, 0.f};
#pragma unroll
                for (int ks = 0; ks < 2; ++ks) { const bf16x8_t kf = *(const LAS bf16x8_t*)(Km + (16 * nt + fr) * KROW + (32 * ks + 8 * fg) * 2); S[nt] = mfma16(kf, qf[ks], S[nt]); }
                mx = fmaxf(mx, fmaxf(fmaxf(S[nt][0], S[nt][1]), fmaxf(S[nt][2], S[nt][3]))); }
            mx = xmax4(mx); float sum = 0.f;
#pragma unroll
            for (int nt = 0; nt < 16; ++nt)
#pragma unroll
                for (int jj = 0; jj < 4; ++jj) { const float e = ex2(S[nt][jj] - mx); S[nt][jj] = e; sum += e; }
            sum = xsum4(sum); const float inv = 1.0f / sum;
            f32x4_t o[4];
#pragma unroll
            for (int dt = 0; dt < 4; ++dt) o[dt] = (f32x4_t){0.f, 0.f, 0.f, 0.f};
#pragma unroll
            for (int c2 = 0; c2 < 8; ++c2) { const bf16x8_t pf = pack8(S[2 * c2], S[2 * c2 + 1]);
#pragma unroll
                for (int dt = 0; dt < 4; ++dt) { const LAS unsigned char* vp = Vm + (32 * c2 + 4 * fg + (fr >> 2)) * KROW + (16 * dt + 4 * (fr & 3)) * 2; o[dt] = mfma16(ldtr2(vp, vp + 16 * KROW), pf, o[dt]); } }
            bf16_t* orow = CATB + row * DM + 768 + hh * 64;
#pragma unroll
            for (int dt = 0; dt < 4; ++dt) { const f32x4_t v = o[dt] * inv; *(uint2*)(orow + 16 * dt + 4 * fg) = make_uint2(cvtpk(v[0], v[1]), cvtpk(v[2], v[3])); }
        }
    }
}
__device__ __forceinline__ void ph_mem_attn_sample(const Params& p, int l, LAS unsigned char* lds, int j0, int jcnt, int jstep) {
    const int tid = ltid(), lane = tid & 63, w = tid >> 6;
    const int ldp = l < 2 ? LDA_ : LDB_, qoff = l < 2 ? 3072 : 768;
    const bf16_t* P16 = (const bf16_t*)(p.ws + B_P16); bf16_t* CATB = (bf16_t*)(p.ws + B_CATB); const float* gq = p.in[I_GMEMQ] + l * 64;
    LAS float* qs = (LAS float*)(lds + w * 2048);
    LAS float* ps = qs + 64;
    __syncthreads();
    for (int ji = 0; ji < jcnt; ++ji) { const int item = (j0 + ji * jstep) * NW_ + w; if (item >= BS * 4) break;
        const int hh = item & 3, b = item >> 2; const size_t row = (size_t)MP + b;
        const float* kv = p.in[I_CMEM] + (size_t)(l * 128 + b) * 256 * 512 + hh * 64;
        { const float v = bf2f(P16[row * ldp + qoff + hh * 64 + lane]); const float ss = wave_sum(v * v); qs[lane] = v * rsqrtf(ss * (1.0f / 64) + EPS) * gq[lane] * (0.125f * LOG2E); }
        asm volatile("s_waitcnt lgkmcnt(0)" ::: "memory");
        float sc[4] = {0.f, 0.f, 0.f, 0.f};
#pragma unroll 4
        for (int d4 = 0; d4 < 16; ++d4) { const f32x4_t q4 = *(const LAS f32x4_t*)(qs + 4 * d4);
#pragma unroll
            for (int k = 0; k < 4; ++k) { const f32x4_t k4 = *(const f32x4_t*)(kv + (size_t)(lane + 64 * k) * 512 + 4 * d4); sc[k] += (q4[0] * k4[0] + q4[1] * k4[1]) + (q4[2] * k4[2] + q4[3] * k4[3]); } }
        float mx = wave_max(fmaxf(fmaxf(sc[0], sc[1]), fmaxf(sc[2], sc[3]))); float sum = 0.f;
#pragma unroll
        for (int k = 0; k < 4; ++k) { sc[k] = ex2(sc[k] - mx); sum += sc[k]; ps[lane + 64 * k] = sc[k]; }
        sum = wave_sum(sum);
        asm volatile("s_waitcnt lgkmcnt(0)" ::: "memory");
        { const int kg = lane >> 4, c4 = lane & 15; f32x4_t o4 = (f32x4_t){0.f, 0.f, 0.f, 0.f};
#pragma unroll 1
          for (int m0 = 0; m0 < 64; m0 += 16) { f32x4_t v[16];
#pragma unroll
              for (int i = 0; i < 16; ++i) v[i] = *(const f32x4_t*)(kv + (size_t)(4 * (m0 + i) + kg) * 512 + 256 + 4 * c4);
#pragma unroll
              for (int i = 0; i < 16; ++i) o4 = o4 + v[i] * ps[4 * (m0 + i) + kg]; }
#pragma unroll
          for (int jx = 0; jx < 4; ++jx) o4[jx] = xsum4(o4[jx]);
          if (kg == 0) { const float inv = 1.0f / sum; *(uint2*)(CATB + row * DM + 768 + hh * 64 + 4 * c4) = make_uint2(cvtpk(o4[0] * inv, o4[1] * inv), cvtpk(o4[2] * inv, o4[3] * inv)); } }
        asm volatile("s_waitcnt lgkmcnt(0)" ::: "memory");
    }
}
__device__ __forceinline__ float row_sum16(float x) {
    x += __int_as_float(__builtin_amdgcn_update_dpp(0, __float_as_int(x), 0x128, 0xf, 0xf, false));
    x += __int_as_float(__builtin_amdgcn_update_dpp(0, __float_as_int(x), 0x124, 0xf, 0xf, false));
    x += __int_as_float(__builtin_amdgcn_update_dpp(0, __float_as_int(x), 0x122, 0xf, 0xf, false));
    x += __int_as_float(__builtin_amdgcn_update_dpp(0, __float_as_int(x), 0x121, 0xf, 0xf, false));
    return x;
}
#define SMP_SCORE(NI, STRIDE) do { const int kq_ = tid >> 4, c_ = tid & 15; f32x4_t q4_[6]; \
        _Pragma("unroll") for (int z = 0; z < 6; ++z) q4_[z] = *(const f32x4_t*)(qs + z * 64 + 4 * c_); \
        f32x4_t kk_[NI]; \
        _Pragma("unroll") for (int i = 0; i < NI; ++i) kk_[i] = *(const f32x4_t*)(kptr[kq_ + 32 * i] + 4 * c_); \
        _Pragma("unroll") for (int i = 0; i < NI; ++i) { const int key_ = kq_ + 32 * i; float sv_ = 0.f; \
            _Pragma("unroll") for (int z = 0; z < 6; ++z) { float a_ = (kk_[i][0] * q4_[z][0] + kk_[i][1] * q4_[z][1]) + (kk_[i][2] * q4_[z][2] + kk_[i][3] * q4_[z][3]); a_ = row_sum16(a_); sv_ = c_ == z ? a_ : sv_; } \
            const int dist_ = kdist[key_]; \
            if (c_ < 6) sc[c_ * (STRIDE) + key_] = dist_ >= 0 ? sv_ * 0.125f + tbl[rel_bucket_alu(dist_) * 6 + c_] : NEGM; } } while (0)
__device__ __forceinline__ void ph_nsa_sample(const Params& p, int j, LAS unsigned char* ldsb) {
    const int tid0 = ltid();
    float* lds = (float*)ldsb;
    float* qs = lds;
    float* sc = lds + 384;
    float* imp = sc + 3072;
    int* sel = (int*)(imp + 40);
    float* gate = (float*)(sel + 8);
    float* oacc = gate + 24;
    const float** kptr = (const float**)(oacc + 384);
    float* part = (float*)(kptr + 512);
    float* tbl = part + 32 * 384;
    int* pts = (int*)(tbl + 192);
    int* kdist = pts + 16;
    const bf16_t* P = (const bf16_t*)(p.ws + B_P16); const float* GT = (const float*)(p.ws + B_GT); const float* KVR = (const float*)(p.ws + B_KVR); bf16_t* CATB = (bf16_t*)(p.ws + B_CATB);
    const float* table = p.in[I_REL]; const int* pt = (const int*)p.in[I_PT];
    for (int item = blockIdx.x; item < BS * 2; item += gridDim.x) {
        int t_l = tid0; asm volatile("" : "+v"(t_l)); const int tid = t_l, lane = tid & 63, wid = tid >> 6;
        int pos_l = PAST; asm volatile("" : "+s"(pos_l)); const int pos = pos_l;
        const int b = item >> 1, g = item & 1, row = MP + b;
        const bf16_t* pr = P + (size_t)row * LDB_;
        __syncthreads();
        if (wid < 6) { const int z = wid; const float v = bf2f(pr[(g * 6 + z) * 64 + lane]); const float ss = wave_sum(v * v); qs[z * 64 + lane] = v * rsqrtf(ss * (1.0f / 64) + EPS) * p.in[I_GQ][j * 64 + lane]; }
        if (tid >= 384 && tid < 384 + 18) { const int t2 = tid - 384; const int br = t2 / 6, z = t2 % 6; gate[t2] = sigmoidf_(GT[(size_t)row * GTW + br * 12 + g * 6 + z] + p.in[I_BGATE][j * 36 + br * 12 + g * 6 + z]); }
        if (tid < 384) oacc[tid] = 0.f;
        if (tid >= 416 && tid < 432) pts[tid - 416] = pt[b * 16 + (tid - 416)];
        if (tid >= 192 && tid < 384) { const int i = tid - 192; tbl[i] = table[(i / 6) * 12 + g * 6 + (i % 6)]; }
        const float* ck = (const float*)(p.ws + B_CK) + (size_t)(8 + b) * 127 * 128; const float* cv = (const float*)(p.ws + B_CV) + (size_t)(8 + b) * 127 * 128;
        if (tid >= 256 && tid < 384) { const int n = tid - 256; kptr[n] = n < 127 ? ck + n * 128 + g * 64 : KVR; kdist[n] = n < 127 ? pos - (16 * n + 31) : -1; }
        __syncthreads();
        SMP_SCORE(4, 128);
        __syncthreads();
        if (wid < 6) row_softmax(sc + wid * 128, 127, lane);
        __syncthreads();
        const int cur = pos >> 6;
        if (tid < 33) { const int jb = tid; float s = 0.f;
            for (int z = 0; z < 6; ++z) { const float* pz = sc + z * 128;
                if (jb < 32) { s += 2.0f * (pz[4 * jb] + pz[4 * jb + 1] + pz[4 * jb + 2]); if (4 * jb + 3 < 127) s += pz[4 * jb + 3]; }
                if (jb >= 1 && jb < 32) s += pz[4 * jb - 1]; }
            imp[jb] = s; }
        __syncthreads();
        if (tid == 0) { sel[0] = 0; sel[1] = cur; sel[2] = cur - 1; }
        if (tid >= 1 && tid <= cur - 2) { const float mine = imp[tid]; int rank = 0;
            for (int j2 = 1; j2 <= cur - 2; ++j2) { const float o = imp[j2]; rank += (o > mine || (o == mine && j2 < tid)) ? 1 : 0; }
            if (rank < 5) sel[3 + rank] = tid; }
        { const int kg = tid >> 4, c4 = tid & 15; f32x4_t v[4]; f32x4_t acc[6];
#pragma unroll
          for (int i = 0; i < 4; ++i) { const int n = kg + 32 * i; v[i] = *(const f32x4_t*)(cv + (n < 127 ? n : 126) * 128 + g * 64 + 4 * c4); }
#pragma unroll
          for (int z = 0; z < 6; ++z) { acc[z] = (f32x4_t){0.f, 0.f, 0.f, 0.f};
#pragma unroll
              for (int i = 0; i < 4; ++i) { const int n = kg + 32 * i; if (n < 127) acc[z] = acc[z] + v[i] * sc[z * 128 + n]; } }
#pragma unroll
          for (int z = 0; z < 6; ++z) *(f32x4_t*)(part + kg * 384 + z * 64 + 4 * c4) = acc[z]; }
        __syncthreads();
        if (tid < 384) { float o = 0.f;
#pragma unroll 8
            for (int kg = 0; kg < 32; ++kg) o += part[kg * 384 + tid];
            oacc[tid] += gate[0 * 6 + (tid >> 6)] * o; }
        __syncthreads();
#pragma unroll 1
        for (int br = 1; br <= 2; ++br) {
            int t_b = tid0; asm volatile("" : "+v"(t_b)); const int tid = t_b, lane = tid & 63, wid = tid >> 6;
            { const int t = tid; const float* kp = nullptr; int dist = -1;
                if (br == 1) { const int blk = sel[t >> 6];
                    if (blk >= 0) { const int tok = blk * 64 + (t & 63); dist = pos - tok;
                        if (dist >= 0) kp = tok < PAST ? p.in[I_CSLC] + ((size_t)pts[tok >> 7] * 128 + (tok & 127)) * 256 + g * 64 : KVR + (size_t)row * 768 + 256 + g * 64; }
                } else { const int kpos = pos - 511 + t; dist = 511 - t;
                    kp = kpos < PAST ? p.in[I_CWIN] + ((size_t)b * 512 + (kpos - (PAST - 512))) * 256 + g * 64 : KVR + (size_t)row * 768 + 512 + g * 64; }
                const bool ok = dist >= 0 && kp; kptr[t] = ok ? kp : KVR; kdist[t] = ok ? dist : -1;
            }
            __syncthreads();
            SMP_SCORE(16, 512);
            __syncthreads();
            if (wid < 6) row_softmax(sc + wid * 512, 512, lane);
            __syncthreads();
            {
                const int kg = tid >> 4, c4 = tid & 15; f32x4_t acc[6];
#pragma unroll
                for (int z = 0; z < 6; ++z) acc[z] = (f32x4_t){0.f, 0.f, 0.f, 0.f};
                { f32x4_t v[16];
#pragma unroll
                    for (int i = 0; i < 16; ++i) v[i] = *(const f32x4_t*)(kptr[kg + 32 * i] + 128 + 4 * c4);
#pragma unroll
                    for (int i = 0; i < 16; ++i)
#pragma unroll
                        for (int z = 0; z < 6; ++z) acc[z] = acc[z] + v[i] * sc[z * 512 + kg + 32 * i]; }
#pragma unroll
                for (int z = 0; z < 6; ++z) *(f32x4_t*)(part + kg * 384 + z * 64 + 4 * c4) = acc[z];
            }
            __syncthreads();
            if (tid < 384) { float o = 0.f;
#pragma unroll 8
                for (int kg = 0; kg < 32; ++kg) o += part[kg * 384 + tid];
                oacc[tid] += gate[br * 6 + (tid >> 6)] * o; }
            __syncthreads();
        }
        if (tid < 384) CATB[(size_t)row * DM + g * 384 + tid] = (bf16_t)f2bf(oacc[tid]);
    }
}
__device__ __forceinline__ void ph_mlstm_sample_fast(const Params& p, int l, LAS unsigned char* ldsb) {
    const int tid = ltid(), lane = tid & 63, w = tid >> 6;
    float* lds = (float*)ldsb;
    float* qs = lds; float* ks = lds + 192; float* n1 = lds + 384; float* part = lds + 576;
    float* scal = part + 8 * 192;
    const bf16_t* P = (const bf16_t*)(p.ws + B_P16); const float* GT = (const float*)(p.ws + B_GT); const float* bif = p.in[I_BIF] + l * 8; float* HR = (float*)(p.ws + B_HRAW);
    for (int item = blockIdx.x; item < BS * 4; item += gridDim.x) {
        const int h = item & 3, b = item >> 2; const size_t row = (size_t)MP + b;
        const bf16_t* pr = P + row * LDA_; const float* gr = GT + row * GTW;
        const size_t sidx = (size_t)(l * 128 + b) * 4 + h;
        const float ig = gr[h] + bif[h], fg_ = gr[4 + h] + bif[4 + h];
        const float m0 = p.in[I_SM][sidx];
        const float logf = logsigmoidf_(fg_);
        const float m_new = fmaxf(logf + m0, ig);
        const float a = expf(logf + m0 - m_new), bb = expf(ig - m_new);
        __syncthreads();
        if (tid < 192) { const float q = bf2f(pr[h * 192 + tid]), k = bf2f(pr[768 + h * 192 + tid]); qs[tid] = q; ks[tid] = k;
            const float nn = a * p.in[I_SN][sidx * 192 + tid] + bb * k; n1[tid] = nn; p.out[O_SN + sidx * 192 + tid] = nn; }
        __syncthreads();
        if (w == 0) { float s = qs[lane] * n1[lane] + qs[lane + 64] * n1[lane + 64] + qs[lane + 128] * n1[lane + 128]; s = wave_sum(s); if (lane == 0) scal[0] = s; }
        const float* C0 = p.in[I_SC] + sidx * 192 * 192; float* C1 = p.out + O_SC + sidx * 192 * 192;
        float ve[3], num[3] = {0.f, 0.f, 0.f};
#pragma unroll
        for (int i = 0; i < 3; ++i) ve[i] = bf2f(pr[1536 + h * 192 + lane + 64 * i]) * bb;
#pragma unroll 1
        for (int d0 = 24 * w; d0 < 24 * w + 24; d0 += 12) {
            float c[12][3];
#pragma unroll
            for (int r = 0; r < 12; ++r)
#pragma unroll
                for (int i = 0; i < 3; ++i) c[r][i] = C0[(size_t)(d0 + r) * 192 + lane + 64 * i];
#pragma unroll
            for (int r = 0; r < 12; ++r) { const float kd = ks[d0 + r], qd = qs[d0 + r];
#pragma unroll
                for (int i = 0; i < 3; ++i) { const float cn = a * c[r][i] + kd * ve[i]; C1[(size_t)(d0 + r) * 192 + lane + 64 * i] = cn; num[i] = fmaf(qd, cn, num[i]); } }
        }
#pragma unroll
        for (int i = 0; i < 3; ++i) part[w * 192 + lane + 64 * i] = num[i];
        __syncthreads();
        if (tid < 192) { float s = 0.f;
#pragma unroll
            for (int ww = 0; ww < 8; ++ww) s += part[ww * 192 + tid];
            HR[row * 768 + h * 192 + tid] = s / fmaxf(fabsf(scal[0]), expf(-m_new)); }
        if (tid == 0) p.out[O_SM + sidx] = m_new;
    }
}
constexpr int RING_BYTES = 131072, MISC_OFF = RING_BYTES + 320, LDS_BYTES = 147456;
typedef float f32x4_ __attribute__((ext_vector_type(4)));

#define STRIP_JOBS(njobs) for (int job = (int)gridDim.x - 1 - (int)blockIdx.x; job < (njobs); job += (int)gridDim.x)
__device__ __forceinline__ void strips_inproj(const Params& p, int l, LAS unsigned char* lds) {
    unsigned char* ws = p.ws; const bf16_t* XB = (const bf16_t*)(ws + B_XB); bf16_t* P16 = (bf16_t*)(ws + B_P16); float* GT = (float*)(ws + B_GT);
    const float* ssq = (const float*)(ws + B_SSQ) + (size_t)(2 * l) * SSQS;
    const bool ka = l < 2; const int ldp = ka ? LDA_ : LDB_, nmain = ka ? 104 * 4 : 32 * 4;
    const bf16_t* Bt = ka ? (const bf16_t*)(ws + B_BTA) + (size_t)l * NBTA * DM : (const bf16_t*)(ws + B_BTB) + (size_t)(l - 2) * NBTB * DM;
    const int tid_ = ltid(); const int lane = tid_ & 63, wave = tid_ >> 6, fr = lane & 15, fq = lane >> 4;
    STRIP_JOBS(nmain + 516) {
        if (job < nmain) {
            const int st = job >> 2, r0 = MP + (job & 3) * 32;
            const int brow[2] = {st * 32, st * 32 + 16}; StripAcc<2> R; strip_gemm<2>(XB, DM, r0, Bt, brow, R, lds);
            if (wave < 2) { const int row = r0 + wave * 16 + fr; const float rs = rstd_of(ssq[row]);
#pragma unroll
                for (int t = 0; t < 2; ++t) { const f32x4_ v = R.a[t] * rs; *(uint2*)(P16 + (size_t)row * ldp + st * 32 + t * 16 + 4 * fq) = make_uint2(pk2(v[0], v[1]), pk2(v[2], v[3])); } }
        } else {
            const int r0 = (job - nmain) * 32, row = r0 + wave * 16 + fr;
            if (ka) { const int brow[1] = {3328}; StripAcc<1> R; strip_gemm<1>(XB, DM, r0, Bt, brow, R, lds); if (wave < 2) *(f32x4_*)(GT + (size_t)row * GTW + 4 * fq) = R.a[0] * rstd_of(ssq[row]); }
            else { const int brow[3] = {1024, 1040, 1056}; StripAcc<3> R; strip_gemm<3>(XB, DM, r0, Bt, brow, R, lds);
                if (wave < 2) { const float rs = rstd_of(ssq[row]);
#pragma unroll
                    for (int t = 0; t < 3; ++t) *(f32x4_*)(GT + (size_t)row * GTW + t * 16 + 4 * fq) = R.a[t] * rs; } }
        }
    }
}
__device__ __forceinline__ void strips_resid(const Params& p, const bf16_t* A, int K, const bf16_t* Bt, float* ssq, float* Y, LAS unsigned char* lds) {
    bf16_t* XB = (bf16_t*)(p.ws + B_XB);
    const int tid_ = ltid(); const int lane = tid_ & 63, wave = tid_ >> 6, fr = lane & 15, fq = lane >> 4;
    STRIP_JOBS(256) {
        const int st = job >> 2, r0 = MP + (job & 3) * 32;
        const int brow[1] = {st * 16}; StripAcc<1> R; strip_gemm<1>(A, K, r0, Bt, brow, R, lds);
        if (wave < 2) { const int row = r0 + wave * 16 + fr; bf16_t* bp = XB + (size_t)row * DM + st * 16 + 4 * fq; const uint2 o = *(const uint2*)bp;
            const f32x4_ x = (f32x4_){bflo(o.x), bfhi(o.x), bflo(o.y), bfhi(o.y)} + R.a[0];
            *(uint2*)bp = make_uint2(pk2(x[0], x[1]), pk2(x[2], x[3]));
            if (Y) *(f32x4_*)(Y + (size_t)row * DM + st * 16 + 4 * fq) = x;
            float ss = (x[0] * x[0] + x[1] * x[1]) + (x[2] * x[2] + x[3] * x[3]); ss += __shfl_xor(ss, 16); ss += __shfl_xor(ss, 32);
            if (fq == 0) (void)__hip_atomic_fetch_add(ssq + row, ss, __ATOMIC_RELAXED, __HIP_MEMORY_SCOPE_AGENT); }
    }
}
__device__ __forceinline__ void strips_gu(const Params& p, int l, LAS unsigned char* lds) {
    unsigned char* ws = p.ws; const bf16_t* XB = (const bf16_t*)(ws + B_XB); bf16_t* HID = (bf16_t*)(ws + B_HID);
    const float* ssq = (const float*)(ws + B_SSQ) + (size_t)(2 * l + 1) * SSQS; const bf16_t* Bt = (const bf16_t*)(ws + B_BTG) + (size_t)l * 2 * DFF * DM;
    const int tid_ = ltid(); const int lane = tid_ & 63, wave = tid_ >> 6, fr = lane & 15, fq = lane >> 4;
    STRIP_JOBS(176 * 4) {
        const int st = job >> 2, r0 = MP + (job & 3) * 32;
        const int brow[2] = {(st >> 3) * 256 + (st & 7) * 16, (st >> 3) * 256 + 128 + (st & 7) * 16}; StripAcc<2> R; strip_gemm<2>(XB, DM, r0, Bt, brow, R, lds);
        if (wave < 2) { const int row = r0 + wave * 16 + fr; const float rs = rstd_of(ssq[row]); float h[4];
#pragma unroll
            for (int j = 0; j < 4; ++j) { const float g = R.a[0][j] * rs, up = R.a[1][j] * rs; h[j] = g * pg8::fast_sigmoid(g) * up; }
            *(uint2*)(HID + (size_t)row * DFF + st * 16 + 4 * fq) = make_uint2(pk2(h[0], h[1]), pk2(h[2], h[3])); }
    }
}
__device__ __forceinline__ void strips_kv(const Params& p, LAS unsigned char* lds) {
    unsigned char* ws = p.ws; const bf16_t* XB = (const bf16_t*)(ws + B_XB); float* KVR = (float*)(ws + B_KVR);
    const float* ssq = (const float*)(ws + B_SSQ) + (size_t)4 * SSQS; const bf16_t* Bt = (const bf16_t*)(ws + B_BTK);
    const int tid_ = ltid(); const int lane = tid_ & 63, wave = tid_ >> 6, fr = lane & 15, fq = lane >> 4;
    STRIP_JOBS(48 * 4) {
        const int st = job >> 2, r0 = MP + (job & 3) * 32;
        const int brow[1] = {st * 16}; StripAcc<1> R; strip_gemm<1>(XB, DM, r0, Bt, brow, R, lds);
        if (wave < 2) { const int row = r0 + wave * 16 + fr; *(f32x4_*)(KVR + (size_t)row * 768 + st * 16 + 4 * fq) = R.a[0] * rstd_of(ssq[row]); }
    }
}

#ifndef COMPRESS_NAIVE
#define COMPRESS_NAIVE 0
#endif
#ifndef MLSTM_NAIVE
#define MLSTM_NAIVE 0
#endif
#ifndef MEMATT_NAIVE
#define MEMATT_NAIVE 0
#endif
#ifndef SAMPLE_ML_NAIVE
#define SAMPLE_ML_NAIVE 0
#endif
#ifndef SAMPLE_NSA_NAIVE
#define SAMPLE_NSA_NAIVE 0
#endif
#ifndef MK_MULTI
#define MK_MULTI 0
#endif
constexpr int PL = 9, NPH = 1 + 4 * PL;
__host__ __device__ constexpr bool phase_nonempty(int ph) {
    if (ph == 0) return true;
    const int l = (ph - 1) / PL, r = (ph - 1) % PL;
    if (r == 2) return l < 2;
    if (r == 7) return false;
    if (r >= 6) return l == 1;
    return true;
}
#ifndef TIME_MASK
#define TIME_MASK 0
#endif
__host__ __device__ constexpr int phase_group(int ph) { if (ph == 0) return 0; const int l = (ph - 1) / PL, r = (ph - 1) % PL; return r == 0 ? 1 : r == 1 ? (l < 2 ? 2 : 4) : r == 2 ? 3 : r == 3 ? 5 : r == 4 ? 6 : r == 5 ? 7 : r == 6 ? 8 : r == 7 ? 9 : 10; }
__global__ void __launch_bounds__(NT_, 2) fwd(Params p) {
    extern __shared__ __attribute__((aligned(16))) unsigned char lds_raw[];
    LAS unsigned char* lds = (LAS unsigned char*)lds_raw;
    float* ldsf = (float*)lds_raw;
    volatile LAS unsigned* MISC = (volatile LAS unsigned*)(lds + MISC_OFF);
    for (int u = threadIdx.x; u < (LDS_BYTES - RING_BYTES) / 4; u += NT_) ((LAS unsigned*)(lds + RING_BYTES))[u] = 0u;
    __syncthreads();
    unsigned char* ws = p.ws;
    XcdBarrier bar; bar.bar = (unsigned*)ws; bar.x = 0; bar.st = MISC + 8;
    const bool single = (p.ph_hi - p.ph_lo) > 1;
    if (single) bar = xcd_barrier_post((unsigned*)ws, MISC + 8);
    bf16_t* XB = (bf16_t*)(ws + B_XB); bf16_t* P16 = (bf16_t*)(ws + B_P16); bf16_t* CATB = (bf16_t*)(ws + B_CATB); bf16_t* HID = (bf16_t*)(ws + B_HID);
    float* SSQ = (float*)(ws + B_SSQ);
    const int G = gridDim.x, c = blockIdx.x;
    if (TIME_SUB && blockIdx.x == TSUB_BLK && threadIdx.x == 0) { for (int i = 0; i < 8; ++i) g_tsub[i] = 0ull; }
    int ph = 0; volatile LAS unsigned long long* TMR = (volatile LAS unsigned long long*)(lds + MISC_OFF + 64);
    if ((TIME_MASK || TIME_SUB) && blockIdx.x == 0 && threadIdx.x == 0) { TMR[0] = 0ull; TMR[1] = __builtin_amdgcn_s_memrealtime(); }
#define ON() (ph >= p.ph_lo && ph < p.ph_hi)
#define NEXT() do { const bool ne_ = phase_nonempty(ph); const int grp_ = phase_group(ph); ++ph; if (ne_ && ph > p.ph_lo && ph < p.ph_hi) xcd_barrier(bar); \
        if (TIME_MASK && blockIdx.x == 0 && threadIdx.x == 0) { const unsigned long long now_ = __builtin_amdgcn_s_memrealtime(); if ((TIME_MASK >> grp_) & 1) TMR[0] = TMR[0] + (now_ - TMR[1]); TMR[1] = now_; } } while (0)
#ifndef NO_PRO
    if (ON()) ph_prologue(p, lds);
#endif
    NEXT();
    for (int l = 0; l < 4; ++l) {
        if (ON()) {
            if (l == 0) { pg8::Gemm g{(const bf16_t*)(ws + B_MPB), (const bf16_t*)(ws + B_BTM), 2048, 2048, DM}; pg8::StaticOrder S; S.init(2048, 2048, G, c);
                pg8::EpiF32 E{(float*)(ws + B_MEMR), 512, nullptr, 512, (size_t)2048 * 512};
                pg8::gemm_phase<pg8::EpiF32, pg8::StaticOrder, true, true>(lds, g, S, E); }
            if (l < 2) { pg8::Gemm g{XB, (const bf16_t*)(ws + B_BTA) + (size_t)l * NBTA * DM, MAP, LDA_ + 256, DM}; pg8::StaticOrder S; S.init(MAP, LDA_ + 256, G, l == 0 ? (c + 192) % G : c);
                pg8::EpiBf16S E{P16, LDA_, SSQ + (size_t)(2 * l) * SSQS, 13, (float*)(ws + B_GT)};
                pg8::gemm_phase<pg8::EpiBf16S, pg8::StaticOrder, true, true>(lds, g, S, E); }
            else { pg8::Gemm g{XB, (const bf16_t*)(ws + B_BTB) + (size_t)(l - 2) * NBTB * DM, MP, LDB_, DM}; pg8::StaticOrder S; S.init(MP, LDB_, G, c);
                pg8::EpiBf16S E{P16, LDB_, SSQ + (size_t)(2 * l) * SSQS, -1, nullptr};
                pg8::gemm_phase<pg8::EpiBf16S, pg8::StaticOrder, true, true>(lds, g, S, E);
#ifndef NO_STRIPS
                strips_inproj(p, l, lds);
#endif
            }
        }
        NEXT();
#ifndef NO_NAIVE
        if (ON()) {
            if (l < 2) { TSUB_BEGIN(); if (MLSTM_NAIVE) ph_mlstm_prompt(p, l, ldsf); else ph_mlstm_fast(p, l, lds); TSUB_END(6); if (G == 256) { if (c >= 192) { ph_mem_attn_fast(p, l, lds, 4 * (c - 192), 4, 1); ph_mem_attn_sample(p, l, lds, c - 192, 1, 64); if (l == 1) ph_swin_copy(p, 192, 64); } TSUB_END(7); }
                else { ph_mem_attn_fast(p, l, lds, c, (256 - c + G - 1) / G, G); if (c < 64) ph_mem_attn_sample(p, l, lds, c, (64 - c + G - 1) / G, G); if (l == 1) ph_swin_copy(p, 0, G); }      if (SAMPLE_ML_NAIVE) ph_mlstm_sample(p, l, ldsf); else ph_mlstm_sample_fast(p, l, lds); }
            else { if (!NSA_NAIVE_ALL) ph_nsa_fast(p, l - 2, lds); { TSUB_BEGIN(); if (SAMPLE_NSA_NAIVE) ph_nsa(p, l - 2, ldsf); else ph_nsa_sample(p, l - 2, lds); TSUB_END(4); } TSUB_BEGIN(); if (MEMATT_NAIVE) ph_mem_attn(p, l); else if (G == 256) { if (c < 16) { ph_mem_attn_fast(p, l, lds, 8 * c, 8, 1); ph_mem_attn_sample(p, l, lds, 2 * c, 2, 1); } else if (c < 32) { ph_mem_attn_fast(p, l, lds, 128 + 5 * (c - 16), 5, 1); ph_mem_attn_sample(p, l, lds, 2 * c, 2, 1); } else if (c < 48) ph_mem_attn_fast(p, l, lds, 208 + 3 * (c - 32), 3, 1); }
                else { ph_mem_attn_fast(p, l, lds, c, (256 - c + G - 1) / G, G); if (c < 64) ph_mem_attn_sample(p, l, lds, c, (64 - c + G - 1) / G, G); } TSUB_END(5); }
        }
#endif
        NEXT();
#ifndef NO_NAIVE
        if (ON()) { if (l < 2) { ph_mlstm_fin(p, l); if (l == 0) ph_memk_norm(p); } }
#endif
        NEXT();
        if (ON()) {
            const bf16_t* Bt = (const bf16_t*)(ws + B_BTO) + (size_t)l * DM * DM; float* sq = SSQ + (size_t)(2 * l + 1) * SSQS;
            pg8::Gemm g{CATB, Bt, MP, DM, DM}; pg8::StaticOrder S; S.init(MP, DM, G, c); pg8::EpiResid E{nullptr, XB, sq};
            pg8::gemm_phase<pg8::EpiResid, pg8::StaticOrder, true, true>(lds, g, S, E);
#ifndef NO_STRIPS
            strips_resid(p, CATB, DM, Bt, sq, nullptr, lds);
#endif
        }
        NEXT();
        if (ON()) {
            pg8::Gemm g{XB, (const bf16_t*)(ws + B_BTG) + (size_t)l * 2 * DFF * DM, MAP, 2 * DFF, DM}; pg8::StaticOrder S; S.init(MAP, 2 * DFF, G, c); pg8::EpiSwiglu E{HID, SSQ + (size_t)(2 * l + 1) * SSQS};
            pg8::gemm_phase<pg8::EpiSwiglu, pg8::StaticOrder, true, true>(lds, g, S, E);
        }
        NEXT();
        if (ON()) {
            const bf16_t* Bt = (const bf16_t*)(ws + B_BTD) + (size_t)l * DM * DFF; float* sq = SSQ + (size_t)(2 * l + 2) * SSQS;
            pg8::Gemm g{HID, Bt, MP, DM, DFF}; pg8::StaticOrder S; S.init(MP, DM, G, c); float* Yo = l == 3 ? p.out : nullptr; pg8::EpiResid E{Yo, XB, sq};
            pg8::gemm_phase<pg8::EpiResid, pg8::StaticOrder, true, true>(lds, g, S, E);
#ifndef NO_STRIPS
            strips_resid(p, HID, DFF, Bt, sq, Yo, lds);
#endif
        }
        NEXT();
        if (ON()) { if (l == 1) {
            pg8::Gemm g{XB, (const bf16_t*)(ws + B_BTK), MAP, 768, DM}; pg8::StaticOrder S; S.init(MAP, 768, G, c); pg8::EpiF32 E{(float*)(ws + B_KVR), 768, SSQ + (size_t)4 * SSQS, 0, 0};
            pg8::gemm_phase<pg8::EpiF32, pg8::StaticOrder, true, true>(lds, g, S, E);
            asm volatile("s_waitcnt vmcnt(0)" ::: "memory"); __syncthreads();
            if (c < 195) {
                constexpr int nM = MAP / 256, nN = 3, nwg = nM * nN, q = nwg / 8, rr = nwg % 8; const int xcd = c % 8, off = c / 8;
                const int wgid = (xcd < rr ? xcd * (q + 1) : rr * (q + 1) + (xcd - rr) * q) + off; constexpr int nig = 8 * nN; const int gid = wgid / nig, fm = gid * 8, gsz = (nM - fm) < 8 ? (nM - fm) : 8;
                rows_post_tile(p, (fm + ((wgid % nig) % gsz)) * 256, (wgid % nig) / gsz); }
            } }
        NEXT();
        NEXT();
#ifndef NO_NAIVE
        if (ON()) { if (l == 1) { if (COMPRESS_NAIVE) ph_compress(p, ldsf); else ph_compress_fast(p, lds); } }
#endif
        NEXT();
    }
    if (TIME_MASK || TIME_SUB) { if (blockIdx.x == 0 && threadIdx.x == 0) { const unsigned long long t_acc = TIME_SUB ? __hip_atomic_load(&g_tsub[TIME_SUB > 0 ? TIME_SUB - 1 : 0], __ATOMIC_RELAXED, __HIP_MEMORY_SCOPE_AGENT) : TMR[0]; const unsigned long long t0 = __builtin_amdgcn_s_memrealtime(); while (__builtin_amdgcn_s_memrealtime() - t0 < 10ull * t_acc) __builtin_amdgcn_s_sleep(8); } }
}

extern "C" void kernel_launch(void* const* d_in, const int* in_sizes, int n_in, void* d_out, int out_size, void* d_ws, size_t ws_size, hipStream_t stream) {
    static int grid = 0;
    if (!grid) {
        int dev = 0, cus = 0;
        (void)hipGetDevice(&dev); (void)hipDeviceGetAttribute(&cus, hipDeviceAttributeMultiprocessorCount, dev);
        if (cus < 1) cus = 256;
        if (hipFuncSetAttribute((const void*)fwd, hipFuncAttributeMaxDynamicSharedMemorySize, LDS_BYTES) != hipSuccess) fprintf(stderr, "kernel_launch: hipFuncSetAttribute failed\n");
        int per_cu = 0; (void)hipOccupancyMaxActiveBlocksPerMultiprocessor(&per_cu, (const void*)fwd, NT_, LDS_BYTES); (void)hipGetLastError();
        if (per_cu < 1) fprintf(stderr, "kernel_launch: occupancy query says %d\n", per_cu);
        grid = cus;
    }
    if (n_in != N_IN || (size_t)out_size != O_END || ws_size < B_END) fprintf(stderr, "kernel_launch: unexpected sizes n_in=%d out=%d ws=%zu need %zu\n", n_in, out_size, ws_size, (size_t)B_END);
    (void)hipMemsetAsync(d_ws, 0, CTL_BYTES, stream);
    Params p{};
    for (int i = 0; i < N_IN; ++i) p.in[i] = (const float*)d_in[i];
    p.out = (float*)d_out; p.ws = (unsigned char*)d_ws;
#if MK_MULTI
    for (int ph = 0; ph < NPH; ++ph) {
        if (!phase_nonempty(ph)) continue;
        p.ph_lo = ph; p.ph_hi = ph + 1;
        hipLaunchKernelGGL(fwd, dim3(grid), dim3(NT_), LDS_BYTES, stream, p);
    }
#else
    p.ph_lo = 0; p.ph_hi = NPH;
    hipLaunchKernelGGL(fwd, dim3(grid), dim3(NT_), LDS_BYTES, stream, p);
#endif
}

#ifdef REGTEST
__global__ void __launch_bounds__(NT_, 2) rt_nsa(Params p) { extern __shared__ __attribute__((aligned(16))) unsigned char l_[]; ph_nsa_fast(p, 0, (LAS unsigned char*)l_); }
__global__ void __launch_bounds__(NT_, 2) rt_mlstm(Params p) { extern __shared__ __attribute__((aligned(16))) unsigned char l_[]; ph_mlstm_fast(p, 0, (LAS unsigned char*)l_); }
__global__ void __launch_bounds__(NT_, 2) rt_nsas(Params p) { extern __shared__ __attribute__((aligned(16))) unsigned char l_[]; ph_nsa_sample(p, 0, (LAS unsigned char*)l_); }
__global__ void __launch_bounds__(NT_, 2) rt_mem(Params p) { extern __shared__ __attribute__((aligned(16))) unsigned char l_[]; ph_mem_attn_fast(p, 0, (LAS unsigned char*)l_, 0, 256, 1); }
__global__ void __launch_bounds__(NT_, 2) rt_cmp(Params p) { extern __shared__ __attribute__((aligned(16))) unsigned char l_[]; ph_compress_fast(p, (LAS unsigned char*)l_); }
#endif
```
